# Optimizing an MI355X kernel written in HIP

```python
import math
import jax, jax.numpy as jnp
from jax import lax
import numpy as np

D_MODEL = 1024
BATCH = 8
SEQ = 2048
DEPTH = 4

GRID_W = 64
CTX_LEN = 256
N_MIXERS = 3
N_LAYERS_A = (DEPTH + 2) // 3
N_LAYERS_B = (DEPTH + 1) // 3
N_LAYERS_C = DEPTH // 3
CHUNK = 64
EPS = 1e-6
CONV_W = 3

A_HEADS = 8
A_QK = D_MODEL // 2
A_V = D_MODEL
A_DK = A_QK // A_HEADS
A_DV = A_V // A_HEADS
A_IN = 2 * A_QK + 2 * A_V + 4 * A_HEADS

B_HEADS = 4
B_QK = D_MODEL // 2
B_V = D_MODEL
B_DK = B_QK // B_HEADS
B_DV = B_V // B_HEADS
B_RANK = 16
B_TAU = 16.0
B_IN = 2 * B_QK + 2 * B_V + 2 * B_RANK

C_FF = 64
C_BANDS = 16
C_EMB = 1 + 2 * C_BANDS
C_INNER = 2
C_TARGET = 1e-2
C_FAST = 0.3
C_SLOW = 1.5

N_EXPERTS = 16
N_GROUPS = 4
EXPERTS_PER_GROUP = N_EXPERTS // N_GROUPS
TOP_K = 2
EXPERT_FF = 1024
MOE_BLOCK = 512

kernel_name = "hybrid_mlstm_gla_hyena_moe_dit"

F32 = jnp.float32


def rmsnorm(x, g):
    xf = x.astype(F32)
    y = xf * lax.rsqrt(jnp.mean(jnp.square(xf), -1, keepdims=True) + EPS)
    return y.astype(x.dtype) * g


def short_conv(x, w, b):
    xp = jnp.pad(x, ((0, 0), (1, 1), (0, 0)))
    return xp[:, :-2] * w[0] + xp[:, 1:-1] * w[1] + xp[:, 2:] * w[2] + b


def to_heads(t, n_heads):
    bsz, s, w = t.shape
    return t.reshape(bsz, s, n_heads, w // n_heads).transpose(0, 2, 1, 3)


def head_rmsnorm(y, g):
    y = y * lax.rsqrt(jnp.mean(jnp.square(y), -1, keepdims=True) + EPS)
    bsz, h, s, d = y.shape
    return y.transpose(0, 2, 1, 3).reshape(bsz, s, h * d).astype(g.dtype) * g


def raster_to_columns(t):
    bsz, s, w = t.shape
    rows = s // GRID_W
    return t.reshape(bsz, rows, GRID_W, w).transpose(0, 2, 1, 3).reshape(bsz, s, w)


def columns_to_raster(t):
    bsz, s, w = t.shape
    rows = s // GRID_W
    return t.reshape(bsz, GRID_W, rows, w).transpose(0, 2, 1, 3).reshape(bsz, s, w)


def run_chunks(step, state0, seqs):
    s = seqs[0].shape[2]
    nc = s // CHUNK
    split = lambda a: jnp.moveaxis(a.reshape(a.shape[:2] + (nc, CHUNK) + a.shape[3:]), 2, 0)
    state, ys = lax.scan(step, state0, tuple(split(a) for a in seqs))
    ys = jnp.moveaxis(ys, 0, 2)
    return ys.reshape(ys.shape[:2] + (s,) + ys.shape[4:]), state


def bidirectional_scan(step, state0, ctx_f, ctx_b, lat_f, lat_b):
    flip = lambda seq: tuple(jnp.flip(a, axis=2) for a in seq)
    yc_f, sc_f = run_chunks(step, state0, ctx_f)
    yl_f, _ = run_chunks(step, sc_f, lat_f)
    yc_b, sc_b = run_chunks(step, state0, flip(ctx_b))
    yl_b, _ = run_chunks(step, sc_b, flip(lat_b))
    return yc_f + jnp.flip(yc_b, 2), yl_f + jnp.flip(yl_b, 2)


def mlstm_chunk(carry, inp):
    C, n, m = carry
    q, k, v, ig, lf = inp
    L = q.shape[2]
    causal = jnp.tril(jnp.ones((L, L), bool))
    b = jnp.cumsum(lf, axis=-1)
    log_d = jnp.where(causal, b[..., :, None] - b[..., None, :] + ig[..., None, :], -jnp.inf)
    log_inter = b + m[..., None]
    m_row = jnp.maximum(log_inter, jnp.max(log_d, -1))
    s = jnp.einsum('bhjd,bhsd->bhjs', q, k) * jnp.exp(log_d - m_row[..., None])
    w_inter = jnp.exp(log_inter - m_row)
    num = jnp.einsum('bhjs,bhsv->bhjv', s, v) + w_inter[..., None] * jnp.einsum('bhjd,bhdv->bhjv', q, C)
    den = jnp.sum(s, -1) + w_inter * jnp.einsum('bhjd,bhd->bhj', q, n)
    h = num / jnp.maximum(jnp.abs(den), jnp.exp(-m_row))[..., None]
    b_end = b[..., -1]
    log_end = b_end[..., None] - b + ig
    m_new = jnp.maximum(b_end + m, jnp.max(log_end, -1))
    w_k = jnp.exp(log_end - m_new[..., None])
    decay = jnp.exp(b_end + m - m_new)
    C_new = decay[..., None, None] * C + jnp.einsum('bhs,bhsd,bhsv->bhdv', w_k, k, v)
    n_new = decay[..., None] * n + jnp.einsum('bhs,bhsd->bhd', w_k, k)
    return (C_new, n_new, m_new), h


def gla_chunk(S, inp):
    q, k, v, lg = inp
    L = q.shape[2]
    causal = jnp.tril(jnp.ones((L, L), bool))
    b = jnp.cumsum(lg, axis=2)
    diff = jnp.where(causal[:, :, None], b[:, :, :, None, :] - b[:, :, None, :, :], -jnp.inf)
    A = jnp.einsum('bhjd,bhsd,bhjsd->bhjs', q, k, jnp.exp(diff))
    o = jnp.einsum('bhjs,bhsv->bhjv', A, v) + jnp.einsum('bhjd,bhdv->bhjv', q * jnp.exp(b), S)
    b_end = b[:, :, -1:, :]
    S_new = jnp.exp(b_end[:, :, 0, :, None]) * S + jnp.einsum('bhsd,bhsv->bhdv', k * jnp.exp(b_end - b), v)
    return S_new, o


def mlstm_mixer(hc, hl, w_in, b_gate, conv_w, conv_b, norm_g, w_out):
    def prep(h):
        p = h @ w_in
        qk = jax.nn.silu(short_conv(p[..., :2 * A_QK], conv_w, conv_b))
        q = to_heads(qk[..., :A_QK], A_HEADS).astype(F32) * (A_DK ** -0.5)
        k = to_heads(qk[..., A_QK:], A_HEADS).astype(F32)
        v = to_heads(p[..., 2 * A_QK:2 * A_QK + A_V], A_HEADS).astype(F32)
        o = jax.nn.sigmoid(p[..., 2 * A_QK + A_V:2 * A_QK + 2 * A_V])
        g = (p[..., 2 * A_QK + 2 * A_V:] + b_gate).astype(F32)
        g = g.reshape(g.shape[0], g.shape[1], 4, A_HEADS).transpose(2, 0, 3, 1)
        fwd = (q, k, v, g[0], jax.nn.log_sigmoid(g[1]))
        bwd = (q, k, v, g[2], jax.nn.log_sigmoid(g[3]))
        return fwd, bwd, o
    cf, cb, oc = prep(hc)
    lf, lb, ol = prep(hl)
    bsz = hl.shape[0]
    state0 = (jnp.zeros((bsz, A_HEADS, A_DK, A_DV), F32), jnp.zeros((bsz, A_HEADS, A_DK), F32),
              jnp.zeros((bsz, A_HEADS), F32))
    yc, yl = bidirectional_scan(mlstm_chunk, state0, cf, cb, lf, lb)
    post = lambda y, o: (head_rmsnorm(y, norm_g) * o) @ w_out
    return post(yc, oc), post(yl, ol)


def gla_mixer(hc, hl, w_in, conv_w, conv_b, gate_w2, gate_b, norm_g, w_out):
    hl = raster_to_columns(hl)
    def prep(h):
        p = h @ w_in
        qkv = jax.nn.silu(short_conv(p[..., :2 * B_QK + B_V], conv_w, conv_b))
        q = to_heads(qkv[..., :B_QK], B_HEADS).astype(F32) * (B_DK ** -0.5)
        k = to_heads(qkv[..., B_QK:2 * B_QK], B_HEADS).astype(F32)
        v = to_heads(qkv[..., 2 * B_QK:], B_HEADS).astype(F32)
        g = p[..., 2 * B_QK + B_V:2 * B_QK + 2 * B_V]
        low = p[..., 2 * B_QK + 2 * B_V:]
        def log_alpha(d):
            pre = low[..., d * B_RANK:(d + 1) * B_RANK] @ gate_w2[d] + gate_b[d]
            return to_heads(jax.nn.log_sigmoid(pre.astype(F32)) / B_TAU, B_HEADS)
        return (q, k, v, log_alpha(0)), (q, k, v, log_alpha(1)), g
    cf, cb, gc = prep(hc)
    lf, lb, gl = prep(hl)
    state0 = jnp.zeros((hl.shape[0], B_HEADS, B_DK, B_DV), F32)
    yc, yl = bidirectional_scan(gla_chunk, state0, cf, cb, lf, lb)
    post = lambda y, g: (head_rmsnorm(y, norm_g) * jax.nn.silu(g)) @ w_out
    return post(yc, gc), columns_to_raster(post(yl, gl))


def hyena_filters(L, w1, b1, w_mid, b_mid, w_out, freq):
    t = jnp.linspace(0.0, 1.0, L, dtype=F32)[:, None]
    pos = jnp.arange(L, dtype=F32)[:, None]
    bands = jnp.linspace(1e-4, C_BANDS - 1, C_BANDS, dtype=F32)[None, :]
    ang = (2.0 * math.pi / L) * pos * bands
    feats = jnp.concatenate([t, jnp.cos(ang), -jnp.sin(ang)], -1)
    fr = freq.astype(F32)
    h = jnp.sin(fr * (feats @ w1.astype(F32) + b1.astype(F32)))
    for m in range(C_INNER):
        h = jnp.sin(fr * (h @ w_mid[m].astype(F32) + b_mid[m].astype(F32)))
    h = (h @ w_out.astype(F32)).reshape(L, 2, D_MODEL)
    deltas = jnp.abs(jnp.linspace(math.log(C_TARGET) / C_SLOW, math.log(C_TARGET) / C_FAST, D_MODEL, dtype=F32))
    h = h * jnp.exp(-t * deltas)[:, None, :]
    hf, hb = h[:, 0], h[:, 1]
    l1 = jnp.sum(jnp.abs(hf), 0) + jnp.sum(jnp.abs(hb[1:]), 0)
    return hf / l1, hb / l1


def bidir_fft_conv(z, hf, hb, skip):
    bsz, L, C = z.shape
    k = jnp.concatenate([hf, jnp.zeros((1, C), F32), hb[:0:-1]], 0)
    kf = jnp.fft.rfft(k, axis=0)
    zf = jnp.fft.rfft(z.astype(F32), n=2 * L, axis=1)
    y = jnp.fft.irfft(zf * kf[None], n=2 * L, axis=1)[:, :L]
    return (y + z.astype(F32) * skip.astype(F32)).astype(z.dtype)


def hyena_mixer(hc, hl, w_in, b_in, conv_w, conv_b, fw1, fb1, fw_mid, fb_mid, fw_out, freq, skip, w_out, b_out):
    def apply(h):
        L = h.shape[1]
        u = short_conv(h @ w_in + b_in, conv_w, conv_b)
        x0, x1, v = u[..., :D_MODEL], u[..., D_MODEL:2 * D_MODEL], u[..., 2 * D_MODEL:]
        hf, hb = hyena_filters(L, fw1, fb1, fw_mid, fb_mid, fw_out, freq)
        z = bidir_fft_conv(x1 * v, hf, hb, skip)
        return (x0 * z) @ w_out + b_out
    return apply(hc), apply(hl)


def moe_ffn(h, router_w, router_b, w1, w3, w2):
    T, D = h.shape
    scores = jax.nn.sigmoid(h.astype(F32) @ router_w.astype(F32))
    sel = (scores + router_b.astype(F32)).reshape(T, N_GROUPS, EXPERTS_PER_GROUP)
    group = jnp.argmax(jnp.sum(lax.top_k(sel, TOP_K)[0], -1), -1)
    in_group = sel[jnp.arange(T), group]
    _, local = lax.top_k(in_group, TOP_K)
    expert_ids = group[:, None] * EXPERTS_PER_GROUP + local
    gate = jnp.take_along_axis(scores, expert_ids, axis=1)
    gate = gate / jnp.sum(gate, -1, keepdims=True)
    n_assign = T * TOP_K
    e_flat = expert_ids.reshape(-1)
    tok_flat = jnp.repeat(jnp.arange(T, dtype=jnp.int32), TOP_K)
    w_flat = gate.reshape(-1)
    counts = jnp.bincount(e_flat, length=N_EXPERTS)
    padded = (counts + MOE_BLOCK - 1) // MOE_BLOCK * MOE_BLOCK
    pad_end = jnp.cumsum(padded)
    pad_start = pad_end - padded
    start = jnp.cumsum(counts) - counts
    order = jnp.argsort(e_flat)
    e_sorted = e_flat[order]
    dest = pad_start[e_sorted] + (jnp.arange(n_assign) - start[e_sorted])
    n_blocks = n_assign // MOE_BLOCK + N_EXPERTS
    n_slots = n_blocks * MOE_BLOCK
    slot_tok = jnp.full((n_slots,), T, jnp.int32).at[dest].set(tok_flat[order])
    slot_w = jnp.zeros((n_slots,), h.dtype).at[dest].set(w_flat[order].astype(h.dtype))
    block_exp = jnp.minimum(jnp.searchsorted(pad_end, jnp.arange(n_blocks) * MOE_BLOCK, side='right'), N_EXPERTS - 1)
    h_pad = jnp.concatenate([h, jnp.zeros((1, D), h.dtype)], 0)
    xb = h_pad[slot_tok].reshape(n_blocks, MOE_BLOCK, D)
    def expert_block(args):
        xblk, e = args
        return (jax.nn.silu(xblk @ w1[e]) * (xblk @ w3[e])) @ w2[e]
    yb = lax.map(expert_block, (xb, block_exp)).reshape(n_slots, D)
    out = jnp.zeros((T + 1, D), h.dtype).at[slot_tok].add(yb * slot_w[:, None])
    return out[:T]


def setup_inputs(seed: int = 0) -> dict:
    key = jax.random.key(seed)
    ks = iter(jax.random.split(key, 64))
    nrm = lambda shape, scale: jax.random.normal(next(ks), shape, F32) * scale
    D = D_MODEL
    nA, nB, nC = N_LAYERS_A, N_LAYERS_B, N_LAYERS_C
    f_bias = jnp.linspace(3.0, 6.0, A_HEADS, dtype=F32)
    zh = jnp.zeros((A_HEADS,), F32)
    gate_base = jnp.concatenate([zh, f_bias, zh, f_bias])
    return {
        'x': nrm((BATCH, SEQ, D), 1.0),
        'c': nrm((BATCH, D), 1.0),
        'ctx': nrm((BATCH, CTX_LEN, D), 1.0),
        'c_ctx': nrm((D,), 1.0),
        'ada_w': nrm((DEPTH, D, 6 * D), 0.5 * D ** -0.5),
        'ada_b': nrm((DEPTH, 6 * D), 0.02),
        'norm1_g': 1.0 + nrm((DEPTH, D), 0.02),
        'norm2_g': 1.0 + nrm((DEPTH, D), 0.02),
        'final_g': 1.0 + nrm((D,), 0.02),
        'ml_w_in': nrm((nA, D, A_IN), D ** -0.5),
        'ml_b_gate': gate_base + nrm((nA, 4 * A_HEADS), 0.1),
        'ml_conv_w': nrm((nA, CONV_W, 2 * A_QK), CONV_W ** -0.5),
        'ml_conv_b': nrm((nA, 2 * A_QK), 0.02),
        'ml_norm_g': 1.0 + nrm((nA, A_V), 0.02),
        'ml_w_out': nrm((nA, A_V, D), A_V ** -0.5),
        'gla_w_in': nrm((nB, D, B_IN), D ** -0.5),
        'gla_conv_w': nrm((nB, CONV_W, 2 * B_QK + B_V), CONV_W ** -0.5),
        'gla_conv_b': nrm((nB, 2 * B_QK + B_V), 0.02),
        'gla_gate_w2': nrm((nB, 2, B_RANK, B_QK), B_RANK ** -0.5),
        'gla_gate_b': nrm((nB, 2, B_QK), 0.1),
        'gla_norm_g': 1.0 + nrm((nB, B_V), 0.02),
        'gla_w_out': nrm((nB, B_V, D), B_V ** -0.5),
        'hy_w_in': nrm((nC, D, 3 * D), D ** -0.5),
        'hy_b_in': nrm((nC, 3 * D), 0.02),
        'hy_conv_w': nrm((nC, CONV_W, 3 * D), CONV_W ** -0.5),
        'hy_conv_b': nrm((nC, 3 * D), 0.02),
        'hy_filt_w1': nrm((nC, C_EMB, C_FF), C_EMB ** -0.5),
        'hy_filt_b1': nrm((nC, C_FF), 0.02),
        'hy_filt_w_mid': nrm((nC, C_INNER, C_FF, C_FF), C_FF ** -0.5),
        'hy_filt_b_mid': nrm((nC, C_INNER, C_FF), 0.02),
        'hy_filt_w_out': nrm((nC, C_FF, 2 * D), C_FF ** -0.5),
        'hy_filt_freq': 1.0 + nrm((nC, C_FF), 0.1),
        'hy_skip': nrm((nC, D), 1.0),
        'hy_w_out': nrm((nC, D, D), D ** -0.5),
        'hy_b_out': nrm((nC, D), 0.02),
        'router_w': nrm((D, N_EXPERTS), D ** -0.5),
        'router_b': nrm((N_EXPERTS,), 0.01),
        'exp_w1': nrm((DEPTH, N_EXPERTS, D, EXPERT_FF), D ** -0.5),
        'exp_w3': nrm((DEPTH, N_EXPERTS, D, EXPERT_FF), D ** -0.5),
        'exp_w2': nrm((DEPTH, N_EXPERTS, EXPERT_FF, D), EXPERT_FF ** -0.5),
    }


def reference(x, c, ctx, c_ctx, ada_w, ada_b, norm1_g, norm2_g, final_g,
              ml_w_in, ml_b_gate, ml_conv_w, ml_conv_b, ml_norm_g, ml_w_out,
              gla_w_in, gla_conv_w, gla_conv_b, gla_gate_w2, gla_gate_b, gla_norm_g, gla_w_out,
              hy_w_in, hy_b_in, hy_conv_w, hy_conv_b, hy_filt_w1, hy_filt_b1, hy_filt_w_mid,
              hy_filt_b_mid, hy_filt_w_out, hy_filt_freq, hy_skip, hy_w_out, hy_b_out,
              router_w, router_b, exp_w1, exp_w3, exp_w2):
    bsz, s, D = x.shape
    xc = ctx
    n_ctx_tok = bsz * ctx.shape[1]
    silu_c = jax.nn.silu(c)
    silu_cc = jax.nn.silu(c_ctx)
    for i in range(DEPTH):
        last = i == DEPTH - 1
        mod = silu_c @ ada_w[i] + ada_b[i]
        mod_c = silu_cc @ ada_w[i] + ada_b[i]
        sh1, sc1, g1, sh2, sc2, g2 = jnp.split(mod[:, None, :], 6, axis=-1)
        sh1c, sc1c, g1c, sh2c, sc2c, g2c = jnp.split(mod_c, 6, axis=-1)
        hl = rmsnorm(x, norm1_g[i]) * (1.0 + sc1) + sh1
        hc = rmsnorm(xc, norm1_g[i]) * (1.0 + sc1c) + sh1c
        kind, j = i % N_MIXERS, i // N_MIXERS
        if kind == 0:
            yc, yl = mlstm_mixer(hc, hl, ml_w_in[j], ml_b_gate[j], ml_conv_w[j], ml_conv_b[j],
                                 ml_norm_g[j], ml_w_out[j])
        elif kind == 1:
            yc, yl = gla_mixer(hc, hl, gla_w_in[j], gla_conv_w[j], gla_conv_b[j], gla_gate_w2[j],
                               gla_gate_b[j], gla_norm_g[j], gla_w_out[j])
        else:
            yc, yl = hyena_mixer(hc, hl, hy_w_in[j], hy_b_in[j], hy_conv_w[j], hy_conv_b[j],
                                 hy_filt_w1[j], hy_filt_b1[j], hy_filt_w_mid[j], hy_filt_b_mid[j],
                                 hy_filt_w_out[j], hy_filt_freq[j], hy_skip[j], hy_w_out[j], hy_b_out[j])
        x = x + g1 * yl
        hl = rmsnorm(x, norm2_g[i]) * (1.0 + sc2) + sh2
        if last:
            x = x + g2 * moe_ffn(hl.reshape(-1, D), router_w, router_b, exp_w1[i], exp_w3[i], exp_w2[i]).reshape(bsz, s, D)
        else:
            xc = xc + g1c * yc
            hc = rmsnorm(xc, norm2_g[i]) * (1.0 + sc2c) + sh2c
            tokens = jnp.concatenate([hc.reshape(-1, D), hl.reshape(-1, D)], 0)
            y = moe_ffn(tokens, router_w, router_b, exp_w1[i], exp_w3[i], exp_w2[i])
            xc = xc + g2c * y[:n_ctx_tok].reshape(xc.shape)
            x = x + g2 * y[n_ctx_tok:].reshape(bsz, s, D)
    return rmsnorm(x, final_g)
```

```cpp
#include <hip/hip_runtime.h>
#include <hip/hip_cooperative_groups.h>
#include <cstdio>
#include <cstdint>
namespace cg = cooperative_groups;

#define LAS __attribute__((address_space(3)))
#define DI __device__ __forceinline__
typedef unsigned short bf16;
typedef float f32x4 __attribute__((ext_vector_type(4)));
typedef float f32x2 __attribute__((ext_vector_type(2)));
typedef unsigned u32x4 __attribute__((ext_vector_type(4)));
typedef unsigned u32x2 __attribute__((ext_vector_type(2)));
typedef short bf16x8 __attribute__((ext_vector_type(8)));

#ifndef FAST_GEMM
#define FAST_GEMM 1
#endif
#ifndef PH_MASK
#define PH_MASK 0xFFFFFFFFu
#endif
#define PH_EN(b) ((PH_MASK >> (b)) & 1u)
#ifndef N_LAUNCH_PER_PHASE
#define N_LAUNCH_PER_PHASE 0
#endif

constexpr int D = 1024, NB = 8, SEQ = 2048, CTX = 256, DEPTH = 4;
constexpr int TC = NB * CTX, TL = NB * SEQ, TT = TC + TL;
constexpr int NEXP = 16;
constexpr int PLD = 3072;
constexpr int NINP = 3328;
constexpr float EPS = 1e-6f;
constexpr int MAXSLOT = 40960;

constexpr size_t MiB = 1u << 20;
constexpr size_t WS_CTL = 0;
constexpr size_t WS_MOD = 1 * MiB;
constexpr size_t WS_HM = 2 * MiB;
constexpr size_t WS_TOK = 3 * MiB;
constexpr size_t WS_HF = 4 * MiB;
constexpr size_t WS_HFC = 20 * MiB;
constexpr size_t WS_ML_WIN = 32 * MiB;
constexpr size_t WS_ML_WOUT = 45 * MiB;
constexpr size_t WS_GLA_WIN = 49 * MiB;
constexpr size_t WS_GLA_WOUT = 56 * MiB;
constexpr size_t WS_HY_WIN = 58 * MiB;
constexpr size_t WS_HY_WOUT = 64 * MiB;
constexpr size_t WS_EXP_UP = 66 * MiB;
constexpr size_t WS_EXP_DN = 322 * MiB;
constexpr size_t WS_X = 450 * MiB;
constexpr size_t WS_XC = 514 * MiB;
constexpr size_t WS_H = 522 * MiB;
constexpr size_t WS_P = 558 * MiB;
constexpr size_t WS_EXTRA = 667 * MiB;
constexpr size_t WS_Y = 670 * MiB;
constexpr size_t WS_BIG = 706 * MiB;
constexpr size_t WS_END = 962 * MiB;
constexpr size_t BIG_HS = 0;
constexpr size_t BIG_ACT = 80 * MiB;
constexpr size_t BIG_PC = 0;
constexpr size_t BIG_YF = 108 * MiB;
constexpr size_t BIG_YB = 180 * MiB;

constexpr int CW_CNT = 1024;

constexpr int LDS_BYTES = 147456;
constexpr int MISC_OFF = 131072;

struct Params {
    const float* in[40];
    float* out;
    unsigned char* ws;
    int ph_lo, ph_hi;
};
enum { I_X = 0, I_C, I_CTX, I_CCTX, I_ADAW, I_ADAB, I_N1G, I_N2G, I_FING, I_MLWIN, I_MLBG, I_MLCW, I_MLCB, I_MLNG, I_MLWOUT,
       I_GLWIN, I_GLCW, I_GLCB, I_GLW2, I_GLGB, I_GLNG, I_GLWOUT, I_HYWIN, I_HYBIN, I_HYCW, I_HYCB, I_HYFW1, I_HYFB1, I_HYFWM, I_HYFBM,
       I_HYFWO, I_HYFREQ, I_HYSKIP, I_HYWOUT, I_HYBOUT, I_RW, I_RB, I_EW1, I_EW3, I_EW2 };

DI float bf2f(bf16 v) { return __uint_as_float(((unsigned)v) << 16); }
DI unsigned cvt_pk_bf16(float lo, float hi) { unsigned r; asm volatile("v_cvt_pk_bf16_f32 %0, %1, %2" : "=v"(r) : "v"(lo), "v"(hi)); return r; }
DI bf16 f2bf(float f) { return (bf16)(cvt_pk_bf16(f, 0.f) & 0xffffu); }
DI float sigmoidf_(float x) { return 1.0f / (1.0f + __expf(-x)); }
DI float siluf_(float x) { return x / (1.0f + __expf(-x)); }
DI float logsigf_(float x) { return fminf(x, 0.f) - log1pf(__expf(-fabsf(x))); }
DI float wave_sum(float v) {
#pragma unroll
    for (int o = 1; o < 64; o <<= 1) v += __shfl_xor(v, o);
    return v;
}
DI void unpack8(const u32x4 w, float (&v)[8]) {
    v[0] = __uint_as_float(w.x << 16); v[1] = __uint_as_float(w.x & 0xffff0000u);
    v[2] = __uint_as_float(w.y << 16); v[3] = __uint_as_float(w.y & 0xffff0000u);
    v[4] = __uint_as_float(w.z << 16); v[5] = __uint_as_float(w.z & 0xffff0000u);
    v[6] = __uint_as_float(w.w << 16); v[7] = __uint_as_float(w.w & 0xffff0000u);
}
DI u32x4 pack8(const float (&v)[8]) { u32x4 w; w.x = cvt_pk_bf16(v[0], v[1]); w.y = cvt_pk_bf16(v[2], v[3]); w.z = cvt_pk_bf16(v[4], v[5]); w.w = cvt_pk_bf16(v[6], v[7]); return w; }
DI void seq_bounds(int row, int& lo, int& hi) {
    if (row < TC) { lo = row & ~(CTX - 1); hi = lo + CTX - 1; } else { lo = TC + ((row - TC) & ~(SEQ - 1)); hi = lo + SEQ - 1; }
}
DI int perm_fwd(int s) { return (s & 63) * 32 + (s >> 6); }
DI int perm_inv(int sp) { return (sp & 31) * 64 + (sp >> 5); }

namespace pg8 {
constexpr int BM = 256, BK = 64, HALF = 128, HTB = HALF * BK * 2, STAGE_BYTES = 8 * HTB, NXCD = 8, WGM = 8;
__host__ __device__ __forceinline__ int lds_byte(int r, int c) { const int st = (r >> 4) * 2 + (c >> 5), rr = r & 15, cc = c & 31, ob = rr * 64 + cc * 2; return st * 1024 + (ob ^ (((ob >> 9) & 1) << 5)); }
__host__ __device__ __forceinline__ void stage_rc(int b, int& R, int& C) { const int st = b / 1024, sb = b % 1024, swz = sb ^ (((sb >> 9) & 1) << 5); R = (st >> 1) * 16 + swz / 64; C = (st & 1) * 32 + (swz % 64) / 2; }
__host__ __device__ __forceinline__ int perm32(int rho) { const int n = rho >> 4, i = rho & 15; return 8 * (i >> 2) + 4 * n + (i & 3); }
}
struct Unit { int pm, pn, e; };

struct DenseOrder {
    const bf16* A; const bf16* Bt; int nM, nN, nwg, G, c;
    DI void init(const bf16* A_, const bf16* Bt_, int M, int N) { A = A_; Bt = Bt_; nM = M / 256; nN = N / 256; nwg = nM * nN; G = gridDim.x; c = blockIdx.x; }
    DI bool next(int i, Unit& u) const {
        const int L = i * G + c; if (L >= nwg) return false;
        int wgid = L; { const int q = nwg / 8, r = nwg % 8, xcd = wgid % 8, off = wgid / 8; wgid = (xcd < r ? xcd * (q + 1) : r * (q + 1) + (xcd - r) * q) + off; }
        const int nig = 8 * nN, gid = wgid / nig, fm = gid * 8, gsz = (nM - fm) < 8 ? (nM - fm) : 8;
        u.pm = fm + ((wgid % nig) % gsz); u.pn = (wgid % nig) / gsz; u.e = 0; return true;
    }
    DI const bf16* aptr(const Unit& u) const { return A + (size_t)u.pm * 256 * 1024; }
    DI const bf16* bptr(const Unit& u) const { return Bt + (size_t)u.pn * 256 * 1024; }
};
struct MoeOrder {
    const bf16* A; const bf16* Bt; size_t bstride; int nsh, G, c; const LAS int* tp;
    DI bool next(int i, Unit& u) const {
        const int L = i * G + c; const int ntile = __builtin_amdgcn_readfirstlane(tp[0]); if (L >= (ntile << nsh)) return false;
        const int rt = L >> nsh; u.pm = rt; u.pn = L & ((1 << nsh) - 1); u.e = __builtin_amdgcn_readfirstlane(tp[1 + rt]); return true;
    }
    DI const bf16* aptr(const Unit& u) const { return A + (size_t)u.pm * 256 * 1024; }
    DI const bf16* bptr(const Unit& u) const { return Bt + (size_t)u.e * bstride + (size_t)u.pn * 256 * 1024; }
};

struct EpiInproj {
    static constexpr bool PAIR = false;
    bf16* P; float* extra; const float* bias; const float* bias_x;
    DI void row8(const Unit& u, int r, int c, const float (&v)[8]) const {
        const int row = u.pm * 256 + r, col = u.pn * 256 + c;
        if (col < PLD) {
            float w[8];
#pragma unroll
            for (int j = 0; j < 8; ++j) w[j] = v[j] + (bias ? bias[col + j] : 0.f);
            *(u32x4*)(P + (size_t)row * PLD + col) = pack8(w);
        } else if (col < PLD + 32) {
            float* o = extra + (size_t)row * 32 + (col - PLD);
#pragma unroll
            for (int j = 0; j < 8; ++j) o[j] = v[j] + (bias_x ? bias_x[col - PLD + j] : 0.f);
        }
    }
};
struct EpiOutproj {
    static constexpr bool PAIR = false;
    const float* xs_l; const float* xs_c; float* X; float* XC; const float* mod; const float* bias; int row_off; int perm;
    DI void row8(const Unit& u, int r, int c, const float (&v)[8]) const {
        const int hrow = u.pm * 256 + r + row_off, col = u.pn * 256 + c;
        const float* src; float* dst; int mr;
        if (hrow < TC) { mr = 8; src = xs_c + (size_t)hrow * D + col; dst = XC + (size_t)hrow * D + col; }
        else { const int rr = hrow - TC, b = rr >> 11, sp = rr & (SEQ - 1), s = perm ? perm_inv(sp) : sp; mr = b;
               src = xs_l + ((size_t)b * SEQ + s) * D + col; dst = X + ((size_t)b * SEQ + s) * D + col; }
        const float* g1 = mod + mr * 6144 + 2048 + col;
        const f32x4 a0 = *(const f32x4*)src, a1 = *(const f32x4*)(src + 4), g0 = *(const f32x4*)g1, gg1 = *(const f32x4*)(g1 + 4);
        f32x4 b0 = {0.f, 0.f, 0.f, 0.f}, b1 = b0;
        if (bias) { b0 = *(const f32x4*)(bias + col); b1 = *(const f32x4*)(bias + col + 4); }
        f32x4 o0, o1;
        o0 = a0 + g0 * ((f32x4){v[0], v[1], v[2], v[3]} + b0); o1 = a1 + gg1 * ((f32x4){v[4], v[5], v[6], v[7]} + b1);
        *(f32x4*)dst = o0; *(f32x4*)(dst + 4) = o1;
    }
};
struct EpiUp {
    static constexpr bool PAIR = true;
    bf16* ACT;
    DI void row8p(const Unit& u, int r, int c, const float (&g)[8], const float (&up)[8]) const {
        float w[8];
#pragma unroll
        for (int j = 0; j < 8; ++j) w[j] = siluf_(g[j]) * up[j];
        *(u32x4*)(ACT + ((size_t)u.pm * 256 + r) * 1024 + u.pn * 128 + c) = pack8(w);
    }
};
struct EpiDown {
    static constexpr bool PAIR = false;
    bf16* YS;
    DI void row8(const Unit& u, int r, int c, const float (&v)[8]) const { *(u32x4*)(YS + ((size_t)u.pm * 256 + r) * 1024 + u.pn * 256 + c) = pack8(v); }
};

template <class Sched, class Epi>
DI void gemm_fast(LAS unsigned char* lds, int tid, const Sched& S, const Epi& E) {
    using namespace pg8;
    constexpr int K = 1024, nt = K / BK;
    const int wid = __builtin_amdgcn_readfirstlane(tid >> 6), lane = tid & 63, wr = wid >> 2, wc = wid & 3, fr = lane & 15, fq = lane >> 4;
    unsigned voffA[2], voffB[2];
#pragma unroll
    for (int i = 0; i < 2; ++i) { int R, C; stage_rc(tid * 16 + i * 8192, R, C); const int Rb = (R & ~31) + perm32(R & 31);
        voffA[i] = (unsigned)(R * K + C) * 2u; voffB[i] = (unsigned)(Rb * K + C) * 2u; }
    const size_t kstep = (size_t)(BK * 2);
    const size_t hstep = (size_t)HALF * K * 2;
    const unsigned ldsw = (unsigned)wid * 1024u;
    const int aoff = lds_byte(wr * 64 + fr, fq * 8), boff = lds_byte(wc * 32 + fr, fq * 8);
#define PG8_SA(b, h) (((b) * 2 + (h)) * HTB)
#define PG8_SB(b, h) ((4 + (b) * 2 + (h)) * HTB)
#define PG8_STAGE(bufoff, gbase, voff) do { _Pragma("unroll") for (int _i = 0; _i < 2; ++_i) \
        __builtin_amdgcn_global_load_lds((const unsigned*)((const char*)(gbase) + (voff)[_i]), (LAS unsigned*)(lds + (bufoff) + ldsw + _i * 8192), 16, 0, 0); } while (0)
#define PG8_LDA(dst, b, h) do { _Pragma("unroll") for (int m = 0; m < 4; ++m) _Pragma("unroll") for (int k = 0; k < 2; ++k) dst[m][k] = *(const LAS bf16x8*)(lds + PG8_SA(b, h) + aoff + m * 2048 + k * 1024); } while (0)
#define PG8_LDB(dst, b, h) do { _Pragma("unroll") for (int n = 0; n < 2; ++n) _Pragma("unroll") for (int k = 0; k < 2; ++k) dst[n][k] = *(const LAS bf16x8*)(lds + PG8_SB(b, h) + boff + n * 2048 + k * 1024); } while (0)
#define PG8_MMA(ai, bj, At, Bt) do { __builtin_amdgcn_s_setprio(1); _Pragma("unroll") for (int m = 0; m < 4; ++m) _Pragma("unroll") for (int n = 0; n < 2; ++n) _Pragma("unroll") for (int k = 0; k < 2; ++k) \
        acc[ai][bj][m][n] = __builtin_amdgcn_mfma_f32_16x16x32_bf16(Bt[n][k], At[m][k], acc[ai][bj][m][n], 0, 0, 0); __builtin_amdgcn_s_setprio(0); } while (0)
#define PG8_WAIT_V(n) asm volatile("s_waitcnt vmcnt(" #n ")" ::: "memory")
#define PG8_WAIT_L(n) asm volatile("s_waitcnt lgkmcnt(" #n ")" ::: "memory")
#define PG8_BAR __builtin_amdgcn_s_barrier()
#define PG8_SCHED __builtin_amdgcn_sched_barrier(0)
    Unit cur, nxt; int ui = 0;
    if (!S.next(0, cur)) return;
    f32x4 acc[2][2][4][2];
#pragma unroll
    for (int a = 0; a < 2; ++a)
#pragma unroll
        for (int b = 0; b < 2; ++b)
#pragma unroll
            for (int m = 0; m < 4; ++m)
#pragma unroll
                for (int n = 0; n < 2; ++n) acc[a][b][m][n] = (f32x4){0.f, 0.f, 0.f, 0.f};
    bf16x8 At[4][2], B0[2][2], B1[2][2];
    const char* cA = (const char*)S.aptr(cur); const char* cB = (const char*)S.bptr(cur);
    PG8_STAGE(PG8_SB(0, 0), cB, voffB); PG8_STAGE(PG8_SA(0, 0), cA, voffA); PG8_STAGE(PG8_SB(0, 1), cB + hstep, voffB); PG8_STAGE(PG8_SA(0, 1), cA + hstep, voffA);
    if (wr == 1) PG8_BAR;
    PG8_WAIT_V(4); PG8_BAR;
    PG8_STAGE(PG8_SB(1, 0), cB + kstep, voffB); PG8_STAGE(PG8_SA(1, 0), cA + kstep, voffA); PG8_STAGE(PG8_SB(1, 1), cB + hstep + kstep, voffB);
    PG8_WAIT_V(6); PG8_BAR;
    for (;;) {
        const bool has_next = S.next(ui + 1, nxt);
        const char* nA = has_next ? (const char*)S.aptr(nxt) : cA; const char* nB = has_next ? (const char*)S.bptr(nxt) : cB;
        for (int t = 0; t < nt; t += 2) {
            const bool last = (t == nt - 2);
            const char* a1 = cA + (size_t)(t + 1) * kstep;
            const char* a2 = last ? nA : cA + (size_t)(t + 2) * kstep; const char* b2 = last ? nB : cB + (size_t)(t + 2) * kstep;
            const char* a3 = a2 + kstep; const char* b3 = b2 + kstep;
            PG8_LDB(B0, 0, 0); PG8_SCHED; PG8_LDA(At, 0, 0); PG8_STAGE(PG8_SA(1, 1), a1 + hstep, voffA);
            PG8_WAIT_L(8); PG8_BAR; PG8_WAIT_L(0); PG8_MMA(0, 0, At, B0); PG8_BAR; PG8_SCHED;
            PG8_LDB(B1, 0, 1); PG8_STAGE(PG8_SB(0, 0), b2, voffB);
            PG8_BAR; PG8_WAIT_L(0); PG8_MMA(0, 1, At, B1); PG8_BAR;
            PG8_LDA(At, 0, 1); PG8_STAGE(PG8_SA(0, 0), a2, voffA);
            PG8_BAR; PG8_WAIT_L(0); PG8_MMA(1, 0, At, B0); PG8_BAR; PG8_SCHED;
            PG8_STAGE(PG8_SB(0, 1), b2 + hstep, voffB);
            PG8_WAIT_V(6); PG8_BAR; PG8_MMA(1, 1, At, B1); PG8_BAR;
            PG8_LDB(B0, 1, 0); PG8_SCHED; PG8_LDA(At, 1, 0); PG8_STAGE(PG8_SA(0, 1), a2 + hstep, voffA);
            PG8_WAIT_L(8); PG8_BAR; PG8_WAIT_L(0); PG8_MMA(0, 0, At, B0); PG8_BAR; PG8_SCHED;
            PG8_LDB(B1, 1, 1); PG8_STAGE(PG8_SB(1, 0), b3, voffB);
            PG8_BAR; PG8_WAIT_L(0); PG8_MMA(0, 1, At, B1); PG8_BAR;
            PG8_LDA(At, 1, 1); PG8_STAGE(PG8_SA(1, 0), a3, voffA);
            PG8_BAR; PG8_WAIT_L(0); PG8_MMA(1, 0, At, B0); PG8_BAR; PG8_SCHED;
            PG8_STAGE(PG8_SB(1, 1), b3 + hstep, voffB);
            PG8_WAIT_V(6); PG8_BAR; PG8_MMA(1, 1, At, B1); PG8_BAR;
        }
#pragma unroll
        for (int ai = 0; ai < 2; ++ai)
#pragma unroll
            for (int m = 0; m < 4; ++m) {
                const int r = ai * HALF + wr * 64 + m * 16 + fr;
                if constexpr (Epi::PAIR) {
                    const float g[8] = {acc[ai][0][m][0][0], acc[ai][0][m][0][1], acc[ai][0][m][0][2], acc[ai][0][m][0][3], acc[ai][0][m][1][0], acc[ai][0][m][1][1], acc[ai][0][m][1][2], acc[ai][0][m][1][3]};
                    const float up[8] = {acc[ai][1][m][0][0], acc[ai][1][m][0][1], acc[ai][1][m][0][2], acc[ai][1][m][0][3], acc[ai][1][m][1][0], acc[ai][1][m][1][1], acc[ai][1][m][1][2], acc[ai][1][m][1][3]};
                    E.row8p(cur, r, wc * 32 + 8 * fq, g, up);
                } else {
#pragma unroll
                    for (int bj = 0; bj < 2; ++bj) {
                        const float v[8] = {acc[ai][bj][m][0][0], acc[ai][bj][m][0][1], acc[ai][bj][m][0][2], acc[ai][bj][m][0][3], acc[ai][bj][m][1][0], acc[ai][bj][m][1][1], acc[ai][bj][m][1][2], acc[ai][bj][m][1][3]};
                        E.row8(cur, r, bj * HALF + wc * 32 + 8 * fq, v);
                    }
                }
            }
        if (!has_next) break;
#pragma unroll
        for (int a = 0; a < 2; ++a)
#pragma unroll
            for (int b = 0; b < 2; ++b)
#pragma unroll
                for (int m = 0; m < 4; ++m)
#pragma unroll
                    for (int n = 0; n < 2; ++n) acc[a][b][m][n] = (f32x4){0.f, 0.f, 0.f, 0.f};
        cur = nxt; cA = nA; cB = nB; ++ui;
    }
    PG8_WAIT_V(0);
    if (wr == 0) PG8_BAR;
    PG8_BAR;
#undef PG8_SA
#undef PG8_SB
#undef PG8_STAGE
#undef PG8_LDA
#undef PG8_LDB
#undef PG8_MMA
#undef PG8_WAIT_V
#undef PG8_WAIT_L
#undef PG8_BAR
#undef PG8_SCHED
}

template <class Sched, class Epi>
DI void gemm_naive(LAS unsigned char* lds, int tid, const Sched& S, const Epi& E) {
    LAS float* As = (LAS float*)lds;
    LAS float* Bs = As + 32 * 132;
    LAS float* Bu = Bs + 32 * 132;
    const int ty = tid >> 4, tx = tid & 15, lr = tid >> 2, kq = tid & 3;
    Unit u;
    for (int i = 0; S.next(i, u); ++i) {
        const bf16* A = S.aptr(u); const bf16* B = S.bptr(u);
        for (int sm = 0; sm < 2; ++sm)
            for (int sn = 0; sn < (Epi::PAIR ? 1 : 2); ++sn) {
                float acc[4][8], accu[4][8];
#pragma unroll
                for (int a = 0; a < 4; ++a)
#pragma unroll
                    for (int b = 0; b < 8; ++b) { acc[a][b] = 0.f; accu[a][b] = 0.f; }
                for (int k0 = 0; k0 < 1024; k0 += 32) {
                    __syncthreads();
                    { float w[8]; unpack8(*(const u32x4*)(A + (size_t)(128 * sm + lr) * 1024 + k0 + 8 * kq), w);
#pragma unroll
                      for (int j = 0; j < 8; ++j) As[(8 * kq + j) * 132 + lr] = w[j];
                      unpack8(*(const u32x4*)(B + (size_t)(128 * sn + lr) * 1024 + k0 + 8 * kq), w);
#pragma unroll
                      for (int j = 0; j < 8; ++j) Bs[(8 * kq + j) * 132 + lr] = w[j];
                      if (Epi::PAIR) { unpack8(*(const u32x4*)(B + (size_t)(128 + lr) * 1024 + k0 + 8 * kq), w);
#pragma unroll
                          for (int j = 0; j < 8; ++j) Bu[(8 * kq + j) * 132 + lr] = w[j]; } }
                    __syncthreads();
#pragma unroll 4
                    for (int k = 0; k < 32; ++k) {
                        const f32x4 a4 = *(const LAS f32x4*)(As + k * 132 + 4 * ty);
                        const f32x4 b0 = *(const LAS f32x4*)(Bs + k * 132 + 8 * tx), b1 = *(const LAS f32x4*)(Bs + k * 132 + 8 * tx + 4);
#pragma unroll
                        for (int a = 0; a < 4; ++a) {
#pragma unroll
                            for (int b = 0; b < 4; ++b) { acc[a][b] += a4[a] * b0[b]; acc[a][4 + b] += a4[a] * b1[b]; } }
                        if (Epi::PAIR) {
                            const f32x4 c0 = *(const LAS f32x4*)(Bu + k * 132 + 8 * tx), c1 = *(const LAS f32x4*)(Bu + k * 132 + 8 * tx + 4);
#pragma unroll
                            for (int a = 0; a < 4; ++a) {
#pragma unroll
                                for (int b = 0; b < 4; ++b) { accu[a][b] += a4[a] * c0[b]; accu[a][4 + b] += a4[a] * c1[b]; } }
                        }
                    }
                }
#pragma unroll
                for (int a = 0; a < 4; ++a) {
                    if constexpr (Epi::PAIR) E.row8p(u, 128 * sm + 4 * ty + a, 8 * tx, acc[a], accu[a]);
                    else E.row8(u, 128 * sm + 4 * ty + a, 128 * sn + 8 * tx, acc[a]);
                }
            }
    }
    __syncthreads();
}
template <class Sched, class Epi>
DI void gemm_run(LAS unsigned char* lds, int tid, const Sched& S, const Epi& E) {
#if FAST_GEMM
    gemm_fast(lds, tid, S, E);
#else
    gemm_naive(lds, tid, S, E);
#endif
}

struct Ctx {
    LAS unsigned char* lds;
    int tid, lane, wave, gw, ngw;
    const float* const* in;
    float* out;
    unsigned char* ws;
};
#define WSP(T, off) ((T*)(c.ws + (off)))

DI void transpose_item(const float* W, int N, bf16* WT, int k0, int n0, int dst_row0, LAS float* scr, int lane) {
#pragma unroll 8
    for (int i = 0; i < 32; ++i) { const int kk = 2 * i + (lane >> 5); scr[kk * 33 + (lane & 31)] = W[(size_t)(k0 + kk) * N + n0 + (lane & 31)]; }
    asm volatile("s_waitcnt lgkmcnt(0)" ::: "memory");
    const int cc = lane & 7;
#pragma unroll
    for (int j = 0; j < 4; ++j) { const int n = (lane >> 3) + 8 * j; const LAS float* s = scr + (8 * cc) * 33 + n;
        u32x4 o; o.x = cvt_pk_bf16(s[0 * 33], s[1 * 33]); o.y = cvt_pk_bf16(s[2 * 33], s[3 * 33]); o.z = cvt_pk_bf16(s[4 * 33], s[5 * 33]); o.w = cvt_pk_bf16(s[6 * 33], s[7 * 33]);
        *(u32x4*)(WT + (size_t)(dst_row0 + n) * 1024 + k0 + 8 * cc) = o; }
    asm volatile("s_waitcnt lgkmcnt(0)" ::: "memory");
}
DI void dense_transpose(const Ctx& c, const float* W, int N, bf16* WT, LAS float* scr) {
    const int nblk = N / 32, nitems = 16 * nblk;
    for (int it = c.gw; it < nitems; it += c.ngw) { const int kb = it / nblk, nb = it % nblk; transpose_item(W, N, WT, 64 * kb, 32 * nb, 32 * nb, scr, c.lane); }
}
DI void phase_pro0(const Ctx& c) {
    LAS float* scr = (LAS float*)(c.lds + c.wave * 8704);
    for (int j = 0; j < 2; ++j) {
        dense_transpose(c, c.in[I_MLWIN] + (size_t)j * 1024 * 3104, 3104, WSP(bf16, WS_ML_WIN) + (size_t)j * NINP * 1024, scr);
        dense_transpose(c, c.in[I_MLWOUT] + (size_t)j * 1024 * 1024, 1024, WSP(bf16, WS_ML_WOUT) + (size_t)j * 1024 * 1024, scr);
    }
    dense_transpose(c, c.in[I_GLWIN], 3104, WSP(bf16, WS_GLA_WIN), scr);
    dense_transpose(c, c.in[I_GLWOUT], 1024, WSP(bf16, WS_GLA_WOUT), scr);
    dense_transpose(c, c.in[I_HYWIN], 3072, WSP(bf16, WS_HY_WIN), scr);
    dense_transpose(c, c.in[I_HYWOUT], 1024, WSP(bf16, WS_HY_WOUT), scr);
    for (int it = c.gw * 64 + c.lane; it < 3 * 28672; it += c.ngw * 64) {
        const int m = it / 28672, r = it % 28672; bf16* base = (m < 2) ? WSP(bf16, WS_ML_WIN) + (size_t)m * NINP * 1024 : WSP(bf16, WS_GLA_WIN);
        *(u32x4*)(base + (size_t)3104 * 1024 + (size_t)r * 8) = (u32x4){0u, 0u, 0u, 0u};
    }
    for (int it = c.gw; it < 64 * 3 * 512; it += c.ngw) {
        const int le = it / 1536, r0 = it % 1536, which = r0 / 512, r = r0 % 512, kb = r / 32, nb = r % 32;
        if (which < 2) {
            const float* W = c.in[which == 0 ? I_EW1 : I_EW3] + (size_t)le * 1024 * 1024;
            const int n0 = 32 * nb, drow = 256 * (n0 >> 7) + (n0 & 127) + (which ? 128 : 0);
            transpose_item(W, 1024, WSP(bf16, WS_EXP_UP) + (size_t)le * 2048 * 1024, 64 * kb, n0, drow, scr, c.lane);
        } else {
            transpose_item(c.in[I_EW2] + (size_t)le * 1024 * 1024, 1024, WSP(bf16, WS_EXP_DN) + (size_t)le * 1024 * 1024, 64 * kb, 32 * nb, 32 * nb, scr, c.lane);
        }
    }
    {
        const float* w1 = c.in[I_HYFW1]; const float* b1 = c.in[I_HYFB1]; const float* wm = c.in[I_HYFWM]; const float* bm = c.in[I_HYFBM]; const float* fr = c.in[I_HYFREQ];
        float* HM = WSP(float, WS_HM);
        for (int row = c.gw; row < 2304; row += c.ngw) {
            const int L = row < 2048 ? 2048 : 256, t = row < 2048 ? row : row - 2048, f = c.lane;
            float feat = 0.f;
            if (f == 0) feat = (float)t / (float)(L - 1);
            else if (f <= 32) { const int b = (f - 1) & 15; const float band = 1e-4f + (float)b * ((15.0f - 1e-4f) / 15.0f);
                const float ang = ((float)(2.0 * 3.14159265358979323846 / (double)L) * (float)t) * band; feat = (f <= 16) ? cosf(ang) : -sinf(ang); }
            float a = b1[f];
            for (int e = 0; e < 33; ++e) a += __shfl(feat, e) * w1[e * 64 + f];
            float h = sinf(fr[f] * a);
            for (int m = 0; m < 2; ++m) {
                float a2 = bm[m * 64 + f];
                for (int g = 0; g < 64; ++g) a2 += __shfl(h, g) * wm[m * 4096 + g * 64 + f];
                h = sinf(fr[f] * a2);
            }
            HM[row * 64 + f] = h;
        }
    }
    __syncthreads();
    {
        LAS float* sv = (LAS float*)c.lds;
        LAS float* red = sv + 9 * 1024;
        for (int i = c.tid; i < 9 * 1024; i += 512) { const float x = (i < 8192) ? c.in[I_C][i] : c.in[I_CCTX][i - 8192]; sv[i] = siluf_(x); }
        __syncthreads();
        float* MOD = WSP(float, WS_MOD);
        const int col = c.tid & 63, kg = c.tid >> 6;
        for (int item = blockIdx.x; item < 4 * 96; item += gridDim.x) {
            const int l = item / 96, j0 = 64 * (item % 96);
            const float* w = c.in[I_ADAW] + (size_t)l * 1024 * 6144 + j0 + col;
            float acc[9];
#pragma unroll
            for (int r = 0; r < 9; ++r) acc[r] = 0.f;
            for (int k = kg * 128; k < kg * 128 + 128; ++k) { const float wv = w[(size_t)k * 6144];
#pragma unroll
                for (int r = 0; r < 9; ++r) acc[r] += sv[r * 1024 + k] * wv; }
#pragma unroll
            for (int r = 0; r < 9; ++r) red[(kg * 9 + r) * 64 + col] = acc[r];
            __syncthreads();
            for (int o = c.tid; o < 9 * 64; o += 512) { const int r = o >> 6, cc = o & 63; float s = c.in[I_ADAB][l * 6144 + j0 + cc];
#pragma unroll
                for (int g = 0; g < 8; ++g) s += red[(g * 9 + r) * 64 + cc];
                MOD[(l * 9 + r) * 6144 + j0 + cc] = s; }
            __syncthreads();
        }
    }
}

DI void phase_pro1(const Ctx& c) {
    LAS float* wo = (LAS float*)c.lds;
    LAS float* red = wo + 2048;
    const float* HM = WSP(float, WS_HM);
    const int ch = c.tid & 15, tg = c.tid >> 4;
    for (int item = blockIdx.x; item < 128; item += gridDim.x) {
        const int lsel = item >> 6, c0 = 16 * (item & 63), L = lsel ? 256 : 2048;
        const float* hm = lsel ? HM + 2048 * 64 : HM; float* tab = lsel ? WSP(float, WS_HFC) : WSP(float, WS_HF);
        __syncthreads();
        for (int i = c.tid; i < 2048; i += 512) { const int side = i >> 10, f = (i >> 4) & 63, cc = i & 15; wo[i] = c.in[I_HYFWO][f * 2048 + side * 1024 + c0 + cc]; }
        __syncthreads();
        const int cg_ = c0 + ch;
        const float da = -4.605170185988091f / 1.5f, db = -4.605170185988091f / 0.3f;
        const float delta = fabsf(da + (float)cg_ * ((db - da) / 1023.0f));
        float* trow = tab + (size_t)cg_ * (2 * L);
        float part = 0.f;
        for (int t = tg; t < L; t += 32) {
            float af = 0.f, ab = 0.f;
            for (int f = 0; f < 64; ++f) { const float h = hm[t * 64 + f]; af += h * wo[f * 16 + ch]; ab += h * wo[1024 + f * 16 + ch]; }
            const float dec = expf(-((float)t / (float)(L - 1)) * delta); af *= dec; ab *= dec;
            trow[L + t] = af; part += fabsf(af);
            if (t >= 1) { trow[L - t] = ab; part += fabsf(ab); }
        }
        red[tg * 16 + ch] = part;
        __syncthreads();
        float l1 = 0.f;
        for (int g = 0; g < 32; ++g) l1 += red[g * 16 + ch];
        const float inv = 1.0f / l1;
        for (int t = tg; t < L; t += 32) { trow[L + t] *= inv; if (t >= 1) trow[L - t] *= inv; }
        if (tg == 0) trow[0] = 0.f;
    }
}

DI void load_row(const float* src, f32x4 (&v)[4], int lane) {
#pragma unroll
    for (int j = 0; j < 4; ++j) v[j] = *(const f32x4*)(src + 256 * j + 4 * lane);
}
DI void norm_row(f32x4 (&v)[4], const float* g, int lane) {
    float s = 0.f;
#pragma unroll
    for (int j = 0; j < 4; ++j) s += (v[j].x * v[j].x + v[j].y * v[j].y) + (v[j].z * v[j].z + v[j].w * v[j].w);
    s = wave_sum(s);
    const float r = 1.0f / sqrtf(s * (1.0f / 1024.0f) + EPS);
#pragma unroll
    for (int j = 0; j < 4; ++j) v[j] = v[j] * r * *(const f32x4*)(g + 256 * j + 4 * lane);
}
DI void mod_row(f32x4 (&v)[4], const float* sh, const float* sc, int lane) {
#pragma unroll
    for (int j = 0; j < 4; ++j) v[j] = v[j] * (*(const f32x4*)(sc + 256 * j + 4 * lane) + 1.0f) + *(const f32x4*)(sh + 256 * j + 4 * lane);
}
DI void store_row_bf16(bf16* dst, const f32x4 (&v)[4], int lane) {
#pragma unroll
    for (int j = 0; j < 4; ++j) { u32x2 w; w.x = cvt_pk_bf16(v[j].x, v[j].y); w.y = cvt_pk_bf16(v[j].z, v[j].w); *(u32x2*)(dst + 256 * j + 4 * lane) = w; }
}
DI int hrow_of(int srow, int kind) {
    if (srow < TC || kind != 1) return srow;
    const int rr = srow - TC, b = rr >> 11, s = rr & (SEQ - 1); return TC + b * SEQ + perm_fwd(s);
}
DI void phase_norm1(const Ctx& c, int l, const float* xl, const float* xc) {
    const float* MOD = WSP(float, WS_MOD) + (size_t)l * 9 * 6144; const float* g = c.in[I_N1G] + l * D; bf16* H = WSP(bf16, WS_H);
    for (int row = c.gw; row < TT; row += c.ngw) {
        f32x4 v[4]; const int mr = row < TC ? 8 : (row - TC) >> 11;
        load_row(row < TC ? xc + (size_t)row * D : xl + (size_t)(row - TC) * D, v, c.lane);
        norm_row(v, g, c.lane); mod_row(v, MOD + mr * 6144, MOD + mr * 6144 + 1024, c.lane);
        store_row_bf16(H + (size_t)hrow_of(row, l % 3) * D, v, c.lane);
    }
}

DI void phase_conv(const Ctx& c, int ncols, const float* cw, const float* cb, bool act, float qs) {
    const bf16* P = WSP(bf16, WS_P); bf16* PC = WSP(bf16, WS_BIG + BIG_PC);
    const int ng = ncols / 8; const long total = (long)TT * ng;
    for (long idx = (long)blockIdx.x * 512 + c.tid; idx < total; idx += (long)gridDim.x * 512) {
        const int row = (int)(idx / ng), col = (int)(idx % ng) * 8; int lo, hi; seq_bounds(row, lo, hi);
        float x0[8], xm[8], xp[8];
        unpack8(*(const u32x4*)(P + (size_t)row * PLD + col), x0);
        if (row > lo) unpack8(*(const u32x4*)(P + (size_t)(row - 1) * PLD + col), xm); else {
#pragma unroll
            for (int j = 0; j < 8; ++j) xm[j] = 0.f; }
        if (row < hi) unpack8(*(const u32x4*)(P + (size_t)(row + 1) * PLD + col), xp); else {
#pragma unroll
            for (int j = 0; j < 8; ++j) xp[j] = 0.f; }
        float o[8];
#pragma unroll
        for (int j = 0; j < 8; ++j) { float v = cw[col + j] * xm[j] + cw[ncols + col + j] * x0[j] + cw[2 * ncols + col + j] * xp[j] + cb[col + j];
            if (act) v = siluf_(v); if (col < 512) v *= qs; o[j] = v; }
        *(u32x4*)(PC + (size_t)row * ncols + col) = pack8(o);
    }
}

DI int scan_row(int step, int b, int dir) {
    if (step < CTX) return b * CTX + (dir ? CTX - 1 - step : step);
    const int s = step - CTX; return TC + b * SEQ + (dir ? SEQ - 1 - s : s);
}
DI void phase_mlstm_scan_naive(const Ctx& c) {
    const bf16* P = WSP(bf16, WS_P); const bf16* PC = WSP(bf16, WS_BIG + BIG_PC); const float* EX = WSP(float, WS_EXTRA);
    LAS float* qs = (LAS float*)c.lds; LAS float* ks = qs + 32 * 64; LAS float* vs = ks + 32 * 64; LAS float* gs = vs + 32 * 128;
    const int v = c.tid >> 2, d0 = (c.tid & 3) * 16;
    for (int item = blockIdx.x; item < 128; item += gridDim.x) {
        const int b = item >> 4, h = (item >> 1) & 7, dir = item & 1;
        float* Yo = WSP(float, WS_BIG + (dir ? BIG_YB : BIG_YF));
        float C[16], n[16];
#pragma unroll
        for (int d = 0; d < 16; ++d) { C[d] = 0.f; n[d] = 0.f; }
        for (int ch = 0; ch < (CTX + SEQ) / 32; ++ch) {
            __syncthreads();
            for (int idx = c.tid; idx < 32 * 256; idx += 512) { const int st = idx >> 8, col = idx & 255, row = scan_row(ch * 32 + st, b, dir);
                if (col < 64) qs[st * 64 + col] = bf2f(PC[(size_t)row * 1024 + h * 64 + col]);
                else if (col < 128) ks[st * 64 + col - 64] = bf2f(PC[(size_t)row * 1024 + 512 + h * 64 + col - 64]);
                else vs[st * 128 + col - 128] = bf2f(P[(size_t)row * PLD + 1024 + h * 128 + col - 128]); }
            if (c.tid < 32) { const int row = scan_row(ch * 32 + c.tid, b, dir); gs[c.tid * 2] = sigmoidf_(EX[(size_t)row * 32 + dir * 16 + 8 + h]); gs[c.tid * 2 + 1] = __expf(EX[(size_t)row * 32 + dir * 16 + h]); }
            __syncthreads();
            for (int st = 0; st < 32; ++st) {
                const float f = gs[st * 2], ei = gs[st * 2 + 1], vv = vs[st * 128 + v] * ei;
                float part = 0.f, dpart = 0.f;
#pragma unroll
                for (int d = 0; d < 16; ++d) { const float kd = ks[st * 64 + d0 + d], qd = qs[st * 64 + d0 + d];
                    C[d] = f * C[d] + kd * vv; part += qd * C[d]; n[d] = f * n[d] + ei * kd; dpart += qd * n[d]; }
                part += __shfl_xor(part, 1); part += __shfl_xor(part, 2); dpart += __shfl_xor(dpart, 1); dpart += __shfl_xor(dpart, 2);
                if ((c.tid & 3) == 0) { const int row = scan_row(ch * 32 + st, b, dir); Yo[(size_t)row * D + h * 128 + v] = part / fmaxf(fabsf(dpart), 1.0f); }
            }
        }
    }
}
DI void phase_gla_scan_naive(const Ctx& c) {
    const bf16* PC = WSP(bf16, WS_BIG + BIG_PC); const float* EX = WSP(float, WS_EXTRA);
    LAS float* qs = (LAS float*)c.lds; LAS float* ks = qs + 16 * 128; LAS float* as = ks + 16 * 128; LAS float* vs = as + 16 * 128; LAS float* lw = vs + 16 * 256;
    const int v = c.tid >> 1, d0 = (c.tid & 1) * 64;
    for (int item = blockIdx.x; item < 64; item += gridDim.x) {
        const int b = item >> 3, h = (item >> 1) & 3, dir = item & 1;
        float* Yo = WSP(float, WS_BIG + (dir ? BIG_YB : BIG_YF));
        const float* w2 = c.in[I_GLW2] + (size_t)dir * 16 * 512 + h * 128; const float* gb = c.in[I_GLGB] + dir * 512 + h * 128;
        float S[64];
#pragma unroll
        for (int d = 0; d < 64; ++d) S[d] = 0.f;
        for (int ch = 0; ch < (CTX + SEQ) / 16; ++ch) {
            __syncthreads();
            if (c.tid < 256) { const int st = c.tid >> 4, r = c.tid & 15, row = scan_row(ch * 16 + st, b, dir); lw[c.tid] = EX[(size_t)row * 32 + dir * 16 + r]; }
            for (int idx = c.tid; idx < 16 * 512; idx += 512) { const int st = idx >> 9, col = idx & 511, row = scan_row(ch * 16 + st, b, dir);
                if (col < 128) qs[st * 128 + col] = bf2f(PC[(size_t)row * 2048 + h * 128 + col]);
                else if (col < 256) ks[st * 128 + col - 128] = bf2f(PC[(size_t)row * 2048 + 512 + h * 128 + col - 128]);
                else vs[st * 256 + col - 256] = bf2f(PC[(size_t)row * 2048 + 1024 + h * 256 + col - 256]); }
            __syncthreads();
            for (int idx = c.tid; idx < 16 * 128; idx += 512) { const int st = idx >> 7, d = idx & 127; float pre = gb[d];
#pragma unroll
                for (int r = 0; r < 16; ++r) pre += lw[st * 16 + r] * w2[r * 512 + d];
                as[idx] = __expf(logsigf_(pre) * (1.0f / 16.0f)); }
            __syncthreads();
            for (int st = 0; st < 16; ++st) {
                const float vv = vs[st * 256 + v]; float part = 0.f;
#pragma unroll
                for (int d = 0; d < 64; ++d) { S[d] = as[st * 128 + d0 + d] * S[d] + ks[st * 128 + d0 + d] * vv; part += qs[st * 128 + d0 + d] * S[d]; }
                part += __shfl_xor(part, 1);
                if ((c.tid & 1) == 0) { const int row = scan_row(ch * 16 + st, b, dir); Yo[(size_t)row * D + h * 256 + v] = part; }
            }
        }
    }
}
DI void phase_headnorm(const Ctx& c, int hd, const float* ng) {
    const float* YF = WSP(float, WS_BIG + BIG_YF); const float* YB = WSP(float, WS_BIG + BIG_YB); const bf16* P = WSP(bf16, WS_P); bf16* Y = WSP(bf16, WS_Y);
    for (int row = c.gw; row < TT; row += c.ngw) {
        const int c0 = 16 * c.lane; float y[16]; float ss = 0.f;
#pragma unroll
        for (int j = 0; j < 4; ++j) { const f32x4 a = *(const f32x4*)(YF + (size_t)row * D + c0 + 4 * j), bb = *(const f32x4*)(YB + (size_t)row * D + c0 + 4 * j);
            y[4 * j] = a.x + bb.x; y[4 * j + 1] = a.y + bb.y; y[4 * j + 2] = a.z + bb.z; y[4 * j + 3] = a.w + bb.w; }
#pragma unroll
        for (int j = 0; j < 16; ++j) ss += y[j] * y[j];
        ss += __shfl_xor(ss, 1); ss += __shfl_xor(ss, 2); ss += __shfl_xor(ss, 4); if (hd == 256) ss += __shfl_xor(ss, 8);
        const float r = 1.0f / sqrtf(ss / (float)hd + EPS);
        float g0[8], g1[8];
        unpack8(*(const u32x4*)(P + (size_t)row * PLD + 2048 + c0), g0); unpack8(*(const u32x4*)(P + (size_t)row * PLD + 2048 + c0 + 8), g1);
        float o[16];
#pragma unroll
        for (int j = 0; j < 16; ++j) { const float gp = j < 8 ? g0[j] : g1[j - 8]; o[j] = y[j] * r * ng[c0 + j] * (hd == 128 ? sigmoidf_(gp) : siluf_(gp)); }
        const float o0[8] = {o[0], o[1], o[2], o[3], o[4], o[5], o[6], o[7]}, o1[8] = {o[8], o[9], o[10], o[11], o[12], o[13], o[14], o[15]};
        *(u32x4*)(Y + (size_t)row * D + c0) = pack8(o0); *(u32x4*)(Y + (size_t)row * D + c0 + 8) = pack8(o1);
    }
}
DI void phase_hyena_conv_naive(const Ctx& c) {
    const bf16* PC = WSP(bf16, WS_BIG + BIG_PC); bf16* Y = WSP(bf16, WS_Y); const float* skip = c.in[I_HYSKIP];
    LAS float* zt = (LAS float*)c.lds;
    LAS float* ft = zt + 4096;
    const int cc = c.tid & 63, tg = c.tid >> 6;
    for (int item = blockIdx.x; item < 4096 + 512; item += gridDim.x) {
        int L, rb, tt, cgi; const float* tab;
        if (item < 4096) { L = SEQ; const int b = item >> 9; tt = (item >> 4) & 31; cgi = item & 15; rb = TC + b * SEQ; tab = WSP(float, WS_HF); }
        else { const int it = item - 4096; L = CTX; const int b = it >> 6; tt = (it >> 4) & 3; cgi = it & 15; rb = b * CTX; tab = WSP(float, WS_HFC); }
        const int t0 = 64 * tt, c0 = 64 * cgi;
        float acc[8];
#pragma unroll
        for (int i = 0; i < 8; ++i) acc[i] = 0.f;
        for (int sb = 0; sb < L / 64; ++sb) {
            const int s0 = 64 * sb;
            __syncthreads();
            for (int idx = c.tid; idx < 4096; idx += 512) { const int sl = idx >> 6, ch = idx & 63; const size_t o = (size_t)(rb + s0 + sl) * PLD + c0 + ch;
                zt[idx] = bf2f(PC[o + 1024]) * bf2f(PC[o + 2048]); }
            for (int idx = c.tid; idx < 64 * 128; idx += 512) { const int ch = idx >> 7, j = idx & 127;
                if (j < 127) ft[j * 65 + ch] = tab[(size_t)(c0 + ch) * (2 * L) + L + (t0 - s0 - 63 + j)]; }
            __syncthreads();
#pragma unroll 1
            for (int g = 0; g < 8; ++g) {
                float w[15], z[8]; const int base = 8 * (tg - g) + 56;
#pragma unroll
                for (int m = 0; m < 15; ++m) w[m] = ft[(base + m) * 65 + cc];
#pragma unroll
                for (int j = 0; j < 8; ++j) z[j] = zt[(8 * g + j) * 64 + cc];
#pragma unroll
                for (int i = 0; i < 8; ++i)
#pragma unroll
                    for (int j = 0; j < 8; ++j) acc[i] += w[i - j + 7] * z[j];
            }
        }
#pragma unroll
        for (int i = 0; i < 8; ++i) { const int row = rb + t0 + 8 * tg + i; const size_t o = (size_t)row * PLD + c0 + cc;
            const float zin = bf2f(PC[o + 1024]) * bf2f(PC[o + 2048]), x0 = bf2f(PC[o]);
            Y[(size_t)row * D + c0 + cc] = f2bf(x0 * (acc[i] + skip[c0 + cc] * zin)); }
    }
}

DI void phase_route(const Ctx& c, int l) {
    LAS float* rw = (LAS float*)c.lds;
    for (int i = c.tid; i < 16 * 1024; i += 512) { const int e = i >> 10, k = i & 1023; rw[i] = c.in[I_RW][k * 16 + e]; }
    __syncthreads();
    const float* MOD = WSP(float, WS_MOD) + (size_t)l * 9 * 6144; const float* g = c.in[I_N2G] + l * D; bf16* H = WSP(bf16, WS_H);
    const float* X = WSP(float, WS_X); const float* XC = WSP(float, WS_XC);
    unsigned* cnt = WSP(unsigned, WS_CTL) + CW_CNT + l * 16; int* TOK = WSP(int, WS_TOK); float* TOKW = WSP(float, WS_TOK + 512 * 1024);
    float rbv[16];
#pragma unroll
    for (int e = 0; e < 16; ++e) rbv[e] = c.in[I_RB][e];
    for (int row = (l == 3 ? TC : 0) + c.gw; row < TT; row += c.ngw) {
        f32x4 v[4]; const int mr = row < TC ? 8 : (row - TC) >> 11;
        load_row(row < TC ? XC + (size_t)row * D : X + (size_t)(row - TC) * D, v, c.lane);
        norm_row(v, g, c.lane); mod_row(v, MOD + mr * 6144 + 3072, MOD + mr * 6144 + 4096, c.lane);
        store_row_bf16(H + (size_t)row * D, v, c.lane);
        float sc[16];
#pragma unroll
        for (int e = 0; e < 16; ++e) { float s = 0.f;
#pragma unroll
            for (int j = 0; j < 4; ++j) { const f32x4 w = *(const LAS f32x4*)(rw + e * 1024 + 256 * j + 4 * c.lane); s += (v[j].x * w.x + v[j].y * w.y) + (v[j].z * w.z + v[j].w * w.w); }
            sc[e] = sigmoidf_(wave_sum(s)); }
        int bg = 0; float bgs = -1e30f;
#pragma unroll
        for (int gq = 0; gq < 4; ++gq) { float m1 = -1e30f, m2 = -1e30f;
#pragma unroll
            for (int j = 0; j < 4; ++j) { const float s = sc[4 * gq + j] + rbv[4 * gq + j]; if (s > m1) { m2 = m1; m1 = s; } else if (s > m2) m2 = s; }
            const float gs = m1 + m2; if (gs > bgs) { bgs = gs; bg = gq; } }
        float s4[4], p4[4];
#pragma unroll
        for (int j = 0; j < 4; ++j) { s4[j] = 0.f; p4[j] = 0.f; }
#pragma unroll
        for (int gq = 0; gq < 4; ++gq)
#pragma unroll
            for (int j = 0; j < 4; ++j) if (bg == gq) { s4[j] = sc[4 * gq + j] + rbv[4 * gq + j]; p4[j] = sc[4 * gq + j]; }
        int i1 = 0; float v1 = s4[0], q1 = p4[0];
#pragma unroll
        for (int j = 1; j < 4; ++j) if (s4[j] > v1) { v1 = s4[j]; i1 = j; q1 = p4[j]; }
        int i2 = -1; float v2 = -1e30f, q2 = 0.f;
#pragma unroll
        for (int j = 0; j < 4; ++j) if (j != i1 && s4[j] > v2) { v2 = s4[j]; i2 = j; q2 = p4[j]; }
        if (c.lane == 0) {
            const int e0 = 4 * bg + i1, e1 = 4 * bg + i2;
            const unsigned p0 = atomicAdd(cnt + e0, 1u), p1 = atomicAdd(cnt + e1, 1u);
            TOK[row * 4 + 0] = e0; TOK[row * 4 + 1] = (int)p0; TOK[row * 4 + 2] = e1; TOK[row * 4 + 3] = (int)p1;
            const float inv = 1.0f / (q1 + q2); TOKW[row * 2] = q1 * inv; TOKW[row * 2 + 1] = q2 * inv;
        }
    }
}
DI void slot_bases(const unsigned* cnt, int lane, int e0, int e1, int& b0, int& b1) {
    const unsigned mine = lane < 16 ? ((cnt[lane] + 255u) & ~255u) : 0u; unsigned pb = 0; b0 = 0; b1 = 0;
#pragma unroll
    for (int e = 0; e < 16; ++e) { const unsigned ce = __shfl(mine, e); if (e == e0) b0 = (int)pb; if (e == e1) b1 = (int)pb; pb += ce; }
}
DI void phase_gather(const Ctx& c, int l) {
    const unsigned* cnt = WSP(unsigned, WS_CTL) + CW_CNT + l * 16; const int* TOK = WSP(int, WS_TOK); int* TOKS = WSP(int, WS_TOK + 768 * 1024);
    const bf16* H = WSP(bf16, WS_H); bf16* HS = WSP(bf16, WS_BIG + BIG_HS);
    for (int row = (l == 3 ? TC : 0) + c.gw; row < TT; row += c.ngw) {
        const int e0 = TOK[row * 4], p0 = TOK[row * 4 + 1], e1 = TOK[row * 4 + 2], p1 = TOK[row * 4 + 3]; int b0, b1;
        slot_bases(cnt, c.lane, e0, e1, b0, b1);
        const int s0 = b0 + p0, s1 = b1 + p1;
        const u32x4 a = *(const u32x4*)(H + (size_t)row * D + 8 * c.lane), bq = *(const u32x4*)(H + (size_t)row * D + 512 + 8 * c.lane);
        *(u32x4*)(HS + (size_t)s0 * D + 8 * c.lane) = a; *(u32x4*)(HS + (size_t)s0 * D + 512 + 8 * c.lane) = bq;
        *(u32x4*)(HS + (size_t)s1 * D + 8 * c.lane) = a; *(u32x4*)(HS + (size_t)s1 * D + 512 + 8 * c.lane) = bq;
        if (c.lane == 0) { TOKS[row * 2] = s0; TOKS[row * 2 + 1] = s1; }
    }
}
DI LAS int* moe_tiles(const Ctx& c, int l) {
    LAS int* tp = (LAS int*)(c.lds + MISC_OFF);
    __syncthreads();
    if (c.tid < 64) {
        const unsigned* cnt = WSP(unsigned, WS_CTL) + CW_CNT + l * 16;
        const int mine = c.lane < 16 ? (int)((cnt[c.lane] + 255u) >> 8) : 0; int p = 0;
        for (int e = 0; e < 16; ++e) { const int ne = __shfl(mine, e); for (int t = c.lane; t < ne; t += 64) tp[1 + p + t] = e; p += ne; }
        if (c.lane == 0) tp[0] = p;
    }
    __syncthreads();
    return tp;
}
DI void phase_combine(const Ctx& c, int l) {
    const float* MOD = WSP(float, WS_MOD) + (size_t)l * 9 * 6144; const int* TOKS = WSP(int, WS_TOK + 768 * 1024); const float* TOKW = WSP(float, WS_TOK + 512 * 1024);
    const bf16* YS = WSP(bf16, WS_BIG + BIG_HS); float* X = WSP(float, WS_X); float* XC = WSP(float, WS_XC); bf16* H = WSP(bf16, WS_H);
    for (int row = (l == 3 ? TC : 0) + c.gw; row < TT; row += c.ngw) {
        const int mr = row < TC ? 8 : (row - TC) >> 11; float* xp = row < TC ? XC + (size_t)row * D : X + (size_t)(row - TC) * D;
        const int s0 = TOKS[row * 2], s1 = TOKS[row * 2 + 1]; const float w0 = TOKW[row * 2], w1 = TOKW[row * 2 + 1];
        f32x4 v[4]; load_row(xp, v, c.lane);
#pragma unroll
        for (int j = 0; j < 4; ++j) {
            const u32x2 a = *(const u32x2*)(YS + (size_t)s0 * D + 256 * j + 4 * c.lane), bq = *(const u32x2*)(YS + (size_t)s1 * D + 256 * j + 4 * c.lane);
            const f32x4 ya = {__uint_as_float(a.x << 16), __uint_as_float(a.x & 0xffff0000u), __uint_as_float(a.y << 16), __uint_as_float(a.y & 0xffff0000u)};
            const f32x4 yb = {__uint_as_float(bq.x << 16), __uint_as_float(bq.x & 0xffff0000u), __uint_as_float(bq.y << 16), __uint_as_float(bq.y & 0xffff0000u)};
            v[j] = v[j] + *(const f32x4*)(MOD + mr * 6144 + 5120 + 256 * j + 4 * c.lane) * (ya * w0 + yb * w1);
            *(f32x4*)(xp + 256 * j + 4 * c.lane) = v[j];
        }
        if (l < 3) {
            const float* MODn = WSP(float, WS_MOD) + (size_t)(l + 1) * 9 * 6144;
            norm_row(v, c.in[I_N1G] + (l + 1) * D, c.lane); mod_row(v, MODn + mr * 6144, MODn + mr * 6144 + 1024, c.lane);
            store_row_bf16(H + (size_t)hrow_of(row, (l + 1) % 3) * D, v, c.lane);
        } else {
            norm_row(v, c.in[I_FING], c.lane);
            float* o = c.out + (size_t)(row - TC) * D;
#pragma unroll
            for (int j = 0; j < 4; ++j) *(f32x4*)(o + 256 * j + 4 * c.lane) = v[j];
        }
    }
}

constexpr int NPHASE = 2 + 11 * DEPTH;
__host__ __device__ inline bool phase_active(int ph) {
    if (ph < 2) return true;
    const int l = (ph - 2) / 11, s = (ph - 2) % 11, kind = l % 3;
    if (s == 0) return l == 0;
    if (s == 4) return kind != 2;
    return true;
}
DI void run_phase(const Ctx& c, int ph) {
    if (ph == 0) { if constexpr (PH_EN(0)) phase_pro0(c); return; }
    if (ph == 1) { if constexpr (PH_EN(1)) phase_pro1(c); return; }
    const int l = (ph - 2) / 11, s = (ph - 2) % 11, kind = l % 3, j = l / 3;
    switch (s) {
    case 0: if constexpr (PH_EN(2)) phase_norm1(c, 0, c.in[I_X], c.in[I_CTX]); break;
    case 1: if constexpr (PH_EN(3)) {
        DenseOrder S; EpiInproj E; E.P = WSP(bf16, WS_P); E.extra = WSP(float, WS_EXTRA); E.bias = nullptr; E.bias_x = nullptr;
        if (kind == 0) { S.init(WSP(bf16, WS_H), WSP(bf16, WS_ML_WIN) + (size_t)j * NINP * 1024, TT, NINP); E.bias_x = c.in[I_MLBG] + j * 32; }
        else if (kind == 1) { S.init(WSP(bf16, WS_H), WSP(bf16, WS_GLA_WIN), TT, NINP); }
        else { S.init(WSP(bf16, WS_H), WSP(bf16, WS_HY_WIN), TT, 3072); E.bias = c.in[I_HYBIN]; }
        gemm_run(c.lds, c.tid, S, E);
    } break;
    case 2: if constexpr (PH_EN(4))
        if (kind == 0) phase_conv(c, 1024, c.in[I_MLCW] + j * 3 * 1024, c.in[I_MLCB] + j * 1024, true, 0.125f);
        else if (kind == 1) phase_conv(c, 2048, c.in[I_GLCW], c.in[I_GLCB], true, 0.08838834764831845f);
        else phase_conv(c, 3072, c.in[I_HYCW], c.in[I_HYCB], false, 1.0f);
        break;
    case 3: if constexpr (PH_EN(5))
        if (kind == 0) phase_mlstm_scan_naive(c);
        else if (kind == 1) phase_gla_scan_naive(c);
        else phase_hyena_conv_naive(c);
        break;
    case 4: if constexpr (PH_EN(6))
        if (kind == 0) phase_headnorm(c, 128, c.in[I_MLNG] + j * 1024);
        else phase_headnorm(c, 256, c.in[I_GLNG]);
        break;
    case 5: if constexpr (PH_EN(7)) {
        DenseOrder S; EpiOutproj E; E.X = WSP(float, WS_X); E.XC = WSP(float, WS_XC); E.mod = WSP(float, WS_MOD) + (size_t)l * 9 * 6144; E.bias = nullptr; E.perm = (kind == 1);
        E.xs_l = (l == 0) ? c.in[I_X] : WSP(float, WS_X); E.xs_c = (l == 0) ? c.in[I_CTX] : WSP(float, WS_XC); E.row_off = (l == 3) ? TC : 0;
        const bf16* W = kind == 0 ? WSP(bf16, WS_ML_WOUT) + (size_t)j * 1024 * 1024 : kind == 1 ? WSP(bf16, WS_GLA_WOUT) : WSP(bf16, WS_HY_WOUT);
        if (kind == 2) E.bias = c.in[I_HYBOUT];
        S.init(WSP(bf16, WS_Y) + (size_t)E.row_off * D, W, TT - E.row_off, 1024);
        gemm_run(c.lds, c.tid, S, E);
    } break;
    case 6: if constexpr (PH_EN(8)) phase_route(c, l); break;
    case 7: if constexpr (PH_EN(9)) phase_gather(c, l); break;
    case 8: if constexpr (PH_EN(10)) {
        MoeOrder S; S.tp = moe_tiles(c, l); S.A = WSP(bf16, WS_BIG + BIG_HS); S.Bt = WSP(bf16, WS_EXP_UP) + (size_t)l * 16 * 2048 * 1024; S.bstride = (size_t)2048 * 1024; S.nsh = 3; S.G = gridDim.x; S.c = blockIdx.x;
        EpiUp E; E.ACT = WSP(bf16, WS_BIG + BIG_ACT);
        gemm_run(c.lds, c.tid, S, E);
    } break;
    case 9: if constexpr (PH_EN(11)) {
        MoeOrder S; S.tp = moe_tiles(c, l); S.A = WSP(bf16, WS_BIG + BIG_ACT); S.Bt = WSP(bf16, WS_EXP_DN) + (size_t)l * 16 * 1024 * 1024; S.bstride = (size_t)1024 * 1024; S.nsh = 2; S.G = gridDim.x; S.c = blockIdx.x;
        EpiDown E; E.YS = WSP(bf16, WS_BIG + BIG_HS);
        gemm_run(c.lds, c.tid, S, E);
    } break;
    case 10: if constexpr (PH_EN(12)) phase_combine(c, l); break;
    }
}

__global__ void __launch_bounds__(512, 2) mega_fwd(Params p) {
    extern __shared__ __attribute__((aligned(16))) unsigned char lds_raw[];
    bool first = true;
    for (int ph = p.ph_lo; ph < p.ph_hi; ++ph) {
        if (!phase_active(ph)) continue;
        if (!first) cg::this_grid().sync();
        first = false;
        int z; asm volatile("s_mov_b32 %0, 0" : "=s"(z));
        Ctx c;
        c.lds = (LAS unsigned char*)lds_raw;
        c.tid = threadIdx.x + z; c.lane = c.tid & 63; c.wave = __builtin_amdgcn_readfirstlane(c.tid >> 6);
        c.gw = blockIdx.x * 8 + c.wave; c.ngw = gridDim.x * 8;
        c.in = p.in + z; c.out = p.out + z; c.ws = p.ws + z;
        run_phase(c, ph);
    }
}

extern "C" void kernel_launch(void* const* d_in, const int* in_sizes, int n_in, void* d_out, int out_size, void* d_ws, size_t ws_size, hipStream_t stream) {
    static int grid = 0;
    if (grid == 0) {
        if (n_in != 40 || ws_size < WS_END || out_size != TL * D) { fprintf(stderr, "kernel_launch: unexpected shapes (n_in %d, ws %zu, out %d)\n", n_in, ws_size, out_size); grid = -1; return; }
        int dev = 0, cus = 0, per_cu = 0;
        hipGetDevice(&dev); hipDeviceGetAttribute(&cus, hipDeviceAttributeMultiprocessorCount, dev);
        if (hipFuncSetAttribute((const void*)mega_fwd, hipFuncAttributeMaxDynamicSharedMemorySize, LDS_BYTES) != hipSuccess) { fprintf(stderr, "kernel_launch: hipFuncSetAttribute failed\n"); grid = -1; return; }
        if (hipOccupancyMaxActiveBlocksPerMultiprocessor(&per_cu, (const void*)mega_fwd, 512, LDS_BYTES) != hipSuccess || per_cu < 1) { fprintf(stderr, "kernel_launch: occupancy query says %d\n", per_cu); per_cu = 1; }
        (void)hipGetLastError();
        grid = cus;
        fprintf(stderr, "kernel_launch: grid %d (cus %d, per_cu %d)\n", grid, cus, per_cu);
    }
    if (grid < 0) return;
    hipMemsetAsync((char*)d_ws + WS_CTL, 0, 1 * MiB, stream);
    Params p{};
    for (int i = 0; i < 40; ++i) p.in[i] = (const float*)d_in[i];
    p.out = (float*)d_out; p.ws = (unsigned char*)d_ws;
#if N_LAUNCH_PER_PHASE
    for (int ph = 0; ph < NPHASE; ++ph) {
        if (!phase_active(ph)) continue;
        p.ph_lo = ph; p.ph_hi = ph + 1; void* args[] = {&p};
        hipError_t e = hipLaunchCooperativeKernel((const void*)mega_fwd, dim3(grid), dim3(512), args, LDS_BYTES, stream);
        if (e != hipSuccess) { fprintf(stderr, "launch failed: %s\n", hipGetErrorString(e)); break; }
    }
#else
    p.ph_lo = 0; p.ph_hi = NPHASE; void* args[] = {&p};
    hipError_t e = hipLaunchCooperativeKernel((const void*)mega_fwd, dim3(grid), dim3(512), args, LDS_BYTES, stream);
    if (e != hipSuccess) fprintf(stderr, "cooperative launch failed: %s (grid %d)\n", hipGetErrorString(e), grid);
#endif
}
```

```cpp
#include <hip/hip_runtime.h>
#include <hip/hip_cooperative_groups.h>
#include <cstdio>
#include <cstdint>
namespace cg = cooperative_groups;

#define LAS __attribute__((address_space(3)))
#define DI __device__ __forceinline__
typedef unsigned short bf16;
typedef float f32x4 __attribute__((ext_vector_type(4)));
typedef float f32x2 __attribute__((ext_vector_type(2)));
typedef unsigned u32x4 __attribute__((ext_vector_type(4)));
typedef unsigned u32x2 __attribute__((ext_vector_type(2)));
typedef short bf16x8 __attribute__((ext_vector_type(8)));

#ifndef FAST_GEMM
#define FAST_GEMM 1
#endif
#ifndef MLSTM_CHUNK
#define MLSTM_CHUNK 1
#endif
#ifndef PH_MASK
#define PH_MASK 0xFFFFFFFFu
#endif
#define PH_EN(b) ((PH_MASK >> (b)) & 1u)
#ifndef REP_LAYERS
#define REP_LAYERS 0xFu
#endif
#ifndef REP_MASK
#define REP_MASK 0u
#endif
#ifndef N_LAUNCH_PER_PHASE
#define N_LAUNCH_PER_PHASE 0
#endif

constexpr int D = 1024, NB = 8, SEQ = 2048, CTX = 256, DEPTH = 4;
constexpr int TC = NB * CTX, TL = NB * SEQ, TT = TC + TL;
constexpr int NEXP = 16;
constexpr int PLD = 3072;
constexpr int NINP = 3328;
constexpr float EPS = 1e-6f;
constexpr int MAXSLOT = 40960;

constexpr size_t MiB = 1u << 20;
constexpr size_t WS_CTL = 0;
constexpr size_t WS_MOD = 1 * MiB;
constexpr size_t WS_HM = 2 * MiB;
constexpr size_t WS_TOK = 3 * MiB;
constexpr size_t WS_HF = 4 * MiB;
constexpr size_t WS_HFC = 20 * MiB;
constexpr size_t WS_ML_WIN = 32 * MiB;
constexpr size_t WS_ML_WOUT = 45 * MiB;
constexpr size_t WS_GLA_WIN = 49 * MiB;
constexpr size_t WS_GLA_WOUT = 56 * MiB;
constexpr size_t WS_HY_WIN = 58 * MiB;
constexpr size_t WS_HY_WOUT = 64 * MiB;
constexpr size_t WS_EXP_UP = 66 * MiB;
constexpr size_t WS_EXP_DN = 322 * MiB;
constexpr size_t WS_X = 450 * MiB;
constexpr size_t WS_XC = 514 * MiB;
constexpr size_t WS_H = 522 * MiB;
constexpr size_t WS_P = 558 * MiB;
constexpr size_t WS_EXTRA = 667 * MiB;
constexpr size_t WS_Y = 670 * MiB;
constexpr size_t WS_BIG = 706 * MiB;
constexpr size_t WS_END = 962 * MiB;
constexpr size_t BIG_HS = 0;
constexpr size_t BIG_ACT = 80 * MiB;
constexpr size_t BIG_PC = 0;
constexpr size_t BIG_YF = 108 * MiB;
constexpr size_t BIG_YB = 180 * MiB;

constexpr size_t BIG_MCT = 108 * MiB;
constexpr size_t BIG_MN = 180 * MiB;

constexpr int CW_CNT = 1024;

constexpr int LDS_BYTES = 147456;
constexpr int MISC_OFF = 131072;

struct Params {
    const float* in[40];
    float* out;
    unsigned char* ws;
    int ph_lo, ph_hi;
};
enum { I_X = 0, I_C, I_CTX, I_CCTX, I_ADAW, I_ADAB, I_N1G, I_N2G, I_FING, I_MLWIN, I_MLBG, I_MLCW, I_MLCB, I_MLNG, I_MLWOUT,
       I_GLWIN, I_GLCW, I_GLCB, I_GLW2, I_GLGB, I_GLNG, I_GLWOUT, I_HYWIN, I_HYBIN, I_HYCW, I_HYCB, I_HYFW1, I_HYFB1, I_HYFWM, I_HYFBM,
       I_HYFWO, I_HYFREQ, I_HYSKIP, I_HYWOUT, I_HYBOUT, I_RW, I_RB, I_EW1, I_EW3, I_EW2 };

DI float bf2f(bf16 v) { return __uint_as_float(((unsigned)v) << 16); }
typedef __bf16 b16x2_t __attribute__((ext_vector_type(2)));
DI unsigned cvt_pk_bf16(float lo, float hi) { const f32x2 v = {lo, hi}; const b16x2_t r = __builtin_convertvector(v, b16x2_t); return __builtin_bit_cast(unsigned, r); }
DI bf16 f2bf(float f) { return (bf16)(cvt_pk_bf16(f, 0.f) & 0xffffu); }
DI float sigmoidf_(float x) { return 1.0f / (1.0f + __expf(-x)); }
DI float siluf_(float x) { return x / (1.0f + __expf(-x)); }
DI float logsigf_(float x) { return fminf(x, 0.f) - log1pf(__expf(-fabsf(x))); }
DI float wave_sum(float v) {
#pragma unroll
    for (int o = 1; o < 64; o <<= 1) v += __shfl_xor(v, o);
    return v;
}
DI void unpack8(const u32x4 w, float (&v)[8]) {
    v[0] = __uint_as_float(w.x << 16); v[1] = __uint_as_float(w.x & 0xffff0000u);
    v[2] = __uint_as_float(w.y << 16); v[3] = __uint_as_float(w.y & 0xffff0000u);
    v[4] = __uint_as_float(w.z << 16); v[5] = __uint_as_float(w.z & 0xffff0000u);
    v[6] = __uint_as_float(w.w << 16); v[7] = __uint_as_float(w.w & 0xffff0000u);
}
DI u32x4 pack8(const float (&v)[8]) { u32x4 w; w.x = cvt_pk_bf16(v[0], v[1]); w.y = cvt_pk_bf16(v[2], v[3]); w.z = cvt_pk_bf16(v[4], v[5]); w.w = cvt_pk_bf16(v[6], v[7]); return w; }
DI void seq_bounds(int row, int& lo, int& hi) {
    if (row < TC) { lo = row & ~(CTX - 1); hi = lo + CTX - 1; } else { lo = TC + ((row - TC) & ~(SEQ - 1)); hi = lo + SEQ - 1; }
}
DI int perm_fwd(int s) { return (s & 63) * 32 + (s >> 6); }
DI int perm_inv(int sp) { return (sp & 31) * 64 + (sp >> 5); }

namespace pg8 {
constexpr int BM = 256, BK = 64, HALF = 128, HTB = HALF * BK * 2, STAGE_BYTES = 8 * HTB, NXCD = 8, WGM = 8;
__host__ __device__ __forceinline__ int lds_byte(int r, int c) { const int st = (r >> 4) * 2 + (c >> 5), rr = r & 15, cc = c & 31, ob = rr * 64 + cc * 2; return st * 1024 + (ob ^ (((ob >> 9) & 1) << 5)); }
__host__ __device__ __forceinline__ void stage_rc(int b, int& R, int& C) { const int st = b / 1024, sb = b % 1024, swz = sb ^ (((sb >> 9) & 1) << 5); R = (st >> 1) * 16 + swz / 64; C = (st & 1) * 32 + (swz % 64) / 2; }
__host__ __device__ __forceinline__ int perm32(int rho) { const int n = rho >> 4, i = rho & 15; return 8 * (i >> 2) + 4 * n + (i & 3); }
}
struct Unit { int pm, pn, e; };

struct DenseOrder {
    const bf16* A; const bf16* Bt; int nM, nN, nwg, G, c;
    DI void init(const bf16* A_, const bf16* Bt_, int M, int N) { A = A_; Bt = Bt_; nM = M / 256; nN = N / 256; nwg = nM * nN; G = gridDim.x; c = blockIdx.x; }
    DI bool next(int i, Unit& u) const {
        const int L = i * G + c; if (L >= nwg) return false;
        int wgid = L; { const int q = nwg / 8, r = nwg % 8, xcd = wgid % 8, off = wgid / 8; wgid = (xcd < r ? xcd * (q + 1) : r * (q + 1) + (xcd - r) * q) + off; }
        const int nig = 8 * nN, gid = wgid / nig, fm = gid * 8, gsz = (nM - fm) < 8 ? (nM - fm) : 8;
        u.pm = fm + ((wgid % nig) % gsz); u.pn = (wgid % nig) / gsz; u.e = 0; return true;
    }
    DI const bf16* aptr(const Unit& u) const { return A + (size_t)u.pm * 256 * 1024; }
    DI const bf16* bptr(const Unit& u) const { return Bt + (size_t)u.pn * 256 * 1024; }
};
struct MoeOrder {
    const bf16* A; const bf16* Bt; size_t bstride; int nsh, G, c; const LAS int* tp;
    DI bool next(int i, Unit& u) const {
        const int L = i * G + c; const int ntile = __builtin_amdgcn_readfirstlane(tp[0]); if (L >= (ntile << nsh)) return false;
        const int rt = L >> nsh; u.pm = rt; u.pn = L & ((1 << nsh) - 1); u.e = __builtin_amdgcn_readfirstlane(tp[1 + rt]); return true;
    }
    DI const bf16* aptr(const Unit& u) const { return A + (size_t)u.pm * 256 * 1024; }
    DI const bf16* bptr(const Unit& u) const { return Bt + (size_t)u.e * bstride + (size_t)u.pn * 256 * 1024; }
};

struct EpiInproj {
    static constexpr bool PAIR = false;
    bf16* P; float* extra; const float* bias; const float* bias_x;
    DI void row8(const Unit& u, int r, int c, const float (&v)[8]) const {
        const int row = u.pm * 256 + r, col = u.pn * 256 + c;
        if (col < PLD) {
            float w[8];
#pragma unroll
            for (int j = 0; j < 8; ++j) w[j] = v[j] + (bias ? bias[col + j] : 0.f);
            *(u32x4*)(P + (size_t)row * PLD + col) = pack8(w);
        } else if (col < PLD + 32) {
            float* o = extra + (size_t)row * 32 + (col - PLD);
#pragma unroll
            for (int j = 0; j < 8; ++j) o[j] = v[j] + (bias_x ? bias_x[col - PLD + j] : 0.f);
        }
    }
};
struct EpiOutproj {
    static constexpr bool PAIR = false;
    const float* xs_l; const float* xs_c; float* X; float* XC; const float* mod; const float* bias; int row_off; int perm;
    DI void row8(const Unit& u, int r, int c, const float (&v)[8]) const {
        const int hrow = u.pm * 256 + r + row_off, col = u.pn * 256 + c;
        const float* src; float* dst; int mr;
        if (hrow < TC) { mr = 8; src = xs_c + (size_t)hrow * D + col; dst = XC + (size_t)hrow * D + col; }
        else { const int rr = hrow - TC, b = rr >> 11, sp = rr & (SEQ - 1), s = perm ? perm_inv(sp) : sp; mr = b;
               src = xs_l + ((size_t)b * SEQ + s) * D + col; dst = X + ((size_t)b * SEQ + s) * D + col; }
        const float* g1 = mod + mr * 6144 + 2048 + col;
        const f32x4 a0 = *(const f32x4*)src, a1 = *(const f32x4*)(src + 4), g0 = *(const f32x4*)g1, gg1 = *(const f32x4*)(g1 + 4);
        f32x4 b0 = {0.f, 0.f, 0.f, 0.f}, b1 = b0;
        if (bias) { b0 = *(const f32x4*)(bias + col); b1 = *(const f32x4*)(bias + col + 4); }
        f32x4 o0, o1;
        o0 = a0 + g0 * ((f32x4){v[0], v[1], v[2], v[3]} + b0); o1 = a1 + gg1 * ((f32x4){v[4], v[5], v[6], v[7]} + b1);
        *(f32x4*)dst = o0; *(f32x4*)(dst + 4) = o1;
    }
};
struct EpiUp {
    static constexpr bool PAIR = true;
    bf16* ACT;
    DI void row8p(const Unit& u, int r, int c, const float (&g)[8], const float (&up)[8]) const {
        float w[8];
#pragma unroll
        for (int j = 0; j < 8; ++j) w[j] = siluf_(g[j]) * up[j];
        *(u32x4*)(ACT + ((size_t)u.pm * 256 + r) * 1024 + u.pn * 128 + c) = pack8(w);
    }
};
struct EpiDown {
    static constexpr bool PAIR = false;
    bf16* YS;
    DI void row8(const Unit& u, int r, int c, const float (&v)[8]) const { *(u32x4*)(YS + ((size_t)u.pm * 256 + r) * 1024 + u.pn * 256 + c) = pack8(v); }
};

template <class Sched, class Epi>
DI void gemm_fast(LAS unsigned char* lds, int tid, const Sched& S, const Epi& E) {
    using namespace pg8;
    constexpr int K = 1024, nt = K / BK;
    const int wid = __builtin_amdgcn_readfirstlane(tid >> 6), lane = tid & 63, wr = wid >> 2, wc = wid & 3, fr = lane & 15, fq = lane >> 4;
    unsigned voffA[2], voffB[2];
#pragma unroll
    for (int i = 0; i < 2; ++i) { int R, C; stage_rc(tid * 16 + i * 8192, R, C); const int Rb = (R & ~31) + perm32(R & 31);
        voffA[i] = (unsigned)(R * K + C) * 2u; voffB[i] = (unsigned)(Rb * K + C) * 2u; }
    const size_t kstep = (size_t)(BK * 2);
    const size_t hstep = (size_t)HALF * K * 2;
    const unsigned ldsw = (unsigned)wid * 1024u;
    const int aoff = lds_byte(wr * 64 + fr, fq * 8), boff = lds_byte(wc * 32 + fr, fq * 8);
#define PG8_SA(b, h) (((b) * 2 + (h)) * HTB)
#define PG8_SB(b, h) ((4 + (b) * 2 + (h)) * HTB)
#define PG8_STAGE(bufoff, gbase, voff) do { _Pragma("unroll") for (int _i = 0; _i < 2; ++_i) \
        __builtin_amdgcn_global_load_lds((const unsigned*)((const char*)(gbase) + (voff)[_i]), (LAS unsigned*)(lds + (bufoff) + ldsw + _i * 8192), 16, 0, 0); } while (0)
#define PG8_LDA(dst, b, h) do { _Pragma("unroll") for (int m = 0; m < 4; ++m) _Pragma("unroll") for (int k = 0; k < 2; ++k) dst[m][k] = *(const LAS bf16x8*)(lds + PG8_SA(b, h) + aoff + m * 2048 + k * 1024); } while (0)
#define PG8_LDB(dst, b, h) do { _Pragma("unroll") for (int n = 0; n < 2; ++n) _Pragma("unroll") for (int k = 0; k < 2; ++k) dst[n][k] = *(const LAS bf16x8*)(lds + PG8_SB(b, h) + boff + n * 2048 + k * 1024); } while (0)
#define PG8_MMA(ai, bj, At, Bt) do { __builtin_amdgcn_s_setprio(1); _Pragma("unroll") for (int m = 0; m < 4; ++m) _Pragma("unroll") for (int n = 0; n < 2; ++n) _Pragma("unroll") for (int k = 0; k < 2; ++k) \
        acc[ai][bj][m][n] = __builtin_amdgcn_mfma_f32_16x16x32_bf16(Bt[n][k], At[m][k], acc[ai][bj][m][n], 0, 0, 0); __builtin_amdgcn_s_setprio(0); } while (0)
#define PG8_WAIT_V(n) asm volatile("s_waitcnt vmcnt(" #n ")" ::: "memory")
#define PG8_WAIT_L(n) asm volatile("s_waitcnt lgkmcnt(" #n ")" ::: "memory")
#define PG8_BAR __builtin_amdgcn_s_barrier()
#define PG8_SCHED __builtin_amdgcn_sched_barrier(0)
    Unit cur, nxt; int ui = 0;
    if (!S.next(0, cur)) return;
    f32x4 acc[2][2][4][2];
#pragma unroll
    for (int a = 0; a < 2; ++a)
#pragma unroll
        for (int b = 0; b < 2; ++b)
#pragma unroll
            for (int m = 0; m < 4; ++m)
#pragma unroll
                for (int n = 0; n < 2; ++n) acc[a][b][m][n] = (f32x4){0.f, 0.f, 0.f, 0.f};
    bf16x8 At[4][2], B0[2][2], B1[2][2];
    const char* cA = (const char*)S.aptr(cur); const char* cB = (const char*)S.bptr(cur);
    PG8_STAGE(PG8_SB(0, 0), cB, voffB); PG8_STAGE(PG8_SA(0, 0), cA, voffA); PG8_STAGE(PG8_SB(0, 1), cB + hstep, voffB); PG8_STAGE(PG8_SA(0, 1), cA + hstep, voffA);
    if (wr == 1) PG8_BAR;
    PG8_WAIT_V(4); PG8_BAR;
    PG8_STAGE(PG8_SB(1, 0), cB + kstep, voffB); PG8_STAGE(PG8_SA(1, 0), cA + kstep, voffA); PG8_STAGE(PG8_SB(1, 1), cB + hstep + kstep, voffB);
    PG8_WAIT_V(6); PG8_BAR;
    for (;;) {
        const bool has_next = S.next(ui + 1, nxt);
        const char* nA = has_next ? (const char*)S.aptr(nxt) : cA; const char* nB = has_next ? (const char*)S.bptr(nxt) : cB;
        for (int t = 0; t < nt; t += 2) {
            const bool last = (t == nt - 2);
            const char* a1 = cA + (size_t)(t + 1) * kstep;
            const char* a2 = last ? nA : cA + (size_t)(t + 2) * kstep; const char* b2 = last ? nB : cB + (size_t)(t + 2) * kstep;
            const char* a3 = a2 + kstep; const char* b3 = b2 + kstep;
            PG8_LDB(B0, 0, 0); PG8_SCHED; PG8_LDA(At, 0, 0); PG8_STAGE(PG8_SA(1, 1), a1 + hstep, voffA);
            PG8_WAIT_L(8); PG8_BAR; PG8_WAIT_L(0); PG8_MMA(0, 0, At, B0); PG8_BAR; PG8_SCHED;
            PG8_LDB(B1, 0, 1); PG8_STAGE(PG8_SB(0, 0), b2, voffB);
            PG8_BAR; PG8_WAIT_L(0); PG8_MMA(0, 1, At, B1); PG8_BAR;
            PG8_LDA(At, 0, 1); PG8_STAGE(PG8_SA(0, 0), a2, voffA);
            PG8_BAR; PG8_WAIT_L(0); PG8_MMA(1, 0, At, B0); PG8_BAR; PG8_SCHED;
            PG8_STAGE(PG8_SB(0, 1), b2 + hstep, voffB);
            PG8_WAIT_V(6); PG8_BAR; PG8_MMA(1, 1, At, B1); PG8_BAR;
            PG8_LDB(B0, 1, 0); PG8_SCHED; PG8_LDA(At, 1, 0); PG8_STAGE(PG8_SA(0, 1), a2 + hstep, voffA);
            PG8_WAIT_L(8); PG8_BAR; PG8_WAIT_L(0); PG8_MMA(0, 0, At, B0); PG8_BAR; PG8_SCHED;
            PG8_LDB(B1, 1, 1); PG8_STAGE(PG8_SB(1, 0), b3, voffB);
            PG8_BAR; PG8_WAIT_L(0); PG8_MMA(0, 1, At, B1); PG8_BAR;
            PG8_LDA(At, 1, 1); PG8_STAGE(PG8_SA(1, 0), a3, voffA);
            PG8_BAR; PG8_WAIT_L(0); PG8_MMA(1, 0, At, B0); PG8_BAR; PG8_SCHED;
            PG8_STAGE(PG8_SB(1, 1), b3 + hstep, voffB);
            PG8_WAIT_V(6); PG8_BAR; PG8_MMA(1, 1, At, B1); PG8_BAR;
        }
#pragma unroll
        for (int ai = 0; ai < 2; ++ai)
#pragma unroll
            for (int m = 0; m < 4; ++m) {
                const int r = ai * HALF + wr * 64 + m * 16 + fr;
                if constexpr (Epi::PAIR) {
                    const float g[8] = {acc[ai][0][m][0][0], acc[ai][0][m][0][1], acc[ai][0][m][0][2], acc[ai][0][m][0][3], acc[ai][0][m][1][0], acc[ai][0][m][1][1], acc[ai][0][m][1][2], acc[ai][0][m][1][3]};
                    const float up[8] = {acc[ai][1][m][0][0], acc[ai][1][m][0][1], acc[ai][1][m][0][2], acc[ai][1][m][0][3], acc[ai][1][m][1][0], acc[ai][1][m][1][1], acc[ai][1][m][1][2], acc[ai][1][m][1][3]};
                    E.row8p(cur, r, wc * 32 + 8 * fq, g, up);
                } else {
#pragma unroll
                    for (int bj = 0; bj < 2; ++bj) {
                        const float v[8] = {acc[ai][bj][m][0][0], acc[ai][bj][m][0][1], acc[ai][bj][m][0][2], acc[ai][bj][m][0][3], acc[ai][bj][m][1][0], acc[ai][bj][m][1][1], acc[ai][bj][m][1][2], acc[ai][bj][m][1][3]};
                        E.row8(cur, r, bj * HALF + wc * 32 + 8 * fq, v);
                    }
                }
            }
        if (!has_next) break;
#pragma unroll
        for (int a = 0; a < 2; ++a)
#pragma unroll
            for (int b = 0; b < 2; ++b)
#pragma unroll
                for (int m = 0; m < 4; ++m)
#pragma unroll
                    for (int n = 0; n < 2; ++n) acc[a][b][m][n] = (f32x4){0.f, 0.f, 0.f, 0.f};
        cur = nxt; cA = nA; cB = nB; ++ui;
    }
    PG8_WAIT_V(0);
    if (wr == 0) PG8_BAR;
    PG8_BAR;
#undef PG8_SA
#undef PG8_SB
#undef PG8_STAGE
#undef PG8_LDA
#undef PG8_LDB
#undef PG8_MMA
#undef PG8_WAIT_V
#undef PG8_WAIT_L
#undef PG8_BAR
#undef PG8_SCHED
}

template <class Sched, class Epi>
DI void gemm_naive(LAS unsigned char* lds, int tid, const Sched& S, const Epi& E) {
    LAS float* As = (LAS float*)lds;
    LAS float* Bs = As + 32 * 132;
    LAS float* Bu = Bs + 32 * 132;
    const int ty = tid >> 4, tx = tid & 15, lr = tid >> 2, kq = tid & 3;
    Unit u;
    for (int i = 0; S.next(i, u); ++i) {
        const bf16* A = S.aptr(u); const bf16* B = S.bptr(u);
        for (int sm = 0; sm < 2; ++sm)
            for (int sn = 0; sn < (Epi::PAIR ? 1 : 2); ++sn) {
                float acc[4][8], accu[4][8];
#pragma unroll
                for (int a = 0; a < 4; ++a)
#pragma unroll
                    for (int b = 0; b < 8; ++b) { acc[a][b] = 0.f; accu[a][b] = 0.f; }
                for (int k0 = 0; k0 < 1024; k0 += 32) {
                    __syncthreads();
                    { float w[8]; unpack8(*(const u32x4*)(A + (size_t)(128 * sm + lr) * 1024 + k0 + 8 * kq), w);
#pragma unroll
                      for (int j = 0; j < 8; ++j) As[(8 * kq + j) * 132 + lr] = w[j];
                      unpack8(*(const u32x4*)(B + (size_t)(128 * sn + lr) * 1024 + k0 + 8 * kq), w);
#pragma unroll
                      for (int j = 0; j < 8; ++j) Bs[(8 * kq + j) * 132 + lr] = w[j];
                      if (Epi::PAIR) { unpack8(*(const u32x4*)(B + (size_t)(128 + lr) * 1024 + k0 + 8 * kq), w);
#pragma unroll
                          for (int j = 0; j < 8; ++j) Bu[(8 * kq + j) * 132 + lr] = w[j]; } }
                    __syncthreads();
#pragma unroll 4
                    for (int k = 0; k < 32; ++k) {
                        const f32x4 a4 = *(const LAS f32x4*)(As + k * 132 + 4 * ty);
                        const f32x4 b0 = *(const LAS f32x4*)(Bs + k * 132 + 8 * tx), b1 = *(const LAS f32x4*)(Bs + k * 132 + 8 * tx + 4);
#pragma unroll
                        for (int a = 0; a < 4; ++a) {
#pragma unroll
                            for (int b = 0; b < 4; ++b) { acc[a][b] += a4[a] * b0[b]; acc[a][4 + b] += a4[a] * b1[b]; } }
                        if (Epi::PAIR) {
                            const f32x4 c0 = *(const LAS f32x4*)(Bu + k * 132 + 8 * tx), c1 = *(const LAS f32x4*)(Bu + k * 132 + 8 * tx + 4);
#pragma unroll
                            for (int a = 0; a < 4; ++a) {
#pragma unroll
                                for (int b = 0; b < 4; ++b) { accu[a][b] += a4[a] * c0[b]; accu[a][4 + b] += a4[a] * c1[b]; } }
                        }
                    }
                }
#pragma unroll
                for (int a = 0; a < 4; ++a) {
                    if constexpr (Epi::PAIR) E.row8p(u, 128 * sm + 4 * ty + a, 8 * tx, acc[a], accu[a]);
                    else E.row8(u, 128 * sm + 4 * ty + a, 128 * sn + 8 * tx, acc[a]);
                }
            }
    }
    __syncthreads();
}
template <class Sched, class Epi>
DI void gemm_run(LAS unsigned char* lds, int tid, const Sched& S, const Epi& E) {
#if FAST_GEMM
    gemm_fast(lds, tid, S, E);
#else
    gemm_naive(lds, tid, S, E);
#endif
}

struct Ctx {
    LAS unsigned char* lds;
    int tid, lane, wave, gw, ngw;
    const float* const* in;
    float* out;
    unsigned char* ws;
};
#define WSP(T, off) ((T*)(c.ws + (off)))

DI void transpose_item(const float* W, int N, bf16* WT, int k0, int n0, int dst_row0, LAS float* scr, int lane) {
#pragma unroll 8
    for (int i = 0; i < 32; ++i) { const int kk = 2 * i + (lane >> 5); scr[kk * 33 + (lane & 31)] = W[(size_t)(k0 + kk) * N + n0 + (lane & 31)]; }
    asm volatile("s_waitcnt lgkmcnt(0)" ::: "memory");
    const int cc = lane & 7;
#pragma unroll
    for (int j = 0; j < 4; ++j) { const int n = (lane >> 3) + 8 * j; const LAS float* s = scr + (8 * cc) * 33 + n;
        u32x4 o; o.x = cvt_pk_bf16(s[0 * 33], s[1 * 33]); o.y = cvt_pk_bf16(s[2 * 33], s[3 * 33]); o.z = cvt_pk_bf16(s[4 * 33], s[5 * 33]); o.w = cvt_pk_bf16(s[6 * 33], s[7 * 33]);
        *(u32x4*)(WT + (size_t)(dst_row0 + n) * 1024 + k0 + 8 * cc) = o; }
    asm volatile("s_waitcnt lgkmcnt(0)" ::: "memory");
}
DI void dense_transpose(const Ctx& c, const float* W, int N, bf16* WT, LAS float* scr) {
    const int nblk = N / 32, nitems = 16 * nblk;
    for (int it = c.gw; it < nitems; it += c.ngw) { const int kb = it / nblk, nb = it % nblk; transpose_item(W, N, WT, 64 * kb, 32 * nb, 32 * nb, scr, c.lane); }
}
DI void phase_pro0(const Ctx& c) {
    LAS float* scr = (LAS float*)(c.lds + c.wave * 8704);
    for (int j = 0; j < 2; ++j) {
        dense_transpose(c, c.in[I_MLWIN] + (size_t)j * 1024 * 3104, 3104, WSP(bf16, WS_ML_WIN) + (size_t)j * NINP * 1024, scr);
        dense_transpose(c, c.in[I_MLWOUT] + (size_t)j * 1024 * 1024, 1024, WSP(bf16, WS_ML_WOUT) + (size_t)j * 1024 * 1024, scr);
    }
    dense_transpose(c, c.in[I_GLWIN], 3104, WSP(bf16, WS_GLA_WIN), scr);
    dense_transpose(c, c.in[I_GLWOUT], 1024, WSP(bf16, WS_GLA_WOUT), scr);
    dense_transpose(c, c.in[I_HYWIN], 3072, WSP(bf16, WS_HY_WIN), scr);
    dense_transpose(c, c.in[I_HYWOUT], 1024, WSP(bf16, WS_HY_WOUT), scr);
    for (int it = c.gw * 64 + c.lane; it < 3 * 28672; it += c.ngw * 64) {
        const int m = it / 28672, r = it % 28672; bf16* base = (m < 2) ? WSP(bf16, WS_ML_WIN) + (size_t)m * NINP * 1024 : WSP(bf16, WS_GLA_WIN);
        *(u32x4*)(base + (size_t)3104 * 1024 + (size_t)r * 8) = (u32x4){0u, 0u, 0u, 0u};
    }
    for (int it = c.gw; it < 64 * 3 * 512; it += c.ngw) {
        const int le = it / 1536, r0 = it % 1536, which = r0 / 512, r = r0 % 512, kb = r / 32, nb = r % 32;
        if (which < 2) {
            const float* W = c.in[which == 0 ? I_EW1 : I_EW3] + (size_t)le * 1024 * 1024;
            const int n0 = 32 * nb, drow = 256 * (n0 >> 7) + (n0 & 127) + (which ? 128 : 0);
            transpose_item(W, 1024, WSP(bf16, WS_EXP_UP) + (size_t)le * 2048 * 1024, 64 * kb, n0, drow, scr, c.lane);
        } else {
            transpose_item(c.in[I_EW2] + (size_t)le * 1024 * 1024, 1024, WSP(bf16, WS_EXP_DN) + (size_t)le * 1024 * 1024, 64 * kb, 32 * nb, 32 * nb, scr, c.lane);
        }
    }
    {
        const float* w1 = c.in[I_HYFW1]; const float* b1 = c.in[I_HYFB1]; const float* wm = c.in[I_HYFWM]; const float* bm = c.in[I_HYFBM]; const float* fr = c.in[I_HYFREQ];
        float* HM = WSP(float, WS_HM);
        for (int row = c.gw; row < 2304; row += c.ngw) {
            const int L = row < 2048 ? 2048 : 256, t = row < 2048 ? row : row - 2048, f = c.lane;
            float feat = 0.f;
            if (f == 0) feat = (float)t / (float)(L - 1);
            else if (f <= 32) { const int b = (f - 1) & 15; const float band = 1e-4f + (float)b * ((15.0f - 1e-4f) / 15.0f);
                const float ang = ((float)(2.0 * 3.14159265358979323846 / (double)L) * (float)t) * band; feat = (f <= 16) ? cosf(ang) : -sinf(ang); }
            float a = b1[f];
            for (int e = 0; e < 33; ++e) a += __shfl(feat, e) * w1[e * 64 + f];
            float h = sinf(fr[f] * a);
            for (int m = 0; m < 2; ++m) {
                float a2 = bm[m * 64 + f];
                for (int g = 0; g < 64; ++g) a2 += __shfl(h, g) * wm[m * 4096 + g * 64 + f];
                h = sinf(fr[f] * a2);
            }
            HM[row * 64 + f] = h;
        }
    }
    __syncthreads();
    {
        LAS float* sv = (LAS float*)c.lds;
        LAS float* red = sv + 9 * 1024;
        for (int i = c.tid; i < 9 * 1024; i += 512) { const float x = (i < 8192) ? c.in[I_C][i] : c.in[I_CCTX][i - 8192]; sv[i] = siluf_(x); }
        __syncthreads();
        float* MOD = WSP(float, WS_MOD);
        const int col = c.tid & 63, kg = c.tid >> 6;
        for (int item = blockIdx.x; item < 4 * 96; item += gridDim.x) {
            const int l = item / 96, j0 = 64 * (item % 96);
            const float* w = c.in[I_ADAW] + (size_t)l * 1024 * 6144 + j0 + col;
            float acc[9];
#pragma unroll
            for (int r = 0; r < 9; ++r) acc[r] = 0.f;
            for (int k = kg * 128; k < kg * 128 + 128; ++k) { const float wv = w[(size_t)k * 6144];
#pragma unroll
                for (int r = 0; r < 9; ++r) acc[r] += sv[r * 1024 + k] * wv; }
#pragma unroll
            for (int r = 0; r < 9; ++r) red[(kg * 9 + r) * 64 + col] = acc[r];
            __syncthreads();
            for (int o = c.tid; o < 9 * 64; o += 512) { const int r = o >> 6, cc = o & 63; float s = c.in[I_ADAB][l * 6144 + j0 + cc];
#pragma unroll
                for (int g = 0; g < 8; ++g) s += red[(g * 9 + r) * 64 + cc];
                MOD[(l * 9 + r) * 6144 + j0 + cc] = s; }
            __syncthreads();
        }
    }
}

DI void phase_pro1(const Ctx& c) {
    LAS float* wo = (LAS float*)c.lds;
    LAS float* red = wo + 2048;
    const float* HM = WSP(float, WS_HM);
    const int ch = c.tid & 15, tg = c.tid >> 4;
    for (int item = blockIdx.x; item < 128; item += gridDim.x) {
        const int lsel = item >> 6, c0 = 16 * (item & 63), L = lsel ? 256 : 2048;
        const float* hm = lsel ? HM + 2048 * 64 : HM; float* tab = lsel ? WSP(float, WS_HFC) : WSP(float, WS_HF);
        __syncthreads();
        for (int i = c.tid; i < 2048; i += 512) { const int side = i >> 10, f = (i >> 4) & 63, cc = i & 15; wo[i] = c.in[I_HYFWO][f * 2048 + side * 1024 + c0 + cc]; }
        __syncthreads();
        const int cg_ = c0 + ch;
        const float da = -4.605170185988091f / 1.5f, db = -4.605170185988091f / 0.3f;
        const float delta = fabsf(da + (float)cg_ * ((db - da) / 1023.0f));
        float* trow = tab + (size_t)cg_ * (2 * L);
        float part = 0.f;
        for (int t = tg; t < L; t += 32) {
            float af = 0.f, ab = 0.f;
            for (int f = 0; f < 64; ++f) { const float h = hm[t * 64 + f]; af += h * wo[f * 16 + ch]; ab += h * wo[1024 + f * 16 + ch]; }
            const float dec = expf(-((float)t / (float)(L - 1)) * delta); af *= dec; ab *= dec;
            trow[L + t] = af; part += fabsf(af);
            if (t >= 1) { trow[L - t] = ab; part += fabsf(ab); }
        }
        red[tg * 16 + ch] = part;
        __syncthreads();
        float l1 = 0.f;
        for (int g = 0; g < 32; ++g) l1 += red[g * 16 + ch];
        const float inv = 1.0f / l1;
        for (int t = tg; t < L; t += 32) { trow[L + t] *= inv; if (t >= 1) trow[L - t] *= inv; }
        if (tg == 0) trow[0] = 0.f;
    }
}

DI void load_row(const float* src, f32x4 (&v)[4], int lane) {
#pragma unroll
    for (int j = 0; j < 4; ++j) v[j] = *(const f32x4*)(src + 256 * j + 4 * lane);
}
DI void norm_row(f32x4 (&v)[4], const float* g, int lane) {
    float s = 0.f;
#pragma unroll
    for (int j = 0; j < 4; ++j) s += (v[j].x * v[j].x + v[j].y * v[j].y) + (v[j].z * v[j].z + v[j].w * v[j].w);
    s = wave_sum(s);
    const float r = 1.0f / sqrtf(s * (1.0f / 1024.0f) + EPS);
#pragma unroll
    for (int j = 0; j < 4; ++j) v[j] = v[j] * r * *(const f32x4*)(g + 256 * j + 4 * lane);
}
DI void mod_row(f32x4 (&v)[4], const float* sh, const float* sc, int lane) {
#pragma unroll
    for (int j = 0; j < 4; ++j) v[j] = v[j] * (*(const f32x4*)(sc + 256 * j + 4 * lane) + 1.0f) + *(const f32x4*)(sh + 256 * j + 4 * lane);
}
DI void store_row_bf16(bf16* dst, const f32x4 (&v)[4], int lane) {
#pragma unroll
    for (int j = 0; j < 4; ++j) { u32x2 w; w.x = cvt_pk_bf16(v[j].x, v[j].y); w.y = cvt_pk_bf16(v[j].z, v[j].w); *(u32x2*)(dst + 256 * j + 4 * lane) = w; }
}
DI int hrow_of(int srow, int kind) {
    if (srow < TC || kind != 1) return srow;
    const int rr = srow - TC, b = rr >> 11, s = rr & (SEQ - 1); return TC + b * SEQ + perm_fwd(s);
}
DI void phase_norm1(const Ctx& c, int l, const float* xl, const float* xc) {
    const float* MOD = WSP(float, WS_MOD) + (size_t)l * 9 * 6144; const float* g = c.in[I_N1G] + l * D; bf16* H = WSP(bf16, WS_H);
    for (int row = c.gw; row < TT; row += c.ngw) {
        f32x4 v[4]; const int mr = row < TC ? 8 : (row - TC) >> 11;
        load_row(row < TC ? xc + (size_t)row * D : xl + (size_t)(row - TC) * D, v, c.lane);
        norm_row(v, g, c.lane); mod_row(v, MOD + mr * 6144, MOD + mr * 6144 + 1024, c.lane);
        store_row_bf16(H + (size_t)hrow_of(row, l % 3) * D, v, c.lane);
    }
}

DI void phase_conv(const Ctx& c, int ncols, const float* cw, const float* cb, bool act, float qs) {
    const bf16* P = WSP(bf16, WS_P); bf16* PC = WSP(bf16, WS_BIG + BIG_PC);
    const int ng = ncols / 8; const long total = (long)TT * ng;
    for (long idx = (long)blockIdx.x * 512 + c.tid; idx < total; idx += (long)gridDim.x * 512) {
        const int row = (int)(idx / ng), col = (int)(idx % ng) * 8; int lo, hi; seq_bounds(row, lo, hi);
        float x0[8], xm[8], xp[8];
        unpack8(*(const u32x4*)(P + (size_t)row * PLD + col), x0);
        if (row > lo) unpack8(*(const u32x4*)(P + (size_t)(row - 1) * PLD + col), xm); else {
#pragma unroll
            for (int j = 0; j < 8; ++j) xm[j] = 0.f; }
        if (row < hi) unpack8(*(const u32x4*)(P + (size_t)(row + 1) * PLD + col), xp); else {
#pragma unroll
            for (int j = 0; j < 8; ++j) xp[j] = 0.f; }
        float o[8];
#pragma unroll
        for (int j = 0; j < 8; ++j) { float v = cw[col + j] * xm[j] + cw[ncols + col + j] * x0[j] + cw[2 * ncols + col + j] * xp[j] + cb[col + j];
            if (act) v = siluf_(v); if (col < 512) v *= qs; o[j] = v; }
        *(u32x4*)(PC + (size_t)row * ncols + col) = pack8(o);
    }
}

DI int scan_row(int step, int b, int dir) {
    if (step < CTX) return b * CTX + (dir ? CTX - 1 - step : step);
    const int s = step - CTX; return TC + b * SEQ + (dir ? SEQ - 1 - s : s);
}
DI void phase_mlstm_scan_naive(const Ctx& c) {
    const bf16* P = WSP(bf16, WS_P); const bf16* PC = WSP(bf16, WS_BIG + BIG_PC); const float* EX = WSP(float, WS_EXTRA);
    LAS float* qs = (LAS float*)c.lds; LAS float* ks = qs + 32 * 64; LAS float* vs = ks + 32 * 64; LAS float* gs = vs + 32 * 128;
    const int v = c.tid >> 2, d0 = (c.tid & 3) * 16;
    for (int item = blockIdx.x; item < 128; item += gridDim.x) {
        const int b = item >> 4, h = (item >> 1) & 7, dir = item & 1;
        float* Yo = WSP(float, WS_BIG + (dir ? BIG_YB : BIG_YF));
        float C[16], n[16];
#pragma unroll
        for (int d = 0; d < 16; ++d) { C[d] = 0.f; n[d] = 0.f; }
        for (int ch = 0; ch < (CTX + SEQ) / 32; ++ch) {
            __syncthreads();
            for (int idx = c.tid; idx < 32 * 256; idx += 512) { const int st = idx >> 8, col = idx & 255, row = scan_row(ch * 32 + st, b, dir);
                if (col < 64) qs[st * 64 + col] = bf2f(PC[(size_t)row * 1024 + h * 64 + col]);
                else if (col < 128) ks[st * 64 + col - 64] = bf2f(PC[(size_t)row * 1024 + 512 + h * 64 + col - 64]);
                else vs[st * 128 + col - 128] = bf2f(P[(size_t)row * PLD + 1024 + h * 128 + col - 128]); }
            if (c.tid < 32) { const int row = scan_row(ch * 32 + c.tid, b, dir); gs[c.tid * 2] = sigmoidf_(EX[(size_t)row * 32 + dir * 16 + 8 + h]); gs[c.tid * 2 + 1] = __expf(EX[(size_t)row * 32 + dir * 16 + h]); }
            __syncthreads();
            for (int st = 0; st < 32; ++st) {
                const float f = gs[st * 2], ei = gs[st * 2 + 1], vv = vs[st * 128 + v] * ei;
                float part = 0.f, dpart = 0.f;
#pragma unroll
                for (int d = 0; d < 16; ++d) { const float kd = ks[st * 64 + d0 + d], qd = qs[st * 64 + d0 + d];
                    C[d] = f * C[d] + kd * vv; part += qd * C[d]; n[d] = f * n[d] + ei * kd; dpart += qd * n[d]; }
                part += __shfl_xor(part, 1); part += __shfl_xor(part, 2); dpart += __shfl_xor(dpart, 1); dpart += __shfl_xor(dpart, 2);
                if ((c.tid & 3) == 0) { const int row = scan_row(ch * 32 + st, b, dir); Yo[(size_t)row * D + h * 128 + v] = part / fmaxf(fabsf(dpart), 1.0f); }
            }
        }
    }
}
typedef short s16x4 __attribute__((ext_vector_type(4)));
typedef float f32x16 __attribute__((ext_vector_type(16)));
#define MFMA32(a, b, c) __builtin_amdgcn_mfma_f32_32x32x16_bf16((a), (b), (c), 0, 0, 0)
DI int crow(int reg, int h) { return (reg & 3) + 8 * (reg >> 2) + 4 * h; }
DI s16x4 ds_tr(const LAS unsigned char* p) { return __builtin_amdgcn_ds_read_tr16_b64_v4i16((LAS s16x4*)p); }
DI bf16x8 cat8(s16x4 lo, s16x4 hi) { return __builtin_shufflevector(lo, hi, 0, 1, 2, 3, 4, 5, 6, 7); }
DI bf16x8 tr_frag(const LAS unsigned char* img, int pitch, int k0, int n0, int lane) {
    const int h = lane >> 5, g16 = (lane >> 4) & 1, i = lane & 15;
    const LAS unsigned char* p = img + (k0 + 8 * h + (i >> 2)) * pitch + (n0 + 16 * g16 + 4 * (i & 3)) * 2;
    return cat8(ds_tr(p), ds_tr(p + 4 * pitch));
}
DI bf16x8 tr_frag_perm(const LAS unsigned char* img, int pitch, int k0, int n0, int lane) {
    const int h = lane >> 5, g16 = (lane >> 4) & 1, i = lane & 15;
    const LAS unsigned char* p = img + (k0 + 4 * h + (i >> 2)) * pitch + (n0 + 16 * g16 + 4 * (i & 3)) * 2;
    return cat8(ds_tr(p), ds_tr(p + 8 * pitch));
}
DI bf16x8 row_frag(const LAS unsigned char* img, int pitch, int row0, int k0, int lane) { return *(const LAS bf16x8*)(img + (row0 + (lane & 31)) * pitch + (k0 + 8 * (lane >> 5)) * 2); }
DI bf16x8 pack_acc(const f32x16& x, int step) {
    u32x4 p; const int o = 8 * step;
    p.x = cvt_pk_bf16(x[o], x[o + 1]); p.y = cvt_pk_bf16(x[o + 2], x[o + 3]); p.z = cvt_pk_bf16(x[o + 4], x[o + 5]); p.w = cvt_pk_bf16(x[o + 6], x[o + 7]);
    return __builtin_bit_cast(bf16x8, p);
}
DI f32x16 zero16() { f32x16 z;
#pragma unroll
    for (int i = 0; i < 16; ++i) z[i] = 0.f; return z; }
DI float wave_incl_prefix(float x, int lane) {
#pragma unroll
    for (int o = 1; o < 64; o <<= 1) { const float t = __shfl_up(x, o); if (lane >= o) x += t; }
    return x;
}
DI float wave_incl_suffix(float x, int lane) {
#pragma unroll
    for (int o = 1; o < 64; o <<= 1) { const float t = __shfl_down(x, o); if (lane + o < 64) x += t; }
    return x;
}
DI int chunk_row0(int p, int b, int dir) {
    if (p < 4) return b * CTX + 64 * (dir ? 3 - p : p);
    return TC + b * SEQ + 64 * (dir ? 35 - p : p - 4);
}

DI void phase_mlstm_state(const Ctx& c) {
    const bf16* P = WSP(bf16, WS_P); const bf16* PC = WSP(bf16, WS_BIG + BIG_PC); const float* EX = WSP(float, WS_EXTRA);
    bf16* MCT = WSP(bf16, WS_BIG + BIG_MCT); float* MN = WSP(float, WS_BIG + BIG_MN);
    LAS float* gi = (LAS float*)c.lds; LAS float* ga = gi + 2304; LAS float* wv = ga + 2304; LAS float* dec = wv + 64;
    LAS unsigned char* Kw = c.lds + 20480; LAS unsigned char* Vs = Kw + 64 * 144;
    const int lane = c.lane, wave = c.wave, h5 = lane >> 5, l31 = lane & 31;
    for (int item = blockIdx.x; item < 256; item += gridDim.x) {
        const int b = item >> 5, h = (item >> 2) & 7, dir = (item >> 1) & 1, dvh = item & 1, seq = (b * 8 + h) * 2 + dir;
        __syncthreads();
        for (int idx = c.tid; idx < 2304; idx += 512) { const int row = chunk_row0(idx >> 6, b, dir) + (idx & 63);
            gi[idx] = EX[(size_t)row * 32 + dir * 16 + h]; ga[idx] = logsigf_(EX[(size_t)row * 32 + dir * 16 + 8 + h]); }
        f32x16 acc = zero16(); float nst = 0.f;
        const int dt = wave & 1, vt = (wave >> 1) & 1;
        const int srow = c.tid >> 3, spc = c.tid & 7;
        u32x4 kreg, vreg;
        { const int r0 = chunk_row0(0, b, dir);
          kreg = *(const u32x4*)(PC + (size_t)(r0 + srow) * 1024 + 512 + h * 64 + 8 * spc);
          vreg = *(const u32x4*)(P + (size_t)(r0 + srow) * PLD + 1024 + h * 128 + dvh * 64 + 8 * spc); }
        __syncthreads();
        for (int p = 0; p < 36; ++p) {
            if (wave < 4) {
                bf16* dst = MCT + ((size_t)seq * 36 + p) * 8192 + (size_t)(dvh * 64 + 32 * vt + l31) * 64 + 32 * dt + 4 * h5;
#pragma unroll
                for (int q = 0; q < 4; ++q) { u32x2 w; w.x = cvt_pk_bf16(acc[4 * q], acc[4 * q + 1]); w.y = cvt_pk_bf16(acc[4 * q + 2], acc[4 * q + 3]); *(u32x2*)(dst + 8 * q) = w; }
            } else if (wave == 4) { if (dvh == 0) MN[((size_t)seq * 36 + p) * 64 + lane] = nst; }
            else if (wave == 7) {
                const float a = ga[p * 64 + lane]; const float bj = dir ? wave_incl_suffix(a, lane) : wave_incl_prefix(a, lane);
                const float tot = __shfl(bj, dir ? 0 : 63);
                wv[lane] = __expf(tot - bj + gi[p * 64 + lane]); if (lane == 0) dec[0] = __expf(tot);
            }
            __syncthreads();
            { float kk[8]; unpack8(kreg, kk); const float w = wv[srow];
#pragma unroll
              for (int j = 0; j < 8; ++j) kk[j] *= w;
              *(LAS u32x4*)(Kw + srow * 144 + spc * 16) = pack8(kk); *(LAS u32x4*)(Vs + srow * 144 + spc * 16) = vreg; }
            if (p + 1 < 36) { const int r0 = chunk_row0(p + 1, b, dir);
                kreg = *(const u32x4*)(PC + (size_t)(r0 + srow) * 1024 + 512 + h * 64 + 8 * spc);
                vreg = *(const u32x4*)(P + (size_t)(r0 + srow) * PLD + 1024 + h * 128 + dvh * 64 + 8 * spc); }
            const float d = dec[0];
            __syncthreads();
            if (wave < 4) {
#pragma unroll
                for (int i = 0; i < 16; ++i) acc[i] *= d;
#pragma unroll
                for (int kk = 0; kk < 4; ++kk) acc = MFMA32(tr_frag(Kw, 144, 16 * kk, 32 * dt, lane), tr_frag(Vs, 144, 16 * kk, 32 * vt, lane), acc);
            } else if (wave == 4) {
                float s = 0.f;
                for (int r = 0; r < 64; ++r) s += bf2f(*(const LAS bf16*)(Kw + r * 144 + lane * 2));
                nst = d * nst + s;
            }
        }
    }
}

DI void phase_mlstm_out(const Ctx& c, const float* ng) {
    const bf16* P = WSP(bf16, WS_P); const bf16* PC = WSP(bf16, WS_BIG + BIG_PC); const float* EX = WSP(float, WS_EXTRA);
    const bf16* MCT = WSP(bf16, WS_BIG + BIG_MCT); const float* MN = WSP(float, WS_BIG + BIG_MN); bf16* Y = WSP(bf16, WS_Y);
    LAS unsigned char* Qs = c.lds; LAS unsigned char* Ks = Qs + 9216; LAS unsigned char* Vs = Ks + 9216;
    LAS unsigned char* CT0 = Vs + 17408;
    LAS float* gt = (LAS float*)(c.lds + MISC_OFF + 1024);
    LAS float* YO = (LAS float*)c.lds;
    const int lane = c.lane, wave = c.wave, h5 = lane >> 5, l31 = lane & 31;
    const int dir = wave >> 2, jt = (wave >> 1) & 1, vh = wave & 1;
    for (int item = blockIdx.x; item < 2304; item += gridDim.x) {
        const int b = item / 288, h = (item / 36) & 7, cc = item % 36;
        const int r0 = cc < 4 ? b * CTX + 64 * cc : TC + b * SEQ + 64 * (cc - 4);
        const int pf = cc, pb = cc < 4 ? 3 - cc : 39 - cc;
        __syncthreads();
        { const int srow = c.tid >> 3, spc = c.tid & 7;
          *(LAS u32x4*)(Qs + srow * 144 + spc * 16) = *(const u32x4*)(PC + (size_t)(r0 + srow) * 1024 + h * 64 + 8 * spc);
          *(LAS u32x4*)(Ks + srow * 144 + spc * 16) = *(const u32x4*)(PC + (size_t)(r0 + srow) * 1024 + 512 + h * 64 + 8 * spc);
#pragma unroll
          for (int i = 0; i < 2; ++i) *(LAS u32x4*)(Vs + srow * 272 + (spc + 8 * i) * 16) = *(const u32x4*)(P + (size_t)(r0 + srow) * PLD + 1024 + h * 128 + 8 * (spc + 8 * i));
#pragma unroll
          for (int i = 0; i < 4; ++i) { const int pc = c.tid + 512 * i, d2 = pc >> 10, rr = (pc >> 3) & 127, sp = pc & 7;
              const size_t so = (((size_t)((b * 8 + h) * 2 + d2)) * 36 + (d2 ? pb : pf)) * 8192;
              *(LAS u32x4*)(CT0 + d2 * 18432 + rr * 144 + sp * 16) = *(const u32x4*)(MCT + so + rr * 64 + 8 * sp); }
          if (wave < 2) { const int d2 = wave; const int row = r0 + lane;
              const float a = logsigf_(EX[(size_t)row * 32 + d2 * 16 + 8 + h]), ig = EX[(size_t)row * 32 + d2 * 16 + h];
              const float bj = d2 ? wave_incl_suffix(a, lane) : wave_incl_prefix(a, lane);
              gt[d2 * 192 + lane] = bj; gt[d2 * 192 + 64 + lane] = ig - bj;
              gt[d2 * 192 + 128 + lane] = MN[(((size_t)((b * 8 + h) * 2 + d2)) * 36 + (d2 ? pb : pf)) * 64 + lane]; } }
        __syncthreads();
        const LAS float* g = gt + dir * 192; const LAS unsigned char* CT = CT0 + dir * 18432;
        const int j = 32 * jt + l31; const float bjj = g[j];
        bf16x8 qf[4];
#pragma unroll
        for (int kk = 0; kk < 4; ++kk) qf[kk] = row_frag(Qs, 144, 32 * jt, 16 * kk, lane);
        float qn = 0.f;
#pragma unroll
        for (int kk = 0; kk < 4; ++kk) { float qv[8]; unpack8(__builtin_bit_cast(u32x4, qf[kk]), qv);
#pragma unroll
            for (int e = 0; e < 8; ++e) qn += qv[e] * g[128 + 16 * kk + 8 * h5 + e]; }
        qn += __shfl_xor(qn, 32);
        f32x16 X[2]; float den = 0.f;
#pragma unroll
        for (int st = 0; st < 2; ++st) {
            X[st] = zero16();
            const bool live = dir ? (st >= jt) : (st <= jt);
            if (live) {
#pragma unroll
                for (int kk = 0; kk < 4; ++kk) X[st] = MFMA32(row_frag(Ks, 144, 32 * st, 16 * kk, lane), qf[kk], X[st]);
#pragma unroll
                for (int r = 0; r < 16; ++r) { const int s = 32 * st + crow(r, h5); const bool ok = dir ? (s >= j) : (s <= j);
                    const float w = ok ? __expf(bjj + g[64 + s]) : 0.f; X[st][r] *= w; den += X[st][r]; }
            }
        }
        den += __shfl_xor(den, 32);
        const float eb = __expf(bjj); den += eb * qn;
        const float scale = 1.0f / fmaxf(fabsf(den), 1.0f);
        f32x16 O[2];
#pragma unroll
        for (int t = 0; t < 2; ++t) {
            const int vt = 2 * vh + t; f32x16 z = zero16(), w = zero16();
#pragma unroll
            for (int st = 0; st < 2; ++st) { const bool live = dir ? (st >= jt) : (st <= jt);
                if (live) {
#pragma unroll
                    for (int step = 0; step < 2; ++step) z = MFMA32(tr_frag_perm(Vs, 272, 32 * st + 16 * step, 32 * vt, lane), pack_acc(X[st], step), z); } }
#pragma unroll
            for (int kk = 0; kk < 4; ++kk) w = MFMA32(row_frag(CT, 144, 32 * vt, 16 * kk, lane), qf[kk], w);
#pragma unroll
            for (int r = 0; r < 16; ++r) O[t][r] = (z[r] + eb * w[r]) * scale;
        }
        __syncthreads();
#pragma unroll
        for (int t = 0; t < 2; ++t) { const int vt = 2 * vh + t;
#pragma unroll
            for (int q = 0; q < 4; ++q) *(LAS f32x4*)(YO + dir * 8448 + j * 132 + 32 * vt + 8 * q + 4 * h5) = (f32x4){O[t][4 * q], O[t][4 * q + 1], O[t][4 * q + 2], O[t][4 * q + 3]}; }
        __syncthreads();
        { const int row = c.tid >> 3, c0 = (c.tid & 7) * 16; float y[16]; float ss = 0.f;
#pragma unroll
          for (int q = 0; q < 4; ++q) { const f32x4 a = *(const LAS f32x4*)(YO + row * 132 + c0 + 4 * q), bb = *(const LAS f32x4*)(YO + 8448 + row * 132 + c0 + 4 * q);
              y[4 * q] = a.x + bb.x; y[4 * q + 1] = a.y + bb.y; y[4 * q + 2] = a.z + bb.z; y[4 * q + 3] = a.w + bb.w; }
#pragma unroll
          for (int q = 0; q < 16; ++q) ss += y[q] * y[q];
          ss += __shfl_xor(ss, 1); ss += __shfl_xor(ss, 2); ss += __shfl_xor(ss, 4);
          const float r = 1.0f / sqrtf(ss * (1.0f / 128.0f) + EPS);
          float g0[8], g1[8];
          unpack8(*(const u32x4*)(P + (size_t)(r0 + row) * PLD + 2048 + h * 128 + c0), g0); unpack8(*(const u32x4*)(P + (size_t)(r0 + row) * PLD + 2048 + h * 128 + c0 + 8), g1);
          float o0[8], o1[8];
#pragma unroll
          for (int q = 0; q < 8; ++q) { o0[q] = y[q] * r * ng[h * 128 + c0 + q] * sigmoidf_(g0[q]); o1[q] = y[8 + q] * r * ng[h * 128 + c0 + 8 + q] * sigmoidf_(g1[q]); }
          *(u32x4*)(Y + (size_t)(r0 + row) * D + h * 128 + c0) = pack8(o0); *(u32x4*)(Y + (size_t)(r0 + row) * D + h * 128 + c0 + 8) = pack8(o1); }
    }
}

DI void phase_gla_scan_naive(const Ctx& c) {
    const bf16* PC = WSP(bf16, WS_BIG + BIG_PC); const float* EX = WSP(float, WS_EXTRA);
    LAS float* qs = (LAS float*)c.lds; LAS float* ks = qs + 16 * 128; LAS float* as = ks + 16 * 128; LAS float* vs = as + 16 * 128; LAS float* lw = vs + 16 * 256;
    const int v = c.tid >> 1, d0 = (c.tid & 1) * 64;
    for (int item = blockIdx.x; item < 64; item += gridDim.x) {
        const int b = item >> 3, h = (item >> 1) & 3, dir = item & 1;
        float* Yo = WSP(float, WS_BIG + (dir ? BIG_YB : BIG_YF));
        const float* w2 = c.in[I_GLW2] + (size_t)dir * 16 * 512 + h * 128; const float* gb = c.in[I_GLGB] + dir * 512 + h * 128;
        float S[64];
#pragma unroll
        for (int d = 0; d < 64; ++d) S[d] = 0.f;
        for (int ch = 0; ch < (CTX + SEQ) / 16; ++ch) {
            __syncthreads();
            if (c.tid < 256) { const int st = c.tid >> 4, r = c.tid & 15, row = scan_row(ch * 16 + st, b, dir); lw[c.tid] = EX[(size_t)row * 32 + dir * 16 + r]; }
            for (int idx = c.tid; idx < 16 * 512; idx += 512) { const int st = idx >> 9, col = idx & 511, row = scan_row(ch * 16 + st, b, dir);
                if (col < 128) qs[st * 128 + col] = bf2f(PC[(size_t)row * 2048 + h * 128 + col]);
                else if (col < 256) ks[st * 128 + col - 128] = bf2f(PC[(size_t)row * 2048 + 512 + h * 128 + col - 128]);
                else vs[st * 256 + col - 256] = bf2f(PC[(size_t)row * 2048 + 1024 + h * 256 + col - 256]); }
            __syncthreads();
            for (int idx = c.tid; idx < 16 * 128; idx += 512) { const int st = idx >> 7, d = idx & 127; float pre = gb[d];
#pragma unroll
                for (int r = 0; r < 16; ++r) pre += lw[st * 16 + r] * w2[r * 512 + d];
                as[idx] = __expf(logsigf_(pre) * (1.0f / 16.0f)); }
            __syncthreads();
            for (int st = 0; st < 16; ++st) {
                const float vv = vs[st * 256 + v]; float part = 0.f;
#pragma unroll
                for (int d = 0; d < 64; ++d) { S[d] = as[st * 128 + d0 + d] * S[d] + ks[st * 128 + d0 + d] * vv; part += qs[st * 128 + d0 + d] * S[d]; }
                part += __shfl_xor(part, 1);
                if ((c.tid & 1) == 0) { const int row = scan_row(ch * 16 + st, b, dir); Yo[(size_t)row * D + h * 256 + v] = part; }
            }
        }
    }
}
DI void phase_headnorm(const Ctx& c, int hd, const float* ng) {
    const float* YF = WSP(float, WS_BIG + BIG_YF); const float* YB = WSP(float, WS_BIG + BIG_YB); const bf16* P = WSP(bf16, WS_P); bf16* Y = WSP(bf16, WS_Y);
    for (int row = c.gw; row < TT; row += c.ngw) {
        const int c0 = 16 * c.lane; float y[16]; float ss = 0.f;
#pragma unroll
        for (int j = 0; j < 4; ++j) { const f32x4 a = *(const f32x4*)(YF + (size_t)row * D + c0 + 4 * j), bb = *(const f32x4*)(YB + (size_t)row * D + c0 + 4 * j);
            y[4 * j] = a.x + bb.x; y[4 * j + 1] = a.y + bb.y; y[4 * j + 2] = a.z + bb.z; y[4 * j + 3] = a.w + bb.w; }
#pragma unroll
        for (int j = 0; j < 16; ++j) ss += y[j] * y[j];
        ss += __shfl_xor(ss, 1); ss += __shfl_xor(ss, 2); ss += __shfl_xor(ss, 4); if (hd == 256) ss += __shfl_xor(ss, 8);
        const float r = 1.0f / sqrtf(ss / (float)hd + EPS);
        float g0[8], g1[8];
        unpack8(*(const u32x4*)(P + (size_t)row * PLD + 2048 + c0), g0); unpack8(*(const u32x4*)(P + (size_t)row * PLD + 2048 + c0 + 8), g1);
        float o[16];
#pragma unroll
        for (int j = 0; j < 16; ++j) { const float gp = j < 8 ? g0[j] : g1[j - 8]; o[j] = y[j] * r * ng[c0 + j] * (hd == 128 ? sigmoidf_(gp) : siluf_(gp)); }
        const float o0[8] = {o[0], o[1], o[2], o[3], o[4], o[5], o[6], o[7]}, o1[8] = {o[8], o[9], o[10], o[11], o[12], o[13], o[14], o[15]};
        *(u32x4*)(Y + (size_t)row * D + c0) = pack8(o0); *(u32x4*)(Y + (size_t)row * D + c0 + 8) = pack8(o1);
    }
}
DI void phase_hyena_conv_naive(const Ctx& c) {
    const bf16* PC = WSP(bf16, WS_BIG + BIG_PC); bf16* Y = WSP(bf16, WS_Y); const float* skip = c.in[I_HYSKIP];
    LAS float* zt = (LAS float*)c.lds;
    LAS float* ft = zt + 4096;
    const int cc = c.tid & 63, tg = c.tid >> 6;
    for (int item = blockIdx.x; item < 4096 + 512; item += gridDim.x) {
        int L, rb, tt, cgi; const float* tab;
        if (item < 4096) { L = SEQ; const int b = item >> 9; tt = (item >> 4) & 31; cgi = item & 15; rb = TC + b * SEQ; tab = WSP(float, WS_HF); }
        else { const int it = item - 4096; L = CTX; const int b = it >> 6; tt = (it >> 4) & 3; cgi = it & 15; rb = b * CTX; tab = WSP(float, WS_HFC); }
        const int t0 = 64 * tt, c0 = 64 * cgi;
        float acc[8];
#pragma unroll
        for (int i = 0; i < 8; ++i) acc[i] = 0.f;
        for (int sb = 0; sb < L / 64; ++sb) {
            const int s0 = 64 * sb;
            __syncthreads();
            for (int idx = c.tid; idx < 4096; idx += 512) { const int sl = idx >> 6, ch = idx & 63; const size_t o = (size_t)(rb + s0 + sl) * PLD + c0 + ch;
                zt[idx] = bf2f(PC[o + 1024]) * bf2f(PC[o + 2048]); }
            for (int idx = c.tid; idx < 64 * 128; idx += 512) { const int ch = idx >> 7, j = idx & 127;
                if (j < 127) ft[j * 65 + ch] = tab[(size_t)(c0 + ch) * (2 * L) + L + (t0 - s0 - 63 + j)]; }
            __syncthreads();
#pragma unroll 1
            for (int g = 0; g < 8; ++g) {
                float w[15], z[8]; const int base = 8 * (tg - g) + 56;
#pragma unroll
                for (int m = 0; m < 15; ++m) w[m] = ft[(base + m) * 65 + cc];
#pragma unroll
                for (int j = 0; j < 8; ++j) z[j] = zt[(8 * g + j) * 64 + cc];
#pragma unroll
                for (int i = 0; i < 8; ++i)
#pragma unroll
                    for (int j = 0; j < 8; ++j) acc[i] += w[i - j + 7] * z[j];
            }
        }
#pragma unroll
        for (int i = 0; i < 8; ++i) { const int row = rb + t0 + 8 * tg + i; const size_t o = (size_t)row * PLD + c0 + cc;
            const float zin = bf2f(PC[o + 1024]) * bf2f(PC[o + 2048]), x0 = bf2f(PC[o]);
            Y[(size_t)row * D + c0 + cc] = f2bf(x0 * (acc[i] + skip[c0 + cc] * zin)); }
    }
}

DI void phase_route(const Ctx& c, int l) {
    LAS float* rw = (LAS float*)c.lds;
    for (int i = c.tid; i < 16 * 1024; i += 512) { const int e = i >> 10, k = i & 1023; rw[i] = c.in[I_RW][k * 16 + e]; }
    __syncthreads();
    const float* MOD = WSP(float, WS_MOD) + (size_t)l * 9 * 6144; const float* g = c.in[I_N2G] + l * D; bf16* H = WSP(bf16, WS_H);
    const float* X = WSP(float, WS_X); const float* XC = WSP(float, WS_XC);
    unsigned* cnt = WSP(unsigned, WS_CTL) + CW_CNT + l * 16; int* TOK = WSP(int, WS_TOK); float* TOKW = WSP(float, WS_TOK + 512 * 1024);
    float rbv[16];
#pragma unroll
    for (int e = 0; e < 16; ++e) rbv[e] = c.in[I_RB][e];
    for (int row = (l == 3 ? TC : 0) + c.gw; row < TT; row += c.ngw) {
        f32x4 v[4]; const int mr = row < TC ? 8 : (row - TC) >> 11;
        load_row(row < TC ? XC + (size_t)row * D : X + (size_t)(row - TC) * D, v, c.lane);
        norm_row(v, g, c.lane); mod_row(v, MOD + mr * 6144 + 3072, MOD + mr * 6144 + 4096, c.lane);
        store_row_bf16(H + (size_t)row * D, v, c.lane);
        float sc[16];
#pragma unroll
        for (int e = 0; e < 16; ++e) { float s = 0.f;
#pragma unroll
            for (int j = 0; j < 4; ++j) { const f32x4 w = *(const LAS f32x4*)(rw + e * 1024 + 256 * j + 4 * c.lane); s += (v[j].x * w.x + v[j].y * w.y) + (v[j].z * w.z + v[j].w * w.w); }
            sc[e] = sigmoidf_(wave_sum(s)); asm volatile("" ::: "memory"); }
        int bg = 0; float bgs = -1e30f;
#pragma unroll
        for (int gq = 0; gq < 4; ++gq) { float m1 = -1e30f, m2 = -1e30f;
#pragma unroll
            for (int j = 0; j < 4; ++j) { const float s = sc[4 * gq + j] + rbv[4 * gq + j]; if (s > m1) { m2 = m1; m1 = s; } else if (s > m2) m2 = s; }
            const float gs = m1 + m2; if (gs > bgs) { bgs = gs; bg = gq; } }
        float s4[4], p4[4];
#pragma unroll
        for (int j = 0; j < 4; ++j) { s4[j] = 0.f; p4[j] = 0.f; }
#pragma unroll
        for (int gq = 0; gq < 4; ++gq)
#pragma unroll
            for (int j = 0; j < 4; ++j) if (bg == gq) { s4[j] = sc[4 * gq + j] + rbv[4 * gq + j]; p4[j] = sc[4 * gq + j]; }
        int i1 = 0; float v1 = s4[0], q1 = p4[0];
#pragma unroll
        for (int j = 1; j < 4; ++j) if (s4[j] > v1) { v1 = s4[j]; i1 = j; q1 = p4[j]; }
        int i2 = -1; float v2 = -1e30f, q2 = 0.f;
#pragma unroll
        for (int j = 0; j < 4; ++j) if (j != i1 && s4[j] > v2) { v2 = s4[j]; i2 = j; q2 = p4[j]; }
        if (c.lane == 0) {
            const int e0 = 4 * bg + i1, e1 = 4 * bg + i2;
            const unsigned p0 = atomicAdd(cnt + e0, 1u), p1 = atomicAdd(cnt + e1, 1u);
            TOK[row * 4 + 0] = e0; TOK[row * 4 + 1] = (int)p0; TOK[row * 4 + 2] = e1; TOK[row * 4 + 3] = (int)p1;
            const float inv = 1.0f / (q1 + q2); TOKW[row * 2] = q1 * inv; TOKW[row * 2 + 1] = q2 * inv;
        }
    }
}
DI void slot_bases(const unsigned* cnt, int lane, int e0, int e1, int& b0, int& b1) {
    const unsigned mine = lane < 16 ? ((cnt[lane] + 255u) & ~255u) : 0u; unsigned pb = 0; b0 = 0; b1 = 0;
#pragma unroll
    for (int e = 0; e < 16; ++e) { const unsigned ce = __shfl(mine, e); if (e == e0) b0 = (int)pb; if (e == e1) b1 = (int)pb; pb += ce; }
}
DI void phase_gather(const Ctx& c, int l) {
    const unsigned* cnt = WSP(unsigned, WS_CTL) + CW_CNT + l * 16; const int* TOK = WSP(int, WS_TOK); int* TOKS = WSP(int, WS_TOK + 768 * 1024);
    const bf16* H = WSP(bf16, WS_H); bf16* HS = WSP(bf16, WS_BIG + BIG_HS);
    for (int row = (l == 3 ? TC : 0) + c.gw; row < TT; row += c.ngw) {
        const int e0 = TOK[row * 4], p0 = TOK[row * 4 + 1], e1 = TOK[row * 4 + 2], p1 = TOK[row * 4 + 3]; int b0, b1;
        slot_bases(cnt, c.lane, e0, e1, b0, b1);
        const int s0 = b0 + p0, s1 = b1 + p1;
        const u32x4 a = *(const u32x4*)(H + (size_t)row * D + 8 * c.lane), bq = *(const u32x4*)(H + (size_t)row * D + 512 + 8 * c.lane);
        *(u32x4*)(HS + (size_t)s0 * D + 8 * c.lane) = a; *(u32x4*)(HS + (size_t)s0 * D + 512 + 8 * c.lane) = bq;
        *(u32x4*)(HS + (size_t)s1 * D + 8 * c.lane) = a; *(u32x4*)(HS + (size_t)s1 * D + 512 + 8 * c.lane) = bq;
        if (c.lane == 0) { TOKS[row * 2] = s0; TOKS[row * 2 + 1] = s1; }
    }
}
DI LAS int* moe_tiles(const Ctx& c, int l) {
    LAS int* tp = (LAS int*)(c.lds + MISC_OFF);
    __syncthreads();
    if (c.tid < 64) {
        const unsigned* cnt = WSP(unsigned, WS_CTL) + CW_CNT + l * 16;
        const int mine = c.lane < 16 ? (int)((cnt[c.lane] + 255u) >> 8) : 0; int p = 0;
        for (int e = 0; e < 16; ++e) { const int ne = __shfl(mine, e); for (int t = c.lane; t < ne; t += 64) tp[1 + p + t] = e; p += ne; }
        if (c.lane == 0) tp[0] = p;
    }
    __syncthreads();
    return tp;
}
DI void phase_combine(const Ctx& c, int l) {
    const float* MOD = WSP(float, WS_MOD) + (size_t)l * 9 * 6144; const int* TOKS = WSP(int, WS_TOK + 768 * 1024); const float* TOKW = WSP(float, WS_TOK + 512 * 1024);
    const bf16* YS = WSP(bf16, WS_BIG + BIG_HS); float* X = WSP(float, WS_X); float* XC = WSP(float, WS_XC); bf16* H = WSP(bf16, WS_H);
    for (int row = (l == 3 ? TC : 0) + c.gw; row < TT; row += c.ngw) {
        const int mr = row < TC ? 8 : (row - TC) >> 11; float* xp = row < TC ? XC + (size_t)row * D : X + (size_t)(row - TC) * D;
        const int s0 = TOKS[row * 2], s1 = TOKS[row * 2 + 1]; const float w0 = TOKW[row * 2], w1 = TOKW[row * 2 + 1];
        f32x4 v[4]; load_row(xp, v, c.lane);
#pragma unroll
        for (int j = 0; j < 4; ++j) {
            const u32x2 a = *(const u32x2*)(YS + (size_t)s0 * D + 256 * j + 4 * c.lane), bq = *(const u32x2*)(YS + (size_t)s1 * D + 256 * j + 4 * c.lane);
            const f32x4 ya = {__uint_as_float(a.x << 16), __uint_as_float(a.x & 0xffff0000u), __uint_as_float(a.y << 16), __uint_as_float(a.y & 0xffff0000u)};
            const f32x4 yb = {__uint_as_float(bq.x << 16), __uint_as_float(bq.x & 0xffff0000u), __uint_as_float(bq.y << 16), __uint_as_float(bq.y & 0xffff0000u)};
            v[j] = v[j] + *(const f32x4*)(MOD + mr * 6144 + 5120 + 256 * j + 4 * c.lane) * (ya * w0 + yb * w1);
            *(f32x4*)(xp + 256 * j + 4 * c.lane) = v[j];
        }
        if (l < 3) {
            const float* MODn = WSP(float, WS_MOD) + (size_t)(l + 1) * 9 * 6144;
            norm_row(v, c.in[I_N1G] + (l + 1) * D, c.lane); mod_row(v, MODn + mr * 6144, MODn + mr * 6144 + 1024, c.lane);
            store_row_bf16(H + (size_t)hrow_of(row, (l + 1) % 3) * D, v, c.lane);
        } else {
            norm_row(v, c.in[I_FING], c.lane);
            float* o = c.out + (size_t)(row - TC) * D;
#pragma unroll
            for (int j = 0; j < 4; ++j) *(f32x4*)(o + 256 * j + 4 * c.lane) = v[j];
        }
    }
}

constexpr int NPHASE = 2 + 11 * DEPTH;
__host__ __device__ inline bool phase_active(int ph) {
    if (ph < 2) return true;
    const int l = (ph - 2) / 11, s = (ph - 2) % 11, kind = l % 3;
    if (s == 0) return l == 0;
    if (s == 4) return kind != 2;
    return true;
}
DI void run_phase(const Ctx& c, int ph) {
    if (ph == 0) { if constexpr (PH_EN(0)) phase_pro0(c); return; }
    if (ph == 1) { if constexpr (PH_EN(1)) phase_pro1(c); return; }
    const int l = (ph - 2) / 11, s = (ph - 2) % 11, kind = l % 3, j = l / 3;
    switch (s) {
    case 0: if constexpr (PH_EN(2)) phase_norm1(c, 0, c.in[I_X], c.in[I_CTX]); break;
    case 1: if constexpr (PH_EN(3)) {
        DenseOrder S; EpiInproj E; E.P = WSP(bf16, WS_P); E.extra = WSP(float, WS_EXTRA); E.bias = nullptr; E.bias_x = nullptr;
        if (kind == 0) { S.init(WSP(bf16, WS_H), WSP(bf16, WS_ML_WIN) + (size_t)j * NINP * 1024, TT, NINP); E.bias_x = c.in[I_MLBG] + j * 32; }
        else if (kind == 1) { S.init(WSP(bf16, WS_H), WSP(bf16, WS_GLA_WIN), TT, NINP); }
        else { S.init(WSP(bf16, WS_H), WSP(bf16, WS_HY_WIN), TT, 3072); E.bias = c.in[I_HYBIN]; }
        gemm_run(c.lds, c.tid, S, E);
    } break;
    case 2: if constexpr (PH_EN(4))
        if (kind == 0) phase_conv(c, 1024, c.in[I_MLCW] + j * 3 * 1024, c.in[I_MLCB] + j * 1024, true, 0.125f);
        else if (kind == 1) phase_conv(c, 2048, c.in[I_GLCW], c.in[I_GLCB], true, 0.08838834764831845f);
        else phase_conv(c, 3072, c.in[I_HYCW], c.in[I_HYCB], false, 1.0f);
        break;
    case 3: if constexpr (PH_EN(5))
        if (kind == 0) { if constexpr (MLSTM_CHUNK) phase_mlstm_state(c); else phase_mlstm_scan_naive(c); }
        else if (kind == 1) phase_gla_scan_naive(c);
        else phase_hyena_conv_naive(c);
        break;
    case 4: if constexpr (PH_EN(6))
        if (kind == 0) { if constexpr (MLSTM_CHUNK) phase_mlstm_out(c, c.in[I_MLNG] + j * 1024); else phase_headnorm(c, 128, c.in[I_MLNG] + j * 1024); }
        else phase_headnorm(c, 256, c.in[I_GLNG]);
        break;
    case 5: if constexpr (PH_EN(7)) {
        DenseOrder S; EpiOutproj E; E.X = WSP(float, WS_X); E.XC = WSP(float, WS_XC); E.mod = WSP(float, WS_MOD) + (size_t)l * 9 * 6144; E.bias = nullptr; E.perm = (kind == 1);
        E.xs_l = (l == 0) ? c.in[I_X] : WSP(float, WS_X); E.xs_c = (l == 0) ? c.in[I_CTX] : WSP(float, WS_XC); E.row_off = (l == 3) ? TC : 0;
        const bf16* W = kind == 0 ? WSP(bf16, WS_ML_WOUT) + (size_t)j * 1024 * 1024 : kind == 1 ? WSP(bf16, WS_GLA_WOUT) : WSP(bf16, WS_HY_WOUT);
        if (kind == 2) E.bias = c.in[I_HYBOUT];
        S.init(WSP(bf16, WS_Y) + (size_t)E.row_off * D, W, TT - E.row_off, 1024);
        gemm_run(c.lds, c.tid, S, E);
    } break;
    case 6: if constexpr (PH_EN(8)) phase_route(c, l); break;
    case 7: if constexpr (PH_EN(9)) phase_gather(c, l); break;
    case 8: if constexpr (PH_EN(10)) {
        MoeOrder S; S.tp = moe_tiles(c, l); S.A = WSP(bf16, WS_BIG + BIG_HS); S.Bt = WSP(bf16, WS_EXP_UP) + (size_t)l * 16 * 2048 * 1024; S.bstride = (size_t)2048 * 1024; S.nsh = 3; S.G = gridDim.x; S.c = blockIdx.x;
        EpiUp E; E.ACT = WSP(bf16, WS_BIG + BIG_ACT);
        gemm_run(c.lds, c.tid, S, E);
    } break;
    case 9: if constexpr (PH_EN(11)) {
        MoeOrder S; S.tp = moe_tiles(c, l); S.A = WSP(bf16, WS_BIG + BIG_ACT); S.Bt = WSP(bf16, WS_EXP_DN) + (size_t)l * 16 * 1024 * 1024; S.bstride = (size_t)1024 * 1024; S.nsh = 2; S.G = gridDim.x; S.c = blockIdx.x;
        EpiDown E; E.YS = WSP(bf16, WS_BIG + BIG_HS);
        gemm_run(c.lds, c.tid, S, E);
    } break;
    case 10: if constexpr (PH_EN(12)) phase_combine(c, l); break;
    }
}

__global__ void __launch_bounds__(512, 2) mega_fwd(Params p) {
    extern __shared__ __attribute__((aligned(16))) unsigned char lds_raw[];
    bool first = true;
    int rep = 0;
    for (int ph = p.ph_lo; ph < p.ph_hi;) {
        if (!phase_active(ph)) { ++ph; continue; }
        if (!first) cg::this_grid().sync();
        first = false;
        int z; asm volatile("s_mov_b32 %0, 0" : "=s"(z));
        Ctx c;
        c.lds = (LAS unsigned char*)lds_raw;
        c.tid = threadIdx.x + z; c.lane = c.tid & 63; c.wave = __builtin_amdgcn_readfirstlane(c.tid >> 6);
        c.gw = blockIdx.x * 8 + c.wave; c.ngw = gridDim.x * 8;
        c.in = p.in + z; c.out = p.out + z; c.ws = p.ws + z;
        run_phase(c, ph);
        if (REP_MASK != 0u && rep == 0 && ph >= 2 && ((REP_MASK >> ((ph - 2) % 11)) & 1u) && ((REP_LAYERS >> ((ph - 2) / 11)) & 1u)) rep = 1; else { rep = 0; ++ph; }
    }
}

extern "C" void kernel_launch(void* const* d_in, const int* in_sizes, int n_in, void* d_out, int out_size, void* d_ws, size_t ws_size, hipStream_t stream) {
    static int grid = 0;
    if (grid == 0) {
        if (n_in != 40 || ws_size < WS_END || out_size != TL * D) { fprintf(stderr, "kernel_launch: unexpected shapes (n_in %d, ws %zu, out %d)\n", n_in, ws_size, out_size); grid = -1; return; }
        int dev = 0, cus = 0, per_cu = 0;
        hipGetDevice(&dev); hipDeviceGetAttribute(&cus, hipDeviceAttributeMultiprocessorCount, dev);
        if (hipFuncSetAttribute((const void*)mega_fwd, hipFuncAttributeMaxDynamicSharedMemorySize, LDS_BYTES) != hipSuccess) { fprintf(stderr, "kernel_launch: hipFuncSetAttribute failed\n"); grid = -1; return; }
        if (hipOccupancyMaxActiveBlocksPerMultiprocessor(&per_cu, (const void*)mega_fwd, 512, LDS_BYTES) != hipSuccess || per_cu < 1) { fprintf(stderr, "kernel_launch: occupancy query says %d\n", per_cu); per_cu = 1; }
        (void)hipGetLastError();
        grid = cus;
        fprintf(stderr, "kernel_launch: grid %d (cus %d, per_cu %d)\n", grid, cus, per_cu);
    }
    if (grid < 0) return;
    hipMemsetAsync((char*)d_ws + WS_CTL, 0, 1 * MiB, stream);
    Params p{};
    for (int i = 0; i < 40; ++i) p.in[i] = (const float*)d_in[i];
    p.out = (float*)d_out; p.ws = (unsigned char*)d_ws;
#if N_LAUNCH_PER_PHASE
    for (int ph = 0; ph < NPHASE; ++ph) {
        if (!phase_active(ph)) continue;
        p.ph_lo = ph; p.ph_hi = ph + 1; void* args[] = {&p};
        hipError_t e = hipLaunchCooperativeKernel((const void*)mega_fwd, dim3(grid), dim3(512), args, LDS_BYTES, stream);
        if (e != hipSuccess) { fprintf(stderr, "launch failed: %s\n", hipGetErrorString(e)); break; }
    }
#else
    p.ph_lo = 0; p.ph_hi = NPHASE; void* args[] = {&p};
    hipError_t e = hipLaunchCooperativeKernel((const void*)mega_fwd, dim3(grid), dim3(512), args, LDS_BYTES, stream);
    if (e != hipSuccess) fprintf(stderr, "cooperative launch failed: %s (grid %d)\n", hipGetErrorString(e), grid);
#endif
}
```

```cpp
#include <hip/hip_runtime.h>
#include <hip/hip_cooperative_groups.h>
#include <cstdio>
#include <cstdint>
namespace cg = cooperative_groups;

#define LAS __attribute__((address_space(3)))
#define DI __device__ __forceinline__
typedef unsigned short bf16;
typedef float f32x4 __attribute__((ext_vector_type(4)));
typedef float f32x2 __attribute__((ext_vector_type(2)));
typedef unsigned u32x4 __attribute__((ext_vector_type(4)));
typedef unsigned u32x2 __attribute__((ext_vector_type(2)));
typedef short bf16x8 __attribute__((ext_vector_type(8)));

#ifndef FAST_GEMM
#define FAST_GEMM 1
#endif
#ifndef MLSTM_CHUNK
#define MLSTM_CHUNK 1
#endif
#ifndef GLA_CHUNK
#define GLA_CHUNK 1
#endif
#ifndef PH_MASK
#define PH_MASK 0xFFFFFFFFu
#endif
#define PH_EN(b) ((PH_MASK >> (b)) & 1u)
#ifndef REP_LAYERS
#define REP_LAYERS 0xFu
#endif
#ifndef REP_MASK
#define REP_MASK 0u
#endif
#ifndef N_LAUNCH_PER_PHASE
#define N_LAUNCH_PER_PHASE 0
#endif

constexpr int D = 1024, NB = 8, SEQ = 2048, CTX = 256, DEPTH = 4;
constexpr int TC = NB * CTX, TL = NB * SEQ, TT = TC + TL;
constexpr int NEXP = 16;
constexpr int PLD = 3072;
constexpr int NINP = 3328;
constexpr float EPS = 1e-6f;
constexpr int MAXSLOT = 40960;

constexpr size_t MiB = 1u << 20;
constexpr size_t WS_CTL = 0;
constexpr size_t WS_MOD = 1 * MiB;
constexpr size_t WS_HM = 2 * MiB;
constexpr size_t WS_TOK = 3 * MiB;
constexpr size_t WS_HF = 4 * MiB;
constexpr size_t WS_HFC = 20 * MiB;
constexpr size_t WS_ML_WIN = 32 * MiB;
constexpr size_t WS_ML_WOUT = 45 * MiB;
constexpr size_t WS_GLA_WIN = 49 * MiB;
constexpr size_t WS_GLA_WOUT = 56 * MiB;
constexpr size_t WS_HY_WIN = 58 * MiB;
constexpr size_t WS_HY_WOUT = 64 * MiB;
constexpr size_t WS_EXP_UP = 66 * MiB;
constexpr size_t WS_EXP_DN = 322 * MiB;
constexpr size_t WS_X = 450 * MiB;
constexpr size_t WS_XC = 514 * MiB;
constexpr size_t WS_H = 522 * MiB;
constexpr size_t WS_P = 558 * MiB;
constexpr size_t WS_EXTRA = 667 * MiB;
constexpr size_t WS_Y = 670 * MiB;
constexpr size_t WS_BIG = 706 * MiB;
constexpr size_t WS_END = 962 * MiB;
constexpr size_t BIG_HS = 0;
constexpr size_t BIG_ACT = 80 * MiB;
constexpr size_t BIG_PC = 0;
constexpr size_t BIG_YF = 108 * MiB;
constexpr size_t BIG_YB = 180 * MiB;

constexpr size_t BIG_MCT = 108 * MiB;
constexpr size_t BIG_MN = 180 * MiB;

constexpr size_t BIG_GST = 108 * MiB;

constexpr int CW_CNT = 1024;

constexpr int LDS_BYTES = 147456;
constexpr int MISC_OFF = 131072;

struct Params {
    const float* in[40];
    float* out;
    unsigned char* ws;
    int ph_lo, ph_hi;
};
enum { I_X = 0, I_C, I_CTX, I_CCTX, I_ADAW, I_ADAB, I_N1G, I_N2G, I_FING, I_MLWIN, I_MLBG, I_MLCW, I_MLCB, I_MLNG, I_MLWOUT,
       I_GLWIN, I_GLCW, I_GLCB, I_GLW2, I_GLGB, I_GLNG, I_GLWOUT, I_HYWIN, I_HYBIN, I_HYCW, I_HYCB, I_HYFW1, I_HYFB1, I_HYFWM, I_HYFBM,
       I_HYFWO, I_HYFREQ, I_HYSKIP, I_HYWOUT, I_HYBOUT, I_RW, I_RB, I_EW1, I_EW3, I_EW2 };

DI float bf2f(bf16 v) { return __uint_as_float(((unsigned)v) << 16); }
typedef __bf16 b16x2_t __attribute__((ext_vector_type(2)));
DI unsigned cvt_pk_bf16(float lo, float hi) { const f32x2 v = {lo, hi}; const b16x2_t r = __builtin_convertvector(v, b16x2_t); return __builtin_bit_cast(unsigned, r); }
DI bf16 f2bf(float f) { return (bf16)(cvt_pk_bf16(f, 0.f) & 0xffffu); }
DI float sigmoidf_(float x) { return 1.0f / (1.0f + __expf(-x)); }
DI float siluf_(float x) { return x / (1.0f + __expf(-x)); }
DI float logsigf_(float x) { return fminf(x, 0.f) - log1pf(__expf(-fabsf(x))); }
DI float wave_sum(float v) {
#pragma unroll
    for (int o = 1; o < 64; o <<= 1) v += __shfl_xor(v, o);
    return v;
}
DI void unpack8(const u32x4 w, float (&v)[8]) {
    v[0] = __uint_as_float(w.x << 16); v[1] = __uint_as_float(w.x & 0xffff0000u);
    v[2] = __uint_as_float(w.y << 16); v[3] = __uint_as_float(w.y & 0xffff0000u);
    v[4] = __uint_as_float(w.z << 16); v[5] = __uint_as_float(w.z & 0xffff0000u);
    v[6] = __uint_as_float(w.w << 16); v[7] = __uint_as_float(w.w & 0xffff0000u);
}
DI u32x4 pack8(const float (&v)[8]) { u32x4 w; w.x = cvt_pk_bf16(v[0], v[1]); w.y = cvt_pk_bf16(v[2], v[3]); w.z = cvt_pk_bf16(v[4], v[5]); w.w = cvt_pk_bf16(v[6], v[7]); return w; }
DI void seq_bounds(int row, int& lo, int& hi) {
    if (row < TC) { lo = row & ~(CTX - 1); hi = lo + CTX - 1; } else { lo = TC + ((row - TC) & ~(SEQ - 1)); hi = lo + SEQ - 1; }
}
DI int perm_fwd(int s) { return (s & 63) * 32 + (s >> 6); }
DI int perm_inv(int sp) { return (sp & 31) * 64 + (sp >> 5); }

namespace pg8 {
constexpr int BM = 256, BK = 64, HALF = 128, HTB = HALF * BK * 2, STAGE_BYTES = 8 * HTB, NXCD = 8, WGM = 8;
__host__ __device__ __forceinline__ int lds_byte(int r, int c) { const int st = (r >> 4) * 2 + (c >> 5), rr = r & 15, cc = c & 31, ob = rr * 64 + cc * 2; return st * 1024 + (ob ^ (((ob >> 9) & 1) << 5)); }
__host__ __device__ __forceinline__ void stage_rc(int b, int& R, int& C) { const int st = b / 1024, sb = b % 1024, swz = sb ^ (((sb >> 9) & 1) << 5); R = (st >> 1) * 16 + swz / 64; C = (st & 1) * 32 + (swz % 64) / 2; }
__host__ __device__ __forceinline__ int perm32(int rho) { const int n = rho >> 4, i = rho & 15; return 8 * (i >> 2) + 4 * n + (i & 3); }
}
struct Unit { int pm, pn, e; };

struct DenseOrder {
    const bf16* A; const bf16* Bt; int nM, nN, nwg, G, c;
    DI void init(const bf16* A_, const bf16* Bt_, int M, int N) { A = A_; Bt = Bt_; nM = M / 256; nN = N / 256; nwg = nM * nN; G = gridDim.x; c = blockIdx.x; }
    DI bool next(int i, Unit& u) const {
        const int L = i * G + c; if (L >= nwg) return false;
        int wgid = L; { const int q = nwg / 8, r = nwg % 8, xcd = wgid % 8, off = wgid / 8; wgid = (xcd < r ? xcd * (q + 1) : r * (q + 1) + (xcd - r) * q) + off; }
        const int nig = 8 * nN, gid = wgid / nig, fm = gid * 8, gsz = (nM - fm) < 8 ? (nM - fm) : 8;
        u.pm = fm + ((wgid % nig) % gsz); u.pn = (wgid % nig) / gsz; u.e = 0; return true;
    }
    DI const bf16* aptr(const Unit& u) const { return A + (size_t)u.pm * 256 * 1024; }
    DI const bf16* bptr(const Unit& u) const { return Bt + (size_t)u.pn * 256 * 1024; }
};
struct MoeOrder {
    const bf16* A; const bf16* Bt; size_t bstride; int nsh, G, c; const LAS int* tp;
    DI bool next(int i, Unit& u) const {
        const int L = i * G + c; const int ntile = __builtin_amdgcn_readfirstlane(tp[0]); if (L >= (ntile << nsh)) return false;
        const int rt = L >> nsh; u.pm = rt; u.pn = L & ((1 << nsh) - 1); u.e = __builtin_amdgcn_readfirstlane(tp[1 + rt]); return true;
    }
    DI const bf16* aptr(const Unit& u) const { return A + (size_t)u.pm * 256 * 1024; }
    DI const bf16* bptr(const Unit& u) const { return Bt + (size_t)u.e * bstride + (size_t)u.pn * 256 * 1024; }
};

struct EpiInproj {
    static constexpr bool PAIR = false;
    bf16* P; float* extra; const float* bias; const float* bias_x;
    DI void row8(const Unit& u, int r, int c, const float (&v)[8]) const {
        const int row = u.pm * 256 + r, col = u.pn * 256 + c;
        if (col < PLD) {
            float w[8];
#pragma unroll
            for (int j = 0; j < 8; ++j) w[j] = v[j] + (bias ? bias[col + j] : 0.f);
            *(u32x4*)(P + (size_t)row * PLD + col) = pack8(w);
        } else if (col < PLD + 32) {
            float* o = extra + (size_t)row * 32 + (col - PLD);
#pragma unroll
            for (int j = 0; j < 8; ++j) o[j] = v[j] + (bias_x ? bias_x[col - PLD + j] : 0.f);
        }
    }
};
struct EpiOutproj {
    static constexpr bool PAIR = false;
    const float* xs_l; const float* xs_c; float* X; float* XC; const float* mod; const float* bias; int row_off; int perm;
    DI void row8(const Unit& u, int r, int c, const float (&v)[8]) const {
        const int hrow = u.pm * 256 + r + row_off, col = u.pn * 256 + c;
        const float* src; float* dst; int mr;
        if (hrow < TC) { mr = 8; src = xs_c + (size_t)hrow * D + col; dst = XC + (size_t)hrow * D + col; }
        else { const int rr = hrow - TC, b = rr >> 11, sp = rr & (SEQ - 1), s = perm ? perm_inv(sp) : sp; mr = b;
               src = xs_l + ((size_t)b * SEQ + s) * D + col; dst = X + ((size_t)b * SEQ + s) * D + col; }
        const float* g1 = mod + mr * 6144 + 2048 + col;
        const f32x4 a0 = *(const f32x4*)src, a1 = *(const f32x4*)(src + 4), g0 = *(const f32x4*)g1, gg1 = *(const f32x4*)(g1 + 4);
        f32x4 b0 = {0.f, 0.f, 0.f, 0.f}, b1 = b0;
        if (bias) { b0 = *(const f32x4*)(bias + col); b1 = *(const f32x4*)(bias + col + 4); }
        f32x4 o0, o1;
        o0 = a0 + g0 * ((f32x4){v[0], v[1], v[2], v[3]} + b0); o1 = a1 + gg1 * ((f32x4){v[4], v[5], v[6], v[7]} + b1);
        *(f32x4*)dst = o0; *(f32x4*)(dst + 4) = o1;
    }
};
struct EpiUp {
    static constexpr bool PAIR = true;
    bf16* ACT;
    DI void row8p(const Unit& u, int r, int c, const float (&g)[8], const float (&up)[8]) const {
        float w[8];
#pragma unroll
        for (int j = 0; j < 8; ++j) w[j] = siluf_(g[j]) * up[j];
        *(u32x4*)(ACT + ((size_t)u.pm * 256 + r) * 1024 + u.pn * 128 + c) = pack8(w);
    }
};
struct EpiDown {
    static constexpr bool PAIR = false;
    bf16* YS;
    DI void row8(const Unit& u, int r, int c, const float (&v)[8]) const { *(u32x4*)(YS + ((size_t)u.pm * 256 + r) * 1024 + u.pn * 256 + c) = pack8(v); }
};

template <class Sched, class Epi>
DI void gemm_fast(LAS unsigned char* lds, int tid, const Sched& S, const Epi& E) {
    using namespace pg8;
    constexpr int K = 1024, nt = K / BK;
    const int wid = __builtin_amdgcn_readfirstlane(tid >> 6), lane = tid & 63, wr = wid >> 2, wc = wid & 3, fr = lane & 15, fq = lane >> 4;
    unsigned voffA[2], voffB[2];
#pragma unroll
    for (int i = 0; i < 2; ++i) { int R, C; stage_rc(tid * 16 + i * 8192, R, C); const int Rb = (R & ~31) + perm32(R & 31);
        voffA[i] = (unsigned)(R * K + C) * 2u; voffB[i] = (unsigned)(Rb * K + C) * 2u; }
    const size_t kstep = (size_t)(BK * 2);
    const size_t hstep = (size_t)HALF * K * 2;
    const unsigned ldsw = (unsigned)wid * 1024u;
    const int aoff = lds_byte(wr * 64 + fr, fq * 8), boff = lds_byte(wc * 32 + fr, fq * 8);
#define PG8_SA(b, h) (((b) * 2 + (h)) * HTB)
#define PG8_SB(b, h) ((4 + (b) * 2 + (h)) * HTB)
#define PG8_STAGE(bufoff, gbase, voff) do { _Pragma("unroll") for (int _i = 0; _i < 2; ++_i) \
        __builtin_amdgcn_global_load_lds((const unsigned*)((const char*)(gbase) + (voff)[_i]), (LAS unsigned*)(lds + (bufoff) + ldsw + _i * 8192), 16, 0, 0); } while (0)
#define PG8_LDA(dst, b, h) do { _Pragma("unroll") for (int m = 0; m < 4; ++m) _Pragma("unroll") for (int k = 0; k < 2; ++k) dst[m][k] = *(const LAS bf16x8*)(lds + PG8_SA(b, h) + aoff + m * 2048 + k * 1024); } while (0)
#define PG8_LDB(dst, b, h) do { _Pragma("unroll") for (int n = 0; n < 2; ++n) _Pragma("unroll") for (int k = 0; k < 2; ++k) dst[n][k] = *(const LAS bf16x8*)(lds + PG8_SB(b, h) + boff + n * 2048 + k * 1024); } while (0)
#define PG8_MMA(ai, bj, At, Bt) do { __builtin_amdgcn_s_setprio(1); _Pragma("unroll") for (int m = 0; m < 4; ++m) _Pragma("unroll") for (int n = 0; n < 2; ++n) _Pragma("unroll") for (int k = 0; k < 2; ++k) \
        acc[ai][bj][m][n] = __builtin_amdgcn_mfma_f32_16x16x32_bf16(Bt[n][k], At[m][k], acc[ai][bj][m][n], 0, 0, 0); __builtin_amdgcn_s_setprio(0); } while (0)
#define PG8_WAIT_V(n) asm volatile("s_waitcnt vmcnt(" #n ")" ::: "memory")
#define PG8_WAIT_L(n) asm volatile("s_waitcnt lgkmcnt(" #n ")" ::: "memory")
#define PG8_BAR __builtin_amdgcn_s_barrier()
#define PG8_SCHED __builtin_amdgcn_sched_barrier(0)
    Unit cur, nxt; int ui = 0;
    if (!S.next(0, cur)) return;
    f32x4 acc[2][2][4][2];
#pragma unroll
    for (int a = 0; a < 2; ++a)
#pragma unroll
        for (int b = 0; b < 2; ++b)
#pragma unroll
            for (int m = 0; m < 4; ++m)
#pragma unroll
                for (int n = 0; n < 2; ++n) acc[a][b][m][n] = (f32x4){0.f, 0.f, 0.f, 0.f};
    bf16x8 At[4][2], B0[2][2], B1[2][2];
    const char* cA = (const char*)S.aptr(cur); const char* cB = (const char*)S.bptr(cur);
    PG8_STAGE(PG8_SB(0, 0), cB, voffB); PG8_STAGE(PG8_SA(0, 0), cA, voffA); PG8_STAGE(PG8_SB(0, 1), cB + hstep, voffB); PG8_STAGE(PG8_SA(0, 1), cA + hstep, voffA);
    if (wr == 1) PG8_BAR;
    PG8_WAIT_V(4); PG8_BAR;
    PG8_STAGE(PG8_SB(1, 0), cB + kstep, voffB); PG8_STAGE(PG8_SA(1, 0), cA + kstep, voffA); PG8_STAGE(PG8_SB(1, 1), cB + hstep + kstep, voffB);
    PG8_WAIT_V(6); PG8_BAR;
    for (;;) {
        const bool has_next = S.next(ui + 1, nxt);
        const char* nA = has_next ? (const char*)S.aptr(nxt) : cA; const char* nB = has_next ? (const char*)S.bptr(nxt) : cB;
        for (int t = 0; t < nt; t += 2) {
            const bool last = (t == nt - 2);
            const char* a1 = cA + (size_t)(t + 1) * kstep;
            const char* a2 = last ? nA : cA + (size_t)(t + 2) * kstep; const char* b2 = last ? nB : cB + (size_t)(t + 2) * kstep;
            const char* a3 = a2 + kstep; const char* b3 = b2 + kstep;
            PG8_LDB(B0, 0, 0); PG8_SCHED; PG8_LDA(At, 0, 0); PG8_STAGE(PG8_SA(1, 1), a1 + hstep, voffA);
            PG8_WAIT_L(8); PG8_BAR; PG8_WAIT_L(0); PG8_MMA(0, 0, At, B0); PG8_BAR; PG8_SCHED;
            PG8_LDB(B1, 0, 1); PG8_STAGE(PG8_SB(0, 0), b2, voffB);
            PG8_BAR; PG8_WAIT_L(0); PG8_MMA(0, 1, At, B1); PG8_BAR;
            PG8_LDA(At, 0, 1); PG8_STAGE(PG8_SA(0, 0), a2, voffA);
            PG8_BAR; PG8_WAIT_L(0); PG8_MMA(1, 0, At, B0); PG8_BAR; PG8_SCHED;
            PG8_STAGE(PG8_SB(0, 1), b2 + hstep, voffB);
            PG8_WAIT_V(6); PG8_BAR; PG8_MMA(1, 1, At, B1); PG8_BAR;
            PG8_LDB(B0, 1, 0); PG8_SCHED; PG8_LDA(At, 1, 0); PG8_STAGE(PG8_SA(0, 1), a2 + hstep, voffA);
            PG8_WAIT_L(8); PG8_BAR; PG8_WAIT_L(0); PG8_MMA(0, 0, At, B0); PG8_BAR; PG8_SCHED;
            PG8_LDB(B1, 1, 1); PG8_STAGE(PG8_SB(1, 0), b3, voffB);
            PG8_BAR; PG8_WAIT_L(0); PG8_MMA(0, 1, At, B1); PG8_BAR;
            PG8_LDA(At, 1, 1); PG8_STAGE(PG8_SA(1, 0), a3, voffA);
            PG8_BAR; PG8_WAIT_L(0); PG8_MMA(1, 0, At, B0); PG8_BAR; PG8_SCHED;
            PG8_STAGE(PG8_SB(1, 1), b3 + hstep, voffB);
            PG8_WAIT_V(6); PG8_BAR; PG8_MMA(1, 1, At, B1); PG8_BAR;
        }
#pragma unroll
        for (int ai = 0; ai < 2; ++ai)
#pragma unroll
            for (int m = 0; m < 4; ++m) {
                const int r = ai * HALF + wr * 64 + m * 16 + fr;
                if constexpr (Epi::PAIR) {
                    const float g[8] = {acc[ai][0][m][0][0], acc[ai][0][m][0][1], acc[ai][0][m][0][2], acc[ai][0][m][0][3], acc[ai][0][m][1][0], acc[ai][0][m][1][1], acc[ai][0][m][1][2], acc[ai][0][m][1][3]};
                    const float up[8] = {acc[ai][1][m][0][0], acc[ai][1][m][0][1], acc[ai][1][m][0][2], acc[ai][1][m][0][3], acc[ai][1][m][1][0], acc[ai][1][m][1][1], acc[ai][1][m][1][2], acc[ai][1][m][1][3]};
                    E.row8p(cur, r, wc * 32 + 8 * fq, g, up);
                } else {
#pragma unroll
                    for (int bj = 0; bj < 2; ++bj) {
                        const float v[8] = {acc[ai][bj][m][0][0], acc[ai][bj][m][0][1], acc[ai][bj][m][0][2], acc[ai][bj][m][0][3], acc[ai][bj][m][1][0], acc[ai][bj][m][1][1], acc[ai][bj][m][1][2], acc[ai][bj][m][1][3]};
                        E.row8(cur, r, bj * HALF + wc * 32 + 8 * fq, v);
                    }
                }
            }
        if (!has_next) break;
#pragma unroll
        for (int a = 0; a < 2; ++a)
#pragma unroll
            for (int b = 0; b < 2; ++b)
#pragma unroll
                for (int m = 0; m < 4; ++m)
#pragma unroll
                    for (int n = 0; n < 2; ++n) acc[a][b][m][n] = (f32x4){0.f, 0.f, 0.f, 0.f};
        cur = nxt; cA = nA; cB = nB; ++ui;
    }
    PG8_WAIT_V(0);
    if (wr == 0) PG8_BAR;
    PG8_BAR;
#undef PG8_SA
#undef PG8_SB
#undef PG8_STAGE
#undef PG8_LDA
#undef PG8_LDB
#undef PG8_MMA
#undef PG8_WAIT_V
#undef PG8_WAIT_L
#undef PG8_BAR
#undef PG8_SCHED
}

template <class Sched, class Epi>
DI void gemm_naive(LAS unsigned char* lds, int tid, const Sched& S, const Epi& E) {
    LAS float* As = (LAS float*)lds;
    LAS float* Bs = As + 32 * 132;
    LAS float* Bu = Bs + 32 * 132;
    const int ty = tid >> 4, tx = tid & 15, lr = tid >> 2, kq = tid & 3;
    Unit u;
    for (int i = 0; S.next(i, u); ++i) {
        const bf16* A = S.aptr(u); const bf16* B = S.bptr(u);
        for (int sm = 0; sm < 2; ++sm)
            for (int sn = 0; sn < (Epi::PAIR ? 1 : 2); ++sn) {
                float acc[4][8], accu[4][8];
#pragma unroll
                for (int a = 0; a < 4; ++a)
#pragma unroll
                    for (int b = 0; b < 8; ++b) { acc[a][b] = 0.f; accu[a][b] = 0.f; }
                for (int k0 = 0; k0 < 1024; k0 += 32) {
                    __syncthreads();
                    { float w[8]; unpack8(*(const u32x4*)(A + (size_t)(128 * sm + lr) * 1024 + k0 + 8 * kq), w);
#pragma unroll
                      for (int j = 0; j < 8; ++j) As[(8 * kq + j) * 132 + lr] = w[j];
                      unpack8(*(const u32x4*)(B + (size_t)(128 * sn + lr) * 1024 + k0 + 8 * kq), w);
#pragma unroll
                      for (int j = 0; j < 8; ++j) Bs[(8 * kq + j) * 132 + lr] = w[j];
                      if (Epi::PAIR) { unpack8(*(const u32x4*)(B + (size_t)(128 + lr) * 1024 + k0 + 8 * kq), w);
#pragma unroll
                          for (int j = 0; j < 8; ++j) Bu[(8 * kq + j) * 132 + lr] = w[j]; } }
                    __syncthreads();
#pragma unroll 4
                    for (int k = 0; k < 32; ++k) {
                        const f32x4 a4 = *(const LAS f32x4*)(As + k * 132 + 4 * ty);
                        const f32x4 b0 = *(const LAS f32x4*)(Bs + k * 132 + 8 * tx), b1 = *(const LAS f32x4*)(Bs + k * 132 + 8 * tx + 4);
#pragma unroll
                        for (int a = 0; a < 4; ++a) {
#pragma unroll
                            for (int b = 0; b < 4; ++b) { acc[a][b] += a4[a] * b0[b]; acc[a][4 + b] += a4[a] * b1[b]; } }
                        if (Epi::PAIR) {
                            const f32x4 c0 = *(const LAS f32x4*)(Bu + k * 132 + 8 * tx), c1 = *(const LAS f32x4*)(Bu + k * 132 + 8 * tx + 4);
#pragma unroll
                            for (int a = 0; a < 4; ++a) {
#pragma unroll
                                for (int b = 0; b < 4; ++b) { accu[a][b] += a4[a] * c0[b]; accu[a][4 + b] += a4[a] * c1[b]; } }
                        }
                    }
                }
#pragma unroll
                for (int a = 0; a < 4; ++a) {
                    if constexpr (Epi::PAIR) E.row8p(u, 128 * sm + 4 * ty + a, 8 * tx, acc[a], accu[a]);
                    else E.row8(u, 128 * sm + 4 * ty + a, 128 * sn + 8 * tx, acc[a]);
                }
            }
    }
    __syncthreads();
}
template <class Sched, class Epi>
DI void gemm_run(LAS unsigned char* lds, int tid, const Sched& S, const Epi& E) {
#if FAST_GEMM
    gemm_fast(lds, tid, S, E);
#else
    gemm_naive(lds, tid, S, E);
#endif
}

struct Ctx {
    LAS unsigned char* lds;
    int tid, lane, wave, gw, ngw;
    const float* const* in;
    float* out;
    unsigned char* ws;
};
#define WSP(T, off) ((T*)(c.ws + (off)))

DI void transpose_item(const float* W, int N, bf16* WT, int k0, int n0, int dst_row0, LAS float* scr, int lane) {
#pragma unroll 8
    for (int i = 0; i < 32; ++i) { const int kk = 2 * i + (lane >> 5); scr[kk * 33 + (lane & 31)] = W[(size_t)(k0 + kk) * N + n0 + (lane & 31)]; }
    asm volatile("s_waitcnt lgkmcnt(0)" ::: "memory");
    const int cc = lane & 7;
#pragma unroll
    for (int j = 0; j < 4; ++j) { const int n = (lane >> 3) + 8 * j; const LAS float* s = scr + (8 * cc) * 33 + n;
        u32x4 o; o.x = cvt_pk_bf16(s[0 * 33], s[1 * 33]); o.y = cvt_pk_bf16(s[2 * 33], s[3 * 33]); o.z = cvt_pk_bf16(s[4 * 33], s[5 * 33]); o.w = cvt_pk_bf16(s[6 * 33], s[7 * 33]);
        *(u32x4*)(WT + (size_t)(dst_row0 + n) * 1024 + k0 + 8 * cc) = o; }
    asm volatile("s_waitcnt lgkmcnt(0)" ::: "memory");
}
DI void dense_transpose(const Ctx& c, const float* W, int N, bf16* WT, LAS float* scr) {
    const int nblk = N / 32, nitems = 16 * nblk;
    for (int it = c.gw; it < nitems; it += c.ngw) { const int kb = it / nblk, nb = it % nblk; transpose_item(W, N, WT, 64 * kb, 32 * nb, 32 * nb, scr, c.lane); }
}
DI void phase_pro0(const Ctx& c) {
    LAS float* scr = (LAS float*)(c.lds + c.wave * 8704);
    for (int j = 0; j < 2; ++j) {
        dense_transpose(c, c.in[I_MLWIN] + (size_t)j * 1024 * 3104, 3104, WSP(bf16, WS_ML_WIN) + (size_t)j * NINP * 1024, scr);
        dense_transpose(c, c.in[I_MLWOUT] + (size_t)j * 1024 * 1024, 1024, WSP(bf16, WS_ML_WOUT) + (size_t)j * 1024 * 1024, scr);
    }
    dense_transpose(c, c.in[I_GLWIN], 3104, WSP(bf16, WS_GLA_WIN), scr);
    dense_transpose(c, c.in[I_GLWOUT], 1024, WSP(bf16, WS_GLA_WOUT), scr);
    dense_transpose(c, c.in[I_HYWIN], 3072, WSP(bf16, WS_HY_WIN), scr);
    dense_transpose(c, c.in[I_HYWOUT], 1024, WSP(bf16, WS_HY_WOUT), scr);
    for (int it = c.gw * 64 + c.lane; it < 3 * 28672; it += c.ngw * 64) {
        const int m = it / 28672, r = it % 28672; bf16* base = (m < 2) ? WSP(bf16, WS_ML_WIN) + (size_t)m * NINP * 1024 : WSP(bf16, WS_GLA_WIN);
        *(u32x4*)(base + (size_t)3104 * 1024 + (size_t)r * 8) = (u32x4){0u, 0u, 0u, 0u};
    }
    for (int it = c.gw; it < 64 * 3 * 512; it += c.ngw) {
        const int le = it / 1536, r0 = it % 1536, which = r0 / 512, r = r0 % 512, kb = r / 32, nb = r % 32;
        if (which < 2) {
            const float* W = c.in[which == 0 ? I_EW1 : I_EW3] + (size_t)le * 1024 * 1024;
            const int n0 = 32 * nb, drow = 256 * (n0 >> 7) + (n0 & 127) + (which ? 128 : 0);
            transpose_item(W, 1024, WSP(bf16, WS_EXP_UP) + (size_t)le * 2048 * 1024, 64 * kb, n0, drow, scr, c.lane);
        } else {
            transpose_item(c.in[I_EW2] + (size_t)le * 1024 * 1024, 1024, WSP(bf16, WS_EXP_DN) + (size_t)le * 1024 * 1024, 64 * kb, 32 * nb, 32 * nb, scr, c.lane);
        }
    }
    {
        const float* w1 = c.in[I_HYFW1]; const float* b1 = c.in[I_HYFB1]; const float* wm = c.in[I_HYFWM]; const float* bm = c.in[I_HYFBM]; const float* fr = c.in[I_HYFREQ];
        float* HM = WSP(float, WS_HM);
        for (int row = c.gw; row < 2304; row += c.ngw) {
            const int L = row < 2048 ? 2048 : 256, t = row < 2048 ? row : row - 2048, f = c.lane;
            float feat = 0.f;
            if (f == 0) feat = (float)t / (float)(L - 1);
            else if (f <= 32) { const int b = (f - 1) & 15; const float band = 1e-4f + (float)b * ((15.0f - 1e-4f) / 15.0f);
                const float ang = ((float)(2.0 * 3.14159265358979323846 / (double)L) * (float)t) * band; feat = (f <= 16) ? cosf(ang) : -sinf(ang); }
            float a = b1[f];
            for (int e = 0; e < 33; ++e) a += __shfl(feat, e) * w1[e * 64 + f];
            float h = sinf(fr[f] * a);
            for (int m = 0; m < 2; ++m) {
                float a2 = bm[m * 64 + f];
                for (int g = 0; g < 64; ++g) a2 += __shfl(h, g) * wm[m * 4096 + g * 64 + f];
                h = sinf(fr[f] * a2);
            }
            HM[row * 64 + f] = h;
        }
    }
    __syncthreads();
    {
        LAS float* sv = (LAS float*)c.lds;
        LAS float* red = sv + 9 * 1024;
        for (int i = c.tid; i < 9 * 1024; i += 512) { const float x = (i < 8192) ? c.in[I_C][i] : c.in[I_CCTX][i - 8192]; sv[i] = siluf_(x); }
        __syncthreads();
        float* MOD = WSP(float, WS_MOD);
        const int col = c.tid & 63, kg = c.tid >> 6;
        for (int item = blockIdx.x; item < 4 * 96; item += gridDim.x) {
            const int l = item / 96, j0 = 64 * (item % 96);
            const float* w = c.in[I_ADAW] + (size_t)l * 1024 * 6144 + j0 + col;
            float acc[9];
#pragma unroll
            for (int r = 0; r < 9; ++r) acc[r] = 0.f;
            for (int k = kg * 128; k < kg * 128 + 128; ++k) { const float wv = w[(size_t)k * 6144];
#pragma unroll
                for (int r = 0; r < 9; ++r) acc[r] += sv[r * 1024 + k] * wv; }
#pragma unroll
            for (int r = 0; r < 9; ++r) red[(kg * 9 + r) * 64 + col] = acc[r];
            __syncthreads();
            for (int o = c.tid; o < 9 * 64; o += 512) { const int r = o >> 6, cc = o & 63; float s = c.in[I_ADAB][l * 6144 + j0 + cc];
#pragma unroll
                for (int g = 0; g < 8; ++g) s += red[(g * 9 + r) * 64 + cc];
                MOD[(l * 9 + r) * 6144 + j0 + cc] = s; }
            __syncthreads();
        }
    }
}

DI void phase_pro1(const Ctx& c) {
    LAS float* wo = (LAS float*)c.lds;
    LAS float* red = wo + 2048;
    const float* HM = WSP(float, WS_HM);
    const int ch = c.tid & 15, tg = c.tid >> 4;
    for (int item = blockIdx.x; item < 128; item += gridDim.x) {
        const int lsel = item >> 6, c0 = 16 * (item & 63), L = lsel ? 256 : 2048;
        const float* hm = lsel ? HM + 2048 * 64 : HM; float* tab = lsel ? WSP(float, WS_HFC) : WSP(float, WS_HF);
        __syncthreads();
        for (int i = c.tid; i < 2048; i += 512) { const int side = i >> 10, f = (i >> 4) & 63, cc = i & 15; wo[i] = c.in[I_HYFWO][f * 2048 + side * 1024 + c0 + cc]; }
        __syncthreads();
        const int cg_ = c0 + ch;
        const float da = -4.605170185988091f / 1.5f, db = -4.605170185988091f / 0.3f;
        const float delta = fabsf(da + (float)cg_ * ((db - da) / 1023.0f));
        float* trow = tab + (size_t)cg_ * (2 * L);
        float part = 0.f;
        for (int t = tg; t < L; t += 32) {
            float af = 0.f, ab = 0.f;
            for (int f = 0; f < 64; ++f) { const float h = hm[t * 64 + f]; af += h * wo[f * 16 + ch]; ab += h * wo[1024 + f * 16 + ch]; }
            const float dec = expf(-((float)t / (float)(L - 1)) * delta); af *= dec; ab *= dec;
            trow[L + t] = af; part += fabsf(af);
            if (t >= 1) { trow[L - t] = ab; part += fabsf(ab); }
        }
        red[tg * 16 + ch] = part;
        __syncthreads();
        float l1 = 0.f;
        for (int g = 0; g < 32; ++g) l1 += red[g * 16 + ch];
        const float inv = 1.0f / l1;
        for (int t = tg; t < L; t += 32) { trow[L + t] *= inv; if (t >= 1) trow[L - t] *= inv; }
        if (tg == 0) trow[0] = 0.f;
    }
}

DI void load_row(const float* src, f32x4 (&v)[4], int lane) {
#pragma unroll
    for (int j = 0; j < 4; ++j) v[j] = *(const f32x4*)(src + 256 * j + 4 * lane);
}
DI void norm_row(f32x4 (&v)[4], const float* g, int lane) {
    float s = 0.f;
#pragma unroll
    for (int j = 0; j < 4; ++j) s += (v[j].x * v[j].x + v[j].y * v[j].y) + (v[j].z * v[j].z + v[j].w * v[j].w);
    s = wave_sum(s);
    const float r = 1.0f / sqrtf(s * (1.0f / 1024.0f) + EPS);
#pragma unroll
    for (int j = 0; j < 4; ++j) v[j] = v[j] * r * *(const f32x4*)(g + 256 * j + 4 * lane);
}
DI void mod_row(f32x4 (&v)[4], const float* sh, const float* sc, int lane) {
#pragma unroll
    for (int j = 0; j < 4; ++j) v[j] = v[j] * (*(const f32x4*)(sc + 256 * j + 4 * lane) + 1.0f) + *(const f32x4*)(sh + 256 * j + 4 * lane);
}
DI void store_row_bf16(bf16* dst, const f32x4 (&v)[4], int lane) {
#pragma unroll
    for (int j = 0; j < 4; ++j) { u32x2 w; w.x = cvt_pk_bf16(v[j].x, v[j].y); w.y = cvt_pk_bf16(v[j].z, v[j].w); *(u32x2*)(dst + 256 * j + 4 * lane) = w; }
}
DI int hrow_of(int srow, int kind) {
    if (srow < TC || kind != 1) return srow;
    const int rr = srow - TC, b = rr >> 11, s = rr & (SEQ - 1); return TC + b * SEQ + perm_fwd(s);
}
DI void phase_norm1(const Ctx& c, int l, const float* xl, const float* xc) {
    const float* MOD = WSP(float, WS_MOD) + (size_t)l * 9 * 6144; const float* g = c.in[I_N1G] + l * D; bf16* H = WSP(bf16, WS_H);
    for (int row = c.gw; row < TT; row += c.ngw) {
        f32x4 v[4]; const int mr = row < TC ? 8 : (row - TC) >> 11;
        load_row(row < TC ? xc + (size_t)row * D : xl + (size_t)(row - TC) * D, v, c.lane);
        norm_row(v, g, c.lane); mod_row(v, MOD + mr * 6144, MOD + mr * 6144 + 1024, c.lane);
        store_row_bf16(H + (size_t)hrow_of(row, l % 3) * D, v, c.lane);
    }
}

DI void phase_conv(const Ctx& c, int ncols, const float* cw, const float* cb, bool act, float qs) {
    const bf16* P = WSP(bf16, WS_P); bf16* PC = WSP(bf16, WS_BIG + BIG_PC);
    const int ng = ncols / 8; const long total = (long)TT * ng;
    for (long idx = (long)blockIdx.x * 512 + c.tid; idx < total; idx += (long)gridDim.x * 512) {
        const int row = (int)(idx / ng), col = (int)(idx % ng) * 8; int lo, hi; seq_bounds(row, lo, hi);
        float x0[8], xm[8], xp[8];
        unpack8(*(const u32x4*)(P + (size_t)row * PLD + col), x0);
        if (row > lo) unpack8(*(const u32x4*)(P + (size_t)(row - 1) * PLD + col), xm); else {
#pragma unroll
            for (int j = 0; j < 8; ++j) xm[j] = 0.f; }
        if (row < hi) unpack8(*(const u32x4*)(P + (size_t)(row + 1) * PLD + col), xp); else {
#pragma unroll
            for (int j = 0; j < 8; ++j) xp[j] = 0.f; }
        float o[8];
#pragma unroll
        for (int j = 0; j < 8; ++j) { float v = cw[col + j] * xm[j] + cw[ncols + col + j] * x0[j] + cw[2 * ncols + col + j] * xp[j] + cb[col + j];
            if (act) v = siluf_(v); if (col < 512) v *= qs; o[j] = v; }
        *(u32x4*)(PC + (size_t)row * ncols + col) = pack8(o);
    }
}

DI int scan_row(int step, int b, int dir) {
    if (step < CTX) return b * CTX + (dir ? CTX - 1 - step : step);
    const int s = step - CTX; return TC + b * SEQ + (dir ? SEQ - 1 - s : s);
}
DI void phase_mlstm_scan_naive(const Ctx& c) {
    const bf16* P = WSP(bf16, WS_P); const bf16* PC = WSP(bf16, WS_BIG + BIG_PC); const float* EX = WSP(float, WS_EXTRA);
    LAS float* qs = (LAS float*)c.lds; LAS float* ks = qs + 32 * 64; LAS float* vs = ks + 32 * 64; LAS float* gs = vs + 32 * 128;
    const int v = c.tid >> 2, d0 = (c.tid & 3) * 16;
    for (int item = blockIdx.x; item < 128; item += gridDim.x) {
        const int b = item >> 4, h = (item >> 1) & 7, dir = item & 1;
        float* Yo = WSP(float, WS_BIG + (dir ? BIG_YB : BIG_YF));
        float C[16], n[16];
#pragma unroll
        for (int d = 0; d < 16; ++d) { C[d] = 0.f; n[d] = 0.f; }
        for (int ch = 0; ch < (CTX + SEQ) / 32; ++ch) {
            __syncthreads();
            for (int idx = c.tid; idx < 32 * 256; idx += 512) { const int st = idx >> 8, col = idx & 255, row = scan_row(ch * 32 + st, b, dir);
                if (col < 64) qs[st * 64 + col] = bf2f(PC[(size_t)row * 1024 + h * 64 + col]);
                else if (col < 128) ks[st * 64 + col - 64] = bf2f(PC[(size_t)row * 1024 + 512 + h * 64 + col - 64]);
                else vs[st * 128 + col - 128] = bf2f(P[(size_t)row * PLD + 1024 + h * 128 + col - 128]); }
            if (c.tid < 32) { const int row = scan_row(ch * 32 + c.tid, b, dir); gs[c.tid * 2] = sigmoidf_(EX[(size_t)row * 32 + dir * 16 + 8 + h]); gs[c.tid * 2 + 1] = __expf(EX[(size_t)row * 32 + dir * 16 + h]); }
            __syncthreads();
            for (int st = 0; st < 32; ++st) {
                const float f = gs[st * 2], ei = gs[st * 2 + 1], vv = vs[st * 128 + v] * ei;
                float part = 0.f, dpart = 0.f;
#pragma unroll
                for (int d = 0; d < 16; ++d) { const float kd = ks[st * 64 + d0 + d], qd = qs[st * 64 + d0 + d];
                    C[d] = f * C[d] + kd * vv; part += qd * C[d]; n[d] = f * n[d] + ei * kd; dpart += qd * n[d]; }
                part += __shfl_xor(part, 1); part += __shfl_xor(part, 2); dpart += __shfl_xor(dpart, 1); dpart += __shfl_xor(dpart, 2);
                if ((c.tid & 3) == 0) { const int row = scan_row(ch * 32 + st, b, dir); Yo[(size_t)row * D + h * 128 + v] = part / fmaxf(fabsf(dpart), 1.0f); }
            }
        }
    }
}
typedef short s16x4 __attribute__((ext_vector_type(4)));
typedef float f32x16 __attribute__((ext_vector_type(16)));
#define MFMA32(a, b, c) __builtin_amdgcn_mfma_f32_32x32x16_bf16((a), (b), (c), 0, 0, 0)
DI int crow(int reg, int h) { return (reg & 3) + 8 * (reg >> 2) + 4 * h; }
DI s16x4 ds_tr(const LAS unsigned char* p) { return __builtin_amdgcn_ds_read_tr16_b64_v4i16((LAS s16x4*)p); }
DI bf16x8 cat8(s16x4 lo, s16x4 hi) { return __builtin_shufflevector(lo, hi, 0, 1, 2, 3, 4, 5, 6, 7); }
DI bf16x8 tr_frag(const LAS unsigned char* img, int pitch, int k0, int n0, int lane) {
    const int h = lane >> 5, g16 = (lane >> 4) & 1, i = lane & 15;
    const LAS unsigned char* p = img + (k0 + 8 * h + (i >> 2)) * pitch + (n0 + 16 * g16 + 4 * (i & 3)) * 2;
    return cat8(ds_tr(p), ds_tr(p + 4 * pitch));
}
DI bf16x8 tr_frag_perm(const LAS unsigned char* img, int pitch, int k0, int n0, int lane) {
    const int h = lane >> 5, g16 = (lane >> 4) & 1, i = lane & 15;
    const LAS unsigned char* p = img + (k0 + 4 * h + (i >> 2)) * pitch + (n0 + 16 * g16 + 4 * (i & 3)) * 2;
    return cat8(ds_tr(p), ds_tr(p + 8 * pitch));
}
DI bf16x8 row_frag(const LAS unsigned char* img, int pitch, int row0, int k0, int lane) { return *(const LAS bf16x8*)(img + (row0 + (lane & 31)) * pitch + (k0 + 8 * (lane >> 5)) * 2); }
DI bf16x8 pack_acc(const f32x16& x, int step) {
    u32x4 p; const int o = 8 * step;
    p.x = cvt_pk_bf16(x[o], x[o + 1]); p.y = cvt_pk_bf16(x[o + 2], x[o + 3]); p.z = cvt_pk_bf16(x[o + 4], x[o + 5]); p.w = cvt_pk_bf16(x[o + 6], x[o + 7]);
    return __builtin_bit_cast(bf16x8, p);
}
DI f32x16 zero16() { f32x16 z;
#pragma unroll
    for (int i = 0; i < 16; ++i) z[i] = 0.f; return z; }
DI float wave_incl_prefix(float x, int lane) {
#pragma unroll
    for (int o = 1; o < 64; o <<= 1) { const float t = __shfl_up(x, o); if (lane >= o) x += t; }
    return x;
}
DI float wave_incl_suffix(float x, int lane) {
#pragma unroll
    for (int o = 1; o < 64; o <<= 1) { const float t = __shfl_down(x, o); if (lane + o < 64) x += t; }
    return x;
}
DI int chunk_row0(int p, int b, int dir) {
    if (p < 4) return b * CTX + 64 * (dir ? 3 - p : p);
    return TC + b * SEQ + 64 * (dir ? 35 - p : p - 4);
}

DI void phase_mlstm_state(const Ctx& c) {
    const bf16* P = WSP(bf16, WS_P); const bf16* PC = WSP(bf16, WS_BIG + BIG_PC); const float* EX = WSP(float, WS_EXTRA);
    bf16* MCT = WSP(bf16, WS_BIG + BIG_MCT); float* MN = WSP(float, WS_BIG + BIG_MN);
    LAS float* gi = (LAS float*)c.lds; LAS float* ga = gi + 2304; LAS float* wv = ga + 2304; LAS float* dec = wv + 64;
    LAS unsigned char* Kw = c.lds + 20480; LAS unsigned char* Vs = Kw + 64 * 144;
    const int lane = c.lane, wave = c.wave, h5 = lane >> 5, l31 = lane & 31;
    for (int item = blockIdx.x; item < 256; item += gridDim.x) {
        const int b = item >> 5, h = (item >> 2) & 7, dir = (item >> 1) & 1, dvh = item & 1, seq = (b * 8 + h) * 2 + dir;
        __syncthreads();
        for (int idx = c.tid; idx < 2304; idx += 512) { const int row = chunk_row0(idx >> 6, b, dir) + (idx & 63);
            gi[idx] = EX[(size_t)row * 32 + dir * 16 + h]; ga[idx] = logsigf_(EX[(size_t)row * 32 + dir * 16 + 8 + h]); }
        f32x16 acc = zero16(); float nst = 0.f;
        const int dt = wave & 1, vt = (wave >> 1) & 1;
        const int srow = c.tid >> 3, spc = c.tid & 7;
        u32x4 kreg, vreg;
        { const int r0 = chunk_row0(0, b, dir);
          kreg = *(const u32x4*)(PC + (size_t)(r0 + srow) * 1024 + 512 + h * 64 + 8 * spc);
          vreg = *(const u32x4*)(P + (size_t)(r0 + srow) * PLD + 1024 + h * 128 + dvh * 64 + 8 * spc); }
        __syncthreads();
        for (int p = 0; p < 36; ++p) {
            if (wave < 4) {
                bf16* dst = MCT + ((size_t)seq * 36 + p) * 8192 + (size_t)(dvh * 64 + 32 * vt + l31) * 64 + 32 * dt + 4 * h5;
#pragma unroll
                for (int q = 0; q < 4; ++q) { u32x2 w; w.x = cvt_pk_bf16(acc[4 * q], acc[4 * q + 1]); w.y = cvt_pk_bf16(acc[4 * q + 2], acc[4 * q + 3]); *(u32x2*)(dst + 8 * q) = w; }
            } else if (wave == 4) { if (dvh == 0) MN[((size_t)seq * 36 + p) * 64 + lane] = nst; }
            else if (wave == 7) {
                const float a = ga[p * 64 + lane]; const float bj = dir ? wave_incl_suffix(a, lane) : wave_incl_prefix(a, lane);
                const float tot = __shfl(bj, dir ? 0 : 63);
                wv[lane] = __expf(tot - bj + gi[p * 64 + lane]); if (lane == 0) dec[0] = __expf(tot);
            }
            __syncthreads();
            { float kk[8]; unpack8(kreg, kk); const float w = wv[srow];
#pragma unroll
              for (int j = 0; j < 8; ++j) kk[j] *= w;
              *(LAS u32x4*)(Kw + srow * 144 + spc * 16) = pack8(kk); *(LAS u32x4*)(Vs + srow * 144 + spc * 16) = vreg; }
            if (p + 1 < 36) { const int r0 = chunk_row0(p + 1, b, dir);
                kreg = *(const u32x4*)(PC + (size_t)(r0 + srow) * 1024 + 512 + h * 64 + 8 * spc);
                vreg = *(const u32x4*)(P + (size_t)(r0 + srow) * PLD + 1024 + h * 128 + dvh * 64 + 8 * spc); }
            const float d = dec[0];
            __syncthreads();
            if (wave < 4) {
#pragma unroll
                for (int i = 0; i < 16; ++i) acc[i] *= d;
#pragma unroll
                for (int kk = 0; kk < 4; ++kk) acc = MFMA32(tr_frag(Kw, 144, 16 * kk, 32 * dt, lane), tr_frag(Vs, 144, 16 * kk, 32 * vt, lane), acc);
            } else if (wave == 4) {
                float s = 0.f;
                for (int r = 0; r < 64; ++r) s += bf2f(*(const LAS bf16*)(Kw + r * 144 + lane * 2));
                nst = d * nst + s;
            }
        }
    }
}

DI void phase_mlstm_out(const Ctx& c, const float* ng) {
    const bf16* P = WSP(bf16, WS_P); const bf16* PC = WSP(bf16, WS_BIG + BIG_PC); const float* EX = WSP(float, WS_EXTRA);
    const bf16* MCT = WSP(bf16, WS_BIG + BIG_MCT); const float* MN = WSP(float, WS_BIG + BIG_MN); bf16* Y = WSP(bf16, WS_Y);
    LAS unsigned char* Qs = c.lds; LAS unsigned char* Ks = Qs + 9216; LAS unsigned char* Vs = Ks + 9216;
    LAS unsigned char* CT0 = Vs + 17408;
    LAS float* gt = (LAS float*)(c.lds + MISC_OFF + 1024);
    LAS float* YO = (LAS float*)c.lds;
    const int lane = c.lane, wave = c.wave, h5 = lane >> 5, l31 = lane & 31;
    const int dir = wave >> 2, jt = (wave >> 1) & 1, vh = wave & 1;
    for (int item = blockIdx.x; item < 2304; item += gridDim.x) {
        const int b = item / 288, h = (item / 36) & 7, cc = item % 36;
        const int r0 = cc < 4 ? b * CTX + 64 * cc : TC + b * SEQ + 64 * (cc - 4);
        const int pf = cc, pb = cc < 4 ? 3 - cc : 39 - cc;
        __syncthreads();
        { const int srow = c.tid >> 3, spc = c.tid & 7;
          *(LAS u32x4*)(Qs + srow * 144 + spc * 16) = *(const u32x4*)(PC + (size_t)(r0 + srow) * 1024 + h * 64 + 8 * spc);
          *(LAS u32x4*)(Ks + srow * 144 + spc * 16) = *(const u32x4*)(PC + (size_t)(r0 + srow) * 1024 + 512 + h * 64 + 8 * spc);
#pragma unroll
          for (int i = 0; i < 2; ++i) *(LAS u32x4*)(Vs + srow * 272 + (spc + 8 * i) * 16) = *(const u32x4*)(P + (size_t)(r0 + srow) * PLD + 1024 + h * 128 + 8 * (spc + 8 * i));
#pragma unroll
          for (int i = 0; i < 4; ++i) { const int pc = c.tid + 512 * i, d2 = pc >> 10, rr = (pc >> 3) & 127, sp = pc & 7;
              const size_t so = (((size_t)((b * 8 + h) * 2 + d2)) * 36 + (d2 ? pb : pf)) * 8192;
              *(LAS u32x4*)(CT0 + d2 * 18432 + rr * 144 + sp * 16) = *(const u32x4*)(MCT + so + rr * 64 + 8 * sp); }
          if (wave < 2) { const int d2 = wave; const int row = r0 + lane;
              const float a = logsigf_(EX[(size_t)row * 32 + d2 * 16 + 8 + h]), ig = EX[(size_t)row * 32 + d2 * 16 + h];
              const float bj = d2 ? wave_incl_suffix(a, lane) : wave_incl_prefix(a, lane);
              gt[d2 * 192 + lane] = bj; gt[d2 * 192 + 64 + lane] = ig - bj;
              gt[d2 * 192 + 128 + lane] = MN[(((size_t)((b * 8 + h) * 2 + d2)) * 36 + (d2 ? pb : pf)) * 64 + lane]; } }
        __syncthreads();
        const LAS float* g = gt + dir * 192; const LAS unsigned char* CT = CT0 + dir * 18432;
        const int j = 32 * jt + l31; const float bjj = g[j];
        bf16x8 qf[4];
#pragma unroll
        for (int kk = 0; kk < 4; ++kk) qf[kk] = row_frag(Qs, 144, 32 * jt, 16 * kk, lane);
        float qn = 0.f;
#pragma unroll
        for (int kk = 0; kk < 4; ++kk) { float qv[8]; unpack8(__builtin_bit_cast(u32x4, qf[kk]), qv);
#pragma unroll
            for (int e = 0; e < 8; ++e) qn += qv[e] * g[128 + 16 * kk + 8 * h5 + e]; }
        qn += __shfl_xor(qn, 32);
        f32x16 X[2]; float den = 0.f;
#pragma unroll
        for (int st = 0; st < 2; ++st) {
            X[st] = zero16();
            const bool live = dir ? (st >= jt) : (st <= jt);
            if (live) {
#pragma unroll
                for (int kk = 0; kk < 4; ++kk) X[st] = MFMA32(row_frag(Ks, 144, 32 * st, 16 * kk, lane), qf[kk], X[st]);
#pragma unroll
                for (int r = 0; r < 16; ++r) { const int s = 32 * st + crow(r, h5); const bool ok = dir ? (s >= j) : (s <= j);
                    const float w = ok ? __expf(bjj + g[64 + s]) : 0.f; X[st][r] *= w; den += X[st][r]; }
            }
        }
        den += __shfl_xor(den, 32);
        const float eb = __expf(bjj); den += eb * qn;
        const float scale = 1.0f / fmaxf(fabsf(den), 1.0f);
        f32x16 O[2];
#pragma unroll
        for (int t = 0; t < 2; ++t) {
            const int vt = 2 * vh + t; f32x16 z = zero16(), w = zero16();
#pragma unroll
            for (int st = 0; st < 2; ++st) { const bool live = dir ? (st >= jt) : (st <= jt);
                if (live) {
#pragma unroll
                    for (int step = 0; step < 2; ++step) z = MFMA32(tr_frag_perm(Vs, 272, 32 * st + 16 * step, 32 * vt, lane), pack_acc(X[st], step), z); } }
#pragma unroll
            for (int kk = 0; kk < 4; ++kk) w = MFMA32(row_frag(CT, 144, 32 * vt, 16 * kk, lane), qf[kk], w);
#pragma unroll
            for (int r = 0; r < 16; ++r) O[t][r] = (z[r] + eb * w[r]) * scale;
        }
        __syncthreads();
#pragma unroll
        for (int t = 0; t < 2; ++t) { const int vt = 2 * vh + t;
#pragma unroll
            for (int q = 0; q < 4; ++q) *(LAS f32x4*)(YO + dir * 8448 + j * 132 + 32 * vt + 8 * q + 4 * h5) = (f32x4){O[t][4 * q], O[t][4 * q + 1], O[t][4 * q + 2], O[t][4 * q + 3]}; }
        __syncthreads();
        { const int row = c.tid >> 3, c0 = (c.tid & 7) * 16; float y[16]; float ss = 0.f;
#pragma unroll
          for (int q = 0; q < 4; ++q) { const f32x4 a = *(const LAS f32x4*)(YO + row * 132 + c0 + 4 * q), bb = *(const LAS f32x4*)(YO + 8448 + row * 132 + c0 + 4 * q);
              y[4 * q] = a.x + bb.x; y[4 * q + 1] = a.y + bb.y; y[4 * q + 2] = a.z + bb.z; y[4 * q + 3] = a.w + bb.w; }
#pragma unroll
          for (int q = 0; q < 16; ++q) ss += y[q] * y[q];
          ss += __shfl_xor(ss, 1); ss += __shfl_xor(ss, 2); ss += __shfl_xor(ss, 4);
          const float r = 1.0f / sqrtf(ss * (1.0f / 128.0f) + EPS);
          float g0[8], g1[8];
          unpack8(*(const u32x4*)(P + (size_t)(r0 + row) * PLD + 2048 + h * 128 + c0), g0); unpack8(*(const u32x4*)(P + (size_t)(r0 + row) * PLD + 2048 + h * 128 + c0 + 8), g1);
          float o0[8], o1[8];
#pragma unroll
          for (int q = 0; q < 8; ++q) { o0[q] = y[q] * r * ng[h * 128 + c0 + q] * sigmoidf_(g0[q]); o1[q] = y[8 + q] * r * ng[h * 128 + c0 + 8 + q] * sigmoidf_(g1[q]); }
          *(u32x4*)(Y + (size_t)(r0 + row) * D + h * 128 + c0) = pack8(o0); *(u32x4*)(Y + (size_t)(r0 + row) * D + h * 128 + c0 + 8) = pack8(o1); }
    }
}

DI void gla_lg(const Ctx& c, const f32x4 (&low)[4], const LAS float* w2s, const LAS float* gbs, LAS float* lgs) {
    const int s = c.tid >> 3, d0 = 16 * (c.tid & 7);
    float pre[16];
#pragma unroll
    for (int e = 0; e < 16; ++e) pre[e] = gbs[d0 + e];
#pragma unroll
    for (int r = 0; r < 16; ++r) { const float lv = low[r >> 2][r & 3];
#pragma unroll
        for (int q = 0; q < 4; ++q) { const f32x4 w = *(const LAS f32x4*)(w2s + r * 128 + d0 + 4 * q); pre[4 * q] += lv * w.x; pre[4 * q + 1] += lv * w.y; pre[4 * q + 2] += lv * w.z; pre[4 * q + 3] += lv * w.w; } }
#pragma unroll
    for (int q = 0; q < 4; ++q) *(LAS f32x4*)(lgs + s * 128 + d0 + 4 * q) = (f32x4){logsigf_(pre[4 * q]) * 0.0625f, logsigf_(pre[4 * q + 1]) * 0.0625f, logsigf_(pre[4 * q + 2]) * 0.0625f, logsigf_(pre[4 * q + 3]) * 0.0625f};
}
DI void gla_scan(const Ctx& c, int dir, LAS float* lgs, LAS float* tot) {
    if (c.tid < 128) { float run = 0.f;
        if (dir == 0) { for (int s = 0; s < 64; ++s) { run += lgs[s * 128 + c.tid]; lgs[s * 128 + c.tid] = run; } }
        else { for (int s = 63; s >= 0; --s) { run += lgs[s * 128 + c.tid]; lgs[s * 128 + c.tid] = run; } }
        tot[c.tid] = run; }
}
DI void phase_gla_state(const Ctx& c) {
    const bf16* PC = WSP(bf16, WS_BIG + BIG_PC); const float* EX = WSP(float, WS_EXTRA); bf16* GST = WSP(bf16, WS_BIG + BIG_GST);
    LAS float* w2s = (LAS float*)c.lds; LAS float* gbs = w2s + 2048; LAS float* tot = gbs + 128; LAS float* lgs = tot + 128;
    LAS unsigned char* Kd = c.lds + 45056; LAS unsigned char* Vs = Kd + 64 * 272;
    const int lane = c.lane, wave = c.wave, h5 = lane >> 5, l31 = lane & 31, dkt = wave & 3, dvt = wave >> 2;
    const int srow = c.tid >> 3, dg = c.tid & 7;
    for (int item = blockIdx.x; item < 256; item += gridDim.x) {
        const int b = item >> 5, h = (item >> 3) & 3, dir = (item >> 2) & 1, dvq = item & 3, seq = (b * 4 + h) * 2 + dir;
        __syncthreads();
        for (int i = c.tid; i < 2048; i += 512) w2s[i] = c.in[I_GLW2][(size_t)dir * 8192 + (i >> 7) * 512 + h * 128 + (i & 127)];
        if (c.tid < 128) gbs[c.tid] = c.in[I_GLGB][dir * 512 + h * 128 + c.tid];
        f32x16 acc = zero16();
        u32x4 kreg[2], vreg; f32x4 low[4];
        { const int row = chunk_row0(0, b, dir) + srow;
          kreg[0] = *(const u32x4*)(PC + (size_t)row * 2048 + 512 + h * 128 + 16 * dg); kreg[1] = *(const u32x4*)(PC + (size_t)row * 2048 + 512 + h * 128 + 16 * dg + 8);
          vreg = *(const u32x4*)(PC + (size_t)row * 2048 + 1024 + h * 256 + dvq * 64 + 8 * dg);
#pragma unroll
          for (int q = 0; q < 4; ++q) low[q] = *(const f32x4*)(EX + (size_t)row * 32 + dir * 16 + 4 * q); }
        __syncthreads();
        for (int p = 0; p < 36; ++p) {
            { bf16* dst = GST + ((size_t)seq * 36 + p) * 32768 + (size_t)(dvq * 64 + 32 * dvt + l31) * 128 + 32 * dkt + 4 * h5;
#pragma unroll
              for (int q = 0; q < 4; ++q) { u32x2 w; w.x = cvt_pk_bf16(acc[4 * q], acc[4 * q + 1]); w.y = cvt_pk_bf16(acc[4 * q + 2], acc[4 * q + 3]); *(u32x2*)(dst + 8 * q) = w; } }
            gla_lg(c, low, w2s, gbs, lgs);
            __syncthreads();
            gla_scan(c, dir, lgs, tot);
            __syncthreads();
            { float kk[16]; { float t8[8]; unpack8(kreg[0], t8);
#pragma unroll
                for (int e = 0; e < 8; ++e) kk[e] = t8[e]; unpack8(kreg[1], t8);
#pragma unroll
                for (int e = 0; e < 8; ++e) kk[8 + e] = t8[e]; }
#pragma unroll
              for (int e = 0; e < 16; ++e) kk[e] *= __expf(tot[16 * dg + e] - lgs[srow * 128 + 16 * dg + e]);
              const float k0[8] = {kk[0], kk[1], kk[2], kk[3], kk[4], kk[5], kk[6], kk[7]}, k1[8] = {kk[8], kk[9], kk[10], kk[11], kk[12], kk[13], kk[14], kk[15]};
              *(LAS u32x4*)(Kd + srow * 272 + dg * 32) = pack8(k0); *(LAS u32x4*)(Kd + srow * 272 + dg * 32 + 16) = pack8(k1);
              *(LAS u32x4*)(Vs + srow * 144 + dg * 16) = vreg; }
            if (p + 1 < 36) { const int row = chunk_row0(p + 1, b, dir) + srow;
                kreg[0] = *(const u32x4*)(PC + (size_t)row * 2048 + 512 + h * 128 + 16 * dg); kreg[1] = *(const u32x4*)(PC + (size_t)row * 2048 + 512 + h * 128 + 16 * dg + 8);
                vreg = *(const u32x4*)(PC + (size_t)row * 2048 + 1024 + h * 256 + dvq * 64 + 8 * dg);
#pragma unroll
                for (int q = 0; q < 4; ++q) low[q] = *(const f32x4*)(EX + (size_t)row * 32 + dir * 16 + 4 * q); }
            float dm[16];
#pragma unroll
            for (int r = 0; r < 16; ++r) dm[r] = __expf(tot[32 * dkt + crow(r, h5)]);
            __syncthreads();
#pragma unroll
            for (int r = 0; r < 16; ++r) acc[r] *= dm[r];
#pragma unroll
            for (int kk = 0; kk < 4; ++kk) acc = MFMA32(tr_frag(Kd, 272, 16 * kk, 32 * dkt, lane), tr_frag(Vs, 144, 16 * kk, 32 * dvt, lane), acc);
        }
    }
}
DI void phase_gla_out(const Ctx& c, const float* ng) {
    const bf16* P = WSP(bf16, WS_P); const bf16* PC = WSP(bf16, WS_BIG + BIG_PC); const float* EX = WSP(float, WS_EXTRA);
    const bf16* GST = WSP(bf16, WS_BIG + BIG_GST); bf16* Y = WSP(bf16, WS_Y);
    LAS unsigned char* Qt = c.lds; LAS unsigned char* Kt = Qt + 17408; LAS unsigned char* Vs = Kt + 17408; LAS unsigned char* STs = Vs + 33792;
    LAS float* lgs = (LAS float*)c.lds;
    LAS float* YO = (LAS float*)STs;
    LAS float* w2s = (LAS float*)(c.lds + 138240); LAS float* gbs = w2s + 2048; LAS float* tot = gbs + 128;
    const int lane = c.lane, wave = c.wave, h5 = lane >> 5, l31 = lane & 31;
    const int srow = c.tid >> 3, dg = c.tid & 7;
    for (int item = blockIdx.x; item < 1152; item += gridDim.x) {
        const int b = item / 144, h = (item / 36) & 3, cc = item % 36;
        const int r0 = cc < 4 ? b * CTX + 64 * cc : TC + b * SEQ + 64 * (cc - 4);
        __syncthreads();
#pragma unroll
        for (int i = 0; i < 4; ++i) { const int pc = dg + 8 * i; *(LAS u32x4*)(Vs + srow * 528 + pc * 16) = *(const u32x4*)(PC + (size_t)(r0 + srow) * 2048 + 1024 + h * 256 + 8 * pc); }
        f32x16 O[2]; O[0] = zero16(); O[1] = zero16();
        for (int dir = 0; dir < 2; ++dir) {
            const int pslot = dir ? (cc < 4 ? 3 - cc : 39 - cc) : cc;
            __syncthreads();
            for (int i = c.tid; i < 2048; i += 512) w2s[i] = c.in[I_GLW2][(size_t)dir * 8192 + (i >> 7) * 512 + h * 128 + (i & 127)];
            if (c.tid < 128) gbs[c.tid] = c.in[I_GLGB][dir * 512 + h * 128 + c.tid];
            { const bf16* src = GST + ((size_t)((b * 4 + h) * 2 + dir) * 36 + pslot) * 32768;
#pragma unroll
              for (int i = 0; i < 8; ++i) { const int pc = c.tid + 512 * i, rr = pc >> 4, sp = pc & 15; *(LAS u32x4*)(STs + rr * 272 + sp * 16) = *(const u32x4*)(src + rr * 128 + 8 * sp); } }
            f32x4 low[4];
#pragma unroll
            for (int q = 0; q < 4; ++q) low[q] = *(const f32x4*)(EX + (size_t)(r0 + srow) * 32 + dir * 16 + 4 * q);
            __syncthreads();
            gla_lg(c, low, w2s, gbs, lgs);
            __syncthreads();
            gla_scan(c, dir, lgs, tot);
            __syncthreads();
            float bb[16];
#pragma unroll
            for (int e = 0; e < 16; ++e) bb[e] = lgs[srow * 128 + 16 * dg + e];
            __syncthreads();
            { float qq[16], kk[16]; float t8[8];
              unpack8(*(const u32x4*)(PC + (size_t)(r0 + srow) * 2048 + h * 128 + 16 * dg), t8);
#pragma unroll
              for (int e = 0; e < 8; ++e) qq[e] = t8[e];
              unpack8(*(const u32x4*)(PC + (size_t)(r0 + srow) * 2048 + h * 128 + 16 * dg + 8), t8);
#pragma unroll
              for (int e = 0; e < 8; ++e) qq[8 + e] = t8[e];
              unpack8(*(const u32x4*)(PC + (size_t)(r0 + srow) * 2048 + 512 + h * 128 + 16 * dg), t8);
#pragma unroll
              for (int e = 0; e < 8; ++e) kk[e] = t8[e];
              unpack8(*(const u32x4*)(PC + (size_t)(r0 + srow) * 2048 + 512 + h * 128 + 16 * dg + 8), t8);
#pragma unroll
              for (int e = 0; e < 8; ++e) kk[8 + e] = t8[e];
#pragma unroll
              for (int e = 0; e < 16; ++e) { const float eb = __expf(bb[e]); qq[e] *= eb; kk[e] *= 1.0f / eb; }
              const float q0[8] = {qq[0], qq[1], qq[2], qq[3], qq[4], qq[5], qq[6], qq[7]}, q1[8] = {qq[8], qq[9], qq[10], qq[11], qq[12], qq[13], qq[14], qq[15]};
              const float k0[8] = {kk[0], kk[1], kk[2], kk[3], kk[4], kk[5], kk[6], kk[7]}, k1[8] = {kk[8], kk[9], kk[10], kk[11], kk[12], kk[13], kk[14], kk[15]};
              *(LAS u32x4*)(Qt + srow * 272 + dg * 32) = pack8(q0); *(LAS u32x4*)(Qt + srow * 272 + dg * 32 + 16) = pack8(q1);
              *(LAS u32x4*)(Kt + srow * 272 + dg * 32) = pack8(k0); *(LAS u32x4*)(Kt + srow * 272 + dg * 32 + 16) = pack8(k1); }
            __syncthreads();
#pragma unroll
            for (int jt = 0; jt < 2; ++jt) {
#pragma unroll
                for (int st = 0; st < 2; ++st) {
                    const bool live = dir ? (st >= jt) : (st <= jt);
                    if (live) {
                        f32x16 X = zero16();
#pragma unroll
                        for (int kk = 0; kk < 8; ++kk) X = MFMA32(row_frag(Kt, 272, 32 * st, 16 * kk, lane), row_frag(Qt, 272, 32 * jt, 16 * kk, lane), X);
                        if (st == jt) {
#pragma unroll
                            for (int r = 0; r < 16; ++r) { const int s = crow(r, h5); const bool ok = dir ? (s >= l31) : (s <= l31); X[r] = ok ? X[r] : 0.f; } }
#pragma unroll
                        for (int step = 0; step < 2; ++step) O[jt] = MFMA32(tr_frag_perm(Vs, 528, 32 * st + 16 * step, 32 * wave, lane), pack_acc(X, step), O[jt]);
                    }
                }
#pragma unroll
                for (int kk = 0; kk < 8; ++kk) O[jt] = MFMA32(row_frag(STs, 272, 32 * wave, 16 * kk, lane), row_frag(Qt, 272, 32 * jt, 16 * kk, lane), O[jt]);
            }
        }
        __syncthreads();
#pragma unroll
        for (int jt = 0; jt < 2; ++jt)
#pragma unroll
            for (int q = 0; q < 4; ++q) *(LAS f32x4*)(YO + (32 * jt + l31) * 260 + 32 * wave + 8 * q + 4 * h5) = (f32x4){O[jt][4 * q], O[jt][4 * q + 1], O[jt][4 * q + 2], O[jt][4 * q + 3]};
        __syncthreads();
        { const int c0 = dg * 32; float y[32]; float ss = 0.f;
#pragma unroll
          for (int q = 0; q < 8; ++q) { const f32x4 a = *(const LAS f32x4*)(YO + srow * 260 + c0 + 4 * q); y[4 * q] = a.x; y[4 * q + 1] = a.y; y[4 * q + 2] = a.z; y[4 * q + 3] = a.w; }
#pragma unroll
          for (int q = 0; q < 32; ++q) ss += y[q] * y[q];
          ss += __shfl_xor(ss, 1); ss += __shfl_xor(ss, 2); ss += __shfl_xor(ss, 4);
          const float r = 1.0f / sqrtf(ss * (1.0f / 256.0f) + EPS);
#pragma unroll
          for (int q = 0; q < 4; ++q) { float g8[8], o8[8]; unpack8(*(const u32x4*)(P + (size_t)(r0 + srow) * PLD + 2048 + h * 256 + c0 + 8 * q), g8);
#pragma unroll
              for (int e = 0; e < 8; ++e) o8[e] = y[8 * q + e] * r * ng[h * 256 + c0 + 8 * q + e] * siluf_(g8[e]);
              *(u32x4*)(Y + (size_t)(r0 + srow) * D + h * 256 + c0 + 8 * q) = pack8(o8); } }
    }
}

DI void phase_gla_scan_naive(const Ctx& c) {
    const bf16* PC = WSP(bf16, WS_BIG + BIG_PC); const float* EX = WSP(float, WS_EXTRA);
    LAS float* qs = (LAS float*)c.lds; LAS float* ks = qs + 16 * 128; LAS float* as = ks + 16 * 128; LAS float* vs = as + 16 * 128; LAS float* lw = vs + 16 * 256;
    const int v = c.tid >> 1, d0 = (c.tid & 1) * 64;
    for (int item = blockIdx.x; item < 64; item += gridDim.x) {
        const int b = item >> 3, h = (item >> 1) & 3, dir = item & 1;
        float* Yo = WSP(float, WS_BIG + (dir ? BIG_YB : BIG_YF));
        const float* w2 = c.in[I_GLW2] + (size_t)dir * 16 * 512 + h * 128; const float* gb = c.in[I_GLGB] + dir * 512 + h * 128;
        float S[64];
#pragma unroll
        for (int d = 0; d < 64; ++d) S[d] = 0.f;
        for (int ch = 0; ch < (CTX + SEQ) / 16; ++ch) {
            __syncthreads();
            if (c.tid < 256) { const int st = c.tid >> 4, r = c.tid & 15, row = scan_row(ch * 16 + st, b, dir); lw[c.tid] = EX[(size_t)row * 32 + dir * 16 + r]; }
            for (int idx = c.tid; idx < 16 * 512; idx += 512) { const int st = idx >> 9, col = idx & 511, row = scan_row(ch * 16 + st, b, dir);
                if (col < 128) qs[st * 128 + col] = bf2f(PC[(size_t)row * 2048 + h * 128 + col]);
                else if (col < 256) ks[st * 128 + col - 128] = bf2f(PC[(size_t)row * 2048 + 512 + h * 128 + col - 128]);
                else vs[st * 256 + col - 256] = bf2f(PC[(size_t)row * 2048 + 1024 + h * 256 + col - 256]); }
            __syncthreads();
            for (int idx = c.tid; idx < 16 * 128; idx += 512) { const int st = idx >> 7, d = idx & 127; float pre = gb[d];
#pragma unroll
                for (int r = 0; r < 16; ++r) pre += lw[st * 16 + r] * w2[r * 512 + d];
                as[idx] = __expf(logsigf_(pre) * (1.0f / 16.0f)); }
            __syncthreads();
            for (int st = 0; st < 16; ++st) {
                const float vv = vs[st * 256 + v]; float part = 0.f;
#pragma unroll
                for (int d = 0; d < 64; ++d) { S[d] = as[st * 128 + d0 + d] * S[d] + ks[st * 128 + d0 + d] * vv; part += qs[st * 128 + d0 + d] * S[d]; }
                part += __shfl_xor(part, 1);
                if ((c.tid & 1) == 0) { const int row = scan_row(ch * 16 + st, b, dir); Yo[(size_t)row * D + h * 256 + v] = part; }
            }
        }
    }
}
DI void phase_headnorm(const Ctx& c, int hd, const float* ng) {
    const float* YF = WSP(float, WS_BIG + BIG_YF); const float* YB = WSP(float, WS_BIG + BIG_YB); const bf16* P = WSP(bf16, WS_P); bf16* Y = WSP(bf16, WS_Y);
    for (int row = c.gw; row < TT; row += c.ngw) {
        const int c0 = 16 * c.lane; float y[16]; float ss = 0.f;
#pragma unroll
        for (int j = 0; j < 4; ++j) { const f32x4 a = *(const f32x4*)(YF + (size_t)row * D + c0 + 4 * j), bb = *(const f32x4*)(YB + (size_t)row * D + c0 + 4 * j);
            y[4 * j] = a.x + bb.x; y[4 * j + 1] = a.y + bb.y; y[4 * j + 2] = a.z + bb.z; y[4 * j + 3] = a.w + bb.w; }
#pragma unroll
        for (int j = 0; j < 16; ++j) ss += y[j] * y[j];
        ss += __shfl_xor(ss, 1); ss += __shfl_xor(ss, 2); ss += __shfl_xor(ss, 4); if (hd == 256) ss += __shfl_xor(ss, 8);
        const float r = 1.0f / sqrtf(ss / (float)hd + EPS);
        float g0[8], g1[8];
        unpack8(*(const u32x4*)(P + (size_t)row * PLD + 2048 + c0), g0); unpack8(*(const u32x4*)(P + (size_t)row * PLD + 2048 + c0 + 8), g1);
        float o[16];
#pragma unroll
        for (int j = 0; j < 16; ++j) { const float gp = j < 8 ? g0[j] : g1[j - 8]; o[j] = y[j] * r * ng[c0 + j] * (hd == 128 ? sigmoidf_(gp) : siluf_(gp)); }
        const float o0[8] = {o[0], o[1], o[2], o[3], o[4], o[5], o[6], o[7]}, o1[8] = {o[8], o[9], o[10], o[11], o[12], o[13], o[14], o[15]};
        *(u32x4*)(Y + (size_t)row * D + c0) = pack8(o0); *(u32x4*)(Y + (size_t)row * D + c0 + 8) = pack8(o1);
    }
}
DI void phase_hyena_conv_naive(const Ctx& c) {
    const bf16* PC = WSP(bf16, WS_BIG + BIG_PC); bf16* Y = WSP(bf16, WS_Y); const float* skip = c.in[I_HYSKIP];
    LAS float* zt = (LAS float*)c.lds;
    LAS float* ft = zt + 4096;
    const int cc = c.tid & 63, tg = c.tid >> 6;
    for (int item = blockIdx.x; item < 4096 + 512; item += gridDim.x) {
        int L, rb, tt, cgi; const float* tab;
        if (item < 4096) { L = SEQ; const int b = item >> 9; tt = (item >> 4) & 31; cgi = item & 15; rb = TC + b * SEQ; tab = WSP(float, WS_HF); }
        else { const int it = item - 4096; L = CTX; const int b = it >> 6; tt = (it >> 4) & 3; cgi = it & 15; rb = b * CTX; tab = WSP(float, WS_HFC); }
        const int t0 = 64 * tt, c0 = 64 * cgi;
        float acc[8];
#pragma unroll
        for (int i = 0; i < 8; ++i) acc[i] = 0.f;
        for (int sb = 0; sb < L / 64; ++sb) {
            const int s0 = 64 * sb;
            __syncthreads();
            for (int idx = c.tid; idx < 4096; idx += 512) { const int sl = idx >> 6, ch = idx & 63; const size_t o = (size_t)(rb + s0 + sl) * PLD + c0 + ch;
                zt[idx] = bf2f(PC[o + 1024]) * bf2f(PC[o + 2048]); }
            for (int idx = c.tid; idx < 64 * 128; idx += 512) { const int ch = idx >> 7, j = idx & 127;
                if (j < 127) ft[j * 65 + ch] = tab[(size_t)(c0 + ch) * (2 * L) + L + (t0 - s0 - 63 + j)]; }
            __syncthreads();
#pragma unroll 1
            for (int g = 0; g < 8; ++g) {
                float w[15], z[8]; const int base = 8 * (tg - g) + 56;
#pragma unroll
                for (int m = 0; m < 15; ++m) w[m] = ft[(base + m) * 65 + cc];
#pragma unroll
                for (int j = 0; j < 8; ++j) z[j] = zt[(8 * g + j) * 64 + cc];
#pragma unroll
                for (int i = 0; i < 8; ++i)
#pragma unroll
                    for (int j = 0; j < 8; ++j) acc[i] += w[i - j + 7] * z[j];
            }
        }
#pragma unroll
        for (int i = 0; i < 8; ++i) { const int row = rb + t0 + 8 * tg + i; const size_t o = (size_t)row * PLD + c0 + cc;
            const float zin = bf2f(PC[o + 1024]) * bf2f(PC[o + 2048]), x0 = bf2f(PC[o]);
            Y[(size_t)row * D + c0 + cc] = f2bf(x0 * (acc[i] + skip[c0 + cc] * zin)); }
    }
}

DI void phase_route(const Ctx& c, int l) {
    LAS float* rw = (LAS float*)c.lds;
    for (int i = c.tid; i < 16 * 1024; i += 512) { const int e = i >> 10, k = i & 1023; rw[i] = c.in[I_RW][k * 16 + e]; }
    __syncthreads();
    const float* MOD = WSP(float, WS_MOD) + (size_t)l * 9 * 6144; const float* g = c.in[I_N2G] + l * D; bf16* H = WSP(bf16, WS_H);
    const float* X = WSP(float, WS_X); const float* XC = WSP(float, WS_XC);
    unsigned* cnt = WSP(unsigned, WS_CTL) + CW_CNT + l * 16; int* TOK = WSP(int, WS_TOK); float* TOKW = WSP(float, WS_TOK + 512 * 1024);
    float rbv[16];
#pragma unroll
    for (int e = 0; e < 16; ++e) rbv[e] = c.in[I_RB][e];
    for (int row = (l == 3 ? TC : 0) + c.gw; row < TT; row += c.ngw) {
        f32x4 v[4]; const int mr = row < TC ? 8 : (row - TC) >> 11;
        load_row(row < TC ? XC + (size_t)row * D : X + (size_t)(row - TC) * D, v, c.lane);
        norm_row(v, g, c.lane); mod_row(v, MOD + mr * 6144 + 3072, MOD + mr * 6144 + 4096, c.lane);
        store_row_bf16(H + (size_t)row * D, v, c.lane);
        float sc[16];
#pragma unroll
        for (int e = 0; e < 16; ++e) { float s = 0.f;
#pragma unroll
            for (int j = 0; j < 4; ++j) { const f32x4 w = *(const LAS f32x4*)(rw + e * 1024 + 256 * j + 4 * c.lane); s += (v[j].x * w.x + v[j].y * w.y) + (v[j].z * w.z + v[j].w * w.w); }
            sc[e] = sigmoidf_(wave_sum(s)); asm volatile("" ::: "memory"); }
        int bg = 0; float bgs = -1e30f;
#pragma unroll
        for (int gq = 0; gq < 4; ++gq) { float m1 = -1e30f, m2 = -1e30f;
#pragma unroll
            for (int j = 0; j < 4; ++j) { const float s = sc[4 * gq + j] + rbv[4 * gq + j]; if (s > m1) { m2 = m1; m1 = s; } else if (s > m2) m2 = s; }
            const float gs = m1 + m2; if (gs > bgs) { bgs = gs; bg = gq; } }
        float s4[4], p4[4];
#pragma unroll
        for (int j = 0; j < 4; ++j) { s4[j] = 0.f; p4[j] = 0.f; }
#pragma unroll
        for (int gq = 0; gq < 4; ++gq)
#pragma unroll
            for (int j = 0; j < 4; ++j) if (bg == gq) { s4[j] = sc[4 * gq + j] + rbv[4 * gq + j]; p4[j] = sc[4 * gq + j]; }
        int i1 = 0; float v1 = s4[0], q1 = p4[0];
#pragma unroll
        for (int j = 1; j < 4; ++j) if (s4[j] > v1) { v1 = s4[j]; i1 = j; q1 = p4[j]; }
        int i2 = -1; float v2 = -1e30f, q2 = 0.f;
#pragma unroll
        for (int j = 0; j < 4; ++j) if (j != i1 && s4[j] > v2) { v2 = s4[j]; i2 = j; q2 = p4[j]; }
        if (c.lane == 0) {
            const int e0 = 4 * bg + i1, e1 = 4 * bg + i2;
            const unsigned p0 = atomicAdd(cnt + e0, 1u), p1 = atomicAdd(cnt + e1, 1u);
            TOK[row * 4 + 0] = e0; TOK[row * 4 + 1] = (int)p0; TOK[row * 4 + 2] = e1; TOK[row * 4 + 3] = (int)p1;
            const float inv = 1.0f / (q1 + q2); TOKW[row * 2] = q1 * inv; TOKW[row * 2 + 1] = q2 * inv;
        }
    }
}
DI void slot_bases(const unsigned* cnt, int lane, int e0, int e1, int& b0, int& b1) {
    const unsigned mine = lane < 16 ? ((cnt[lane] + 255u) & ~255u) : 0u; unsigned pb = 0; b0 = 0; b1 = 0;
#pragma unroll
    for (int e = 0; e < 16; ++e) { const unsigned ce = __shfl(mine, e); if (e == e0) b0 = (int)pb; if (e == e1) b1 = (int)pb; pb += ce; }
}
DI void phase_gather(const Ctx& c, int l) {
    const unsigned* cnt = WSP(unsigned, WS_CTL) + CW_CNT + l * 16; const int* TOK = WSP(int, WS_TOK); int* TOKS = WSP(int, WS_TOK + 768 * 1024);
    const bf16* H = WSP(bf16, WS_H); bf16* HS = WSP(bf16, WS_BIG + BIG_HS);
    for (int row = (l == 3 ? TC : 0) + c.gw; row < TT; row += c.ngw) {
        const int e0 = TOK[row * 4], p0 = TOK[row * 4 + 1], e1 = TOK[row * 4 + 2], p1 = TOK[row * 4 + 3]; int b0, b1;
        slot_bases(cnt, c.lane, e0, e1, b0, b1);
        const int s0 = b0 + p0, s1 = b1 + p1;
        const u32x4 a = *(const u32x4*)(H + (size_t)row * D + 8 * c.lane), bq = *(const u32x4*)(H + (size_t)row * D + 512 + 8 * c.lane);
        *(u32x4*)(HS + (size_t)s0 * D + 8 * c.lane) = a; *(u32x4*)(HS + (size_t)s0 * D + 512 + 8 * c.lane) = bq;
        *(u32x4*)(HS + (size_t)s1 * D + 8 * c.lane) = a; *(u32x4*)(HS + (size_t)s1 * D + 512 + 8 * c.lane) = bq;
        if (c.lane == 0) { TOKS[row * 2] = s0; TOKS[row * 2 + 1] = s1; }
    }
}
DI LAS int* moe_tiles(const Ctx& c, int l) {
    LAS int* tp = (LAS int*)(c.lds + MISC_OFF);
    __syncthreads();
    if (c.tid < 64) {
        const unsigned* cnt = WSP(unsigned, WS_CTL) + CW_CNT + l * 16;
        const int mine = c.lane < 16 ? (int)((cnt[c.lane] + 255u) >> 8) : 0; int p = 0;
        for (int e = 0; e < 16; ++e) { const int ne = __shfl(mine, e); for (int t = c.lane; t < ne; t += 64) tp[1 + p + t] = e; p += ne; }
        if (c.lane == 0) tp[0] = p;
    }
    __syncthreads();
    return tp;
}
DI void phase_combine(const Ctx& c, int l) {
    const float* MOD = WSP(float, WS_MOD) + (size_t)l * 9 * 6144; const int* TOKS = WSP(int, WS_TOK + 768 * 1024); const float* TOKW = WSP(float, WS_TOK + 512 * 1024);
    const bf16* YS = WSP(bf16, WS_BIG + BIG_HS); float* X = WSP(float, WS_X); float* XC = WSP(float, WS_XC); bf16* H = WSP(bf16, WS_H);
    for (int row = (l == 3 ? TC : 0) + c.gw; row < TT; row += c.ngw) {
        const int mr = row < TC ? 8 : (row - TC) >> 11; float* xp = row < TC ? XC + (size_t)row * D : X + (size_t)(row - TC) * D;
        const int s0 = TOKS[row * 2], s1 = TOKS[row * 2 + 1]; const float w0 = TOKW[row * 2], w1 = TOKW[row * 2 + 1];
        f32x4 v[4]; load_row(xp, v, c.lane);
#pragma unroll
        for (int j = 0; j < 4; ++j) {
            const u32x2 a = *(const u32x2*)(YS + (size_t)s0 * D + 256 * j + 4 * c.lane), bq = *(const u32x2*)(YS + (size_t)s1 * D + 256 * j + 4 * c.lane);
            const f32x4 ya = {__uint_as_float(a.x << 16), __uint_as_float(a.x & 0xffff0000u), __uint_as_float(a.y << 16), __uint_as_float(a.y & 0xffff0000u)};
            const f32x4 yb = {__uint_as_float(bq.x << 16), __uint_as_float(bq.x & 0xffff0000u), __uint_as_float(bq.y << 16), __uint_as_float(bq.y & 0xffff0000u)};
            v[j] = v[j] + *(const f32x4*)(MOD + mr * 6144 + 5120 + 256 * j + 4 * c.lane) * (ya * w0 + yb * w1);
            *(f32x4*)(xp + 256 * j + 4 * c.lane) = v[j];
        }
        if (l < 3) {
            const float* MODn = WSP(float, WS_MOD) + (size_t)(l + 1) * 9 * 6144;
            norm_row(v, c.in[I_N1G] + (l + 1) * D, c.lane); mod_row(v, MODn + mr * 6144, MODn + mr * 6144 + 1024, c.lane);
            store_row_bf16(H + (size_t)hrow_of(row, (l + 1) % 3) * D, v, c.lane);
        } else {
            norm_row(v, c.in[I_FING], c.lane);
            float* o = c.out + (size_t)(row - TC) * D;
#pragma unroll
            for (int j = 0; j < 4; ++j) *(f32x4*)(o + 256 * j + 4 * c.lane) = v[j];
        }
    }
}

constexpr int NPHASE = 2 + 11 * DEPTH;
__host__ __device__ inline bool phase_active(int ph) {
    if (ph < 2) return true;
    const int l = (ph - 2) / 11, s = (ph - 2) % 11, kind = l % 3;
    if (s == 0) return l == 0;
    if (s == 4) return kind != 2;
    return true;
}
DI void run_phase(const Ctx& c, int ph) {
    if (ph == 0) { if constexpr (PH_EN(0)) phase_pro0(c); return; }
    if (ph == 1) { if constexpr (PH_EN(1)) phase_pro1(c); return; }
    const int l = (ph - 2) / 11, s = (ph - 2) % 11, kind = l % 3, j = l / 3;
    switch (s) {
    case 0: if constexpr (PH_EN(2)) phase_norm1(c, 0, c.in[I_X], c.in[I_CTX]); break;
    case 1: if constexpr (PH_EN(3)) {
        DenseOrder S; EpiInproj E; E.P = WSP(bf16, WS_P); E.extra = WSP(float, WS_EXTRA); E.bias = nullptr; E.bias_x = nullptr;
        if (kind == 0) { S.init(WSP(bf16, WS_H), WSP(bf16, WS_ML_WIN) + (size_t)j * NINP * 1024, TT, NINP); E.bias_x = c.in[I_MLBG] + j * 32; }
        else if (kind == 1) { S.init(WSP(bf16, WS_H), WSP(bf16, WS_GLA_WIN), TT, NINP); }
        else { S.init(WSP(bf16, WS_H), WSP(bf16, WS_HY_WIN), TT, 3072); E.bias = c.in[I_HYBIN]; }
        gemm_run(c.lds, c.tid, S, E);
    } break;
    case 2: if constexpr (PH_EN(4))
        if (kind == 0) phase_conv(c, 1024, c.in[I_MLCW] + j * 3 * 1024, c.in[I_MLCB] + j * 1024, true, 0.125f);
        else if (kind == 1) phase_conv(c, 2048, c.in[I_GLCW], c.in[I_GLCB], true, 0.08838834764831845f);
        else phase_conv(c, 3072, c.in[I_HYCW], c.in[I_HYCB], false, 1.0f);
        break;
    case 3: if constexpr (PH_EN(5))
        if (kind == 0) { if constexpr (MLSTM_CHUNK) phase_mlstm_state(c); else phase_mlstm_scan_naive(c); }
        else if (kind == 1) { if constexpr (GLA_CHUNK) phase_gla_state(c); else phase_gla_scan_naive(c); }
        else phase_hyena_conv_naive(c);
        break;
    case 4: if constexpr (PH_EN(6))
        if (kind == 0) { if constexpr (MLSTM_CHUNK) phase_mlstm_out(c, c.in[I_MLNG] + j * 1024); else phase_headnorm(c, 128, c.in[I_MLNG] + j * 1024); }
        else { if constexpr (GLA_CHUNK) phase_gla_out(c, c.in[I_GLNG]); else phase_headnorm(c, 256, c.in[I_GLNG]); }
        break;
    case 5: if constexpr (PH_EN(7)) {
        DenseOrder S; EpiOutproj E; E.X = WSP(float, WS_X); E.XC = WSP(float, WS_XC); E.mod = WSP(float, WS_MOD) + (size_t)l * 9 * 6144; E.bias = nullptr; E.perm = (kind == 1);
        E.xs_l = (l == 0) ? c.in[I_X] : WSP(float, WS_X); E.xs_c = (l == 0) ? c.in[I_CTX] : WSP(float, WS_XC); E.row_off = (l == 3) ? TC : 0;
        const bf16* W = kind == 0 ? WSP(bf16, WS_ML_WOUT) + (size_t)j * 1024 * 1024 : kind == 1 ? WSP(bf16, WS_GLA_WOUT) : WSP(bf16, WS_HY_WOUT);
        if (kind == 2) E.bias = c.in[I_HYBOUT];
        S.init(WSP(bf16, WS_Y) + (size_t)E.row_off * D, W, TT - E.row_off, 1024);
        gemm_run(c.lds, c.tid, S, E);
    } break;
    case 6: if constexpr (PH_EN(8)) phase_route(c, l); break;
    case 7: if constexpr (PH_EN(9)) phase_gather(c, l); break;
    case 8: if constexpr (PH_EN(10)) {
        MoeOrder S; S.tp = moe_tiles(c, l); S.A = WSP(bf16, WS_BIG + BIG_HS); S.Bt = WSP(bf16, WS_EXP_UP) + (size_t)l * 16 * 2048 * 1024; S.bstride = (size_t)2048 * 1024; S.nsh = 3; S.G = gridDim.x; S.c = blockIdx.x;
        EpiUp E; E.ACT = WSP(bf16, WS_BIG + BIG_ACT);
        gemm_run(c.lds, c.tid, S, E);
    } break;
    case 9: if constexpr (PH_EN(11)) {
        MoeOrder S; S.tp = moe_tiles(c, l); S.A = WSP(bf16, WS_BIG + BIG_ACT); S.Bt = WSP(bf16, WS_EXP_DN) + (size_t)l * 16 * 1024 * 1024; S.bstride = (size_t)1024 * 1024; S.nsh = 2; S.G = gridDim.x; S.c = blockIdx.x;
        EpiDown E; E.YS = WSP(bf16, WS_BIG + BIG_HS);
        gemm_run(c.lds, c.tid, S, E);
    } break;
    case 10: if constexpr (PH_EN(12)) phase_combine(c, l); break;
    }
}

__global__ void __launch_bounds__(512, 2) mega_fwd(Params p) {
    extern __shared__ __attribute__((aligned(16))) unsigned char lds_raw[];
    bool first = true;
    int rep = 0;
    for (int ph = p.ph_lo; ph < p.ph_hi;) {
        if (!phase_active(ph)) { ++ph; continue; }
        if (!first) cg::this_grid().sync();
        first = false;
        int z; asm volatile("s_mov_b32 %0, 0" : "=s"(z));
        Ctx c;
        c.lds = (LAS unsigned char*)lds_raw;
        c.tid = threadIdx.x + z; c.lane = c.tid & 63; c.wave = __builtin_amdgcn_readfirstlane(c.tid >> 6);
        c.gw = blockIdx.x * 8 + c.wave; c.ngw = gridDim.x * 8;
        c.in = p.in + z; c.out = p.out + z; c.ws = p.ws + z;
        run_phase(c, ph);
        if (REP_MASK != 0u && rep == 0 && ph >= 2 && ((REP_MASK >> ((ph - 2) % 11)) & 1u) && ((REP_LAYERS >> ((ph - 2) / 11)) & 1u)) rep = 1; else { rep = 0; ++ph; }
    }
}

extern "C" void kernel_launch(void* const* d_in, const int* in_sizes, int n_in, void* d_out, int out_size, void* d_ws, size_t ws_size, hipStream_t stream) {
    static int grid = 0;
    if (grid == 0) {
        if (n_in != 40 || ws_size < WS_END || out_size != TL * D) { fprintf(stderr, "kernel_launch: unexpected shapes (n_in %d, ws %zu, out %d)\n", n_in, ws_size, out_size); grid = -1; return; }
        int dev = 0, cus = 0, per_cu = 0;
        hipGetDevice(&dev); hipDeviceGetAttribute(&cus, hipDeviceAttributeMultiprocessorCount, dev);
        if (hipFuncSetAttribute((const void*)mega_fwd, hipFuncAttributeMaxDynamicSharedMemorySize, LDS_BYTES) != hipSuccess) { fprintf(stderr, "kernel_launch: hipFuncSetAttribute failed\n"); grid = -1; return; }
        if (hipOccupancyMaxActiveBlocksPerMultiprocessor(&per_cu, (const void*)mega_fwd, 512, LDS_BYTES) != hipSuccess || per_cu < 1) { fprintf(stderr, "kernel_launch: occupancy query says %d\n", per_cu); per_cu = 1; }
        (void)hipGetLastError();
        grid = cus;
        fprintf(stderr, "kernel_launch: grid %d (cus %d, per_cu %d)\n", grid, cus, per_cu);
    }
    if (grid < 0) return;
    hipMemsetAsync((char*)d_ws + WS_CTL, 0, 1 * MiB, stream);
    Params p{};
    for (int i = 0; i < 40; ++i) p.in[i] = (const float*)d_in[i];
    p.out = (float*)d_out; p.ws = (unsigned char*)d_ws;
#if N_LAUNCH_PER_PHASE
    for (int ph = 0; ph < NPHASE; ++ph) {
        if (!phase_active(ph)) continue;
        p.ph_lo = ph; p.ph_hi = ph + 1; void* args[] = {&p};
        hipError_t e = hipLaunchCooperativeKernel((const void*)mega_fwd, dim3(grid), dim3(512), args, LDS_BYTES, stream);
        if (e != hipSuccess) { fprintf(stderr, "launch failed: %s\n", hipGetErrorString(e)); break; }
    }
#else
    p.ph_lo = 0; p.ph_hi = NPHASE; void* args[] = {&p};
    hipError_t e = hipLaunchCooperativeKernel((const void*)mega_fwd, dim3(grid), dim3(512), args, LDS_BYTES, stream);
    if (e != hipSuccess) fprintf(stderr, "cooperative launch failed: %s (grid %d)\n", hipGetErrorString(e), grid);
#endif
}
```

```cpp
#include <hip/hip_runtime.h>
#include <hip/hip_cooperative_groups.h>
#include <cstdio>
#include <cstdint>
namespace cg = cooperative_groups;

#define LAS __attribute__((address_space(3)))
#define DI __device__ __forceinline__
typedef unsigned short bf16;
typedef float f32x4 __attribute__((ext_vector_type(4)));
typedef float f32x2 __attribute__((ext_vector_type(2)));
typedef unsigned u32x4 __attribute__((ext_vector_type(4)));
typedef unsigned u32x2 __attribute__((ext_vector_type(2)));
typedef short bf16x8 __attribute__((ext_vector_type(8)));

#ifndef FAST_GEMM
#define FAST_GEMM 1
#endif
#ifndef MLSTM_CHUNK
#define MLSTM_CHUNK 1
#endif
#ifndef GLA_CHUNK
#define GLA_CHUNK 1
#endif
#ifndef HY_MFMA
#define HY_MFMA 1
#endif
#ifndef PH_MASK
#define PH_MASK 0xFFFFFFFFu
#endif
#define PH_EN(b) ((PH_MASK >> (b)) & 1u)
#ifndef REP_LAYERS
#define REP_LAYERS 0xFu
#endif
#ifndef REP_MASK
#define REP_MASK 0u
#endif
#ifndef N_LAUNCH_PER_PHASE
#define N_LAUNCH_PER_PHASE 0
#endif

constexpr int D = 1024, NB = 8, SEQ = 2048, CTX = 256, DEPTH = 4;
constexpr int TC = NB * CTX, TL = NB * SEQ, TT = TC + TL;
constexpr int NEXP = 16;
constexpr int PLD = 3072;
constexpr int NINP = 3328;
constexpr float EPS = 1e-6f;
constexpr int MAXSLOT = 40960;

constexpr size_t MiB = 1u << 20;
constexpr size_t WS_CTL = 0;
constexpr size_t WS_MOD = 1 * MiB;
constexpr size_t WS_HM = 2 * MiB;
constexpr size_t WS_TOK = 3 * MiB;
constexpr size_t WS_HF = 4 * MiB;
constexpr size_t WS_HFC = 20 * MiB;
constexpr size_t WS_ML_WIN = 32 * MiB;
constexpr size_t WS_ML_WOUT = 45 * MiB;
constexpr size_t WS_GLA_WIN = 49 * MiB;
constexpr size_t WS_GLA_WOUT = 56 * MiB;
constexpr size_t WS_HY_WIN = 58 * MiB;
constexpr size_t WS_HY_WOUT = 64 * MiB;
constexpr size_t WS_EXP_UP = 66 * MiB;
constexpr size_t WS_EXP_DN = 322 * MiB;
constexpr size_t WS_X = 450 * MiB;
constexpr size_t WS_XC = 514 * MiB;
constexpr size_t WS_H = 522 * MiB;
constexpr size_t WS_P = 558 * MiB;
constexpr size_t WS_EXTRA = 667 * MiB;
constexpr size_t WS_Y = 670 * MiB;
constexpr size_t WS_BIG = 706 * MiB;
constexpr size_t WS_END = 962 * MiB;
constexpr size_t BIG_HS = 0;
constexpr size_t BIG_ACT = 80 * MiB;
constexpr size_t BIG_PC = 0;
constexpr size_t BIG_YF = 108 * MiB;
constexpr size_t BIG_YB = 180 * MiB;

constexpr size_t BIG_MCT = 108 * MiB;
constexpr size_t BIG_MN = 180 * MiB;

constexpr size_t BIG_GST = 108 * MiB;

constexpr size_t BIG_ZTL = 108 * MiB;
constexpr size_t BIG_ZTC = 140 * MiB;
constexpr size_t BIG_YTL = 144 * MiB;
constexpr size_t BIG_YTC = 176 * MiB;

constexpr int CW_CNT = 1024;

constexpr int LDS_BYTES = 147456;
constexpr int MISC_OFF = 131072;

struct Params {
    const float* in[40];
    float* out;
    unsigned char* ws;
    int ph_lo, ph_hi;
};
enum { I_X = 0, I_C, I_CTX, I_CCTX, I_ADAW, I_ADAB, I_N1G, I_N2G, I_FING, I_MLWIN, I_MLBG, I_MLCW, I_MLCB, I_MLNG, I_MLWOUT,
       I_GLWIN, I_GLCW, I_GLCB, I_GLW2, I_GLGB, I_GLNG, I_GLWOUT, I_HYWIN, I_HYBIN, I_HYCW, I_HYCB, I_HYFW1, I_HYFB1, I_HYFWM, I_HYFBM,
       I_HYFWO, I_HYFREQ, I_HYSKIP, I_HYWOUT, I_HYBOUT, I_RW, I_RB, I_EW1, I_EW3, I_EW2 };

DI float bf2f(bf16 v) { return __uint_as_float(((unsigned)v) << 16); }
typedef __bf16 b16x2_t __attribute__((ext_vector_type(2)));
DI unsigned cvt_pk_bf16(float lo, float hi) { const f32x2 v = {lo, hi}; const b16x2_t r = __builtin_convertvector(v, b16x2_t); return __builtin_bit_cast(unsigned, r); }
DI bf16 f2bf(float f) { return (bf16)(cvt_pk_bf16(f, 0.f) & 0xffffu); }
DI float sigmoidf_(float x) { return 1.0f / (1.0f + __expf(-x)); }
DI float siluf_(float x) { return x / (1.0f + __expf(-x)); }
DI float logsigf_(float x) { return fminf(x, 0.f) - log1pf(__expf(-fabsf(x))); }
DI float wave_sum(float v) {
#pragma unroll
    for (int o = 1; o < 64; o <<= 1) v += __shfl_xor(v, o);
    return v;
}
DI void unpack8(const u32x4 w, float (&v)[8]) {
    v[0] = __uint_as_float(w.x << 16); v[1] = __uint_as_float(w.x & 0xffff0000u);
    v[2] = __uint_as_float(w.y << 16); v[3] = __uint_as_float(w.y & 0xffff0000u);
    v[4] = __uint_as_float(w.z << 16); v[5] = __uint_as_float(w.z & 0xffff0000u);
    v[6] = __uint_as_float(w.w << 16); v[7] = __uint_as_float(w.w & 0xffff0000u);
}
DI u32x4 pack8(const float (&v)[8]) { u32x4 w; w.x = cvt_pk_bf16(v[0], v[1]); w.y = cvt_pk_bf16(v[2], v[3]); w.z = cvt_pk_bf16(v[4], v[5]); w.w = cvt_pk_bf16(v[6], v[7]); return w; }
DI void seq_bounds(int row, int& lo, int& hi) {
    if (row < TC) { lo = row & ~(CTX - 1); hi = lo + CTX - 1; } else { lo = TC + ((row - TC) & ~(SEQ - 1)); hi = lo + SEQ - 1; }
}
DI int perm_fwd(int s) { return (s & 63) * 32 + (s >> 6); }
DI int perm_inv(int sp) { return (sp & 31) * 64 + (sp >> 5); }

namespace pg8 {
constexpr int BM = 256, BK = 64, HALF = 128, HTB = HALF * BK * 2, STAGE_BYTES = 8 * HTB, NXCD = 8, WGM = 8;
__host__ __device__ __forceinline__ int lds_byte(int r, int c) { const int st = (r >> 4) * 2 + (c >> 5), rr = r & 15, cc = c & 31, ob = rr * 64 + cc * 2; return st * 1024 + (ob ^ (((ob >> 9) & 1) << 5)); }
__host__ __device__ __forceinline__ void stage_rc(int b, int& R, int& C) { const int st = b / 1024, sb = b % 1024, swz = sb ^ (((sb >> 9) & 1) << 5); R = (st >> 1) * 16 + swz / 64; C = (st & 1) * 32 + (swz % 64) / 2; }
__host__ __device__ __forceinline__ int perm32(int rho) { const int n = rho >> 4, i = rho & 15; return 8 * (i >> 2) + 4 * n + (i & 3); }
}
struct Unit { int pm, pn, e; };

struct DenseOrder {
    const bf16* A; const bf16* Bt; int nM, nN, nwg, G, c;
    DI void init(const bf16* A_, const bf16* Bt_, int M, int N) { A = A_; Bt = Bt_; nM = M / 256; nN = N / 256; nwg = nM * nN; G = gridDim.x; c = blockIdx.x; }
    DI bool next(int i, Unit& u) const {
        const int L = i * G + c; if (L >= nwg) return false;
        int wgid = L; { const int q = nwg / 8, r = nwg % 8, xcd = wgid % 8, off = wgid / 8; wgid = (xcd < r ? xcd * (q + 1) : r * (q + 1) + (xcd - r) * q) + off; }
        const int nig = 8 * nN, gid = wgid / nig, fm = gid * 8, gsz = (nM - fm) < 8 ? (nM - fm) : 8;
        u.pm = fm + ((wgid % nig) % gsz); u.pn = (wgid % nig) / gsz; u.e = 0; return true;
    }
    DI const bf16* aptr(const Unit& u) const { return A + (size_t)u.pm * 256 * 1024; }
    DI const bf16* bptr(const Unit& u) const { return Bt + (size_t)u.pn * 256 * 1024; }
};
struct MoeOrder {
    const bf16* A; const bf16* Bt; size_t bstride; int nsh, G, c; const LAS int* tp;
    DI bool next(int i, Unit& u) const {
        const int L = i * G + c; const int ntile = __builtin_amdgcn_readfirstlane(tp[0]); if (L >= (ntile << nsh)) return false;
        const int rt = L >> nsh; u.pm = rt; u.pn = L & ((1 << nsh) - 1); u.e = __builtin_amdgcn_readfirstlane(tp[1 + rt]); return true;
    }
    DI const bf16* aptr(const Unit& u) const { return A + (size_t)u.pm * 256 * 1024; }
    DI const bf16* bptr(const Unit& u) const { return Bt + (size_t)u.e * bstride + (size_t)u.pn * 256 * 1024; }
};

struct EpiInproj {
    static constexpr bool PAIR = false;
    bf16* P; float* extra; const float* bias; const float* bias_x;
    DI void row8(const Unit& u, int r, int c, const float (&v)[8]) const {
        const int row = u.pm * 256 + r, col = u.pn * 256 + c;
        if (col < PLD) {
            float w[8];
#pragma unroll
            for (int j = 0; j < 8; ++j) w[j] = v[j] + (bias ? bias[col + j] : 0.f);
            *(u32x4*)(P + (size_t)row * PLD + col) = pack8(w);
        } else if (col < PLD + 32) {
            float* o = extra + (size_t)row * 32 + (col - PLD);
#pragma unroll
            for (int j = 0; j < 8; ++j) o[j] = v[j] + (bias_x ? bias_x[col - PLD + j] : 0.f);
        }
    }
};
struct EpiOutproj {
    static constexpr bool PAIR = false;
    const float* xs_l; const float* xs_c; float* X; float* XC; const float* mod; const float* bias; int row_off; int perm;
    DI void row8(const Unit& u, int r, int c, const float (&v)[8]) const {
        const int hrow = u.pm * 256 + r + row_off, col = u.pn * 256 + c;
        const float* src; float* dst; int mr;
        if (hrow < TC) { mr = 8; src = xs_c + (size_t)hrow * D + col; dst = XC + (size_t)hrow * D + col; }
        else { const int rr = hrow - TC, b = rr >> 11, sp = rr & (SEQ - 1), s = perm ? perm_inv(sp) : sp; mr = b;
               src = xs_l + ((size_t)b * SEQ + s) * D + col; dst = X + ((size_t)b * SEQ + s) * D + col; }
        const float* g1 = mod + mr * 6144 + 2048 + col;
        const f32x4 a0 = *(const f32x4*)src, a1 = *(const f32x4*)(src + 4), g0 = *(const f32x4*)g1, gg1 = *(const f32x4*)(g1 + 4);
        f32x4 b0 = {0.f, 0.f, 0.f, 0.f}, b1 = b0;
        if (bias) { b0 = *(const f32x4*)(bias + col); b1 = *(const f32x4*)(bias + col + 4); }
        f32x4 o0, o1;
        o0 = a0 + g0 * ((f32x4){v[0], v[1], v[2], v[3]} + b0); o1 = a1 + gg1 * ((f32x4){v[4], v[5], v[6], v[7]} + b1);
        *(f32x4*)dst = o0; *(f32x4*)(dst + 4) = o1;
    }
};
struct EpiUp {
    static constexpr bool PAIR = true;
    bf16* ACT;
    DI void row8p(const Unit& u, int r, int c, const float (&g)[8], const float (&up)[8]) const {
        float w[8];
#pragma unroll
        for (int j = 0; j < 8; ++j) w[j] = siluf_(g[j]) * up[j];
        *(u32x4*)(ACT + ((size_t)u.pm * 256 + r) * 1024 + u.pn * 128 + c) = pack8(w);
    }
};
struct EpiDown {
    static constexpr bool PAIR = false;
    bf16* YS;
    DI void row8(const Unit& u, int r, int c, const float (&v)[8]) const { *(u32x4*)(YS + ((size_t)u.pm * 256 + r) * 1024 + u.pn * 256 + c) = pack8(v); }
};

template <class Sched, class Epi>
DI void gemm_fast(LAS unsigned char* lds, int tid, const Sched& S, const Epi& E) {
    using namespace pg8;
    constexpr int K = 1024, nt = K / BK;
    const int wid = __builtin_amdgcn_readfirstlane(tid >> 6), lane = tid & 63, wr = wid >> 2, wc = wid & 3, fr = lane & 15, fq = lane >> 4;
    unsigned voffA[2], voffB[2];
#pragma unroll
    for (int i = 0; i < 2; ++i) { int R, C; stage_rc(tid * 16 + i * 8192, R, C); const int Rb = (R & ~31) + perm32(R & 31);
        voffA[i] = (unsigned)(R * K + C) * 2u; voffB[i] = (unsigned)(Rb * K + C) * 2u; }
    const size_t kstep = (size_t)(BK * 2);
    const size_t hstep = (size_t)HALF * K * 2;
    const unsigned ldsw = (unsigned)wid * 1024u;
    const int aoff = lds_byte(wr * 64 + fr, fq * 8), boff = lds_byte(wc * 32 + fr, fq * 8);
#define PG8_SA(b, h) (((b) * 2 + (h)) * HTB)
#define PG8_SB(b, h) ((4 + (b) * 2 + (h)) * HTB)
#define PG8_STAGE(bufoff, gbase, voff) do { _Pragma("unroll") for (int _i = 0; _i < 2; ++_i) \
        __builtin_amdgcn_global_load_lds((const unsigned*)((const char*)(gbase) + (voff)[_i]), (LAS unsigned*)(lds + (bufoff) + ldsw + _i * 8192), 16, 0, 0); } while (0)
#define PG8_LDA(dst, b, h) do { _Pragma("unroll") for (int m = 0; m < 4; ++m) _Pragma("unroll") for (int k = 0; k < 2; ++k) dst[m][k] = *(const LAS bf16x8*)(lds + PG8_SA(b, h) + aoff + m * 2048 + k * 1024); } while (0)
#define PG8_LDB(dst, b, h) do { _Pragma("unroll") for (int n = 0; n < 2; ++n) _Pragma("unroll") for (int k = 0; k < 2; ++k) dst[n][k] = *(const LAS bf16x8*)(lds + PG8_SB(b, h) + boff + n * 2048 + k * 1024); } while (0)
#define PG8_MMA(ai, bj, At, Bt) do { __builtin_amdgcn_s_setprio(1); _Pragma("unroll") for (int m = 0; m < 4; ++m) _Pragma("unroll") for (int n = 0; n < 2; ++n) _Pragma("unroll") for (int k = 0; k < 2; ++k) \
        acc[ai][bj][m][n] = __builtin_amdgcn_mfma_f32_16x16x32_bf16(Bt[n][k], At[m][k], acc[ai][bj][m][n], 0, 0, 0); __builtin_amdgcn_s_setprio(0); } while (0)
#define PG8_WAIT_V(n) asm volatile("s_waitcnt vmcnt(" #n ")" ::: "memory")
#define PG8_WAIT_L(n) asm volatile("s_waitcnt lgkmcnt(" #n ")" ::: "memory")
#define PG8_BAR __builtin_amdgcn_s_barrier()
#define PG8_SCHED __builtin_amdgcn_sched_barrier(0)
    Unit cur, nxt; int ui = 0;
    if (!S.next(0, cur)) return;
    f32x4 acc[2][2][4][2];
#pragma unroll
    for (int a = 0; a < 2; ++a)
#pragma unroll
        for (int b = 0; b < 2; ++b)
#pragma unroll
            for (int m = 0; m < 4; ++m)
#pragma unroll
                for (int n = 0; n < 2; ++n) acc[a][b][m][n] = (f32x4){0.f, 0.f, 0.f, 0.f};
    bf16x8 At[4][2], B0[2][2], B1[2][2];
    const char* cA = (const char*)S.aptr(cur); const char* cB = (const char*)S.bptr(cur);
    PG8_STAGE(PG8_SB(0, 0), cB, voffB); PG8_STAGE(PG8_SA(0, 0), cA, voffA); PG8_STAGE(PG8_SB(0, 1), cB + hstep, voffB); PG8_STAGE(PG8_SA(0, 1), cA + hstep, voffA);
    if (wr == 1) PG8_BAR;
    PG8_WAIT_V(4); PG8_BAR;
    PG8_STAGE(PG8_SB(1, 0), cB + kstep, voffB); PG8_STAGE(PG8_SA(1, 0), cA + kstep, voffA); PG8_STAGE(PG8_SB(1, 1), cB + hstep + kstep, voffB);
    PG8_WAIT_V(6); PG8_BAR;
    for (;;) {
        const bool has_next = S.next(ui + 1, nxt);
        const char* nA = has_next ? (const char*)S.aptr(nxt) : cA; const char* nB = has_next ? (const char*)S.bptr(nxt) : cB;
        for (int t = 0; t < nt; t += 2) {
            const bool last = (t == nt - 2);
            const char* a1 = cA + (size_t)(t + 1) * kstep;
            const char* a2 = last ? nA : cA + (size_t)(t + 2) * kstep; const char* b2 = last ? nB : cB + (size_t)(t + 2) * kstep;
            const char* a3 = a2 + kstep; const char* b3 = b2 + kstep;
            PG8_LDB(B0, 0, 0); PG8_SCHED; PG8_LDA(At, 0, 0); PG8_STAGE(PG8_SA(1, 1), a1 + hstep, voffA);
            PG8_WAIT_L(8); PG8_BAR; PG8_WAIT_L(0); PG8_MMA(0, 0, At, B0); PG8_BAR; PG8_SCHED;
            PG8_LDB(B1, 0, 1); PG8_STAGE(PG8_SB(0, 0), b2, voffB);
            PG8_BAR; PG8_WAIT_L(0); PG8_MMA(0, 1, At, B1); PG8_BAR;
            PG8_LDA(At, 0, 1); PG8_STAGE(PG8_SA(0, 0), a2, voffA);
            PG8_BAR; PG8_WAIT_L(0); PG8_MMA(1, 0, At, B0); PG8_BAR; PG8_SCHED;
            PG8_STAGE(PG8_SB(0, 1), b2 + hstep, voffB);
            PG8_WAIT_V(6); PG8_BAR; PG8_MMA(1, 1, At, B1); PG8_BAR;
            PG8_LDB(B0, 1, 0); PG8_SCHED; PG8_LDA(At, 1, 0); PG8_STAGE(PG8_SA(0, 1), a2 + hstep, voffA);
            PG8_WAIT_L(8); PG8_BAR; PG8_WAIT_L(0); PG8_MMA(0, 0, At, B0); PG8_BAR; PG8_SCHED;
            PG8_LDB(B1, 1, 1); PG8_STAGE(PG8_SB(1, 0), b3, voffB);
            PG8_BAR; PG8_WAIT_L(0); PG8_MMA(0, 1, At, B1); PG8_BAR;
            PG8_LDA(At, 1, 1); PG8_STAGE(PG8_SA(1, 0), a3, voffA);
            PG8_BAR; PG8_WAIT_L(0); PG8_MMA(1, 0, At, B0); PG8_BAR; PG8_SCHED;
            PG8_STAGE(PG8_SB(1, 1), b3 + hstep, voffB);
            PG8_WAIT_V(6); PG8_BAR; PG8_MMA(1, 1, At, B1); PG8_BAR;
        }
#pragma unroll
        for (int ai = 0; ai < 2; ++ai)
#pragma unroll
            for (int m = 0; m < 4; ++m) {
                const int r = ai * HALF + wr * 64 + m * 16 + fr;
                if constexpr (Epi::PAIR) {
                    const float g[8] = {acc[ai][0][m][0][0], acc[ai][0][m][0][1], acc[ai][0][m][0][2], acc[ai][0][m][0][3], acc[ai][0][m][1][0], acc[ai][0][m][1][1], acc[ai][0][m][1][2], acc[ai][0][m][1][3]};
                    const float up[8] = {acc[ai][1][m][0][0], acc[ai][1][m][0][1], acc[ai][1][m][0][2], acc[ai][1][m][0][3], acc[ai][1][m][1][0], acc[ai][1][m][1][1], acc[ai][1][m][1][2], acc[ai][1][m][1][3]};
                    E.row8p(cur, r, wc * 32 + 8 * fq, g, up);
                } else {
#pragma unroll
                    for (int bj = 0; bj < 2; ++bj) {
                        const float v[8] = {acc[ai][bj][m][0][0], acc[ai][bj][m][0][1], acc[ai][bj][m][0][2], acc[ai][bj][m][0][3], acc[ai][bj][m][1][0], acc[ai][bj][m][1][1], acc[ai][bj][m][1][2], acc[ai][bj][m][1][3]};
                        E.row8(cur, r, bj * HALF + wc * 32 + 8 * fq, v);
                    }
                }
            }
        if (!has_next) break;
#pragma unroll
        for (int a = 0; a < 2; ++a)
#pragma unroll
            for (int b = 0; b < 2; ++b)
#pragma unroll
                for (int m = 0; m < 4; ++m)
#pragma unroll
                    for (int n = 0; n < 2; ++n) acc[a][b][m][n] = (f32x4){0.f, 0.f, 0.f, 0.f};
        cur = nxt; cA = nA; cB = nB; ++ui;
    }
    PG8_WAIT_V(0);
    if (wr == 0) PG8_BAR;
    PG8_BAR;
#undef PG8_SA
#undef PG8_SB
#undef PG8_STAGE
#undef PG8_LDA
#undef PG8_LDB
#undef PG8_MMA
#undef PG8_WAIT_V
#undef PG8_WAIT_L
#undef PG8_BAR
#undef PG8_SCHED
}

template <class Sched, class Epi>
DI void gemm_naive(LAS unsigned char* lds, int tid, const Sched& S, const Epi& E) {
    LAS float* As = (LAS float*)lds;
    LAS float* Bs = As + 32 * 132;
    LAS float* Bu = Bs + 32 * 132;
    const int ty = tid >> 4, tx = tid & 15, lr = tid >> 2, kq = tid & 3;
    Unit u;
    for (int i = 0; S.next(i, u); ++i) {
        const bf16* A = S.aptr(u); const bf16* B = S.bptr(u);
        for (int sm = 0; sm < 2; ++sm)
            for (int sn = 0; sn < (Epi::PAIR ? 1 : 2); ++sn) {
                float acc[4][8], accu[4][8];
#pragma unroll
                for (int a = 0; a < 4; ++a)
#pragma unroll
                    for (int b = 0; b < 8; ++b) { acc[a][b] = 0.f; accu[a][b] = 0.f; }
                for (int k0 = 0; k0 < 1024; k0 += 32) {
                    __syncthreads();
                    { float w[8]; unpack8(*(const u32x4*)(A + (size_t)(128 * sm + lr) * 1024 + k0 + 8 * kq), w);
#pragma unroll
                      for (int j = 0; j < 8; ++j) As[(8 * kq + j) * 132 + lr] = w[j];
                      unpack8(*(const u32x4*)(B + (size_t)(128 * sn + lr) * 1024 + k0 + 8 * kq), w);
#pragma unroll
                      for (int j = 0; j < 8; ++j) Bs[(8 * kq + j) * 132 + lr] = w[j];
                      if (Epi::PAIR) { unpack8(*(const u32x4*)(B + (size_t)(128 + lr) * 1024 + k0 + 8 * kq), w);
#pragma unroll
                          for (int j = 0; j < 8; ++j) Bu[(8 * kq + j) * 132 + lr] = w[j]; } }
                    __syncthreads();
#pragma unroll 4
                    for (int k = 0; k < 32; ++k) {
                        const f32x4 a4 = *(const LAS f32x4*)(As + k * 132 + 4 * ty);
                        const f32x4 b0 = *(const LAS f32x4*)(Bs + k * 132 + 8 * tx), b1 = *(const LAS f32x4*)(Bs + k * 132 + 8 * tx + 4);
#pragma unroll
                        for (int a = 0; a < 4; ++a) {
#pragma unroll
                            for (int b = 0; b < 4; ++b) { acc[a][b] += a4[a] * b0[b]; acc[a][4 + b] += a4[a] * b1[b]; } }
                        if (Epi::PAIR) {
                            const f32x4 c0 = *(const LAS f32x4*)(Bu + k * 132 + 8 * tx), c1 = *(const LAS f32x4*)(Bu + k * 132 + 8 * tx + 4);
#pragma unroll
                            for (int a = 0; a < 4; ++a) {
#pragma unroll
                                for (int b = 0; b < 4; ++b) { accu[a][b] += a4[a] * c0[b]; accu[a][4 + b] += a4[a] * c1[b]; } }
                        }
                    }
                }
#pragma unroll
                for (int a = 0; a < 4; ++a) {
                    if constexpr (Epi::PAIR) E.row8p(u, 128 * sm + 4 * ty + a, 8 * tx, acc[a], accu[a]);
                    else E.row8(u, 128 * sm + 4 * ty + a, 128 * sn + 8 * tx, acc[a]);
                }
            }
    }
    __syncthreads();
}
template <class Sched, class Epi>
DI void gemm_run(LAS unsigned char* lds, int tid, const Sched& S, const Epi& E) {
#if FAST_GEMM
    gemm_fast(lds, tid, S, E);
#else
    gemm_naive(lds, tid, S, E);
#endif
}

struct Ctx {
    LAS unsigned char* lds;
    int tid, lane, wave, gw, ngw;
    const float* const* in;
    float* out;
    unsigned char* ws;
};
#define WSP(T, off) ((T*)(c.ws + (off)))

DI void transpose_item(const float* W, int N, bf16* WT, int k0, int n0, int dst_row0, LAS float* scr, int lane) {
#pragma unroll 8
    for (int i = 0; i < 32; ++i) { const int kk = 2 * i + (lane >> 5); scr[kk * 33 + (lane & 31)] = W[(size_t)(k0 + kk) * N + n0 + (lane & 31)]; }
    asm volatile("s_waitcnt lgkmcnt(0)" ::: "memory");
    const int cc = lane & 7;
#pragma unroll
    for (int j = 0; j < 4; ++j) { const int n = (lane >> 3) + 8 * j; const LAS float* s = scr + (8 * cc) * 33 + n;
        u32x4 o; o.x = cvt_pk_bf16(s[0 * 33], s[1 * 33]); o.y = cvt_pk_bf16(s[2 * 33], s[3 * 33]); o.z = cvt_pk_bf16(s[4 * 33], s[5 * 33]); o.w = cvt_pk_bf16(s[6 * 33], s[7 * 33]);
        *(u32x4*)(WT + (size_t)(dst_row0 + n) * 1024 + k0 + 8 * cc) = o; }
    asm volatile("s_waitcnt lgkmcnt(0)" ::: "memory");
}
DI void dense_transpose(const Ctx& c, const float* W, int N, bf16* WT, LAS float* scr) {
    const int nblk = N / 32, nitems = 16 * nblk;
    for (int it = c.gw; it < nitems; it += c.ngw) { const int kb = it / nblk, nb = it % nblk; transpose_item(W, N, WT, 64 * kb, 32 * nb, 32 * nb, scr, c.lane); }
}
DI void phase_pro0(const Ctx& c) {
    LAS float* scr = (LAS float*)(c.lds + c.wave * 8704);
    for (int j = 0; j < 2; ++j) {
        dense_transpose(c, c.in[I_MLWIN] + (size_t)j * 1024 * 3104, 3104, WSP(bf16, WS_ML_WIN) + (size_t)j * NINP * 1024, scr);
        dense_transpose(c, c.in[I_MLWOUT] + (size_t)j * 1024 * 1024, 1024, WSP(bf16, WS_ML_WOUT) + (size_t)j * 1024 * 1024, scr);
    }
    dense_transpose(c, c.in[I_GLWIN], 3104, WSP(bf16, WS_GLA_WIN), scr);
    dense_transpose(c, c.in[I_GLWOUT], 1024, WSP(bf16, WS_GLA_WOUT), scr);
    dense_transpose(c, c.in[I_HYWIN], 3072, WSP(bf16, WS_HY_WIN), scr);
    dense_transpose(c, c.in[I_HYWOUT], 1024, WSP(bf16, WS_HY_WOUT), scr);
    for (int it = c.gw * 64 + c.lane; it < 3 * 28672; it += c.ngw * 64) {
        const int m = it / 28672, r = it % 28672; bf16* base = (m < 2) ? WSP(bf16, WS_ML_WIN) + (size_t)m * NINP * 1024 : WSP(bf16, WS_GLA_WIN);
        *(u32x4*)(base + (size_t)3104 * 1024 + (size_t)r * 8) = (u32x4){0u, 0u, 0u, 0u};
    }
    for (int it = c.gw; it < 64 * 3 * 512; it += c.ngw) {
        const int le = it / 1536, r0 = it % 1536, which = r0 / 512, r = r0 % 512, kb = r / 32, nb = r % 32;
        if (which < 2) {
            const float* W = c.in[which == 0 ? I_EW1 : I_EW3] + (size_t)le * 1024 * 1024;
            const int n0 = 32 * nb, drow = 256 * (n0 >> 7) + (n0 & 127) + (which ? 128 : 0);
            transpose_item(W, 1024, WSP(bf16, WS_EXP_UP) + (size_t)le * 2048 * 1024, 64 * kb, n0, drow, scr, c.lane);
        } else {
            transpose_item(c.in[I_EW2] + (size_t)le * 1024 * 1024, 1024, WSP(bf16, WS_EXP_DN) + (size_t)le * 1024 * 1024, 64 * kb, 32 * nb, 32 * nb, scr, c.lane);
        }
    }
    {
        const float* w1 = c.in[I_HYFW1]; const float* b1 = c.in[I_HYFB1]; const float* wm = c.in[I_HYFWM]; const float* bm = c.in[I_HYFBM]; const float* fr = c.in[I_HYFREQ];
        float* HM = WSP(float, WS_HM);
        for (int row = c.gw; row < 2304; row += c.ngw) {
            const int L = row < 2048 ? 2048 : 256, t = row < 2048 ? row : row - 2048, f = c.lane;
            float feat = 0.f;
            if (f == 0) feat = (float)t / (float)(L - 1);
            else if (f <= 32) { const int b = (f - 1) & 15; const float band = 1e-4f + (float)b * ((15.0f - 1e-4f) / 15.0f);
                const float ang = ((float)(2.0 * 3.14159265358979323846 / (double)L) * (float)t) * band; feat = (f <= 16) ? cosf(ang) : -sinf(ang); }
            float a = b1[f];
            for (int e = 0; e < 33; ++e) a += __shfl(feat, e) * w1[e * 64 + f];
            float h = sinf(fr[f] * a);
            for (int m = 0; m < 2; ++m) {
                float a2 = bm[m * 64 + f];
                for (int g = 0; g < 64; ++g) a2 += __shfl(h, g) * wm[m * 4096 + g * 64 + f];
                h = sinf(fr[f] * a2);
            }
            HM[row * 64 + f] = h;
        }
    }
    __syncthreads();
    {
        LAS float* sv = (LAS float*)c.lds;
        LAS float* red = sv + 9 * 1024;
        for (int i = c.tid; i < 9 * 1024; i += 512) { const float x = (i < 8192) ? c.in[I_C][i] : c.in[I_CCTX][i - 8192]; sv[i] = siluf_(x); }
        __syncthreads();
        float* MOD = WSP(float, WS_MOD);
        const int col = c.tid & 63, kg = c.tid >> 6;
        for (int item = blockIdx.x; item < 4 * 96; item += gridDim.x) {
            const int l = item / 96, j0 = 64 * (item % 96);
            const float* w = c.in[I_ADAW] + (size_t)l * 1024 * 6144 + j0 + col;
            float acc[9];
#pragma unroll
            for (int r = 0; r < 9; ++r) acc[r] = 0.f;
            for (int k = kg * 128; k < kg * 128 + 128; ++k) { const float wv = w[(size_t)k * 6144];
#pragma unroll
                for (int r = 0; r < 9; ++r) acc[r] += sv[r * 1024 + k] * wv; }
#pragma unroll
            for (int r = 0; r < 9; ++r) red[(kg * 9 + r) * 64 + col] = acc[r];
            __syncthreads();
            for (int o = c.tid; o < 9 * 64; o += 512) { const int r = o >> 6, cc = o & 63; float s = c.in[I_ADAB][l * 6144 + j0 + cc];
#pragma unroll
                for (int g = 0; g < 8; ++g) s += red[(g * 9 + r) * 64 + cc];
                MOD[(l * 9 + r) * 6144 + j0 + cc] = s; }
            __syncthreads();
        }
    }
}

DI void phase_pro1(const Ctx& c) {
    LAS float* wo = (LAS float*)c.lds;
    LAS float* red = wo + 2048;
    const float* HM = WSP(float, WS_HM);
    const int ch = c.tid & 15, tg = c.tid >> 4;
    for (int item = blockIdx.x; item < 128; item += gridDim.x) {
        const int lsel = item >> 6, c0 = 16 * (item & 63), L = lsel ? 256 : 2048;
        const float* hm = lsel ? HM + 2048 * 64 : HM; float* tab = lsel ? WSP(float, WS_HFC) : WSP(float, WS_HF);
        __syncthreads();
        for (int i = c.tid; i < 2048; i += 512) { const int side = i >> 10, f = (i >> 4) & 63, cc = i & 15; wo[i] = c.in[I_HYFWO][f * 2048 + side * 1024 + c0 + cc]; }
        __syncthreads();
        const int cg_ = c0 + ch;
        const float da = -4.605170185988091f / 1.5f, db = -4.605170185988091f / 0.3f;
        const float delta = fabsf(da + (float)cg_ * ((db - da) / 1023.0f));
        float* trow = tab + (size_t)cg_ * (2 * L);
        float part = 0.f;
        for (int t = tg; t < L; t += 32) {
            float af = 0.f, ab = 0.f;
            for (int f = 0; f < 64; ++f) { const float h = hm[t * 64 + f]; af += h * wo[f * 16 + ch]; ab += h * wo[1024 + f * 16 + ch]; }
            const float dec = expf(-((float)t / (float)(L - 1)) * delta); af *= dec; ab *= dec;
            trow[L + t] = af; part += fabsf(af);
            if (t >= 1) { trow[L - t] = ab; part += fabsf(ab); }
        }
        red[tg * 16 + ch] = part;
        __syncthreads();
        float l1 = 0.f;
        for (int g = 0; g < 32; ++g) l1 += red[g * 16 + ch];
        const float inv = 1.0f / l1;
        for (int t = tg; t < L; t += 32) { trow[L + t] *= inv; if (t >= 1) trow[L - t] *= inv; }
        if (tg == 0) trow[0] = 0.f;
    }
}

DI void load_row(const float* src, f32x4 (&v)[4], int lane) {
#pragma unroll
    for (int j = 0; j < 4; ++j) v[j] = *(const f32x4*)(src + 256 * j + 4 * lane);
}
DI void norm_row(f32x4 (&v)[4], const float* g, int lane) {
    float s = 0.f;
#pragma unroll
    for (int j = 0; j < 4; ++j) s += (v[j].x * v[j].x + v[j].y * v[j].y) + (v[j].z * v[j].z + v[j].w * v[j].w);
    s = wave_sum(s);
    const float r = 1.0f / sqrtf(s * (1.0f / 1024.0f) + EPS);
#pragma unroll
    for (int j = 0; j < 4; ++j) v[j] = v[j] * r * *(const f32x4*)(g + 256 * j + 4 * lane);
}
DI void mod_row(f32x4 (&v)[4], const float* sh, const float* sc, int lane) {
#pragma unroll
    for (int j = 0; j < 4; ++j) v[j] = v[j] * (*(const f32x4*)(sc + 256 * j + 4 * lane) + 1.0f) + *(const f32x4*)(sh + 256 * j + 4 * lane);
}
DI void store_row_bf16(bf16* dst, const f32x4 (&v)[4], int lane) {
#pragma unroll
    for (int j = 0; j < 4; ++j) { u32x2 w; w.x = cvt_pk_bf16(v[j].x, v[j].y); w.y = cvt_pk_bf16(v[j].z, v[j].w); *(u32x2*)(dst + 256 * j + 4 * lane) = w; }
}
DI int hrow_of(int srow, int kind) {
    if (srow < TC || kind != 1) return srow;
    const int rr = srow - TC, b = rr >> 11, s = rr & (SEQ - 1); return TC + b * SEQ + perm_fwd(s);
}
DI void phase_norm1(const Ctx& c, int l, const float* xl, const float* xc) {
    const float* MOD = WSP(float, WS_MOD) + (size_t)l * 9 * 6144; const float* g = c.in[I_N1G] + l * D; bf16* H = WSP(bf16, WS_H);
    for (int row = c.gw; row < TT; row += c.ngw) {
        f32x4 v[4]; const int mr = row < TC ? 8 : (row - TC) >> 11;
        load_row(row < TC ? xc + (size_t)row * D : xl + (size_t)(row - TC) * D, v, c.lane);
        norm_row(v, g, c.lane); mod_row(v, MOD + mr * 6144, MOD + mr * 6144 + 1024, c.lane);
        store_row_bf16(H + (size_t)hrow_of(row, l % 3) * D, v, c.lane);
    }
}

DI void phase_conv(const Ctx& c, int ncols, const float* cw, const float* cb, bool act, float qs) {
    const bf16* P = WSP(bf16, WS_P); bf16* PC = WSP(bf16, WS_BIG + BIG_PC);
    const int ng = ncols / 8; const long total = (long)TT * ng;
    for (long idx = (long)blockIdx.x * 512 + c.tid; idx < total; idx += (long)gridDim.x * 512) {
        const int row = (int)(idx / ng), col = (int)(idx % ng) * 8; int lo, hi; seq_bounds(row, lo, hi);
        float x0[8], xm[8], xp[8];
        unpack8(*(const u32x4*)(P + (size_t)row * PLD + col), x0);
        if (row > lo) unpack8(*(const u32x4*)(P + (size_t)(row - 1) * PLD + col), xm); else {
#pragma unroll
            for (int j = 0; j < 8; ++j) xm[j] = 0.f; }
        if (row < hi) unpack8(*(const u32x4*)(P + (size_t)(row + 1) * PLD + col), xp); else {
#pragma unroll
            for (int j = 0; j < 8; ++j) xp[j] = 0.f; }
        float o[8];
#pragma unroll
        for (int j = 0; j < 8; ++j) { float v = cw[col + j] * xm[j] + cw[ncols + col + j] * x0[j] + cw[2 * ncols + col + j] * xp[j] + cb[col + j];
            if (act) v = siluf_(v); if (col < 512) v *= qs; o[j] = v; }
        *(u32x4*)(PC + (size_t)row * ncols + col) = pack8(o);
    }
}

DI int scan_row(int step, int b, int dir) {
    if (step < CTX) return b * CTX + (dir ? CTX - 1 - step : step);
    const int s = step - CTX; return TC + b * SEQ + (dir ? SEQ - 1 - s : s);
}
DI void phase_mlstm_scan_naive(const Ctx& c) {
    const bf16* P = WSP(bf16, WS_P); const bf16* PC = WSP(bf16, WS_BIG + BIG_PC); const float* EX = WSP(float, WS_EXTRA);
    LAS float* qs = (LAS float*)c.lds; LAS float* ks = qs + 32 * 64; LAS float* vs = ks + 32 * 64; LAS float* gs = vs + 32 * 128;
    const int v = c.tid >> 2, d0 = (c.tid & 3) * 16;
    for (int item = blockIdx.x; item < 128; item += gridDim.x) {
        const int b = item >> 4, h = (item >> 1) & 7, dir = item & 1;
        float* Yo = WSP(float, WS_BIG + (dir ? BIG_YB : BIG_YF));
        float C[16], n[16];
#pragma unroll
        for (int d = 0; d < 16; ++d) { C[d] = 0.f; n[d] = 0.f; }
        for (int ch = 0; ch < (CTX + SEQ) / 32; ++ch) {
            __syncthreads();
            for (int idx = c.tid; idx < 32 * 256; idx += 512) { const int st = idx >> 8, col = idx & 255, row = scan_row(ch * 32 + st, b, dir);
                if (col < 64) qs[st * 64 + col] = bf2f(PC[(size_t)row * 1024 + h * 64 + col]);
                else if (col < 128) ks[st * 64 + col - 64] = bf2f(PC[(size_t)row * 1024 + 512 + h * 64 + col - 64]);
                else vs[st * 128 + col - 128] = bf2f(P[(size_t)row * PLD + 1024 + h * 128 + col - 128]); }
            if (c.tid < 32) { const int row = scan_row(ch * 32 + c.tid, b, dir); gs[c.tid * 2] = sigmoidf_(EX[(size_t)row * 32 + dir * 16 + 8 + h]); gs[c.tid * 2 + 1] = __expf(EX[(size_t)row * 32 + dir * 16 + h]); }
            __syncthreads();
            for (int st = 0; st < 32; ++st) {
                const float f = gs[st * 2], ei = gs[st * 2 + 1], vv = vs[st * 128 + v] * ei;
                float part = 0.f, dpart = 0.f;
#pragma unroll
                for (int d = 0; d < 16; ++d) { const float kd = ks[st * 64 + d0 + d], qd = qs[st * 64 + d0 + d];
                    C[d] = f * C[d] + kd * vv; part += qd * C[d]; n[d] = f * n[d] + ei * kd; dpart += qd * n[d]; }
                part += __shfl_xor(part, 1); part += __shfl_xor(part, 2); dpart += __shfl_xor(dpart, 1); dpart += __shfl_xor(dpart, 2);
                if ((c.tid & 3) == 0) { const int row = scan_row(ch * 32 + st, b, dir); Yo[(size_t)row * D + h * 128 + v] = part / fmaxf(fabsf(dpart), 1.0f); }
            }
        }
    }
}
typedef short s16x4 __attribute__((ext_vector_type(4)));
typedef float f32x16 __attribute__((ext_vector_type(16)));
#define MFMA32(a, b, c) __builtin_amdgcn_mfma_f32_32x32x16_bf16((a), (b), (c), 0, 0, 0)
DI int crow(int reg, int h) { return (reg & 3) + 8 * (reg >> 2) + 4 * h; }
DI s16x4 ds_tr(const LAS unsigned char* p) { return __builtin_amdgcn_ds_read_tr16_b64_v4i16((LAS s16x4*)p); }
DI bf16x8 cat8(s16x4 lo, s16x4 hi) { return __builtin_shufflevector(lo, hi, 0, 1, 2, 3, 4, 5, 6, 7); }
DI bf16x8 tr_frag(const LAS unsigned char* img, int pitch, int k0, int n0, int lane) {
    const int h = lane >> 5, g16 = (lane >> 4) & 1, i = lane & 15;
    const LAS unsigned char* p = img + (k0 + 8 * h + (i >> 2)) * pitch + (n0 + 16 * g16 + 4 * (i & 3)) * 2;
    return cat8(ds_tr(p), ds_tr(p + 4 * pitch));
}
DI bf16x8 tr_frag_perm(const LAS unsigned char* img, int pitch, int k0, int n0, int lane) {
    const int h = lane >> 5, g16 = (lane >> 4) & 1, i = lane & 15;
    const LAS unsigned char* p = img + (k0 + 4 * h + (i >> 2)) * pitch + (n0 + 16 * g16 + 4 * (i & 3)) * 2;
    return cat8(ds_tr(p), ds_tr(p + 8 * pitch));
}
DI bf16x8 row_frag(const LAS unsigned char* img, int pitch, int row0, int k0, int lane) { return *(const LAS bf16x8*)(img + (row0 + (lane & 31)) * pitch + (k0 + 8 * (lane >> 5)) * 2); }
DI bf16x8 pack_acc(const f32x16& x, int step) {
    u32x4 p; const int o = 8 * step;
    p.x = cvt_pk_bf16(x[o], x[o + 1]); p.y = cvt_pk_bf16(x[o + 2], x[o + 3]); p.z = cvt_pk_bf16(x[o + 4], x[o + 5]); p.w = cvt_pk_bf16(x[o + 6], x[o + 7]);
    return __builtin_bit_cast(bf16x8, p);
}
DI f32x16 zero16() { f32x16 z;
#pragma unroll
    for (int i = 0; i < 16; ++i) z[i] = 0.f; return z; }
DI float wave_incl_prefix(float x, int lane) {
#pragma unroll
    for (int o = 1; o < 64; o <<= 1) { const float t = __shfl_up(x, o); if (lane >= o) x += t; }
    return x;
}
DI float wave_incl_suffix(float x, int lane) {
#pragma unroll
    for (int o = 1; o < 64; o <<= 1) { const float t = __shfl_down(x, o); if (lane + o < 64) x += t; }
    return x;
}
DI int chunk_row0(int p, int b, int dir) {
    if (p < 4) return b * CTX + 64 * (dir ? 3 - p : p);
    return TC + b * SEQ + 64 * (dir ? 35 - p : p - 4);
}

DI void phase_mlstm_state(const Ctx& c) {
    const bf16* P = WSP(bf16, WS_P); const bf16* PC = WSP(bf16, WS_BIG + BIG_PC); const float* EX = WSP(float, WS_EXTRA);
    bf16* MCT = WSP(bf16, WS_BIG + BIG_MCT); float* MN = WSP(float, WS_BIG + BIG_MN);
    LAS float* gi = (LAS float*)c.lds; LAS float* ga = gi + 2304; LAS float* wv = ga + 2304; LAS float* dec = wv + 64;
    LAS unsigned char* Kw = c.lds + 20480; LAS unsigned char* Vs = Kw + 64 * 144;
    const int lane = c.lane, wave = c.wave, h5 = lane >> 5, l31 = lane & 31;
    for (int item = blockIdx.x; item < 256; item += gridDim.x) {
        const int b = item >> 5, h = (item >> 2) & 7, dir = (item >> 1) & 1, dvh = item & 1, seq = (b * 8 + h) * 2 + dir;
        __syncthreads();
        for (int idx = c.tid; idx < 2304; idx += 512) { const int row = chunk_row0(idx >> 6, b, dir) + (idx & 63);
            gi[idx] = EX[(size_t)row * 32 + dir * 16 + h]; ga[idx] = logsigf_(EX[(size_t)row * 32 + dir * 16 + 8 + h]); }
        f32x16 acc = zero16(); float nst = 0.f;
        const int dt = wave & 1, vt = (wave >> 1) & 1;
        const int srow = c.tid >> 3, spc = c.tid & 7;
        u32x4 kreg, vreg;
        { const int r0 = chunk_row0(0, b, dir);
          kreg = *(const u32x4*)(PC + (size_t)(r0 + srow) * 1024 + 512 + h * 64 + 8 * spc);
          vreg = *(const u32x4*)(P + (size_t)(r0 + srow) * PLD + 1024 + h * 128 + dvh * 64 + 8 * spc); }
        __syncthreads();
        for (int p = 0; p < 36; ++p) {
            if (wave < 4) {
                bf16* dst = MCT + ((size_t)seq * 36 + p) * 8192 + (size_t)(dvh * 64 + 32 * vt + l31) * 64 + 32 * dt + 4 * h5;
#pragma unroll
                for (int q = 0; q < 4; ++q) { u32x2 w; w.x = cvt_pk_bf16(acc[4 * q], acc[4 * q + 1]); w.y = cvt_pk_bf16(acc[4 * q + 2], acc[4 * q + 3]); *(u32x2*)(dst + 8 * q) = w; }
            } else if (wave == 4) { if (dvh == 0) MN[((size_t)seq * 36 + p) * 64 + lane] = nst; }
            else if (wave == 7) {
                const float a = ga[p * 64 + lane]; const float bj = dir ? wave_incl_suffix(a, lane) : wave_incl_prefix(a, lane);
                const float tot = __shfl(bj, dir ? 0 : 63);
                wv[lane] = __expf(tot - bj + gi[p * 64 + lane]); if (lane == 0) dec[0] = __expf(tot);
            }
            __syncthreads();
            { float kk[8]; unpack8(kreg, kk); const float w = wv[srow];
#pragma unroll
              for (int j = 0; j < 8; ++j) kk[j] *= w;
              *(LAS u32x4*)(Kw + srow * 144 + spc * 16) = pack8(kk); *(LAS u32x4*)(Vs + srow * 144 + spc * 16) = vreg; }
            if (p + 1 < 36) { const int r0 = chunk_row0(p + 1, b, dir);
                kreg = *(const u32x4*)(PC + (size_t)(r0 + srow) * 1024 + 512 + h * 64 + 8 * spc);
                vreg = *(const u32x4*)(P + (size_t)(r0 + srow) * PLD + 1024 + h * 128 + dvh * 64 + 8 * spc); }
            const float d = dec[0];
            __syncthreads();
            if (wave < 4) {
#pragma unroll
                for (int i = 0; i < 16; ++i) acc[i] *= d;
#pragma unroll
                for (int kk = 0; kk < 4; ++kk) acc = MFMA32(tr_frag(Kw, 144, 16 * kk, 32 * dt, lane), tr_frag(Vs, 144, 16 * kk, 32 * vt, lane), acc);
            } else if (wave == 4) {
                float s = 0.f;
                for (int r = 0; r < 64; ++r) s += bf2f(*(const LAS bf16*)(Kw + r * 144 + lane * 2));
                nst = d * nst + s;
            }
        }
    }
}

DI void phase_mlstm_out(const Ctx& c, const float* ng) {
    const bf16* P = WSP(bf16, WS_P); const bf16* PC = WSP(bf16, WS_BIG + BIG_PC); const float* EX = WSP(float, WS_EXTRA);
    const bf16* MCT = WSP(bf16, WS_BIG + BIG_MCT); const float* MN = WSP(float, WS_BIG + BIG_MN); bf16* Y = WSP(bf16, WS_Y);
    LAS unsigned char* Qs = c.lds; LAS unsigned char* Ks = Qs + 9216; LAS unsigned char* Vs = Ks + 9216;
    LAS unsigned char* CT0 = Vs + 17408;
    LAS float* gt = (LAS float*)(c.lds + MISC_OFF + 1024);
    LAS float* YO = (LAS float*)c.lds;
    const int lane = c.lane, wave = c.wave, h5 = lane >> 5, l31 = lane & 31;
    const int dir = wave >> 2, jt = (wave >> 1) & 1, vh = wave & 1;
    for (int item = blockIdx.x; item < 2304; item += gridDim.x) {
        const int b = item / 288, h = (item / 36) & 7, cc = item % 36;
        const int r0 = cc < 4 ? b * CTX + 64 * cc : TC + b * SEQ + 64 * (cc - 4);
        const int pf = cc, pb = cc < 4 ? 3 - cc : 39 - cc;
        __syncthreads();
        { const int srow = c.tid >> 3, spc = c.tid & 7;
          *(LAS u32x4*)(Qs + srow * 144 + spc * 16) = *(const u32x4*)(PC + (size_t)(r0 + srow) * 1024 + h * 64 + 8 * spc);
          *(LAS u32x4*)(Ks + srow * 144 + spc * 16) = *(const u32x4*)(PC + (size_t)(r0 + srow) * 1024 + 512 + h * 64 + 8 * spc);
#pragma unroll
          for (int i = 0; i < 2; ++i) *(LAS u32x4*)(Vs + srow * 272 + (spc + 8 * i) * 16) = *(const u32x4*)(P + (size_t)(r0 + srow) * PLD + 1024 + h * 128 + 8 * (spc + 8 * i));
#pragma unroll
          for (int i = 0; i < 4; ++i) { const int pc = c.tid + 512 * i, d2 = pc >> 10, rr = (pc >> 3) & 127, sp = pc & 7;
              const size_t so = (((size_t)((b * 8 + h) * 2 + d2)) * 36 + (d2 ? pb : pf)) * 8192;
              *(LAS u32x4*)(CT0 + d2 * 18432 + rr * 144 + sp * 16) = *(const u32x4*)(MCT + so + rr * 64 + 8 * sp); }
          if (wave < 2) { const int d2 = wave; const int row = r0 + lane;
              const float a = logsigf_(EX[(size_t)row * 32 + d2 * 16 + 8 + h]), ig = EX[(size_t)row * 32 + d2 * 16 + h];
              const float bj = d2 ? wave_incl_suffix(a, lane) : wave_incl_prefix(a, lane);
              gt[d2 * 192 + lane] = bj; gt[d2 * 192 + 64 + lane] = ig - bj;
              gt[d2 * 192 + 128 + lane] = MN[(((size_t)((b * 8 + h) * 2 + d2)) * 36 + (d2 ? pb : pf)) * 64 + lane]; } }
        __syncthreads();
        const LAS float* g = gt + dir * 192; const LAS unsigned char* CT = CT0 + dir * 18432;
        const int j = 32 * jt + l31; const float bjj = g[j];
        bf16x8 qf[4];
#pragma unroll
        for (int kk = 0; kk < 4; ++kk) qf[kk] = row_frag(Qs, 144, 32 * jt, 16 * kk, lane);
        float qn = 0.f;
#pragma unroll
        for (int kk = 0; kk < 4; ++kk) { float qv[8]; unpack8(__builtin_bit_cast(u32x4, qf[kk]), qv);
#pragma unroll
            for (int e = 0; e < 8; ++e) qn += qv[e] * g[128 + 16 * kk + 8 * h5 + e]; }
        qn += __shfl_xor(qn, 32);
        f32x16 X[2]; float den = 0.f;
#pragma unroll
        for (int st = 0; st < 2; ++st) {
            X[st] = zero16();
            const bool live = dir ? (st >= jt) : (st <= jt);
            if (live) {
#pragma unroll
                for (int kk = 0; kk < 4; ++kk) X[st] = MFMA32(row_frag(Ks, 144, 32 * st, 16 * kk, lane), qf[kk], X[st]);
#pragma unroll
                for (int r = 0; r < 16; ++r) { const int s = 32 * st + crow(r, h5); const bool ok = dir ? (s >= j) : (s <= j);
                    const float w = ok ? __expf(bjj + g[64 + s]) : 0.f; X[st][r] *= w; den += X[st][r]; }
            }
        }
        den += __shfl_xor(den, 32);
        const float eb = __expf(bjj); den += eb * qn;
        const float scale = 1.0f / fmaxf(fabsf(den), 1.0f);
        f32x16 O[2];
#pragma unroll
        for (int t = 0; t < 2; ++t) {
            const int vt = 2 * vh + t; f32x16 z = zero16(), w = zero16();
#pragma unroll
            for (int st = 0; st < 2; ++st) { const bool live = dir ? (st >= jt) : (st <= jt);
                if (live) {
#pragma unroll
                    for (int step = 0; step < 2; ++step) z = MFMA32(tr_frag_perm(Vs, 272, 32 * st + 16 * step, 32 * vt, lane), pack_acc(X[st], step), z); } }
#pragma unroll
            for (int kk = 0; kk < 4; ++kk) w = MFMA32(row_frag(CT, 144, 32 * vt, 16 * kk, lane), qf[kk], w);
#pragma unroll
            for (int r = 0; r < 16; ++r) O[t][r] = (z[r] + eb * w[r]) * scale;
        }
        __syncthreads();
#pragma unroll
        for (int t = 0; t < 2; ++t) { const int vt = 2 * vh + t;
#pragma unroll
            for (int q = 0; q < 4; ++q) *(LAS f32x4*)(YO + dir * 8448 + j * 132 + 32 * vt + 8 * q + 4 * h5) = (f32x4){O[t][4 * q], O[t][4 * q + 1], O[t][4 * q + 2], O[t][4 * q + 3]}; }
        __syncthreads();
        { const int row = c.tid >> 3, c0 = (c.tid & 7) * 16; float y[16]; float ss = 0.f;
#pragma unroll
          for (int q = 0; q < 4; ++q) { const f32x4 a = *(const LAS f32x4*)(YO + row * 132 + c0 + 4 * q), bb = *(const LAS f32x4*)(YO + 8448 + row * 132 + c0 + 4 * q);
              y[4 * q] = a.x + bb.x; y[4 * q + 1] = a.y + bb.y; y[4 * q + 2] = a.z + bb.z; y[4 * q + 3] = a.w + bb.w; }
#pragma unroll
          for (int q = 0; q < 16; ++q) ss += y[q] * y[q];
          ss += __shfl_xor(ss, 1); ss += __shfl_xor(ss, 2); ss += __shfl_xor(ss, 4);
          const float r = 1.0f / sqrtf(ss * (1.0f / 128.0f) + EPS);
          float g0[8], g1[8];
          unpack8(*(const u32x4*)(P + (size_t)(r0 + row) * PLD + 2048 + h * 128 + c0), g0); unpack8(*(const u32x4*)(P + (size_t)(r0 + row) * PLD + 2048 + h * 128 + c0 + 8), g1);
          float o0[8], o1[8];
#pragma unroll
          for (int q = 0; q < 8; ++q) { o0[q] = y[q] * r * ng[h * 128 + c0 + q] * sigmoidf_(g0[q]); o1[q] = y[8 + q] * r * ng[h * 128 + c0 + 8 + q] * sigmoidf_(g1[q]); }
          *(u32x4*)(Y + (size_t)(r0 + row) * D + h * 128 + c0) = pack8(o0); *(u32x4*)(Y + (size_t)(r0 + row) * D + h * 128 + c0 + 8) = pack8(o1); }
    }
}

DI void gla_lg(const Ctx& c, const f32x4 (&low)[4], const LAS float* w2s, const LAS float* gbs, LAS float* lgs) {
    const int s = c.tid >> 3, d0 = 16 * (c.tid & 7);
    float pre[16];
#pragma unroll
    for (int e = 0; e < 16; ++e) pre[e] = gbs[d0 + e];
#pragma unroll
    for (int r = 0; r < 16; ++r) { const float lv = low[r >> 2][r & 3];
#pragma unroll
        for (int q = 0; q < 4; ++q) { const f32x4 w = *(const LAS f32x4*)(w2s + r * 128 + d0 + 4 * q); pre[4 * q] += lv * w.x; pre[4 * q + 1] += lv * w.y; pre[4 * q + 2] += lv * w.z; pre[4 * q + 3] += lv * w.w; } }
#pragma unroll
    for (int q = 0; q < 4; ++q) *(LAS f32x4*)(lgs + s * 128 + d0 + 4 * q) = (f32x4){logsigf_(pre[4 * q]) * 0.0625f, logsigf_(pre[4 * q + 1]) * 0.0625f, logsigf_(pre[4 * q + 2]) * 0.0625f, logsigf_(pre[4 * q + 3]) * 0.0625f};
}
DI void gla_scan(const Ctx& c, int dir, LAS float* lgs, LAS float* tot) {
    if (c.tid < 128) { float run = 0.f;
        if (dir == 0) { for (int s = 0; s < 64; ++s) { run += lgs[s * 128 + c.tid]; lgs[s * 128 + c.tid] = run; } }
        else { for (int s = 63; s >= 0; --s) { run += lgs[s * 128 + c.tid]; lgs[s * 128 + c.tid] = run; } }
        tot[c.tid] = run; }
}
DI void phase_gla_state(const Ctx& c) {
    const bf16* PC = WSP(bf16, WS_BIG + BIG_PC); const float* EX = WSP(float, WS_EXTRA); bf16* GST = WSP(bf16, WS_BIG + BIG_GST);
    LAS float* w2s = (LAS float*)c.lds; LAS float* gbs = w2s + 2048; LAS float* tot = gbs + 128; LAS float* lgs = tot + 128;
    LAS unsigned char* Kd = c.lds + 45056; LAS unsigned char* Vs = Kd + 64 * 272;
    const int lane = c.lane, wave = c.wave, h5 = lane >> 5, l31 = lane & 31, dkt = wave & 3, dvt = wave >> 2;
    const int srow = c.tid >> 3, dg = c.tid & 7;
    for (int item = blockIdx.x; item < 256; item += gridDim.x) {
        const int b = item >> 5, h = (item >> 3) & 3, dir = (item >> 2) & 1, dvq = item & 3, seq = (b * 4 + h) * 2 + dir;
        __syncthreads();
        for (int i = c.tid; i < 2048; i += 512) w2s[i] = c.in[I_GLW2][(size_t)dir * 8192 + (i >> 7) * 512 + h * 128 + (i & 127)];
        if (c.tid < 128) gbs[c.tid] = c.in[I_GLGB][dir * 512 + h * 128 + c.tid];
        f32x16 acc = zero16();
        u32x4 kreg[2], vreg; f32x4 low[4];
        { const int row = chunk_row0(0, b, dir) + srow;
          kreg[0] = *(const u32x4*)(PC + (size_t)row * 2048 + 512 + h * 128 + 16 * dg); kreg[1] = *(const u32x4*)(PC + (size_t)row * 2048 + 512 + h * 128 + 16 * dg + 8);
          vreg = *(const u32x4*)(PC + (size_t)row * 2048 + 1024 + h * 256 + dvq * 64 + 8 * dg);
#pragma unroll
          for (int q = 0; q < 4; ++q) low[q] = *(const f32x4*)(EX + (size_t)row * 32 + dir * 16 + 4 * q); }
        __syncthreads();
        for (int p = 0; p < 36; ++p) {
            { bf16* dst = GST + ((size_t)seq * 36 + p) * 32768 + (size_t)(dvq * 64 + 32 * dvt + l31) * 128 + 32 * dkt + 4 * h5;
#pragma unroll
              for (int q = 0; q < 4; ++q) { u32x2 w; w.x = cvt_pk_bf16(acc[4 * q], acc[4 * q + 1]); w.y = cvt_pk_bf16(acc[4 * q + 2], acc[4 * q + 3]); *(u32x2*)(dst + 8 * q) = w; } }
            gla_lg(c, low, w2s, gbs, lgs);
            __syncthreads();
            gla_scan(c, dir, lgs, tot);
            __syncthreads();
            { float kk[16]; { float t8[8]; unpack8(kreg[0], t8);
#pragma unroll
                for (int e = 0; e < 8; ++e) kk[e] = t8[e]; unpack8(kreg[1], t8);
#pragma unroll
                for (int e = 0; e < 8; ++e) kk[8 + e] = t8[e]; }
#pragma unroll
              for (int e = 0; e < 16; ++e) kk[e] *= __expf(tot[16 * dg + e] - lgs[srow * 128 + 16 * dg + e]);
              const float k0[8] = {kk[0], kk[1], kk[2], kk[3], kk[4], kk[5], kk[6], kk[7]}, k1[8] = {kk[8], kk[9], kk[10], kk[11], kk[12], kk[13], kk[14], kk[15]};
              *(LAS u32x4*)(Kd + srow * 272 + dg * 32) = pack8(k0); *(LAS u32x4*)(Kd + srow * 272 + dg * 32 + 16) = pack8(k1);
              *(LAS u32x4*)(Vs + srow * 144 + dg * 16) = vreg; }
            if (p + 1 < 36) { const int row = chunk_row0(p + 1, b, dir) + srow;
                kreg[0] = *(const u32x4*)(PC + (size_t)row * 2048 + 512 + h * 128 + 16 * dg); kreg[1] = *(const u32x4*)(PC + (size_t)row * 2048 + 512 + h * 128 + 16 * dg + 8);
                vreg = *(const u32x4*)(PC + (size_t)row * 2048 + 1024 + h * 256 + dvq * 64 + 8 * dg);
#pragma unroll
                for (int q = 0; q < 4; ++q) low[q] = *(const f32x4*)(EX + (size_t)row * 32 + dir * 16 + 4 * q); }
            float dm[16];
#pragma unroll
            for (int r = 0; r < 16; ++r) dm[r] = __expf(tot[32 * dkt + crow(r, h5)]);
            __syncthreads();
#pragma unroll
            for (int r = 0; r < 16; ++r) acc[r] *= dm[r];
#pragma unroll
            for (int kk = 0; kk < 4; ++kk) acc = MFMA32(tr_frag(Kd, 272, 16 * kk, 32 * dkt, lane), tr_frag(Vs, 144, 16 * kk, 32 * dvt, lane), acc);
        }
    }
}
DI void phase_gla_out(const Ctx& c, const float* ng) {
    const bf16* P = WSP(bf16, WS_P); const bf16* PC = WSP(bf16, WS_BIG + BIG_PC); const float* EX = WSP(float, WS_EXTRA);
    const bf16* GST = WSP(bf16, WS_BIG + BIG_GST); bf16* Y = WSP(bf16, WS_Y);
    LAS unsigned char* Qt = c.lds; LAS unsigned char* Kt = Qt + 17408; LAS unsigned char* Vs = Kt + 17408; LAS unsigned char* STs = Vs + 33792;
    LAS float* lgs = (LAS float*)c.lds;
    LAS float* YO = (LAS float*)STs;
    LAS float* w2s = (LAS float*)(c.lds + 138240); LAS float* gbs = w2s + 2048; LAS float* tot = gbs + 128;
    const int lane = c.lane, wave = c.wave, h5 = lane >> 5, l31 = lane & 31;
    const int srow = c.tid >> 3, dg = c.tid & 7;
    for (int item = blockIdx.x; item < 1152; item += gridDim.x) {
        const int b = item / 144, h = (item / 36) & 3, cc = item % 36;
        const int r0 = cc < 4 ? b * CTX + 64 * cc : TC + b * SEQ + 64 * (cc - 4);
        __syncthreads();
#pragma unroll
        for (int i = 0; i < 4; ++i) { const int pc = dg + 8 * i; *(LAS u32x4*)(Vs + srow * 528 + pc * 16) = *(const u32x4*)(PC + (size_t)(r0 + srow) * 2048 + 1024 + h * 256 + 8 * pc); }
        f32x16 O[2]; O[0] = zero16(); O[1] = zero16();
        for (int dir = 0; dir < 2; ++dir) {
            const int pslot = dir ? (cc < 4 ? 3 - cc : 39 - cc) : cc;
            __syncthreads();
            for (int i = c.tid; i < 2048; i += 512) w2s[i] = c.in[I_GLW2][(size_t)dir * 8192 + (i >> 7) * 512 + h * 128 + (i & 127)];
            if (c.tid < 128) gbs[c.tid] = c.in[I_GLGB][dir * 512 + h * 128 + c.tid];
            { const bf16* src = GST + ((size_t)((b * 4 + h) * 2 + dir) * 36 + pslot) * 32768;
#pragma unroll
              for (int i = 0; i < 8; ++i) { const int pc = c.tid + 512 * i, rr = pc >> 4, sp = pc & 15; *(LAS u32x4*)(STs + rr * 272 + sp * 16) = *(const u32x4*)(src + rr * 128 + 8 * sp); } }
            f32x4 low[4];
#pragma unroll
            for (int q = 0; q < 4; ++q) low[q] = *(const f32x4*)(EX + (size_t)(r0 + srow) * 32 + dir * 16 + 4 * q);
            __syncthreads();
            gla_lg(c, low, w2s, gbs, lgs);
            __syncthreads();
            gla_scan(c, dir, lgs, tot);
            __syncthreads();
            float bb[16];
#pragma unroll
            for (int e = 0; e < 16; ++e) bb[e] = lgs[srow * 128 + 16 * dg + e];
            __syncthreads();
            { float qq[16], kk[16]; float t8[8];
              unpack8(*(const u32x4*)(PC + (size_t)(r0 + srow) * 2048 + h * 128 + 16 * dg), t8);
#pragma unroll
              for (int e = 0; e < 8; ++e) qq[e] = t8[e];
              unpack8(*(const u32x4*)(PC + (size_t)(r0 + srow) * 2048 + h * 128 + 16 * dg + 8), t8);
#pragma unroll
              for (int e = 0; e < 8; ++e) qq[8 + e] = t8[e];
              unpack8(*(const u32x4*)(PC + (size_t)(r0 + srow) * 2048 + 512 + h * 128 + 16 * dg), t8);
#pragma unroll
              for (int e = 0; e < 8; ++e) kk[e] = t8[e];
              unpack8(*(const u32x4*)(PC + (size_t)(r0 + srow) * 2048 + 512 + h * 128 + 16 * dg + 8), t8);
#pragma unroll
              for (int e = 0; e < 8; ++e) kk[8 + e] = t8[e];
#pragma unroll
              for (int e = 0; e < 16; ++e) { const float eb = __expf(bb[e]); qq[e] *= eb; kk[e] *= 1.0f / eb; }
              const float q0[8] = {qq[0], qq[1], qq[2], qq[3], qq[4], qq[5], qq[6], qq[7]}, q1[8] = {qq[8], qq[9], qq[10], qq[11], qq[12], qq[13], qq[14], qq[15]};
              const float k0[8] = {kk[0], kk[1], kk[2], kk[3], kk[4], kk[5], kk[6], kk[7]}, k1[8] = {kk[8], kk[9], kk[10], kk[11], kk[12], kk[13], kk[14], kk[15]};
              *(LAS u32x4*)(Qt + srow * 272 + dg * 32) = pack8(q0); *(LAS u32x4*)(Qt + srow * 272 + dg * 32 + 16) = pack8(q1);
              *(LAS u32x4*)(Kt + srow * 272 + dg * 32) = pack8(k0); *(LAS u32x4*)(Kt + srow * 272 + dg * 32 + 16) = pack8(k1); }
            __syncthreads();
#pragma unroll
            for (int jt = 0; jt < 2; ++jt) {
#pragma unroll
                for (int st = 0; st < 2; ++st) {
                    const bool live = dir ? (st >= jt) : (st <= jt);
                    if (live) {
                        f32x16 X = zero16();
#pragma unroll
                        for (int kk = 0; kk < 8; ++kk) X = MFMA32(row_frag(Kt, 272, 32 * st, 16 * kk, lane), row_frag(Qt, 272, 32 * jt, 16 * kk, lane), X);
                        if (st == jt) {
#pragma unroll
                            for (int r = 0; r < 16; ++r) { const int s = crow(r, h5); const bool ok = dir ? (s >= l31) : (s <= l31); X[r] = ok ? X[r] : 0.f; } }
#pragma unroll
                        for (int step = 0; step < 2; ++step) O[jt] = MFMA32(tr_frag_perm(Vs, 528, 32 * st + 16 * step, 32 * wave, lane), pack_acc(X, step), O[jt]);
                    }
                }
#pragma unroll
                for (int kk = 0; kk < 8; ++kk) O[jt] = MFMA32(row_frag(STs, 272, 32 * wave, 16 * kk, lane), row_frag(Qt, 272, 32 * jt, 16 * kk, lane), O[jt]);
            }
        }
        __syncthreads();
#pragma unroll
        for (int jt = 0; jt < 2; ++jt)
#pragma unroll
            for (int q = 0; q < 4; ++q) *(LAS f32x4*)(YO + (32 * jt + l31) * 260 + 32 * wave + 8 * q + 4 * h5) = (f32x4){O[jt][4 * q], O[jt][4 * q + 1], O[jt][4 * q + 2], O[jt][4 * q + 3]};
        __syncthreads();
        { const int c0 = dg * 32; float y[32]; float ss = 0.f;
#pragma unroll
          for (int q = 0; q < 8; ++q) { const f32x4 a = *(const LAS f32x4*)(YO + srow * 260 + c0 + 4 * q); y[4 * q] = a.x; y[4 * q + 1] = a.y; y[4 * q + 2] = a.z; y[4 * q + 3] = a.w; }
#pragma unroll
          for (int q = 0; q < 32; ++q) ss += y[q] * y[q];
          ss += __shfl_xor(ss, 1); ss += __shfl_xor(ss, 2); ss += __shfl_xor(ss, 4);
          const float r = 1.0f / sqrtf(ss * (1.0f / 256.0f) + EPS);
#pragma unroll
          for (int q = 0; q < 4; ++q) { float g8[8], o8[8]; unpack8(*(const u32x4*)(P + (size_t)(r0 + srow) * PLD + 2048 + h * 256 + c0 + 8 * q), g8);
#pragma unroll
              for (int e = 0; e < 8; ++e) o8[e] = y[8 * q + e] * r * ng[h * 256 + c0 + 8 * q + e] * siluf_(g8[e]);
              *(u32x4*)(Y + (size_t)(r0 + srow) * D + h * 256 + c0 + 8 * q) = pack8(o8); } }
    }
}

DI void phase_gla_scan_naive(const Ctx& c) {
    const bf16* PC = WSP(bf16, WS_BIG + BIG_PC); const float* EX = WSP(float, WS_EXTRA);
    LAS float* qs = (LAS float*)c.lds; LAS float* ks = qs + 16 * 128; LAS float* as = ks + 16 * 128; LAS float* vs = as + 16 * 128; LAS float* lw = vs + 16 * 256;
    const int v = c.tid >> 1, d0 = (c.tid & 1) * 64;
    for (int item = blockIdx.x; item < 64; item += gridDim.x) {
        const int b = item >> 3, h = (item >> 1) & 3, dir = item & 1;
        float* Yo = WSP(float, WS_BIG + (dir ? BIG_YB : BIG_YF));
        const float* w2 = c.in[I_GLW2] + (size_t)dir * 16 * 512 + h * 128; const float* gb = c.in[I_GLGB] + dir * 512 + h * 128;
        float S[64];
#pragma unroll
        for (int d = 0; d < 64; ++d) S[d] = 0.f;
        for (int ch = 0; ch < (CTX + SEQ) / 16; ++ch) {
            __syncthreads();
            if (c.tid < 256) { const int st = c.tid >> 4, r = c.tid & 15, row = scan_row(ch * 16 + st, b, dir); lw[c.tid] = EX[(size_t)row * 32 + dir * 16 + r]; }
            for (int idx = c.tid; idx < 16 * 512; idx += 512) { const int st = idx >> 9, col = idx & 511, row = scan_row(ch * 16 + st, b, dir);
                if (col < 128) qs[st * 128 + col] = bf2f(PC[(size_t)row * 2048 + h * 128 + col]);
                else if (col < 256) ks[st * 128 + col - 128] = bf2f(PC[(size_t)row * 2048 + 512 + h * 128 + col - 128]);
                else vs[st * 256 + col - 256] = bf2f(PC[(size_t)row * 2048 + 1024 + h * 256 + col - 256]); }
            __syncthreads();
            for (int idx = c.tid; idx < 16 * 128; idx += 512) { const int st = idx >> 7, d = idx & 127; float pre = gb[d];
#pragma unroll
                for (int r = 0; r < 16; ++r) pre += lw[st * 16 + r] * w2[r * 512 + d];
                as[idx] = __expf(logsigf_(pre) * (1.0f / 16.0f)); }
            __syncthreads();
            for (int st = 0; st < 16; ++st) {
                const float vv = vs[st * 256 + v]; float part = 0.f;
#pragma unroll
                for (int d = 0; d < 64; ++d) { S[d] = as[st * 128 + d0 + d] * S[d] + ks[st * 128 + d0 + d] * vv; part += qs[st * 128 + d0 + d] * S[d]; }
                part += __shfl_xor(part, 1);
                if ((c.tid & 1) == 0) { const int row = scan_row(ch * 16 + st, b, dir); Yo[(size_t)row * D + h * 256 + v] = part; }
            }
        }
    }
}
DI void phase_headnorm(const Ctx& c, int hd, const float* ng) {
    const float* YF = WSP(float, WS_BIG + BIG_YF); const float* YB = WSP(float, WS_BIG + BIG_YB); const bf16* P = WSP(bf16, WS_P); bf16* Y = WSP(bf16, WS_Y);
    for (int row = c.gw; row < TT; row += c.ngw) {
        const int c0 = 16 * c.lane; float y[16]; float ss = 0.f;
#pragma unroll
        for (int j = 0; j < 4; ++j) { const f32x4 a = *(const f32x4*)(YF + (size_t)row * D + c0 + 4 * j), bb = *(const f32x4*)(YB + (size_t)row * D + c0 + 4 * j);
            y[4 * j] = a.x + bb.x; y[4 * j + 1] = a.y + bb.y; y[4 * j + 2] = a.z + bb.z; y[4 * j + 3] = a.w + bb.w; }
#pragma unroll
        for (int j = 0; j < 16; ++j) ss += y[j] * y[j];
        ss += __shfl_xor(ss, 1); ss += __shfl_xor(ss, 2); ss += __shfl_xor(ss, 4); if (hd == 256) ss += __shfl_xor(ss, 8);
        const float r = 1.0f / sqrtf(ss / (float)hd + EPS);
        float g0[8], g1[8];
        unpack8(*(const u32x4*)(P + (size_t)row * PLD + 2048 + c0), g0); unpack8(*(const u32x4*)(P + (size_t)row * PLD + 2048 + c0 + 8), g1);
        float o[16];
#pragma unroll
        for (int j = 0; j < 16; ++j) { const float gp = j < 8 ? g0[j] : g1[j - 8]; o[j] = y[j] * r * ng[c0 + j] * (hd == 128 ? sigmoidf_(gp) : siluf_(gp)); }
        const float o0[8] = {o[0], o[1], o[2], o[3], o[4], o[5], o[6], o[7]}, o1[8] = {o[8], o[9], o[10], o[11], o[12], o[13], o[14], o[15]};
        *(u32x4*)(Y + (size_t)row * D + c0) = pack8(o0); *(u32x4*)(Y + (size_t)row * D + c0 + 8) = pack8(o1);
    }
}
DI void phase_hyena_conv_naive(const Ctx& c) {
    const bf16* PC = WSP(bf16, WS_BIG + BIG_PC); bf16* Y = WSP(bf16, WS_Y); const float* skip = c.in[I_HYSKIP];
    LAS float* zt = (LAS float*)c.lds;
    LAS float* ft = zt + 4096;
    const int cc = c.tid & 63, tg = c.tid >> 6;
    for (int item = blockIdx.x; item < 4096 + 512; item += gridDim.x) {
        int L, rb, tt, cgi; const float* tab;
        if (item < 4096) { L = SEQ; const int b = item >> 9; tt = (item >> 4) & 31; cgi = item & 15; rb = TC + b * SEQ; tab = WSP(float, WS_HF); }
        else { const int it = item - 4096; L = CTX; const int b = it >> 6; tt = (it >> 4) & 3; cgi = it & 15; rb = b * CTX; tab = WSP(float, WS_HFC); }
        const int t0 = 64 * tt, c0 = 64 * cgi;
        float acc[8];
#pragma unroll
        for (int i = 0; i < 8; ++i) acc[i] = 0.f;
        for (int sb = 0; sb < L / 64; ++sb) {
            const int s0 = 64 * sb;
            __syncthreads();
            for (int idx = c.tid; idx < 4096; idx += 512) { const int sl = idx >> 6, ch = idx & 63; const size_t o = (size_t)(rb + s0 + sl) * PLD + c0 + ch;
                zt[idx] = bf2f(PC[o + 1024]) * bf2f(PC[o + 2048]); }
            for (int idx = c.tid; idx < 64 * 128; idx += 512) { const int ch = idx >> 7, j = idx & 127;
                if (j < 127) ft[j * 65 + ch] = tab[(size_t)(c0 + ch) * (2 * L) + L + (t0 - s0 - 63 + j)]; }
            __syncthreads();
#pragma unroll 1
            for (int g = 0; g < 8; ++g) {
                float w[15], z[8]; const int base = 8 * (tg - g) + 56;
#pragma unroll
                for (int m = 0; m < 15; ++m) w[m] = ft[(base + m) * 65 + cc];
#pragma unroll
                for (int j = 0; j < 8; ++j) z[j] = zt[(8 * g + j) * 64 + cc];
#pragma unroll
                for (int i = 0; i < 8; ++i)
#pragma unroll
                    for (int j = 0; j < 8; ++j) acc[i] += w[i - j + 7] * z[j];
            }
        }
#pragma unroll
        for (int i = 0; i < 8; ++i) { const int row = rb + t0 + 8 * tg + i; const size_t o = (size_t)row * PLD + c0 + cc;
            const float zin = bf2f(PC[o + 1024]) * bf2f(PC[o + 2048]), x0 = bf2f(PC[o]);
            Y[(size_t)row * D + c0 + cc] = f2bf(x0 * (acc[i] + skip[c0 + cc] * zin)); }
    }
}

DI void hy_item(int item, int& L, int& b, int& t0, int& c0, int& rb) {
    if (item < 4096) { L = SEQ; b = item >> 9; t0 = 64 * ((item >> 4) & 31); c0 = 64 * (item & 15); rb = TC + b * SEQ; }
    else { const int it = item - 4096; L = CTX; b = it >> 6; t0 = 64 * ((it >> 4) & 3); c0 = 64 * (it & 15); rb = b * CTX; }
}
DI void phase_hy_prep(const Ctx& c) {
    const bf16* P = WSP(bf16, WS_P); bf16* X0C = WSP(bf16, WS_BIG + BIG_PC); const float* cw = c.in[I_HYCW]; const float* cb = c.in[I_HYCB];
    LAS unsigned char* raw = c.lds;
    LAS float* zt = (LAS float*)(c.lds + 32768);
    for (int item = blockIdx.x; item < 4608; item += gridDim.x) {
        int L, b, t0, c0, rb; hy_item(item, L, b, t0, c0, rb);
        bf16* ZT = L == SEQ ? WSP(bf16, WS_BIG + BIG_ZTL) : WSP(bf16, WS_BIG + BIG_ZTC);
        __syncthreads();
        for (int pc = c.tid; pc < 3 * 66 * 8; pc += 512) { const int g = pc / 528, rr = (pc % 528) >> 3, sp = pc & 7, t = t0 - 1 + rr;
            u32x4 v = {0u, 0u, 0u, 0u};
            if (t >= 0 && t < L) v = *(const u32x4*)(P + (size_t)(rb + t) * PLD + g * 1024 + c0 + 8 * sp);
            *(LAS u32x4*)(raw + (g * 66 + rr) * 128 + sp * 16) = v; }
        __syncthreads();
        { const int t = c.tid >> 3, sp = c.tid & 7; float u[3][8];
#pragma unroll
          for (int g = 0; g < 3; ++g) { float xm[8], x0[8], xp[8];
              unpack8(*(const LAS u32x4*)(raw + (g * 66 + t) * 128 + sp * 16), xm); unpack8(*(const LAS u32x4*)(raw + (g * 66 + t + 1) * 128 + sp * 16), x0); unpack8(*(const LAS u32x4*)(raw + (g * 66 + t + 2) * 128 + sp * 16), xp);
              const int col = g * 1024 + c0 + 8 * sp;
#pragma unroll
              for (int e = 0; e < 8; ++e) u[g][e] = cw[col + e] * xm[e] + cw[3072 + col + e] * x0[e] + cw[6144 + col + e] * xp[e] + cb[col + e]; }
          *(u32x4*)(X0C + (size_t)(rb + t0 + t) * 1024 + c0 + 8 * sp) = pack8(u[0]);
#pragma unroll
          for (int e = 0; e < 8; ++e) zt[t * 65 + 8 * sp + e] = u[1][e] * u[2][e]; }
        __syncthreads();
        { const int ch = c.tid >> 3, tp = c.tid & 7; float z[8];
#pragma unroll
          for (int e = 0; e < 8; ++e) z[e] = zt[(8 * tp + e) * 65 + ch];
          *(u32x4*)(ZT + ((size_t)(c0 + ch) * NB + b) * L + t0 + 8 * tp) = pack8(z); }
    }
}
template <int L>
DI void hy_toeplitz_channel(const Ctx& c, const float* hrow  , const bf16* zsrc  , bf16* ydst  ) {
    constexpr int NBK = L / 32, CP = 2 * L + 8, NT = (NBK + 31) / 32;
    LAS unsigned char* F = c.lds;
    LAS unsigned char* Zs = c.lds + 8 * CP * 2;
    const int lane = c.lane, w = c.wave, h5 = lane >> 5, a = lane & 31;
    __syncthreads();
    for (int idx = c.tid; idx < 8 * 2 * L; idx += 512) { const int r = idx / (2 * L), m = idx % (2 * L), y = m + r;
        const float v = (y >= 1 && y <= 2 * L - 1) ? hrow[2 * L - y] : 0.f;
        *(LAS bf16*)(F + (r * CP + m) * 2) = f2bf(v); }
    for (int pc = c.tid; pc < 8 * L / 8; pc += 512) { const int bb = pc / (L / 8), pi = pc % (L / 8);
        *(LAS u32x4*)(Zs + (bb * NBK + (pi >> 2)) * 80 + (pi & 3) * 16) = *(const u32x4*)(zsrc + (size_t)bb * L + 8 * pi); }
    __syncthreads();
    const int r = (-a) & 7;
    f32x16 acc[NT];
#pragma unroll
    for (int q = 0; q < NT; ++q) acc[q] = zero16();
    for (int d = -(NBK - 1); d <= NBK - 1; ++d) {
#pragma unroll
        for (int step = 0; step < 2; ++step) {
            const int y0 = L - 32 * d - a + 16 * step + 8 * h5;
            const bf16x8 A = *(const LAS bf16x8*)(F + (r * CP + (y0 - r)) * 2);
#pragma unroll
            for (int q = 0; q < NT; ++q) {
                if (d >= 32 * q - (NBK - 1) && d <= 32 * q + 31) {
                    const int src = 32 * q + a - d; const bool ok = (unsigned)src < (unsigned)NBK; const int sc = ok ? src : 0;
                    bf16x8 B = *(const LAS bf16x8*)(Zs + (w * NBK + sc) * 80 + 32 * step + 16 * h5);
                    if (!ok) B = (bf16x8){0, 0, 0, 0, 0, 0, 0, 0};
                    acc[q] = MFMA32(A, B, acc[q]);
                }
            }
        }
    }
#pragma unroll
    for (int q = 0; q < NT; ++q) { const int i = 32 * q + a;
        if (i < NBK) {
#pragma unroll
            for (int qq = 0; qq < 4; ++qq) { u32x2 o; o.x = cvt_pk_bf16(acc[q][4 * qq], acc[q][4 * qq + 1]); o.y = cvt_pk_bf16(acc[q][4 * qq + 2], acc[q][4 * qq + 3]);
                *(u32x2*)(ydst + (size_t)w * L + 32 * i + 8 * qq + 4 * h5) = o; } } }
}
DI void phase_hy_toeplitz(const Ctx& c) {
    for (int ch = blockIdx.x; ch < 1024; ch += gridDim.x) {
        hy_toeplitz_channel<SEQ>(c, WSP(float, WS_HF) + (size_t)ch * 4096, WSP(bf16, WS_BIG + BIG_ZTL) + (size_t)ch * NB * SEQ, WSP(bf16, WS_BIG + BIG_YTL) + (size_t)ch * NB * SEQ);
        hy_toeplitz_channel<CTX>(c, WSP(float, WS_HFC) + (size_t)ch * 512, WSP(bf16, WS_BIG + BIG_ZTC) + (size_t)ch * NB * CTX, WSP(bf16, WS_BIG + BIG_YTC) + (size_t)ch * NB * CTX);
    }
}
DI void phase_hy_post(const Ctx& c) {
    const bf16* X0C = WSP(bf16, WS_BIG + BIG_PC); bf16* Y = WSP(bf16, WS_Y); const float* skip = c.in[I_HYSKIP];
    LAS float* tl = (LAS float*)c.lds;
    for (int item = blockIdx.x; item < 4608; item += gridDim.x) {
        int L, b, t0, c0, rb; hy_item(item, L, b, t0, c0, rb);
        const bf16* ZT = L == SEQ ? WSP(bf16, WS_BIG + BIG_ZTL) : WSP(bf16, WS_BIG + BIG_ZTC); const bf16* YT = L == SEQ ? WSP(bf16, WS_BIG + BIG_YTL) : WSP(bf16, WS_BIG + BIG_YTC);
        __syncthreads();
        { const int ch = c.tid >> 3, tp = c.tid & 7; const size_t o = ((size_t)(c0 + ch) * NB + b) * L + t0 + 8 * tp; float y[8], z[8];
          unpack8(*(const u32x4*)(YT + o), y); unpack8(*(const u32x4*)(ZT + o), z); const float sk = skip[c0 + ch];
#pragma unroll
          for (int e = 0; e < 8; ++e) tl[ch * 65 + 8 * tp + e] = y[e] + sk * z[e]; }
        __syncthreads();
        { const int t = c.tid >> 3, sp = c.tid & 7; float x0[8], o[8];
          unpack8(*(const u32x4*)(X0C + (size_t)(rb + t0 + t) * 1024 + c0 + 8 * sp), x0);
#pragma unroll
          for (int e = 0; e < 8; ++e) o[e] = x0[e] * tl[(8 * sp + e) * 65 + t];
          *(u32x4*)(Y + (size_t)(rb + t0 + t) * D + c0 + 8 * sp) = pack8(o); }
    }
}

DI void phase_route(const Ctx& c, int l) {
    LAS float* rw = (LAS float*)c.lds;
    for (int i = c.tid; i < 16 * 1024; i += 512) { const int e = i >> 10, k = i & 1023; rw[i] = c.in[I_RW][k * 16 + e]; }
    __syncthreads();
    const float* MOD = WSP(float, WS_MOD) + (size_t)l * 9 * 6144; const float* g = c.in[I_N2G] + l * D; bf16* H = WSP(bf16, WS_H);
    const float* X = WSP(float, WS_X); const float* XC = WSP(float, WS_XC);
    unsigned* cnt = WSP(unsigned, WS_CTL) + CW_CNT + l * 16; int* TOK = WSP(int, WS_TOK); float* TOKW = WSP(float, WS_TOK + 512 * 1024);
    float rbv[16];
#pragma unroll
    for (int e = 0; e < 16; ++e) rbv[e] = c.in[I_RB][e];
    for (int row = (l == 3 ? TC : 0) + c.gw; row < TT; row += c.ngw) {
        f32x4 v[4]; const int mr = row < TC ? 8 : (row - TC) >> 11;
        load_row(row < TC ? XC + (size_t)row * D : X + (size_t)(row - TC) * D, v, c.lane);
        norm_row(v, g, c.lane); mod_row(v, MOD + mr * 6144 + 3072, MOD + mr * 6144 + 4096, c.lane);
        store_row_bf16(H + (size_t)row * D, v, c.lane);
        float sc[16];
#pragma unroll
        for (int e = 0; e < 16; ++e) { float s = 0.f;
#pragma unroll
            for (int j = 0; j < 4; ++j) { const f32x4 w = *(const LAS f32x4*)(rw + e * 1024 + 256 * j + 4 * c.lane); s += (v[j].x * w.x + v[j].y * w.y) + (v[j].z * w.z + v[j].w * w.w); }
            sc[e] = sigmoidf_(wave_sum(s)); asm volatile("" ::: "memory"); }
        int bg = 0; float bgs = -1e30f;
#pragma unroll
        for (int gq = 0; gq < 4; ++gq) { float m1 = -1e30f, m2 = -1e30f;
#pragma unroll
            for (int j = 0; j < 4; ++j) { const float s = sc[4 * gq + j] + rbv[4 * gq + j]; if (s > m1) { m2 = m1; m1 = s; } else if (s > m2) m2 = s; }
            const float gs = m1 + m2; if (gs > bgs) { bgs = gs; bg = gq; } }
        float s4[4], p4[4];
#pragma unroll
        for (int j = 0; j < 4; ++j) { s4[j] = 0.f; p4[j] = 0.f; }
#pragma unroll
        for (int gq = 0; gq < 4; ++gq)
#pragma unroll
            for (int j = 0; j < 4; ++j) if (bg == gq) { s4[j] = sc[4 * gq + j] + rbv[4 * gq + j]; p4[j] = sc[4 * gq + j]; }
        int i1 = 0; float v1 = s4[0], q1 = p4[0];
#pragma unroll
        for (int j = 1; j < 4; ++j) if (s4[j] > v1) { v1 = s4[j]; i1 = j; q1 = p4[j]; }
        int i2 = -1; float v2 = -1e30f, q2 = 0.f;
#pragma unroll
        for (int j = 0; j < 4; ++j) if (j != i1 && s4[j] > v2) { v2 = s4[j]; i2 = j; q2 = p4[j]; }
        if (c.lane == 0) {
            const int e0 = 4 * bg + i1, e1 = 4 * bg + i2;
            const unsigned p0 = atomicAdd(cnt + e0, 1u), p1 = atomicAdd(cnt + e1, 1u);
            TOK[row * 4 + 0] = e0; TOK[row * 4 + 1] = (int)p0; TOK[row * 4 + 2] = e1; TOK[row * 4 + 3] = (int)p1;
            const float inv = 1.0f / (q1 + q2); TOKW[row * 2] = q1 * inv; TOKW[row * 2 + 1] = q2 * inv;
        }
    }
}
DI void slot_bases(const unsigned* cnt, int lane, int e0, int e1, int& b0, int& b1) {
    const unsigned mine = lane < 16 ? ((cnt[lane] + 255u) & ~255u) : 0u; unsigned pb = 0; b0 = 0; b1 = 0;
#pragma unroll
    for (int e = 0; e < 16; ++e) { const unsigned ce = __shfl(mine, e); if (e == e0) b0 = (int)pb; if (e == e1) b1 = (int)pb; pb += ce; }
}
DI void phase_gather(const Ctx& c, int l) {
    const unsigned* cnt = WSP(unsigned, WS_CTL) + CW_CNT + l * 16; const int* TOK = WSP(int, WS_TOK); int* TOKS = WSP(int, WS_TOK + 768 * 1024);
    const bf16* H = WSP(bf16, WS_H); bf16* HS = WSP(bf16, WS_BIG + BIG_HS);
    for (int row = (l == 3 ? TC : 0) + c.gw; row < TT; row += c.ngw) {
        const int e0 = TOK[row * 4], p0 = TOK[row * 4 + 1], e1 = TOK[row * 4 + 2], p1 = TOK[row * 4 + 3]; int b0, b1;
        slot_bases(cnt, c.lane, e0, e1, b0, b1);
        const int s0 = b0 + p0, s1 = b1 + p1;
        const u32x4 a = *(const u32x4*)(H + (size_t)row * D + 8 * c.lane), bq = *(const u32x4*)(H + (size_t)row * D + 512 + 8 * c.lane);
        *(u32x4*)(HS + (size_t)s0 * D + 8 * c.lane) = a; *(u32x4*)(HS + (size_t)s0 * D + 512 + 8 * c.lane) = bq;
        *(u32x4*)(HS + (size_t)s1 * D + 8 * c.lane) = a; *(u32x4*)(HS + (size_t)s1 * D + 512 + 8 * c.lane) = bq;
        if (c.lane == 0) { TOKS[row * 2] = s0; TOKS[row * 2 + 1] = s1; }
    }
}
DI LAS int* moe_tiles(const Ctx& c, int l) {
    LAS int* tp = (LAS int*)(c.lds + MISC_OFF);
    __syncthreads();
    if (c.tid < 64) {
        const unsigned* cnt = WSP(unsigned, WS_CTL) + CW_CNT + l * 16;
        const int mine = c.lane < 16 ? (int)((cnt[c.lane] + 255u) >> 8) : 0; int p = 0;
        for (int e = 0; e < 16; ++e) { const int ne = __shfl(mine, e); for (int t = c.lane; t < ne; t += 64) tp[1 + p + t] = e; p += ne; }
        if (c.lane == 0) tp[0] = p;
    }
    __syncthreads();
    return tp;
}
DI void phase_combine(const Ctx& c, int l) {
    const float* MOD = WSP(float, WS_MOD) + (size_t)l * 9 * 6144; const int* TOKS = WSP(int, WS_TOK + 768 * 1024); const float* TOKW = WSP(float, WS_TOK + 512 * 1024);
    const bf16* YS = WSP(bf16, WS_BIG + BIG_HS); float* X = WSP(float, WS_X); float* XC = WSP(float, WS_XC); bf16* H = WSP(bf16, WS_H);
    for (int row = (l == 3 ? TC : 0) + c.gw; row < TT; row += c.ngw) {
        const int mr = row < TC ? 8 : (row - TC) >> 11; float* xp = row < TC ? XC + (size_t)row * D : X + (size_t)(row - TC) * D;
        const int s0 = TOKS[row * 2], s1 = TOKS[row * 2 + 1]; const float w0 = TOKW[row * 2], w1 = TOKW[row * 2 + 1];
        f32x4 v[4]; load_row(xp, v, c.lane);
#pragma unroll
        for (int j = 0; j < 4; ++j) {
            const u32x2 a = *(const u32x2*)(YS + (size_t)s0 * D + 256 * j + 4 * c.lane), bq = *(const u32x2*)(YS + (size_t)s1 * D + 256 * j + 4 * c.lane);
            const f32x4 ya = {__uint_as_float(a.x << 16), __uint_as_float(a.x & 0xffff0000u), __uint_as_float(a.y << 16), __uint_as_float(a.y & 0xffff0000u)};
            const f32x4 yb = {__uint_as_float(bq.x << 16), __uint_as_float(bq.x & 0xffff0000u), __uint_as_float(bq.y << 16), __uint_as_float(bq.y & 0xffff0000u)};
            v[j] = v[j] + *(const f32x4*)(MOD + mr * 6144 + 5120 + 256 * j + 4 * c.lane) * (ya * w0 + yb * w1);
            *(f32x4*)(xp + 256 * j + 4 * c.lane) = v[j];
        }
        if (l < 3) {
            const float* MODn = WSP(float, WS_MOD) + (size_t)(l + 1) * 9 * 6144;
            norm_row(v, c.in[I_N1G] + (l + 1) * D, c.lane); mod_row(v, MODn + mr * 6144, MODn + mr * 6144 + 1024, c.lane);
            store_row_bf16(H + (size_t)hrow_of(row, (l + 1) % 3) * D, v, c.lane);
        } else {
            norm_row(v, c.in[I_FING], c.lane);
            float* o = c.out + (size_t)(row - TC) * D;
#pragma unroll
            for (int j = 0; j < 4; ++j) *(f32x4*)(o + 256 * j + 4 * c.lane) = v[j];
        }
    }
}

constexpr int NPHASE = 2 + 11 * DEPTH;
__host__ __device__ inline bool phase_active(int ph) {
    if (ph < 2) return true;
    const int l = (ph - 2) / 11, s = (ph - 2) % 11, kind = l % 3;
    if (s == 0) return l == 0;
    if (s == 4) return kind != 2 || HY_MFMA;
    return true;
}
DI void run_phase(const Ctx& c, int ph) {
    if (ph == 0) { if constexpr (PH_EN(0)) phase_pro0(c); return; }
    if (ph == 1) { if constexpr (PH_EN(1)) phase_pro1(c); return; }
    const int l = (ph - 2) / 11, s = (ph - 2) % 11, kind = l % 3, j = l / 3;
    switch (s) {
    case 0: if constexpr (PH_EN(2)) phase_norm1(c, 0, c.in[I_X], c.in[I_CTX]); break;
    case 1: if constexpr (PH_EN(3)) {
        DenseOrder S; EpiInproj E; E.P = WSP(bf16, WS_P); E.extra = WSP(float, WS_EXTRA); E.bias = nullptr; E.bias_x = nullptr;
        if (kind == 0) { S.init(WSP(bf16, WS_H), WSP(bf16, WS_ML_WIN) + (size_t)j * NINP * 1024, TT, NINP); E.bias_x = c.in[I_MLBG] + j * 32; }
        else if (kind == 1) { S.init(WSP(bf16, WS_H), WSP(bf16, WS_GLA_WIN), TT, NINP); }
        else { S.init(WSP(bf16, WS_H), WSP(bf16, WS_HY_WIN), TT, 3072); E.bias = c.in[I_HYBIN]; }
        gemm_run(c.lds, c.tid, S, E);
    } break;
    case 2: if constexpr (PH_EN(4))
        if (kind == 0) phase_conv(c, 1024, c.in[I_MLCW] + j * 3 * 1024, c.in[I_MLCB] + j * 1024, true, 0.125f);
        else if (kind == 1) phase_conv(c, 2048, c.in[I_GLCW], c.in[I_GLCB], true, 0.08838834764831845f);
        else { if constexpr (HY_MFMA) phase_hy_prep(c); else phase_conv(c, 3072, c.in[I_HYCW], c.in[I_HYCB], false, 1.0f); }
        break;
    case 3: if constexpr (PH_EN(5))
        if (kind == 0) { if constexpr (MLSTM_CHUNK) phase_mlstm_state(c); else phase_mlstm_scan_naive(c); }
        else if (kind == 1) { if constexpr (GLA_CHUNK) phase_gla_state(c); else phase_gla_scan_naive(c); }
        else { if constexpr (HY_MFMA) phase_hy_toeplitz(c); else phase_hyena_conv_naive(c); }
        break;
    case 4: if constexpr (PH_EN(6))
        if (kind == 0) { if constexpr (MLSTM_CHUNK) phase_mlstm_out(c, c.in[I_MLNG] + j * 1024); else phase_headnorm(c, 128, c.in[I_MLNG] + j * 1024); }
        else if (kind == 1) { if constexpr (GLA_CHUNK) phase_gla_out(c, c.in[I_GLNG]); else phase_headnorm(c, 256, c.in[I_GLNG]); }
        else { if constexpr (HY_MFMA) phase_hy_post(c); }
        break;
    case 5: if constexpr (PH_EN(7)) {
        DenseOrder S; EpiOutproj E; E.X = WSP(float, WS_X); E.XC = WSP(float, WS_XC); E.mod = WSP(float, WS_MOD) + (size_t)l * 9 * 6144; E.bias = nullptr; E.perm = (kind == 1);
        E.xs_l = (l == 0) ? c.in[I_X] : WSP(float, WS_X); E.xs_c = (l == 0) ? c.in[I_CTX] : WSP(float, WS_XC); E.row_off = (l == 3) ? TC : 0;
        const bf16* W = kind == 0 ? WSP(bf16, WS_ML_WOUT) + (size_t)j * 1024 * 1024 : kind == 1 ? WSP(bf16, WS_GLA_WOUT) : WSP(bf16, WS_HY_WOUT);
        if (kind == 2) E.bias = c.in[I_HYBOUT];
        S.init(WSP(bf16, WS_Y) + (size_t)E.row_off * D, W, TT - E.row_off, 1024);
        gemm_run(c.lds, c.tid, S, E);
    } break;
    case 6: if constexpr (PH_EN(8)) phase_route(c, l); break;
    case 7: if constexpr (PH_EN(9)) phase_gather(c, l); break;
    case 8: if constexpr (PH_EN(10)) {
        MoeOrder S; S.tp = moe_tiles(c, l); S.A = WSP(bf16, WS_BIG + BIG_HS); S.Bt = WSP(bf16, WS_EXP_UP) + (size_t)l * 16 * 2048 * 1024; S.bstride = (size_t)2048 * 1024; S.nsh = 3; S.G = gridDim.x; S.c = blockIdx.x;
        EpiUp E; E.ACT = WSP(bf16, WS_BIG + BIG_ACT);
        gemm_run(c.lds, c.tid, S, E);
    } break;
    case 9: if constexpr (PH_EN(11)) {
        MoeOrder S; S.tp = moe_tiles(c, l); S.A = WSP(bf16, WS_BIG + BIG_ACT); S.Bt = WSP(bf16, WS_EXP_DN) + (size_t)l * 16 * 1024 * 1024; S.bstride = (size_t)1024 * 1024; S.nsh = 2; S.G = gridDim.x; S.c = blockIdx.x;
        EpiDown E; E.YS = WSP(bf16, WS_BIG + BIG_HS);
        gemm_run(c.lds, c.tid, S, E);
    } break;
    case 10: if constexpr (PH_EN(12)) phase_combine(c, l); break;
    }
}

__global__ void __launch_bounds__(512, 2) mega_fwd(Params p) {
    extern __shared__ __attribute__((aligned(16))) unsigned char lds_raw[];
    bool first = true;
    int rep = 0;
    for (int ph = p.ph_lo; ph < p.ph_hi;) {
        if (!phase_active(ph)) { ++ph; continue; }
        if (!first) cg::this_grid().sync();
        first = false;
        int z; asm volatile("s_mov_b32 %0, 0" : "=s"(z));
        Ctx c;
        c.lds = (LAS unsigned char*)lds_raw;
        c.tid = threadIdx.x + z; c.lane = c.tid & 63; c.wave = __builtin_amdgcn_readfirstlane(c.tid >> 6);
        c.gw = blockIdx.x * 8 + c.wave; c.ngw = gridDim.x * 8;
        c.in = p.in + z; c.out = p.out + z; c.ws = p.ws + z;
        run_phase(c, ph);
        if (REP_MASK != 0u && rep == 0 && ph >= 2 && ((REP_MASK >> ((ph - 2) % 11)) & 1u) && ((REP_LAYERS >> ((ph - 2) / 11)) & 1u)) rep = 1; else { rep = 0; ++ph; }
    }
}

extern "C" void kernel_launch(void* const* d_in, const int* in_sizes, int n_in, void* d_out, int out_size, void* d_ws, size_t ws_size, hipStream_t stream) {
    static int grid = 0;
    if (grid == 0) {
        if (n_in != 40 || ws_size < WS_END || out_size != TL * D) { fprintf(stderr, "kernel_launch: unexpected shapes (n_in %d, ws %zu, out %d)\n", n_in, ws_size, out_size); grid = -1; return; }
        int dev = 0, cus = 0, per_cu = 0;
        hipGetDevice(&dev); hipDeviceGetAttribute(&cus, hipDeviceAttributeMultiprocessorCount, dev);
        if (hipFuncSetAttribute((const void*)mega_fwd, hipFuncAttributeMaxDynamicSharedMemorySize, LDS_BYTES) != hipSuccess) { fprintf(stderr, "kernel_launch: hipFuncSetAttribute failed\n"); grid = -1; return; }
        if (hipOccupancyMaxActiveBlocksPerMultiprocessor(&per_cu, (const void*)mega_fwd, 512, LDS_BYTES) != hipSuccess || per_cu < 1) { fprintf(stderr, "kernel_launch: occupancy query says %d\n", per_cu); per_cu = 1; }
        (void)hipGetLastError();
        grid = cus;
        fprintf(stderr, "kernel_launch: grid %d (cus %d, per_cu %d)\n", grid, cus, per_cu);
    }
    if (grid < 0) return;
    hipMemsetAsync((char*)d_ws + WS_CTL, 0, 1 * MiB, stream);
    Params p{};
    for (int i = 0; i < 40; ++i) p.in[i] = (const float*)d_in[i];
    p.out = (float*)d_out; p.ws = (unsigned char*)d_ws;
#if N_LAUNCH_PER_PHASE
    for (int ph = 0; ph < NPHASE; ++ph) {
        if (!phase_active(ph)) continue;
        p.ph_lo = ph; p.ph_hi = ph + 1; void* args[] = {&p};
        hipError_t e = hipLaunchCooperativeKernel((const void*)mega_fwd, dim3(grid), dim3(512), args, LDS_BYTES, stream);
        if (e != hipSuccess) { fprintf(stderr, "launch failed: %s\n", hipGetErrorString(e)); break; }
    }
#else
    p.ph_lo = 0; p.ph_hi = NPHASE; void* args[] = {&p};
    hipError_t e = hipLaunchCooperativeKernel((const void*)mega_fwd, dim3(grid), dim3(512), args, LDS_BYTES, stream);
    if (e != hipSuccess) fprintf(stderr, "cooperative launch failed: %s (grid %d)\n", hipGetErrorString(e), grid);
#endif
}
```

```cpp
#include <hip/hip_runtime.h>
#include <hip/hip_cooperative_groups.h>
#include <cstdio>
#include <cstdint>
namespace cg = cooperative_groups;

#define LAS __attribute__((address_space(3)))
#define DI __device__ __forceinline__
typedef unsigned short bf16;
typedef float f32x4 __attribute__((ext_vector_type(4)));
typedef float f32x2 __attribute__((ext_vector_type(2)));
typedef unsigned u32x4 __attribute__((ext_vector_type(4)));
typedef unsigned u32x2 __attribute__((ext_vector_type(2)));
typedef short bf16x8 __attribute__((ext_vector_type(8)));

#ifndef FAST_GEMM
#define FAST_GEMM 1
#endif
#ifndef MLSTM_CHUNK
#define MLSTM_CHUNK 1
#endif
#ifndef GLA_CHUNK
#define GLA_CHUNK 1
#endif
#ifndef HY_MFMA
#define HY_MFMA 1
#endif
#ifndef XCD_BARRIER
#define XCD_BARRIER 1
#endif
#ifndef PH_MASK
#define PH_MASK 0xFFFFFFFFu
#endif
#define PH_EN(b) ((PH_MASK >> (b)) & 1u)
#ifndef REP_LAYERS
#define REP_LAYERS 0xFu
#endif
#ifndef REP_MASK
#define REP_MASK 0u
#endif
#ifndef N_LAUNCH_PER_PHASE
#define N_LAUNCH_PER_PHASE 0
#endif

constexpr int D = 1024, NB = 8, SEQ = 2048, CTX = 256, DEPTH = 4;
constexpr int TC = NB * CTX, TL = NB * SEQ, TT = TC + TL;
constexpr int NEXP = 16;
constexpr int PLD = 3072;
constexpr int NINP = 3328;
constexpr float EPS = 1e-6f;
constexpr int MAXSLOT = 40960;

constexpr size_t MiB = 1u << 20;
constexpr size_t WS_CTL = 0;
constexpr size_t WS_MOD = 1 * MiB;
constexpr size_t WS_HM = 2 * MiB;
constexpr size_t WS_TOK = 3 * MiB;
constexpr size_t WS_HF = 4 * MiB;
constexpr size_t WS_HFC = 20 * MiB;
constexpr size_t WS_ML_WIN = 32 * MiB;
constexpr size_t WS_ML_WOUT = 45 * MiB;
constexpr size_t WS_GLA_WIN = 49 * MiB;
constexpr size_t WS_GLA_WOUT = 56 * MiB;
constexpr size_t WS_HY_WIN = 58 * MiB;
constexpr size_t WS_HY_WOUT = 64 * MiB;
constexpr size_t WS_EXP_UP = 66 * MiB;
constexpr size_t WS_EXP_DN = 322 * MiB;
constexpr size_t WS_X = 450 * MiB;
constexpr size_t WS_XC = 514 * MiB;
constexpr size_t WS_H = 522 * MiB;
constexpr size_t WS_P = 558 * MiB;
constexpr size_t WS_EXTRA = 667 * MiB;
constexpr size_t WS_Y = 670 * MiB;
constexpr size_t WS_BIG = 706 * MiB;
constexpr size_t WS_END = 962 * MiB;
constexpr size_t BIG_HS = 0;
constexpr size_t BIG_ACT = 80 * MiB;
constexpr size_t BIG_PC = 0;
constexpr size_t BIG_YF = 108 * MiB;
constexpr size_t BIG_YB = 180 * MiB;

constexpr size_t BIG_MCT = 108 * MiB;
constexpr size_t BIG_MN = 180 * MiB;

constexpr size_t BIG_GST = 108 * MiB;

constexpr size_t BIG_ZTL = 108 * MiB;
constexpr size_t BIG_ZTC = 140 * MiB;
constexpr size_t BIG_YTL = 144 * MiB;
constexpr size_t BIG_YTC = 176 * MiB;

constexpr int CW_CNT = 1024;
constexpr int CW_BAR = 4096;

constexpr int LDS_BYTES = 148480;
constexpr int BAR_LDS_OFF = 147456;
constexpr int MISC_OFF = 131072;

struct Params {
    const float* in[40];
    float* out;
    unsigned char* ws;
    int ph_lo, ph_hi;
};
enum { I_X = 0, I_C, I_CTX, I_CCTX, I_ADAW, I_ADAB, I_N1G, I_N2G, I_FING, I_MLWIN, I_MLBG, I_MLCW, I_MLCB, I_MLNG, I_MLWOUT,
       I_GLWIN, I_GLCW, I_GLCB, I_GLW2, I_GLGB, I_GLNG, I_GLWOUT, I_HYWIN, I_HYBIN, I_HYCW, I_HYCB, I_HYFW1, I_HYFB1, I_HYFWM, I_HYFBM,
       I_HYFWO, I_HYFREQ, I_HYSKIP, I_HYWOUT, I_HYBOUT, I_RW, I_RB, I_EW1, I_EW3, I_EW2 };

DI float bf2f(bf16 v) { return __uint_as_float(((unsigned)v) << 16); }
typedef __bf16 b16x2_t __attribute__((ext_vector_type(2)));
DI unsigned cvt_pk_bf16(float lo, float hi) { const f32x2 v = {lo, hi}; const b16x2_t r = __builtin_convertvector(v, b16x2_t); return __builtin_bit_cast(unsigned, r); }
DI bf16 f2bf(float f) { return (bf16)(cvt_pk_bf16(f, 0.f) & 0xffffu); }
DI float sigmoidf_(float x) { return 1.0f / (1.0f + __expf(-x)); }
DI float siluf_(float x) { return x / (1.0f + __expf(-x)); }
DI float logsigf_(float x) { return fminf(x, 0.f) - log1pf(__expf(-fabsf(x))); }
DI float wave_sum(float v) {
#pragma unroll
    for (int o = 1; o < 64; o <<= 1) v += __shfl_xor(v, o);
    return v;
}
DI void unpack8(const u32x4 w, float (&v)[8]) {
    v[0] = __uint_as_float(w.x << 16); v[1] = __uint_as_float(w.x & 0xffff0000u);
    v[2] = __uint_as_float(w.y << 16); v[3] = __uint_as_float(w.y & 0xffff0000u);
    v[4] = __uint_as_float(w.z << 16); v[5] = __uint_as_float(w.z & 0xffff0000u);
    v[6] = __uint_as_float(w.w << 16); v[7] = __uint_as_float(w.w & 0xffff0000u);
}
DI u32x4 pack8(const float (&v)[8]) { u32x4 w; w.x = cvt_pk_bf16(v[0], v[1]); w.y = cvt_pk_bf16(v[2], v[3]); w.z = cvt_pk_bf16(v[4], v[5]); w.w = cvt_pk_bf16(v[6], v[7]); return w; }
DI void seq_bounds(int row, int& lo, int& hi) {
    if (row < TC) { lo = row & ~(CTX - 1); hi = lo + CTX - 1; } else { lo = TC + ((row - TC) & ~(SEQ - 1)); hi = lo + SEQ - 1; }
}
DI int perm_fwd(int s) { return (s & 63) * 32 + (s >> 6); }
DI int perm_inv(int sp) { return (sp & 31) * 64 + (sp >> 5); }

namespace pg8 {
constexpr int BM = 256, BK = 64, HALF = 128, HTB = HALF * BK * 2, STAGE_BYTES = 8 * HTB, NXCD = 8, WGM = 8;
__host__ __device__ __forceinline__ int lds_byte(int r, int c) { const int st = (r >> 4) * 2 + (c >> 5), rr = r & 15, cc = c & 31, ob = rr * 64 + cc * 2; return st * 1024 + (ob ^ (((ob >> 9) & 1) << 5)); }
__host__ __device__ __forceinline__ void stage_rc(int b, int& R, int& C) { const int st = b / 1024, sb = b % 1024, swz = sb ^ (((sb >> 9) & 1) << 5); R = (st >> 1) * 16 + swz / 64; C = (st & 1) * 32 + (swz % 64) / 2; }
__host__ __device__ __forceinline__ int perm32(int rho) { const int n = rho >> 4, i = rho & 15; return 8 * (i >> 2) + 4 * n + (i & 3); }
}
struct Unit { int pm, pn, e; };

struct DenseOrder {
    const bf16* A; const bf16* Bt; int nM, nN, nwg, G, c;
    DI void init(const bf16* A_, const bf16* Bt_, int M, int N) { A = A_; Bt = Bt_; nM = M / 256; nN = N / 256; nwg = nM * nN; G = gridDim.x; c = blockIdx.x; }
    DI bool next(int i, Unit& u) const {
        const int L = i * G + c; if (L >= nwg) return false;
        int wgid = L; { const int q = nwg / 8, r = nwg % 8, xcd = wgid % 8, off = wgid / 8; wgid = (xcd < r ? xcd * (q + 1) : r * (q + 1) + (xcd - r) * q) + off; }
        const int nig = 8 * nN, gid = wgid / nig, fm = gid * 8, gsz = (nM - fm) < 8 ? (nM - fm) : 8;
        u.pm = fm + ((wgid % nig) % gsz); u.pn = (wgid % nig) / gsz; u.e = 0; return true;
    }
    DI const bf16* aptr(const Unit& u) const { return A + (size_t)u.pm * 256 * 1024; }
    DI const bf16* bptr(const Unit& u) const { return Bt + (size_t)u.pn * 256 * 1024; }
};
struct MoeOrder {
    const bf16* A; const bf16* Bt; size_t bstride; int nsh, G, c; const LAS int* tp;
    DI bool next(int i, Unit& u) const {
        const int L = i * G + c; const int ntile = __builtin_amdgcn_readfirstlane(tp[0]); if (L >= (ntile << nsh)) return false;
        const int rt = L >> nsh; u.pm = rt; u.pn = L & ((1 << nsh) - 1); u.e = __builtin_amdgcn_readfirstlane(tp[1 + rt]); return true;
    }
    DI const bf16* aptr(const Unit& u) const { return A + (size_t)u.pm * 256 * 1024; }
    DI const bf16* bptr(const Unit& u) const { return Bt + (size_t)u.e * bstride + (size_t)u.pn * 256 * 1024; }
};

struct EpiInproj {
    static constexpr bool PAIR = false;
    bf16* P; float* extra; const float* bias; const float* bias_x;
    DI void row8(const Unit& u, int r, int c, const float (&v)[8]) const {
        const int row = u.pm * 256 + r, col = u.pn * 256 + c;
        if (col < PLD) {
            float w[8];
#pragma unroll
            for (int j = 0; j < 8; ++j) w[j] = v[j] + (bias ? bias[col + j] : 0.f);
            *(u32x4*)(P + (size_t)row * PLD + col) = pack8(w);
        } else if (col < PLD + 32) {
            float* o = extra + (size_t)row * 32 + (col - PLD);
#pragma unroll
            for (int j = 0; j < 8; ++j) o[j] = v[j] + (bias_x ? bias_x[col - PLD + j] : 0.f);
        }
    }
};
struct EpiOutproj {
    static constexpr bool PAIR = false;
    const float* xs_l; const float* xs_c; float* X; float* XC; const float* mod; const float* bias; int row_off; int perm;
    DI void row8(const Unit& u, int r, int c, const float (&v)[8]) const {
        const int hrow = u.pm * 256 + r + row_off, col = u.pn * 256 + c;
        const float* src; float* dst; int mr;
        if (hrow < TC) { mr = 8; src = xs_c + (size_t)hrow * D + col; dst = XC + (size_t)hrow * D + col; }
        else { const int rr = hrow - TC, b = rr >> 11, sp = rr & (SEQ - 1), s = perm ? perm_inv(sp) : sp; mr = b;
               src = xs_l + ((size_t)b * SEQ + s) * D + col; dst = X + ((size_t)b * SEQ + s) * D + col; }
        const float* g1 = mod + mr * 6144 + 2048 + col;
        const f32x4 a0 = *(const f32x4*)src, a1 = *(const f32x4*)(src + 4), g0 = *(const f32x4*)g1, gg1 = *(const f32x4*)(g1 + 4);
        f32x4 b0 = {0.f, 0.f, 0.f, 0.f}, b1 = b0;
        if (bias) { b0 = *(const f32x4*)(bias + col); b1 = *(const f32x4*)(bias + col + 4); }
        f32x4 o0, o1;
        o0 = a0 + g0 * ((f32x4){v[0], v[1], v[2], v[3]} + b0); o1 = a1 + gg1 * ((f32x4){v[4], v[5], v[6], v[7]} + b1);
        *(f32x4*)dst = o0; *(f32x4*)(dst + 4) = o1;
    }
};
struct EpiUp {
    static constexpr bool PAIR = true;
    bf16* ACT;
    DI void row8p(const Unit& u, int r, int c, const float (&g)[8], const float (&up)[8]) const {
        float w[8];
#pragma unroll
        for (int j = 0; j < 8; ++j) w[j] = siluf_(g[j]) * up[j];
        *(u32x4*)(ACT + ((size_t)u.pm * 256 + r) * 1024 + u.pn * 128 + c) = pack8(w);
    }
};
struct EpiDown {
    static constexpr bool PAIR = false;
    bf16* YS;
    DI void row8(const Unit& u, int r, int c, const float (&v)[8]) const { *(u32x4*)(YS + ((size_t)u.pm * 256 + r) * 1024 + u.pn * 256 + c) = pack8(v); }
};

template <class Sched, class Epi>
DI void gemm_fast(LAS unsigned char* lds, int tid, const Sched& S, const Epi& E) {
    using namespace pg8;
    constexpr int K = 1024, nt = K / BK;
    const int wid = __builtin_amdgcn_readfirstlane(tid >> 6), lane = tid & 63, wr = wid >> 2, wc = wid & 3, fr = lane & 15, fq = lane >> 4;
    unsigned voffA[2], voffB[2];
#pragma unroll
    for (int i = 0; i < 2; ++i) { int R, C; stage_rc(tid * 16 + i * 8192, R, C); const int Rb = (R & ~31) + perm32(R & 31);
        voffA[i] = (unsigned)(R * K + C) * 2u; voffB[i] = (unsigned)(Rb * K + C) * 2u; }
    const size_t kstep = (size_t)(BK * 2);
    const size_t hstep = (size_t)HALF * K * 2;
    const unsigned ldsw = (unsigned)wid * 1024u;
    const int aoff = lds_byte(wr * 64 + fr, fq * 8), boff = lds_byte(wc * 32 + fr, fq * 8);
#define PG8_SA(b, h) (((b) * 2 + (h)) * HTB)
#define PG8_SB(b, h) ((4 + (b) * 2 + (h)) * HTB)
#define PG8_STAGE(bufoff, gbase, voff) do { _Pragma("unroll") for (int _i = 0; _i < 2; ++_i) \
        __builtin_amdgcn_global_load_lds((const unsigned*)((const char*)(gbase) + (voff)[_i]), (LAS unsigned*)(lds + (bufoff) + ldsw + _i * 8192), 16, 0, 0); } while (0)
#define PG8_LDA(dst, b, h) do { _Pragma("unroll") for (int m = 0; m < 4; ++m) _Pragma("unroll") for (int k = 0; k < 2; ++k) dst[m][k] = *(const LAS bf16x8*)(lds + PG8_SA(b, h) + aoff + m * 2048 + k * 1024); } while (0)
#define PG8_LDB(dst, b, h) do { _Pragma("unroll") for (int n = 0; n < 2; ++n) _Pragma("unroll") for (int k = 0; k < 2; ++k) dst[n][k] = *(const LAS bf16x8*)(lds + PG8_SB(b, h) + boff + n * 2048 + k * 1024); } while (0)
#define PG8_MMA(ai, bj, At, Bt) do { __builtin_amdgcn_s_setprio(1); _Pragma("unroll") for (int m = 0; m < 4; ++m) _Pragma("unroll") for (int n = 0; n < 2; ++n) _Pragma("unroll") for (int k = 0; k < 2; ++k) \
        acc[ai][bj][m][n] = __builtin_amdgcn_mfma_f32_16x16x32_bf16(Bt[n][k], At[m][k], acc[ai][bj][m][n], 0, 0, 0); __builtin_amdgcn_s_setprio(0); } while (0)
#define PG8_WAIT_V(n) asm volatile("s_waitcnt vmcnt(" #n ")" ::: "memory")
#define PG8_WAIT_L(n) asm volatile("s_waitcnt lgkmcnt(" #n ")" ::: "memory")
#define PG8_BAR __builtin_amdgcn_s_barrier()
#define PG8_SCHED __builtin_amdgcn_sched_barrier(0)
    Unit cur, nxt; int ui = 0;
    if (!S.next(0, cur)) return;
    f32x4 acc[2][2][4][2];
#pragma unroll
    for (int a = 0; a < 2; ++a)
#pragma unroll
        for (int b = 0; b < 2; ++b)
#pragma unroll
            for (int m = 0; m < 4; ++m)
#pragma unroll
                for (int n = 0; n < 2; ++n) acc[a][b][m][n] = (f32x4){0.f, 0.f, 0.f, 0.f};
    bf16x8 At[4][2], B0[2][2], B1[2][2];
    const char* cA = (const char*)S.aptr(cur); const char* cB = (const char*)S.bptr(cur);
    PG8_STAGE(PG8_SB(0, 0), cB, voffB); PG8_STAGE(PG8_SA(0, 0), cA, voffA); PG8_STAGE(PG8_SB(0, 1), cB + hstep, voffB); PG8_STAGE(PG8_SA(0, 1), cA + hstep, voffA);
    if (wr == 1) PG8_BAR;
    PG8_WAIT_V(4); PG8_BAR;
    PG8_STAGE(PG8_SB(1, 0), cB + kstep, voffB); PG8_STAGE(PG8_SA(1, 0), cA + kstep, voffA); PG8_STAGE(PG8_SB(1, 1), cB + hstep + kstep, voffB);
    PG8_WAIT_V(6); PG8_BAR;
    for (;;) {
        const bool has_next = S.next(ui + 1, nxt);
        const char* nA = has_next ? (const char*)S.aptr(nxt) : cA; const char* nB = has_next ? (const char*)S.bptr(nxt) : cB;
        for (int t = 0; t < nt; t += 2) {
            const bool last = (t == nt - 2);
            const char* a1 = cA + (size_t)(t + 1) * kstep;
            const char* a2 = last ? nA : cA + (size_t)(t + 2) * kstep; const char* b2 = last ? nB : cB + (size_t)(t + 2) * kstep;
            const char* a3 = a2 + kstep; const char* b3 = b2 + kstep;
            PG8_LDB(B0, 0, 0); PG8_SCHED; PG8_LDA(At, 0, 0); PG8_STAGE(PG8_SA(1, 1), a1 + hstep, voffA);
            PG8_WAIT_L(8); PG8_BAR; PG8_WAIT_L(0); PG8_MMA(0, 0, At, B0); PG8_BAR; PG8_SCHED;
            PG8_LDB(B1, 0, 1); PG8_STAGE(PG8_SB(0, 0), b2, voffB);
            PG8_BAR; PG8_WAIT_L(0); PG8_MMA(0, 1, At, B1); PG8_BAR;
            PG8_LDA(At, 0, 1); PG8_STAGE(PG8_SA(0, 0), a2, voffA);
            PG8_BAR; PG8_WAIT_L(0); PG8_MMA(1, 0, At, B0); PG8_BAR; PG8_SCHED;
            PG8_STAGE(PG8_SB(0, 1), b2 + hstep, voffB);
            PG8_WAIT_V(6); PG8_BAR; PG8_MMA(1, 1, At, B1); PG8_BAR;
            PG8_LDB(B0, 1, 0); PG8_SCHED; PG8_LDA(At, 1, 0); PG8_STAGE(PG8_SA(0, 1), a2 + hstep, voffA);
            PG8_WAIT_L(8); PG8_BAR; PG8_WAIT_L(0); PG8_MMA(0, 0, At, B0); PG8_BAR; PG8_SCHED;
            PG8_LDB(B1, 1, 1); PG8_STAGE(PG8_SB(1, 0), b3, voffB);
            PG8_BAR; PG8_WAIT_L(0); PG8_MMA(0, 1, At, B1); PG8_BAR;
            PG8_LDA(At, 1, 1); PG8_STAGE(PG8_SA(1, 0), a3, voffA);
            PG8_BAR; PG8_WAIT_L(0); PG8_MMA(1, 0, At, B0); PG8_BAR; PG8_SCHED;
            PG8_STAGE(PG8_SB(1, 1), b3 + hstep, voffB);
            PG8_WAIT_V(6); PG8_BAR; PG8_MMA(1, 1, At, B1); PG8_BAR;
        }
#pragma unroll
        for (int ai = 0; ai < 2; ++ai)
#pragma unroll
            for (int m = 0; m < 4; ++m) {
                const int r = ai * HALF + wr * 64 + m * 16 + fr;
                if constexpr (Epi::PAIR) {
                    const float g[8] = {acc[ai][0][m][0][0], acc[ai][0][m][0][1], acc[ai][0][m][0][2], acc[ai][0][m][0][3], acc[ai][0][m][1][0], acc[ai][0][m][1][1], acc[ai][0][m][1][2], acc[ai][0][m][1][3]};
                    const float up[8] = {acc[ai][1][m][0][0], acc[ai][1][m][0][1], acc[ai][1][m][0][2], acc[ai][1][m][0][3], acc[ai][1][m][1][0], acc[ai][1][m][1][1], acc[ai][1][m][1][2], acc[ai][1][m][1][3]};
                    E.row8p(cur, r, wc * 32 + 8 * fq, g, up);
                } else {
#pragma unroll
                    for (int bj = 0; bj < 2; ++bj) {
                        const float v[8] = {acc[ai][bj][m][0][0], acc[ai][bj][m][0][1], acc[ai][bj][m][0][2], acc[ai][bj][m][0][3], acc[ai][bj][m][1][0], acc[ai][bj][m][1][1], acc[ai][bj][m][1][2], acc[ai][bj][m][1][3]};
                        E.row8(cur, r, bj * HALF + wc * 32 + 8 * fq, v);
                    }
                }
            }
        if (!has_next) break;
#pragma unroll
        for (int a = 0; a < 2; ++a)
#pragma unroll
            for (int b = 0; b < 2; ++b)
#pragma unroll
                for (int m = 0; m < 4; ++m)
#pragma unroll
                    for (int n = 0; n < 2; ++n) acc[a][b][m][n] = (f32x4){0.f, 0.f, 0.f, 0.f};
        cur = nxt; cA = nA; cB = nB; ++ui;
    }
    PG8_WAIT_V(0);
    if (wr == 0) PG8_BAR;
    PG8_BAR;
#undef PG8_SA
#undef PG8_SB
#undef PG8_STAGE
#undef PG8_LDA
#undef PG8_LDB
#undef PG8_MMA
#undef PG8_WAIT_V
#undef PG8_WAIT_L
#undef PG8_BAR
#undef PG8_SCHED
}

template <class Sched, class Epi>
DI void gemm_naive(LAS unsigned char* lds, int tid, const Sched& S, const Epi& E) {
    LAS float* As = (LAS float*)lds;
    LAS float* Bs = As + 32 * 132;
    LAS float* Bu = Bs + 32 * 132;
    const int ty = tid >> 4, tx = tid & 15, lr = tid >> 2, kq = tid & 3;
    Unit u;
    for (int i = 0; S.next(i, u); ++i) {
        const bf16* A = S.aptr(u); const bf16* B = S.bptr(u);
        for (int sm = 0; sm < 2; ++sm)
            for (int sn = 0; sn < (Epi::PAIR ? 1 : 2); ++sn) {
                float acc[4][8], accu[4][8];
#pragma unroll
                for (int a = 0; a < 4; ++a)
#pragma unroll
                    for (int b = 0; b < 8; ++b) { acc[a][b] = 0.f; accu[a][b] = 0.f; }
                for (int k0 = 0; k0 < 1024; k0 += 32) {
                    __syncthreads();
                    { float w[8]; unpack8(*(const u32x4*)(A + (size_t)(128 * sm + lr) * 1024 + k0 + 8 * kq), w);
#pragma unroll
                      for (int j = 0; j < 8; ++j) As[(8 * kq + j) * 132 + lr] = w[j];
                      unpack8(*(const u32x4*)(B + (size_t)(128 * sn + lr) * 1024 + k0 + 8 * kq), w);
#pragma unroll
                      for (int j = 0; j < 8; ++j) Bs[(8 * kq + j) * 132 + lr] = w[j];
                      if (Epi::PAIR) { unpack8(*(const u32x4*)(B + (size_t)(128 + lr) * 1024 + k0 + 8 * kq), w);
#pragma unroll
                          for (int j = 0; j < 8; ++j) Bu[(8 * kq + j) * 132 + lr] = w[j]; } }
                    __syncthreads();
#pragma unroll 4
                    for (int k = 0; k < 32; ++k) {
                        const f32x4 a4 = *(const LAS f32x4*)(As + k * 132 + 4 * ty);
                        const f32x4 b0 = *(const LAS f32x4*)(Bs + k * 132 + 8 * tx), b1 = *(const LAS f32x4*)(Bs + k * 132 + 8 * tx + 4);
#pragma unroll
                        for (int a = 0; a < 4; ++a) {
#pragma unroll
                            for (int b = 0; b < 4; ++b) { acc[a][b] += a4[a] * b0[b]; acc[a][4 + b] += a4[a] * b1[b]; } }
                        if (Epi::PAIR) {
                            const f32x4 c0 = *(const LAS f32x4*)(Bu + k * 132 + 8 * tx), c1 = *(const LAS f32x4*)(Bu + k * 132 + 8 * tx + 4);
#pragma unroll
                            for (int a = 0; a < 4; ++a) {
#pragma unroll
                                for (int b = 0; b < 4; ++b) { accu[a][b] += a4[a] * c0[b]; accu[a][4 + b] += a4[a] * c1[b]; } }
                        }
                    }
                }
#pragma unroll
                for (int a = 0; a < 4; ++a) {
                    if constexpr (Epi::PAIR) E.row8p(u, 128 * sm + 4 * ty + a, 8 * tx, acc[a], accu[a]);
                    else E.row8(u, 128 * sm + 4 * ty + a, 128 * sn + 8 * tx, acc[a]);
                }
            }
    }
    __syncthreads();
}
template <class Sched, class Epi>
DI void gemm_run(LAS unsigned char* lds, int tid, const Sched& S, const Epi& E) {
#if FAST_GEMM
    gemm_fast(lds, tid, S, E);
#else
    gemm_naive(lds, tid, S, E);
#endif
}

struct Ctx {
    LAS unsigned char* lds;
    int tid, lane, wave, gw, ngw;
    const float* const* in;
    float* out;
    unsigned char* ws;
};
#define WSP(T, off) ((T*)(c.ws + (off)))

DI void transpose_item(const float* W, int N, bf16* WT, int k0, int n0, int dst_row0, LAS float* scr, int lane) {
#pragma unroll 8
    for (int i = 0; i < 32; ++i) { const int kk = 2 * i + (lane >> 5); scr[kk * 33 + (lane & 31)] = W[(size_t)(k0 + kk) * N + n0 + (lane & 31)]; }
    asm volatile("s_waitcnt lgkmcnt(0)" ::: "memory");
    const int cc = lane & 7;
#pragma unroll
    for (int j = 0; j < 4; ++j) { const int n = (lane >> 3) + 8 * j; const LAS float* s = scr + (8 * cc) * 33 + n;
        u32x4 o; o.x = cvt_pk_bf16(s[0 * 33], s[1 * 33]); o.y = cvt_pk_bf16(s[2 * 33], s[3 * 33]); o.z = cvt_pk_bf16(s[4 * 33], s[5 * 33]); o.w = cvt_pk_bf16(s[6 * 33], s[7 * 33]);
        *(u32x4*)(WT + (size_t)(dst_row0 + n) * 1024 + k0 + 8 * cc) = o; }
    asm volatile("s_waitcnt lgkmcnt(0)" ::: "memory");
}
DI void dense_transpose(const Ctx& c, const float* W, int N, bf16* WT, LAS float* scr) {
    const int nblk = N / 32, nitems = 16 * nblk;
    for (int it = c.gw; it < nitems; it += c.ngw) { const int kb = it / nblk, nb = it % nblk; transpose_item(W, N, WT, 64 * kb, 32 * nb, 32 * nb, scr, c.lane); }
}
DI void phase_pro0(const Ctx& c) {
    LAS float* scr = (LAS float*)(c.lds + c.wave * 8704);
    for (int j = 0; j < 2; ++j) {
        dense_transpose(c, c.in[I_MLWIN] + (size_t)j * 1024 * 3104, 3104, WSP(bf16, WS_ML_WIN) + (size_t)j * NINP * 1024, scr);
        dense_transpose(c, c.in[I_MLWOUT] + (size_t)j * 1024 * 1024, 1024, WSP(bf16, WS_ML_WOUT) + (size_t)j * 1024 * 1024, scr);
    }
    dense_transpose(c, c.in[I_GLWIN], 3104, WSP(bf16, WS_GLA_WIN), scr);
    dense_transpose(c, c.in[I_GLWOUT], 1024, WSP(bf16, WS_GLA_WOUT), scr);
    dense_transpose(c, c.in[I_HYWIN], 3072, WSP(bf16, WS_HY_WIN), scr);
    dense_transpose(c, c.in[I_HYWOUT], 1024, WSP(bf16, WS_HY_WOUT), scr);
    for (int it = c.gw * 64 + c.lane; it < 3 * 28672; it += c.ngw * 64) {
        const int m = it / 28672, r = it % 28672; bf16* base = (m < 2) ? WSP(bf16, WS_ML_WIN) + (size_t)m * NINP * 1024 : WSP(bf16, WS_GLA_WIN);
        *(u32x4*)(base + (size_t)3104 * 1024 + (size_t)r * 8) = (u32x4){0u, 0u, 0u, 0u};
    }
    for (int it = c.gw; it < 64 * 3 * 512; it += c.ngw) {
        const int le = it / 1536, r0 = it % 1536, which = r0 / 512, r = r0 % 512, kb = r / 32, nb = r % 32;
        if (which < 2) {
            const float* W = c.in[which == 0 ? I_EW1 : I_EW3] + (size_t)le * 1024 * 1024;
            const int n0 = 32 * nb, drow = 256 * (n0 >> 7) + (n0 & 127) + (which ? 128 : 0);
            transpose_item(W, 1024, WSP(bf16, WS_EXP_UP) + (size_t)le * 2048 * 1024, 64 * kb, n0, drow, scr, c.lane);
        } else {
            transpose_item(c.in[I_EW2] + (size_t)le * 1024 * 1024, 1024, WSP(bf16, WS_EXP_DN) + (size_t)le * 1024 * 1024, 64 * kb, 32 * nb, 32 * nb, scr, c.lane);
        }
    }
    {
        const float* w1 = c.in[I_HYFW1]; const float* b1 = c.in[I_HYFB1]; const float* wm = c.in[I_HYFWM]; const float* bm = c.in[I_HYFBM]; const float* fr = c.in[I_HYFREQ];
        float* HM = WSP(float, WS_HM);
        for (int row = c.gw; row < 2304; row += c.ngw) {
            const int L = row < 2048 ? 2048 : 256, t = row < 2048 ? row : row - 2048, f = c.lane;
            float feat = 0.f;
            if (f == 0) feat = (float)t / (float)(L - 1);
            else if (f <= 32) { const int b = (f - 1) & 15; const float band = 1e-4f + (float)b * ((15.0f - 1e-4f) / 15.0f);
                const float ang = ((float)(2.0 * 3.14159265358979323846 / (double)L) * (float)t) * band; feat = (f <= 16) ? cosf(ang) : -sinf(ang); }
            float a = b1[f];
            for (int e = 0; e < 33; ++e) a += __shfl(feat, e) * w1[e * 64 + f];
            float h = sinf(fr[f] * a);
            for (int m = 0; m < 2; ++m) {
                float a2 = bm[m * 64 + f];
                for (int g = 0; g < 64; ++g) a2 += __shfl(h, g) * wm[m * 4096 + g * 64 + f];
                h = sinf(fr[f] * a2);
            }
            HM[row * 64 + f] = h;
        }
    }
    __syncthreads();
    {
        LAS float* sv = (LAS float*)c.lds;
        LAS float* red = sv + 9 * 1024;
        for (int i = c.tid; i < 9 * 1024; i += 512) { const float x = (i < 8192) ? c.in[I_C][i] : c.in[I_CCTX][i - 8192]; sv[i] = siluf_(x); }
        __syncthreads();
        float* MOD = WSP(float, WS_MOD);
        const int col = c.tid & 63, kg = c.tid >> 6;
        for (int item = blockIdx.x; item < 4 * 96; item += gridDim.x) {
            const int l = item / 96, j0 = 64 * (item % 96);
            const float* w = c.in[I_ADAW] + (size_t)l * 1024 * 6144 + j0 + col;
            float acc[9];
#pragma unroll
            for (int r = 0; r < 9; ++r) acc[r] = 0.f;
            for (int k = kg * 128; k < kg * 128 + 128; ++k) { const float wv = w[(size_t)k * 6144];
#pragma unroll
                for (int r = 0; r < 9; ++r) acc[r] += sv[r * 1024 + k] * wv; }
#pragma unroll
            for (int r = 0; r < 9; ++r) red[(kg * 9 + r) * 64 + col] = acc[r];
            __syncthreads();
            for (int o = c.tid; o < 9 * 64; o += 512) { const int r = o >> 6, cc = o & 63; float s = c.in[I_ADAB][l * 6144 + j0 + cc];
#pragma unroll
                for (int g = 0; g < 8; ++g) s += red[(g * 9 + r) * 64 + cc];
                MOD[(l * 9 + r) * 6144 + j0 + cc] = s; }
            __syncthreads();
        }
    }
}

DI void phase_pro1(const Ctx& c) {
    LAS float* wo = (LAS float*)c.lds;
    LAS float* red = wo + 2048;
    const float* HM = WSP(float, WS_HM);
    const int ch = c.tid & 15, tg = c.tid >> 4;
    for (int item = blockIdx.x; item < 128; item += gridDim.x) {
        const int lsel = item >> 6, c0 = 16 * (item & 63), L = lsel ? 256 : 2048;
        const float* hm = lsel ? HM + 2048 * 64 : HM; float* tab = lsel ? WSP(float, WS_HFC) : WSP(float, WS_HF);
        __syncthreads();
        for (int i = c.tid; i < 2048; i += 512) { const int side = i >> 10, f = (i >> 4) & 63, cc = i & 15; wo[i] = c.in[I_HYFWO][f * 2048 + side * 1024 + c0 + cc]; }
        __syncthreads();
        const int cg_ = c0 + ch;
        const float da = -4.605170185988091f / 1.5f, db = -4.605170185988091f / 0.3f;
        const float delta = fabsf(da + (float)cg_ * ((db - da) / 1023.0f));
        float* trow = tab + (size_t)cg_ * (2 * L);
        float part = 0.f;
        for (int t = tg; t < L; t += 32) {
            float af = 0.f, ab = 0.f;
            for (int f = 0; f < 64; ++f) { const float h = hm[t * 64 + f]; af += h * wo[f * 16 + ch]; ab += h * wo[1024 + f * 16 + ch]; }
            const float dec = expf(-((float)t / (float)(L - 1)) * delta); af *= dec; ab *= dec;
            trow[L + t] = af; part += fabsf(af);
            if (t >= 1) { trow[L - t] = ab; part += fabsf(ab); }
        }
        red[tg * 16 + ch] = part;
        __syncthreads();
        float l1 = 0.f;
        for (int g = 0; g < 32; ++g) l1 += red[g * 16 + ch];
        const float inv = 1.0f / l1;
        for (int t = tg; t < L; t += 32) { trow[L + t] *= inv; if (t >= 1) trow[L - t] *= inv; }
        if (tg == 0) trow[0] = 0.f;
    }
}

DI void load_row(const float* src, f32x4 (&v)[4], int lane) {
#pragma unroll
    for (int j = 0; j < 4; ++j) v[j] = *(const f32x4*)(src + 256 * j + 4 * lane);
}
DI void norm_row(f32x4 (&v)[4], const float* g, int lane) {
    float s = 0.f;
#pragma unroll
    for (int j = 0; j < 4; ++j) s += (v[j].x * v[j].x + v[j].y * v[j].y) + (v[j].z * v[j].z + v[j].w * v[j].w);
    s = wave_sum(s);
    const float r = 1.0f / sqrtf(s * (1.0f / 1024.0f) + EPS);
#pragma unroll
    for (int j = 0; j < 4; ++j) v[j] = v[j] * r * *(const f32x4*)(g + 256 * j + 4 * lane);
}
DI void mod_row(f32x4 (&v)[4], const float* sh, const float* sc, int lane) {
#pragma unroll
    for (int j = 0; j < 4; ++j) v[j] = v[j] * (*(const f32x4*)(sc + 256 * j + 4 * lane) + 1.0f) + *(const f32x4*)(sh + 256 * j + 4 * lane);
}
DI void store_row_bf16(bf16* dst, const f32x4 (&v)[4], int lane) {
#pragma unroll
    for (int j = 0; j < 4; ++j) { u32x2 w; w.x = cvt_pk_bf16(v[j].x, v[j].y); w.y = cvt_pk_bf16(v[j].z, v[j].w); *(u32x2*)(dst + 256 * j + 4 * lane) = w; }
}
DI int hrow_of(int srow, int kind) {
    if (srow < TC || kind != 1) return srow;
    const int rr = srow - TC, b = rr >> 11, s = rr & (SEQ - 1); return TC + b * SEQ + perm_fwd(s);
}
DI void phase_norm1(const Ctx& c, int l, const float* xl, const float* xc) {
    const float* MOD = WSP(float, WS_MOD) + (size_t)l * 9 * 6144; const float* g = c.in[I_N1G] + l * D; bf16* H = WSP(bf16, WS_H);
    for (int row = c.gw; row < TT; row += c.ngw) {
        f32x4 v[4]; const int mr = row < TC ? 8 : (row - TC) >> 11;
        load_row(row < TC ? xc + (size_t)row * D : xl + (size_t)(row - TC) * D, v, c.lane);
        norm_row(v, g, c.lane); mod_row(v, MOD + mr * 6144, MOD + mr * 6144 + 1024, c.lane);
        store_row_bf16(H + (size_t)hrow_of(row, l % 3) * D, v, c.lane);
    }
}

DI void phase_conv(const Ctx& c, int ncols, const float* cw, const float* cb, bool act, float qs) {
    const bf16* P = WSP(bf16, WS_P); bf16* PC = WSP(bf16, WS_BIG + BIG_PC);
    const int ng = ncols / 8; const long total = (long)TT * ng;
    for (long idx = (long)blockIdx.x * 512 + c.tid; idx < total; idx += (long)gridDim.x * 512) {
        const int row = (int)(idx / ng), col = (int)(idx % ng) * 8; int lo, hi; seq_bounds(row, lo, hi);
        float x0[8], xm[8], xp[8];
        unpack8(*(const u32x4*)(P + (size_t)row * PLD + col), x0);
        if (row > lo) unpack8(*(const u32x4*)(P + (size_t)(row - 1) * PLD + col), xm); else {
#pragma unroll
            for (int j = 0; j < 8; ++j) xm[j] = 0.f; }
        if (row < hi) unpack8(*(const u32x4*)(P + (size_t)(row + 1) * PLD + col), xp); else {
#pragma unroll
            for (int j = 0; j < 8; ++j) xp[j] = 0.f; }
        float o[8];
#pragma unroll
        for (int j = 0; j < 8; ++j) { float v = cw[col + j] * xm[j] + cw[ncols + col + j] * x0[j] + cw[2 * ncols + col + j] * xp[j] + cb[col + j];
            if (act) v = siluf_(v); if (col < 512) v *= qs; o[j] = v; }
        *(u32x4*)(PC + (size_t)row * ncols + col) = pack8(o);
    }
}

DI int scan_row(int step, int b, int dir) {
    if (step < CTX) return b * CTX + (dir ? CTX - 1 - step : step);
    const int s = step - CTX; return TC + b * SEQ + (dir ? SEQ - 1 - s : s);
}
DI void phase_mlstm_scan_naive(const Ctx& c) {
    const bf16* P = WSP(bf16, WS_P); const bf16* PC = WSP(bf16, WS_BIG + BIG_PC); const float* EX = WSP(float, WS_EXTRA);
    LAS float* qs = (LAS float*)c.lds; LAS float* ks = qs + 32 * 64; LAS float* vs = ks + 32 * 64; LAS float* gs = vs + 32 * 128;
    const int v = c.tid >> 2, d0 = (c.tid & 3) * 16;
    for (int item = blockIdx.x; item < 128; item += gridDim.x) {
        const int b = item >> 4, h = (item >> 1) & 7, dir = item & 1;
        float* Yo = WSP(float, WS_BIG + (dir ? BIG_YB : BIG_YF));
        float C[16], n[16];
#pragma unroll
        for (int d = 0; d < 16; ++d) { C[d] = 0.f; n[d] = 0.f; }
        for (int ch = 0; ch < (CTX + SEQ) / 32; ++ch) {
            __syncthreads();
            for (int idx = c.tid; idx < 32 * 256; idx += 512) { const int st = idx >> 8, col = idx & 255, row = scan_row(ch * 32 + st, b, dir);
                if (col < 64) qs[st * 64 + col] = bf2f(PC[(size_t)row * 1024 + h * 64 + col]);
                else if (col < 128) ks[st * 64 + col - 64] = bf2f(PC[(size_t)row * 1024 + 512 + h * 64 + col - 64]);
                else vs[st * 128 + col - 128] = bf2f(P[(size_t)row * PLD + 1024 + h * 128 + col - 128]); }
            if (c.tid < 32) { const int row = scan_row(ch * 32 + c.tid, b, dir); gs[c.tid * 2] = sigmoidf_(EX[(size_t)row * 32 + dir * 16 + 8 + h]); gs[c.tid * 2 + 1] = __expf(EX[(size_t)row * 32 + dir * 16 + h]); }
            __syncthreads();
            for (int st = 0; st < 32; ++st) {
                const float f = gs[st * 2], ei = gs[st * 2 + 1], vv = vs[st * 128 + v] * ei;
                float part = 0.f, dpart = 0.f;
#pragma unroll
                for (int d = 0; d < 16; ++d) { const float kd = ks[st * 64 + d0 + d], qd = qs[st * 64 + d0 + d];
                    C[d] = f * C[d] + kd * vv; part += qd * C[d]; n[d] = f * n[d] + ei * kd; dpart += qd * n[d]; }
                part += __shfl_xor(part, 1); part += __shfl_xor(part, 2); dpart += __shfl_xor(dpart, 1); dpart += __shfl_xor(dpart, 2);
                if ((c.tid & 3) == 0) { const int row = scan_row(ch * 32 + st, b, dir); Yo[(size_t)row * D + h * 128 + v] = part / fmaxf(fabsf(dpart), 1.0f); }
            }
        }
    }
}
typedef short s16x4 __attribute__((ext_vector_type(4)));
typedef float f32x16 __attribute__((ext_vector_type(16)));
#define MFMA32(a, b, c) __builtin_amdgcn_mfma_f32_32x32x16_bf16((a), (b), (c), 0, 0, 0)
DI int crow(int reg, int h) { return (reg & 3) + 8 * (reg >> 2) + 4 * h; }
DI s16x4 ds_tr(const LAS unsigned char* p) { return __builtin_amdgcn_ds_read_tr16_b64_v4i16((LAS s16x4*)p); }
DI bf16x8 cat8(s16x4 lo, s16x4 hi) { return __builtin_shufflevector(lo, hi, 0, 1, 2, 3, 4, 5, 6, 7); }
DI bf16x8 tr_frag(const LAS unsigned char* img, int pitch, int k0, int n0, int lane) {
    const int h = lane >> 5, g16 = (lane >> 4) & 1, i = lane & 15;
    const LAS unsigned char* p = img + (k0 + 8 * h + (i >> 2)) * pitch + (n0 + 16 * g16 + 4 * (i & 3)) * 2;
    return cat8(ds_tr(p), ds_tr(p + 4 * pitch));
}
DI bf16x8 tr_frag_perm(const LAS unsigned char* img, int pitch, int k0, int n0, int lane) {
    const int h = lane >> 5, g16 = (lane >> 4) & 1, i = lane & 15;
    const LAS unsigned char* p = img + (k0 + 4 * h + (i >> 2)) * pitch + (n0 + 16 * g16 + 4 * (i & 3)) * 2;
    return cat8(ds_tr(p), ds_tr(p + 8 * pitch));
}
DI bf16x8 row_frag(const LAS unsigned char* img, int pitch, int row0, int k0, int lane) { return *(const LAS bf16x8*)(img + (row0 + (lane & 31)) * pitch + (k0 + 8 * (lane >> 5)) * 2); }
DI bf16x8 pack_acc(const f32x16& x, int step) {
    u32x4 p; const int o = 8 * step;
    p.x = cvt_pk_bf16(x[o], x[o + 1]); p.y = cvt_pk_bf16(x[o + 2], x[o + 3]); p.z = cvt_pk_bf16(x[o + 4], x[o + 5]); p.w = cvt_pk_bf16(x[o + 6], x[o + 7]);
    return __builtin_bit_cast(bf16x8, p);
}
DI f32x16 zero16() { f32x16 z;
#pragma unroll
    for (int i = 0; i < 16; ++i) z[i] = 0.f; return z; }
DI float wave_incl_prefix(float x, int lane) {
#pragma unroll
    for (int o = 1; o < 64; o <<= 1) { const float t = __shfl_up(x, o); if (lane >= o) x += t; }
    return x;
}
DI float wave_incl_suffix(float x, int lane) {
#pragma unroll
    for (int o = 1; o < 64; o <<= 1) { const float t = __shfl_down(x, o); if (lane + o < 64) x += t; }
    return x;
}
DI int chunk_row0(int p, int b, int dir) {
    if (p < 4) return b * CTX + 64 * (dir ? 3 - p : p);
    return TC + b * SEQ + 64 * (dir ? 35 - p : p - 4);
}

DI void phase_mlstm_state(const Ctx& c) {
    const bf16* P = WSP(bf16, WS_P); const bf16* PC = WSP(bf16, WS_BIG + BIG_PC); const float* EX = WSP(float, WS_EXTRA);
    bf16* MCT = WSP(bf16, WS_BIG + BIG_MCT); float* MN = WSP(float, WS_BIG + BIG_MN);
    LAS float* gi = (LAS float*)c.lds; LAS float* ga = gi + 2304; LAS float* wv = ga + 2304; LAS float* dec = wv + 64;
    LAS unsigned char* Kw = c.lds + 20480; LAS unsigned char* Vs = Kw + 64 * 144;
    const int lane = c.lane, wave = c.wave, h5 = lane >> 5, l31 = lane & 31;
    for (int item = blockIdx.x; item < 256; item += gridDim.x) {
        const int b = item >> 5, h = (item >> 2) & 7, dir = (item >> 1) & 1, dvh = item & 1, seq = (b * 8 + h) * 2 + dir;
        __syncthreads();
        for (int idx = c.tid; idx < 2304; idx += 512) { const int row = chunk_row0(idx >> 6, b, dir) + (idx & 63);
            gi[idx] = EX[(size_t)row * 32 + dir * 16 + h]; ga[idx] = logsigf_(EX[(size_t)row * 32 + dir * 16 + 8 + h]); }
        f32x16 acc = zero16(); float nst = 0.f;
        const int dt = wave & 1, vt = (wave >> 1) & 1;
        const int srow = c.tid >> 3, spc = c.tid & 7;
        u32x4 kreg, vreg;
        { const int r0 = chunk_row0(0, b, dir);
          kreg = *(const u32x4*)(PC + (size_t)(r0 + srow) * 1024 + 512 + h * 64 + 8 * spc);
          vreg = *(const u32x4*)(P + (size_t)(r0 + srow) * PLD + 1024 + h * 128 + dvh * 64 + 8 * spc); }
        __syncthreads();
        for (int p = 0; p < 36; ++p) {
            if (wave < 4) {
                bf16* dst = MCT + ((size_t)seq * 36 + p) * 8192 + (size_t)(dvh * 64 + 32 * vt + l31) * 64 + 32 * dt + 4 * h5;
#pragma unroll
                for (int q = 0; q < 4; ++q) { u32x2 w; w.x = cvt_pk_bf16(acc[4 * q], acc[4 * q + 1]); w.y = cvt_pk_bf16(acc[4 * q + 2], acc[4 * q + 3]); *(u32x2*)(dst + 8 * q) = w; }
            } else if (wave == 4) { if (dvh == 0) MN[((size_t)seq * 36 + p) * 64 + lane] = nst; }
            else if (wave == 7) {
                const float a = ga[p * 64 + lane]; const float bj = dir ? wave_incl_suffix(a, lane) : wave_incl_prefix(a, lane);
                const float tot = __shfl(bj, dir ? 0 : 63);
                wv[lane] = __expf(tot - bj + gi[p * 64 + lane]); if (lane == 0) dec[0] = __expf(tot);
            }
            __syncthreads();
            { float kk[8]; unpack8(kreg, kk); const float w = wv[srow];
#pragma unroll
              for (int j = 0; j < 8; ++j) kk[j] *= w;
              *(LAS u32x4*)(Kw + srow * 144 + spc * 16) = pack8(kk); *(LAS u32x4*)(Vs + srow * 144 + spc * 16) = vreg; }
            if (p + 1 < 36) { const int r0 = chunk_row0(p + 1, b, dir);
                kreg = *(const u32x4*)(PC + (size_t)(r0 + srow) * 1024 + 512 + h * 64 + 8 * spc);
                vreg = *(const u32x4*)(P + (size_t)(r0 + srow) * PLD + 1024 + h * 128 + dvh * 64 + 8 * spc); }
            const float d = dec[0];
            __syncthreads();
            if (wave < 4) {
#pragma unroll
                for (int i = 0; i < 16; ++i) acc[i] *= d;
#pragma unroll
                for (int kk = 0; kk < 4; ++kk) acc = MFMA32(tr_frag(Kw, 144, 16 * kk, 32 * dt, lane), tr_frag(Vs, 144, 16 * kk, 32 * vt, lane), acc);
            } else if (wave == 4) {
                float s = 0.f;
                for (int r = 0; r < 64; ++r) s += bf2f(*(const LAS bf16*)(Kw + r * 144 + lane * 2));
                nst = d * nst + s;
            }
        }
    }
}

DI void phase_mlstm_out(const Ctx& c, const float* ng) {
    const bf16* P = WSP(bf16, WS_P); const bf16* PC = WSP(bf16, WS_BIG + BIG_PC); const float* EX = WSP(float, WS_EXTRA);
    const bf16* MCT = WSP(bf16, WS_BIG + BIG_MCT); const float* MN = WSP(float, WS_BIG + BIG_MN); bf16* Y = WSP(bf16, WS_Y);
    LAS unsigned char* Qs = c.lds; LAS unsigned char* Ks = Qs + 9216; LAS unsigned char* Vs = Ks + 9216;
    LAS unsigned char* CT0 = Vs + 17408;
    LAS float* gt = (LAS float*)(c.lds + MISC_OFF + 1024);
    LAS float* YO = (LAS float*)c.lds;
    const int lane = c.lane, wave = c.wave, h5 = lane >> 5, l31 = lane & 31;
    const int dir = wave >> 2, jt = (wave >> 1) & 1, vh = wave & 1;
    for (int item = blockIdx.x; item < 2304; item += gridDim.x) {
        const int b = item / 288, h = (item / 36) & 7, cc = item % 36;
        const int r0 = cc < 4 ? b * CTX + 64 * cc : TC + b * SEQ + 64 * (cc - 4);
        const int pf = cc, pb = cc < 4 ? 3 - cc : 39 - cc;
        __syncthreads();
        { const int srow = c.tid >> 3, spc = c.tid & 7;
          *(LAS u32x4*)(Qs + srow * 144 + spc * 16) = *(const u32x4*)(PC + (size_t)(r0 + srow) * 1024 + h * 64 + 8 * spc);
          *(LAS u32x4*)(Ks + srow * 144 + spc * 16) = *(const u32x4*)(PC + (size_t)(r0 + srow) * 1024 + 512 + h * 64 + 8 * spc);
#pragma unroll
          for (int i = 0; i < 2; ++i) *(LAS u32x4*)(Vs + srow * 272 + (spc + 8 * i) * 16) = *(const u32x4*)(P + (size_t)(r0 + srow) * PLD + 1024 + h * 128 + 8 * (spc + 8 * i));
#pragma unroll
          for (int i = 0; i < 4; ++i) { const int pc = c.tid + 512 * i, d2 = pc >> 10, rr = (pc >> 3) & 127, sp = pc & 7;
              const size_t so = (((size_t)((b * 8 + h) * 2 + d2)) * 36 + (d2 ? pb : pf)) * 8192;
              *(LAS u32x4*)(CT0 + d2 * 18432 + rr * 144 + sp * 16) = *(const u32x4*)(MCT + so + rr * 64 + 8 * sp); }
          if (wave < 2) { const int d2 = wave; const int row = r0 + lane;
              const float a = logsigf_(EX[(size_t)row * 32 + d2 * 16 + 8 + h]), ig = EX[(size_t)row * 32 + d2 * 16 + h];
              const float bj = d2 ? wave_incl_suffix(a, lane) : wave_incl_prefix(a, lane);
              gt[d2 * 192 + lane] = bj; gt[d2 * 192 + 64 + lane] = ig - bj;
              gt[d2 * 192 + 128 + lane] = MN[(((size_t)((b * 8 + h) * 2 + d2)) * 36 + (d2 ? pb : pf)) * 64 + lane]; } }
        __syncthreads();
        const LAS float* g = gt + dir * 192; const LAS unsigned char* CT = CT0 + dir * 18432;
        const int j = 32 * jt + l31; const float bjj = g[j];
        bf16x8 qf[4];
#pragma unroll
        for (int kk = 0; kk < 4; ++kk) qf[kk] = row_frag(Qs, 144, 32 * jt, 16 * kk, lane);
        float qn = 0.f;
#pragma unroll
        for (int kk = 0; kk < 4; ++kk) { float qv[8]; unpack8(__builtin_bit_cast(u32x4, qf[kk]), qv);
#pragma unroll
            for (int e = 0; e < 8; ++e) qn += qv[e] * g[128 + 16 * kk + 8 * h5 + e]; }
        qn += __shfl_xor(qn, 32);
        f32x16 X[2]; float den = 0.f;
#pragma unroll
        for (int st = 0; st < 2; ++st) {
            X[st] = zero16();
            const bool live = dir ? (st >= jt) : (st <= jt);
            if (live) {
#pragma unroll
                for (int kk = 0; kk < 4; ++kk) X[st] = MFMA32(row_frag(Ks, 144, 32 * st, 16 * kk, lane), qf[kk], X[st]);
#pragma unroll
                for (int r = 0; r < 16; ++r) { const int s = 32 * st + crow(r, h5); const bool ok = dir ? (s >= j) : (s <= j);
                    const float w = ok ? __expf(bjj + g[64 + s]) : 0.f; X[st][r] *= w; den += X[st][r]; }
            }
        }
        den += __shfl_xor(den, 32);
        const float eb = __expf(bjj); den += eb * qn;
        const float scale = 1.0f / fmaxf(fabsf(den), 1.0f);
        f32x16 O[2];
#pragma unroll
        for (int t = 0; t < 2; ++t) {
            const int vt = 2 * vh + t; f32x16 z = zero16(), w = zero16();
#pragma unroll
            for (int st = 0; st < 2; ++st) { const bool live = dir ? (st >= jt) : (st <= jt);
                if (live) {
#pragma unroll
                    for (int step = 0; step < 2; ++step) z = MFMA32(tr_frag_perm(Vs, 272, 32 * st + 16 * step, 32 * vt, lane), pack_acc(X[st], step), z); } }
#pragma unroll
            for (int kk = 0; kk < 4; ++kk) w = MFMA32(row_frag(CT, 144, 32 * vt, 16 * kk, lane), qf[kk], w);
#pragma unroll
            for (int r = 0; r < 16; ++r) O[t][r] = (z[r] + eb * w[r]) * scale;
        }
        __syncthreads();
#pragma unroll
        for (int t = 0; t < 2; ++t) { const int vt = 2 * vh + t;
#pragma unroll
            for (int q = 0; q < 4; ++q) *(LAS f32x4*)(YO + dir * 8448 + j * 132 + 32 * vt + 8 * q + 4 * h5) = (f32x4){O[t][4 * q], O[t][4 * q + 1], O[t][4 * q + 2], O[t][4 * q + 3]}; }
        __syncthreads();
        { const int row = c.tid >> 3, c0 = (c.tid & 7) * 16; float y[16]; float ss = 0.f;
#pragma unroll
          for (int q = 0; q < 4; ++q) { const f32x4 a = *(const LAS f32x4*)(YO + row * 132 + c0 + 4 * q), bb = *(const LAS f32x4*)(YO + 8448 + row * 132 + c0 + 4 * q);
              y[4 * q] = a.x + bb.x; y[4 * q + 1] = a.y + bb.y; y[4 * q + 2] = a.z + bb.z; y[4 * q + 3] = a.w + bb.w; }
#pragma unroll
          for (int q = 0; q < 16; ++q) ss += y[q] * y[q];
          ss += __shfl_xor(ss, 1); ss += __shfl_xor(ss, 2); ss += __shfl_xor(ss, 4);
          const float r = 1.0f / sqrtf(ss * (1.0f / 128.0f) + EPS);
          float g0[8], g1[8];
          unpack8(*(const u32x4*)(P + (size_t)(r0 + row) * PLD + 2048 + h * 128 + c0), g0); unpack8(*(const u32x4*)(P + (size_t)(r0 + row) * PLD + 2048 + h * 128 + c0 + 8), g1);
          float o0[8], o1[8];
#pragma unroll
          for (int q = 0; q < 8; ++q) { o0[q] = y[q] * r * ng[h * 128 + c0 + q] * sigmoidf_(g0[q]); o1[q] = y[8 + q] * r * ng[h * 128 + c0 + 8 + q] * sigmoidf_(g1[q]); }
          *(u32x4*)(Y + (size_t)(r0 + row) * D + h * 128 + c0) = pack8(o0); *(u32x4*)(Y + (size_t)(r0 + row) * D + h * 128 + c0 + 8) = pack8(o1); }
    }
}

DI void gla_lg(const Ctx& c, const f32x4 (&low)[4], const LAS float* w2s, const LAS float* gbs, LAS float* lgs) {
    const int s = c.tid >> 3, d0 = 16 * (c.tid & 7);
    float pre[16];
#pragma unroll
    for (int e = 0; e < 16; ++e) pre[e] = gbs[d0 + e];
#pragma unroll
    for (int r = 0; r < 16; ++r) { const float lv = low[r >> 2][r & 3];
#pragma unroll
        for (int q = 0; q < 4; ++q) { const f32x4 w = *(const LAS f32x4*)(w2s + r * 128 + d0 + 4 * q); pre[4 * q] += lv * w.x; pre[4 * q + 1] += lv * w.y; pre[4 * q + 2] += lv * w.z; pre[4 * q + 3] += lv * w.w; } }
#pragma unroll
    for (int q = 0; q < 4; ++q) *(LAS f32x4*)(lgs + s * 128 + d0 + 4 * q) = (f32x4){logsigf_(pre[4 * q]) * 0.0625f, logsigf_(pre[4 * q + 1]) * 0.0625f, logsigf_(pre[4 * q + 2]) * 0.0625f, logsigf_(pre[4 * q + 3]) * 0.0625f};
}
DI void gla_scan(const Ctx& c, int dir, LAS float* lgs, LAS float* tot) {
    if (c.tid < 128) { float run = 0.f;
        if (dir == 0) { for (int s = 0; s < 64; ++s) { run += lgs[s * 128 + c.tid]; lgs[s * 128 + c.tid] = run; } }
        else { for (int s = 63; s >= 0; --s) { run += lgs[s * 128 + c.tid]; lgs[s * 128 + c.tid] = run; } }
        tot[c.tid] = run; }
}
DI void phase_gla_state(const Ctx& c) {
    const bf16* PC = WSP(bf16, WS_BIG + BIG_PC); const float* EX = WSP(float, WS_EXTRA); bf16* GST = WSP(bf16, WS_BIG + BIG_GST);
    LAS float* w2s = (LAS float*)c.lds; LAS float* gbs = w2s + 2048; LAS float* tot = gbs + 128; LAS float* lgs = tot + 128;
    LAS unsigned char* Kd = c.lds + 45056; LAS unsigned char* Vs = Kd + 64 * 272;
    const int lane = c.lane, wave = c.wave, h5 = lane >> 5, l31 = lane & 31, dkt = wave & 3, dvt = wave >> 2;
    const int srow = c.tid >> 3, dg = c.tid & 7;
    for (int item = blockIdx.x; item < 256; item += gridDim.x) {
        const int b = item >> 5, h = (item >> 3) & 3, dir = (item >> 2) & 1, dvq = item & 3, seq = (b * 4 + h) * 2 + dir;
        __syncthreads();
        for (int i = c.tid; i < 2048; i += 512) w2s[i] = c.in[I_GLW2][(size_t)dir * 8192 + (i >> 7) * 512 + h * 128 + (i & 127)];
        if (c.tid < 128) gbs[c.tid] = c.in[I_GLGB][dir * 512 + h * 128 + c.tid];
        f32x16 acc = zero16();
        u32x4 kreg[2], vreg; f32x4 low[4];
        { const int row = chunk_row0(0, b, dir) + srow;
          kreg[0] = *(const u32x4*)(PC + (size_t)row * 2048 + 512 + h * 128 + 16 * dg); kreg[1] = *(const u32x4*)(PC + (size_t)row * 2048 + 512 + h * 128 + 16 * dg + 8);
          vreg = *(const u32x4*)(PC + (size_t)row * 2048 + 1024 + h * 256 + dvq * 64 + 8 * dg);
#pragma unroll
          for (int q = 0; q < 4; ++q) low[q] = *(const f32x4*)(EX + (size_t)row * 32 + dir * 16 + 4 * q); }
        __syncthreads();
        for (int p = 0; p < 36; ++p) {
            { bf16* dst = GST + ((size_t)seq * 36 + p) * 32768 + (size_t)(dvq * 64 + 32 * dvt + l31) * 128 + 32 * dkt + 4 * h5;
#pragma unroll
              for (int q = 0; q < 4; ++q) { u32x2 w; w.x = cvt_pk_bf16(acc[4 * q], acc[4 * q + 1]); w.y = cvt_pk_bf16(acc[4 * q + 2], acc[4 * q + 3]); *(u32x2*)(dst + 8 * q) = w; } }
            gla_lg(c, low, w2s, gbs, lgs);
            __syncthreads();
            gla_scan(c, dir, lgs, tot);
            __syncthreads();
            { float kk[16]; { float t8[8]; unpack8(kreg[0], t8);
#pragma unroll
                for (int e = 0; e < 8; ++e) kk[e] = t8[e]; unpack8(kreg[1], t8);
#pragma unroll
                for (int e = 0; e < 8; ++e) kk[8 + e] = t8[e]; }
#pragma unroll
              for (int e = 0; e < 16; ++e) kk[e] *= __expf(tot[16 * dg + e] - lgs[srow * 128 + 16 * dg + e]);
              const float k0[8] = {kk[0], kk[1], kk[2], kk[3], kk[4], kk[5], kk[6], kk[7]}, k1[8] = {kk[8], kk[9], kk[10], kk[11], kk[12], kk[13], kk[14], kk[15]};
              *(LAS u32x4*)(Kd + srow * 272 + dg * 32) = pack8(k0); *(LAS u32x4*)(Kd + srow * 272 + dg * 32 + 16) = pack8(k1);
              *(LAS u32x4*)(Vs + srow * 144 + dg * 16) = vreg; }
            if (p + 1 < 36) { const int row = chunk_row0(p + 1, b, dir) + srow;
                kreg[0] = *(const u32x4*)(PC + (size_t)row * 2048 + 512 + h * 128 + 16 * dg); kreg[1] = *(const u32x4*)(PC + (size_t)row * 2048 + 512 + h * 128 + 16 * dg + 8);
                vreg = *(const u32x4*)(PC + (size_t)row * 2048 + 1024 + h * 256 + dvq * 64 + 8 * dg);
#pragma unroll
                for (int q = 0; q < 4; ++q) low[q] = *(const f32x4*)(EX + (size_t)row * 32 + dir * 16 + 4 * q); }
            float dm[16];
#pragma unroll
            for (int r = 0; r < 16; ++r) dm[r] = __expf(tot[32 * dkt + crow(r, h5)]);
            __syncthreads();
#pragma unroll
            for (int r = 0; r < 16; ++r) acc[r] *= dm[r];
#pragma unroll
            for (int kk = 0; kk < 4; ++kk) acc = MFMA32(tr_frag(Kd, 272, 16 * kk, 32 * dkt, lane), tr_frag(Vs, 144, 16 * kk, 32 * dvt, lane), acc);
        }
    }
}
DI void phase_gla_out(const Ctx& c, const float* ng) {
    const bf16* P = WSP(bf16, WS_P); const bf16* PC = WSP(bf16, WS_BIG + BIG_PC); const float* EX = WSP(float, WS_EXTRA);
    const bf16* GST = WSP(bf16, WS_BIG + BIG_GST); bf16* Y = WSP(bf16, WS_Y);
    LAS unsigned char* Qt = c.lds; LAS unsigned char* Kt = Qt + 17408; LAS unsigned char* Vs = Kt + 17408; LAS unsigned char* STs = Vs + 33792;
    LAS float* lgs = (LAS float*)c.lds;
    LAS float* YO = (LAS float*)STs;
    LAS float* w2s = (LAS float*)(c.lds + 138240); LAS float* gbs = w2s + 2048; LAS float* tot = gbs + 128;
    const int lane = c.lane, wave = c.wave, h5 = lane >> 5, l31 = lane & 31;
    const int srow = c.tid >> 3, dg = c.tid & 7;
    for (int item = blockIdx.x; item < 1152; item += gridDim.x) {
        const int b = item / 144, h = (item / 36) & 3, cc = item % 36;
        const int r0 = cc < 4 ? b * CTX + 64 * cc : TC + b * SEQ + 64 * (cc - 4);
        __syncthreads();
#pragma unroll
        for (int i = 0; i < 4; ++i) { const int pc = dg + 8 * i; *(LAS u32x4*)(Vs + srow * 528 + pc * 16) = *(const u32x4*)(PC + (size_t)(r0 + srow) * 2048 + 1024 + h * 256 + 8 * pc); }
        f32x16 O[2]; O[0] = zero16(); O[1] = zero16();
        for (int dir = 0; dir < 2; ++dir) {
            const int pslot = dir ? (cc < 4 ? 3 - cc : 39 - cc) : cc;
            __syncthreads();
            for (int i = c.tid; i < 2048; i += 512) w2s[i] = c.in[I_GLW2][(size_t)dir * 8192 + (i >> 7) * 512 + h * 128 + (i & 127)];
            if (c.tid < 128) gbs[c.tid] = c.in[I_GLGB][dir * 512 + h * 128 + c.tid];
            { const bf16* src = GST + ((size_t)((b * 4 + h) * 2 + dir) * 36 + pslot) * 32768;
#pragma unroll
              for (int i = 0; i < 8; ++i) { const int pc = c.tid + 512 * i, rr = pc >> 4, sp = pc & 15; *(LAS u32x4*)(STs + rr * 272 + sp * 16) = *(const u32x4*)(src + rr * 128 + 8 * sp); } }
            f32x4 low[4];
#pragma unroll
            for (int q = 0; q < 4; ++q) low[q] = *(const f32x4*)(EX + (size_t)(r0 + srow) * 32 + dir * 16 + 4 * q);
            __syncthreads();
            gla_lg(c, low, w2s, gbs, lgs);
            __syncthreads();
            gla_scan(c, dir, lgs, tot);
            __syncthreads();
            float bb[16];
#pragma unroll
            for (int e = 0; e < 16; ++e) bb[e] = lgs[srow * 128 + 16 * dg + e];
            __syncthreads();
            { float qq[16], kk[16]; float t8[8];
              unpack8(*(const u32x4*)(PC + (size_t)(r0 + srow) * 2048 + h * 128 + 16 * dg), t8);
#pragma unroll
              for (int e = 0; e < 8; ++e) qq[e] = t8[e];
              unpack8(*(const u32x4*)(PC + (size_t)(r0 + srow) * 2048 + h * 128 + 16 * dg + 8), t8);
#pragma unroll
              for (int e = 0; e < 8; ++e) qq[8 + e] = t8[e];
              unpack8(*(const u32x4*)(PC + (size_t)(r0 + srow) * 2048 + 512 + h * 128 + 16 * dg), t8);
#pragma unroll
              for (int e = 0; e < 8; ++e) kk[e] = t8[e];
              unpack8(*(const u32x4*)(PC + (size_t)(r0 + srow) * 2048 + 512 + h * 128 + 16 * dg + 8), t8);
#pragma unroll
              for (int e = 0; e < 8; ++e) kk[8 + e] = t8[e];
#pragma unroll
              for (int e = 0; e < 16; ++e) { const float eb = __expf(bb[e]); qq[e] *= eb; kk[e] *= 1.0f / eb; }
              const float q0[8] = {qq[0], qq[1], qq[2], qq[3], qq[4], qq[5], qq[6], qq[7]}, q1[8] = {qq[8], qq[9], qq[10], qq[11], qq[12], qq[13], qq[14], qq[15]};
              const float k0[8] = {kk[0], kk[1], kk[2], kk[3], kk[4], kk[5], kk[6], kk[7]}, k1[8] = {kk[8], kk[9], kk[10], kk[11], kk[12], kk[13], kk[14], kk[15]};
              *(LAS u32x4*)(Qt + srow * 272 + dg * 32) = pack8(q0); *(LAS u32x4*)(Qt + srow * 272 + dg * 32 + 16) = pack8(q1);
              *(LAS u32x4*)(Kt + srow * 272 + dg * 32) = pack8(k0); *(LAS u32x4*)(Kt + srow * 272 + dg * 32 + 16) = pack8(k1); }
            __syncthreads();
#pragma unroll
            for (int jt = 0; jt < 2; ++jt) {
#pragma unroll
                for (int st = 0; st < 2; ++st) {
                    const bool live = dir ? (st >= jt) : (st <= jt);
                    if (live) {
                        f32x16 X = zero16();
#pragma unroll
                        for (int kk = 0; kk < 8; ++kk) X = MFMA32(row_frag(Kt, 272, 32 * st, 16 * kk, lane), row_frag(Qt, 272, 32 * jt, 16 * kk, lane), X);
                        if (st == jt) {
#pragma unroll
                            for (int r = 0; r < 16; ++r) { const int s = crow(r, h5); const bool ok = dir ? (s >= l31) : (s <= l31); X[r] = ok ? X[r] : 0.f; } }
#pragma unroll
                        for (int step = 0; step < 2; ++step) O[jt] = MFMA32(tr_frag_perm(Vs, 528, 32 * st + 16 * step, 32 * wave, lane), pack_acc(X, step), O[jt]);
                    }
                }
#pragma unroll
                for (int kk = 0; kk < 8; ++kk) O[jt] = MFMA32(row_frag(STs, 272, 32 * wave, 16 * kk, lane), row_frag(Qt, 272, 32 * jt, 16 * kk, lane), O[jt]);
            }
        }
        __syncthreads();
#pragma unroll
        for (int jt = 0; jt < 2; ++jt)
#pragma unroll
            for (int q = 0; q < 4; ++q) *(LAS f32x4*)(YO + (32 * jt + l31) * 260 + 32 * wave + 8 * q + 4 * h5) = (f32x4){O[jt][4 * q], O[jt][4 * q + 1], O[jt][4 * q + 2], O[jt][4 * q + 3]};
        __syncthreads();
        { const int c0 = dg * 32; float y[32]; float ss = 0.f;
#pragma unroll
          for (int q = 0; q < 8; ++q) { const f32x4 a = *(const LAS f32x4*)(YO + srow * 260 + c0 + 4 * q); y[4 * q] = a.x; y[4 * q + 1] = a.y; y[4 * q + 2] = a.z; y[4 * q + 3] = a.w; }
#pragma unroll
          for (int q = 0; q < 32; ++q) ss += y[q] * y[q];
          ss += __shfl_xor(ss, 1); ss += __shfl_xor(ss, 2); ss += __shfl_xor(ss, 4);
          const float r = 1.0f / sqrtf(ss * (1.0f / 256.0f) + EPS);
#pragma unroll
          for (int q = 0; q < 4; ++q) { float g8[8], o8[8]; unpack8(*(const u32x4*)(P + (size_t)(r0 + srow) * PLD + 2048 + h * 256 + c0 + 8 * q), g8);
#pragma unroll
              for (int e = 0; e < 8; ++e) o8[e] = y[8 * q + e] * r * ng[h * 256 + c0 + 8 * q + e] * siluf_(g8[e]);
              *(u32x4*)(Y + (size_t)(r0 + srow) * D + h * 256 + c0 + 8 * q) = pack8(o8); } }
    }
}

DI void phase_gla_scan_naive(const Ctx& c) {
    const bf16* PC = WSP(bf16, WS_BIG + BIG_PC); const float* EX = WSP(float, WS_EXTRA);
    LAS float* qs = (LAS float*)c.lds; LAS float* ks = qs + 16 * 128; LAS float* as = ks + 16 * 128; LAS float* vs = as + 16 * 128; LAS float* lw = vs + 16 * 256;
    const int v = c.tid >> 1, d0 = (c.tid & 1) * 64;
    for (int item = blockIdx.x; item < 64; item += gridDim.x) {
        const int b = item >> 3, h = (item >> 1) & 3, dir = item & 1;
        float* Yo = WSP(float, WS_BIG + (dir ? BIG_YB : BIG_YF));
        const float* w2 = c.in[I_GLW2] + (size_t)dir * 16 * 512 + h * 128; const float* gb = c.in[I_GLGB] + dir * 512 + h * 128;
        float S[64];
#pragma unroll
        for (int d = 0; d < 64; ++d) S[d] = 0.f;
        for (int ch = 0; ch < (CTX + SEQ) / 16; ++ch) {
            __syncthreads();
            if (c.tid < 256) { const int st = c.tid >> 4, r = c.tid & 15, row = scan_row(ch * 16 + st, b, dir); lw[c.tid] = EX[(size_t)row * 32 + dir * 16 + r]; }
            for (int idx = c.tid; idx < 16 * 512; idx += 512) { const int st = idx >> 9, col = idx & 511, row = scan_row(ch * 16 + st, b, dir);
                if (col < 128) qs[st * 128 + col] = bf2f(PC[(size_t)row * 2048 + h * 128 + col]);
                else if (col < 256) ks[st * 128 + col - 128] = bf2f(PC[(size_t)row * 2048 + 512 + h * 128 + col - 128]);
                else vs[st * 256 + col - 256] = bf2f(PC[(size_t)row * 2048 + 1024 + h * 256 + col - 256]); }
            __syncthreads();
            for (int idx = c.tid; idx < 16 * 128; idx += 512) { const int st = idx >> 7, d = idx & 127; float pre = gb[d];
#pragma unroll
                for (int r = 0; r < 16; ++r) pre += lw[st * 16 + r] * w2[r * 512 + d];
                as[idx] = __expf(logsigf_(pre) * (1.0f / 16.0f)); }
            __syncthreads();
            for (int st = 0; st < 16; ++st) {
                const float vv = vs[st * 256 + v]; float part = 0.f;
#pragma unroll
                for (int d = 0; d < 64; ++d) { S[d] = as[st * 128 + d0 + d] * S[d] + ks[st * 128 + d0 + d] * vv; part += qs[st * 128 + d0 + d] * S[d]; }
                part += __shfl_xor(part, 1);
                if ((c.tid & 1) == 0) { const int row = scan_row(ch * 16 + st, b, dir); Yo[(size_t)row * D + h * 256 + v] = part; }
            }
        }
    }
}
DI void phase_headnorm(const Ctx& c, int hd, const float* ng) {
    const float* YF = WSP(float, WS_BIG + BIG_YF); const float* YB = WSP(float, WS_BIG + BIG_YB); const bf16* P = WSP(bf16, WS_P); bf16* Y = WSP(bf16, WS_Y);
    for (int row = c.gw; row < TT; row += c.ngw) {
        const int c0 = 16 * c.lane; float y[16]; float ss = 0.f;
#pragma unroll
        for (int j = 0; j < 4; ++j) { const f32x4 a = *(const f32x4*)(YF + (size_t)row * D + c0 + 4 * j), bb = *(const f32x4*)(YB + (size_t)row * D + c0 + 4 * j);
            y[4 * j] = a.x + bb.x; y[4 * j + 1] = a.y + bb.y; y[4 * j + 2] = a.z + bb.z; y[4 * j + 3] = a.w + bb.w; }
#pragma unroll
        for (int j = 0; j < 16; ++j) ss += y[j] * y[j];
        ss += __shfl_xor(ss, 1); ss += __shfl_xor(ss, 2); ss += __shfl_xor(ss, 4); if (hd == 256) ss += __shfl_xor(ss, 8);
        const float r = 1.0f / sqrtf(ss / (float)hd + EPS);
        float g0[8], g1[8];
        unpack8(*(const u32x4*)(P + (size_t)row * PLD + 2048 + c0), g0); unpack8(*(const u32x4*)(P + (size_t)row * PLD + 2048 + c0 + 8), g1);
        float o[16];
#pragma unroll
        for (int j = 0; j < 16; ++j) { const float gp = j < 8 ? g0[j] : g1[j - 8]; o[j] = y[j] * r * ng[c0 + j] * (hd == 128 ? sigmoidf_(gp) : siluf_(gp)); }
        const float o0[8] = {o[0], o[1], o[2], o[3], o[4], o[5], o[6], o[7]}, o1[8] = {o[8], o[9], o[10], o[11], o[12], o[13], o[14], o[15]};
        *(u32x4*)(Y + (size_t)row * D + c0) = pack8(o0); *(u32x4*)(Y + (size_t)row * D + c0 + 8) = pack8(o1);
    }
}
DI void phase_hyena_conv_naive(const Ctx& c) {
    const bf16* PC = WSP(bf16, WS_BIG + BIG_PC); bf16* Y = WSP(bf16, WS_Y); const float* skip = c.in[I_HYSKIP];
    LAS float* zt = (LAS float*)c.lds;
    LAS float* ft = zt + 4096;
    const int cc = c.tid & 63, tg = c.tid >> 6;
    for (int item = blockIdx.x; item < 4096 + 512; item += gridDim.x) {
        int L, rb, tt, cgi; const float* tab;
        if (item < 4096) { L = SEQ; const int b = item >> 9; tt = (item >> 4) & 31; cgi = item & 15; rb = TC + b * SEQ; tab = WSP(float, WS_HF); }
        else { const int it = item - 4096; L = CTX; const int b = it >> 6; tt = (it >> 4) & 3; cgi = it & 15; rb = b * CTX; tab = WSP(float, WS_HFC); }
        const int t0 = 64 * tt, c0 = 64 * cgi;
        float acc[8];
#pragma unroll
        for (int i = 0; i < 8; ++i) acc[i] = 0.f;
        for (int sb = 0; sb < L / 64; ++sb) {
            const int s0 = 64 * sb;
            __syncthreads();
            for (int idx = c.tid; idx < 4096; idx += 512) { const int sl = idx >> 6, ch = idx & 63; const size_t o = (size_t)(rb + s0 + sl) * PLD + c0 + ch;
                zt[idx] = bf2f(PC[o + 1024]) * bf2f(PC[o + 2048]); }
            for (int idx = c.tid; idx < 64 * 128; idx += 512) { const int ch = idx >> 7, j = idx & 127;
                if (j < 127) ft[j * 65 + ch] = tab[(size_t)(c0 + ch) * (2 * L) + L + (t0 - s0 - 63 + j)]; }
            __syncthreads();
#pragma unroll 1
            for (int g = 0; g < 8; ++g) {
                float w[15], z[8]; const int base = 8 * (tg - g) + 56;
#pragma unroll
                for (int m = 0; m < 15; ++m) w[m] = ft[(base + m) * 65 + cc];
#pragma unroll
                for (int j = 0; j < 8; ++j) z[j] = zt[(8 * g + j) * 64 + cc];
#pragma unroll
                for (int i = 0; i < 8; ++i)
#pragma unroll
                    for (int j = 0; j < 8; ++j) acc[i] += w[i - j + 7] * z[j];
            }
        }
#pragma unroll
        for (int i = 0; i < 8; ++i) { const int row = rb + t0 + 8 * tg + i; const size_t o = (size_t)row * PLD + c0 + cc;
            const float zin = bf2f(PC[o + 1024]) * bf2f(PC[o + 2048]), x0 = bf2f(PC[o]);
            Y[(size_t)row * D + c0 + cc] = f2bf(x0 * (acc[i] + skip[c0 + cc] * zin)); }
    }
}

DI void hy_item(int item, int& L, int& b, int& t0, int& c0, int& rb) {
    if (item < 4096) { L = SEQ; b = item >> 9; t0 = 64 * ((item >> 4) & 31); c0 = 64 * (item & 15); rb = TC + b * SEQ; }
    else { const int it = item - 4096; L = CTX; b = it >> 6; t0 = 64 * ((it >> 4) & 3); c0 = 64 * (it & 15); rb = b * CTX; }
}
DI void phase_hy_prep(const Ctx& c) {
    const bf16* P = WSP(bf16, WS_P); bf16* X0C = WSP(bf16, WS_BIG + BIG_PC); const float* cw = c.in[I_HYCW]; const float* cb = c.in[I_HYCB];
    LAS unsigned char* raw = c.lds;
    LAS float* zt = (LAS float*)(c.lds + 32768);
    for (int item = blockIdx.x; item < 4608; item += gridDim.x) {
        int L, b, t0, c0, rb; hy_item(item, L, b, t0, c0, rb);
        bf16* ZT = L == SEQ ? WSP(bf16, WS_BIG + BIG_ZTL) : WSP(bf16, WS_BIG + BIG_ZTC);
        __syncthreads();
        for (int pc = c.tid; pc < 3 * 66 * 8; pc += 512) { const int g = pc / 528, rr = (pc % 528) >> 3, sp = pc & 7, t = t0 - 1 + rr;
            u32x4 v = {0u, 0u, 0u, 0u};
            if (t >= 0 && t < L) v = *(const u32x4*)(P + (size_t)(rb + t) * PLD + g * 1024 + c0 + 8 * sp);
            *(LAS u32x4*)(raw + (g * 66 + rr) * 128 + sp * 16) = v; }
        __syncthreads();
        { const int t = c.tid >> 3, sp = c.tid & 7; float u[3][8];
#pragma unroll
          for (int g = 0; g < 3; ++g) { float xm[8], x0[8], xp[8];
              unpack8(*(const LAS u32x4*)(raw + (g * 66 + t) * 128 + sp * 16), xm); unpack8(*(const LAS u32x4*)(raw + (g * 66 + t + 1) * 128 + sp * 16), x0); unpack8(*(const LAS u32x4*)(raw + (g * 66 + t + 2) * 128 + sp * 16), xp);
              const int col = g * 1024 + c0 + 8 * sp;
#pragma unroll
              for (int e = 0; e < 8; ++e) u[g][e] = cw[col + e] * xm[e] + cw[3072 + col + e] * x0[e] + cw[6144 + col + e] * xp[e] + cb[col + e]; }
          *(u32x4*)(X0C + (size_t)(rb + t0 + t) * 1024 + c0 + 8 * sp) = pack8(u[0]);
#pragma unroll
          for (int e = 0; e < 8; ++e) zt[t * 65 + 8 * sp + e] = u[1][e] * u[2][e]; }
        __syncthreads();
        { const int ch = c.tid >> 3, tp = c.tid & 7; float z[8];
#pragma unroll
          for (int e = 0; e < 8; ++e) z[e] = zt[(8 * tp + e) * 65 + ch];
          *(u32x4*)(ZT + ((size_t)(c0 + ch) * NB + b) * L + t0 + 8 * tp) = pack8(z); }
    }
}
template <int L>
DI void hy_toeplitz_channel(const Ctx& c, const float* hrow  , const bf16* zsrc  , bf16* ydst  ) {
    constexpr int NBK = L / 32, CP = 2 * L + 8, NT = (NBK + 31) / 32;
    LAS unsigned char* F = c.lds;
    LAS unsigned char* Zs = c.lds + 8 * CP * 2;
    const int lane = c.lane, w = c.wave, h5 = lane >> 5, a = lane & 31;
    __syncthreads();
    for (int idx = c.tid; idx < 8 * 2 * L; idx += 512) { const int r = idx / (2 * L), m = idx % (2 * L), y = m + r;
        const float v = (y >= 1 && y <= 2 * L - 1) ? hrow[2 * L - y] : 0.f;
        *(LAS bf16*)(F + (r * CP + m) * 2) = f2bf(v); }
    for (int pc = c.tid; pc < 8 * L / 8; pc += 512) { const int bb = pc / (L / 8), pi = pc % (L / 8);
        *(LAS u32x4*)(Zs + (bb * NBK + (pi >> 2)) * 80 + (pi & 3) * 16) = *(const u32x4*)(zsrc + (size_t)bb * L + 8 * pi); }
    __syncthreads();
    const int r = (-a) & 7;
    f32x16 acc[NT];
#pragma unroll
    for (int q = 0; q < NT; ++q) acc[q] = zero16();
    for (int d = -(NBK - 1); d <= NBK - 1; ++d) {
#pragma unroll
        for (int step = 0; step < 2; ++step) {
            const int y0 = L - 32 * d - a + 16 * step + 8 * h5;
            const bf16x8 A = *(const LAS bf16x8*)(F + (r * CP + (y0 - r)) * 2);
#pragma unroll
            for (int q = 0; q < NT; ++q) {
                if (d >= 32 * q - (NBK - 1) && d <= 32 * q + 31) {
                    const int src = 32 * q + a - d; const bool ok = (unsigned)src < (unsigned)NBK; const int sc = ok ? src : 0;
                    bf16x8 B = *(const LAS bf16x8*)(Zs + (w * NBK + sc) * 80 + 32 * step + 16 * h5);
                    if (!ok) B = (bf16x8){0, 0, 0, 0, 0, 0, 0, 0};
                    acc[q] = MFMA32(A, B, acc[q]);
                }
            }
        }
    }
#pragma unroll
    for (int q = 0; q < NT; ++q) { const int i = 32 * q + a;
        if (i < NBK) {
#pragma unroll
            for (int qq = 0; qq < 4; ++qq) { u32x2 o; o.x = cvt_pk_bf16(acc[q][4 * qq], acc[q][4 * qq + 1]); o.y = cvt_pk_bf16(acc[q][4 * qq + 2], acc[q][4 * qq + 3]);
                *(u32x2*)(ydst + (size_t)w * L + 32 * i + 8 * qq + 4 * h5) = o; } } }
}
DI void phase_hy_toeplitz(const Ctx& c) {
    for (int ch = blockIdx.x; ch < 1024; ch += gridDim.x) {
        hy_toeplitz_channel<SEQ>(c, WSP(float, WS_HF) + (size_t)ch * 4096, WSP(bf16, WS_BIG + BIG_ZTL) + (size_t)ch * NB * SEQ, WSP(bf16, WS_BIG + BIG_YTL) + (size_t)ch * NB * SEQ);
        hy_toeplitz_channel<CTX>(c, WSP(float, WS_HFC) + (size_t)ch * 512, WSP(bf16, WS_BIG + BIG_ZTC) + (size_t)ch * NB * CTX, WSP(bf16, WS_BIG + BIG_YTC) + (size_t)ch * NB * CTX);
    }
}
DI void phase_hy_post(const Ctx& c) {
    const bf16* X0C = WSP(bf16, WS_BIG + BIG_PC); bf16* Y = WSP(bf16, WS_Y); const float* skip = c.in[I_HYSKIP];
    LAS float* tl = (LAS float*)c.lds;
    for (int item = blockIdx.x; item < 4608; item += gridDim.x) {
        int L, b, t0, c0, rb; hy_item(item, L, b, t0, c0, rb);
        const bf16* ZT = L == SEQ ? WSP(bf16, WS_BIG + BIG_ZTL) : WSP(bf16, WS_BIG + BIG_ZTC); const bf16* YT = L == SEQ ? WSP(bf16, WS_BIG + BIG_YTL) : WSP(bf16, WS_BIG + BIG_YTC);
        __syncthreads();
        { const int ch = c.tid >> 3, tp = c.tid & 7; const size_t o = ((size_t)(c0 + ch) * NB + b) * L + t0 + 8 * tp; float y[8], z[8];
          unpack8(*(const u32x4*)(YT + o), y); unpack8(*(const u32x4*)(ZT + o), z); const float sk = skip[c0 + ch];
#pragma unroll
          for (int e = 0; e < 8; ++e) tl[ch * 65 + 8 * tp + e] = y[e] + sk * z[e]; }
        __syncthreads();
        { const int t = c.tid >> 3, sp = c.tid & 7; float x0[8], o[8];
          unpack8(*(const u32x4*)(X0C + (size_t)(rb + t0 + t) * 1024 + c0 + 8 * sp), x0);
#pragma unroll
          for (int e = 0; e < 8; ++e) o[e] = x0[e] * tl[(8 * sp + e) * 65 + t];
          *(u32x4*)(Y + (size_t)(rb + t0 + t) * D + c0 + 8 * sp) = pack8(o); }
    }
}

DI void phase_route(const Ctx& c, int l) {
    LAS float* rw = (LAS float*)c.lds;
    for (int i = c.tid; i < 16 * 1024; i += 512) { const int e = i >> 10, k = i & 1023; rw[i] = c.in[I_RW][k * 16 + e]; }
    __syncthreads();
    const float* MOD = WSP(float, WS_MOD) + (size_t)l * 9 * 6144; const float* g = c.in[I_N2G] + l * D; bf16* H = WSP(bf16, WS_H);
    const float* X = WSP(float, WS_X); const float* XC = WSP(float, WS_XC);
    unsigned* cnt = WSP(unsigned, WS_CTL) + CW_CNT + l * 16; int* TOK = WSP(int, WS_TOK); float* TOKW = WSP(float, WS_TOK + 512 * 1024);
    float rbv[16];
#pragma unroll
    for (int e = 0; e < 16; ++e) rbv[e] = c.in[I_RB][e];
    for (int row = (l == 3 ? TC : 0) + c.gw; row < TT; row += c.ngw) {
        f32x4 v[4]; const int mr = row < TC ? 8 : (row - TC) >> 11;
        load_row(row < TC ? XC + (size_t)row * D : X + (size_t)(row - TC) * D, v, c.lane);
        norm_row(v, g, c.lane); mod_row(v, MOD + mr * 6144 + 3072, MOD + mr * 6144 + 4096, c.lane);
        store_row_bf16(H + (size_t)row * D, v, c.lane);
        float sc[16];
#pragma unroll
        for (int e = 0; e < 16; ++e) { float s = 0.f;
#pragma unroll
            for (int j = 0; j < 4; ++j) { const f32x4 w = *(const LAS f32x4*)(rw + e * 1024 + 256 * j + 4 * c.lane); s += (v[j].x * w.x + v[j].y * w.y) + (v[j].z * w.z + v[j].w * w.w); }
            sc[e] = sigmoidf_(wave_sum(s)); asm volatile("" ::: "memory"); }
        int bg = 0; float bgs = -1e30f;
#pragma unroll
        for (int gq = 0; gq < 4; ++gq) { float m1 = -1e30f, m2 = -1e30f;
#pragma unroll
            for (int j = 0; j < 4; ++j) { const float s = sc[4 * gq + j] + rbv[4 * gq + j]; if (s > m1) { m2 = m1; m1 = s; } else if (s > m2) m2 = s; }
            const float gs = m1 + m2; if (gs > bgs) { bgs = gs; bg = gq; } }
        float s4[4], p4[4];
#pragma unroll
        for (int j = 0; j < 4; ++j) { s4[j] = 0.f; p4[j] = 0.f; }
#pragma unroll
        for (int gq = 0; gq < 4; ++gq)
#pragma unroll
            for (int j = 0; j < 4; ++j) if (bg == gq) { s4[j] = sc[4 * gq + j] + rbv[4 * gq + j]; p4[j] = sc[4 * gq + j]; }
        int i1 = 0; float v1 = s4[0], q1 = p4[0];
#pragma unroll
        for (int j = 1; j < 4; ++j) if (s4[j] > v1) { v1 = s4[j]; i1 = j; q1 = p4[j]; }
        int i2 = -1; float v2 = -1e30f, q2 = 0.f;
#pragma unroll
        for (int j = 0; j < 4; ++j) if (j != i1 && s4[j] > v2) { v2 = s4[j]; i2 = j; q2 = p4[j]; }
        if (c.lane == 0) {
            const int e0 = 4 * bg + i1, e1 = 4 * bg + i2;
            const unsigned p0 = atomicAdd(cnt + e0, 1u), p1 = atomicAdd(cnt + e1, 1u);
            TOK[row * 4 + 0] = e0; TOK[row * 4 + 1] = (int)p0; TOK[row * 4 + 2] = e1; TOK[row * 4 + 3] = (int)p1;
            const float inv = 1.0f / (q1 + q2); TOKW[row * 2] = q1 * inv; TOKW[row * 2 + 1] = q2 * inv;
        }
    }
}
DI void slot_bases(const unsigned* cnt, int lane, int e0, int e1, int& b0, int& b1) {
    const unsigned mine = lane < 16 ? ((cnt[lane] + 255u) & ~255u) : 0u; unsigned pb = 0; b0 = 0; b1 = 0;
#pragma unroll
    for (int e = 0; e < 16; ++e) { const unsigned ce = __shfl(mine, e); if (e == e0) b0 = (int)pb; if (e == e1) b1 = (int)pb; pb += ce; }
}
DI void phase_gather(const Ctx& c, int l) {
    const unsigned* cnt = WSP(unsigned, WS_CTL) + CW_CNT + l * 16; const int* TOK = WSP(int, WS_TOK); int* TOKS = WSP(int, WS_TOK + 768 * 1024);
    const bf16* H = WSP(bf16, WS_H); bf16* HS = WSP(bf16, WS_BIG + BIG_HS);
    for (int row = (l == 3 ? TC : 0) + c.gw; row < TT; row += c.ngw) {
        const int e0 = TOK[row * 4], p0 = TOK[row * 4 + 1], e1 = TOK[row * 4 + 2], p1 = TOK[row * 4 + 3]; int b0, b1;
        slot_bases(cnt, c.lane, e0, e1, b0, b1);
        const int s0 = b0 + p0, s1 = b1 + p1;
        const u32x4 a = *(const u32x4*)(H + (size_t)row * D + 8 * c.lane), bq = *(const u32x4*)(H + (size_t)row * D + 512 + 8 * c.lane);
        *(u32x4*)(HS + (size_t)s0 * D + 8 * c.lane) = a; *(u32x4*)(HS + (size_t)s0 * D + 512 + 8 * c.lane) = bq;
        *(u32x4*)(HS + (size_t)s1 * D + 8 * c.lane) = a; *(u32x4*)(HS + (size_t)s1 * D + 512 + 8 * c.lane) = bq;
        if (c.lane == 0) { TOKS[row * 2] = s0; TOKS[row * 2 + 1] = s1; }
    }
}
DI LAS int* moe_tiles(const Ctx& c, int l) {
    LAS int* tp = (LAS int*)(c.lds + MISC_OFF);
    __syncthreads();
    if (c.tid < 64) {
        const unsigned* cnt = WSP(unsigned, WS_CTL) + CW_CNT + l * 16;
        const int mine = c.lane < 16 ? (int)((cnt[c.lane] + 255u) >> 8) : 0; int p = 0;
        for (int e = 0; e < 16; ++e) { const int ne = __shfl(mine, e); for (int t = c.lane; t < ne; t += 64) tp[1 + p + t] = e; p += ne; }
        if (c.lane == 0) tp[0] = p;
    }
    __syncthreads();
    return tp;
}
DI void phase_combine(const Ctx& c, int l) {
    const float* MOD = WSP(float, WS_MOD) + (size_t)l * 9 * 6144; const int* TOKS = WSP(int, WS_TOK + 768 * 1024); const float* TOKW = WSP(float, WS_TOK + 512 * 1024);
    const bf16* YS = WSP(bf16, WS_BIG + BIG_HS); float* X = WSP(float, WS_X); float* XC = WSP(float, WS_XC); bf16* H = WSP(bf16, WS_H);
    for (int row = (l == 3 ? TC : 0) + c.gw; row < TT; row += c.ngw) {
        const int mr = row < TC ? 8 : (row - TC) >> 11; float* xp = row < TC ? XC + (size_t)row * D : X + (size_t)(row - TC) * D;
        const int s0 = TOKS[row * 2], s1 = TOKS[row * 2 + 1]; const float w0 = TOKW[row * 2], w1 = TOKW[row * 2 + 1];
        f32x4 v[4]; load_row(xp, v, c.lane);
#pragma unroll
        for (int j = 0; j < 4; ++j) {
            const u32x2 a = *(const u32x2*)(YS + (size_t)s0 * D + 256 * j + 4 * c.lane), bq = *(const u32x2*)(YS + (size_t)s1 * D + 256 * j + 4 * c.lane);
            const f32x4 ya = {__uint_as_float(a.x << 16), __uint_as_float(a.x & 0xffff0000u), __uint_as_float(a.y << 16), __uint_as_float(a.y & 0xffff0000u)};
            const f32x4 yb = {__uint_as_float(bq.x << 16), __uint_as_float(bq.x & 0xffff0000u), __uint_as_float(bq.y << 16), __uint_as_float(bq.y & 0xffff0000u)};
            v[j] = v[j] + *(const f32x4*)(MOD + mr * 6144 + 5120 + 256 * j + 4 * c.lane) * (ya * w0 + yb * w1);
            *(f32x4*)(xp + 256 * j + 4 * c.lane) = v[j];
        }
        if (l < 3) {
            const float* MODn = WSP(float, WS_MOD) + (size_t)(l + 1) * 9 * 6144;
            norm_row(v, c.in[I_N1G] + (l + 1) * D, c.lane); mod_row(v, MODn + mr * 6144, MODn + mr * 6144 + 1024, c.lane);
            store_row_bf16(H + (size_t)hrow_of(row, (l + 1) % 3) * D, v, c.lane);
        } else {
            norm_row(v, c.in[I_FING], c.lane);
            float* o = c.out + (size_t)(row - TC) * D;
#pragma unroll
            for (int j = 0; j < 4; ++j) *(f32x4*)(o + 256 * j + 4 * c.lane) = v[j];
        }
    }
}

#define XB_TMO      128
#define XB_XCNT(j)  (256  + 64 * (j))
#define XB_XSUB(j)  (1280 + 64 * (j))
#define XB_XGEN(j)  (2304 + 64 * (j))
#define XB_TOP      3328
#define XB_TOPGEN   3392
#define XCD_BAR_WORDS 3456
#define XB_SPIN_CAP (1u << 18)
DI unsigned xb_ld(unsigned* p)              { return __hip_atomic_load(p, __ATOMIC_RELAXED, __HIP_MEMORY_SCOPE_AGENT); }
DI unsigned xb_add(unsigned* p, unsigned v) { return __hip_atomic_fetch_add(p, v, __ATOMIC_RELAXED, __HIP_MEMORY_SCOPE_AGENT); }
DI unsigned xb_xcc_id() { return (unsigned)__builtin_amdgcn_s_getreg((3 << 11) | 20) & 0xFu; }
#define XB_SPIN(cond, bar) do { unsigned _sp = 0; while (cond) { __builtin_amdgcn_s_sleep(1); \
    if ((++_sp & 255u) == 0u) { if (xb_ld(&(bar)[XB_TMO])) break; if (_sp > XB_SPIN_CAP) { atomicAdd(&(bar)[XB_TMO], 1u); break; } } } } while (0)
DI void xcd_barrier_complete(unsigned* bar, unsigned x, unsigned& nloc, unsigned& nx) {
    const unsigned G = gridDim.x * gridDim.y * gridDim.z;
    unsigned sum, cnt, mine, sp = 0u;
    for (;;) {
        sum = 0u; cnt = 0u; mine = 0u;
#pragma unroll
        for (unsigned j = 0; j < 16; ++j) { const unsigned cj = xb_ld(&bar[XB_XCNT(j)]); sum += cj; cnt += (cj > 0u) ? 1u : 0u; mine = (j == x) ? cj : mine; }
        if (sum == G) break;
        __builtin_amdgcn_s_sleep(1);
        if ((++sp & 255u) == 0u) { if (xb_ld(&bar[XB_TMO])) break; if (sp > XB_SPIN_CAP) { atomicAdd(&bar[XB_TMO], 1u); break; } }
    }
    nloc = mine > 0u ? mine : 1u; nx = cnt > 0u ? cnt : 1u;
}
DI void xcd_barrier(unsigned* bar, volatile LAS unsigned* st) {
    asm volatile("s_waitcnt vmcnt(0)" ::: "memory");
    __syncthreads();
    if (threadIdx.x == 0) {
        const unsigned x = xb_xcc_id();
        __builtin_amdgcn_s_waitcnt(0);
        unsigned nloc = st[0], nx = st[1];
        if (nloc == 0u) { xcd_barrier_complete(bar, x, nloc, nx); st[0] = nloc; st[1] = nx; }
        const unsigned old = xb_add(&bar[XB_XSUB(x)], 1u);
        const unsigned gen = old / nloc;
        if (old + 1u == (gen + 1u) * nloc) {
            __builtin_amdgcn_fence(__ATOMIC_RELEASE, "agent");
            asm volatile("s_waitcnt vmcnt(0)" ::: "memory");
            const unsigned og = xb_add(&bar[XB_TOP], 1u);
            const unsigned tg = og / nx;
            if (og + 1u == (tg + 1u) * nx) xb_add(&bar[XB_TOPGEN], 1u);
            else XB_SPIN(xb_ld(&bar[XB_TOPGEN]) == tg, bar);
            __builtin_amdgcn_fence(__ATOMIC_ACQUIRE, "agent");
            xb_add(&bar[XB_XGEN(x)], 1u);
            asm volatile("s_waitcnt vmcnt(0)" ::: "memory");
        } else {
            XB_SPIN(xb_ld(&bar[XB_XGEN(x)]) == gen, bar);
            __builtin_amdgcn_fence(__ATOMIC_ACQUIRE, "agent");
            asm volatile("s_waitcnt vmcnt(0)" ::: "memory");
        }
    }
    __syncthreads();
}

constexpr int NPHASE = 2 + 11 * DEPTH;
__host__ __device__ inline bool phase_active(int ph) {
    if (ph < 2) return true;
    const int l = (ph - 2) / 11, s = (ph - 2) % 11, kind = l % 3;
    if (s == 0) return l == 0;
    if (s == 4) return kind != 2 || HY_MFMA;
    return true;
}
DI void run_phase(const Ctx& c, int ph) {
    if (ph == 0) { if constexpr (PH_EN(0)) phase_pro0(c); return; }
    if (ph == 1) { if constexpr (PH_EN(1)) phase_pro1(c); return; }
    const int l = (ph - 2) / 11, s = (ph - 2) % 11, kind = l % 3, j = l / 3;
    switch (s) {
    case 0: if constexpr (PH_EN(2)) phase_norm1(c, 0, c.in[I_X], c.in[I_CTX]); break;
    case 1: if constexpr (PH_EN(3)) {
        DenseOrder S; EpiInproj E; E.P = WSP(bf16, WS_P); E.extra = WSP(float, WS_EXTRA); E.bias = nullptr; E.bias_x = nullptr;
        if (kind == 0) { S.init(WSP(bf16, WS_H), WSP(bf16, WS_ML_WIN) + (size_t)j * NINP * 1024, TT, NINP); E.bias_x = c.in[I_MLBG] + j * 32; }
        else if (kind == 1) { S.init(WSP(bf16, WS_H), WSP(bf16, WS_GLA_WIN), TT, NINP); }
        else { S.init(WSP(bf16, WS_H), WSP(bf16, WS_HY_WIN), TT, 3072); E.bias = c.in[I_HYBIN]; }
        gemm_run(c.lds, c.tid, S, E);
    } break;
    case 2: if constexpr (PH_EN(4))
        if (kind == 0) phase_conv(c, 1024, c.in[I_MLCW] + j * 3 * 1024, c.in[I_MLCB] + j * 1024, true, 0.125f);
        else if (kind == 1) phase_conv(c, 2048, c.in[I_GLCW], c.in[I_GLCB], true, 0.08838834764831845f);
        else { if constexpr (HY_MFMA) phase_hy_prep(c); else phase_conv(c, 3072, c.in[I_HYCW], c.in[I_HYCB], false, 1.0f); }
        break;
    case 3: if constexpr (PH_EN(5))
        if (kind == 0) { if constexpr (MLSTM_CHUNK) phase_mlstm_state(c); else phase_mlstm_scan_naive(c); }
        else if (kind == 1) { if constexpr (GLA_CHUNK) phase_gla_state(c); else phase_gla_scan_naive(c); }
        else { if constexpr (HY_MFMA) phase_hy_toeplitz(c); else phase_hyena_conv_naive(c); }
        break;
    case 4: if constexpr (PH_EN(6))
        if (kind == 0) { if constexpr (MLSTM_CHUNK) phase_mlstm_out(c, c.in[I_MLNG] + j * 1024); else phase_headnorm(c, 128, c.in[I_MLNG] + j * 1024); }
        else if (kind == 1) { if constexpr (GLA_CHUNK) phase_gla_out(c, c.in[I_GLNG]); else phase_headnorm(c, 256, c.in[I_GLNG]); }
        else { if constexpr (HY_MFMA) phase_hy_post(c); }
        break;
    case 5: if constexpr (PH_EN(7)) {
        DenseOrder S; EpiOutproj E; E.X = WSP(float, WS_X); E.XC = WSP(float, WS_XC); E.mod = WSP(float, WS_MOD) + (size_t)l * 9 * 6144; E.bias = nullptr; E.perm = (kind == 1);
        E.xs_l = (l == 0) ? c.in[I_X] : WSP(float, WS_X); E.xs_c = (l == 0) ? c.in[I_CTX] : WSP(float, WS_XC); E.row_off = (l == 3) ? TC : 0;
        const bf16* W = kind == 0 ? WSP(bf16, WS_ML_WOUT) + (size_t)j * 1024 * 1024 : kind == 1 ? WSP(bf16, WS_GLA_WOUT) : WSP(bf16, WS_HY_WOUT);
        if (kind == 2) E.bias = c.in[I_HYBOUT];
        S.init(WSP(bf16, WS_Y) + (size_t)E.row_off * D, W, TT - E.row_off, 1024);
        gemm_run(c.lds, c.tid, S, E);
    } break;
    case 6: if constexpr (PH_EN(8)) phase_route(c, l); break;
    case 7: if constexpr (PH_EN(9)) phase_gather(c, l); break;
    case 8: if constexpr (PH_EN(10)) {
        MoeOrder S; S.tp = moe_tiles(c, l); S.A = WSP(bf16, WS_BIG + BIG_HS); S.Bt = WSP(bf16, WS_EXP_UP) + (size_t)l * 16 * 2048 * 1024; S.bstride = (size_t)2048 * 1024; S.nsh = 3; S.G = gridDim.x; S.c = blockIdx.x;
        EpiUp E; E.ACT = WSP(bf16, WS_BIG + BIG_ACT);
        gemm_run(c.lds, c.tid, S, E);
    } break;
    case 9: if constexpr (PH_EN(11)) {
        MoeOrder S; S.tp = moe_tiles(c, l); S.A = WSP(bf16, WS_BIG + BIG_ACT); S.Bt = WSP(bf16, WS_EXP_DN) + (size_t)l * 16 * 1024 * 1024; S.bstride = (size_t)1024 * 1024; S.nsh = 2; S.G = gridDim.x; S.c = blockIdx.x;
        EpiDown E; E.YS = WSP(bf16, WS_BIG + BIG_HS);
        gemm_run(c.lds, c.tid, S, E);
    } break;
    case 10: if constexpr (PH_EN(12)) phase_combine(c, l); break;
    }
}

__global__ void __launch_bounds__(512, 2) mega_fwd(Params p) {
    extern __shared__ __attribute__((aligned(16))) unsigned char lds_raw[];
#if XCD_BARRIER
    {
        volatile LAS unsigned* st0 = (volatile LAS unsigned*)((LAS unsigned char*)lds_raw + BAR_LDS_OFF);
        if (threadIdx.x == 0) { st0[0] = 0u; st0[1] = 0u; (void)xb_add((unsigned*)(p.ws + WS_CTL) + CW_BAR + XB_XCNT(xb_xcc_id()), 1u); }
        __syncthreads();
    }
#endif
    bool first = true;
    int rep = 0;
    for (int ph = p.ph_lo; ph < p.ph_hi;) {
        if (!phase_active(ph)) { ++ph; continue; }
        int z; asm volatile("s_mov_b32 %0, 0" : "=s"(z));
        if (!first) {
#if XCD_BARRIER
            xcd_barrier((unsigned*)(p.ws + z + WS_CTL) + CW_BAR, (volatile LAS unsigned*)((LAS unsigned char*)lds_raw + BAR_LDS_OFF));
#else
            cg::this_grid().sync();
#endif
        }
        first = false;
        Ctx c;
        c.lds = (LAS unsigned char*)lds_raw;
        c.tid = threadIdx.x + z; c.lane = c.tid & 63; c.wave = __builtin_amdgcn_readfirstlane(c.tid >> 6);
        c.gw = blockIdx.x * 8 + c.wave; c.ngw = gridDim.x * 8;
        c.in = p.in + z; c.out = p.out + z; c.ws = p.ws + z;
        run_phase(c, ph);
        if (REP_MASK != 0u && rep == 0 && ph >= 2 && ((REP_MASK >> ((ph - 2) % 11)) & 1u) && ((REP_LAYERS >> ((ph - 2) / 11)) & 1u)) rep = 1; else { rep = 0; ++ph; }
    }
}

extern "C" void kernel_launch(void* const* d_in, const int* in_sizes, int n_in, void* d_out, int out_size, void* d_ws, size_t ws_size, hipStream_t stream) {
    static int grid = 0;
    if (grid == 0) {
        if (n_in != 40 || ws_size < WS_END || out_size != TL * D) { fprintf(stderr, "kernel_launch: unexpected shapes (n_in %d, ws %zu, out %d)\n", n_in, ws_size, out_size); grid = -1; return; }
        int dev = 0, cus = 0, per_cu = 0;
        hipGetDevice(&dev); hipDeviceGetAttribute(&cus, hipDeviceAttributeMultiprocessorCount, dev);
        if (hipFuncSetAttribute((const void*)mega_fwd, hipFuncAttributeMaxDynamicSharedMemorySize, LDS_BYTES) != hipSuccess) { fprintf(stderr, "kernel_launch: hipFuncSetAttribute failed\n"); grid = -1; return; }
        if (hipOccupancyMaxActiveBlocksPerMultiprocessor(&per_cu, (const void*)mega_fwd, 512, LDS_BYTES) != hipSuccess || per_cu < 1) { fprintf(stderr, "kernel_launch: occupancy query says %d\n", per_cu); per_cu = 1; }
        (void)hipGetLastError();
        grid = cus;
        fprintf(stderr, "kernel_launch: grid %d (cus %d, per_cu %d)\n", grid, cus, per_cu);
    }
    if (grid < 0) return;
    hipMemsetAsync((char*)d_ws + WS_CTL, 0, 1 * MiB, stream);
    Params p{};
    for (int i = 0; i < 40; ++i) p.in[i] = (const float*)d_in[i];
    p.out = (float*)d_out; p.ws = (unsigned char*)d_ws;
#if N_LAUNCH_PER_PHASE
    for (int ph = 0; ph < NPHASE; ++ph) {
        if (!phase_active(ph)) continue;
        p.ph_lo = ph; p.ph_hi = ph + 1; void* args[] = {&p};
        hipError_t e = hipLaunchCooperativeKernel((const void*)mega_fwd, dim3(grid), dim3(512), args, LDS_BYTES, stream);
        if (e != hipSuccess) { fprintf(stderr, "launch failed: %s\n", hipGetErrorString(e)); break; }
    }
#else
    p.ph_lo = 0; p.ph_hi = NPHASE; void* args[] = {&p};
    hipError_t e = hipLaunchCooperativeKernel((const void*)mega_fwd, dim3(grid), dim3(512), args, LDS_BYTES, stream);
    if (e != hipSuccess) fprintf(stderr, "cooperative launch failed: %s (grid %d)\n", hipGetErrorString(e), grid);
#endif
}
```

```cpp
#include <hip/hip_runtime.h>
#include <hip/hip_cooperative_groups.h>
#include <cstdio>
#include <cstdint>
namespace cg = cooperative_groups;

#define LAS __attribute__((address_space(3)))
#define DI __device__ __forceinline__
typedef unsigned short bf16;
typedef float f32x4 __attribute__((ext_vector_type(4)));
typedef float f32x2 __attribute__((ext_vector_type(2)));
typedef unsigned u32x4 __attribute__((ext_vector_type(4)));
typedef unsigned u32x2 __attribute__((ext_vector_type(2)));
typedef short bf16x8 __attribute__((ext_vector_type(8)));

#ifndef FAST_GEMM
#define FAST_GEMM 1
#endif
#ifndef MLSTM_CHUNK
#define MLSTM_CHUNK 1
#endif
#ifndef GLA_CHUNK
#define GLA_CHUNK 1
#endif
#ifndef HY_MFMA
#define HY_MFMA 1
#endif
#ifndef XCD_BARRIER
#define XCD_BARRIER 1
#endif
#ifndef PH_MASK
#define PH_MASK 0xFFFFFFFFu
#endif
#define PH_EN(b) ((PH_MASK >> (b)) & 1u)
#ifndef REP_LAYERS
#define REP_LAYERS 0xFu
#endif
#ifndef REP_MASK
#define REP_MASK 0u
#endif
#ifndef N_LAUNCH_PER_PHASE
#define N_LAUNCH_PER_PHASE 0
#endif

constexpr int D = 1024, NB = 8, SEQ = 2048, CTX = 256, DEPTH = 4;
constexpr int TC = NB * CTX, TL = NB * SEQ, TT = TC + TL;
constexpr int NEXP = 16;
constexpr int PLD = 3072;
constexpr int NINP = 3328;
constexpr float EPS = 1e-6f;
constexpr int MAXSLOT = 40960;

constexpr size_t MiB = 1u << 20;
constexpr size_t WS_CTL = 0;
constexpr size_t WS_MOD = 1 * MiB;
constexpr size_t WS_HM = 2 * MiB;
constexpr size_t WS_TOK = 3 * MiB;
constexpr size_t WS_HF = 4 * MiB;
constexpr size_t WS_HFC = 20 * MiB;
constexpr size_t WS_ML_WIN = 32 * MiB;
constexpr size_t WS_ML_WOUT = 45 * MiB;
constexpr size_t WS_GLA_WIN = 49 * MiB;
constexpr size_t WS_GLA_WOUT = 56 * MiB;
constexpr size_t WS_HY_WIN = 58 * MiB;
constexpr size_t WS_HY_WOUT = 64 * MiB;
constexpr size_t WS_EXP_UP = 66 * MiB;
constexpr size_t WS_EXP_DN = 322 * MiB;
constexpr size_t WS_X = 450 * MiB;
constexpr size_t WS_XC = 514 * MiB;
constexpr size_t WS_H = 522 * MiB;
constexpr size_t WS_P = 558 * MiB;
constexpr size_t WS_EXTRA = 667 * MiB;
constexpr size_t WS_Y = 670 * MiB;
constexpr size_t WS_BIG = 706 * MiB;
constexpr size_t WS_END = 962 * MiB;
constexpr size_t BIG_HS = 0;
constexpr size_t BIG_ACT = 80 * MiB;
constexpr size_t BIG_PC = 0;
constexpr size_t BIG_YF = 108 * MiB;
constexpr size_t BIG_YB = 180 * MiB;

constexpr size_t BIG_MCT = 108 * MiB;
constexpr size_t BIG_MN = 180 * MiB;

constexpr size_t BIG_GST = 108 * MiB;

constexpr size_t BIG_ZTL = 108 * MiB;
constexpr size_t BIG_ZTC = 140 * MiB;
constexpr size_t BIG_YTL = 144 * MiB;
constexpr size_t BIG_YTC = 176 * MiB;

constexpr int CW_CNT = 1024;
constexpr int CW_BAR = 4096;

constexpr int LDS_BYTES = 148480;
constexpr int BAR_LDS_OFF = 147456;
constexpr int MISC_OFF = 131072;

struct Params {
    const float* in[40];
    float* out;
    unsigned char* ws;
    int ph_lo, ph_hi;
};
enum { I_X = 0, I_C, I_CTX, I_CCTX, I_ADAW, I_ADAB, I_N1G, I_N2G, I_FING, I_MLWIN, I_MLBG, I_MLCW, I_MLCB, I_MLNG, I_MLWOUT,
       I_GLWIN, I_GLCW, I_GLCB, I_GLW2, I_GLGB, I_GLNG, I_GLWOUT, I_HYWIN, I_HYBIN, I_HYCW, I_HYCB, I_HYFW1, I_HYFB1, I_HYFWM, I_HYFBM,
       I_HYFWO, I_HYFREQ, I_HYSKIP, I_HYWOUT, I_HYBOUT, I_RW, I_RB, I_EW1, I_EW3, I_EW2 };

DI float bf2f(bf16 v) { return __uint_as_float(((unsigned)v) << 16); }
typedef __bf16 b16x2_t __attribute__((ext_vector_type(2)));
DI unsigned cvt_pk_bf16(float lo, float hi) { const f32x2 v = {lo, hi}; const b16x2_t r = __builtin_convertvector(v, b16x2_t); return __builtin_bit_cast(unsigned, r); }
DI bf16 f2bf(float f) { return (bf16)(cvt_pk_bf16(f, 0.f) & 0xffffu); }
DI float sigmoidf_(float x) { return 1.0f / (1.0f + __expf(-x)); }
DI float siluf_(float x) { return x / (1.0f + __expf(-x)); }
DI float logsigf_(float x) { return fminf(x, 0.f) - log1pf(__expf(-fabsf(x))); }
DI float wave_sum(float v) {
#pragma unroll
    for (int o = 1; o < 64; o <<= 1) v += __shfl_xor(v, o);
    return v;
}
DI void unpack8(const u32x4 w, float (&v)[8]) {
    v[0] = __uint_as_float(w.x << 16); v[1] = __uint_as_float(w.x & 0xffff0000u);
    v[2] = __uint_as_float(w.y << 16); v[3] = __uint_as_float(w.y & 0xffff0000u);
    v[4] = __uint_as_float(w.z << 16); v[5] = __uint_as_float(w.z & 0xffff0000u);
    v[6] = __uint_as_float(w.w << 16); v[7] = __uint_as_float(w.w & 0xffff0000u);
}
DI u32x4 pack8(const float (&v)[8]) { u32x4 w; w.x = cvt_pk_bf16(v[0], v[1]); w.y = cvt_pk_bf16(v[2], v[3]); w.z = cvt_pk_bf16(v[4], v[5]); w.w = cvt_pk_bf16(v[6], v[7]); return w; }
DI void seq_bounds(int row, int& lo, int& hi) {
    if (row < TC) { lo = row & ~(CTX - 1); hi = lo + CTX - 1; } else { lo = TC + ((row - TC) & ~(SEQ - 1)); hi = lo + SEQ - 1; }
}
DI int perm_fwd(int s) { return (s & 63) * 32 + (s >> 6); }
DI int perm_inv(int sp) { return (sp & 31) * 64 + (sp >> 5); }

namespace pg8 {
constexpr int BM = 256, BK = 64, HALF = 128, HTB = HALF * BK * 2, STAGE_BYTES = 8 * HTB, NXCD = 8, WGM = 8;
__host__ __device__ __forceinline__ int lds_byte(int r, int c) { const int st = (r >> 4) * 2 + (c >> 5), rr = r & 15, cc = c & 31, ob = rr * 64 + cc * 2; return st * 1024 + (ob ^ (((ob >> 9) & 1) << 5)); }
__host__ __device__ __forceinline__ void stage_rc(int b, int& R, int& C) { const int st = b / 1024, sb = b % 1024, swz = sb ^ (((sb >> 9) & 1) << 5); R = (st >> 1) * 16 + swz / 64; C = (st & 1) * 32 + (swz % 64) / 2; }
__host__ __device__ __forceinline__ int perm32(int rho) { const int n = rho >> 4, i = rho & 15; return 8 * (i >> 2) + 4 * n + (i & 3); }
}
struct Unit { int pm, pn, e; };

struct DenseOrder {
    const bf16* A; const bf16* Bt; int nM, nN, nwg, G, c;
    DI void init(const bf16* A_, const bf16* Bt_, int M, int N) { A = A_; Bt = Bt_; nM = M / 256; nN = N / 256; nwg = nM * nN; G = gridDim.x; c = blockIdx.x; }
    DI bool next(int i, Unit& u) const {
        const int L = i * G + c; if (L >= nwg) return false;
        int wgid = L; { const int q = nwg / 8, r = nwg % 8, xcd = wgid % 8, off = wgid / 8; wgid = (xcd < r ? xcd * (q + 1) : r * (q + 1) + (xcd - r) * q) + off; }
        const int nig = 8 * nN, gid = wgid / nig, fm = gid * 8, gsz = (nM - fm) < 8 ? (nM - fm) : 8;
        u.pm = fm + ((wgid % nig) % gsz); u.pn = (wgid % nig) / gsz; u.e = 0; return true;
    }
    DI const bf16* aptr(const Unit& u) const { return A + (size_t)u.pm * 256 * 1024; }
    DI const bf16* bptr(const Unit& u) const { return Bt + (size_t)u.pn * 256 * 1024; }
};
struct MoeOrder {
    const bf16* A; const bf16* Bt; size_t bstride; const LAS int* ul;
    DI bool next(int i, Unit& u) const {
        const int w = __builtin_amdgcn_readfirstlane(ul[i]); if (w < 0) return false;
        u.pm = w & 0xfff; u.pn = (w >> 12) & 0xf; u.e = w >> 16; return true;
    }
    DI const bf16* aptr(const Unit& u) const { return A + (size_t)u.pm * 256 * 1024; }
    DI const bf16* bptr(const Unit& u) const { return Bt + (size_t)u.e * bstride + (size_t)u.pn * 256 * 1024; }
};

struct EpiInproj {
    static constexpr bool PAIR = false;
    bf16* P; float* extra; const float* bias; const float* bias_x;
    DI void row8(const Unit& u, int r, int c, const float (&v)[8]) const {
        const int row = u.pm * 256 + r, col = u.pn * 256 + c;
        if (col < PLD) {
            float w[8];
#pragma unroll
            for (int j = 0; j < 8; ++j) w[j] = v[j] + (bias ? bias[col + j] : 0.f);
            *(u32x4*)(P + (size_t)row * PLD + col) = pack8(w);
        } else if (col < PLD + 32) {
            float* o = extra + (size_t)row * 32 + (col - PLD);
#pragma unroll
            for (int j = 0; j < 8; ++j) o[j] = v[j] + (bias_x ? bias_x[col - PLD + j] : 0.f);
        }
    }
};
struct EpiOutproj {
    static constexpr bool PAIR = false;
    const float* xs_l; const float* xs_c; float* X; float* XC; const float* mod; const float* bias; int row_off; int perm;
    DI void row8(const Unit& u, int r, int c, const float (&v)[8]) const {
        const int hrow = u.pm * 256 + r + row_off, col = u.pn * 256 + c;
        const float* src; float* dst; int mr;
        if (hrow < TC) { mr = 8; src = xs_c + (size_t)hrow * D + col; dst = XC + (size_t)hrow * D + col; }
        else { const int rr = hrow - TC, b = rr >> 11, sp = rr & (SEQ - 1), s = perm ? perm_inv(sp) : sp; mr = b;
               src = xs_l + ((size_t)b * SEQ + s) * D + col; dst = X + ((size_t)b * SEQ + s) * D + col; }
        const float* g1 = mod + mr * 6144 + 2048 + col;
        const f32x4 a0 = *(const f32x4*)src, a1 = *(const f32x4*)(src + 4), g0 = *(const f32x4*)g1, gg1 = *(const f32x4*)(g1 + 4);
        f32x4 b0 = {0.f, 0.f, 0.f, 0.f}, b1 = b0;
        if (bias) { b0 = *(const f32x4*)(bias + col); b1 = *(const f32x4*)(bias + col + 4); }
        f32x4 o0, o1;
        o0 = a0 + g0 * ((f32x4){v[0], v[1], v[2], v[3]} + b0); o1 = a1 + gg1 * ((f32x4){v[4], v[5], v[6], v[7]} + b1);
        *(f32x4*)dst = o0; *(f32x4*)(dst + 4) = o1;
    }
};
struct EpiUp {
    static constexpr bool PAIR = true;
    bf16* ACT;
    DI void row8p(const Unit& u, int r, int c, const float (&g)[8], const float (&up)[8]) const {
        float w[8];
#pragma unroll
        for (int j = 0; j < 8; ++j) w[j] = siluf_(g[j]) * up[j];
        *(u32x4*)(ACT + ((size_t)u.pm * 256 + r) * 1024 + u.pn * 128 + c) = pack8(w);
    }
};
struct EpiDown {
    static constexpr bool PAIR = false;
    bf16* YS;
    DI void row8(const Unit& u, int r, int c, const float (&v)[8]) const { *(u32x4*)(YS + ((size_t)u.pm * 256 + r) * 1024 + u.pn * 256 + c) = pack8(v); }
};

template <class Sched, class Epi>
DI void gemm_fast(LAS unsigned char* lds, int tid, const Sched& S, const Epi& E) {
    using namespace pg8;
    constexpr int K = 1024, nt = K / BK;
    const int wid = __builtin_amdgcn_readfirstlane(tid >> 6), lane = tid & 63, wr = wid >> 2, wc = wid & 3, fr = lane & 15, fq = lane >> 4;
    unsigned voffA[2], voffB[2];
#pragma unroll
    for (int i = 0; i < 2; ++i) { int R, C; stage_rc(tid * 16 + i * 8192, R, C); const int Rb = (R & ~31) + perm32(R & 31);
        voffA[i] = (unsigned)(R * K + C) * 2u; voffB[i] = (unsigned)(Rb * K + C) * 2u; }
    const size_t kstep = (size_t)(BK * 2);
    const size_t hstep = (size_t)HALF * K * 2;
    const unsigned ldsw = (unsigned)wid * 1024u;
    const int aoff = lds_byte(wr * 64 + fr, fq * 8), boff = lds_byte(wc * 32 + fr, fq * 8);
#define PG8_SA(b, h) (((b) * 2 + (h)) * HTB)
#define PG8_SB(b, h) ((4 + (b) * 2 + (h)) * HTB)
#define PG8_STAGE(bufoff, gbase, voff) do { _Pragma("unroll") for (int _i = 0; _i < 2; ++_i) \
        __builtin_amdgcn_global_load_lds((const unsigned*)((const char*)(gbase) + (voff)[_i]), (LAS unsigned*)(lds + (bufoff) + ldsw + _i * 8192), 16, 0, 0); } while (0)
#define PG8_LDA(dst, b, h) do { _Pragma("unroll") for (int m = 0; m < 4; ++m) _Pragma("unroll") for (int k = 0; k < 2; ++k) dst[m][k] = *(const LAS bf16x8*)(lds + PG8_SA(b, h) + aoff + m * 2048 + k * 1024); } while (0)
#define PG8_LDB(dst, b, h) do { _Pragma("unroll") for (int n = 0; n < 2; ++n) _Pragma("unroll") for (int k = 0; k < 2; ++k) dst[n][k] = *(const LAS bf16x8*)(lds + PG8_SB(b, h) + boff + n * 2048 + k * 1024); } while (0)
#define PG8_MMA(ai, bj, At, Bt) do { __builtin_amdgcn_s_setprio(1); _Pragma("unroll") for (int m = 0; m < 4; ++m) _Pragma("unroll") for (int n = 0; n < 2; ++n) _Pragma("unroll") for (int k = 0; k < 2; ++k) \
        acc[ai][bj][m][n] = __builtin_amdgcn_mfma_f32_16x16x32_bf16(Bt[n][k], At[m][k], acc[ai][bj][m][n], 0, 0, 0); __builtin_amdgcn_s_setprio(0); } while (0)
#define PG8_WAIT_V(n) asm volatile("s_waitcnt vmcnt(" #n ")" ::: "memory")
#define PG8_WAIT_L(n) asm volatile("s_waitcnt lgkmcnt(" #n ")" ::: "memory")
#define PG8_BAR __builtin_amdgcn_s_barrier()
#define PG8_SCHED __builtin_amdgcn_sched_barrier(0)
    Unit cur, nxt; int ui = 0;
    if (!S.next(0, cur)) return;
    f32x4 acc[2][2][4][2];
#pragma unroll
    for (int a = 0; a < 2; ++a)
#pragma unroll
        for (int b = 0; b < 2; ++b)
#pragma unroll
            for (int m = 0; m < 4; ++m)
#pragma unroll
                for (int n = 0; n < 2; ++n) acc[a][b][m][n] = (f32x4){0.f, 0.f, 0.f, 0.f};
    bf16x8 At[4][2], B0[2][2], B1[2][2];
    const char* cA = (const char*)S.aptr(cur); const char* cB = (const char*)S.bptr(cur);
    PG8_STAGE(PG8_SB(0, 0), cB, voffB); PG8_STAGE(PG8_SA(0, 0), cA, voffA); PG8_STAGE(PG8_SB(0, 1), cB + hstep, voffB); PG8_STAGE(PG8_SA(0, 1), cA + hstep, voffA);
    if (wr == 1) PG8_BAR;
    PG8_WAIT_V(4); PG8_BAR;
    PG8_STAGE(PG8_SB(1, 0), cB + kstep, voffB); PG8_STAGE(PG8_SA(1, 0), cA + kstep, voffA); PG8_STAGE(PG8_SB(1, 1), cB + hstep + kstep, voffB);
    PG8_WAIT_V(6); PG8_BAR;
    for (;;) {
        const bool has_next = S.next(ui + 1, nxt);
        const char* nA = has_next ? (const char*)S.aptr(nxt) : cA; const char* nB = has_next ? (const char*)S.bptr(nxt) : cB;
        for (int t = 0; t < nt; t += 2) {
            const bool last = (t == nt - 2);
            const char* a1 = cA + (size_t)(t + 1) * kstep;
            const char* a2 = last ? nA : cA + (size_t)(t + 2) * kstep; const char* b2 = last ? nB : cB + (size_t)(t + 2) * kstep;
            const char* a3 = a2 + kstep; const char* b3 = b2 + kstep;
            PG8_LDB(B0, 0, 0); PG8_SCHED; PG8_LDA(At, 0, 0); PG8_STAGE(PG8_SA(1, 1), a1 + hstep, voffA);
            PG8_WAIT_L(8); PG8_BAR; PG8_WAIT_L(0); PG8_MMA(0, 0, At, B0); PG8_BAR; PG8_SCHED;
            PG8_LDB(B1, 0, 1); PG8_STAGE(PG8_SB(0, 0), b2, voffB);
            PG8_BAR; PG8_WAIT_L(0); PG8_MMA(0, 1, At, B1); PG8_BAR;
            PG8_LDA(At, 0, 1); PG8_STAGE(PG8_SA(0, 0), a2, voffA);
            PG8_BAR; PG8_WAIT_L(0); PG8_MMA(1, 0, At, B0); PG8_BAR; PG8_SCHED;
            PG8_STAGE(PG8_SB(0, 1), b2 + hstep, voffB);
            PG8_WAIT_V(6); PG8_BAR; PG8_MMA(1, 1, At, B1); PG8_BAR;
            PG8_LDB(B0, 1, 0); PG8_SCHED; PG8_LDA(At, 1, 0); PG8_STAGE(PG8_SA(0, 1), a2 + hstep, voffA);
            PG8_WAIT_L(8); PG8_BAR; PG8_WAIT_L(0); PG8_MMA(0, 0, At, B0); PG8_BAR; PG8_SCHED;
            PG8_LDB(B1, 1, 1); PG8_STAGE(PG8_SB(1, 0), b3, voffB);
            PG8_BAR; PG8_WAIT_L(0); PG8_MMA(0, 1, At, B1); PG8_BAR;
            PG8_LDA(At, 1, 1); PG8_STAGE(PG8_SA(1, 0), a3, voffA);
            PG8_BAR; PG8_WAIT_L(0); PG8_MMA(1, 0, At, B0); PG8_BAR; PG8_SCHED;
            PG8_STAGE(PG8_SB(1, 1), b3 + hstep, voffB);
            PG8_WAIT_V(6); PG8_BAR; PG8_MMA(1, 1, At, B1); PG8_BAR;
        }
#pragma unroll
        for (int ai = 0; ai < 2; ++ai)
#pragma unroll
            for (int m = 0; m < 4; ++m) {
                const int r = ai * HALF + wr * 64 + m * 16 + fr;
                if constexpr (Epi::PAIR) {
                    const float g[8] = {acc[ai][0][m][0][0], acc[ai][0][m][0][1], acc[ai][0][m][0][2], acc[ai][0][m][0][3], acc[ai][0][m][1][0], acc[ai][0][m][1][1], acc[ai][0][m][1][2], acc[ai][0][m][1][3]};
                    const float up[8] = {acc[ai][1][m][0][0], acc[ai][1][m][0][1], acc[ai][1][m][0][2], acc[ai][1][m][0][3], acc[ai][1][m][1][0], acc[ai][1][m][1][1], acc[ai][1][m][1][2], acc[ai][1][m][1][3]};
                    E.row8p(cur, r, wc * 32 + 8 * fq, g, up);
                } else {
#pragma unroll
                    for (int bj = 0; bj < 2; ++bj) {
                        const float v[8] = {acc[ai][bj][m][0][0], acc[ai][bj][m][0][1], acc[ai][bj][m][0][2], acc[ai][bj][m][0][3], acc[ai][bj][m][1][0], acc[ai][bj][m][1][1], acc[ai][bj][m][1][2], acc[ai][bj][m][1][3]};
                        E.row8(cur, r, bj * HALF + wc * 32 + 8 * fq, v);
                    }
                }
            }
        if (!has_next) break;
#pragma unroll
        for (int a = 0; a < 2; ++a)
#pragma unroll
            for (int b = 0; b < 2; ++b)
#pragma unroll
                for (int m = 0; m < 4; ++m)
#pragma unroll
                    for (int n = 0; n < 2; ++n) acc[a][b][m][n] = (f32x4){0.f, 0.f, 0.f, 0.f};
        cur = nxt; cA = nA; cB = nB; ++ui;
    }
    PG8_WAIT_V(0);
    if (wr == 0) PG8_BAR;
    PG8_BAR;
#undef PG8_SA
#undef PG8_SB
#undef PG8_STAGE
#undef PG8_LDA
#undef PG8_LDB
#undef PG8_MMA
#undef PG8_WAIT_V
#undef PG8_WAIT_L
#undef PG8_BAR
#undef PG8_SCHED
}

template <class Sched, class Epi>
DI void gemm_naive(LAS unsigned char* lds, int tid, const Sched& S, const Epi& E) {
    LAS float* As = (LAS float*)lds;
    LAS float* Bs = As + 32 * 132;
    LAS float* Bu = Bs + 32 * 132;
    const int ty = tid >> 4, tx = tid & 15, lr = tid >> 2, kq = tid & 3;
    Unit u;
    for (int i = 0; S.next(i, u); ++i) {
        const bf16* A = S.aptr(u); const bf16* B = S.bptr(u);
        for (int sm = 0; sm < 2; ++sm)
            for (int sn = 0; sn < (Epi::PAIR ? 1 : 2); ++sn) {
                float acc[4][8], accu[4][8];
#pragma unroll
                for (int a = 0; a < 4; ++a)
#pragma unroll
                    for (int b = 0; b < 8; ++b) { acc[a][b] = 0.f; accu[a][b] = 0.f; }
                for (int k0 = 0; k0 < 1024; k0 += 32) {
                    __syncthreads();
                    { float w[8]; unpack8(*(const u32x4*)(A + (size_t)(128 * sm + lr) * 1024 + k0 + 8 * kq), w);
#pragma unroll
                      for (int j = 0; j < 8; ++j) As[(8 * kq + j) * 132 + lr] = w[j];
                      unpack8(*(const u32x4*)(B + (size_t)(128 * sn + lr) * 1024 + k0 + 8 * kq), w);
#pragma unroll
                      for (int j = 0; j < 8; ++j) Bs[(8 * kq + j) * 132 + lr] = w[j];
                      if (Epi::PAIR) { unpack8(*(const u32x4*)(B + (size_t)(128 + lr) * 1024 + k0 + 8 * kq), w);
#pragma unroll
                          for (int j = 0; j < 8; ++j) Bu[(8 * kq + j) * 132 + lr] = w[j]; } }
                    __syncthreads();
#pragma unroll 4
                    for (int k = 0; k < 32; ++k) {
                        const f32x4 a4 = *(const LAS f32x4*)(As + k * 132 + 4 * ty);
                        const f32x4 b0 = *(const LAS f32x4*)(Bs + k * 132 + 8 * tx), b1 = *(const LAS f32x4*)(Bs + k * 132 + 8 * tx + 4);
#pragma unroll
                        for (int a = 0; a < 4; ++a) {
#pragma unroll
                            for (int b = 0; b < 4; ++b) { acc[a][b] += a4[a] * b0[b]; acc[a][4 + b] += a4[a] * b1[b]; } }
                        if (Epi::PAIR) {
                            const f32x4 c0 = *(const LAS f32x4*)(Bu + k * 132 + 8 * tx), c1 = *(const LAS f32x4*)(Bu + k * 132 + 8 * tx + 4);
#pragma unroll
                            for (int a = 0; a < 4; ++a) {
#pragma unroll
                                for (int b = 0; b < 4; ++b) { accu[a][b] += a4[a] * c0[b]; accu[a][4 + b] += a4[a] * c1[b]; } }
                        }
                    }
                }
#pragma unroll
                for (int a = 0; a < 4; ++a) {
                    if constexpr (Epi::PAIR) E.row8p(u, 128 * sm + 4 * ty + a, 8 * tx, acc[a], accu[a]);
                    else E.row8(u, 128 * sm + 4 * ty + a, 128 * sn + 8 * tx, acc[a]);
                }
            }
    }
    __syncthreads();
}
template <class Sched, class Epi>
DI void gemm_run(LAS unsigned char* lds, int tid, const Sched& S, const Epi& E) {
#if FAST_GEMM
    gemm_fast(lds, tid, S, E);
#else
    gemm_naive(lds, tid, S, E);
#endif
}

struct Ctx {
    LAS unsigned char* lds;
    int tid, lane, wave, gw, ngw;
    const float* const* in;
    float* out;
    unsigned char* ws;
};
#define WSP(T, off) ((T*)(c.ws + (off)))

DI void transpose_item(const float* W, int N, bf16* WT, int k0, int n0, int dst_row0, LAS float* scr, int lane) {
#pragma unroll 8
    for (int i = 0; i < 32; ++i) { const int kk = 2 * i + (lane >> 5); scr[kk * 33 + (lane & 31)] = W[(size_t)(k0 + kk) * N + n0 + (lane & 31)]; }
    asm volatile("s_waitcnt lgkmcnt(0)" ::: "memory");
    const int cc = lane & 7;
#pragma unroll
    for (int j = 0; j < 4; ++j) { const int n = (lane >> 3) + 8 * j; const LAS float* s = scr + (8 * cc) * 33 + n;
        u32x4 o; o.x = cvt_pk_bf16(s[0 * 33], s[1 * 33]); o.y = cvt_pk_bf16(s[2 * 33], s[3 * 33]); o.z = cvt_pk_bf16(s[4 * 33], s[5 * 33]); o.w = cvt_pk_bf16(s[6 * 33], s[7 * 33]);
        *(u32x4*)(WT + (size_t)(dst_row0 + n) * 1024 + k0 + 8 * cc) = o; }
    asm volatile("s_waitcnt lgkmcnt(0)" ::: "memory");
}
DI void dense_transpose(const Ctx& c, const float* W, int N, bf16* WT, LAS float* scr) {
    const int nblk = N / 32, nitems = 16 * nblk;
    for (int it = c.gw; it < nitems; it += c.ngw) { const int kb = it / nblk, nb = it % nblk; transpose_item(W, N, WT, 64 * kb, 32 * nb, 32 * nb, scr, c.lane); }
}
DI void phase_pro0(const Ctx& c) {
    LAS float* scr = (LAS float*)(c.lds + c.wave * 8704);
    for (int j = 0; j < 2; ++j) {
        dense_transpose(c, c.in[I_MLWIN] + (size_t)j * 1024 * 3104, 3104, WSP(bf16, WS_ML_WIN) + (size_t)j * NINP * 1024, scr);
        dense_transpose(c, c.in[I_MLWOUT] + (size_t)j * 1024 * 1024, 1024, WSP(bf16, WS_ML_WOUT) + (size_t)j * 1024 * 1024, scr);
    }
    dense_transpose(c, c.in[I_GLWIN], 3104, WSP(bf16, WS_GLA_WIN), scr);
    dense_transpose(c, c.in[I_GLWOUT], 1024, WSP(bf16, WS_GLA_WOUT), scr);
    dense_transpose(c, c.in[I_HYWIN], 3072, WSP(bf16, WS_HY_WIN), scr);
    dense_transpose(c, c.in[I_HYWOUT], 1024, WSP(bf16, WS_HY_WOUT), scr);
    for (int it = c.gw * 64 + c.lane; it < 3 * 28672; it += c.ngw * 64) {
        const int m = it / 28672, r = it % 28672; bf16* base = (m < 2) ? WSP(bf16, WS_ML_WIN) + (size_t)m * NINP * 1024 : WSP(bf16, WS_GLA_WIN);
        *(u32x4*)(base + (size_t)3104 * 1024 + (size_t)r * 8) = (u32x4){0u, 0u, 0u, 0u};
    }
    for (int it = c.gw; it < 64 * 3 * 512; it += c.ngw) {
        const int le = it / 1536, r0 = it % 1536, which = r0 / 512, r = r0 % 512, kb = r / 32, nb = r % 32;
        if (which < 2) {
            const float* W = c.in[which == 0 ? I_EW1 : I_EW3] + (size_t)le * 1024 * 1024;
            const int n0 = 32 * nb, drow = 256 * (n0 >> 7) + (n0 & 127) + (which ? 128 : 0);
            transpose_item(W, 1024, WSP(bf16, WS_EXP_UP) + (size_t)le * 2048 * 1024, 64 * kb, n0, drow, scr, c.lane);
        } else {
            transpose_item(c.in[I_EW2] + (size_t)le * 1024 * 1024, 1024, WSP(bf16, WS_EXP_DN) + (size_t)le * 1024 * 1024, 64 * kb, 32 * nb, 32 * nb, scr, c.lane);
        }
    }
    {
        const float* w1 = c.in[I_HYFW1]; const float* b1 = c.in[I_HYFB1]; const float* wm = c.in[I_HYFWM]; const float* bm = c.in[I_HYFBM]; const float* fr = c.in[I_HYFREQ];
        float* HM = WSP(float, WS_HM);
        for (int row = c.gw; row < 2304; row += c.ngw) {
            const int L = row < 2048 ? 2048 : 256, t = row < 2048 ? row : row - 2048, f = c.lane;
            float feat = 0.f;
            if (f == 0) feat = (float)t / (float)(L - 1);
            else if (f <= 32) { const int b = (f - 1) & 15; const float band = 1e-4f + (float)b * ((15.0f - 1e-4f) / 15.0f);
                const float ang = ((float)(2.0 * 3.14159265358979323846 / (double)L) * (float)t) * band; feat = (f <= 16) ? cosf(ang) : -sinf(ang); }
            float a = b1[f];
            for (int e = 0; e < 33; ++e) a += __shfl(feat, e) * w1[e * 64 + f];
            float h = sinf(fr[f] * a);
            for (int m = 0; m < 2; ++m) {
                float a2 = bm[m * 64 + f];
                for (int g = 0; g < 64; ++g) a2 += __shfl(h, g) * wm[m * 4096 + g * 64 + f];
                h = sinf(fr[f] * a2);
            }
            HM[row * 64 + f] = h;
        }
    }
    __syncthreads();
    {
        LAS float* sv = (LAS float*)c.lds;
        LAS float* red = sv + 9 * 1024;
        for (int i = c.tid; i < 9 * 1024; i += 512) { const float x = (i < 8192) ? c.in[I_C][i] : c.in[I_CCTX][i - 8192]; sv[i] = siluf_(x); }
        __syncthreads();
        float* MOD = WSP(float, WS_MOD);
        const int col = c.tid & 63, kg = c.tid >> 6;
        for (int item = blockIdx.x; item < 4 * 96; item += gridDim.x) {
            const int l = item / 96, j0 = 64 * (item % 96);
            const float* w = c.in[I_ADAW] + (size_t)l * 1024 * 6144 + j0 + col;
            float acc[9];
#pragma unroll
            for (int r = 0; r < 9; ++r) acc[r] = 0.f;
            for (int k = kg * 128; k < kg * 128 + 128; ++k) { const float wv = w[(size_t)k * 6144];
#pragma unroll
                for (int r = 0; r < 9; ++r) acc[r] += sv[r * 1024 + k] * wv; }
#pragma unroll
            for (int r = 0; r < 9; ++r) red[(kg * 9 + r) * 64 + col] = acc[r];
            __syncthreads();
            for (int o = c.tid; o < 9 * 64; o += 512) { const int r = o >> 6, cc = o & 63; float s = c.in[I_ADAB][l * 6144 + j0 + cc];
#pragma unroll
                for (int g = 0; g < 8; ++g) s += red[(g * 9 + r) * 64 + cc];
                MOD[(l * 9 + r) * 6144 + j0 + cc] = s; }
            __syncthreads();
        }
    }
}

template <int L>
DI void pro1_len(const Ctx& c, int c0, const float* hm, float* tab, const LAS float* wo  , LAS float* red  ) {
    constexpr int NT = (L + 511) / 512;
    float val[NT][8]; float part[4] = {0.f, 0.f, 0.f, 0.f};
    const float da = -4.605170185988091f / 1.5f, db = -4.605170185988091f / 0.3f;
#pragma unroll
    for (int i = 0; i < NT; ++i) {
        const int t = c.tid + 512 * i;
#pragma unroll
        for (int o = 0; o < 8; ++o) val[i][o] = 0.f;
        if (t < L) {
            const float* hr = hm + (size_t)t * 64;
#pragma unroll 2
            for (int q = 0; q < 16; ++q) { const f32x4 h4 = *(const f32x4*)(hr + 4 * q); asm volatile("" ::: "memory");
#pragma unroll
                for (int o = 0; o < 8; ++o) { const f32x4 w4 = *(const LAS f32x4*)(wo + o * 64 + 4 * q); val[i][o] += (h4.x * w4.x + h4.y * w4.y) + (h4.z * w4.z + h4.w * w4.w); } }
            const float tl = (float)t / (float)(L - 1);
#pragma unroll
            for (int ch = 0; ch < 4; ++ch) { const float delta = fabsf(da + (float)(c0 + ch) * ((db - da) / 1023.0f)), dec = expf(-tl * delta);
                val[i][ch] *= dec; val[i][4 + ch] *= dec; part[ch] += fabsf(val[i][ch]) + (t >= 1 ? fabsf(val[i][4 + ch]) : 0.f); }
        }
    }
#pragma unroll
    for (int ch = 0; ch < 4; ++ch) part[ch] = wave_sum(part[ch]);
    __syncthreads();
    if (c.lane == 0) {
#pragma unroll
        for (int ch = 0; ch < 4; ++ch) red[c.wave * 4 + ch] = part[ch]; }
    __syncthreads();
    float inv[4];
#pragma unroll
    for (int ch = 0; ch < 4; ++ch) { float s = 0.f;
#pragma unroll
        for (int w = 0; w < 8; ++w) s += red[w * 4 + ch];
        inv[ch] = 1.0f / s; }
#pragma unroll
    for (int i = 0; i < NT; ++i) { const int t = c.tid + 512 * i;
        if (t < L) {
#pragma unroll
            for (int ch = 0; ch < 4; ++ch) { float* trow = tab + (size_t)(c0 + ch) * (2 * L); trow[L + t] = val[i][ch] * inv[ch]; if (t >= 1) trow[L - t] = val[i][4 + ch] * inv[ch]; else trow[0] = 0.f; } } }
}
DI void phase_pro1(const Ctx& c) {
    LAS float* wo = (LAS float*)c.lds;
    LAS float* red = wo + 512;
    const float* HM = WSP(float, WS_HM);
    for (int item = blockIdx.x; item < 256; item += gridDim.x) {
        const int c0 = 4 * item;
        __syncthreads();
        { const int o = c.tid >> 6, f = c.tid & 63; wo[c.tid] = c.in[I_HYFWO][f * 2048 + (o >> 2) * 1024 + c0 + (o & 3)]; }
        __syncthreads();
        pro1_len<SEQ>(c, c0, HM, WSP(float, WS_HF), wo, red);
        pro1_len<CTX>(c, c0, HM + 2048 * 64, WSP(float, WS_HFC), wo, red);
    }
}

DI void load_row(const float* src, f32x4 (&v)[4], int lane) {
#pragma unroll
    for (int j = 0; j < 4; ++j) v[j] = *(const f32x4*)(src + 256 * j + 4 * lane);
}
DI void norm_row(f32x4 (&v)[4], const float* g, int lane) {
    float s = 0.f;
#pragma unroll
    for (int j = 0; j < 4; ++j) s += (v[j].x * v[j].x + v[j].y * v[j].y) + (v[j].z * v[j].z + v[j].w * v[j].w);
    s = wave_sum(s);
    const float r = 1.0f / sqrtf(s * (1.0f / 1024.0f) + EPS);
#pragma unroll
    for (int j = 0; j < 4; ++j) v[j] = v[j] * r * *(const f32x4*)(g + 256 * j + 4 * lane);
}
DI void mod_row(f32x4 (&v)[4], const float* sh, const float* sc, int lane) {
#pragma unroll
    for (int j = 0; j < 4; ++j) v[j] = v[j] * (*(const f32x4*)(sc + 256 * j + 4 * lane) + 1.0f) + *(const f32x4*)(sh + 256 * j + 4 * lane);
}
DI void store_row_bf16(bf16* dst, const f32x4 (&v)[4], int lane) {
#pragma unroll
    for (int j = 0; j < 4; ++j) { u32x2 w; w.x = cvt_pk_bf16(v[j].x, v[j].y); w.y = cvt_pk_bf16(v[j].z, v[j].w); *(u32x2*)(dst + 256 * j + 4 * lane) = w; }
}
DI int hrow_of(int srow, int kind) {
    if (srow < TC || kind != 1) return srow;
    const int rr = srow - TC, b = rr >> 11, s = rr & (SEQ - 1); return TC + b * SEQ + perm_fwd(s);
}
DI void phase_norm1(const Ctx& c, int l, const float* xl, const float* xc) {
    const float* MOD = WSP(float, WS_MOD) + (size_t)l * 9 * 6144; const float* g = c.in[I_N1G] + l * D; bf16* H = WSP(bf16, WS_H);
    for (int row = c.gw; row < TT; row += c.ngw) {
        f32x4 v[4]; const int mr = row < TC ? 8 : (row - TC) >> 11;
        load_row(row < TC ? xc + (size_t)row * D : xl + (size_t)(row - TC) * D, v, c.lane);
        norm_row(v, g, c.lane); mod_row(v, MOD + mr * 6144, MOD + mr * 6144 + 1024, c.lane);
        store_row_bf16(H + (size_t)hrow_of(row, l % 3) * D, v, c.lane);
    }
}

DI void phase_conv(const Ctx& c, int ncols, const float* cw, const float* cb, bool act, float qs) {
    const bf16* P = WSP(bf16, WS_P); bf16* PC = WSP(bf16, WS_BIG + BIG_PC);
    const int ng = ncols / 8; const long total = (long)TT * ng;
    for (long idx = (long)blockIdx.x * 512 + c.tid; idx < total; idx += (long)gridDim.x * 512) {
        const int row = (int)(idx / ng), col = (int)(idx % ng) * 8; int lo, hi; seq_bounds(row, lo, hi);
        float x0[8], xm[8], xp[8];
        unpack8(*(const u32x4*)(P + (size_t)row * PLD + col), x0);
        if (row > lo) unpack8(*(const u32x4*)(P + (size_t)(row - 1) * PLD + col), xm); else {
#pragma unroll
            for (int j = 0; j < 8; ++j) xm[j] = 0.f; }
        if (row < hi) unpack8(*(const u32x4*)(P + (size_t)(row + 1) * PLD + col), xp); else {
#pragma unroll
            for (int j = 0; j < 8; ++j) xp[j] = 0.f; }
        float o[8];
#pragma unroll
        for (int j = 0; j < 8; ++j) { float v = cw[col + j] * xm[j] + cw[ncols + col + j] * x0[j] + cw[2 * ncols + col + j] * xp[j] + cb[col + j];
            if (act) v = siluf_(v); if (col < 512) v *= qs; o[j] = v; }
        *(u32x4*)(PC + (size_t)row * ncols + col) = pack8(o);
    }
}

DI int scan_row(int step, int b, int dir) {
    if (step < CTX) return b * CTX + (dir ? CTX - 1 - step : step);
    const int s = step - CTX; return TC + b * SEQ + (dir ? SEQ - 1 - s : s);
}
DI void phase_mlstm_scan_naive(const Ctx& c) {
    const bf16* P = WSP(bf16, WS_P); const bf16* PC = WSP(bf16, WS_BIG + BIG_PC); const float* EX = WSP(float, WS_EXTRA);
    LAS float* qs = (LAS float*)c.lds; LAS float* ks = qs + 32 * 64; LAS float* vs = ks + 32 * 64; LAS float* gs = vs + 32 * 128;
    const int v = c.tid >> 2, d0 = (c.tid & 3) * 16;
    for (int item = blockIdx.x; item < 128; item += gridDim.x) {
        const int b = item >> 4, h = (item >> 1) & 7, dir = item & 1;
        float* Yo = WSP(float, WS_BIG + (dir ? BIG_YB : BIG_YF));
        float C[16], n[16];
#pragma unroll
        for (int d = 0; d < 16; ++d) { C[d] = 0.f; n[d] = 0.f; }
        for (int ch = 0; ch < (CTX + SEQ) / 32; ++ch) {
            __syncthreads();
            for (int idx = c.tid; idx < 32 * 256; idx += 512) { const int st = idx >> 8, col = idx & 255, row = scan_row(ch * 32 + st, b, dir);
                if (col < 64) qs[st * 64 + col] = bf2f(PC[(size_t)row * 1024 + h * 64 + col]);
                else if (col < 128) ks[st * 64 + col - 64] = bf2f(PC[(size_t)row * 1024 + 512 + h * 64 + col - 64]);
                else vs[st * 128 + col - 128] = bf2f(P[(size_t)row * PLD + 1024 + h * 128 + col - 128]); }
            if (c.tid < 32) { const int row = scan_row(ch * 32 + c.tid, b, dir); gs[c.tid * 2] = sigmoidf_(EX[(size_t)row * 32 + dir * 16 + 8 + h]); gs[c.tid * 2 + 1] = __expf(EX[(size_t)row * 32 + dir * 16 + h]); }
            __syncthreads();
            for (int st = 0; st < 32; ++st) {
                const float f = gs[st * 2], ei = gs[st * 2 + 1], vv = vs[st * 128 + v] * ei;
                float part = 0.f, dpart = 0.f;
#pragma unroll
                for (int d = 0; d < 16; ++d) { const float kd = ks[st * 64 + d0 + d], qd = qs[st * 64 + d0 + d];
                    C[d] = f * C[d] + kd * vv; part += qd * C[d]; n[d] = f * n[d] + ei * kd; dpart += qd * n[d]; }
                part += __shfl_xor(part, 1); part += __shfl_xor(part, 2); dpart += __shfl_xor(dpart, 1); dpart += __shfl_xor(dpart, 2);
                if ((c.tid & 3) == 0) { const int row = scan_row(ch * 32 + st, b, dir); Yo[(size_t)row * D + h * 128 + v] = part / fmaxf(fabsf(dpart), 1.0f); }
            }
        }
    }
}
typedef short s16x4 __attribute__((ext_vector_type(4)));
typedef float f32x16 __attribute__((ext_vector_type(16)));
#define MFMA32(a, b, c) __builtin_amdgcn_mfma_f32_32x32x16_bf16((a), (b), (c), 0, 0, 0)
DI int crow(int reg, int h) { return (reg & 3) + 8 * (reg >> 2) + 4 * h; }
DI s16x4 ds_tr(const LAS unsigned char* p) { return __builtin_amdgcn_ds_read_tr16_b64_v4i16((LAS s16x4*)p); }
DI bf16x8 cat8(s16x4 lo, s16x4 hi) { return __builtin_shufflevector(lo, hi, 0, 1, 2, 3, 4, 5, 6, 7); }
DI bf16x8 tr_frag(const LAS unsigned char* img, int pitch, int k0, int n0, int lane) {
    const int h = lane >> 5, g16 = (lane >> 4) & 1, i = lane & 15;
    const LAS unsigned char* p = img + (k0 + 8 * h + (i >> 2)) * pitch + (n0 + 16 * g16 + 4 * (i & 3)) * 2;
    return cat8(ds_tr(p), ds_tr(p + 4 * pitch));
}
DI bf16x8 tr_frag_perm(const LAS unsigned char* img, int pitch, int k0, int n0, int lane) {
    const int h = lane >> 5, g16 = (lane >> 4) & 1, i = lane & 15;
    const LAS unsigned char* p = img + (k0 + 4 * h + (i >> 2)) * pitch + (n0 + 16 * g16 + 4 * (i & 3)) * 2;
    return cat8(ds_tr(p), ds_tr(p + 8 * pitch));
}
DI bf16x8 row_frag(const LAS unsigned char* img, int pitch, int row0, int k0, int lane) { return *(const LAS bf16x8*)(img + (row0 + (lane & 31)) * pitch + (k0 + 8 * (lane >> 5)) * 2); }
DI bf16x8 pack_acc(const f32x16& x, int step) {
    u32x4 p; const int o = 8 * step;
    p.x = cvt_pk_bf16(x[o], x[o + 1]); p.y = cvt_pk_bf16(x[o + 2], x[o + 3]); p.z = cvt_pk_bf16(x[o + 4], x[o + 5]); p.w = cvt_pk_bf16(x[o + 6], x[o + 7]);
    return __builtin_bit_cast(bf16x8, p);
}
DI f32x16 zero16() { f32x16 z;
#pragma unroll
    for (int i = 0; i < 16; ++i) z[i] = 0.f; return z; }
DI float wave_incl_prefix(float x, int lane) {
#pragma unroll
    for (int o = 1; o < 64; o <<= 1) { const float t = __shfl_up(x, o); if (lane >= o) x += t; }
    return x;
}
DI float wave_incl_suffix(float x, int lane) {
#pragma unroll
    for (int o = 1; o < 64; o <<= 1) { const float t = __shfl_down(x, o); if (lane + o < 64) x += t; }
    return x;
}
DI int chunk_row0(int p, int b, int dir) {
    if (p < 4) return b * CTX + 64 * (dir ? 3 - p : p);
    return TC + b * SEQ + 64 * (dir ? 35 - p : p - 4);
}

DI void phase_mlstm_state(const Ctx& c) {
    const bf16* P = WSP(bf16, WS_P); const bf16* PC = WSP(bf16, WS_BIG + BIG_PC); const float* EX = WSP(float, WS_EXTRA);
    bf16* MCT = WSP(bf16, WS_BIG + BIG_MCT); float* MN = WSP(float, WS_BIG + BIG_MN);
    LAS float* gi = (LAS float*)c.lds; LAS float* ga = gi + 2304; LAS float* wv = ga + 2304; LAS float* dec = wv + 64;
    LAS unsigned char* Kw = c.lds + 20480; LAS unsigned char* Vs = Kw + 64 * 144;
    const int lane = c.lane, wave = c.wave, h5 = lane >> 5, l31 = lane & 31;
    for (int item = blockIdx.x; item < 256; item += gridDim.x) {
        const int b = item >> 5, h = (item >> 2) & 7, dir = (item >> 1) & 1, dvh = item & 1, seq = (b * 8 + h) * 2 + dir;
        __syncthreads();
        for (int idx = c.tid; idx < 2304; idx += 512) { const int row = chunk_row0(idx >> 6, b, dir) + (idx & 63);
            gi[idx] = EX[(size_t)row * 32 + dir * 16 + h]; ga[idx] = logsigf_(EX[(size_t)row * 32 + dir * 16 + 8 + h]); }
        f32x16 acc = zero16(); float nst = 0.f;
        const int dt = wave & 1, vt = (wave >> 1) & 1;
        const int srow = c.tid >> 3, spc = c.tid & 7;
        u32x4 kreg, vreg;
        { const int r0 = chunk_row0(0, b, dir);
          kreg = *(const u32x4*)(PC + (size_t)(r0 + srow) * 1024 + 512 + h * 64 + 8 * spc);
          vreg = *(const u32x4*)(P + (size_t)(r0 + srow) * PLD + 1024 + h * 128 + dvh * 64 + 8 * spc); }
        __syncthreads();
        for (int p = 0; p < 36; ++p) {
            if (wave < 4) {
                bf16* dst = MCT + ((size_t)seq * 36 + p) * 8192 + (size_t)(dvh * 64 + 32 * vt + l31) * 64 + 32 * dt + 4 * h5;
#pragma unroll
                for (int q = 0; q < 4; ++q) { u32x2 w; w.x = cvt_pk_bf16(acc[4 * q], acc[4 * q + 1]); w.y = cvt_pk_bf16(acc[4 * q + 2], acc[4 * q + 3]); *(u32x2*)(dst + 8 * q) = w; }
            } else if (wave == 4) { if (dvh == 0) MN[((size_t)seq * 36 + p) * 64 + lane] = nst; }
            else if (wave == 7) {
                const float a = ga[p * 64 + lane]; const float bj = dir ? wave_incl_suffix(a, lane) : wave_incl_prefix(a, lane);
                const float tot = __shfl(bj, dir ? 0 : 63);
                wv[lane] = __expf(tot - bj + gi[p * 64 + lane]); if (lane == 0) dec[0] = __expf(tot);
            }
            __syncthreads();
            { float kk[8]; unpack8(kreg, kk); const float w = wv[srow];
#pragma unroll
              for (int j = 0; j < 8; ++j) kk[j] *= w;
              *(LAS u32x4*)(Kw + srow * 144 + spc * 16) = pack8(kk); *(LAS u32x4*)(Vs + srow * 144 + spc * 16) = vreg; }
            if (p + 1 < 36) { const int r0 = chunk_row0(p + 1, b, dir);
                kreg = *(const u32x4*)(PC + (size_t)(r0 + srow) * 1024 + 512 + h * 64 + 8 * spc);
                vreg = *(const u32x4*)(P + (size_t)(r0 + srow) * PLD + 1024 + h * 128 + dvh * 64 + 8 * spc); }
            const float d = dec[0];
            __syncthreads();
            if (wave < 4) {
#pragma unroll
                for (int i = 0; i < 16; ++i) acc[i] *= d;
#pragma unroll
                for (int kk = 0; kk < 4; ++kk) acc = MFMA32(tr_frag(Kw, 144, 16 * kk, 32 * dt, lane), tr_frag(Vs, 144, 16 * kk, 32 * vt, lane), acc);
            } else if (wave == 4) {
                float s = 0.f;
                for (int r = 0; r < 64; ++r) s += bf2f(*(const LAS bf16*)(Kw + r * 144 + lane * 2));
                nst = d * nst + s;
            }
        }
    }
}

DI void phase_mlstm_out(const Ctx& c, const float* ng) {
    const bf16* P = WSP(bf16, WS_P); const bf16* PC = WSP(bf16, WS_BIG + BIG_PC); const float* EX = WSP(float, WS_EXTRA);
    const bf16* MCT = WSP(bf16, WS_BIG + BIG_MCT); const float* MN = WSP(float, WS_BIG + BIG_MN); bf16* Y = WSP(bf16, WS_Y);
    LAS unsigned char* Qs = c.lds; LAS unsigned char* Ks = Qs + 9216; LAS unsigned char* Vs = Ks + 9216;
    LAS unsigned char* CT0 = Vs + 17408;
    LAS float* gt = (LAS float*)(c.lds + MISC_OFF + 1024);
    LAS float* YO = (LAS float*)c.lds;
    const int lane = c.lane, wave = c.wave, h5 = lane >> 5, l31 = lane & 31;
    const int dir = wave >> 2, jt = (wave >> 1) & 1, vh = wave & 1;
    for (int item = blockIdx.x; item < 2304; item += gridDim.x) {
        const int b = item / 288, h = (item / 36) & 7, cc = item % 36;
        const int r0 = cc < 4 ? b * CTX + 64 * cc : TC + b * SEQ + 64 * (cc - 4);
        const int pf = cc, pb = cc < 4 ? 3 - cc : 39 - cc;
        __syncthreads();
        { const int srow = c.tid >> 3, spc = c.tid & 7;
          *(LAS u32x4*)(Qs + srow * 144 + spc * 16) = *(const u32x4*)(PC + (size_t)(r0 + srow) * 1024 + h * 64 + 8 * spc);
          *(LAS u32x4*)(Ks + srow * 144 + spc * 16) = *(const u32x4*)(PC + (size_t)(r0 + srow) * 1024 + 512 + h * 64 + 8 * spc);
#pragma unroll
          for (int i = 0; i < 2; ++i) *(LAS u32x4*)(Vs + srow * 272 + (spc + 8 * i) * 16) = *(const u32x4*)(P + (size_t)(r0 + srow) * PLD + 1024 + h * 128 + 8 * (spc + 8 * i));
#pragma unroll
          for (int i = 0; i < 4; ++i) { const int pc = c.tid + 512 * i, d2 = pc >> 10, rr = (pc >> 3) & 127, sp = pc & 7;
              const size_t so = (((size_t)((b * 8 + h) * 2 + d2)) * 36 + (d2 ? pb : pf)) * 8192;
              *(LAS u32x4*)(CT0 + d2 * 18432 + rr * 144 + sp * 16) = *(const u32x4*)(MCT + so + rr * 64 + 8 * sp); }
          if (wave < 2) { const int d2 = wave; const int row = r0 + lane;
              const float a = logsigf_(EX[(size_t)row * 32 + d2 * 16 + 8 + h]), ig = EX[(size_t)row * 32 + d2 * 16 + h];
              const float bj = d2 ? wave_incl_suffix(a, lane) : wave_incl_prefix(a, lane);
              gt[d2 * 192 + lane] = bj; gt[d2 * 192 + 64 + lane] = ig - bj;
              gt[d2 * 192 + 128 + lane] = MN[(((size_t)((b * 8 + h) * 2 + d2)) * 36 + (d2 ? pb : pf)) * 64 + lane]; } }
        __syncthreads();
        const LAS float* g = gt + dir * 192; const LAS unsigned char* CT = CT0 + dir * 18432;
        const int j = 32 * jt + l31; const float bjj = g[j];
        bf16x8 qf[4];
#pragma unroll
        for (int kk = 0; kk < 4; ++kk) qf[kk] = row_frag(Qs, 144, 32 * jt, 16 * kk, lane);
        float qn = 0.f;
#pragma unroll
        for (int kk = 0; kk < 4; ++kk) { float qv[8]; unpack8(__builtin_bit_cast(u32x4, qf[kk]), qv);
#pragma unroll
            for (int e = 0; e < 8; ++e) qn += qv[e] * g[128 + 16 * kk + 8 * h5 + e]; }
        qn += __shfl_xor(qn, 32);
        f32x16 X[2]; float den = 0.f;
#pragma unroll
        for (int st = 0; st < 2; ++st) {
            X[st] = zero16();
            const bool live = dir ? (st >= jt) : (st <= jt);
            if (live) {
#pragma unroll
                for (int kk = 0; kk < 4; ++kk) X[st] = MFMA32(row_frag(Ks, 144, 32 * st, 16 * kk, lane), qf[kk], X[st]);
#pragma unroll
                for (int r = 0; r < 16; ++r) { const int s = 32 * st + crow(r, h5); const bool ok = dir ? (s >= j) : (s <= j);
                    const float w = ok ? __expf(bjj + g[64 + s]) : 0.f; X[st][r] *= w; den += X[st][r]; }
            }
        }
        den += __shfl_xor(den, 32);
        const float eb = __expf(bjj); den += eb * qn;
        const float scale = 1.0f / fmaxf(fabsf(den), 1.0f);
        f32x16 O[2];
#pragma unroll
        for (int t = 0; t < 2; ++t) {
            const int vt = 2 * vh + t; f32x16 z = zero16(), w = zero16();
#pragma unroll
            for (int st = 0; st < 2; ++st) { const bool live = dir ? (st >= jt) : (st <= jt);
                if (live) {
#pragma unroll
                    for (int step = 0; step < 2; ++step) z = MFMA32(tr_frag_perm(Vs, 272, 32 * st + 16 * step, 32 * vt, lane), pack_acc(X[st], step), z); } }
#pragma unroll
            for (int kk = 0; kk < 4; ++kk) w = MFMA32(row_frag(CT, 144, 32 * vt, 16 * kk, lane), qf[kk], w);
#pragma unroll
            for (int r = 0; r < 16; ++r) O[t][r] = (z[r] + eb * w[r]) * scale;
        }
        __syncthreads();
#pragma unroll
        for (int t = 0; t < 2; ++t) { const int vt = 2 * vh + t;
#pragma unroll
            for (int q = 0; q < 4; ++q) *(LAS f32x4*)(YO + dir * 8448 + j * 132 + 32 * vt + 8 * q + 4 * h5) = (f32x4){O[t][4 * q], O[t][4 * q + 1], O[t][4 * q + 2], O[t][4 * q + 3]}; }
        __syncthreads();
        { const int row = c.tid >> 3, c0 = (c.tid & 7) * 16; float y[16]; float ss = 0.f;
#pragma unroll
          for (int q = 0; q < 4; ++q) { const f32x4 a = *(const LAS f32x4*)(YO + row * 132 + c0 + 4 * q), bb = *(const LAS f32x4*)(YO + 8448 + row * 132 + c0 + 4 * q);
              y[4 * q] = a.x + bb.x; y[4 * q + 1] = a.y + bb.y; y[4 * q + 2] = a.z + bb.z; y[4 * q + 3] = a.w + bb.w; }
#pragma unroll
          for (int q = 0; q < 16; ++q) ss += y[q] * y[q];
          ss += __shfl_xor(ss, 1); ss += __shfl_xor(ss, 2); ss += __shfl_xor(ss, 4);
          const float r = 1.0f / sqrtf(ss * (1.0f / 128.0f) + EPS);
          float g0[8], g1[8];
          unpack8(*(const u32x4*)(P + (size_t)(r0 + row) * PLD + 2048 + h * 128 + c0), g0); unpack8(*(const u32x4*)(P + (size_t)(r0 + row) * PLD + 2048 + h * 128 + c0 + 8), g1);
          float o0[8], o1[8];
#pragma unroll
          for (int q = 0; q < 8; ++q) { o0[q] = y[q] * r * ng[h * 128 + c0 + q] * sigmoidf_(g0[q]); o1[q] = y[8 + q] * r * ng[h * 128 + c0 + 8 + q] * sigmoidf_(g1[q]); }
          *(u32x4*)(Y + (size_t)(r0 + row) * D + h * 128 + c0) = pack8(o0); *(u32x4*)(Y + (size_t)(r0 + row) * D + h * 128 + c0 + 8) = pack8(o1); }
    }
}

DI void gla_lg(const Ctx& c, const f32x4 (&low)[4], const LAS float* w2s, const LAS float* gbs, LAS float* lgs) {
    const int s = c.tid >> 3, d0 = 16 * (c.tid & 7);
    float pre[16];
#pragma unroll
    for (int e = 0; e < 16; ++e) pre[e] = gbs[d0 + e];
#pragma unroll
    for (int r = 0; r < 16; ++r) { const float lv = low[r >> 2][r & 3];
#pragma unroll
        for (int q = 0; q < 4; ++q) { const f32x4 w = *(const LAS f32x4*)(w2s + r * 128 + d0 + 4 * q); pre[4 * q] += lv * w.x; pre[4 * q + 1] += lv * w.y; pre[4 * q + 2] += lv * w.z; pre[4 * q + 3] += lv * w.w; } }
#pragma unroll
    for (int q = 0; q < 4; ++q) *(LAS f32x4*)(lgs + s * 128 + d0 + 4 * q) = (f32x4){logsigf_(pre[4 * q]) * 0.0625f, logsigf_(pre[4 * q + 1]) * 0.0625f, logsigf_(pre[4 * q + 2]) * 0.0625f, logsigf_(pre[4 * q + 3]) * 0.0625f};
}
DI void gla_scan(const Ctx& c, int dir, LAS float* lgs, LAS float* tot) {
    if (c.tid < 128) { float run = 0.f;
        if (dir == 0) { for (int s = 0; s < 64; ++s) { run += lgs[s * 128 + c.tid]; lgs[s * 128 + c.tid] = run; } }
        else { for (int s = 63; s >= 0; --s) { run += lgs[s * 128 + c.tid]; lgs[s * 128 + c.tid] = run; } }
        tot[c.tid] = run; }
}
DI void phase_gla_state(const Ctx& c) {
    const bf16* PC = WSP(bf16, WS_BIG + BIG_PC); const float* EX = WSP(float, WS_EXTRA); bf16* GST = WSP(bf16, WS_BIG + BIG_GST);
    LAS float* w2s = (LAS float*)c.lds; LAS float* gbs = w2s + 2048; LAS float* tot = gbs + 128; LAS float* lgs = tot + 128;
    LAS unsigned char* Kd = c.lds + 45056; LAS unsigned char* Vs = Kd + 64 * 272;
    const int lane = c.lane, wave = c.wave, h5 = lane >> 5, l31 = lane & 31, dkt = wave & 3, dvt = wave >> 2;
    const int srow = c.tid >> 3, dg = c.tid & 7;
    for (int item = blockIdx.x; item < 256; item += gridDim.x) {
        const int b = item >> 5, h = (item >> 3) & 3, dir = (item >> 2) & 1, dvq = item & 3, seq = (b * 4 + h) * 2 + dir;
        __syncthreads();
        for (int i = c.tid; i < 2048; i += 512) w2s[i] = c.in[I_GLW2][(size_t)dir * 8192 + (i >> 7) * 512 + h * 128 + (i & 127)];
        if (c.tid < 128) gbs[c.tid] = c.in[I_GLGB][dir * 512 + h * 128 + c.tid];
        f32x16 acc = zero16();
        u32x4 kreg[2], vreg; f32x4 low[4];
        { const int row = chunk_row0(0, b, dir) + srow;
          kreg[0] = *(const u32x4*)(PC + (size_t)row * 2048 + 512 + h * 128 + 16 * dg); kreg[1] = *(const u32x4*)(PC + (size_t)row * 2048 + 512 + h * 128 + 16 * dg + 8);
          vreg = *(const u32x4*)(PC + (size_t)row * 2048 + 1024 + h * 256 + dvq * 64 + 8 * dg);
#pragma unroll
          for (int q = 0; q < 4; ++q) low[q] = *(const f32x4*)(EX + (size_t)row * 32 + dir * 16 + 4 * q); }
        __syncthreads();
        for (int p = 0; p < 36; ++p) {
            { bf16* dst = GST + ((size_t)seq * 36 + p) * 32768 + (size_t)(dvq * 64 + 32 * dvt + l31) * 128 + 32 * dkt + 4 * h5;
#pragma unroll
              for (int q = 0; q < 4; ++q) { u32x2 w; w.x = cvt_pk_bf16(acc[4 * q], acc[4 * q + 1]); w.y = cvt_pk_bf16(acc[4 * q + 2], acc[4 * q + 3]); *(u32x2*)(dst + 8 * q) = w; } }
            gla_lg(c, low, w2s, gbs, lgs);
            __syncthreads();
            gla_scan(c, dir, lgs, tot);
            __syncthreads();
            { float kk[16]; { float t8[8]; unpack8(kreg[0], t8);
#pragma unroll
                for (int e = 0; e < 8; ++e) kk[e] = t8[e]; unpack8(kreg[1], t8);
#pragma unroll
                for (int e = 0; e < 8; ++e) kk[8 + e] = t8[e]; }
#pragma unroll
              for (int e = 0; e < 16; ++e) kk[e] *= __expf(tot[16 * dg + e] - lgs[srow * 128 + 16 * dg + e]);
              const float k0[8] = {kk[0], kk[1], kk[2], kk[3], kk[4], kk[5], kk[6], kk[7]}, k1[8] = {kk[8], kk[9], kk[10], kk[11], kk[12], kk[13], kk[14], kk[15]};
              *(LAS u32x4*)(Kd + srow * 272 + dg * 32) = pack8(k0); *(LAS u32x4*)(Kd + srow * 272 + dg * 32 + 16) = pack8(k1);
              *(LAS u32x4*)(Vs + srow * 144 + dg * 16) = vreg; }
            if (p + 1 < 36) { const int row = chunk_row0(p + 1, b, dir) + srow;
                kreg[0] = *(const u32x4*)(PC + (size_t)row * 2048 + 512 + h * 128 + 16 * dg); kreg[1] = *(const u32x4*)(PC + (size_t)row * 2048 + 512 + h * 128 + 16 * dg + 8);
                vreg = *(const u32x4*)(PC + (size_t)row * 2048 + 1024 + h * 256 + dvq * 64 + 8 * dg);
#pragma unroll
                for (int q = 0; q < 4; ++q) low[q] = *(const f32x4*)(EX + (size_t)row * 32 + dir * 16 + 4 * q); }
            float dm[16];
#pragma unroll
            for (int r = 0; r < 16; ++r) dm[r] = __expf(tot[32 * dkt + crow(r, h5)]);
            __syncthreads();
#pragma unroll
            for (int r = 0; r < 16; ++r) acc[r] *= dm[r];
#pragma unroll
            for (int kk = 0; kk < 4; ++kk) acc = MFMA32(tr_frag(Kd, 272, 16 * kk, 32 * dkt, lane), tr_frag(Vs, 144, 16 * kk, 32 * dvt, lane), acc);
        }
    }
}
DI void phase_gla_out(const Ctx& c, const float* ng) {
    const bf16* P = WSP(bf16, WS_P); const bf16* PC = WSP(bf16, WS_BIG + BIG_PC); const float* EX = WSP(float, WS_EXTRA);
    const bf16* GST = WSP(bf16, WS_BIG + BIG_GST); bf16* Y = WSP(bf16, WS_Y);
    LAS unsigned char* Qt = c.lds; LAS unsigned char* Kt = Qt + 17408; LAS unsigned char* Vs = Kt + 17408; LAS unsigned char* STs = Vs + 33792;
    LAS float* lgs = (LAS float*)c.lds;
    LAS float* YO = (LAS float*)STs;
    LAS float* w2s = (LAS float*)(c.lds + 138240); LAS float* gbs = w2s + 2048; LAS float* tot = gbs + 128;
    const int lane = c.lane, wave = c.wave, h5 = lane >> 5, l31 = lane & 31;
    const int srow = c.tid >> 3, dg = c.tid & 7;
    for (int item = blockIdx.x; item < 1152; item += gridDim.x) {
        const int b = item / 144, h = (item / 36) & 3, cc = item % 36;
        const int r0 = cc < 4 ? b * CTX + 64 * cc : TC + b * SEQ + 64 * (cc - 4);
        __syncthreads();
#pragma unroll
        for (int i = 0; i < 4; ++i) { const int pc = dg + 8 * i; *(LAS u32x4*)(Vs + srow * 528 + pc * 16) = *(const u32x4*)(PC + (size_t)(r0 + srow) * 2048 + 1024 + h * 256 + 8 * pc); }
        f32x16 O[2]; O[0] = zero16(); O[1] = zero16();
        for (int dir = 0; dir < 2; ++dir) {
            const int pslot = dir ? (cc < 4 ? 3 - cc : 39 - cc) : cc;
            __syncthreads();
            for (int i = c.tid; i < 2048; i += 512) w2s[i] = c.in[I_GLW2][(size_t)dir * 8192 + (i >> 7) * 512 + h * 128 + (i & 127)];
            if (c.tid < 128) gbs[c.tid] = c.in[I_GLGB][dir * 512 + h * 128 + c.tid];
            { const bf16* src = GST + ((size_t)((b * 4 + h) * 2 + dir) * 36 + pslot) * 32768;
#pragma unroll
              for (int i = 0; i < 8; ++i) { const int pc = c.tid + 512 * i, rr = pc >> 4, sp = pc & 15; *(LAS u32x4*)(STs + rr * 272 + sp * 16) = *(const u32x4*)(src + rr * 128 + 8 * sp); } }
            f32x4 low[4];
#pragma unroll
            for (int q = 0; q < 4; ++q) low[q] = *(const f32x4*)(EX + (size_t)(r0 + srow) * 32 + dir * 16 + 4 * q);
            __syncthreads();
            gla_lg(c, low, w2s, gbs, lgs);
            __syncthreads();
            gla_scan(c, dir, lgs, tot);
            __syncthreads();
            float bb[16];
#pragma unroll
            for (int e = 0; e < 16; ++e) bb[e] = lgs[srow * 128 + 16 * dg + e];
            __syncthreads();
            { float qq[16], kk[16]; float t8[8];
              unpack8(*(const u32x4*)(PC + (size_t)(r0 + srow) * 2048 + h * 128 + 16 * dg), t8);
#pragma unroll
              for (int e = 0; e < 8; ++e) qq[e] = t8[e];
              unpack8(*(const u32x4*)(PC + (size_t)(r0 + srow) * 2048 + h * 128 + 16 * dg + 8), t8);
#pragma unroll
              for (int e = 0; e < 8; ++e) qq[8 + e] = t8[e];
              unpack8(*(const u32x4*)(PC + (size_t)(r0 + srow) * 2048 + 512 + h * 128 + 16 * dg), t8);
#pragma unroll
              for (int e = 0; e < 8; ++e) kk[e] = t8[e];
              unpack8(*(const u32x4*)(PC + (size_t)(r0 + srow) * 2048 + 512 + h * 128 + 16 * dg + 8), t8);
#pragma unroll
              for (int e = 0; e < 8; ++e) kk[8 + e] = t8[e];
#pragma unroll
              for (int e = 0; e < 16; ++e) { const float eb = __expf(bb[e]); qq[e] *= eb; kk[e] *= 1.0f / eb; }
              const float q0[8] = {qq[0], qq[1], qq[2], qq[3], qq[4], qq[5], qq[6], qq[7]}, q1[8] = {qq[8], qq[9], qq[10], qq[11], qq[12], qq[13], qq[14], qq[15]};
              const float k0[8] = {kk[0], kk[1], kk[2], kk[3], kk[4], kk[5], kk[6], kk[7]}, k1[8] = {kk[8], kk[9], kk[10], kk[11], kk[12], kk[13], kk[14], kk[15]};
              *(LAS u32x4*)(Qt + srow * 272 + dg * 32) = pack8(q0); *(LAS u32x4*)(Qt + srow * 272 + dg * 32 + 16) = pack8(q1);
              *(LAS u32x4*)(Kt + srow * 272 + dg * 32) = pack8(k0); *(LAS u32x4*)(Kt + srow * 272 + dg * 32 + 16) = pack8(k1); }
            __syncthreads();
#pragma unroll
            for (int jt = 0; jt < 2; ++jt) {
#pragma unroll
                for (int st = 0; st < 2; ++st) {
                    const bool live = dir ? (st >= jt) : (st <= jt);
                    if (live) {
                        f32x16 X = zero16();
#pragma unroll
                        for (int kk = 0; kk < 8; ++kk) X = MFMA32(row_frag(Kt, 272, 32 * st, 16 * kk, lane), row_frag(Qt, 272, 32 * jt, 16 * kk, lane), X);
                        if (st == jt) {
#pragma unroll
                            for (int r = 0; r < 16; ++r) { const int s = crow(r, h5); const bool ok = dir ? (s >= l31) : (s <= l31); X[r] = ok ? X[r] : 0.f; } }
#pragma unroll
                        for (int step = 0; step < 2; ++step) O[jt] = MFMA32(tr_frag_perm(Vs, 528, 32 * st + 16 * step, 32 * wave, lane), pack_acc(X, step), O[jt]);
                    }
                }
#pragma unroll
                for (int kk = 0; kk < 8; ++kk) O[jt] = MFMA32(row_frag(STs, 272, 32 * wave, 16 * kk, lane), row_frag(Qt, 272, 32 * jt, 16 * kk, lane), O[jt]);
            }
        }
        __syncthreads();
#pragma unroll
        for (int jt = 0; jt < 2; ++jt)
#pragma unroll
            for (int q = 0; q < 4; ++q) *(LAS f32x4*)(YO + (32 * jt + l31) * 260 + 32 * wave + 8 * q + 4 * h5) = (f32x4){O[jt][4 * q], O[jt][4 * q + 1], O[jt][4 * q + 2], O[jt][4 * q + 3]};
        __syncthreads();
        { const int c0 = dg * 32; float y[32]; float ss = 0.f;
#pragma unroll
          for (int q = 0; q < 8; ++q) { const f32x4 a = *(const LAS f32x4*)(YO + srow * 260 + c0 + 4 * q); y[4 * q] = a.x; y[4 * q + 1] = a.y; y[4 * q + 2] = a.z; y[4 * q + 3] = a.w; }
#pragma unroll
          for (int q = 0; q < 32; ++q) ss += y[q] * y[q];
          ss += __shfl_xor(ss, 1); ss += __shfl_xor(ss, 2); ss += __shfl_xor(ss, 4);
          const float r = 1.0f / sqrtf(ss * (1.0f / 256.0f) + EPS);
#pragma unroll
          for (int q = 0; q < 4; ++q) { float g8[8], o8[8]; unpack8(*(const u32x4*)(P + (size_t)(r0 + srow) * PLD + 2048 + h * 256 + c0 + 8 * q), g8);
#pragma unroll
              for (int e = 0; e < 8; ++e) o8[e] = y[8 * q + e] * r * ng[h * 256 + c0 + 8 * q + e] * siluf_(g8[e]);
              *(u32x4*)(Y + (size_t)(r0 + srow) * D + h * 256 + c0 + 8 * q) = pack8(o8); } }
    }
}

DI void phase_gla_scan_naive(const Ctx& c) {
    const bf16* PC = WSP(bf16, WS_BIG + BIG_PC); const float* EX = WSP(float, WS_EXTRA);
    LAS float* qs = (LAS float*)c.lds; LAS float* ks = qs + 16 * 128; LAS float* as = ks + 16 * 128; LAS float* vs = as + 16 * 128; LAS float* lw = vs + 16 * 256;
    const int v = c.tid >> 1, d0 = (c.tid & 1) * 64;
    for (int item = blockIdx.x; item < 64; item += gridDim.x) {
        const int b = item >> 3, h = (item >> 1) & 3, dir = item & 1;
        float* Yo = WSP(float, WS_BIG + (dir ? BIG_YB : BIG_YF));
        const float* w2 = c.in[I_GLW2] + (size_t)dir * 16 * 512 + h * 128; const float* gb = c.in[I_GLGB] + dir * 512 + h * 128;
        float S[64];
#pragma unroll
        for (int d = 0; d < 64; ++d) S[d] = 0.f;
        for (int ch = 0; ch < (CTX + SEQ) / 16; ++ch) {
            __syncthreads();
            if (c.tid < 256) { const int st = c.tid >> 4, r = c.tid & 15, row = scan_row(ch * 16 + st, b, dir); lw[c.tid] = EX[(size_t)row * 32 + dir * 16 + r]; }
            for (int idx = c.tid; idx < 16 * 512; idx += 512) { const int st = idx >> 9, col = idx & 511, row = scan_row(ch * 16 + st, b, dir);
                if (col < 128) qs[st * 128 + col] = bf2f(PC[(size_t)row * 2048 + h * 128 + col]);
                else if (col < 256) ks[st * 128 + col - 128] = bf2f(PC[(size_t)row * 2048 + 512 + h * 128 + col - 128]);
                else vs[st * 256 + col - 256] = bf2f(PC[(size_t)row * 2048 + 1024 + h * 256 + col - 256]); }
            __syncthreads();
            for (int idx = c.tid; idx < 16 * 128; idx += 512) { const int st = idx >> 7, d = idx & 127; float pre = gb[d];
#pragma unroll
                for (int r = 0; r < 16; ++r) pre += lw[st * 16 + r] * w2[r * 512 + d];
                as[idx] = __expf(logsigf_(pre) * (1.0f / 16.0f)); }
            __syncthreads();
            for (int st = 0; st < 16; ++st) {
                const float vv = vs[st * 256 + v]; float part = 0.f;
#pragma unroll
                for (int d = 0; d < 64; ++d) { S[d] = as[st * 128 + d0 + d] * S[d] + ks[st * 128 + d0 + d] * vv; part += qs[st * 128 + d0 + d] * S[d]; }
                part += __shfl_xor(part, 1);
                if ((c.tid & 1) == 0) { const int row = scan_row(ch * 16 + st, b, dir); Yo[(size_t)row * D + h * 256 + v] = part; }
            }
        }
    }
}
DI void phase_headnorm(const Ctx& c, int hd, const float* ng) {
    const float* YF = WSP(float, WS_BIG + BIG_YF); const float* YB = WSP(float, WS_BIG + BIG_YB); const bf16* P = WSP(bf16, WS_P); bf16* Y = WSP(bf16, WS_Y);
    for (int row = c.gw; row < TT; row += c.ngw) {
        const int c0 = 16 * c.lane; float y[16]; float ss = 0.f;
#pragma unroll
        for (int j = 0; j < 4; ++j) { const f32x4 a = *(const f32x4*)(YF + (size_t)row * D + c0 + 4 * j), bb = *(const f32x4*)(YB + (size_t)row * D + c0 + 4 * j);
            y[4 * j] = a.x + bb.x; y[4 * j + 1] = a.y + bb.y; y[4 * j + 2] = a.z + bb.z; y[4 * j + 3] = a.w + bb.w; }
#pragma unroll
        for (int j = 0; j < 16; ++j) ss += y[j] * y[j];
        ss += __shfl_xor(ss, 1); ss += __shfl_xor(ss, 2); ss += __shfl_xor(ss, 4); if (hd == 256) ss += __shfl_xor(ss, 8);
        const float r = 1.0f / sqrtf(ss / (float)hd + EPS);
        float g0[8], g1[8];
        unpack8(*(const u32x4*)(P + (size_t)row * PLD + 2048 + c0), g0); unpack8(*(const u32x4*)(P + (size_t)row * PLD + 2048 + c0 + 8), g1);
        float o[16];
#pragma unroll
        for (int j = 0; j < 16; ++j) { const float gp = j < 8 ? g0[j] : g1[j - 8]; o[j] = y[j] * r * ng[c0 + j] * (hd == 128 ? sigmoidf_(gp) : siluf_(gp)); }
        const float o0[8] = {o[0], o[1], o[2], o[3], o[4], o[5], o[6], o[7]}, o1[8] = {o[8], o[9], o[10], o[11], o[12], o[13], o[14], o[15]};
        *(u32x4*)(Y + (size_t)row * D + c0) = pack8(o0); *(u32x4*)(Y + (size_t)row * D + c0 + 8) = pack8(o1);
    }
}
DI void phase_hyena_conv_naive(const Ctx& c) {
    const bf16* PC = WSP(bf16, WS_BIG + BIG_PC); bf16* Y = WSP(bf16, WS_Y); const float* skip = c.in[I_HYSKIP];
    LAS float* zt = (LAS float*)c.lds;
    LAS float* ft = zt + 4096;
    const int cc = c.tid & 63, tg = c.tid >> 6;
    for (int item = blockIdx.x; item < 4096 + 512; item += gridDim.x) {
        int L, rb, tt, cgi; const float* tab;
        if (item < 4096) { L = SEQ; const int b = item >> 9; tt = (item >> 4) & 31; cgi = item & 15; rb = TC + b * SEQ; tab = WSP(float, WS_HF); }
        else { const int it = item - 4096; L = CTX; const int b = it >> 6; tt = (it >> 4) & 3; cgi = it & 15; rb = b * CTX; tab = WSP(float, WS_HFC); }
        const int t0 = 64 * tt, c0 = 64 * cgi;
        float acc[8];
#pragma unroll
        for (int i = 0; i < 8; ++i) acc[i] = 0.f;
        for (int sb = 0; sb < L / 64; ++sb) {
            const int s0 = 64 * sb;
            __syncthreads();
            for (int idx = c.tid; idx < 4096; idx += 512) { const int sl = idx >> 6, ch = idx & 63; const size_t o = (size_t)(rb + s0 + sl) * PLD + c0 + ch;
                zt[idx] = bf2f(PC[o + 1024]) * bf2f(PC[o + 2048]); }
            for (int idx = c.tid; idx < 64 * 128; idx += 512) { const int ch = idx >> 7, j = idx & 127;
                if (j < 127) ft[j * 65 + ch] = tab[(size_t)(c0 + ch) * (2 * L) + L + (t0 - s0 - 63 + j)]; }
            __syncthreads();
#pragma unroll 1
            for (int g = 0; g < 8; ++g) {
                float w[15], z[8]; const int base = 8 * (tg - g) + 56;
#pragma unroll
                for (int m = 0; m < 15; ++m) w[m] = ft[(base + m) * 65 + cc];
#pragma unroll
                for (int j = 0; j < 8; ++j) z[j] = zt[(8 * g + j) * 64 + cc];
#pragma unroll
                for (int i = 0; i < 8; ++i)
#pragma unroll
                    for (int j = 0; j < 8; ++j) acc[i] += w[i - j + 7] * z[j];
            }
        }
#pragma unroll
        for (int i = 0; i < 8; ++i) { const int row = rb + t0 + 8 * tg + i; const size_t o = (size_t)row * PLD + c0 + cc;
            const float zin = bf2f(PC[o + 1024]) * bf2f(PC[o + 2048]), x0 = bf2f(PC[o]);
            Y[(size_t)row * D + c0 + cc] = f2bf(x0 * (acc[i] + skip[c0 + cc] * zin)); }
    }
}

DI void hy_item(int item, int& L, int& b, int& t0, int& c0, int& rb) {
    if (item < 4096) { L = SEQ; b = item >> 9; t0 = 64 * ((item >> 4) & 31); c0 = 64 * (item & 15); rb = TC + b * SEQ; }
    else { const int it = item - 4096; L = CTX; b = it >> 6; t0 = 64 * ((it >> 4) & 3); c0 = 64 * (it & 15); rb = b * CTX; }
}
DI void phase_hy_prep(const Ctx& c) {
    const bf16* P = WSP(bf16, WS_P); bf16* X0C = WSP(bf16, WS_BIG + BIG_PC); const float* cw = c.in[I_HYCW]; const float* cb = c.in[I_HYCB];
    LAS unsigned char* raw = c.lds;
    LAS float* zt = (LAS float*)(c.lds + 32768);
    for (int item = blockIdx.x; item < 4608; item += gridDim.x) {
        int L, b, t0, c0, rb; hy_item(item, L, b, t0, c0, rb);
        bf16* ZT = L == SEQ ? WSP(bf16, WS_BIG + BIG_ZTL) : WSP(bf16, WS_BIG + BIG_ZTC);
        __syncthreads();
        for (int pc = c.tid; pc < 3 * 66 * 8; pc += 512) { const int g = pc / 528, rr = (pc % 528) >> 3, sp = pc & 7, t = t0 - 1 + rr;
            u32x4 v = {0u, 0u, 0u, 0u};
            if (t >= 0 && t < L) v = *(const u32x4*)(P + (size_t)(rb + t) * PLD + g * 1024 + c0 + 8 * sp);
            *(LAS u32x4*)(raw + (g * 66 + rr) * 128 + sp * 16) = v; }
        __syncthreads();
        { const int t = c.tid >> 3, sp = c.tid & 7; float u[3][8];
#pragma unroll
          for (int g = 0; g < 3; ++g) { float xm[8], x0[8], xp[8];
              unpack8(*(const LAS u32x4*)(raw + (g * 66 + t) * 128 + sp * 16), xm); unpack8(*(const LAS u32x4*)(raw + (g * 66 + t + 1) * 128 + sp * 16), x0); unpack8(*(const LAS u32x4*)(raw + (g * 66 + t + 2) * 128 + sp * 16), xp);
              const int col = g * 1024 + c0 + 8 * sp;
#pragma unroll
              for (int e = 0; e < 8; ++e) u[g][e] = cw[col + e] * xm[e] + cw[3072 + col + e] * x0[e] + cw[6144 + col + e] * xp[e] + cb[col + e]; }
          *(u32x4*)(X0C + (size_t)(rb + t0 + t) * 1024 + c0 + 8 * sp) = pack8(u[0]);
#pragma unroll
          for (int e = 0; e < 8; ++e) zt[t * 65 + 8 * sp + e] = u[1][e] * u[2][e]; }
        __syncthreads();
        { const int ch = c.tid >> 3, tp = c.tid & 7; float z[8];
#pragma unroll
          for (int e = 0; e < 8; ++e) z[e] = zt[(8 * tp + e) * 65 + ch];
          *(u32x4*)(ZT + ((size_t)(c0 + ch) * NB + b) * L + t0 + 8 * tp) = pack8(z); }
    }
}
template <int L>
DI void hy_toeplitz_channel(const Ctx& c, const float* hrow  , const bf16* zsrc  , bf16* ydst  ) {
    constexpr int NBK = L / 32, CP = 2 * L + 8, NT = (NBK + 31) / 32;
    LAS unsigned char* F = c.lds;
    LAS unsigned char* Zs = c.lds + 8 * CP * 2;
    const int lane = c.lane, w = c.wave, h5 = lane >> 5, a = lane & 31;
    __syncthreads();
    for (int idx = c.tid; idx < 8 * 2 * L; idx += 512) { const int r = idx / (2 * L), m = idx % (2 * L), y = m + r;
        const float v = (y >= 1 && y <= 2 * L - 1) ? hrow[2 * L - y] : 0.f;
        *(LAS bf16*)(F + (r * CP + m) * 2) = f2bf(v); }
    for (int pc = c.tid; pc < 8 * L / 8; pc += 512) { const int bb = pc / (L / 8), pi = pc % (L / 8);
        *(LAS u32x4*)(Zs + (bb * NBK + (pi >> 2)) * 80 + (pi & 3) * 16) = *(const u32x4*)(zsrc + (size_t)bb * L + 8 * pi); }
    __syncthreads();
    const int r = (-a) & 7;
    f32x16 acc[NT];
#pragma unroll
    for (int q = 0; q < NT; ++q) acc[q] = zero16();
    for (int d = -(NBK - 1); d <= NBK - 1; ++d) {
#pragma unroll
        for (int step = 0; step < 2; ++step) {
            const int y0 = L - 32 * d - a + 16 * step + 8 * h5;
            const bf16x8 A = *(const LAS bf16x8*)(F + (r * CP + (y0 - r)) * 2);
#pragma unroll
            for (int q = 0; q < NT; ++q) {
                if (d >= 32 * q - (NBK - 1) && d <= 32 * q + 31) {
                    const int src = 32 * q + a - d; const bool ok = (unsigned)src < (unsigned)NBK; const int sc = ok ? src : 0;
                    bf16x8 B = *(const LAS bf16x8*)(Zs + (w * NBK + sc) * 80 + 32 * step + 16 * h5);
                    if (!ok) B = (bf16x8){0, 0, 0, 0, 0, 0, 0, 0};
                    acc[q] = MFMA32(A, B, acc[q]);
                }
            }
        }
    }
#pragma unroll
    for (int q = 0; q < NT; ++q) { const int i = 32 * q + a;
        if (i < NBK) {
#pragma unroll
            for (int qq = 0; qq < 4; ++qq) { u32x2 o; o.x = cvt_pk_bf16(acc[q][4 * qq], acc[q][4 * qq + 1]); o.y = cvt_pk_bf16(acc[q][4 * qq + 2], acc[q][4 * qq + 3]);
                *(u32x2*)(ydst + (size_t)w * L + 32 * i + 8 * qq + 4 * h5) = o; } } }
}
DI void phase_hy_toeplitz(const Ctx& c) {
    for (int ch = blockIdx.x; ch < 1024; ch += gridDim.x) {
        hy_toeplitz_channel<SEQ>(c, WSP(float, WS_HF) + (size_t)ch * 4096, WSP(bf16, WS_BIG + BIG_ZTL) + (size_t)ch * NB * SEQ, WSP(bf16, WS_BIG + BIG_YTL) + (size_t)ch * NB * SEQ);
        hy_toeplitz_channel<CTX>(c, WSP(float, WS_HFC) + (size_t)ch * 512, WSP(bf16, WS_BIG + BIG_ZTC) + (size_t)ch * NB * CTX, WSP(bf16, WS_BIG + BIG_YTC) + (size_t)ch * NB * CTX);
    }
}
DI void phase_hy_post(const Ctx& c) {
    const bf16* X0C = WSP(bf16, WS_BIG + BIG_PC); bf16* Y = WSP(bf16, WS_Y); const float* skip = c.in[I_HYSKIP];
    LAS float* tl = (LAS float*)c.lds;
    for (int item = blockIdx.x; item < 4608; item += gridDim.x) {
        int L, b, t0, c0, rb; hy_item(item, L, b, t0, c0, rb);
        const bf16* ZT = L == SEQ ? WSP(bf16, WS_BIG + BIG_ZTL) : WSP(bf16, WS_BIG + BIG_ZTC); const bf16* YT = L == SEQ ? WSP(bf16, WS_BIG + BIG_YTL) : WSP(bf16, WS_BIG + BIG_YTC);
        __syncthreads();
        { const int ch = c.tid >> 3, tp = c.tid & 7; const size_t o = ((size_t)(c0 + ch) * NB + b) * L + t0 + 8 * tp; float y[8], z[8];
          unpack8(*(const u32x4*)(YT + o), y); unpack8(*(const u32x4*)(ZT + o), z); const float sk = skip[c0 + ch];
#pragma unroll
          for (int e = 0; e < 8; ++e) tl[ch * 65 + 8 * tp + e] = y[e] + sk * z[e]; }
        __syncthreads();
        { const int t = c.tid >> 3, sp = c.tid & 7; float x0[8], o[8];
          unpack8(*(const u32x4*)(X0C + (size_t)(rb + t0 + t) * 1024 + c0 + 8 * sp), x0);
#pragma unroll
          for (int e = 0; e < 8; ++e) o[e] = x0[e] * tl[(8 * sp + e) * 65 + t];
          *(u32x4*)(Y + (size_t)(rb + t0 + t) * D + c0 + 8 * sp) = pack8(o); }
    }
}

DI void phase_route(const Ctx& c, int l) {
    LAS float* rw = (LAS float*)c.lds;
    LAS int* lcnt = (LAS int*)(c.lds + 65536);
    LAS int* rinfo = lcnt + 32;
    LAS float* rwt = (LAS float*)(rinfo + 4 * 128);
    for (int i = c.tid; i < 16 * 1024; i += 512) { const int e = i >> 10, k = i & 1023; rw[i] = c.in[I_RW][k * 16 + e]; }
    if (c.tid < 16) lcnt[c.tid] = 0;
    __syncthreads();
    const float* MOD = WSP(float, WS_MOD) + (size_t)l * 9 * 6144; const float* g = c.in[I_N2G] + l * D; bf16* H = WSP(bf16, WS_H);
    const float* X = WSP(float, WS_X); const float* XC = WSP(float, WS_XC);
    unsigned* cnt = WSP(unsigned, WS_CTL) + CW_CNT + l * 16; int* TOK = WSP(int, WS_TOK); float* TOKW = WSP(float, WS_TOK + 512 * 1024);
    float rbv[16];
#pragma unroll
    for (int e = 0; e < 16; ++e) rbv[e] = c.in[I_RB][e];
    const int rlo = (l == 3 ? TC : 0), nrow = TT - rlo, per = (nrow + (int)gridDim.x - 1) / (int)gridDim.x;
    const int brow0 = rlo + (int)blockIdx.x * per, bn = min(per, TT - brow0);
    for (int lr = c.wave; lr < bn; lr += 8) {
        const int row = brow0 + lr;
        f32x4 v[4]; const int mr = row < TC ? 8 : (row - TC) >> 11;
        load_row(row < TC ? XC + (size_t)row * D : X + (size_t)(row - TC) * D, v, c.lane);
        norm_row(v, g, c.lane); mod_row(v, MOD + mr * 6144 + 3072, MOD + mr * 6144 + 4096, c.lane);
        store_row_bf16(H + (size_t)row * D, v, c.lane);
        float sc[16];
#pragma unroll
        for (int e = 0; e < 16; ++e) { float s = 0.f;
#pragma unroll
            for (int j = 0; j < 4; ++j) { const f32x4 w = *(const LAS f32x4*)(rw + e * 1024 + 256 * j + 4 * c.lane); s += (v[j].x * w.x + v[j].y * w.y) + (v[j].z * w.z + v[j].w * w.w); }
            sc[e] = sigmoidf_(wave_sum(s)); asm volatile("" ::: "memory"); }
        int bg = 0; float bgs = -1e30f;
#pragma unroll
        for (int gq = 0; gq < 4; ++gq) { float m1 = -1e30f, m2 = -1e30f;
#pragma unroll
            for (int j = 0; j < 4; ++j) { const float s = sc[4 * gq + j] + rbv[4 * gq + j]; if (s > m1) { m2 = m1; m1 = s; } else if (s > m2) m2 = s; }
            const float gs = m1 + m2; if (gs > bgs) { bgs = gs; bg = gq; } }
        float s4[4], p4[4];
#pragma unroll
        for (int j = 0; j < 4; ++j) { s4[j] = 0.f; p4[j] = 0.f; }
#pragma unroll
        for (int gq = 0; gq < 4; ++gq)
#pragma unroll
            for (int j = 0; j < 4; ++j) if (bg == gq) { s4[j] = sc[4 * gq + j] + rbv[4 * gq + j]; p4[j] = sc[4 * gq + j]; }
        int i1 = 0; float v1 = s4[0], q1 = p4[0];
#pragma unroll
        for (int j = 1; j < 4; ++j) if (s4[j] > v1) { v1 = s4[j]; i1 = j; q1 = p4[j]; }
        int i2 = -1; float v2 = -1e30f, q2 = 0.f;
#pragma unroll
        for (int j = 0; j < 4; ++j) if (j != i1 && s4[j] > v2) { v2 = s4[j]; i2 = j; q2 = p4[j]; }
        if (c.lane == 0) {
            const int e0 = 4 * bg + i1, e1 = 4 * bg + i2;
            const int p0 = __hip_atomic_fetch_add(lcnt + e0, 1, __ATOMIC_RELAXED, __HIP_MEMORY_SCOPE_WORKGROUP), p1 = __hip_atomic_fetch_add(lcnt + e1, 1, __ATOMIC_RELAXED, __HIP_MEMORY_SCOPE_WORKGROUP);
            rinfo[lr * 4 + 0] = e0; rinfo[lr * 4 + 1] = p0; rinfo[lr * 4 + 2] = e1; rinfo[lr * 4 + 3] = p1;
            const float inv = 1.0f / (q1 + q2); rwt[lr * 2] = q1 * inv; rwt[lr * 2 + 1] = q2 * inv;
        }
    }
    __syncthreads();
    if (c.tid < 16) lcnt[16 + c.tid] = (int)atomicAdd(cnt + c.tid, (unsigned)lcnt[c.tid]);
    __syncthreads();
    for (int lr = c.tid; lr < bn; lr += 512) { const int row = brow0 + lr, e0 = rinfo[lr * 4], e1 = rinfo[lr * 4 + 2];
        TOK[row * 4 + 0] = e0; TOK[row * 4 + 1] = lcnt[16 + e0] + rinfo[lr * 4 + 1]; TOK[row * 4 + 2] = e1; TOK[row * 4 + 3] = lcnt[16 + e1] + rinfo[lr * 4 + 3];
        TOKW[row * 2] = rwt[lr * 2]; TOKW[row * 2 + 1] = rwt[lr * 2 + 1]; }
}
DI void slot_bases(const unsigned* cnt, int lane, int e0, int e1, int& b0, int& b1) {
    const unsigned mine = lane < 16 ? ((cnt[lane] + 255u) & ~255u) : 0u; unsigned pb = 0; b0 = 0; b1 = 0;
#pragma unroll
    for (int e = 0; e < 16; ++e) { const unsigned ce = __shfl(mine, e); if (e == e0) b0 = (int)pb; if (e == e1) b1 = (int)pb; pb += ce; }
}
DI void phase_gather(const Ctx& c, int l) {
    const unsigned* cnt = WSP(unsigned, WS_CTL) + CW_CNT + l * 16; const int* TOK = WSP(int, WS_TOK); int* TOKS = WSP(int, WS_TOK + 768 * 1024);
    const bf16* H = WSP(bf16, WS_H); bf16* HS = WSP(bf16, WS_BIG + BIG_HS);
    for (int row = (l == 3 ? TC : 0) + c.gw; row < TT; row += c.ngw) {
        const int e0 = TOK[row * 4], p0 = TOK[row * 4 + 1], e1 = TOK[row * 4 + 2], p1 = TOK[row * 4 + 3]; int b0, b1;
        slot_bases(cnt, c.lane, e0, e1, b0, b1);
        const int s0 = b0 + p0, s1 = b1 + p1;
        const u32x4 a = *(const u32x4*)(H + (size_t)row * D + 8 * c.lane), bq = *(const u32x4*)(H + (size_t)row * D + 512 + 8 * c.lane);
        *(u32x4*)(HS + (size_t)s0 * D + 8 * c.lane) = a; *(u32x4*)(HS + (size_t)s0 * D + 512 + 8 * c.lane) = bq;
        *(u32x4*)(HS + (size_t)s1 * D + 8 * c.lane) = a; *(u32x4*)(HS + (size_t)s1 * D + 512 + 8 * c.lane) = bq;
        if (c.lane == 0) { TOKS[row * 2] = s0; TOKS[row * 2 + 1] = s1; }
    }
}
DI LAS int* moe_tiles(const Ctx& c, int l, int nsh) {
    LAS int* tp = (LAS int*)(c.lds + MISC_OFF);
    LAS int* ul = tp + 192;
    __syncthreads();
    if (c.tid < 64) {
        const unsigned* cnt = WSP(unsigned, WS_CTL) + CW_CNT + l * 16;
        const int mine = c.lane < 16 ? (int)((cnt[c.lane] + 255u) >> 8) : 0; int p = 0;
        for (int e = 0; e < 16; ++e) { const int ne = __shfl(mine, e); for (int t = c.lane; t < ne; t += 64) tp[1 + p + t] = e; p += ne; }
        if (c.lane == 0) tp[0] = p;
    }
    __syncthreads();
    if (c.tid < 32) {
        const int i = c.tid, ntile = tp[0], G = gridDim.x, cb = blockIdx.x; int rt = 1 << 20, pn = 0;
        if ((G & 7) == 0 && ((G >> 3) >> nsh) > 0) { const int x = cb & 7, v = cb >> 3, rpx = (G >> 3) >> nsh;
            if (v < (rpx << nsh)) { rt = (i * 8 + x) * rpx + (v >> nsh); pn = v & ((1 << nsh) - 1); } }
        else { const int L = i * G + cb; rt = L >> nsh; pn = L & ((1 << nsh) - 1); }
        ul[i] = rt < ntile ? (rt | (pn << 12) | (tp[1 + rt] << 16)) : -1;
    }
    __syncthreads();
    return ul;
}
DI void phase_combine(const Ctx& c, int l) {
    const float* MOD = WSP(float, WS_MOD) + (size_t)l * 9 * 6144; const int* TOKS = WSP(int, WS_TOK + 768 * 1024); const float* TOKW = WSP(float, WS_TOK + 512 * 1024);
    const bf16* YS = WSP(bf16, WS_BIG + BIG_HS); float* X = WSP(float, WS_X); float* XC = WSP(float, WS_XC); bf16* H = WSP(bf16, WS_H);
    for (int row = (l == 3 ? TC : 0) + c.gw; row < TT; row += c.ngw) {
        const int mr = row < TC ? 8 : (row - TC) >> 11; float* xp = row < TC ? XC + (size_t)row * D : X + (size_t)(row - TC) * D;
        const int s0 = TOKS[row * 2], s1 = TOKS[row * 2 + 1]; const float w0 = TOKW[row * 2], w1 = TOKW[row * 2 + 1];
        f32x4 v[4]; load_row(xp, v, c.lane);
#pragma unroll
        for (int j = 0; j < 4; ++j) {
            const u32x2 a = *(const u32x2*)(YS + (size_t)s0 * D + 256 * j + 4 * c.lane), bq = *(const u32x2*)(YS + (size_t)s1 * D + 256 * j + 4 * c.lane);
            const f32x4 ya = {__uint_as_float(a.x << 16), __uint_as_float(a.x & 0xffff0000u), __uint_as_float(a.y << 16), __uint_as_float(a.y & 0xffff0000u)};
            const f32x4 yb = {__uint_as_float(bq.x << 16), __uint_as_float(bq.x & 0xffff0000u), __uint_as_float(bq.y << 16), __uint_as_float(bq.y & 0xffff0000u)};
            v[j] = v[j] + *(const f32x4*)(MOD + mr * 6144 + 5120 + 256 * j + 4 * c.lane) * (ya * w0 + yb * w1);
            *(f32x4*)(xp + 256 * j + 4 * c.lane) = v[j];
        }
        if (l < 3) {
            const float* MODn = WSP(float, WS_MOD) + (size_t)(l + 1) * 9 * 6144;
            norm_row(v, c.in[I_N1G] + (l + 1) * D, c.lane); mod_row(v, MODn + mr * 6144, MODn + mr * 6144 + 1024, c.lane);
            store_row_bf16(H + (size_t)hrow_of(row, (l + 1) % 3) * D, v, c.lane);
        } else {
            norm_row(v, c.in[I_FING], c.lane);
            float* o = c.out + (size_t)(row - TC) * D;
#pragma unroll
            for (int j = 0; j < 4; ++j) *(f32x4*)(o + 256 * j + 4 * c.lane) = v[j];
        }
    }
}

#define XB_TMO      128
#define XB_XCNT(j)  (256  + 64 * (j))
#define XB_XSUB(j)  (1280 + 64 * (j))
#define XB_XGEN(j)  (2304 + 64 * (j))
#define XB_TOP      3328
#define XB_TOPGEN   3392
#define XCD_BAR_WORDS 3456
#define XB_SPIN_CAP (1u << 18)
DI unsigned xb_ld(unsigned* p)              { return __hip_atomic_load(p, __ATOMIC_RELAXED, __HIP_MEMORY_SCOPE_AGENT); }
DI unsigned xb_add(unsigned* p, unsigned v) { return __hip_atomic_fetch_add(p, v, __ATOMIC_RELAXED, __HIP_MEMORY_SCOPE_AGENT); }
DI unsigned xb_xcc_id() { return (unsigned)__builtin_amdgcn_s_getreg((3 << 11) | 20) & 0xFu; }
#define XB_SPIN(cond, bar) do { unsigned _sp = 0; while (cond) { __builtin_amdgcn_s_sleep(1); \
    if ((++_sp & 255u) == 0u) { if (xb_ld(&(bar)[XB_TMO])) break; if (_sp > XB_SPIN_CAP) { atomicAdd(&(bar)[XB_TMO], 1u); break; } } } } while (0)
DI void xcd_barrier_complete(unsigned* bar, unsigned x, unsigned& nloc, unsigned& nx) {
    const unsigned G = gridDim.x * gridDim.y * gridDim.z;
    unsigned sum, cnt, mine, sp = 0u;
    for (;;) {
        sum = 0u; cnt = 0u; mine = 0u;
#pragma unroll
        for (unsigned j = 0; j < 16; ++j) { const unsigned cj = xb_ld(&bar[XB_XCNT(j)]); sum += cj; cnt += (cj > 0u) ? 1u : 0u; mine = (j == x) ? cj : mine; }
        if (sum == G) break;
        __builtin_amdgcn_s_sleep(1);
        if ((++sp & 255u) == 0u) { if (xb_ld(&bar[XB_TMO])) break; if (sp > XB_SPIN_CAP) { atomicAdd(&bar[XB_TMO], 1u); break; } }
    }
    nloc = mine > 0u ? mine : 1u; nx = cnt > 0u ? cnt : 1u;
}
DI void xcd_barrier(unsigned* bar, volatile LAS unsigned* st) {
    asm volatile("s_waitcnt vmcnt(0)" ::: "memory");
    __syncthreads();
    if (threadIdx.x == 0) {
        const unsigned x = xb_xcc_id();
        __builtin_amdgcn_s_waitcnt(0);
        unsigned nloc = st[0], nx = st[1];
        if (nloc == 0u) { xcd_barrier_complete(bar, x, nloc, nx); st[0] = nloc; st[1] = nx; }
        const unsigned old = xb_add(&bar[XB_XSUB(x)], 1u);
        const unsigned gen = old / nloc;
        if (old + 1u == (gen + 1u) * nloc) {
            __builtin_amdgcn_fence(__ATOMIC_RELEASE, "agent");
            asm volatile("s_waitcnt vmcnt(0)" ::: "memory");
            const unsigned og = xb_add(&bar[XB_TOP], 1u);
            const unsigned tg = og / nx;
            if (og + 1u == (tg + 1u) * nx) xb_add(&bar[XB_TOPGEN], 1u);
            else XB_SPIN(xb_ld(&bar[XB_TOPGEN]) == tg, bar);
            __builtin_amdgcn_fence(__ATOMIC_ACQUIRE, "agent");
            xb_add(&bar[XB_XGEN(x)], 1u);
            asm volatile("s_waitcnt vmcnt(0)" ::: "memory");
        } else {
            XB_SPIN(xb_ld(&bar[XB_XGEN(x)]) == gen, bar);
            __builtin_amdgcn_fence(__ATOMIC_ACQUIRE, "agent");
            asm volatile("s_waitcnt vmcnt(0)" ::: "memory");
        }
    }
    __syncthreads();
}

constexpr int NPHASE = 2 + 11 * DEPTH;
__host__ __device__ inline bool phase_active(int ph) {
    if (ph < 2) return true;
    const int l = (ph - 2) / 11, s = (ph - 2) % 11, kind = l % 3;
    if (s == 0) return false;
    if (s == 4) return kind != 2 || HY_MFMA;
    return true;
}
DI void run_phase(const Ctx& c, int ph) {
    if (ph == 0) { if constexpr (PH_EN(0)) phase_pro0(c); return; }
    if (ph == 1) { if constexpr (PH_EN(1)) { phase_pro1(c); phase_norm1(c, 0, c.in[I_X], c.in[I_CTX]); } return; }
    const int l = (ph - 2) / 11, s = (ph - 2) % 11, kind = l % 3, j = l / 3;
    switch (s) {
    case 0: if constexpr (PH_EN(2)) phase_norm1(c, 0, c.in[I_X], c.in[I_CTX]); break;
    case 1: if constexpr (PH_EN(3)) {
        DenseOrder S; EpiInproj E; E.P = WSP(bf16, WS_P); E.extra = WSP(float, WS_EXTRA); E.bias = nullptr; E.bias_x = nullptr;
        if (kind == 0) { S.init(WSP(bf16, WS_H), WSP(bf16, WS_ML_WIN) + (size_t)j * NINP * 1024, TT, NINP); E.bias_x = c.in[I_MLBG] + j * 32; }
        else if (kind == 1) { S.init(WSP(bf16, WS_H), WSP(bf16, WS_GLA_WIN), TT, NINP); }
        else { S.init(WSP(bf16, WS_H), WSP(bf16, WS_HY_WIN), TT, 3072); E.bias = c.in[I_HYBIN]; }
        gemm_run(c.lds, c.tid, S, E);
    } break;
    case 2: if constexpr (PH_EN(4))
        if (kind == 0) phase_conv(c, 1024, c.in[I_MLCW] + j * 3 * 1024, c.in[I_MLCB] + j * 1024, true, 0.125f);
        else if (kind == 1) phase_conv(c, 2048, c.in[I_GLCW], c.in[I_GLCB], true, 0.08838834764831845f);
        else { if constexpr (HY_MFMA) phase_hy_prep(c); else phase_conv(c, 3072, c.in[I_HYCW], c.in[I_HYCB], false, 1.0f); }
        break;
    case 3: if constexpr (PH_EN(5))
        if (kind == 0) { if constexpr (MLSTM_CHUNK) phase_mlstm_state(c); else phase_mlstm_scan_naive(c); }
        else if (kind == 1) { if constexpr (GLA_CHUNK) phase_gla_state(c); else phase_gla_scan_naive(c); }
        else { if constexpr (HY_MFMA) phase_hy_toeplitz(c); else phase_hyena_conv_naive(c); }
        break;
    case 4: if constexpr (PH_EN(6))
        if (kind == 0) { if constexpr (MLSTM_CHUNK) phase_mlstm_out(c, c.in[I_MLNG] + j * 1024); else phase_headnorm(c, 128, c.in[I_MLNG] + j * 1024); }
        else if (kind == 1) { if constexpr (GLA_CHUNK) phase_gla_out(c, c.in[I_GLNG]); else phase_headnorm(c, 256, c.in[I_GLNG]); }
        else { if constexpr (HY_MFMA) phase_hy_post(c); }
        break;
    case 5: if constexpr (PH_EN(7)) {
        DenseOrder S; EpiOutproj E; E.X = WSP(float, WS_X); E.XC = WSP(float, WS_XC); E.mod = WSP(float, WS_MOD) + (size_t)l * 9 * 6144; E.bias = nullptr; E.perm = (kind == 1);
        E.xs_l = (l == 0) ? c.in[I_X] : WSP(float, WS_X); E.xs_c = (l == 0) ? c.in[I_CTX] : WSP(float, WS_XC); E.row_off = (l == 3) ? TC : 0;
        const bf16* W = kind == 0 ? WSP(bf16, WS_ML_WOUT) + (size_t)j * 1024 * 1024 : kind == 1 ? WSP(bf16, WS_GLA_WOUT) : WSP(bf16, WS_HY_WOUT);
        if (kind == 2) E.bias = c.in[I_HYBOUT];
        S.init(WSP(bf16, WS_Y) + (size_t)E.row_off * D, W, TT - E.row_off, 1024);
        gemm_run(c.lds, c.tid, S, E);
    } break;
    case 6: if constexpr (PH_EN(8)) phase_route(c, l); break;
    case 7: if constexpr (PH_EN(9)) phase_gather(c, l); break;
    case 8: if constexpr (PH_EN(10)) {
        MoeOrder S; S.ul = moe_tiles(c, l, 3); S.A = WSP(bf16, WS_BIG + BIG_HS); S.Bt = WSP(bf16, WS_EXP_UP) + (size_t)l * 16 * 2048 * 1024; S.bstride = (size_t)2048 * 1024;
        EpiUp E; E.ACT = WSP(bf16, WS_BIG + BIG_ACT);
        gemm_run(c.lds, c.tid, S, E);
    } break;
    case 9: if constexpr (PH_EN(11)) {
        MoeOrder S; S.ul = moe_tiles(c, l, 2); S.A = WSP(bf16, WS_BIG + BIG_ACT); S.Bt = WSP(bf16, WS_EXP_DN) + (size_t)l * 16 * 1024 * 1024; S.bstride = (size_t)1024 * 1024;
        EpiDown E; E.YS = WSP(bf16, WS_BIG + BIG_HS);
        gemm_run(c.lds, c.tid, S, E);
    } break;
    case 10: if constexpr (PH_EN(12)) phase_combine(c, l); break;
    }
}

__global__ void __launch_bounds__(512, 2) mega_fwd(Params p) {
    extern __shared__ __attribute__((aligned(16))) unsigned char lds_raw[];
#if XCD_BARRIER
    {
        volatile LAS unsigned* st0 = (volatile LAS unsigned*)((LAS unsigned char*)lds_raw + BAR_LDS_OFF);
        if (threadIdx.x == 0) { st0[0] = 0u; st0[1] = 0u; (void)xb_add((unsigned*)(p.ws + WS_CTL) + CW_BAR + XB_XCNT(xb_xcc_id()), 1u); }
        __syncthreads();
    }
#endif
    bool first = true;
    int rep = 0;
    for (int ph = p.ph_lo; ph < p.ph_hi;) {
        if (!phase_active(ph)) { ++ph; continue; }
        int z; asm volatile("s_mov_b32 %0, 0" : "=s"(z));
        if (!first) {
#if XCD_BARRIER
            xcd_barrier((unsigned*)(p.ws + z + WS_CTL) + CW_BAR, (volatile LAS unsigned*)((LAS unsigned char*)lds_raw + BAR_LDS_OFF));
#else
            cg::this_grid().sync();
#endif
        }
        first = false;
        Ctx c;
        c.lds = (LAS unsigned char*)lds_raw;
        c.tid = threadIdx.x + z; c.lane = c.tid & 63; c.wave = __builtin_amdgcn_readfirstlane(c.tid >> 6);
        c.gw = blockIdx.x * 8 + c.wave; c.ngw = gridDim.x * 8;
        c.in = p.in + z; c.out = p.out + z; c.ws = p.ws + z;
        run_phase(c, ph);
        if (REP_MASK != 0u && rep == 0 && (ph >= 2 ? (((REP_MASK >> ((ph - 2) % 11)) & 1u) && ((REP_LAYERS >> ((ph - 2) / 11)) & 1u)) : ((REP_MASK >> (16 + ph)) & 1u))) rep = 1; else { rep = 0; ++ph; }
    }
}

extern "C" void kernel_launch(void* const* d_in, const int* in_sizes, int n_in, void* d_out, int out_size, void* d_ws, size_t ws_size, hipStream_t stream) {
    static int grid = 0;
    if (grid == 0) {
        if (n_in != 40 || ws_size < WS_END || out_size != TL * D) { fprintf(stderr, "kernel_launch: unexpected shapes (n_in %d, ws %zu, out %d)\n", n_in, ws_size, out_size); grid = -1; return; }
        int dev = 0, cus = 0, per_cu = 0;
        hipGetDevice(&dev); hipDeviceGetAttribute(&cus, hipDeviceAttributeMultiprocessorCount, dev);
        if (hipFuncSetAttribute((const void*)mega_fwd, hipFuncAttributeMaxDynamicSharedMemorySize, LDS_BYTES) != hipSuccess) { fprintf(stderr, "kernel_launch: hipFuncSetAttribute failed\n"); grid = -1; return; }
        if (hipOccupancyMaxActiveBlocksPerMultiprocessor(&per_cu, (const void*)mega_fwd, 512, LDS_BYTES) != hipSuccess || per_cu < 1) { fprintf(stderr, "kernel_launch: occupancy query says %d\n", per_cu); per_cu = 1; }
        (void)hipGetLastError();
        grid = cus;
        fprintf(stderr, "kernel_launch: grid %d (cus %d, per_cu %d)\n", grid, cus, per_cu);
    }
    if (grid < 0) return;
    hipMemsetAsync((char*)d_ws + WS_CTL, 0, 1 * MiB, stream);
    Params p{};
    for (int i = 0; i < 40; ++i) p.in[i] = (const float*)d_in[i];
    p.out = (float*)d_out; p.ws = (unsigned char*)d_ws;
#if N_LAUNCH_PER_PHASE
    for (int ph = 0; ph < NPHASE; ++ph) {
        if (!phase_active(ph)) continue;
        p.ph_lo = ph; p.ph_hi = ph + 1; void* args[] = {&p};
        hipError_t e = hipLaunchCooperativeKernel((const void*)mega_fwd, dim3(grid), dim3(512), args, LDS_BYTES, stream);
        if (e != hipSuccess) { fprintf(stderr, "launch failed: %s\n", hipGetErrorString(e)); break; }
    }
#else
    p.ph_lo = 0; p.ph_hi = NPHASE; void* args[] = {&p};
    hipError_t e = hipLaunchCooperativeKernel((const void*)mega_fwd, dim3(grid), dim3(512), args, LDS_BYTES, stream);
    if (e != hipSuccess) fprintf(stderr, "cooperative launch failed: %s (grid %d)\n", hipGetErrorString(e), grid);
#endif
}
```

```cpp
#include <hip/hip_runtime.h>
#include <hip/hip_cooperative_groups.h>
#include <cstdio>
#include <cstdint>
namespace cg = cooperative_groups;

#define LAS __attribute__((address_space(3)))
#define DI __device__ __forceinline__
typedef unsigned short bf16;
typedef float f32x4 __attribute__((ext_vector_type(4)));
typedef float f32x2 __attribute__((ext_vector_type(2)));
typedef unsigned u32x4 __attribute__((ext_vector_type(4)));
typedef unsigned u32x2 __attribute__((ext_vector_type(2)));
typedef short bf16x8 __attribute__((ext_vector_type(8)));

#ifndef FAST_GEMM
#define FAST_GEMM 1
#endif
#ifndef MLSTM_CHUNK
#define MLSTM_CHUNK 1
#endif
#ifndef GLA_CHUNK
#define GLA_CHUNK 1
#endif
#ifndef HY_MFMA
#define HY_MFMA 1
#endif
#ifndef XCD_BARRIER
#define XCD_BARRIER 1
#endif
#ifndef PH_MASK
#define PH_MASK 0xFFFFFFFFu
#endif
#define PH_EN(b) ((PH_MASK >> (b)) & 1u)
#ifndef REP_LAYERS
#define REP_LAYERS 0xFu
#endif
#ifndef REP_MASK
#define REP_MASK 0u
#endif
#ifndef N_LAUNCH_PER_PHASE
#define N_LAUNCH_PER_PHASE 0
#endif

constexpr int D = 1024, NB = 8, SEQ = 2048, CTX = 256, DEPTH = 4;
constexpr int TC = NB * CTX, TL = NB * SEQ, TT = TC + TL;
constexpr int NEXP = 16;
constexpr int PLD = 3072;
constexpr int NINP = 3328;
constexpr float EPS = 1e-6f;
constexpr int MAXSLOT = 40960;

constexpr size_t MiB = 1u << 20;
constexpr size_t WS_CTL = 0;
constexpr size_t WS_MOD = 1 * MiB;
constexpr size_t WS_HM = 2 * MiB;
constexpr size_t WS_TOK = 3 * MiB;
constexpr size_t WS_HF = 4 * MiB;
constexpr size_t WS_HFC = 20 * MiB;
constexpr size_t WS_ML_WIN = 32 * MiB;
constexpr size_t WS_ML_WOUT = 45 * MiB;
constexpr size_t WS_GLA_WIN = 49 * MiB;
constexpr size_t WS_GLA_WOUT = 56 * MiB;
constexpr size_t WS_HY_WIN = 58 * MiB;
constexpr size_t WS_HY_WOUT = 64 * MiB;
constexpr size_t WS_EXP_UP = 66 * MiB;
constexpr size_t WS_EXP_DN = 322 * MiB;
constexpr size_t WS_X = 450 * MiB;
constexpr size_t WS_XC = 514 * MiB;
constexpr size_t WS_H = 522 * MiB;
constexpr size_t WS_P = 558 * MiB;
constexpr size_t WS_EXTRA = 667 * MiB;
constexpr size_t WS_Y = 670 * MiB;
constexpr size_t WS_BIG = 706 * MiB;
constexpr size_t WS_END = 1024 * MiB;
constexpr size_t BIG_HS = 0;
constexpr size_t BIG_ACT = 80 * MiB;
constexpr size_t BIG_PC = 0;
constexpr size_t BIG_YF = 108 * MiB;
constexpr size_t BIG_YB = 180 * MiB;

constexpr size_t BIG_MCT = 108 * MiB;
constexpr size_t BIG_MN = 180 * MiB;

constexpr size_t BIG_GB = 72 * MiB;
constexpr size_t BIG_GST = 144 * MiB;

constexpr size_t BIG_ZTL = 108 * MiB;
constexpr size_t BIG_ZTC = 140 * MiB;
constexpr size_t BIG_YTL = 144 * MiB;
constexpr size_t BIG_YTC = 176 * MiB;

constexpr int CW_CNT = 1024;
constexpr int CW_BAR = 4096;

constexpr int LDS_BYTES = 148480;
constexpr int BAR_LDS_OFF = 147456;
constexpr int MISC_OFF = 131072;

struct Params {
    const float* in[40];
    float* out;
    unsigned char* ws;
    int ph_lo, ph_hi;
};
static_assert(__builtin_offsetof(Params, in) == 0, "the input pointer table must be the first kernel argument bytes");
enum { I_X = 0, I_C, I_CTX, I_CCTX, I_ADAW, I_ADAB, I_N1G, I_N2G, I_FING, I_MLWIN, I_MLBG, I_MLCW, I_MLCB, I_MLNG, I_MLWOUT,
       I_GLWIN, I_GLCW, I_GLCB, I_GLW2, I_GLGB, I_GLNG, I_GLWOUT, I_HYWIN, I_HYBIN, I_HYCW, I_HYCB, I_HYFW1, I_HYFB1, I_HYFWM, I_HYFBM,
       I_HYFWO, I_HYFREQ, I_HYSKIP, I_HYWOUT, I_HYBOUT, I_RW, I_RB, I_EW1, I_EW3, I_EW2 };

DI float bf2f(bf16 v) { return __uint_as_float(((unsigned)v) << 16); }
typedef __bf16 b16x2_t __attribute__((ext_vector_type(2)));
DI unsigned cvt_pk_bf16(float lo, float hi) { const f32x2 v = {lo, hi}; const b16x2_t r = __builtin_convertvector(v, b16x2_t); return __builtin_bit_cast(unsigned, r); }
DI bf16 f2bf(float f) { return (bf16)(cvt_pk_bf16(f, 0.f) & 0xffffu); }
DI float sigmoidf_(float x) { return 1.0f / (1.0f + __expf(-x)); }
DI float siluf_(float x) { return x / (1.0f + __expf(-x)); }
DI float logsigf_(float x) { return fminf(x, 0.f) - log1pf(__expf(-fabsf(x))); }
DI float wave_sum(float v) {
#pragma unroll
    for (int o = 1; o < 64; o <<= 1) v += __shfl_xor(v, o);
    return v;
}
DI void unpack8(const u32x4 w, float (&v)[8]) {
    v[0] = __uint_as_float(w.x << 16); v[1] = __uint_as_float(w.x & 0xffff0000u);
    v[2] = __uint_as_float(w.y << 16); v[3] = __uint_as_float(w.y & 0xffff0000u);
    v[4] = __uint_as_float(w.z << 16); v[5] = __uint_as_float(w.z & 0xffff0000u);
    v[6] = __uint_as_float(w.w << 16); v[7] = __uint_as_float(w.w & 0xffff0000u);
}
DI u32x4 pack8(const float (&v)[8]) { u32x4 w; w.x = cvt_pk_bf16(v[0], v[1]); w.y = cvt_pk_bf16(v[2], v[3]); w.z = cvt_pk_bf16(v[4], v[5]); w.w = cvt_pk_bf16(v[6], v[7]); return w; }
DI void seq_bounds(int row, int& lo, int& hi) {
    if (row < TC) { lo = row & ~(CTX - 1); hi = lo + CTX - 1; } else { lo = TC + ((row - TC) & ~(SEQ - 1)); hi = lo + SEQ - 1; }
}
DI int perm_fwd(int s) { return (s & 63) * 32 + (s >> 6); }
DI int perm_inv(int sp) { return (sp & 31) * 64 + (sp >> 5); }

namespace pg8 {
constexpr int BM = 256, BK = 64, HALF = 128, HTB = HALF * BK * 2, STAGE_BYTES = 8 * HTB, NXCD = 8, WGM = 8;
__host__ __device__ __forceinline__ int lds_byte(int r, int c) { const int st = (r >> 4) * 2 + (c >> 5), rr = r & 15, cc = c & 31, ob = rr * 64 + cc * 2; return st * 1024 + (ob ^ (((ob >> 9) & 1) << 5)); }
__host__ __device__ __forceinline__ void stage_rc(int b, int& R, int& C) { const int st = b / 1024, sb = b % 1024, swz = sb ^ (((sb >> 9) & 1) << 5); R = (st >> 1) * 16 + swz / 64; C = (st & 1) * 32 + (swz % 64) / 2; }
__host__ __device__ __forceinline__ int perm32(int rho) { const int n = rho >> 4, i = rho & 15; return 8 * (i >> 2) + 4 * n + (i & 3); }
}
struct Unit { int pm, pn, e; };

DI LAS int* dense_units(LAS unsigned char* lds, int tid, int M, int N) {
    LAS int* ul = (LAS int*)(lds + MISC_OFF) + 192;
    __syncthreads();
    if (tid < 32) {
        const int nM = M / 256, nN = N / 256, nwg = nM * nN, G = gridDim.x, L = tid * G + (int)blockIdx.x; int w = -1;
        if (L < nwg) {
            int wgid = L; { const int q = nwg / 8, r = nwg % 8, xcd = wgid % 8, off = wgid / 8; wgid = (xcd < r ? xcd * (q + 1) : r * (q + 1) + (xcd - r) * q) + off; }
            const int nig = 8 * nN, gid = wgid / nig, fm = gid * 8, gsz = (nM - fm) < 8 ? (nM - fm) : 8;
            w = (fm + ((wgid % nig) % gsz)) | (((wgid % nig) / gsz) << 12);
        }
        ul[tid] = w;
    }
    __syncthreads();
    return ul;
}
struct DenseOrder {
    const bf16* A; const bf16* Bt; const LAS int* ul;
    DI bool next(int i, Unit& u) const {
        const int w = __builtin_amdgcn_readfirstlane(ul[i]); if (w < 0) return false;
        u.pm = w & 0xfff; u.pn = (w >> 12) & 0xf; u.e = 0; return true;
    }
    DI const bf16* aptr(const Unit& u) const { return A + (size_t)u.pm * 256 * 1024; }
    DI const bf16* bptr(const Unit& u) const { return Bt + (size_t)u.pn * 256 * 1024; }
};
struct MoeOrder {
    const bf16* A; const bf16* Bt; size_t bstride; const LAS int* ul;
    DI bool next(int i, Unit& u) const {
        const int w = __builtin_amdgcn_readfirstlane(ul[i]); if (w < 0) return false;
        u.pm = w & 0xfff; u.pn = (w >> 12) & 0xf; u.e = w >> 16; return true;
    }
    DI const bf16* aptr(const Unit& u) const { return A + (size_t)u.pm * 256 * 1024; }
    DI const bf16* bptr(const Unit& u) const { return Bt + (size_t)u.e * bstride + (size_t)u.pn * 256 * 1024; }
};

struct EpiInproj {
    static constexpr bool PAIR = false;
    bf16* P; float* extra; const float* bias; const float* bias_x;
    DI void row8(const Unit& u, int r, int c, const float (&v)[8]) const {
        const int row = u.pm * 256 + r, col = u.pn * 256 + c;
        if (col < PLD) {
            float w[8];
#pragma unroll
            for (int j = 0; j < 8; ++j) w[j] = v[j] + (bias ? bias[col + j] : 0.f);
            *(u32x4*)(P + (size_t)row * PLD + col) = pack8(w);
        } else if (col < PLD + 32) {
            float* o = extra + (size_t)row * 32 + (col - PLD);
#pragma unroll
            for (int j = 0; j < 8; ++j) o[j] = v[j] + (bias_x ? bias_x[col - PLD + j] : 0.f);
        }
    }
};
struct EpiOutproj {
    static constexpr bool PAIR = false;
    const float* xs_l; const float* xs_c; float* X; float* XC; const float* mod; const float* bias; int row_off; int perm;
    DI void row8(const Unit& u, int r, int c, const float (&v)[8]) const {
        const int hrow = u.pm * 256 + r + row_off, col = u.pn * 256 + c;
        const float* src; float* dst; int mr;
        if (hrow < TC) { mr = 8; src = xs_c + (size_t)hrow * D + col; dst = XC + (size_t)hrow * D + col; }
        else { const int rr = hrow - TC, b = rr >> 11, sp = rr & (SEQ - 1), s = perm ? perm_inv(sp) : sp; mr = b;
               src = xs_l + ((size_t)b * SEQ + s) * D + col; dst = X + ((size_t)b * SEQ + s) * D + col; }
        const float* g1 = mod + mr * 6144 + 2048 + col;
        const f32x4 a0 = *(const f32x4*)src, a1 = *(const f32x4*)(src + 4), g0 = *(const f32x4*)g1, gg1 = *(const f32x4*)(g1 + 4);
        f32x4 b0 = {0.f, 0.f, 0.f, 0.f}, b1 = b0;
        if (bias) { b0 = *(const f32x4*)(bias + col); b1 = *(const f32x4*)(bias + col + 4); }
        f32x4 o0, o1;
        o0 = a0 + g0 * ((f32x4){v[0], v[1], v[2], v[3]} + b0); o1 = a1 + gg1 * ((f32x4){v[4], v[5], v[6], v[7]} + b1);
        *(f32x4*)dst = o0; *(f32x4*)(dst + 4) = o1;
    }
};
struct EpiUp {
    static constexpr bool PAIR = true;
    bf16* ACT;
    DI void row8p(const Unit& u, int r, int c, const float (&g)[8], const float (&up)[8]) const {
        float w[8];
#pragma unroll
        for (int j = 0; j < 8; ++j) w[j] = siluf_(g[j]) * up[j];
        *(u32x4*)(ACT + ((size_t)u.pm * 256 + r) * 1024 + u.pn * 128 + c) = pack8(w);
    }
};
struct EpiDown {
    static constexpr bool PAIR = false;
    bf16* YS;
    DI void row8(const Unit& u, int r, int c, const float (&v)[8]) const { *(u32x4*)(YS + ((size_t)u.pm * 256 + r) * 1024 + u.pn * 256 + c) = pack8(v); }
};

template <class Sched, class Epi>
DI void gemm_fast(LAS unsigned char* lds, int tid, const Sched& S, const Epi& E) {
    using namespace pg8;
    constexpr int K = 1024, nt = K / BK;
    const int wid = __builtin_amdgcn_readfirstlane(tid >> 6), lane = tid & 63, wr = wid >> 2, wc = wid & 3, fr = lane & 15, fq = lane >> 4;
    unsigned voffA[2], voffB[2];
#pragma unroll
    for (int i = 0; i < 2; ++i) { int R, C; stage_rc(tid * 16 + i * 8192, R, C); const int Rb = (R & ~31) + perm32(R & 31);
        voffA[i] = (unsigned)(R * K + C) * 2u; voffB[i] = (unsigned)(Rb * K + C) * 2u; }
    const size_t kstep = (size_t)(BK * 2);
    const size_t hstep = (size_t)HALF * K * 2;
    const unsigned ldsw = (unsigned)wid * 1024u;
    const int aoff = lds_byte(wr * 64 + fr, fq * 8), boff = lds_byte(wc * 32 + fr, fq * 8);
#define PG8_SA(b, h) (((b) * 2 + (h)) * HTB)
#define PG8_SB(b, h) ((4 + (b) * 2 + (h)) * HTB)
#define PG8_STAGE(bufoff, gbase, voff) do { _Pragma("unroll") for (int _i = 0; _i < 2; ++_i) \
        __builtin_amdgcn_global_load_lds((const unsigned*)((const char*)(gbase) + (voff)[_i]), (LAS unsigned*)(lds + (bufoff) + ldsw + _i * 8192), 16, 0, 0); } while (0)
#define PG8_LDA(dst, b, h) do { _Pragma("unroll") for (int m = 0; m < 4; ++m) _Pragma("unroll") for (int k = 0; k < 2; ++k) dst[m][k] = *(const LAS bf16x8*)(lds + PG8_SA(b, h) + aoff + m * 2048 + k * 1024); } while (0)
#define PG8_LDB(dst, b, h) do { _Pragma("unroll") for (int n = 0; n < 2; ++n) _Pragma("unroll") for (int k = 0; k < 2; ++k) dst[n][k] = *(const LAS bf16x8*)(lds + PG8_SB(b, h) + boff + n * 2048 + k * 1024); } while (0)
#define PG8_MMA(ai, bj, At, Bt) do { __builtin_amdgcn_s_setprio(1); _Pragma("unroll") for (int m = 0; m < 4; ++m) _Pragma("unroll") for (int n = 0; n < 2; ++n) _Pragma("unroll") for (int k = 0; k < 2; ++k) \
        acc[ai][bj][m][n] = __builtin_amdgcn_mfma_f32_16x16x32_bf16(Bt[n][k], At[m][k], acc[ai][bj][m][n], 0, 0, 0); __builtin_amdgcn_s_setprio(0); } while (0)
#define PG8_WAIT_V(n) asm volatile("s_waitcnt vmcnt(" #n ")" ::: "memory")
#define PG8_WAIT_L(n) asm volatile("s_waitcnt lgkmcnt(" #n ")" ::: "memory")
#define PG8_BAR __builtin_amdgcn_s_barrier()
#define PG8_SCHED __builtin_amdgcn_sched_barrier(0)
    Unit cur, nxt; int ui = 0;
    if (!S.next(0, cur)) return;
    f32x4 acc[2][2][4][2];
#pragma unroll
    for (int a = 0; a < 2; ++a)
#pragma unroll
        for (int b = 0; b < 2; ++b)
#pragma unroll
            for (int m = 0; m < 4; ++m)
#pragma unroll
                for (int n = 0; n < 2; ++n) acc[a][b][m][n] = (f32x4){0.f, 0.f, 0.f, 0.f};
    bf16x8 At[4][2], B0[2][2], B1[2][2];
    const char* cA = (const char*)S.aptr(cur); const char* cB = (const char*)S.bptr(cur);
    PG8_STAGE(PG8_SB(0, 0), cB, voffB); PG8_STAGE(PG8_SA(0, 0), cA, voffA); PG8_STAGE(PG8_SB(0, 1), cB + hstep, voffB); PG8_STAGE(PG8_SA(0, 1), cA + hstep, voffA);
    if (wr == 1) PG8_BAR;
    PG8_WAIT_V(4); PG8_BAR;
    PG8_STAGE(PG8_SB(1, 0), cB + kstep, voffB); PG8_STAGE(PG8_SA(1, 0), cA + kstep, voffA); PG8_STAGE(PG8_SB(1, 1), cB + hstep + kstep, voffB);
    PG8_WAIT_V(6); PG8_BAR;
    for (;;) {
        const bool has_next = S.next(ui + 1, nxt);
        const char* nA = has_next ? (const char*)S.aptr(nxt) : cA; const char* nB = has_next ? (const char*)S.bptr(nxt) : cB;
        for (int t = 0; t < nt; t += 2) {
            const bool last = (t == nt - 2);
            const char* a1 = cA + (size_t)(t + 1) * kstep;
            const char* a2 = last ? nA : cA + (size_t)(t + 2) * kstep; const char* b2 = last ? nB : cB + (size_t)(t + 2) * kstep;
            const char* a3 = a2 + kstep; const char* b3 = b2 + kstep;
            PG8_LDB(B0, 0, 0); PG8_SCHED; PG8_LDA(At, 0, 0); PG8_STAGE(PG8_SA(1, 1), a1 + hstep, voffA);
            PG8_WAIT_L(8); PG8_BAR; PG8_WAIT_L(0); PG8_MMA(0, 0, At, B0); PG8_BAR; PG8_SCHED;
            PG8_LDB(B1, 0, 1); PG8_STAGE(PG8_SB(0, 0), b2, voffB);
            PG8_BAR; PG8_WAIT_L(0); PG8_MMA(0, 1, At, B1); PG8_BAR;
            PG8_LDA(At, 0, 1); PG8_STAGE(PG8_SA(0, 0), a2, voffA);
            PG8_BAR; PG8_WAIT_L(0); PG8_MMA(1, 0, At, B0); PG8_BAR; PG8_SCHED;
            PG8_STAGE(PG8_SB(0, 1), b2 + hstep, voffB);
            PG8_WAIT_V(6); PG8_BAR; PG8_MMA(1, 1, At, B1); PG8_BAR;
            PG8_LDB(B0, 1, 0); PG8_SCHED; PG8_LDA(At, 1, 0); PG8_STAGE(PG8_SA(0, 1), a2 + hstep, voffA);
            PG8_WAIT_L(8); PG8_BAR; PG8_WAIT_L(0); PG8_MMA(0, 0, At, B0); PG8_BAR; PG8_SCHED;
            PG8_LDB(B1, 1, 1); PG8_STAGE(PG8_SB(1, 0), b3, voffB);
            PG8_BAR; PG8_WAIT_L(0); PG8_MMA(0, 1, At, B1); PG8_BAR;
            PG8_LDA(At, 1, 1); PG8_STAGE(PG8_SA(1, 0), a3, voffA);
            PG8_BAR; PG8_WAIT_L(0); PG8_MMA(1, 0, At, B0); PG8_BAR; PG8_SCHED;
            PG8_STAGE(PG8_SB(1, 1), b3 + hstep, voffB);
            PG8_WAIT_V(6); PG8_BAR; PG8_MMA(1, 1, At, B1); PG8_BAR;
        }
#pragma unroll
        for (int ai = 0; ai < 2; ++ai)
#pragma unroll
            for (int m = 0; m < 4; ++m) {
                const int r = ai * HALF + wr * 64 + m * 16 + fr;
                if constexpr (Epi::PAIR) {
                    const float g[8] = {acc[ai][0][m][0][0], acc[ai][0][m][0][1], acc[ai][0][m][0][2], acc[ai][0][m][0][3], acc[ai][0][m][1][0], acc[ai][0][m][1][1], acc[ai][0][m][1][2], acc[ai][0][m][1][3]};
                    const float up[8] = {acc[ai][1][m][0][0], acc[ai][1][m][0][1], acc[ai][1][m][0][2], acc[ai][1][m][0][3], acc[ai][1][m][1][0], acc[ai][1][m][1][1], acc[ai][1][m][1][2], acc[ai][1][m][1][3]};
                    E.row8p(cur, r, wc * 32 + 8 * fq, g, up);
                } else {
#pragma unroll
                    for (int bj = 0; bj < 2; ++bj) {
                        const float v[8] = {acc[ai][bj][m][0][0], acc[ai][bj][m][0][1], acc[ai][bj][m][0][2], acc[ai][bj][m][0][3], acc[ai][bj][m][1][0], acc[ai][bj][m][1][1], acc[ai][bj][m][1][2], acc[ai][bj][m][1][3]};
                        E.row8(cur, r, bj * HALF + wc * 32 + 8 * fq, v);
                    }
                }
            }
        if (!has_next) break;
#pragma unroll
        for (int a = 0; a < 2; ++a)
#pragma unroll
            for (int b = 0; b < 2; ++b)
#pragma unroll
                for (int m = 0; m < 4; ++m)
#pragma unroll
                    for (int n = 0; n < 2; ++n) acc[a][b][m][n] = (f32x4){0.f, 0.f, 0.f, 0.f};
        cur = nxt; cA = nA; cB = nB; ++ui;
    }
    PG8_WAIT_V(0);
    if (wr == 0) PG8_BAR;
    PG8_BAR;
#undef PG8_SA
#undef PG8_SB
#undef PG8_STAGE
#undef PG8_LDA
#undef PG8_LDB
#undef PG8_MMA
#undef PG8_WAIT_V
#undef PG8_WAIT_L
#undef PG8_BAR
#undef PG8_SCHED
}

template <class Sched, class Epi>
DI void gemm_naive(LAS unsigned char* lds, int tid, const Sched& S, const Epi& E) {
    LAS float* As = (LAS float*)lds;
    LAS float* Bs = As + 32 * 132;
    LAS float* Bu = Bs + 32 * 132;
    const int ty = tid >> 4, tx = tid & 15, lr = tid >> 2, kq = tid & 3;
    Unit u;
    for (int i = 0; S.next(i, u); ++i) {
        const bf16* A = S.aptr(u); const bf16* B = S.bptr(u);
        for (int sm = 0; sm < 2; ++sm)
            for (int sn = 0; sn < (Epi::PAIR ? 1 : 2); ++sn) {
                float acc[4][8], accu[4][8];
#pragma unroll
                for (int a = 0; a < 4; ++a)
#pragma unroll
                    for (int b = 0; b < 8; ++b) { acc[a][b] = 0.f; accu[a][b] = 0.f; }
                for (int k0 = 0; k0 < 1024; k0 += 32) {
                    __syncthreads();
                    { float w[8]; unpack8(*(const u32x4*)(A + (size_t)(128 * sm + lr) * 1024 + k0 + 8 * kq), w);
#pragma unroll
                      for (int j = 0; j < 8; ++j) As[(8 * kq + j) * 132 + lr] = w[j];
                      unpack8(*(const u32x4*)(B + (size_t)(128 * sn + lr) * 1024 + k0 + 8 * kq), w);
#pragma unroll
                      for (int j = 0; j < 8; ++j) Bs[(8 * kq + j) * 132 + lr] = w[j];
                      if (Epi::PAIR) { unpack8(*(const u32x4*)(B + (size_t)(128 + lr) * 1024 + k0 + 8 * kq), w);
#pragma unroll
                          for (int j = 0; j < 8; ++j) Bu[(8 * kq + j) * 132 + lr] = w[j]; } }
                    __syncthreads();
#pragma unroll 4
                    for (int k = 0; k < 32; ++k) {
                        const f32x4 a4 = *(const LAS f32x4*)(As + k * 132 + 4 * ty);
                        const f32x4 b0 = *(const LAS f32x4*)(Bs + k * 132 + 8 * tx), b1 = *(const LAS f32x4*)(Bs + k * 132 + 8 * tx + 4);
#pragma unroll
                        for (int a = 0; a < 4; ++a) {
#pragma unroll
                            for (int b = 0; b < 4; ++b) { acc[a][b] += a4[a] * b0[b]; acc[a][4 + b] += a4[a] * b1[b]; } }
                        if (Epi::PAIR) {
                            const f32x4 c0 = *(const LAS f32x4*)(Bu + k * 132 + 8 * tx), c1 = *(const LAS f32x4*)(Bu + k * 132 + 8 * tx + 4);
#pragma unroll
                            for (int a = 0; a < 4; ++a) {
#pragma unroll
                                for (int b = 0; b < 4; ++b) { accu[a][b] += a4[a] * c0[b]; accu[a][4 + b] += a4[a] * c1[b]; } }
                        }
                    }
                }
#pragma unroll
                for (int a = 0; a < 4; ++a) {
                    if constexpr (Epi::PAIR) E.row8p(u, 128 * sm + 4 * ty + a, 8 * tx, acc[a], accu[a]);
                    else E.row8(u, 128 * sm + 4 * ty + a, 128 * sn + 8 * tx, acc[a]);
                }
            }
    }
    __syncthreads();
}
template <class Sched, class Epi>
DI void gemm_run(LAS unsigned char* lds, int tid, const Sched& S, const Epi& E) {
#if FAST_GEMM
    gemm_fast(lds, tid, S, E);
#else
    gemm_naive(lds, tid, S, E);
#endif
}

struct Ctx {
    LAS unsigned char* lds;
    int tid, lane, wave, gw, ngw;
    unsigned z;
    const float* const __attribute__((address_space(4)))* in;
    float* out;
    unsigned char* ws;
};
#define WSP(T, off) ((T*)(c.ws + (off)))

DI void transpose_item(const float* W, int N, bf16* WT, int k0, int n0, int dst_row0, LAS float* scr, int lane) {
#pragma unroll 8
    for (int i = 0; i < 32; ++i) { const int kk = 2 * i + (lane >> 5); scr[kk * 33 + (lane & 31)] = W[(size_t)(k0 + kk) * N + n0 + (lane & 31)]; }
    asm volatile("s_waitcnt lgkmcnt(0)" ::: "memory");
    const int cc = lane & 7;
#pragma unroll
    for (int j = 0; j < 4; ++j) { const int n = (lane >> 3) + 8 * j; const LAS float* s = scr + (8 * cc) * 33 + n;
        u32x4 o; o.x = cvt_pk_bf16(s[0 * 33], s[1 * 33]); o.y = cvt_pk_bf16(s[2 * 33], s[3 * 33]); o.z = cvt_pk_bf16(s[4 * 33], s[5 * 33]); o.w = cvt_pk_bf16(s[6 * 33], s[7 * 33]);
        *(u32x4*)(WT + (size_t)(dst_row0 + n) * 1024 + k0 + 8 * cc) = o; }
    asm volatile("s_waitcnt lgkmcnt(0)" ::: "memory");
}
DI void dense_transpose(const Ctx& c, const float* W, int N, bf16* WT, LAS float* scr) {
    const int nblk = N / 32, nitems = 16 * nblk;
    for (int it = c.gw; it < nitems; it += c.ngw) { const int kb = it / nblk, nb = it % nblk; transpose_item(W, N, WT, 64 * kb, 32 * nb, 32 * nb, scr, c.lane); }
}
DI void phase_pro0(const Ctx& c) {
    LAS float* scr = (LAS float*)(c.lds + c.wave * 8704);
    for (int j = 0; j < 2; ++j) {
        dense_transpose(c, c.in[I_MLWIN] + (size_t)j * 1024 * 3104, 3104, WSP(bf16, WS_ML_WIN) + (size_t)j * NINP * 1024, scr);
        dense_transpose(c, c.in[I_MLWOUT] + (size_t)j * 1024 * 1024, 1024, WSP(bf16, WS_ML_WOUT) + (size_t)j * 1024 * 1024, scr);
    }
    dense_transpose(c, c.in[I_GLWIN], 3104, WSP(bf16, WS_GLA_WIN), scr);
    dense_transpose(c, c.in[I_GLWOUT], 1024, WSP(bf16, WS_GLA_WOUT), scr);
    dense_transpose(c, c.in[I_HYWIN], 3072, WSP(bf16, WS_HY_WIN), scr);
    dense_transpose(c, c.in[I_HYWOUT], 1024, WSP(bf16, WS_HY_WOUT), scr);
    for (int it = c.gw * 64 + c.lane; it < 3 * 28672; it += c.ngw * 64) {
        const int m = it / 28672, r = it % 28672; bf16* base = (m < 2) ? WSP(bf16, WS_ML_WIN) + (size_t)m * NINP * 1024 : WSP(bf16, WS_GLA_WIN);
        *(u32x4*)(base + (size_t)3104 * 1024 + (size_t)r * 8) = (u32x4){c.z, c.z, c.z, c.z};
    }
    for (int it = c.gw; it < 64 * 3 * 512; it += c.ngw) {
        const int le = it / 1536, r0 = it % 1536, which = r0 / 512, r = r0 % 512, kb = r / 32, nb = r % 32;
        if (which < 2) {
            const float* W = c.in[which == 0 ? I_EW1 : I_EW3] + (size_t)le * 1024 * 1024;
            const int n0 = 32 * nb, drow = 256 * (n0 >> 7) + (n0 & 127) + (which ? 128 : 0);
            transpose_item(W, 1024, WSP(bf16, WS_EXP_UP) + (size_t)le * 2048 * 1024, 64 * kb, n0, drow, scr, c.lane);
        } else {
            transpose_item(c.in[I_EW2] + (size_t)le * 1024 * 1024, 1024, WSP(bf16, WS_EXP_DN) + (size_t)le * 1024 * 1024, 64 * kb, 32 * nb, 32 * nb, scr, c.lane);
        }
    }
    {
        const float* w1 = c.in[I_HYFW1]; const float* b1 = c.in[I_HYFB1]; const float* wm = c.in[I_HYFWM]; const float* bm = c.in[I_HYFBM]; const float* fr = c.in[I_HYFREQ];
        float* HM = WSP(float, WS_HM);
        for (int row = c.gw; row < 2304; row += c.ngw) {
            const int L = row < 2048 ? 2048 : 256, t = row < 2048 ? row : row - 2048, f = c.lane;
            float feat = 0.f;
            if (f == 0) feat = (float)t / (float)(L - 1);
            else if (f <= 32) { const int b = (f - 1) & 15; const float band = 1e-4f + (float)b * ((15.0f - 1e-4f) / 15.0f);
                const float ang = ((float)(2.0 * 3.14159265358979323846 / (double)L) * (float)t) * band; feat = (f <= 16) ? cosf(ang) : -sinf(ang); }
            float a = b1[f];
            for (int e = 0; e < 33; ++e) a += __shfl(feat, e) * w1[e * 64 + f];
            float h = sinf(fr[f] * a);
            for (int m = 0; m < 2; ++m) {
                float a2 = bm[m * 64 + f];
                for (int g = 0; g < 64; ++g) a2 += __shfl(h, g) * wm[m * 4096 + g * 64 + f];
                h = sinf(fr[f] * a2);
            }
            HM[row * 64 + f] = h;
        }
    }
    __syncthreads();
    {
        LAS float* sv = (LAS float*)c.lds;
        LAS float* red = sv + 9 * 1024;
        for (int i = c.tid; i < 9 * 1024; i += 512) { const float x = (i < 8192) ? c.in[I_C][i] : c.in[I_CCTX][i - 8192]; sv[i] = siluf_(x); }
        __syncthreads();
        float* MOD = WSP(float, WS_MOD);
        const int col = c.tid & 63, kg = c.tid >> 6;
        for (int item = blockIdx.x; item < 4 * 96; item += gridDim.x) {
            const int l = item / 96, j0 = 64 * (item % 96);
            const float* w = c.in[I_ADAW] + (size_t)l * 1024 * 6144 + j0 + col;
            float acc[9];
#pragma unroll
            for (int r = 0; r < 9; ++r) acc[r] = 0.f;
            for (int k = kg * 128; k < kg * 128 + 128; ++k) { const float wv = w[(size_t)k * 6144];
#pragma unroll
                for (int r = 0; r < 9; ++r) acc[r] += sv[r * 1024 + k] * wv; }
#pragma unroll
            for (int r = 0; r < 9; ++r) red[(kg * 9 + r) * 64 + col] = acc[r];
            __syncthreads();
            for (int o = c.tid; o < 9 * 64; o += 512) { const int r = o >> 6, cc = o & 63; float s = c.in[I_ADAB][l * 6144 + j0 + cc];
#pragma unroll
                for (int g = 0; g < 8; ++g) s += red[(g * 9 + r) * 64 + cc];
                MOD[(l * 9 + r) * 6144 + j0 + cc] = s; }
            __syncthreads();
        }
    }
}

template <int L>
DI void pro1_len(const Ctx& c, int c0, const float* hm, float* tab, const LAS float* wo  , LAS float* red  ) {
    constexpr int NT = (L + 511) / 512;
    float val[NT][8]; float part[4] = {0.f, 0.f, 0.f, 0.f};
    const float da = -4.605170185988091f / 1.5f, db = -4.605170185988091f / 0.3f;
#pragma unroll
    for (int i = 0; i < NT; ++i) {
        const int t = c.tid + 512 * i;
#pragma unroll
        for (int o = 0; o < 8; ++o) val[i][o] = 0.f;
        if (t < L) {
            const float* hr = hm + (size_t)t * 64;
#pragma unroll 2
            for (int q = 0; q < 16; ++q) { const f32x4 h4 = *(const f32x4*)(hr + 4 * q); asm volatile("" ::: "memory");
#pragma unroll
                for (int o = 0; o < 8; ++o) { const f32x4 w4 = *(const LAS f32x4*)(wo + o * 64 + 4 * q); val[i][o] += (h4.x * w4.x + h4.y * w4.y) + (h4.z * w4.z + h4.w * w4.w); } }
            const float tl = (float)t / (float)(L - 1);
#pragma unroll
            for (int ch = 0; ch < 4; ++ch) { const float delta = fabsf(da + (float)(c0 + ch) * ((db - da) / 1023.0f)), dec = expf(-tl * delta);
                val[i][ch] *= dec; val[i][4 + ch] *= dec; part[ch] += fabsf(val[i][ch]) + (t >= 1 ? fabsf(val[i][4 + ch]) : 0.f); }
        }
    }
#pragma unroll
    for (int ch = 0; ch < 4; ++ch) part[ch] = wave_sum(part[ch]);
    __syncthreads();
    if (c.lane == 0) {
#pragma unroll
        for (int ch = 0; ch < 4; ++ch) red[c.wave * 4 + ch] = part[ch]; }
    __syncthreads();
    float inv[4];
#pragma unroll
    for (int ch = 0; ch < 4; ++ch) { float s = 0.f;
#pragma unroll
        for (int w = 0; w < 8; ++w) s += red[w * 4 + ch];
        inv[ch] = 1.0f / s; }
#pragma unroll
    for (int i = 0; i < NT; ++i) { const int t = c.tid + 512 * i;
        if (t < L) {
#pragma unroll
            for (int ch = 0; ch < 4; ++ch) { float* trow = tab + (size_t)(c0 + ch) * (2 * L); trow[L + t] = val[i][ch] * inv[ch]; if (t >= 1) trow[L - t] = val[i][4 + ch] * inv[ch]; else trow[0] = 0.f; } } }
}
DI void phase_pro1(const Ctx& c) {
    LAS float* wo = (LAS float*)c.lds;
    LAS float* red = wo + 512;
    const float* HM = WSP(float, WS_HM);
    for (int item = blockIdx.x; item < 256; item += gridDim.x) {
        const int c0 = 4 * item;
        __syncthreads();
        { const int o = c.tid >> 6, f = c.tid & 63; wo[c.tid] = c.in[I_HYFWO][f * 2048 + (o >> 2) * 1024 + c0 + (o & 3)]; }
        __syncthreads();
        pro1_len<SEQ>(c, c0, HM, WSP(float, WS_HF), wo, red);
        pro1_len<CTX>(c, c0, HM + 2048 * 64, WSP(float, WS_HFC), wo, red);
    }
}

DI void load_row(const float* src, f32x4 (&v)[4], int lane) {
#pragma unroll
    for (int j = 0; j < 4; ++j) v[j] = *(const f32x4*)(src + 256 * j + 4 * lane);
}
DI void norm_row(f32x4 (&v)[4], const float* g, int lane) {
    float s = 0.f;
#pragma unroll
    for (int j = 0; j < 4; ++j) s += (v[j].x * v[j].x + v[j].y * v[j].y) + (v[j].z * v[j].z + v[j].w * v[j].w);
    s = wave_sum(s);
    const float r = 1.0f / sqrtf(s * (1.0f / 1024.0f) + EPS);
#pragma unroll
    for (int j = 0; j < 4; ++j) v[j] = v[j] * r * *(const f32x4*)(g + 256 * j + 4 * lane);
}
DI void mod_row(f32x4 (&v)[4], const float* sh, const float* sc, int lane) {
#pragma unroll
    for (int j = 0; j < 4; ++j) v[j] = v[j] * (*(const f32x4*)(sc + 256 * j + 4 * lane) + 1.0f) + *(const f32x4*)(sh + 256 * j + 4 * lane);
}
DI void store_row_bf16(bf16* dst, const f32x4 (&v)[4], int lane) {
#pragma unroll
    for (int j = 0; j < 4; ++j) { u32x2 w; w.x = cvt_pk_bf16(v[j].x, v[j].y); w.y = cvt_pk_bf16(v[j].z, v[j].w); *(u32x2*)(dst + 256 * j + 4 * lane) = w; }
}
DI int hrow_of(int srow, int kind) {
    if (srow < TC || kind != 1) return srow;
    const int rr = srow - TC, b = rr >> 11, s = rr & (SEQ - 1); return TC + b * SEQ + perm_fwd(s);
}
DI void phase_norm1(const Ctx& c, int l, const float* xl, const float* xc) {
    const float* MOD = WSP(float, WS_MOD) + (size_t)l * 9 * 6144; const float* g = c.in[I_N1G] + l * D; bf16* H = WSP(bf16, WS_H);
    for (int row = c.gw; row < TT; row += c.ngw) {
        f32x4 v[4]; const int mr = row < TC ? 8 : (row - TC) >> 11;
        load_row(row < TC ? xc + (size_t)row * D : xl + (size_t)(row - TC) * D, v, c.lane);
        norm_row(v, g, c.lane); mod_row(v, MOD + mr * 6144, MOD + mr * 6144 + 1024, c.lane);
        store_row_bf16(H + (size_t)hrow_of(row, l % 3) * D, v, c.lane);
    }
}

DI void phase_conv(const Ctx& c, int ncols, const float* cw, const float* cb, bool act, float qs) {
    const bf16* P = WSP(bf16, WS_P); bf16* PC = WSP(bf16, WS_BIG + BIG_PC);
    const int ng = ncols / 8; const long total = (long)TT * ng;
    for (long idx = (long)blockIdx.x * 512 + c.tid; idx < total; idx += (long)gridDim.x * 512) {
        const int row = (int)(idx / ng), col = (int)(idx % ng) * 8; int lo, hi; seq_bounds(row, lo, hi);
        float x0[8], xm[8], xp[8];
        unpack8(*(const u32x4*)(P + (size_t)row * PLD + col), x0);
        if (row > lo) unpack8(*(const u32x4*)(P + (size_t)(row - 1) * PLD + col), xm); else {
#pragma unroll
            for (int j = 0; j < 8; ++j) xm[j] = 0.f; }
        if (row < hi) unpack8(*(const u32x4*)(P + (size_t)(row + 1) * PLD + col), xp); else {
#pragma unroll
            for (int j = 0; j < 8; ++j) xp[j] = 0.f; }
        float o[8];
#pragma unroll
        for (int j = 0; j < 8; ++j) { float v = cw[col + j] * xm[j] + cw[ncols + col + j] * x0[j] + cw[2 * ncols + col + j] * xp[j] + cb[col + j];
            if (act) v = siluf_(v); if (col < 512) v *= qs; o[j] = v; }
        *(u32x4*)(PC + (size_t)row * ncols + col) = pack8(o);
    }
}

DI int scan_row(int step, int b, int dir) {
    if (step < CTX) return b * CTX + (dir ? CTX - 1 - step : step);
    const int s = step - CTX; return TC + b * SEQ + (dir ? SEQ - 1 - s : s);
}
DI void phase_mlstm_scan_naive(const Ctx& c) {
    const bf16* P = WSP(bf16, WS_P); const bf16* PC = WSP(bf16, WS_BIG + BIG_PC); const float* EX = WSP(float, WS_EXTRA);
    LAS float* qs = (LAS float*)c.lds; LAS float* ks = qs + 32 * 64; LAS float* vs = ks + 32 * 64; LAS float* gs = vs + 32 * 128;
    const int v = c.tid >> 2, d0 = (c.tid & 3) * 16;
    for (int item = blockIdx.x; item < 128; item += gridDim.x) {
        const int b = item >> 4, h = (item >> 1) & 7, dir = item & 1;
        float* Yo = WSP(float, WS_BIG + (dir ? BIG_YB : BIG_YF));
        float C[16], n[16];
#pragma unroll
        for (int d = 0; d < 16; ++d) { C[d] = 0.f; n[d] = 0.f; }
        for (int ch = 0; ch < (CTX + SEQ) / 32; ++ch) {
            __syncthreads();
            for (int idx = c.tid; idx < 32 * 256; idx += 512) { const int st = idx >> 8, col = idx & 255, row = scan_row(ch * 32 + st, b, dir);
                if (col < 64) qs[st * 64 + col] = bf2f(PC[(size_t)row * 1024 + h * 64 + col]);
                else if (col < 128) ks[st * 64 + col - 64] = bf2f(PC[(size_t)row * 1024 + 512 + h * 64 + col - 64]);
                else vs[st * 128 + col - 128] = bf2f(P[(size_t)row * PLD + 1024 + h * 128 + col - 128]); }
            if (c.tid < 32) { const int row = scan_row(ch * 32 + c.tid, b, dir); gs[c.tid * 2] = sigmoidf_(EX[(size_t)row * 32 + dir * 16 + 8 + h]); gs[c.tid * 2 + 1] = __expf(EX[(size_t)row * 32 + dir * 16 + h]); }
            __syncthreads();
            for (int st = 0; st < 32; ++st) {
                const float f = gs[st * 2], ei = gs[st * 2 + 1], vv = vs[st * 128 + v] * ei;
                float part = 0.f, dpart = 0.f;
#pragma unroll
                for (int d = 0; d < 16; ++d) { const float kd = ks[st * 64 + d0 + d], qd = qs[st * 64 + d0 + d];
                    C[d] = f * C[d] + kd * vv; part += qd * C[d]; n[d] = f * n[d] + ei * kd; dpart += qd * n[d]; }
                part += __shfl_xor(part, 1); part += __shfl_xor(part, 2); dpart += __shfl_xor(dpart, 1); dpart += __shfl_xor(dpart, 2);
                if ((c.tid & 3) == 0) { const int row = scan_row(ch * 32 + st, b, dir); Yo[(size_t)row * D + h * 128 + v] = part / fmaxf(fabsf(dpart), 1.0f); }
            }
        }
    }
}
typedef short s16x4 __attribute__((ext_vector_type(4)));
typedef float f32x16 __attribute__((ext_vector_type(16)));
#define MFMA32(a, b, c) __builtin_amdgcn_mfma_f32_32x32x16_bf16((a), (b), (c), 0, 0, 0)
DI int crow(int reg, int h) { return (reg & 3) + 8 * (reg >> 2) + 4 * h; }
DI s16x4 ds_tr(const LAS unsigned char* p) { return __builtin_amdgcn_ds_read_tr16_b64_v4i16((LAS s16x4*)p); }
DI bf16x8 cat8(s16x4 lo, s16x4 hi) { return __builtin_shufflevector(lo, hi, 0, 1, 2, 3, 4, 5, 6, 7); }
DI bf16x8 tr_frag(const LAS unsigned char* img, int pitch, int k0, int n0, int lane) {
    const int h = lane >> 5, g16 = (lane >> 4) & 1, i = lane & 15;
    const LAS unsigned char* p = img + (k0 + 8 * h + (i >> 2)) * pitch + (n0 + 16 * g16 + 4 * (i & 3)) * 2;
    return cat8(ds_tr(p), ds_tr(p + 4 * pitch));
}
DI bf16x8 tr_frag_perm(const LAS unsigned char* img, int pitch, int k0, int n0, int lane) {
    const int h = lane >> 5, g16 = (lane >> 4) & 1, i = lane & 15;
    const LAS unsigned char* p = img + (k0 + 4 * h + (i >> 2)) * pitch + (n0 + 16 * g16 + 4 * (i & 3)) * 2;
    return cat8(ds_tr(p), ds_tr(p + 8 * pitch));
}
DI bf16x8 row_frag(const LAS unsigned char* img, int pitch, int row0, int k0, int lane) { return *(const LAS bf16x8*)(img + (row0 + (lane & 31)) * pitch + (k0 + 8 * (lane >> 5)) * 2); }
DI bf16x8 pack_acc(const f32x16& x, int step) {
    u32x4 p; const int o = 8 * step;
    p.x = cvt_pk_bf16(x[o], x[o + 1]); p.y = cvt_pk_bf16(x[o + 2], x[o + 3]); p.z = cvt_pk_bf16(x[o + 4], x[o + 5]); p.w = cvt_pk_bf16(x[o + 6], x[o + 7]);
    return __builtin_bit_cast(bf16x8, p);
}
DI f32x16 zero16() { f32x16 z;
#pragma unroll
    for (int i = 0; i < 16; ++i) z[i] = 0.f; return z; }
DI float wave_incl_prefix(float x, int lane) {
#pragma unroll
    for (int o = 1; o < 64; o <<= 1) { const float t = __shfl_up(x, o); if (lane >= o) x += t; }
    return x;
}
DI float wave_incl_suffix(float x, int lane) {
#pragma unroll
    for (int o = 1; o < 64; o <<= 1) { const float t = __shfl_down(x, o); if (lane + o < 64) x += t; }
    return x;
}
DI int chunk_row0(int p, int b, int dir) {
    if (p < 4) return b * CTX + 64 * (dir ? 3 - p : p);
    return TC + b * SEQ + 64 * (dir ? 35 - p : p - 4);
}

DI void phase_mlstm_state(const Ctx& c) {
    const bf16* P = WSP(bf16, WS_P); const bf16* PC = WSP(bf16, WS_BIG + BIG_PC); const float* EX = WSP(float, WS_EXTRA);
    bf16* MCT = WSP(bf16, WS_BIG + BIG_MCT); float* MN = WSP(float, WS_BIG + BIG_MN);
    LAS float* gi = (LAS float*)c.lds; LAS float* ga = gi + 2304; LAS float* wv = ga + 2304; LAS float* dec = wv + 64;
    LAS unsigned char* Kw = c.lds + 20480; LAS unsigned char* Vs = Kw + 64 * 144;
    const int lane = c.lane, wave = c.wave, h5 = lane >> 5, l31 = lane & 31;
    for (int item = blockIdx.x; item < 256; item += gridDim.x) {
        const int b = item >> 5, h = (item >> 2) & 7, dir = (item >> 1) & 1, dvh = item & 1, seq = (b * 8 + h) * 2 + dir;
        __syncthreads();
        for (int idx = c.tid; idx < 2304; idx += 512) { const int row = chunk_row0(idx >> 6, b, dir) + (idx & 63);
            gi[idx] = EX[(size_t)row * 32 + dir * 16 + h]; ga[idx] = logsigf_(EX[(size_t)row * 32 + dir * 16 + 8 + h]); }
        f32x16 acc = zero16(); float nst = 0.f;
        const int dt = wave & 1, vt = (wave >> 1) & 1;
        const int srow = c.tid >> 3, spc = c.tid & 7;
        u32x4 kreg, vreg;
        { const int r0 = chunk_row0(0, b, dir);
          kreg = *(const u32x4*)(PC + (size_t)(r0 + srow) * 1024 + 512 + h * 64 + 8 * spc);
          vreg = *(const u32x4*)(P + (size_t)(r0 + srow) * PLD + 1024 + h * 128 + dvh * 64 + 8 * spc); }
        __syncthreads();
        for (int p = 0; p < 36; ++p) {
            if (wave < 4) {
                bf16* dst = MCT + ((size_t)seq * 36 + p) * 8192 + (size_t)(dvh * 64 + 32 * vt + l31) * 64 + 32 * dt + 4 * h5;
#pragma unroll
                for (int q = 0; q < 4; ++q) { u32x2 w; w.x = cvt_pk_bf16(acc[4 * q], acc[4 * q + 1]); w.y = cvt_pk_bf16(acc[4 * q + 2], acc[4 * q + 3]); *(u32x2*)(dst + 8 * q) = w; }
            } else if (wave == 4) { if (dvh == 0) MN[((size_t)seq * 36 + p) * 64 + lane] = nst; }
            else if (wave == 7) {
                const float a = ga[p * 64 + lane]; const float bj = dir ? wave_incl_suffix(a, lane) : wave_incl_prefix(a, lane);
                const float tot = __shfl(bj, dir ? 0 : 63);
                wv[lane] = __expf(tot - bj + gi[p * 64 + lane]); if (lane == 0) dec[0] = __expf(tot);
            }
            __syncthreads();
            { float kk[8]; unpack8(kreg, kk); const float w = wv[srow];
#pragma unroll
              for (int j = 0; j < 8; ++j) kk[j] *= w;
              *(LAS u32x4*)(Kw + srow * 144 + spc * 16) = pack8(kk); *(LAS u32x4*)(Vs + srow * 144 + spc * 16) = vreg; }
            if (p + 1 < 36) { const int r0 = chunk_row0(p + 1, b, dir);
                kreg = *(const u32x4*)(PC + (size_t)(r0 + srow) * 1024 + 512 + h * 64 + 8 * spc);
                vreg = *(const u32x4*)(P + (size_t)(r0 + srow) * PLD + 1024 + h * 128 + dvh * 64 + 8 * spc); }
            const float d = dec[0];
            __syncthreads();
            if (wave < 4) {
#pragma unroll
                for (int i = 0; i < 16; ++i) acc[i] *= d;
#pragma unroll
                for (int kk = 0; kk < 4; ++kk) acc = MFMA32(tr_frag(Kw, 144, 16 * kk, 32 * dt, lane), tr_frag(Vs, 144, 16 * kk, 32 * vt, lane), acc);
            } else if (wave == 4) {
                float s = 0.f;
                for (int r = 0; r < 64; ++r) s += bf2f(*(const LAS bf16*)(Kw + r * 144 + lane * 2));
                nst = d * nst + s;
            }
        }
    }
}

DI void phase_mlstm_out(const Ctx& c, const float* ng) {
    const bf16* P = WSP(bf16, WS_P); const bf16* PC = WSP(bf16, WS_BIG + BIG_PC); const float* EX = WSP(float, WS_EXTRA);
    const bf16* MCT = WSP(bf16, WS_BIG + BIG_MCT); const float* MN = WSP(float, WS_BIG + BIG_MN); bf16* Y = WSP(bf16, WS_Y);
    LAS unsigned char* Qs = c.lds; LAS unsigned char* Ks = Qs + 9216; LAS unsigned char* Vs = Ks + 9216;
    LAS unsigned char* CT0 = Vs + 17408;
    LAS float* gt = (LAS float*)(c.lds + MISC_OFF + 1024);
    LAS float* YO = (LAS float*)c.lds;
    const int lane = c.lane, wave = c.wave, h5 = lane >> 5, l31 = lane & 31;
    const int dir = wave >> 2, jt = (wave >> 1) & 1, vh = wave & 1;
    for (int item = blockIdx.x; item < 2304; item += gridDim.x) {
        const int b = item / 288, h = (item / 36) & 7, cc = item % 36;
        const int r0 = cc < 4 ? b * CTX + 64 * cc : TC + b * SEQ + 64 * (cc - 4);
        const int pf = cc, pb = cc < 4 ? 3 - cc : 39 - cc;
        __syncthreads();
        { const int srow = c.tid >> 3, spc = c.tid & 7;
          *(LAS u32x4*)(Qs + srow * 144 + spc * 16) = *(const u32x4*)(PC + (size_t)(r0 + srow) * 1024 + h * 64 + 8 * spc);
          *(LAS u32x4*)(Ks + srow * 144 + spc * 16) = *(const u32x4*)(PC + (size_t)(r0 + srow) * 1024 + 512 + h * 64 + 8 * spc);
#pragma unroll
          for (int i = 0; i < 2; ++i) *(LAS u32x4*)(Vs + srow * 272 + (spc + 8 * i) * 16) = *(const u32x4*)(P + (size_t)(r0 + srow) * PLD + 1024 + h * 128 + 8 * (spc + 8 * i));
#pragma unroll
          for (int i = 0; i < 4; ++i) { const int pc = c.tid + 512 * i, d2 = pc >> 10, rr = (pc >> 3) & 127, sp = pc & 7;
              const size_t so = (((size_t)((b * 8 + h) * 2 + d2)) * 36 + (d2 ? pb : pf)) * 8192;
              *(LAS u32x4*)(CT0 + d2 * 18432 + rr * 144 + sp * 16) = *(const u32x4*)(MCT + so + rr * 64 + 8 * sp); }
          if (wave < 2) { const int d2 = wave; const int row = r0 + lane;
              const float a = logsigf_(EX[(size_t)row * 32 + d2 * 16 + 8 + h]), ig = EX[(size_t)row * 32 + d2 * 16 + h];
              const float bj = d2 ? wave_incl_suffix(a, lane) : wave_incl_prefix(a, lane);
              gt[d2 * 192 + lane] = bj; gt[d2 * 192 + 64 + lane] = ig - bj;
              gt[d2 * 192 + 128 + lane] = MN[(((size_t)((b * 8 + h) * 2 + d2)) * 36 + (d2 ? pb : pf)) * 64 + lane]; } }
        __syncthreads();
        const LAS float* g = gt + dir * 192; const LAS unsigned char* CT = CT0 + dir * 18432;
        const int j = 32 * jt + l31; const float bjj = g[j];
        bf16x8 qf[4];
#pragma unroll
        for (int kk = 0; kk < 4; ++kk) qf[kk] = row_frag(Qs, 144, 32 * jt, 16 * kk, lane);
        float qn = 0.f;
#pragma unroll
        for (int kk = 0; kk < 4; ++kk) { float qv[8]; unpack8(__builtin_bit_cast(u32x4, qf[kk]), qv);
#pragma unroll
            for (int e = 0; e < 8; ++e) qn += qv[e] * g[128 + 16 * kk + 8 * h5 + e]; }
        qn += __shfl_xor(qn, 32);
        f32x16 X[2]; float den = 0.f;
#pragma unroll
        for (int st = 0; st < 2; ++st) {
            X[st] = zero16();
            const bool live = dir ? (st >= jt) : (st <= jt);
            if (live) {
#pragma unroll
                for (int kk = 0; kk < 4; ++kk) X[st] = MFMA32(row_frag(Ks, 144, 32 * st, 16 * kk, lane), qf[kk], X[st]);
#pragma unroll
                for (int r = 0; r < 16; ++r) { const int s = 32 * st + crow(r, h5); const bool ok = dir ? (s >= j) : (s <= j);
                    const float w = ok ? __expf(bjj + g[64 + s]) : 0.f; X[st][r] *= w; den += X[st][r]; }
            }
        }
        den += __shfl_xor(den, 32);
        const float eb = __expf(bjj); den += eb * qn;
        const float scale = 1.0f / fmaxf(fabsf(den), 1.0f);
        f32x16 O[2];
#pragma unroll
        for (int t = 0; t < 2; ++t) {
            const int vt = 2 * vh + t; f32x16 z = zero16(), w = zero16();
#pragma unroll
            for (int st = 0; st < 2; ++st) { const bool live = dir ? (st >= jt) : (st <= jt);
                if (live) {
#pragma unroll
                    for (int step = 0; step < 2; ++step) z = MFMA32(tr_frag_perm(Vs, 272, 32 * st + 16 * step, 32 * vt, lane), pack_acc(X[st], step), z); } }
#pragma unroll
            for (int kk = 0; kk < 4; ++kk) w = MFMA32(row_frag(CT, 144, 32 * vt, 16 * kk, lane), qf[kk], w);
#pragma unroll
            for (int r = 0; r < 16; ++r) O[t][r] = (z[r] + eb * w[r]) * scale;
        }
        __syncthreads();
#pragma unroll
        for (int t = 0; t < 2; ++t) { const int vt = 2 * vh + t;
#pragma unroll
            for (int q = 0; q < 4; ++q) *(LAS f32x4*)(YO + dir * 8448 + j * 132 + 32 * vt + 8 * q + 4 * h5) = (f32x4){O[t][4 * q], O[t][4 * q + 1], O[t][4 * q + 2], O[t][4 * q + 3]}; }
        __syncthreads();
        { const int row = c.tid >> 3, c0 = (c.tid & 7) * 16; float y[16]; float ss = 0.f;
#pragma unroll
          for (int q = 0; q < 4; ++q) { const f32x4 a = *(const LAS f32x4*)(YO + row * 132 + c0 + 4 * q), bb = *(const LAS f32x4*)(YO + 8448 + row * 132 + c0 + 4 * q);
              y[4 * q] = a.x + bb.x; y[4 * q + 1] = a.y + bb.y; y[4 * q + 2] = a.z + bb.z; y[4 * q + 3] = a.w + bb.w; }
#pragma unroll
          for (int q = 0; q < 16; ++q) ss += y[q] * y[q];
          ss += __shfl_xor(ss, 1); ss += __shfl_xor(ss, 2); ss += __shfl_xor(ss, 4);
          const float r = 1.0f / sqrtf(ss * (1.0f / 128.0f) + EPS);
          float g0[8], g1[8];
          unpack8(*(const u32x4*)(P + (size_t)(r0 + row) * PLD + 2048 + h * 128 + c0), g0); unpack8(*(const u32x4*)(P + (size_t)(r0 + row) * PLD + 2048 + h * 128 + c0 + 8), g1);
          float o0[8], o1[8];
#pragma unroll
          for (int q = 0; q < 8; ++q) { o0[q] = y[q] * r * ng[h * 128 + c0 + q] * sigmoidf_(g0[q]); o1[q] = y[8 + q] * r * ng[h * 128 + c0 + 8 + q] * sigmoidf_(g1[q]); }
          *(u32x4*)(Y + (size_t)(r0 + row) * D + h * 128 + c0) = pack8(o0); *(u32x4*)(Y + (size_t)(r0 + row) * D + h * 128 + c0 + 8) = pack8(o1); }
    }
}

DI void phase_gla_decay(const Ctx& c) {
    const float* EX = WSP(float, WS_EXTRA); float* GB = WSP(float, WS_BIG + BIG_GB);
    LAS float* w2s = (LAS float*)c.lds; LAS float* gbs = w2s + 2048; LAS float* lgs = gbs + 128; LAS float* segs = lgs + 8192;
    const int srow = c.tid >> 3, dg = c.tid & 7;
    for (int item = blockIdx.x; item < 288 * 8; item += gridDim.x) {
        const int ck = item >> 3, dir = (item >> 2) & 1, h = item & 3, r0 = 64 * ck;
        __syncthreads();
        for (int i = c.tid; i < 2048; i += 512) w2s[i] = c.in[I_GLW2][(size_t)dir * 8192 + (i >> 7) * 512 + h * 128 + (i & 127)];
        if (c.tid < 128) gbs[c.tid] = c.in[I_GLGB][dir * 512 + h * 128 + c.tid];
        f32x4 low[4];
#pragma unroll
        for (int q = 0; q < 4; ++q) low[q] = *(const f32x4*)(EX + (size_t)(r0 + srow) * 32 + dir * 16 + 4 * q);
        __syncthreads();
        { const int d0 = 16 * dg; float pre[16];
#pragma unroll
          for (int e = 0; e < 16; ++e) pre[e] = gbs[d0 + e];
#pragma unroll
          for (int r = 0; r < 16; ++r) { const float lv = low[r >> 2][r & 3];
#pragma unroll
              for (int q = 0; q < 4; ++q) { const f32x4 w = *(const LAS f32x4*)(w2s + r * 128 + d0 + 4 * q); pre[4 * q] += lv * w.x; pre[4 * q + 1] += lv * w.y; pre[4 * q + 2] += lv * w.z; pre[4 * q + 3] += lv * w.w; } }
#pragma unroll
          for (int q = 0; q < 4; ++q) *(LAS f32x4*)(lgs + srow * 128 + d0 + 4 * q) = (f32x4){logsigf_(pre[4 * q]) * 0.0625f, logsigf_(pre[4 * q + 1]) * 0.0625f, logsigf_(pre[4 * q + 2]) * 0.0625f, logsigf_(pre[4 * q + 3]) * 0.0625f}; }
        __syncthreads();
        { const int d = c.tid & 127, sg = c.tid >> 7; float v[16];
#pragma unroll
          for (int i = 0; i < 16; ++i) { const int s = dir ? 63 - (16 * sg + i) : 16 * sg + i; v[i] = lgs[s * 128 + d]; }
#pragma unroll
          for (int i = 1; i < 16; ++i) v[i] += v[i - 1];
          segs[sg * 128 + d] = v[15];
          __syncthreads();
          float off = 0.f;
#pragma unroll
          for (int g2 = 0; g2 < 3; ++g2) off += (g2 < sg) ? segs[g2 * 128 + d] : 0.f;
#pragma unroll
          for (int i = 0; i < 16; ++i) { const int s = dir ? 63 - (16 * sg + i) : 16 * sg + i; GB[((size_t)dir * TT + r0 + s) * 512 + h * 128 + d] = v[i] + off; } }
    }
}
DI void phase_gla_state(const Ctx& c) {
    const bf16* PC = WSP(bf16, WS_BIG + BIG_PC); const float* GB = WSP(float, WS_BIG + BIG_GB); bf16* GST = WSP(bf16, WS_BIG + BIG_GST);
    LAS float* tot = (LAS float*)c.lds;
    LAS unsigned char* Kd = c.lds + 1024; LAS unsigned char* Vs = Kd + 64 * 272;
    const int lane = c.lane, wave = c.wave, h5 = lane >> 5, l31 = lane & 31, dkt = wave & 3, dvt = wave >> 2;
    const int srow = c.tid >> 3, dg = c.tid & 7;
    for (int item = blockIdx.x; item < 256; item += gridDim.x) {
        const int b = item >> 5, h = (item >> 3) & 3, dir = (item >> 2) & 1, dvq = item & 3, seq = (b * 4 + h) * 2 + dir;
        f32x16 acc = zero16();
        u32x4 kreg[2], vreg; f32x4 bv[4], tv[4];
#define GLA_PREFETCH(p_) do { const int r0_ = chunk_row0((p_), b, dir), row = r0_ + srow; \
          kreg[0] = *(const u32x4*)(PC + (size_t)row * 2048 + 512 + h * 128 + 16 * dg); kreg[1] = *(const u32x4*)(PC + (size_t)row * 2048 + 512 + h * 128 + 16 * dg + 8); \
          vreg = *(const u32x4*)(PC + (size_t)row * 2048 + 1024 + h * 256 + dvq * 64 + 8 * dg); \
          _Pragma("unroll") for (int q = 0; q < 4; ++q) { bv[q] = *(const f32x4*)(GB + ((size_t)dir * TT + row) * 512 + h * 128 + 16 * dg + 4 * q); \
              tv[q] = *(const f32x4*)(GB + ((size_t)dir * TT + r0_ + (dir ? 0 : 63)) * 512 + h * 128 + 16 * dg + 4 * q); } } while (0)
        GLA_PREFETCH(0);
        for (int p = 0; p < 36; ++p) {
            { bf16* dst = GST + ((size_t)seq * 36 + p) * 32768 + (size_t)(dvq * 64 + 32 * dvt + l31) * 128 + 32 * dkt + 4 * h5;
#pragma unroll
              for (int q = 0; q < 4; ++q) { u32x2 w; w.x = cvt_pk_bf16(acc[4 * q], acc[4 * q + 1]); w.y = cvt_pk_bf16(acc[4 * q + 2], acc[4 * q + 3]); *(u32x2*)(dst + 8 * q) = w; } }
            __syncthreads();
            { float kk[16]; { float t8[8]; unpack8(kreg[0], t8);
#pragma unroll
                for (int e = 0; e < 8; ++e) kk[e] = t8[e]; unpack8(kreg[1], t8);
#pragma unroll
                for (int e = 0; e < 8; ++e) kk[8 + e] = t8[e]; }
#pragma unroll
              for (int e = 0; e < 16; ++e) kk[e] *= __expf(tv[e >> 2][e & 3] - bv[e >> 2][e & 3]);
              const float k0[8] = {kk[0], kk[1], kk[2], kk[3], kk[4], kk[5], kk[6], kk[7]}, k1[8] = {kk[8], kk[9], kk[10], kk[11], kk[12], kk[13], kk[14], kk[15]};
              *(LAS u32x4*)(Kd + srow * 272 + dg * 32) = pack8(k0); *(LAS u32x4*)(Kd + srow * 272 + dg * 32 + 16) = pack8(k1);
              *(LAS u32x4*)(Vs + srow * 144 + dg * 16) = vreg;
              if (srow == 0) {
#pragma unroll
                  for (int q = 0; q < 4; ++q) *(LAS f32x4*)(tot + 16 * dg + 4 * q) = tv[q]; } }
            if (p + 1 < 36) GLA_PREFETCH(p + 1);
            __syncthreads();
#pragma unroll
            for (int r = 0; r < 16; ++r) acc[r] *= __expf(tot[32 * dkt + crow(r, h5)]);
#pragma unroll
            for (int kk = 0; kk < 4; ++kk) acc = MFMA32(tr_frag(Kd, 272, 16 * kk, 32 * dkt, lane), tr_frag(Vs, 144, 16 * kk, 32 * dvt, lane), acc);
        }
#undef GLA_PREFETCH
    }
}
DI void phase_gla_out(const Ctx& c, const float* ng) {
    const bf16* P = WSP(bf16, WS_P); const bf16* PC = WSP(bf16, WS_BIG + BIG_PC); const float* GB = WSP(float, WS_BIG + BIG_GB);
    const bf16* GST = WSP(bf16, WS_BIG + BIG_GST); bf16* Y = WSP(bf16, WS_Y);
    LAS unsigned char* Qt = c.lds; LAS unsigned char* Kt = Qt + 17408; LAS unsigned char* Vs = Kt + 17408; LAS unsigned char* STs = Vs + 33792;
    LAS float* YO = (LAS float*)STs;
    const int lane = c.lane, wave = c.wave, h5 = lane >> 5, l31 = lane & 31;
    const int srow = c.tid >> 3, dg = c.tid & 7;
    for (int item = blockIdx.x; item < 1152; item += gridDim.x) {
        const int b = item / 144, h = (item / 36) & 3, cc = item % 36;
        const int r0 = cc < 4 ? b * CTX + 64 * cc : TC + b * SEQ + 64 * (cc - 4);
        __syncthreads();
#pragma unroll
        for (int i = 0; i < 4; ++i) { const int pc = dg + 8 * i; *(LAS u32x4*)(Vs + srow * 528 + pc * 16) = *(const u32x4*)(PC + (size_t)(r0 + srow) * 2048 + 1024 + h * 256 + 8 * pc); }
        f32x16 O[2]; O[0] = zero16(); O[1] = zero16();
        for (int dir = 0; dir < 2; ++dir) {
            const int pslot = dir ? (cc < 4 ? 3 - cc : 39 - cc) : cc;
            if (dir) __syncthreads();
            { const bf16* src = GST + ((size_t)((b * 4 + h) * 2 + dir) * 36 + pslot) * 32768;
#pragma unroll
              for (int i = 0; i < 8; ++i) { const int pc = c.tid + 512 * i, rr = pc >> 4, sp = pc & 15; *(LAS u32x4*)(STs + rr * 272 + sp * 16) = *(const u32x4*)(src + rr * 128 + 8 * sp); } }
            { float qq[16], kk[16], bb[16]; float t8[8];
#pragma unroll
              for (int q = 0; q < 4; ++q) { const f32x4 t4 = *(const f32x4*)(GB + ((size_t)dir * TT + r0 + srow) * 512 + h * 128 + 16 * dg + 4 * q); bb[4 * q] = t4.x; bb[4 * q + 1] = t4.y; bb[4 * q + 2] = t4.z; bb[4 * q + 3] = t4.w; }
              unpack8(*(const u32x4*)(PC + (size_t)(r0 + srow) * 2048 + h * 128 + 16 * dg), t8);
#pragma unroll
              for (int e = 0; e < 8; ++e) qq[e] = t8[e];
              unpack8(*(const u32x4*)(PC + (size_t)(r0 + srow) * 2048 + h * 128 + 16 * dg + 8), t8);
#pragma unroll
              for (int e = 0; e < 8; ++e) qq[8 + e] = t8[e];
              unpack8(*(const u32x4*)(PC + (size_t)(r0 + srow) * 2048 + 512 + h * 128 + 16 * dg), t8);
#pragma unroll
              for (int e = 0; e < 8; ++e) kk[e] = t8[e];
              unpack8(*(const u32x4*)(PC + (size_t)(r0 + srow) * 2048 + 512 + h * 128 + 16 * dg + 8), t8);
#pragma unroll
              for (int e = 0; e < 8; ++e) kk[8 + e] = t8[e];
#pragma unroll
              for (int e = 0; e < 16; ++e) { const float eb = __expf(bb[e]); qq[e] *= eb; kk[e] *= 1.0f / eb; }
              const float q0[8] = {qq[0], qq[1], qq[2], qq[3], qq[4], qq[5], qq[6], qq[7]}, q1[8] = {qq[8], qq[9], qq[10], qq[11], qq[12], qq[13], qq[14], qq[15]};
              const float k0[8] = {kk[0], kk[1], kk[2], kk[3], kk[4], kk[5], kk[6], kk[7]}, k1[8] = {kk[8], kk[9], kk[10], kk[11], kk[12], kk[13], kk[14], kk[15]};
              *(LAS u32x4*)(Qt + srow * 272 + dg * 32) = pack8(q0); *(LAS u32x4*)(Qt + srow * 272 + dg * 32 + 16) = pack8(q1);
              *(LAS u32x4*)(Kt + srow * 272 + dg * 32) = pack8(k0); *(LAS u32x4*)(Kt + srow * 272 + dg * 32 + 16) = pack8(k1); }
            __syncthreads();
#pragma unroll
            for (int jt = 0; jt < 2; ++jt) {
#pragma unroll
                for (int st = 0; st < 2; ++st) {
                    const bool live = dir ? (st >= jt) : (st <= jt);
                    if (live) {
                        f32x16 X = zero16();
#pragma unroll
                        for (int kk = 0; kk < 8; ++kk) X = MFMA32(row_frag(Kt, 272, 32 * st, 16 * kk, lane), row_frag(Qt, 272, 32 * jt, 16 * kk, lane), X);
                        if (st == jt) {
#pragma unroll
                            for (int r = 0; r < 16; ++r) { const int s = crow(r, h5); const bool ok = dir ? (s >= l31) : (s <= l31); X[r] = ok ? X[r] : 0.f; } }
#pragma unroll
                        for (int step = 0; step < 2; ++step) O[jt] = MFMA32(tr_frag_perm(Vs, 528, 32 * st + 16 * step, 32 * wave, lane), pack_acc(X, step), O[jt]);
                    }
                }
#pragma unroll
                for (int kk = 0; kk < 8; ++kk) O[jt] = MFMA32(row_frag(STs, 272, 32 * wave, 16 * kk, lane), row_frag(Qt, 272, 32 * jt, 16 * kk, lane), O[jt]);
            }
        }
        __syncthreads();
#pragma unroll
        for (int jt = 0; jt < 2; ++jt)
#pragma unroll
            for (int q = 0; q < 4; ++q) *(LAS f32x4*)(YO + (32 * jt + l31) * 260 + 32 * wave + 8 * q + 4 * h5) = (f32x4){O[jt][4 * q], O[jt][4 * q + 1], O[jt][4 * q + 2], O[jt][4 * q + 3]};
        __syncthreads();
        { const int c0 = dg * 32; float y[32]; float ss = 0.f;
#pragma unroll
          for (int q = 0; q < 8; ++q) { const f32x4 a = *(const LAS f32x4*)(YO + srow * 260 + c0 + 4 * q); y[4 * q] = a.x; y[4 * q + 1] = a.y; y[4 * q + 2] = a.z; y[4 * q + 3] = a.w; }
#pragma unroll
          for (int q = 0; q < 32; ++q) ss += y[q] * y[q];
          ss += __shfl_xor(ss, 1); ss += __shfl_xor(ss, 2); ss += __shfl_xor(ss, 4);
          const float r = 1.0f / sqrtf(ss * (1.0f / 256.0f) + EPS);
#pragma unroll
          for (int q = 0; q < 4; ++q) { float g8[8], o8[8]; unpack8(*(const u32x4*)(P + (size_t)(r0 + srow) * PLD + 2048 + h * 256 + c0 + 8 * q), g8);
#pragma unroll
              for (int e = 0; e < 8; ++e) o8[e] = y[8 * q + e] * r * ng[h * 256 + c0 + 8 * q + e] * siluf_(g8[e]);
              *(u32x4*)(Y + (size_t)(r0 + srow) * D + h * 256 + c0 + 8 * q) = pack8(o8); } }
    }
}

DI void phase_gla_scan_naive(const Ctx& c) {
    const bf16* PC = WSP(bf16, WS_BIG + BIG_PC); const float* EX = WSP(float, WS_EXTRA);
    LAS float* qs = (LAS float*)c.lds; LAS float* ks = qs + 16 * 128; LAS float* as = ks + 16 * 128; LAS float* vs = as + 16 * 128; LAS float* lw = vs + 16 * 256;
    const int v = c.tid >> 1, d0 = (c.tid & 1) * 64;
    for (int item = blockIdx.x; item < 64; item += gridDim.x) {
        const int b = item >> 3, h = (item >> 1) & 3, dir = item & 1;
        float* Yo = WSP(float, WS_BIG + (dir ? BIG_YB : BIG_YF));
        const float* w2 = c.in[I_GLW2] + (size_t)dir * 16 * 512 + h * 128; const float* gb = c.in[I_GLGB] + dir * 512 + h * 128;
        float S[64];
#pragma unroll
        for (int d = 0; d < 64; ++d) S[d] = 0.f;
        for (int ch = 0; ch < (CTX + SEQ) / 16; ++ch) {
            __syncthreads();
            if (c.tid < 256) { const int st = c.tid >> 4, r = c.tid & 15, row = scan_row(ch * 16 + st, b, dir); lw[c.tid] = EX[(size_t)row * 32 + dir * 16 + r]; }
            for (int idx = c.tid; idx < 16 * 512; idx += 512) { const int st = idx >> 9, col = idx & 511, row = scan_row(ch * 16 + st, b, dir);
                if (col < 128) qs[st * 128 + col] = bf2f(PC[(size_t)row * 2048 + h * 128 + col]);
                else if (col < 256) ks[st * 128 + col - 128] = bf2f(PC[(size_t)row * 2048 + 512 + h * 128 + col - 128]);
                else vs[st * 256 + col - 256] = bf2f(PC[(size_t)row * 2048 + 1024 + h * 256 + col - 256]); }
            __syncthreads();
            for (int idx = c.tid; idx < 16 * 128; idx += 512) { const int st = idx >> 7, d = idx & 127; float pre = gb[d];
#pragma unroll
                for (int r = 0; r < 16; ++r) pre += lw[st * 16 + r] * w2[r * 512 + d];
                as[idx] = __expf(logsigf_(pre) * (1.0f / 16.0f)); }
            __syncthreads();
            for (int st = 0; st < 16; ++st) {
                const float vv = vs[st * 256 + v]; float part = 0.f;
#pragma unroll
                for (int d = 0; d < 64; ++d) { S[d] = as[st * 128 + d0 + d] * S[d] + ks[st * 128 + d0 + d] * vv; part += qs[st * 128 + d0 + d] * S[d]; }
                part += __shfl_xor(part, 1);
                if ((c.tid & 1) == 0) { const int row = scan_row(ch * 16 + st, b, dir); Yo[(size_t)row * D + h * 256 + v] = part; }
            }
        }
    }
}
DI void phase_headnorm(const Ctx& c, int hd, const float* ng) {
    const float* YF = WSP(float, WS_BIG + BIG_YF); const float* YB = WSP(float, WS_BIG + BIG_YB); const bf16* P = WSP(bf16, WS_P); bf16* Y = WSP(bf16, WS_Y);
    for (int row = c.gw; row < TT; row += c.ngw) {
        const int c0 = 16 * c.lane; float y[16]; float ss = 0.f;
#pragma unroll
        for (int j = 0; j < 4; ++j) { const f32x4 a = *(const f32x4*)(YF + (size_t)row * D + c0 + 4 * j), bb = *(const f32x4*)(YB + (size_t)row * D + c0 + 4 * j);
            y[4 * j] = a.x + bb.x; y[4 * j + 1] = a.y + bb.y; y[4 * j + 2] = a.z + bb.z; y[4 * j + 3] = a.w + bb.w; }
#pragma unroll
        for (int j = 0; j < 16; ++j) ss += y[j] * y[j];
        ss += __shfl_xor(ss, 1); ss += __shfl_xor(ss, 2); ss += __shfl_xor(ss, 4); if (hd == 256) ss += __shfl_xor(ss, 8);
        const float r = 1.0f / sqrtf(ss / (float)hd + EPS);
        float g0[8], g1[8];
        unpack8(*(const u32x4*)(P + (size_t)row * PLD + 2048 + c0), g0); unpack8(*(const u32x4*)(P + (size_t)row * PLD + 2048 + c0 + 8), g1);
        float o[16];
#pragma unroll
        for (int j = 0; j < 16; ++j) { const float gp = j < 8 ? g0[j] : g1[j - 8]; o[j] = y[j] * r * ng[c0 + j] * (hd == 128 ? sigmoidf_(gp) : siluf_(gp)); }
        const float o0[8] = {o[0], o[1], o[2], o[3], o[4], o[5], o[6], o[7]}, o1[8] = {o[8], o[9], o[10], o[11], o[12], o[13], o[14], o[15]};
        *(u32x4*)(Y + (size_t)row * D + c0) = pack8(o0); *(u32x4*)(Y + (size_t)row * D + c0 + 8) = pack8(o1);
    }
}
DI void phase_hyena_conv_naive(const Ctx& c) {
    const bf16* PC = WSP(bf16, WS_BIG + BIG_PC); bf16* Y = WSP(bf16, WS_Y); const float* skip = c.in[I_HYSKIP];
    LAS float* zt = (LAS float*)c.lds;
    LAS float* ft = zt + 4096;
    const int cc = c.tid & 63, tg = c.tid >> 6;
    for (int item = blockIdx.x; item < 4096 + 512; item += gridDim.x) {
        int L, rb, tt, cgi; const float* tab;
        if (item < 4096) { L = SEQ; const int b = item >> 9; tt = (item >> 4) & 31; cgi = item & 15; rb = TC + b * SEQ; tab = WSP(float, WS_HF); }
        else { const int it = item - 4096; L = CTX; const int b = it >> 6; tt = (it >> 4) & 3; cgi = it & 15; rb = b * CTX; tab = WSP(float, WS_HFC); }
        const int t0 = 64 * tt, c0 = 64 * cgi;
        float acc[8];
#pragma unroll
        for (int i = 0; i < 8; ++i) acc[i] = 0.f;
        for (int sb = 0; sb < L / 64; ++sb) {
            const int s0 = 64 * sb;
            __syncthreads();
            for (int idx = c.tid; idx < 4096; idx += 512) { const int sl = idx >> 6, ch = idx & 63; const size_t o = (size_t)(rb + s0 + sl) * PLD + c0 + ch;
                zt[idx] = bf2f(PC[o + 1024]) * bf2f(PC[o + 2048]); }
            for (int idx = c.tid; idx < 64 * 128; idx += 512) { const int ch = idx >> 7, j = idx & 127;
                if (j < 127) ft[j * 65 + ch] = tab[(size_t)(c0 + ch) * (2 * L) + L + (t0 - s0 - 63 + j)]; }
            __syncthreads();
#pragma unroll 1
            for (int g = 0; g < 8; ++g) {
                float w[15], z[8]; const int base = 8 * (tg - g) + 56;
#pragma unroll
                for (int m = 0; m < 15; ++m) w[m] = ft[(base + m) * 65 + cc];
#pragma unroll
                for (int j = 0; j < 8; ++j) z[j] = zt[(8 * g + j) * 64 + cc];
#pragma unroll
                for (int i = 0; i < 8; ++i)
#pragma unroll
                    for (int j = 0; j < 8; ++j) acc[i] += w[i - j + 7] * z[j];
            }
        }
#pragma unroll
        for (int i = 0; i < 8; ++i) { const int row = rb + t0 + 8 * tg + i; const size_t o = (size_t)row * PLD + c0 + cc;
            const float zin = bf2f(PC[o + 1024]) * bf2f(PC[o + 2048]), x0 = bf2f(PC[o]);
            Y[(size_t)row * D + c0 + cc] = f2bf(x0 * (acc[i] + skip[c0 + cc] * zin)); }
    }
}

DI void hy_item(int item, int& L, int& b, int& t0, int& c0, int& rb) {
    if (item < 4096) { L = SEQ; b = item >> 9; t0 = 64 * ((item >> 4) & 31); c0 = 64 * (item & 15); rb = TC + b * SEQ; }
    else { const int it = item - 4096; L = CTX; b = it >> 6; t0 = 64 * ((it >> 4) & 3); c0 = 64 * (it & 15); rb = b * CTX; }
}
DI void phase_hy_prep(const Ctx& c) {
    const bf16* P = WSP(bf16, WS_P); bf16* X0C = WSP(bf16, WS_BIG + BIG_PC); const float* cw = c.in[I_HYCW]; const float* cb = c.in[I_HYCB];
    LAS unsigned char* raw = c.lds;
    LAS float* zt = (LAS float*)(c.lds + 32768);
    for (int item = blockIdx.x; item < 4608; item += gridDim.x) {
        int L, b, t0, c0, rb; hy_item(item, L, b, t0, c0, rb);
        bf16* ZT = L == SEQ ? WSP(bf16, WS_BIG + BIG_ZTL) : WSP(bf16, WS_BIG + BIG_ZTC);
        __syncthreads();
        for (int pc = c.tid; pc < 3 * 66 * 8; pc += 512) { const int g = pc / 528, rr = (pc % 528) >> 3, sp = pc & 7, t = t0 - 1 + rr;
            u32x4 v = {c.z, c.z, c.z, c.z};
            if (t >= 0 && t < L) v = *(const u32x4*)(P + (size_t)(rb + t) * PLD + g * 1024 + c0 + 8 * sp);
            *(LAS u32x4*)(raw + (g * 66 + rr) * 128 + sp * 16) = v; }
        __syncthreads();
        { const int t = c.tid >> 3, sp = c.tid & 7; float u[3][8];
#pragma unroll
          for (int g = 0; g < 3; ++g) { float xm[8], x0[8], xp[8];
              unpack8(*(const LAS u32x4*)(raw + (g * 66 + t) * 128 + sp * 16), xm); unpack8(*(const LAS u32x4*)(raw + (g * 66 + t + 1) * 128 + sp * 16), x0); unpack8(*(const LAS u32x4*)(raw + (g * 66 + t + 2) * 128 + sp * 16), xp);
              const int col = g * 1024 + c0 + 8 * sp;
#pragma unroll
              for (int e = 0; e < 8; ++e) u[g][e] = cw[col + e] * xm[e] + cw[3072 + col + e] * x0[e] + cw[6144 + col + e] * xp[e] + cb[col + e]; }
          *(u32x4*)(X0C + (size_t)(rb + t0 + t) * 1024 + c0 + 8 * sp) = pack8(u[0]);
#pragma unroll
          for (int e = 0; e < 8; ++e) zt[t * 65 + 8 * sp + e] = u[1][e] * u[2][e]; }
        __syncthreads();
        { const int ch = c.tid >> 3, tp = c.tid & 7; float z[8];
#pragma unroll
          for (int e = 0; e < 8; ++e) z[e] = zt[(8 * tp + e) * 65 + ch];
          *(u32x4*)(ZT + ((size_t)(c0 + ch) * NB + b) * L + t0 + 8 * tp) = pack8(z); }
    }
}
template <int L>
DI void hy_toeplitz_channel(const Ctx& c, const float* hrow  , const bf16* zsrc  , bf16* ydst  ) {
    constexpr int NBK = L / 32, CP = 2 * L + 8, NT = (NBK + 31) / 32;
    LAS unsigned char* F = c.lds;
    LAS unsigned char* Zs = c.lds + 8 * CP * 2;
    const int lane = c.lane, w = c.wave, h5 = lane >> 5, a = lane & 31;
    __syncthreads();
    for (int idx = c.tid; idx < 8 * 2 * L; idx += 512) { const int r = idx / (2 * L), m = idx % (2 * L), y = m + r;
        const float v = (y >= 1 && y <= 2 * L - 1) ? hrow[2 * L - y] : 0.f;
        *(LAS bf16*)(F + (r * CP + m) * 2) = f2bf(v); }
    if (c.tid < 20) *(LAS unsigned*)(Zs + 8 * NBK * 80 + 4 * c.tid) = c.z;
    for (int pc = c.tid; pc < 8 * L / 8; pc += 512) { const int bb = pc / (L / 8), pi = pc % (L / 8);
        *(LAS u32x4*)(Zs + (bb * NBK + (pi >> 2)) * 80 + (pi & 3) * 16) = *(const u32x4*)(zsrc + (size_t)bb * L + 8 * pi); }
    __syncthreads();
    const int r = (-a) & 7;
    f32x16 acc[NT];
#pragma unroll
    for (int q = 0; q < NT; ++q) acc[q] = zero16();
    for (int d = -(NBK - 1); d <= NBK - 1; ++d) {
#pragma unroll
        for (int step = 0; step < 2; ++step) {
            const int y0 = L - 32 * d - a + 16 * step + 8 * h5;
            const bf16x8 A = *(const LAS bf16x8*)(F + (r * CP + (y0 - r)) * 2);
#pragma unroll
            for (int q = 0; q < NT; ++q) {
                if (d >= 32 * q - (NBK - 1) && d <= 32 * q + 31) {
                    const int src = 32 * q + a - d; const bool ok = (unsigned)src < (unsigned)NBK; const int sc = ok ? w * NBK + src : 8 * NBK;
                    const bf16x8 B = *(const LAS bf16x8*)(Zs + sc * 80 + 32 * step + 16 * h5);
                    acc[q] = MFMA32(A, B, acc[q]);
                }
            }
        }
    }
#pragma unroll
    for (int q = 0; q < NT; ++q) { const int i = 32 * q + a;
        if (i < NBK) {
#pragma unroll
            for (int qq = 0; qq < 4; ++qq) { u32x2 o; o.x = cvt_pk_bf16(acc[q][4 * qq], acc[q][4 * qq + 1]); o.y = cvt_pk_bf16(acc[q][4 * qq + 2], acc[q][4 * qq + 3]);
                *(u32x2*)(ydst + (size_t)w * L + 32 * i + 8 * qq + 4 * h5) = o; } } }
}
DI void phase_hy_toeplitz(const Ctx& c) {
    for (int ch = blockIdx.x; ch < 1024; ch += gridDim.x) {
        hy_toeplitz_channel<SEQ>(c, WSP(float, WS_HF) + (size_t)ch * 4096, WSP(bf16, WS_BIG + BIG_ZTL) + (size_t)ch * NB * SEQ, WSP(bf16, WS_BIG + BIG_YTL) + (size_t)ch * NB * SEQ);
        hy_toeplitz_channel<CTX>(c, WSP(float, WS_HFC) + (size_t)ch * 512, WSP(bf16, WS_BIG + BIG_ZTC) + (size_t)ch * NB * CTX, WSP(bf16, WS_BIG + BIG_YTC) + (size_t)ch * NB * CTX);
    }
}
DI void phase_hy_post(const Ctx& c) {
    const bf16* X0C = WSP(bf16, WS_BIG + BIG_PC); bf16* Y = WSP(bf16, WS_Y); const float* skip = c.in[I_HYSKIP];
    LAS float* tl = (LAS float*)c.lds;
    for (int item = blockIdx.x; item < 4608; item += gridDim.x) {
        int L, b, t0, c0, rb; hy_item(item, L, b, t0, c0, rb);
        const bf16* ZT = L == SEQ ? WSP(bf16, WS_BIG + BIG_ZTL) : WSP(bf16, WS_BIG + BIG_ZTC); const bf16* YT = L == SEQ ? WSP(bf16, WS_BIG + BIG_YTL) : WSP(bf16, WS_BIG + BIG_YTC);
        __syncthreads();
        { const int ch = c.tid >> 3, tp = c.tid & 7; const size_t o = ((size_t)(c0 + ch) * NB + b) * L + t0 + 8 * tp; float y[8], z[8];
          unpack8(*(const u32x4*)(YT + o), y); unpack8(*(const u32x4*)(ZT + o), z); const float sk = skip[c0 + ch];
#pragma unroll
          for (int e = 0; e < 8; ++e) tl[ch * 65 + 8 * tp + e] = y[e] + sk * z[e]; }
        __syncthreads();
        { const int t = c.tid >> 3, sp = c.tid & 7; float x0[8], o[8];
          unpack8(*(const u32x4*)(X0C + (size_t)(rb + t0 + t) * 1024 + c0 + 8 * sp), x0);
#pragma unroll
          for (int e = 0; e < 8; ++e) o[e] = x0[e] * tl[(8 * sp + e) * 65 + t];
          *(u32x4*)(Y + (size_t)(rb + t0 + t) * D + c0 + 8 * sp) = pack8(o); }
    }
}

DI void phase_route(const Ctx& c, int l) {
    LAS float* rw = (LAS float*)c.lds;
    LAS int* lcnt = (LAS int*)(c.lds + 65536);
    LAS int* rinfo = lcnt + 32;
    LAS float* rwt = (LAS float*)(rinfo + 4 * 128);
    for (int i = c.tid; i < 16 * 1024; i += 512) { const int e = i >> 10, k = i & 1023; rw[i] = c.in[I_RW][k * 16 + e]; }
    if (c.tid < 16) lcnt[c.tid] = 0;
    __syncthreads();
    const float* MOD = WSP(float, WS_MOD) + (size_t)l * 9 * 6144; const float* g = c.in[I_N2G] + l * D; bf16* H = WSP(bf16, WS_H);
    const float* X = WSP(float, WS_X); const float* XC = WSP(float, WS_XC);
    unsigned* cnt = WSP(unsigned, WS_CTL) + CW_CNT + l * 16; int* TOK = WSP(int, WS_TOK); float* TOKW = WSP(float, WS_TOK + 512 * 1024);
    float rbv[16];
#pragma unroll
    for (int e = 0; e < 16; ++e) rbv[e] = c.in[I_RB][e];
    const int rlo = (l == 3 ? TC : 0), nrow = TT - rlo, per = (nrow + (int)gridDim.x - 1) / (int)gridDim.x;
    const int brow0 = rlo + (int)blockIdx.x * per, bn = min(per, TT - brow0);
    for (int lr = c.wave; lr < bn; lr += 8) {
        const int row = brow0 + lr;
        f32x4 v[4]; const int mr = row < TC ? 8 : (row - TC) >> 11;
        load_row(row < TC ? XC + (size_t)row * D : X + (size_t)(row - TC) * D, v, c.lane);
        norm_row(v, g, c.lane); mod_row(v, MOD + mr * 6144 + 3072, MOD + mr * 6144 + 4096, c.lane);
        store_row_bf16(H + (size_t)row * D, v, c.lane);
        float sc[16];
#pragma unroll
        for (int e = 0; e < 16; ++e) { float s = 0.f;
#pragma unroll
            for (int j = 0; j < 4; ++j) { const f32x4 w = *(const LAS f32x4*)(rw + e * 1024 + 256 * j + 4 * c.lane); s += (v[j].x * w.x + v[j].y * w.y) + (v[j].z * w.z + v[j].w * w.w); }
            sc[e] = sigmoidf_(wave_sum(s)); asm volatile("" ::: "memory"); }
        int bg = 0; float bgs = -1e30f;
#pragma unroll
        for (int gq = 0; gq < 4; ++gq) { float m1 = -1e30f, m2 = -1e30f;
#pragma unroll
            for (int j = 0; j < 4; ++j) { const float s = sc[4 * gq + j] + rbv[4 * gq + j]; if (s > m1) { m2 = m1; m1 = s; } else if (s > m2) m2 = s; }
            const float gs = m1 + m2; if (gs > bgs) { bgs = gs; bg = gq; } }
        float s4[4], p4[4];
#pragma unroll
        for (int j = 0; j < 4; ++j) { s4[j] = 0.f; p4[j] = 0.f; }
#pragma unroll
        for (int gq = 0; gq < 4; ++gq)
#pragma unroll
            for (int j = 0; j < 4; ++j) if (bg == gq) { s4[j] = sc[4 * gq + j] + rbv[4 * gq + j]; p4[j] = sc[4 * gq + j]; }
        int i1 = 0; float v1 = s4[0], q1 = p4[0];
#pragma unroll
        for (int j = 1; j < 4; ++j) if (s4[j] > v1) { v1 = s4[j]; i1 = j; q1 = p4[j]; }
        int i2 = -1; float v2 = -1e30f, q2 = 0.f;
#pragma unroll
        for (int j = 0; j < 4; ++j) if (j != i1 && s4[j] > v2) { v2 = s4[j]; i2 = j; q2 = p4[j]; }
        if (c.lane == 0) {
            const int e0 = 4 * bg + i1, e1 = 4 * bg + i2;
            const int p0 = __hip_atomic_fetch_add(lcnt + e0, 1, __ATOMIC_RELAXED, __HIP_MEMORY_SCOPE_WORKGROUP), p1 = __hip_atomic_fetch_add(lcnt + e1, 1, __ATOMIC_RELAXED, __HIP_MEMORY_SCOPE_WORKGROUP);
            rinfo[lr * 4 + 0] = e0; rinfo[lr * 4 + 1] = p0; rinfo[lr * 4 + 2] = e1; rinfo[lr * 4 + 3] = p1;
            const float inv = 1.0f / (q1 + q2); rwt[lr * 2] = q1 * inv; rwt[lr * 2 + 1] = q2 * inv;
        }
    }
    __syncthreads();
    if (c.tid < 16) lcnt[16 + c.tid] = (int)atomicAdd(cnt + c.tid, (unsigned)lcnt[c.tid]);
    __syncthreads();
    for (int lr = c.tid; lr < bn; lr += 512) { const int row = brow0 + lr, e0 = rinfo[lr * 4], e1 = rinfo[lr * 4 + 2];
        TOK[row * 4 + 0] = e0; TOK[row * 4 + 1] = lcnt[16 + e0] + rinfo[lr * 4 + 1]; TOK[row * 4 + 2] = e1; TOK[row * 4 + 3] = lcnt[16 + e1] + rinfo[lr * 4 + 3];
        TOKW[row * 2] = rwt[lr * 2]; TOKW[row * 2 + 1] = rwt[lr * 2 + 1]; }
}
DI void slot_bases(const unsigned* cnt, int lane, int e0, int e1, int& b0, int& b1) {
    const unsigned mine = lane < 16 ? ((cnt[lane] + 255u) & ~255u) : 0u; unsigned pb = 0; b0 = 0; b1 = 0;
#pragma unroll
    for (int e = 0; e < 16; ++e) { const unsigned ce = __shfl(mine, e); if (e == e0) b0 = (int)pb; if (e == e1) b1 = (int)pb; pb += ce; }
}
DI void phase_gather(const Ctx& c, int l) {
    const unsigned* cnt = WSP(unsigned, WS_CTL) + CW_CNT + l * 16; const int* TOK = WSP(int, WS_TOK); int* TOKS = WSP(int, WS_TOK + 768 * 1024);
    const bf16* H = WSP(bf16, WS_H); bf16* HS = WSP(bf16, WS_BIG + BIG_HS);
    for (int row = (l == 3 ? TC : 0) + c.gw; row < TT; row += c.ngw) {
        const int e0 = TOK[row * 4], p0 = TOK[row * 4 + 1], e1 = TOK[row * 4 + 2], p1 = TOK[row * 4 + 3]; int b0, b1;
        slot_bases(cnt, c.lane, e0, e1, b0, b1);
        const int s0 = b0 + p0, s1 = b1 + p1;
        const u32x4 a = *(const u32x4*)(H + (size_t)row * D + 8 * c.lane), bq = *(const u32x4*)(H + (size_t)row * D + 512 + 8 * c.lane);
        *(u32x4*)(HS + (size_t)s0 * D + 8 * c.lane) = a; *(u32x4*)(HS + (size_t)s0 * D + 512 + 8 * c.lane) = bq;
        *(u32x4*)(HS + (size_t)s1 * D + 8 * c.lane) = a; *(u32x4*)(HS + (size_t)s1 * D + 512 + 8 * c.lane) = bq;
        if (c.lane == 0) { TOKS[row * 2] = s0; TOKS[row * 2 + 1] = s1; }
    }
}
DI LAS int* moe_tiles(const Ctx& c, int l, int nsh) {
    LAS int* tp = (LAS int*)(c.lds + MISC_OFF);
    LAS int* ul = tp + 192;
    __syncthreads();
    if (c.tid < 64) {
        const unsigned* cnt = WSP(unsigned, WS_CTL) + CW_CNT + l * 16;
        const int mine = c.lane < 16 ? (int)((cnt[c.lane] + 255u) >> 8) : 0; int p = 0;
        for (int e = 0; e < 16; ++e) { const int ne = __shfl(mine, e); for (int t = c.lane; t < ne; t += 64) tp[1 + p + t] = e; p += ne; }
        if (c.lane == 0) tp[0] = p;
    }
    __syncthreads();
    if (c.tid < 32) {
        const int i = c.tid, ntile = tp[0], G = gridDim.x, cb = blockIdx.x; int rt = 1 << 20, pn = 0;
        if ((G & 7) == 0 && ((G >> 3) >> nsh) > 0) { const int x = cb & 7, v = cb >> 3, rpx = (G >> 3) >> nsh;
            if (v < (rpx << nsh)) { rt = (i * 8 + x) * rpx + (v >> nsh); pn = v & ((1 << nsh) - 1); } }
        else { const int L = i * G + cb; rt = L >> nsh; pn = L & ((1 << nsh) - 1); }
        ul[i] = rt < ntile ? (rt | (pn << 12) | (tp[1 + rt] << 16)) : -1;
    }
    __syncthreads();
    return ul;
}
DI void phase_combine(const Ctx& c, int l) {
    const float* MOD = WSP(float, WS_MOD) + (size_t)l * 9 * 6144; const int* TOKS = WSP(int, WS_TOK + 768 * 1024); const float* TOKW = WSP(float, WS_TOK + 512 * 1024);
    const bf16* YS = WSP(bf16, WS_BIG + BIG_HS); float* X = WSP(float, WS_X); float* XC = WSP(float, WS_XC); bf16* H = WSP(bf16, WS_H);
    for (int row = (l == 3 ? TC : 0) + c.gw; row < TT; row += c.ngw) {
        const int mr = row < TC ? 8 : (row - TC) >> 11; float* xp = row < TC ? XC + (size_t)row * D : X + (size_t)(row - TC) * D;
        const int s0 = TOKS[row * 2], s1 = TOKS[row * 2 + 1]; const float w0 = TOKW[row * 2], w1 = TOKW[row * 2 + 1];
        f32x4 v[4]; load_row(xp, v, c.lane);
#pragma unroll
        for (int j = 0; j < 4; ++j) {
            const u32x2 a = *(const u32x2*)(YS + (size_t)s0 * D + 256 * j + 4 * c.lane), bq = *(const u32x2*)(YS + (size_t)s1 * D + 256 * j + 4 * c.lane);
            const f32x4 ya = {__uint_as_float(a.x << 16), __uint_as_float(a.x & 0xffff0000u), __uint_as_float(a.y << 16), __uint_as_float(a.y & 0xffff0000u)};
            const f32x4 yb = {__uint_as_float(bq.x << 16), __uint_as_float(bq.x & 0xffff0000u), __uint_as_float(bq.y << 16), __uint_as_float(bq.y & 0xffff0000u)};
            v[j] = v[j] + *(const f32x4*)(MOD + mr * 6144 + 5120 + 256 * j + 4 * c.lane) * (ya * w0 + yb * w1);
            *(f32x4*)(xp + 256 * j + 4 * c.lane) = v[j];
        }
        if (l < 3) {
            const float* MODn = WSP(float, WS_MOD) + (size_t)(l + 1) * 9 * 6144;
            norm_row(v, c.in[I_N1G] + (l + 1) * D, c.lane); mod_row(v, MODn + mr * 6144, MODn + mr * 6144 + 1024, c.lane);
            store_row_bf16(H + (size_t)hrow_of(row, (l + 1) % 3) * D, v, c.lane);
        } else {
            norm_row(v, c.in[I_FING], c.lane);
            float* o = c.out + (size_t)(row - TC) * D;
#pragma unroll
            for (int j = 0; j < 4; ++j) *(f32x4*)(o + 256 * j + 4 * c.lane) = v[j];
        }
    }
}

#define XB_TMO      128
#define XB_XCNT(j)  (256  + 64 * (j))
#define XB_XSUB(j)  (1280 + 64 * (j))
#define XB_XGEN(j)  (2304 + 64 * (j))
#define XB_TOP      3328
#define XB_TOPGEN   3392
#define XCD_BAR_WORDS 3456
#define XB_SPIN_CAP (1u << 18)
DI unsigned xb_ld(unsigned* p)              { return __hip_atomic_load(p, __ATOMIC_RELAXED, __HIP_MEMORY_SCOPE_AGENT); }
DI unsigned xb_add(unsigned* p, unsigned v) { return __hip_atomic_fetch_add(p, v, __ATOMIC_RELAXED, __HIP_MEMORY_SCOPE_AGENT); }
DI unsigned xb_xcc_id() { return (unsigned)__builtin_amdgcn_s_getreg((3 << 11) | 20) & 0xFu; }
#define XB_SPIN(cond, bar) do { unsigned _sp = 0; while (cond) { __builtin_amdgcn_s_sleep(1); \
    if ((++_sp & 255u) == 0u) { if (xb_ld(&(bar)[XB_TMO])) break; if (_sp > XB_SPIN_CAP) { atomicAdd(&(bar)[XB_TMO], 1u); break; } } } } while (0)
DI void xcd_barrier_complete(unsigned* bar, unsigned x, unsigned& nloc, unsigned& nx) {
    const unsigned G = gridDim.x * gridDim.y * gridDim.z;
    unsigned sum, cnt, mine, sp = 0u;
    for (;;) {
        sum = 0u; cnt = 0u; mine = 0u;
#pragma unroll
        for (unsigned j = 0; j < 16; ++j) { const unsigned cj = xb_ld(&bar[XB_XCNT(j)]); sum += cj; cnt += (cj > 0u) ? 1u : 0u; mine = (j == x) ? cj : mine; }
        if (sum == G) break;
        __builtin_amdgcn_s_sleep(1);
        if ((++sp & 255u) == 0u) { if (xb_ld(&bar[XB_TMO])) break; if (sp > XB_SPIN_CAP) { atomicAdd(&bar[XB_TMO], 1u); break; } }
    }
    nloc = mine > 0u ? mine : 1u; nx = cnt > 0u ? cnt : 1u;
}
DI void xcd_barrier(unsigned* bar, volatile LAS unsigned* st) {
    asm volatile("s_waitcnt vmcnt(0)" ::: "memory");
    __syncthreads();
    if (threadIdx.x == 0) {
        const unsigned x = xb_xcc_id();
        __builtin_amdgcn_s_waitcnt(0);
        unsigned nloc = st[0], nx = st[1];
        if (nloc == 0u) { xcd_barrier_complete(bar, x, nloc, nx); st[0] = nloc; st[1] = nx; }
        const unsigned old = xb_add(&bar[XB_XSUB(x)], 1u);
        const unsigned gen = old / nloc;
        if (old + 1u == (gen + 1u) * nloc) {
            __builtin_amdgcn_fence(__ATOMIC_RELEASE, "agent");
            asm volatile("s_waitcnt vmcnt(0)" ::: "memory");
            const unsigned og = xb_add(&bar[XB_TOP], 1u);
            const unsigned tg = og / nx;
            if (og + 1u == (tg + 1u) * nx) xb_add(&bar[XB_TOPGEN], 1u);
            else XB_SPIN(xb_ld(&bar[XB_TOPGEN]) == tg, bar);
            __builtin_amdgcn_fence(__ATOMIC_ACQUIRE, "agent");
            xb_add(&bar[XB_XGEN(x)], 1u);
            asm volatile("s_waitcnt vmcnt(0)" ::: "memory");
        } else {
            XB_SPIN(xb_ld(&bar[XB_XGEN(x)]) == gen, bar);
            __builtin_amdgcn_fence(__ATOMIC_ACQUIRE, "agent");
            asm volatile("s_waitcnt vmcnt(0)" ::: "memory");
        }
    }
    __syncthreads();
}

constexpr int NPHASE = 2 + 11 * DEPTH;
__host__ __device__ inline bool phase_active(int ph) {
    if (ph < 2) return true;
    const int l = (ph - 2) / 11, s = (ph - 2) % 11, kind = l % 3;
    if (s == 0) return false;
    if (s == 4) return kind != 2 || HY_MFMA;
    return true;
}
DI void run_phase(const Ctx& c, int ph) {
    if (ph == 0) { if constexpr (PH_EN(0)) phase_pro0(c); return; }
    if (ph == 1) { if constexpr (PH_EN(1)) { phase_pro1(c); phase_norm1(c, 0, c.in[I_X], c.in[I_CTX]); } return; }
    const int l = (ph - 2) / 11, s = (ph - 2) % 11, kind = l % 3, j = l / 3;
    switch (s) {
    case 0: if constexpr (PH_EN(2)) phase_norm1(c, 0, c.in[I_X], c.in[I_CTX]); break;
    case 1: if constexpr (PH_EN(3)) {
        DenseOrder S; EpiInproj E; E.P = WSP(bf16, WS_P); E.extra = WSP(float, WS_EXTRA); E.bias = nullptr; E.bias_x = nullptr;
        S.A = WSP(bf16, WS_H); S.ul = dense_units(c.lds, c.tid, TT, kind == 2 ? 3072 : NINP);
        if (kind == 0) { S.Bt = WSP(bf16, WS_ML_WIN) + (size_t)j * NINP * 1024; E.bias_x = c.in[I_MLBG] + j * 32; }
        else if (kind == 1) { S.Bt = WSP(bf16, WS_GLA_WIN); }
        else { S.Bt = WSP(bf16, WS_HY_WIN); E.bias = c.in[I_HYBIN]; }
        gemm_run(c.lds, c.tid, S, E);
    } break;
    case 2: if constexpr (PH_EN(4))
        if (kind == 0) phase_conv(c, 1024, c.in[I_MLCW] + j * 3 * 1024, c.in[I_MLCB] + j * 1024, true, 0.125f);
        else if (kind == 1) { phase_conv(c, 2048, c.in[I_GLCW], c.in[I_GLCB], true, 0.08838834764831845f); if constexpr (GLA_CHUNK) phase_gla_decay(c); }
        else { if constexpr (HY_MFMA) phase_hy_prep(c); else phase_conv(c, 3072, c.in[I_HYCW], c.in[I_HYCB], false, 1.0f); }
        break;
    case 3: if constexpr (PH_EN(5))
        if (kind == 0) { if constexpr (MLSTM_CHUNK) phase_mlstm_state(c); else phase_mlstm_scan_naive(c); }
        else if (kind == 1) { if constexpr (GLA_CHUNK) phase_gla_state(c); else phase_gla_scan_naive(c); }
        else { if constexpr (HY_MFMA) phase_hy_toeplitz(c); else phase_hyena_conv_naive(c); }
        break;
    case 4: if constexpr (PH_EN(6))
        if (kind == 0) { if constexpr (MLSTM_CHUNK) phase_mlstm_out(c, c.in[I_MLNG] + j * 1024); else phase_headnorm(c, 128, c.in[I_MLNG] + j * 1024); }
        else if (kind == 1) { if constexpr (GLA_CHUNK) phase_gla_out(c, c.in[I_GLNG]); else phase_headnorm(c, 256, c.in[I_GLNG]); }
        else { if constexpr (HY_MFMA) phase_hy_post(c); }
        break;
    case 5: if constexpr (PH_EN(7)) {
        DenseOrder S; EpiOutproj E; E.X = WSP(float, WS_X); E.XC = WSP(float, WS_XC); E.mod = WSP(float, WS_MOD) + (size_t)l * 9 * 6144; E.bias = nullptr; E.perm = (kind == 1);
        E.xs_l = (l == 0) ? c.in[I_X] : WSP(float, WS_X); E.xs_c = (l == 0) ? c.in[I_CTX] : WSP(float, WS_XC); E.row_off = (l == 3) ? TC : 0;
        const bf16* W = kind == 0 ? WSP(bf16, WS_ML_WOUT) + (size_t)j * 1024 * 1024 : kind == 1 ? WSP(bf16, WS_GLA_WOUT) : WSP(bf16, WS_HY_WOUT);
        if (kind == 2) E.bias = c.in[I_HYBOUT];
        S.A = WSP(bf16, WS_Y) + (size_t)E.row_off * D; S.Bt = W; S.ul = dense_units(c.lds, c.tid, TT - E.row_off, 1024);
        gemm_run(c.lds, c.tid, S, E);
    } break;
    case 6: if constexpr (PH_EN(8)) phase_route(c, l); break;
    case 7: if constexpr (PH_EN(9)) phase_gather(c, l); break;
    case 8: if constexpr (PH_EN(10)) {
        MoeOrder S; S.ul = moe_tiles(c, l, 3); S.A = WSP(bf16, WS_BIG + BIG_HS); S.Bt = WSP(bf16, WS_EXP_UP) + (size_t)l * 16 * 2048 * 1024; S.bstride = (size_t)2048 * 1024;
        EpiUp E; E.ACT = WSP(bf16, WS_BIG + BIG_ACT);
        gemm_run(c.lds, c.tid, S, E);
    } break;
    case 9: if constexpr (PH_EN(11)) {
        MoeOrder S; S.ul = moe_tiles(c, l, 2); S.A = WSP(bf16, WS_BIG + BIG_ACT); S.Bt = WSP(bf16, WS_EXP_DN) + (size_t)l * 16 * 1024 * 1024; S.bstride = (size_t)1024 * 1024;
        EpiDown E; E.YS = WSP(bf16, WS_BIG + BIG_HS);
        gemm_run(c.lds, c.tid, S, E);
    } break;
    case 10: if constexpr (PH_EN(12)) phase_combine(c, l); break;
    }
}

__global__ void __launch_bounds__(512, 2) mega_fwd(Params p) {
    extern __shared__ __attribute__((aligned(16))) unsigned char lds_raw[];
#if XCD_BARRIER
    {
        volatile LAS unsigned* st0 = (volatile LAS unsigned*)((LAS unsigned char*)lds_raw + BAR_LDS_OFF);
        if (threadIdx.x == 0) { st0[0] = 0u; st0[1] = 0u; (void)xb_add((unsigned*)(p.ws + WS_CTL) + CW_BAR + XB_XCNT(xb_xcc_id()), 1u); }
        __syncthreads();
    }
#endif
    bool first = true;
    int rep = 0;
    for (int ph = p.ph_lo; ph < p.ph_hi;) {
        if (!phase_active(ph)) { ++ph; continue; }
        int z; asm volatile("s_mov_b32 %0, 0" : "=s"(z));
        if (!first) {
#if XCD_BARRIER
            xcd_barrier((unsigned*)(p.ws + z + WS_CTL) + CW_BAR, (volatile LAS unsigned*)((LAS unsigned char*)lds_raw + BAR_LDS_OFF));
#else
            cg::this_grid().sync();
#endif
        }
        first = false;
        Ctx c;
        c.lds = (LAS unsigned char*)lds_raw;
        c.tid = threadIdx.x + z; c.lane = c.tid & 63; c.wave = __builtin_amdgcn_readfirstlane(c.tid >> 6);
        c.gw = blockIdx.x * 8 + c.wave; c.ngw = gridDim.x * 8;
        c.in = (const float* const __attribute__((address_space(4)))*)__builtin_amdgcn_kernarg_segment_ptr() + z; c.out = p.out + z; c.ws = p.ws + z; c.z = (unsigned)z;
        run_phase(c, ph);
        if (REP_MASK != 0u && rep == 0 && (ph >= 2 ? (((REP_MASK >> ((ph - 2) % 11)) & 1u) && ((REP_LAYERS >> ((ph - 2) / 11)) & 1u)) : ((REP_MASK >> (16 + ph)) & 1u))) rep = 1; else { rep = 0; ++ph; }
    }
}

extern "C" void kernel_launch(void* const* d_in, const int* in_sizes, int n_in, void* d_out, int out_size, void* d_ws, size_t ws_size, hipStream_t stream) {
    static int grid = 0;
    if (grid == 0) {
        if (n_in != 40 || ws_size < WS_END || out_size != TL * D) { fprintf(stderr, "kernel_launch: unexpected shapes (n_in %d, ws %zu, out %d)\n", n_in, ws_size, out_size); grid = -1; return; }
        int dev = 0, cus = 0, per_cu = 0;
        hipGetDevice(&dev); hipDeviceGetAttribute(&cus, hipDeviceAttributeMultiprocessorCount, dev);
        if (hipFuncSetAttribute((const void*)mega_fwd, hipFuncAttributeMaxDynamicSharedMemorySize, LDS_BYTES) != hipSuccess) { fprintf(stderr, "kernel_launch: hipFuncSetAttribute failed\n"); grid = -1; return; }
        if (hipOccupancyMaxActiveBlocksPerMultiprocessor(&per_cu, (const void*)mega_fwd, 512, LDS_BYTES) != hipSuccess || per_cu < 1) { fprintf(stderr, "kernel_launch: occupancy query says %d\n", per_cu); per_cu = 1; }
        (void)hipGetLastError();
        grid = cus;
        fprintf(stderr, "kernel_launch: grid %d (cus %d, per_cu %d)\n", grid, cus, per_cu);
    }
    if (grid < 0) return;
    hipMemsetAsync((char*)d_ws + WS_CTL, 0, 1 * MiB, stream);
    Params p{};
    for (int i = 0; i < 40; ++i) p.in[i] = (const float*)d_in[i];
    p.out = (float*)d_out; p.ws = (unsigned char*)d_ws;
#if N_LAUNCH_PER_PHASE
    for (int ph = 0; ph < NPHASE; ++ph) {
        if (!phase_active(ph)) continue;
        p.ph_lo = ph; p.ph_hi = ph + 1; void* args[] = {&p};
        hipError_t e = hipLaunchCooperativeKernel((const void*)mega_fwd, dim3(grid), dim3(512), args, LDS_BYTES, stream);
        if (e != hipSuccess) { fprintf(stderr, "launch failed: %s\n", hipGetErrorString(e)); break; }
    }
#else
    p.ph_lo = 0; p.ph_hi = NPHASE; void* args[] = {&p};
    hipError_t e = hipLaunchCooperativeKernel((const void*)mega_fwd, dim3(grid), dim3(512), args, LDS_BYTES, stream);
    if (e != hipSuccess) fprintf(stderr, "cooperative launch failed: %s (grid %d)\n", hipGetErrorString(e), grid);
#endif
}
```

```cpp
#include <hip/hip_runtime.h>
#include <hip/hip_cooperative_groups.h>
#include <cstdio>
#include <cstdint>
namespace cg = cooperative_groups;

#define LAS __attribute__((address_space(3)))
#define DI __device__ __forceinline__
typedef unsigned short bf16;
typedef float f32x4 __attribute__((ext_vector_type(4)));
typedef float f32x2 __attribute__((ext_vector_type(2)));
typedef unsigned u32x4 __attribute__((ext_vector_type(4)));
typedef unsigned u32x2 __attribute__((ext_vector_type(2)));
typedef short bf16x8 __attribute__((ext_vector_type(8)));

#ifndef FAST_GEMM
#define FAST_GEMM 1
#endif
#ifndef MLSTM_CHUNK
#define MLSTM_CHUNK 1
#endif
#ifndef GLA_CHUNK
#define GLA_CHUNK 1
#endif
#ifndef HY_MFMA
#define HY_MFMA 1
#endif
#ifndef XCD_BARRIER
#define XCD_BARRIER 1
#endif
#ifndef PH_MASK
#define PH_MASK 0xFFFFFFFFu
#endif
#define PH_EN(b) ((PH_MASK >> (b)) & 1u)
#ifndef REP_LAYERS
#define REP_LAYERS 0xFu
#endif
#ifndef REP_MASK
#define REP_MASK 0u
#endif
#ifndef N_LAUNCH_PER_PHASE
#define N_LAUNCH_PER_PHASE 0
#endif

constexpr int D = 1024, NB = 8, SEQ = 2048, CTX = 256, DEPTH = 4;
constexpr int TC = NB * CTX, TL = NB * SEQ, TT = TC + TL;
constexpr int NEXP = 16;
constexpr int PLD = 3072;
constexpr int NINP = 3328;
constexpr float EPS = 1e-6f;
constexpr int MAXSLOT = 40960;

constexpr size_t MiB = 1u << 20;
constexpr size_t WS_CTL = 0;
constexpr size_t WS_MOD = 1 * MiB;
constexpr size_t WS_HM = 2 * MiB;
constexpr size_t WS_TOK = 3 * MiB;
constexpr size_t WS_HF = 4 * MiB;
constexpr size_t WS_HFC = 20 * MiB;
constexpr size_t WS_ML_WIN = 32 * MiB;
constexpr size_t WS_ML_WOUT = 45 * MiB;
constexpr size_t WS_GLA_WIN = 49 * MiB;
constexpr size_t WS_GLA_WOUT = 56 * MiB;
constexpr size_t WS_HY_WIN = 58 * MiB;
constexpr size_t WS_HY_WOUT = 64 * MiB;
constexpr size_t WS_EXP_UP = 66 * MiB;
constexpr size_t WS_EXP_DN = 322 * MiB;
constexpr size_t WS_X = 450 * MiB;
constexpr size_t WS_XC = 514 * MiB;
constexpr size_t WS_H = 522 * MiB;
constexpr size_t WS_P = 558 * MiB;
constexpr size_t WS_EXTRA = 667 * MiB;
constexpr size_t WS_Y = 670 * MiB;
constexpr size_t WS_BIG = 706 * MiB;
constexpr size_t WS_END = 1024 * MiB;
constexpr size_t BIG_HS = 0;
constexpr size_t BIG_ACT = 80 * MiB;
constexpr size_t BIG_PC = 0;
constexpr size_t BIG_YF = 108 * MiB;
constexpr size_t BIG_YB = 180 * MiB;

constexpr size_t BIG_MCT = 108 * MiB;
constexpr size_t BIG_MN = 180 * MiB;

constexpr size_t BIG_GB = 72 * MiB;
constexpr size_t BIG_GST = 144 * MiB;

constexpr size_t BIG_ZTL = 108 * MiB;
constexpr size_t BIG_ZTC = 140 * MiB;
constexpr size_t BIG_YTL = 144 * MiB;
constexpr size_t BIG_YTC = 176 * MiB;

constexpr int CW_CNT = 1024;
constexpr int CW_BAR = 4096;

constexpr int LDS_BYTES = 148480;
constexpr int BAR_LDS_OFF = 147456;
constexpr int MISC_OFF = 131072;

struct Params {
    const float* in[40];
    float* out;
    unsigned char* ws;
    int ph_lo, ph_hi;
};
static_assert(__builtin_offsetof(Params, in) == 0, "the input pointer table must be the first kernel argument bytes");
enum { I_X = 0, I_C, I_CTX, I_CCTX, I_ADAW, I_ADAB, I_N1G, I_N2G, I_FING, I_MLWIN, I_MLBG, I_MLCW, I_MLCB, I_MLNG, I_MLWOUT,
       I_GLWIN, I_GLCW, I_GLCB, I_GLW2, I_GLGB, I_GLNG, I_GLWOUT, I_HYWIN, I_HYBIN, I_HYCW, I_HYCB, I_HYFW1, I_HYFB1, I_HYFWM, I_HYFBM,
       I_HYFWO, I_HYFREQ, I_HYSKIP, I_HYWOUT, I_HYBOUT, I_RW, I_RB, I_EW1, I_EW3, I_EW2 };

DI float bf2f(bf16 v) { return __uint_as_float(((unsigned)v) << 16); }
typedef __bf16 b16x2_t __attribute__((ext_vector_type(2)));
DI unsigned cvt_pk_bf16(float lo, float hi) { const f32x2 v = {lo, hi}; const b16x2_t r = __builtin_convertvector(v, b16x2_t); return __builtin_bit_cast(unsigned, r); }
DI bf16 f2bf(float f) { return (bf16)(cvt_pk_bf16(f, 0.f) & 0xffffu); }
DI float sigmoidf_(float x) { return 1.0f / (1.0f + __expf(-x)); }
DI float siluf_(float x) { return x / (1.0f + __expf(-x)); }
DI float logsigf_(float x) { return fminf(x, 0.f) - log1pf(__expf(-fabsf(x))); }
DI void lds_barrier() { asm volatile("s_waitcnt lgkmcnt(0)" ::: "memory"); __builtin_amdgcn_s_barrier(); asm volatile("" ::: "memory"); }
DI float wave_sum(float v) {
#pragma unroll
    for (int o = 1; o < 64; o <<= 1) v += __shfl_xor(v, o);
    return v;
}
DI void unpack8(const u32x4 w, float (&v)[8]) {
    v[0] = __uint_as_float(w.x << 16); v[1] = __uint_as_float(w.x & 0xffff0000u);
    v[2] = __uint_as_float(w.y << 16); v[3] = __uint_as_float(w.y & 0xffff0000u);
    v[4] = __uint_as_float(w.z << 16); v[5] = __uint_as_float(w.z & 0xffff0000u);
    v[6] = __uint_as_float(w.w << 16); v[7] = __uint_as_float(w.w & 0xffff0000u);
}
DI u32x4 pack8(const float (&v)[8]) { u32x4 w; w.x = cvt_pk_bf16(v[0], v[1]); w.y = cvt_pk_bf16(v[2], v[3]); w.z = cvt_pk_bf16(v[4], v[5]); w.w = cvt_pk_bf16(v[6], v[7]); return w; }
DI void seq_bounds(int row, int& lo, int& hi) {
    if (row < TC) { lo = row & ~(CTX - 1); hi = lo + CTX - 1; } else { lo = TC + ((row - TC) & ~(SEQ - 1)); hi = lo + SEQ - 1; }
}
DI int perm_fwd(int s) { return (s & 63) * 32 + (s >> 6); }
DI int perm_inv(int sp) { return (sp & 31) * 64 + (sp >> 5); }

namespace pg8 {
constexpr int BM = 256, BK = 64, HALF = 128, HTB = HALF * BK * 2, STAGE_BYTES = 8 * HTB, NXCD = 8, WGM = 8;
__host__ __device__ __forceinline__ int lds_byte(int r, int c) { const int st = (r >> 4) * 2 + (c >> 5), rr = r & 15, cc = c & 31, ob = rr * 64 + cc * 2; return st * 1024 + (ob ^ (((ob >> 9) & 1) << 5)); }
__host__ __device__ __forceinline__ void stage_rc(int b, int& R, int& C) { const int st = b / 1024, sb = b % 1024, swz = sb ^ (((sb >> 9) & 1) << 5); R = (st >> 1) * 16 + swz / 64; C = (st & 1) * 32 + (swz % 64) / 2; }
__host__ __device__ __forceinline__ int perm32(int rho) { const int n = rho >> 4, i = rho & 15; return 8 * (i >> 2) + 4 * n + (i & 3); }
}
struct Unit { int pm, pn, e; };

DI LAS int* dense_units(LAS unsigned char* lds, int tid, int M, int N) {
    LAS int* ul = (LAS int*)(lds + MISC_OFF) + 192;
    __syncthreads();
    if (tid < 32) {
        const int nM = M / 256, nN = N / 256, nwg = nM * nN, G = gridDim.x, L = tid * G + (int)blockIdx.x; int w = -1;
        if (L < nwg) {
            int wgid = L; { const int q = nwg / 8, r = nwg % 8, xcd = wgid % 8, off = wgid / 8; wgid = (xcd < r ? xcd * (q + 1) : r * (q + 1) + (xcd - r) * q) + off; }
            const int nig = 8 * nN, gid = wgid / nig, fm = gid * 8, gsz = (nM - fm) < 8 ? (nM - fm) : 8;
            w = (fm + ((wgid % nig) % gsz)) | (((wgid % nig) / gsz) << 12);
        }
        ul[tid] = w;
    }
    __syncthreads();
    return ul;
}
struct DenseOrder {
    const bf16* A; const bf16* Bt; const LAS int* ul;
    DI bool next(int i, Unit& u) const {
        const int w = __builtin_amdgcn_readfirstlane(ul[i]); if (w < 0) return false;
        u.pm = w & 0xfff; u.pn = (w >> 12) & 0xf; u.e = 0; return true;
    }
    DI const bf16* aptr(const Unit& u) const { return A + (size_t)u.pm * 256 * 1024; }
    DI const bf16* bptr(const Unit& u) const { return Bt + (size_t)u.pn * 256 * 1024; }
};
struct MoeOrder {
    const bf16* A; const bf16* Bt; size_t bstride; const LAS int* ul;
    DI bool next(int i, Unit& u) const {
        const int w = __builtin_amdgcn_readfirstlane(ul[i]); if (w < 0) return false;
        u.pm = w & 0xfff; u.pn = (w >> 12) & 0xf; u.e = w >> 16; return true;
    }
    DI const bf16* aptr(const Unit& u) const { return A + (size_t)u.pm * 256 * 1024; }
    DI const bf16* bptr(const Unit& u) const { return Bt + (size_t)u.e * bstride + (size_t)u.pn * 256 * 1024; }
};

struct EpiInproj {
    static constexpr bool PAIR = false;
    bf16* P; float* extra; const float* bias; const float* bias_x;
    DI void row8(const Unit& u, int r, int c, const float (&v)[8]) const {
        const int row = u.pm * 256 + r, col = u.pn * 256 + c;
        if (col < PLD) {
            float w[8];
#pragma unroll
            for (int j = 0; j < 8; ++j) w[j] = v[j] + (bias ? bias[col + j] : 0.f);
            *(u32x4*)(P + (size_t)row * PLD + col) = pack8(w);
        } else if (col < PLD + 32) {
            float* o = extra + (size_t)row * 32 + (col - PLD);
#pragma unroll
            for (int j = 0; j < 8; ++j) o[j] = v[j] + (bias_x ? bias_x[col - PLD + j] : 0.f);
        }
    }
};
struct EpiOutproj {
    static constexpr bool PAIR = false;
    const float* xs_l; const float* xs_c; float* X; float* XC; const float* mod; const float* bias; int row_off; int perm;
    DI void row8(const Unit& u, int r, int c, const float (&v)[8]) const {
        const int hrow = u.pm * 256 + r + row_off, col = u.pn * 256 + c;
        const float* src; float* dst; int mr;
        if (hrow < TC) { mr = 8; src = xs_c + (size_t)hrow * D + col; dst = XC + (size_t)hrow * D + col; }
        else { const int rr = hrow - TC, b = rr >> 11, sp = rr & (SEQ - 1), s = perm ? perm_inv(sp) : sp; mr = b;
               src = xs_l + ((size_t)b * SEQ + s) * D + col; dst = X + ((size_t)b * SEQ + s) * D + col; }
        const float* g1 = mod + mr * 6144 + 2048 + col;
        const f32x4 a0 = *(const f32x4*)src, a1 = *(const f32x4*)(src + 4), g0 = *(const f32x4*)g1, gg1 = *(const f32x4*)(g1 + 4);
        f32x4 b0 = {0.f, 0.f, 0.f, 0.f}, b1 = b0;
        if (bias) { b0 = *(const f32x4*)(bias + col); b1 = *(const f32x4*)(bias + col + 4); }
        f32x4 o0, o1;
        o0 = a0 + g0 * ((f32x4){v[0], v[1], v[2], v[3]} + b0); o1 = a1 + gg1 * ((f32x4){v[4], v[5], v[6], v[7]} + b1);
        *(f32x4*)dst = o0; *(f32x4*)(dst + 4) = o1;
    }
};
struct EpiUp {
    static constexpr bool PAIR = true;
    bf16* ACT;
    DI void row8p(const Unit& u, int r, int c, const float (&g)[8], const float (&up)[8]) const {
        float w[8];
#pragma unroll
        for (int j = 0; j < 8; ++j) w[j] = siluf_(g[j]) * up[j];
        *(u32x4*)(ACT + ((size_t)u.pm * 256 + r) * 1024 + u.pn * 128 + c) = pack8(w);
    }
};
struct EpiDown {
    static constexpr bool PAIR = false;
    bf16* YS;
    DI void row8(const Unit& u, int r, int c, const float (&v)[8]) const { *(u32x4*)(YS + ((size_t)u.pm * 256 + r) * 1024 + u.pn * 256 + c) = pack8(v); }
};

template <class Sched, class Epi>
DI void gemm_fast(LAS unsigned char* lds, int tid, const Sched& S, const Epi& E) {
    using namespace pg8;
    constexpr int K = 1024, nt = K / BK;
    const int wid = __builtin_amdgcn_readfirstlane(tid >> 6), lane = tid & 63, wr = wid >> 2, wc = wid & 3, fr = lane & 15, fq = lane >> 4;
    unsigned voffA[2], voffB[2];
#pragma unroll
    for (int i = 0; i < 2; ++i) { int R, C; stage_rc(tid * 16 + i * 8192, R, C); const int Rb = (R & ~31) + perm32(R & 31);
        voffA[i] = (unsigned)(R * K + C) * 2u; voffB[i] = (unsigned)(Rb * K + C) * 2u; }
    const size_t kstep = (size_t)(BK * 2);
    const size_t hstep = (size_t)HALF * K * 2;
    const unsigned ldsw = (unsigned)wid * 1024u;
    const int aoff = lds_byte(wr * 64 + fr, fq * 8), boff = lds_byte(wc * 32 + fr, fq * 8);
#define PG8_SA(b, h) (((b) * 2 + (h)) * HTB)
#define PG8_SB(b, h) ((4 + (b) * 2 + (h)) * HTB)
#define PG8_STAGE(bufoff, gbase, voff) do { _Pragma("unroll") for (int _i = 0; _i < 2; ++_i) \
        __builtin_amdgcn_global_load_lds((const unsigned*)((const char*)(gbase) + (voff)[_i]), (LAS unsigned*)(lds + (bufoff) + ldsw + _i * 8192), 16, 0, 0); } while (0)
#define PG8_LDA(dst, b, h) do { _Pragma("unroll") for (int m = 0; m < 4; ++m) _Pragma("unroll") for (int k = 0; k < 2; ++k) dst[m][k] = *(const LAS bf16x8*)(lds + PG8_SA(b, h) + aoff + m * 2048 + k * 1024); } while (0)
#define PG8_LDB(dst, b, h) do { _Pragma("unroll") for (int n = 0; n < 2; ++n) _Pragma("unroll") for (int k = 0; k < 2; ++k) dst[n][k] = *(const LAS bf16x8*)(lds + PG8_SB(b, h) + boff + n * 2048 + k * 1024); } while (0)
#define PG8_MMA(ai, bj, At, Bt) do { __builtin_amdgcn_s_setprio(1); _Pragma("unroll") for (int m = 0; m < 4; ++m) _Pragma("unroll") for (int n = 0; n < 2; ++n) _Pragma("unroll") for (int k = 0; k < 2; ++k) \
        acc[ai][bj][m][n] = __builtin_amdgcn_mfma_f32_16x16x32_bf16(Bt[n][k], At[m][k], acc[ai][bj][m][n], 0, 0, 0); __builtin_amdgcn_s_setprio(0); } while (0)
#define PG8_WAIT_V(n) asm volatile("s_waitcnt vmcnt(" #n ")" ::: "memory")
#define PG8_WAIT_L(n) asm volatile("s_waitcnt lgkmcnt(" #n ")" ::: "memory")
#define PG8_BAR __builtin_amdgcn_s_barrier()
#define PG8_SCHED __builtin_amdgcn_sched_barrier(0)
    Unit cur, nxt; int ui = 0;
    if (!S.next(0, cur)) return;
    f32x4 acc[2][2][4][2];
#pragma unroll
    for (int a = 0; a < 2; ++a)
#pragma unroll
        for (int b = 0; b < 2; ++b)
#pragma unroll
            for (int m = 0; m < 4; ++m)
#pragma unroll
                for (int n = 0; n < 2; ++n) acc[a][b][m][n] = (f32x4){0.f, 0.f, 0.f, 0.f};
    bf16x8 At[4][2], B0[2][2], B1[2][2];
    const char* cA = (const char*)S.aptr(cur); const char* cB = (const char*)S.bptr(cur);
    PG8_STAGE(PG8_SB(0, 0), cB, voffB); PG8_STAGE(PG8_SA(0, 0), cA, voffA); PG8_STAGE(PG8_SB(0, 1), cB + hstep, voffB); PG8_STAGE(PG8_SA(0, 1), cA + hstep, voffA);
    if (wr == 1) PG8_BAR;
    PG8_WAIT_V(4); PG8_BAR;
    PG8_STAGE(PG8_SB(1, 0), cB + kstep, voffB); PG8_STAGE(PG8_SA(1, 0), cA + kstep, voffA); PG8_STAGE(PG8_SB(1, 1), cB + hstep + kstep, voffB);
    PG8_WAIT_V(6); PG8_BAR;
    for (;;) {
        const bool has_next = S.next(ui + 1, nxt);
        const char* nA = has_next ? (const char*)S.aptr(nxt) : cA; const char* nB = has_next ? (const char*)S.bptr(nxt) : cB;
        for (int t = 0; t < nt; t += 2) {
            const bool last = (t == nt - 2);
            const char* a1 = cA + (size_t)(t + 1) * kstep;
            const char* a2 = last ? nA : cA + (size_t)(t + 2) * kstep; const char* b2 = last ? nB : cB + (size_t)(t + 2) * kstep;
            const char* a3 = a2 + kstep; const char* b3 = b2 + kstep;
            PG8_LDB(B0, 0, 0); PG8_SCHED; PG8_LDA(At, 0, 0); PG8_STAGE(PG8_SA(1, 1), a1 + hstep, voffA);
            PG8_WAIT_L(8); PG8_BAR; PG8_WAIT_L(0); PG8_MMA(0, 0, At, B0); PG8_BAR; PG8_SCHED;
            PG8_LDB(B1, 0, 1); PG8_STAGE(PG8_SB(0, 0), b2, voffB);
            PG8_BAR; PG8_WAIT_L(0); PG8_MMA(0, 1, At, B1); PG8_BAR;
            PG8_LDA(At, 0, 1); PG8_STAGE(PG8_SA(0, 0), a2, voffA);
            PG8_BAR; PG8_WAIT_L(0); PG8_MMA(1, 0, At, B0); PG8_BAR; PG8_SCHED;
            PG8_STAGE(PG8_SB(0, 1), b2 + hstep, voffB);
            PG8_WAIT_V(6); PG8_BAR; PG8_MMA(1, 1, At, B1); PG8_BAR;
            PG8_LDB(B0, 1, 0); PG8_SCHED; PG8_LDA(At, 1, 0); PG8_STAGE(PG8_SA(0, 1), a2 + hstep, voffA);
            PG8_WAIT_L(8); PG8_BAR; PG8_WAIT_L(0); PG8_MMA(0, 0, At, B0); PG8_BAR; PG8_SCHED;
            PG8_LDB(B1, 1, 1); PG8_STAGE(PG8_SB(1, 0), b3, voffB);
            PG8_BAR; PG8_WAIT_L(0); PG8_MMA(0, 1, At, B1); PG8_BAR;
            PG8_LDA(At, 1, 1); PG8_STAGE(PG8_SA(1, 0), a3, voffA);
            PG8_BAR; PG8_WAIT_L(0); PG8_MMA(1, 0, At, B0); PG8_BAR; PG8_SCHED;
            PG8_STAGE(PG8_SB(1, 1), b3 + hstep, voffB);
            PG8_WAIT_V(6); PG8_BAR; PG8_MMA(1, 1, At, B1); PG8_BAR;
        }
#pragma unroll
        for (int ai = 0; ai < 2; ++ai)
#pragma unroll
            for (int m = 0; m < 4; ++m) {
                const int r = ai * HALF + wr * 64 + m * 16 + fr;
                if constexpr (Epi::PAIR) {
                    const float g[8] = {acc[ai][0][m][0][0], acc[ai][0][m][0][1], acc[ai][0][m][0][2], acc[ai][0][m][0][3], acc[ai][0][m][1][0], acc[ai][0][m][1][1], acc[ai][0][m][1][2], acc[ai][0][m][1][3]};
                    const float up[8] = {acc[ai][1][m][0][0], acc[ai][1][m][0][1], acc[ai][1][m][0][2], acc[ai][1][m][0][3], acc[ai][1][m][1][0], acc[ai][1][m][1][1], acc[ai][1][m][1][2], acc[ai][1][m][1][3]};
                    E.row8p(cur, r, wc * 32 + 8 * fq, g, up);
                } else {
#pragma unroll
                    for (int bj = 0; bj < 2; ++bj) {
                        const float v[8] = {acc[ai][bj][m][0][0], acc[ai][bj][m][0][1], acc[ai][bj][m][0][2], acc[ai][bj][m][0][3], acc[ai][bj][m][1][0], acc[ai][bj][m][1][1], acc[ai][bj][m][1][2], acc[ai][bj][m][1][3]};
                        E.row8(cur, r, bj * HALF + wc * 32 + 8 * fq, v);
                    }
                }
            }
        if (!has_next) break;
#pragma unroll
        for (int a = 0; a < 2; ++a)
#pragma unroll
            for (int b = 0; b < 2; ++b)
#pragma unroll
                for (int m = 0; m < 4; ++m)
#pragma unroll
                    for (int n = 0; n < 2; ++n) acc[a][b][m][n] = (f32x4){0.f, 0.f, 0.f, 0.f};
        cur = nxt; cA = nA; cB = nB; ++ui;
    }
    PG8_WAIT_V(0);
    if (wr == 0) PG8_BAR;
    PG8_BAR;
#undef PG8_SA
#undef PG8_SB
#undef PG8_STAGE
#undef PG8_LDA
#undef PG8_LDB
#undef PG8_MMA
#undef PG8_WAIT_V
#undef PG8_WAIT_L
#undef PG8_BAR
#undef PG8_SCHED
}

template <class Sched, class Epi>
DI void gemm_naive(LAS unsigned char* lds, int tid, const Sched& S, const Epi& E) {
    LAS float* As = (LAS float*)lds;
    LAS float* Bs = As + 32 * 132;
    LAS float* Bu = Bs + 32 * 132;
    const int ty = tid >> 4, tx = tid & 15, lr = tid >> 2, kq = tid & 3;
    Unit u;
    for (int i = 0; S.next(i, u); ++i) {
        const bf16* A = S.aptr(u); const bf16* B = S.bptr(u);
        for (int sm = 0; sm < 2; ++sm)
            for (int sn = 0; sn < (Epi::PAIR ? 1 : 2); ++sn) {
                float acc[4][8], accu[4][8];
#pragma unroll
                for (int a = 0; a < 4; ++a)
#pragma unroll
                    for (int b = 0; b < 8; ++b) { acc[a][b] = 0.f; accu[a][b] = 0.f; }
                for (int k0 = 0; k0 < 1024; k0 += 32) {
                    __syncthreads();
                    { float w[8]; unpack8(*(const u32x4*)(A + (size_t)(128 * sm + lr) * 1024 + k0 + 8 * kq), w);
#pragma unroll
                      for (int j = 0; j < 8; ++j) As[(8 * kq + j) * 132 + lr] = w[j];
                      unpack8(*(const u32x4*)(B + (size_t)(128 * sn + lr) * 1024 + k0 + 8 * kq), w);
#pragma unroll
                      for (int j = 0; j < 8; ++j) Bs[(8 * kq + j) * 132 + lr] = w[j];
                      if (Epi::PAIR) { unpack8(*(const u32x4*)(B + (size_t)(128 + lr) * 1024 + k0 + 8 * kq), w);
#pragma unroll
                          for (int j = 0; j < 8; ++j) Bu[(8 * kq + j) * 132 + lr] = w[j]; } }
                    __syncthreads();
#pragma unroll 4
                    for (int k = 0; k < 32; ++k) {
                        const f32x4 a4 = *(const LAS f32x4*)(As + k * 132 + 4 * ty);
                        const f32x4 b0 = *(const LAS f32x4*)(Bs + k * 132 + 8 * tx), b1 = *(const LAS f32x4*)(Bs + k * 132 + 8 * tx + 4);
#pragma unroll
                        for (int a = 0; a < 4; ++a) {
#pragma unroll
                            for (int b = 0; b < 4; ++b) { acc[a][b] += a4[a] * b0[b]; acc[a][4 + b] += a4[a] * b1[b]; } }
                        if (Epi::PAIR) {
                            const f32x4 c0 = *(const LAS f32x4*)(Bu + k * 132 + 8 * tx), c1 = *(const LAS f32x4*)(Bu + k * 132 + 8 * tx + 4);
#pragma unroll
                            for (int a = 0; a < 4; ++a) {
#pragma unroll
                                for (int b = 0; b < 4; ++b) { accu[a][b] += a4[a] * c0[b]; accu[a][4 + b] += a4[a] * c1[b]; } }
                        }
                    }
                }
#pragma unroll
                for (int a = 0; a < 4; ++a) {
                    if constexpr (Epi::PAIR) E.row8p(u, 128 * sm + 4 * ty + a, 8 * tx, acc[a], accu[a]);
                    else E.row8(u, 128 * sm + 4 * ty + a, 128 * sn + 8 * tx, acc[a]);
                }
            }
    }
    __syncthreads();
}
template <class Sched, class Epi>
DI void gemm_run(LAS unsigned char* lds, int tid, const Sched& S, const Epi& E) {
#if FAST_GEMM
    gemm_fast(lds, tid, S, E);
#else
    gemm_naive(lds, tid, S, E);
#endif
}

struct Ctx {
    LAS unsigned char* lds;
    int tid, lane, wave, gw, ngw;
    unsigned z;
    const float* const __attribute__((address_space(4)))* in;
    float* out;
    unsigned char* ws;
};
#define WSP(T, off) ((T*)(c.ws + (off)))

DI void transpose_item(const float* W, int N, bf16* WT, int k0, int n0, int dst_row0, LAS float* scr, int lane) {
#pragma unroll 8
    for (int i = 0; i < 32; ++i) { const int kk = 2 * i + (lane >> 5); scr[kk * 33 + (lane & 31)] = W[(size_t)(k0 + kk) * N + n0 + (lane & 31)]; }
    asm volatile("s_waitcnt lgkmcnt(0)" ::: "memory");
    const int cc = lane & 7;
#pragma unroll
    for (int j = 0; j < 4; ++j) { const int n = (lane >> 3) + 8 * j; const LAS float* s = scr + (8 * cc) * 33 + n;
        u32x4 o; o.x = cvt_pk_bf16(s[0 * 33], s[1 * 33]); o.y = cvt_pk_bf16(s[2 * 33], s[3 * 33]); o.z = cvt_pk_bf16(s[4 * 33], s[5 * 33]); o.w = cvt_pk_bf16(s[6 * 33], s[7 * 33]);
        *(u32x4*)(WT + (size_t)(dst_row0 + n) * 1024 + k0 + 8 * cc) = o; }
    asm volatile("s_waitcnt lgkmcnt(0)" ::: "memory");
}
DI void dense_transpose(const Ctx& c, const float* W, int N, bf16* WT, LAS float* scr) {
    const int nblk = N / 32, nitems = 16 * nblk;
    for (int it = c.gw; it < nitems; it += c.ngw) { const int kb = it / nblk, nb = it % nblk; transpose_item(W, N, WT, 64 * kb, 32 * nb, 32 * nb, scr, c.lane); }
}
DI void phase_pro0(const Ctx& c) {
    LAS float* scr = (LAS float*)(c.lds + c.wave * 8704);
    for (int j = 0; j < 2; ++j) {
        dense_transpose(c, c.in[I_MLWIN] + (size_t)j * 1024 * 3104, 3104, WSP(bf16, WS_ML_WIN) + (size_t)j * NINP * 1024, scr);
        dense_transpose(c, c.in[I_MLWOUT] + (size_t)j * 1024 * 1024, 1024, WSP(bf16, WS_ML_WOUT) + (size_t)j * 1024 * 1024, scr);
    }
    dense_transpose(c, c.in[I_GLWIN], 3104, WSP(bf16, WS_GLA_WIN), scr);
    dense_transpose(c, c.in[I_GLWOUT], 1024, WSP(bf16, WS_GLA_WOUT), scr);
    dense_transpose(c, c.in[I_HYWIN], 3072, WSP(bf16, WS_HY_WIN), scr);
    dense_transpose(c, c.in[I_HYWOUT], 1024, WSP(bf16, WS_HY_WOUT), scr);
    for (int it = c.gw * 64 + c.lane; it < 3 * 28672; it += c.ngw * 64) {
        const int m = it / 28672, r = it % 28672; bf16* base = (m < 2) ? WSP(bf16, WS_ML_WIN) + (size_t)m * NINP * 1024 : WSP(bf16, WS_GLA_WIN);
        *(u32x4*)(base + (size_t)3104 * 1024 + (size_t)r * 8) = (u32x4){c.z, c.z, c.z, c.z};
    }
    for (int it = c.gw; it < 64 * 3 * 512; it += c.ngw) {
        const int le = it / 1536, r0 = it % 1536, which = r0 / 512, r = r0 % 512, kb = r / 32, nb = r % 32;
        if (which < 2) {
            const float* W = c.in[which == 0 ? I_EW1 : I_EW3] + (size_t)le * 1024 * 1024;
            const int n0 = 32 * nb, drow = 256 * (n0 >> 7) + (n0 & 127) + (which ? 128 : 0);
            transpose_item(W, 1024, WSP(bf16, WS_EXP_UP) + (size_t)le * 2048 * 1024, 64 * kb, n0, drow, scr, c.lane);
        } else {
            transpose_item(c.in[I_EW2] + (size_t)le * 1024 * 1024, 1024, WSP(bf16, WS_EXP_DN) + (size_t)le * 1024 * 1024, 64 * kb, 32 * nb, 32 * nb, scr, c.lane);
        }
    }
    {
        const float* w1 = c.in[I_HYFW1]; const float* b1 = c.in[I_HYFB1]; const float* wm = c.in[I_HYFWM]; const float* bm = c.in[I_HYFBM]; const float* fr = c.in[I_HYFREQ];
        float* HM = WSP(float, WS_HM);
        for (int row = c.gw; row < 2304; row += c.ngw) {
            const int L = row < 2048 ? 2048 : 256, t = row < 2048 ? row : row - 2048, f = c.lane;
            float feat = 0.f;
            if (f == 0) feat = (float)t / (float)(L - 1);
            else if (f <= 32) { const int b = (f - 1) & 15; const float band = 1e-4f + (float)b * ((15.0f - 1e-4f) / 15.0f);
                const float ang = ((float)(2.0 * 3.14159265358979323846 / (double)L) * (float)t) * band; feat = (f <= 16) ? cosf(ang) : -sinf(ang); }
            float a = b1[f];
            for (int e = 0; e < 33; ++e) a += __shfl(feat, e) * w1[e * 64 + f];
            float h = sinf(fr[f] * a);
            for (int m = 0; m < 2; ++m) {
                float a2 = bm[m * 64 + f];
                for (int g = 0; g < 64; ++g) a2 += __shfl(h, g) * wm[m * 4096 + g * 64 + f];
                h = sinf(fr[f] * a2);
            }
            HM[row * 64 + f] = h;
        }
    }
    __syncthreads();
    {
        LAS float* sv = (LAS float*)c.lds;
        LAS float* red = sv + 9 * 1024;
        for (int i = c.tid; i < 9 * 1024; i += 512) { const float x = (i < 8192) ? c.in[I_C][i] : c.in[I_CCTX][i - 8192]; sv[i] = siluf_(x); }
        __syncthreads();
        float* MOD = WSP(float, WS_MOD);
        const int col = c.tid & 63, kg = c.tid >> 6;
        for (int item = blockIdx.x; item < 4 * 96; item += gridDim.x) {
            const int l = item / 96, j0 = 64 * (item % 96);
            const float* w = c.in[I_ADAW] + (size_t)l * 1024 * 6144 + j0 + col;
            float acc[9];
#pragma unroll
            for (int r = 0; r < 9; ++r) acc[r] = 0.f;
            for (int k = kg * 128; k < kg * 128 + 128; ++k) { const float wv = w[(size_t)k * 6144];
#pragma unroll
                for (int r = 0; r < 9; ++r) acc[r] += sv[r * 1024 + k] * wv; }
#pragma unroll
            for (int r = 0; r < 9; ++r) red[(kg * 9 + r) * 64 + col] = acc[r];
            __syncthreads();
            for (int o = c.tid; o < 9 * 64; o += 512) { const int r = o >> 6, cc = o & 63; float s = c.in[I_ADAB][l * 6144 + j0 + cc];
#pragma unroll
                for (int g = 0; g < 8; ++g) s += red[(g * 9 + r) * 64 + cc];
                MOD[(l * 9 + r) * 6144 + j0 + cc] = s; }
            __syncthreads();
        }
    }
}

template <int L>
DI void pro1_len(const Ctx& c, int c0, const float* hm, float* tab, LAS float* hmT  , const LAS f32x4* wo4  , float (&part)[4]) {
    const int side = c.wave & 1, ts = c.wave >> 1;
    const float da = -4.605170185988091f / 1.5f, db = -4.605170185988091f / 0.3f;
#pragma unroll 1
    for (int t0 = 0; t0 < L; t0 += 256) {
        __syncthreads();
#pragma unroll
        for (int k = 0; k < 8; ++k) { const int idx = c.tid + 512 * k, row = idx >> 4, q = idx & 15; const f32x4 v = *(const f32x4*)(hm + (size_t)(t0 + row) * 64 + 4 * q);
            LAS float* d = hmT + row * 65 + 4 * q; d[0] = v.x; d[1] = v.y; d[2] = v.z; d[3] = v.w; }
        __syncthreads();
        const int t = t0 + 64 * ts + c.lane; const LAS float* hr = hmT + (64 * ts + c.lane) * 65;
        f32x4 acc = {0.f, 0.f, 0.f, 0.f};
#pragma unroll 8
        for (int f = 0; f < 64; ++f) acc += wo4[side * 64 + f] * hr[f];
        const float tl = (float)t / (float)(L - 1);
#pragma unroll
        for (int ch = 0; ch < 4; ++ch) { const float delta = fabsf(da + (float)(c0 + ch) * ((db - da) / 1023.0f)), v = acc[ch] * expf(-tl * delta);
            float* trow = tab + (size_t)(c0 + ch) * (2 * L);
            if (side == 0) { trow[L + t] = v; part[ch] += fabsf(v); }
            else if (t >= 1) { trow[L - t] = v; part[ch] += fabsf(v); }
            else trow[0] = 0.f; }
    }
}
template <int L>
DI void pro1_scale(const Ctx& c, int c0, float* tab, const float (&inv)[4]) {
    const int side = c.wave & 1, ts = c.wave >> 1;
#pragma unroll 1
    for (int t0 = 0; t0 < L; t0 += 256) { const int t = t0 + 64 * ts + c.lane;
#pragma unroll
        for (int ch = 0; ch < 4; ++ch) { float* trow = tab + (size_t)(c0 + ch) * (2 * L); if (side == 0) trow[L + t] *= inv[ch]; else if (t >= 1) trow[L - t] *= inv[ch]; } }
}
DI void pro1_reduce(const Ctx& c, float (&part)[4], LAS float* red, float (&inv)[4]) {
#pragma unroll
    for (int ch = 0; ch < 4; ++ch) part[ch] = wave_sum(part[ch]);
    __syncthreads();
    if (c.lane == 0) {
#pragma unroll
        for (int ch = 0; ch < 4; ++ch) red[c.wave * 4 + ch] = part[ch]; }
    __syncthreads();
#pragma unroll
    for (int ch = 0; ch < 4; ++ch) { float s = 0.f;
#pragma unroll
        for (int w = 0; w < 8; ++w) s += red[w * 4 + ch];
        inv[ch] = 1.0f / s; }
}
DI void phase_pro1(const Ctx& c) {
    LAS float* hmT = (LAS float*)c.lds; LAS f32x4* wo4 = (LAS f32x4*)(c.lds + 67584); LAS float* red = (LAS float*)(c.lds + 67584 + 2048);
    const float* HM = WSP(float, WS_HM);
    for (int item = blockIdx.x; item < 256; item += gridDim.x) {
        const int c0 = 4 * item;
        __syncthreads();
        if (c.tid < 128) wo4[c.tid] = *(const f32x4*)(c.in[I_HYFWO] + (size_t)(c.tid & 63) * 2048 + (c.tid >> 6) * 1024 + c0);
        float part[4] = {0.f, 0.f, 0.f, 0.f}, inv[4];
        pro1_len<SEQ>(c, c0, HM, WSP(float, WS_HF), hmT, wo4, part);
        pro1_reduce(c, part, red, inv);
        pro1_scale<SEQ>(c, c0, WSP(float, WS_HF), inv);
        float part2[4] = {0.f, 0.f, 0.f, 0.f};
        pro1_len<CTX>(c, c0, HM + 2048 * 64, WSP(float, WS_HFC), hmT, wo4, part2);
        pro1_reduce(c, part2, red, inv);
        pro1_scale<CTX>(c, c0, WSP(float, WS_HFC), inv);
    }
}

DI void load_row(const float* src, f32x4 (&v)[4], int lane) {
#pragma unroll
    for (int j = 0; j < 4; ++j) v[j] = *(const f32x4*)(src + 256 * j + 4 * lane);
}
DI void norm_row(f32x4 (&v)[4], const float* g, int lane) {
    float s = 0.f;
#pragma unroll
    for (int j = 0; j < 4; ++j) s += (v[j].x * v[j].x + v[j].y * v[j].y) + (v[j].z * v[j].z + v[j].w * v[j].w);
    s = wave_sum(s);
    const float r = 1.0f / sqrtf(s * (1.0f / 1024.0f) + EPS);
#pragma unroll
    for (int j = 0; j < 4; ++j) v[j] = v[j] * r * *(const f32x4*)(g + 256 * j + 4 * lane);
}
DI void mod_row(f32x4 (&v)[4], const float* sh, const float* sc, int lane) {
#pragma unroll
    for (int j = 0; j < 4; ++j) v[j] = v[j] * (*(const f32x4*)(sc + 256 * j + 4 * lane) + 1.0f) + *(const f32x4*)(sh + 256 * j + 4 * lane);
}
DI void store_row_bf16(bf16* dst, const f32x4 (&v)[4], int lane) {
#pragma unroll
    for (int j = 0; j < 4; ++j) { u32x2 w; w.x = cvt_pk_bf16(v[j].x, v[j].y); w.y = cvt_pk_bf16(v[j].z, v[j].w); *(u32x2*)(dst + 256 * j + 4 * lane) = w; }
}
DI int hrow_of(int srow, int kind) {
    if (srow < TC || kind != 1) return srow;
    const int rr = srow - TC, b = rr >> 11, s = rr & (SEQ - 1); return TC + b * SEQ + perm_fwd(s);
}
DI void phase_norm1(const Ctx& c, int l, const float* xl, const float* xc) {
    const float* MOD = WSP(float, WS_MOD) + (size_t)l * 9 * 6144; const float* g = c.in[I_N1G] + l * D; bf16* H = WSP(bf16, WS_H);
    for (int row = c.gw; row < TT; row += c.ngw) {
        f32x4 v[4]; const int mr = row < TC ? 8 : (row - TC) >> 11;
        load_row(row < TC ? xc + (size_t)row * D : xl + (size_t)(row - TC) * D, v, c.lane);
        norm_row(v, g, c.lane); mod_row(v, MOD + mr * 6144, MOD + mr * 6144 + 1024, c.lane);
        store_row_bf16(H + (size_t)hrow_of(row, l % 3) * D, v, c.lane);
    }
}

DI void phase_conv(const Ctx& c, int ncols, const float* cw, const float* cb, bool act, float qs) {
    const bf16* P = WSP(bf16, WS_P); bf16* PC = WSP(bf16, WS_BIG + BIG_PC);
    const int ng = ncols / 8; const long total = (long)TT * ng;
    for (long idx = (long)blockIdx.x * 512 + c.tid; idx < total; idx += (long)gridDim.x * 512) {
        const int row = (int)(idx / ng), col = (int)(idx % ng) * 8; int lo, hi; seq_bounds(row, lo, hi);
        float x0[8], xm[8], xp[8];
        unpack8(*(const u32x4*)(P + (size_t)row * PLD + col), x0);
        if (row > lo) unpack8(*(const u32x4*)(P + (size_t)(row - 1) * PLD + col), xm); else {
#pragma unroll
            for (int j = 0; j < 8; ++j) xm[j] = 0.f; }
        if (row < hi) unpack8(*(const u32x4*)(P + (size_t)(row + 1) * PLD + col), xp); else {
#pragma unroll
            for (int j = 0; j < 8; ++j) xp[j] = 0.f; }
        float o[8];
#pragma unroll
        for (int j = 0; j < 8; ++j) { float v = cw[col + j] * xm[j] + cw[ncols + col + j] * x0[j] + cw[2 * ncols + col + j] * xp[j] + cb[col + j];
            if (act) v = siluf_(v); if (col < 512) v *= qs; o[j] = v; }
        *(u32x4*)(PC + (size_t)row * ncols + col) = pack8(o);
    }
}

DI int scan_row(int step, int b, int dir) {
    if (step < CTX) return b * CTX + (dir ? CTX - 1 - step : step);
    const int s = step - CTX; return TC + b * SEQ + (dir ? SEQ - 1 - s : s);
}
DI void phase_mlstm_scan_naive(const Ctx& c) {
    const bf16* P = WSP(bf16, WS_P); const bf16* PC = WSP(bf16, WS_BIG + BIG_PC); const float* EX = WSP(float, WS_EXTRA);
    LAS float* qs = (LAS float*)c.lds; LAS float* ks = qs + 32 * 64; LAS float* vs = ks + 32 * 64; LAS float* gs = vs + 32 * 128;
    const int v = c.tid >> 2, d0 = (c.tid & 3) * 16;
    for (int item = blockIdx.x; item < 128; item += gridDim.x) {
        const int b = item >> 4, h = (item >> 1) & 7, dir = item & 1;
        float* Yo = WSP(float, WS_BIG + (dir ? BIG_YB : BIG_YF));
        float C[16], n[16];
#pragma unroll
        for (int d = 0; d < 16; ++d) { C[d] = 0.f; n[d] = 0.f; }
        for (int ch = 0; ch < (CTX + SEQ) / 32; ++ch) {
            __syncthreads();
            for (int idx = c.tid; idx < 32 * 256; idx += 512) { const int st = idx >> 8, col = idx & 255, row = scan_row(ch * 32 + st, b, dir);
                if (col < 64) qs[st * 64 + col] = bf2f(PC[(size_t)row * 1024 + h * 64 + col]);
                else if (col < 128) ks[st * 64 + col - 64] = bf2f(PC[(size_t)row * 1024 + 512 + h * 64 + col - 64]);
                else vs[st * 128 + col - 128] = bf2f(P[(size_t)row * PLD + 1024 + h * 128 + col - 128]); }
            if (c.tid < 32) { const int row = scan_row(ch * 32 + c.tid, b, dir); gs[c.tid * 2] = sigmoidf_(EX[(size_t)row * 32 + dir * 16 + 8 + h]); gs[c.tid * 2 + 1] = __expf(EX[(size_t)row * 32 + dir * 16 + h]); }
            __syncthreads();
            for (int st = 0; st < 32; ++st) {
                const float f = gs[st * 2], ei = gs[st * 2 + 1], vv = vs[st * 128 + v] * ei;
                float part = 0.f, dpart = 0.f;
#pragma unroll
                for (int d = 0; d < 16; ++d) { const float kd = ks[st * 64 + d0 + d], qd = qs[st * 64 + d0 + d];
                    C[d] = f * C[d] + kd * vv; part += qd * C[d]; n[d] = f * n[d] + ei * kd; dpart += qd * n[d]; }
                part += __shfl_xor(part, 1); part += __shfl_xor(part, 2); dpart += __shfl_xor(dpart, 1); dpart += __shfl_xor(dpart, 2);
                if ((c.tid & 3) == 0) { const int row = scan_row(ch * 32 + st, b, dir); Yo[(size_t)row * D + h * 128 + v] = part / fmaxf(fabsf(dpart), 1.0f); }
            }
        }
    }
}
typedef short s16x4 __attribute__((ext_vector_type(4)));
typedef float f32x16 __attribute__((ext_vector_type(16)));
#define MFMA32(a, b, c) __builtin_amdgcn_mfma_f32_32x32x16_bf16((a), (b), (c), 0, 0, 0)
DI int crow(int reg, int h) { return (reg & 3) + 8 * (reg >> 2) + 4 * h; }
DI s16x4 ds_tr(const LAS unsigned char* p) { return __builtin_amdgcn_ds_read_tr16_b64_v4i16((LAS s16x4*)p); }
DI bf16x8 cat8(s16x4 lo, s16x4 hi) { return __builtin_shufflevector(lo, hi, 0, 1, 2, 3, 4, 5, 6, 7); }
DI bf16x8 tr_frag(const LAS unsigned char* img, int pitch, int k0, int n0, int lane) {
    const int h = lane >> 5, g16 = (lane >> 4) & 1, i = lane & 15;
    const LAS unsigned char* p = img + (k0 + 8 * h + (i >> 2)) * pitch + (n0 + 16 * g16 + 4 * (i & 3)) * 2;
    return cat8(ds_tr(p), ds_tr(p + 4 * pitch));
}
DI bf16x8 tr_frag_perm(const LAS unsigned char* img, int pitch, int k0, int n0, int lane) {
    const int h = lane >> 5, g16 = (lane >> 4) & 1, i = lane & 15;
    const LAS unsigned char* p = img + (k0 + 4 * h + (i >> 2)) * pitch + (n0 + 16 * g16 + 4 * (i & 3)) * 2;
    return cat8(ds_tr(p), ds_tr(p + 8 * pitch));
}
DI bf16x8 row_frag(const LAS unsigned char* img, int pitch, int row0, int k0, int lane) { return *(const LAS bf16x8*)(img + (row0 + (lane & 31)) * pitch + (k0 + 8 * (lane >> 5)) * 2); }
DI bf16x8 pack_acc(const f32x16& x, int step) {
    u32x4 p; const int o = 8 * step;
    p.x = cvt_pk_bf16(x[o], x[o + 1]); p.y = cvt_pk_bf16(x[o + 2], x[o + 3]); p.z = cvt_pk_bf16(x[o + 4], x[o + 5]); p.w = cvt_pk_bf16(x[o + 6], x[o + 7]);
    return __builtin_bit_cast(bf16x8, p);
}
DI f32x16 zero16() { f32x16 z;
#pragma unroll
    for (int i = 0; i < 16; ++i) z[i] = 0.f; return z; }
DI float wave_incl_prefix(float x, int lane) {
#pragma unroll
    for (int o = 1; o < 64; o <<= 1) { const float t = __shfl_up(x, o); if (lane >= o) x += t; }
    return x;
}
DI float wave_incl_suffix(float x, int lane) {
#pragma unroll
    for (int o = 1; o < 64; o <<= 1) { const float t = __shfl_down(x, o); if (lane + o < 64) x += t; }
    return x;
}
DI int chunk_row0(int p, int b, int dir) {
    if (p < 4) return b * CTX + 64 * (dir ? 3 - p : p);
    return TC + b * SEQ + 64 * (dir ? 35 - p : p - 4);
}

DI void phase_mlstm_state(const Ctx& c) {
    const bf16* P = WSP(bf16, WS_P); const bf16* PC = WSP(bf16, WS_BIG + BIG_PC); const float* EX = WSP(float, WS_EXTRA);
    bf16* MCT = WSP(bf16, WS_BIG + BIG_MCT); float* MN = WSP(float, WS_BIG + BIG_MN);
    LAS float* gi = (LAS float*)c.lds; LAS float* ga = gi + 2304; LAS float* wv = ga + 2304; LAS float* dec = wv + 64;
    LAS unsigned char* Kw = c.lds + 20480; LAS unsigned char* Vs = Kw + 64 * 144;
    const int lane = c.lane, wave = c.wave, h5 = lane >> 5, l31 = lane & 31;
    for (int item = blockIdx.x; item < 256; item += gridDim.x) {
        const int b = item >> 5, h = (item >> 2) & 7, dir = (item >> 1) & 1, dvh = item & 1, seq = (b * 8 + h) * 2 + dir;
        __syncthreads();
        for (int idx = c.tid; idx < 2304; idx += 512) { const int row = chunk_row0(idx >> 6, b, dir) + (idx & 63);
            gi[idx] = EX[(size_t)row * 32 + dir * 16 + h]; ga[idx] = logsigf_(EX[(size_t)row * 32 + dir * 16 + 8 + h]); }
        f32x16 acc = zero16(); float nst = 0.f;
        const int dt = wave & 1, vt = (wave >> 1) & 1;
        const int srow = c.tid >> 3, spc = c.tid & 7;
        u32x4 kregA, vregA, kregB, vregB;
#define ML_PREFETCH(p_, kr, vr) do { const int r0_ = chunk_row0((p_), b, dir); \
          kr = *(const u32x4*)(PC + (size_t)(r0_ + srow) * 1024 + 512 + h * 64 + 8 * spc); \
          vr = *(const u32x4*)(P + (size_t)(r0_ + srow) * PLD + 1024 + h * 128 + dvh * 64 + 8 * spc); } while (0)
        ML_PREFETCH(0, kregA, vregA); ML_PREFETCH(1, kregB, vregB);
        __syncthreads();
#define ML_STEP(p, kreg, vreg) do { \
              \
            if (wave < 4) { \
                bf16* dst = MCT + ((size_t)seq * 36 + (p)) * 8192 + (size_t)(dvh * 64 + 32 * vt + l31) * 64 + 32 * dt + 4 * h5; \
                _Pragma("unroll") for (int q = 0; q < 4; ++q) { u32x2 w; w.x = cvt_pk_bf16(acc[4 * q], acc[4 * q + 1]); w.y = cvt_pk_bf16(acc[4 * q + 2], acc[4 * q + 3]); *(u32x2*)(dst + 8 * q) = w; } \
            } else if (wave == 4) { if (dvh == 0) MN[((size_t)seq * 36 + (p)) * 64 + lane] = nst; } \
            else if (wave == 7) { \
                const float a = ga[(p) * 64 + lane]; const float bj = dir ? wave_incl_suffix(a, lane) : wave_incl_prefix(a, lane); \
                const float tot = __shfl(bj, dir ? 0 : 63); \
                wv[lane] = __expf(tot - bj + gi[(p) * 64 + lane]); if (lane == 0) dec[0] = __expf(tot); \
            } \
            lds_barrier(); \
              \
            { float kk[8]; unpack8(kreg, kk); const float w = wv[srow]; \
              _Pragma("unroll") for (int j = 0; j < 8; ++j) kk[j] *= w; \
              *(LAS u32x4*)(Kw + srow * 144 + spc * 16) = pack8(kk); *(LAS u32x4*)(Vs + srow * 144 + spc * 16) = vreg; } \
            if ((p) + 2 < 36) ML_PREFETCH((p) + 2, kreg, vreg); \
            const float d = dec[0];            \
            lds_barrier(); \
              \
            if (wave < 4) { \
                _Pragma("unroll") for (int i = 0; i < 16; ++i) acc[i] *= d; \
                _Pragma("unroll") for (int kk = 0; kk < 4; ++kk) acc = MFMA32(tr_frag(Kw, 144, 16 * kk, 32 * dt, lane), tr_frag(Vs, 144, 16 * kk, 32 * vt, lane), acc); \
            } else if (wave == 4) { \
                float s = 0.f; \
                for (int r = 0; r < 64; ++r) s += bf2f(*(const LAS bf16*)(Kw + r * 144 + lane * 2)); \
                nst = d * nst + s; \
            } } while (0)
        for (int p = 0; p < 36; p += 2) { ML_STEP(p, kregA, vregA); ML_STEP(p + 1, kregB, vregB); }
#undef ML_STEP
#undef ML_PREFETCH
    }
}

DI void phase_mlstm_out(const Ctx& c, const float* ng) {
    const bf16* P = WSP(bf16, WS_P); const bf16* PC = WSP(bf16, WS_BIG + BIG_PC); const float* EX = WSP(float, WS_EXTRA);
    const bf16* MCT = WSP(bf16, WS_BIG + BIG_MCT); const float* MN = WSP(float, WS_BIG + BIG_MN); bf16* Y = WSP(bf16, WS_Y);
    LAS unsigned char* Qs = c.lds; LAS unsigned char* Ks = Qs + 9216; LAS unsigned char* Vs = Ks + 9216;
    LAS unsigned char* CT0 = Vs + 17408;
    LAS float* gt = (LAS float*)(c.lds + MISC_OFF + 1024);
    LAS float* YO = (LAS float*)c.lds;
    const int lane = c.lane, wave = c.wave, h5 = lane >> 5, l31 = lane & 31;
    const int dir = wave >> 2, jt = (wave >> 1) & 1, vh = wave & 1;
    for (int item = blockIdx.x; item < 2304; item += gridDim.x) {
        const int b = item / 288, h = (item / 36) & 7, cc = item % 36;
        const int r0 = cc < 4 ? b * CTX + 64 * cc : TC + b * SEQ + 64 * (cc - 4);
        const int pf = cc, pb = cc < 4 ? 3 - cc : 39 - cc;
        __syncthreads();
        { const int srow = c.tid >> 3, spc = c.tid & 7;
          *(LAS u32x4*)(Qs + srow * 144 + spc * 16) = *(const u32x4*)(PC + (size_t)(r0 + srow) * 1024 + h * 64 + 8 * spc);
          *(LAS u32x4*)(Ks + srow * 144 + spc * 16) = *(const u32x4*)(PC + (size_t)(r0 + srow) * 1024 + 512 + h * 64 + 8 * spc);
#pragma unroll
          for (int i = 0; i < 2; ++i) *(LAS u32x4*)(Vs + srow * 272 + (spc + 8 * i) * 16) = *(const u32x4*)(P + (size_t)(r0 + srow) * PLD + 1024 + h * 128 + 8 * (spc + 8 * i));
#pragma unroll
          for (int i = 0; i < 4; ++i) { const int pc = c.tid + 512 * i, d2 = pc >> 10, rr = (pc >> 3) & 127, sp = pc & 7;
              const size_t so = (((size_t)((b * 8 + h) * 2 + d2)) * 36 + (d2 ? pb : pf)) * 8192;
              *(LAS u32x4*)(CT0 + d2 * 18432 + rr * 144 + sp * 16) = *(const u32x4*)(MCT + so + rr * 64 + 8 * sp); }
          if (wave < 2) { const int d2 = wave; const int row = r0 + lane;
              const float a = logsigf_(EX[(size_t)row * 32 + d2 * 16 + 8 + h]), ig = EX[(size_t)row * 32 + d2 * 16 + h];
              const float bj = d2 ? wave_incl_suffix(a, lane) : wave_incl_prefix(a, lane);
              gt[d2 * 192 + lane] = bj; gt[d2 * 192 + 64 + lane] = ig - bj;
              gt[d2 * 192 + 128 + lane] = MN[(((size_t)((b * 8 + h) * 2 + d2)) * 36 + (d2 ? pb : pf)) * 64 + lane]; } }
        __syncthreads();
        const LAS float* g = gt + dir * 192; const LAS unsigned char* CT = CT0 + dir * 18432;
        const int j = 32 * jt + l31; const float bjj = g[j];
        bf16x8 qf[4];
#pragma unroll
        for (int kk = 0; kk < 4; ++kk) qf[kk] = row_frag(Qs, 144, 32 * jt, 16 * kk, lane);
        float qn = 0.f;
#pragma unroll
        for (int kk = 0; kk < 4; ++kk) { float qv[8]; unpack8(__builtin_bit_cast(u32x4, qf[kk]), qv);
#pragma unroll
            for (int e = 0; e < 8; ++e) qn += qv[e] * g[128 + 16 * kk + 8 * h5 + e]; }
        qn += __shfl_xor(qn, 32);
        f32x16 X[2]; float den = 0.f;
#pragma unroll
        for (int st = 0; st < 2; ++st) {
            X[st] = zero16();
            const bool live = dir ? (st >= jt) : (st <= jt);
            if (live) {
#pragma unroll
                for (int kk = 0; kk < 4; ++kk) X[st] = MFMA32(row_frag(Ks, 144, 32 * st, 16 * kk, lane), qf[kk], X[st]);
#pragma unroll
                for (int r = 0; r < 16; ++r) { const int s = 32 * st + crow(r, h5); const bool ok = dir ? (s >= j) : (s <= j);
                    const float w = ok ? __expf(bjj + g[64 + s]) : 0.f; X[st][r] *= w; den += X[st][r]; }
            }
        }
        den += __shfl_xor(den, 32);
        const float eb = __expf(bjj); den += eb * qn;
        const float scale = 1.0f / fmaxf(fabsf(den), 1.0f);
        f32x16 O[2];
#pragma unroll
        for (int t = 0; t < 2; ++t) {
            const int vt = 2 * vh + t; f32x16 z = zero16(), w = zero16();
#pragma unroll
            for (int st = 0; st < 2; ++st) { const bool live = dir ? (st >= jt) : (st <= jt);
                if (live) {
#pragma unroll
                    for (int step = 0; step < 2; ++step) z = MFMA32(tr_frag_perm(Vs, 272, 32 * st + 16 * step, 32 * vt, lane), pack_acc(X[st], step), z); } }
#pragma unroll
            for (int kk = 0; kk < 4; ++kk) w = MFMA32(row_frag(CT, 144, 32 * vt, 16 * kk, lane), qf[kk], w);
#pragma unroll
            for (int r = 0; r < 16; ++r) O[t][r] = (z[r] + eb * w[r]) * scale;
        }
        __syncthreads();
#pragma unroll
        for (int t = 0; t < 2; ++t) { const int vt = 2 * vh + t;
#pragma unroll
            for (int q = 0; q < 4; ++q) *(LAS f32x4*)(YO + dir * 8448 + j * 132 + 32 * vt + 8 * q + 4 * h5) = (f32x4){O[t][4 * q], O[t][4 * q + 1], O[t][4 * q + 2], O[t][4 * q + 3]}; }
        __syncthreads();
        { const int row = c.tid >> 3, c0 = (c.tid & 7) * 16; float y[16]; float ss = 0.f;
#pragma unroll
          for (int q = 0; q < 4; ++q) { const f32x4 a = *(const LAS f32x4*)(YO + row * 132 + c0 + 4 * q), bb = *(const LAS f32x4*)(YO + 8448 + row * 132 + c0 + 4 * q);
              y[4 * q] = a.x + bb.x; y[4 * q + 1] = a.y + bb.y; y[4 * q + 2] = a.z + bb.z; y[4 * q + 3] = a.w + bb.w; }
#pragma unroll
          for (int q = 0; q < 16; ++q) ss += y[q] * y[q];
          ss += __shfl_xor(ss, 1); ss += __shfl_xor(ss, 2); ss += __shfl_xor(ss, 4);
          const float r = 1.0f / sqrtf(ss * (1.0f / 128.0f) + EPS);
          float g0[8], g1[8];
          unpack8(*(const u32x4*)(P + (size_t)(r0 + row) * PLD + 2048 + h * 128 + c0), g0); unpack8(*(const u32x4*)(P + (size_t)(r0 + row) * PLD + 2048 + h * 128 + c0 + 8), g1);
          float o0[8], o1[8];
#pragma unroll
          for (int q = 0; q < 8; ++q) { o0[q] = y[q] * r * ng[h * 128 + c0 + q] * sigmoidf_(g0[q]); o1[q] = y[8 + q] * r * ng[h * 128 + c0 + 8 + q] * sigmoidf_(g1[q]); }
          *(u32x4*)(Y + (size_t)(r0 + row) * D + h * 128 + c0) = pack8(o0); *(u32x4*)(Y + (size_t)(r0 + row) * D + h * 128 + c0 + 8) = pack8(o1); }
    }
}

DI void phase_gla_decay(const Ctx& c) {
    const float* EX = WSP(float, WS_EXTRA); float* GB = WSP(float, WS_BIG + BIG_GB);
    LAS float* w2s = (LAS float*)c.lds; LAS float* gbs = w2s + 2048; LAS float* lgs = gbs + 128; LAS float* segs = lgs + 8192;
    const int srow = c.tid >> 3, dg = c.tid & 7;
    for (int item = blockIdx.x; item < 288 * 8; item += gridDim.x) {
        const int ck = item >> 3, dir = (item >> 2) & 1, h = item & 3, r0 = 64 * ck;
        __syncthreads();
        for (int i = c.tid; i < 2048; i += 512) w2s[i] = c.in[I_GLW2][(size_t)dir * 8192 + (i >> 7) * 512 + h * 128 + (i & 127)];
        if (c.tid < 128) gbs[c.tid] = c.in[I_GLGB][dir * 512 + h * 128 + c.tid];
        f32x4 low[4];
#pragma unroll
        for (int q = 0; q < 4; ++q) low[q] = *(const f32x4*)(EX + (size_t)(r0 + srow) * 32 + dir * 16 + 4 * q);
        __syncthreads();
        { const int d0 = 16 * dg; float pre[16];
#pragma unroll
          for (int e = 0; e < 16; ++e) pre[e] = gbs[d0 + e];
#pragma unroll
          for (int r = 0; r < 16; ++r) { const float lv = low[r >> 2][r & 3];
#pragma unroll
              for (int q = 0; q < 4; ++q) { const f32x4 w = *(const LAS f32x4*)(w2s + r * 128 + d0 + 4 * q); pre[4 * q] += lv * w.x; pre[4 * q + 1] += lv * w.y; pre[4 * q + 2] += lv * w.z; pre[4 * q + 3] += lv * w.w; } }
#pragma unroll
          for (int q = 0; q < 4; ++q) *(LAS f32x4*)(lgs + srow * 128 + d0 + 4 * q) = (f32x4){logsigf_(pre[4 * q]) * 0.0625f, logsigf_(pre[4 * q + 1]) * 0.0625f, logsigf_(pre[4 * q + 2]) * 0.0625f, logsigf_(pre[4 * q + 3]) * 0.0625f}; }
        __syncthreads();
        { const int d = c.tid & 127, sg = c.tid >> 7; float v[16];
#pragma unroll
          for (int i = 0; i < 16; ++i) { const int s = dir ? 63 - (16 * sg + i) : 16 * sg + i; v[i] = lgs[s * 128 + d]; }
#pragma unroll
          for (int i = 1; i < 16; ++i) v[i] += v[i - 1];
          segs[sg * 128 + d] = v[15];
          __syncthreads();
          float off = 0.f;
#pragma unroll
          for (int g2 = 0; g2 < 3; ++g2) off += (g2 < sg) ? segs[g2 * 128 + d] : 0.f;
#pragma unroll
          for (int i = 0; i < 16; ++i) { const int s = dir ? 63 - (16 * sg + i) : 16 * sg + i; GB[((size_t)dir * TT + r0 + s) * 512 + h * 128 + d] = v[i] + off; } }
    }
}
DI void phase_gla_state(const Ctx& c) {
    const bf16* PC = WSP(bf16, WS_BIG + BIG_PC); const float* GB = WSP(float, WS_BIG + BIG_GB); bf16* GST = WSP(bf16, WS_BIG + BIG_GST);
    LAS float* tot = (LAS float*)c.lds;
    LAS unsigned char* Kd = c.lds + 1024; LAS unsigned char* Vs = Kd + 64 * 272;
    const int lane = c.lane, wave = c.wave, h5 = lane >> 5, l31 = lane & 31, dkt = wave & 3, dvt = wave >> 2;
    const int srow = c.tid >> 3, dg = c.tid & 7;
    for (int item = blockIdx.x; item < 256; item += gridDim.x) {
        const int b = item >> 5, h = (item >> 3) & 3, dir = (item >> 2) & 1, dvq = item & 3, seq = (b * 4 + h) * 2 + dir;
        f32x16 acc = zero16();
        u32x4 kA0, kA1, vA, kB0, kB1, vB; f32x4 bvA[4], tvA[4], bvB[4], tvB[4];
#define GLA_PREFETCH(p_, k0, k1, vr, bv, tv) do { const int r0_ = chunk_row0((p_), b, dir), row = r0_ + srow; \
          k0 = *(const u32x4*)(PC + (size_t)row * 2048 + 512 + h * 128 + 16 * dg); k1 = *(const u32x4*)(PC + (size_t)row * 2048 + 512 + h * 128 + 16 * dg + 8); \
          vr = *(const u32x4*)(PC + (size_t)row * 2048 + 1024 + h * 256 + dvq * 64 + 8 * dg); \
          _Pragma("unroll") for (int q = 0; q < 4; ++q) { bv[q] = *(const f32x4*)(GB + ((size_t)dir * TT + row) * 512 + h * 128 + 16 * dg + 4 * q); \
              tv[q] = *(const f32x4*)(GB + ((size_t)dir * TT + r0_ + (dir ? 0 : 63)) * 512 + h * 128 + 16 * dg + 4 * q); } } while (0)
        GLA_PREFETCH(0, kA0, kA1, vA, bvA, tvA); GLA_PREFETCH(1, kB0, kB1, vB, bvB, tvB);
#define GLA_STEP(p, k0r, k1r, vr, bv, tv) do { \
            { bf16* dst = GST + ((size_t)seq * 36 + (p)) * 32768 + (size_t)(dvq * 64 + 32 * dvt + l31) * 128 + 32 * dkt + 4 * h5; \
              _Pragma("unroll") for (int q = 0; q < 4; ++q) { u32x2 w; w.x = cvt_pk_bf16(acc[4 * q], acc[4 * q + 1]); w.y = cvt_pk_bf16(acc[4 * q + 2], acc[4 * q + 3]); *(u32x2*)(dst + 8 * q) = w; } } \
            lds_barrier();                                    \
            { float kk[16]; { float t8[8]; unpack8(k0r, t8); \
                _Pragma("unroll") for (int e = 0; e < 8; ++e) kk[e] = t8[e]; unpack8(k1r, t8); \
                _Pragma("unroll") for (int e = 0; e < 8; ++e) kk[8 + e] = t8[e]; } \
              _Pragma("unroll") for (int e = 0; e < 16; ++e) kk[e] *= __expf(tv[e >> 2][e & 3] - bv[e >> 2][e & 3]); \
              const float k0[8] = {kk[0], kk[1], kk[2], kk[3], kk[4], kk[5], kk[6], kk[7]}, k1[8] = {kk[8], kk[9], kk[10], kk[11], kk[12], kk[13], kk[14], kk[15]}; \
              *(LAS u32x4*)(Kd + srow * 272 + dg * 32) = pack8(k0); *(LAS u32x4*)(Kd + srow * 272 + dg * 32 + 16) = pack8(k1); \
              *(LAS u32x4*)(Vs + srow * 144 + dg * 16) = vr; \
              if (srow == 0) { \
                  _Pragma("unroll") for (int q = 0; q < 4; ++q) *(LAS f32x4*)(tot + 16 * dg + 4 * q) = tv[q]; } } \
            if ((p) + 2 < 36) GLA_PREFETCH((p) + 2, k0r, k1r, vr, bv, tv); \
            lds_barrier(); \
            _Pragma("unroll") for (int r = 0; r < 16; ++r) acc[r] *= __expf(tot[32 * dkt + crow(r, h5)]); \
            _Pragma("unroll") for (int kk = 0; kk < 4; ++kk) acc = MFMA32(tr_frag(Kd, 272, 16 * kk, 32 * dkt, lane), tr_frag(Vs, 144, 16 * kk, 32 * dvt, lane), acc); \
            } while (0)
        for (int p = 0; p < 36; p += 2) { GLA_STEP(p, kA0, kA1, vA, bvA, tvA); GLA_STEP(p + 1, kB0, kB1, vB, bvB, tvB); }
#undef GLA_STEP
#undef GLA_PREFETCH
    }
}
DI void phase_gla_out(const Ctx& c, const float* ng) {
    const bf16* P = WSP(bf16, WS_P); const bf16* PC = WSP(bf16, WS_BIG + BIG_PC); const float* GB = WSP(float, WS_BIG + BIG_GB);
    const bf16* GST = WSP(bf16, WS_BIG + BIG_GST); bf16* Y = WSP(bf16, WS_Y);
    LAS unsigned char* Qt = c.lds; LAS unsigned char* Kt = Qt + 17408; LAS unsigned char* Vs = Kt + 17408; LAS unsigned char* STs = Vs + 33792;
    LAS float* YO = (LAS float*)STs;
    const int lane = c.lane, wave = c.wave, h5 = lane >> 5, l31 = lane & 31;
    const int srow = c.tid >> 3, dg = c.tid & 7;
    for (int item = blockIdx.x; item < 1152; item += gridDim.x) {
        const int b = item / 144, h = (item / 36) & 3, cc = item % 36;
        const int r0 = cc < 4 ? b * CTX + 64 * cc : TC + b * SEQ + 64 * (cc - 4);
        __syncthreads();
#pragma unroll
        for (int i = 0; i < 4; ++i) { const int pc = dg + 8 * i; *(LAS u32x4*)(Vs + srow * 528 + pc * 16) = *(const u32x4*)(PC + (size_t)(r0 + srow) * 2048 + 1024 + h * 256 + 8 * pc); }
        f32x16 O[2]; O[0] = zero16(); O[1] = zero16();
        for (int dir = 0; dir < 2; ++dir) {
            const int pslot = dir ? (cc < 4 ? 3 - cc : 39 - cc) : cc;
            if (dir) __syncthreads();
            { const bf16* src = GST + ((size_t)((b * 4 + h) * 2 + dir) * 36 + pslot) * 32768;
#pragma unroll
              for (int i = 0; i < 8; ++i) { const int pc = c.tid + 512 * i, rr = pc >> 4, sp = pc & 15; *(LAS u32x4*)(STs + rr * 272 + sp * 16) = *(const u32x4*)(src + rr * 128 + 8 * sp); } }
            { float qq[16], kk[16], bb[16]; float t8[8];
#pragma unroll
              for (int q = 0; q < 4; ++q) { const f32x4 t4 = *(const f32x4*)(GB + ((size_t)dir * TT + r0 + srow) * 512 + h * 128 + 16 * dg + 4 * q); bb[4 * q] = t4.x; bb[4 * q + 1] = t4.y; bb[4 * q + 2] = t4.z; bb[4 * q + 3] = t4.w; }
              unpack8(*(const u32x4*)(PC + (size_t)(r0 + srow) * 2048 + h * 128 + 16 * dg), t8);
#pragma unroll
              for (int e = 0; e < 8; ++e) qq[e] = t8[e];
              unpack8(*(const u32x4*)(PC + (size_t)(r0 + srow) * 2048 + h * 128 + 16 * dg + 8), t8);
#pragma unroll
              for (int e = 0; e < 8; ++e) qq[8 + e] = t8[e];
              unpack8(*(const u32x4*)(PC + (size_t)(r0 + srow) * 2048 + 512 + h * 128 + 16 * dg), t8);
#pragma unroll
              for (int e = 0; e < 8; ++e) kk[e] = t8[e];
              unpack8(*(const u32x4*)(PC + (size_t)(r0 + srow) * 2048 + 512 + h * 128 + 16 * dg + 8), t8);
#pragma unroll
              for (int e = 0; e < 8; ++e) kk[8 + e] = t8[e];
#pragma unroll
              for (int e = 0; e < 16; ++e) { const float eb = __expf(bb[e]); qq[e] *= eb; kk[e] *= 1.0f / eb; }
              const float q0[8] = {qq[0], qq[1], qq[2], qq[3], qq[4], qq[5], qq[6], qq[7]}, q1[8] = {qq[8], qq[9], qq[10], qq[11], qq[12], qq[13], qq[14], qq[15]};
              const float k0[8] = {kk[0], kk[1], kk[2], kk[3], kk[4], kk[5], kk[6], kk[7]}, k1[8] = {kk[8], kk[9], kk[10], kk[11], kk[12], kk[13], kk[14], kk[15]};
              *(LAS u32x4*)(Qt + srow * 272 + dg * 32) = pack8(q0); *(LAS u32x4*)(Qt + srow * 272 + dg * 32 + 16) = pack8(q1);
              *(LAS u32x4*)(Kt + srow * 272 + dg * 32) = pack8(k0); *(LAS u32x4*)(Kt + srow * 272 + dg * 32 + 16) = pack8(k1); }
            __syncthreads();
#pragma unroll
            for (int jt = 0; jt < 2; ++jt) {
#pragma unroll
                for (int st = 0; st < 2; ++st) {
                    const bool live = dir ? (st >= jt) : (st <= jt);
                    if (live) {
                        f32x16 X = zero16();
#pragma unroll
                        for (int kk = 0; kk < 8; ++kk) X = MFMA32(row_frag(Kt, 272, 32 * st, 16 * kk, lane), row_frag(Qt, 272, 32 * jt, 16 * kk, lane), X);
                        if (st == jt) {
#pragma unroll
                            for (int r = 0; r < 16; ++r) { const int s = crow(r, h5); const bool ok = dir ? (s >= l31) : (s <= l31); X[r] = ok ? X[r] : 0.f; } }
#pragma unroll
                        for (int step = 0; step < 2; ++step) O[jt] = MFMA32(tr_frag_perm(Vs, 528, 32 * st + 16 * step, 32 * wave, lane), pack_acc(X, step), O[jt]);
                    }
                }
#pragma unroll
                for (int kk = 0; kk < 8; ++kk) O[jt] = MFMA32(row_frag(STs, 272, 32 * wave, 16 * kk, lane), row_frag(Qt, 272, 32 * jt, 16 * kk, lane), O[jt]);
            }
        }
        __syncthreads();
#pragma unroll
        for (int jt = 0; jt < 2; ++jt)
#pragma unroll
            for (int q = 0; q < 4; ++q) *(LAS f32x4*)(YO + (32 * jt + l31) * 260 + 32 * wave + 8 * q + 4 * h5) = (f32x4){O[jt][4 * q], O[jt][4 * q + 1], O[jt][4 * q + 2], O[jt][4 * q + 3]};
        __syncthreads();
        { const int c0 = dg * 32; float y[32]; float ss = 0.f;
#pragma unroll
          for (int q = 0; q < 8; ++q) { const f32x4 a = *(const LAS f32x4*)(YO + srow * 260 + c0 + 4 * q); y[4 * q] = a.x; y[4 * q + 1] = a.y; y[4 * q + 2] = a.z; y[4 * q + 3] = a.w; }
#pragma unroll
          for (int q = 0; q < 32; ++q) ss += y[q] * y[q];
          ss += __shfl_xor(ss, 1); ss += __shfl_xor(ss, 2); ss += __shfl_xor(ss, 4);
          const float r = 1.0f / sqrtf(ss * (1.0f / 256.0f) + EPS);
#pragma unroll
          for (int q = 0; q < 4; ++q) { float g8[8], o8[8]; unpack8(*(const u32x4*)(P + (size_t)(r0 + srow) * PLD + 2048 + h * 256 + c0 + 8 * q), g8);
#pragma unroll
              for (int e = 0; e < 8; ++e) o8[e] = y[8 * q + e] * r * ng[h * 256 + c0 + 8 * q + e] * siluf_(g8[e]);
              *(u32x4*)(Y + (size_t)(r0 + srow) * D + h * 256 + c0 + 8 * q) = pack8(o8); } }
    }
}

DI void phase_gla_scan_naive(const Ctx& c) {
    const bf16* PC = WSP(bf16, WS_BIG + BIG_PC); const float* EX = WSP(float, WS_EXTRA);
    LAS float* qs = (LAS float*)c.lds; LAS float* ks = qs + 16 * 128; LAS float* as = ks + 16 * 128; LAS float* vs = as + 16 * 128; LAS float* lw = vs + 16 * 256;
    const int v = c.tid >> 1, d0 = (c.tid & 1) * 64;
    for (int item = blockIdx.x; item < 64; item += gridDim.x) {
        const int b = item >> 3, h = (item >> 1) & 3, dir = item & 1;
        float* Yo = WSP(float, WS_BIG + (dir ? BIG_YB : BIG_YF));
        const float* w2 = c.in[I_GLW2] + (size_t)dir * 16 * 512 + h * 128; const float* gb = c.in[I_GLGB] + dir * 512 + h * 128;
        float S[64];
#pragma unroll
        for (int d = 0; d < 64; ++d) S[d] = 0.f;
        for (int ch = 0; ch < (CTX + SEQ) / 16; ++ch) {
            __syncthreads();
            if (c.tid < 256) { const int st = c.tid >> 4, r = c.tid & 15, row = scan_row(ch * 16 + st, b, dir); lw[c.tid] = EX[(size_t)row * 32 + dir * 16 + r]; }
            for (int idx = c.tid; idx < 16 * 512; idx += 512) { const int st = idx >> 9, col = idx & 511, row = scan_row(ch * 16 + st, b, dir);
                if (col < 128) qs[st * 128 + col] = bf2f(PC[(size_t)row * 2048 + h * 128 + col]);
                else if (col < 256) ks[st * 128 + col - 128] = bf2f(PC[(size_t)row * 2048 + 512 + h * 128 + col - 128]);
                else vs[st * 256 + col - 256] = bf2f(PC[(size_t)row * 2048 + 1024 + h * 256 + col - 256]); }
            __syncthreads();
            for (int idx = c.tid; idx < 16 * 128; idx += 512) { const int st = idx >> 7, d = idx & 127; float pre = gb[d];
#pragma unroll
                for (int r = 0; r < 16; ++r) pre += lw[st * 16 + r] * w2[r * 512 + d];
                as[idx] = __expf(logsigf_(pre) * (1.0f / 16.0f)); }
            __syncthreads();
            for (int st = 0; st < 16; ++st) {
                const float vv = vs[st * 256 + v]; float part = 0.f;
#pragma unroll
                for (int d = 0; d < 64; ++d) { S[d] = as[st * 128 + d0 + d] * S[d] + ks[st * 128 + d0 + d] * vv; part += qs[st * 128 + d0 + d] * S[d]; }
                part += __shfl_xor(part, 1);
                if ((c.tid & 1) == 0) { const int row = scan_row(ch * 16 + st, b, dir); Yo[(size_t)row * D + h * 256 + v] = part; }
            }
        }
    }
}
DI void phase_headnorm(const Ctx& c, int hd, const float* ng) {
    const float* YF = WSP(float, WS_BIG + BIG_YF); const float* YB = WSP(float, WS_BIG + BIG_YB); const bf16* P = WSP(bf16, WS_P); bf16* Y = WSP(bf16, WS_Y);
    for (int row = c.gw; row < TT; row += c.ngw) {
        const int c0 = 16 * c.lane; float y[16]; float ss = 0.f;
#pragma unroll
        for (int j = 0; j < 4; ++j) { const f32x4 a = *(const f32x4*)(YF + (size_t)row * D + c0 + 4 * j), bb = *(const f32x4*)(YB + (size_t)row * D + c0 + 4 * j);
            y[4 * j] = a.x + bb.x; y[4 * j + 1] = a.y + bb.y; y[4 * j + 2] = a.z + bb.z; y[4 * j + 3] = a.w + bb.w; }
#pragma unroll
        for (int j = 0; j < 16; ++j) ss += y[j] * y[j];
        ss += __shfl_xor(ss, 1); ss += __shfl_xor(ss, 2); ss += __shfl_xor(ss, 4); if (hd == 256) ss += __shfl_xor(ss, 8);
        const float r = 1.0f / sqrtf(ss / (float)hd + EPS);
        float g0[8], g1[8];
        unpack8(*(const u32x4*)(P + (size_t)row * PLD + 2048 + c0), g0); unpack8(*(const u32x4*)(P + (size_t)row * PLD + 2048 + c0 + 8), g1);
        float o[16];
#pragma unroll
        for (int j = 0; j < 16; ++j) { const float gp = j < 8 ? g0[j] : g1[j - 8]; o[j] = y[j] * r * ng[c0 + j] * (hd == 128 ? sigmoidf_(gp) : siluf_(gp)); }
        const float o0[8] = {o[0], o[1], o[2], o[3], o[4], o[5], o[6], o[7]}, o1[8] = {o[8], o[9], o[10], o[11], o[12], o[13], o[14], o[15]};
        *(u32x4*)(Y + (size_t)row * D + c0) = pack8(o0); *(u32x4*)(Y + (size_t)row * D + c0 + 8) = pack8(o1);
    }
}
DI void phase_hyena_conv_naive(const Ctx& c) {
    const bf16* PC = WSP(bf16, WS_BIG + BIG_PC); bf16* Y = WSP(bf16, WS_Y); const float* skip = c.in[I_HYSKIP];
    LAS float* zt = (LAS float*)c.lds;
    LAS float* ft = zt + 4096;
    const int cc = c.tid & 63, tg = c.tid >> 6;
    for (int item = blockIdx.x; item < 4096 + 512; item += gridDim.x) {
        int L, rb, tt, cgi; const float* tab;
        if (item < 4096) { L = SEQ; const int b = item >> 9; tt = (item >> 4) & 31; cgi = item & 15; rb = TC + b * SEQ; tab = WSP(float, WS_HF); }
        else { const int it = item - 4096; L = CTX; const int b = it >> 6; tt = (it >> 4) & 3; cgi = it & 15; rb = b * CTX; tab = WSP(float, WS_HFC); }
        const int t0 = 64 * tt, c0 = 64 * cgi;
        float acc[8];
#pragma unroll
        for (int i = 0; i < 8; ++i) acc[i] = 0.f;
        for (int sb = 0; sb < L / 64; ++sb) {
            const int s0 = 64 * sb;
            __syncthreads();
            for (int idx = c.tid; idx < 4096; idx += 512) { const int sl = idx >> 6, ch = idx & 63; const size_t o = (size_t)(rb + s0 + sl) * PLD + c0 + ch;
                zt[idx] = bf2f(PC[o + 1024]) * bf2f(PC[o + 2048]); }
            for (int idx = c.tid; idx < 64 * 128; idx += 512) { const int ch = idx >> 7, j = idx & 127;
                if (j < 127) ft[j * 65 + ch] = tab[(size_t)(c0 + ch) * (2 * L) + L + (t0 - s0 - 63 + j)]; }
            __syncthreads();
#pragma unroll 1
            for (int g = 0; g < 8; ++g) {
                float w[15], z[8]; const int base = 8 * (tg - g) + 56;
#pragma unroll
                for (int m = 0; m < 15; ++m) w[m] = ft[(base + m) * 65 + cc];
#pragma unroll
                for (int j = 0; j < 8; ++j) z[j] = zt[(8 * g + j) * 64 + cc];
#pragma unroll
                for (int i = 0; i < 8; ++i)
#pragma unroll
                    for (int j = 0; j < 8; ++j) acc[i] += w[i - j + 7] * z[j];
            }
        }
#pragma unroll
        for (int i = 0; i < 8; ++i) { const int row = rb + t0 + 8 * tg + i; const size_t o = (size_t)row * PLD + c0 + cc;
            const float zin = bf2f(PC[o + 1024]) * bf2f(PC[o + 2048]), x0 = bf2f(PC[o]);
            Y[(size_t)row * D + c0 + cc] = f2bf(x0 * (acc[i] + skip[c0 + cc] * zin)); }
    }
}

DI void hy_item(int item, int& L, int& b, int& t0, int& c0, int& rb) {
    if (item < 4096) { L = SEQ; b = item >> 9; t0 = 64 * ((item >> 4) & 31); c0 = 64 * (item & 15); rb = TC + b * SEQ; }
    else { const int it = item - 4096; L = CTX; b = it >> 6; t0 = 64 * ((it >> 4) & 3); c0 = 64 * (it & 15); rb = b * CTX; }
}
DI void phase_hy_prep(const Ctx& c) {
    const bf16* P = WSP(bf16, WS_P); bf16* X0C = WSP(bf16, WS_BIG + BIG_PC); const float* cw = c.in[I_HYCW]; const float* cb = c.in[I_HYCB];
    LAS unsigned char* raw = c.lds;
    LAS float* zt = (LAS float*)(c.lds + 32768);
    for (int item = blockIdx.x; item < 4608; item += gridDim.x) {
        int L, b, t0, c0, rb; hy_item(item, L, b, t0, c0, rb);
        bf16* ZT = L == SEQ ? WSP(bf16, WS_BIG + BIG_ZTL) : WSP(bf16, WS_BIG + BIG_ZTC);
        __syncthreads();
        for (int pc = c.tid; pc < 3 * 66 * 8; pc += 512) { const int g = pc / 528, rr = (pc % 528) >> 3, sp = pc & 7, t = t0 - 1 + rr;
            u32x4 v = {c.z, c.z, c.z, c.z};
            if (t >= 0 && t < L) v = *(const u32x4*)(P + (size_t)(rb + t) * PLD + g * 1024 + c0 + 8 * sp);
            *(LAS u32x4*)(raw + (g * 66 + rr) * 128 + sp * 16) = v; }
        __syncthreads();
        { const int t = c.tid >> 3, sp = c.tid & 7; float u[3][8];
#pragma unroll
          for (int g = 0; g < 3; ++g) { float xm[8], x0[8], xp[8];
              unpack8(*(const LAS u32x4*)(raw + (g * 66 + t) * 128 + sp * 16), xm); unpack8(*(const LAS u32x4*)(raw + (g * 66 + t + 1) * 128 + sp * 16), x0); unpack8(*(const LAS u32x4*)(raw + (g * 66 + t + 2) * 128 + sp * 16), xp);
              const int col = g * 1024 + c0 + 8 * sp;
#pragma unroll
              for (int e = 0; e < 8; ++e) u[g][e] = cw[col + e] * xm[e] + cw[3072 + col + e] * x0[e] + cw[6144 + col + e] * xp[e] + cb[col + e]; }
          *(u32x4*)(X0C + (size_t)(rb + t0 + t) * 1024 + c0 + 8 * sp) = pack8(u[0]);
#pragma unroll
          for (int e = 0; e < 8; ++e) zt[t * 65 + 8 * sp + e] = u[1][e] * u[2][e]; }
        __syncthreads();
        { const int ch = c.tid >> 3, tp = c.tid & 7; float z[8];
#pragma unroll
          for (int e = 0; e < 8; ++e) z[e] = zt[(8 * tp + e) * 65 + ch];
          *(u32x4*)(ZT + ((size_t)(c0 + ch) * NB + b) * L + t0 + 8 * tp) = pack8(z); }
    }
}
template <int L>
DI void hy_toeplitz_channel(const Ctx& c, const float* hrow  , const bf16* zsrc  , bf16* ydst  ) {
    constexpr int NBK = L / 32, CP = 2 * L + 8, NT = (NBK + 31) / 32;
    LAS unsigned char* F = c.lds;
    LAS unsigned char* Zs = c.lds + 8 * CP * 2;
    const int lane = c.lane, w = c.wave, h5 = lane >> 5, a = lane & 31;
    __syncthreads();
    for (int idx = c.tid; idx < 8 * 2 * L; idx += 512) { const int r = idx / (2 * L), m = idx % (2 * L), y = m + r;
        const float v = (y >= 1 && y <= 2 * L - 1) ? hrow[2 * L - y] : 0.f;
        *(LAS bf16*)(F + (r * CP + m) * 2) = f2bf(v); }
    if (c.tid < 20) *(LAS unsigned*)(Zs + 8 * NBK * 80 + 4 * c.tid) = c.z;
    for (int pc = c.tid; pc < 8 * L / 8; pc += 512) { const int bb = pc / (L / 8), pi = pc % (L / 8);
        *(LAS u32x4*)(Zs + (bb * NBK + (pi >> 2)) * 80 + (pi & 3) * 16) = *(const u32x4*)(zsrc + (size_t)bb * L + 8 * pi); }
    __syncthreads();
    const int r = (-a) & 7;
    f32x16 acc[NT];
#pragma unroll
    for (int q = 0; q < NT; ++q) acc[q] = zero16();
    for (int d = -(NBK - 1); d <= NBK - 1; ++d) {
#pragma unroll
        for (int step = 0; step < 2; ++step) {
            const int y0 = L - 32 * d - a + 16 * step + 8 * h5;
            const bf16x8 A = *(const LAS bf16x8*)(F + (r * CP + (y0 - r)) * 2);
#pragma unroll
            for (int q = 0; q < NT; ++q) {
                if (d >= 32 * q - (NBK - 1) && d <= 32 * q + 31) {
                    const int src = 32 * q + a - d; const bool ok = (unsigned)src < (unsigned)NBK; const int sc = ok ? w * NBK + src : 8 * NBK;
                    const bf16x8 B = *(const LAS bf16x8*)(Zs + sc * 80 + 32 * step + 16 * h5);
                    acc[q] = MFMA32(A, B, acc[q]);
                }
            }
        }
    }
#pragma unroll
    for (int q = 0; q < NT; ++q) { const int i = 32 * q + a;
        if (i < NBK) {
#pragma unroll
            for (int qq = 0; qq < 4; ++qq) { u32x2 o; o.x = cvt_pk_bf16(acc[q][4 * qq], acc[q][4 * qq + 1]); o.y = cvt_pk_bf16(acc[q][4 * qq + 2], acc[q][4 * qq + 3]);
                *(u32x2*)(ydst + (size_t)w * L + 32 * i + 8 * qq + 4 * h5) = o; } } }
}
DI void phase_hy_toeplitz(const Ctx& c) {
    for (int ch = blockIdx.x; ch < 1024; ch += gridDim.x) {
        hy_toeplitz_channel<SEQ>(c, WSP(float, WS_HF) + (size_t)ch * 4096, WSP(bf16, WS_BIG + BIG_ZTL) + (size_t)ch * NB * SEQ, WSP(bf16, WS_BIG + BIG_YTL) + (size_t)ch * NB * SEQ);
        hy_toeplitz_channel<CTX>(c, WSP(float, WS_HFC) + (size_t)ch * 512, WSP(bf16, WS_BIG + BIG_ZTC) + (size_t)ch * NB * CTX, WSP(bf16, WS_BIG + BIG_YTC) + (size_t)ch * NB * CTX);
    }
}
DI void phase_hy_post(const Ctx& c) {
    const bf16* X0C = WSP(bf16, WS_BIG + BIG_PC); bf16* Y = WSP(bf16, WS_Y); const float* skip = c.in[I_HYSKIP];
    LAS float* tl = (LAS float*)c.lds;
    for (int item = blockIdx.x; item < 4608; item += gridDim.x) {
        int L, b, t0, c0, rb; hy_item(item, L, b, t0, c0, rb);
        const bf16* ZT = L == SEQ ? WSP(bf16, WS_BIG + BIG_ZTL) : WSP(bf16, WS_BIG + BIG_ZTC); const bf16* YT = L == SEQ ? WSP(bf16, WS_BIG + BIG_YTL) : WSP(bf16, WS_BIG + BIG_YTC);
        __syncthreads();
        { const int ch = c.tid >> 3, tp = c.tid & 7; const size_t o = ((size_t)(c0 + ch) * NB + b) * L + t0 + 8 * tp; float y[8], z[8];
          unpack8(*(const u32x4*)(YT + o), y); unpack8(*(const u32x4*)(ZT + o), z); const float sk = skip[c0 + ch];
#pragma unroll
          for (int e = 0; e < 8; ++e) tl[ch * 65 + 8 * tp + e] = y[e] + sk * z[e]; }
        __syncthreads();
        { const int t = c.tid >> 3, sp = c.tid & 7; float x0[8], o[8];
          unpack8(*(const u32x4*)(X0C + (size_t)(rb + t0 + t) * 1024 + c0 + 8 * sp), x0);
#pragma unroll
          for (int e = 0; e < 8; ++e) o[e] = x0[e] * tl[(8 * sp + e) * 65 + t];
          *(u32x4*)(Y + (size_t)(rb + t0 + t) * D + c0 + 8 * sp) = pack8(o); }
    }
}

DI void phase_route(const Ctx& c, int l) {
    LAS float* rw = (LAS float*)c.lds;
    LAS int* lcnt = (LAS int*)(c.lds + 65536);
    LAS int* rinfo = lcnt + 32;
    LAS float* rwt = (LAS float*)(rinfo + 4 * 128);
    for (int i = c.tid; i < 16 * 1024; i += 512) { const int e = i >> 10, k = i & 1023; rw[i] = c.in[I_RW][k * 16 + e]; }
    if (c.tid < 16) lcnt[c.tid] = 0;
    __syncthreads();
    const float* MOD = WSP(float, WS_MOD) + (size_t)l * 9 * 6144; const float* g = c.in[I_N2G] + l * D; bf16* H = WSP(bf16, WS_H);
    const float* X = WSP(float, WS_X); const float* XC = WSP(float, WS_XC);
    unsigned* cnt = WSP(unsigned, WS_CTL) + CW_CNT + l * 16; int* TOK = WSP(int, WS_TOK); float* TOKW = WSP(float, WS_TOK + 512 * 1024);
    float rbv[16];
#pragma unroll
    for (int e = 0; e < 16; ++e) rbv[e] = c.in[I_RB][e];
    const int rlo = (l == 3 ? TC : 0), nrow = TT - rlo, per = (nrow + (int)gridDim.x - 1) / (int)gridDim.x;
    const int brow0 = rlo + (int)blockIdx.x * per, bn = min(per, TT - brow0);
    for (int lr = c.wave; lr < bn; lr += 8) {
        const int row = brow0 + lr;
        f32x4 v[4]; const int mr = row < TC ? 8 : (row - TC) >> 11;
        load_row(row < TC ? XC + (size_t)row * D : X + (size_t)(row - TC) * D, v, c.lane);
        norm_row(v, g, c.lane); mod_row(v, MOD + mr * 6144 + 3072, MOD + mr * 6144 + 4096, c.lane);
        store_row_bf16(H + (size_t)row * D, v, c.lane);
        float sc[16];
#pragma unroll
        for (int e = 0; e < 16; ++e) { float s = 0.f;
#pragma unroll
            for (int j = 0; j < 4; ++j) { const f32x4 w = *(const LAS f32x4*)(rw + e * 1024 + 256 * j + 4 * c.lane); s += (v[j].x * w.x + v[j].y * w.y) + (v[j].z * w.z + v[j].w * w.w); }
            sc[e] = sigmoidf_(wave_sum(s)); asm volatile("" ::: "memory"); }
        int bg = 0; float bgs = -1e30f;
#pragma unroll
        for (int gq = 0; gq < 4; ++gq) { float m1 = -1e30f, m2 = -1e30f;
#pragma unroll
            for (int j = 0; j < 4; ++j) { const float s = sc[4 * gq + j] + rbv[4 * gq + j]; if (s > m1) { m2 = m1; m1 = s; } else if (s > m2) m2 = s; }
            const float gs = m1 + m2; if (gs > bgs) { bgs = gs; bg = gq; } }
        float s4[4], p4[4];
#pragma unroll
        for (int j = 0; j < 4; ++j) { s4[j] = 0.f; p4[j] = 0.f; }
#pragma unroll
        for (int gq = 0; gq < 4; ++gq)
#pragma unroll
            for (int j = 0; j < 4; ++j) if (bg == gq) { s4[j] = sc[4 * gq + j] + rbv[4 * gq + j]; p4[j] = sc[4 * gq + j]; }
        int i1 = 0; float v1 = s4[0], q1 = p4[0];
#pragma unroll
        for (int j = 1; j < 4; ++j) if (s4[j] > v1) { v1 = s4[j]; i1 = j; q1 = p4[j]; }
        int i2 = -1; float v2 = -1e30f, q2 = 0.f;
#pragma unroll
        for (int j = 0; j < 4; ++j) if (j != i1 && s4[j] > v2) { v2 = s4[j]; i2 = j; q2 = p4[j]; }
        if (c.lane == 0) {
            const int e0 = 4 * bg + i1, e1 = 4 * bg + i2;
            const int p0 = __hip_atomic_fetch_add(lcnt + e0, 1, __ATOMIC_RELAXED, __HIP_MEMORY_SCOPE_WORKGROUP), p1 = __hip_atomic_fetch_add(lcnt + e1, 1, __ATOMIC_RELAXED, __HIP_MEMORY_SCOPE_WORKGROUP);
            rinfo[lr * 4 + 0] = e0; rinfo[lr * 4 + 1] = p0; rinfo[lr * 4 + 2] = e1; rinfo[lr * 4 + 3] = p1;
            const float inv = 1.0f / (q1 + q2); rwt[lr * 2] = q1 * inv; rwt[lr * 2 + 1] = q2 * inv;
        }
    }
    __syncthreads();
    if (c.tid < 16) lcnt[16 + c.tid] = (int)atomicAdd(cnt + c.tid, (unsigned)lcnt[c.tid]);
    __syncthreads();
    for (int lr = c.tid; lr < bn; lr += 512) { const int row = brow0 + lr, e0 = rinfo[lr * 4], e1 = rinfo[lr * 4 + 2];
        TOK[row * 4 + 0] = e0; TOK[row * 4 + 1] = lcnt[16 + e0] + rinfo[lr * 4 + 1]; TOK[row * 4 + 2] = e1; TOK[row * 4 + 3] = lcnt[16 + e1] + rinfo[lr * 4 + 3];
        TOKW[row * 2] = rwt[lr * 2]; TOKW[row * 2 + 1] = rwt[lr * 2 + 1]; }
}
DI void slot_bases(const unsigned* cnt, int lane, int e0, int e1, int& b0, int& b1) {
    const unsigned mine = lane < 16 ? ((cnt[lane] + 255u) & ~255u) : 0u; unsigned pb = 0; b0 = 0; b1 = 0;
#pragma unroll
    for (int e = 0; e < 16; ++e) { const unsigned ce = __shfl(mine, e); if (e == e0) b0 = (int)pb; if (e == e1) b1 = (int)pb; pb += ce; }
}
DI void phase_gather(const Ctx& c, int l) {
    const unsigned* cnt = WSP(unsigned, WS_CTL) + CW_CNT + l * 16; const int* TOK = WSP(int, WS_TOK); int* TOKS = WSP(int, WS_TOK + 768 * 1024);
    const bf16* H = WSP(bf16, WS_H); bf16* HS = WSP(bf16, WS_BIG + BIG_HS);
    for (int row = (l == 3 ? TC : 0) + c.gw; row < TT; row += c.ngw) {
        const int e0 = TOK[row * 4], p0 = TOK[row * 4 + 1], e1 = TOK[row * 4 + 2], p1 = TOK[row * 4 + 3]; int b0, b1;
        slot_bases(cnt, c.lane, e0, e1, b0, b1);
        const int s0 = b0 + p0, s1 = b1 + p1;
        const u32x4 a = *(const u32x4*)(H + (size_t)row * D + 8 * c.lane), bq = *(const u32x4*)(H + (size_t)row * D + 512 + 8 * c.lane);
        *(u32x4*)(HS + (size_t)s0 * D + 8 * c.lane) = a; *(u32x4*)(HS + (size_t)s0 * D + 512 + 8 * c.lane) = bq;
        *(u32x4*)(HS + (size_t)s1 * D + 8 * c.lane) = a; *(u32x4*)(HS + (size_t)s1 * D + 512 + 8 * c.lane) = bq;
        if (c.lane == 0) { TOKS[row * 2] = s0; TOKS[row * 2 + 1] = s1; }
    }
}
DI LAS int* moe_tiles(const Ctx& c, int l, int nsh) {
    LAS int* tp = (LAS int*)(c.lds + MISC_OFF);
    LAS int* ul = tp + 192;
    __syncthreads();
    if (c.tid < 64) {
        const unsigned* cnt = WSP(unsigned, WS_CTL) + CW_CNT + l * 16;
        const int mine = c.lane < 16 ? (int)((cnt[c.lane] + 255u) >> 8) : 0; int p = 0;
        for (int e = 0; e < 16; ++e) { const int ne = __shfl(mine, e); for (int t = c.lane; t < ne; t += 64) tp[1 + p + t] = e; p += ne; }
        if (c.lane == 0) tp[0] = p;
    }
    __syncthreads();
    if (c.tid < 32) {
        const int i = c.tid, ntile = tp[0], G = gridDim.x, cb = blockIdx.x; int rt = 1 << 20, pn = 0;
        if ((G & 7) == 0 && ((G >> 3) >> nsh) > 0) { const int x = cb & 7, v = cb >> 3, rpx = (G >> 3) >> nsh;
            if (v < (rpx << nsh)) { rt = (i * 8 + x) * rpx + (v >> nsh); pn = v & ((1 << nsh) - 1); } }
        else { const int L = i * G + cb; rt = L >> nsh; pn = L & ((1 << nsh) - 1); }
        ul[i] = rt < ntile ? (rt | (pn << 12) | (tp[1 + rt] << 16)) : -1;
    }
    __syncthreads();
    return ul;
}
DI void phase_combine(const Ctx& c, int l) {
    const float* MOD = WSP(float, WS_MOD) + (size_t)l * 9 * 6144; const int* TOKS = WSP(int, WS_TOK + 768 * 1024); const float* TOKW = WSP(float, WS_TOK + 512 * 1024);
    const bf16* YS = WSP(bf16, WS_BIG + BIG_HS); float* X = WSP(float, WS_X); float* XC = WSP(float, WS_XC); bf16* H = WSP(bf16, WS_H);
    for (int row = (l == 3 ? TC : 0) + c.gw; row < TT; row += c.ngw) {
        const int mr = row < TC ? 8 : (row - TC) >> 11; float* xp = row < TC ? XC + (size_t)row * D : X + (size_t)(row - TC) * D;
        const int s0 = TOKS[row * 2], s1 = TOKS[row * 2 + 1]; const float w0 = TOKW[row * 2], w1 = TOKW[row * 2 + 1];
        f32x4 v[4]; load_row(xp, v, c.lane);
#pragma unroll
        for (int j = 0; j < 4; ++j) {
            const u32x2 a = *(const u32x2*)(YS + (size_t)s0 * D + 256 * j + 4 * c.lane), bq = *(const u32x2*)(YS + (size_t)s1 * D + 256 * j + 4 * c.lane);
            const f32x4 ya = {__uint_as_float(a.x << 16), __uint_as_float(a.x & 0xffff0000u), __uint_as_float(a.y << 16), __uint_as_float(a.y & 0xffff0000u)};
            const f32x4 yb = {__uint_as_float(bq.x << 16), __uint_as_float(bq.x & 0xffff0000u), __uint_as_float(bq.y << 16), __uint_as_float(bq.y & 0xffff0000u)};
            v[j] = v[j] + *(const f32x4*)(MOD + mr * 6144 + 5120 + 256 * j + 4 * c.lane) * (ya * w0 + yb * w1);
            *(f32x4*)(xp + 256 * j + 4 * c.lane) = v[j];
        }
        if (l < 3) {
            const float* MODn = WSP(float, WS_MOD) + (size_t)(l + 1) * 9 * 6144;
            norm_row(v, c.in[I_N1G] + (l + 1) * D, c.lane); mod_row(v, MODn + mr * 6144, MODn + mr * 6144 + 1024, c.lane);
            store_row_bf16(H + (size_t)hrow_of(row, (l + 1) % 3) * D, v, c.lane);
        } else {
            norm_row(v, c.in[I_FING], c.lane);
            float* o = c.out + (size_t)(row - TC) * D;
#pragma unroll
            for (int j = 0; j < 4; ++j) *(f32x4*)(o + 256 * j + 4 * c.lane) = v[j];
        }
    }
}

#define XB_TMO      128
#define XB_XCNT(j)  (256  + 64 * (j))
#define XB_XSUB(j)  (1280 + 64 * (j))
#define XB_XGEN(j)  (2304 + 64 * (j))
#define XB_TOP      3328
#define XB_TOPGEN   3392
#define XCD_BAR_WORDS 3456
#define XB_SPIN_CAP (1u << 18)
DI unsigned xb_ld(unsigned* p)              { return __hip_atomic_load(p, __ATOMIC_RELAXED, __HIP_MEMORY_SCOPE_AGENT); }
DI unsigned xb_add(unsigned* p, unsigned v) { return __hip_atomic_fetch_add(p, v, __ATOMIC_RELAXED, __HIP_MEMORY_SCOPE_AGENT); }
DI unsigned xb_xcc_id() { return (unsigned)__builtin_amdgcn_s_getreg((3 << 11) | 20) & 0xFu; }
#define XB_SPIN(cond, bar) do { unsigned _sp = 0; while (cond) { __builtin_amdgcn_s_sleep(1); \
    if ((++_sp & 255u) == 0u) { if (xb_ld(&(bar)[XB_TMO])) break; if (_sp > XB_SPIN_CAP) { atomicAdd(&(bar)[XB_TMO], 1u); break; } } } } while (0)
DI void xcd_barrier_complete(unsigned* bar, unsigned x, unsigned& nloc, unsigned& nx) {
    const unsigned G = gridDim.x * gridDim.y * gridDim.z;
    unsigned sum, cnt, mine, sp = 0u;
    for (;;) {
        sum = 0u; cnt = 0u; mine = 0u;
#pragma unroll
        for (unsigned j = 0; j < 16; ++j) { const unsigned cj = xb_ld(&bar[XB_XCNT(j)]); sum += cj; cnt += (cj > 0u) ? 1u : 0u; mine = (j == x) ? cj : mine; }
        if (sum == G) break;
        __builtin_amdgcn_s_sleep(1);
        if ((++sp & 255u) == 0u) { if (xb_ld(&bar[XB_TMO])) break; if (sp > XB_SPIN_CAP) { atomicAdd(&bar[XB_TMO], 1u); break; } }
    }
    nloc = mine > 0u ? mine : 1u; nx = cnt > 0u ? cnt : 1u;
}
DI void xcd_barrier(unsigned* bar, volatile LAS unsigned* st) {
    asm volatile("s_waitcnt vmcnt(0)" ::: "memory");
    __syncthreads();
    if (threadIdx.x == 0) {
        const unsigned x = xb_xcc_id();
        __builtin_amdgcn_s_waitcnt(0);
        unsigned nloc = st[0], nx = st[1];
        if (nloc == 0u) { xcd_barrier_complete(bar, x, nloc, nx); st[0] = nloc; st[1] = nx; }
        const unsigned old = xb_add(&bar[XB_XSUB(x)], 1u);
        const unsigned gen = old / nloc;
        if (old + 1u == (gen + 1u) * nloc) {
            __builtin_amdgcn_fence(__ATOMIC_RELEASE, "agent");
            asm volatile("s_waitcnt vmcnt(0)" ::: "memory");
            const unsigned og = xb_add(&bar[XB_TOP], 1u);
            const unsigned tg = og / nx;
            if (og + 1u == (tg + 1u) * nx) xb_add(&bar[XB_TOPGEN], 1u);
            else XB_SPIN(xb_ld(&bar[XB_TOPGEN]) == tg, bar);
            __builtin_amdgcn_fence(__ATOMIC_ACQUIRE, "agent");
            xb_add(&bar[XB_XGEN(x)], 1u);
            asm volatile("s_waitcnt vmcnt(0)" ::: "memory");
        } else {
            XB_SPIN(xb_ld(&bar[XB_XGEN(x)]) == gen, bar);
            __builtin_amdgcn_fence(__ATOMIC_ACQUIRE, "agent");
            asm volatile("s_waitcnt vmcnt(0)" ::: "memory");
        }
    }
    __syncthreads();
}

constexpr int NPHASE = 2 + 11 * DEPTH;
__host__ __device__ inline bool phase_active(int ph) {
    if (ph < 2) return true;
    const int l = (ph - 2) / 11, s = (ph - 2) % 11, kind = l % 3;
    if (s == 0) return false;
    if (s == 4) return kind != 2 || HY_MFMA;
    return true;
}
DI void run_phase(const Ctx& c, int ph) {
    if (ph == 0) { if constexpr (PH_EN(0)) phase_pro0(c); return; }
    if (ph == 1) { if constexpr (PH_EN(1)) { phase_pro1(c); phase_norm1(c, 0, c.in[I_X], c.in[I_CTX]); } return; }
    const int l = (ph - 2) / 11, s = (ph - 2) % 11, kind = l % 3, j = l / 3;
    switch (s) {
    case 0: if constexpr (PH_EN(2)) phase_norm1(c, 0, c.in[I_X], c.in[I_CTX]); break;
    case 1: if constexpr (PH_EN(3)) {
        DenseOrder S; EpiInproj E; E.P = WSP(bf16, WS_P); E.extra = WSP(float, WS_EXTRA); E.bias = nullptr; E.bias_x = nullptr;
        S.A = WSP(bf16, WS_H); S.ul = dense_units(c.lds, c.tid, TT, kind == 2 ? 3072 : NINP);
        if (kind == 0) { S.Bt = WSP(bf16, WS_ML_WIN) + (size_t)j * NINP * 1024; E.bias_x = c.in[I_MLBG] + j * 32; }
        else if (kind == 1) { S.Bt = WSP(bf16, WS_GLA_WIN); }
        else { S.Bt = WSP(bf16, WS_HY_WIN); E.bias = c.in[I_HYBIN]; }
        gemm_run(c.lds, c.tid, S, E);
    } break;
    case 2: if constexpr (PH_EN(4))
        if (kind == 0) phase_conv(c, 1024, c.in[I_MLCW] + j * 3 * 1024, c.in[I_MLCB] + j * 1024, true, 0.125f);
        else if (kind == 1) { phase_conv(c, 2048, c.in[I_GLCW], c.in[I_GLCB], true, 0.08838834764831845f); if constexpr (GLA_CHUNK) phase_gla_decay(c); }
        else { if constexpr (HY_MFMA) phase_hy_prep(c); else phase_conv(c, 3072, c.in[I_HYCW], c.in[I_HYCB], false, 1.0f); }
        break;
    case 3: if constexpr (PH_EN(5))
        if (kind == 0) { if constexpr (MLSTM_CHUNK) phase_mlstm_state(c); else phase_mlstm_scan_naive(c); }
        else if (kind == 1) { if constexpr (GLA_CHUNK) phase_gla_state(c); else phase_gla_scan_naive(c); }
        else { if constexpr (HY_MFMA) phase_hy_toeplitz(c); else phase_hyena_conv_naive(c); }
        break;
    case 4: if constexpr (PH_EN(6))
        if (kind == 0) { if constexpr (MLSTM_CHUNK) phase_mlstm_out(c, c.in[I_MLNG] + j * 1024); else phase_headnorm(c, 128, c.in[I_MLNG] + j * 1024); }
        else if (kind == 1) { if constexpr (GLA_CHUNK) phase_gla_out(c, c.in[I_GLNG]); else phase_headnorm(c, 256, c.in[I_GLNG]); }
        else { if constexpr (HY_MFMA) phase_hy_post(c); }
        break;
    case 5: if constexpr (PH_EN(7)) {
        DenseOrder S; EpiOutproj E; E.X = WSP(float, WS_X); E.XC = WSP(float, WS_XC); E.mod = WSP(float, WS_MOD) + (size_t)l * 9 * 6144; E.bias = nullptr; E.perm = (kind == 1);
        E.xs_l = (l == 0) ? c.in[I_X] : WSP(float, WS_X); E.xs_c = (l == 0) ? c.in[I_CTX] : WSP(float, WS_XC); E.row_off = (l == 3) ? TC : 0;
        const bf16* W = kind == 0 ? WSP(bf16, WS_ML_WOUT) + (size_t)j * 1024 * 1024 : kind == 1 ? WSP(bf16, WS_GLA_WOUT) : WSP(bf16, WS_HY_WOUT);
        if (kind == 2) E.bias = c.in[I_HYBOUT];
        S.A = WSP(bf16, WS_Y) + (size_t)E.row_off * D; S.Bt = W; S.ul = dense_units(c.lds, c.tid, TT - E.row_off, 1024);
        gemm_run(c.lds, c.tid, S, E);
    } break;
    case 6: if constexpr (PH_EN(8)) phase_route(c, l); break;
    case 7: if constexpr (PH_EN(9)) phase_gather(c, l); break;
    case 8: if constexpr (PH_EN(10)) {
        MoeOrder S; S.ul = moe_tiles(c, l, 3); S.A = WSP(bf16, WS_BIG + BIG_HS); S.Bt = WSP(bf16, WS_EXP_UP) + (size_t)l * 16 * 2048 * 1024; S.bstride = (size_t)2048 * 1024;
        EpiUp E; E.ACT = WSP(bf16, WS_BIG + BIG_ACT);
        gemm_run(c.lds, c.tid, S, E);
    } break;
    case 9: if constexpr (PH_EN(11)) {
        MoeOrder S; S.ul = moe_tiles(c, l, 2); S.A = WSP(bf16, WS_BIG + BIG_ACT); S.Bt = WSP(bf16, WS_EXP_DN) + (size_t)l * 16 * 1024 * 1024; S.bstride = (size_t)1024 * 1024;
        EpiDown E; E.YS = WSP(bf16, WS_BIG + BIG_HS);
        gemm_run(c.lds, c.tid, S, E);
    } break;
    case 10: if constexpr (PH_EN(12)) phase_combine(c, l); break;
    }
}

__global__ void __launch_bounds__(512, 2) mega_fwd(Params p) {
    extern __shared__ __attribute__((aligned(16))) unsigned char lds_raw[];
#if XCD_BARRIER
    {
        volatile LAS unsigned* st0 = (volatile LAS unsigned*)((LAS unsigned char*)lds_raw + BAR_LDS_OFF);
        if (threadIdx.x == 0) { st0[0] = 0u; st0[1] = 0u; (void)xb_add((unsigned*)(p.ws + WS_CTL) + CW_BAR + XB_XCNT(xb_xcc_id()), 1u); }
        __syncthreads();
    }
#endif
    bool first = true;
    int rep = 0;
    for (int ph = p.ph_lo; ph < p.ph_hi;) {
        if (!phase_active(ph)) { ++ph; continue; }
        int z; asm volatile("s_mov_b32 %0, 0" : "=s"(z));
        if (!first) {
#if XCD_BARRIER
            xcd_barrier((unsigned*)(p.ws + z + WS_CTL) + CW_BAR, (volatile LAS unsigned*)((LAS unsigned char*)lds_raw + BAR_LDS_OFF));
#else
            cg::this_grid().sync();
#endif
        }
        first = false;
        Ctx c;
        c.lds = (LAS unsigned char*)lds_raw;
        c.tid = threadIdx.x + z; c.lane = c.tid & 63; c.wave = __builtin_amdgcn_readfirstlane(c.tid >> 6);
        c.gw = blockIdx.x * 8 + c.wave; c.ngw = gridDim.x * 8;
        c.in = (const float* const __attribute__((address_space(4)))*)__builtin_amdgcn_kernarg_segment_ptr() + z; c.out = p.out + z; c.ws = p.ws + z; c.z = (unsigned)z;
        run_phase(c, ph);
        if (REP_MASK != 0u && rep == 0 && (ph >= 2 ? (((REP_MASK >> ((ph - 2) % 11)) & 1u) && ((REP_LAYERS >> ((ph - 2) / 11)) & 1u)) : ((REP_MASK >> (16 + ph)) & 1u))) rep = 1; else { rep = 0; ++ph; }
    }
}

extern "C" void kernel_launch(void* const* d_in, const int* in_sizes, int n_in, void* d_out, int out_size, void* d_ws, size_t ws_size, hipStream_t stream) {
    static int grid = 0;
    if (grid == 0) {
        if (n_in != 40 || ws_size < WS_END || out_size != TL * D) { fprintf(stderr, "kernel_launch: unexpected shapes (n_in %d, ws %zu, out %d)\n", n_in, ws_size, out_size); grid = -1; return; }
        int dev = 0, cus = 0, per_cu = 0;
        hipGetDevice(&dev); hipDeviceGetAttribute(&cus, hipDeviceAttributeMultiprocessorCount, dev);
        if (hipFuncSetAttribute((const void*)mega_fwd, hipFuncAttributeMaxDynamicSharedMemorySize, LDS_BYTES) != hipSuccess) { fprintf(stderr, "kernel_launch: hipFuncSetAttribute failed\n"); grid = -1; return; }
        if (hipOccupancyMaxActiveBlocksPerMultiprocessor(&per_cu, (const void*)mega_fwd, 512, LDS_BYTES) != hipSuccess || per_cu < 1) { fprintf(stderr, "kernel_launch: occupancy query says %d\n", per_cu); per_cu = 1; }
        (void)hipGetLastError();
        grid = cus;
        fprintf(stderr, "kernel_launch: grid %d (cus %d, per_cu %d)\n", grid, cus, per_cu);
    }
    if (grid < 0) return;
    hipMemsetAsync((char*)d_ws + WS_CTL, 0, 1 * MiB, stream);
    Params p{};
    for (int i = 0; i < 40; ++i) p.in[i] = (const float*)d_in[i];
    p.out = (float*)d_out; p.ws = (unsigned char*)d_ws;
#if N_LAUNCH_PER_PHASE
    for (int ph = 0; ph < NPHASE; ++ph) {
        if (!phase_active(ph)) continue;
        p.ph_lo = ph; p.ph_hi = ph + 1; void* args[] = {&p};
        hipError_t e = hipLaunchCooperativeKernel((const void*)mega_fwd, dim3(grid), dim3(512), args, LDS_BYTES, stream);
        if (e != hipSuccess) { fprintf(stderr, "launch failed: %s\n", hipGetErrorString(e)); break; }
    }
#else
    p.ph_lo = 0; p.ph_hi = NPHASE; void* args[] = {&p};
    hipError_t e = hipLaunchCooperativeKernel((const void*)mega_fwd, dim3(grid), dim3(512), args, LDS_BYTES, stream);
    if (e != hipSuccess) fprintf(stderr, "cooperative launch failed: %s (grid %d)\n", hipGetErrorString(e), grid);
#endif
}
```

```cpp
#include <hip/hip_runtime.h>
#include <hip/hip_cooperative_groups.h>
#include <cstdio>
#include <cstdint>
namespace cg = cooperative_groups;

#define LAS __attribute__((address_space(3)))
#define DI __device__ __forceinline__
typedef unsigned short bf16;
typedef float f32x4 __attribute__((ext_vector_type(4)));
typedef float f32x2 __attribute__((ext_vector_type(2)));
typedef unsigned u32x4 __attribute__((ext_vector_type(4)));
typedef unsigned u32x2 __attribute__((ext_vector_type(2)));
typedef short bf16x8 __attribute__((ext_vector_type(8)));

#ifndef FAST_GEMM
#define FAST_GEMM 1
#endif
#ifndef MLSTM_CHUNK
#define MLSTM_CHUNK 1
#endif
#ifndef GLA_CHUNK
#define GLA_CHUNK 1
#endif
#ifndef HY_MFMA
#define HY_MFMA 1
#endif
#ifndef XCD_BARRIER
#define XCD_BARRIER 1
#endif
#ifndef PH_MASK
#define PH_MASK 0xFFFFFFFFu
#endif
#define PH_EN(b) ((PH_MASK >> (b)) & 1u)
#ifndef TP_MASK
#define TP_MASK 0u
#endif
#ifndef TP_LAYERS
#define TP_LAYERS 0xFu
#endif
#define TP_AMP 4
#ifndef REP_LAYERS
#define REP_LAYERS 0xFu
#endif
#ifndef REP_MASK
#define REP_MASK 0u
#endif
#ifndef N_LAUNCH_PER_PHASE
#define N_LAUNCH_PER_PHASE 0
#endif

constexpr int D = 1024, NB = 8, SEQ = 2048, CTX = 256, DEPTH = 4;
constexpr int TC = NB * CTX, TL = NB * SEQ, TT = TC + TL;
constexpr int NEXP = 16;
constexpr int PLD = 3072;
constexpr int NINP = 3328;
constexpr float EPS = 1e-6f;
constexpr int MAXSLOT = 40960;

constexpr size_t MiB = 1u << 20;
constexpr size_t WS_CTL = 0;
constexpr size_t WS_MOD = 1 * MiB;
constexpr size_t WS_HM = 2 * MiB;
constexpr size_t WS_TOK = 3 * MiB;
constexpr size_t WS_RWT = 3 * MiB + 944 * 1024;
constexpr size_t WS_HF = 4 * MiB;
constexpr size_t WS_HFC = 20 * MiB;
constexpr size_t WS_ML_WIN = 32 * MiB;
constexpr size_t WS_ML_WOUT = 45 * MiB;
constexpr size_t WS_GLA_WIN = 49 * MiB;
constexpr size_t WS_GLA_WOUT = 56 * MiB;
constexpr size_t WS_HY_WIN = 58 * MiB;
constexpr size_t WS_HY_WOUT = 64 * MiB;
constexpr size_t WS_EXP_UP = 66 * MiB;
constexpr size_t WS_EXP_DN = 322 * MiB;
constexpr size_t WS_X = 450 * MiB;
constexpr size_t WS_XC = 514 * MiB;
constexpr size_t WS_H = 522 * MiB;
constexpr size_t WS_P = 558 * MiB;
constexpr size_t WS_EXTRA = 667 * MiB;
constexpr size_t WS_Y = 670 * MiB;
constexpr size_t WS_BIG = 706 * MiB;
constexpr size_t WS_END = 1024 * MiB;
constexpr size_t BIG_HS = 0;
constexpr size_t BIG_ACT = 80 * MiB;
constexpr size_t BIG_PC = 0;
constexpr size_t BIG_YF = 108 * MiB;
constexpr size_t BIG_YB = 180 * MiB;

constexpr size_t BIG_MCT = 108 * MiB;
constexpr size_t BIG_MN = 180 * MiB;

constexpr size_t BIG_GB = 72 * MiB;
constexpr size_t BIG_GST = 144 * MiB;

constexpr size_t BIG_ZTL = 108 * MiB;
constexpr size_t BIG_ZTC = 140 * MiB;
constexpr size_t BIG_YTL = 144 * MiB;
constexpr size_t BIG_YTC = 176 * MiB;

constexpr int CW_CNT = 1024;
constexpr int CW_BAR = 4096;

constexpr int LDS_BYTES = 148480;
constexpr int BAR_LDS_OFF = 147456;
constexpr int MISC_OFF = 131072;

struct Params {
    const float* in[40];
    float* out;
    unsigned char* ws;
    int ph_lo, ph_hi;
};
static_assert(__builtin_offsetof(Params, in) == 0, "the input pointer table must be the first kernel argument bytes");
enum { I_X = 0, I_C, I_CTX, I_CCTX, I_ADAW, I_ADAB, I_N1G, I_N2G, I_FING, I_MLWIN, I_MLBG, I_MLCW, I_MLCB, I_MLNG, I_MLWOUT,
       I_GLWIN, I_GLCW, I_GLCB, I_GLW2, I_GLGB, I_GLNG, I_GLWOUT, I_HYWIN, I_HYBIN, I_HYCW, I_HYCB, I_HYFW1, I_HYFB1, I_HYFWM, I_HYFBM,
       I_HYFWO, I_HYFREQ, I_HYSKIP, I_HYWOUT, I_HYBOUT, I_RW, I_RB, I_EW1, I_EW3, I_EW2 };

DI float bf2f(bf16 v) { return __uint_as_float(((unsigned)v) << 16); }
typedef __bf16 b16x2_t __attribute__((ext_vector_type(2)));
DI unsigned cvt_pk_bf16(float lo, float hi) { const f32x2 v = {lo, hi}; const b16x2_t r = __builtin_convertvector(v, b16x2_t); return __builtin_bit_cast(unsigned, r); }
DI bf16 f2bf(float f) { return (bf16)(cvt_pk_bf16(f, 0.f) & 0xffffu); }
DI float sigmoidf_(float x) { return 1.0f / (1.0f + __expf(-x)); }
DI float siluf_(float x) { return x / (1.0f + __expf(-x)); }
DI float logsigf_(float x) { return fminf(x, 0.f) - __logf(1.0f + __expf(-fabsf(x))); }
DI void lds_barrier() { asm volatile("s_waitcnt lgkmcnt(0)" ::: "memory"); __builtin_amdgcn_s_barrier(); asm volatile("" ::: "memory"); }
DI float wave_sum(float v) {
#pragma unroll
    for (int o = 1; o < 64; o <<= 1) v += __shfl_xor(v, o);
    return v;
}
DI void unpack8(const u32x4 w, float (&v)[8]) {
    v[0] = __uint_as_float(w.x << 16); v[1] = __uint_as_float(w.x & 0xffff0000u);
    v[2] = __uint_as_float(w.y << 16); v[3] = __uint_as_float(w.y & 0xffff0000u);
    v[4] = __uint_as_float(w.z << 16); v[5] = __uint_as_float(w.z & 0xffff0000u);
    v[6] = __uint_as_float(w.w << 16); v[7] = __uint_as_float(w.w & 0xffff0000u);
}
DI u32x4 pack8(const float (&v)[8]) { u32x4 w; w.x = cvt_pk_bf16(v[0], v[1]); w.y = cvt_pk_bf16(v[2], v[3]); w.z = cvt_pk_bf16(v[4], v[5]); w.w = cvt_pk_bf16(v[6], v[7]); return w; }
DI void seq_bounds(int row, int& lo, int& hi) {
    if (row < TC) { lo = row & ~(CTX - 1); hi = lo + CTX - 1; } else { lo = TC + ((row - TC) & ~(SEQ - 1)); hi = lo + SEQ - 1; }
}
DI int perm_fwd(int s) { return (s & 63) * 32 + (s >> 6); }
DI int perm_inv(int sp) { return (sp & 31) * 64 + (sp >> 5); }

namespace pg8 {
constexpr int BM = 256, BK = 64, HALF = 128, HTB = HALF * BK * 2, STAGE_BYTES = 8 * HTB, NXCD = 8, WGM = 8;
__host__ __device__ __forceinline__ int lds_byte(int r, int c) { const int st = (r >> 4) * 2 + (c >> 5), rr = r & 15, cc = c & 31, ob = rr * 64 + cc * 2; return st * 1024 + (ob ^ (((ob >> 9) & 1) << 5)); }
__host__ __device__ __forceinline__ void stage_rc(int b, int& R, int& C) { const int st = b / 1024, sb = b % 1024, swz = sb ^ (((sb >> 9) & 1) << 5); R = (st >> 1) * 16 + swz / 64; C = (st & 1) * 32 + (swz % 64) / 2; }
__host__ __device__ __forceinline__ int perm32(int rho) { const int n = rho >> 4, i = rho & 15; return 8 * (i >> 2) + 4 * n + (i & 3); }
}
struct Unit { int pm, pn, e; };

DI LAS int* dense_units(LAS unsigned char* lds, int tid, int M, int N) {
    LAS int* ul = (LAS int*)(lds + MISC_OFF) + 192;
    __syncthreads();
    if (tid < 32) {
        const int nM = M / 256, nN = N / 256, nwg = nM * nN, G = gridDim.x, L = tid * G + (int)blockIdx.x; int w = -1;
        if (L < nwg) {
            int wgid = L; { const int q = nwg / 8, r = nwg % 8, xcd = wgid % 8, off = wgid / 8; wgid = (xcd < r ? xcd * (q + 1) : r * (q + 1) + (xcd - r) * q) + off; }
            const int nig = 8 * nN, gid = wgid / nig, fm = gid * 8, gsz = (nM - fm) < 8 ? (nM - fm) : 8;
            w = (fm + ((wgid % nig) % gsz)) | (((wgid % nig) / gsz) << 12);
        }
        ul[tid] = w;
    }
    __syncthreads();
    return ul;
}
struct DenseOrder {
    const bf16* A; const bf16* Bt; const LAS int* ul;
    DI bool next(int i, Unit& u) const {
        const int w = __builtin_amdgcn_readfirstlane(ul[i]); if (w < 0) return false;
        u.pm = w & 0xfff; u.pn = (w >> 12) & 0xf; u.e = 0; return true;
    }
    DI const bf16* aptr(const Unit& u) const { return A + (size_t)u.pm * 256 * 1024; }
    DI const bf16* bptr(const Unit& u) const { return Bt + (size_t)u.pn * 256 * 1024; }
};
struct MoeOrder {
    const bf16* A; const bf16* Bt; size_t bstride; const LAS int* ul;
    DI bool next(int i, Unit& u) const {
        const int w = __builtin_amdgcn_readfirstlane(ul[i]); if (w < 0) return false;
        u.pm = w & 0xfff; u.pn = (w >> 12) & 0xf; u.e = w >> 16; return true;
    }
    DI const bf16* aptr(const Unit& u) const { return A + (size_t)u.pm * 256 * 1024; }
    DI const bf16* bptr(const Unit& u) const { return Bt + (size_t)u.e * bstride + (size_t)u.pn * 256 * 1024; }
};

struct EpiInproj {
    static constexpr bool PAIR = false, BATCHED = false;
    bf16* P; float* extra; const float* bias; const float* bias_x;
    DI void row8(const Unit& u, int r, int c, const float (&v)[8]) const {
        const int row = u.pm * 256 + r, col = u.pn * 256 + c;
        if (col < PLD) {
            float w[8];
#pragma unroll
            for (int j = 0; j < 8; ++j) w[j] = v[j] + (bias ? bias[col + j] : 0.f);
            *(u32x4*)(P + (size_t)row * PLD + col) = pack8(w);
        } else if (col < PLD + 32) {
            float* o = extra + (size_t)row * 32 + (col - PLD);
#pragma unroll
            for (int j = 0; j < 8; ++j) o[j] = v[j] + (bias_x ? bias_x[col - PLD + j] : 0.f);
        }
    }
};
struct EpiOutproj {
    static constexpr bool PAIR = false, BATCHED = true;
    const float* xs_l; const float* xs_c; bf16* X; bf16* XC; const float* mod; const float* bias; int row_off; int perm;
    DI size_t off(const Unit& u, int r, int col) const {
        const int rr = u.pm * 256 + r + row_off - TC, b = rr >> 11, sp = rr & (SEQ - 1), s = perm ? perm_inv(sp) : sp; return ((size_t)b * SEQ + s) * D + col; }
    DI void tile(const f32x4 (&acc)[2][2][4][2], const Unit& u, int wr, int wc, int fr, int fq) const {
        const int b = (u.pm * 256 + row_off - TC) >> 11; const float* g1p = mod + b * 6144 + 2048;
        float g1[2][8], bs[2][8];
#pragma unroll
        for (int bj = 0; bj < 2; ++bj) { const int col = u.pn * 256 + bj * 128 + wc * 32 + 8 * fq;
#pragma unroll
            for (int j = 0; j < 8; ++j) { g1[bj][j] = g1p[col + j]; bs[bj][j] = bias ? bias[col + j] : 0.f; } }
#pragma unroll
        for (int ai = 0; ai < 2; ++ai)
#pragma unroll
            for (int mp = 0; mp < 2; ++mp) {
                float xo[2][2][8];
#pragma unroll
                for (int mm = 0; mm < 2; ++mm)
#pragma unroll
                    for (int bj = 0; bj < 2; ++bj) { const size_t o = off(u, ai * 128 + wr * 64 + (2 * mp + mm) * 16 + fr, u.pn * 256 + bj * 128 + wc * 32 + 8 * fq);
                        if (xs_l) { const f32x4 a0 = *(const f32x4*)(xs_l + o), a1 = *(const f32x4*)(xs_l + o + 4); xo[mm][bj][0] = a0.x; xo[mm][bj][1] = a0.y; xo[mm][bj][2] = a0.z; xo[mm][bj][3] = a0.w; xo[mm][bj][4] = a1.x; xo[mm][bj][5] = a1.y; xo[mm][bj][6] = a1.z; xo[mm][bj][7] = a1.w; }
                        else unpack8(*(const u32x4*)(X + o), xo[mm][bj]); }
#pragma unroll
                for (int mm = 0; mm < 2; ++mm)
#pragma unroll
                    for (int bj = 0; bj < 2; ++bj) { const int m = 2 * mp + mm; const size_t o = off(u, ai * 128 + wr * 64 + m * 16 + fr, u.pn * 256 + bj * 128 + wc * 32 + 8 * fq); float w[8];
#pragma unroll
                        for (int j = 0; j < 8; ++j) w[j] = xo[mm][bj][j] + g1[bj][j] * (acc[ai][bj][m][j >> 2][j & 3] + bs[bj][j]);
                        *(u32x4*)(X + o) = pack8(w); }
            }
    }
    DI void row8(const Unit& u, int r, int c, const float (&v)[8]) const {
        const int col = u.pn * 256 + c; const size_t o = off(u, r, col); const int b = (u.pm * 256 + row_off - TC) >> 11;
        float a[8];
        if (xs_l) { const f32x4 a0 = *(const f32x4*)(xs_l + o), a1 = *(const f32x4*)(xs_l + o + 4); a[0] = a0.x; a[1] = a0.y; a[2] = a0.z; a[3] = a0.w; a[4] = a1.x; a[5] = a1.y; a[6] = a1.z; a[7] = a1.w; }
        else unpack8(*(const u32x4*)(X + o), a);
        const float* g1 = mod + b * 6144 + 2048 + col; float w[8];
#pragma unroll
        for (int j = 0; j < 8; ++j) w[j] = a[j] + g1[j] * (v[j] + (bias ? bias[col + j] : 0.f));
        *(u32x4*)(X + o) = pack8(w);
    }
};
struct EpiUp {
    static constexpr bool PAIR = true, BATCHED = false;
    bf16* ACT;
    DI void row8p(const Unit& u, int r, int c, const float (&g)[8], const float (&up)[8]) const {
        float w[8];
#pragma unroll
        for (int j = 0; j < 8; ++j) w[j] = siluf_(g[j]) * up[j];
        *(u32x4*)(ACT + ((size_t)u.pm * 256 + r) * 1024 + u.pn * 128 + c) = pack8(w);
    }
};
struct EpiDown {
    static constexpr bool PAIR = false, BATCHED = false;
    bf16* YS;
    DI void row8(const Unit& u, int r, int c, const float (&v)[8]) const { *(u32x4*)(YS + ((size_t)u.pm * 256 + r) * 1024 + u.pn * 256 + c) = pack8(v); }
};

template <class Sched, class Epi>
DI void gemm_fast(LAS unsigned char* lds, int tid, const Sched& S, const Epi& E) {
    using namespace pg8;
    constexpr int K = 1024, nt = K / BK;
    const int wid = __builtin_amdgcn_readfirstlane(tid >> 6), lane = tid & 63, wr = wid >> 2, wc = wid & 3, fr = lane & 15, fq = lane >> 4;
    unsigned voffA[2], voffB[2];
#pragma unroll
    for (int i = 0; i < 2; ++i) { int R, C; stage_rc(tid * 16 + i * 8192, R, C); const int Rb = (R & ~31) + perm32(R & 31);
        voffA[i] = (unsigned)(R * K + C) * 2u; voffB[i] = (unsigned)(Rb * K + C) * 2u; }
    const size_t kstep = (size_t)(BK * 2);
    const size_t hstep = (size_t)HALF * K * 2;
    const unsigned ldsw = (unsigned)wid * 1024u;
    const int aoff = lds_byte(wr * 64 + fr, fq * 8), boff = lds_byte(wc * 32 + fr, fq * 8);
#define PG8_SA(b, h) (((b) * 2 + (h)) * HTB)
#define PG8_SB(b, h) ((4 + (b) * 2 + (h)) * HTB)
#define PG8_STAGE(bufoff, gbase, voff) do { _Pragma("unroll") for (int _i = 0; _i < 2; ++_i) \
        __builtin_amdgcn_global_load_lds((const unsigned*)((const char*)(gbase) + (voff)[_i]), (LAS unsigned*)(lds + (bufoff) + ldsw + _i * 8192), 16, 0, 0); } while (0)
#define PG8_LDA(dst, b, h) do { _Pragma("unroll") for (int m = 0; m < 4; ++m) _Pragma("unroll") for (int k = 0; k < 2; ++k) dst[m][k] = *(const LAS bf16x8*)(lds + PG8_SA(b, h) + aoff + m * 2048 + k * 1024); } while (0)
#define PG8_LDB(dst, b, h) do { _Pragma("unroll") for (int n = 0; n < 2; ++n) _Pragma("unroll") for (int k = 0; k < 2; ++k) dst[n][k] = *(const LAS bf16x8*)(lds + PG8_SB(b, h) + boff + n * 2048 + k * 1024); } while (0)
#define PG8_MMA(ai, bj, At, Bt) do { __builtin_amdgcn_s_setprio(1); _Pragma("unroll") for (int m = 0; m < 4; ++m) _Pragma("unroll") for (int n = 0; n < 2; ++n) _Pragma("unroll") for (int k = 0; k < 2; ++k) \
        acc[ai][bj][m][n] = __builtin_amdgcn_mfma_f32_16x16x32_bf16(Bt[n][k], At[m][k], acc[ai][bj][m][n], 0, 0, 0); __builtin_amdgcn_s_setprio(0); } while (0)
#define PG8_WAIT_V(n) asm volatile("s_waitcnt vmcnt(" #n ")" ::: "memory")
#define PG8_WAIT_L(n) asm volatile("s_waitcnt lgkmcnt(" #n ")" ::: "memory")
#define PG8_BAR __builtin_amdgcn_s_barrier()
#define PG8_SCHED __builtin_amdgcn_sched_barrier(0)
    Unit cur, nxt; int ui = 0;
    if (!S.next(0, cur)) return;
    f32x4 acc[2][2][4][2];
#pragma unroll
    for (int a = 0; a < 2; ++a)
#pragma unroll
        for (int b = 0; b < 2; ++b)
#pragma unroll
            for (int m = 0; m < 4; ++m)
#pragma unroll
                for (int n = 0; n < 2; ++n) acc[a][b][m][n] = (f32x4){0.f, 0.f, 0.f, 0.f};
    bf16x8 At[4][2], B0[2][2], B1[2][2];
    const char* cA = (const char*)S.aptr(cur); const char* cB = (const char*)S.bptr(cur);
    PG8_STAGE(PG8_SB(0, 0), cB, voffB); PG8_STAGE(PG8_SA(0, 0), cA, voffA); PG8_STAGE(PG8_SB(0, 1), cB + hstep, voffB); PG8_STAGE(PG8_SA(0, 1), cA + hstep, voffA);
    if (wr == 1) PG8_BAR;
    PG8_WAIT_V(4); PG8_BAR;
    PG8_STAGE(PG8_SB(1, 0), cB + kstep, voffB); PG8_STAGE(PG8_SA(1, 0), cA + kstep, voffA); PG8_STAGE(PG8_SB(1, 1), cB + hstep + kstep, voffB);
    PG8_WAIT_V(6); PG8_BAR;
    for (;;) {
        const bool has_next = S.next(ui + 1, nxt);
        const char* nA = has_next ? (const char*)S.aptr(nxt) : cA; const char* nB = has_next ? (const char*)S.bptr(nxt) : cB;
        for (int t = 0; t < nt; t += 2) {
            const bool last = (t == nt - 2);
            const char* a1 = cA + (size_t)(t + 1) * kstep;
            const char* a2 = last ? nA : cA + (size_t)(t + 2) * kstep; const char* b2 = last ? nB : cB + (size_t)(t + 2) * kstep;
            const char* a3 = a2 + kstep; const char* b3 = b2 + kstep;
            PG8_LDB(B0, 0, 0); PG8_SCHED; PG8_LDA(At, 0, 0); PG8_STAGE(PG8_SA(1, 1), a1 + hstep, voffA);
            PG8_WAIT_L(8); PG8_BAR; PG8_WAIT_L(0); PG8_MMA(0, 0, At, B0); PG8_BAR; PG8_SCHED;
            PG8_LDB(B1, 0, 1); PG8_STAGE(PG8_SB(0, 0), b2, voffB);
            PG8_BAR; PG8_WAIT_L(0); PG8_MMA(0, 1, At, B1); PG8_BAR;
            PG8_LDA(At, 0, 1); PG8_STAGE(PG8_SA(0, 0), a2, voffA);
            PG8_BAR; PG8_WAIT_L(0); PG8_MMA(1, 0, At, B0); PG8_BAR; PG8_SCHED;
            PG8_STAGE(PG8_SB(0, 1), b2 + hstep, voffB);
            PG8_WAIT_V(6); PG8_BAR; PG8_MMA(1, 1, At, B1); PG8_BAR;
            PG8_LDB(B0, 1, 0); PG8_SCHED; PG8_LDA(At, 1, 0); PG8_STAGE(PG8_SA(0, 1), a2 + hstep, voffA);
            PG8_WAIT_L(8); PG8_BAR; PG8_WAIT_L(0); PG8_MMA(0, 0, At, B0); PG8_BAR; PG8_SCHED;
            PG8_LDB(B1, 1, 1); PG8_STAGE(PG8_SB(1, 0), b3, voffB);
            PG8_BAR; PG8_WAIT_L(0); PG8_MMA(0, 1, At, B1); PG8_BAR;
            PG8_LDA(At, 1, 1); PG8_STAGE(PG8_SA(1, 0), a3, voffA);
            PG8_BAR; PG8_WAIT_L(0); PG8_MMA(1, 0, At, B0); PG8_BAR; PG8_SCHED;
            PG8_STAGE(PG8_SB(1, 1), b3 + hstep, voffB);
            PG8_WAIT_V(6); PG8_BAR; PG8_MMA(1, 1, At, B1); PG8_BAR;
        }
        int efr = fr, efq = fq; asm volatile("" : "+v"(efr), "+v"(efq));
        if constexpr (Epi::BATCHED) E.tile(acc, cur, wr, wc, efr, efq); else
#pragma unroll
        for (int ai = 0; ai < 2; ++ai)
#pragma unroll
            for (int m = 0; m < 4; ++m) {
                const int r = ai * HALF + wr * 64 + m * 16 + efr;
                if constexpr (Epi::PAIR) {
                    const float g[8] = {acc[ai][0][m][0][0], acc[ai][0][m][0][1], acc[ai][0][m][0][2], acc[ai][0][m][0][3], acc[ai][0][m][1][0], acc[ai][0][m][1][1], acc[ai][0][m][1][2], acc[ai][0][m][1][3]};
                    const float up[8] = {acc[ai][1][m][0][0], acc[ai][1][m][0][1], acc[ai][1][m][0][2], acc[ai][1][m][0][3], acc[ai][1][m][1][0], acc[ai][1][m][1][1], acc[ai][1][m][1][2], acc[ai][1][m][1][3]};
                    E.row8p(cur, r, wc * 32 + 8 * efq, g, up);
                } else {
#pragma unroll
                    for (int bj = 0; bj < 2; ++bj) {
                        const float v[8] = {acc[ai][bj][m][0][0], acc[ai][bj][m][0][1], acc[ai][bj][m][0][2], acc[ai][bj][m][0][3], acc[ai][bj][m][1][0], acc[ai][bj][m][1][1], acc[ai][bj][m][1][2], acc[ai][bj][m][1][3]};
                        E.row8(cur, r, bj * HALF + wc * 32 + 8 * efq, v);
                    }
                }
            }
        if (!has_next) break;
#pragma unroll
        for (int a = 0; a < 2; ++a)
#pragma unroll
            for (int b = 0; b < 2; ++b)
#pragma unroll
                for (int m = 0; m < 4; ++m)
#pragma unroll
                    for (int n = 0; n < 2; ++n) acc[a][b][m][n] = (f32x4){0.f, 0.f, 0.f, 0.f};
        cur = nxt; cA = nA; cB = nB; ++ui;
    }
    PG8_WAIT_V(0);
    if (wr == 0) PG8_BAR;
    PG8_BAR;
#undef PG8_SA
#undef PG8_SB
#undef PG8_STAGE
#undef PG8_LDA
#undef PG8_LDB
#undef PG8_MMA
#undef PG8_WAIT_V
#undef PG8_WAIT_L
#undef PG8_BAR
#undef PG8_SCHED
}

template <class Sched, class Epi>
DI void gemm_naive(LAS unsigned char* lds, int tid, const Sched& S, const Epi& E) {
    LAS float* As = (LAS float*)lds;
    LAS float* Bs = As + 32 * 132;
    LAS float* Bu = Bs + 32 * 132;
    const int ty = tid >> 4, tx = tid & 15, lr = tid >> 2, kq = tid & 3;
    Unit u;
    for (int i = 0; S.next(i, u); ++i) {
        const bf16* A = S.aptr(u); const bf16* B = S.bptr(u);
        for (int sm = 0; sm < 2; ++sm)
            for (int sn = 0; sn < (Epi::PAIR ? 1 : 2); ++sn) {
                float acc[4][8], accu[4][8];
#pragma unroll
                for (int a = 0; a < 4; ++a)
#pragma unroll
                    for (int b = 0; b < 8; ++b) { acc[a][b] = 0.f; accu[a][b] = 0.f; }
                for (int k0 = 0; k0 < 1024; k0 += 32) {
                    __syncthreads();
                    { float w[8]; unpack8(*(const u32x4*)(A + (size_t)(128 * sm + lr) * 1024 + k0 + 8 * kq), w);
#pragma unroll
                      for (int j = 0; j < 8; ++j) As[(8 * kq + j) * 132 + lr] = w[j];
                      unpack8(*(const u32x4*)(B + (size_t)(128 * sn + lr) * 1024 + k0 + 8 * kq), w);
#pragma unroll
                      for (int j = 0; j < 8; ++j) Bs[(8 * kq + j) * 132 + lr] = w[j];
                      if (Epi::PAIR) { unpack8(*(const u32x4*)(B + (size_t)(128 + lr) * 1024 + k0 + 8 * kq), w);
#pragma unroll
                          for (int j = 0; j < 8; ++j) Bu[(8 * kq + j) * 132 + lr] = w[j]; } }
                    __syncthreads();
#pragma unroll 4
                    for (int k = 0; k < 32; ++k) {
                        const f32x4 a4 = *(const LAS f32x4*)(As + k * 132 + 4 * ty);
                        const f32x4 b0 = *(const LAS f32x4*)(Bs + k * 132 + 8 * tx), b1 = *(const LAS f32x4*)(Bs + k * 132 + 8 * tx + 4);
#pragma unroll
                        for (int a = 0; a < 4; ++a) {
#pragma unroll
                            for (int b = 0; b < 4; ++b) { acc[a][b] += a4[a] * b0[b]; acc[a][4 + b] += a4[a] * b1[b]; } }
                        if (Epi::PAIR) {
                            const f32x4 c0 = *(const LAS f32x4*)(Bu + k * 132 + 8 * tx), c1 = *(const LAS f32x4*)(Bu + k * 132 + 8 * tx + 4);
#pragma unroll
                            for (int a = 0; a < 4; ++a) {
#pragma unroll
                                for (int b = 0; b < 4; ++b) { accu[a][b] += a4[a] * c0[b]; accu[a][4 + b] += a4[a] * c1[b]; } }
                        }
                    }
                }
#pragma unroll
                for (int a = 0; a < 4; ++a) {
                    if constexpr (Epi::PAIR) E.row8p(u, 128 * sm + 4 * ty + a, 8 * tx, acc[a], accu[a]);
                    else E.row8(u, 128 * sm + 4 * ty + a, 128 * sn + 8 * tx, acc[a]);
                }
            }
    }
    __syncthreads();
}
template <class Sched, class Epi>
DI void gemm_run(LAS unsigned char* lds, int tid, const Sched& S, const Epi& E) {
#if FAST_GEMM
    gemm_fast(lds, tid, S, E);
#else
    gemm_naive(lds, tid, S, E);
#endif
}

struct Ctx {
    LAS unsigned char* lds;
    int tid, lane, wave, gw, ngw;
    unsigned z;
    const float* const __attribute__((address_space(4)))* in;
    float* out;
    unsigned char* ws;
};
#define WSP(T, off) ((T*)(c.ws + (off)))

DI void transpose_item(const float* W, int N, bf16* WT, int k0, int n0, int dst_row0, LAS float* scr, int lane) {
#pragma unroll 8
    for (int i = 0; i < 32; ++i) { const int kk = 2 * i + (lane >> 5); scr[kk * 33 + (lane & 31)] = __builtin_nontemporal_load(W + (size_t)(k0 + kk) * N + n0 + (lane & 31)); }
    asm volatile("s_waitcnt lgkmcnt(0)" ::: "memory");
    const int cc = lane & 7;
#pragma unroll
    for (int j = 0; j < 4; ++j) { const int n = (lane >> 3) + 8 * j; const LAS float* s = scr + (8 * cc) * 33 + n;
        u32x4 o; o.x = cvt_pk_bf16(s[0 * 33], s[1 * 33]); o.y = cvt_pk_bf16(s[2 * 33], s[3 * 33]); o.z = cvt_pk_bf16(s[4 * 33], s[5 * 33]); o.w = cvt_pk_bf16(s[6 * 33], s[7 * 33]);
        *(u32x4*)(WT + (size_t)(dst_row0 + n) * 1024 + k0 + 8 * cc) = o; }
    asm volatile("s_waitcnt lgkmcnt(0)" ::: "memory");
}
DI void dense_transpose(const Ctx& c, const float* W, int N, bf16* WT, LAS float* scr) {
    const int nblk = N / 32, nitems = 16 * nblk;
    for (int it = c.gw; it < nitems; it += c.ngw) { const int kb = it / nblk, nb = it % nblk; transpose_item(W, N, WT, 64 * kb, 32 * nb, 32 * nb, scr, c.lane); }
}
DI void phase_pro0(const Ctx& c) {
    LAS float* scr = (LAS float*)(c.lds + c.wave * 8704);
    for (int j = 0; j < 2; ++j) {
        dense_transpose(c, c.in[I_MLWIN] + (size_t)j * 1024 * 3104, 3104, WSP(bf16, WS_ML_WIN) + (size_t)j * NINP * 1024, scr);
        dense_transpose(c, c.in[I_MLWOUT] + (size_t)j * 1024 * 1024, 1024, WSP(bf16, WS_ML_WOUT) + (size_t)j * 1024 * 1024, scr);
    }
    dense_transpose(c, c.in[I_GLWIN], 3104, WSP(bf16, WS_GLA_WIN), scr);
    dense_transpose(c, c.in[I_GLWOUT], 1024, WSP(bf16, WS_GLA_WOUT), scr);
    dense_transpose(c, c.in[I_HYWIN], 3072, WSP(bf16, WS_HY_WIN), scr);
    dense_transpose(c, c.in[I_HYWOUT], 1024, WSP(bf16, WS_HY_WOUT), scr);
    for (int it = c.gw * 64 + c.lane; it < 3 * 28672; it += c.ngw * 64) {
        const int m = it / 28672, r = it % 28672; bf16* base = (m < 2) ? WSP(bf16, WS_ML_WIN) + (size_t)m * NINP * 1024 : WSP(bf16, WS_GLA_WIN);
        *(u32x4*)(base + (size_t)3104 * 1024 + (size_t)r * 8) = (u32x4){c.z, c.z, c.z, c.z};
    }
    for (int it = c.gw; it < 64 * 3 * 512; it += c.ngw) {
        const int le = it / 1536, r0 = it % 1536, which = r0 / 512, r = r0 % 512, kb = r / 32, nb = r % 32;
        if (which < 2) {
            const float* W = c.in[which == 0 ? I_EW1 : I_EW3] + (size_t)le * 1024 * 1024;
            const int n0 = 32 * nb, drow = 256 * (n0 >> 7) + (n0 & 127) + (which ? 128 : 0);
            transpose_item(W, 1024, WSP(bf16, WS_EXP_UP) + (size_t)le * 2048 * 1024, 64 * kb, n0, drow, scr, c.lane);
        } else {
            transpose_item(c.in[I_EW2] + (size_t)le * 1024 * 1024, 1024, WSP(bf16, WS_EXP_DN) + (size_t)le * 1024 * 1024, 64 * kb, 32 * nb, 32 * nb, scr, c.lane);
        }
    }
    for (int i = blockIdx.x * 512 + c.tid; i < 16 * 1024; i += gridDim.x * 512) WSP(float, WS_RWT)[i] = c.in[I_RW][(i & 1023) * 16 + (i >> 10)];
    {
        const float* w1 = c.in[I_HYFW1]; const float* b1 = c.in[I_HYFB1]; const float* wm = c.in[I_HYFWM]; const float* bm = c.in[I_HYFBM]; const float* fr = c.in[I_HYFREQ];
        float* HM = WSP(float, WS_HM);
        for (int row = c.gw; row < 2304; row += c.ngw) {
            const int L = row < 2048 ? 2048 : 256, t = row < 2048 ? row : row - 2048, f = c.lane;
            float feat = 0.f;
            if (f == 0) feat = (float)t / (float)(L - 1);
            else if (f <= 32) { const int b = (f - 1) & 15; const float band = 1e-4f + (float)b * ((15.0f - 1e-4f) / 15.0f);
                const float ang = ((float)(2.0 * 3.14159265358979323846 / (double)L) * (float)t) * band; feat = (f <= 16) ? cosf(ang) : -sinf(ang); }
            float a = b1[f];
            for (int e = 0; e < 33; ++e) a += __shfl(feat, e) * w1[e * 64 + f];
            float h = sinf(fr[f] * a);
            for (int m = 0; m < 2; ++m) {
                float a2 = bm[m * 64 + f];
                for (int g = 0; g < 64; ++g) a2 += __shfl(h, g) * wm[m * 4096 + g * 64 + f];
                h = sinf(fr[f] * a2);
            }
            HM[row * 64 + f] = h;
        }
    }
    __syncthreads();
    {
        LAS float* sv = (LAS float*)c.lds;
        LAS float* red = sv + 9 * 1024;
        for (int i = c.tid; i < 9 * 1024; i += 512) { const float x = (i < 8192) ? c.in[I_C][i] : c.in[I_CCTX][i - 8192]; sv[i] = siluf_(x); }
        __syncthreads();
        float* MOD = WSP(float, WS_MOD);
        const int col = c.tid & 63, kg = c.tid >> 6;
        for (int item = blockIdx.x; item < 4 * 96; item += gridDim.x) {
            const int l = item / 96, j0 = 64 * (item % 96);
            const float* w = c.in[I_ADAW] + (size_t)l * 1024 * 6144 + j0 + col;
            float acc[9];
#pragma unroll
            for (int r = 0; r < 9; ++r) acc[r] = 0.f;
            for (int k = kg * 128; k < kg * 128 + 128; ++k) { const float wv = w[(size_t)k * 6144];
#pragma unroll
                for (int r = 0; r < 9; ++r) acc[r] += sv[r * 1024 + k] * wv; }
#pragma unroll
            for (int r = 0; r < 9; ++r) red[(kg * 9 + r) * 64 + col] = acc[r];
            __syncthreads();
            for (int o = c.tid; o < 9 * 64; o += 512) { const int r = o >> 6, cc = o & 63; float s = c.in[I_ADAB][l * 6144 + j0 + cc];
#pragma unroll
                for (int g = 0; g < 8; ++g) s += red[(g * 9 + r) * 64 + cc];
                MOD[(l * 9 + r) * 6144 + j0 + cc] = s; }
            __syncthreads();
        }
    }
}

template <int L>
DI void pro1_len(const Ctx& c, int c0, const float* hm, float* tab, LAS float* hmT  , const LAS f32x4* wo4  , float (&part)[4]) {
    const int side = c.wave & 1, ts = c.wave >> 1;
    const float da = -4.605170185988091f / 1.5f, db = -4.605170185988091f / 0.3f;
#pragma unroll 1
    for (int t0 = 0; t0 < L; t0 += 256) {
        __syncthreads();
#pragma unroll
        for (int k = 0; k < 8; ++k) { const int idx = c.tid + 512 * k, row = idx >> 4, q = idx & 15; const f32x4 v = *(const f32x4*)(hm + (size_t)(t0 + row) * 64 + 4 * q);
            LAS float* d = hmT + row * 65 + 4 * q; d[0] = v.x; d[1] = v.y; d[2] = v.z; d[3] = v.w; }
        __syncthreads();
        const int t = t0 + 64 * ts + c.lane; const LAS float* hr = hmT + (64 * ts + c.lane) * 65;
        f32x4 acc = {0.f, 0.f, 0.f, 0.f};
#pragma unroll 8
        for (int f = 0; f < 64; ++f) acc += wo4[side * 64 + f] * hr[f];
        const float tl = (float)t / (float)(L - 1);
#pragma unroll
        for (int ch = 0; ch < 4; ++ch) { const float delta = fabsf(da + (float)(c0 + ch) * ((db - da) / 1023.0f)), v = acc[ch] * expf(-tl * delta);
            float* trow = tab + (size_t)(c0 + ch) * (2 * L);
            if (side == 0) { trow[L + t] = v; part[ch] += fabsf(v); }
            else if (t >= 1) { trow[L - t] = v; part[ch] += fabsf(v); }
            else trow[0] = 0.f; }
    }
}
template <int L>
DI void pro1_scale(const Ctx& c, int c0, float* tab, const float (&inv)[4]) {
    const int side = c.wave & 1, ts = c.wave >> 1;
#pragma unroll 1
    for (int t0 = 0; t0 < L; t0 += 256) { const int t = t0 + 64 * ts + c.lane;
#pragma unroll
        for (int ch = 0; ch < 4; ++ch) { float* trow = tab + (size_t)(c0 + ch) * (2 * L); if (side == 0) trow[L + t] *= inv[ch]; else if (t >= 1) trow[L - t] *= inv[ch]; } }
}
DI void pro1_reduce(const Ctx& c, float (&part)[4], LAS float* red, float (&inv)[4]) {
#pragma unroll
    for (int ch = 0; ch < 4; ++ch) part[ch] = wave_sum(part[ch]);
    __syncthreads();
    if (c.lane == 0) {
#pragma unroll
        for (int ch = 0; ch < 4; ++ch) red[c.wave * 4 + ch] = part[ch]; }
    __syncthreads();
#pragma unroll
    for (int ch = 0; ch < 4; ++ch) { float s = 0.f;
#pragma unroll
        for (int w = 0; w < 8; ++w) s += red[w * 4 + ch];
        inv[ch] = 1.0f / s; }
}
DI void phase_pro1(const Ctx& c) {
    LAS float* hmT = (LAS float*)c.lds; LAS f32x4* wo4 = (LAS f32x4*)(c.lds + 67584); LAS float* red = (LAS float*)(c.lds + 67584 + 2048);
    const float* HM = WSP(float, WS_HM);
    for (int item = blockIdx.x; item < 256; item += gridDim.x) {
        const int c0 = 4 * item;
        __syncthreads();
        if (c.tid < 128) wo4[c.tid] = *(const f32x4*)(c.in[I_HYFWO] + (size_t)(c.tid & 63) * 2048 + (c.tid >> 6) * 1024 + c0);
        float part[4] = {0.f, 0.f, 0.f, 0.f}, inv[4];
        pro1_len<SEQ>(c, c0, HM, WSP(float, WS_HF), hmT, wo4, part);
        pro1_reduce(c, part, red, inv);
        pro1_scale<SEQ>(c, c0, WSP(float, WS_HF), inv);
        float part2[4] = {0.f, 0.f, 0.f, 0.f};
        pro1_len<CTX>(c, c0, HM + 2048 * 64, WSP(float, WS_HFC), hmT, wo4, part2);
        pro1_reduce(c, part2, red, inv);
        pro1_scale<CTX>(c, c0, WSP(float, WS_HFC), inv);
    }
}

DI void load_row(const float* src, f32x4 (&v)[4], int lane) {
#pragma unroll
    for (int j = 0; j < 4; ++j) v[j] = __builtin_nontemporal_load((const f32x4*)(src + 256 * j + 4 * lane));
}
DI void load_row_bf(const bf16* src, f32x4 (&v)[4], int lane) {
#pragma unroll
    for (int j = 0; j < 4; ++j) { const u32x2 a = __builtin_nontemporal_load((const u32x2*)(src + 256 * j + 4 * lane));
        v[j] = (f32x4){__uint_as_float(a.x << 16), __uint_as_float(a.x & 0xffff0000u), __uint_as_float(a.y << 16), __uint_as_float(a.y & 0xffff0000u)}; }
}
DI void norm_row(f32x4 (&v)[4], const float* g, int lane) {
    float s = 0.f;
#pragma unroll
    for (int j = 0; j < 4; ++j) s += (v[j].x * v[j].x + v[j].y * v[j].y) + (v[j].z * v[j].z + v[j].w * v[j].w);
    s = wave_sum(s);
    const float r = 1.0f / sqrtf(s * (1.0f / 1024.0f) + EPS);
#pragma unroll
    for (int j = 0; j < 4; ++j) v[j] = v[j] * r * *(const f32x4*)(g + 256 * j + 4 * lane);
}
DI void mod_row(f32x4 (&v)[4], const float* sh, const float* sc, int lane) {
#pragma unroll
    for (int j = 0; j < 4; ++j) v[j] = v[j] * (*(const f32x4*)(sc + 256 * j + 4 * lane) + 1.0f) + *(const f32x4*)(sh + 256 * j + 4 * lane);
}
DI void store_row_bf16(bf16* dst, const f32x4 (&v)[4], int lane) {
#pragma unroll
    for (int j = 0; j < 4; ++j) { u32x2 w; w.x = cvt_pk_bf16(v[j].x, v[j].y); w.y = cvt_pk_bf16(v[j].z, v[j].w); *(u32x2*)(dst + 256 * j + 4 * lane) = w; }
}
DI int hrow_of(int srow, int kind) {
    if (srow < TC || kind != 1) return srow;
    const int rr = srow - TC, b = rr >> 11, s = rr & (SEQ - 1); return TC + b * SEQ + perm_fwd(s);
}
DI void phase_norm1(const Ctx& c, int l, const float* xl, const float* xc) {
    const float* MOD = WSP(float, WS_MOD) + (size_t)l * 9 * 6144; const float* g = c.in[I_N1G] + l * D; bf16* H = WSP(bf16, WS_H);
    for (int row = c.gw; row < TT; row += c.ngw) {
        f32x4 v[4]; const int mr = row < TC ? 8 : (row - TC) >> 11;
        load_row(row < TC ? xc + (size_t)row * D : xl + (size_t)(row - TC) * D, v, c.lane);
        norm_row(v, g, c.lane); mod_row(v, MOD + mr * 6144, MOD + mr * 6144 + 1024, c.lane);
        store_row_bf16(H + (size_t)hrow_of(row, l % 3) * D, v, c.lane);
    }
}

DI void phase_conv(const Ctx& c, int ncols, const float* cw, const float* cb, bool act, float qs) {
    const bf16* P = WSP(bf16, WS_P); bf16* PC = WSP(bf16, WS_BIG + BIG_PC);
    const int ng = ncols / 8; const long total = (long)TT * ng;
    for (long idx = (long)blockIdx.x * 512 + c.tid; idx < total; idx += (long)gridDim.x * 512) {
        const int row = (int)(idx / ng), col = (int)(idx % ng) * 8; int lo, hi; seq_bounds(row, lo, hi);
        float x0[8], xm[8], xp[8];
        unpack8(*(const u32x4*)(P + (size_t)row * PLD + col), x0);
        if (row > lo) unpack8(*(const u32x4*)(P + (size_t)(row - 1) * PLD + col), xm); else {
#pragma unroll
            for (int j = 0; j < 8; ++j) xm[j] = 0.f; }
        if (row < hi) unpack8(*(const u32x4*)(P + (size_t)(row + 1) * PLD + col), xp); else {
#pragma unroll
            for (int j = 0; j < 8; ++j) xp[j] = 0.f; }
        float o[8];
#pragma unroll
        for (int j = 0; j < 8; ++j) { float v = cw[col + j] * xm[j] + cw[ncols + col + j] * x0[j] + cw[2 * ncols + col + j] * xp[j] + cb[col + j];
            if (act) v = siluf_(v); if (col < 512) v *= qs; o[j] = v; }
        *(u32x4*)(PC + (size_t)row * ncols + col) = pack8(o);
    }
}

DI int scan_row(int step, int b, int dir) {
    if (step < CTX) return b * CTX + (dir ? CTX - 1 - step : step);
    const int s = step - CTX; return TC + b * SEQ + (dir ? SEQ - 1 - s : s);
}
DI void phase_mlstm_scan_naive(const Ctx& c) {
    const bf16* P = WSP(bf16, WS_P); const bf16* PC = WSP(bf16, WS_BIG + BIG_PC); const float* EX = WSP(float, WS_EXTRA);
    LAS float* qs = (LAS float*)c.lds; LAS float* ks = qs + 32 * 64; LAS float* vs = ks + 32 * 64; LAS float* gs = vs + 32 * 128;
    const int v = c.tid >> 2, d0 = (c.tid & 3) * 16;
    for (int item = blockIdx.x; item < 128; item += gridDim.x) {
        const int b = item >> 4, h = (item >> 1) & 7, dir = item & 1;
        float* Yo = WSP(float, WS_BIG + (dir ? BIG_YB : BIG_YF));
        float C[16], n[16];
#pragma unroll
        for (int d = 0; d < 16; ++d) { C[d] = 0.f; n[d] = 0.f; }
        for (int ch = 0; ch < (CTX + SEQ) / 32; ++ch) {
            __syncthreads();
            for (int idx = c.tid; idx < 32 * 256; idx += 512) { const int st = idx >> 8, col = idx & 255, row = scan_row(ch * 32 + st, b, dir);
                if (col < 64) qs[st * 64 + col] = bf2f(PC[(size_t)row * 1024 + h * 64 + col]);
                else if (col < 128) ks[st * 64 + col - 64] = bf2f(PC[(size_t)row * 1024 + 512 + h * 64 + col - 64]);
                else vs[st * 128 + col - 128] = bf2f(P[(size_t)row * PLD + 1024 + h * 128 + col - 128]); }
            if (c.tid < 32) { const int row = scan_row(ch * 32 + c.tid, b, dir); gs[c.tid * 2] = sigmoidf_(EX[(size_t)row * 32 + dir * 16 + 8 + h]); gs[c.tid * 2 + 1] = __expf(EX[(size_t)row * 32 + dir * 16 + h]); }
            __syncthreads();
            for (int st = 0; st < 32; ++st) {
                const float f = gs[st * 2], ei = gs[st * 2 + 1], vv = vs[st * 128 + v] * ei;
                float part = 0.f, dpart = 0.f;
#pragma unroll
                for (int d = 0; d < 16; ++d) { const float kd = ks[st * 64 + d0 + d], qd = qs[st * 64 + d0 + d];
                    C[d] = f * C[d] + kd * vv; part += qd * C[d]; n[d] = f * n[d] + ei * kd; dpart += qd * n[d]; }
                part += __shfl_xor(part, 1); part += __shfl_xor(part, 2); dpart += __shfl_xor(dpart, 1); dpart += __shfl_xor(dpart, 2);
                if ((c.tid & 3) == 0) { const int row = scan_row(ch * 32 + st, b, dir); Yo[(size_t)row * D + h * 128 + v] = part / fmaxf(fabsf(dpart), 1.0f); }
            }
        }
    }
}
typedef short s16x4 __attribute__((ext_vector_type(4)));
typedef float f32x16 __attribute__((ext_vector_type(16)));
#define MFMA32(a, b, c) __builtin_amdgcn_mfma_f32_32x32x16_bf16((a), (b), (c), 0, 0, 0)
DI int crow(int reg, int h) { return (reg & 3) + 8 * (reg >> 2) + 4 * h; }
DI s16x4 ds_tr(const LAS unsigned char* p) { return __builtin_amdgcn_ds_read_tr16_b64_v4i16((LAS s16x4*)p); }
DI bf16x8 cat8(s16x4 lo, s16x4 hi) { return __builtin_shufflevector(lo, hi, 0, 1, 2, 3, 4, 5, 6, 7); }
DI bf16x8 tr_frag(const LAS unsigned char* img, int pitch, int k0, int n0, int lane) {
    const int h = lane >> 5, g16 = (lane >> 4) & 1, i = lane & 15;
    const LAS unsigned char* p = img + (k0 + 8 * h + (i >> 2)) * pitch + (n0 + 16 * g16 + 4 * (i & 3)) * 2;
    return cat8(ds_tr(p), ds_tr(p + 4 * pitch));
}
DI bf16x8 tr_frag_perm(const LAS unsigned char* img, int pitch, int k0, int n0, int lane) {
    const int h = lane >> 5, g16 = (lane >> 4) & 1, i = lane & 15;
    const LAS unsigned char* p = img + (k0 + 4 * h + (i >> 2)) * pitch + (n0 + 16 * g16 + 4 * (i & 3)) * 2;
    return cat8(ds_tr(p), ds_tr(p + 8 * pitch));
}
DI bf16x8 row_frag(const LAS unsigned char* img, int pitch, int row0, int k0, int lane) { return *(const LAS bf16x8*)(img + (row0 + (lane & 31)) * pitch + (k0 + 8 * (lane >> 5)) * 2); }
DI bf16x8 pack_acc(const f32x16& x, int step) {
    u32x4 p; const int o = 8 * step;
    p.x = cvt_pk_bf16(x[o], x[o + 1]); p.y = cvt_pk_bf16(x[o + 2], x[o + 3]); p.z = cvt_pk_bf16(x[o + 4], x[o + 5]); p.w = cvt_pk_bf16(x[o + 6], x[o + 7]);
    return __builtin_bit_cast(bf16x8, p);
}
DI f32x16 zero16() { f32x16 z;
#pragma unroll
    for (int i = 0; i < 16; ++i) z[i] = 0.f; return z; }
DI float wave_incl_prefix(float x, int lane) {
#pragma unroll
    for (int o = 1; o < 64; o <<= 1) { const float t = __shfl_up(x, o); if (lane >= o) x += t; }
    return x;
}
DI float wave_incl_suffix(float x, int lane) {
#pragma unroll
    for (int o = 1; o < 64; o <<= 1) { const float t = __shfl_down(x, o); if (lane + o < 64) x += t; }
    return x;
}
DI int chunk_row0(int p, int b, int dir) {
    if (p < 4) return b * CTX + 64 * (dir ? 3 - p : p);
    return TC + b * SEQ + 64 * (dir ? 35 - p : p - 4);
}

DI void phase_mlstm_state(const Ctx& c) {
    const bf16* P = WSP(bf16, WS_P); const bf16* PC = WSP(bf16, WS_BIG + BIG_PC); const float* EX = WSP(float, WS_EXTRA);
    bf16* MCT = WSP(bf16, WS_BIG + BIG_MCT); float* MN = WSP(float, WS_BIG + BIG_MN);
    LAS float* gi = (LAS float*)c.lds; LAS float* ga = gi + 2304; LAS float* wv = ga + 2304; LAS float* dec = wv + 64;
    LAS unsigned char* Kw = c.lds + 20480; LAS unsigned char* Vs = Kw + 64 * 144;
    const int lane = c.lane, wave = c.wave, h5 = lane >> 5, l31 = lane & 31;
    for (int item = blockIdx.x; item < 256; item += gridDim.x) {
        const int b = item >> 5, h = (item >> 2) & 7, dir = (item >> 1) & 1, dvh = item & 1, seq = (b * 8 + h) * 2 + dir;
        __syncthreads();
        for (int idx = c.tid; idx < 2304; idx += 512) { const int row = chunk_row0(idx >> 6, b, dir) + (idx & 63);
            gi[idx] = EX[(size_t)row * 32 + dir * 16 + h]; ga[idx] = logsigf_(EX[(size_t)row * 32 + dir * 16 + 8 + h]); }
        f32x16 acc = zero16(); float nst = 0.f;
        const int dt = wave & 1, vt = (wave >> 1) & 1;
        const int srow = c.tid >> 3, spc = c.tid & 7;
        u32x4 kregA, vregA, kregB, vregB;
#define ML_PREFETCH(p_, kr, vr) do { const int r0_ = chunk_row0((p_), b, dir); \
          kr = *(const u32x4*)(PC + (size_t)(r0_ + srow) * 1024 + 512 + h * 64 + 8 * spc); \
          vr = *(const u32x4*)(P + (size_t)(r0_ + srow) * PLD + 1024 + h * 128 + dvh * 64 + 8 * spc); } while (0)
        ML_PREFETCH(0, kregA, vregA); ML_PREFETCH(1, kregB, vregB);
        __syncthreads();
#define ML_STEP(p, kreg, vreg) do { \
              \
            if (wave < 4) { \
                bf16* dst = MCT + ((size_t)seq * 36 + (p)) * 8192 + (size_t)(dvh * 64 + 32 * vt + l31) * 64 + 32 * dt + 4 * h5; \
                _Pragma("unroll") for (int q = 0; q < 4; ++q) { u32x2 w; w.x = cvt_pk_bf16(acc[4 * q], acc[4 * q + 1]); w.y = cvt_pk_bf16(acc[4 * q + 2], acc[4 * q + 3]); *(u32x2*)(dst + 8 * q) = w; } \
            } else if (wave == 4) { if (dvh == 0) MN[((size_t)seq * 36 + (p)) * 64 + lane] = nst; } \
            else if (wave == 7) { \
                const float a = ga[(p) * 64 + lane]; const float bj = dir ? wave_incl_suffix(a, lane) : wave_incl_prefix(a, lane); \
                const float tot = __shfl(bj, dir ? 0 : 63); \
                wv[lane] = __expf(tot - bj + gi[(p) * 64 + lane]); if (lane == 0) dec[0] = __expf(tot); \
            } \
            lds_barrier(); \
              \
            { float kk[8]; unpack8(kreg, kk); const float w = wv[srow]; \
              _Pragma("unroll") for (int j = 0; j < 8; ++j) kk[j] *= w; \
              *(LAS u32x4*)(Kw + srow * 144 + spc * 16) = pack8(kk); *(LAS u32x4*)(Vs + srow * 144 + spc * 16) = vreg; } \
            if ((p) + 2 < 36) ML_PREFETCH((p) + 2, kreg, vreg); \
            const float d = dec[0];            \
            lds_barrier(); \
              \
            if (wave < 4) { \
                _Pragma("unroll") for (int i = 0; i < 16; ++i) acc[i] *= d; \
                _Pragma("unroll") for (int kk = 0; kk < 4; ++kk) acc = MFMA32(tr_frag(Kw, 144, 16 * kk, 32 * dt, lane), tr_frag(Vs, 144, 16 * kk, 32 * vt, lane), acc); \
            } else if (wave == 4) { \
                float s = 0.f; \
                for (int r = 0; r < 64; ++r) s += bf2f(*(const LAS bf16*)(Kw + r * 144 + lane * 2)); \
                nst = d * nst + s; \
            } } while (0)
        for (int p = 0; p < 36; p += 2) { ML_STEP(p, kregA, vregA); ML_STEP(p + 1, kregB, vregB); }
#undef ML_STEP
#undef ML_PREFETCH
    }
}

DI void phase_mlstm_out(const Ctx& c, const float* ng) {
    const bf16* P = WSP(bf16, WS_P); const bf16* PC = WSP(bf16, WS_BIG + BIG_PC); const float* EX = WSP(float, WS_EXTRA);
    const bf16* MCT = WSP(bf16, WS_BIG + BIG_MCT); const float* MN = WSP(float, WS_BIG + BIG_MN); bf16* Y = WSP(bf16, WS_Y);
    LAS unsigned char* Qs = c.lds; LAS unsigned char* Ks = Qs + 9216; LAS unsigned char* Vs = Ks + 9216;
    LAS unsigned char* CT0 = Vs + 17408;
    LAS float* gt = (LAS float*)(c.lds + MISC_OFF + 1024);
    LAS float* YO = (LAS float*)c.lds;
    const int lane = c.lane, wave = c.wave, h5 = lane >> 5, l31 = lane & 31;
    const int dir = wave >> 2, jt = (wave >> 1) & 1, vh = wave & 1;
    const int srow = c.tid >> 3, spc = c.tid & 7;
    u32x4 pq, pk, pv[2], pct[4], pgate[2]; float pga = 0.f, pgi = 0.f, pgn = 0.f;
#define MO_DECODE(it_) const int b = (it_) / 288, h = ((it_) / 36) & 7, cc = (it_) % 36; \
        const int r0 = cc < 4 ? b * CTX + 64 * cc : TC + b * SEQ + 64 * (cc - 4); const int pf = cc, pb = cc < 4 ? 3 - cc : 39 - cc
#define MO_PREFETCH(it_) do { MO_DECODE(it_); \
        pq = *(const u32x4*)(PC + (size_t)(r0 + srow) * 1024 + h * 64 + 8 * spc); pk = *(const u32x4*)(PC + (size_t)(r0 + srow) * 1024 + 512 + h * 64 + 8 * spc); \
        _Pragma("unroll") for (int i = 0; i < 2; ++i) pv[i] = *(const u32x4*)(P + (size_t)(r0 + srow) * PLD + 1024 + h * 128 + 8 * (spc + 8 * i)); \
        _Pragma("unroll") for (int i = 0; i < 4; ++i) { const int pc = c.tid + 512 * i, d2 = pc >> 10, rr = (pc >> 3) & 127, sp = pc & 7; \
            pct[i] = *(const u32x4*)(MCT + (((size_t)((b * 8 + h) * 2 + d2)) * 36 + (d2 ? pb : pf)) * 8192 + rr * 64 + 8 * sp); } \
        _Pragma("unroll") for (int i = 0; i < 2; ++i) pgate[i] = *(const u32x4*)(P + (size_t)(r0 + srow) * PLD + 2048 + h * 128 + 16 * spc + 8 * i); \
        if (wave < 2) { const int d2 = wave, row = r0 + lane; pga = EX[(size_t)row * 32 + d2 * 16 + 8 + h]; pgi = EX[(size_t)row * 32 + d2 * 16 + h]; \
            pgn = MN[(((size_t)((b * 8 + h) * 2 + d2)) * 36 + (d2 ? pb : pf)) * 64 + lane]; } } while (0)
    if ((int)blockIdx.x < 2304) MO_PREFETCH((int)blockIdx.x);
    for (int item = blockIdx.x; item < 2304; item += gridDim.x) {
        MO_DECODE(item); (void)pf; (void)pb;
        lds_barrier();
        *(LAS u32x4*)(Qs + srow * 144 + spc * 16) = pq; *(LAS u32x4*)(Ks + srow * 144 + spc * 16) = pk;
#pragma unroll
        for (int i = 0; i < 2; ++i) *(LAS u32x4*)(Vs + srow * 272 + (spc + 8 * i) * 16) = pv[i];
#pragma unroll
        for (int i = 0; i < 4; ++i) { const int pc = c.tid + 512 * i, d2 = pc >> 10, rr = (pc >> 3) & 127, sp = pc & 7; *(LAS u32x4*)(CT0 + d2 * 18432 + rr * 144 + sp * 16) = pct[i]; }
        if (wave < 2) { const int d2 = wave; const float a = logsigf_(pga);
            const float bj = d2 ? wave_incl_suffix(a, lane) : wave_incl_prefix(a, lane);
            gt[d2 * 192 + lane] = bj; gt[d2 * 192 + 64 + lane] = pgi - bj; gt[d2 * 192 + 128 + lane] = pgn; }
        const u32x4 gate0 = pgate[0], gate1 = pgate[1];
        if (item + (int)gridDim.x < 2304) MO_PREFETCH(item + (int)gridDim.x);
        lds_barrier();
        const LAS float* g = gt + dir * 192; const LAS unsigned char* CT = CT0 + dir * 18432;
        const int j = 32 * jt + l31; const float bjj = g[j];
        bf16x8 qf[4];
#pragma unroll
        for (int kk = 0; kk < 4; ++kk) qf[kk] = row_frag(Qs, 144, 32 * jt, 16 * kk, lane);
        float qn = 0.f;
#pragma unroll
        for (int kk = 0; kk < 4; ++kk) { float qv[8]; unpack8(__builtin_bit_cast(u32x4, qf[kk]), qv);
#pragma unroll
            for (int e = 0; e < 8; ++e) qn += qv[e] * g[128 + 16 * kk + 8 * h5 + e]; }
        qn += __shfl_xor(qn, 32);
        f32x16 X[2]; float den = 0.f;
#pragma unroll
        for (int st = 0; st < 2; ++st) {
            X[st] = zero16();
            const bool live = dir ? (st >= jt) : (st <= jt);
            if (live) {
#pragma unroll
                for (int kk = 0; kk < 4; ++kk) X[st] = MFMA32(row_frag(Ks, 144, 32 * st, 16 * kk, lane), qf[kk], X[st]);
#pragma unroll
                for (int r = 0; r < 16; ++r) { const int s = 32 * st + crow(r, h5); const bool ok = dir ? (s >= j) : (s <= j);
                    const float w = ok ? __expf(bjj + g[64 + s]) : 0.f; X[st][r] *= w; den += X[st][r]; }
            }
        }
        den += __shfl_xor(den, 32);
        const float eb = __expf(bjj); den += eb * qn;
        const float scale = 1.0f / fmaxf(fabsf(den), 1.0f);
        f32x16 O[2];
#pragma unroll
        for (int t = 0; t < 2; ++t) {
            const int vt = 2 * vh + t; f32x16 z = zero16(), w = zero16();
#pragma unroll
            for (int st = 0; st < 2; ++st) { const bool live = dir ? (st >= jt) : (st <= jt);
                if (live) {
#pragma unroll
                    for (int step = 0; step < 2; ++step) z = MFMA32(tr_frag_perm(Vs, 272, 32 * st + 16 * step, 32 * vt, lane), pack_acc(X[st], step), z); } }
#pragma unroll
            for (int kk = 0; kk < 4; ++kk) w = MFMA32(row_frag(CT, 144, 32 * vt, 16 * kk, lane), qf[kk], w);
#pragma unroll
            for (int r = 0; r < 16; ++r) O[t][r] = (z[r] + eb * w[r]) * scale;
        }
        lds_barrier();
#pragma unroll
        for (int t = 0; t < 2; ++t) { const int vt = 2 * vh + t;
#pragma unroll
            for (int q = 0; q < 4; ++q) *(LAS f32x4*)(YO + dir * 8448 + j * 132 + 32 * vt + 8 * q + 4 * h5) = (f32x4){O[t][4 * q], O[t][4 * q + 1], O[t][4 * q + 2], O[t][4 * q + 3]}; }
        lds_barrier();
        { const int row = c.tid >> 3, c0 = (c.tid & 7) * 16; float y[16]; float ss = 0.f;
#pragma unroll
          for (int q = 0; q < 4; ++q) { const f32x4 a = *(const LAS f32x4*)(YO + row * 132 + c0 + 4 * q), bb = *(const LAS f32x4*)(YO + 8448 + row * 132 + c0 + 4 * q);
              y[4 * q] = a.x + bb.x; y[4 * q + 1] = a.y + bb.y; y[4 * q + 2] = a.z + bb.z; y[4 * q + 3] = a.w + bb.w; }
#pragma unroll
          for (int q = 0; q < 16; ++q) ss += y[q] * y[q];
          ss += __shfl_xor(ss, 1); ss += __shfl_xor(ss, 2); ss += __shfl_xor(ss, 4);
          const float r = 1.0f / sqrtf(ss * (1.0f / 128.0f) + EPS);
          float g0[8], g1[8];
          unpack8(gate0, g0); unpack8(gate1, g1);
          float o0[8], o1[8];
#pragma unroll
          for (int q = 0; q < 8; ++q) { o0[q] = y[q] * r * ng[h * 128 + c0 + q] * sigmoidf_(g0[q]); o1[q] = y[8 + q] * r * ng[h * 128 + c0 + 8 + q] * sigmoidf_(g1[q]); }
          *(u32x4*)(Y + (size_t)(r0 + row) * D + h * 128 + c0) = pack8(o0); *(u32x4*)(Y + (size_t)(r0 + row) * D + h * 128 + c0 + 8) = pack8(o1); }
    }
#undef MO_PREFETCH
#undef MO_DECODE
}

DI void phase_gla_decay(const Ctx& c) {
    const float* EX = WSP(float, WS_EXTRA); float* GB = WSP(float, WS_BIG + BIG_GB);
    LAS float* w2s = (LAS float*)c.lds; LAS float* gbs = w2s + 2048; LAS float* lgs = gbs + 128; LAS float* segs = lgs + 8192;
    const int srow = c.tid >> 3, dg = c.tid & 7;
    const int dir = (blockIdx.x >> 2) & 1, h = blockIdx.x & 3, nper = gridDim.x >> 3;
    __syncthreads();
    for (int i = c.tid; i < 2048; i += 512) w2s[i] = c.in[I_GLW2][(size_t)dir * 8192 + (i >> 7) * 512 + h * 128 + (i & 127)];
    if (c.tid < 128) gbs[c.tid] = c.in[I_GLGB][dir * 512 + h * 128 + c.tid];
    for (int ck = blockIdx.x >> 3; ck < 288; ck += nper) {
        const int r0 = 64 * ck;
        __syncthreads();
        f32x4 low[4];
#pragma unroll
        for (int q = 0; q < 4; ++q) low[q] = *(const f32x4*)(EX + (size_t)(r0 + srow) * 32 + dir * 16 + 4 * q);
        __syncthreads();
        { const int d0 = 16 * dg; float pre[16];
#pragma unroll
          for (int e = 0; e < 16; ++e) pre[e] = gbs[d0 + e];
#pragma unroll
          for (int r = 0; r < 16; ++r) { const float lv = low[r >> 2][r & 3];
#pragma unroll
              for (int q = 0; q < 4; ++q) { const f32x4 w = *(const LAS f32x4*)(w2s + r * 128 + d0 + 4 * q); pre[4 * q] += lv * w.x; pre[4 * q + 1] += lv * w.y; pre[4 * q + 2] += lv * w.z; pre[4 * q + 3] += lv * w.w; } }
#pragma unroll
          for (int q = 0; q < 4; ++q) *(LAS f32x4*)(lgs + srow * 128 + d0 + 4 * q) = (f32x4){logsigf_(pre[4 * q]) * 0.0625f, logsigf_(pre[4 * q + 1]) * 0.0625f, logsigf_(pre[4 * q + 2]) * 0.0625f, logsigf_(pre[4 * q + 3]) * 0.0625f}; }
        __syncthreads();
        { const int d = c.tid & 127, sg = c.tid >> 7; float v[16];
#pragma unroll
          for (int i = 0; i < 16; ++i) { const int s = dir ? 63 - (16 * sg + i) : 16 * sg + i; v[i] = lgs[s * 128 + d]; }
#pragma unroll
          for (int i = 1; i < 16; ++i) v[i] += v[i - 1];
          segs[sg * 128 + d] = v[15];
          __syncthreads();
          float off = 0.f;
#pragma unroll
          for (int g2 = 0; g2 < 3; ++g2) off += (g2 < sg) ? segs[g2 * 128 + d] : 0.f;
#pragma unroll
          for (int i = 0; i < 16; ++i) { const int s = dir ? 63 - (16 * sg + i) : 16 * sg + i; GB[((size_t)dir * TT + r0 + s) * 512 + h * 128 + d] = v[i] + off; } }
    }
}
DI void phase_gla_state(const Ctx& c) {
    const bf16* PC = WSP(bf16, WS_BIG + BIG_PC); const float* GB = WSP(float, WS_BIG + BIG_GB); bf16* GST = WSP(bf16, WS_BIG + BIG_GST);
    LAS float* tot = (LAS float*)c.lds;
    LAS unsigned char* Kd = c.lds + 1024; LAS unsigned char* Vs = Kd + 64 * 272;
    const int lane = c.lane, wave = c.wave, h5 = lane >> 5, l31 = lane & 31, dkt = wave & 3, dvt = wave >> 2;
    const int srow = c.tid >> 3, dg = c.tid & 7;
    for (int item = blockIdx.x; item < 256; item += gridDim.x) {
        const int b = item >> 5, h = (item >> 3) & 3, dir = (item >> 2) & 1, dvq = item & 3, seq = (b * 4 + h) * 2 + dir;
        f32x16 acc = zero16();
        u32x4 kA0, kA1, vA, kB0, kB1, vB; f32x4 bvA[4], tvA[4], bvB[4], tvB[4];
#define GLA_PREFETCH(p_, k0, k1, vr, bv, tv) do { const int r0_ = chunk_row0((p_), b, dir), row = r0_ + srow; \
          k0 = *(const u32x4*)(PC + (size_t)row * 2048 + 512 + h * 128 + 16 * dg); k1 = *(const u32x4*)(PC + (size_t)row * 2048 + 512 + h * 128 + 16 * dg + 8); \
          vr = *(const u32x4*)(PC + (size_t)row * 2048 + 1024 + h * 256 + dvq * 64 + 8 * dg); \
          _Pragma("unroll") for (int q = 0; q < 4; ++q) { bv[q] = *(const f32x4*)(GB + ((size_t)dir * TT + row) * 512 + h * 128 + 16 * dg + 4 * q); \
              tv[q] = *(const f32x4*)(GB + ((size_t)dir * TT + r0_ + (dir ? 0 : 63)) * 512 + h * 128 + 16 * dg + 4 * q); } } while (0)
        GLA_PREFETCH(0, kA0, kA1, vA, bvA, tvA); GLA_PREFETCH(1, kB0, kB1, vB, bvB, tvB);
#define GLA_STEP(p, k0r, k1r, vr, bv, tv) do { \
            { bf16* dst = GST + ((size_t)seq * 36 + (p)) * 32768 + (size_t)(dvq * 64 + 32 * dvt + l31) * 128 + 32 * dkt + 4 * h5; \
              _Pragma("unroll") for (int q = 0; q < 4; ++q) { u32x2 w; w.x = cvt_pk_bf16(acc[4 * q], acc[4 * q + 1]); w.y = cvt_pk_bf16(acc[4 * q + 2], acc[4 * q + 3]); *(u32x2*)(dst + 8 * q) = w; } } \
            lds_barrier();                                    \
            { float kk[16]; { float t8[8]; unpack8(k0r, t8); \
                _Pragma("unroll") for (int e = 0; e < 8; ++e) kk[e] = t8[e]; unpack8(k1r, t8); \
                _Pragma("unroll") for (int e = 0; e < 8; ++e) kk[8 + e] = t8[e]; } \
              _Pragma("unroll") for (int e = 0; e < 16; ++e) kk[e] *= __expf(tv[e >> 2][e & 3] - bv[e >> 2][e & 3]); \
              const float k0[8] = {kk[0], kk[1], kk[2], kk[3], kk[4], kk[5], kk[6], kk[7]}, k1[8] = {kk[8], kk[9], kk[10], kk[11], kk[12], kk[13], kk[14], kk[15]}; \
              *(LAS u32x4*)(Kd + srow * 272 + dg * 32) = pack8(k0); *(LAS u32x4*)(Kd + srow * 272 + dg * 32 + 16) = pack8(k1); \
              *(LAS u32x4*)(Vs + srow * 144 + dg * 16) = vr; \
              if (srow == 0) { \
                  _Pragma("unroll") for (int q = 0; q < 4; ++q) *(LAS f32x4*)(tot + 16 * dg + 4 * q) = tv[q]; } } \
            if ((p) + 2 < 36) GLA_PREFETCH((p) + 2, k0r, k1r, vr, bv, tv); \
            lds_barrier(); \
            _Pragma("unroll") for (int r = 0; r < 16; ++r) acc[r] *= __expf(tot[32 * dkt + crow(r, h5)]); \
            _Pragma("unroll") for (int kk = 0; kk < 4; ++kk) acc = MFMA32(tr_frag(Kd, 272, 16 * kk, 32 * dkt, lane), tr_frag(Vs, 144, 16 * kk, 32 * dvt, lane), acc); \
            } while (0)
        for (int p = 0; p < 36; p += 2) { GLA_STEP(p, kA0, kA1, vA, bvA, tvA); GLA_STEP(p + 1, kB0, kB1, vB, bvB, tvB); }
#undef GLA_STEP
#undef GLA_PREFETCH
    }
}
DI void phase_gla_out(const Ctx& c, const float* ng) {
    const bf16* P = WSP(bf16, WS_P); const bf16* PC = WSP(bf16, WS_BIG + BIG_PC); const float* GB = WSP(float, WS_BIG + BIG_GB);
    const bf16* GST = WSP(bf16, WS_BIG + BIG_GST); bf16* Y = WSP(bf16, WS_Y);
    LAS unsigned char* Qt = c.lds; LAS unsigned char* Kt = Qt + 17408; LAS unsigned char* Vs = Kt + 17408; LAS unsigned char* STs = Vs + 33792;
    LAS float* YO = (LAS float*)STs;
    const int lane = c.lane, wave = c.wave, h5 = lane >> 5, l31 = lane & 31;
    const int srow = c.tid >> 3, dg = c.tid & 7;
    for (int item = blockIdx.x; item < 1152; item += gridDim.x) {
        const int b = item / 144, h = (item / 36) & 3, cc = item % 36;
        const int r0 = cc < 4 ? b * CTX + 64 * cc : TC + b * SEQ + 64 * (cc - 4);
        __syncthreads();
#pragma unroll
        for (int i = 0; i < 4; ++i) { const int pc = dg + 8 * i; *(LAS u32x4*)(Vs + srow * 528 + pc * 16) = *(const u32x4*)(PC + (size_t)(r0 + srow) * 2048 + 1024 + h * 256 + 8 * pc); }
        f32x16 O[2]; O[0] = zero16(); O[1] = zero16();
        for (int dir = 0; dir < 2; ++dir) {
            const int pslot = dir ? (cc < 4 ? 3 - cc : 39 - cc) : cc;
            if (dir) __syncthreads();
            { const bf16* src = GST + ((size_t)((b * 4 + h) * 2 + dir) * 36 + pslot) * 32768;
#pragma unroll
              for (int i = 0; i < 8; ++i) { const int pc = c.tid + 512 * i, rr = pc >> 4, sp = pc & 15; *(LAS u32x4*)(STs + rr * 272 + sp * 16) = *(const u32x4*)(src + rr * 128 + 8 * sp); } }
            { float qq[16], kk[16], bb[16]; float t8[8];
#pragma unroll
              for (int q = 0; q < 4; ++q) { const f32x4 t4 = *(const f32x4*)(GB + ((size_t)dir * TT + r0 + srow) * 512 + h * 128 + 16 * dg + 4 * q); bb[4 * q] = t4.x; bb[4 * q + 1] = t4.y; bb[4 * q + 2] = t4.z; bb[4 * q + 3] = t4.w; }
              unpack8(*(const u32x4*)(PC + (size_t)(r0 + srow) * 2048 + h * 128 + 16 * dg), t8);
#pragma unroll
              for (int e = 0; e < 8; ++e) qq[e] = t8[e];
              unpack8(*(const u32x4*)(PC + (size_t)(r0 + srow) * 2048 + h * 128 + 16 * dg + 8), t8);
#pragma unroll
              for (int e = 0; e < 8; ++e) qq[8 + e] = t8[e];
              unpack8(*(const u32x4*)(PC + (size_t)(r0 + srow) * 2048 + 512 + h * 128 + 16 * dg), t8);
#pragma unroll
              for (int e = 0; e < 8; ++e) kk[e] = t8[e];
              unpack8(*(const u32x4*)(PC + (size_t)(r0 + srow) * 2048 + 512 + h * 128 + 16 * dg + 8), t8);
#pragma unroll
              for (int e = 0; e < 8; ++e) kk[8 + e] = t8[e];
#pragma unroll
              for (int e = 0; e < 16; ++e) { const float eb = __expf(bb[e]); qq[e] *= eb; kk[e] *= 1.0f / eb; }
              const float q0[8] = {qq[0], qq[1], qq[2], qq[3], qq[4], qq[5], qq[6], qq[7]}, q1[8] = {qq[8], qq[9], qq[10], qq[11], qq[12], qq[13], qq[14], qq[15]};
              const float k0[8] = {kk[0], kk[1], kk[2], kk[3], kk[4], kk[5], kk[6], kk[7]}, k1[8] = {kk[8], kk[9], kk[10], kk[11], kk[12], kk[13], kk[14], kk[15]};
              *(LAS u32x4*)(Qt + srow * 272 + dg * 32) = pack8(q0); *(LAS u32x4*)(Qt + srow * 272 + dg * 32 + 16) = pack8(q1);
              *(LAS u32x4*)(Kt + srow * 272 + dg * 32) = pack8(k0); *(LAS u32x4*)(Kt + srow * 272 + dg * 32 + 16) = pack8(k1); }
            __syncthreads();
#pragma unroll
            for (int jt = 0; jt < 2; ++jt) {
#pragma unroll
                for (int st = 0; st < 2; ++st) {
                    const bool live = dir ? (st >= jt) : (st <= jt);
                    if (live) {
                        f32x16 X = zero16();
#pragma unroll
                        for (int kk = 0; kk < 8; ++kk) X = MFMA32(row_frag(Kt, 272, 32 * st, 16 * kk, lane), row_frag(Qt, 272, 32 * jt, 16 * kk, lane), X);
                        if (st == jt) {
#pragma unroll
                            for (int r = 0; r < 16; ++r) { const int s = crow(r, h5); const bool ok = dir ? (s >= l31) : (s <= l31); X[r] = ok ? X[r] : 0.f; } }
#pragma unroll
                        for (int step = 0; step < 2; ++step) O[jt] = MFMA32(tr_frag_perm(Vs, 528, 32 * st + 16 * step, 32 * wave, lane), pack_acc(X, step), O[jt]);
                    }
                }
#pragma unroll
                for (int kk = 0; kk < 8; ++kk) O[jt] = MFMA32(row_frag(STs, 272, 32 * wave, 16 * kk, lane), row_frag(Qt, 272, 32 * jt, 16 * kk, lane), O[jt]);
            }
        }
        __syncthreads();
#pragma unroll
        for (int jt = 0; jt < 2; ++jt)
#pragma unroll
            for (int q = 0; q < 4; ++q) *(LAS f32x4*)(YO + (32 * jt + l31) * 260 + 32 * wave + 8 * q + 4 * h5) = (f32x4){O[jt][4 * q], O[jt][4 * q + 1], O[jt][4 * q + 2], O[jt][4 * q + 3]};
        __syncthreads();
        { const int c0 = dg * 32; float y[32]; float ss = 0.f;
#pragma unroll
          for (int q = 0; q < 8; ++q) { const f32x4 a = *(const LAS f32x4*)(YO + srow * 260 + c0 + 4 * q); y[4 * q] = a.x; y[4 * q + 1] = a.y; y[4 * q + 2] = a.z; y[4 * q + 3] = a.w; }
#pragma unroll
          for (int q = 0; q < 32; ++q) ss += y[q] * y[q];
          ss += __shfl_xor(ss, 1); ss += __shfl_xor(ss, 2); ss += __shfl_xor(ss, 4);
          const float r = 1.0f / sqrtf(ss * (1.0f / 256.0f) + EPS);
#pragma unroll
          for (int q = 0; q < 4; ++q) { float g8[8], o8[8]; unpack8(*(const u32x4*)(P + (size_t)(r0 + srow) * PLD + 2048 + h * 256 + c0 + 8 * q), g8);
#pragma unroll
              for (int e = 0; e < 8; ++e) o8[e] = y[8 * q + e] * r * ng[h * 256 + c0 + 8 * q + e] * siluf_(g8[e]);
              *(u32x4*)(Y + (size_t)(r0 + srow) * D + h * 256 + c0 + 8 * q) = pack8(o8); } }
    }
}

DI void phase_gla_scan_naive(const Ctx& c) {
    const bf16* PC = WSP(bf16, WS_BIG + BIG_PC); const float* EX = WSP(float, WS_EXTRA);
    LAS float* qs = (LAS float*)c.lds; LAS float* ks = qs + 16 * 128; LAS float* as = ks + 16 * 128; LAS float* vs = as + 16 * 128; LAS float* lw = vs + 16 * 256;
    const int v = c.tid >> 1, d0 = (c.tid & 1) * 64;
    for (int item = blockIdx.x; item < 64; item += gridDim.x) {
        const int b = item >> 3, h = (item >> 1) & 3, dir = item & 1;
        float* Yo = WSP(float, WS_BIG + (dir ? BIG_YB : BIG_YF));
        const float* w2 = c.in[I_GLW2] + (size_t)dir * 16 * 512 + h * 128; const float* gb = c.in[I_GLGB] + dir * 512 + h * 128;
        float S[64];
#pragma unroll
        for (int d = 0; d < 64; ++d) S[d] = 0.f;
        for (int ch = 0; ch < (CTX + SEQ) / 16; ++ch) {
            __syncthreads();
            if (c.tid < 256) { const int st = c.tid >> 4, r = c.tid & 15, row = scan_row(ch * 16 + st, b, dir); lw[c.tid] = EX[(size_t)row * 32 + dir * 16 + r]; }
            for (int idx = c.tid; idx < 16 * 512; idx += 512) { const int st = idx >> 9, col = idx & 511, row = scan_row(ch * 16 + st, b, dir);
                if (col < 128) qs[st * 128 + col] = bf2f(PC[(size_t)row * 2048 + h * 128 + col]);
                else if (col < 256) ks[st * 128 + col - 128] = bf2f(PC[(size_t)row * 2048 + 512 + h * 128 + col - 128]);
                else vs[st * 256 + col - 256] = bf2f(PC[(size_t)row * 2048 + 1024 + h * 256 + col - 256]); }
            __syncthreads();
            for (int idx = c.tid; idx < 16 * 128; idx += 512) { const int st = idx >> 7, d = idx & 127; float pre = gb[d];
#pragma unroll
                for (int r = 0; r < 16; ++r) pre += lw[st * 16 + r] * w2[r * 512 + d];
                as[idx] = __expf(logsigf_(pre) * (1.0f / 16.0f)); }
            __syncthreads();
            for (int st = 0; st < 16; ++st) {
                const float vv = vs[st * 256 + v]; float part = 0.f;
#pragma unroll
                for (int d = 0; d < 64; ++d) { S[d] = as[st * 128 + d0 + d] * S[d] + ks[st * 128 + d0 + d] * vv; part += qs[st * 128 + d0 + d] * S[d]; }
                part += __shfl_xor(part, 1);
                if ((c.tid & 1) == 0) { const int row = scan_row(ch * 16 + st, b, dir); Yo[(size_t)row * D + h * 256 + v] = part; }
            }
        }
    }
}
DI void phase_headnorm(const Ctx& c, int hd, const float* ng) {
    const float* YF = WSP(float, WS_BIG + BIG_YF); const float* YB = WSP(float, WS_BIG + BIG_YB); const bf16* P = WSP(bf16, WS_P); bf16* Y = WSP(bf16, WS_Y);
    for (int row = c.gw; row < TT; row += c.ngw) {
        const int c0 = 16 * c.lane; float y[16]; float ss = 0.f;
#pragma unroll
        for (int j = 0; j < 4; ++j) { const f32x4 a = *(const f32x4*)(YF + (size_t)row * D + c0 + 4 * j), bb = *(const f32x4*)(YB + (size_t)row * D + c0 + 4 * j);
            y[4 * j] = a.x + bb.x; y[4 * j + 1] = a.y + bb.y; y[4 * j + 2] = a.z + bb.z; y[4 * j + 3] = a.w + bb.w; }
#pragma unroll
        for (int j = 0; j < 16; ++j) ss += y[j] * y[j];
        ss += __shfl_xor(ss, 1); ss += __shfl_xor(ss, 2); ss += __shfl_xor(ss, 4); if (hd == 256) ss += __shfl_xor(ss, 8);
        const float r = 1.0f / sqrtf(ss / (float)hd + EPS);
        float g0[8], g1[8];
        unpack8(*(const u32x4*)(P + (size_t)row * PLD + 2048 + c0), g0); unpack8(*(const u32x4*)(P + (size_t)row * PLD + 2048 + c0 + 8), g1);
        float o[16];
#pragma unroll
        for (int j = 0; j < 16; ++j) { const float gp = j < 8 ? g0[j] : g1[j - 8]; o[j] = y[j] * r * ng[c0 + j] * (hd == 128 ? sigmoidf_(gp) : siluf_(gp)); }
        const float o0[8] = {o[0], o[1], o[2], o[3], o[4], o[5], o[6], o[7]}, o1[8] = {o[8], o[9], o[10], o[11], o[12], o[13], o[14], o[15]};
        *(u32x4*)(Y + (size_t)row * D + c0) = pack8(o0); *(u32x4*)(Y + (size_t)row * D + c0 + 8) = pack8(o1);
    }
}
DI void phase_hyena_conv_naive(const Ctx& c) {
    const bf16* PC = WSP(bf16, WS_BIG + BIG_PC); bf16* Y = WSP(bf16, WS_Y); const float* skip = c.in[I_HYSKIP];
    LAS float* zt = (LAS float*)c.lds;
    LAS float* ft = zt + 4096;
    const int cc = c.tid & 63, tg = c.tid >> 6;
    for (int item = blockIdx.x; item < 4096 + 512; item += gridDim.x) {
        int L, rb, tt, cgi; const float* tab;
        if (item < 4096) { L = SEQ; const int b = item >> 9; tt = (item >> 4) & 31; cgi = item & 15; rb = TC + b * SEQ; tab = WSP(float, WS_HF); }
        else { const int it = item - 4096; L = CTX; const int b = it >> 6; tt = (it >> 4) & 3; cgi = it & 15; rb = b * CTX; tab = WSP(float, WS_HFC); }
        const int t0 = 64 * tt, c0 = 64 * cgi;
        float acc[8];
#pragma unroll
        for (int i = 0; i < 8; ++i) acc[i] = 0.f;
        for (int sb = 0; sb < L / 64; ++sb) {
            const int s0 = 64 * sb;
            __syncthreads();
            for (int idx = c.tid; idx < 4096; idx += 512) { const int sl = idx >> 6, ch = idx & 63; const size_t o = (size_t)(rb + s0 + sl) * PLD + c0 + ch;
                zt[idx] = bf2f(PC[o + 1024]) * bf2f(PC[o + 2048]); }
            for (int idx = c.tid; idx < 64 * 128; idx += 512) { const int ch = idx >> 7, j = idx & 127;
                if (j < 127) ft[j * 65 + ch] = tab[(size_t)(c0 + ch) * (2 * L) + L + (t0 - s0 - 63 + j)]; }
            __syncthreads();
#pragma unroll 1
            for (int g = 0; g < 8; ++g) {
                float w[15], z[8]; const int base = 8 * (tg - g) + 56;
#pragma unroll
                for (int m = 0; m < 15; ++m) w[m] = ft[(base + m) * 65 + cc];
#pragma unroll
                for (int j = 0; j < 8; ++j) z[j] = zt[(8 * g + j) * 64 + cc];
#pragma unroll
                for (int i = 0; i < 8; ++i)
#pragma unroll
                    for (int j = 0; j < 8; ++j) acc[i] += w[i - j + 7] * z[j];
            }
        }
#pragma unroll
        for (int i = 0; i < 8; ++i) { const int row = rb + t0 + 8 * tg + i; const size_t o = (size_t)row * PLD + c0 + cc;
            const float zin = bf2f(PC[o + 1024]) * bf2f(PC[o + 2048]), x0 = bf2f(PC[o]);
            Y[(size_t)row * D + c0 + cc] = f2bf(x0 * (acc[i] + skip[c0 + cc] * zin)); }
    }
}

DI void hy_item(int item, int& L, int& b, int& t0, int& c0, int& rb) {
    if (item < 4096) { L = SEQ; b = item >> 9; t0 = 64 * ((item >> 4) & 31); c0 = 64 * (item & 15); rb = TC + b * SEQ; }
    else { const int it = item - 4096; L = CTX; b = it >> 6; t0 = 64 * ((it >> 4) & 3); c0 = 64 * (it & 15); rb = b * CTX; }
}
DI void phase_hy_prep(const Ctx& c) {
    const bf16* P = WSP(bf16, WS_P); bf16* X0C = WSP(bf16, WS_BIG + BIG_PC); const float* cw = c.in[I_HYCW]; const float* cb = c.in[I_HYCB];
    LAS unsigned char* raw = c.lds;
    LAS float* zt = (LAS float*)(c.lds + 32768);
    u32x4 pre[4];
#define HP_PREF(it_) do { int L_, b_, t0_, c0_, rb_; hy_item((it_), L_, b_, t0_, c0_, rb_); \
        _Pragma("unroll") for (int k = 0; k < 4; ++k) { const int pc = c.tid + 512 * k; pre[k] = (u32x4){c.z, c.z, c.z, c.z}; \
            if (pc < 3 * 66 * 8) { const int g = pc / 528, rr = (pc % 528) >> 3, sp = pc & 7, t = t0_ - 1 + rr; \
                if (t >= 0 && t < L_) pre[k] = *(const u32x4*)(P + (size_t)(rb_ + t) * PLD + g * 1024 + c0_ + 8 * sp); } } } while (0)
    if ((int)blockIdx.x < 4608) HP_PREF((int)blockIdx.x);
    for (int item = blockIdx.x; item < 4608; item += gridDim.x) {
        int L, b, t0, c0, rb; hy_item(item, L, b, t0, c0, rb);
        bf16* ZT = L == SEQ ? WSP(bf16, WS_BIG + BIG_ZTL) : WSP(bf16, WS_BIG + BIG_ZTC);
        lds_barrier();
#pragma unroll
        for (int k = 0; k < 4; ++k) { const int pc = c.tid + 512 * k; if (pc < 3 * 66 * 8) { const int g = pc / 528, rr = (pc % 528) >> 3, sp = pc & 7; *(LAS u32x4*)(raw + (g * 66 + rr) * 128 + sp * 16) = pre[k]; } }
        if (item + (int)gridDim.x < 4608) HP_PREF(item + (int)gridDim.x);
        lds_barrier();
        { const int t = c.tid >> 3, sp = c.tid & 7; float u[3][8];
#pragma unroll
          for (int g = 0; g < 3; ++g) { float xm[8], x0[8], xp[8];
              unpack8(*(const LAS u32x4*)(raw + (g * 66 + t) * 128 + sp * 16), xm); unpack8(*(const LAS u32x4*)(raw + (g * 66 + t + 1) * 128 + sp * 16), x0); unpack8(*(const LAS u32x4*)(raw + (g * 66 + t + 2) * 128 + sp * 16), xp);
              const int col = g * 1024 + c0 + 8 * sp;
#pragma unroll
              for (int e = 0; e < 8; ++e) u[g][e] = cw[col + e] * xm[e] + cw[3072 + col + e] * x0[e] + cw[6144 + col + e] * xp[e] + cb[col + e]; }
          *(u32x4*)(X0C + (size_t)(rb + t0 + t) * 1024 + c0 + 8 * sp) = pack8(u[0]);
#pragma unroll
          for (int e = 0; e < 8; ++e) zt[t * 65 + 8 * sp + e] = u[1][e] * u[2][e]; }
        lds_barrier();
        { const int ch = c.tid >> 3, tp = c.tid & 7; float z[8];
#pragma unroll
          for (int e = 0; e < 8; ++e) z[e] = zt[(8 * tp + e) * 65 + ch];
          *(u32x4*)(ZT + ((size_t)(c0 + ch) * NB + b) * L + t0 + 8 * tp) = pack8(z); }
    }
#undef HP_PREF
}
template <int L>
DI void hy_toeplitz_channel(const Ctx& c, const float* hrow  , const bf16* zsrc  , bf16* ydst  ) {
    constexpr int NBK = L / 32, CP = 2 * L + 8, NT = (NBK + 31) / 32, DMIN = -(NBK - 1), DMAX = NBK - 1;
    LAS unsigned char* F = c.lds;
    LAS unsigned char* Zs = c.lds + 8 * CP * 2;
    LAS unsigned char* R1 = Zs + (8 * NBK + 1) * 80;
    const int lane = c.lane, w = c.wave, h5 = lane >> 5, a = lane & 31, pi = lane & 15, rho = (lane >> 4) & 1;
    __syncthreads();
    for (int g = c.tid; g < (2 * L + 16) / 8; g += 512) { float v[8];
#pragma unroll
        for (int j = 0; j < 8; ++j) { const int y = 8 * g + j; v[j] = (y >= 1 && y <= 2 * L - 1) ? hrow[2 * L - y] : 0.f; }
        *(LAS u32x4*)(R1 + g * 16) = pack8(v); }
    if (c.tid < 20) *(LAS unsigned*)(Zs + 8 * NBK * 80 + 4 * c.tid) = c.z;
    for (int pc = c.tid; pc < 8 * L / 8; pc += 512) { const int bb = pc / (L / 8), pj = pc % (L / 8);
        *(LAS u32x4*)(Zs + (bb * NBK + (pj >> 2)) * 80 + (pj & 3) * 16) = *(const u32x4*)(zsrc + (size_t)bb * L + 8 * pj); }
    __syncthreads();
    for (int g = c.tid; g < 2 * L / 8; g += 512) {
        const u32x4 lo = *(const LAS u32x4*)(R1 + g * 16), hi = *(const LAS u32x4*)(R1 + g * 16 + 16);
        const unsigned Dw[8] = {lo.x, lo.y, lo.z, lo.w, hi.x, hi.y, hi.z, hi.w};
#pragma unroll
        for (int r = 0; r < 8; ++r) { u32x4 o;
            if (r & 1) { o.x = __builtin_amdgcn_alignbit(Dw[r / 2 + 1], Dw[r / 2], 16); o.y = __builtin_amdgcn_alignbit(Dw[r / 2 + 2], Dw[r / 2 + 1], 16);
                         o.z = __builtin_amdgcn_alignbit(Dw[r / 2 + 3], Dw[r / 2 + 2], 16); o.w = __builtin_amdgcn_alignbit(Dw[r / 2 + 4], Dw[r / 2 + 3], 16); }
            else { o.x = Dw[r / 2]; o.y = Dw[r / 2 + 1]; o.z = Dw[r / 2 + 2]; o.w = Dw[r / 2 + 3]; }
            *(LAS u32x4*)(F + (r * CP + 8 * g) * 2) = o; } }
    __syncthreads();
    const int r = (-a) & 7;
    f32x16 acc[NT];
    u32x4 Bf[2][NT][2];
#define HY_BLK(blk_) ((unsigned)(blk_) < (unsigned)NBK ? w * NBK + (blk_) : 8 * NBK)
#pragma unroll
    for (int q = 0; q < NT; ++q) { acc[q] = zero16();
#pragma unroll
        for (int par = 0; par < 2; ++par)
#pragma unroll
            for (int step = 0; step < 2; ++step) Bf[par][q][step] = *(const LAS u32x4*)(Zs + HY_BLK(32 * q + 2 * pi + rho - (DMIN + par)) * 80 + 32 * step + 16 * h5); }
    for (int d0 = DMIN; d0 <= DMAX; d0 += 2) {
#pragma unroll
        for (int par = 0; par < 2; ++par) {
            const int d = d0 + par;
            if (d <= DMAX) {
#pragma unroll
                for (int step = 0; step < 2; ++step) {
                    const int y0 = L - 32 * d - a + 16 * step + 8 * h5;
                    const bf16x8 A = *(const LAS bf16x8*)(F + (r * CP + (y0 - r)) * 2);
#pragma unroll
                    for (int q = 0; q < NT; ++q) if (d >= 32 * q - (NBK - 1) && d <= 32 * q + 31) acc[q] = MFMA32(A, __builtin_bit_cast(bf16x8, Bf[par][q][step]), acc[q]);
                }
#pragma unroll
                for (int q = 0; q < NT; ++q)
#pragma unroll
                    for (int step = 0; step < 2; ++step) {
                        const u32x4 fr = *(const LAS u32x4*)(Zs + HY_BLK(32 * q + rho - (d + 2)) * 80 + 32 * step + 16 * h5); u32x4 nb;
                        nb.x = (unsigned)__builtin_amdgcn_update_dpp((int)fr.x, (int)Bf[par][q][step].x, 0x111, 0xf, 0xf, false);
                        nb.y = (unsigned)__builtin_amdgcn_update_dpp((int)fr.y, (int)Bf[par][q][step].y, 0x111, 0xf, 0xf, false);
                        nb.z = (unsigned)__builtin_amdgcn_update_dpp((int)fr.z, (int)Bf[par][q][step].z, 0x111, 0xf, 0xf, false);
                        nb.w = (unsigned)__builtin_amdgcn_update_dpp((int)fr.w, (int)Bf[par][q][step].w, 0x111, 0xf, 0xf, false);
                        Bf[par][q][step] = nb; }
            }
        }
    }
#undef HY_BLK
#pragma unroll
    for (int q = 0; q < NT; ++q) { const int i = 32 * q + 2 * pi + rho;
        if (i < NBK) {
#pragma unroll
            for (int qq = 0; qq < 4; ++qq) { u32x2 o; o.x = cvt_pk_bf16(acc[q][4 * qq], acc[q][4 * qq + 1]); o.y = cvt_pk_bf16(acc[q][4 * qq + 2], acc[q][4 * qq + 3]);
                *(u32x2*)(ydst + (size_t)w * L + 32 * i + 8 * qq + 4 * h5) = o; } } }
}
DI void phase_hy_toeplitz(const Ctx& c) {
    for (int ch = blockIdx.x; ch < 1024; ch += gridDim.x) {
        hy_toeplitz_channel<SEQ>(c, WSP(float, WS_HF) + (size_t)ch * 4096, WSP(bf16, WS_BIG + BIG_ZTL) + (size_t)ch * NB * SEQ, WSP(bf16, WS_BIG + BIG_YTL) + (size_t)ch * NB * SEQ);
        hy_toeplitz_channel<CTX>(c, WSP(float, WS_HFC) + (size_t)ch * 512, WSP(bf16, WS_BIG + BIG_ZTC) + (size_t)ch * NB * CTX, WSP(bf16, WS_BIG + BIG_YTC) + (size_t)ch * NB * CTX);
    }
}
DI void phase_hy_post(const Ctx& c) {
    const bf16* X0C = WSP(bf16, WS_BIG + BIG_PC); bf16* Y = WSP(bf16, WS_Y); const float* skip = c.in[I_HYSKIP];
    LAS float* tl = (LAS float*)c.lds;
    u32x4 py, pz, px; float psk = 0.f;
#define HQ_PREF(it_) do { int L_, b_, t0_, c0_, rb_; hy_item((it_), L_, b_, t0_, c0_, rb_); \
        const bf16* ZT_ = L_ == SEQ ? WSP(bf16, WS_BIG + BIG_ZTL) : WSP(bf16, WS_BIG + BIG_ZTC); const bf16* YT_ = L_ == SEQ ? WSP(bf16, WS_BIG + BIG_YTL) : WSP(bf16, WS_BIG + BIG_YTC); \
        const int ch_ = c.tid >> 3, tp_ = c.tid & 7; const size_t o_ = ((size_t)(c0_ + ch_) * NB + b_) * L_ + t0_ + 8 * tp_; \
        py = *(const u32x4*)(YT_ + o_); pz = *(const u32x4*)(ZT_ + o_); psk = skip[c0_ + ch_]; \
        px = *(const u32x4*)(X0C + (size_t)(rb_ + t0_ + (c.tid >> 3)) * 1024 + c0_ + 8 * (c.tid & 7)); } while (0)
    if ((int)blockIdx.x < 4608) HQ_PREF((int)blockIdx.x);
    for (int item = blockIdx.x; item < 4608; item += gridDim.x) {
        int L, b, t0, c0, rb; hy_item(item, L, b, t0, c0, rb); (void)L; (void)b;
        lds_barrier();
        { const int ch = c.tid >> 3, tp = c.tid & 7; float y[8], z[8]; unpack8(py, y); unpack8(pz, z); const float sk = psk;
#pragma unroll
          for (int e = 0; e < 8; ++e) tl[ch * 65 + 8 * tp + e] = y[e] + sk * z[e]; }
        const u32x4 xc = px;
        if (item + (int)gridDim.x < 4608) HQ_PREF(item + (int)gridDim.x);
        lds_barrier();
        { const int t = c.tid >> 3, sp = c.tid & 7; float x0[8], o[8]; unpack8(xc, x0);
#pragma unroll
          for (int e = 0; e < 8; ++e) o[e] = x0[e] * tl[(8 * sp + e) * 65 + t];
          *(u32x4*)(Y + (size_t)(rb + t0 + t) * D + c0 + 8 * sp) = pack8(o); }
    }
#undef HQ_PREF
}

DI void phase_route(const Ctx& c, int l) {
    LAS float* rw = (LAS float*)c.lds;
    LAS int* lcnt = (LAS int*)(c.lds + 65536);
    LAS int* rinfo = lcnt + 32;
    LAS float* rwt = (LAS float*)(rinfo + 4 * 128);
    { const f32x4* srcw = (const f32x4*)WSP(float, WS_RWT);
#pragma unroll
      for (int i = 0; i < 8; ++i) *(LAS f32x4*)(rw + 4 * (c.tid + 512 * i)) = srcw[c.tid + 512 * i]; }
    if (c.tid < 16) lcnt[c.tid] = 0;
    __syncthreads();
    const float* MOD = WSP(float, WS_MOD) + (size_t)l * 9 * 6144; const float* g = c.in[I_N2G] + l * D; bf16* H = WSP(bf16, WS_H);
    const bf16* X = WSP(bf16, WS_X); const bf16* XC = WSP(bf16, WS_XC);
    unsigned* cnt = WSP(unsigned, WS_CTL) + CW_CNT + l * 16; int* TOK = WSP(int, WS_TOK); float* TOKW = WSP(float, WS_TOK + 512 * 1024);
    const float rbl = c.lane < 16 ? c.in[I_RB][c.lane] : 0.f;
    const int rlo = (l == 3 ? TC : 0), nrow = TT - rlo, per = (nrow + (int)gridDim.x - 1) / (int)gridDim.x;
    const int brow0 = rlo + (int)blockIdx.x * per, bn = min(per, TT - brow0);
    f32x4 vn[4];
    if (c.wave < bn) { const int row = brow0 + c.wave; load_row_bf(row < TC ? XC + (size_t)row * D : X + (size_t)(row - TC) * D, vn, c.lane); }
    for (int lr = c.wave; lr < bn; lr += 8) {
        const int row = brow0 + lr;
        f32x4 v[4];
#pragma unroll
        for (int j = 0; j < 4; ++j) v[j] = vn[j];
        if (lr + 8 < bn) { const int rn = row + 8; load_row_bf(rn < TC ? XC + (size_t)rn * D : X + (size_t)(rn - TC) * D, vn, c.lane); }
        const int mr = row < TC ? 8 : (row - TC) >> 11;
        norm_row(v, g, c.lane); mod_row(v, MOD + mr * 6144 + 3072, MOD + mr * 6144 + 4096, c.lane);
        store_row_bf16(H + (size_t)row * D, v, c.lane);
        float s16[16];
#pragma unroll
        for (int e = 0; e < 16; ++e) { float s = 0.f;
#pragma unroll
            for (int j = 0; j < 4; ++j) { const f32x4 w = *(const LAS f32x4*)(rw + e * 1024 + 256 * j + 4 * c.lane); s += (v[j].x * w.x + v[j].y * w.y) + (v[j].z * w.z + v[j].w * w.w); }
            s16[e] = s; if ((e & 3) == 3) asm volatile("" ::: "memory"); }
        float s8[8], s4[4], s2[2], s1;
        { const bool up = (c.lane & 32) != 0;
#pragma unroll
          for (int i = 0; i < 8; ++i) { const float keep = up ? s16[8 + i] : s16[i], give = up ? s16[i] : s16[8 + i]; s8[i] = keep + __shfl_xor(give, 32); } }
        { const bool up = (c.lane & 16) != 0;
#pragma unroll
          for (int i = 0; i < 4; ++i) { const float keep = up ? s8[4 + i] : s8[i], give = up ? s8[i] : s8[4 + i]; s4[i] = keep + __shfl_xor(give, 16); } }
        { const bool up = (c.lane & 8) != 0;
#pragma unroll
          for (int i = 0; i < 2; ++i) { const float keep = up ? s4[2 + i] : s4[i], give = up ? s4[i] : s4[2 + i]; s2[i] = keep + __shfl_xor(give, 8); } }
        { const bool up = (c.lane & 4) != 0; const float keep = up ? s2[1] : s2[0], give = up ? s2[0] : s2[1]; s1 = keep + __shfl_xor(give, 4); }
        s1 += __shfl_xor(s1, 2); s1 += __shfl_xor(s1, 1);
        const int eb = c.lane & 15; const int srcl = (((eb >> 3) & 1) << 5) | (((eb >> 2) & 1) << 4) | (((eb >> 1) & 1) << 3) | ((eb & 1) << 2);
        const float sc = sigmoidf_(__shfl(s1, srcl));
        const float sel = sc + rbl;
        float m1 = sel, m2 = -1e30f;
        { const float o1 = __shfl_xor(sel, 1); const float hi = fmaxf(sel, o1), lo = fminf(sel, o1);
          const float ohi = __shfl_xor(hi, 2), olo = __shfl_xor(lo, 2);
          m1 = fmaxf(hi, ohi); m2 = fmaxf(fminf(hi, ohi), fmaxf(lo, olo)); }
        const float gs = m1 + m2;
        const float g0 = __shfl(gs, 0), g1 = __shfl(gs, 4), g2 = __shfl(gs, 8), g3 = __shfl(gs, 12);
        int bg = 0; float bgs = g0; if (g1 > bgs) { bgs = g1; bg = 1; } if (g2 > bgs) { bgs = g2; bg = 2; } if (g3 > bgs) { bgs = g3; bg = 3; }
        float s4b[4], p4b[4];
#pragma unroll
        for (int j = 0; j < 4; ++j) { s4b[j] = __shfl(sel, 4 * bg + j); p4b[j] = __shfl(sc, 4 * bg + j); }
        int i1 = 0; float v1 = s4b[0], q1 = p4b[0];
#pragma unroll
        for (int j = 1; j < 4; ++j) if (s4b[j] > v1) { v1 = s4b[j]; i1 = j; q1 = p4b[j]; }
        int i2 = -1; float v2 = -1e30f, q2 = 0.f;
#pragma unroll
        for (int j = 0; j < 4; ++j) if (j != i1 && s4b[j] > v2) { v2 = s4b[j]; i2 = j; q2 = p4b[j]; }
        if (c.lane == 0) {
            const int e0 = 4 * bg + i1, e1 = 4 * bg + i2;
            const int p0 = __hip_atomic_fetch_add(lcnt + e0, 1, __ATOMIC_RELAXED, __HIP_MEMORY_SCOPE_WORKGROUP), p1 = __hip_atomic_fetch_add(lcnt + e1, 1, __ATOMIC_RELAXED, __HIP_MEMORY_SCOPE_WORKGROUP);
            rinfo[lr * 4 + 0] = e0; rinfo[lr * 4 + 1] = p0; rinfo[lr * 4 + 2] = e1; rinfo[lr * 4 + 3] = p1;
            const float inv = 1.0f / (q1 + q2); rwt[lr * 2] = q1 * inv; rwt[lr * 2 + 1] = q2 * inv;
        }
    }
    __syncthreads();
    if (c.tid < 16) lcnt[16 + c.tid] = (int)atomicAdd(cnt + c.tid, (unsigned)lcnt[c.tid]);
    __syncthreads();
    for (int lr = c.tid; lr < bn; lr += 512) { const int row = brow0 + lr, e0 = rinfo[lr * 4], e1 = rinfo[lr * 4 + 2];
        TOK[row * 4 + 0] = e0; TOK[row * 4 + 1] = lcnt[16 + e0] + rinfo[lr * 4 + 1]; TOK[row * 4 + 2] = e1; TOK[row * 4 + 3] = lcnt[16 + e1] + rinfo[lr * 4 + 3];
        TOKW[row * 2] = rwt[lr * 2]; TOKW[row * 2 + 1] = rwt[lr * 2 + 1]; }
}
DI void slot_bases(const unsigned* cnt, int lane, int e0, int e1, int& b0, int& b1) {
    const unsigned mine = lane < 16 ? ((cnt[lane] + 255u) & ~255u) : 0u; unsigned pb = 0; b0 = 0; b1 = 0;
#pragma unroll
    for (int e = 0; e < 16; ++e) { const unsigned ce = __shfl(mine, e); if (e == e0) b0 = (int)pb; if (e == e1) b1 = (int)pb; pb += ce; }
}
DI void phase_gather(const Ctx& c, int l) {
    const unsigned* cnt = WSP(unsigned, WS_CTL) + CW_CNT + l * 16; const int* TOK = WSP(int, WS_TOK); int* TOKS = WSP(int, WS_TOK + 768 * 1024);
    const bf16* H = WSP(bf16, WS_H); bf16* HS = WSP(bf16, WS_BIG + BIG_HS);
    const unsigned minep = c.lane < 16 ? ((cnt[c.lane] + 255u) & ~255u) : 0u; unsigned pb = 0; int mybase = 0;
#pragma unroll
    for (int e = 0; e < 16; ++e) { const unsigned ce = __shfl(minep, e); if (c.lane == e) mybase = (int)pb; pb += ce; }
    const int rfirst = (l == 3 ? TC : 0) + c.gw, rstep = c.ngw;
    int e0n = 0, p0n = 0, e1n = 0, p1n = 0; u32x4 an = {0u, 0u, 0u, 0u}, bn = an;
    if (rfirst < TT) { e0n = TOK[rfirst * 4]; p0n = TOK[rfirst * 4 + 1]; e1n = TOK[rfirst * 4 + 2]; p1n = TOK[rfirst * 4 + 3];
        an = __builtin_nontemporal_load((const u32x4*)(H + (size_t)rfirst * D + 8 * c.lane)); bn = __builtin_nontemporal_load((const u32x4*)(H + (size_t)rfirst * D + 512 + 8 * c.lane)); }
    for (int row = rfirst; row < TT; row += rstep) {
        const int e0 = e0n, p0 = p0n, e1 = e1n, p1 = p1n; const u32x4 a = an, bq = bn;
        if (row + rstep < TT) { const int r = row + rstep; e0n = TOK[r * 4]; p0n = TOK[r * 4 + 1]; e1n = TOK[r * 4 + 2]; p1n = TOK[r * 4 + 3];
            an = __builtin_nontemporal_load((const u32x4*)(H + (size_t)r * D + 8 * c.lane)); bn = __builtin_nontemporal_load((const u32x4*)(H + (size_t)r * D + 512 + 8 * c.lane)); }
        const int s0 = __shfl(mybase, e0) + p0, s1 = __shfl(mybase, e1) + p1;
        *(u32x4*)(HS + (size_t)s0 * D + 8 * c.lane) = a; *(u32x4*)(HS + (size_t)s0 * D + 512 + 8 * c.lane) = bq;
        *(u32x4*)(HS + (size_t)s1 * D + 8 * c.lane) = a; *(u32x4*)(HS + (size_t)s1 * D + 512 + 8 * c.lane) = bq;
        if (c.lane == 0) { TOKS[row * 2] = s0; TOKS[row * 2 + 1] = s1; }
    }
}
DI LAS int* moe_tiles(const Ctx& c, int l, int nsh) {
    LAS int* tp = (LAS int*)(c.lds + MISC_OFF);
    LAS int* ul = tp + 192;
    __syncthreads();
    if (c.tid < 64) {
        const unsigned* cnt = WSP(unsigned, WS_CTL) + CW_CNT + l * 16;
        const int mine = c.lane < 16 ? (int)((cnt[c.lane] + 255u) >> 8) : 0; int p = 0;
        for (int e = 0; e < 16; ++e) { const int ne = __shfl(mine, e); for (int t = c.lane; t < ne; t += 64) tp[1 + p + t] = e; p += ne; }
        if (c.lane == 0) tp[0] = p;
    }
    __syncthreads();
    if (c.tid < 32) {
        const int i = c.tid, ntile = tp[0], G = gridDim.x, cb = blockIdx.x; int rt = 1 << 20, pn = 0;
        if ((G & 7) == 0 && ((G >> 3) >> nsh) > 0) { const int x = cb & 7, v = cb >> 3, rpx = (G >> 3) >> nsh;
            if (v < (rpx << nsh)) { rt = (i * 8 + x) * rpx + (v >> nsh); pn = v & ((1 << nsh) - 1); } }
        else { const int L = i * G + cb; rt = L >> nsh; pn = L & ((1 << nsh) - 1); }
        ul[i] = rt < ntile ? (rt | (pn << 12) | (tp[1 + rt] << 16)) : -1;
    }
    __syncthreads();
    return ul;
}
DI void phase_combine(const Ctx& c, int l) {
    const float* MOD = WSP(float, WS_MOD) + (size_t)l * 9 * 6144; const int* TOKS = WSP(int, WS_TOK + 768 * 1024); const float* TOKW = WSP(float, WS_TOK + 512 * 1024);
    const bf16* YS = WSP(bf16, WS_BIG + BIG_HS); bf16* X = WSP(bf16, WS_X); bf16* XC = WSP(bf16, WS_XC); bf16* H = WSP(bf16, WS_H);
    const int rfirst = (l == 3 ? TC : 0) + c.gw, rstep = c.ngw;
    int sa0 = 0, sa1 = 0, sb0 = 0, sb1 = 0; float wa0 = 0.f, wa1 = 0.f, wb0 = 0.f, wb1 = 0.f;
    u32x2 dx[4], dy0[4], dy1[4];
#define CB_XP(r_) ((r_) < TC ? XC + (size_t)(r_) * D : X + (size_t)((r_) - TC) * D)
#define CB_LOAD(r_, s0_, s1_) do { const bf16* xq = CB_XP(r_); _Pragma("unroll") for (int j = 0; j < 4; ++j) { dx[j] = __builtin_nontemporal_load((const u32x2*)(xq + 256 * j + 4 * c.lane)); \
        dy0[j] = __builtin_nontemporal_load((const u32x2*)(YS + (size_t)(s0_) * D + 256 * j + 4 * c.lane)); dy1[j] = __builtin_nontemporal_load((const u32x2*)(YS + (size_t)(s1_) * D + 256 * j + 4 * c.lane)); } } while (0)
    if (rfirst < TT) { sa0 = TOKS[rfirst * 2]; sa1 = TOKS[rfirst * 2 + 1]; wa0 = TOKW[rfirst * 2]; wa1 = TOKW[rfirst * 2 + 1]; }
    if (rfirst + rstep < TT) { const int r = rfirst + rstep; sb0 = TOKS[r * 2]; sb1 = TOKS[r * 2 + 1]; wb0 = TOKW[r * 2]; wb1 = TOKW[r * 2 + 1]; }
    if (rfirst < TT) CB_LOAD(rfirst, sa0, sa1);
    for (int row = rfirst; row < TT; row += rstep) {
        const int mr = row < TC ? 8 : (row - TC) >> 11; bf16* xp = CB_XP(row);
        const float w0 = wa0, w1 = wa1;
        f32x4 v[4], ya[4], yb[4];
#pragma unroll
        for (int j = 0; j < 4; ++j) {
            v[j] = (f32x4){__uint_as_float(dx[j].x << 16), __uint_as_float(dx[j].x & 0xffff0000u), __uint_as_float(dx[j].y << 16), __uint_as_float(dx[j].y & 0xffff0000u)};
            ya[j] = (f32x4){__uint_as_float(dy0[j].x << 16), __uint_as_float(dy0[j].x & 0xffff0000u), __uint_as_float(dy0[j].y << 16), __uint_as_float(dy0[j].y & 0xffff0000u)};
            yb[j] = (f32x4){__uint_as_float(dy1[j].x << 16), __uint_as_float(dy1[j].x & 0xffff0000u), __uint_as_float(dy1[j].y << 16), __uint_as_float(dy1[j].y & 0xffff0000u)}; }
        sa0 = sb0; sa1 = sb1; wa0 = wb0; wa1 = wb1;
        if (row + 2 * rstep < TT) { const int r = row + 2 * rstep; sb0 = TOKS[r * 2]; sb1 = TOKS[r * 2 + 1]; wb0 = TOKW[r * 2]; wb1 = TOKW[r * 2 + 1]; }
        if (row + rstep < TT) CB_LOAD(row + rstep, sa0, sa1);
#pragma unroll
        for (int j = 0; j < 4; ++j) v[j] = v[j] + *(const f32x4*)(MOD + mr * 6144 + 5120 + 256 * j + 4 * c.lane) * (ya[j] * w0 + yb[j] * w1);
        if (l < 3) store_row_bf16(xp, v, c.lane);
        if (l < 3) {
            const float* MODn = WSP(float, WS_MOD) + (size_t)(l + 1) * 9 * 6144;
            norm_row(v, c.in[I_N1G] + (l + 1) * D, c.lane); mod_row(v, MODn + mr * 6144, MODn + mr * 6144 + 1024, c.lane);
            store_row_bf16(H + (size_t)hrow_of(row, (l + 1) % 3) * D, v, c.lane);
        } else {
            norm_row(v, c.in[I_FING], c.lane);
            float* o = c.out + (size_t)(row - TC) * D;
#pragma unroll
            for (int j = 0; j < 4; ++j) *(f32x4*)(o + 256 * j + 4 * c.lane) = v[j];
        }
    }
#undef CB_LOAD
#undef CB_XP
}

DI void ctx_outproj_mini(const Ctx& c, const bf16* Yc, const bf16* Wt, const float* xs_c  , bf16* XC, const float* modc  , const float* bias) {
    const int lane = c.lane, h5 = lane >> 5, l31 = lane & 31;
    for (int tile = blockIdx.x; tile < 256; tile += gridDim.x) {
        const int m0 = 64 * (tile >> 3) + 32 * (c.wave >> 2), n0 = 128 * (tile & 7) + 32 * (c.wave & 3);
        const bf16* ap = Yc + (size_t)(m0 + l31) * 1024 + 8 * h5; const bf16* bp = Wt + (size_t)(n0 + l31) * 1024 + 8 * h5;
        const int row = m0 + l31;
        float xo[4][4]; f32x4 g1[4], bb[4];
#pragma unroll
        for (int q = 0; q < 4; ++q) { const int col = n0 + 8 * q + 4 * h5; const size_t o = (size_t)row * D + col;
            if (xs_c) { const f32x4 t = *(const f32x4*)(xs_c + o); xo[q][0] = t.x; xo[q][1] = t.y; xo[q][2] = t.z; xo[q][3] = t.w; }
            else { const u32x2 t = *(const u32x2*)(XC + o); xo[q][0] = __uint_as_float(t.x << 16); xo[q][1] = __uint_as_float(t.x & 0xffff0000u); xo[q][2] = __uint_as_float(t.y << 16); xo[q][3] = __uint_as_float(t.y & 0xffff0000u); }
            g1[q] = *(const f32x4*)(modc + 2048 + col); bb[q] = bias ? *(const f32x4*)(bias + col) : (f32x4){0.f, 0.f, 0.f, 0.f}; }
        f32x16 acc = zero16();
        bf16x8 afA[4], wfA[4], afB[4], wfB[4];
#define MINI_LD(af, wf, k0_) do { _Pragma("unroll") for (int s = 0; s < 4; ++s) { af[s] = *(const bf16x8*)(ap + (k0_) + 16 * s); wf[s] = *(const bf16x8*)(bp + (k0_) + 16 * s); } } while (0)
#define MINI_MM(af, wf) do { _Pragma("unroll") for (int s = 0; s < 4; ++s) acc = MFMA32(wf[s], af[s], acc); } while (0)
        MINI_LD(afA, wfA, 0); MINI_LD(afB, wfB, 64);
#pragma unroll 1
        for (int k0 = 0; k0 < 1024; k0 += 128) {
            MINI_MM(afA, wfA); if (k0 + 128 < 1024) MINI_LD(afA, wfA, k0 + 128);
            MINI_MM(afB, wfB); if (k0 + 192 < 1024) MINI_LD(afB, wfB, k0 + 192);
        }
#undef MINI_LD
#undef MINI_MM
#pragma unroll
        for (int q = 0; q < 4; ++q) { const int col = n0 + 8 * q + 4 * h5; const size_t o = (size_t)row * D + col;
            u32x2 w; w.x = cvt_pk_bf16(xo[q][0] + g1[q].x * (acc[4 * q] + bb[q].x), xo[q][1] + g1[q].y * (acc[4 * q + 1] + bb[q].y));
            w.y = cvt_pk_bf16(xo[q][2] + g1[q].z * (acc[4 * q + 2] + bb[q].z), xo[q][3] + g1[q].w * (acc[4 * q + 3] + bb[q].w));
            *(u32x2*)(XC + o) = w; }
    }
}

#define XB_TMO      128
#define XB_XCNT(j)  (256  + 64 * (j))
#define XB_XSUB(j)  (1280 + 64 * (j))
#define XB_XGEN(j)  (2304 + 64 * (j))
#define XB_TOP      3328
#define XB_TOPGEN   3392
#define XCD_BAR_WORDS 3456
#define XB_SPIN_CAP (1u << 18)
DI unsigned xb_ld(unsigned* p)              { return __hip_atomic_load(p, __ATOMIC_RELAXED, __HIP_MEMORY_SCOPE_AGENT); }
DI unsigned xb_add(unsigned* p, unsigned v) { return __hip_atomic_fetch_add(p, v, __ATOMIC_RELAXED, __HIP_MEMORY_SCOPE_AGENT); }
DI unsigned xb_xcc_id() { return (unsigned)__builtin_amdgcn_s_getreg((3 << 11) | 20) & 0xFu; }
#define XB_SPIN(cond, bar) do { unsigned _sp = 0; while (cond) { __builtin_amdgcn_s_sleep(1); \
    if ((++_sp & 255u) == 0u) { if (xb_ld(&(bar)[XB_TMO])) break; if (_sp > XB_SPIN_CAP) { atomicAdd(&(bar)[XB_TMO], 1u); break; } } } } while (0)
DI void xcd_barrier_complete(unsigned* bar, unsigned x, unsigned& nloc, unsigned& nx) {
    const unsigned G = gridDim.x * gridDim.y * gridDim.z;
    unsigned sum, cnt, mine, sp = 0u;
    for (;;) {
        sum = 0u; cnt = 0u; mine = 0u;
#pragma unroll
        for (unsigned j = 0; j < 16; ++j) { const unsigned cj = xb_ld(&bar[XB_XCNT(j)]); sum += cj; cnt += (cj > 0u) ? 1u : 0u; mine = (j == x) ? cj : mine; }
        if (sum == G) break;
        __builtin_amdgcn_s_sleep(1);
        if ((++sp & 255u) == 0u) { if (xb_ld(&bar[XB_TMO])) break; if (sp > XB_SPIN_CAP) { atomicAdd(&bar[XB_TMO], 1u); break; } }
    }
    nloc = mine > 0u ? mine : 1u; nx = cnt > 0u ? cnt : 1u;
}
DI void xcd_barrier(unsigned* bar, volatile LAS unsigned* st) {
    asm volatile("s_waitcnt vmcnt(0)" ::: "memory");
    __syncthreads();
    if (threadIdx.x == 0) {
        const unsigned x = xb_xcc_id();
        __builtin_amdgcn_s_waitcnt(0);
        unsigned nloc = st[0], nx = st[1];
        if (nloc == 0u) { xcd_barrier_complete(bar, x, nloc, nx); st[0] = nloc; st[1] = nx; }
        const unsigned old = xb_add(&bar[XB_XSUB(x)], 1u);
        const unsigned gen = old / nloc;
        if (old + 1u == (gen + 1u) * nloc) {
            __builtin_amdgcn_fence(__ATOMIC_RELEASE, "agent");
            asm volatile("s_waitcnt vmcnt(0)" ::: "memory");
            const unsigned og = xb_add(&bar[XB_TOP], 1u);
            const unsigned tg = og / nx;
            if (og + 1u == (tg + 1u) * nx) xb_add(&bar[XB_TOPGEN], 1u);
            else XB_SPIN(xb_ld(&bar[XB_TOPGEN]) == tg, bar);
            __builtin_amdgcn_fence(__ATOMIC_ACQUIRE, "agent");
            xb_add(&bar[XB_XGEN(x)], 1u);
            asm volatile("s_waitcnt vmcnt(0)" ::: "memory");
        } else {
            XB_SPIN(xb_ld(&bar[XB_XGEN(x)]) == gen, bar);
            __builtin_amdgcn_fence(__ATOMIC_ACQUIRE, "agent");
            asm volatile("s_waitcnt vmcnt(0)" ::: "memory");
        }
    }
    __syncthreads();
}

constexpr int NPHASE = 2 + 11 * DEPTH;
__host__ __device__ inline bool phase_active(int ph) {
    if (ph < 2) return true;
    const int l = (ph - 2) / 11, s = (ph - 2) % 11, kind = l % 3;
    if (s == 0) return false;
    if (s == 4) return kind != 2 || HY_MFMA;
    return true;
}
DI void run_phase(const Ctx& c, int ph) {
    if (ph == 0) { if constexpr (PH_EN(0)) phase_pro0(c); return; }
    if (ph == 1) { if constexpr (PH_EN(1)) { phase_pro1(c); phase_norm1(c, 0, c.in[I_X], c.in[I_CTX]); } return; }
    const int l = (ph - 2) / 11, s = (ph - 2) % 11, kind = l % 3, j = l / 3;
    switch (s) {
    case 0: if constexpr (PH_EN(2)) phase_norm1(c, 0, c.in[I_X], c.in[I_CTX]); break;
    case 1: if constexpr (PH_EN(3)) {
        DenseOrder S; EpiInproj E; E.P = WSP(bf16, WS_P); E.extra = WSP(float, WS_EXTRA); E.bias = nullptr; E.bias_x = nullptr;
        S.A = WSP(bf16, WS_H); S.ul = dense_units(c.lds, c.tid, TT, kind == 2 ? 3072 : NINP);
        if (kind == 0) { S.Bt = WSP(bf16, WS_ML_WIN) + (size_t)j * NINP * 1024; E.bias_x = c.in[I_MLBG] + j * 32; }
        else if (kind == 1) { S.Bt = WSP(bf16, WS_GLA_WIN); }
        else { S.Bt = WSP(bf16, WS_HY_WIN); E.bias = c.in[I_HYBIN]; }
        gemm_run(c.lds, c.tid, S, E);
    } break;
    case 2: if constexpr (PH_EN(4))
        if (kind == 0) phase_conv(c, 1024, c.in[I_MLCW] + j * 3 * 1024, c.in[I_MLCB] + j * 1024, true, 0.125f);
        else if (kind == 1) { phase_conv(c, 2048, c.in[I_GLCW], c.in[I_GLCB], true, 0.08838834764831845f); if constexpr (GLA_CHUNK) phase_gla_decay(c); }
        else { if constexpr (HY_MFMA) phase_hy_prep(c); else phase_conv(c, 3072, c.in[I_HYCW], c.in[I_HYCB], false, 1.0f); }
        break;
    case 3: if constexpr (PH_EN(5))
        if (kind == 0) { if constexpr (MLSTM_CHUNK) phase_mlstm_state(c); else phase_mlstm_scan_naive(c); }
        else if (kind == 1) { if constexpr (GLA_CHUNK) phase_gla_state(c); else phase_gla_scan_naive(c); }
        else { if constexpr (HY_MFMA) phase_hy_toeplitz(c); else phase_hyena_conv_naive(c); }
        break;
    case 4: if constexpr (PH_EN(6))
        if (kind == 0) { if constexpr (MLSTM_CHUNK) phase_mlstm_out(c, c.in[I_MLNG] + j * 1024); else phase_headnorm(c, 128, c.in[I_MLNG] + j * 1024); }
        else if (kind == 1) { if constexpr (GLA_CHUNK) phase_gla_out(c, c.in[I_GLNG]); else phase_headnorm(c, 256, c.in[I_GLNG]); }
        else { if constexpr (HY_MFMA) phase_hy_post(c); }
        break;
    case 5: if constexpr (PH_EN(7)) {
        DenseOrder S; EpiOutproj E; E.X = WSP(bf16, WS_X); E.XC = WSP(bf16, WS_XC); E.mod = WSP(float, WS_MOD) + (size_t)l * 9 * 6144; E.bias = nullptr; E.perm = (kind == 1);
        E.xs_l = (l == 0) ? c.in[I_X] : nullptr; E.xs_c = (l == 0) ? c.in[I_CTX] : nullptr; E.row_off = TC;
        const bf16* W = kind == 0 ? WSP(bf16, WS_ML_WOUT) + (size_t)j * 1024 * 1024 : kind == 1 ? WSP(bf16, WS_GLA_WOUT) : WSP(bf16, WS_HY_WOUT);
        if (kind == 2) E.bias = c.in[I_HYBOUT];
        S.A = WSP(bf16, WS_Y) + (size_t)E.row_off * D; S.Bt = W; S.ul = dense_units(c.lds, c.tid, TT - E.row_off, 1024);
        gemm_run(c.lds, c.tid, S, E);
        if (l < 3) ctx_outproj_mini(c, WSP(bf16, WS_Y), W, E.xs_c, WSP(bf16, WS_XC), E.mod + 8 * 6144, E.bias);
    } break;
    case 6: if constexpr (PH_EN(8)) phase_route(c, l); break;
    case 7: if constexpr (PH_EN(9)) phase_gather(c, l); break;
    case 8: if constexpr (PH_EN(10)) {
        MoeOrder S; S.ul = moe_tiles(c, l, 3); S.A = WSP(bf16, WS_BIG + BIG_HS); S.Bt = WSP(bf16, WS_EXP_UP) + (size_t)l * 16 * 2048 * 1024; S.bstride = (size_t)2048 * 1024;
        EpiUp E; E.ACT = WSP(bf16, WS_BIG + BIG_ACT);
        gemm_run(c.lds, c.tid, S, E);
    } break;
    case 9: if constexpr (PH_EN(11)) {
        MoeOrder S; S.ul = moe_tiles(c, l, 2); S.A = WSP(bf16, WS_BIG + BIG_ACT); S.Bt = WSP(bf16, WS_EXP_DN) + (size_t)l * 16 * 1024 * 1024; S.bstride = (size_t)1024 * 1024;
        EpiDown E; E.YS = WSP(bf16, WS_BIG + BIG_HS);
        gemm_run(c.lds, c.tid, S, E);
    } break;
    case 10: if constexpr (PH_EN(12)) phase_combine(c, l); break;
    }
}

__global__ void __launch_bounds__(512, 2) mega_fwd(Params p) {
    extern __shared__ __attribute__((aligned(16))) unsigned char lds_raw[];
#if XCD_BARRIER
    {
        volatile LAS unsigned* st0 = (volatile LAS unsigned*)((LAS unsigned char*)lds_raw + BAR_LDS_OFF);
        if (threadIdx.x == 0) { st0[0] = 0u; st0[1] = 0u; (void)xb_add((unsigned*)(p.ws + WS_CTL) + CW_BAR + XB_XCNT(xb_xcc_id()), 1u); }
        __syncthreads();
    }
#endif
    bool first = true;
    int rep = 0;
    unsigned long long tp_acc = 0, tp_prev = 0; bool tp_sel = false;
    for (int ph = p.ph_lo; ph < p.ph_hi;) {
        if (!phase_active(ph)) { ++ph; continue; }
        int z; asm volatile("s_mov_b32 %0, 0" : "=s"(z));
        if (!first) {
#if XCD_BARRIER
            xcd_barrier((unsigned*)(p.ws + z + WS_CTL) + CW_BAR, (volatile LAS unsigned*)((LAS unsigned char*)lds_raw + BAR_LDS_OFF));
#else
            cg::this_grid().sync();
#endif
        }
        first = false;
        Ctx c;
        c.lds = (LAS unsigned char*)lds_raw;
        c.tid = threadIdx.x + z; c.lane = c.tid & 63; c.wave = __builtin_amdgcn_readfirstlane(c.tid >> 6);
        c.gw = blockIdx.x * 8 + c.wave; c.ngw = gridDim.x * 8;
        c.in = (const float* const __attribute__((address_space(4)))*)__builtin_amdgcn_kernarg_segment_ptr() + z; c.out = p.out + z; c.ws = p.ws + z; c.z = (unsigned)z;
        if (TP_MASK != 0u) {
            const unsigned long long now = __builtin_amdgcn_s_memrealtime();
            if (tp_sel) tp_acc += now - tp_prev;
            tp_prev = now; tp_sel = (ph >= 2 ? (((TP_MASK >> ((ph - 2) % 11)) & 1u) && ((TP_LAYERS >> ((ph - 2) / 11)) & 1u)) : ((TP_MASK >> (16 + ph)) & 1u));
        }
        run_phase(c, ph);
        if (REP_MASK != 0u && rep == 0 && (ph >= 2 ? (((REP_MASK >> ((ph - 2) % 11)) & 1u) && ((REP_LAYERS >> ((ph - 2) / 11)) & 1u)) : ((REP_MASK >> (16 + ph)) & 1u))) rep = 1; else { rep = 0; ++ph; }
    }
    if (TP_MASK != 0u && blockIdx.x == 0) { asm volatile("s_waitcnt vmcnt(0)" ::: "memory"); __syncthreads(); const unsigned long long now = __builtin_amdgcn_s_memrealtime(); if (tp_sel) tp_acc += now - tp_prev;
        const unsigned long long t_end = now + (unsigned long long)TP_AMP * tp_acc; while (__builtin_amdgcn_s_memrealtime() < t_end) __builtin_amdgcn_s_sleep(8); }
}

extern "C" void kernel_launch(void* const* d_in, const int* in_sizes, int n_in, void* d_out, int out_size, void* d_ws, size_t ws_size, hipStream_t stream) {
    static int grid = 0;
    if (grid == 0) {
        if (n_in != 40 || ws_size < WS_END || out_size != TL * D) { fprintf(stderr, "kernel_launch: unexpected shapes (n_in %d, ws %zu, out %d)\n", n_in, ws_size, out_size); grid = -1; return; }
        int dev = 0, cus = 0, per_cu = 0;
        hipGetDevice(&dev); hipDeviceGetAttribute(&cus, hipDeviceAttributeMultiprocessorCount, dev);
        if (hipFuncSetAttribute((const void*)mega_fwd, hipFuncAttributeMaxDynamicSharedMemorySize, LDS_BYTES) != hipSuccess) { fprintf(stderr, "kernel_launch: hipFuncSetAttribute failed\n"); grid = -1; return; }
        if (hipOccupancyMaxActiveBlocksPerMultiprocessor(&per_cu, (const void*)mega_fwd, 512, LDS_BYTES) != hipSuccess || per_cu < 1) { fprintf(stderr, "kernel_launch: occupancy query says %d\n", per_cu); per_cu = 1; }
        (void)hipGetLastError();
        grid = cus;
        fprintf(stderr, "kernel_launch: grid %d (cus %d, per_cu %d)\n", grid, cus, per_cu);
    }
    if (grid < 0) return;
    hipMemsetAsync((char*)d_ws + WS_CTL, 0, 1 * MiB, stream);
    Params p{};
    for (int i = 0; i < 40; ++i) p.in[i] = (const float*)d_in[i];
    p.out = (float*)d_out; p.ws = (unsigned char*)d_ws;
#if N_LAUNCH_PER_PHASE
    for (int ph = 0; ph < NPHASE; ++ph) {
        if (!phase_active(ph)) continue;
        p.ph_lo = ph; p.ph_hi = ph + 1; void* args[] = {&p};
        hipError_t e = hipLaunchCooperativeKernel((const void*)mega_fwd, dim3(grid), dim3(512), args, LDS_BYTES, stream);
        if (e != hipSuccess) { fprintf(stderr, "launch failed: %s\n", hipGetErrorString(e)); break; }
    }
#else
    p.ph_lo = 0; p.ph_hi = NPHASE; void* args[] = {&p};
    hipError_t e = hipLaunchCooperativeKernel((const void*)mega_fwd, dim3(grid), dim3(512), args, LDS_BYTES, stream);
    if (e != hipSuccess) fprintf(stderr, "cooperative launch failed: %s (grid %d)\n", hipGetErrorString(e), grid);
#endif
}
```

```cpp
#include <hip/hip_runtime.h>
#include <hip/hip_cooperative_groups.h>
#include <cstdio>
#include <cstdint>
namespace cg = cooperative_groups;

#define LAS __attribute__((address_space(3)))
#define DI __device__ __forceinline__
typedef unsigned short bf16;
typedef float f32x4 __attribute__((ext_vector_type(4)));
typedef float f32x2 __attribute__((ext_vector_type(2)));
typedef unsigned u32x4 __attribute__((ext_vector_type(4)));
typedef unsigned u32x2 __attribute__((ext_vector_type(2)));
typedef short bf16x8 __attribute__((ext_vector_type(8)));

#ifndef FAST_GEMM
#define FAST_GEMM 1
#endif
#ifndef MLSTM_CHUNK
#define MLSTM_CHUNK 1
#endif
#ifndef GLA_CHUNK
#define GLA_CHUNK 1
#endif
#ifndef HY_MFMA
#define HY_MFMA 1
#endif
#ifndef XCD_BARRIER
#define XCD_BARRIER 1
#endif
#ifndef PH_MASK
#define PH_MASK 0xFFFFFFFFu
#endif
#define PH_EN(b) ((PH_MASK >> (b)) & 1u)
#ifndef TP_MASK
#define TP_MASK 0u
#endif
#ifndef TP_LAYERS
#define TP_LAYERS 0xFu
#endif
#define TP_AMP 4
#ifndef REP_LAYERS
#define REP_LAYERS 0xFu
#endif
#ifndef REP_MASK
#define REP_MASK 0u
#endif
#ifndef N_LAUNCH_PER_PHASE
#define N_LAUNCH_PER_PHASE 0
#endif

constexpr int D = 1024, NB = 8, SEQ = 2048, CTX = 256, DEPTH = 4;
constexpr int TC = NB * CTX, TL = NB * SEQ, TT = TC + TL;
constexpr int NEXP = 16;
constexpr int PLD = 3072;
constexpr int NINP = 3328;
constexpr float EPS = 1e-6f;
constexpr int MAXSLOT = 40960;

constexpr size_t MiB = 1u << 20;
constexpr size_t WS_CTL = 0;
constexpr size_t WS_MOD = 1 * MiB;
constexpr size_t WS_HM = 2 * MiB;
constexpr size_t WS_TOK = 3 * MiB;
constexpr size_t WS_RWT = 3 * MiB + 944 * 1024;
constexpr size_t WS_HF = 4 * MiB;
constexpr size_t WS_HFC = 20 * MiB;
constexpr size_t WS_ML_WIN = 32 * MiB;
constexpr size_t WS_ML_WOUT = 45 * MiB;
constexpr size_t WS_GLA_WIN = 49 * MiB;
constexpr size_t WS_GLA_WOUT = 56 * MiB;
constexpr size_t WS_HY_WIN = 58 * MiB;
constexpr size_t WS_HY_WOUT = 64 * MiB;
constexpr size_t WS_EXP_UP = 66 * MiB;
constexpr size_t WS_EXP_DN = 322 * MiB;
constexpr size_t WS_X = 450 * MiB;
constexpr size_t WS_XC = 514 * MiB;
constexpr size_t WS_H = 522 * MiB;
constexpr size_t WS_P = 558 * MiB;
constexpr size_t WS_EXTRA = 667 * MiB;
constexpr size_t WS_Y = 670 * MiB;
constexpr size_t WS_BIG = 706 * MiB;
constexpr size_t WS_END = 1024 * MiB;
constexpr size_t BIG_HS = 0;
constexpr size_t BIG_ACT = 80 * MiB;
constexpr size_t BIG_PC = 0;
constexpr size_t BIG_YF = 108 * MiB;
constexpr size_t BIG_YB = 180 * MiB;

constexpr size_t BIG_MCT = 108 * MiB;
constexpr size_t BIG_MN = 180 * MiB;

constexpr size_t BIG_GB = 72 * MiB;
constexpr size_t BIG_GST = 144 * MiB;

constexpr size_t BIG_ZTL = 108 * MiB;
constexpr size_t BIG_ZTC = 140 * MiB;
constexpr size_t BIG_YTL = 144 * MiB;
constexpr size_t BIG_YTC = 176 * MiB;

constexpr int CW_CNT = 1024;
constexpr int CW_BAR = 4096;

constexpr int LDS_BYTES = 148480;
constexpr int BAR_LDS_OFF = 147456;
constexpr int MISC_OFF = 131072;

struct Params {
    const float* in[40];
    float* out;
    unsigned char* ws;
    int ph_lo, ph_hi;
};
static_assert(__builtin_offsetof(Params, in) == 0, "the input pointer table must be the first kernel argument bytes");
enum { I_X = 0, I_C, I_CTX, I_CCTX, I_ADAW, I_ADAB, I_N1G, I_N2G, I_FING, I_MLWIN, I_MLBG, I_MLCW, I_MLCB, I_MLNG, I_MLWOUT,
       I_GLWIN, I_GLCW, I_GLCB, I_GLW2, I_GLGB, I_GLNG, I_GLWOUT, I_HYWIN, I_HYBIN, I_HYCW, I_HYCB, I_HYFW1, I_HYFB1, I_HYFWM, I_HYFBM,
       I_HYFWO, I_HYFREQ, I_HYSKIP, I_HYWOUT, I_HYBOUT, I_RW, I_RB, I_EW1, I_EW3, I_EW2 };

DI float bf2f(bf16 v) { return __uint_as_float(((unsigned)v) << 16); }
typedef __bf16 b16x2_t __attribute__((ext_vector_type(2)));
DI unsigned cvt_pk_bf16(float lo, float hi) { const f32x2 v = {lo, hi}; const b16x2_t r = __builtin_convertvector(v, b16x2_t); return __builtin_bit_cast(unsigned, r); }
DI bf16 f2bf(float f) { return (bf16)(cvt_pk_bf16(f, 0.f) & 0xffffu); }
DI float sigmoidf_(float x) { return 1.0f / (1.0f + __expf(-x)); }
DI float siluf_(float x) { return x / (1.0f + __expf(-x)); }
DI float logsigf_(float x) { return fminf(x, 0.f) - __logf(1.0f + __expf(-fabsf(x))); }
DI void lds_barrier() { asm volatile("s_waitcnt lgkmcnt(0)" ::: "memory"); __builtin_amdgcn_s_barrier(); asm volatile("" ::: "memory"); }
DI float wave_sum(float v) {
#pragma unroll
    for (int o = 1; o < 64; o <<= 1) v += __shfl_xor(v, o);
    return v;
}
DI void unpack8(const u32x4 w, float (&v)[8]) {
    v[0] = __uint_as_float(w.x << 16); v[1] = __uint_as_float(w.x & 0xffff0000u);
    v[2] = __uint_as_float(w.y << 16); v[3] = __uint_as_float(w.y & 0xffff0000u);
    v[4] = __uint_as_float(w.z << 16); v[5] = __uint_as_float(w.z & 0xffff0000u);
    v[6] = __uint_as_float(w.w << 16); v[7] = __uint_as_float(w.w & 0xffff0000u);
}
DI u32x4 pack8(const float (&v)[8]) { u32x4 w; w.x = cvt_pk_bf16(v[0], v[1]); w.y = cvt_pk_bf16(v[2], v[3]); w.z = cvt_pk_bf16(v[4], v[5]); w.w = cvt_pk_bf16(v[6], v[7]); return w; }
DI void seq_bounds(int row, int& lo, int& hi) {
    if (row < TC) { lo = row & ~(CTX - 1); hi = lo + CTX - 1; } else { lo = TC + ((row - TC) & ~(SEQ - 1)); hi = lo + SEQ - 1; }
}
DI int perm_fwd(int s) { return (s & 63) * 32 + (s >> 6); }
DI int perm_inv(int sp) { return (sp & 31) * 64 + (sp >> 5); }

namespace pg8 {
constexpr int BM = 256, BK = 64, HALF = 128, HTB = HALF * BK * 2, STAGE_BYTES = 8 * HTB, NXCD = 8, WGM = 8;
__host__ __device__ __forceinline__ int lds_byte(int r, int c) { const int st = (r >> 4) * 2 + (c >> 5), rr = r & 15, cc = c & 31, ob = rr * 64 + cc * 2; return st * 1024 + (ob ^ (((ob >> 9) & 1) << 5)); }
__host__ __device__ __forceinline__ void stage_rc(int b, int& R, int& C) { const int st = b / 1024, sb = b % 1024, swz = sb ^ (((sb >> 9) & 1) << 5); R = (st >> 1) * 16 + swz / 64; C = (st & 1) * 32 + (swz % 64) / 2; }
__host__ __device__ __forceinline__ int perm32(int rho) { const int n = rho >> 4, i = rho & 15; return 8 * (i >> 2) + 4 * n + (i & 3); }
}
struct Unit { int pm, pn, e; };

DI LAS int* dense_units(LAS unsigned char* lds, int tid, int M, int N) {
    LAS int* ul = (LAS int*)(lds + MISC_OFF) + 192;
    __syncthreads();
    if (tid < 32) {
        const int nM = M / 256, nN = N / 256, nwg = nM * nN, G = gridDim.x, L = tid * G + (int)blockIdx.x; int w = -1;
        if (L < nwg) {
            int wgid = L; { const int q = nwg / 8, r = nwg % 8, xcd = wgid % 8, off = wgid / 8; wgid = (xcd < r ? xcd * (q + 1) : r * (q + 1) + (xcd - r) * q) + off; }
            const int nig = 8 * nN, gid = wgid / nig, fm = gid * 8, gsz = (nM - fm) < 8 ? (nM - fm) : 8;
            w = (fm + ((wgid % nig) % gsz)) | (((wgid % nig) / gsz) << 12);
        }
        ul[tid] = w;
    }
    __syncthreads();
    return ul;
}
struct DenseOrder {
    const bf16* A; const bf16* Bt; const LAS int* ul;
    DI bool next(int i, Unit& u) const {
        const int w = __builtin_amdgcn_readfirstlane(ul[i]); if (w < 0) return false;
        u.pm = w & 0xfff; u.pn = (w >> 12) & 0xf; u.e = 0; return true;
    }
    DI const bf16* aptr(const Unit& u) const { return A + (size_t)u.pm * 256 * 1024; }
    DI const bf16* bptr(const Unit& u) const { return Bt + (size_t)u.pn * 256 * 1024; }
};
struct MoeOrder {
    const bf16* A; const bf16* Bt; size_t bstride; const LAS int* ul;
    DI bool next(int i, Unit& u) const {
        const int w = __builtin_amdgcn_readfirstlane(ul[i]); if (w < 0) return false;
        u.pm = w & 0xfff; u.pn = (w >> 12) & 0xf; u.e = w >> 16; return true;
    }
    DI const bf16* aptr(const Unit& u) const { return A + (size_t)u.pm * 256 * 1024; }
    DI const bf16* bptr(const Unit& u) const { return Bt + (size_t)u.e * bstride + (size_t)u.pn * 256 * 1024; }
};

struct EpiInproj {
    static constexpr bool PAIR = false, BATCHED = false;
    bf16* P; float* extra; const float* bias; const float* bias_x;
    DI void row8(const Unit& u, int r, int c, const float (&v)[8]) const {
        const int row = u.pm * 256 + r, col = u.pn * 256 + c;
        if (col < PLD) {
            float w[8];
#pragma unroll
            for (int j = 0; j < 8; ++j) w[j] = v[j] + (bias ? bias[col + j] : 0.f);
            *(u32x4*)(P + (size_t)row * PLD + col) = pack8(w);
        } else if (col < PLD + 32) {
            float* o = extra + (size_t)row * 32 + (col - PLD);
#pragma unroll
            for (int j = 0; j < 8; ++j) o[j] = v[j] + (bias_x ? bias_x[col - PLD + j] : 0.f);
        }
    }
};
struct EpiOutproj {
    static constexpr bool PAIR = false, BATCHED = true;
    const float* xs_l; const float* xs_c; bf16* X; bf16* XC; const float* mod; const float* bias; int row_off; int perm;
    DI size_t off(const Unit& u, int r, int col) const {
        const int rr = u.pm * 256 + r + row_off - TC, b = rr >> 11, sp = rr & (SEQ - 1), s = perm ? perm_inv(sp) : sp; return ((size_t)b * SEQ + s) * D + col; }
    DI void tile(const f32x4 (&acc)[2][2][4][2], const Unit& u, int wr, int wc, int fr, int fq) const {
        const int b = (u.pm * 256 + row_off - TC) >> 11; const float* g1p = mod + b * 6144 + 2048;
        float g1[2][8], bs[2][8];
#pragma unroll
        for (int bj = 0; bj < 2; ++bj) { const int col = u.pn * 256 + bj * 128 + wc * 32 + 8 * fq;
#pragma unroll
            for (int j = 0; j < 8; ++j) { g1[bj][j] = g1p[col + j]; bs[bj][j] = bias ? bias[col + j] : 0.f; } }
#pragma unroll
        for (int ai = 0; ai < 2; ++ai)
#pragma unroll
            for (int mp = 0; mp < 2; ++mp) {
                float xo[2][2][8];
#pragma unroll
                for (int mm = 0; mm < 2; ++mm)
#pragma unroll
                    for (int bj = 0; bj < 2; ++bj) { const size_t o = off(u, ai * 128 + wr * 64 + (2 * mp + mm) * 16 + fr, u.pn * 256 + bj * 128 + wc * 32 + 8 * fq);
                        if (xs_l) { const f32x4 a0 = *(const f32x4*)(xs_l + o), a1 = *(const f32x4*)(xs_l + o + 4); xo[mm][bj][0] = a0.x; xo[mm][bj][1] = a0.y; xo[mm][bj][2] = a0.z; xo[mm][bj][3] = a0.w; xo[mm][bj][4] = a1.x; xo[mm][bj][5] = a1.y; xo[mm][bj][6] = a1.z; xo[mm][bj][7] = a1.w; }
                        else unpack8(*(const u32x4*)(X + o), xo[mm][bj]); }
#pragma unroll
                for (int mm = 0; mm < 2; ++mm)
#pragma unroll
                    for (int bj = 0; bj < 2; ++bj) { const int m = 2 * mp + mm; const size_t o = off(u, ai * 128 + wr * 64 + m * 16 + fr, u.pn * 256 + bj * 128 + wc * 32 + 8 * fq); float w[8];
#pragma unroll
                        for (int j = 0; j < 8; ++j) w[j] = xo[mm][bj][j] + g1[bj][j] * (acc[ai][bj][m][j >> 2][j & 3] + bs[bj][j]);
                        *(u32x4*)(X + o) = pack8(w); }
            }
    }
    DI void row8(const Unit& u, int r, int c, const float (&v)[8]) const {
        const int col = u.pn * 256 + c; const size_t o = off(u, r, col); const int b = (u.pm * 256 + row_off - TC) >> 11;
        float a[8];
        if (xs_l) { const f32x4 a0 = *(const f32x4*)(xs_l + o), a1 = *(const f32x4*)(xs_l + o + 4); a[0] = a0.x; a[1] = a0.y; a[2] = a0.z; a[3] = a0.w; a[4] = a1.x; a[5] = a1.y; a[6] = a1.z; a[7] = a1.w; }
        else unpack8(*(const u32x4*)(X + o), a);
        const float* g1 = mod + b * 6144 + 2048 + col; float w[8];
#pragma unroll
        for (int j = 0; j < 8; ++j) w[j] = a[j] + g1[j] * (v[j] + (bias ? bias[col + j] : 0.f));
        *(u32x4*)(X + o) = pack8(w);
    }
};
struct EpiUp {
    static constexpr bool PAIR = true, BATCHED = false;
    bf16* ACT;
    DI void row8p(const Unit& u, int r, int c, const float (&g)[8], const float (&up)[8]) const {
        float w[8];
#pragma unroll
        for (int j = 0; j < 8; ++j) w[j] = siluf_(g[j]) * up[j];
        *(u32x4*)(ACT + ((size_t)u.pm * 256 + r) * 1024 + u.pn * 128 + c) = pack8(w);
    }
};
struct EpiDown {
    static constexpr bool PAIR = false, BATCHED = false;
    bf16* YS;
    DI void row8(const Unit& u, int r, int c, const float (&v)[8]) const { *(u32x4*)(YS + ((size_t)u.pm * 256 + r) * 1024 + u.pn * 256 + c) = pack8(v); }
};

template <class Sched, class Epi>
DI void gemm_fast(LAS unsigned char* lds, int tid, const Sched& S, const Epi& E) {
    using namespace pg8;
    constexpr int K = 1024, nt = K / BK;
    const int wid = __builtin_amdgcn_readfirstlane(tid >> 6), lane = tid & 63, wr = wid >> 2, wc = wid & 3, fr = lane & 15, fq = lane >> 4;
    unsigned voffA[2], voffB[2];
#pragma unroll
    for (int i = 0; i < 2; ++i) { int R, C; stage_rc(tid * 16 + i * 8192, R, C); const int Rb = (R & ~31) + perm32(R & 31);
        voffA[i] = (unsigned)(R * K + C) * 2u; voffB[i] = (unsigned)(Rb * K + C) * 2u; }
    const size_t kstep = (size_t)(BK * 2);
    const size_t hstep = (size_t)HALF * K * 2;
    const unsigned ldsw = (unsigned)wid * 1024u;
    const int aoff = lds_byte(wr * 64 + fr, fq * 8), boff = lds_byte(wc * 32 + fr, fq * 8);
#define PG8_SA(b, h) (((b) * 2 + (h)) * HTB)
#define PG8_SB(b, h) ((4 + (b) * 2 + (h)) * HTB)
#define PG8_STAGE(bufoff, gbase, voff) do { _Pragma("unroll") for (int _i = 0; _i < 2; ++_i) \
        __builtin_amdgcn_global_load_lds((const unsigned*)((const char*)(gbase) + (voff)[_i]), (LAS unsigned*)(lds + (bufoff) + ldsw + _i * 8192), 16, 0, 0); } while (0)
#define PG8_LDA(dst, b, h) do { _Pragma("unroll") for (int m = 0; m < 4; ++m) _Pragma("unroll") for (int k = 0; k < 2; ++k) dst[m][k] = *(const LAS bf16x8*)(lds + PG8_SA(b, h) + aoff + m * 2048 + k * 1024); } while (0)
#define PG8_LDB(dst, b, h) do { _Pragma("unroll") for (int n = 0; n < 2; ++n) _Pragma("unroll") for (int k = 0; k < 2; ++k) dst[n][k] = *(const LAS bf16x8*)(lds + PG8_SB(b, h) + boff + n * 2048 + k * 1024); } while (0)
#define PG8_MMA(ai, bj, At, Bt) do { __builtin_amdgcn_s_setprio(1); _Pragma("unroll") for (int m = 0; m < 4; ++m) _Pragma("unroll") for (int n = 0; n < 2; ++n) _Pragma("unroll") for (int k = 0; k < 2; ++k) \
        acc[ai][bj][m][n] = __builtin_amdgcn_mfma_f32_16x16x32_bf16(Bt[n][k], At[m][k], acc[ai][bj][m][n], 0, 0, 0); __builtin_amdgcn_s_setprio(0); } while (0)
#define PG8_WAIT_V(n) asm volatile("s_waitcnt vmcnt(" #n ")" ::: "memory")
#define PG8_WAIT_L(n) asm volatile("s_waitcnt lgkmcnt(" #n ")" ::: "memory")
#define PG8_BAR __builtin_amdgcn_s_barrier()
#define PG8_SCHED __builtin_amdgcn_sched_barrier(0)
    Unit cur, nxt; int ui = 0;
    if (!S.next(0, cur)) return;
    f32x4 acc[2][2][4][2];
#pragma unroll
    for (int a = 0; a < 2; ++a)
#pragma unroll
        for (int b = 0; b < 2; ++b)
#pragma unroll
            for (int m = 0; m < 4; ++m)
#pragma unroll
                for (int n = 0; n < 2; ++n) acc[a][b][m][n] = (f32x4){0.f, 0.f, 0.f, 0.f};
    bf16x8 At[4][2], B0[2][2], B1[2][2];
    const char* cA = (const char*)S.aptr(cur); const char* cB = (const char*)S.bptr(cur);
    PG8_STAGE(PG8_SB(0, 0), cB, voffB); PG8_STAGE(PG8_SA(0, 0), cA, voffA); PG8_STAGE(PG8_SB(0, 1), cB + hstep, voffB); PG8_STAGE(PG8_SA(0, 1), cA + hstep, voffA);
    if (wr == 1) PG8_BAR;
    PG8_WAIT_V(4); PG8_BAR;
    PG8_STAGE(PG8_SB(1, 0), cB + kstep, voffB); PG8_STAGE(PG8_SA(1, 0), cA + kstep, voffA); PG8_STAGE(PG8_SB(1, 1), cB + hstep + kstep, voffB);
    PG8_WAIT_V(6); PG8_BAR;
    for (;;) {
        const bool has_next = S.next(ui + 1, nxt);
        const char* nA = has_next ? (const char*)S.aptr(nxt) : cA; const char* nB = has_next ? (const char*)S.bptr(nxt) : cB;
        for (int t = 0; t < nt; t += 2) {
            const bool last = (t == nt - 2);
            const char* a1 = cA + (size_t)(t + 1) * kstep;
            const char* a2 = last ? nA : cA + (size_t)(t + 2) * kstep; const char* b2 = last ? nB : cB + (size_t)(t + 2) * kstep;
            const char* a3 = a2 + kstep; const char* b3 = b2 + kstep;
            PG8_LDB(B0, 0, 0); PG8_SCHED; PG8_LDA(At, 0, 0); PG8_STAGE(PG8_SA(1, 1), a1 + hstep, voffA);
            PG8_WAIT_L(8); PG8_BAR; PG8_WAIT_L(0); PG8_MMA(0, 0, At, B0); PG8_BAR; PG8_SCHED;
            PG8_LDB(B1, 0, 1); PG8_STAGE(PG8_SB(0, 0), b2, voffB);
            PG8_BAR; PG8_WAIT_L(0); PG8_MMA(0, 1, At, B1); PG8_BAR;
            PG8_LDA(At, 0, 1); PG8_STAGE(PG8_SA(0, 0), a2, voffA);
            PG8_BAR; PG8_WAIT_L(0); PG8_MMA(1, 0, At, B0); PG8_BAR; PG8_SCHED;
            PG8_STAGE(PG8_SB(0, 1), b2 + hstep, voffB);
            PG8_WAIT_V(6); PG8_BAR; PG8_MMA(1, 1, At, B1); PG8_BAR;
            PG8_LDB(B0, 1, 0); PG8_SCHED; PG8_LDA(At, 1, 0); PG8_STAGE(PG8_SA(0, 1), a2 + hstep, voffA);
            PG8_WAIT_L(8); PG8_BAR; PG8_WAIT_L(0); PG8_MMA(0, 0, At, B0); PG8_BAR; PG8_SCHED;
            PG8_LDB(B1, 1, 1); PG8_STAGE(PG8_SB(1, 0), b3, voffB);
            PG8_BAR; PG8_WAIT_L(0); PG8_MMA(0, 1, At, B1); PG8_BAR;
            PG8_LDA(At, 1, 1); PG8_STAGE(PG8_SA(1, 0), a3, voffA);
            PG8_BAR; PG8_WAIT_L(0); PG8_MMA(1, 0, At, B0); PG8_BAR; PG8_SCHED;
            PG8_STAGE(PG8_SB(1, 1), b3 + hstep, voffB);
            PG8_WAIT_V(6); PG8_BAR; PG8_MMA(1, 1, At, B1); PG8_BAR;
        }
        int efr = fr, efq = fq; asm volatile("" : "+v"(efr), "+v"(efq));
        if constexpr (Epi::BATCHED) E.tile(acc, cur, wr, wc, efr, efq); else
#pragma unroll
        for (int ai = 0; ai < 2; ++ai)
#pragma unroll
            for (int m = 0; m < 4; ++m) {
                const int r = ai * HALF + wr * 64 + m * 16 + efr;
                if constexpr (Epi::PAIR) {
                    const float g[8] = {acc[ai][0][m][0][0], acc[ai][0][m][0][1], acc[ai][0][m][0][2], acc[ai][0][m][0][3], acc[ai][0][m][1][0], acc[ai][0][m][1][1], acc[ai][0][m][1][2], acc[ai][0][m][1][3]};
                    const float up[8] = {acc[ai][1][m][0][0], acc[ai][1][m][0][1], acc[ai][1][m][0][2], acc[ai][1][m][0][3], acc[ai][1][m][1][0], acc[ai][1][m][1][1], acc[ai][1][m][1][2], acc[ai][1][m][1][3]};
                    E.row8p(cur, r, wc * 32 + 8 * efq, g, up);
                } else {
#pragma unroll
                    for (int bj = 0; bj < 2; ++bj) {
                        const float v[8] = {acc[ai][bj][m][0][0], acc[ai][bj][m][0][1], acc[ai][bj][m][0][2], acc[ai][bj][m][0][3], acc[ai][bj][m][1][0], acc[ai][bj][m][1][1], acc[ai][bj][m][1][2], acc[ai][bj][m][1][3]};
                        E.row8(cur, r, bj * HALF + wc * 32 + 8 * efq, v);
                    }
                }
            }
        if (!has_next) break;
#pragma unroll
        for (int a = 0; a < 2; ++a)
#pragma unroll
            for (int b = 0; b < 2; ++b)
#pragma unroll
                for (int m = 0; m < 4; ++m)
#pragma unroll
                    for (int n = 0; n < 2; ++n) acc[a][b][m][n] = (f32x4){0.f, 0.f, 0.f, 0.f};
        cur = nxt; cA = nA; cB = nB; ++ui;
    }
    PG8_WAIT_V(0);
    if (wr == 0) PG8_BAR;
    PG8_BAR;
#undef PG8_SA
#undef PG8_SB
#undef PG8_STAGE
#undef PG8_LDA
#undef PG8_LDB
#undef PG8_MMA
#undef PG8_WAIT_V
#undef PG8_WAIT_L
#undef PG8_BAR
#undef PG8_SCHED
}

template <class Sched, class Epi>
DI void gemm_naive(LAS unsigned char* lds, int tid, const Sched& S, const Epi& E) {
    LAS float* As = (LAS float*)lds;
    LAS float* Bs = As + 32 * 132;
    LAS float* Bu = Bs + 32 * 132;
    const int ty = tid >> 4, tx = tid & 15, lr = tid >> 2, kq = tid & 3;
    Unit u;
    for (int i = 0; S.next(i, u); ++i) {
        const bf16* A = S.aptr(u); const bf16* B = S.bptr(u);
        for (int sm = 0; sm < 2; ++sm)
            for (int sn = 0; sn < (Epi::PAIR ? 1 : 2); ++sn) {
                float acc[4][8], accu[4][8];
#pragma unroll
                for (int a = 0; a < 4; ++a)
#pragma unroll
                    for (int b = 0; b < 8; ++b) { acc[a][b] = 0.f; accu[a][b] = 0.f; }
                for (int k0 = 0; k0 < 1024; k0 += 32) {
                    __syncthreads();
                    { float w[8]; unpack8(*(const u32x4*)(A + (size_t)(128 * sm + lr) * 1024 + k0 + 8 * kq), w);
#pragma unroll
                      for (int j = 0; j < 8; ++j) As[(8 * kq + j) * 132 + lr] = w[j];
                      unpack8(*(const u32x4*)(B + (size_t)(128 * sn + lr) * 1024 + k0 + 8 * kq), w);
#pragma unroll
                      for (int j = 0; j < 8; ++j) Bs[(8 * kq + j) * 132 + lr] = w[j];
                      if (Epi::PAIR) { unpack8(*(const u32x4*)(B + (size_t)(128 + lr) * 1024 + k0 + 8 * kq), w);
#pragma unroll
                          for (int j = 0; j < 8; ++j) Bu[(8 * kq + j) * 132 + lr] = w[j]; } }
                    __syncthreads();
#pragma unroll 4
                    for (int k = 0; k < 32; ++k) {
                        const f32x4 a4 = *(const LAS f32x4*)(As + k * 132 + 4 * ty);
                        const f32x4 b0 = *(const LAS f32x4*)(Bs + k * 132 + 8 * tx), b1 = *(const LAS f32x4*)(Bs + k * 132 + 8 * tx + 4);
#pragma unroll
                        for (int a = 0; a < 4; ++a) {
#pragma unroll
                            for (int b = 0; b < 4; ++b) { acc[a][b] += a4[a] * b0[b]; acc[a][4 + b] += a4[a] * b1[b]; } }
                        if (Epi::PAIR) {
                            const f32x4 c0 = *(const LAS f32x4*)(Bu + k * 132 + 8 * tx), c1 = *(const LAS f32x4*)(Bu + k * 132 + 8 * tx + 4);
#pragma unroll
                            for (int a = 0; a < 4; ++a) {
#pragma unroll
                                for (int b = 0; b < 4; ++b) { accu[a][b] += a4[a] * c0[b]; accu[a][4 + b] += a4[a] * c1[b]; } }
                        }
                    }
                }
#pragma unroll
                for (int a = 0; a < 4; ++a) {
                    if constexpr (Epi::PAIR) E.row8p(u, 128 * sm + 4 * ty + a, 8 * tx, acc[a], accu[a]);
                    else E.row8(u, 128 * sm + 4 * ty + a, 128 * sn + 8 * tx, acc[a]);
                }
            }
    }
    __syncthreads();
}
template <class Sched, class Epi>
DI void gemm_run(LAS unsigned char* lds, int tid, const Sched& S, const Epi& E) {
#if FAST_GEMM
    gemm_fast(lds, tid, S, E);
#else
    gemm_naive(lds, tid, S, E);
#endif
}

struct Ctx {
    LAS unsigned char* lds;
    int tid, lane, wave, gw, ngw;
    unsigned z;
    const float* const __attribute__((address_space(4)))* in;
    float* out;
    unsigned char* ws;
};
#define WSP(T, off) ((T*)(c.ws + (off)))

DI void transpose_item(const float* W, int N, bf16* WT, int k0, int n0, int dst_row0, LAS float* scr, int lane) {
#pragma unroll 8
    for (int i = 0; i < 32; ++i) { const int kk = 2 * i + (lane >> 5); scr[kk * 33 + (lane & 31)] = __builtin_nontemporal_load(W + (size_t)(k0 + kk) * N + n0 + (lane & 31)); }
    asm volatile("s_waitcnt lgkmcnt(0)" ::: "memory");
    const int cc = lane & 7;
#pragma unroll
    for (int j = 0; j < 4; ++j) { const int n = (lane >> 3) + 8 * j; const LAS float* s = scr + (8 * cc) * 33 + n;
        u32x4 o; o.x = cvt_pk_bf16(s[0 * 33], s[1 * 33]); o.y = cvt_pk_bf16(s[2 * 33], s[3 * 33]); o.z = cvt_pk_bf16(s[4 * 33], s[5 * 33]); o.w = cvt_pk_bf16(s[6 * 33], s[7 * 33]);
        *(u32x4*)(WT + (size_t)(dst_row0 + n) * 1024 + k0 + 8 * cc) = o; }
    asm volatile("s_waitcnt lgkmcnt(0)" ::: "memory");
}
DI void dense_transpose(const Ctx& c, const float* W, int N, bf16* WT, LAS float* scr) {
    const int nblk = N / 32, nitems = 16 * nblk;
    for (int it = c.gw; it < nitems; it += c.ngw) { const int kb = it / nblk, nb = it % nblk; transpose_item(W, N, WT, 64 * kb, 32 * nb, 32 * nb, scr, c.lane); }
}
DI void phase_pro0(const Ctx& c) {
    LAS float* scr = (LAS float*)(c.lds + c.wave * 8704);
    for (int j = 0; j < 2; ++j) {
        dense_transpose(c, c.in[I_MLWIN] + (size_t)j * 1024 * 3104, 3104, WSP(bf16, WS_ML_WIN) + (size_t)j * NINP * 1024, scr);
        dense_transpose(c, c.in[I_MLWOUT] + (size_t)j * 1024 * 1024, 1024, WSP(bf16, WS_ML_WOUT) + (size_t)j * 1024 * 1024, scr);
    }
    dense_transpose(c, c.in[I_GLWIN], 3104, WSP(bf16, WS_GLA_WIN), scr);
    dense_transpose(c, c.in[I_GLWOUT], 1024, WSP(bf16, WS_GLA_WOUT), scr);
    dense_transpose(c, c.in[I_HYWIN], 3072, WSP(bf16, WS_HY_WIN), scr);
    dense_transpose(c, c.in[I_HYWOUT], 1024, WSP(bf16, WS_HY_WOUT), scr);
    for (int it = c.gw * 64 + c.lane; it < 3 * 28672; it += c.ngw * 64) {
        const int m = it / 28672, r = it % 28672; bf16* base = (m < 2) ? WSP(bf16, WS_ML_WIN) + (size_t)m * NINP * 1024 : WSP(bf16, WS_GLA_WIN);
        *(u32x4*)(base + (size_t)3104 * 1024 + (size_t)r * 8) = (u32x4){c.z, c.z, c.z, c.z};
    }
    for (int it = c.gw; it < 64 * 3 * 512; it += c.ngw) {
        const int le = it / 1536, r0 = it % 1536, which = r0 / 512, r = r0 % 512, kb = r / 32, nb = r % 32;
        if (which < 2) {
            const float* W = c.in[which == 0 ? I_EW1 : I_EW3] + (size_t)le * 1024 * 1024;
            const int n0 = 32 * nb, drow = 256 * (n0 >> 7) + (n0 & 127) + (which ? 128 : 0);
            transpose_item(W, 1024, WSP(bf16, WS_EXP_UP) + (size_t)le * 2048 * 1024, 64 * kb, n0, drow, scr, c.lane);
        } else {
            transpose_item(c.in[I_EW2] + (size_t)le * 1024 * 1024, 1024, WSP(bf16, WS_EXP_DN) + (size_t)le * 1024 * 1024, 64 * kb, 32 * nb, 32 * nb, scr, c.lane);
        }
    }
    for (int i = blockIdx.x * 512 + c.tid; i < 16 * 1024; i += gridDim.x * 512) WSP(float, WS_RWT)[i] = c.in[I_RW][(i & 1023) * 16 + (i >> 10)];
    {
        const float* w1 = c.in[I_HYFW1]; const float* b1 = c.in[I_HYFB1]; const float* wm = c.in[I_HYFWM]; const float* bm = c.in[I_HYFBM]; const float* fr = c.in[I_HYFREQ];
        float* HM = WSP(float, WS_HM);
        for (int row = c.gw; row < 2304; row += c.ngw) {
            const int L = row < 2048 ? 2048 : 256, t = row < 2048 ? row : row - 2048, f = c.lane;
            float feat = 0.f;
            if (f == 0) feat = (float)t / (float)(L - 1);
            else if (f <= 32) { const int b = (f - 1) & 15; const float band = 1e-4f + (float)b * ((15.0f - 1e-4f) / 15.0f);
                const float ang = ((float)(2.0 * 3.14159265358979323846 / (double)L) * (float)t) * band; feat = (f <= 16) ? cosf(ang) : -sinf(ang); }
            float a = b1[f];
            for (int e = 0; e < 33; ++e) a += __shfl(feat, e) * w1[e * 64 + f];
            float h = sinf(fr[f] * a);
            for (int m = 0; m < 2; ++m) {
                float a2 = bm[m * 64 + f];
                for (int g = 0; g < 64; ++g) a2 += __shfl(h, g) * wm[m * 4096 + g * 64 + f];
                h = sinf(fr[f] * a2);
            }
            HM[row * 64 + f] = h;
        }
    }
    __syncthreads();
    {
        LAS float* sv = (LAS float*)c.lds;
        LAS float* red = sv + 9 * 1024;
        for (int i = c.tid; i < 9 * 1024; i += 512) { const float x = (i < 8192) ? c.in[I_C][i] : c.in[I_CCTX][i - 8192]; sv[i] = siluf_(x); }
        __syncthreads();
        float* MOD = WSP(float, WS_MOD);
        const int col = c.tid & 63, kg = c.tid >> 6;
        for (int item = blockIdx.x; item < 4 * 96; item += gridDim.x) {
            const int l = item / 96, j0 = 64 * (item % 96);
            const float* w = c.in[I_ADAW] + (size_t)l * 1024 * 6144 + j0 + col;
            float acc[9];
#pragma unroll
            for (int r = 0; r < 9; ++r) acc[r] = 0.f;
            for (int k = kg * 128; k < kg * 128 + 128; ++k) { const float wv = w[(size_t)k * 6144];
#pragma unroll
                for (int r = 0; r < 9; ++r) acc[r] += sv[r * 1024 + k] * wv; }
#pragma unroll
            for (int r = 0; r < 9; ++r) red[(kg * 9 + r) * 64 + col] = acc[r];
            __syncthreads();
            for (int o = c.tid; o < 9 * 64; o += 512) { const int r = o >> 6, cc = o & 63; float s = c.in[I_ADAB][l * 6144 + j0 + cc];
#pragma unroll
                for (int g = 0; g < 8; ++g) s += red[(g * 9 + r) * 64 + cc];
                MOD[(l * 9 + r) * 6144 + j0 + cc] = s; }
            __syncthreads();
        }
    }
}

template <int L>
DI void pro1_len(const Ctx& c, int c0, const float* hm, float* tab, LAS float* hmT  , const LAS f32x4* wo4  , float (&part)[4]) {
    const int side = c.wave & 1, ts = c.wave >> 1;
    const float da = -4.605170185988091f / 1.5f, db = -4.605170185988091f / 0.3f;
#pragma unroll 1
    for (int t0 = 0; t0 < L; t0 += 256) {
        __syncthreads();
#pragma unroll
        for (int k = 0; k < 8; ++k) { const int idx = c.tid + 512 * k, row = idx >> 4, q = idx & 15; const f32x4 v = *(const f32x4*)(hm + (size_t)(t0 + row) * 64 + 4 * q);
            LAS float* d = hmT + row * 65 + 4 * q; d[0] = v.x; d[1] = v.y; d[2] = v.z; d[3] = v.w; }
        __syncthreads();
        const int t = t0 + 64 * ts + c.lane; const LAS float* hr = hmT + (64 * ts + c.lane) * 65;
        f32x4 acc = {0.f, 0.f, 0.f, 0.f};
#pragma unroll 8
        for (int f = 0; f < 64; ++f) acc += wo4[side * 64 + f] * hr[f];
        const float tl = (float)t / (float)(L - 1);
#pragma unroll
        for (int ch = 0; ch < 4; ++ch) { const float delta = fabsf(da + (float)(c0 + ch) * ((db - da) / 1023.0f)), v = acc[ch] * expf(-tl * delta);
            float* trow = tab + (size_t)(c0 + ch) * (2 * L);
            if (side == 0) { trow[L + t] = v; part[ch] += fabsf(v); }
            else if (t >= 1) { trow[L - t] = v; part[ch] += fabsf(v); }
            else trow[0] = 0.f; }
    }
}
template <int L>
DI void pro1_scale(const Ctx& c, int c0, float* tab, const float (&inv)[4]) {
    const int side = c.wave & 1, ts = c.wave >> 1;
#pragma unroll 1
    for (int t0 = 0; t0 < L; t0 += 256) { const int t = t0 + 64 * ts + c.lane;
#pragma unroll
        for (int ch = 0; ch < 4; ++ch) { float* trow = tab + (size_t)(c0 + ch) * (2 * L); if (side == 0) trow[L + t] *= inv[ch]; else if (t >= 1) trow[L - t] *= inv[ch]; } }
}
DI void pro1_reduce(const Ctx& c, float (&part)[4], LAS float* red, float (&inv)[4]) {
#pragma unroll
    for (int ch = 0; ch < 4; ++ch) part[ch] = wave_sum(part[ch]);
    __syncthreads();
    if (c.lane == 0) {
#pragma unroll
        for (int ch = 0; ch < 4; ++ch) red[c.wave * 4 + ch] = part[ch]; }
    __syncthreads();
#pragma unroll
    for (int ch = 0; ch < 4; ++ch) { float s = 0.f;
#pragma unroll
        for (int w = 0; w < 8; ++w) s += red[w * 4 + ch];
        inv[ch] = 1.0f / s; }
}
DI void phase_pro1(const Ctx& c) {
    LAS float* hmT = (LAS float*)c.lds; LAS f32x4* wo4 = (LAS f32x4*)(c.lds + 67584); LAS float* red = (LAS float*)(c.lds + 67584 + 2048);
    const float* HM = WSP(float, WS_HM);
    for (int item = blockIdx.x; item < 256; item += gridDim.x) {
        const int c0 = 4 * item;
        __syncthreads();
        if (c.tid < 128) wo4[c.tid] = *(const f32x4*)(c.in[I_HYFWO] + (size_t)(c.tid & 63) * 2048 + (c.tid >> 6) * 1024 + c0);
        float part[4] = {0.f, 0.f, 0.f, 0.f}, inv[4];
        pro1_len<SEQ>(c, c0, HM, WSP(float, WS_HF), hmT, wo4, part);
        pro1_reduce(c, part, red, inv);
        pro1_scale<SEQ>(c, c0, WSP(float, WS_HF), inv);
        float part2[4] = {0.f, 0.f, 0.f, 0.f};
        pro1_len<CTX>(c, c0, HM + 2048 * 64, WSP(float, WS_HFC), hmT, wo4, part2);
        pro1_reduce(c, part2, red, inv);
        pro1_scale<CTX>(c, c0, WSP(float, WS_HFC), inv);
    }
}

DI void load_row(const float* src, f32x4 (&v)[4], int lane) {
#pragma unroll
    for (int j = 0; j < 4; ++j) v[j] = *(const f32x4*)(src + 256 * j + 4 * lane);
}
DI void load_row_bf(const bf16* src, f32x4 (&v)[4], int lane) {
#pragma unroll
    for (int j = 0; j < 4; ++j) { const u32x2 a = *(const u32x2*)(src + 256 * j + 4 * lane);
        v[j] = (f32x4){__uint_as_float(a.x << 16), __uint_as_float(a.x & 0xffff0000u), __uint_as_float(a.y << 16), __uint_as_float(a.y & 0xffff0000u)}; }
}
DI void norm_row(f32x4 (&v)[4], const float* g, int lane) {
    float s = 0.f;
#pragma unroll
    for (int j = 0; j < 4; ++j) s += (v[j].x * v[j].x + v[j].y * v[j].y) + (v[j].z * v[j].z + v[j].w * v[j].w);
    s = wave_sum(s);
    const float r = 1.0f / sqrtf(s * (1.0f / 1024.0f) + EPS);
#pragma unroll
    for (int j = 0; j < 4; ++j) v[j] = v[j] * r * *(const f32x4*)(g + 256 * j + 4 * lane);
}
DI void mod_row(f32x4 (&v)[4], const float* sh, const float* sc, int lane) {
#pragma unroll
    for (int j = 0; j < 4; ++j) v[j] = v[j] * (*(const f32x4*)(sc + 256 * j + 4 * lane) + 1.0f) + *(const f32x4*)(sh + 256 * j + 4 * lane);
}
DI void store_row_bf16(bf16* dst, const f32x4 (&v)[4], int lane) {
#pragma unroll
    for (int j = 0; j < 4; ++j) { u32x2 w; w.x = cvt_pk_bf16(v[j].x, v[j].y); w.y = cvt_pk_bf16(v[j].z, v[j].w); *(u32x2*)(dst + 256 * j + 4 * lane) = w; }
}
DI int hrow_of(int srow, int kind) {
    if (srow < TC || kind != 1) return srow;
    const int rr = srow - TC, b = rr >> 11, s = rr & (SEQ - 1); return TC + b * SEQ + perm_fwd(s);
}
DI void phase_norm1(const Ctx& c, int l, const float* xl, const float* xc) {
    const float* MOD = WSP(float, WS_MOD) + (size_t)l * 9 * 6144; const float* g = c.in[I_N1G] + l * D; bf16* H = WSP(bf16, WS_H);
    for (int row = c.gw; row < TT; row += c.ngw) {
        f32x4 v[4]; const int mr = row < TC ? 8 : (row - TC) >> 11;
        load_row(row < TC ? xc + (size_t)row * D : xl + (size_t)(row - TC) * D, v, c.lane);
        norm_row(v, g, c.lane); mod_row(v, MOD + mr * 6144, MOD + mr * 6144 + 1024, c.lane);
        store_row_bf16(H + (size_t)hrow_of(row, l % 3) * D, v, c.lane);
    }
}

DI void phase_conv(const Ctx& c, int ncols, const float* cw, const float* cb, bool act, float qs) {
    const bf16* P = WSP(bf16, WS_P); bf16* PC = WSP(bf16, WS_BIG + BIG_PC);
    const int ng = ncols / 8; const long total = (long)TT * ng;
    for (long idx = (long)blockIdx.x * 512 + c.tid; idx < total; idx += (long)gridDim.x * 512) {
        const int row = (int)(idx / ng), col = (int)(idx % ng) * 8; int lo, hi; seq_bounds(row, lo, hi);
        float x0[8], xm[8], xp[8];
        unpack8(*(const u32x4*)(P + (size_t)row * PLD + col), x0);
        if (row > lo) unpack8(*(const u32x4*)(P + (size_t)(row - 1) * PLD + col), xm); else {
#pragma unroll
            for (int j = 0; j < 8; ++j) xm[j] = 0.f; }
        if (row < hi) unpack8(*(const u32x4*)(P + (size_t)(row + 1) * PLD + col), xp); else {
#pragma unroll
            for (int j = 0; j < 8; ++j) xp[j] = 0.f; }
        float o[8];
#pragma unroll
        for (int j = 0; j < 8; ++j) { float v = cw[col + j] * xm[j] + cw[ncols + col + j] * x0[j] + cw[2 * ncols + col + j] * xp[j] + cb[col + j];
            if (act) v = siluf_(v); if (col < 512) v *= qs; o[j] = v; }
        *(u32x4*)(PC + (size_t)row * ncols + col) = pack8(o);
    }
}

DI int scan_row(int step, int b, int dir) {
    if (step < CTX) return b * CTX + (dir ? CTX - 1 - step : step);
    const int s = step - CTX; return TC + b * SEQ + (dir ? SEQ - 1 - s : s);
}
DI void phase_mlstm_scan_naive(const Ctx& c) {
    const bf16* P = WSP(bf16, WS_P); const bf16* PC = WSP(bf16, WS_BIG + BIG_PC); const float* EX = WSP(float, WS_EXTRA);
    LAS float* qs = (LAS float*)c.lds; LAS float* ks = qs + 32 * 64; LAS float* vs = ks + 32 * 64; LAS float* gs = vs + 32 * 128;
    const int v = c.tid >> 2, d0 = (c.tid & 3) * 16;
    for (int item = blockIdx.x; item < 128; item += gridDim.x) {
        const int b = item >> 4, h = (item >> 1) & 7, dir = item & 1;
        float* Yo = WSP(float, WS_BIG + (dir ? BIG_YB : BIG_YF));
        float C[16], n[16];
#pragma unroll
        for (int d = 0; d < 16; ++d) { C[d] = 0.f; n[d] = 0.f; }
        for (int ch = 0; ch < (CTX + SEQ) / 32; ++ch) {
            __syncthreads();
            for (int idx = c.tid; idx < 32 * 256; idx += 512) { const int st = idx >> 8, col = idx & 255, row = scan_row(ch * 32 + st, b, dir);
                if (col < 64) qs[st * 64 + col] = bf2f(PC[(size_t)row * 1024 + h * 64 + col]);
                else if (col < 128) ks[st * 64 + col - 64] = bf2f(PC[(size_t)row * 1024 + 512 + h * 64 + col - 64]);
                else vs[st * 128 + col - 128] = bf2f(P[(size_t)row * PLD + 1024 + h * 128 + col - 128]); }
            if (c.tid < 32) { const int row = scan_row(ch * 32 + c.tid, b, dir); gs[c.tid * 2] = sigmoidf_(EX[(size_t)row * 32 + dir * 16 + 8 + h]); gs[c.tid * 2 + 1] = __expf(EX[(size_t)row * 32 + dir * 16 + h]); }
            __syncthreads();
            for (int st = 0; st < 32; ++st) {
                const float f = gs[st * 2], ei = gs[st * 2 + 1], vv = vs[st * 128 + v] * ei;
                float part = 0.f, dpart = 0.f;
#pragma unroll
                for (int d = 0; d < 16; ++d) { const float kd = ks[st * 64 + d0 + d], qd = qs[st * 64 + d0 + d];
                    C[d] = f * C[d] + kd * vv; part += qd * C[d]; n[d] = f * n[d] + ei * kd; dpart += qd * n[d]; }
                part += __shfl_xor(part, 1); part += __shfl_xor(part, 2); dpart += __shfl_xor(dpart, 1); dpart += __shfl_xor(dpart, 2);
                if ((c.tid & 3) == 0) { const int row = scan_row(ch * 32 + st, b, dir); Yo[(size_t)row * D + h * 128 + v] = part / fmaxf(fabsf(dpart), 1.0f); }
            }
        }
    }
}
typedef short s16x4 __attribute__((ext_vector_type(4)));
typedef float f32x16 __attribute__((ext_vector_type(16)));
#define MFMA32(a, b, c) __builtin_amdgcn_mfma_f32_32x32x16_bf16((a), (b), (c), 0, 0, 0)
DI int crow(int reg, int h) { return (reg & 3) + 8 * (reg >> 2) + 4 * h; }
DI s16x4 ds_tr(const LAS unsigned char* p) { return __builtin_amdgcn_ds_read_tr16_b64_v4i16((LAS s16x4*)p); }
DI bf16x8 cat8(s16x4 lo, s16x4 hi) { return __builtin_shufflevector(lo, hi, 0, 1, 2, 3, 4, 5, 6, 7); }
DI bf16x8 tr_frag(const LAS unsigned char* img, int pitch, int k0, int n0, int lane) {
    const int h = lane >> 5, g16 = (lane >> 4) & 1, i = lane & 15;
    const LAS unsigned char* p = img + (k0 + 8 * h + (i >> 2)) * pitch + (n0 + 16 * g16 + 4 * (i & 3)) * 2;
    return cat8(ds_tr(p), ds_tr(p + 4 * pitch));
}
DI bf16x8 tr_frag_perm(const LAS unsigned char* img, int pitch, int k0, int n0, int lane) {
    const int h = lane >> 5, g16 = (lane >> 4) & 1, i = lane & 15;
    const LAS unsigned char* p = img + (k0 + 4 * h + (i >> 2)) * pitch + (n0 + 16 * g16 + 4 * (i & 3)) * 2;
    return cat8(ds_tr(p), ds_tr(p + 8 * pitch));
}
DI bf16x8 row_frag(const LAS unsigned char* img, int pitch, int row0, int k0, int lane) { return *(const LAS bf16x8*)(img + (row0 + (lane & 31)) * pitch + (k0 + 8 * (lane >> 5)) * 2); }
DI bf16x8 pack_acc(const f32x16& x, int step) {
    u32x4 p; const int o = 8 * step;
    p.x = cvt_pk_bf16(x[o], x[o + 1]); p.y = cvt_pk_bf16(x[o + 2], x[o + 3]); p.z = cvt_pk_bf16(x[o + 4], x[o + 5]); p.w = cvt_pk_bf16(x[o + 6], x[o + 7]);
    return __builtin_bit_cast(bf16x8, p);
}
DI f32x16 zero16() { f32x16 z;
#pragma unroll
    for (int i = 0; i < 16; ++i) z[i] = 0.f; return z; }
DI float wave_incl_prefix(float x, int lane) {
#pragma unroll
    for (int o = 1; o < 64; o <<= 1) { const float t = __shfl_up(x, o); if (lane >= o) x += t; }
    return x;
}
DI float wave_incl_suffix(float x, int lane) {
#pragma unroll
    for (int o = 1; o < 64; o <<= 1) { const float t = __shfl_down(x, o); if (lane + o < 64) x += t; }
    return x;
}
DI int chunk_row0(int p, int b, int dir) {
    if (p < 4) return b * CTX + 64 * (dir ? 3 - p : p);
    return TC + b * SEQ + 64 * (dir ? 35 - p : p - 4);
}

DI void phase_mlstm_state(const Ctx& c) {
    const bf16* P = WSP(bf16, WS_P); const bf16* PC = WSP(bf16, WS_BIG + BIG_PC); const float* EX = WSP(float, WS_EXTRA);
    bf16* MCT = WSP(bf16, WS_BIG + BIG_MCT); float* MN = WSP(float, WS_BIG + BIG_MN);
    LAS float* gi = (LAS float*)c.lds; LAS float* ga = gi + 2304; LAS float* wv = ga + 2304; LAS float* dec = wv + 64;
    LAS unsigned char* Kw = c.lds + 20480; LAS unsigned char* Vs = Kw + 64 * 144;
    const int lane = c.lane, wave = c.wave, h5 = lane >> 5, l31 = lane & 31;
    for (int it0 = blockIdx.x; it0 < 256; it0 += gridDim.x) {
        const int item = (gridDim.x == 256) ? ((it0 & 7) * 32 + (it0 >> 3)) : it0;
        const int b = item >> 5, h = (item >> 2) & 7, dir = (item >> 1) & 1, dvh = item & 1, seq = (b * 8 + h) * 2 + dir;
        __syncthreads();
        for (int idx = c.tid; idx < 2304; idx += 512) { const int row = chunk_row0(idx >> 6, b, dir) + (idx & 63);
            gi[idx] = EX[(size_t)row * 32 + dir * 16 + h]; ga[idx] = logsigf_(EX[(size_t)row * 32 + dir * 16 + 8 + h]); }
        f32x16 acc = zero16(); float nst = 0.f;
        const int dt = wave & 1, vt = (wave >> 1) & 1;
        const int srow = c.tid >> 3, spc = c.tid & 7;
        u32x4 kregA, vregA, kregB, vregB;
#define ML_PREFETCH(p_, kr, vr) do { const int r0_ = chunk_row0((p_), b, dir); \
          kr = *(const u32x4*)(PC + (size_t)(r0_ + srow) * 1024 + 512 + h * 64 + 8 * spc); \
          vr = *(const u32x4*)(P + (size_t)(r0_ + srow) * PLD + 1024 + h * 128 + dvh * 64 + 8 * spc); } while (0)
        ML_PREFETCH(0, kregA, vregA); ML_PREFETCH(1, kregB, vregB);
        __syncthreads();
#define ML_STEP(p, kreg, vreg) do { \
              \
            if (wave < 4) { \
                bf16* dst = MCT + ((size_t)seq * 36 + (p)) * 8192 + (size_t)(dvh * 64 + 32 * vt + l31) * 64 + 32 * dt + 4 * h5; \
                _Pragma("unroll") for (int q = 0; q < 4; ++q) { u32x2 w; w.x = cvt_pk_bf16(acc[4 * q], acc[4 * q + 1]); w.y = cvt_pk_bf16(acc[4 * q + 2], acc[4 * q + 3]); *(u32x2*)(dst + 8 * q) = w; } \
            } else if (wave == 4) { if (dvh == 0) MN[((size_t)seq * 36 + (p)) * 64 + lane] = nst; } \
            else if (wave == 7) { \
                const float a = ga[(p) * 64 + lane]; const float bj = dir ? wave_incl_suffix(a, lane) : wave_incl_prefix(a, lane); \
                const float tot = __shfl(bj, dir ? 0 : 63); \
                wv[lane] = __expf(tot - bj + gi[(p) * 64 + lane]); if (lane == 0) dec[0] = __expf(tot); \
            } \
            lds_barrier(); \
              \
            { float kk[8]; unpack8(kreg, kk); const float w = wv[srow]; \
              _Pragma("unroll") for (int j = 0; j < 8; ++j) kk[j] *= w; \
              *(LAS u32x4*)(Kw + srow * 144 + spc * 16) = pack8(kk); *(LAS u32x4*)(Vs + srow * 144 + spc * 16) = vreg; } \
            if ((p) + 2 < 36) ML_PREFETCH((p) + 2, kreg, vreg); \
            const float d = dec[0];            \
            lds_barrier(); \
              \
            if (wave < 4) { \
                _Pragma("unroll") for (int i = 0; i < 16; ++i) acc[i] *= d; \
                _Pragma("unroll") for (int kk = 0; kk < 4; ++kk) acc = MFMA32(tr_frag(Kw, 144, 16 * kk, 32 * dt, lane), tr_frag(Vs, 144, 16 * kk, 32 * vt, lane), acc); \
            } else if (wave == 4) { \
                float s = 0.f; \
                for (int r = 0; r < 64; ++r) s += bf2f(*(const LAS bf16*)(Kw + r * 144 + lane * 2)); \
                nst = d * nst + s; \
            } } while (0)
        for (int p = 0; p < 36; p += 2) { ML_STEP(p, kregA, vregA); ML_STEP(p + 1, kregB, vregB); }
#undef ML_STEP
#undef ML_PREFETCH
    }
}

DI void phase_mlstm_out(const Ctx& c, const float* ng) {
    const bf16* P = WSP(bf16, WS_P); const bf16* PC = WSP(bf16, WS_BIG + BIG_PC); const float* EX = WSP(float, WS_EXTRA);
    const bf16* MCT = WSP(bf16, WS_BIG + BIG_MCT); const float* MN = WSP(float, WS_BIG + BIG_MN); bf16* Y = WSP(bf16, WS_Y);
    LAS unsigned char* Qs = c.lds; LAS unsigned char* Ks = Qs + 9216; LAS unsigned char* Vs = Ks + 9216;
    LAS unsigned char* CT0 = Vs + 17408;
    LAS float* gt = (LAS float*)(c.lds + MISC_OFF + 1024);
    LAS float* YO = (LAS float*)c.lds;
    const int lane = c.lane, wave = c.wave, h5 = lane >> 5, l31 = lane & 31;
    const int dir = wave >> 2, jt = (wave >> 1) & 1, vh = wave & 1;
    const int srow = c.tid >> 3, spc = c.tid & 7;
    u32x4 pq, pk, pv[2], pct[4], pgate[2]; float pga = 0.f, pgi = 0.f, pgn = 0.f;
#define MO_DECODE(it_) const int b = (it_) / 288, h = ((it_) / 36) & 7, cc = (it_) % 36; \
        const int r0 = cc < 4 ? b * CTX + 64 * cc : TC + b * SEQ + 64 * (cc - 4); const int pf = cc, pb = cc < 4 ? 3 - cc : 39 - cc
#define MO_PREFETCH(it_) do { MO_DECODE(it_); \
        pq = *(const u32x4*)(PC + (size_t)(r0 + srow) * 1024 + h * 64 + 8 * spc); pk = *(const u32x4*)(PC + (size_t)(r0 + srow) * 1024 + 512 + h * 64 + 8 * spc); \
        _Pragma("unroll") for (int i = 0; i < 2; ++i) pv[i] = *(const u32x4*)(P + (size_t)(r0 + srow) * PLD + 1024 + h * 128 + 8 * (spc + 8 * i)); \
        _Pragma("unroll") for (int i = 0; i < 4; ++i) { const int pc = c.tid + 512 * i, d2 = pc >> 10, rr = (pc >> 3) & 127, sp = pc & 7; \
            pct[i] = *(const u32x4*)(MCT + (((size_t)((b * 8 + h) * 2 + d2)) * 36 + (d2 ? pb : pf)) * 8192 + rr * 64 + 8 * sp); } \
        _Pragma("unroll") for (int i = 0; i < 2; ++i) pgate[i] = *(const u32x4*)(P + (size_t)(r0 + srow) * PLD + 2048 + h * 128 + 16 * spc + 8 * i); \
        if (wave < 2) { const int d2 = wave, row = r0 + lane; pga = EX[(size_t)row * 32 + d2 * 16 + 8 + h]; pgi = EX[(size_t)row * 32 + d2 * 16 + h]; \
            pgn = MN[(((size_t)((b * 8 + h) * 2 + d2)) * 36 + (d2 ? pb : pf)) * 64 + lane]; } } while (0)
    if ((int)blockIdx.x < 2304) MO_PREFETCH((int)blockIdx.x);
    for (int item = blockIdx.x; item < 2304; item += gridDim.x) {
        MO_DECODE(item); (void)pf; (void)pb;
        lds_barrier();
        *(LAS u32x4*)(Qs + srow * 144 + spc * 16) = pq; *(LAS u32x4*)(Ks + srow * 144 + spc * 16) = pk;
#pragma unroll
        for (int i = 0; i < 2; ++i) *(LAS u32x4*)(Vs + srow * 272 + (spc + 8 * i) * 16) = pv[i];
#pragma unroll
        for (int i = 0; i < 4; ++i) { const int pc = c.tid + 512 * i, d2 = pc >> 10, rr = (pc >> 3) & 127, sp = pc & 7; *(LAS u32x4*)(CT0 + d2 * 18432 + rr * 144 + sp * 16) = pct[i]; }
        if (wave < 2) { const int d2 = wave; const float a = logsigf_(pga);
            const float bj = d2 ? wave_incl_suffix(a, lane) : wave_incl_prefix(a, lane);
            gt[d2 * 192 + lane] = bj; gt[d2 * 192 + 64 + lane] = pgi - bj; gt[d2 * 192 + 128 + lane] = pgn; }
        const u32x4 gate0 = pgate[0], gate1 = pgate[1];
        if (item + (int)gridDim.x < 2304) MO_PREFETCH(item + (int)gridDim.x);
        lds_barrier();
        const LAS float* g = gt + dir * 192; const LAS unsigned char* CT = CT0 + dir * 18432;
        const int j = 32 * jt + l31; const float bjj = g[j];
        bf16x8 qf[4];
#pragma unroll
        for (int kk = 0; kk < 4; ++kk) qf[kk] = row_frag(Qs, 144, 32 * jt, 16 * kk, lane);
        float qn = 0.f;
#pragma unroll
        for (int kk = 0; kk < 4; ++kk) { float qv[8]; unpack8(__builtin_bit_cast(u32x4, qf[kk]), qv);
#pragma unroll
            for (int e = 0; e < 8; ++e) qn += qv[e] * g[128 + 16 * kk + 8 * h5 + e]; }
        qn += __shfl_xor(qn, 32);
        f32x16 X[2]; float den = 0.f;
#pragma unroll
        for (int st = 0; st < 2; ++st) {
            X[st] = zero16();
            const bool live = dir ? (st >= jt) : (st <= jt);
            if (live) {
#pragma unroll
                for (int kk = 0; kk < 4; ++kk) X[st] = MFMA32(row_frag(Ks, 144, 32 * st, 16 * kk, lane), qf[kk], X[st]);
#pragma unroll
                for (int r = 0; r < 16; ++r) { const int s = 32 * st + crow(r, h5); const bool ok = dir ? (s >= j) : (s <= j);
                    const float w = ok ? __expf(bjj + g[64 + s]) : 0.f; X[st][r] *= w; den += X[st][r]; }
            }
        }
        den += __shfl_xor(den, 32);
        const float eb = __expf(bjj); den += eb * qn;
        const float scale = 1.0f / fmaxf(fabsf(den), 1.0f);
        f32x16 O[2];
#pragma unroll
        for (int t = 0; t < 2; ++t) {
            const int vt = 2 * vh + t; f32x16 z = zero16(), w = zero16();
#pragma unroll
            for (int st = 0; st < 2; ++st) { const bool live = dir ? (st >= jt) : (st <= jt);
                if (live) {
#pragma unroll
                    for (int step = 0; step < 2; ++step) z = MFMA32(tr_frag_perm(Vs, 272, 32 * st + 16 * step, 32 * vt, lane), pack_acc(X[st], step), z); } }
#pragma unroll
            for (int kk = 0; kk < 4; ++kk) w = MFMA32(row_frag(CT, 144, 32 * vt, 16 * kk, lane), qf[kk], w);
#pragma unroll
            for (int r = 0; r < 16; ++r) O[t][r] = (z[r] + eb * w[r]) * scale;
        }
        lds_barrier();
#pragma unroll
        for (int t = 0; t < 2; ++t) { const int vt = 2 * vh + t;
#pragma unroll
            for (int q = 0; q < 4; ++q) *(LAS f32x4*)(YO + dir * 8448 + j * 132 + 32 * vt + 8 * q + 4 * h5) = (f32x4){O[t][4 * q], O[t][4 * q + 1], O[t][4 * q + 2], O[t][4 * q + 3]}; }
        lds_barrier();
        { const int row = c.tid >> 3, c0 = (c.tid & 7) * 16; float y[16]; float ss = 0.f;
#pragma unroll
          for (int q = 0; q < 4; ++q) { const f32x4 a = *(const LAS f32x4*)(YO + row * 132 + c0 + 4 * q), bb = *(const LAS f32x4*)(YO + 8448 + row * 132 + c0 + 4 * q);
              y[4 * q] = a.x + bb.x; y[4 * q + 1] = a.y + bb.y; y[4 * q + 2] = a.z + bb.z; y[4 * q + 3] = a.w + bb.w; }
#pragma unroll
          for (int q = 0; q < 16; ++q) ss += y[q] * y[q];
          ss += __shfl_xor(ss, 1); ss += __shfl_xor(ss, 2); ss += __shfl_xor(ss, 4);
          const float r = 1.0f / sqrtf(ss * (1.0f / 128.0f) + EPS);
          float g0[8], g1[8];
          unpack8(gate0, g0); unpack8(gate1, g1);
          float o0[8], o1[8];
#pragma unroll
          for (int q = 0; q < 8; ++q) { o0[q] = y[q] * r * ng[h * 128 + c0 + q] * sigmoidf_(g0[q]); o1[q] = y[8 + q] * r * ng[h * 128 + c0 + 8 + q] * sigmoidf_(g1[q]); }
          *(u32x4*)(Y + (size_t)(r0 + row) * D + h * 128 + c0) = pack8(o0); *(u32x4*)(Y + (size_t)(r0 + row) * D + h * 128 + c0 + 8) = pack8(o1); }
    }
#undef MO_PREFETCH
#undef MO_DECODE
}

DI void phase_gla_decay(const Ctx& c) {
    const float* EX = WSP(float, WS_EXTRA); float* GB = WSP(float, WS_BIG + BIG_GB);
    LAS float* w2s = (LAS float*)c.lds; LAS float* gbs = w2s + 2048; LAS float* lgs = gbs + 128; LAS float* segs = lgs + 8192;
    const int srow = c.tid >> 3, dg = c.tid & 7;
    const int dir = (blockIdx.x >> 2) & 1, h = blockIdx.x & 3, nper = gridDim.x >> 3;
    __syncthreads();
    for (int i = c.tid; i < 2048; i += 512) w2s[i] = c.in[I_GLW2][(size_t)dir * 8192 + (i >> 7) * 512 + h * 128 + (i & 127)];
    if (c.tid < 128) gbs[c.tid] = c.in[I_GLGB][dir * 512 + h * 128 + c.tid];
    for (int ck = blockIdx.x >> 3; ck < 288; ck += nper) {
        const int r0 = 64 * ck;
        __syncthreads();
        f32x4 low[4];
#pragma unroll
        for (int q = 0; q < 4; ++q) low[q] = *(const f32x4*)(EX + (size_t)(r0 + srow) * 32 + dir * 16 + 4 * q);
        __syncthreads();
        { const int d0 = 16 * dg; float pre[16];
#pragma unroll
          for (int e = 0; e < 16; ++e) pre[e] = gbs[d0 + e];
#pragma unroll
          for (int r = 0; r < 16; ++r) { const float lv = low[r >> 2][r & 3];
#pragma unroll
              for (int q = 0; q < 4; ++q) { const f32x4 w = *(const LAS f32x4*)(w2s + r * 128 + d0 + 4 * q); pre[4 * q] += lv * w.x; pre[4 * q + 1] += lv * w.y; pre[4 * q + 2] += lv * w.z; pre[4 * q + 3] += lv * w.w; } }
#pragma unroll
          for (int q = 0; q < 4; ++q) *(LAS f32x4*)(lgs + srow * 128 + d0 + 4 * q) = (f32x4){logsigf_(pre[4 * q]) * 0.0625f, logsigf_(pre[4 * q + 1]) * 0.0625f, logsigf_(pre[4 * q + 2]) * 0.0625f, logsigf_(pre[4 * q + 3]) * 0.0625f}; }
        __syncthreads();
        { const int d = c.tid & 127, sg = c.tid >> 7; float v[16];
#pragma unroll
          for (int i = 0; i < 16; ++i) { const int s = dir ? 63 - (16 * sg + i) : 16 * sg + i; v[i] = lgs[s * 128 + d]; }
#pragma unroll
          for (int i = 1; i < 16; ++i) v[i] += v[i - 1];
          segs[sg * 128 + d] = v[15];
          __syncthreads();
          float off = 0.f;
#pragma unroll
          for (int g2 = 0; g2 < 3; ++g2) off += (g2 < sg) ? segs[g2 * 128 + d] : 0.f;
#pragma unroll
          for (int i = 0; i < 16; ++i) { const int s = dir ? 63 - (16 * sg + i) : 16 * sg + i; GB[((size_t)dir * TT + r0 + s) * 512 + h * 128 + d] = v[i] + off; } }
    }
}
DI void phase_gla_state(const Ctx& c) {
    const bf16* PC = WSP(bf16, WS_BIG + BIG_PC); const float* GB = WSP(float, WS_BIG + BIG_GB); bf16* GST = WSP(bf16, WS_BIG + BIG_GST);
    LAS float* tot = (LAS float*)c.lds;
    LAS unsigned char* Kd = c.lds + 1024; LAS unsigned char* Vs = Kd + 64 * 272;
    const int lane = c.lane, wave = c.wave, h5 = lane >> 5, l31 = lane & 31, dkt = wave & 3, dvt = wave >> 2;
    const int srow = c.tid >> 3, dg = c.tid & 7;
    for (int it0 = blockIdx.x; it0 < 256; it0 += gridDim.x) {
        const int item = (gridDim.x == 256) ? ((it0 & 7) * 32 + (it0 >> 3)) : it0;
        const int b = item >> 5, h = (item >> 3) & 3, dir = (item >> 2) & 1, dvq = item & 3, seq = (b * 4 + h) * 2 + dir;
        f32x16 acc = zero16();
        u32x4 kA0, kA1, vA, kB0, kB1, vB; f32x4 bvA[4], tvA[4], bvB[4], tvB[4];
#define GLA_PREFETCH(p_, k0, k1, vr, bv, tv) do { const int r0_ = chunk_row0((p_), b, dir), row = r0_ + srow; \
          k0 = *(const u32x4*)(PC + (size_t)row * 2048 + 512 + h * 128 + 16 * dg); k1 = *(const u32x4*)(PC + (size_t)row * 2048 + 512 + h * 128 + 16 * dg + 8); \
          vr = *(const u32x4*)(PC + (size_t)row * 2048 + 1024 + h * 256 + dvq * 64 + 8 * dg); \
          _Pragma("unroll") for (int q = 0; q < 4; ++q) { bv[q] = *(const f32x4*)(GB + ((size_t)dir * TT + row) * 512 + h * 128 + 16 * dg + 4 * q); \
              tv[q] = *(const f32x4*)(GB + ((size_t)dir * TT + r0_ + (dir ? 0 : 63)) * 512 + h * 128 + 16 * dg + 4 * q); } } while (0)
        GLA_PREFETCH(0, kA0, kA1, vA, bvA, tvA); GLA_PREFETCH(1, kB0, kB1, vB, bvB, tvB);
#define GLA_STEP(p, k0r, k1r, vr, bv, tv) do { \
            { bf16* dst = GST + ((size_t)seq * 36 + (p)) * 32768 + (size_t)(dvq * 64 + 32 * dvt + l31) * 128 + 32 * dkt + 4 * h5; \
              _Pragma("unroll") for (int q = 0; q < 4; ++q) { u32x2 w; w.x = cvt_pk_bf16(acc[4 * q], acc[4 * q + 1]); w.y = cvt_pk_bf16(acc[4 * q + 2], acc[4 * q + 3]); *(u32x2*)(dst + 8 * q) = w; } } \
            lds_barrier();                                    \
            { float kk[16]; { float t8[8]; unpack8(k0r, t8); \
                _Pragma("unroll") for (int e = 0; e < 8; ++e) kk[e] = t8[e]; unpack8(k1r, t8); \
                _Pragma("unroll") for (int e = 0; e < 8; ++e) kk[8 + e] = t8[e]; } \
              _Pragma("unroll") for (int e = 0; e < 16; ++e) kk[e] *= __expf(tv[e >> 2][e & 3] - bv[e >> 2][e & 3]); \
              const float k0[8] = {kk[0], kk[1], kk[2], kk[3], kk[4], kk[5], kk[6], kk[7]}, k1[8] = {kk[8], kk[9], kk[10], kk[11], kk[12], kk[13], kk[14], kk[15]}; \
              *(LAS u32x4*)(Kd + srow * 272 + dg * 32) = pack8(k0); *(LAS u32x4*)(Kd + srow * 272 + dg * 32 + 16) = pack8(k1); \
              *(LAS u32x4*)(Vs + srow * 144 + dg * 16) = vr; \
              if (srow == 0) { \
                  _Pragma("unroll") for (int q = 0; q < 4; ++q) *(LAS f32x4*)(tot + 16 * dg + 4 * q) = tv[q]; } } \
            if ((p) + 2 < 36) GLA_PREFETCH((p) + 2, k0r, k1r, vr, bv, tv); \
            lds_barrier(); \
            _Pragma("unroll") for (int r = 0; r < 16; ++r) acc[r] *= __expf(tot[32 * dkt + crow(r, h5)]); \
            _Pragma("unroll") for (int kk = 0; kk < 4; ++kk) acc = MFMA32(tr_frag(Kd, 272, 16 * kk, 32 * dkt, lane), tr_frag(Vs, 144, 16 * kk, 32 * dvt, lane), acc); \
            } while (0)
        for (int p = 0; p < 36; p += 2) { GLA_STEP(p, kA0, kA1, vA, bvA, tvA); GLA_STEP(p + 1, kB0, kB1, vB, bvB, tvB); }
#undef GLA_STEP
#undef GLA_PREFETCH
    }
}
DI void phase_gla_out(const Ctx& c, const float* ng) {
    const bf16* P = WSP(bf16, WS_P); const bf16* PC = WSP(bf16, WS_BIG + BIG_PC); const float* GB = WSP(float, WS_BIG + BIG_GB);
    const bf16* GST = WSP(bf16, WS_BIG + BIG_GST); bf16* Y = WSP(bf16, WS_Y);
    LAS unsigned char* Qt = c.lds; LAS unsigned char* Kt = Qt + 17408; LAS unsigned char* Vs = Kt + 17408; LAS unsigned char* STs = Vs + 33792;
    LAS float* YO = (LAS float*)STs;
    const int lane = c.lane, wave = c.wave, h5 = lane >> 5, l31 = lane & 31;
    const int srow = c.tid >> 3, dg = c.tid & 7;
    for (int item = blockIdx.x; item < 1152; item += gridDim.x) {
        const int b = item / 144, h = (item / 36) & 3, cc = item % 36;
        const int r0 = cc < 4 ? b * CTX + 64 * cc : TC + b * SEQ + 64 * (cc - 4);
        __syncthreads();
#pragma unroll
        for (int i = 0; i < 4; ++i) { const int pc = dg + 8 * i; *(LAS u32x4*)(Vs + srow * 528 + pc * 16) = *(const u32x4*)(PC + (size_t)(r0 + srow) * 2048 + 1024 + h * 256 + 8 * pc); }
        f32x16 O[2]; O[0] = zero16(); O[1] = zero16();
        for (int dir = 0; dir < 2; ++dir) {
            const int pslot = dir ? (cc < 4 ? 3 - cc : 39 - cc) : cc;
            if (dir) __syncthreads();
            { const bf16* src = GST + ((size_t)((b * 4 + h) * 2 + dir) * 36 + pslot) * 32768;
#pragma unroll
              for (int i = 0; i < 8; ++i) { const int pc = c.tid + 512 * i, rr = pc >> 4, sp = pc & 15; *(LAS u32x4*)(STs + rr * 272 + sp * 16) = *(const u32x4*)(src + rr * 128 + 8 * sp); } }
            { float qq[16], kk[16], bb[16]; float t8[8];
#pragma unroll
              for (int q = 0; q < 4; ++q) { const f32x4 t4 = *(const f32x4*)(GB + ((size_t)dir * TT + r0 + srow) * 512 + h * 128 + 16 * dg + 4 * q); bb[4 * q] = t4.x; bb[4 * q + 1] = t4.y; bb[4 * q + 2] = t4.z; bb[4 * q + 3] = t4.w; }
              unpack8(*(const u32x4*)(PC + (size_t)(r0 + srow) * 2048 + h * 128 + 16 * dg), t8);
#pragma unroll
              for (int e = 0; e < 8; ++e) qq[e] = t8[e];
              unpack8(*(const u32x4*)(PC + (size_t)(r0 + srow) * 2048 + h * 128 + 16 * dg + 8), t8);
#pragma unroll
              for (int e = 0; e < 8; ++e) qq[8 + e] = t8[e];
              unpack8(*(const u32x4*)(PC + (size_t)(r0 + srow) * 2048 + 512 + h * 128 + 16 * dg), t8);
#pragma unroll
              for (int e = 0; e < 8; ++e) kk[e] = t8[e];
              unpack8(*(const u32x4*)(PC + (size_t)(r0 + srow) * 2048 + 512 + h * 128 + 16 * dg + 8), t8);
#pragma unroll
              for (int e = 0; e < 8; ++e) kk[8 + e] = t8[e];
#pragma unroll
              for (int e = 0; e < 16; ++e) { const float eb = __expf(bb[e]); qq[e] *= eb; kk[e] *= 1.0f / eb; }
              const float q0[8] = {qq[0], qq[1], qq[2], qq[3], qq[4], qq[5], qq[6], qq[7]}, q1[8] = {qq[8], qq[9], qq[10], qq[11], qq[12], qq[13], qq[14], qq[15]};
              const float k0[8] = {kk[0], kk[1], kk[2], kk[3], kk[4], kk[5], kk[6], kk[7]}, k1[8] = {kk[8], kk[9], kk[10], kk[11], kk[12], kk[13], kk[14], kk[15]};
              *(LAS u32x4*)(Qt + srow * 272 + dg * 32) = pack8(q0); *(LAS u32x4*)(Qt + srow * 272 + dg * 32 + 16) = pack8(q1);
              *(LAS u32x4*)(Kt + srow * 272 + dg * 32) = pack8(k0); *(LAS u32x4*)(Kt + srow * 272 + dg * 32 + 16) = pack8(k1); }
            __syncthreads();
#pragma unroll
            for (int jt = 0; jt < 2; ++jt) {
#pragma unroll
                for (int st = 0; st < 2; ++st) {
                    const bool live = dir ? (st >= jt) : (st <= jt);
                    if (live) {
                        f32x16 X = zero16();
#pragma unroll
                        for (int kk = 0; kk < 8; ++kk) X = MFMA32(row_frag(Kt, 272, 32 * st, 16 * kk, lane), row_frag(Qt, 272, 32 * jt, 16 * kk, lane), X);
                        if (st == jt) {
#pragma unroll
                            for (int r = 0; r < 16; ++r) { const int s = crow(r, h5); const bool ok = dir ? (s >= l31) : (s <= l31); X[r] = ok ? X[r] : 0.f; } }
#pragma unroll
                        for (int step = 0; step < 2; ++step) O[jt] = MFMA32(tr_frag_perm(Vs, 528, 32 * st + 16 * step, 32 * wave, lane), pack_acc(X, step), O[jt]);
                    }
                }
#pragma unroll
                for (int kk = 0; kk < 8; ++kk) O[jt] = MFMA32(row_frag(STs, 272, 32 * wave, 16 * kk, lane), row_frag(Qt, 272, 32 * jt, 16 * kk, lane), O[jt]);
            }
        }
        __syncthreads();
#pragma unroll
        for (int jt = 0; jt < 2; ++jt)
#pragma unroll
            for (int q = 0; q < 4; ++q) *(LAS f32x4*)(YO + (32 * jt + l31) * 260 + 32 * wave + 8 * q + 4 * h5) = (f32x4){O[jt][4 * q], O[jt][4 * q + 1], O[jt][4 * q + 2], O[jt][4 * q + 3]};
        __syncthreads();
        { const int c0 = dg * 32; float y[32]; float ss = 0.f;
#pragma unroll
          for (int q = 0; q < 8; ++q) { const f32x4 a = *(const LAS f32x4*)(YO + srow * 260 + c0 + 4 * q); y[4 * q] = a.x; y[4 * q + 1] = a.y; y[4 * q + 2] = a.z; y[4 * q + 3] = a.w; }
#pragma unroll
          for (int q = 0; q < 32; ++q) ss += y[q] * y[q];
          ss += __shfl_xor(ss, 1); ss += __shfl_xor(ss, 2); ss += __shfl_xor(ss, 4);
          const float r = 1.0f / sqrtf(ss * (1.0f / 256.0f) + EPS);
#pragma unroll
          for (int q = 0; q < 4; ++q) { float g8[8], o8[8]; unpack8(*(const u32x4*)(P + (size_t)(r0 + srow) * PLD + 2048 + h * 256 + c0 + 8 * q), g8);
#pragma unroll
              for (int e = 0; e < 8; ++e) o8[e] = y[8 * q + e] * r * ng[h * 256 + c0 + 8 * q + e] * siluf_(g8[e]);
              *(u32x4*)(Y + (size_t)(r0 + srow) * D + h * 256 + c0 + 8 * q) = pack8(o8); } }
    }
}

DI void phase_gla_scan_naive(const Ctx& c) {
    const bf16* PC = WSP(bf16, WS_BIG + BIG_PC); const float* EX = WSP(float, WS_EXTRA);
    LAS float* qs = (LAS float*)c.lds; LAS float* ks = qs + 16 * 128; LAS float* as = ks + 16 * 128; LAS float* vs = as + 16 * 128; LAS float* lw = vs + 16 * 256;
    const int v = c.tid >> 1, d0 = (c.tid & 1) * 64;
    for (int item = blockIdx.x; item < 64; item += gridDim.x) {
        const int b = item >> 3, h = (item >> 1) & 3, dir = item & 1;
        float* Yo = WSP(float, WS_BIG + (dir ? BIG_YB : BIG_YF));
        const float* w2 = c.in[I_GLW2] + (size_t)dir * 16 * 512 + h * 128; const float* gb = c.in[I_GLGB] + dir * 512 + h * 128;
        float S[64];
#pragma unroll
        for (int d = 0; d < 64; ++d) S[d] = 0.f;
        for (int ch = 0; ch < (CTX + SEQ) / 16; ++ch) {
            __syncthreads();
            if (c.tid < 256) { const int st = c.tid >> 4, r = c.tid & 15, row = scan_row(ch * 16 + st, b, dir); lw[c.tid] = EX[(size_t)row * 32 + dir * 16 + r]; }
            for (int idx = c.tid; idx < 16 * 512; idx += 512) { const int st = idx >> 9, col = idx & 511, row = scan_row(ch * 16 + st, b, dir);
                if (col < 128) qs[st * 128 + col] = bf2f(PC[(size_t)row * 2048 + h * 128 + col]);
                else if (col < 256) ks[st * 128 + col - 128] = bf2f(PC[(size_t)row * 2048 + 512 + h * 128 + col - 128]);
                else vs[st * 256 + col - 256] = bf2f(PC[(size_t)row * 2048 + 1024 + h * 256 + col - 256]); }
            __syncthreads();
            for (int idx = c.tid; idx < 16 * 128; idx += 512) { const int st = idx >> 7, d = idx & 127; float pre = gb[d];
#pragma unroll
                for (int r = 0; r < 16; ++r) pre += lw[st * 16 + r] * w2[r * 512 + d];
                as[idx] = __expf(logsigf_(pre) * (1.0f / 16.0f)); }
            __syncthreads();
            for (int st = 0; st < 16; ++st) {
                const float vv = vs[st * 256 + v]; float part = 0.f;
#pragma unroll
                for (int d = 0; d < 64; ++d) { S[d] = as[st * 128 + d0 + d] * S[d] + ks[st * 128 + d0 + d] * vv; part += qs[st * 128 + d0 + d] * S[d]; }
                part += __shfl_xor(part, 1);
                if ((c.tid & 1) == 0) { const int row = scan_row(ch * 16 + st, b, dir); Yo[(size_t)row * D + h * 256 + v] = part; }
            }
        }
    }
}
DI void phase_headnorm(const Ctx& c, int hd, const float* ng) {
    const float* YF = WSP(float, WS_BIG + BIG_YF); const float* YB = WSP(float, WS_BIG + BIG_YB); const bf16* P = WSP(bf16, WS_P); bf16* Y = WSP(bf16, WS_Y);
    for (int row = c.gw; row < TT; row += c.ngw) {
        const int c0 = 16 * c.lane; float y[16]; float ss = 0.f;
#pragma unroll
        for (int j = 0; j < 4; ++j) { const f32x4 a = *(const f32x4*)(YF + (size_t)row * D + c0 + 4 * j), bb = *(const f32x4*)(YB + (size_t)row * D + c0 + 4 * j);
            y[4 * j] = a.x + bb.x; y[4 * j + 1] = a.y + bb.y; y[4 * j + 2] = a.z + bb.z; y[4 * j + 3] = a.w + bb.w; }
#pragma unroll
        for (int j = 0; j < 16; ++j) ss += y[j] * y[j];
        ss += __shfl_xor(ss, 1); ss += __shfl_xor(ss, 2); ss += __shfl_xor(ss, 4); if (hd == 256) ss += __shfl_xor(ss, 8);
        const float r = 1.0f / sqrtf(ss / (float)hd + EPS);
        float g0[8], g1[8];
        unpack8(*(const u32x4*)(P + (size_t)row * PLD + 2048 + c0), g0); unpack8(*(const u32x4*)(P + (size_t)row * PLD + 2048 + c0 + 8), g1);
        float o[16];
#pragma unroll
        for (int j = 0; j < 16; ++j) { const float gp = j < 8 ? g0[j] : g1[j - 8]; o[j] = y[j] * r * ng[c0 + j] * (hd == 128 ? sigmoidf_(gp) : siluf_(gp)); }
        const float o0[8] = {o[0], o[1], o[2], o[3], o[4], o[5], o[6], o[7]}, o1[8] = {o[8], o[9], o[10], o[11], o[12], o[13], o[14], o[15]};
        *(u32x4*)(Y + (size_t)row * D + c0) = pack8(o0); *(u32x4*)(Y + (size_t)row * D + c0 + 8) = pack8(o1);
    }
}
DI void phase_hyena_conv_naive(const Ctx& c) {
    const bf16* PC = WSP(bf16, WS_BIG + BIG_PC); bf16* Y = WSP(bf16, WS_Y); const float* skip = c.in[I_HYSKIP];
    LAS float* zt = (LAS float*)c.lds;
    LAS float* ft = zt + 4096;
    const int cc = c.tid & 63, tg = c.tid >> 6;
    for (int item = blockIdx.x; item < 4096 + 512; item += gridDim.x) {
        int L, rb, tt, cgi; const float* tab;
        if (item < 4096) { L = SEQ; const int b = item >> 9; tt = (item >> 4) & 31; cgi = item & 15; rb = TC + b * SEQ; tab = WSP(float, WS_HF); }
        else { const int it = item - 4096; L = CTX; const int b = it >> 6; tt = (it >> 4) & 3; cgi = it & 15; rb = b * CTX; tab = WSP(float, WS_HFC); }
        const int t0 = 64 * tt, c0 = 64 * cgi;
        float acc[8];
#pragma unroll
        for (int i = 0; i < 8; ++i) acc[i] = 0.f;
        for (int sb = 0; sb < L / 64; ++sb) {
            const int s0 = 64 * sb;
            __syncthreads();
            for (int idx = c.tid; idx < 4096; idx += 512) { const int sl = idx >> 6, ch = idx & 63; const size_t o = (size_t)(rb + s0 + sl) * PLD + c0 + ch;
                zt[idx] = bf2f(PC[o + 1024]) * bf2f(PC[o + 2048]); }
            for (int idx = c.tid; idx < 64 * 128; idx += 512) { const int ch = idx >> 7, j = idx & 127;
                if (j < 127) ft[j * 65 + ch] = tab[(size_t)(c0 + ch) * (2 * L) + L + (t0 - s0 - 63 + j)]; }
            __syncthreads();
#pragma unroll 1
            for (int g = 0; g < 8; ++g) {
                float w[15], z[8]; const int base = 8 * (tg - g) + 56;
#pragma unroll
                for (int m = 0; m < 15; ++m) w[m] = ft[(base + m) * 65 + cc];
#pragma unroll
                for (int j = 0; j < 8; ++j) z[j] = zt[(8 * g + j) * 64 + cc];
#pragma unroll
                for (int i = 0; i < 8; ++i)
#pragma unroll
                    for (int j = 0; j < 8; ++j) acc[i] += w[i - j + 7] * z[j];
            }
        }
#pragma unroll
        for (int i = 0; i < 8; ++i) { const int row = rb + t0 + 8 * tg + i; const size_t o = (size_t)row * PLD + c0 + cc;
            const float zin = bf2f(PC[o + 1024]) * bf2f(PC[o + 2048]), x0 = bf2f(PC[o]);
            Y[(size_t)row * D + c0 + cc] = f2bf(x0 * (acc[i] + skip[c0 + cc] * zin)); }
    }
}

DI void hy_item(int item, int& L, int& b, int& t0, int& c0, int& rb) {
    if (item < 4096) { L = SEQ; b = item >> 9; t0 = 64 * ((item >> 4) & 31); c0 = 64 * (item & 15); rb = TC + b * SEQ; }
    else { const int it = item - 4096; L = CTX; b = it >> 6; t0 = 64 * ((it >> 4) & 3); c0 = 64 * (it & 15); rb = b * CTX; }
}
DI void phase_hy_prep(const Ctx& c) {
    const bf16* P = WSP(bf16, WS_P); bf16* X0C = WSP(bf16, WS_BIG + BIG_PC); const float* cw = c.in[I_HYCW]; const float* cb = c.in[I_HYCB];
    LAS unsigned char* raw = c.lds;
    LAS float* zt = (LAS float*)(c.lds + 32768);
    u32x4 pre[4];
#define HP_PREF(it_) do { int L_, b_, t0_, c0_, rb_; hy_item((it_), L_, b_, t0_, c0_, rb_); \
        _Pragma("unroll") for (int k = 0; k < 4; ++k) { const int pc = c.tid + 512 * k; pre[k] = (u32x4){c.z, c.z, c.z, c.z}; \
            if (pc < 3 * 66 * 8) { const int g = pc / 528, rr = (pc % 528) >> 3, sp = pc & 7, t = t0_ - 1 + rr; \
                if (t >= 0 && t < L_) pre[k] = *(const u32x4*)(P + (size_t)(rb_ + t) * PLD + g * 1024 + c0_ + 8 * sp); } } } while (0)
    if ((int)blockIdx.x < 4608) HP_PREF((int)blockIdx.x);
    for (int item = blockIdx.x; item < 4608; item += gridDim.x) {
        int L, b, t0, c0, rb; hy_item(item, L, b, t0, c0, rb);
        bf16* ZT = L == SEQ ? WSP(bf16, WS_BIG + BIG_ZTL) : WSP(bf16, WS_BIG + BIG_ZTC);
        lds_barrier();
#pragma unroll
        for (int k = 0; k < 4; ++k) { const int pc = c.tid + 512 * k; if (pc < 3 * 66 * 8) { const int g = pc / 528, rr = (pc % 528) >> 3, sp = pc & 7; *(LAS u32x4*)(raw + (g * 66 + rr) * 128 + sp * 16) = pre[k]; } }
        if (item + (int)gridDim.x < 4608) HP_PREF(item + (int)gridDim.x);
        lds_barrier();
        { const int t = c.tid >> 3, sp = c.tid & 7; float u[3][8];
#pragma unroll
          for (int g = 0; g < 3; ++g) { float xm[8], x0[8], xp[8];
              unpack8(*(const LAS u32x4*)(raw + (g * 66 + t) * 128 + sp * 16), xm); unpack8(*(const LAS u32x4*)(raw + (g * 66 + t + 1) * 128 + sp * 16), x0); unpack8(*(const LAS u32x4*)(raw + (g * 66 + t + 2) * 128 + sp * 16), xp);
              const int col = g * 1024 + c0 + 8 * sp;
#pragma unroll
              for (int e = 0; e < 8; ++e) u[g][e] = cw[col + e] * xm[e] + cw[3072 + col + e] * x0[e] + cw[6144 + col + e] * xp[e] + cb[col + e]; }
          *(u32x4*)(X0C + (size_t)(rb + t0 + t) * 1024 + c0 + 8 * sp) = pack8(u[0]);
#pragma unroll
          for (int e = 0; e < 8; ++e) zt[t * 65 + 8 * sp + e] = u[1][e] * u[2][e]; }
        lds_barrier();
        { const int ch = c.tid >> 3, tp = c.tid & 7; float z[8];
#pragma unroll
          for (int e = 0; e < 8; ++e) z[e] = zt[(8 * tp + e) * 65 + ch];
          *(u32x4*)(ZT + ((size_t)(c0 + ch) * NB + b) * L + t0 + 8 * tp) = pack8(z); }
    }
#undef HP_PREF
}
template <int L>
DI void hy_toeplitz_channel(const Ctx& c, const float* hrow  , const bf16* zsrc  , bf16* ydst  ) {
    constexpr int NBK = L / 32, CP = 2 * L + 8, NT = (NBK + 31) / 32, DMIN = -(NBK - 1), DMAX = NBK - 1;
    LAS unsigned char* F = c.lds;
    LAS unsigned char* Zs = c.lds + 8 * CP * 2;
    LAS unsigned char* R1 = Zs + (8 * NBK + 1) * 80;
    const int lane = c.lane, w = c.wave, h5 = lane >> 5, a = lane & 31, pi = lane & 15, rho = (lane >> 4) & 1;
    __syncthreads();
    for (int g = c.tid; g < (2 * L + 16) / 8; g += 512) { float v[8];
#pragma unroll
        for (int j = 0; j < 8; ++j) { const int y = 8 * g + j; v[j] = (y >= 1 && y <= 2 * L - 1) ? hrow[2 * L - y] : 0.f; }
        *(LAS u32x4*)(R1 + g * 16) = pack8(v); }
    if (c.tid < 20) *(LAS unsigned*)(Zs + 8 * NBK * 80 + 4 * c.tid) = c.z;
    for (int pc = c.tid; pc < 8 * L / 8; pc += 512) { const int bb = pc / (L / 8), pj = pc % (L / 8);
        *(LAS u32x4*)(Zs + (bb * NBK + (pj >> 2)) * 80 + (pj & 3) * 16) = *(const u32x4*)(zsrc + (size_t)bb * L + 8 * pj); }
    __syncthreads();
    for (int g = c.tid; g < 2 * L / 8; g += 512) {
        const u32x4 lo = *(const LAS u32x4*)(R1 + g * 16), hi = *(const LAS u32x4*)(R1 + g * 16 + 16);
        const unsigned Dw[8] = {lo.x, lo.y, lo.z, lo.w, hi.x, hi.y, hi.z, hi.w};
#pragma unroll
        for (int r = 0; r < 8; ++r) { u32x4 o;
            if (r & 1) { o.x = __builtin_amdgcn_alignbit(Dw[r / 2 + 1], Dw[r / 2], 16); o.y = __builtin_amdgcn_alignbit(Dw[r / 2 + 2], Dw[r / 2 + 1], 16);
                         o.z = __builtin_amdgcn_alignbit(Dw[r / 2 + 3], Dw[r / 2 + 2], 16); o.w = __builtin_amdgcn_alignbit(Dw[r / 2 + 4], Dw[r / 2 + 3], 16); }
            else { o.x = Dw[r / 2]; o.y = Dw[r / 2 + 1]; o.z = Dw[r / 2 + 2]; o.w = Dw[r / 2 + 3]; }
            *(LAS u32x4*)(F + (r * CP + 8 * g) * 2) = o; } }
    __syncthreads();
    const int r = (-a) & 7;
    f32x16 acc[NT];
    u32x4 Bf[2][NT][2];
#define HY_BLK(blk_) ((unsigned)(blk_) < (unsigned)NBK ? w * NBK + (blk_) : 8 * NBK)
#pragma unroll
    for (int q = 0; q < NT; ++q) { acc[q] = zero16();
#pragma unroll
        for (int par = 0; par < 2; ++par)
#pragma unroll
            for (int step = 0; step < 2; ++step) Bf[par][q][step] = *(const LAS u32x4*)(Zs + HY_BLK(32 * q + 2 * pi + rho - (DMIN + par)) * 80 + 32 * step + 16 * h5); }
    for (int d0 = DMIN; d0 <= DMAX; d0 += 2) {
#pragma unroll
        for (int par = 0; par < 2; ++par) {
            const int d = d0 + par;
            if (d <= DMAX) {
#pragma unroll
                for (int step = 0; step < 2; ++step) {
                    const int y0 = L - 32 * d - a + 16 * step + 8 * h5;
                    const bf16x8 A = *(const LAS bf16x8*)(F + (r * CP + (y0 - r)) * 2);
#pragma unroll
                    for (int q = 0; q < NT; ++q) if (d >= 32 * q - (NBK - 1) && d <= 32 * q + 31) acc[q] = MFMA32(A, __builtin_bit_cast(bf16x8, Bf[par][q][step]), acc[q]);
                }
#pragma unroll
                for (int q = 0; q < NT; ++q)
#pragma unroll
                    for (int step = 0; step < 2; ++step) {
                        const u32x4 fr = *(const LAS u32x4*)(Zs + HY_BLK(32 * q + rho - (d + 2)) * 80 + 32 * step + 16 * h5); u32x4 nb;
                        nb.x = (unsigned)__builtin_amdgcn_update_dpp((int)fr.x, (int)Bf[par][q][step].x, 0x111, 0xf, 0xf, false);
                        nb.y = (unsigned)__builtin_amdgcn_update_dpp((int)fr.y, (int)Bf[par][q][step].y, 0x111, 0xf, 0xf, false);
                        nb.z = (unsigned)__builtin_amdgcn_update_dpp((int)fr.z, (int)Bf[par][q][step].z, 0x111, 0xf, 0xf, false);
                        nb.w = (unsigned)__builtin_amdgcn_update_dpp((int)fr.w, (int)Bf[par][q][step].w, 0x111, 0xf, 0xf, false);
                        Bf[par][q][step] = nb; }
            }
        }
    }
#undef HY_BLK
#pragma unroll
    for (int q = 0; q < NT; ++q) { const int i = 32 * q + 2 * pi + rho;
        if (i < NBK) {
#pragma unroll
            for (int qq = 0; qq < 4; ++qq) { u32x2 o; o.x = cvt_pk_bf16(acc[q][4 * qq], acc[q][4 * qq + 1]); o.y = cvt_pk_bf16(acc[q][4 * qq + 2], acc[q][4 * qq + 3]);
                *(u32x2*)(ydst + (size_t)w * L + 32 * i + 8 * qq + 4 * h5) = o; } } }
}
DI void phase_hy_toeplitz(const Ctx& c) {
    for (int ch = blockIdx.x; ch < 1024; ch += gridDim.x) {
        hy_toeplitz_channel<SEQ>(c, WSP(float, WS_HF) + (size_t)ch * 4096, WSP(bf16, WS_BIG + BIG_ZTL) + (size_t)ch * NB * SEQ, WSP(bf16, WS_BIG + BIG_YTL) + (size_t)ch * NB * SEQ);
        hy_toeplitz_channel<CTX>(c, WSP(float, WS_HFC) + (size_t)ch * 512, WSP(bf16, WS_BIG + BIG_ZTC) + (size_t)ch * NB * CTX, WSP(bf16, WS_BIG + BIG_YTC) + (size_t)ch * NB * CTX);
    }
}
DI void phase_hy_post(const Ctx& c) {
    const bf16* X0C = WSP(bf16, WS_BIG + BIG_PC); bf16* Y = WSP(bf16, WS_Y); const float* skip = c.in[I_HYSKIP];
    LAS float* tl = (LAS float*)c.lds;
    u32x4 py, pz, px; float psk = 0.f;
#define HQ_PREF(it_) do { int L_, b_, t0_, c0_, rb_; hy_item((it_), L_, b_, t0_, c0_, rb_); \
        const bf16* ZT_ = L_ == SEQ ? WSP(bf16, WS_BIG + BIG_ZTL) : WSP(bf16, WS_BIG + BIG_ZTC); const bf16* YT_ = L_ == SEQ ? WSP(bf16, WS_BIG + BIG_YTL) : WSP(bf16, WS_BIG + BIG_YTC); \
        const int ch_ = c.tid >> 3, tp_ = c.tid & 7; const size_t o_ = ((size_t)(c0_ + ch_) * NB + b_) * L_ + t0_ + 8 * tp_; \
        py = *(const u32x4*)(YT_ + o_); pz = *(const u32x4*)(ZT_ + o_); psk = skip[c0_ + ch_]; \
        px = *(const u32x4*)(X0C + (size_t)(rb_ + t0_ + (c.tid >> 3)) * 1024 + c0_ + 8 * (c.tid & 7)); } while (0)
    if ((int)blockIdx.x < 4608) HQ_PREF((int)blockIdx.x);
    for (int item = blockIdx.x; item < 4608; item += gridDim.x) {
        int L, b, t0, c0, rb; hy_item(item, L, b, t0, c0, rb); (void)L; (void)b;
        lds_barrier();
        { const int ch = c.tid >> 3, tp = c.tid & 7; float y[8], z[8]; unpack8(py, y); unpack8(pz, z); const float sk = psk;
#pragma unroll
          for (int e = 0; e < 8; ++e) tl[ch * 65 + 8 * tp + e] = y[e] + sk * z[e]; }
        const u32x4 xc = px;
        if (item + (int)gridDim.x < 4608) HQ_PREF(item + (int)gridDim.x);
        lds_barrier();
        { const int t = c.tid >> 3, sp = c.tid & 7; float x0[8], o[8]; unpack8(xc, x0);
#pragma unroll
          for (int e = 0; e < 8; ++e) o[e] = x0[e] * tl[(8 * sp + e) * 65 + t];
          *(u32x4*)(Y + (size_t)(rb + t0 + t) * D + c0 + 8 * sp) = pack8(o); }
    }
#undef HQ_PREF
}

DI void phase_route(const Ctx& c, int l) {
    LAS float* rw = (LAS float*)c.lds;
    LAS int* lcnt = (LAS int*)(c.lds + 65536);
    LAS int* rinfo = lcnt + 32;
    LAS float* rwt = (LAS float*)(rinfo + 4 * 128);
    { const f32x4* srcw = (const f32x4*)WSP(float, WS_RWT);
#pragma unroll
      for (int i = 0; i < 8; ++i) *(LAS f32x4*)(rw + 4 * (c.tid + 512 * i)) = srcw[c.tid + 512 * i]; }
    if (c.tid < 16) lcnt[c.tid] = 0;
    __syncthreads();
    const float* MOD = WSP(float, WS_MOD) + (size_t)l * 9 * 6144; const float* g = c.in[I_N2G] + l * D; bf16* H = WSP(bf16, WS_H);
    const bf16* X = WSP(bf16, WS_X); const bf16* XC = WSP(bf16, WS_XC);
    unsigned* cnt = WSP(unsigned, WS_CTL) + CW_CNT + l * 16; int* TOK = WSP(int, WS_TOK); float* TOKW = WSP(float, WS_TOK + 512 * 1024);
    const float rbl = c.lane < 16 ? c.in[I_RB][c.lane] : 0.f;
    const int rlo = (l == 3 ? TC : 0), nrow = TT - rlo, per = (nrow + (int)gridDim.x - 1) / (int)gridDim.x;
    const int brow0 = rlo + (int)blockIdx.x * per, bn = min(per, TT - brow0);
    f32x4 vn[4];
    if (c.wave < bn) { const int row = brow0 + c.wave; load_row_bf(row < TC ? XC + (size_t)row * D : X + (size_t)(row - TC) * D, vn, c.lane); }
    for (int lr = c.wave; lr < bn; lr += 8) {
        const int row = brow0 + lr;
        f32x4 v[4];
#pragma unroll
        for (int j = 0; j < 4; ++j) v[j] = vn[j];
        if (lr + 8 < bn) { const int rn = row + 8; load_row_bf(rn < TC ? XC + (size_t)rn * D : X + (size_t)(rn - TC) * D, vn, c.lane); }
        const int mr = row < TC ? 8 : (row - TC) >> 11;
        norm_row(v, g, c.lane); mod_row(v, MOD + mr * 6144 + 3072, MOD + mr * 6144 + 4096, c.lane);
        store_row_bf16(H + (size_t)row * D, v, c.lane);
        float s16[16];
#pragma unroll
        for (int e = 0; e < 16; ++e) { float s = 0.f;
#pragma unroll
            for (int j = 0; j < 4; ++j) { const f32x4 w = *(const LAS f32x4*)(rw + e * 1024 + 256 * j + 4 * c.lane); s += (v[j].x * w.x + v[j].y * w.y) + (v[j].z * w.z + v[j].w * w.w); }
            s16[e] = s; if ((e & 3) == 3) asm volatile("" ::: "memory"); }
        float s8[8], s4[4], s2[2], s1;
        { const bool up = (c.lane & 32) != 0;
#pragma unroll
          for (int i = 0; i < 8; ++i) { const float keep = up ? s16[8 + i] : s16[i], give = up ? s16[i] : s16[8 + i]; s8[i] = keep + __shfl_xor(give, 32); } }
        { const bool up = (c.lane & 16) != 0;
#pragma unroll
          for (int i = 0; i < 4; ++i) { const float keep = up ? s8[4 + i] : s8[i], give = up ? s8[i] : s8[4 + i]; s4[i] = keep + __shfl_xor(give, 16); } }
        { const bool up = (c.lane & 8) != 0;
#pragma unroll
          for (int i = 0; i < 2; ++i) { const float keep = up ? s4[2 + i] : s4[i], give = up ? s4[i] : s4[2 + i]; s2[i] = keep + __shfl_xor(give, 8); } }
        { const bool up = (c.lane & 4) != 0; const float keep = up ? s2[1] : s2[0], give = up ? s2[0] : s2[1]; s1 = keep + __shfl_xor(give, 4); }
        s1 += __shfl_xor(s1, 2); s1 += __shfl_xor(s1, 1);
        const int eb = c.lane & 15; const int srcl = (((eb >> 3) & 1) << 5) | (((eb >> 2) & 1) << 4) | (((eb >> 1) & 1) << 3) | ((eb & 1) << 2);
        const float sc = sigmoidf_(__shfl(s1, srcl));
        const float sel = sc + rbl;
        float m1 = sel, m2 = -1e30f;
        { const float o1 = __shfl_xor(sel, 1); const float hi = fmaxf(sel, o1), lo = fminf(sel, o1);
          const float ohi = __shfl_xor(hi, 2), olo = __shfl_xor(lo, 2);
          m1 = fmaxf(hi, ohi); m2 = fmaxf(fminf(hi, ohi), fmaxf(lo, olo)); }
        const float gs = m1 + m2;
        const float g0 = __shfl(gs, 0), g1 = __shfl(gs, 4), g2 = __shfl(gs, 8), g3 = __shfl(gs, 12);
        int bg = 0; float bgs = g0; if (g1 > bgs) { bgs = g1; bg = 1; } if (g2 > bgs) { bgs = g2; bg = 2; } if (g3 > bgs) { bgs = g3; bg = 3; }
        float s4b[4], p4b[4];
#pragma unroll
        for (int j = 0; j < 4; ++j) { s4b[j] = __shfl(sel, 4 * bg + j); p4b[j] = __shfl(sc, 4 * bg + j); }
        int i1 = 0; float v1 = s4b[0], q1 = p4b[0];
#pragma unroll
        for (int j = 1; j < 4; ++j) if (s4b[j] > v1) { v1 = s4b[j]; i1 = j; q1 = p4b[j]; }
        int i2 = -1; float v2 = -1e30f, q2 = 0.f;
#pragma unroll
        for (int j = 0; j < 4; ++j) if (j != i1 && s4b[j] > v2) { v2 = s4b[j]; i2 = j; q2 = p4b[j]; }
        if (c.lane == 0) {
            const int e0 = 4 * bg + i1, e1 = 4 * bg + i2;
            const int p0 = __hip_atomic_fetch_add(lcnt + e0, 1, __ATOMIC_RELAXED, __HIP_MEMORY_SCOPE_WORKGROUP), p1 = __hip_atomic_fetch_add(lcnt + e1, 1, __ATOMIC_RELAXED, __HIP_MEMORY_SCOPE_WORKGROUP);
            rinfo[lr * 4 + 0] = e0; rinfo[lr * 4 + 1] = p0; rinfo[lr * 4 + 2] = e1; rinfo[lr * 4 + 3] = p1;
            const float inv = 1.0f / (q1 + q2); rwt[lr * 2] = q1 * inv; rwt[lr * 2 + 1] = q2 * inv;
        }
    }
    __syncthreads();
    if (c.tid < 16) lcnt[16 + c.tid] = (int)atomicAdd(cnt + c.tid, (unsigned)lcnt[c.tid]);
    __syncthreads();
    for (int lr = c.tid; lr < bn; lr += 512) { const int row = brow0 + lr, e0 = rinfo[lr * 4], e1 = rinfo[lr * 4 + 2];
        TOK[row * 4 + 0] = e0; TOK[row * 4 + 1] = lcnt[16 + e0] + rinfo[lr * 4 + 1]; TOK[row * 4 + 2] = e1; TOK[row * 4 + 3] = lcnt[16 + e1] + rinfo[lr * 4 + 3];
        TOKW[row * 2] = rwt[lr * 2]; TOKW[row * 2 + 1] = rwt[lr * 2 + 1]; }
}
DI void slot_bases(const unsigned* cnt, int lane, int e0, int e1, int& b0, int& b1) {
    const unsigned mine = lane < 16 ? ((cnt[lane] + 255u) & ~255u) : 0u; unsigned pb = 0; b0 = 0; b1 = 0;
#pragma unroll
    for (int e = 0; e < 16; ++e) { const unsigned ce = __shfl(mine, e); if (e == e0) b0 = (int)pb; if (e == e1) b1 = (int)pb; pb += ce; }
}
DI void phase_gather(const Ctx& c, int l) {
    const unsigned* cnt = WSP(unsigned, WS_CTL) + CW_CNT + l * 16; const int* TOK = WSP(int, WS_TOK); int* TOKS = WSP(int, WS_TOK + 768 * 1024);
    const bf16* H = WSP(bf16, WS_H); bf16* HS = WSP(bf16, WS_BIG + BIG_HS);
    const unsigned minep = c.lane < 16 ? ((cnt[c.lane] + 255u) & ~255u) : 0u; unsigned pb = 0; int mybase = 0;
#pragma unroll
    for (int e = 0; e < 16; ++e) { const unsigned ce = __shfl(minep, e); if (c.lane == e) mybase = (int)pb; pb += ce; }
    const int rfirst = (l == 3 ? TC : 0) + c.gw, rstep = c.ngw;
    int e0n = 0, p0n = 0, e1n = 0, p1n = 0; u32x4 an = {0u, 0u, 0u, 0u}, bn = an;
    if (rfirst < TT) { e0n = TOK[rfirst * 4]; p0n = TOK[rfirst * 4 + 1]; e1n = TOK[rfirst * 4 + 2]; p1n = TOK[rfirst * 4 + 3];
        an = *(const u32x4*)(H + (size_t)rfirst * D + 8 * c.lane); bn = *(const u32x4*)(H + (size_t)rfirst * D + 512 + 8 * c.lane); }
    for (int row = rfirst; row < TT; row += rstep) {
        const int e0 = e0n, p0 = p0n, e1 = e1n, p1 = p1n; const u32x4 a = an, bq = bn;
        if (row + rstep < TT) { const int r = row + rstep; e0n = TOK[r * 4]; p0n = TOK[r * 4 + 1]; e1n = TOK[r * 4 + 2]; p1n = TOK[r * 4 + 3];
            an = *(const u32x4*)(H + (size_t)r * D + 8 * c.lane); bn = *(const u32x4*)(H + (size_t)r * D + 512 + 8 * c.lane); }
        const int s0 = __shfl(mybase, e0) + p0, s1 = __shfl(mybase, e1) + p1;
        *(u32x4*)(HS + (size_t)s0 * D + 8 * c.lane) = a; *(u32x4*)(HS + (size_t)s0 * D + 512 + 8 * c.lane) = bq;
        *(u32x4*)(HS + (size_t)s1 * D + 8 * c.lane) = a; *(u32x4*)(HS + (size_t)s1 * D + 512 + 8 * c.lane) = bq;
        if (c.lane == 0) { TOKS[row * 2] = s0; TOKS[row * 2 + 1] = s1; }
    }
}
DI LAS int* moe_tiles(const Ctx& c, int l, int nsh) {
    LAS int* tp = (LAS int*)(c.lds + MISC_OFF);
    LAS int* ul = tp + 192;
    __syncthreads();
    if (c.tid < 64) {
        const unsigned* cnt = WSP(unsigned, WS_CTL) + CW_CNT + l * 16;
        const int mine = c.lane < 16 ? (int)((cnt[c.lane] + 255u) >> 8) : 0; int p = 0;
        for (int e = 0; e < 16; ++e) { const int ne = __shfl(mine, e); for (int t = c.lane; t < ne; t += 64) tp[1 + p + t] = e; p += ne; }
        if (c.lane == 0) tp[0] = p;
    }
    __syncthreads();
    if (c.tid < 32) {
        const int i = c.tid, ntile = tp[0], G = gridDim.x, cb = blockIdx.x; int rt = 1 << 20, pn = 0;
        if ((G & 7) == 0 && ((G >> 3) >> nsh) > 0) { const int x = cb & 7, v = cb >> 3, rpx = (G >> 3) >> nsh;
            if (v < (rpx << nsh)) { rt = (i * 8 + x) * rpx + (v >> nsh); pn = v & ((1 << nsh) - 1); } }
        else { const int L = i * G + cb; rt = L >> nsh; pn = L & ((1 << nsh) - 1); }
        ul[i] = rt < ntile ? (rt | (pn << 12) | (tp[1 + rt] << 16)) : -1;
    }
    __syncthreads();
    return ul;
}
DI void phase_combine(const Ctx& c, int l) {
    const float* MOD = WSP(float, WS_MOD) + (size_t)l * 9 * 6144; const int* TOKS = WSP(int, WS_TOK + 768 * 1024); const float* TOKW = WSP(float, WS_TOK + 512 * 1024);
    const bf16* YS = WSP(bf16, WS_BIG + BIG_HS); bf16* X = WSP(bf16, WS_X); bf16* XC = WSP(bf16, WS_XC); bf16* H = WSP(bf16, WS_H);
    const int rfirst = (l == 3 ? TC : 0) + c.gw, rstep = c.ngw;
    int sa0 = 0, sa1 = 0, sb0 = 0, sb1 = 0; float wa0 = 0.f, wa1 = 0.f, wb0 = 0.f, wb1 = 0.f;
    u32x2 dx[4], dy0[4], dy1[4];
#define CB_XP(r_) ((r_) < TC ? XC + (size_t)(r_) * D : X + (size_t)((r_) - TC) * D)
#define CB_LOAD(r_, s0_, s1_) do { const bf16* xq = CB_XP(r_); _Pragma("unroll") for (int j = 0; j < 4; ++j) { dx[j] = *(const u32x2*)(xq + 256 * j + 4 * c.lane); \
        dy0[j] = *(const u32x2*)(YS + (size_t)(s0_) * D + 256 * j + 4 * c.lane); dy1[j] = *(const u32x2*)(YS + (size_t)(s1_) * D + 256 * j + 4 * c.lane); } } while (0)
    if (rfirst < TT) { sa0 = TOKS[rfirst * 2]; sa1 = TOKS[rfirst * 2 + 1]; wa0 = TOKW[rfirst * 2]; wa1 = TOKW[rfirst * 2 + 1]; }
    if (rfirst + rstep < TT) { const int r = rfirst + rstep; sb0 = TOKS[r * 2]; sb1 = TOKS[r * 2 + 1]; wb0 = TOKW[r * 2]; wb1 = TOKW[r * 2 + 1]; }
    if (rfirst < TT) CB_LOAD(rfirst, sa0, sa1);
    for (int row = rfirst; row < TT; row += rstep) {
        const int mr = row < TC ? 8 : (row - TC) >> 11; bf16* xp = CB_XP(row);
        const float w0 = wa0, w1 = wa1;
        f32x4 v[4], ya[4], yb[4];
#pragma unroll
        for (int j = 0; j < 4; ++j) {
            v[j] = (f32x4){__uint_as_float(dx[j].x << 16), __uint_as_float(dx[j].x & 0xffff0000u), __uint_as_float(dx[j].y << 16), __uint_as_float(dx[j].y & 0xffff0000u)};
            ya[j] = (f32x4){__uint_as_float(dy0[j].x << 16), __uint_as_float(dy0[j].x & 0xffff0000u), __uint_as_float(dy0[j].y << 16), __uint_as_float(dy0[j].y & 0xffff0000u)};
            yb[j] = (f32x4){__uint_as_float(dy1[j].x << 16), __uint_as_float(dy1[j].x & 0xffff0000u), __uint_as_float(dy1[j].y << 16), __uint_as_float(dy1[j].y & 0xffff0000u)}; }
        sa0 = sb0; sa1 = sb1; wa0 = wb0; wa1 = wb1;
        if (row + 2 * rstep < TT) { const int r = row + 2 * rstep; sb0 = TOKS[r * 2]; sb1 = TOKS[r * 2 + 1]; wb0 = TOKW[r * 2]; wb1 = TOKW[r * 2 + 1]; }
        if (row + rstep < TT) CB_LOAD(row + rstep, sa0, sa1);
#pragma unroll
        for (int j = 0; j < 4; ++j) v[j] = v[j] + *(const f32x4*)(MOD + mr * 6144 + 5120 + 256 * j + 4 * c.lane) * (ya[j] * w0 + yb[j] * w1);
        if (l < 3) store_row_bf16(xp, v, c.lane);
        if (l < 3) {
            const float* MODn = WSP(float, WS_MOD) + (size_t)(l + 1) * 9 * 6144;
            norm_row(v, c.in[I_N1G] + (l + 1) * D, c.lane); mod_row(v, MODn + mr * 6144, MODn + mr * 6144 + 1024, c.lane);
            store_row_bf16(H + (size_t)hrow_of(row, (l + 1) % 3) * D, v, c.lane);
        } else {
            norm_row(v, c.in[I_FING], c.lane);
            float* o = c.out + (size_t)(row - TC) * D;
#pragma unroll
            for (int j = 0; j < 4; ++j) *(f32x4*)(o + 256 * j + 4 * c.lane) = v[j];
        }
    }
#undef CB_LOAD
#undef CB_XP
}

DI void ctx_outproj_mini(const Ctx& c, const bf16* Yc, const bf16* Wt, const float* xs_c  , bf16* XC, const float* modc  , const float* bias) {
    const int lane = c.lane, h5 = lane >> 5, l31 = lane & 31;
    for (int tile = blockIdx.x; tile < 256; tile += gridDim.x) {
        const int m0 = 64 * (tile >> 3) + 32 * (c.wave >> 2), n0 = 128 * (tile & 7) + 32 * (c.wave & 3);
        const bf16* ap = Yc + (size_t)(m0 + l31) * 1024 + 8 * h5; const bf16* bp = Wt + (size_t)(n0 + l31) * 1024 + 8 * h5;
        const int row = m0 + l31;
        float xo[4][4]; f32x4 g1[4], bb[4];
#pragma unroll
        for (int q = 0; q < 4; ++q) { const int col = n0 + 8 * q + 4 * h5; const size_t o = (size_t)row * D + col;
            if (xs_c) { const f32x4 t = *(const f32x4*)(xs_c + o); xo[q][0] = t.x; xo[q][1] = t.y; xo[q][2] = t.z; xo[q][3] = t.w; }
            else { const u32x2 t = *(const u32x2*)(XC + o); xo[q][0] = __uint_as_float(t.x << 16); xo[q][1] = __uint_as_float(t.x & 0xffff0000u); xo[q][2] = __uint_as_float(t.y << 16); xo[q][3] = __uint_as_float(t.y & 0xffff0000u); }
            g1[q] = *(const f32x4*)(modc + 2048 + col); bb[q] = bias ? *(const f32x4*)(bias + col) : (f32x4){0.f, 0.f, 0.f, 0.f}; }
        f32x16 acc = zero16();
        bf16x8 afA[4], wfA[4], afB[4], wfB[4];
#define MINI_LD(af, wf, k0_) do { _Pragma("unroll") for (int s = 0; s < 4; ++s) { af[s] = *(const bf16x8*)(ap + (k0_) + 16 * s); wf[s] = *(const bf16x8*)(bp + (k0_) + 16 * s); } } while (0)
#define MINI_MM(af, wf) do { _Pragma("unroll") for (int s = 0; s < 4; ++s) acc = MFMA32(wf[s], af[s], acc); } while (0)
        MINI_LD(afA, wfA, 0); MINI_LD(afB, wfB, 64);
#pragma unroll 1
        for (int k0 = 0; k0 < 1024; k0 += 128) {
            MINI_MM(afA, wfA); if (k0 + 128 < 1024) MINI_LD(afA, wfA, k0 + 128);
            MINI_MM(afB, wfB); if (k0 + 192 < 1024) MINI_LD(afB, wfB, k0 + 192);
        }
#undef MINI_LD
#undef MINI_MM
#pragma unroll
        for (int q = 0; q < 4; ++q) { const int col = n0 + 8 * q + 4 * h5; const size_t o = (size_t)row * D + col;
            u32x2 w; w.x = cvt_pk_bf16(xo[q][0] + g1[q].x * (acc[4 * q] + bb[q].x), xo[q][1] + g1[q].y * (acc[4 * q + 1] + bb[q].y));
            w.y = cvt_pk_bf16(xo[q][2] + g1[q].z * (acc[4 * q + 2] + bb[q].z), xo[q][3] + g1[q].w * (acc[4 * q + 3] + bb[q].w));
            *(u32x2*)(XC + o) = w; }
    }
}

#define XB_TMO      128
#define XB_XCNT(j)  (256  + 64 * (j))
#define XB_XSUB(j)  (1280 + 64 * (j))
#define XB_XGEN(j)  (2304 + 64 * (j))
#define XB_TOP      3328
#define XB_TOPGEN   3392
#define XCD_BAR_WORDS 3456
#define XB_SPIN_CAP (1u << 18)
DI unsigned xb_ld(unsigned* p)              { return __hip_atomic_load(p, __ATOMIC_RELAXED, __HIP_MEMORY_SCOPE_AGENT); }
DI unsigned xb_add(unsigned* p, unsigned v) { return __hip_atomic_fetch_add(p, v, __ATOMIC_RELAXED, __HIP_MEMORY_SCOPE_AGENT); }
DI unsigned xb_xcc_id() { return (unsigned)__builtin_amdgcn_s_getreg((3 << 11) | 20) & 0xFu; }
#define XB_SPIN(cond, bar) do { unsigned _sp = 0; while (cond) { __builtin_amdgcn_s_sleep(1); \
    if ((++_sp & 255u) == 0u) { if (xb_ld(&(bar)[XB_TMO])) break; if (_sp > XB_SPIN_CAP) { atomicAdd(&(bar)[XB_TMO], 1u); break; } } } } while (0)
DI void xcd_barrier_complete(unsigned* bar, unsigned x, unsigned& nloc, unsigned& nx) {
    const unsigned G = gridDim.x * gridDim.y * gridDim.z;
    unsigned sum, cnt, mine, sp = 0u;
    for (;;) {
        sum = 0u; cnt = 0u; mine = 0u;
#pragma unroll
        for (unsigned j = 0; j < 16; ++j) { const unsigned cj = xb_ld(&bar[XB_XCNT(j)]); sum += cj; cnt += (cj > 0u) ? 1u : 0u; mine = (j == x) ? cj : mine; }
        if (sum == G) break;
        __builtin_amdgcn_s_sleep(1);
        if ((++sp & 255u) == 0u) { if (xb_ld(&bar[XB_TMO])) break; if (sp > XB_SPIN_CAP) { atomicAdd(&bar[XB_TMO], 1u); break; } }
    }
    nloc = mine > 0u ? mine : 1u; nx = cnt > 0u ? cnt : 1u;
}
DI void xcd_barrier(unsigned* bar, volatile LAS unsigned* st) {
    asm volatile("s_waitcnt vmcnt(0)" ::: "memory");
    __syncthreads();
    if (threadIdx.x == 0) {
        const unsigned x = xb_xcc_id();
        __builtin_amdgcn_s_waitcnt(0);
        unsigned nloc = st[0], nx = st[1];
        if (nloc == 0u) { xcd_barrier_complete(bar, x, nloc, nx); st[0] = nloc; st[1] = nx; }
        const unsigned old = xb_add(&bar[XB_XSUB(x)], 1u);
        const unsigned gen = old / nloc;
        if (old + 1u == (gen + 1u) * nloc) {
            __builtin_amdgcn_fence(__ATOMIC_RELEASE, "agent");
            asm volatile("s_waitcnt vmcnt(0)" ::: "memory");
            const unsigned og = xb_add(&bar[XB_TOP], 1u);
            const unsigned tg = og / nx;
            if (og + 1u == (tg + 1u) * nx) xb_add(&bar[XB_TOPGEN], 1u);
            else XB_SPIN(xb_ld(&bar[XB_TOPGEN]) == tg, bar);
            __builtin_amdgcn_fence(__ATOMIC_ACQUIRE, "agent");
            xb_add(&bar[XB_XGEN(x)], 1u);
            asm volatile("s_waitcnt vmcnt(0)" ::: "memory");
        } else {
            XB_SPIN(xb_ld(&bar[XB_XGEN(x)]) == gen, bar);
            __builtin_amdgcn_fence(__ATOMIC_ACQUIRE, "agent");
            asm volatile("s_waitcnt vmcnt(0)" ::: "memory");
        }
    }
    __syncthreads();
}

constexpr int NPHASE = 2 + 11 * DEPTH;
__host__ __device__ inline bool phase_active(int ph) {
    if (ph < 2) return true;
    const int l = (ph - 2) / 11, s = (ph - 2) % 11, kind = l % 3;
    if (s == 0) return false;
    if (s == 4) return kind != 2 || HY_MFMA;
    return true;
}
DI void run_phase(const Ctx& c, int ph) {
    if (ph == 0) { if constexpr (PH_EN(0)) phase_pro0(c); return; }
    if (ph == 1) { if constexpr (PH_EN(1)) { phase_pro1(c); phase_norm1(c, 0, c.in[I_X], c.in[I_CTX]); } return; }
    const int l = (ph - 2) / 11, s = (ph - 2) % 11, kind = l % 3, j = l / 3;
    switch (s) {
    case 0: if constexpr (PH_EN(2)) phase_norm1(c, 0, c.in[I_X], c.in[I_CTX]); break;
    case 1: if constexpr (PH_EN(3)) {
        DenseOrder S; EpiInproj E; E.P = WSP(bf16, WS_P); E.extra = WSP(float, WS_EXTRA); E.bias = nullptr; E.bias_x = nullptr;
        S.A = WSP(bf16, WS_H); S.ul = dense_units(c.lds, c.tid, TT, kind == 2 ? 3072 : NINP);
        if (kind == 0) { S.Bt = WSP(bf16, WS_ML_WIN) + (size_t)j * NINP * 1024; E.bias_x = c.in[I_MLBG] + j * 32; }
        else if (kind == 1) { S.Bt = WSP(bf16, WS_GLA_WIN); }
        else { S.Bt = WSP(bf16, WS_HY_WIN); E.bias = c.in[I_HYBIN]; }
        gemm_run(c.lds, c.tid, S, E);
    } break;
    case 2: if constexpr (PH_EN(4))
        if (kind == 0) phase_conv(c, 1024, c.in[I_MLCW] + j * 3 * 1024, c.in[I_MLCB] + j * 1024, true, 0.125f);
        else if (kind == 1) { phase_conv(c, 2048, c.in[I_GLCW], c.in[I_GLCB], true, 0.08838834764831845f); if constexpr (GLA_CHUNK) phase_gla_decay(c); }
        else { if constexpr (HY_MFMA) phase_hy_prep(c); else phase_conv(c, 3072, c.in[I_HYCW], c.in[I_HYCB], false, 1.0f); }
        break;
    case 3: if constexpr (PH_EN(5))
        if (kind == 0) { if constexpr (MLSTM_CHUNK) phase_mlstm_state(c); else phase_mlstm_scan_naive(c); }
        else if (kind == 1) { if constexpr (GLA_CHUNK) phase_gla_state(c); else phase_gla_scan_naive(c); }
        else { if constexpr (HY_MFMA) phase_hy_toeplitz(c); else phase_hyena_conv_naive(c); }
        break;
    case 4: if constexpr (PH_EN(6))
        if (kind == 0) { if constexpr (MLSTM_CHUNK) phase_mlstm_out(c, c.in[I_MLNG] + j * 1024); else phase_headnorm(c, 128, c.in[I_MLNG] + j * 1024); }
        else if (kind == 1) { if constexpr (GLA_CHUNK) phase_gla_out(c, c.in[I_GLNG]); else phase_headnorm(c, 256, c.in[I_GLNG]); }
        else { if constexpr (HY_MFMA) phase_hy_post(c); }
        break;
    case 5: if constexpr (PH_EN(7)) {
        DenseOrder S; EpiOutproj E; E.X = WSP(bf16, WS_X); E.XC = WSP(bf16, WS_XC); E.mod = WSP(float, WS_MOD) + (size_t)l * 9 * 6144; E.bias = nullptr; E.perm = (kind == 1);
        E.xs_l = (l == 0) ? c.in[I_X] : nullptr; E.xs_c = (l == 0) ? c.in[I_CTX] : nullptr; E.row_off = TC;
        const bf16* W = kind == 0 ? WSP(bf16, WS_ML_WOUT) + (size_t)j * 1024 * 1024 : kind == 1 ? WSP(bf16, WS_GLA_WOUT) : WSP(bf16, WS_HY_WOUT);
        if (kind == 2) E.bias = c.in[I_HYBOUT];
        S.A = WSP(bf16, WS_Y) + (size_t)E.row_off * D; S.Bt = W; S.ul = dense_units(c.lds, c.tid, TT - E.row_off, 1024);
        gemm_run(c.lds, c.tid, S, E);
        if (l < 3) ctx_outproj_mini(c, WSP(bf16, WS_Y), W, E.xs_c, WSP(bf16, WS_XC), E.mod + 8 * 6144, E.bias);
    } break;
    case 6: if constexpr (PH_EN(8)) phase_route(c, l); break;
    case 7: if constexpr (PH_EN(9)) phase_gather(c, l); break;
    case 8: if constexpr (PH_EN(10)) {
        MoeOrder S; S.ul = moe_tiles(c, l, 3); S.A = WSP(bf16, WS_BIG + BIG_HS); S.Bt = WSP(bf16, WS_EXP_UP) + (size_t)l * 16 * 2048 * 1024; S.bstride = (size_t)2048 * 1024;
        EpiUp E; E.ACT = WSP(bf16, WS_BIG + BIG_ACT);
        gemm_run(c.lds, c.tid, S, E);
    } break;
    case 9: if constexpr (PH_EN(11)) {
        MoeOrder S; S.ul = moe_tiles(c, l, 2); S.A = WSP(bf16, WS_BIG + BIG_ACT); S.Bt = WSP(bf16, WS_EXP_DN) + (size_t)l * 16 * 1024 * 1024; S.bstride = (size_t)1024 * 1024;
        EpiDown E; E.YS = WSP(bf16, WS_BIG + BIG_HS);
        gemm_run(c.lds, c.tid, S, E);
    } break;
    case 10: if constexpr (PH_EN(12)) phase_combine(c, l); break;
    }
}

__global__ void __launch_bounds__(512, 2) mega_fwd(Params p) {
    extern __shared__ __attribute__((aligned(16))) unsigned char lds_raw[];
#if XCD_BARRIER
    {
        volatile LAS unsigned* st0 = (volatile LAS unsigned*)((LAS unsigned char*)lds_raw + BAR_LDS_OFF);
        if (threadIdx.x == 0) { st0[0] = 0u; st0[1] = 0u; (void)xb_add((unsigned*)(p.ws + WS_CTL) + CW_BAR + XB_XCNT(xb_xcc_id()), 1u); }
        __syncthreads();
    }
#endif
    bool first = true;
    int rep = 0;
    unsigned long long tp_acc = 0, tp_prev = 0; bool tp_sel = false;
    for (int ph = p.ph_lo; ph < p.ph_hi;) {
        if (!phase_active(ph)) { ++ph; continue; }
        int z; asm volatile("s_mov_b32 %0, 0" : "=s"(z));
        if (!first) {
#if XCD_BARRIER
            xcd_barrier((unsigned*)(p.ws + z + WS_CTL) + CW_BAR, (volatile LAS unsigned*)((LAS unsigned char*)lds_raw + BAR_LDS_OFF));
#else
            cg::this_grid().sync();
#endif
        }
        first = false;
        Ctx c;
        c.lds = (LAS unsigned char*)lds_raw;
        c.tid = threadIdx.x + z; c.lane = c.tid & 63; c.wave = __builtin_amdgcn_readfirstlane(c.tid >> 6);
        c.gw = blockIdx.x * 8 + c.wave; c.ngw = gridDim.x * 8;
        c.in = (const float* const __attribute__((address_space(4)))*)__builtin_amdgcn_kernarg_segment_ptr() + z; c.out = p.out + z; c.ws = p.ws + z; c.z = (unsigned)z;
        if (TP_MASK != 0u) {
            const unsigned long long now = __builtin_amdgcn_s_memrealtime();
            if (tp_sel) tp_acc += now - tp_prev;
            tp_prev = now; tp_sel = (ph >= 2 ? (((TP_MASK >> ((ph - 2) % 11)) & 1u) && ((TP_LAYERS >> ((ph - 2) / 11)) & 1u)) : ((TP_MASK >> (16 + ph)) & 1u));
        }
        run_phase(c, ph);
        if (REP_MASK != 0u && rep == 0 && (ph >= 2 ? (((REP_MASK >> ((ph - 2) % 11)) & 1u) && ((REP_LAYERS >> ((ph - 2) / 11)) & 1u)) : ((REP_MASK >> (16 + ph)) & 1u))) rep = 1; else { rep = 0; ++ph; }
    }
    if (TP_MASK != 0u && blockIdx.x == 0) { asm volatile("s_waitcnt vmcnt(0)" ::: "memory"); __syncthreads(); const unsigned long long now = __builtin_amdgcn_s_memrealtime(); if (tp_sel) tp_acc += now - tp_prev;
        const unsigned long long t_end = now + (unsigned long long)TP_AMP * tp_acc; while (__builtin_amdgcn_s_memrealtime() < t_end) __builtin_amdgcn_s_sleep(8); }
}

extern "C" void kernel_launch(void* const* d_in, const int* in_sizes, int n_in, void* d_out, int out_size, void* d_ws, size_t ws_size, hipStream_t stream) {
    static int grid = 0;
    if (grid == 0) {
        if (n_in != 40 || ws_size < WS_END || out_size != TL * D) { fprintf(stderr, "kernel_launch: unexpected shapes (n_in %d, ws %zu, out %d)\n", n_in, ws_size, out_size); grid = -1; return; }
        int dev = 0, cus = 0, per_cu = 0;
        hipGetDevice(&dev); hipDeviceGetAttribute(&cus, hipDeviceAttributeMultiprocessorCount, dev);
        if (hipFuncSetAttribute((const void*)mega_fwd, hipFuncAttributeMaxDynamicSharedMemorySize, LDS_BYTES) != hipSuccess) { fprintf(stderr, "kernel_launch: hipFuncSetAttribute failed\n"); grid = -1; return; }
        if (hipOccupancyMaxActiveBlocksPerMultiprocessor(&per_cu, (const void*)mega_fwd, 512, LDS_BYTES) != hipSuccess || per_cu < 1) { fprintf(stderr, "kernel_launch: occupancy query says %d\n", per_cu); per_cu = 1; }
        (void)hipGetLastError();
        grid = cus;
        fprintf(stderr, "kernel_launch: grid %d (cus %d, per_cu %d)\n", grid, cus, per_cu);
    }
    if (grid < 0) return;
    hipMemsetAsync((char*)d_ws + WS_CTL, 0, 1 * MiB, stream);
    Params p{};
    for (int i = 0; i < 40; ++i) p.in[i] = (const float*)d_in[i];
    p.out = (float*)d_out; p.ws = (unsigned char*)d_ws;
#if N_LAUNCH_PER_PHASE
    for (int ph = 0; ph < NPHASE; ++ph) {
        if (!phase_active(ph)) continue;
        p.ph_lo = ph; p.ph_hi = ph + 1; void* args[] = {&p};
        hipError_t e = hipLaunchCooperativeKernel((const void*)mega_fwd, dim3(grid), dim3(512), args, LDS_BYTES, stream);
        if (e != hipSuccess) { fprintf(stderr, "launch failed: %s\n", hipGetErrorString(e)); break; }
    }
#else
    p.ph_lo = 0; p.ph_hi = NPHASE; void* args[] = {&p};
    hipError_t e = hipLaunchCooperativeKernel((const void*)mega_fwd, dim3(grid), dim3(512), args, LDS_BYTES, stream);
    if (e != hipSuccess) fprintf(stderr, "cooperative launch failed: %s (grid %d)\n", hipGetErrorString(e), grid);
#endif
}
```

```cpp
#include <hip/hip_runtime.h>
#include <hip/hip_cooperative_groups.h>
#include <cstdio>
#include <cstdint>
namespace cg = cooperative_groups;

#define LAS __attribute__((address_space(3)))
#define DI __device__ __forceinline__
typedef unsigned short bf16;
typedef float f32x4 __attribute__((ext_vector_type(4)));
typedef float f32x2 __attribute__((ext_vector_type(2)));
typedef unsigned u32x4 __attribute__((ext_vector_type(4)));
typedef unsigned u32x2 __attribute__((ext_vector_type(2)));
typedef short bf16x8 __attribute__((ext_vector_type(8)));

#ifndef FAST_GEMM
#define FAST_GEMM 1
#endif
#ifndef MLSTM_CHUNK
#define MLSTM_CHUNK 1
#endif
#ifndef GLA_CHUNK
#define GLA_CHUNK 1
#endif
#ifndef HY_MFMA
#define HY_MFMA 1
#endif
#ifndef XCD_BARRIER
#define XCD_BARRIER 1
#endif
#ifndef PH_MASK
#define PH_MASK 0xFFFFFFFFu
#endif
#define PH_EN(b) ((PH_MASK >> (b)) & 1u)
#ifndef TP_MASK
#define TP_MASK 0u
#endif
#ifndef TP_LAYERS
#define TP_LAYERS 0xFu
#endif
#define TP_AMP 4
#ifndef REP_LAYERS
#define REP_LAYERS 0xFu
#endif
#ifndef REP_MASK
#define REP_MASK 0u
#endif
#ifndef N_LAUNCH_PER_PHASE
#define N_LAUNCH_PER_PHASE 0
#endif

constexpr int D = 1024, NB = 8, SEQ = 2048, CTX = 256, DEPTH = 4;
constexpr int TC = NB * CTX, TL = NB * SEQ, TT = TC + TL;
constexpr int NEXP = 16;
constexpr int PLD = 3072;
constexpr int NINP = 3328;
constexpr float EPS = 1e-6f;
constexpr int MAXSLOT = 40960;

constexpr size_t MiB = 1u << 20;
constexpr size_t WS_CTL = 0;
constexpr size_t WS_MOD = 1 * MiB;
constexpr size_t WS_HM = 2 * MiB;
constexpr size_t WS_TOK = 3 * MiB;
constexpr size_t WS_RWT = 3 * MiB + 944 * 1024;
constexpr size_t WS_HF = 4 * MiB;
constexpr size_t WS_HFC = 20 * MiB;
constexpr size_t WS_ML_WIN = 32 * MiB;
constexpr size_t WS_ML_WOUT = 45 * MiB;
constexpr size_t WS_GLA_WIN = 49 * MiB;
constexpr size_t WS_GLA_WOUT = 56 * MiB;
constexpr size_t WS_HY_WIN = 58 * MiB;
constexpr size_t WS_HY_WOUT = 64 * MiB;
constexpr size_t WS_EXP_UP = 66 * MiB;
constexpr size_t WS_EXP_DN = 322 * MiB;
constexpr size_t WS_X = 450 * MiB;
constexpr size_t WS_XC = 514 * MiB;
constexpr size_t WS_H = 522 * MiB;
constexpr size_t WS_P = 558 * MiB;
constexpr size_t WS_EXTRA = 667 * MiB;
constexpr size_t WS_Y = 670 * MiB;
constexpr size_t WS_BIG = 706 * MiB;
constexpr size_t WS_END = 1024 * MiB;
constexpr size_t BIG_HS = 0;
constexpr size_t BIG_ACT = 80 * MiB;
constexpr size_t BIG_PC = 0;
constexpr size_t BIG_YF = 108 * MiB;
constexpr size_t BIG_YB = 180 * MiB;

constexpr size_t BIG_MCT = 108 * MiB;
constexpr size_t BIG_MN = 180 * MiB;

constexpr size_t BIG_GB = 72 * MiB;
constexpr size_t BIG_GST = 144 * MiB;

constexpr size_t BIG_ZTL = 108 * MiB;
constexpr size_t BIG_ZTC = 140 * MiB;
constexpr size_t BIG_YTL = 144 * MiB;
constexpr size_t BIG_YTC = 176 * MiB;

constexpr int CW_CNT = 1024;
constexpr int CW_BAR = 4096;

constexpr int LDS_BYTES = 148480;
constexpr int BAR_LDS_OFF = 147456;
constexpr int MISC_OFF = 131072;

struct Params {
    const float* in[40];
    float* out;
    unsigned char* ws;
    int ph_lo, ph_hi;
};
static_assert(__builtin_offsetof(Params, in) == 0, "the input pointer table must be the first kernel argument bytes");
enum { I_X = 0, I_C, I_CTX, I_CCTX, I_ADAW, I_ADAB, I_N1G, I_N2G, I_FING, I_MLWIN, I_MLBG, I_MLCW, I_MLCB, I_MLNG, I_MLWOUT,
       I_GLWIN, I_GLCW, I_GLCB, I_GLW2, I_GLGB, I_GLNG, I_GLWOUT, I_HYWIN, I_HYBIN, I_HYCW, I_HYCB, I_HYFW1, I_HYFB1, I_HYFWM, I_HYFBM,
       I_HYFWO, I_HYFREQ, I_HYSKIP, I_HYWOUT, I_HYBOUT, I_RW, I_RB, I_EW1, I_EW3, I_EW2 };

DI float bf2f(bf16 v) { return __uint_as_float(((unsigned)v) << 16); }
typedef __bf16 b16x2_t __attribute__((ext_vector_type(2)));
DI unsigned cvt_pk_bf16(float lo, float hi) { const f32x2 v = {lo, hi}; const b16x2_t r = __builtin_convertvector(v, b16x2_t); return __builtin_bit_cast(unsigned, r); }
DI bf16 f2bf(float f) { return (bf16)(cvt_pk_bf16(f, 0.f) & 0xffffu); }
DI float sigmoidf_(float x) { return 1.0f / (1.0f + __expf(-x)); }
DI float siluf_(float x) { return x / (1.0f + __expf(-x)); }
DI float logsigf_(float x) { return fminf(x, 0.f) - __logf(1.0f + __expf(-fabsf(x))); }
DI void lds_barrier() { asm volatile("s_waitcnt lgkmcnt(0)" ::: "memory"); __builtin_amdgcn_s_barrier(); asm volatile("" ::: "memory"); }
DI float wave_sum(float v) {
#pragma unroll
    for (int o = 1; o < 64; o <<= 1) v += __shfl_xor(v, o);
    return v;
}
DI void unpack8(const u32x4 w, float (&v)[8]) {
    v[0] = __uint_as_float(w.x << 16); v[1] = __uint_as_float(w.x & 0xffff0000u);
    v[2] = __uint_as_float(w.y << 16); v[3] = __uint_as_float(w.y & 0xffff0000u);
    v[4] = __uint_as_float(w.z << 16); v[5] = __uint_as_float(w.z & 0xffff0000u);
    v[6] = __uint_as_float(w.w << 16); v[7] = __uint_as_float(w.w & 0xffff0000u);
}
DI u32x4 pack8(const float (&v)[8]) { u32x4 w; w.x = cvt_pk_bf16(v[0], v[1]); w.y = cvt_pk_bf16(v[2], v[3]); w.z = cvt_pk_bf16(v[4], v[5]); w.w = cvt_pk_bf16(v[6], v[7]); return w; }
DI void seq_bounds(int row, int& lo, int& hi) {
    if (row < TC) { lo = row & ~(CTX - 1); hi = lo + CTX - 1; } else { lo = TC + ((row - TC) & ~(SEQ - 1)); hi = lo + SEQ - 1; }
}
DI int perm_fwd(int s) { return (s & 63) * 32 + (s >> 6); }
DI int perm_inv(int sp) { return (sp & 31) * 64 + (sp >> 5); }

namespace pg8 {
constexpr int BM = 256, BK = 64, HALF = 128, HTB = HALF * BK * 2, STAGE_BYTES = 8 * HTB, NXCD = 8, WGM = 8;
__host__ __device__ __forceinline__ int lds_byte(int r, int c) { const int st = (r >> 4) * 2 + (c >> 5), rr = r & 15, cc = c & 31, ob = rr * 64 + cc * 2; return st * 1024 + (ob ^ (((ob >> 9) & 1) << 5)); }
__host__ __device__ __forceinline__ void stage_rc(int b, int& R, int& C) { const int st = b / 1024, sb = b % 1024, swz = sb ^ (((sb >> 9) & 1) << 5); R = (st >> 1) * 16 + swz / 64; C = (st & 1) * 32 + (swz % 64) / 2; }
__host__ __device__ __forceinline__ int perm32(int rho) { const int n = rho >> 4, i = rho & 15; return 8 * (i >> 2) + 4 * n + (i & 3); }
}
struct Unit { int pm, pn, e; };

DI LAS int* dense_units(LAS unsigned char* lds, int tid, int M, int N) {
    LAS int* ul = (LAS int*)(lds + MISC_OFF) + 192;
    __syncthreads();
    if (tid < 32) {
        const int nM = M / 256, nN = N / 256, nwg = nM * nN, G = gridDim.x, L = tid * G + (int)blockIdx.x; int w = -1;
        if (L < nwg) {
            int wgid = L; { const int q = nwg / 8, r = nwg % 8, xcd = wgid % 8, off = wgid / 8; wgid = (xcd < r ? xcd * (q + 1) : r * (q + 1) + (xcd - r) * q) + off; }
            const int nig = 8 * nN, gid = wgid / nig, fm = gid * 8, gsz = (nM - fm) < 8 ? (nM - fm) : 8;
            w = (fm + ((wgid % nig) % gsz)) | (((wgid % nig) / gsz) << 12);
        }
        ul[tid] = w;
    }
    __syncthreads();
    return ul;
}
struct DenseOrder {
    const bf16* A; const bf16* Bt; const LAS int* ul;
    DI bool next(int i, Unit& u) const {
        const int w = __builtin_amdgcn_readfirstlane(ul[i]); if (w < 0) return false;
        u.pm = w & 0xfff; u.pn = (w >> 12) & 0xf; u.e = 0; return true;
    }
    DI const bf16* aptr(const Unit& u) const { return A + (size_t)u.pm * 256 * 1024; }
    DI const bf16* bptr(const Unit& u) const { return Bt + (size_t)u.pn * 256 * 1024; }
};
struct MoeOrder {
    const bf16* A; const bf16* Bt; size_t bstride; const LAS int* ul;
    DI bool next(int i, Unit& u) const {
        const int w = __builtin_amdgcn_readfirstlane(ul[i]); if (w < 0) return false;
        u.pm = w & 0xfff; u.pn = (w >> 12) & 0xf; u.e = w >> 16; return true;
    }
    DI const bf16* aptr(const Unit& u) const { return A + (size_t)u.pm * 256 * 1024; }
    DI const bf16* bptr(const Unit& u) const { return Bt + (size_t)u.e * bstride + (size_t)u.pn * 256 * 1024; }
};

struct EpiInproj {
    static constexpr bool PAIR = false, BATCHED = false;
    bf16* P; float* extra; const float* bias; const float* bias_x;
    DI void row8(const Unit& u, int r, int c, const float (&v)[8]) const {
        const int row = u.pm * 256 + r, col = u.pn * 256 + c;
        if (col < PLD) {
            float w[8];
#pragma unroll
            for (int j = 0; j < 8; ++j) w[j] = v[j] + (bias ? bias[col + j] : 0.f);
            *(u32x4*)(P + (size_t)row * PLD + col) = pack8(w);
        } else if (col < PLD + 32) {
            float* o = extra + (size_t)row * 32 + (col - PLD);
#pragma unroll
            for (int j = 0; j < 8; ++j) o[j] = v[j] + (bias_x ? bias_x[col - PLD + j] : 0.f);
        }
    }
};
struct EpiOutproj {
    static constexpr bool PAIR = false, BATCHED = true;
    const float* xs_l; const float* xs_c; bf16* X; bf16* XC; const float* mod; const float* bias; int row_off; int perm;
    DI size_t off(const Unit& u, int r, int col) const {
        const int rr = u.pm * 256 + r + row_off - TC, b = rr >> 11, sp = rr & (SEQ - 1), s = perm ? perm_inv(sp) : sp; return ((size_t)b * SEQ + s) * D + col; }
    DI void tile(const f32x4 (&acc)[2][2][4][2], const Unit& u, int wr, int wc, int fr, int fq) const {
        const int b = (u.pm * 256 + row_off - TC) >> 11; const float* g1p = mod + b * 6144 + 2048;
        const int rr0 = u.pm * 256 + row_off - TC, sp0 = rr0 & (SEQ - 1);
        const int d_ai = perm ? 4 : 128, d_m1 = perm ? 1024 : 16, d_m2 = perm ? 1 : 32;
        const unsigned voff = (unsigned)((perm ? fr * 64 + wr * 2 : wr * 64 + fr) * D + wc * 32 + 8 * fq);
        const size_t ubase = ((size_t)b * SEQ + (perm ? (sp0 >> 5) : sp0)) * D + u.pn * 256;
#define OPJ_OFF(bj_, ai_, m_) ((size_t)((ai_) * d_ai + ((m_) & 1) * d_m1 + ((m_) >> 1) * d_m2) * D + (bj_) * 128)
#pragma unroll
        for (int bj = 0; bj < 2; ++bj) {
            char* Xu = (char*)(X + ubase); float g1[8], bs[8];
            if (xs_l) {
                const char* Su = (const char*)(xs_l + ubase); f32x4 rf[2][4][2];
#pragma unroll
                for (int ai = 0; ai < 2; ++ai)
#pragma unroll
                    for (int m = 0; m < 4; ++m) { const char* p = Su + OPJ_OFF(bj, ai, m) * 4 + voff * 4u; rf[ai][m][0] = *(const f32x4*)p; rf[ai][m][1] = *(const f32x4*)(p + 16); }
                { const int col = u.pn * 256 + bj * 128 + wc * 32 + 8 * fq;
#pragma unroll
                    for (int j = 0; j < 8; ++j) { g1[j] = g1p[col + j]; bs[j] = bias ? bias[col + j] : 0.f; } }
#pragma unroll
                for (int ai = 0; ai < 2; ++ai)
#pragma unroll
                    for (int m = 0; m < 4; ++m) { float w[8];
#pragma unroll
                        for (int j = 0; j < 8; ++j) w[j] = rf[ai][m][j >> 2][j & 3] + g1[j] * (acc[ai][bj][m][j >> 2][j & 3] + bs[j]);
                        *(u32x4*)(Xu + OPJ_OFF(bj, ai, m) * 2 + voff * 2u) = pack8(w); }
            } else {
                u32x4 raw[2][4];
#pragma unroll
                for (int ai = 0; ai < 2; ++ai)
#pragma unroll
                    for (int m = 0; m < 4; ++m) raw[ai][m] = *(const u32x4*)(Xu + OPJ_OFF(bj, ai, m) * 2 + voff * 2u);
                { const int col = u.pn * 256 + bj * 128 + wc * 32 + 8 * fq;
#pragma unroll
                    for (int j = 0; j < 8; ++j) { g1[j] = g1p[col + j]; bs[j] = bias ? bias[col + j] : 0.f; } }
#pragma unroll
                for (int ai = 0; ai < 2; ++ai)
#pragma unroll
                    for (int m = 0; m < 4; ++m) { float xo[8], w[8];
                        unpack8(raw[ai][m], xo);
#pragma unroll
                        for (int j = 0; j < 8; ++j) w[j] = xo[j] + g1[j] * (acc[ai][bj][m][j >> 2][j & 3] + bs[j]);
                        *(u32x4*)(Xu + OPJ_OFF(bj, ai, m) * 2 + voff * 2u) = pack8(w); }
            }
            asm volatile("" ::: "memory");
        }
#undef OPJ_OFF
    }
    DI void row8(const Unit& u, int r, int c, const float (&v)[8]) const {
        const int col = u.pn * 256 + c; const size_t o = off(u, r, col); const int b = (u.pm * 256 + row_off - TC) >> 11;
        float a[8];
        if (xs_l) { const f32x4 a0 = *(const f32x4*)(xs_l + o), a1 = *(const f32x4*)(xs_l + o + 4); a[0] = a0.x; a[1] = a0.y; a[2] = a0.z; a[3] = a0.w; a[4] = a1.x; a[5] = a1.y; a[6] = a1.z; a[7] = a1.w; }
        else unpack8(*(const u32x4*)(X + o), a);
        const float* g1 = mod + b * 6144 + 2048 + col; float w[8];
#pragma unroll
        for (int j = 0; j < 8; ++j) w[j] = a[j] + g1[j] * (v[j] + (bias ? bias[col + j] : 0.f));
        *(u32x4*)(X + o) = pack8(w);
    }
};
struct EpiUp {
    static constexpr bool PAIR = true, BATCHED = false;
    bf16* ACT;
    DI void row8p(const Unit& u, int r, int c, const float (&g)[8], const float (&up)[8]) const {
        float w[8];
#pragma unroll
        for (int j = 0; j < 8; ++j) w[j] = siluf_(g[j]) * up[j];
        *(u32x4*)(ACT + ((size_t)u.pm * 256 + r) * 1024 + u.pn * 128 + c) = pack8(w);
    }
};
struct EpiDown {
    static constexpr bool PAIR = false, BATCHED = false;
    bf16* YS;
    DI void row8(const Unit& u, int r, int c, const float (&v)[8]) const { *(u32x4*)(YS + ((size_t)u.pm * 256 + r) * 1024 + u.pn * 256 + c) = pack8(v); }
};

template <class Sched, class Epi>
DI void gemm_fast(LAS unsigned char* lds, int tid, const Sched& S, const Epi& E) {
    using namespace pg8;
    constexpr int K = 1024, nt = K / BK;
    const int wid = __builtin_amdgcn_readfirstlane(tid >> 6), lane = tid & 63, wr = wid >> 2, wc = wid & 3, fr = lane & 15, fq = lane >> 4;
    unsigned voffA[2], voffB[2];
#pragma unroll
    for (int i = 0; i < 2; ++i) { int R, C; stage_rc(tid * 16 + i * 8192, R, C); const int Rb = (R & ~31) + perm32(R & 31);
        voffA[i] = (unsigned)(R * K + C) * 2u; voffB[i] = (unsigned)(Rb * K + C) * 2u; }
    const size_t kstep = (size_t)(BK * 2);
    const size_t hstep = (size_t)HALF * K * 2;
    const unsigned ldsw = (unsigned)wid * 1024u;
    const int aoff = lds_byte(wr * 64 + fr, fq * 8), boff = lds_byte(wc * 32 + fr, fq * 8);
#define PG8_SA(b, h) (((b) * 2 + (h)) * HTB)
#define PG8_SB(b, h) ((4 + (b) * 2 + (h)) * HTB)
#define PG8_STAGE(bufoff, gbase, voff) do { _Pragma("unroll") for (int _i = 0; _i < 2; ++_i) \
        __builtin_amdgcn_global_load_lds((const unsigned*)((const char*)(gbase) + (voff)[_i]), (LAS unsigned*)(lds + (bufoff) + ldsw + _i * 8192), 16, 0, 0); } while (0)
#define PG8_LDA(dst, b, h) do { _Pragma("unroll") for (int m = 0; m < 4; ++m) _Pragma("unroll") for (int k = 0; k < 2; ++k) dst[m][k] = *(const LAS bf16x8*)(lds + PG8_SA(b, h) + aoff + m * 2048 + k * 1024); } while (0)
#define PG8_LDB(dst, b, h) do { _Pragma("unroll") for (int n = 0; n < 2; ++n) _Pragma("unroll") for (int k = 0; k < 2; ++k) dst[n][k] = *(const LAS bf16x8*)(lds + PG8_SB(b, h) + boff + n * 2048 + k * 1024); } while (0)
#define PG8_MMA(ai, bj, At, Bt) do { __builtin_amdgcn_s_setprio(1); _Pragma("unroll") for (int m = 0; m < 4; ++m) _Pragma("unroll") for (int n = 0; n < 2; ++n) _Pragma("unroll") for (int k = 0; k < 2; ++k) \
        acc[ai][bj][m][n] = __builtin_amdgcn_mfma_f32_16x16x32_bf16(Bt[n][k], At[m][k], acc[ai][bj][m][n], 0, 0, 0); __builtin_amdgcn_s_setprio(0); } while (0)
#define PG8_WAIT_V(n) asm volatile("s_waitcnt vmcnt(" #n ")" ::: "memory")
#define PG8_WAIT_L(n) asm volatile("s_waitcnt lgkmcnt(" #n ")" ::: "memory")
#define PG8_BAR __builtin_amdgcn_s_barrier()
#define PG8_SCHED __builtin_amdgcn_sched_barrier(0)
    Unit cur, nxt; int ui = 0;
    if (!S.next(0, cur)) return;
    f32x4 acc[2][2][4][2];
#pragma unroll
    for (int a = 0; a < 2; ++a)
#pragma unroll
        for (int b = 0; b < 2; ++b)
#pragma unroll
            for (int m = 0; m < 4; ++m)
#pragma unroll
                for (int n = 0; n < 2; ++n) acc[a][b][m][n] = (f32x4){0.f, 0.f, 0.f, 0.f};
    bf16x8 At[4][2], B0[2][2], B1[2][2];
    const char* cA = (const char*)S.aptr(cur); const char* cB = (const char*)S.bptr(cur);
    PG8_STAGE(PG8_SB(0, 0), cB, voffB); PG8_STAGE(PG8_SA(0, 0), cA, voffA); PG8_STAGE(PG8_SB(0, 1), cB + hstep, voffB); PG8_STAGE(PG8_SA(0, 1), cA + hstep, voffA);
    if (wr == 1) PG8_BAR;
    PG8_WAIT_V(4); PG8_BAR;
    PG8_STAGE(PG8_SB(1, 0), cB + kstep, voffB); PG8_STAGE(PG8_SA(1, 0), cA + kstep, voffA); PG8_STAGE(PG8_SB(1, 1), cB + hstep + kstep, voffB);
    PG8_WAIT_V(6); PG8_BAR;
    for (;;) {
        const bool has_next = S.next(ui + 1, nxt);
        const char* nA = has_next ? (const char*)S.aptr(nxt) : cA; const char* nB = has_next ? (const char*)S.bptr(nxt) : cB;
        for (int t = 0; t < nt; t += 2) {
            const bool last = (t == nt - 2);
            const char* a1 = cA + (size_t)(t + 1) * kstep;
            const char* a2 = last ? nA : cA + (size_t)(t + 2) * kstep; const char* b2 = last ? nB : cB + (size_t)(t + 2) * kstep;
            const char* a3 = a2 + kstep; const char* b3 = b2 + kstep;
            PG8_LDB(B0, 0, 0); PG8_SCHED; PG8_LDA(At, 0, 0); PG8_STAGE(PG8_SA(1, 1), a1 + hstep, voffA);
            PG8_WAIT_L(8); PG8_BAR; PG8_WAIT_L(0); PG8_MMA(0, 0, At, B0); PG8_BAR; PG8_SCHED;
            PG8_LDB(B1, 0, 1); PG8_STAGE(PG8_SB(0, 0), b2, voffB);
            PG8_BAR; PG8_WAIT_L(0); PG8_MMA(0, 1, At, B1); PG8_BAR;
            PG8_LDA(At, 0, 1); PG8_STAGE(PG8_SA(0, 0), a2, voffA);
            PG8_BAR; PG8_WAIT_L(0); PG8_MMA(1, 0, At, B0); PG8_BAR; PG8_SCHED;
            PG8_STAGE(PG8_SB(0, 1), b2 + hstep, voffB);
            PG8_WAIT_V(6); PG8_BAR; PG8_MMA(1, 1, At, B1); PG8_BAR;
            PG8_LDB(B0, 1, 0); PG8_SCHED; PG8_LDA(At, 1, 0); PG8_STAGE(PG8_SA(0, 1), a2 + hstep, voffA);
            PG8_WAIT_L(8); PG8_BAR; PG8_WAIT_L(0); PG8_MMA(0, 0, At, B0); PG8_BAR; PG8_SCHED;
            PG8_LDB(B1, 1, 1); PG8_STAGE(PG8_SB(1, 0), b3, voffB);
            PG8_BAR; PG8_WAIT_L(0); PG8_MMA(0, 1, At, B1); PG8_BAR;
            PG8_LDA(At, 1, 1); PG8_STAGE(PG8_SA(1, 0), a3, voffA);
            PG8_BAR; PG8_WAIT_L(0); PG8_MMA(1, 0, At, B0); PG8_BAR; PG8_SCHED;
            PG8_STAGE(PG8_SB(1, 1), b3 + hstep, voffB);
            PG8_WAIT_V(6); PG8_BAR; PG8_MMA(1, 1, At, B1); PG8_BAR;
        }
        int efr = fr, efq = fq; asm volatile("" : "+v"(efr), "+v"(efq));
        if constexpr (Epi::BATCHED) E.tile(acc, cur, wr, wc, efr, efq); else
#pragma unroll
        for (int ai = 0; ai < 2; ++ai)
#pragma unroll
            for (int m = 0; m < 4; ++m) {
                const int r = ai * HALF + wr * 64 + m * 16 + efr;
                if constexpr (Epi::PAIR) {
                    const float g[8] = {acc[ai][0][m][0][0], acc[ai][0][m][0][1], acc[ai][0][m][0][2], acc[ai][0][m][0][3], acc[ai][0][m][1][0], acc[ai][0][m][1][1], acc[ai][0][m][1][2], acc[ai][0][m][1][3]};
                    const float up[8] = {acc[ai][1][m][0][0], acc[ai][1][m][0][1], acc[ai][1][m][0][2], acc[ai][1][m][0][3], acc[ai][1][m][1][0], acc[ai][1][m][1][1], acc[ai][1][m][1][2], acc[ai][1][m][1][3]};
                    E.row8p(cur, r, wc * 32 + 8 * efq, g, up);
                } else {
#pragma unroll
                    for (int bj = 0; bj < 2; ++bj) {
                        const float v[8] = {acc[ai][bj][m][0][0], acc[ai][bj][m][0][1], acc[ai][bj][m][0][2], acc[ai][bj][m][0][3], acc[ai][bj][m][1][0], acc[ai][bj][m][1][1], acc[ai][bj][m][1][2], acc[ai][bj][m][1][3]};
                        E.row8(cur, r, bj * HALF + wc * 32 + 8 * efq, v);
                    }
                }
            }
        if (!has_next) break;
#pragma unroll
        for (int a = 0; a < 2; ++a)
#pragma unroll
            for (int b = 0; b < 2; ++b)
#pragma unroll
                for (int m = 0; m < 4; ++m)
#pragma unroll
                    for (int n = 0; n < 2; ++n) acc[a][b][m][n] = (f32x4){0.f, 0.f, 0.f, 0.f};
        cur = nxt; cA = nA; cB = nB; ++ui;
    }
    PG8_WAIT_V(0);
    if (wr == 0) PG8_BAR;
    PG8_BAR;
#undef PG8_SA
#undef PG8_SB
#undef PG8_STAGE
#undef PG8_LDA
#undef PG8_LDB
#undef PG8_MMA
#undef PG8_WAIT_V
#undef PG8_WAIT_L
#undef PG8_BAR
#undef PG8_SCHED
}

template <class Sched, class Epi>
DI void gemm_naive(LAS unsigned char* lds, int tid, const Sched& S, const Epi& E) {
    LAS float* As = (LAS float*)lds;
    LAS float* Bs = As + 32 * 132;
    LAS float* Bu = Bs + 32 * 132;
    const int ty = tid >> 4, tx = tid & 15, lr = tid >> 2, kq = tid & 3;
    Unit u;
    for (int i = 0; S.next(i, u); ++i) {
        const bf16* A = S.aptr(u); const bf16* B = S.bptr(u);
        for (int sm = 0; sm < 2; ++sm)
            for (int sn = 0; sn < (Epi::PAIR ? 1 : 2); ++sn) {
                float acc[4][8], accu[4][8];
#pragma unroll
                for (int a = 0; a < 4; ++a)
#pragma unroll
                    for (int b = 0; b < 8; ++b) { acc[a][b] = 0.f; accu[a][b] = 0.f; }
                for (int k0 = 0; k0 < 1024; k0 += 32) {
                    __syncthreads();
                    { float w[8]; unpack8(*(const u32x4*)(A + (size_t)(128 * sm + lr) * 1024 + k0 + 8 * kq), w);
#pragma unroll
                      for (int j = 0; j < 8; ++j) As[(8 * kq + j) * 132 + lr] = w[j];
                      unpack8(*(const u32x4*)(B + (size_t)(128 * sn + lr) * 1024 + k0 + 8 * kq), w);
#pragma unroll
                      for (int j = 0; j < 8; ++j) Bs[(8 * kq + j) * 132 + lr] = w[j];
                      if (Epi::PAIR) { unpack8(*(const u32x4*)(B + (size_t)(128 + lr) * 1024 + k0 + 8 * kq), w);
#pragma unroll
                          for (int j = 0; j < 8; ++j) Bu[(8 * kq + j) * 132 + lr] = w[j]; } }
                    __syncthreads();
#pragma unroll 4
                    for (int k = 0; k < 32; ++k) {
                        const f32x4 a4 = *(const LAS f32x4*)(As + k * 132 + 4 * ty);
                        const f32x4 b0 = *(const LAS f32x4*)(Bs + k * 132 + 8 * tx), b1 = *(const LAS f32x4*)(Bs + k * 132 + 8 * tx + 4);
#pragma unroll
                        for (int a = 0; a < 4; ++a) {
#pragma unroll
                            for (int b = 0; b < 4; ++b) { acc[a][b] += a4[a] * b0[b]; acc[a][4 + b] += a4[a] * b1[b]; } }
                        if (Epi::PAIR) {
                            const f32x4 c0 = *(const LAS f32x4*)(Bu + k * 132 + 8 * tx), c1 = *(const LAS f32x4*)(Bu + k * 132 + 8 * tx + 4);
#pragma unroll
                            for (int a = 0; a < 4; ++a) {
#pragma unroll
                                for (int b = 0; b < 4; ++b) { accu[a][b] += a4[a] * c0[b]; accu[a][4 + b] += a4[a] * c1[b]; } }
                        }
                    }
                }
#pragma unroll
                for (int a = 0; a < 4; ++a) {
                    if constexpr (Epi::PAIR) E.row8p(u, 128 * sm + 4 * ty + a, 8 * tx, acc[a], accu[a]);
                    else E.row8(u, 128 * sm + 4 * ty + a, 128 * sn + 8 * tx, acc[a]);
                }
            }
    }
    __syncthreads();
}
template <class Sched, class Epi>
DI void gemm_run(LAS unsigned char* lds, int tid, const Sched& S, const Epi& E) {
#if FAST_GEMM
    gemm_fast(lds, tid, S, E);
#else
    gemm_naive(lds, tid, S, E);
#endif
}

struct Ctx {
    LAS unsigned char* lds;
    int tid, lane, wave, gw, ngw;
    unsigned z;
    const float* const __attribute__((address_space(4)))* in;
    float* out;
    unsigned char* ws;
};
#define WSP(T, off) ((T*)(c.ws + (off)))

DI void transpose_item(const float* W, int N, bf16* WT, int k0, int n0, int dst_row0, LAS float* scr, int lane) {
#pragma unroll 8
    for (int i = 0; i < 32; ++i) { const int kk = 2 * i + (lane >> 5); scr[kk * 33 + (lane & 31)] = __builtin_nontemporal_load(W + (size_t)(k0 + kk) * N + n0 + (lane & 31)); }
    asm volatile("s_waitcnt lgkmcnt(0)" ::: "memory");
    const int cc = lane & 7;
#pragma unroll
    for (int j = 0; j < 4; ++j) { const int n = (lane >> 3) + 8 * j; const LAS float* s = scr + (8 * cc) * 33 + n;
        u32x4 o; o.x = cvt_pk_bf16(s[0 * 33], s[1 * 33]); o.y = cvt_pk_bf16(s[2 * 33], s[3 * 33]); o.z = cvt_pk_bf16(s[4 * 33], s[5 * 33]); o.w = cvt_pk_bf16(s[6 * 33], s[7 * 33]);
        *(u32x4*)(WT + (size_t)(dst_row0 + n) * 1024 + k0 + 8 * cc) = o; }
    asm volatile("s_waitcnt lgkmcnt(0)" ::: "memory");
}
DI void dense_transpose(const Ctx& c, const float* W, int N, bf16* WT, LAS float* scr) {
    const int nblk = N / 32, nitems = 16 * nblk;
    for (int it = c.gw; it < nitems; it += c.ngw) { const int kb = it / nblk, nb = it % nblk; transpose_item(W, N, WT, 64 * kb, 32 * nb, 32 * nb, scr, c.lane); }
}
DI void phase_pro0(const Ctx& c) {
    LAS float* scr = (LAS float*)(c.lds + c.wave * 8704);
    for (int j = 0; j < 2; ++j) {
        dense_transpose(c, c.in[I_MLWIN] + (size_t)j * 1024 * 3104, 3104, WSP(bf16, WS_ML_WIN) + (size_t)j * NINP * 1024, scr);
        dense_transpose(c, c.in[I_MLWOUT] + (size_t)j * 1024 * 1024, 1024, WSP(bf16, WS_ML_WOUT) + (size_t)j * 1024 * 1024, scr);
    }
    dense_transpose(c, c.in[I_GLWIN], 3104, WSP(bf16, WS_GLA_WIN), scr);
    dense_transpose(c, c.in[I_GLWOUT], 1024, WSP(bf16, WS_GLA_WOUT), scr);
    dense_transpose(c, c.in[I_HYWIN], 3072, WSP(bf16, WS_HY_WIN), scr);
    dense_transpose(c, c.in[I_HYWOUT], 1024, WSP(bf16, WS_HY_WOUT), scr);
    for (int it = c.gw * 64 + c.lane; it < 3 * 28672; it += c.ngw * 64) {
        const int m = it / 28672, r = it % 28672; bf16* base = (m < 2) ? WSP(bf16, WS_ML_WIN) + (size_t)m * NINP * 1024 : WSP(bf16, WS_GLA_WIN);
        *(u32x4*)(base + (size_t)3104 * 1024 + (size_t)r * 8) = (u32x4){c.z, c.z, c.z, c.z};
    }
    for (int it = c.gw; it < 64 * 3 * 512; it += c.ngw) {
        const int le = it / 1536, r0 = it % 1536, which = r0 / 512, r = r0 % 512, kb = r / 32, nb = r % 32;
        if (which < 2) {
            const float* W = c.in[which == 0 ? I_EW1 : I_EW3] + (size_t)le * 1024 * 1024;
            const int n0 = 32 * nb, drow = 256 * (n0 >> 7) + (n0 & 127) + (which ? 128 : 0);
            transpose_item(W, 1024, WSP(bf16, WS_EXP_UP) + (size_t)le * 2048 * 1024, 64 * kb, n0, drow, scr, c.lane);
        } else {
            transpose_item(c.in[I_EW2] + (size_t)le * 1024 * 1024, 1024, WSP(bf16, WS_EXP_DN) + (size_t)le * 1024 * 1024, 64 * kb, 32 * nb, 32 * nb, scr, c.lane);
        }
    }
    for (int i = blockIdx.x * 512 + c.tid; i < 16 * 1024; i += gridDim.x * 512) WSP(float, WS_RWT)[i] = c.in[I_RW][(i & 1023) * 16 + (i >> 10)];
    {
        const float* w1 = c.in[I_HYFW1]; const float* b1 = c.in[I_HYFB1]; const float* wm = c.in[I_HYFWM]; const float* bm = c.in[I_HYFBM]; const float* fr = c.in[I_HYFREQ];
        float* HM = WSP(float, WS_HM);
        for (int row = c.gw; row < 2304; row += c.ngw) {
            const int L = row < 2048 ? 2048 : 256, t = row < 2048 ? row : row - 2048, f = c.lane;
            float feat = 0.f;
            if (f == 0) feat = (float)t / (float)(L - 1);
            else if (f <= 32) { const int b = (f - 1) & 15; const float band = 1e-4f + (float)b * ((15.0f - 1e-4f) / 15.0f);
                const float ang = ((float)(2.0 * 3.14159265358979323846 / (double)L) * (float)t) * band; feat = (f <= 16) ? cosf(ang) : -sinf(ang); }
            float a = b1[f];
            for (int e = 0; e < 33; ++e) a += __shfl(feat, e) * w1[e * 64 + f];
            float h = sinf(fr[f] * a);
            for (int m = 0; m < 2; ++m) {
                float a2 = bm[m * 64 + f];
                for (int g = 0; g < 64; ++g) a2 += __shfl(h, g) * wm[m * 4096 + g * 64 + f];
                h = sinf(fr[f] * a2);
            }
            HM[row * 64 + f] = h;
        }
    }
    __syncthreads();
    {
        LAS float* sv = (LAS float*)c.lds;
        LAS float* red = sv + 9 * 1024;
        for (int i = c.tid; i < 9 * 1024; i += 512) { const float x = (i < 8192) ? c.in[I_C][i] : c.in[I_CCTX][i - 8192]; sv[i] = siluf_(x); }
        __syncthreads();
        float* MOD = WSP(float, WS_MOD);
        const int col = c.tid & 63, kg = c.tid >> 6;
        for (int item = blockIdx.x; item < 4 * 96; item += gridDim.x) {
            const int l = item / 96, j0 = 64 * (item % 96);
            const float* w = c.in[I_ADAW] + (size_t)l * 1024 * 6144 + j0 + col;
            float acc[9];
#pragma unroll
            for (int r = 0; r < 9; ++r) acc[r] = 0.f;
            for (int k = kg * 128; k < kg * 128 + 128; ++k) { const float wv = w[(size_t)k * 6144];
#pragma unroll
                for (int r = 0; r < 9; ++r) acc[r] += sv[r * 1024 + k] * wv; }
#pragma unroll
            for (int r = 0; r < 9; ++r) red[(kg * 9 + r) * 64 + col] = acc[r];
            __syncthreads();
            for (int o = c.tid; o < 9 * 64; o += 512) { const int r = o >> 6, cc = o & 63; float s = c.in[I_ADAB][l * 6144 + j0 + cc];
#pragma unroll
                for (int g = 0; g < 8; ++g) s += red[(g * 9 + r) * 64 + cc];
                MOD[(l * 9 + r) * 6144 + j0 + cc] = s; }
            __syncthreads();
        }
    }
}

template <int L>
DI void pro1_len(const Ctx& c, int c0, const float* hm, float* tab, LAS float* hmT  , const LAS f32x4* wo4  , float (&part)[4]) {
    const int side = c.wave & 1, ts = c.wave >> 1;
    const float da = -4.605170185988091f / 1.5f, db = -4.605170185988091f / 0.3f;
#pragma unroll 1
    for (int t0 = 0; t0 < L; t0 += 256) {
        __syncthreads();
#pragma unroll
        for (int k = 0; k < 8; ++k) { const int idx = c.tid + 512 * k, row = idx >> 4, q = idx & 15; const f32x4 v = *(const f32x4*)(hm + (size_t)(t0 + row) * 64 + 4 * q);
            LAS float* d = hmT + row * 65 + 4 * q; d[0] = v.x; d[1] = v.y; d[2] = v.z; d[3] = v.w; }
        __syncthreads();
        const int t = t0 + 64 * ts + c.lane; const LAS float* hr = hmT + (64 * ts + c.lane) * 65;
        f32x4 acc = {0.f, 0.f, 0.f, 0.f};
#pragma unroll 8
        for (int f = 0; f < 64; ++f) acc += wo4[side * 64 + f] * hr[f];
        const float tl = (float)t / (float)(L - 1);
#pragma unroll
        for (int ch = 0; ch < 4; ++ch) { const float delta = fabsf(da + (float)(c0 + ch) * ((db - da) / 1023.0f)), v = acc[ch] * expf(-tl * delta);
            float* trow = tab + (size_t)(c0 + ch) * (2 * L);
            if (side == 0) { trow[L + t] = v; part[ch] += fabsf(v); }
            else if (t >= 1) { trow[L - t] = v; part[ch] += fabsf(v); }
            else trow[0] = 0.f; }
    }
}
template <int L>
DI void pro1_scale(const Ctx& c, int c0, float* tab, const float (&inv)[4]) {
    const int side = c.wave & 1, ts = c.wave >> 1;
#pragma unroll 1
    for (int t0 = 0; t0 < L; t0 += 256) { const int t = t0 + 64 * ts + c.lane;
#pragma unroll
        for (int ch = 0; ch < 4; ++ch) { float* trow = tab + (size_t)(c0 + ch) * (2 * L); if (side == 0) trow[L + t] *= inv[ch]; else if (t >= 1) trow[L - t] *= inv[ch]; } }
}
DI void pro1_reduce(const Ctx& c, float (&part)[4], LAS float* red, float (&inv)[4]) {
#pragma unroll
    for (int ch = 0; ch < 4; ++ch) part[ch] = wave_sum(part[ch]);
    __syncthreads();
    if (c.lane == 0) {
#pragma unroll
        for (int ch = 0; ch < 4; ++ch) red[c.wave * 4 + ch] = part[ch]; }
    __syncthreads();
#pragma unroll
    for (int ch = 0; ch < 4; ++ch) { float s = 0.f;
#pragma unroll
        for (int w = 0; w < 8; ++w) s += red[w * 4 + ch];
        inv[ch] = 1.0f / s; }
}
DI void phase_pro1(const Ctx& c) {
    LAS float* hmT = (LAS float*)c.lds; LAS f32x4* wo4 = (LAS f32x4*)(c.lds + 67584); LAS float* red = (LAS float*)(c.lds + 67584 + 2048);
    const float* HM = WSP(float, WS_HM);
    for (int item = blockIdx.x; item < 256; item += gridDim.x) {
        const int c0 = 4 * item;
        __syncthreads();
        if (c.tid < 128) wo4[c.tid] = *(const f32x4*)(c.in[I_HYFWO] + (size_t)(c.tid & 63) * 2048 + (c.tid >> 6) * 1024 + c0);
        float part[4] = {0.f, 0.f, 0.f, 0.f}, inv[4];
        pro1_len<SEQ>(c, c0, HM, WSP(float, WS_HF), hmT, wo4, part);
        pro1_reduce(c, part, red, inv);
        pro1_scale<SEQ>(c, c0, WSP(float, WS_HF), inv);
        float part2[4] = {0.f, 0.f, 0.f, 0.f};
        pro1_len<CTX>(c, c0, HM + 2048 * 64, WSP(float, WS_HFC), hmT, wo4, part2);
        pro1_reduce(c, part2, red, inv);
        pro1_scale<CTX>(c, c0, WSP(float, WS_HFC), inv);
    }
}

DI void load_row(const float* src, f32x4 (&v)[4], int lane) {
#pragma unroll
    for (int j = 0; j < 4; ++j) v[j] = *(const f32x4*)(src + 256 * j + 4 * lane);
}
DI void load_row_bf(const bf16* src, f32x4 (&v)[4], int lane) {
#pragma unroll
    for (int j = 0; j < 4; ++j) { const u32x2 a = *(const u32x2*)(src + 256 * j + 4 * lane);
        v[j] = (f32x4){__uint_as_float(a.x << 16), __uint_as_float(a.x & 0xffff0000u), __uint_as_float(a.y << 16), __uint_as_float(a.y & 0xffff0000u)}; }
}
DI void norm_row(f32x4 (&v)[4], const float* g, int lane) {
    float s = 0.f;
#pragma unroll
    for (int j = 0; j < 4; ++j) s += (v[j].x * v[j].x + v[j].y * v[j].y) + (v[j].z * v[j].z + v[j].w * v[j].w);
    s = wave_sum(s);
    const float r = 1.0f / sqrtf(s * (1.0f / 1024.0f) + EPS);
#pragma unroll
    for (int j = 0; j < 4; ++j) v[j] = v[j] * r * *(const f32x4*)(g + 256 * j + 4 * lane);
}
DI void mod_row(f32x4 (&v)[4], const float* sh, const float* sc, int lane) {
#pragma unroll
    for (int j = 0; j < 4; ++j) v[j] = v[j] * (*(const f32x4*)(sc + 256 * j + 4 * lane) + 1.0f) + *(const f32x4*)(sh + 256 * j + 4 * lane);
}
DI void store_row_bf16(bf16* dst, const f32x4 (&v)[4], int lane) {
#pragma unroll
    for (int j = 0; j < 4; ++j) { u32x2 w; w.x = cvt_pk_bf16(v[j].x, v[j].y); w.y = cvt_pk_bf16(v[j].z, v[j].w); *(u32x2*)(dst + 256 * j + 4 * lane) = w; }
}
DI int hrow_of(int srow, int kind) {
    if (srow < TC || kind != 1) return srow;
    const int rr = srow - TC, b = rr >> 11, s = rr & (SEQ - 1); return TC + b * SEQ + perm_fwd(s);
}
DI void phase_norm1(const Ctx& c, int l, const float* xl, const float* xc) {
    const float* MOD = WSP(float, WS_MOD) + (size_t)l * 9 * 6144; const float* g = c.in[I_N1G] + l * D; bf16* H = WSP(bf16, WS_H);
    for (int row = c.gw; row < TT; row += c.ngw) {
        f32x4 v[4]; const int mr = row < TC ? 8 : (row - TC) >> 11;
        load_row(row < TC ? xc + (size_t)row * D : xl + (size_t)(row - TC) * D, v, c.lane);
        norm_row(v, g, c.lane); mod_row(v, MOD + mr * 6144, MOD + mr * 6144 + 1024, c.lane);
        store_row_bf16(H + (size_t)hrow_of(row, l % 3) * D, v, c.lane);
    }
}

DI void phase_conv(const Ctx& c, int ncols, const float* cw, const float* cb, bool act, float qs) {
    const bf16* P = WSP(bf16, WS_P); bf16* PC = WSP(bf16, WS_BIG + BIG_PC);
    const int ng = ncols / 8; const long total = (long)TT * ng;
    for (long idx = (long)blockIdx.x * 512 + c.tid; idx < total; idx += (long)gridDim.x * 512) {
        const int row = (int)(idx / ng), col = (int)(idx % ng) * 8; int lo, hi; seq_bounds(row, lo, hi);
        float x0[8], xm[8], xp[8];
        unpack8(*(const u32x4*)(P + (size_t)row * PLD + col), x0);
        if (row > lo) unpack8(*(const u32x4*)(P + (size_t)(row - 1) * PLD + col), xm); else {
#pragma unroll
            for (int j = 0; j < 8; ++j) xm[j] = 0.f; }
        if (row < hi) unpack8(*(const u32x4*)(P + (size_t)(row + 1) * PLD + col), xp); else {
#pragma unroll
            for (int j = 0; j < 8; ++j) xp[j] = 0.f; }
        float o[8];
#pragma unroll
        for (int j = 0; j < 8; ++j) { float v = cw[col + j] * xm[j] + cw[ncols + col + j] * x0[j] + cw[2 * ncols + col + j] * xp[j] + cb[col + j];
            if (act) v = siluf_(v); if (col < 512) v *= qs; o[j] = v; }
        *(u32x4*)(PC + (size_t)row * ncols + col) = pack8(o);
    }
}

DI int scan_row(int step, int b, int dir) {
    if (step < CTX) return b * CTX + (dir ? CTX - 1 - step : step);
    const int s = step - CTX; return TC + b * SEQ + (dir ? SEQ - 1 - s : s);
}
DI void phase_mlstm_scan_naive(const Ctx& c) {
    const bf16* P = WSP(bf16, WS_P); const bf16* PC = WSP(bf16, WS_BIG + BIG_PC); const float* EX = WSP(float, WS_EXTRA);
    LAS float* qs = (LAS float*)c.lds; LAS float* ks = qs + 32 * 64; LAS float* vs = ks + 32 * 64; LAS float* gs = vs + 32 * 128;
    const int v = c.tid >> 2, d0 = (c.tid & 3) * 16;
    for (int item = blockIdx.x; item < 128; item += gridDim.x) {
        const int b = item >> 4, h = (item >> 1) & 7, dir = item & 1;
        float* Yo = WSP(float, WS_BIG + (dir ? BIG_YB : BIG_YF));
        float C[16], n[16];
#pragma unroll
        for (int d = 0; d < 16; ++d) { C[d] = 0.f; n[d] = 0.f; }
        for (int ch = 0; ch < (CTX + SEQ) / 32; ++ch) {
            __syncthreads();
            for (int idx = c.tid; idx < 32 * 256; idx += 512) { const int st = idx >> 8, col = idx & 255, row = scan_row(ch * 32 + st, b, dir);
                if (col < 64) qs[st * 64 + col] = bf2f(PC[(size_t)row * 1024 + h * 64 + col]);
                else if (col < 128) ks[st * 64 + col - 64] = bf2f(PC[(size_t)row * 1024 + 512 + h * 64 + col - 64]);
                else vs[st * 128 + col - 128] = bf2f(P[(size_t)row * PLD + 1024 + h * 128 + col - 128]); }
            if (c.tid < 32) { const int row = scan_row(ch * 32 + c.tid, b, dir); gs[c.tid * 2] = sigmoidf_(EX[(size_t)row * 32 + dir * 16 + 8 + h]); gs[c.tid * 2 + 1] = __expf(EX[(size_t)row * 32 + dir * 16 + h]); }
            __syncthreads();
            for (int st = 0; st < 32; ++st) {
                const float f = gs[st * 2], ei = gs[st * 2 + 1], vv = vs[st * 128 + v] * ei;
                float part = 0.f, dpart = 0.f;
#pragma unroll
                for (int d = 0; d < 16; ++d) { const float kd = ks[st * 64 + d0 + d], qd = qs[st * 64 + d0 + d];
                    C[d] = f * C[d] + kd * vv; part += qd * C[d]; n[d] = f * n[d] + ei * kd; dpart += qd * n[d]; }
                part += __shfl_xor(part, 1); part += __shfl_xor(part, 2); dpart += __shfl_xor(dpart, 1); dpart += __shfl_xor(dpart, 2);
                if ((c.tid & 3) == 0) { const int row = scan_row(ch * 32 + st, b, dir); Yo[(size_t)row * D + h * 128 + v] = part / fmaxf(fabsf(dpart), 1.0f); }
            }
        }
    }
}
typedef short s16x4 __attribute__((ext_vector_type(4)));
typedef float f32x16 __attribute__((ext_vector_type(16)));
#define MFMA32(a, b, c) __builtin_amdgcn_mfma_f32_32x32x16_bf16((a), (b), (c), 0, 0, 0)
DI int crow(int reg, int h) { return (reg & 3) + 8 * (reg >> 2) + 4 * h; }
DI s16x4 ds_tr(const LAS unsigned char* p) { return __builtin_amdgcn_ds_read_tr16_b64_v4i16((LAS s16x4*)p); }
DI bf16x8 cat8(s16x4 lo, s16x4 hi) { return __builtin_shufflevector(lo, hi, 0, 1, 2, 3, 4, 5, 6, 7); }
DI bf16x8 tr_frag(const LAS unsigned char* img, int pitch, int k0, int n0, int lane) {
    const int h = lane >> 5, g16 = (lane >> 4) & 1, i = lane & 15;
    const LAS unsigned char* p = img + (k0 + 8 * h + (i >> 2)) * pitch + (n0 + 16 * g16 + 4 * (i & 3)) * 2;
    return cat8(ds_tr(p), ds_tr(p + 4 * pitch));
}
DI bf16x8 tr_frag_perm(const LAS unsigned char* img, int pitch, int k0, int n0, int lane) {
    const int h = lane >> 5, g16 = (lane >> 4) & 1, i = lane & 15;
    const LAS unsigned char* p = img + (k0 + 4 * h + (i >> 2)) * pitch + (n0 + 16 * g16 + 4 * (i & 3)) * 2;
    return cat8(ds_tr(p), ds_tr(p + 8 * pitch));
}
DI bf16x8 row_frag(const LAS unsigned char* img, int pitch, int row0, int k0, int lane) { return *(const LAS bf16x8*)(img + (row0 + (lane & 31)) * pitch + (k0 + 8 * (lane >> 5)) * 2); }
DI bf16x8 pack_acc(const f32x16& x, int step) {
    u32x4 p; const int o = 8 * step;
    p.x = cvt_pk_bf16(x[o], x[o + 1]); p.y = cvt_pk_bf16(x[o + 2], x[o + 3]); p.z = cvt_pk_bf16(x[o + 4], x[o + 5]); p.w = cvt_pk_bf16(x[o + 6], x[o + 7]);
    return __builtin_bit_cast(bf16x8, p);
}
DI f32x16 zero16() { f32x16 z;
#pragma unroll
    for (int i = 0; i < 16; ++i) z[i] = 0.f; return z; }
DI float wave_incl_prefix(float x, int lane) {
#pragma unroll
    for (int o = 1; o < 64; o <<= 1) { const float t = __shfl_up(x, o); if (lane >= o) x += t; }
    return x;
}
DI float wave_incl_suffix(float x, int lane) {
#pragma unroll
    for (int o = 1; o < 64; o <<= 1) { const float t = __shfl_down(x, o); if (lane + o < 64) x += t; }
    return x;
}
DI int chunk_row0(int p, int b, int dir) {
    if (p < 4) return b * CTX + 64 * (dir ? 3 - p : p);
    return TC + b * SEQ + 64 * (dir ? 35 - p : p - 4);
}

DI void phase_mlstm_state(const Ctx& c) {
    const bf16* P = WSP(bf16, WS_P); const bf16* PC = WSP(bf16, WS_BIG + BIG_PC); const float* EX = WSP(float, WS_EXTRA);
    bf16* MCT = WSP(bf16, WS_BIG + BIG_MCT); float* MN = WSP(float, WS_BIG + BIG_MN);
    LAS float* gi = (LAS float*)c.lds; LAS float* ga = gi + 2304; LAS float* wv = ga + 2304; LAS float* dec = wv + 64;
    LAS unsigned char* Kw = c.lds + 20480; LAS unsigned char* Vs = Kw + 64 * 144;
    const int lane = c.lane, wave = c.wave, h5 = lane >> 5, l31 = lane & 31;
    for (int it0 = blockIdx.x; it0 < 256; it0 += gridDim.x) {
        const int item = (gridDim.x == 256) ? ((it0 & 7) * 32 + (it0 >> 3)) : it0;
        const int b = item >> 5, h = (item >> 2) & 7, dir = (item >> 1) & 1, dvh = item & 1, seq = (b * 8 + h) * 2 + dir;
        __syncthreads();
        for (int idx = c.tid; idx < 2304; idx += 512) { const int row = chunk_row0(idx >> 6, b, dir) + (idx & 63);
            gi[idx] = EX[(size_t)row * 32 + dir * 16 + h]; ga[idx] = logsigf_(EX[(size_t)row * 32 + dir * 16 + 8 + h]); }
        f32x16 acc = zero16(); float nst = 0.f;
        const int dt = wave & 1, vt = (wave >> 1) & 1;
        const int srow = c.tid >> 3, spc = c.tid & 7;
        u32x4 kregA, vregA, kregB, vregB;
#define ML_PREFETCH(p_, kr, vr) do { const int r0_ = chunk_row0((p_), b, dir); \
          kr = *(const u32x4*)(PC + (size_t)(r0_ + srow) * 1024 + 512 + h * 64 + 8 * spc); \
          vr = *(const u32x4*)(P + (size_t)(r0_ + srow) * PLD + 1024 + h * 128 + dvh * 64 + 8 * spc); } while (0)
        ML_PREFETCH(0, kregA, vregA); ML_PREFETCH(1, kregB, vregB);
        __syncthreads();
#define ML_STEP(p, kreg, vreg) do { \
              \
            if (wave < 4) { \
                bf16* dst = MCT + ((size_t)seq * 36 + (p)) * 8192 + (size_t)(dvh * 64 + 32 * vt + l31) * 64 + 32 * dt + 4 * h5; \
                _Pragma("unroll") for (int q = 0; q < 4; ++q) { u32x2 w; w.x = cvt_pk_bf16(acc[4 * q], acc[4 * q + 1]); w.y = cvt_pk_bf16(acc[4 * q + 2], acc[4 * q + 3]); *(u32x2*)(dst + 8 * q) = w; } \
            } else if (wave == 4) { if (dvh == 0) MN[((size_t)seq * 36 + (p)) * 64 + lane] = nst; } \
            else if (wave == 7) { \
                const float a = ga[(p) * 64 + lane]; const float bj = dir ? wave_incl_suffix(a, lane) : wave_incl_prefix(a, lane); \
                const float tot = __shfl(bj, dir ? 0 : 63); \
                wv[lane] = __expf(tot - bj + gi[(p) * 64 + lane]); if (lane == 0) dec[0] = __expf(tot); \
            } \
            lds_barrier(); \
              \
            { float kk[8]; unpack8(kreg, kk); const float w = wv[srow]; \
              _Pragma("unroll") for (int j = 0; j < 8; ++j) kk[j] *= w; \
              *(LAS u32x4*)(Kw + srow * 144 + spc * 16) = pack8(kk); *(LAS u32x4*)(Vs + srow * 144 + spc * 16) = vreg; } \
            if ((p) + 2 < 36) ML_PREFETCH((p) + 2, kreg, vreg); \
            const float d = dec[0];            \
            lds_barrier(); \
              \
            if (wave < 4) { \
                _Pragma("unroll") for (int i = 0; i < 16; ++i) acc[i] *= d; \
                _Pragma("unroll") for (int kk = 0; kk < 4; ++kk) acc = MFMA32(tr_frag(Kw, 144, 16 * kk, 32 * dt, lane), tr_frag(Vs, 144, 16 * kk, 32 * vt, lane), acc); \
            } else if (wave == 4) { \
                float s = 0.f; \
                for (int r = 0; r < 64; ++r) s += bf2f(*(const LAS bf16*)(Kw + r * 144 + lane * 2)); \
                nst = d * nst + s; \
            } } while (0)
        for (int p = 0; p < 36; p += 2) { ML_STEP(p, kregA, vregA); ML_STEP(p + 1, kregB, vregB); }
#undef ML_STEP
#undef ML_PREFETCH
    }
}

DI void phase_mlstm_out(const Ctx& c, const float* ng) {
    const bf16* P = WSP(bf16, WS_P); const bf16* PC = WSP(bf16, WS_BIG + BIG_PC); const float* EX = WSP(float, WS_EXTRA);
    const bf16* MCT = WSP(bf16, WS_BIG + BIG_MCT); const float* MN = WSP(float, WS_BIG + BIG_MN); bf16* Y = WSP(bf16, WS_Y);
    LAS unsigned char* Qs = c.lds; LAS unsigned char* Ks = Qs + 9216; LAS unsigned char* Vs = Ks + 9216;
    LAS unsigned char* CT0 = Vs + 17408;
    LAS float* gt = (LAS float*)(c.lds + MISC_OFF + 1024);
    LAS float* YO = (LAS float*)c.lds;
    const int lane = c.lane, wave = c.wave, h5 = lane >> 5, l31 = lane & 31;
    const int dir = wave >> 2, jt = (wave >> 1) & 1, vh = wave & 1;
    const int srow = c.tid >> 3, spc = c.tid & 7;
    u32x4 pq, pk, pv[2], pct[4], pgate[2]; float pga = 0.f, pgi = 0.f, pgn = 0.f;
#define MO_DECODE(it_) const int b = (it_) / 288, h = ((it_) / 36) & 7, cc = (it_) % 36; \
        const int r0 = cc < 4 ? b * CTX + 64 * cc : TC + b * SEQ + 64 * (cc - 4); const int pf = cc, pb = cc < 4 ? 3 - cc : 39 - cc
#define MO_PREFETCH(it_) do { MO_DECODE(it_); \
        pq = *(const u32x4*)(PC + (size_t)(r0 + srow) * 1024 + h * 64 + 8 * spc); pk = *(const u32x4*)(PC + (size_t)(r0 + srow) * 1024 + 512 + h * 64 + 8 * spc); \
        _Pragma("unroll") for (int i = 0; i < 2; ++i) pv[i] = *(const u32x4*)(P + (size_t)(r0 + srow) * PLD + 1024 + h * 128 + 8 * (spc + 8 * i)); \
        _Pragma("unroll") for (int i = 0; i < 4; ++i) { const int pc = c.tid + 512 * i, d2 = pc >> 10, rr = (pc >> 3) & 127, sp = pc & 7; \
            pct[i] = *(const u32x4*)(MCT + (((size_t)((b * 8 + h) * 2 + d2)) * 36 + (d2 ? pb : pf)) * 8192 + rr * 64 + 8 * sp); } \
        _Pragma("unroll") for (int i = 0; i < 2; ++i) pgate[i] = *(const u32x4*)(P + (size_t)(r0 + srow) * PLD + 2048 + h * 128 + 16 * spc + 8 * i); \
        if (wave < 2) { const int d2 = wave, row = r0 + lane; pga = EX[(size_t)row * 32 + d2 * 16 + 8 + h]; pgi = EX[(size_t)row * 32 + d2 * 16 + h]; \
            pgn = MN[(((size_t)((b * 8 + h) * 2 + d2)) * 36 + (d2 ? pb : pf)) * 64 + lane]; } } while (0)
    if ((int)blockIdx.x < 2304) MO_PREFETCH((int)blockIdx.x);
    for (int item = blockIdx.x; item < 2304; item += gridDim.x) {
        MO_DECODE(item); (void)pf; (void)pb;
        lds_barrier();
        *(LAS u32x4*)(Qs + srow * 144 + spc * 16) = pq; *(LAS u32x4*)(Ks + srow * 144 + spc * 16) = pk;
#pragma unroll
        for (int i = 0; i < 2; ++i) *(LAS u32x4*)(Vs + srow * 272 + (spc + 8 * i) * 16) = pv[i];
#pragma unroll
        for (int i = 0; i < 4; ++i) { const int pc = c.tid + 512 * i, d2 = pc >> 10, rr = (pc >> 3) & 127, sp = pc & 7; *(LAS u32x4*)(CT0 + d2 * 18432 + rr * 144 + sp * 16) = pct[i]; }
        if (wave < 2) { const int d2 = wave; const float a = logsigf_(pga);
            const float bj = d2 ? wave_incl_suffix(a, lane) : wave_incl_prefix(a, lane);
            gt[d2 * 192 + lane] = bj; gt[d2 * 192 + 64 + lane] = pgi - bj; gt[d2 * 192 + 128 + lane] = pgn; }
        const u32x4 gate0 = pgate[0], gate1 = pgate[1];
        if (item + (int)gridDim.x < 2304) MO_PREFETCH(item + (int)gridDim.x);
        lds_barrier();
        const LAS float* g = gt + dir * 192; const LAS unsigned char* CT = CT0 + dir * 18432;
        const int j = 32 * jt + l31; const float bjj = g[j];
        bf16x8 qf[4];
#pragma unroll
        for (int kk = 0; kk < 4; ++kk) qf[kk] = row_frag(Qs, 144, 32 * jt, 16 * kk, lane);
        float qn = 0.f;
#pragma unroll
        for (int kk = 0; kk < 4; ++kk) { float qv[8]; unpack8(__builtin_bit_cast(u32x4, qf[kk]), qv);
#pragma unroll
            for (int e = 0; e < 8; ++e) qn += qv[e] * g[128 + 16 * kk + 8 * h5 + e]; }
        qn += __shfl_xor(qn, 32);
        f32x16 X[2]; float den = 0.f;
#pragma unroll
        for (int st = 0; st < 2; ++st) {
            X[st] = zero16();
            const bool live = dir ? (st >= jt) : (st <= jt);
            if (live) {
#pragma unroll
                for (int kk = 0; kk < 4; ++kk) X[st] = MFMA32(row_frag(Ks, 144, 32 * st, 16 * kk, lane), qf[kk], X[st]);
#pragma unroll
                for (int r = 0; r < 16; ++r) { const int s = 32 * st + crow(r, h5); const bool ok = dir ? (s >= j) : (s <= j);
                    const float w = ok ? __expf(bjj + g[64 + s]) : 0.f; X[st][r] *= w; den += X[st][r]; }
            }
        }
        den += __shfl_xor(den, 32);
        const float eb = __expf(bjj); den += eb * qn;
        const float scale = 1.0f / fmaxf(fabsf(den), 1.0f);
        f32x16 O[2];
#pragma unroll
        for (int t = 0; t < 2; ++t) {
            const int vt = 2 * vh + t; f32x16 z = zero16(), w = zero16();
#pragma unroll
            for (int st = 0; st < 2; ++st) { const bool live = dir ? (st >= jt) : (st <= jt);
                if (live) {
#pragma unroll
                    for (int step = 0; step < 2; ++step) z = MFMA32(tr_frag_perm(Vs, 272, 32 * st + 16 * step, 32 * vt, lane), pack_acc(X[st], step), z); } }
#pragma unroll
            for (int kk = 0; kk < 4; ++kk) w = MFMA32(row_frag(CT, 144, 32 * vt, 16 * kk, lane), qf[kk], w);
#pragma unroll
            for (int r = 0; r < 16; ++r) O[t][r] = (z[r] + eb * w[r]) * scale;
        }
        lds_barrier();
#pragma unroll
        for (int t = 0; t < 2; ++t) { const int vt = 2 * vh + t;
#pragma unroll
            for (int q = 0; q < 4; ++q) *(LAS f32x4*)(YO + dir * 8448 + j * 132 + 32 * vt + 8 * q + 4 * h5) = (f32x4){O[t][4 * q], O[t][4 * q + 1], O[t][4 * q + 2], O[t][4 * q + 3]}; }
        lds_barrier();
        { const int row = c.tid >> 3, c0 = (c.tid & 7) * 16; float y[16]; float ss = 0.f;
#pragma unroll
          for (int q = 0; q < 4; ++q) { const f32x4 a = *(const LAS f32x4*)(YO + row * 132 + c0 + 4 * q), bb = *(const LAS f32x4*)(YO + 8448 + row * 132 + c0 + 4 * q);
              y[4 * q] = a.x + bb.x; y[4 * q + 1] = a.y + bb.y; y[4 * q + 2] = a.z + bb.z; y[4 * q + 3] = a.w + bb.w; }
#pragma unroll
          for (int q = 0; q < 16; ++q) ss += y[q] * y[q];
          ss += __shfl_xor(ss, 1); ss += __shfl_xor(ss, 2); ss += __shfl_xor(ss, 4);
          const float r = 1.0f / sqrtf(ss * (1.0f / 128.0f) + EPS);
          float g0[8], g1[8];
          unpack8(gate0, g0); unpack8(gate1, g1);
          float o0[8], o1[8];
#pragma unroll
          for (int q = 0; q < 8; ++q) { o0[q] = y[q] * r * ng[h * 128 + c0 + q] * sigmoidf_(g0[q]); o1[q] = y[8 + q] * r * ng[h * 128 + c0 + 8 + q] * sigmoidf_(g1[q]); }
          *(u32x4*)(Y + (size_t)(r0 + row) * D + h * 128 + c0) = pack8(o0); *(u32x4*)(Y + (size_t)(r0 + row) * D + h * 128 + c0 + 8) = pack8(o1); }
    }
#undef MO_PREFETCH
#undef MO_DECODE
}

DI void phase_gla_decay(const Ctx& c) {
    const float* EX = WSP(float, WS_EXTRA); float* GB = WSP(float, WS_BIG + BIG_GB);
    LAS float* w2s = (LAS float*)c.lds; LAS float* gbs = w2s + 2048; LAS float* lgs = gbs + 128; LAS float* segs = lgs + 8192;
    const int srow = c.tid >> 3, dg = c.tid & 7;
    const int dir = (blockIdx.x >> 2) & 1, h = blockIdx.x & 3, nper = gridDim.x >> 3;
    __syncthreads();
    for (int i = c.tid; i < 2048; i += 512) w2s[i] = c.in[I_GLW2][(size_t)dir * 8192 + (i >> 7) * 512 + h * 128 + (i & 127)];
    if (c.tid < 128) gbs[c.tid] = c.in[I_GLGB][dir * 512 + h * 128 + c.tid];
    for (int ck = blockIdx.x >> 3; ck < 288; ck += nper) {
        const int r0 = 64 * ck;
        __syncthreads();
        f32x4 low[4];
#pragma unroll
        for (int q = 0; q < 4; ++q) low[q] = *(const f32x4*)(EX + (size_t)(r0 + srow) * 32 + dir * 16 + 4 * q);
        __syncthreads();
        { const int d0 = 16 * dg; float pre[16];
#pragma unroll
          for (int e = 0; e < 16; ++e) pre[e] = gbs[d0 + e];
#pragma unroll
          for (int r = 0; r < 16; ++r) { const float lv = low[r >> 2][r & 3];
#pragma unroll
              for (int q = 0; q < 4; ++q) { const f32x4 w = *(const LAS f32x4*)(w2s + r * 128 + d0 + 4 * q); pre[4 * q] += lv * w.x; pre[4 * q + 1] += lv * w.y; pre[4 * q + 2] += lv * w.z; pre[4 * q + 3] += lv * w.w; } }
#pragma unroll
          for (int q = 0; q < 4; ++q) *(LAS f32x4*)(lgs + srow * 128 + d0 + 4 * q) = (f32x4){logsigf_(pre[4 * q]) * 0.0625f, logsigf_(pre[4 * q + 1]) * 0.0625f, logsigf_(pre[4 * q + 2]) * 0.0625f, logsigf_(pre[4 * q + 3]) * 0.0625f}; }
        __syncthreads();
        { const int d = c.tid & 127, sg = c.tid >> 7; float v[16];
#pragma unroll
          for (int i = 0; i < 16; ++i) { const int s = dir ? 63 - (16 * sg + i) : 16 * sg + i; v[i] = lgs[s * 128 + d]; }
#pragma unroll
          for (int i = 1; i < 16; ++i) v[i] += v[i - 1];
          segs[sg * 128 + d] = v[15];
          __syncthreads();
          float off = 0.f;
#pragma unroll
          for (int g2 = 0; g2 < 3; ++g2) off += (g2 < sg) ? segs[g2 * 128 + d] : 0.f;
#pragma unroll
          for (int i = 0; i < 16; ++i) { const int s = dir ? 63 - (16 * sg + i) : 16 * sg + i; GB[((size_t)dir * TT + r0 + s) * 512 + h * 128 + d] = v[i] + off; } }
    }
}
DI void phase_gla_state(const Ctx& c) {
    const bf16* PC = WSP(bf16, WS_BIG + BIG_PC); const float* GB = WSP(float, WS_BIG + BIG_GB); bf16* GST = WSP(bf16, WS_BIG + BIG_GST);
    LAS float* tot = (LAS float*)c.lds;
    LAS unsigned char* Kd = c.lds + 1024; LAS unsigned char* Vs = Kd + 64 * 272;
    const int lane = c.lane, wave = c.wave, h5 = lane >> 5, l31 = lane & 31, dkt = wave & 3, dvt = wave >> 2;
    const int srow = c.tid >> 3, dg = c.tid & 7;
    for (int it0 = blockIdx.x; it0 < 256; it0 += gridDim.x) {
        const int item = (gridDim.x == 256) ? ((it0 & 7) * 32 + (it0 >> 3)) : it0;
        const int b = item >> 5, h = (item >> 3) & 3, dir = (item >> 2) & 1, dvq = item & 3, seq = (b * 4 + h) * 2 + dir;
        f32x16 acc = zero16();
        u32x4 kA0, kA1, vA, kB0, kB1, vB; f32x4 bvA[4], tvA[4], bvB[4], tvB[4];
#define GLA_PREFETCH(p_, k0, k1, vr, bv, tv) do { const int r0_ = chunk_row0((p_), b, dir), row = r0_ + srow; \
          k0 = *(const u32x4*)(PC + (size_t)row * 2048 + 512 + h * 128 + 16 * dg); k1 = *(const u32x4*)(PC + (size_t)row * 2048 + 512 + h * 128 + 16 * dg + 8); \
          vr = *(const u32x4*)(PC + (size_t)row * 2048 + 1024 + h * 256 + dvq * 64 + 8 * dg); \
          _Pragma("unroll") for (int q = 0; q < 4; ++q) { bv[q] = *(const f32x4*)(GB + ((size_t)dir * TT + row) * 512 + h * 128 + 16 * dg + 4 * q); \
              tv[q] = *(const f32x4*)(GB + ((size_t)dir * TT + r0_ + (dir ? 0 : 63)) * 512 + h * 128 + 16 * dg + 4 * q); } } while (0)
        GLA_PREFETCH(0, kA0, kA1, vA, bvA, tvA); GLA_PREFETCH(1, kB0, kB1, vB, bvB, tvB);
#define GLA_STEP(p, k0r, k1r, vr, bv, tv) do { \
            { bf16* dst = GST + ((size_t)seq * 36 + (p)) * 32768 + (size_t)(dvq * 64 + 32 * dvt + l31) * 128 + 32 * dkt + 4 * h5; \
              _Pragma("unroll") for (int q = 0; q < 4; ++q) { u32x2 w; w.x = cvt_pk_bf16(acc[4 * q], acc[4 * q + 1]); w.y = cvt_pk_bf16(acc[4 * q + 2], acc[4 * q + 3]); *(u32x2*)(dst + 8 * q) = w; } } \
            lds_barrier();                                    \
            { float kk[16]; { float t8[8]; unpack8(k0r, t8); \
                _Pragma("unroll") for (int e = 0; e < 8; ++e) kk[e] = t8[e]; unpack8(k1r, t8); \
                _Pragma("unroll") for (int e = 0; e < 8; ++e) kk[8 + e] = t8[e]; } \
              _Pragma("unroll") for (int e = 0; e < 16; ++e) kk[e] *= __expf(tv[e >> 2][e & 3] - bv[e >> 2][e & 3]); \
              const float k0[8] = {kk[0], kk[1], kk[2], kk[3], kk[4], kk[5], kk[6], kk[7]}, k1[8] = {kk[8], kk[9], kk[10], kk[11], kk[12], kk[13], kk[14], kk[15]}; \
              *(LAS u32x4*)(Kd + srow * 272 + dg * 32) = pack8(k0); *(LAS u32x4*)(Kd + srow * 272 + dg * 32 + 16) = pack8(k1); \
              *(LAS u32x4*)(Vs + srow * 144 + dg * 16) = vr; \
              if (srow == 0) { \
                  _Pragma("unroll") for (int q = 0; q < 4; ++q) *(LAS f32x4*)(tot + 16 * dg + 4 * q) = tv[q]; } } \
            if ((p) + 2 < 36) GLA_PREFETCH((p) + 2, k0r, k1r, vr, bv, tv); \
            lds_barrier(); \
            _Pragma("unroll") for (int r = 0; r < 16; ++r) acc[r] *= __expf(tot[32 * dkt + crow(r, h5)]); \
            _Pragma("unroll") for (int kk = 0; kk < 4; ++kk) acc = MFMA32(tr_frag(Kd, 272, 16 * kk, 32 * dkt, lane), tr_frag(Vs, 144, 16 * kk, 32 * dvt, lane), acc); \
            } while (0)
        for (int p = 0; p < 36; p += 2) { GLA_STEP(p, kA0, kA1, vA, bvA, tvA); GLA_STEP(p + 1, kB0, kB1, vB, bvB, tvB); }
#undef GLA_STEP
#undef GLA_PREFETCH
    }
}
DI void phase_gla_out(const Ctx& c, const float* ng) {
    const bf16* P = WSP(bf16, WS_P); const bf16* PC = WSP(bf16, WS_BIG + BIG_PC); const float* GB = WSP(float, WS_BIG + BIG_GB);
    const bf16* GST = WSP(bf16, WS_BIG + BIG_GST); bf16* Y = WSP(bf16, WS_Y);
    LAS unsigned char* Qt = c.lds; LAS unsigned char* Kt = Qt + 17408; LAS unsigned char* Vs = Kt + 17408; LAS unsigned char* STs = Vs + 33792;
    LAS float* YO = (LAS float*)STs;
    const int lane = c.lane, wave = c.wave, h5 = lane >> 5, l31 = lane & 31;
    const int srow = c.tid >> 3, dg = c.tid & 7;
    for (int item = blockIdx.x; item < 1152; item += gridDim.x) {
        const int b = item / 144, h = (item / 36) & 3, cc = item % 36;
        const int r0 = cc < 4 ? b * CTX + 64 * cc : TC + b * SEQ + 64 * (cc - 4);
        __syncthreads();
#pragma unroll
        for (int i = 0; i < 4; ++i) { const int pc = dg + 8 * i; *(LAS u32x4*)(Vs + srow * 528 + pc * 16) = *(const u32x4*)(PC + (size_t)(r0 + srow) * 2048 + 1024 + h * 256 + 8 * pc); }
        f32x16 O[2]; O[0] = zero16(); O[1] = zero16();
        for (int dir = 0; dir < 2; ++dir) {
            const int pslot = dir ? (cc < 4 ? 3 - cc : 39 - cc) : cc;
            if (dir) __syncthreads();
            { const bf16* src = GST + ((size_t)((b * 4 + h) * 2 + dir) * 36 + pslot) * 32768;
#pragma unroll
              for (int i = 0; i < 8; ++i) { const int pc = c.tid + 512 * i, rr = pc >> 4, sp = pc & 15; *(LAS u32x4*)(STs + rr * 272 + sp * 16) = *(const u32x4*)(src + rr * 128 + 8 * sp); } }
            { float qq[16], kk[16], bb[16]; float t8[8];
#pragma unroll
              for (int q = 0; q < 4; ++q) { const f32x4 t4 = *(const f32x4*)(GB + ((size_t)dir * TT + r0 + srow) * 512 + h * 128 + 16 * dg + 4 * q); bb[4 * q] = t4.x; bb[4 * q + 1] = t4.y; bb[4 * q + 2] = t4.z; bb[4 * q + 3] = t4.w; }
              unpack8(*(const u32x4*)(PC + (size_t)(r0 + srow) * 2048 + h * 128 + 16 * dg), t8);
#pragma unroll
              for (int e = 0; e < 8; ++e) qq[e] = t8[e];
              unpack8(*(const u32x4*)(PC + (size_t)(r0 + srow) * 2048 + h * 128 + 16 * dg + 8), t8);
#pragma unroll
              for (int e = 0; e < 8; ++e) qq[8 + e] = t8[e];
              unpack8(*(const u32x4*)(PC + (size_t)(r0 + srow) * 2048 + 512 + h * 128 + 16 * dg), t8);
#pragma unroll
              for (int e = 0; e < 8; ++e) kk[e] = t8[e];
              unpack8(*(const u32x4*)(PC + (size_t)(r0 + srow) * 2048 + 512 + h * 128 + 16 * dg + 8), t8);
#pragma unroll
              for (int e = 0; e < 8; ++e) kk[8 + e] = t8[e];
#pragma unroll
              for (int e = 0; e < 16; ++e) { const float eb = __expf(bb[e]); qq[e] *= eb; kk[e] *= 1.0f / eb; }
              const float q0[8] = {qq[0], qq[1], qq[2], qq[3], qq[4], qq[5], qq[6], qq[7]}, q1[8] = {qq[8], qq[9], qq[10], qq[11], qq[12], qq[13], qq[14], qq[15]};
              const float k0[8] = {kk[0], kk[1], kk[2], kk[3], kk[4], kk[5], kk[6], kk[7]}, k1[8] = {kk[8], kk[9], kk[10], kk[11], kk[12], kk[13], kk[14], kk[15]};
              *(LAS u32x4*)(Qt + srow * 272 + dg * 32) = pack8(q0); *(LAS u32x4*)(Qt + srow * 272 + dg * 32 + 16) = pack8(q1);
              *(LAS u32x4*)(Kt + srow * 272 + dg * 32) = pack8(k0); *(LAS u32x4*)(Kt + srow * 272 + dg * 32 + 16) = pack8(k1); }
            __syncthreads();
#pragma unroll
            for (int jt = 0; jt < 2; ++jt) {
#pragma unroll
                for (int st = 0; st < 2; ++st) {
                    const bool live = dir ? (st >= jt) : (st <= jt);
                    if (live) {
                        f32x16 X = zero16();
#pragma unroll
                        for (int kk = 0; kk < 8; ++kk) X = MFMA32(row_frag(Kt, 272, 32 * st, 16 * kk, lane), row_frag(Qt, 272, 32 * jt, 16 * kk, lane), X);
                        if (st == jt) {
#pragma unroll
                            for (int r = 0; r < 16; ++r) { const int s = crow(r, h5); const bool ok = dir ? (s >= l31) : (s <= l31); X[r] = ok ? X[r] : 0.f; } }
#pragma unroll
                        for (int step = 0; step < 2; ++step) O[jt] = MFMA32(tr_frag_perm(Vs, 528, 32 * st + 16 * step, 32 * wave, lane), pack_acc(X, step), O[jt]);
                    }
                }
#pragma unroll
                for (int kk = 0; kk < 8; ++kk) O[jt] = MFMA32(row_frag(STs, 272, 32 * wave, 16 * kk, lane), row_frag(Qt, 272, 32 * jt, 16 * kk, lane), O[jt]);
            }
        }
        __syncthreads();
#pragma unroll
        for (int jt = 0; jt < 2; ++jt)
#pragma unroll
            for (int q = 0; q < 4; ++q) *(LAS f32x4*)(YO + (32 * jt + l31) * 260 + 32 * wave + 8 * q + 4 * h5) = (f32x4){O[jt][4 * q], O[jt][4 * q + 1], O[jt][4 * q + 2], O[jt][4 * q + 3]};
        __syncthreads();
        { const int c0 = dg * 32; float y[32]; float ss = 0.f;
#pragma unroll
          for (int q = 0; q < 8; ++q) { const f32x4 a = *(const LAS f32x4*)(YO + srow * 260 + c0 + 4 * q); y[4 * q] = a.x; y[4 * q + 1] = a.y; y[4 * q + 2] = a.z; y[4 * q + 3] = a.w; }
#pragma unroll
          for (int q = 0; q < 32; ++q) ss += y[q] * y[q];
          ss += __shfl_xor(ss, 1); ss += __shfl_xor(ss, 2); ss += __shfl_xor(ss, 4);
          const float r = 1.0f / sqrtf(ss * (1.0f / 256.0f) + EPS);
#pragma unroll
          for (int q = 0; q < 4; ++q) { float g8[8], o8[8]; unpack8(*(const u32x4*)(P + (size_t)(r0 + srow) * PLD + 2048 + h * 256 + c0 + 8 * q), g8);
#pragma unroll
              for (int e = 0; e < 8; ++e) o8[e] = y[8 * q + e] * r * ng[h * 256 + c0 + 8 * q + e] * siluf_(g8[e]);
              *(u32x4*)(Y + (size_t)(r0 + srow) * D + h * 256 + c0 + 8 * q) = pack8(o8); } }
    }
}

DI void phase_gla_scan_naive(const Ctx& c) {
    const bf16* PC = WSP(bf16, WS_BIG + BIG_PC); const float* EX = WSP(float, WS_EXTRA);
    LAS float* qs = (LAS float*)c.lds; LAS float* ks = qs + 16 * 128; LAS float* as = ks + 16 * 128; LAS float* vs = as + 16 * 128; LAS float* lw = vs + 16 * 256;
    const int v = c.tid >> 1, d0 = (c.tid & 1) * 64;
    for (int item = blockIdx.x; item < 64; item += gridDim.x) {
        const int b = item >> 3, h = (item >> 1) & 3, dir = item & 1;
        float* Yo = WSP(float, WS_BIG + (dir ? BIG_YB : BIG_YF));
        const float* w2 = c.in[I_GLW2] + (size_t)dir * 16 * 512 + h * 128; const float* gb = c.in[I_GLGB] + dir * 512 + h * 128;
        float S[64];
#pragma unroll
        for (int d = 0; d < 64; ++d) S[d] = 0.f;
        for (int ch = 0; ch < (CTX + SEQ) / 16; ++ch) {
            __syncthreads();
            if (c.tid < 256) { const int st = c.tid >> 4, r = c.tid & 15, row = scan_row(ch * 16 + st, b, dir); lw[c.tid] = EX[(size_t)row * 32 + dir * 16 + r]; }
            for (int idx = c.tid; idx < 16 * 512; idx += 512) { const int st = idx >> 9, col = idx & 511, row = scan_row(ch * 16 + st, b, dir);
                if (col < 128) qs[st * 128 + col] = bf2f(PC[(size_t)row * 2048 + h * 128 + col]);
                else if (col < 256) ks[st * 128 + col - 128] = bf2f(PC[(size_t)row * 2048 + 512 + h * 128 + col - 128]);
                else vs[st * 256 + col - 256] = bf2f(PC[(size_t)row * 2048 + 1024 + h * 256 + col - 256]); }
            __syncthreads();
            for (int idx = c.tid; idx < 16 * 128; idx += 512) { const int st = idx >> 7, d = idx & 127; float pre = gb[d];
#pragma unroll
                for (int r = 0; r < 16; ++r) pre += lw[st * 16 + r] * w2[r * 512 + d];
                as[idx] = __expf(logsigf_(pre) * (1.0f / 16.0f)); }
            __syncthreads();
            for (int st = 0; st < 16; ++st) {
                const float vv = vs[st * 256 + v]; float part = 0.f;
#pragma unroll
                for (int d = 0; d < 64; ++d) { S[d] = as[st * 128 + d0 + d] * S[d] + ks[st * 128 + d0 + d] * vv; part += qs[st * 128 + d0 + d] * S[d]; }
                part += __shfl_xor(part, 1);
                if ((c.tid & 1) == 0) { const int row = scan_row(ch * 16 + st, b, dir); Yo[(size_t)row * D + h * 256 + v] = part; }
            }
        }
    }
}
DI void phase_headnorm(const Ctx& c, int hd, const float* ng) {
    const float* YF = WSP(float, WS_BIG + BIG_YF); const float* YB = WSP(float, WS_BIG + BIG_YB); const bf16* P = WSP(bf16, WS_P); bf16* Y = WSP(bf16, WS_Y);
    for (int row = c.gw; row < TT; row += c.ngw) {
        const int c0 = 16 * c.lane; float y[16]; float ss = 0.f;
#pragma unroll
        for (int j = 0; j < 4; ++j) { const f32x4 a = *(const f32x4*)(YF + (size_t)row * D + c0 + 4 * j), bb = *(const f32x4*)(YB + (size_t)row * D + c0 + 4 * j);
            y[4 * j] = a.x + bb.x; y[4 * j + 1] = a.y + bb.y; y[4 * j + 2] = a.z + bb.z; y[4 * j + 3] = a.w + bb.w; }
#pragma unroll
        for (int j = 0; j < 16; ++j) ss += y[j] * y[j];
        ss += __shfl_xor(ss, 1); ss += __shfl_xor(ss, 2); ss += __shfl_xor(ss, 4); if (hd == 256) ss += __shfl_xor(ss, 8);
        const float r = 1.0f / sqrtf(ss / (float)hd + EPS);
        float g0[8], g1[8];
        unpack8(*(const u32x4*)(P + (size_t)row * PLD + 2048 + c0), g0); unpack8(*(const u32x4*)(P + (size_t)row * PLD + 2048 + c0 + 8), g1);
        float o[16];
#pragma unroll
        for (int j = 0; j < 16; ++j) { const float gp = j < 8 ? g0[j] : g1[j - 8]; o[j] = y[j] * r * ng[c0 + j] * (hd == 128 ? sigmoidf_(gp) : siluf_(gp)); }
        const float o0[8] = {o[0], o[1], o[2], o[3], o[4], o[5], o[6], o[7]}, o1[8] = {o[8], o[9], o[10], o[11], o[12], o[13], o[14], o[15]};
        *(u32x4*)(Y + (size_t)row * D + c0) = pack8(o0); *(u32x4*)(Y + (size_t)row * D + c0 + 8) = pack8(o1);
    }
}
DI void phase_hyena_conv_naive(const Ctx& c) {
    const bf16* PC = WSP(bf16, WS_BIG + BIG_PC); bf16* Y = WSP(bf16, WS_Y); const float* skip = c.in[I_HYSKIP];
    LAS float* zt = (LAS float*)c.lds;
    LAS float* ft = zt + 4096;
    const int cc = c.tid & 63, tg = c.tid >> 6;
    for (int item = blockIdx.x; item < 4096 + 512; item += gridDim.x) {
        int L, rb, tt, cgi; const float* tab;
        if (item < 4096) { L = SEQ; const int b = item >> 9; tt = (item >> 4) & 31; cgi = item & 15; rb = TC + b * SEQ; tab = WSP(float, WS_HF); }
        else { const int it = item - 4096; L = CTX; const int b = it >> 6; tt = (it >> 4) & 3; cgi = it & 15; rb = b * CTX; tab = WSP(float, WS_HFC); }
        const int t0 = 64 * tt, c0 = 64 * cgi;
        float acc[8];
#pragma unroll
        for (int i = 0; i < 8; ++i) acc[i] = 0.f;
        for (int sb = 0; sb < L / 64; ++sb) {
            const int s0 = 64 * sb;
            __syncthreads();
            for (int idx = c.tid; idx < 4096; idx += 512) { const int sl = idx >> 6, ch = idx & 63; const size_t o = (size_t)(rb + s0 + sl) * PLD + c0 + ch;
                zt[idx] = bf2f(PC[o + 1024]) * bf2f(PC[o + 2048]); }
            for (int idx = c.tid; idx < 64 * 128; idx += 512) { const int ch = idx >> 7, j = idx & 127;
                if (j < 127) ft[j * 65 + ch] = tab[(size_t)(c0 + ch) * (2 * L) + L + (t0 - s0 - 63 + j)]; }
            __syncthreads();
#pragma unroll 1
            for (int g = 0; g < 8; ++g) {
                float w[15], z[8]; const int base = 8 * (tg - g) + 56;
#pragma unroll
                for (int m = 0; m < 15; ++m) w[m] = ft[(base + m) * 65 + cc];
#pragma unroll
                for (int j = 0; j < 8; ++j) z[j] = zt[(8 * g + j) * 64 + cc];
#pragma unroll
                for (int i = 0; i < 8; ++i)
#pragma unroll
                    for (int j = 0; j < 8; ++j) acc[i] += w[i - j + 7] * z[j];
            }
        }
#pragma unroll
        for (int i = 0; i < 8; ++i) { const int row = rb + t0 + 8 * tg + i; const size_t o = (size_t)row * PLD + c0 + cc;
            const float zin = bf2f(PC[o + 1024]) * bf2f(PC[o + 2048]), x0 = bf2f(PC[o]);
            Y[(size_t)row * D + c0 + cc] = f2bf(x0 * (acc[i] + skip[c0 + cc] * zin)); }
    }
}

DI void hy_item(int item, int& L, int& b, int& t0, int& c0, int& rb) {
    if (item < 4096) { L = SEQ; b = item >> 9; t0 = 64 * ((item >> 4) & 31); c0 = 64 * (item & 15); rb = TC + b * SEQ; }
    else { const int it = item - 4096; L = CTX; b = it >> 6; t0 = 64 * ((it >> 4) & 3); c0 = 64 * (it & 15); rb = b * CTX; }
}
DI void phase_hy_prep(const Ctx& c) {
    const bf16* P = WSP(bf16, WS_P); bf16* X0C = WSP(bf16, WS_BIG + BIG_PC); const float* cw = c.in[I_HYCW]; const float* cb = c.in[I_HYCB];
    LAS unsigned char* raw = c.lds;
    LAS float* zt = (LAS float*)(c.lds + 32768);
    u32x4 pre[4];
#define HP_PREF(it_) do { int L_, b_, t0_, c0_, rb_; hy_item((it_), L_, b_, t0_, c0_, rb_); \
        _Pragma("unroll") for (int k = 0; k < 4; ++k) { const int pc = c.tid + 512 * k; pre[k] = (u32x4){c.z, c.z, c.z, c.z}; \
            if (pc < 3 * 66 * 8) { const int g = pc / 528, rr = (pc % 528) >> 3, sp = pc & 7, t = t0_ - 1 + rr; \
                if (t >= 0 && t < L_) pre[k] = *(const u32x4*)(P + (size_t)(rb_ + t) * PLD + g * 1024 + c0_ + 8 * sp); } } } while (0)
    if ((int)blockIdx.x < 4608) HP_PREF((int)blockIdx.x);
    for (int item = blockIdx.x; item < 4608; item += gridDim.x) {
        int L, b, t0, c0, rb; hy_item(item, L, b, t0, c0, rb);
        bf16* ZT = L == SEQ ? WSP(bf16, WS_BIG + BIG_ZTL) : WSP(bf16, WS_BIG + BIG_ZTC);
        lds_barrier();
#pragma unroll
        for (int k = 0; k < 4; ++k) { const int pc = c.tid + 512 * k; if (pc < 3 * 66 * 8) { const int g = pc / 528, rr = (pc % 528) >> 3, sp = pc & 7; *(LAS u32x4*)(raw + (g * 66 + rr) * 128 + sp * 16) = pre[k]; } }
        if (item + (int)gridDim.x < 4608) HP_PREF(item + (int)gridDim.x);
        lds_barrier();
        { const int t = c.tid >> 3, sp = c.tid & 7; float u[3][8];
#pragma unroll
          for (int g = 0; g < 3; ++g) { float xm[8], x0[8], xp[8];
              unpack8(*(const LAS u32x4*)(raw + (g * 66 + t) * 128 + sp * 16), xm); unpack8(*(const LAS u32x4*)(raw + (g * 66 + t + 1) * 128 + sp * 16), x0); unpack8(*(const LAS u32x4*)(raw + (g * 66 + t + 2) * 128 + sp * 16), xp);
              const int col = g * 1024 + c0 + 8 * sp;
#pragma unroll
              for (int e = 0; e < 8; ++e) u[g][e] = cw[col + e] * xm[e] + cw[3072 + col + e] * x0[e] + cw[6144 + col + e] * xp[e] + cb[col + e]; }
          *(u32x4*)(X0C + (size_t)(rb + t0 + t) * 1024 + c0 + 8 * sp) = pack8(u[0]);
#pragma unroll
          for (int e = 0; e < 8; ++e) zt[t * 65 + 8 * sp + e] = u[1][e] * u[2][e]; }
        lds_barrier();
        { const int ch = c.tid >> 3, tp = c.tid & 7; float z[8];
#pragma unroll
          for (int e = 0; e < 8; ++e) z[e] = zt[(8 * tp + e) * 65 + ch];
          *(u32x4*)(ZT + ((size_t)(c0 + ch) * NB + b) * L + t0 + 8 * tp) = pack8(z); }
    }
#undef HP_PREF
}
template <int L>
DI void hy_toeplitz_channel(const Ctx& c, const float* hrow  , const bf16* zsrc  , bf16* ydst  ) {
    constexpr int NBK = L / 32, CP = 2 * L + 8, NT = (NBK + 31) / 32, DMIN = -(NBK - 1), DMAX = NBK - 1;
    LAS unsigned char* F = c.lds;
    LAS unsigned char* Zs = c.lds + 8 * CP * 2;
    LAS unsigned char* R1 = Zs + (8 * NBK + 1) * 80;
    const int lane = c.lane, w = c.wave, h5 = lane >> 5, a = lane & 31, pi = lane & 15, rho = (lane >> 4) & 1;
    __syncthreads();
    for (int g = c.tid; g < (2 * L + 16) / 8; g += 512) { float v[8];
#pragma unroll
        for (int j = 0; j < 8; ++j) { const int y = 8 * g + j; v[j] = (y >= 1 && y <= 2 * L - 1) ? hrow[2 * L - y] : 0.f; }
        *(LAS u32x4*)(R1 + g * 16) = pack8(v); }
    if (c.tid < 20) *(LAS unsigned*)(Zs + 8 * NBK * 80 + 4 * c.tid) = c.z;
    for (int pc = c.tid; pc < 8 * L / 8; pc += 512) { const int bb = pc / (L / 8), pj = pc % (L / 8);
        *(LAS u32x4*)(Zs + (bb * NBK + (pj >> 2)) * 80 + (pj & 3) * 16) = *(const u32x4*)(zsrc + (size_t)bb * L + 8 * pj); }
    __syncthreads();
    for (int g = c.tid; g < 2 * L / 8; g += 512) {
        const u32x4 lo = *(const LAS u32x4*)(R1 + g * 16), hi = *(const LAS u32x4*)(R1 + g * 16 + 16);
        const unsigned Dw[8] = {lo.x, lo.y, lo.z, lo.w, hi.x, hi.y, hi.z, hi.w};
#pragma unroll
        for (int r = 0; r < 8; ++r) { u32x4 o;
            if (r & 1) { o.x = __builtin_amdgcn_alignbit(Dw[r / 2 + 1], Dw[r / 2], 16); o.y = __builtin_amdgcn_alignbit(Dw[r / 2 + 2], Dw[r / 2 + 1], 16);
                         o.z = __builtin_amdgcn_alignbit(Dw[r / 2 + 3], Dw[r / 2 + 2], 16); o.w = __builtin_amdgcn_alignbit(Dw[r / 2 + 4], Dw[r / 2 + 3], 16); }
            else { o.x = Dw[r / 2]; o.y = Dw[r / 2 + 1]; o.z = Dw[r / 2 + 2]; o.w = Dw[r / 2 + 3]; }
            *(LAS u32x4*)(F + (r * CP + 8 * g) * 2) = o; } }
    __syncthreads();
    const int r = (-a) & 7;
    f32x16 acc[NT];
    u32x4 Bf[2][NT][2];
#define HY_BLK(blk_) ((unsigned)(blk_) < (unsigned)NBK ? w * NBK + (blk_) : 8 * NBK)
#pragma unroll
    for (int q = 0; q < NT; ++q) { acc[q] = zero16();
#pragma unroll
        for (int par = 0; par < 2; ++par)
#pragma unroll
            for (int step = 0; step < 2; ++step) Bf[par][q][step] = *(const LAS u32x4*)(Zs + HY_BLK(32 * q + 2 * pi + rho - (DMIN + par)) * 80 + 32 * step + 16 * h5); }
    for (int d0 = DMIN; d0 <= DMAX; d0 += 2) {
#pragma unroll
        for (int par = 0; par < 2; ++par) {
            const int d = d0 + par;
            if (d <= DMAX) {
#pragma unroll
                for (int step = 0; step < 2; ++step) {
                    const int y0 = L - 32 * d - a + 16 * step + 8 * h5;
                    const bf16x8 A = *(const LAS bf16x8*)(F + (r * CP + (y0 - r)) * 2);
#pragma unroll
                    for (int q = 0; q < NT; ++q) if (d >= 32 * q - (NBK - 1) && d <= 32 * q + 31) acc[q] = MFMA32(A, __builtin_bit_cast(bf16x8, Bf[par][q][step]), acc[q]);
                }
#pragma unroll
                for (int q = 0; q < NT; ++q)
#pragma unroll
                    for (int step = 0; step < 2; ++step) {
                        const u32x4 fr = *(const LAS u32x4*)(Zs + HY_BLK(32 * q + rho - (d + 2)) * 80 + 32 * step + 16 * h5); u32x4 nb;
                        nb.x = (unsigned)__builtin_amdgcn_update_dpp((int)fr.x, (int)Bf[par][q][step].x, 0x111, 0xf, 0xf, false);
                        nb.y = (unsigned)__builtin_amdgcn_update_dpp((int)fr.y, (int)Bf[par][q][step].y, 0x111, 0xf, 0xf, false);
                        nb.z = (unsigned)__builtin_amdgcn_update_dpp((int)fr.z, (int)Bf[par][q][step].z, 0x111, 0xf, 0xf, false);
                        nb.w = (unsigned)__builtin_amdgcn_update_dpp((int)fr.w, (int)Bf[par][q][step].w, 0x111, 0xf, 0xf, false);
                        Bf[par][q][step] = nb; }
            }
        }
    }
#undef HY_BLK
#pragma unroll
    for (int q = 0; q < NT; ++q) { const int i = 32 * q + 2 * pi + rho;
        if (i < NBK) {
#pragma unroll
            for (int qq = 0; qq < 4; ++qq) { u32x2 o; o.x = cvt_pk_bf16(acc[q][4 * qq], acc[q][4 * qq + 1]); o.y = cvt_pk_bf16(acc[q][4 * qq + 2], acc[q][4 * qq + 3]);
                *(u32x2*)(ydst + (size_t)w * L + 32 * i + 8 * qq + 4 * h5) = o; } } }
}
DI void phase_hy_toeplitz(const Ctx& c) {
    for (int ch = blockIdx.x; ch < 1024; ch += gridDim.x) {
        hy_toeplitz_channel<SEQ>(c, WSP(float, WS_HF) + (size_t)ch * 4096, WSP(bf16, WS_BIG + BIG_ZTL) + (size_t)ch * NB * SEQ, WSP(bf16, WS_BIG + BIG_YTL) + (size_t)ch * NB * SEQ);
        hy_toeplitz_channel<CTX>(c, WSP(float, WS_HFC) + (size_t)ch * 512, WSP(bf16, WS_BIG + BIG_ZTC) + (size_t)ch * NB * CTX, WSP(bf16, WS_BIG + BIG_YTC) + (size_t)ch * NB * CTX);
    }
}
DI void phase_hy_post(const Ctx& c) {
    const bf16* X0C = WSP(bf16, WS_BIG + BIG_PC); bf16* Y = WSP(bf16, WS_Y); const float* skip = c.in[I_HYSKIP];
    LAS float* tl = (LAS float*)c.lds;
    u32x4 py, pz, px; float psk = 0.f;
#define HQ_PREF(it_) do { int L_, b_, t0_, c0_, rb_; hy_item((it_), L_, b_, t0_, c0_, rb_); \
        const bf16* ZT_ = L_ == SEQ ? WSP(bf16, WS_BIG + BIG_ZTL) : WSP(bf16, WS_BIG + BIG_ZTC); const bf16* YT_ = L_ == SEQ ? WSP(bf16, WS_BIG + BIG_YTL) : WSP(bf16, WS_BIG + BIG_YTC); \
        const int ch_ = c.tid >> 3, tp_ = c.tid & 7; const size_t o_ = ((size_t)(c0_ + ch_) * NB + b_) * L_ + t0_ + 8 * tp_; \
        py = *(const u32x4*)(YT_ + o_); pz = *(const u32x4*)(ZT_ + o_); psk = skip[c0_ + ch_]; \
        px = *(const u32x4*)(X0C + (size_t)(rb_ + t0_ + (c.tid >> 3)) * 1024 + c0_ + 8 * (c.tid & 7)); } while (0)
    if ((int)blockIdx.x < 4608) HQ_PREF((int)blockIdx.x);
    for (int item = blockIdx.x; item < 4608; item += gridDim.x) {
        int L, b, t0, c0, rb; hy_item(item, L, b, t0, c0, rb); (void)L; (void)b;
        lds_barrier();
        { const int ch = c.tid >> 3, tp = c.tid & 7; float y[8], z[8]; unpack8(py, y); unpack8(pz, z); const float sk = psk;
#pragma unroll
          for (int e = 0; e < 8; ++e) tl[ch * 65 + 8 * tp + e] = y[e] + sk * z[e]; }
        const u32x4 xc = px;
        if (item + (int)gridDim.x < 4608) HQ_PREF(item + (int)gridDim.x);
        lds_barrier();
        { const int t = c.tid >> 3, sp = c.tid & 7; float x0[8], o[8]; unpack8(xc, x0);
#pragma unroll
          for (int e = 0; e < 8; ++e) o[e] = x0[e] * tl[(8 * sp + e) * 65 + t];
          *(u32x4*)(Y + (size_t)(rb + t0 + t) * D + c0 + 8 * sp) = pack8(o); }
    }
#undef HQ_PREF
}

DI void phase_route(const Ctx& c, int l) {
    LAS float* rw = (LAS float*)c.lds;
    LAS int* lcnt = (LAS int*)(c.lds + 65536);
    LAS int* rinfo = lcnt + 32;
    LAS float* rwt = (LAS float*)(rinfo + 4 * 128);
    { const f32x4* srcw = (const f32x4*)WSP(float, WS_RWT);
#pragma unroll
      for (int i = 0; i < 8; ++i) *(LAS f32x4*)(rw + 4 * (c.tid + 512 * i)) = srcw[c.tid + 512 * i]; }
    if (c.tid < 16) lcnt[c.tid] = 0;
    __syncthreads();
    const float* MOD = WSP(float, WS_MOD) + (size_t)l * 9 * 6144; const float* g = c.in[I_N2G] + l * D; bf16* H = WSP(bf16, WS_H);
    const bf16* X = WSP(bf16, WS_X); const bf16* XC = WSP(bf16, WS_XC);
    unsigned* cnt = WSP(unsigned, WS_CTL) + CW_CNT + l * 16; int* TOK = WSP(int, WS_TOK); float* TOKW = WSP(float, WS_TOK + 512 * 1024);
    const float rbl = c.lane < 16 ? c.in[I_RB][c.lane] : 0.f;
    const int rlo = (l == 3 ? TC : 0), nrow = TT - rlo, per = (nrow + (int)gridDim.x - 1) / (int)gridDim.x;
    const int brow0 = rlo + (int)blockIdx.x * per, bn = min(per, TT - brow0);
    f32x4 vn[4];
    if (c.wave < bn) { const int row = brow0 + c.wave; load_row_bf(row < TC ? XC + (size_t)row * D : X + (size_t)(row - TC) * D, vn, c.lane); }
    for (int lr = c.wave; lr < bn; lr += 8) {
        const int row = brow0 + lr;
        f32x4 v[4];
#pragma unroll
        for (int j = 0; j < 4; ++j) v[j] = vn[j];
        if (lr + 8 < bn) { const int rn = row + 8; load_row_bf(rn < TC ? XC + (size_t)rn * D : X + (size_t)(rn - TC) * D, vn, c.lane); }
        const int mr = row < TC ? 8 : (row - TC) >> 11;
        norm_row(v, g, c.lane); mod_row(v, MOD + mr * 6144 + 3072, MOD + mr * 6144 + 4096, c.lane);
        store_row_bf16(H + (size_t)row * D, v, c.lane);
        float s16[16];
#pragma unroll
        for (int e = 0; e < 16; ++e) { float s = 0.f;
#pragma unroll
            for (int j = 0; j < 4; ++j) { const f32x4 w = *(const LAS f32x4*)(rw + e * 1024 + 256 * j + 4 * c.lane); s += (v[j].x * w.x + v[j].y * w.y) + (v[j].z * w.z + v[j].w * w.w); }
            s16[e] = s; if ((e & 3) == 3) asm volatile("" ::: "memory"); }
        float s8[8], s4[4], s2[2], s1;
        { const bool up = (c.lane & 32) != 0;
#pragma unroll
          for (int i = 0; i < 8; ++i) { const float keep = up ? s16[8 + i] : s16[i], give = up ? s16[i] : s16[8 + i]; s8[i] = keep + __shfl_xor(give, 32); } }
        { const bool up = (c.lane & 16) != 0;
#pragma unroll
          for (int i = 0; i < 4; ++i) { const float keep = up ? s8[4 + i] : s8[i], give = up ? s8[i] : s8[4 + i]; s4[i] = keep + __shfl_xor(give, 16); } }
        { const bool up = (c.lane & 8) != 0;
#pragma unroll
          for (int i = 0; i < 2; ++i) { const float keep = up ? s4[2 + i] : s4[i], give = up ? s4[i] : s4[2 + i]; s2[i] = keep + __shfl_xor(give, 8); } }
        { const bool up = (c.lane & 4) != 0; const float keep = up ? s2[1] : s2[0], give = up ? s2[0] : s2[1]; s1 = keep + __shfl_xor(give, 4); }
        s1 += __shfl_xor(s1, 2); s1 += __shfl_xor(s1, 1);
        const int eb = c.lane & 15; const int srcl = (((eb >> 3) & 1) << 5) | (((eb >> 2) & 1) << 4) | (((eb >> 1) & 1) << 3) | ((eb & 1) << 2);
        const float sc = sigmoidf_(__shfl(s1, srcl));
        const float sel = sc + rbl;
        float m1 = sel, m2 = -1e30f;
        { const float o1 = __shfl_xor(sel, 1); const float hi = fmaxf(sel, o1), lo = fminf(sel, o1);
          const float ohi = __shfl_xor(hi, 2), olo = __shfl_xor(lo, 2);
          m1 = fmaxf(hi, ohi); m2 = fmaxf(fminf(hi, ohi), fmaxf(lo, olo)); }
        const float gs = m1 + m2;
        const float g0 = __shfl(gs, 0), g1 = __shfl(gs, 4), g2 = __shfl(gs, 8), g3 = __shfl(gs, 12);
        int bg = 0; float bgs = g0; if (g1 > bgs) { bgs = g1; bg = 1; } if (g2 > bgs) { bgs = g2; bg = 2; } if (g3 > bgs) { bgs = g3; bg = 3; }
        float s4b[4], p4b[4];
#pragma unroll
        for (int j = 0; j < 4; ++j) { s4b[j] = __shfl(sel, 4 * bg + j); p4b[j] = __shfl(sc, 4 * bg + j); }
        int i1 = 0; float v1 = s4b[0], q1 = p4b[0];
#pragma unroll
        for (int j = 1; j < 4; ++j) if (s4b[j] > v1) { v1 = s4b[j]; i1 = j; q1 = p4b[j]; }
        int i2 = -1; float v2 = -1e30f, q2 = 0.f;
#pragma unroll
        for (int j = 0; j < 4; ++j) if (j != i1 && s4b[j] > v2) { v2 = s4b[j]; i2 = j; q2 = p4b[j]; }
        if (c.lane == 0) {
            const int e0 = 4 * bg + i1, e1 = 4 * bg + i2;
            const int p0 = __hip_atomic_fetch_add(lcnt + e0, 1, __ATOMIC_RELAXED, __HIP_MEMORY_SCOPE_WORKGROUP), p1 = __hip_atomic_fetch_add(lcnt + e1, 1, __ATOMIC_RELAXED, __HIP_MEMORY_SCOPE_WORKGROUP);
            rinfo[lr * 4 + 0] = e0; rinfo[lr * 4 + 1] = p0; rinfo[lr * 4 + 2] = e1; rinfo[lr * 4 + 3] = p1;
            const float inv = 1.0f / (q1 + q2); rwt[lr * 2] = q1 * inv; rwt[lr * 2 + 1] = q2 * inv;
        }
    }
    __syncthreads();
    if (c.tid < 16) lcnt[16 + c.tid] = (int)atomicAdd(cnt + c.tid, (unsigned)lcnt[c.tid]);
    __syncthreads();
    for (int lr = c.tid; lr < bn; lr += 512) { const int row = brow0 + lr, e0 = rinfo[lr * 4], e1 = rinfo[lr * 4 + 2];
        TOK[row * 4 + 0] = e0; TOK[row * 4 + 1] = lcnt[16 + e0] + rinfo[lr * 4 + 1]; TOK[row * 4 + 2] = e1; TOK[row * 4 + 3] = lcnt[16 + e1] + rinfo[lr * 4 + 3];
        TOKW[row * 2] = rwt[lr * 2]; TOKW[row * 2 + 1] = rwt[lr * 2 + 1]; }
}
DI void slot_bases(const unsigned* cnt, int lane, int e0, int e1, int& b0, int& b1) {
    const unsigned mine = lane < 16 ? ((cnt[lane] + 255u) & ~255u) : 0u; unsigned pb = 0; b0 = 0; b1 = 0;
#pragma unroll
    for (int e = 0; e < 16; ++e) { const unsigned ce = __shfl(mine, e); if (e == e0) b0 = (int)pb; if (e == e1) b1 = (int)pb; pb += ce; }
}
DI void phase_gather(const Ctx& c, int l) {
    const unsigned* cnt = WSP(unsigned, WS_CTL) + CW_CNT + l * 16; const int* TOK = WSP(int, WS_TOK); int* TOKS = WSP(int, WS_TOK + 768 * 1024);
    const bf16* H = WSP(bf16, WS_H); bf16* HS = WSP(bf16, WS_BIG + BIG_HS);
    const unsigned minep = c.lane < 16 ? ((cnt[c.lane] + 255u) & ~255u) : 0u; unsigned pb = 0; int mybase = 0;
#pragma unroll
    for (int e = 0; e < 16; ++e) { const unsigned ce = __shfl(minep, e); if (c.lane == e) mybase = (int)pb; pb += ce; }
    const int rfirst = (l == 3 ? TC : 0) + c.gw, rstep = c.ngw;
    int e0n = 0, p0n = 0, e1n = 0, p1n = 0; u32x4 an = {0u, 0u, 0u, 0u}, bn = an;
    if (rfirst < TT) { e0n = TOK[rfirst * 4]; p0n = TOK[rfirst * 4 + 1]; e1n = TOK[rfirst * 4 + 2]; p1n = TOK[rfirst * 4 + 3];
        an = *(const u32x4*)(H + (size_t)rfirst * D + 8 * c.lane); bn = *(const u32x4*)(H + (size_t)rfirst * D + 512 + 8 * c.lane); }
    for (int row = rfirst; row < TT; row += rstep) {
        const int e0 = e0n, p0 = p0n, e1 = e1n, p1 = p1n; const u32x4 a = an, bq = bn;
        if (row + rstep < TT) { const int r = row + rstep; e0n = TOK[r * 4]; p0n = TOK[r * 4 + 1]; e1n = TOK[r * 4 + 2]; p1n = TOK[r * 4 + 3];
            an = *(const u32x4*)(H + (size_t)r * D + 8 * c.lane); bn = *(const u32x4*)(H + (size_t)r * D + 512 + 8 * c.lane); }
        const int s0 = __shfl(mybase, e0) + p0, s1 = __shfl(mybase, e1) + p1;
        *(u32x4*)(HS + (size_t)s0 * D + 8 * c.lane) = a; *(u32x4*)(HS + (size_t)s0 * D + 512 + 8 * c.lane) = bq;
        *(u32x4*)(HS + (size_t)s1 * D + 8 * c.lane) = a; *(u32x4*)(HS + (size_t)s1 * D + 512 + 8 * c.lane) = bq;
        if (c.lane == 0) { TOKS[row * 2] = s0; TOKS[row * 2 + 1] = s1; }
    }
}
DI LAS int* moe_tiles(const Ctx& c, int l, int nsh) {
    LAS int* tp = (LAS int*)(c.lds + MISC_OFF);
    LAS int* ul = tp + 192;
    __syncthreads();
    if (c.tid < 64) {
        const unsigned* cnt = WSP(unsigned, WS_CTL) + CW_CNT + l * 16;
        const int mine = c.lane < 16 ? (int)((cnt[c.lane] + 255u) >> 8) : 0; int p = 0;
        for (int e = 0; e < 16; ++e) { const int ne = __shfl(mine, e); for (int t = c.lane; t < ne; t += 64) tp[1 + p + t] = e; p += ne; }
        if (c.lane == 0) tp[0] = p;
    }
    __syncthreads();
    if (c.tid < 32) {
        const int i = c.tid, ntile = tp[0], G = gridDim.x, cb = blockIdx.x; int rt = 1 << 20, pn = 0;
        if ((G & 7) == 0 && ((G >> 3) >> nsh) > 0) { const int x = cb & 7, v = cb >> 3, rpx = (G >> 3) >> nsh;
            if (v < (rpx << nsh)) { rt = (i * 8 + x) * rpx + (v >> nsh); pn = v & ((1 << nsh) - 1); } }
        else { const int L = i * G + cb; rt = L >> nsh; pn = L & ((1 << nsh) - 1); }
        ul[i] = rt < ntile ? (rt | (pn << 12) | (tp[1 + rt] << 16)) : -1;
    }
    __syncthreads();
    return ul;
}
DI void phase_combine(const Ctx& c, int l) {
    const float* MOD = WSP(float, WS_MOD) + (size_t)l * 9 * 6144; const int* TOKS = WSP(int, WS_TOK + 768 * 1024); const float* TOKW = WSP(float, WS_TOK + 512 * 1024);
    const bf16* YS = WSP(bf16, WS_BIG + BIG_HS); bf16* X = WSP(bf16, WS_X); bf16* XC = WSP(bf16, WS_XC); bf16* H = WSP(bf16, WS_H);
    const int rfirst = (l == 3 ? TC : 0) + c.gw, rstep = c.ngw;
    int sa0 = 0, sa1 = 0, sb0 = 0, sb1 = 0; float wa0 = 0.f, wa1 = 0.f, wb0 = 0.f, wb1 = 0.f;
    u32x2 dx[4], dy0[4], dy1[4];
#define CB_XP(r_) ((r_) < TC ? XC + (size_t)(r_) * D : X + (size_t)((r_) - TC) * D)
#define CB_LOAD(r_, s0_, s1_) do { const bf16* xq = CB_XP(r_); _Pragma("unroll") for (int j = 0; j < 4; ++j) { dx[j] = *(const u32x2*)(xq + 256 * j + 4 * c.lane); \
        dy0[j] = *(const u32x2*)(YS + (size_t)(s0_) * D + 256 * j + 4 * c.lane); dy1[j] = *(const u32x2*)(YS + (size_t)(s1_) * D + 256 * j + 4 * c.lane); } } while (0)
    if (rfirst < TT) { sa0 = TOKS[rfirst * 2]; sa1 = TOKS[rfirst * 2 + 1]; wa0 = TOKW[rfirst * 2]; wa1 = TOKW[rfirst * 2 + 1]; }
    if (rfirst + rstep < TT) { const int r = rfirst + rstep; sb0 = TOKS[r * 2]; sb1 = TOKS[r * 2 + 1]; wb0 = TOKW[r * 2]; wb1 = TOKW[r * 2 + 1]; }
    if (rfirst < TT) CB_LOAD(rfirst, sa0, sa1);
    for (int row = rfirst; row < TT; row += rstep) {
        const int mr = row < TC ? 8 : (row - TC) >> 11; bf16* xp = CB_XP(row);
        const float w0 = wa0, w1 = wa1;
        f32x4 v[4], ya[4], yb[4];
#pragma unroll
        for (int j = 0; j < 4; ++j) {
            v[j] = (f32x4){__uint_as_float(dx[j].x << 16), __uint_as_float(dx[j].x & 0xffff0000u), __uint_as_float(dx[j].y << 16), __uint_as_float(dx[j].y & 0xffff0000u)};
            ya[j] = (f32x4){__uint_as_float(dy0[j].x << 16), __uint_as_float(dy0[j].x & 0xffff0000u), __uint_as_float(dy0[j].y << 16), __uint_as_float(dy0[j].y & 0xffff0000u)};
            yb[j] = (f32x4){__uint_as_float(dy1[j].x << 16), __uint_as_float(dy1[j].x & 0xffff0000u), __uint_as_float(dy1[j].y << 16), __uint_as_float(dy1[j].y & 0xffff0000u)}; }
        sa0 = sb0; sa1 = sb1; wa0 = wb0; wa1 = wb1;
        if (row + 2 * rstep < TT) { const int r = row + 2 * rstep; sb0 = TOKS[r * 2]; sb1 = TOKS[r * 2 + 1]; wb0 = TOKW[r * 2]; wb1 = TOKW[r * 2 + 1]; }
        if (row + rstep < TT) CB_LOAD(row + rstep, sa0, sa1);
#pragma unroll
        for (int j = 0; j < 4; ++j) v[j] = v[j] + *(const f32x4*)(MOD + mr * 6144 + 5120 + 256 * j + 4 * c.lane) * (ya[j] * w0 + yb[j] * w1);
        if (l < 3) store_row_bf16(xp, v, c.lane);
        if (l < 3) {
            const float* MODn = WSP(float, WS_MOD) + (size_t)(l + 1) * 9 * 6144;
            norm_row(v, c.in[I_N1G] + (l + 1) * D, c.lane); mod_row(v, MODn + mr * 6144, MODn + mr * 6144 + 1024, c.lane);
            store_row_bf16(H + (size_t)hrow_of(row, (l + 1) % 3) * D, v, c.lane);
        } else {
            norm_row(v, c.in[I_FING], c.lane);
            float* o = c.out + (size_t)(row - TC) * D;
#pragma unroll
            for (int j = 0; j < 4; ++j) *(f32x4*)(o + 256 * j + 4 * c.lane) = v[j];
        }
    }
#undef CB_LOAD
#undef CB_XP
}

DI void ctx_outproj_mini(const Ctx& c, const bf16* Yc, const bf16* Wt, const float* xs_c  , bf16* XC, const float* modc  , const float* bias) {
    const int lane = c.lane, h5 = lane >> 5, l31 = lane & 31;
    for (int tile = blockIdx.x; tile < 256; tile += gridDim.x) {
        const int m0 = 64 * (tile >> 3) + 32 * (c.wave >> 2), n0 = 128 * (tile & 7) + 32 * (c.wave & 3);
        const bf16* ap = Yc + (size_t)(m0 + l31) * 1024 + 8 * h5; const bf16* bp = Wt + (size_t)(n0 + l31) * 1024 + 8 * h5;
        const int row = m0 + l31;
        float xo[4][4]; f32x4 g1[4], bb[4];
#pragma unroll
        for (int q = 0; q < 4; ++q) { const int col = n0 + 8 * q + 4 * h5; const size_t o = (size_t)row * D + col;
            if (xs_c) { const f32x4 t = *(const f32x4*)(xs_c + o); xo[q][0] = t.x; xo[q][1] = t.y; xo[q][2] = t.z; xo[q][3] = t.w; }
            else { const u32x2 t = *(const u32x2*)(XC + o); xo[q][0] = __uint_as_float(t.x << 16); xo[q][1] = __uint_as_float(t.x & 0xffff0000u); xo[q][2] = __uint_as_float(t.y << 16); xo[q][3] = __uint_as_float(t.y & 0xffff0000u); }
            g1[q] = *(const f32x4*)(modc + 2048 + col); bb[q] = bias ? *(const f32x4*)(bias + col) : (f32x4){0.f, 0.f, 0.f, 0.f}; }
        f32x16 acc = zero16();
        bf16x8 afA[4], wfA[4], afB[4], wfB[4];
#define MINI_LD(af, wf, k0_) do { _Pragma("unroll") for (int s = 0; s < 4; ++s) { af[s] = *(const bf16x8*)(ap + (k0_) + 16 * s); wf[s] = *(const bf16x8*)(bp + (k0_) + 16 * s); } } while (0)
#define MINI_MM(af, wf) do { _Pragma("unroll") for (int s = 0; s < 4; ++s) acc = MFMA32(wf[s], af[s], acc); } while (0)
        MINI_LD(afA, wfA, 0); MINI_LD(afB, wfB, 64);
#pragma unroll 1
        for (int k0 = 0; k0 < 1024; k0 += 128) {
            MINI_MM(afA, wfA); if (k0 + 128 < 1024) MINI_LD(afA, wfA, k0 + 128);
            MINI_MM(afB, wfB); if (k0 + 192 < 1024) MINI_LD(afB, wfB, k0 + 192);
        }
#undef MINI_LD
#undef MINI_MM
#pragma unroll
        for (int q = 0; q < 4; ++q) { const int col = n0 + 8 * q + 4 * h5; const size_t o = (size_t)row * D + col;
            u32x2 w; w.x = cvt_pk_bf16(xo[q][0] + g1[q].x * (acc[4 * q] + bb[q].x), xo[q][1] + g1[q].y * (acc[4 * q + 1] + bb[q].y));
            w.y = cvt_pk_bf16(xo[q][2] + g1[q].z * (acc[4 * q + 2] + bb[q].z), xo[q][3] + g1[q].w * (acc[4 * q + 3] + bb[q].w));
            *(u32x2*)(XC + o) = w; }
    }
}

#define XB_TMO      128
#define XB_XCNT(j)  (256  + 64 * (j))
#define XB_XSUB(j)  (1280 + 64 * (j))
#define XB_XGEN(j)  (2304 + 64 * (j))
#define XB_TOP      3328
#define XB_TOPGEN   3392
#define XCD_BAR_WORDS 3456
#define XB_SPIN_CAP (1u << 18)
DI unsigned xb_ld(unsigned* p)              { return __hip_atomic_load(p, __ATOMIC_RELAXED, __HIP_MEMORY_SCOPE_AGENT); }
DI unsigned xb_add(unsigned* p, unsigned v) { return __hip_atomic_fetch_add(p, v, __ATOMIC_RELAXED, __HIP_MEMORY_SCOPE_AGENT); }
DI unsigned xb_xcc_id() { return (unsigned)__builtin_amdgcn_s_getreg((3 << 11) | 20) & 0xFu; }
#define XB_SPIN(cond, bar) do { unsigned _sp = 0; while (cond) { __builtin_amdgcn_s_sleep(1); \
    if ((++_sp & 255u) == 0u) { if (xb_ld(&(bar)[XB_TMO])) break; if (_sp > XB_SPIN_CAP) { atomicAdd(&(bar)[XB_TMO], 1u); break; } } } } while (0)
DI void xcd_barrier_complete(unsigned* bar, unsigned x, unsigned& nloc, unsigned& nx) {
    const unsigned G = gridDim.x * gridDim.y * gridDim.z;
    unsigned sum, cnt, mine, sp = 0u;
    for (;;) {
        sum = 0u; cnt = 0u; mine = 0u;
#pragma unroll
        for (unsigned j = 0; j < 16; ++j) { const unsigned cj = xb_ld(&bar[XB_XCNT(j)]); sum += cj; cnt += (cj > 0u) ? 1u : 0u; mine = (j == x) ? cj : mine; }
        if (sum == G) break;
        __builtin_amdgcn_s_sleep(1);
        if ((++sp & 255u) == 0u) { if (xb_ld(&bar[XB_TMO])) break; if (sp > XB_SPIN_CAP) { atomicAdd(&bar[XB_TMO], 1u); break; } }
    }
    nloc = mine > 0u ? mine : 1u; nx = cnt > 0u ? cnt : 1u;
}
DI void xcd_barrier(unsigned* bar, volatile LAS unsigned* st) {
    asm volatile("s_waitcnt vmcnt(0)" ::: "memory");
    __syncthreads();
    if (threadIdx.x == 0) {
        const unsigned x = xb_xcc_id();
        __builtin_amdgcn_s_waitcnt(0);
        unsigned nloc = st[0], nx = st[1];
        if (nloc == 0u) { xcd_barrier_complete(bar, x, nloc, nx); st[0] = nloc; st[1] = nx; }
        const unsigned old = xb_add(&bar[XB_XSUB(x)], 1u);
        const unsigned gen = old / nloc;
        if (old + 1u == (gen + 1u) * nloc) {
            __builtin_amdgcn_fence(__ATOMIC_RELEASE, "agent");
            asm volatile("s_waitcnt vmcnt(0)" ::: "memory");
            const unsigned og = xb_add(&bar[XB_TOP], 1u);
            const unsigned tg = og / nx;
            if (og + 1u == (tg + 1u) * nx) xb_add(&bar[XB_TOPGEN], 1u);
            else XB_SPIN(xb_ld(&bar[XB_TOPGEN]) == tg, bar);
            __builtin_amdgcn_fence(__ATOMIC_ACQUIRE, "agent");
            xb_add(&bar[XB_XGEN(x)], 1u);
            asm volatile("s_waitcnt vmcnt(0)" ::: "memory");
        } else {
            XB_SPIN(xb_ld(&bar[XB_XGEN(x)]) == gen, bar);
            __builtin_amdgcn_fence(__ATOMIC_ACQUIRE, "agent");
            asm volatile("s_waitcnt vmcnt(0)" ::: "memory");
        }
    }
    __syncthreads();
}

constexpr int NPHASE = 2 + 11 * DEPTH;
__host__ __device__ inline bool phase_active(int ph) {
    if (ph < 2) return true;
    const int l = (ph - 2) / 11, s = (ph - 2) % 11, kind = l % 3;
    if (s == 0) return false;
    if (s == 4) return kind != 2 || HY_MFMA;
    return true;
}
DI void run_phase(const Ctx& c, int ph) {
    if (ph == 0) { if constexpr (PH_EN(0)) phase_pro0(c); return; }
    if (ph == 1) { if constexpr (PH_EN(1)) { phase_pro1(c); phase_norm1(c, 0, c.in[I_X], c.in[I_CTX]); } return; }
    const int l = (ph - 2) / 11, s = (ph - 2) % 11, kind = l % 3, j = l / 3;
    switch (s) {
    case 0: if constexpr (PH_EN(2)) phase_norm1(c, 0, c.in[I_X], c.in[I_CTX]); break;
    case 1: if constexpr (PH_EN(3)) {
        DenseOrder S; EpiInproj E; E.P = WSP(bf16, WS_P); E.extra = WSP(float, WS_EXTRA); E.bias = nullptr; E.bias_x = nullptr;
        S.A = WSP(bf16, WS_H); S.ul = dense_units(c.lds, c.tid, TT, kind == 2 ? 3072 : NINP);
        if (kind == 0) { S.Bt = WSP(bf16, WS_ML_WIN) + (size_t)j * NINP * 1024; E.bias_x = c.in[I_MLBG] + j * 32; }
        else if (kind == 1) { S.Bt = WSP(bf16, WS_GLA_WIN); }
        else { S.Bt = WSP(bf16, WS_HY_WIN); E.bias = c.in[I_HYBIN]; }
        gemm_run(c.lds, c.tid, S, E);
    } break;
    case 2: if constexpr (PH_EN(4))
        if (kind == 0) phase_conv(c, 1024, c.in[I_MLCW] + j * 3 * 1024, c.in[I_MLCB] + j * 1024, true, 0.125f);
        else if (kind == 1) { phase_conv(c, 2048, c.in[I_GLCW], c.in[I_GLCB], true, 0.08838834764831845f); if constexpr (GLA_CHUNK) phase_gla_decay(c); }
        else { if constexpr (HY_MFMA) phase_hy_prep(c); else phase_conv(c, 3072, c.in[I_HYCW], c.in[I_HYCB], false, 1.0f); }
        break;
    case 3: if constexpr (PH_EN(5))
        if (kind == 0) { if constexpr (MLSTM_CHUNK) phase_mlstm_state(c); else phase_mlstm_scan_naive(c); }
        else if (kind == 1) { if constexpr (GLA_CHUNK) phase_gla_state(c); else phase_gla_scan_naive(c); }
        else { if constexpr (HY_MFMA) phase_hy_toeplitz(c); else phase_hyena_conv_naive(c); }
        break;
    case 4: if constexpr (PH_EN(6))
        if (kind == 0) { if constexpr (MLSTM_CHUNK) phase_mlstm_out(c, c.in[I_MLNG] + j * 1024); else phase_headnorm(c, 128, c.in[I_MLNG] + j * 1024); }
        else if (kind == 1) { if constexpr (GLA_CHUNK) phase_gla_out(c, c.in[I_GLNG]); else phase_headnorm(c, 256, c.in[I_GLNG]); }
        else { if constexpr (HY_MFMA) phase_hy_post(c); }
        break;
    case 5: if constexpr (PH_EN(7)) {
        DenseOrder S; EpiOutproj E; E.X = WSP(bf16, WS_X); E.XC = WSP(bf16, WS_XC); E.mod = WSP(float, WS_MOD) + (size_t)l * 9 * 6144; E.bias = nullptr; E.perm = (kind == 1);
        E.xs_l = (l == 0) ? c.in[I_X] : nullptr; E.xs_c = (l == 0) ? c.in[I_CTX] : nullptr; E.row_off = TC;
        const bf16* W = kind == 0 ? WSP(bf16, WS_ML_WOUT) + (size_t)j * 1024 * 1024 : kind == 1 ? WSP(bf16, WS_GLA_WOUT) : WSP(bf16, WS_HY_WOUT);
        if (kind == 2) E.bias = c.in[I_HYBOUT];
        S.A = WSP(bf16, WS_Y) + (size_t)E.row_off * D; S.Bt = W; S.ul = dense_units(c.lds, c.tid, TT - E.row_off, 1024);
        gemm_run(c.lds, c.tid, S, E);
        if (l < 3) ctx_outproj_mini(c, WSP(bf16, WS_Y), W, E.xs_c, WSP(bf16, WS_XC), E.mod + 8 * 6144, E.bias);
    } break;
    case 6: if constexpr (PH_EN(8)) phase_route(c, l); break;
    case 7: if constexpr (PH_EN(9)) phase_gather(c, l); break;
    case 8: if constexpr (PH_EN(10)) {
        MoeOrder S; S.ul = moe_tiles(c, l, 3); S.A = WSP(bf16, WS_BIG + BIG_HS); S.Bt = WSP(bf16, WS_EXP_UP) + (size_t)l * 16 * 2048 * 1024; S.bstride = (size_t)2048 * 1024;
        EpiUp E; E.ACT = WSP(bf16, WS_BIG + BIG_ACT);
        gemm_run(c.lds, c.tid, S, E);
    } break;
    case 9: if constexpr (PH_EN(11)) {
        MoeOrder S; S.ul = moe_tiles(c, l, 2); S.A = WSP(bf16, WS_BIG + BIG_ACT); S.Bt = WSP(bf16, WS_EXP_DN) + (size_t)l * 16 * 1024 * 1024; S.bstride = (size_t)1024 * 1024;
        EpiDown E; E.YS = WSP(bf16, WS_BIG + BIG_HS);
        gemm_run(c.lds, c.tid, S, E);
    } break;
    case 10: if constexpr (PH_EN(12)) phase_combine(c, l); break;
    }
}

__global__ void __launch_bounds__(512, 2) mega_fwd(Params p) {
    extern __shared__ __attribute__((aligned(16))) unsigned char lds_raw[];
#if XCD_BARRIER
    {
        volatile LAS unsigned* st0 = (volatile LAS unsigned*)((LAS unsigned char*)lds_raw + BAR_LDS_OFF);
        if (threadIdx.x == 0) { st0[0] = 0u; st0[1] = 0u; (void)xb_add((unsigned*)(p.ws + WS_CTL) + CW_BAR + XB_XCNT(xb_xcc_id()), 1u); }
        __syncthreads();
    }
#endif
    bool first = true;
    int rep = 0;
    unsigned long long tp_acc = 0, tp_prev = 0; bool tp_sel = false;
    for (int ph = p.ph_lo; ph < p.ph_hi;) {
        if (!phase_active(ph)) { ++ph; continue; }
        int z; asm volatile("s_mov_b32 %0, 0" : "=s"(z));
        if (!first) {
#if XCD_BARRIER
            xcd_barrier((unsigned*)(p.ws + z + WS_CTL) + CW_BAR, (volatile LAS unsigned*)((LAS unsigned char*)lds_raw + BAR_LDS_OFF));
#else
            cg::this_grid().sync();
#endif
        }
        first = false;
        Ctx c;
        c.lds = (LAS unsigned char*)lds_raw;
        c.tid = threadIdx.x + z; c.lane = c.tid & 63; c.wave = __builtin_amdgcn_readfirstlane(c.tid >> 6);
        c.gw = blockIdx.x * 8 + c.wave; c.ngw = gridDim.x * 8;
        c.in = (const float* const __attribute__((address_space(4)))*)__builtin_amdgcn_kernarg_segment_ptr() + z; c.out = p.out + z; c.ws = p.ws + z; c.z = (unsigned)z;
        if (TP_MASK != 0u) {
            const unsigned long long now = __builtin_amdgcn_s_memrealtime();
            if (tp_sel) tp_acc += now - tp_prev;
            tp_prev = now; tp_sel = (ph >= 2 ? (((TP_MASK >> ((ph - 2) % 11)) & 1u) && ((TP_LAYERS >> ((ph - 2) / 11)) & 1u)) : ((TP_MASK >> (16 + ph)) & 1u));
        }
        run_phase(c, ph);
        if (REP_MASK != 0u && rep == 0 && (ph >= 2 ? (((REP_MASK >> ((ph - 2) % 11)) & 1u) && ((REP_LAYERS >> ((ph - 2) / 11)) & 1u)) : ((REP_MASK >> (16 + ph)) & 1u))) rep = 1; else { rep = 0; ++ph; }
    }
    if (TP_MASK != 0u && blockIdx.x == 0) { asm volatile("s_waitcnt vmcnt(0)" ::: "memory"); __syncthreads(); const unsigned long long now = __builtin_amdgcn_s_memrealtime(); if (tp_sel) tp_acc += now - tp_prev;
        const unsigned long long t_end = now + (unsigned long long)TP_AMP * tp_acc; while (__builtin_amdgcn_s_memrealtime() < t_end) __builtin_amdgcn_s_sleep(8); }
}

extern "C" void kernel_launch(void* const* d_in, const int* in_sizes, int n_in, void* d_out, int out_size, void* d_ws, size_t ws_size, hipStream_t stream) {
    static int grid = 0;
    if (grid == 0) {
        if (n_in != 40 || ws_size < WS_END || out_size != TL * D) { fprintf(stderr, "kernel_launch: unexpected shapes (n_in %d, ws %zu, out %d)\n", n_in, ws_size, out_size); grid = -1; return; }
        int dev = 0, cus = 0, per_cu = 0;
        hipGetDevice(&dev); hipDeviceGetAttribute(&cus, hipDeviceAttributeMultiprocessorCount, dev);
        if (hipFuncSetAttribute((const void*)mega_fwd, hipFuncAttributeMaxDynamicSharedMemorySize, LDS_BYTES) != hipSuccess) { fprintf(stderr, "kernel_launch: hipFuncSetAttribute failed\n"); grid = -1; return; }
        if (hipOccupancyMaxActiveBlocksPerMultiprocessor(&per_cu, (const void*)mega_fwd, 512, LDS_BYTES) != hipSuccess || per_cu < 1) { fprintf(stderr, "kernel_launch: occupancy query says %d\n", per_cu); per_cu = 1; }
        (void)hipGetLastError();
        grid = cus;
        fprintf(stderr, "kernel_launch: grid %d (cus %d, per_cu %d)\n", grid, cus, per_cu);
    }
    if (grid < 0) return;
    hipMemsetAsync((char*)d_ws + WS_CTL, 0, 1 * MiB, stream);
    Params p{};
    for (int i = 0; i < 40; ++i) p.in[i] = (const float*)d_in[i];
    p.out = (float*)d_out; p.ws = (unsigned char*)d_ws;
#if N_LAUNCH_PER_PHASE
    for (int ph = 0; ph < NPHASE; ++ph) {
        if (!phase_active(ph)) continue;
        p.ph_lo = ph; p.ph_hi = ph + 1; void* args[] = {&p};
        hipError_t e = hipLaunchCooperativeKernel((const void*)mega_fwd, dim3(grid), dim3(512), args, LDS_BYTES, stream);
        if (e != hipSuccess) { fprintf(stderr, "launch failed: %s\n", hipGetErrorString(e)); break; }
    }
#else
    p.ph_lo = 0; p.ph_hi = NPHASE; void* args[] = {&p};
    hipError_t e = hipLaunchCooperativeKernel((const void*)mega_fwd, dim3(grid), dim3(512), args, LDS_BYTES, stream);
    if (e != hipSuccess) fprintf(stderr, "cooperative launch failed: %s (grid %d)\n", hipGetErrorString(e), grid);
#endif
}
```

```cpp
#include <hip/hip_runtime.h>
#include <hip/hip_cooperative_groups.h>
#include <cstdio>
#include <cstdint>
namespace cg = cooperative_groups;

#define LAS __attribute__((address_space(3)))
#define DI __device__ __forceinline__
typedef unsigned short bf16;
typedef float f32x4 __attribute__((ext_vector_type(4)));
typedef float f32x2 __attribute__((ext_vector_type(2)));
typedef unsigned u32x4 __attribute__((ext_vector_type(4)));
typedef unsigned u32x2 __attribute__((ext_vector_type(2)));
typedef short bf16x8 __attribute__((ext_vector_type(8)));

#ifndef FAST_GEMM
#define FAST_GEMM 1
#endif
#ifndef MLSTM_CHUNK
#define MLSTM_CHUNK 1
#endif
#ifndef GLA_CHUNK
#define GLA_CHUNK 1
#endif
#ifndef HY_MFMA
#define HY_MFMA 1
#endif
#ifndef XCD_BARRIER
#define XCD_BARRIER 1
#endif
#ifndef PH_MASK
#define PH_MASK 0xFFFFFFFFu
#endif
#define PH_EN(b) ((PH_MASK >> (b)) & 1u)
#ifndef TP_MASK
#define TP_MASK 0u
#endif
#ifndef TP_LAYERS
#define TP_LAYERS 0xFu
#endif
#define TP_AMP 4
#ifndef REP_LAYERS
#define REP_LAYERS 0xFu
#endif
#ifndef REP_MASK
#define REP_MASK 0u
#endif
#ifndef N_LAUNCH_PER_PHASE
#define N_LAUNCH_PER_PHASE 0
#endif

constexpr int D = 1024, NB = 8, SEQ = 2048, CTX = 256, DEPTH = 4;
constexpr int TC = NB * CTX, TL = NB * SEQ, TT = TC + TL;
constexpr int NEXP = 16;
constexpr int PLD = 3072;
constexpr int NINP = 3328;
constexpr float EPS = 1e-6f;
constexpr int MAXSLOT = 40960;

constexpr size_t MiB = 1u << 20;
constexpr size_t WS_CTL = 0;
constexpr size_t WS_MOD = 1 * MiB;
constexpr size_t WS_HM = 2 * MiB;
constexpr size_t WS_TOK = 3 * MiB;
constexpr size_t WS_RWT = 3 * MiB + 944 * 1024;
constexpr size_t WS_HF = 4 * MiB;
constexpr size_t WS_HFC = 20 * MiB;
constexpr size_t WS_ML_WIN = 32 * MiB;
constexpr size_t WS_ML_WOUT = 45 * MiB;
constexpr size_t WS_GLA_WIN = 49 * MiB;
constexpr size_t WS_GLA_WOUT = 56 * MiB;
constexpr size_t WS_HY_WIN = 58 * MiB;
constexpr size_t WS_HY_WOUT = 64 * MiB;
constexpr size_t WS_EXP_UP = 66 * MiB;
constexpr size_t WS_EXP_DN = 322 * MiB;
constexpr size_t WS_X = 450 * MiB;
constexpr size_t WS_XC = 514 * MiB;
constexpr size_t WS_H = 522 * MiB;
constexpr size_t WS_P = 558 * MiB;
constexpr size_t WS_EXTRA = 667 * MiB;
constexpr size_t WS_Y = 670 * MiB;
constexpr size_t WS_BIG = 706 * MiB;
constexpr size_t WS_END = 1024 * MiB;
constexpr size_t BIG_HS = 0;
constexpr size_t BIG_ACT = 80 * MiB;
constexpr size_t BIG_PC = 0;
constexpr size_t BIG_YF = 108 * MiB;
constexpr size_t BIG_YB = 180 * MiB;

constexpr size_t BIG_MCT = 108 * MiB;
constexpr size_t BIG_MN = 180 * MiB;

constexpr size_t BIG_GB = 72 * MiB;
constexpr size_t BIG_GST = 144 * MiB;

constexpr size_t BIG_ZTL = 108 * MiB;
constexpr size_t BIG_ZTC = 140 * MiB;
constexpr size_t BIG_YTL = 144 * MiB;
constexpr size_t BIG_YTC = 176 * MiB;

constexpr int CW_CNT = 1024;
constexpr int CW_BAR = 4096;

constexpr int LDS_BYTES = 148480;
constexpr int BAR_LDS_OFF = 147456;
constexpr int MISC_OFF = 131072;

struct Params {
    const float* in[40];
    float* out;
    unsigned char* ws;
    int ph_lo, ph_hi;
};
static_assert(__builtin_offsetof(Params, in) == 0, "the input pointer table must be the first kernel argument bytes");
enum { I_X = 0, I_C, I_CTX, I_CCTX, I_ADAW, I_ADAB, I_N1G, I_N2G, I_FING, I_MLWIN, I_MLBG, I_MLCW, I_MLCB, I_MLNG, I_MLWOUT,
       I_GLWIN, I_GLCW, I_GLCB, I_GLW2, I_GLGB, I_GLNG, I_GLWOUT, I_HYWIN, I_HYBIN, I_HYCW, I_HYCB, I_HYFW1, I_HYFB1, I_HYFWM, I_HYFBM,
       I_HYFWO, I_HYFREQ, I_HYSKIP, I_HYWOUT, I_HYBOUT, I_RW, I_RB, I_EW1, I_EW3, I_EW2 };

DI float bf2f(bf16 v) { return __uint_as_float(((unsigned)v) << 16); }
typedef __bf16 b16x2_t __attribute__((ext_vector_type(2)));
DI unsigned cvt_pk_bf16(float lo, float hi) { const f32x2 v = {lo, hi}; const b16x2_t r = __builtin_convertvector(v, b16x2_t); return __builtin_bit_cast(unsigned, r); }
DI bf16 f2bf(float f) { return (bf16)(cvt_pk_bf16(f, 0.f) & 0xffffu); }
DI float sigmoidf_(float x) { return 1.0f / (1.0f + __expf(-x)); }
DI float siluf_(float x) { return x / (1.0f + __expf(-x)); }
DI float logsigf_(float x) { return fminf(x, 0.f) - __logf(1.0f + __expf(-fabsf(x))); }
DI void lds_barrier() { asm volatile("s_waitcnt lgkmcnt(0)" ::: "memory"); __builtin_amdgcn_s_barrier(); asm volatile("" ::: "memory"); }
DI float wave_sum(float v) {
#pragma unroll
    for (int o = 1; o < 64; o <<= 1) v += __shfl_xor(v, o);
    return v;
}
DI void unpack8(const u32x4 w, float (&v)[8]) {
    v[0] = __uint_as_float(w.x << 16); v[1] = __uint_as_float(w.x & 0xffff0000u);
    v[2] = __uint_as_float(w.y << 16); v[3] = __uint_as_float(w.y & 0xffff0000u);
    v[4] = __uint_as_float(w.z << 16); v[5] = __uint_as_float(w.z & 0xffff0000u);
    v[6] = __uint_as_float(w.w << 16); v[7] = __uint_as_float(w.w & 0xffff0000u);
}
DI u32x4 pack8(const float (&v)[8]) { u32x4 w; w.x = cvt_pk_bf16(v[0], v[1]); w.y = cvt_pk_bf16(v[2], v[3]); w.z = cvt_pk_bf16(v[4], v[5]); w.w = cvt_pk_bf16(v[6], v[7]); return w; }
DI void seq_bounds(int row, int& lo, int& hi) {
    if (row < TC) { lo = row & ~(CTX - 1); hi = lo + CTX - 1; } else { lo = TC + ((row - TC) & ~(SEQ - 1)); hi = lo + SEQ - 1; }
}
DI int perm_fwd(int s) { return (s & 63) * 32 + (s >> 6); }
DI int perm_inv(int sp) { return (sp & 31) * 64 + (sp >> 5); }

namespace pg8 {
constexpr int BM = 256, BK = 64, HALF = 128, HTB = HALF * BK * 2, STAGE_BYTES = 8 * HTB, NXCD = 8, WGM = 8;
__host__ __device__ __forceinline__ int lds_byte(int r, int c) { const int st = (r >> 4) * 2 + (c >> 5), rr = r & 15, cc = c & 31, ob = rr * 64 + cc * 2; return st * 1024 + (ob ^ (((ob >> 9) & 1) << 5)); }
__host__ __device__ __forceinline__ void stage_rc(int b, int& R, int& C) { const int st = b / 1024, sb = b % 1024, swz = sb ^ (((sb >> 9) & 1) << 5); R = (st >> 1) * 16 + swz / 64; C = (st & 1) * 32 + (swz % 64) / 2; }
__host__ __device__ __forceinline__ int perm32(int rho) { const int n = rho >> 4, i = rho & 15; return 8 * (i >> 2) + 4 * n + (i & 3); }
}
struct Unit { int pm, pn, e; };

DI LAS int* dense_units(LAS unsigned char* lds, int tid, int M, int N) {
    LAS int* ul = (LAS int*)(lds + MISC_OFF) + 192;
    __syncthreads();
    if (tid < 32) {
        const int nM = M / 256, nN = N / 256, nwg = nM * nN, G = gridDim.x, L = tid * G + (int)blockIdx.x; int w = -1;
        if (L < nwg) {
            int wgid = L; { const int q = nwg / 8, r = nwg % 8, xcd = wgid % 8, off = wgid / 8; wgid = (xcd < r ? xcd * (q + 1) : r * (q + 1) + (xcd - r) * q) + off; }
            const int nig = 8 * nN, gid = wgid / nig, fm = gid * 8, gsz = (nM - fm) < 8 ? (nM - fm) : 8;
            w = (fm + ((wgid % nig) % gsz)) | (((wgid % nig) / gsz) << 12);
        }
        ul[tid] = w;
    }
    __syncthreads();
    return ul;
}
struct DenseOrder {
    const bf16* A; const bf16* Bt; const LAS int* ul;
    DI bool next(int i, Unit& u) const {
        const int w = __builtin_amdgcn_readfirstlane(ul[i]); if (w < 0) return false;
        u.pm = w & 0xfff; u.pn = (w >> 12) & 0xf; u.e = 0; return true;
    }
    DI const bf16* aptr(const Unit& u) const { return A + (size_t)u.pm * 256 * 1024; }
    DI const bf16* bptr(const Unit& u) const { return Bt + (size_t)u.pn * 256 * 1024; }
};
struct MoeOrder {
    const bf16* A; const bf16* Bt; size_t bstride; const LAS int* ul;
    DI bool next(int i, Unit& u) const {
        const int w = __builtin_amdgcn_readfirstlane(ul[i]); if (w < 0) return false;
        u.pm = w & 0xfff; u.pn = (w >> 12) & 0xf; u.e = w >> 16; return true;
    }
    DI const bf16* aptr(const Unit& u) const { return A + (size_t)u.pm * 256 * 1024; }
    DI const bf16* bptr(const Unit& u) const { return Bt + (size_t)u.e * bstride + (size_t)u.pn * 256 * 1024; }
};

struct EpiInproj {
    static constexpr bool PAIR = false, BATCHED = false;
    bf16* P; float* extra; const float* bias; const float* bias_x;
    DI void row8(const Unit& u, int r, int c, const float (&v)[8]) const {
        const int row = u.pm * 256 + r, col = u.pn * 256 + c;
        if (col < PLD) {
            float w[8];
#pragma unroll
            for (int j = 0; j < 8; ++j) w[j] = v[j] + (bias ? bias[col + j] : 0.f);
            *(u32x4*)(P + (size_t)row * PLD + col) = pack8(w);
        } else if (col < PLD + 32) {
            float* o = extra + (size_t)row * 32 + (col - PLD);
#pragma unroll
            for (int j = 0; j < 8; ++j) o[j] = v[j] + (bias_x ? bias_x[col - PLD + j] : 0.f);
        }
    }
};
struct EpiOutproj {
    static constexpr bool PAIR = false, BATCHED = true;
    const float* xs_l; const float* xs_c; bf16* X; bf16* XC; const float* mod; const float* bias; int row_off; int perm;
    DI size_t off(const Unit& u, int r, int col) const {
        const int rr = u.pm * 256 + r + row_off - TC, b = rr >> 11, sp = rr & (SEQ - 1), s = perm ? perm_inv(sp) : sp; return ((size_t)b * SEQ + s) * D + col; }
    DI void tile(const f32x4 (&acc)[2][2][4][2], const Unit& u, int wr, int wc, int fr, int fq) const {
        const int b = (u.pm * 256 + row_off - TC) >> 11; const float* g1p = mod + b * 6144 + 2048;
        const int rr0 = u.pm * 256 + row_off - TC, sp0 = rr0 & (SEQ - 1);
        const int d_ai = perm ? 4 : 128, d_m1 = perm ? 1024 : 16, d_m2 = perm ? 1 : 32;
        const unsigned voff = (unsigned)((perm ? fr * 64 + wr * 2 : wr * 64 + fr) * D + wc * 32 + 8 * fq);
        const size_t ubase = ((size_t)b * SEQ + (perm ? (sp0 >> 5) : sp0)) * D + u.pn * 256;
#define OPJ_OFF(bj_, ai_, m_) ((size_t)((ai_) * d_ai + ((m_) & 1) * d_m1 + ((m_) >> 1) * d_m2) * D + (bj_) * 128)
#pragma unroll
        for (int bj = 0; bj < 2; ++bj) {
            char* Xu = (char*)(X + ubase); float g1[8], bs[8];
            if (xs_l) {
                const char* Su = (const char*)(xs_l + ubase); f32x4 rf[2][4][2];
#pragma unroll
                for (int ai = 0; ai < 2; ++ai)
#pragma unroll
                    for (int m = 0; m < 4; ++m) { const char* p = Su + OPJ_OFF(bj, ai, m) * 4 + voff * 4u; rf[ai][m][0] = *(const f32x4*)p; rf[ai][m][1] = *(const f32x4*)(p + 16); }
                { const int col = u.pn * 256 + bj * 128 + wc * 32 + 8 * fq;
#pragma unroll
                    for (int j = 0; j < 8; ++j) { g1[j] = g1p[col + j]; bs[j] = bias ? bias[col + j] : 0.f; } }
#pragma unroll
                for (int ai = 0; ai < 2; ++ai)
#pragma unroll
                    for (int m = 0; m < 4; ++m) { float w[8];
#pragma unroll
                        for (int j = 0; j < 8; ++j) w[j] = rf[ai][m][j >> 2][j & 3] + g1[j] * (acc[ai][bj][m][j >> 2][j & 3] + bs[j]);
                        *(u32x4*)(Xu + OPJ_OFF(bj, ai, m) * 2 + voff * 2u) = pack8(w); }
            } else {
                u32x4 raw[2][4];
#pragma unroll
                for (int ai = 0; ai < 2; ++ai)
#pragma unroll
                    for (int m = 0; m < 4; ++m) raw[ai][m] = *(const u32x4*)(Xu + OPJ_OFF(bj, ai, m) * 2 + voff * 2u);
                { const int col = u.pn * 256 + bj * 128 + wc * 32 + 8 * fq;
#pragma unroll
                    for (int j = 0; j < 8; ++j) { g1[j] = g1p[col + j]; bs[j] = bias ? bias[col + j] : 0.f; } }
#pragma unroll
                for (int ai = 0; ai < 2; ++ai)
#pragma unroll
                    for (int m = 0; m < 4; ++m) { float xo[8], w[8];
                        unpack8(raw[ai][m], xo);
#pragma unroll
                        for (int j = 0; j < 8; ++j) w[j] = xo[j] + g1[j] * (acc[ai][bj][m][j >> 2][j & 3] + bs[j]);
                        *(u32x4*)(Xu + OPJ_OFF(bj, ai, m) * 2 + voff * 2u) = pack8(w); }
            }
            asm volatile("" ::: "memory");
        }
#undef OPJ_OFF
    }
    DI void row8(const Unit& u, int r, int c, const float (&v)[8]) const {
        const int col = u.pn * 256 + c; const size_t o = off(u, r, col); const int b = (u.pm * 256 + row_off - TC) >> 11;
        float a[8];
        if (xs_l) { const f32x4 a0 = *(const f32x4*)(xs_l + o), a1 = *(const f32x4*)(xs_l + o + 4); a[0] = a0.x; a[1] = a0.y; a[2] = a0.z; a[3] = a0.w; a[4] = a1.x; a[5] = a1.y; a[6] = a1.z; a[7] = a1.w; }
        else unpack8(*(const u32x4*)(X + o), a);
        const float* g1 = mod + b * 6144 + 2048 + col; float w[8];
#pragma unroll
        for (int j = 0; j < 8; ++j) w[j] = a[j] + g1[j] * (v[j] + (bias ? bias[col + j] : 0.f));
        *(u32x4*)(X + o) = pack8(w);
    }
};
struct EpiUp {
    static constexpr bool PAIR = true, BATCHED = false;
    bf16* ACT;
    DI void row8p(const Unit& u, int r, int c, const float (&g)[8], const float (&up)[8]) const {
        float w[8];
#pragma unroll
        for (int j = 0; j < 8; ++j) w[j] = siluf_(g[j]) * up[j];
        *(u32x4*)(ACT + ((size_t)u.pm * 256 + r) * 1024 + u.pn * 128 + c) = pack8(w);
    }
};
struct EpiDown {
    static constexpr bool PAIR = false, BATCHED = false;
    bf16* YS;
    DI void row8(const Unit& u, int r, int c, const float (&v)[8]) const { *(u32x4*)(YS + ((size_t)u.pm * 256 + r) * 1024 + u.pn * 256 + c) = pack8(v); }
};

template <class Sched, class Epi>
DI void gemm_fast(LAS unsigned char* lds, int tid, const Sched& S, const Epi& E) {
    using namespace pg8;
    constexpr int K = 1024, nt = K / BK;
    const int wid = __builtin_amdgcn_readfirstlane(tid >> 6), lane = tid & 63, wr = wid >> 2, wc = wid & 3, fr = lane & 15, fq = lane >> 4;
    unsigned voffA[2], voffB[2];
#pragma unroll
    for (int i = 0; i < 2; ++i) { int R, C; stage_rc(tid * 16 + i * 8192, R, C); const int Rb = (R & ~31) + perm32(R & 31);
        voffA[i] = (unsigned)(R * K + C) * 2u; voffB[i] = (unsigned)(Rb * K + C) * 2u; }
    const size_t kstep = (size_t)(BK * 2);
    const size_t hstep = (size_t)HALF * K * 2;
    const unsigned ldsw = (unsigned)wid * 1024u;
    const int aoff = lds_byte(wr * 64 + fr, fq * 8), boff = lds_byte(wc * 32 + fr, fq * 8);
#define PG8_SA(b, h) (((b) * 2 + (h)) * HTB)
#define PG8_SB(b, h) ((4 + (b) * 2 + (h)) * HTB)
#define PG8_STAGE(bufoff, gbase, voff) do { _Pragma("unroll") for (int _i = 0; _i < 2; ++_i) \
        __builtin_amdgcn_global_load_lds((const unsigned*)((const char*)(gbase) + (voff)[_i]), (LAS unsigned*)(lds + (bufoff) + ldsw + _i * 8192), 16, 0, 0); } while (0)
#define PG8_LDA(dst, b, h) do { _Pragma("unroll") for (int m = 0; m < 4; ++m) _Pragma("unroll") for (int k = 0; k < 2; ++k) dst[m][k] = *(const LAS bf16x8*)(lds + PG8_SA(b, h) + aoff + m * 2048 + k * 1024); } while (0)
#define PG8_LDB(dst, b, h) do { _Pragma("unroll") for (int n = 0; n < 2; ++n) _Pragma("unroll") for (int k = 0; k < 2; ++k) dst[n][k] = *(const LAS bf16x8*)(lds + PG8_SB(b, h) + boff + n * 2048 + k * 1024); } while (0)
#define PG8_MMA(ai, bj, At, Bt) do { __builtin_amdgcn_s_setprio(1); _Pragma("unroll") for (int m = 0; m < 4; ++m) _Pragma("unroll") for (int n = 0; n < 2; ++n) _Pragma("unroll") for (int k = 0; k < 2; ++k) \
        acc[ai][bj][m][n] = __builtin_amdgcn_mfma_f32_16x16x32_bf16(Bt[n][k], At[m][k], acc[ai][bj][m][n], 0, 0, 0); __builtin_amdgcn_s_setprio(0); } while (0)
#define PG8_WAIT_V(n) asm volatile("s_waitcnt vmcnt(" #n ")" ::: "memory")
#define PG8_WAIT_L(n) asm volatile("s_waitcnt lgkmcnt(" #n ")" ::: "memory")
#define PG8_BAR __builtin_amdgcn_s_barrier()
#define PG8_SCHED __builtin_amdgcn_sched_barrier(0)
    Unit cur, nxt; int ui = 0;
    if (!S.next(0, cur)) return;
    f32x4 acc[2][2][4][2];
#pragma unroll
    for (int a = 0; a < 2; ++a)
#pragma unroll
        for (int b = 0; b < 2; ++b)
#pragma unroll
            for (int m = 0; m < 4; ++m)
#pragma unroll
                for (int n = 0; n < 2; ++n) acc[a][b][m][n] = (f32x4){0.f, 0.f, 0.f, 0.f};
    bf16x8 At[4][2], B0[2][2], B1[2][2];
    const char* cA = (const char*)S.aptr(cur); const char* cB = (const char*)S.bptr(cur);
    PG8_STAGE(PG8_SB(0, 0), cB, voffB); PG8_STAGE(PG8_SA(0, 0), cA, voffA); PG8_STAGE(PG8_SB(0, 1), cB + hstep, voffB); PG8_STAGE(PG8_SA(0, 1), cA + hstep, voffA);
    if (wr == 1) PG8_BAR;
    PG8_WAIT_V(4); PG8_BAR;
    PG8_STAGE(PG8_SB(1, 0), cB + kstep, voffB); PG8_STAGE(PG8_SA(1, 0), cA + kstep, voffA); PG8_STAGE(PG8_SB(1, 1), cB + hstep + kstep, voffB);
    PG8_WAIT_V(6); PG8_BAR;
    for (;;) {
        const bool has_next = S.next(ui + 1, nxt);
        const char* nA = has_next ? (const char*)S.aptr(nxt) : cA; const char* nB = has_next ? (const char*)S.bptr(nxt) : cB;
        for (int t = 0; t < nt; t += 2) {
            const bool last = (t == nt - 2);
            const char* a1 = cA + (size_t)(t + 1) * kstep;
            const char* a2 = last ? nA : cA + (size_t)(t + 2) * kstep; const char* b2 = last ? nB : cB + (size_t)(t + 2) * kstep;
            const char* a3 = a2 + kstep; const char* b3 = b2 + kstep;
            PG8_LDB(B0, 0, 0); PG8_SCHED; PG8_LDA(At, 0, 0); PG8_STAGE(PG8_SA(1, 1), a1 + hstep, voffA);
            PG8_WAIT_L(8); PG8_BAR; PG8_WAIT_L(0); PG8_MMA(0, 0, At, B0); PG8_BAR; PG8_SCHED;
            PG8_LDB(B1, 0, 1); PG8_STAGE(PG8_SB(0, 0), b2, voffB);
            PG8_BAR; PG8_WAIT_L(0); PG8_MMA(0, 1, At, B1); PG8_BAR;
            PG8_LDA(At, 0, 1); PG8_STAGE(PG8_SA(0, 0), a2, voffA);
            PG8_BAR; PG8_WAIT_L(0); PG8_MMA(1, 0, At, B0); PG8_BAR; PG8_SCHED;
            PG8_STAGE(PG8_SB(0, 1), b2 + hstep, voffB);
            PG8_WAIT_V(6); PG8_BAR; PG8_MMA(1, 1, At, B1); PG8_BAR;
            PG8_LDB(B0, 1, 0); PG8_SCHED; PG8_LDA(At, 1, 0); PG8_STAGE(PG8_SA(0, 1), a2 + hstep, voffA);
            PG8_WAIT_L(8); PG8_BAR; PG8_WAIT_L(0); PG8_MMA(0, 0, At, B0); PG8_BAR; PG8_SCHED;
            PG8_LDB(B1, 1, 1); PG8_STAGE(PG8_SB(1, 0), b3, voffB);
            PG8_BAR; PG8_WAIT_L(0); PG8_MMA(0, 1, At, B1); PG8_BAR;
            PG8_LDA(At, 1, 1); PG8_STAGE(PG8_SA(1, 0), a3, voffA);
            PG8_BAR; PG8_WAIT_L(0); PG8_MMA(1, 0, At, B0); PG8_BAR; PG8_SCHED;
            PG8_STAGE(PG8_SB(1, 1), b3 + hstep, voffB);
            PG8_WAIT_V(6); PG8_BAR; PG8_MMA(1, 1, At, B1); PG8_BAR;
        }
        int efr = fr, efq = fq; asm volatile("" : "+v"(efr), "+v"(efq));
        if constexpr (Epi::BATCHED) E.tile(acc, cur, wr, wc, efr, efq); else
#pragma unroll
        for (int ai = 0; ai < 2; ++ai)
#pragma unroll
            for (int m = 0; m < 4; ++m) {
                const int r = ai * HALF + wr * 64 + m * 16 + efr;
                if constexpr (Epi::PAIR) {
                    const float g[8] = {acc[ai][0][m][0][0], acc[ai][0][m][0][1], acc[ai][0][m][0][2], acc[ai][0][m][0][3], acc[ai][0][m][1][0], acc[ai][0][m][1][1], acc[ai][0][m][1][2], acc[ai][0][m][1][3]};
                    const float up[8] = {acc[ai][1][m][0][0], acc[ai][1][m][0][1], acc[ai][1][m][0][2], acc[ai][1][m][0][3], acc[ai][1][m][1][0], acc[ai][1][m][1][1], acc[ai][1][m][1][2], acc[ai][1][m][1][3]};
                    E.row8p(cur, r, wc * 32 + 8 * efq, g, up);
                } else {
#pragma unroll
                    for (int bj = 0; bj < 2; ++bj) {
                        const float v[8] = {acc[ai][bj][m][0][0], acc[ai][bj][m][0][1], acc[ai][bj][m][0][2], acc[ai][bj][m][0][3], acc[ai][bj][m][1][0], acc[ai][bj][m][1][1], acc[ai][bj][m][1][2], acc[ai][bj][m][1][3]};
                        E.row8(cur, r, bj * HALF + wc * 32 + 8 * efq, v);
                    }
                }
            }
        if (!has_next) break;
#pragma unroll
        for (int a = 0; a < 2; ++a)
#pragma unroll
            for (int b = 0; b < 2; ++b)
#pragma unroll
                for (int m = 0; m < 4; ++m)
#pragma unroll
                    for (int n = 0; n < 2; ++n) acc[a][b][m][n] = (f32x4){0.f, 0.f, 0.f, 0.f};
        cur = nxt; cA = nA; cB = nB; ++ui;
    }
    PG8_WAIT_V(0);
    if (wr == 0) PG8_BAR;
    PG8_BAR;
#undef PG8_SA
#undef PG8_SB
#undef PG8_STAGE
#undef PG8_LDA
#undef PG8_LDB
#undef PG8_MMA
#undef PG8_WAIT_V
#undef PG8_WAIT_L
#undef PG8_BAR
#undef PG8_SCHED
}

template <class Sched, class Epi>
DI void gemm_naive(LAS unsigned char* lds, int tid, const Sched& S, const Epi& E) {
    LAS float* As = (LAS float*)lds;
    LAS float* Bs = As + 32 * 132;
    LAS float* Bu = Bs + 32 * 132;
    const int ty = tid >> 4, tx = tid & 15, lr = tid >> 2, kq = tid & 3;
    Unit u;
    for (int i = 0; S.next(i, u); ++i) {
        const bf16* A = S.aptr(u); const bf16* B = S.bptr(u);
        for (int sm = 0; sm < 2; ++sm)
            for (int sn = 0; sn < (Epi::PAIR ? 1 : 2); ++sn) {
                float acc[4][8], accu[4][8];
#pragma unroll
                for (int a = 0; a < 4; ++a)
#pragma unroll
                    for (int b = 0; b < 8; ++b) { acc[a][b] = 0.f; accu[a][b] = 0.f; }
                for (int k0 = 0; k0 < 1024; k0 += 32) {
                    __syncthreads();
                    { float w[8]; unpack8(*(const u32x4*)(A + (size_t)(128 * sm + lr) * 1024 + k0 + 8 * kq), w);
#pragma unroll
                      for (int j = 0; j < 8; ++j) As[(8 * kq + j) * 132 + lr] = w[j];
                      unpack8(*(const u32x4*)(B + (size_t)(128 * sn + lr) * 1024 + k0 + 8 * kq), w);
#pragma unroll
                      for (int j = 0; j < 8; ++j) Bs[(8 * kq + j) * 132 + lr] = w[j];
                      if (Epi::PAIR) { unpack8(*(const u32x4*)(B + (size_t)(128 + lr) * 1024 + k0 + 8 * kq), w);
#pragma unroll
                          for (int j = 0; j < 8; ++j) Bu[(8 * kq + j) * 132 + lr] = w[j]; } }
                    __syncthreads();
#pragma unroll 4
                    for (int k = 0; k < 32; ++k) {
                        const f32x4 a4 = *(const LAS f32x4*)(As + k * 132 + 4 * ty);
                        const f32x4 b0 = *(const LAS f32x4*)(Bs + k * 132 + 8 * tx), b1 = *(const LAS f32x4*)(Bs + k * 132 + 8 * tx + 4);
#pragma unroll
                        for (int a = 0; a < 4; ++a) {
#pragma unroll
                            for (int b = 0; b < 4; ++b) { acc[a][b] += a4[a] * b0[b]; acc[a][4 + b] += a4[a] * b1[b]; } }
                        if (Epi::PAIR) {
                            const f32x4 c0 = *(const LAS f32x4*)(Bu + k * 132 + 8 * tx), c1 = *(const LAS f32x4*)(Bu + k * 132 + 8 * tx + 4);
#pragma unroll
                            for (int a = 0; a < 4; ++a) {
#pragma unroll
                                for (int b = 0; b < 4; ++b) { accu[a][b] += a4[a] * c0[b]; accu[a][4 + b] += a4[a] * c1[b]; } }
                        }
                    }
                }
#pragma unroll
                for (int a = 0; a < 4; ++a) {
                    if constexpr (Epi::PAIR) E.row8p(u, 128 * sm + 4 * ty + a, 8 * tx, acc[a], accu[a]);
                    else E.row8(u, 128 * sm + 4 * ty + a, 128 * sn + 8 * tx, acc[a]);
                }
            }
    }
    __syncthreads();
}
template <class Sched, class Epi>
DI void gemm_run(LAS unsigned char* lds, int tid, const Sched& S, const Epi& E) {
#if FAST_GEMM
    gemm_fast(lds, tid, S, E);
#else
    gemm_naive(lds, tid, S, E);
#endif
}

struct Ctx {
    LAS unsigned char* lds;
    int tid, lane, wave, gw, ngw;
    unsigned z;
    const float* const __attribute__((address_space(4)))* in;
    float* out;
    unsigned char* ws;
};
#define WSP(T, off) ((T*)(c.ws + (off)))

DI void transpose_item(const float* W, int N, bf16* WT, int k0, int n0, int dst_row0, LAS float* scr, int lane) {
#pragma unroll 8
    for (int i = 0; i < 32; ++i) { const int kk = 2 * i + (lane >> 5); scr[kk * 33 + (lane & 31)] = __builtin_nontemporal_load(W + (size_t)(k0 + kk) * N + n0 + (lane & 31)); }
    asm volatile("s_waitcnt lgkmcnt(0)" ::: "memory");
    const int cc = lane & 7;
#pragma unroll
    for (int j = 0; j < 4; ++j) { const int n = (lane >> 3) + 8 * j; const LAS float* s = scr + (8 * cc) * 33 + n;
        u32x4 o; o.x = cvt_pk_bf16(s[0 * 33], s[1 * 33]); o.y = cvt_pk_bf16(s[2 * 33], s[3 * 33]); o.z = cvt_pk_bf16(s[4 * 33], s[5 * 33]); o.w = cvt_pk_bf16(s[6 * 33], s[7 * 33]);
        *(u32x4*)(WT + (size_t)(dst_row0 + n) * 1024 + k0 + 8 * cc) = o; }
    asm volatile("s_waitcnt lgkmcnt(0)" ::: "memory");
}
DI void dense_transpose(const Ctx& c, const float* W, int N, bf16* WT, LAS float* scr) {
    const int nblk = N / 32, nitems = 16 * nblk;
    for (int it = c.gw; it < nitems; it += c.ngw) { const int kb = it / nblk, nb = it % nblk; transpose_item(W, N, WT, 64 * kb, 32 * nb, 32 * nb, scr, c.lane); }
}
DI void phase_pro0(const Ctx& c) {
    LAS float* scr = (LAS float*)(c.lds + c.wave * 8704);
    for (int j = 0; j < 2; ++j) {
        dense_transpose(c, c.in[I_MLWIN] + (size_t)j * 1024 * 3104, 3104, WSP(bf16, WS_ML_WIN) + (size_t)j * NINP * 1024, scr);
        dense_transpose(c, c.in[I_MLWOUT] + (size_t)j * 1024 * 1024, 1024, WSP(bf16, WS_ML_WOUT) + (size_t)j * 1024 * 1024, scr);
    }
    dense_transpose(c, c.in[I_GLWIN], 3104, WSP(bf16, WS_GLA_WIN), scr);
    dense_transpose(c, c.in[I_GLWOUT], 1024, WSP(bf16, WS_GLA_WOUT), scr);
    dense_transpose(c, c.in[I_HYWIN], 3072, WSP(bf16, WS_HY_WIN), scr);
    dense_transpose(c, c.in[I_HYWOUT], 1024, WSP(bf16, WS_HY_WOUT), scr);
    for (int it = c.gw * 64 + c.lane; it < 3 * 28672; it += c.ngw * 64) {
        const int m = it / 28672, r = it % 28672; bf16* base = (m < 2) ? WSP(bf16, WS_ML_WIN) + (size_t)m * NINP * 1024 : WSP(bf16, WS_GLA_WIN);
        *(u32x4*)(base + (size_t)3104 * 1024 + (size_t)r * 8) = (u32x4){c.z, c.z, c.z, c.z};
    }
    for (int it = c.gw; it < 64 * 3 * 512; it += c.ngw) {
        const int le = it / 1536, r0 = it % 1536, which = r0 / 512, r = r0 % 512, kb = r / 32, nb = r % 32;
        if (which < 2) {
            const float* W = c.in[which == 0 ? I_EW1 : I_EW3] + (size_t)le * 1024 * 1024;
            const int n0 = 32 * nb, drow = 256 * (n0 >> 7) + (n0 & 127) + (which ? 128 : 0);
            transpose_item(W, 1024, WSP(bf16, WS_EXP_UP) + (size_t)le * 2048 * 1024, 64 * kb, n0, drow, scr, c.lane);
        } else {
            transpose_item(c.in[I_EW2] + (size_t)le * 1024 * 1024, 1024, WSP(bf16, WS_EXP_DN) + (size_t)le * 1024 * 1024, 64 * kb, 32 * nb, 32 * nb, scr, c.lane);
        }
    }
    for (int i = blockIdx.x * 512 + c.tid; i < 16 * 1024; i += gridDim.x * 512) WSP(float, WS_RWT)[i] = c.in[I_RW][(i & 1023) * 16 + (i >> 10)];
    {
        const float* w1 = c.in[I_HYFW1]; const float* b1 = c.in[I_HYFB1]; const float* wm = c.in[I_HYFWM]; const float* bm = c.in[I_HYFBM]; const float* fr = c.in[I_HYFREQ];
        float* HM = WSP(float, WS_HM);
        for (int row = c.gw; row < 2304; row += c.ngw) {
            const int L = row < 2048 ? 2048 : 256, t = row < 2048 ? row : row - 2048, f = c.lane;
            float feat = 0.f;
            if (f == 0) feat = (float)t / (float)(L - 1);
            else if (f <= 32) { const int b = (f - 1) & 15; const float band = 1e-4f + (float)b * ((15.0f - 1e-4f) / 15.0f);
                const float ang = ((float)(2.0 * 3.14159265358979323846 / (double)L) * (float)t) * band; feat = (f <= 16) ? cosf(ang) : -sinf(ang); }
            float a = b1[f];
            for (int e = 0; e < 33; ++e) a += __shfl(feat, e) * w1[e * 64 + f];
            float h = sinf(fr[f] * a);
            for (int m = 0; m < 2; ++m) {
                float a2 = bm[m * 64 + f];
                for (int g = 0; g < 64; ++g) a2 += __shfl(h, g) * wm[m * 4096 + g * 64 + f];
                h = sinf(fr[f] * a2);
            }
            HM[row * 64 + f] = h;
        }
    }
    __syncthreads();
    {
        LAS float* sv = (LAS float*)c.lds;
        LAS float* red = sv + 9 * 1024;
        for (int i = c.tid; i < 9 * 1024; i += 512) { const float x = (i < 8192) ? c.in[I_C][i] : c.in[I_CCTX][i - 8192]; sv[i] = siluf_(x); }
        __syncthreads();
        float* MOD = WSP(float, WS_MOD);
        const int col = c.tid & 63, kg = c.tid >> 6;
        for (int item = blockIdx.x; item < 4 * 96; item += gridDim.x) {
            const int l = item / 96, j0 = 64 * (item % 96);
            const float* w = c.in[I_ADAW] + (size_t)l * 1024 * 6144 + j0 + col;
            float acc[9];
#pragma unroll
            for (int r = 0; r < 9; ++r) acc[r] = 0.f;
            for (int k = kg * 128; k < kg * 128 + 128; ++k) { const float wv = w[(size_t)k * 6144];
#pragma unroll
                for (int r = 0; r < 9; ++r) acc[r] += sv[r * 1024 + k] * wv; }
#pragma unroll
            for (int r = 0; r < 9; ++r) red[(kg * 9 + r) * 64 + col] = acc[r];
            __syncthreads();
            for (int o = c.tid; o < 9 * 64; o += 512) { const int r = o >> 6, cc = o & 63; float s = c.in[I_ADAB][l * 6144 + j0 + cc];
#pragma unroll
                for (int g = 0; g < 8; ++g) s += red[(g * 9 + r) * 64 + cc];
                MOD[(l * 9 + r) * 6144 + j0 + cc] = s; }
            __syncthreads();
        }
    }
}

template <int L>
DI void pro1_len(const Ctx& c, int c0, const float* hm, float* tab, LAS float* hmT  , const LAS f32x4* wo4  , float (&part)[4]) {
    const int side = c.wave & 1, ts = c.wave >> 1;
    const float da = -4.605170185988091f / 1.5f, db = -4.605170185988091f / 0.3f;
#pragma unroll 1
    for (int t0 = 0; t0 < L; t0 += 256) {
        __syncthreads();
#pragma unroll
        for (int k = 0; k < 8; ++k) { const int idx = c.tid + 512 * k, row = idx >> 4, q = idx & 15; const f32x4 v = *(const f32x4*)(hm + (size_t)(t0 + row) * 64 + 4 * q);
            LAS float* d = hmT + row * 65 + 4 * q; d[0] = v.x; d[1] = v.y; d[2] = v.z; d[3] = v.w; }
        __syncthreads();
        const int t = t0 + 64 * ts + c.lane; const LAS float* hr = hmT + (64 * ts + c.lane) * 65;
        f32x4 acc = {0.f, 0.f, 0.f, 0.f};
#pragma unroll 8
        for (int f = 0; f < 64; ++f) acc += wo4[side * 64 + f] * hr[f];
        const float tl = (float)t / (float)(L - 1);
#pragma unroll
        for (int ch = 0; ch < 4; ++ch) { const float delta = fabsf(da + (float)(c0 + ch) * ((db - da) / 1023.0f)), v = acc[ch] * expf(-tl * delta);
            float* trow = tab + (size_t)(c0 + ch) * (2 * L);
            if (side == 0) { trow[L + t] = v; part[ch] += fabsf(v); }
            else if (t >= 1) { trow[L - t] = v; part[ch] += fabsf(v); }
            else trow[0] = 0.f; }
    }
}
template <int L>
DI void pro1_scale(const Ctx& c, int c0, float* tab, const float (&inv)[4]) {
    const int side = c.wave & 1, ts = c.wave >> 1;
#pragma unroll 1
    for (int t0 = 0; t0 < L; t0 += 256) { const int t = t0 + 64 * ts + c.lane;
#pragma unroll
        for (int ch = 0; ch < 4; ++ch) { float* trow = tab + (size_t)(c0 + ch) * (2 * L); if (side == 0) trow[L + t] *= inv[ch]; else if (t >= 1) trow[L - t] *= inv[ch]; } }
}
DI void pro1_reduce(const Ctx& c, float (&part)[4], LAS float* red, float (&inv)[4]) {
#pragma unroll
    for (int ch = 0; ch < 4; ++ch) part[ch] = wave_sum(part[ch]);
    __syncthreads();
    if (c.lane == 0) {
#pragma unroll
        for (int ch = 0; ch < 4; ++ch) red[c.wave * 4 + ch] = part[ch]; }
    __syncthreads();
#pragma unroll
    for (int ch = 0; ch < 4; ++ch) { float s = 0.f;
#pragma unroll
        for (int w = 0; w < 8; ++w) s += red[w * 4 + ch];
        inv[ch] = 1.0f / s; }
}
DI void phase_pro1(const Ctx& c) {
    LAS float* hmT = (LAS float*)c.lds; LAS f32x4* wo4 = (LAS f32x4*)(c.lds + 67584); LAS float* red = (LAS float*)(c.lds + 67584 + 2048);
    const float* HM = WSP(float, WS_HM);
    for (int item = blockIdx.x; item < 256; item += gridDim.x) {
        const int c0 = 4 * item;
        __syncthreads();
        if (c.tid < 128) wo4[c.tid] = *(const f32x4*)(c.in[I_HYFWO] + (size_t)(c.tid & 63) * 2048 + (c.tid >> 6) * 1024 + c0);
        float part[4] = {0.f, 0.f, 0.f, 0.f}, inv[4];
        pro1_len<SEQ>(c, c0, HM, WSP(float, WS_HF), hmT, wo4, part);
        pro1_reduce(c, part, red, inv);
        pro1_scale<SEQ>(c, c0, WSP(float, WS_HF), inv);
        float part2[4] = {0.f, 0.f, 0.f, 0.f};
        pro1_len<CTX>(c, c0, HM + 2048 * 64, WSP(float, WS_HFC), hmT, wo4, part2);
        pro1_reduce(c, part2, red, inv);
        pro1_scale<CTX>(c, c0, WSP(float, WS_HFC), inv);
    }
}

DI void load_row(const float* src, f32x4 (&v)[4], int lane) {
#pragma unroll
    for (int j = 0; j < 4; ++j) v[j] = *(const f32x4*)(src + 256 * j + 4 * lane);
}
DI void load_row_bf(const bf16* src, f32x4 (&v)[4], int lane) {
#pragma unroll
    for (int j = 0; j < 4; ++j) { const u32x2 a = *(const u32x2*)(src + 256 * j + 4 * lane);
        v[j] = (f32x4){__uint_as_float(a.x << 16), __uint_as_float(a.x & 0xffff0000u), __uint_as_float(a.y << 16), __uint_as_float(a.y & 0xffff0000u)}; }
}
DI void norm_row(f32x4 (&v)[4], const float* g, int lane) {
    float s = 0.f;
#pragma unroll
    for (int j = 0; j < 4; ++j) s += (v[j].x * v[j].x + v[j].y * v[j].y) + (v[j].z * v[j].z + v[j].w * v[j].w);
    s = wave_sum(s);
    const float r = 1.0f / sqrtf(s * (1.0f / 1024.0f) + EPS);
#pragma unroll
    for (int j = 0; j < 4; ++j) v[j] = v[j] * r * *(const f32x4*)(g + 256 * j + 4 * lane);
}
DI void mod_row(f32x4 (&v)[4], const float* sh, const float* sc, int lane) {
#pragma unroll
    for (int j = 0; j < 4; ++j) v[j] = v[j] * (*(const f32x4*)(sc + 256 * j + 4 * lane) + 1.0f) + *(const f32x4*)(sh + 256 * j + 4 * lane);
}
DI void store_row_bf16(bf16* dst, const f32x4 (&v)[4], int lane) {
#pragma unroll
    for (int j = 0; j < 4; ++j) { u32x2 w; w.x = cvt_pk_bf16(v[j].x, v[j].y); w.y = cvt_pk_bf16(v[j].z, v[j].w); *(u32x2*)(dst + 256 * j + 4 * lane) = w; }
}
DI int hrow_of(int srow, int kind) {
    if (srow < TC || kind != 1) return srow;
    const int rr = srow - TC, b = rr >> 11, s = rr & (SEQ - 1); return TC + b * SEQ + perm_fwd(s);
}
DI void phase_norm1(const Ctx& c, int l, const float* xl, const float* xc) {
    const float* MOD = WSP(float, WS_MOD) + (size_t)l * 9 * 6144; const float* g = c.in[I_N1G] + l * D; bf16* H = WSP(bf16, WS_H);
    for (int row = c.gw; row < TT; row += c.ngw) {
        f32x4 v[4]; const int mr = row < TC ? 8 : (row - TC) >> 11;
        load_row(row < TC ? xc + (size_t)row * D : xl + (size_t)(row - TC) * D, v, c.lane);
        norm_row(v, g, c.lane); mod_row(v, MOD + mr * 6144, MOD + mr * 6144 + 1024, c.lane);
        store_row_bf16(H + (size_t)hrow_of(row, l % 3) * D, v, c.lane);
    }
}

DI void phase_conv(const Ctx& c, int ncols, const float* cw, const float* cb, bool act, float qs) {
    const bf16* P = WSP(bf16, WS_P); bf16* PC = WSP(bf16, WS_BIG + BIG_PC);
    const int ng = ncols / 8; const long total = (long)TT * ng;
    for (long idx = (long)blockIdx.x * 512 + c.tid; idx < total; idx += (long)gridDim.x * 512) {
        const int row = (int)(idx / ng), col = (int)(idx % ng) * 8; int lo, hi; seq_bounds(row, lo, hi);
        float x0[8], xm[8], xp[8];
        unpack8(*(const u32x4*)(P + (size_t)row * PLD + col), x0);
        if (row > lo) unpack8(*(const u32x4*)(P + (size_t)(row - 1) * PLD + col), xm); else {
#pragma unroll
            for (int j = 0; j < 8; ++j) xm[j] = 0.f; }
        if (row < hi) unpack8(*(const u32x4*)(P + (size_t)(row + 1) * PLD + col), xp); else {
#pragma unroll
            for (int j = 0; j < 8; ++j) xp[j] = 0.f; }
        float o[8];
#pragma unroll
        for (int j = 0; j < 8; ++j) { float v = cw[col + j] * xm[j] + cw[ncols + col + j] * x0[j] + cw[2 * ncols + col + j] * xp[j] + cb[col + j];
            if (act) v = siluf_(v); if (col < 512) v *= qs; o[j] = v; }
        *(u32x4*)(PC + (size_t)row * ncols + col) = pack8(o);
    }
}

DI int scan_row(int step, int b, int dir) {
    if (step < CTX) return b * CTX + (dir ? CTX - 1 - step : step);
    const int s = step - CTX; return TC + b * SEQ + (dir ? SEQ - 1 - s : s);
}
DI void phase_mlstm_scan_naive(const Ctx& c) {
    const bf16* P = WSP(bf16, WS_P); const bf16* PC = WSP(bf16, WS_BIG + BIG_PC); const float* EX = WSP(float, WS_EXTRA);
    LAS float* qs = (LAS float*)c.lds; LAS float* ks = qs + 32 * 64; LAS float* vs = ks + 32 * 64; LAS float* gs = vs + 32 * 128;
    const int v = c.tid >> 2, d0 = (c.tid & 3) * 16;
    for (int item = blockIdx.x; item < 128; item += gridDim.x) {
        const int b = item >> 4, h = (item >> 1) & 7, dir = item & 1;
        float* Yo = WSP(float, WS_BIG + (dir ? BIG_YB : BIG_YF));
        float C[16], n[16];
#pragma unroll
        for (int d = 0; d < 16; ++d) { C[d] = 0.f; n[d] = 0.f; }
        for (int ch = 0; ch < (CTX + SEQ) / 32; ++ch) {
            __syncthreads();
            for (int idx = c.tid; idx < 32 * 256; idx += 512) { const int st = idx >> 8, col = idx & 255, row = scan_row(ch * 32 + st, b, dir);
                if (col < 64) qs[st * 64 + col] = bf2f(PC[(size_t)row * 1024 + h * 64 + col]);
                else if (col < 128) ks[st * 64 + col - 64] = bf2f(PC[(size_t)row * 1024 + 512 + h * 64 + col - 64]);
                else vs[st * 128 + col - 128] = bf2f(P[(size_t)row * PLD + 1024 + h * 128 + col - 128]); }
            if (c.tid < 32) { const int row = scan_row(ch * 32 + c.tid, b, dir); gs[c.tid * 2] = sigmoidf_(EX[(size_t)row * 32 + dir * 16 + 8 + h]); gs[c.tid * 2 + 1] = __expf(EX[(size_t)row * 32 + dir * 16 + h]); }
            __syncthreads();
            for (int st = 0; st < 32; ++st) {
                const float f = gs[st * 2], ei = gs[st * 2 + 1], vv = vs[st * 128 + v] * ei;
                float part = 0.f, dpart = 0.f;
#pragma unroll
                for (int d = 0; d < 16; ++d) { const float kd = ks[st * 64 + d0 + d], qd = qs[st * 64 + d0 + d];
                    C[d] = f * C[d] + kd * vv; part += qd * C[d]; n[d] = f * n[d] + ei * kd; dpart += qd * n[d]; }
                part += __shfl_xor(part, 1); part += __shfl_xor(part, 2); dpart += __shfl_xor(dpart, 1); dpart += __shfl_xor(dpart, 2);
                if ((c.tid & 3) == 0) { const int row = scan_row(ch * 32 + st, b, dir); Yo[(size_t)row * D + h * 128 + v] = part / fmaxf(fabsf(dpart), 1.0f); }
            }
        }
    }
}
typedef short s16x4 __attribute__((ext_vector_type(4)));
typedef float f32x16 __attribute__((ext_vector_type(16)));
#define MFMA32(a, b, c) __builtin_amdgcn_mfma_f32_32x32x16_bf16((a), (b), (c), 0, 0, 0)
DI int crow(int reg, int h) { return (reg & 3) + 8 * (reg >> 2) + 4 * h; }
DI s16x4 ds_tr(const LAS unsigned char* p) { return __builtin_amdgcn_ds_read_tr16_b64_v4i16((LAS s16x4*)p); }
DI bf16x8 cat8(s16x4 lo, s16x4 hi) { return __builtin_shufflevector(lo, hi, 0, 1, 2, 3, 4, 5, 6, 7); }
DI bf16x8 tr_frag(const LAS unsigned char* img, int pitch, int k0, int n0, int lane) {
    const int h = lane >> 5, g16 = (lane >> 4) & 1, i = lane & 15;
    const LAS unsigned char* p = img + (k0 + 8 * h + (i >> 2)) * pitch + (n0 + 16 * g16 + 4 * (i & 3)) * 2;
    return cat8(ds_tr(p), ds_tr(p + 4 * pitch));
}
DI bf16x8 tr_frag_perm(const LAS unsigned char* img, int pitch, int k0, int n0, int lane) {
    const int h = lane >> 5, g16 = (lane >> 4) & 1, i = lane & 15;
    const LAS unsigned char* p = img + (k0 + 4 * h + (i >> 2)) * pitch + (n0 + 16 * g16 + 4 * (i & 3)) * 2;
    return cat8(ds_tr(p), ds_tr(p + 8 * pitch));
}
DI bf16x8 row_frag(const LAS unsigned char* img, int pitch, int row0, int k0, int lane) { return *(const LAS bf16x8*)(img + (row0 + (lane & 31)) * pitch + (k0 + 8 * (lane >> 5)) * 2); }
DI bf16x8 pack_acc(const f32x16& x, int step) {
    u32x4 p; const int o = 8 * step;
    p.x = cvt_pk_bf16(x[o], x[o + 1]); p.y = cvt_pk_bf16(x[o + 2], x[o + 3]); p.z = cvt_pk_bf16(x[o + 4], x[o + 5]); p.w = cvt_pk_bf16(x[o + 6], x[o + 7]);
    return __builtin_bit_cast(bf16x8, p);
}
DI f32x16 zero16() { f32x16 z;
#pragma unroll
    for (int i = 0; i < 16; ++i) z[i] = 0.f; return z; }
DI float wave_incl_prefix(float x, int lane) {
#pragma unroll
    for (int o = 1; o < 64; o <<= 1) { const float t = __shfl_up(x, o); if (lane >= o) x += t; }
    return x;
}
DI float wave_incl_suffix(float x, int lane) {
#pragma unroll
    for (int o = 1; o < 64; o <<= 1) { const float t = __shfl_down(x, o); if (lane + o < 64) x += t; }
    return x;
}
DI int chunk_row0(int p, int b, int dir) {
    if (p < 4) return b * CTX + 64 * (dir ? 3 - p : p);
    return TC + b * SEQ + 64 * (dir ? 35 - p : p - 4);
}

DI void phase_mlstm_state(const Ctx& c) {
    const bf16* P = WSP(bf16, WS_P); const bf16* PC = WSP(bf16, WS_BIG + BIG_PC); const float* EX = WSP(float, WS_EXTRA);
    bf16* MCT = WSP(bf16, WS_BIG + BIG_MCT); float* MN = WSP(float, WS_BIG + BIG_MN);
    LAS float* gi = (LAS float*)c.lds; LAS float* ga = gi + 2304; LAS float* wv = ga + 2304; LAS float* dec = wv + 64;
    LAS unsigned char* Kw = c.lds + 20480; LAS unsigned char* Vs = Kw + 64 * 144;
    const int lane = c.lane, wave = c.wave, h5 = lane >> 5, l31 = lane & 31;
    for (int it0 = blockIdx.x; it0 < 256; it0 += gridDim.x) {
        const int item = (gridDim.x == 256) ? ((it0 & 7) * 32 + (it0 >> 3)) : it0;
        const int b = item >> 5, h = (item >> 2) & 7, dir = (item >> 1) & 1, dvh = item & 1, seq = (b * 8 + h) * 2 + dir;
        __syncthreads();
        for (int idx = c.tid; idx < 2304; idx += 512) { const int row = chunk_row0(idx >> 6, b, dir) + (idx & 63);
            gi[idx] = EX[(size_t)row * 32 + dir * 16 + h]; ga[idx] = logsigf_(EX[(size_t)row * 32 + dir * 16 + 8 + h]); }
        f32x16 acc = zero16(); float nst = 0.f;
        const int dt = wave & 1, vt = (wave >> 1) & 1;
        const int srow = c.tid >> 3, spc = c.tid & 7;
        u32x4 kregA, vregA, kregB, vregB;
#define ML_PREFETCH(p_, kr, vr) do { const int r0_ = chunk_row0((p_), b, dir); \
          kr = *(const u32x4*)(PC + (size_t)(r0_ + srow) * 1024 + 512 + h * 64 + 8 * spc); \
          vr = *(const u32x4*)(P + (size_t)(r0_ + srow) * PLD + 1024 + h * 128 + dvh * 64 + 8 * spc); } while (0)
        ML_PREFETCH(0, kregA, vregA); ML_PREFETCH(1, kregB, vregB);
        __syncthreads();
#define ML_STEP(p, kreg, vreg) do { \
              \
            if (wave < 4) { \
                bf16* dst = MCT + ((size_t)seq * 36 + (p)) * 8192 + (size_t)(dvh * 64 + 32 * vt + l31) * 64 + 32 * dt + 4 * h5; \
                _Pragma("unroll") for (int q = 0; q < 4; ++q) { u32x2 w; w.x = cvt_pk_bf16(acc[4 * q], acc[4 * q + 1]); w.y = cvt_pk_bf16(acc[4 * q + 2], acc[4 * q + 3]); *(u32x2*)(dst + 8 * q) = w; } \
            } else if (wave == 4) { if (dvh == 0) MN[((size_t)seq * 36 + (p)) * 64 + lane] = nst; } \
            else if (wave == 7) { \
                const float a = ga[(p) * 64 + lane]; const float bj = dir ? wave_incl_suffix(a, lane) : wave_incl_prefix(a, lane); \
                const float tot = __shfl(bj, dir ? 0 : 63); \
                wv[lane] = __expf(tot - bj + gi[(p) * 64 + lane]); if (lane == 0) dec[0] = __expf(tot); \
            } \
            lds_barrier(); \
              \
            { float kk[8]; unpack8(kreg, kk); const float w = wv[srow]; \
              _Pragma("unroll") for (int j = 0; j < 8; ++j) kk[j] *= w; \
              *(LAS u32x4*)(Kw + srow * 144 + spc * 16) = pack8(kk); *(LAS u32x4*)(Vs + srow * 144 + spc * 16) = vreg; } \
            if ((p) + 2 < 36) ML_PREFETCH((p) + 2, kreg, vreg); \
            const float d = dec[0];            \
            lds_barrier(); \
              \
            if (wave < 4) { \
                _Pragma("unroll") for (int i = 0; i < 16; ++i) acc[i] *= d; \
                _Pragma("unroll") for (int kk = 0; kk < 4; ++kk) acc = MFMA32(tr_frag(Kw, 144, 16 * kk, 32 * dt, lane), tr_frag(Vs, 144, 16 * kk, 32 * vt, lane), acc); \
            } else if (wave == 4) { \
                float s = 0.f; \
                for (int r = 0; r < 64; ++r) s += bf2f(*(const LAS bf16*)(Kw + r * 144 + lane * 2)); \
                nst = d * nst + s; \
            } } while (0)
        for (int p = 0; p < 36; p += 2) { ML_STEP(p, kregA, vregA); ML_STEP(p + 1, kregB, vregB); }
#undef ML_STEP
#undef ML_PREFETCH
    }
}

DI void phase_mlstm_out(const Ctx& c, const float* ng) {
    const bf16* P = WSP(bf16, WS_P); const bf16* PC = WSP(bf16, WS_BIG + BIG_PC); const float* EX = WSP(float, WS_EXTRA);
    const bf16* MCT = WSP(bf16, WS_BIG + BIG_MCT); const float* MN = WSP(float, WS_BIG + BIG_MN); bf16* Y = WSP(bf16, WS_Y);
    LAS unsigned char* Qs = c.lds; LAS unsigned char* Ks = Qs + 9216; LAS unsigned char* Vs = Ks + 9216;
    LAS unsigned char* CT0 = Vs + 17408;
    LAS float* gt = (LAS float*)(c.lds + MISC_OFF + 1024);
    LAS float* YO = (LAS float*)c.lds;
    const int lane = c.lane, wave = c.wave, h5 = lane >> 5, l31 = lane & 31;
    const int dir = wave >> 2, jt = (wave >> 1) & 1, vh = wave & 1;
    const int srow = c.tid >> 3, spc = c.tid & 7;
    u32x4 pq, pk, pv[2], pct[4], pgate[2]; float pga = 0.f, pgi = 0.f, pgn = 0.f;
#define MO_DECODE(it_) const int b = (it_) / 288, h = ((it_) / 36) & 7, cc = (it_) % 36; \
        const int r0 = cc < 4 ? b * CTX + 64 * cc : TC + b * SEQ + 64 * (cc - 4); const int pf = cc, pb = cc < 4 ? 3 - cc : 39 - cc
#define MO_PREFETCH(it_) do { MO_DECODE(it_); \
        pq = *(const u32x4*)(PC + (size_t)(r0 + srow) * 1024 + h * 64 + 8 * spc); pk = *(const u32x4*)(PC + (size_t)(r0 + srow) * 1024 + 512 + h * 64 + 8 * spc); \
        _Pragma("unroll") for (int i = 0; i < 2; ++i) pv[i] = *(const u32x4*)(P + (size_t)(r0 + srow) * PLD + 1024 + h * 128 + 8 * (spc + 8 * i)); \
        _Pragma("unroll") for (int i = 0; i < 4; ++i) { const int pc = c.tid + 512 * i, d2 = pc >> 10, rr = (pc >> 3) & 127, sp = pc & 7; \
            pct[i] = *(const u32x4*)(MCT + (((size_t)((b * 8 + h) * 2 + d2)) * 36 + (d2 ? pb : pf)) * 8192 + rr * 64 + 8 * sp); } \
        _Pragma("unroll") for (int i = 0; i < 2; ++i) pgate[i] = *(const u32x4*)(P + (size_t)(r0 + srow) * PLD + 2048 + h * 128 + 16 * spc + 8 * i); \
        if (wave < 2) { const int d2 = wave, row = r0 + lane; pga = EX[(size_t)row * 32 + d2 * 16 + 8 + h]; pgi = EX[(size_t)row * 32 + d2 * 16 + h]; \
            pgn = MN[(((size_t)((b * 8 + h) * 2 + d2)) * 36 + (d2 ? pb : pf)) * 64 + lane]; } } while (0)
    if ((int)blockIdx.x < 2304) MO_PREFETCH((int)blockIdx.x);
    for (int item = blockIdx.x; item < 2304; item += gridDim.x) {
        MO_DECODE(item); (void)pf; (void)pb;
        lds_barrier();
        *(LAS u32x4*)(Qs + srow * 144 + spc * 16) = pq; *(LAS u32x4*)(Ks + srow * 144 + spc * 16) = pk;
#pragma unroll
        for (int i = 0; i < 2; ++i) *(LAS u32x4*)(Vs + srow * 272 + (spc + 8 * i) * 16) = pv[i];
#pragma unroll
        for (int i = 0; i < 4; ++i) { const int pc = c.tid + 512 * i, d2 = pc >> 10, rr = (pc >> 3) & 127, sp = pc & 7; *(LAS u32x4*)(CT0 + d2 * 18432 + rr * 144 + sp * 16) = pct[i]; }
        if (wave < 2) { const int d2 = wave; const float a = logsigf_(pga);
            const float bj = d2 ? wave_incl_suffix(a, lane) : wave_incl_prefix(a, lane);
            gt[d2 * 192 + lane] = bj; gt[d2 * 192 + 64 + lane] = pgi - bj; gt[d2 * 192 + 128 + lane] = pgn; }
        const u32x4 gate0 = pgate[0], gate1 = pgate[1];
        if (item + (int)gridDim.x < 2304) MO_PREFETCH(item + (int)gridDim.x);
        lds_barrier();
        const LAS float* g = gt + dir * 192; const LAS unsigned char* CT = CT0 + dir * 18432;
        const int j = 32 * jt + l31; const float bjj = g[j];
        bf16x8 qf[4];
#pragma unroll
        for (int kk = 0; kk < 4; ++kk) qf[kk] = row_frag(Qs, 144, 32 * jt, 16 * kk, lane);
        float qn = 0.f;
#pragma unroll
        for (int kk = 0; kk < 4; ++kk) { float qv[8]; unpack8(__builtin_bit_cast(u32x4, qf[kk]), qv);
#pragma unroll
            for (int e = 0; e < 8; ++e) qn += qv[e] * g[128 + 16 * kk + 8 * h5 + e]; }
        qn += __shfl_xor(qn, 32);
        f32x16 X[2]; float den = 0.f;
#pragma unroll
        for (int st = 0; st < 2; ++st) {
            X[st] = zero16();
            const bool live = dir ? (st >= jt) : (st <= jt);
            if (live) {
#pragma unroll
                for (int kk = 0; kk < 4; ++kk) X[st] = MFMA32(row_frag(Ks, 144, 32 * st, 16 * kk, lane), qf[kk], X[st]);
#pragma unroll
                for (int r = 0; r < 16; ++r) { const int s = 32 * st + crow(r, h5); const bool ok = dir ? (s >= j) : (s <= j);
                    const float w = ok ? __expf(bjj + g[64 + s]) : 0.f; X[st][r] *= w; den += X[st][r]; }
            }
        }
        den += __shfl_xor(den, 32);
        const float eb = __expf(bjj); den += eb * qn;
        const float scale = 1.0f / fmaxf(fabsf(den), 1.0f);
        f32x16 O[2];
#pragma unroll
        for (int t = 0; t < 2; ++t) {
            const int vt = 2 * vh + t; f32x16 z = zero16(), w = zero16();
#pragma unroll
            for (int st = 0; st < 2; ++st) { const bool live = dir ? (st >= jt) : (st <= jt);
                if (live) {
#pragma unroll
                    for (int step = 0; step < 2; ++step) z = MFMA32(tr_frag_perm(Vs, 272, 32 * st + 16 * step, 32 * vt, lane), pack_acc(X[st], step), z); } }
#pragma unroll
            for (int kk = 0; kk < 4; ++kk) w = MFMA32(row_frag(CT, 144, 32 * vt, 16 * kk, lane), qf[kk], w);
#pragma unroll
            for (int r = 0; r < 16; ++r) O[t][r] = (z[r] + eb * w[r]) * scale;
        }
        lds_barrier();
#pragma unroll
        for (int t = 0; t < 2; ++t) { const int vt = 2 * vh + t;
#pragma unroll
            for (int q = 0; q < 4; ++q) *(LAS f32x4*)(YO + dir * 8448 + j * 132 + 32 * vt + 8 * q + 4 * h5) = (f32x4){O[t][4 * q], O[t][4 * q + 1], O[t][4 * q + 2], O[t][4 * q + 3]}; }
        lds_barrier();
        { const int row = c.tid >> 3, c0 = (c.tid & 7) * 16; float y[16]; float ss = 0.f;
#pragma unroll
          for (int q = 0; q < 4; ++q) { const f32x4 a = *(const LAS f32x4*)(YO + row * 132 + c0 + 4 * q), bb = *(const LAS f32x4*)(YO + 8448 + row * 132 + c0 + 4 * q);
              y[4 * q] = a.x + bb.x; y[4 * q + 1] = a.y + bb.y; y[4 * q + 2] = a.z + bb.z; y[4 * q + 3] = a.w + bb.w; }
#pragma unroll
          for (int q = 0; q < 16; ++q) ss += y[q] * y[q];
          ss += __shfl_xor(ss, 1); ss += __shfl_xor(ss, 2); ss += __shfl_xor(ss, 4);
          const float r = 1.0f / sqrtf(ss * (1.0f / 128.0f) + EPS);
          float g0[8], g1[8];
          unpack8(gate0, g0); unpack8(gate1, g1);
          float o0[8], o1[8];
#pragma unroll
          for (int q = 0; q < 8; ++q) { o0[q] = y[q] * r * ng[h * 128 + c0 + q] * sigmoidf_(g0[q]); o1[q] = y[8 + q] * r * ng[h * 128 + c0 + 8 + q] * sigmoidf_(g1[q]); }
          *(u32x4*)(Y + (size_t)(r0 + row) * D + h * 128 + c0) = pack8(o0); *(u32x4*)(Y + (size_t)(r0 + row) * D + h * 128 + c0 + 8) = pack8(o1); }
    }
#undef MO_PREFETCH
#undef MO_DECODE
}

DI void phase_gla_decay(const Ctx& c) {
    const float* EX = WSP(float, WS_EXTRA); float* GB = WSP(float, WS_BIG + BIG_GB);
    LAS float* w2s = (LAS float*)c.lds; LAS float* gbs = w2s + 2048; LAS float* lgs = gbs + 128; LAS float* segs = lgs + 8192;
    const int srow = c.tid >> 3, dg = c.tid & 7;
    const int dir = (blockIdx.x >> 2) & 1, h = blockIdx.x & 3, nper = gridDim.x >> 3;
    __syncthreads();
    for (int i = c.tid; i < 2048; i += 512) w2s[i] = c.in[I_GLW2][(size_t)dir * 8192 + (i >> 7) * 512 + h * 128 + (i & 127)];
    if (c.tid < 128) gbs[c.tid] = c.in[I_GLGB][dir * 512 + h * 128 + c.tid];
    for (int ck = blockIdx.x >> 3; ck < 288; ck += nper) {
        const int r0 = 64 * ck;
        __syncthreads();
        f32x4 low[4];
#pragma unroll
        for (int q = 0; q < 4; ++q) low[q] = *(const f32x4*)(EX + (size_t)(r0 + srow) * 32 + dir * 16 + 4 * q);
        __syncthreads();
        { const int d0 = 16 * dg; float pre[16];
#pragma unroll
          for (int e = 0; e < 16; ++e) pre[e] = gbs[d0 + e];
#pragma unroll
          for (int r = 0; r < 16; ++r) { const float lv = low[r >> 2][r & 3];
#pragma unroll
              for (int q = 0; q < 4; ++q) { const f32x4 w = *(const LAS f32x4*)(w2s + r * 128 + d0 + 4 * q); pre[4 * q] += lv * w.x; pre[4 * q + 1] += lv * w.y; pre[4 * q + 2] += lv * w.z; pre[4 * q + 3] += lv * w.w; } }
#pragma unroll
          for (int q = 0; q < 4; ++q) *(LAS f32x4*)(lgs + srow * 128 + d0 + 4 * q) = (f32x4){logsigf_(pre[4 * q]) * 0.0625f, logsigf_(pre[4 * q + 1]) * 0.0625f, logsigf_(pre[4 * q + 2]) * 0.0625f, logsigf_(pre[4 * q + 3]) * 0.0625f}; }
        __syncthreads();
        { const int d = c.tid & 127, sg = c.tid >> 7; float v[16];
#pragma unroll
          for (int i = 0; i < 16; ++i) { const int s = dir ? 63 - (16 * sg + i) : 16 * sg + i; v[i] = lgs[s * 128 + d]; }
#pragma unroll
          for (int i = 1; i < 16; ++i) v[i] += v[i - 1];
          segs[sg * 128 + d] = v[15];
          __syncthreads();
          float off = 0.f;
#pragma unroll
          for (int g2 = 0; g2 < 3; ++g2) off += (g2 < sg) ? segs[g2 * 128 + d] : 0.f;
#pragma unroll
          for (int i = 0; i < 16; ++i) { const int s = dir ? 63 - (16 * sg + i) : 16 * sg + i; GB[((size_t)dir * TT + r0 + s) * 512 + h * 128 + d] = v[i] + off; } }
    }
}
DI void phase_gla_state(const Ctx& c) {
    const bf16* PC = WSP(bf16, WS_BIG + BIG_PC); const float* GB = WSP(float, WS_BIG + BIG_GB); bf16* GST = WSP(bf16, WS_BIG + BIG_GST);
    LAS float* tot = (LAS float*)c.lds;
    LAS unsigned char* Kd = c.lds + 1024; LAS unsigned char* Vs = Kd + 64 * 272;
    const int lane = c.lane, wave = c.wave, h5 = lane >> 5, l31 = lane & 31, dkt = wave & 3, dvt = wave >> 2;
    const int srow = c.tid >> 3, dg = c.tid & 7;
    for (int it0 = blockIdx.x; it0 < 256; it0 += gridDim.x) {
        const int item = (gridDim.x == 256) ? ((it0 & 7) * 32 + (it0 >> 3)) : it0;
        const int b = item >> 5, h = (item >> 3) & 3, dir = (item >> 2) & 1, dvq = item & 3, seq = (b * 4 + h) * 2 + dir;
        f32x16 acc = zero16();
        u32x4 kA0, kA1, vA, kB0, kB1, vB; f32x4 bvA[4], tvA[4], bvB[4], tvB[4];
#define GLA_PREFETCH(p_, k0, k1, vr, bv, tv) do { const int r0_ = chunk_row0((p_), b, dir), row = r0_ + srow; \
          k0 = *(const u32x4*)(PC + (size_t)row * 2048 + 512 + h * 128 + 16 * dg); k1 = *(const u32x4*)(PC + (size_t)row * 2048 + 512 + h * 128 + 16 * dg + 8); \
          vr = *(const u32x4*)(PC + (size_t)row * 2048 + 1024 + h * 256 + dvq * 64 + 8 * dg); \
          _Pragma("unroll") for (int q = 0; q < 4; ++q) { bv[q] = *(const f32x4*)(GB + ((size_t)dir * TT + row) * 512 + h * 128 + 16 * dg + 4 * q); \
              tv[q] = *(const f32x4*)(GB + ((size_t)dir * TT + r0_ + (dir ? 0 : 63)) * 512 + h * 128 + 16 * dg + 4 * q); } } while (0)
        GLA_PREFETCH(0, kA0, kA1, vA, bvA, tvA); GLA_PREFETCH(1, kB0, kB1, vB, bvB, tvB);
#define GLA_STEP(p, k0r, k1r, vr, bv, tv) do { \
            { bf16* dst = GST + ((size_t)seq * 36 + (p)) * 32768 + (size_t)(dvq * 64 + 32 * dvt + l31) * 128 + 32 * dkt + 4 * h5; \
              _Pragma("unroll") for (int q = 0; q < 4; ++q) { u32x2 w; w.x = cvt_pk_bf16(acc[4 * q], acc[4 * q + 1]); w.y = cvt_pk_bf16(acc[4 * q + 2], acc[4 * q + 3]); *(u32x2*)(dst + 8 * q) = w; } } \
            lds_barrier();                                    \
            { float kk[16]; { float t8[8]; unpack8(k0r, t8); \
                _Pragma("unroll") for (int e = 0; e < 8; ++e) kk[e] = t8[e]; unpack8(k1r, t8); \
                _Pragma("unroll") for (int e = 0; e < 8; ++e) kk[8 + e] = t8[e]; } \
              _Pragma("unroll") for (int e = 0; e < 16; ++e) kk[e] *= __expf(tv[e >> 2][e & 3] - bv[e >> 2][e & 3]); \
              const float k0[8] = {kk[0], kk[1], kk[2], kk[3], kk[4], kk[5], kk[6], kk[7]}, k1[8] = {kk[8], kk[9], kk[10], kk[11], kk[12], kk[13], kk[14], kk[15]}; \
              *(LAS u32x4*)(Kd + srow * 272 + dg * 32) = pack8(k0); *(LAS u32x4*)(Kd + srow * 272 + dg * 32 + 16) = pack8(k1); \
              *(LAS u32x4*)(Vs + srow * 144 + dg * 16) = vr; \
              if (srow == 0) { \
                  _Pragma("unroll") for (int q = 0; q < 4; ++q) *(LAS f32x4*)(tot + 16 * dg + 4 * q) = tv[q]; } } \
            if ((p) + 2 < 36) GLA_PREFETCH((p) + 2, k0r, k1r, vr, bv, tv); \
            lds_barrier(); \
            _Pragma("unroll") for (int r = 0; r < 16; ++r) acc[r] *= __expf(tot[32 * dkt + crow(r, h5)]); \
            _Pragma("unroll") for (int kk = 0; kk < 4; ++kk) acc = MFMA32(tr_frag(Kd, 272, 16 * kk, 32 * dkt, lane), tr_frag(Vs, 144, 16 * kk, 32 * dvt, lane), acc); \
            } while (0)
        for (int p = 0; p < 36; p += 2) { GLA_STEP(p, kA0, kA1, vA, bvA, tvA); GLA_STEP(p + 1, kB0, kB1, vB, bvB, tvB); }
#undef GLA_STEP
#undef GLA_PREFETCH
    }
}
DI void phase_gla_out(const Ctx& c, const float* ng) {
    const bf16* P = WSP(bf16, WS_P); const bf16* PC = WSP(bf16, WS_BIG + BIG_PC); const float* GB = WSP(float, WS_BIG + BIG_GB);
    const bf16* GST = WSP(bf16, WS_BIG + BIG_GST); bf16* Y = WSP(bf16, WS_Y);
    LAS unsigned char* Qt = c.lds; LAS unsigned char* Kt = Qt + 17408; LAS unsigned char* Vs = Kt + 17408; LAS unsigned char* STs = Vs + 33792;
    LAS float* YO = (LAS float*)STs;
    const int lane = c.lane, wave = c.wave, h5 = lane >> 5, l31 = lane & 31;
    const int srow = c.tid >> 3, dg = c.tid & 7;
    for (int item = blockIdx.x; item < 1152; item += gridDim.x) {
        const int b = item / 144, h = (item / 36) & 3, cc = item % 36;
        const int r0 = cc < 4 ? b * CTX + 64 * cc : TC + b * SEQ + 64 * (cc - 4);
        __syncthreads();
#pragma unroll
        for (int i = 0; i < 4; ++i) { const int pc = dg + 8 * i; *(LAS u32x4*)(Vs + srow * 528 + pc * 16) = *(const u32x4*)(PC + (size_t)(r0 + srow) * 2048 + 1024 + h * 256 + 8 * pc); }
        f32x16 O[2]; O[0] = zero16(); O[1] = zero16();
        for (int dir = 0; dir < 2; ++dir) {
            const int pslot = dir ? (cc < 4 ? 3 - cc : 39 - cc) : cc;
            if (dir) __syncthreads();
            { const bf16* src = GST + ((size_t)((b * 4 + h) * 2 + dir) * 36 + pslot) * 32768;
#pragma unroll
              for (int i = 0; i < 8; ++i) { const int pc = c.tid + 512 * i, rr = pc >> 4, sp = pc & 15; *(LAS u32x4*)(STs + rr * 272 + sp * 16) = *(const u32x4*)(src + rr * 128 + 8 * sp); } }
            { float qq[16], kk[16], bb[16]; float t8[8];
#pragma unroll
              for (int q = 0; q < 4; ++q) { const f32x4 t4 = *(const f32x4*)(GB + ((size_t)dir * TT + r0 + srow) * 512 + h * 128 + 16 * dg + 4 * q); bb[4 * q] = t4.x; bb[4 * q + 1] = t4.y; bb[4 * q + 2] = t4.z; bb[4 * q + 3] = t4.w; }
              unpack8(*(const u32x4*)(PC + (size_t)(r0 + srow) * 2048 + h * 128 + 16 * dg), t8);
#pragma unroll
              for (int e = 0; e < 8; ++e) qq[e] = t8[e];
              unpack8(*(const u32x4*)(PC + (size_t)(r0 + srow) * 2048 + h * 128 + 16 * dg + 8), t8);
#pragma unroll
              for (int e = 0; e < 8; ++e) qq[8 + e] = t8[e];
              unpack8(*(const u32x4*)(PC + (size_t)(r0 + srow) * 2048 + 512 + h * 128 + 16 * dg), t8);
#pragma unroll
              for (int e = 0; e < 8; ++e) kk[e] = t8[e];
              unpack8(*(const u32x4*)(PC + (size_t)(r0 + srow) * 2048 + 512 + h * 128 + 16 * dg + 8), t8);
#pragma unroll
              for (int e = 0; e < 8; ++e) kk[8 + e] = t8[e];
#pragma unroll
              for (int e = 0; e < 16; ++e) { const float eb = __expf(bb[e]); qq[e] *= eb; kk[e] *= 1.0f / eb; }
              const float q0[8] = {qq[0], qq[1], qq[2], qq[3], qq[4], qq[5], qq[6], qq[7]}, q1[8] = {qq[8], qq[9], qq[10], qq[11], qq[12], qq[13], qq[14], qq[15]};
              const float k0[8] = {kk[0], kk[1], kk[2], kk[3], kk[4], kk[5], kk[6], kk[7]}, k1[8] = {kk[8], kk[9], kk[10], kk[11], kk[12], kk[13], kk[14], kk[15]};
              *(LAS u32x4*)(Qt + srow * 272 + dg * 32) = pack8(q0); *(LAS u32x4*)(Qt + srow * 272 + dg * 32 + 16) = pack8(q1);
              *(LAS u32x4*)(Kt + srow * 272 + dg * 32) = pack8(k0); *(LAS u32x4*)(Kt + srow * 272 + dg * 32 + 16) = pack8(k1); }
            __syncthreads();
#pragma unroll
            for (int jt = 0; jt < 2; ++jt) {
#pragma unroll
                for (int st = 0; st < 2; ++st) {
                    const bool live = dir ? (st >= jt) : (st <= jt);
                    if (live) {
                        f32x16 X = zero16();
#pragma unroll
                        for (int kk = 0; kk < 8; ++kk) X = MFMA32(row_frag(Kt, 272, 32 * st, 16 * kk, lane), row_frag(Qt, 272, 32 * jt, 16 * kk, lane), X);
                        if (st == jt) {
#pragma unroll
                            for (int r = 0; r < 16; ++r) { const int s = crow(r, h5); const bool ok = dir ? (s >= l31) : (s <= l31); X[r] = ok ? X[r] : 0.f; } }
#pragma unroll
                        for (int step = 0; step < 2; ++step) O[jt] = MFMA32(tr_frag_perm(Vs, 528, 32 * st + 16 * step, 32 * wave, lane), pack_acc(X, step), O[jt]);
                    }
                }
#pragma unroll
                for (int kk = 0; kk < 8; ++kk) O[jt] = MFMA32(row_frag(STs, 272, 32 * wave, 16 * kk, lane), row_frag(Qt, 272, 32 * jt, 16 * kk, lane), O[jt]);
            }
        }
        __syncthreads();
#pragma unroll
        for (int jt = 0; jt < 2; ++jt)
#pragma unroll
            for (int q = 0; q < 4; ++q) *(LAS f32x4*)(YO + (32 * jt + l31) * 260 + 32 * wave + 8 * q + 4 * h5) = (f32x4){O[jt][4 * q], O[jt][4 * q + 1], O[jt][4 * q + 2], O[jt][4 * q + 3]};
        __syncthreads();
        { const int c0 = dg * 32; float y[32]; float ss = 0.f;
#pragma unroll
          for (int q = 0; q < 8; ++q) { const f32x4 a = *(const LAS f32x4*)(YO + srow * 260 + c0 + 4 * q); y[4 * q] = a.x; y[4 * q + 1] = a.y; y[4 * q + 2] = a.z; y[4 * q + 3] = a.w; }
#pragma unroll
          for (int q = 0; q < 32; ++q) ss += y[q] * y[q];
          ss += __shfl_xor(ss, 1); ss += __shfl_xor(ss, 2); ss += __shfl_xor(ss, 4);
          const float r = 1.0f / sqrtf(ss * (1.0f / 256.0f) + EPS);
#pragma unroll
          for (int q = 0; q < 4; ++q) { float g8[8], o8[8]; unpack8(*(const u32x4*)(P + (size_t)(r0 + srow) * PLD + 2048 + h * 256 + c0 + 8 * q), g8);
#pragma unroll
              for (int e = 0; e < 8; ++e) o8[e] = y[8 * q + e] * r * ng[h * 256 + c0 + 8 * q + e] * siluf_(g8[e]);
              *(u32x4*)(Y + (size_t)(r0 + srow) * D + h * 256 + c0 + 8 * q) = pack8(o8); } }
    }
}

DI void phase_gla_scan_naive(const Ctx& c) {
    const bf16* PC = WSP(bf16, WS_BIG + BIG_PC); const float* EX = WSP(float, WS_EXTRA);
    LAS float* qs = (LAS float*)c.lds; LAS float* ks = qs + 16 * 128; LAS float* as = ks + 16 * 128; LAS float* vs = as + 16 * 128; LAS float* lw = vs + 16 * 256;
    const int v = c.tid >> 1, d0 = (c.tid & 1) * 64;
    for (int item = blockIdx.x; item < 64; item += gridDim.x) {
        const int b = item >> 3, h = (item >> 1) & 3, dir = item & 1;
        float* Yo = WSP(float, WS_BIG + (dir ? BIG_YB : BIG_YF));
        const float* w2 = c.in[I_GLW2] + (size_t)dir * 16 * 512 + h * 128; const float* gb = c.in[I_GLGB] + dir * 512 + h * 128;
        float S[64];
#pragma unroll
        for (int d = 0; d < 64; ++d) S[d] = 0.f;
        for (int ch = 0; ch < (CTX + SEQ) / 16; ++ch) {
            __syncthreads();
            if (c.tid < 256) { const int st = c.tid >> 4, r = c.tid & 15, row = scan_row(ch * 16 + st, b, dir); lw[c.tid] = EX[(size_t)row * 32 + dir * 16 + r]; }
            for (int idx = c.tid; idx < 16 * 512; idx += 512) { const int st = idx >> 9, col = idx & 511, row = scan_row(ch * 16 + st, b, dir);
                if (col < 128) qs[st * 128 + col] = bf2f(PC[(size_t)row * 2048 + h * 128 + col]);
                else if (col < 256) ks[st * 128 + col - 128] = bf2f(PC[(size_t)row * 2048 + 512 + h * 128 + col - 128]);
                else vs[st * 256 + col - 256] = bf2f(PC[(size_t)row * 2048 + 1024 + h * 256 + col - 256]); }
            __syncthreads();
            for (int idx = c.tid; idx < 16 * 128; idx += 512) { const int st = idx >> 7, d = idx & 127; float pre = gb[d];
#pragma unroll
                for (int r = 0; r < 16; ++r) pre += lw[st * 16 + r] * w2[r * 512 + d];
                as[idx] = __expf(logsigf_(pre) * (1.0f / 16.0f)); }
            __syncthreads();
            for (int st = 0; st < 16; ++st) {
                const float vv = vs[st * 256 + v]; float part = 0.f;
#pragma unroll
                for (int d = 0; d < 64; ++d) { S[d] = as[st * 128 + d0 + d] * S[d] + ks[st * 128 + d0 + d] * vv; part += qs[st * 128 + d0 + d] * S[d]; }
                part += __shfl_xor(part, 1);
                if ((c.tid & 1) == 0) { const int row = scan_row(ch * 16 + st, b, dir); Yo[(size_t)row * D + h * 256 + v] = part; }
            }
        }
    }
}
DI void phase_headnorm(const Ctx& c, int hd, const float* ng) {
    const float* YF = WSP(float, WS_BIG + BIG_YF); const float* YB = WSP(float, WS_BIG + BIG_YB); const bf16* P = WSP(bf16, WS_P); bf16* Y = WSP(bf16, WS_Y);
    for (int row = c.gw; row < TT; row += c.ngw) {
        const int c0 = 16 * c.lane; float y[16]; float ss = 0.f;
#pragma unroll
        for (int j = 0; j < 4; ++j) { const f32x4 a = *(const f32x4*)(YF + (size_t)row * D + c0 + 4 * j), bb = *(const f32x4*)(YB + (size_t)row * D + c0 + 4 * j);
            y[4 * j] = a.x + bb.x; y[4 * j + 1] = a.y + bb.y; y[4 * j + 2] = a.z + bb.z; y[4 * j + 3] = a.w + bb.w; }
#pragma unroll
        for (int j = 0; j < 16; ++j) ss += y[j] * y[j];
        ss += __shfl_xor(ss, 1); ss += __shfl_xor(ss, 2); ss += __shfl_xor(ss, 4); if (hd == 256) ss += __shfl_xor(ss, 8);
        const float r = 1.0f / sqrtf(ss / (float)hd + EPS);
        float g0[8], g1[8];
        unpack8(*(const u32x4*)(P + (size_t)row * PLD + 2048 + c0), g0); unpack8(*(const u32x4*)(P + (size_t)row * PLD + 2048 + c0 + 8), g1);
        float o[16];
#pragma unroll
        for (int j = 0; j < 16; ++j) { const float gp = j < 8 ? g0[j] : g1[j - 8]; o[j] = y[j] * r * ng[c0 + j] * (hd == 128 ? sigmoidf_(gp) : siluf_(gp)); }
        const float o0[8] = {o[0], o[1], o[2], o[3], o[4], o[5], o[6], o[7]}, o1[8] = {o[8], o[9], o[10], o[11], o[12], o[13], o[14], o[15]};
        *(u32x4*)(Y + (size_t)row * D + c0) = pack8(o0); *(u32x4*)(Y + (size_t)row * D + c0 + 8) = pack8(o1);
    }
}
DI void phase_hyena_conv_naive(const Ctx& c) {
    const bf16* PC = WSP(bf16, WS_BIG + BIG_PC); bf16* Y = WSP(bf16, WS_Y); const float* skip = c.in[I_HYSKIP];
    LAS float* zt = (LAS float*)c.lds;
    LAS float* ft = zt + 4096;
    const int cc = c.tid & 63, tg = c.tid >> 6;
    for (int item = blockIdx.x; item < 4096 + 512; item += gridDim.x) {
        int L, rb, tt, cgi; const float* tab;
        if (item < 4096) { L = SEQ; const int b = item >> 9; tt = (item >> 4) & 31; cgi = item & 15; rb = TC + b * SEQ; tab = WSP(float, WS_HF); }
        else { const int it = item - 4096; L = CTX; const int b = it >> 6; tt = (it >> 4) & 3; cgi = it & 15; rb = b * CTX; tab = WSP(float, WS_HFC); }
        const int t0 = 64 * tt, c0 = 64 * cgi;
        float acc[8];
#pragma unroll
        for (int i = 0; i < 8; ++i) acc[i] = 0.f;
        for (int sb = 0; sb < L / 64; ++sb) {
            const int s0 = 64 * sb;
            __syncthreads();
            for (int idx = c.tid; idx < 4096; idx += 512) { const int sl = idx >> 6, ch = idx & 63; const size_t o = (size_t)(rb + s0 + sl) * PLD + c0 + ch;
                zt[idx] = bf2f(PC[o + 1024]) * bf2f(PC[o + 2048]); }
            for (int idx = c.tid; idx < 64 * 128; idx += 512) { const int ch = idx >> 7, j = idx & 127;
                if (j < 127) ft[j * 65 + ch] = tab[(size_t)(c0 + ch) * (2 * L) + L + (t0 - s0 - 63 + j)]; }
            __syncthreads();
#pragma unroll 1
            for (int g = 0; g < 8; ++g) {
                float w[15], z[8]; const int base = 8 * (tg - g) + 56;
#pragma unroll
                for (int m = 0; m < 15; ++m) w[m] = ft[(base + m) * 65 + cc];
#pragma unroll
                for (int j = 0; j < 8; ++j) z[j] = zt[(8 * g + j) * 64 + cc];
#pragma unroll
                for (int i = 0; i < 8; ++i)
#pragma unroll
                    for (int j = 0; j < 8; ++j) acc[i] += w[i - j + 7] * z[j];
            }
        }
#pragma unroll
        for (int i = 0; i < 8; ++i) { const int row = rb + t0 + 8 * tg + i; const size_t o = (size_t)row * PLD + c0 + cc;
            const float zin = bf2f(PC[o + 1024]) * bf2f(PC[o + 2048]), x0 = bf2f(PC[o]);
            Y[(size_t)row * D + c0 + cc] = f2bf(x0 * (acc[i] + skip[c0 + cc] * zin)); }
    }
}

DI void hy_item(int item, int& L, int& b, int& t0, int& c0, int& rb) {
    if (item < 4096) { L = SEQ; b = item >> 9; t0 = 64 * ((item >> 4) & 31); c0 = 64 * (item & 15); rb = TC + b * SEQ; }
    else { const int it = item - 4096; L = CTX; b = it >> 6; t0 = 64 * ((it >> 4) & 3); c0 = 64 * (it & 15); rb = b * CTX; }
}
DI void phase_hy_prep(const Ctx& c) {
    const bf16* P = WSP(bf16, WS_P); bf16* X0C = WSP(bf16, WS_BIG + BIG_PC); const float* cw = c.in[I_HYCW]; const float* cb = c.in[I_HYCB];
    LAS unsigned char* raw = c.lds;
    LAS float* zt = (LAS float*)(c.lds + 32768);
    u32x4 pre[4];
#define HP_PREF(it_) do { int L_, b_, t0_, c0_, rb_; hy_item((it_), L_, b_, t0_, c0_, rb_); \
        _Pragma("unroll") for (int k = 0; k < 4; ++k) { const int pc = c.tid + 512 * k; pre[k] = (u32x4){c.z, c.z, c.z, c.z}; \
            if (pc < 3 * 66 * 8) { const int g = pc / 528, rr = (pc % 528) >> 3, sp = pc & 7, t = t0_ - 1 + rr; \
                if (t >= 0 && t < L_) pre[k] = *(const u32x4*)(P + (size_t)(rb_ + t) * PLD + g * 1024 + c0_ + 8 * sp); } } } while (0)
    if ((int)blockIdx.x < 4608) HP_PREF((int)blockIdx.x);
    for (int item = blockIdx.x; item < 4608; item += gridDim.x) {
        int L, b, t0, c0, rb; hy_item(item, L, b, t0, c0, rb);
        bf16* ZT = L == SEQ ? WSP(bf16, WS_BIG + BIG_ZTL) : WSP(bf16, WS_BIG + BIG_ZTC);
        lds_barrier();
#pragma unroll
        for (int k = 0; k < 4; ++k) { const int pc = c.tid + 512 * k; if (pc < 3 * 66 * 8) { const int g = pc / 528, rr = (pc % 528) >> 3, sp = pc & 7; *(LAS u32x4*)(raw + (g * 66 + rr) * 128 + sp * 16) = pre[k]; } }
        if (item + (int)gridDim.x < 4608) HP_PREF(item + (int)gridDim.x);
        lds_barrier();
        { const int t = c.tid >> 3, sp = c.tid & 7; float u[3][8];
#pragma unroll
          for (int g = 0; g < 3; ++g) { float xm[8], x0[8], xp[8];
              unpack8(*(const LAS u32x4*)(raw + (g * 66 + t) * 128 + sp * 16), xm); unpack8(*(const LAS u32x4*)(raw + (g * 66 + t + 1) * 128 + sp * 16), x0); unpack8(*(const LAS u32x4*)(raw + (g * 66 + t + 2) * 128 + sp * 16), xp);
              const int col = g * 1024 + c0 + 8 * sp;
#pragma unroll
              for (int e = 0; e < 8; ++e) u[g][e] = cw[col + e] * xm[e] + cw[3072 + col + e] * x0[e] + cw[6144 + col + e] * xp[e] + cb[col + e]; }
          *(u32x4*)(X0C + (size_t)(rb + t0 + t) * 1024 + c0 + 8 * sp) = pack8(u[0]);
#pragma unroll
          for (int e = 0; e < 8; ++e) zt[t * 65 + 8 * sp + e] = u[1][e] * u[2][e]; }
        lds_barrier();
        { const int ch = c.tid >> 3, tp = c.tid & 7; float z[8];
#pragma unroll
          for (int e = 0; e < 8; ++e) z[e] = zt[(8 * tp + e) * 65 + ch];
          *(u32x4*)(ZT + ((size_t)(c0 + ch) * NB + b) * L + t0 + 8 * tp) = pack8(z); }
    }
#undef HP_PREF
}
template <int L>
DI void hy_toeplitz_channel(const Ctx& c, const float* hrow  , const bf16* zsrc  , bf16* ydst  ) {
    constexpr int NBK = L / 32, CP = 2 * L + 8, NT = (NBK + 31) / 32, DMIN = -(NBK - 1), DMAX = NBK - 1;
    LAS unsigned char* F = c.lds;
    LAS unsigned char* Zs = c.lds + 8 * CP * 2;
    LAS unsigned char* R1 = Zs + (8 * NBK + 1) * 80;
    const int lane = c.lane, w = c.wave, h5 = lane >> 5, a = lane & 31, pi = lane & 15, rho = (lane >> 4) & 1;
    __syncthreads();
    for (int g = c.tid; g < (2 * L + 16) / 8; g += 512) { float v[8];
#pragma unroll
        for (int j = 0; j < 8; ++j) { const int y = 8 * g + j; v[j] = (y >= 1 && y <= 2 * L - 1) ? hrow[2 * L - y] : 0.f; }
        *(LAS u32x4*)(R1 + g * 16) = pack8(v); }
    if (c.tid < 20) *(LAS unsigned*)(Zs + 8 * NBK * 80 + 4 * c.tid) = c.z;
    for (int pc = c.tid; pc < 8 * L / 8; pc += 512) { const int bb = pc / (L / 8), pj = pc % (L / 8);
        *(LAS u32x4*)(Zs + (bb * NBK + (pj >> 2)) * 80 + (pj & 3) * 16) = *(const u32x4*)(zsrc + (size_t)bb * L + 8 * pj); }
    __syncthreads();
    for (int g = c.tid; g < 2 * L / 8; g += 512) {
        const u32x4 lo = *(const LAS u32x4*)(R1 + g * 16), hi = *(const LAS u32x4*)(R1 + g * 16 + 16);
        const unsigned Dw[8] = {lo.x, lo.y, lo.z, lo.w, hi.x, hi.y, hi.z, hi.w};
#pragma unroll
        for (int r = 0; r < 8; ++r) { u32x4 o;
            if (r & 1) { o.x = __builtin_amdgcn_alignbit(Dw[r / 2 + 1], Dw[r / 2], 16); o.y = __builtin_amdgcn_alignbit(Dw[r / 2 + 2], Dw[r / 2 + 1], 16);
                         o.z = __builtin_amdgcn_alignbit(Dw[r / 2 + 3], Dw[r / 2 + 2], 16); o.w = __builtin_amdgcn_alignbit(Dw[r / 2 + 4], Dw[r / 2 + 3], 16); }
            else { o.x = Dw[r / 2]; o.y = Dw[r / 2 + 1]; o.z = Dw[r / 2 + 2]; o.w = Dw[r / 2 + 3]; }
            *(LAS u32x4*)(F + (r * CP + 8 * g) * 2) = o; } }
    __syncthreads();
    const int r = (-a) & 7;
    f32x16 acc[NT];
    u32x4 Bf[2][NT][2];
#define HY_BLK(blk_) ((unsigned)(blk_) < (unsigned)NBK ? w * NBK + (blk_) : 8 * NBK)
#pragma unroll
    for (int q = 0; q < NT; ++q) { acc[q] = zero16();
#pragma unroll
        for (int par = 0; par < 2; ++par)
#pragma unroll
            for (int step = 0; step < 2; ++step) Bf[par][q][step] = *(const LAS u32x4*)(Zs + HY_BLK(32 * q + 2 * pi + rho - (DMIN + par)) * 80 + 32 * step + 16 * h5); }
    for (int d0 = DMIN; d0 <= DMAX; d0 += 2) {
#pragma unroll
        for (int par = 0; par < 2; ++par) {
            const int d = d0 + par;
            if (d <= DMAX) {
#pragma unroll
                for (int step = 0; step < 2; ++step) {
                    const int y0 = L - 32 * d - a + 16 * step + 8 * h5;
                    const bf16x8 A = *(const LAS bf16x8*)(F + (r * CP + (y0 - r)) * 2);
#pragma unroll
                    for (int q = 0; q < NT; ++q) if (d >= 32 * q - (NBK - 1) && d <= 32 * q + 31) acc[q] = MFMA32(A, __builtin_bit_cast(bf16x8, Bf[par][q][step]), acc[q]);
                }
#pragma unroll
                for (int q = 0; q < NT; ++q)
#pragma unroll
                    for (int step = 0; step < 2; ++step) {
                        const u32x4 fr = *(const LAS u32x4*)(Zs + HY_BLK(32 * q + rho - (d + 2)) * 80 + 32 * step + 16 * h5); u32x4 nb;
                        nb.x = (unsigned)__builtin_amdgcn_update_dpp((int)fr.x, (int)Bf[par][q][step].x, 0x111, 0xf, 0xf, false);
                        nb.y = (unsigned)__builtin_amdgcn_update_dpp((int)fr.y, (int)Bf[par][q][step].y, 0x111, 0xf, 0xf, false);
                        nb.z = (unsigned)__builtin_amdgcn_update_dpp((int)fr.z, (int)Bf[par][q][step].z, 0x111, 0xf, 0xf, false);
                        nb.w = (unsigned)__builtin_amdgcn_update_dpp((int)fr.w, (int)Bf[par][q][step].w, 0x111, 0xf, 0xf, false);
                        Bf[par][q][step] = nb; }
            }
        }
    }
#undef HY_BLK
#pragma unroll
    for (int q = 0; q < NT; ++q) { const int i = 32 * q + 2 * pi + rho;
        if (i < NBK) {
#pragma unroll
            for (int qq = 0; qq < 4; ++qq) { u32x2 o; o.x = cvt_pk_bf16(acc[q][4 * qq], acc[q][4 * qq + 1]); o.y = cvt_pk_bf16(acc[q][4 * qq + 2], acc[q][4 * qq + 3]);
                *(u32x2*)(ydst + (size_t)w * L + 32 * i + 8 * qq + 4 * h5) = o; } } }
}
DI void phase_hy_toeplitz(const Ctx& c) {
    for (int ch = blockIdx.x; ch < 1024; ch += gridDim.x) {
        hy_toeplitz_channel<SEQ>(c, WSP(float, WS_HF) + (size_t)ch * 4096, WSP(bf16, WS_BIG + BIG_ZTL) + (size_t)ch * NB * SEQ, WSP(bf16, WS_BIG + BIG_YTL) + (size_t)ch * NB * SEQ);
        hy_toeplitz_channel<CTX>(c, WSP(float, WS_HFC) + (size_t)ch * 512, WSP(bf16, WS_BIG + BIG_ZTC) + (size_t)ch * NB * CTX, WSP(bf16, WS_BIG + BIG_YTC) + (size_t)ch * NB * CTX);
    }
}
DI void phase_hy_post(const Ctx& c) {
    const bf16* X0C = WSP(bf16, WS_BIG + BIG_PC); bf16* Y = WSP(bf16, WS_Y); const float* skip = c.in[I_HYSKIP];
    LAS float* tl = (LAS float*)c.lds;
    u32x4 py, pz, px; float psk = 0.f;
#define HQ_PREF(it_) do { int L_, b_, t0_, c0_, rb_; hy_item((it_), L_, b_, t0_, c0_, rb_); \
        const bf16* ZT_ = L_ == SEQ ? WSP(bf16, WS_BIG + BIG_ZTL) : WSP(bf16, WS_BIG + BIG_ZTC); const bf16* YT_ = L_ == SEQ ? WSP(bf16, WS_BIG + BIG_YTL) : WSP(bf16, WS_BIG + BIG_YTC); \
        const int ch_ = c.tid >> 3, tp_ = c.tid & 7; const size_t o_ = ((size_t)(c0_ + ch_) * NB + b_) * L_ + t0_ + 8 * tp_; \
        py = *(const u32x4*)(YT_ + o_); pz = *(const u32x4*)(ZT_ + o_); psk = skip[c0_ + ch_]; \
        px = *(const u32x4*)(X0C + (size_t)(rb_ + t0_ + (c.tid >> 3)) * 1024 + c0_ + 8 * (c.tid & 7)); } while (0)
    if ((int)blockIdx.x < 4608) HQ_PREF((int)blockIdx.x);
    for (int item = blockIdx.x; item < 4608; item += gridDim.x) {
        int L, b, t0, c0, rb; hy_item(item, L, b, t0, c0, rb); (void)L; (void)b;
        lds_barrier();
        { const int ch = c.tid >> 3, tp = c.tid & 7; float y[8], z[8]; unpack8(py, y); unpack8(pz, z); const float sk = psk;
#pragma unroll
          for (int e = 0; e < 8; ++e) tl[ch * 65 + 8 * tp + e] = y[e] + sk * z[e]; }
        const u32x4 xc = px;
        if (item + (int)gridDim.x < 4608) HQ_PREF(item + (int)gridDim.x);
        lds_barrier();
        { const int t = c.tid >> 3, sp = c.tid & 7; float x0[8], o[8]; unpack8(xc, x0);
#pragma unroll
          for (int e = 0; e < 8; ++e) o[e] = x0[e] * tl[(8 * sp + e) * 65 + t];
          *(u32x4*)(Y + (size_t)(rb + t0 + t) * D + c0 + 8 * sp) = pack8(o); }
    }
#undef HQ_PREF
}

DI void phase_route(const Ctx& c, int l) {
    LAS float* rw = (LAS float*)c.lds;
    LAS int* lcnt = (LAS int*)(c.lds + 65536);
    LAS int* rinfo = lcnt + 32;
    LAS float* rwt = (LAS float*)(rinfo + 4 * 128);
    { const f32x4* srcw = (const f32x4*)WSP(float, WS_RWT);
#pragma unroll
      for (int i = 0; i < 8; ++i) *(LAS f32x4*)(rw + 4 * (c.tid + 512 * i)) = srcw[c.tid + 512 * i]; }
    if (c.tid < 16) lcnt[c.tid] = 0;
    __syncthreads();
    const float* MOD = WSP(float, WS_MOD) + (size_t)l * 9 * 6144; const float* g = c.in[I_N2G] + l * D; bf16* H = WSP(bf16, WS_H);
    const bf16* X = WSP(bf16, WS_X); const bf16* XC = WSP(bf16, WS_XC);
    unsigned* cnt = WSP(unsigned, WS_CTL) + CW_CNT + l * 16; int* TOK = WSP(int, WS_TOK); float* TOKW = WSP(float, WS_TOK + 512 * 1024);
    const float rbl = c.lane < 16 ? c.in[I_RB][c.lane] : 0.f;
    const int rlo = (l == 3 ? TC : 0), nrow = TT - rlo, per = (nrow + (int)gridDim.x - 1) / (int)gridDim.x;
    const int brow0 = rlo + (int)blockIdx.x * per, bn = min(per, TT - brow0);
    f32x4 vn[4];
    if (c.wave < bn) { const int row = brow0 + c.wave; load_row_bf(row < TC ? XC + (size_t)row * D : X + (size_t)(row - TC) * D, vn, c.lane); }
    for (int lr = c.wave; lr < bn; lr += 8) {
        const int row = brow0 + lr;
        f32x4 v[4];
#pragma unroll
        for (int j = 0; j < 4; ++j) v[j] = vn[j];
        if (lr + 8 < bn) { const int rn = row + 8; load_row_bf(rn < TC ? XC + (size_t)rn * D : X + (size_t)(rn - TC) * D, vn, c.lane); }
        const int mr = row < TC ? 8 : (row - TC) >> 11;
        norm_row(v, g, c.lane); mod_row(v, MOD + mr * 6144 + 3072, MOD + mr * 6144 + 4096, c.lane);
        store_row_bf16(H + (size_t)row * D, v, c.lane);
        float s16[16];
#pragma unroll
        for (int e = 0; e < 16; ++e) { float s = 0.f;
#pragma unroll
            for (int j = 0; j < 4; ++j) { const f32x4 w = *(const LAS f32x4*)(rw + e * 1024 + 256 * j + 4 * c.lane); s += (v[j].x * w.x + v[j].y * w.y) + (v[j].z * w.z + v[j].w * w.w); }
            s16[e] = s; if ((e & 3) == 3) asm volatile("" ::: "memory"); }
        float s8[8], s4[4], s2[2], s1;
        { const bool up = (c.lane & 32) != 0;
#pragma unroll
          for (int i = 0; i < 8; ++i) { const float keep = up ? s16[8 + i] : s16[i], give = up ? s16[i] : s16[8 + i]; s8[i] = keep + __shfl_xor(give, 32); } }
        { const bool up = (c.lane & 16) != 0;
#pragma unroll
          for (int i = 0; i < 4; ++i) { const float keep = up ? s8[4 + i] : s8[i], give = up ? s8[i] : s8[4 + i]; s4[i] = keep + __shfl_xor(give, 16); } }
        { const bool up = (c.lane & 8) != 0;
#pragma unroll
          for (int i = 0; i < 2; ++i) { const float keep = up ? s4[2 + i] : s4[i], give = up ? s4[i] : s4[2 + i]; s2[i] = keep + __shfl_xor(give, 8); } }
        { const bool up = (c.lane & 4) != 0; const float keep = up ? s2[1] : s2[0], give = up ? s2[0] : s2[1]; s1 = keep + __shfl_xor(give, 4); }
        s1 += __shfl_xor(s1, 2); s1 += __shfl_xor(s1, 1);
        const int eb = c.lane & 15; const int srcl = (((eb >> 3) & 1) << 5) | (((eb >> 2) & 1) << 4) | (((eb >> 1) & 1) << 3) | ((eb & 1) << 2);
        const float sc = sigmoidf_(__shfl(s1, srcl));
        const float sel = sc + rbl;
        float m1 = sel, m2 = -1e30f;
        { const float o1 = __shfl_xor(sel, 1); const float hi = fmaxf(sel, o1), lo = fminf(sel, o1);
          const float ohi = __shfl_xor(hi, 2), olo = __shfl_xor(lo, 2);
          m1 = fmaxf(hi, ohi); m2 = fmaxf(fminf(hi, ohi), fmaxf(lo, olo)); }
        const float gs = m1 + m2;
        const float g0 = __shfl(gs, 0), g1 = __shfl(gs, 4), g2 = __shfl(gs, 8), g3 = __shfl(gs, 12);
        int bg = 0; float bgs = g0; if (g1 > bgs) { bgs = g1; bg = 1; } if (g2 > bgs) { bgs = g2; bg = 2; } if (g3 > bgs) { bgs = g3; bg = 3; }
        float s4b[4], p4b[4];
#pragma unroll
        for (int j = 0; j < 4; ++j) { s4b[j] = __shfl(sel, 4 * bg + j); p4b[j] = __shfl(sc, 4 * bg + j); }
        int i1 = 0; float v1 = s4b[0], q1 = p4b[0];
#pragma unroll
        for (int j = 1; j < 4; ++j) if (s4b[j] > v1) { v1 = s4b[j]; i1 = j; q1 = p4b[j]; }
        int i2 = -1; float v2 = -1e30f, q2 = 0.f;
#pragma unroll
        for (int j = 0; j < 4; ++j) if (j != i1 && s4b[j] > v2) { v2 = s4b[j]; i2 = j; q2 = p4b[j]; }
        if (c.lane == 0) {
            const int e0 = 4 * bg + i1, e1 = 4 * bg + i2;
            const int p0 = __hip_atomic_fetch_add(lcnt + e0, 1, __ATOMIC_RELAXED, __HIP_MEMORY_SCOPE_WORKGROUP), p1 = __hip_atomic_fetch_add(lcnt + e1, 1, __ATOMIC_RELAXED, __HIP_MEMORY_SCOPE_WORKGROUP);
            rinfo[lr * 4 + 0] = e0; rinfo[lr * 4 + 1] = p0; rinfo[lr * 4 + 2] = e1; rinfo[lr * 4 + 3] = p1;
            const float inv = 1.0f / (q1 + q2); rwt[lr * 2] = q1 * inv; rwt[lr * 2 + 1] = q2 * inv;
        }
    }
    __syncthreads();
    if (c.tid < 16) lcnt[16 + c.tid] = (int)atomicAdd(cnt + c.tid, (unsigned)lcnt[c.tid]);
    __syncthreads();
    for (int lr = c.tid; lr < bn; lr += 512) { const int row = brow0 + lr, e0 = rinfo[lr * 4], e1 = rinfo[lr * 4 + 2];
        TOK[row * 4 + 0] = e0; TOK[row * 4 + 1] = lcnt[16 + e0] + rinfo[lr * 4 + 1]; TOK[row * 4 + 2] = e1; TOK[row * 4 + 3] = lcnt[16 + e1] + rinfo[lr * 4 + 3];
        TOKW[row * 2] = rwt[lr * 2]; TOKW[row * 2 + 1] = rwt[lr * 2 + 1]; }
}
DI void slot_bases(const unsigned* cnt, int lane, int e0, int e1, int& b0, int& b1) {
    const unsigned mine = lane < 16 ? ((cnt[lane] + 255u) & ~255u) : 0u; unsigned pb = 0; b0 = 0; b1 = 0;
#pragma unroll
    for (int e = 0; e < 16; ++e) { const unsigned ce = __shfl(mine, e); if (e == e0) b0 = (int)pb; if (e == e1) b1 = (int)pb; pb += ce; }
}
DI void phase_gather(const Ctx& c, int l) {
    const unsigned* cnt = WSP(unsigned, WS_CTL) + CW_CNT + l * 16; const int* TOK = WSP(int, WS_TOK); int* TOKS = WSP(int, WS_TOK + 768 * 1024);
    const bf16* H = WSP(bf16, WS_H); bf16* HS = WSP(bf16, WS_BIG + BIG_HS);
    const unsigned minep = c.lane < 16 ? ((cnt[c.lane] + 255u) & ~255u) : 0u; unsigned pb = 0; int mybase = 0;
#pragma unroll
    for (int e = 0; e < 16; ++e) { const unsigned ce = __shfl(minep, e); if (c.lane == e) mybase = (int)pb; pb += ce; }
    const int rfirst = (l == 3 ? TC : 0) + c.gw, rstep = c.ngw;
    int e0n = 0, p0n = 0, e1n = 0, p1n = 0; u32x4 an = {0u, 0u, 0u, 0u}, bn = an;
    if (rfirst < TT) { e0n = TOK[rfirst * 4]; p0n = TOK[rfirst * 4 + 1]; e1n = TOK[rfirst * 4 + 2]; p1n = TOK[rfirst * 4 + 3];
        an = *(const u32x4*)(H + (size_t)rfirst * D + 8 * c.lane); bn = *(const u32x4*)(H + (size_t)rfirst * D + 512 + 8 * c.lane); }
    for (int row = rfirst; row < TT; row += rstep) {
        const int e0 = e0n, p0 = p0n, e1 = e1n, p1 = p1n; const u32x4 a = an, bq = bn;
        if (row + rstep < TT) { const int r = row + rstep; e0n = TOK[r * 4]; p0n = TOK[r * 4 + 1]; e1n = TOK[r * 4 + 2]; p1n = TOK[r * 4 + 3];
            an = *(const u32x4*)(H + (size_t)r * D + 8 * c.lane); bn = *(const u32x4*)(H + (size_t)r * D + 512 + 8 * c.lane); }
        const int s0 = __shfl(mybase, e0) + p0, s1 = __shfl(mybase, e1) + p1;
        *(u32x4*)(HS + (size_t)s0 * D + 8 * c.lane) = a; *(u32x4*)(HS + (size_t)s0 * D + 512 + 8 * c.lane) = bq;
        *(u32x4*)(HS + (size_t)s1 * D + 8 * c.lane) = a; *(u32x4*)(HS + (size_t)s1 * D + 512 + 8 * c.lane) = bq;
        if (c.lane == 0) { TOKS[row * 2] = s0; TOKS[row * 2 + 1] = s1; }
    }
}
DI LAS int* moe_tiles(const Ctx& c, int l, int nsh) {
    LAS int* tp = (LAS int*)(c.lds + MISC_OFF);
    LAS int* ul = tp + 192;
    __syncthreads();
    if (c.tid < 64) {
        const unsigned* cnt = WSP(unsigned, WS_CTL) + CW_CNT + l * 16;
        const int mine = c.lane < 16 ? (int)((cnt[c.lane] + 255u) >> 8) : 0; int p = 0;
        for (int e = 0; e < 16; ++e) { const int ne = __shfl(mine, e); for (int t = c.lane; t < ne; t += 64) tp[1 + p + t] = e; p += ne; }
        if (c.lane == 0) tp[0] = p;
    }
    __syncthreads();
    if (c.tid < 32) {
        const int i = c.tid, ntile = tp[0], G = gridDim.x, cb = blockIdx.x; int rt = 1 << 20, pn = 0;
        if ((G & 7) == 0 && ((G >> 3) >> nsh) > 0) { const int x = cb & 7, v = cb >> 3, rpx = (G >> 3) >> nsh;
            if (v < (rpx << nsh)) { rt = (i * 8 + x) * rpx + (v >> nsh); pn = v & ((1 << nsh) - 1); } }
        else { const int L = i * G + cb; rt = L >> nsh; pn = L & ((1 << nsh) - 1); }
        ul[i] = rt < ntile ? (rt | (pn << 12) | (tp[1 + rt] << 16)) : -1;
    }
    __syncthreads();
    return ul;
}
DI void phase_combine(const Ctx& c, int l) {
    const float* MOD = WSP(float, WS_MOD) + (size_t)l * 9 * 6144; const int* TOKS = WSP(int, WS_TOK + 768 * 1024); const float* TOKW = WSP(float, WS_TOK + 512 * 1024);
    const bf16* YS = WSP(bf16, WS_BIG + BIG_HS); bf16* X = WSP(bf16, WS_X); bf16* XC = WSP(bf16, WS_XC); bf16* H = WSP(bf16, WS_H);
    const int rfirst = (l == 3 ? TC : 0) + c.gw, rstep = c.ngw;
    int sa0 = 0, sa1 = 0, sb0 = 0, sb1 = 0; float wa0 = 0.f, wa1 = 0.f, wb0 = 0.f, wb1 = 0.f;
    u32x2 dx[4], dy0[4], dy1[4];
#define CB_XP(r_) ((r_) < TC ? XC + (size_t)(r_) * D : X + (size_t)((r_) - TC) * D)
#define CB_LOAD(r_, s0_, s1_) do { const bf16* xq = CB_XP(r_); _Pragma("unroll") for (int j = 0; j < 4; ++j) { dx[j] = *(const u32x2*)(xq + 256 * j + 4 * c.lane); \
        dy0[j] = *(const u32x2*)(YS + (size_t)(s0_) * D + 256 * j + 4 * c.lane); dy1[j] = *(const u32x2*)(YS + (size_t)(s1_) * D + 256 * j + 4 * c.lane); } } while (0)
    if (rfirst < TT) { sa0 = TOKS[rfirst * 2]; sa1 = TOKS[rfirst * 2 + 1]; wa0 = TOKW[rfirst * 2]; wa1 = TOKW[rfirst * 2 + 1]; }
    if (rfirst + rstep < TT) { const int r = rfirst + rstep; sb0 = TOKS[r * 2]; sb1 = TOKS[r * 2 + 1]; wb0 = TOKW[r * 2]; wb1 = TOKW[r * 2 + 1]; }
    if (rfirst < TT) CB_LOAD(rfirst, sa0, sa1);
    for (int row = rfirst; row < TT; row += rstep) {
        const int mr = row < TC ? 8 : (row - TC) >> 11; bf16* xp = CB_XP(row);
        const float w0 = wa0, w1 = wa1;
        f32x4 v[4], ya[4], yb[4];
#pragma unroll
        for (int j = 0; j < 4; ++j) {
            v[j] = (f32x4){__uint_as_float(dx[j].x << 16), __uint_as_float(dx[j].x & 0xffff0000u), __uint_as_float(dx[j].y << 16), __uint_as_float(dx[j].y & 0xffff0000u)};
            ya[j] = (f32x4){__uint_as_float(dy0[j].x << 16), __uint_as_float(dy0[j].x & 0xffff0000u), __uint_as_float(dy0[j].y << 16), __uint_as_float(dy0[j].y & 0xffff0000u)};
            yb[j] = (f32x4){__uint_as_float(dy1[j].x << 16), __uint_as_float(dy1[j].x & 0xffff0000u), __uint_as_float(dy1[j].y << 16), __uint_as_float(dy1[j].y & 0xffff0000u)}; }
        sa0 = sb0; sa1 = sb1; wa0 = wb0; wa1 = wb1;
        if (row + 2 * rstep < TT) { const int r = row + 2 * rstep; sb0 = TOKS[r * 2]; sb1 = TOKS[r * 2 + 1]; wb0 = TOKW[r * 2]; wb1 = TOKW[r * 2 + 1]; }
        if (row + rstep < TT) CB_LOAD(row + rstep, sa0, sa1);
#pragma unroll
        for (int j = 0; j < 4; ++j) v[j] = v[j] + *(const f32x4*)(MOD + mr * 6144 + 5120 + 256 * j + 4 * c.lane) * (ya[j] * w0 + yb[j] * w1);
        if (l < 3) store_row_bf16(xp, v, c.lane);
        if (l < 3) {
            const float* MODn = WSP(float, WS_MOD) + (size_t)(l + 1) * 9 * 6144;
            norm_row(v, c.in[I_N1G] + (l + 1) * D, c.lane); mod_row(v, MODn + mr * 6144, MODn + mr * 6144 + 1024, c.lane);
            store_row_bf16(H + (size_t)hrow_of(row, (l + 1) % 3) * D, v, c.lane);
        } else {
            norm_row(v, c.in[I_FING], c.lane);
            float* o = c.out + (size_t)(row - TC) * D;
#pragma unroll
            for (int j = 0; j < 4; ++j) *(f32x4*)(o + 256 * j + 4 * c.lane) = v[j];
        }
    }
#undef CB_LOAD
#undef CB_XP
}

DI void ctx_outproj_mini(const Ctx& c, const bf16* Yc, const bf16* Wt, const float* xs_c  , bf16* XC, const float* modc  , const float* bias) {
    constexpr int RS = 272, ABYTES = 64 * RS, STG = 192 * RS;
    const int lane = c.lane, h5 = lane >> 5, l31 = lane & 31;
    const int srow = c.tid >> 4, sch = c.tid & 15;
    for (int tile = blockIdx.x; tile < 256; tile += gridDim.x) {
        const int mt = 64 * (tile >> 3), nt = 128 * (tile & 7);
        const int m0 = mt + 32 * (c.wave >> 2), n0 = nt + 32 * (c.wave & 3);
        const bf16* ag = Yc + (size_t)(mt + srow) * 1024 + 8 * sch; const bf16* bg = Wt + (size_t)(nt + srow) * 1024 + 8 * sch;
        u32x4 st[6];
#define MINI_G(k0_) do { _Pragma("unroll") for (int i = 0; i < 2; ++i) st[i] = *(const u32x4*)(ag + (size_t)(32 * i) * 1024 + (k0_)); \
                         _Pragma("unroll") for (int i = 0; i < 4; ++i) st[2 + i] = *(const u32x4*)(bg + (size_t)(32 * i) * 1024 + (k0_)); } while (0)
#define MINI_W(buf_) do { LAS unsigned char* wb = c.lds + (buf_) * STG + srow * RS + sch * 16; \
                         _Pragma("unroll") for (int i = 0; i < 2; ++i) *(LAS u32x4*)(wb + 32 * i * RS) = st[i]; \
                         _Pragma("unroll") for (int i = 0; i < 4; ++i) *(LAS u32x4*)(wb + ABYTES + 32 * i * RS) = st[2 + i]; } while (0)
        MINI_G(0);
        const int row = m0 + l31;
        float xo[4][4]; f32x4 g1[4], bb[4];
#pragma unroll
        for (int q = 0; q < 4; ++q) { const int col = n0 + 8 * q + 4 * h5; const size_t o = (size_t)row * D + col;
            if (xs_c) { const f32x4 t = *(const f32x4*)(xs_c + o); xo[q][0] = t.x; xo[q][1] = t.y; xo[q][2] = t.z; xo[q][3] = t.w; }
            else { const u32x2 t = *(const u32x2*)(XC + o); xo[q][0] = __uint_as_float(t.x << 16); xo[q][1] = __uint_as_float(t.x & 0xffff0000u); xo[q][2] = __uint_as_float(t.y << 16); xo[q][3] = __uint_as_float(t.y & 0xffff0000u); }
            g1[q] = *(const f32x4*)(modc + 2048 + col); bb[q] = bias ? *(const f32x4*)(bias + col) : (f32x4){0.f, 0.f, 0.f, 0.f}; }
        __syncthreads();
        MINI_W(0);
        lds_barrier();
        f32x16 acc = zero16();
        const LAS unsigned char* ar = c.lds + (32 * (c.wave >> 2) + l31) * RS + 16 * h5;
        const LAS unsigned char* br = c.lds + ABYTES + (32 * (c.wave & 3) + l31) * RS + 16 * h5;
#pragma unroll 1
        for (int s = 0; s < 8; ++s) {
            if (s < 7) MINI_G(128 * (s + 1));
            const int bo = (s & 1) * STG;
#pragma unroll
            for (int k = 0; k < 8; ++k) { const bf16x8 af = *(const LAS bf16x8*)(ar + bo + 32 * k), wf = *(const LAS bf16x8*)(br + bo + 32 * k); acc = MFMA32(wf, af, acc); }
            if (s < 7) MINI_W((s + 1) & 1);
            lds_barrier();
        }
#undef MINI_G
#undef MINI_W
#pragma unroll
        for (int q = 0; q < 4; ++q) { const int col = n0 + 8 * q + 4 * h5; const size_t o = (size_t)row * D + col;
            u32x2 w; w.x = cvt_pk_bf16(xo[q][0] + g1[q].x * (acc[4 * q] + bb[q].x), xo[q][1] + g1[q].y * (acc[4 * q + 1] + bb[q].y));
            w.y = cvt_pk_bf16(xo[q][2] + g1[q].z * (acc[4 * q + 2] + bb[q].z), xo[q][3] + g1[q].w * (acc[4 * q + 3] + bb[q].w));
            *(u32x2*)(XC + o) = w; }
    }
}

#define XB_TMO      128
#define XB_XCNT(j)  (256  + 64 * (j))
#define XB_XSUB(j)  (1280 + 64 * (j))
#define XB_XGEN(j)  (2304 + 64 * (j))
#define XB_TOP      3328
#define XB_TOPGEN   3392
#define XCD_BAR_WORDS 3456
#define XB_SPIN_CAP (1u << 18)
DI unsigned xb_ld(unsigned* p)              { return __hip_atomic_load(p, __ATOMIC_RELAXED, __HIP_MEMORY_SCOPE_AGENT); }
DI unsigned xb_add(unsigned* p, unsigned v) { return __hip_atomic_fetch_add(p, v, __ATOMIC_RELAXED, __HIP_MEMORY_SCOPE_AGENT); }
DI unsigned xb_xcc_id() { return (unsigned)__builtin_amdgcn_s_getreg((3 << 11) | 20) & 0xFu; }
#define XB_SPIN(cond, bar) do { unsigned _sp = 0; while (cond) { __builtin_amdgcn_s_sleep(1); \
    if ((++_sp & 255u) == 0u) { if (xb_ld(&(bar)[XB_TMO])) break; if (_sp > XB_SPIN_CAP) { atomicAdd(&(bar)[XB_TMO], 1u); break; } } } } while (0)
DI void xcd_barrier_complete(unsigned* bar, unsigned x, unsigned& nloc, unsigned& nx) {
    const unsigned G = gridDim.x * gridDim.y * gridDim.z;
    unsigned sum, cnt, mine, sp = 0u;
    for (;;) {
        sum = 0u; cnt = 0u; mine = 0u;
#pragma unroll
        for (unsigned j = 0; j < 16; ++j) { const unsigned cj = xb_ld(&bar[XB_XCNT(j)]); sum += cj; cnt += (cj > 0u) ? 1u : 0u; mine = (j == x) ? cj : mine; }
        if (sum == G) break;
        __builtin_amdgcn_s_sleep(1);
        if ((++sp & 255u) == 0u) { if (xb_ld(&bar[XB_TMO])) break; if (sp > XB_SPIN_CAP) { atomicAdd(&bar[XB_TMO], 1u); break; } }
    }
    nloc = mine > 0u ? mine : 1u; nx = cnt > 0u ? cnt : 1u;
}
DI void xcd_barrier(unsigned* bar, volatile LAS unsigned* st) {
    asm volatile("s_waitcnt vmcnt(0)" ::: "memory");
    __syncthreads();
    if (threadIdx.x == 0) {
        const unsigned x = xb_xcc_id();
        __builtin_amdgcn_s_waitcnt(0);
        unsigned nloc = st[0], nx = st[1];
        if (nloc == 0u) { xcd_barrier_complete(bar, x, nloc, nx); st[0] = nloc; st[1] = nx; }
        const unsigned old = xb_add(&bar[XB_XSUB(x)], 1u);
        const unsigned gen = old / nloc;
        if (old + 1u == (gen + 1u) * nloc) {
            __builtin_amdgcn_fence(__ATOMIC_RELEASE, "agent");
            asm volatile("s_waitcnt vmcnt(0)" ::: "memory");
            const unsigned og = xb_add(&bar[XB_TOP], 1u);
            const unsigned tg = og / nx;
            if (og + 1u == (tg + 1u) * nx) xb_add(&bar[XB_TOPGEN], 1u);
            else XB_SPIN(xb_ld(&bar[XB_TOPGEN]) == tg, bar);
            __builtin_amdgcn_fence(__ATOMIC_ACQUIRE, "agent");
            xb_add(&bar[XB_XGEN(x)], 1u);
            asm volatile("s_waitcnt vmcnt(0)" ::: "memory");
        } else {
            XB_SPIN(xb_ld(&bar[XB_XGEN(x)]) == gen, bar);
            __builtin_amdgcn_fence(__ATOMIC_ACQUIRE, "agent");
            asm volatile("s_waitcnt vmcnt(0)" ::: "memory");
        }
    }
    __syncthreads();
}

constexpr int NPHASE = 2 + 11 * DEPTH;
__host__ __device__ inline bool phase_active(int ph) {
    if (ph < 2) return true;
    const int l = (ph - 2) / 11, s = (ph - 2) % 11, kind = l % 3;
    if (s == 0) return false;
    if (s == 4) return kind != 2 || HY_MFMA;
    return true;
}
DI void run_phase(const Ctx& c, int ph) {
    if (ph == 0) { if constexpr (PH_EN(0)) phase_pro0(c); return; }
    if (ph == 1) { if constexpr (PH_EN(1)) { phase_pro1(c); phase_norm1(c, 0, c.in[I_X], c.in[I_CTX]); } return; }
    const int l = (ph - 2) / 11, s = (ph - 2) % 11, kind = l % 3, j = l / 3;
    switch (s) {
    case 0: if constexpr (PH_EN(2)) phase_norm1(c, 0, c.in[I_X], c.in[I_CTX]); break;
    case 1: if constexpr (PH_EN(3)) {
        DenseOrder S; EpiInproj E; E.P = WSP(bf16, WS_P); E.extra = WSP(float, WS_EXTRA); E.bias = nullptr; E.bias_x = nullptr;
        S.A = WSP(bf16, WS_H); S.ul = dense_units(c.lds, c.tid, TT, kind == 2 ? 3072 : NINP);
        if (kind == 0) { S.Bt = WSP(bf16, WS_ML_WIN) + (size_t)j * NINP * 1024; E.bias_x = c.in[I_MLBG] + j * 32; }
        else if (kind == 1) { S.Bt = WSP(bf16, WS_GLA_WIN); }
        else { S.Bt = WSP(bf16, WS_HY_WIN); E.bias = c.in[I_HYBIN]; }
        gemm_run(c.lds, c.tid, S, E);
    } break;
    case 2: if constexpr (PH_EN(4))
        if (kind == 0) phase_conv(c, 1024, c.in[I_MLCW] + j * 3 * 1024, c.in[I_MLCB] + j * 1024, true, 0.125f);
        else if (kind == 1) { phase_conv(c, 2048, c.in[I_GLCW], c.in[I_GLCB], true, 0.08838834764831845f); if constexpr (GLA_CHUNK) phase_gla_decay(c); }
        else { if constexpr (HY_MFMA) phase_hy_prep(c); else phase_conv(c, 3072, c.in[I_HYCW], c.in[I_HYCB], false, 1.0f); }
        break;
    case 3: if constexpr (PH_EN(5))
        if (kind == 0) { if constexpr (MLSTM_CHUNK) phase_mlstm_state(c); else phase_mlstm_scan_naive(c); }
        else if (kind == 1) { if constexpr (GLA_CHUNK) phase_gla_state(c); else phase_gla_scan_naive(c); }
        else { if constexpr (HY_MFMA) phase_hy_toeplitz(c); else phase_hyena_conv_naive(c); }
        break;
    case 4: if constexpr (PH_EN(6))
        if (kind == 0) { if constexpr (MLSTM_CHUNK) phase_mlstm_out(c, c.in[I_MLNG] + j * 1024); else phase_headnorm(c, 128, c.in[I_MLNG] + j * 1024); }
        else if (kind == 1) { if constexpr (GLA_CHUNK) phase_gla_out(c, c.in[I_GLNG]); else phase_headnorm(c, 256, c.in[I_GLNG]); }
        else { if constexpr (HY_MFMA) phase_hy_post(c); }
        break;
    case 5: if constexpr (PH_EN(7)) {
        DenseOrder S; EpiOutproj E; E.X = WSP(bf16, WS_X); E.XC = WSP(bf16, WS_XC); E.mod = WSP(float, WS_MOD) + (size_t)l * 9 * 6144; E.bias = nullptr; E.perm = (kind == 1);
        E.xs_l = (l == 0) ? c.in[I_X] : nullptr; E.xs_c = (l == 0) ? c.in[I_CTX] : nullptr; E.row_off = TC;
        const bf16* W = kind == 0 ? WSP(bf16, WS_ML_WOUT) + (size_t)j * 1024 * 1024 : kind == 1 ? WSP(bf16, WS_GLA_WOUT) : WSP(bf16, WS_HY_WOUT);
        if (kind == 2) E.bias = c.in[I_HYBOUT];
        S.A = WSP(bf16, WS_Y) + (size_t)E.row_off * D; S.Bt = W; S.ul = dense_units(c.lds, c.tid, TT - E.row_off, 1024);
        gemm_run(c.lds, c.tid, S, E);
        if (l < 3) ctx_outproj_mini(c, WSP(bf16, WS_Y), W, E.xs_c, WSP(bf16, WS_XC), E.mod + 8 * 6144, E.bias);
    } break;
    case 6: if constexpr (PH_EN(8)) phase_route(c, l); break;
    case 7: if constexpr (PH_EN(9)) phase_gather(c, l); break;
    case 8: if constexpr (PH_EN(10)) {
        MoeOrder S; S.ul = moe_tiles(c, l, 3); S.A = WSP(bf16, WS_BIG + BIG_HS); S.Bt = WSP(bf16, WS_EXP_UP) + (size_t)l * 16 * 2048 * 1024; S.bstride = (size_t)2048 * 1024;
        EpiUp E; E.ACT = WSP(bf16, WS_BIG + BIG_ACT);
        gemm_run(c.lds, c.tid, S, E);
    } break;
    case 9: if constexpr (PH_EN(11)) {
        MoeOrder S; S.ul = moe_tiles(c, l, 2); S.A = WSP(bf16, WS_BIG + BIG_ACT); S.Bt = WSP(bf16, WS_EXP_DN) + (size_t)l * 16 * 1024 * 1024; S.bstride = (size_t)1024 * 1024;
        EpiDown E; E.YS = WSP(bf16, WS_BIG + BIG_HS);
        gemm_run(c.lds, c.tid, S, E);
    } break;
    case 10: if constexpr (PH_EN(12)) phase_combine(c, l); break;
    }
}

__global__ void __launch_bounds__(512, 2) mega_fwd(Params p) {
    extern __shared__ __attribute__((aligned(16))) unsigned char lds_raw[];
#if XCD_BARRIER
    {
        volatile LAS unsigned* st0 = (volatile LAS unsigned*)((LAS unsigned char*)lds_raw + BAR_LDS_OFF);
        if (threadIdx.x == 0) { st0[0] = 0u; st0[1] = 0u; (void)xb_add((unsigned*)(p.ws + WS_CTL) + CW_BAR + XB_XCNT(xb_xcc_id()), 1u); }
        __syncthreads();
    }
#endif
    bool first = true;
    int rep = 0;
    unsigned long long tp_acc = 0, tp_prev = 0; bool tp_sel = false;
    for (int ph = p.ph_lo; ph < p.ph_hi;) {
        if (!phase_active(ph)) { ++ph; continue; }
        int z; asm volatile("s_mov_b32 %0, 0" : "=s"(z));
        if (!first) {
#if XCD_BARRIER
            xcd_barrier((unsigned*)(p.ws + z + WS_CTL) + CW_BAR, (volatile LAS unsigned*)((LAS unsigned char*)lds_raw + BAR_LDS_OFF));
#else
            cg::this_grid().sync();
#endif
        }
        first = false;
        Ctx c;
        c.lds = (LAS unsigned char*)lds_raw;
        c.tid = threadIdx.x + z; c.lane = c.tid & 63; c.wave = __builtin_amdgcn_readfirstlane(c.tid >> 6);
        c.gw = blockIdx.x * 8 + c.wave; c.ngw = gridDim.x * 8;
        c.in = (const float* const __attribute__((address_space(4)))*)__builtin_amdgcn_kernarg_segment_ptr() + z; c.out = p.out + z; c.ws = p.ws + z; c.z = (unsigned)z;
        if (TP_MASK != 0u) {
            const unsigned long long now = __builtin_amdgcn_s_memrealtime();
            if (tp_sel) tp_acc += now - tp_prev;
            tp_prev = now; tp_sel = (ph >= 2 ? (((TP_MASK >> ((ph - 2) % 11)) & 1u) && ((TP_LAYERS >> ((ph - 2) / 11)) & 1u)) : ((TP_MASK >> (16 + ph)) & 1u));
        }
        run_phase(c, ph);
        if (REP_MASK != 0u && rep == 0 && (ph >= 2 ? (((REP_MASK >> ((ph - 2) % 11)) & 1u) && ((REP_LAYERS >> ((ph - 2) / 11)) & 1u)) : ((REP_MASK >> (16 + ph)) & 1u))) rep = 1; else { rep = 0; ++ph; }
    }
    if (TP_MASK != 0u && blockIdx.x == 0) { asm volatile("s_waitcnt vmcnt(0)" ::: "memory"); __syncthreads(); const unsigned long long now = __builtin_amdgcn_s_memrealtime(); if (tp_sel) tp_acc += now - tp_prev;
        const unsigned long long t_end = now + (unsigned long long)TP_AMP * tp_acc; while (__builtin_amdgcn_s_memrealtime() < t_end) __builtin_amdgcn_s_sleep(8); }
}

extern "C" void kernel_launch(void* const* d_in, const int* in_sizes, int n_in, void* d_out, int out_size, void* d_ws, size_t ws_size, hipStream_t stream) {
    static int grid = 0;
    if (grid == 0) {
        if (n_in != 40 || ws_size < WS_END || out_size != TL * D) { fprintf(stderr, "kernel_launch: unexpected shapes (n_in %d, ws %zu, out %d)\n", n_in, ws_size, out_size); grid = -1; return; }
        int dev = 0, cus = 0, per_cu = 0;
        hipGetDevice(&dev); hipDeviceGetAttribute(&cus, hipDeviceAttributeMultiprocessorCount, dev);
        if (hipFuncSetAttribute((const void*)mega_fwd, hipFuncAttributeMaxDynamicSharedMemorySize, LDS_BYTES) != hipSuccess) { fprintf(stderr, "kernel_launch: hipFuncSetAttribute failed\n"); grid = -1; return; }
        if (hipOccupancyMaxActiveBlocksPerMultiprocessor(&per_cu, (const void*)mega_fwd, 512, LDS_BYTES) != hipSuccess || per_cu < 1) { fprintf(stderr, "kernel_launch: occupancy query says %d\n", per_cu); per_cu = 1; }
        (void)hipGetLastError();
        grid = cus;
        fprintf(stderr, "kernel_launch: grid %d (cus %d, per_cu %d)\n", grid, cus, per_cu);
    }
    if (grid < 0) return;
    hipMemsetAsync((char*)d_ws + WS_CTL, 0, 1 * MiB, stream);
    Params p{};
    for (int i = 0; i < 40; ++i) p.in[i] = (const float*)d_in[i];
    p.out = (float*)d_out; p.ws = (unsigned char*)d_ws;
#if N_LAUNCH_PER_PHASE
    for (int ph = 0; ph < NPHASE; ++ph) {
        if (!phase_active(ph)) continue;
        p.ph_lo = ph; p.ph_hi = ph + 1; void* args[] = {&p};
        hipError_t e = hipLaunchCooperativeKernel((const void*)mega_fwd, dim3(grid), dim3(512), args, LDS_BYTES, stream);
        if (e != hipSuccess) { fprintf(stderr, "launch failed: %s\n", hipGetErrorString(e)); break; }
    }
#else
    p.ph_lo = 0; p.ph_hi = NPHASE; void* args[] = {&p};
    hipError_t e = hipLaunchCooperativeKernel((const void*)mega_fwd, dim3(grid), dim3(512), args, LDS_BYTES, stream);
    if (e != hipSuccess) fprintf(stderr, "cooperative launch failed: %s (grid %d)\n", hipGetErrorString(e), grid);
#endif
}
```

```cpp
#include <hip/hip_runtime.h>
#include <hip/hip_cooperative_groups.h>
#include <cstdio>
#include <cstdint>
namespace cg = cooperative_groups;

#define LAS __attribute__((address_space(3)))
#define DI __device__ __forceinline__
typedef unsigned short bf16;
typedef float f32x4 __attribute__((ext_vector_type(4)));
typedef float f32x2 __attribute__((ext_vector_type(2)));
typedef unsigned u32x4 __attribute__((ext_vector_type(4)));
typedef unsigned u32x2 __attribute__((ext_vector_type(2)));
typedef short bf16x8 __attribute__((ext_vector_type(8)));

#ifndef FAST_GEMM
#define FAST_GEMM 1
#endif
#ifndef MLSTM_CHUNK
#define MLSTM_CHUNK 1
#endif
#ifndef GLA_CHUNK
#define GLA_CHUNK 1
#endif
#ifndef HY_MFMA
#define HY_MFMA 1
#endif
#ifndef XCD_BARRIER
#define XCD_BARRIER 1
#endif
#ifndef PH_MASK
#define PH_MASK 0xFFFFFFFFu
#endif
#define PH_EN(b) ((PH_MASK >> (b)) & 1u)
#ifndef TP_MASK
#define TP_MASK 0u
#endif
#ifndef TP_LAYERS
#define TP_LAYERS 0xFu
#endif
#define TP_AMP 4
#ifndef REP_LAYERS
#define REP_LAYERS 0xFu
#endif
#ifndef REP_MASK
#define REP_MASK 0u
#endif
#ifndef N_LAUNCH_PER_PHASE
#define N_LAUNCH_PER_PHASE 0
#endif

constexpr int D = 1024, NB = 8, SEQ = 2048, CTX = 256, DEPTH = 4;
constexpr int TC = NB * CTX, TL = NB * SEQ, TT = TC + TL;
constexpr int NEXP = 16;
constexpr int PLD = 3072;
constexpr int NINP = 3328;
constexpr float EPS = 1e-6f;
constexpr int MAXSLOT = 40960;

constexpr size_t MiB = 1u << 20;
constexpr size_t WS_CTL = 0;
constexpr size_t WS_MOD = 1 * MiB;
constexpr size_t WS_HM = 2 * MiB;
constexpr size_t WS_TOK = 3 * MiB;
constexpr size_t WS_RWT = 3 * MiB + 944 * 1024;
constexpr size_t WS_HF = 4 * MiB;
constexpr size_t WS_HFC = 20 * MiB;
constexpr size_t WS_ML_WIN = 32 * MiB;
constexpr size_t WS_ML_WOUT = 45 * MiB;
constexpr size_t WS_GLA_WIN = 49 * MiB;
constexpr size_t WS_GLA_WOUT = 56 * MiB;
constexpr size_t WS_HY_WIN = 58 * MiB;
constexpr size_t WS_HY_WOUT = 64 * MiB;
constexpr size_t WS_EXP_UP = 66 * MiB;
constexpr size_t WS_EXP_DN = 322 * MiB;
constexpr size_t WS_X = 450 * MiB;
constexpr size_t WS_XC = 514 * MiB;
constexpr size_t WS_H = 522 * MiB;
constexpr size_t WS_P = 558 * MiB;
constexpr size_t WS_EXTRA = 667 * MiB;
constexpr size_t WS_Y = 670 * MiB;
constexpr size_t WS_BIG = 706 * MiB;
constexpr size_t WS_END = 1024 * MiB;
constexpr size_t BIG_HS = 0;
constexpr size_t BIG_ACT = 80 * MiB;
constexpr size_t BIG_PC = 0;
constexpr size_t BIG_YF = 108 * MiB;
constexpr size_t BIG_YB = 180 * MiB;

constexpr size_t BIG_MCT = 108 * MiB;
constexpr size_t BIG_MN = 180 * MiB;

constexpr size_t BIG_GB = 72 * MiB;
constexpr size_t BIG_GST = 144 * MiB;

constexpr size_t BIG_ZTL = 108 * MiB;
constexpr size_t BIG_ZTC = 140 * MiB;
constexpr size_t BIG_YTL = 144 * MiB;
constexpr size_t BIG_YTC = 176 * MiB;

constexpr int CW_CNT = 1024;
constexpr int CW_BAR = 4096;

constexpr int LDS_BYTES = 148480;
constexpr int BAR_LDS_OFF = 147456;
constexpr int MISC_OFF = 131072;

struct Params {
    const float* in[40];
    float* out;
    unsigned char* ws;
    int ph_lo, ph_hi;
};
static_assert(__builtin_offsetof(Params, in) == 0, "the input pointer table must be the first kernel argument bytes");
enum { I_X = 0, I_C, I_CTX, I_CCTX, I_ADAW, I_ADAB, I_N1G, I_N2G, I_FING, I_MLWIN, I_MLBG, I_MLCW, I_MLCB, I_MLNG, I_MLWOUT,
       I_GLWIN, I_GLCW, I_GLCB, I_GLW2, I_GLGB, I_GLNG, I_GLWOUT, I_HYWIN, I_HYBIN, I_HYCW, I_HYCB, I_HYFW1, I_HYFB1, I_HYFWM, I_HYFBM,
       I_HYFWO, I_HYFREQ, I_HYSKIP, I_HYWOUT, I_HYBOUT, I_RW, I_RB, I_EW1, I_EW3, I_EW2 };

DI float bf2f(bf16 v) { return __uint_as_float(((unsigned)v) << 16); }
typedef __bf16 b16x2_t __attribute__((ext_vector_type(2)));
DI unsigned cvt_pk_bf16(float lo, float hi) { const f32x2 v = {lo, hi}; const b16x2_t r = __builtin_convertvector(v, b16x2_t); return __builtin_bit_cast(unsigned, r); }
DI bf16 f2bf(float f) { return (bf16)(cvt_pk_bf16(f, 0.f) & 0xffffu); }
DI float sigmoidf_(float x) { return 1.0f / (1.0f + __expf(-x)); }
DI float siluf_(float x) { return x / (1.0f + __expf(-x)); }
DI float logsigf_(float x) { return fminf(x, 0.f) - __logf(1.0f + __expf(-fabsf(x))); }
DI void lds_barrier() { asm volatile("s_waitcnt lgkmcnt(0)" ::: "memory"); __builtin_amdgcn_s_barrier(); asm volatile("" ::: "memory"); }
DI float shx_(float v, int m) {
    const int x = __float_as_int(v); int r;
    switch (m) {
    case 1:  r = __builtin_amdgcn_update_dpp(0, x, 0xB1, 0xf, 0xf, true); break;
    case 2:  r = __builtin_amdgcn_update_dpp(0, x, 0x4E, 0xf, 0xf, true); break;
    case 4:  r = __builtin_amdgcn_ds_swizzle(x, 0x101F); break;
    case 8:  r = __builtin_amdgcn_update_dpp(0, x, 0x128, 0xf, 0xf, true); break;
    case 16: r = __builtin_amdgcn_ds_swizzle(x, 0x401F); break;
    default: { int idx = ((int)__builtin_amdgcn_mbcnt_hi(~0u, __builtin_amdgcn_mbcnt_lo(~0u, 0u)) ^ 32) << 2; asm volatile("" : "+v"(idx)); r = __builtin_amdgcn_ds_bpermute(idx, x); } break;
    }
    return __int_as_float(r);
}
DI float wave_sum(float v) {
#pragma unroll
    for (int o = 1; o < 64; o <<= 1) v += shx_(v, o);
    return v;
}
DI void unpack8(const u32x4 w, float (&v)[8]) {
    v[0] = __uint_as_float(w.x << 16); v[1] = __uint_as_float(w.x & 0xffff0000u);
    v[2] = __uint_as_float(w.y << 16); v[3] = __uint_as_float(w.y & 0xffff0000u);
    v[4] = __uint_as_float(w.z << 16); v[5] = __uint_as_float(w.z & 0xffff0000u);
    v[6] = __uint_as_float(w.w << 16); v[7] = __uint_as_float(w.w & 0xffff0000u);
}
DI u32x4 pack8(const float (&v)[8]) { u32x4 w; w.x = cvt_pk_bf16(v[0], v[1]); w.y = cvt_pk_bf16(v[2], v[3]); w.z = cvt_pk_bf16(v[4], v[5]); w.w = cvt_pk_bf16(v[6], v[7]); return w; }
DI void seq_bounds(int row, int& lo, int& hi) {
    if (row < TC) { lo = row & ~(CTX - 1); hi = lo + CTX - 1; } else { lo = TC + ((row - TC) & ~(SEQ - 1)); hi = lo + SEQ - 1; }
}
DI int perm_fwd(int s) { return (s & 63) * 32 + (s >> 6); }
DI int perm_inv(int sp) { return (sp & 31) * 64 + (sp >> 5); }

namespace pg8 {
constexpr int BM = 256, BK = 64, HALF = 128, HTB = HALF * BK * 2, STAGE_BYTES = 8 * HTB, NXCD = 8, WGM = 8;
__host__ __device__ __forceinline__ int lds_byte(int r, int c) { const int st = (r >> 4) * 2 + (c >> 5), rr = r & 15, cc = c & 31, ob = rr * 64 + cc * 2; return st * 1024 + (ob ^ (((ob >> 9) & 1) << 5)); }
__host__ __device__ __forceinline__ void stage_rc(int b, int& R, int& C) { const int st = b / 1024, sb = b % 1024, swz = sb ^ (((sb >> 9) & 1) << 5); R = (st >> 1) * 16 + swz / 64; C = (st & 1) * 32 + (swz % 64) / 2; }
__host__ __device__ __forceinline__ int perm32(int rho) { const int n = rho >> 4, i = rho & 15; return 8 * (i >> 2) + 4 * n + (i & 3); }
}
struct Unit { int pm, pn, e; };

DI LAS int* dense_units(LAS unsigned char* lds, int tid, int M, int N) {
    LAS int* ul = (LAS int*)(lds + MISC_OFF) + 192;
    __syncthreads();
    if (tid < 32) {
        const int nM = M / 256, nN = N / 256, nwg = nM * nN, G = gridDim.x, L = tid * G + (int)blockIdx.x; int w = -1;
        if (L < nwg) {
            int wgid = L; { const int q = nwg / 8, r = nwg % 8, xcd = wgid % 8, off = wgid / 8; wgid = (xcd < r ? xcd * (q + 1) : r * (q + 1) + (xcd - r) * q) + off; }
            const int nig = 8 * nN, gid = wgid / nig, fm = gid * 8, gsz = (nM - fm) < 8 ? (nM - fm) : 8;
            w = (fm + ((wgid % nig) % gsz)) | (((wgid % nig) / gsz) << 12);
        }
        ul[tid] = w;
    }
    __syncthreads();
    return ul;
}
struct DenseOrder {
    const bf16* A; const bf16* Bt; const LAS int* ul;
    DI bool next(int i, Unit& u) const {
        const int w = __builtin_amdgcn_readfirstlane(ul[i]); if (w < 0) return false;
        u.pm = w & 0xfff; u.pn = (w >> 12) & 0xf; u.e = 0; return true;
    }
    DI const bf16* aptr(const Unit& u) const { return A + (size_t)u.pm * 256 * 1024; }
    DI const bf16* bptr(const Unit& u) const { return Bt + (size_t)u.pn * 256 * 1024; }
};
struct MoeOrder {
    const bf16* A; const bf16* Bt; size_t bstride; const LAS int* ul;
    DI bool next(int i, Unit& u) const {
        const int w = __builtin_amdgcn_readfirstlane(ul[i]); if (w < 0) return false;
        u.pm = w & 0xfff; u.pn = (w >> 12) & 0xf; u.e = w >> 16; return true;
    }
    DI const bf16* aptr(const Unit& u) const { return A + (size_t)u.pm * 256 * 1024; }
    DI const bf16* bptr(const Unit& u) const { return Bt + (size_t)u.e * bstride + (size_t)u.pn * 256 * 1024; }
};

struct EpiInproj {
    static constexpr bool PAIR = false, BATCHED = false;
    bf16* P; float* extra; const float* bias; const float* bias_x;
    DI void row8(const Unit& u, int r, int c, const float (&v)[8]) const {
        const int row = u.pm * 256 + r, col = u.pn * 256 + c;
        if (col < PLD) {
            float w[8];
#pragma unroll
            for (int j = 0; j < 8; ++j) w[j] = v[j] + (bias ? bias[col + j] : 0.f);
            *(u32x4*)(P + (size_t)row * PLD + col) = pack8(w);
        } else if (col < PLD + 32) {
            float* o = extra + (size_t)row * 32 + (col - PLD);
#pragma unroll
            for (int j = 0; j < 8; ++j) o[j] = v[j] + (bias_x ? bias_x[col - PLD + j] : 0.f);
        }
    }
};
struct EpiOutproj {
    static constexpr bool PAIR = false, BATCHED = true;
    const float* xs_l; const float* xs_c; bf16* X; bf16* XC; const float* mod; const float* bias; int row_off; int perm;
    DI size_t off(const Unit& u, int r, int col) const {
        const int rr = u.pm * 256 + r + row_off - TC, b = rr >> 11, sp = rr & (SEQ - 1), s = perm ? perm_inv(sp) : sp; return ((size_t)b * SEQ + s) * D + col; }
    DI void tile(const f32x4 (&acc)[2][2][4][2], const Unit& u, int wr, int wc, int fr, int fq) const {
        const int b = (u.pm * 256 + row_off - TC) >> 11; const float* g1p = mod + b * 6144 + 2048;
        const int rr0 = u.pm * 256 + row_off - TC, sp0 = rr0 & (SEQ - 1);
        const int d_ai = perm ? 4 : 128, d_m1 = perm ? 1024 : 16, d_m2 = perm ? 1 : 32;
        const unsigned voff = (unsigned)((perm ? fr * 64 + wr * 2 : wr * 64 + fr) * D + wc * 32 + 8 * fq);
        const size_t ubase = ((size_t)b * SEQ + (perm ? (sp0 >> 5) : sp0)) * D + u.pn * 256;
#define OPJ_OFF(bj_, ai_, m_) ((size_t)((ai_) * d_ai + ((m_) & 1) * d_m1 + ((m_) >> 1) * d_m2) * D + (bj_) * 128)
#pragma unroll
        for (int bj = 0; bj < 2; ++bj) {
            char* Xu = (char*)(X + ubase); float g1[8], bs[8];
            if (xs_l) {
                const char* Su = (const char*)(xs_l + ubase); f32x4 rf[2][4][2];
#pragma unroll
                for (int ai = 0; ai < 2; ++ai)
#pragma unroll
                    for (int m = 0; m < 4; ++m) { const char* p = Su + OPJ_OFF(bj, ai, m) * 4 + voff * 4u; rf[ai][m][0] = *(const f32x4*)p; rf[ai][m][1] = *(const f32x4*)(p + 16); }
                { const int col = u.pn * 256 + bj * 128 + wc * 32 + 8 * fq;
#pragma unroll
                    for (int j = 0; j < 8; ++j) { g1[j] = g1p[col + j]; bs[j] = bias ? bias[col + j] : 0.f; } }
#pragma unroll
                for (int ai = 0; ai < 2; ++ai)
#pragma unroll
                    for (int m = 0; m < 4; ++m) { float w[8];
#pragma unroll
                        for (int j = 0; j < 8; ++j) w[j] = rf[ai][m][j >> 2][j & 3] + g1[j] * (acc[ai][bj][m][j >> 2][j & 3] + bs[j]);
                        *(u32x4*)(Xu + OPJ_OFF(bj, ai, m) * 2 + voff * 2u) = pack8(w); }
            } else {
                u32x4 raw[2][4];
#pragma unroll
                for (int ai = 0; ai < 2; ++ai)
#pragma unroll
                    for (int m = 0; m < 4; ++m) raw[ai][m] = *(const u32x4*)(Xu + OPJ_OFF(bj, ai, m) * 2 + voff * 2u);
                { const int col = u.pn * 256 + bj * 128 + wc * 32 + 8 * fq;
#pragma unroll
                    for (int j = 0; j < 8; ++j) { g1[j] = g1p[col + j]; bs[j] = bias ? bias[col + j] : 0.f; } }
#pragma unroll
                for (int ai = 0; ai < 2; ++ai)
#pragma unroll
                    for (int m = 0; m < 4; ++m) { float xo[8], w[8];
                        unpack8(raw[ai][m], xo);
#pragma unroll
                        for (int j = 0; j < 8; ++j) w[j] = xo[j] + g1[j] * (acc[ai][bj][m][j >> 2][j & 3] + bs[j]);
                        *(u32x4*)(Xu + OPJ_OFF(bj, ai, m) * 2 + voff * 2u) = pack8(w); }
            }
            asm volatile("" ::: "memory");
        }
#undef OPJ_OFF
    }
    DI void row8(const Unit& u, int r, int c, const float (&v)[8]) const {
        const int col = u.pn * 256 + c; const size_t o = off(u, r, col); const int b = (u.pm * 256 + row_off - TC) >> 11;
        float a[8];
        if (xs_l) { const f32x4 a0 = *(const f32x4*)(xs_l + o), a1 = *(const f32x4*)(xs_l + o + 4); a[0] = a0.x; a[1] = a0.y; a[2] = a0.z; a[3] = a0.w; a[4] = a1.x; a[5] = a1.y; a[6] = a1.z; a[7] = a1.w; }
        else unpack8(*(const u32x4*)(X + o), a);
        const float* g1 = mod + b * 6144 + 2048 + col; float w[8];
#pragma unroll
        for (int j = 0; j < 8; ++j) w[j] = a[j] + g1[j] * (v[j] + (bias ? bias[col + j] : 0.f));
        *(u32x4*)(X + o) = pack8(w);
    }
};
struct EpiUp {
    static constexpr bool PAIR = true, BATCHED = false;
    bf16* ACT;
    DI void row8p(const Unit& u, int r, int c, const float (&g)[8], const float (&up)[8]) const {
        float w[8];
#pragma unroll
        for (int j = 0; j < 8; ++j) w[j] = siluf_(g[j]) * up[j];
        *(u32x4*)(ACT + ((size_t)u.pm * 256 + r) * 1024 + u.pn * 128 + c) = pack8(w);
    }
};
struct EpiDown {
    static constexpr bool PAIR = false, BATCHED = false;
    bf16* YS;
    DI void row8(const Unit& u, int r, int c, const float (&v)[8]) const { *(u32x4*)(YS + ((size_t)u.pm * 256 + r) * 1024 + u.pn * 256 + c) = pack8(v); }
};

template <class Sched, class Epi>
DI void gemm_fast(LAS unsigned char* lds, int tid, const Sched& S, const Epi& E) {
    using namespace pg8;
    constexpr int K = 1024, nt = K / BK;
    const int wid = __builtin_amdgcn_readfirstlane(tid >> 6), lane = tid & 63, wr = wid >> 2, wc = wid & 3, fr = lane & 15, fq = lane >> 4;
    unsigned voffA[2], voffB[2];
#pragma unroll
    for (int i = 0; i < 2; ++i) { int R, C; stage_rc(tid * 16 + i * 8192, R, C); const int Rb = (R & ~31) + perm32(R & 31);
        voffA[i] = (unsigned)(R * K + C) * 2u; voffB[i] = (unsigned)(Rb * K + C) * 2u; }
    const size_t kstep = (size_t)(BK * 2);
    const size_t hstep = (size_t)HALF * K * 2;
    const unsigned ldsw = (unsigned)wid * 1024u;
    const int aoff = lds_byte(wr * 64 + fr, fq * 8), boff = lds_byte(wc * 32 + fr, fq * 8);
#define PG8_SA(b, h) (((b) * 2 + (h)) * HTB)
#define PG8_SB(b, h) ((4 + (b) * 2 + (h)) * HTB)
#define PG8_STAGE(bufoff, gbase, voff) do { _Pragma("unroll") for (int _i = 0; _i < 2; ++_i) \
        __builtin_amdgcn_global_load_lds((const unsigned*)((const char*)(gbase) + (voff)[_i]), (LAS unsigned*)(lds + (bufoff) + ldsw + _i * 8192), 16, 0, 0); } while (0)
#define PG8_LDA(dst, b, h) do { _Pragma("unroll") for (int m = 0; m < 4; ++m) _Pragma("unroll") for (int k = 0; k < 2; ++k) dst[m][k] = *(const LAS bf16x8*)(lds + PG8_SA(b, h) + aoff + m * 2048 + k * 1024); } while (0)
#define PG8_LDB(dst, b, h) do { _Pragma("unroll") for (int n = 0; n < 2; ++n) _Pragma("unroll") for (int k = 0; k < 2; ++k) dst[n][k] = *(const LAS bf16x8*)(lds + PG8_SB(b, h) + boff + n * 2048 + k * 1024); } while (0)
#define PG8_MMA(ai, bj, At, Bt) do { __builtin_amdgcn_s_setprio(1); _Pragma("unroll") for (int m = 0; m < 4; ++m) _Pragma("unroll") for (int n = 0; n < 2; ++n) _Pragma("unroll") for (int k = 0; k < 2; ++k) \
        acc[ai][bj][m][n] = __builtin_amdgcn_mfma_f32_16x16x32_bf16(Bt[n][k], At[m][k], acc[ai][bj][m][n], 0, 0, 0); __builtin_amdgcn_s_setprio(0); } while (0)
#define PG8_WAIT_V(n) asm volatile("s_waitcnt vmcnt(" #n ")" ::: "memory")
#define PG8_WAIT_L(n) asm volatile("s_waitcnt lgkmcnt(" #n ")" ::: "memory")
#define PG8_BAR __builtin_amdgcn_s_barrier()
#define PG8_SCHED __builtin_amdgcn_sched_barrier(0)
    Unit cur, nxt; int ui = 0;
    if (!S.next(0, cur)) return;
    f32x4 acc[2][2][4][2];
#pragma unroll
    for (int a = 0; a < 2; ++a)
#pragma unroll
        for (int b = 0; b < 2; ++b)
#pragma unroll
            for (int m = 0; m < 4; ++m)
#pragma unroll
                for (int n = 0; n < 2; ++n) acc[a][b][m][n] = (f32x4){0.f, 0.f, 0.f, 0.f};
    bf16x8 At[4][2], B0[2][2], B1[2][2];
    const char* cA = (const char*)S.aptr(cur); const char* cB = (const char*)S.bptr(cur);
    PG8_STAGE(PG8_SB(0, 0), cB, voffB); PG8_STAGE(PG8_SA(0, 0), cA, voffA); PG8_STAGE(PG8_SB(0, 1), cB + hstep, voffB); PG8_STAGE(PG8_SA(0, 1), cA + hstep, voffA);
    if (wr == 1) PG8_BAR;
    PG8_WAIT_V(4); PG8_BAR;
    PG8_STAGE(PG8_SB(1, 0), cB + kstep, voffB); PG8_STAGE(PG8_SA(1, 0), cA + kstep, voffA); PG8_STAGE(PG8_SB(1, 1), cB + hstep + kstep, voffB);
    PG8_WAIT_V(6); PG8_BAR;
    for (;;) {
        const bool has_next = S.next(ui + 1, nxt);
        const char* nA = has_next ? (const char*)S.aptr(nxt) : cA; const char* nB = has_next ? (const char*)S.bptr(nxt) : cB;
        for (int t = 0; t < nt; t += 2) {
            const bool last = (t == nt - 2);
            const char* a1 = cA + (size_t)(t + 1) * kstep;
            const char* a2 = last ? nA : cA + (size_t)(t + 2) * kstep; const char* b2 = last ? nB : cB + (size_t)(t + 2) * kstep;
            const char* a3 = a2 + kstep; const char* b3 = b2 + kstep;
            PG8_LDB(B0, 0, 0); PG8_SCHED; PG8_LDA(At, 0, 0); PG8_STAGE(PG8_SA(1, 1), a1 + hstep, voffA);
            PG8_WAIT_L(8); PG8_BAR; PG8_WAIT_L(0); PG8_MMA(0, 0, At, B0); PG8_BAR; PG8_SCHED;
            PG8_LDB(B1, 0, 1); PG8_STAGE(PG8_SB(0, 0), b2, voffB);
            PG8_BAR; PG8_WAIT_L(0); PG8_MMA(0, 1, At, B1); PG8_BAR;
            PG8_LDA(At, 0, 1); PG8_STAGE(PG8_SA(0, 0), a2, voffA);
            PG8_BAR; PG8_WAIT_L(0); PG8_MMA(1, 0, At, B0); PG8_BAR; PG8_SCHED;
            PG8_STAGE(PG8_SB(0, 1), b2 + hstep, voffB);
            PG8_WAIT_V(6); PG8_BAR; PG8_MMA(1, 1, At, B1); PG8_BAR;
            PG8_LDB(B0, 1, 0); PG8_SCHED; PG8_LDA(At, 1, 0); PG8_STAGE(PG8_SA(0, 1), a2 + hstep, voffA);
            PG8_WAIT_L(8); PG8_BAR; PG8_WAIT_L(0); PG8_MMA(0, 0, At, B0); PG8_BAR; PG8_SCHED;
            PG8_LDB(B1, 1, 1); PG8_STAGE(PG8_SB(1, 0), b3, voffB);
            PG8_BAR; PG8_WAIT_L(0); PG8_MMA(0, 1, At, B1); PG8_BAR;
            PG8_LDA(At, 1, 1); PG8_STAGE(PG8_SA(1, 0), a3, voffA);
            PG8_BAR; PG8_WAIT_L(0); PG8_MMA(1, 0, At, B0); PG8_BAR; PG8_SCHED;
            PG8_STAGE(PG8_SB(1, 1), b3 + hstep, voffB);
            PG8_WAIT_V(6); PG8_BAR; PG8_MMA(1, 1, At, B1); PG8_BAR;
        }
        int efr = fr, efq = fq; asm volatile("" : "+v"(efr), "+v"(efq));
        if constexpr (Epi::BATCHED) E.tile(acc, cur, wr, wc, efr, efq); else
#pragma unroll
        for (int ai = 0; ai < 2; ++ai)
#pragma unroll
            for (int m = 0; m < 4; ++m) {
                const int r = ai * HALF + wr * 64 + m * 16 + efr;
                if constexpr (Epi::PAIR) {
                    const float g[8] = {acc[ai][0][m][0][0], acc[ai][0][m][0][1], acc[ai][0][m][0][2], acc[ai][0][m][0][3], acc[ai][0][m][1][0], acc[ai][0][m][1][1], acc[ai][0][m][1][2], acc[ai][0][m][1][3]};
                    const float up[8] = {acc[ai][1][m][0][0], acc[ai][1][m][0][1], acc[ai][1][m][0][2], acc[ai][1][m][0][3], acc[ai][1][m][1][0], acc[ai][1][m][1][1], acc[ai][1][m][1][2], acc[ai][1][m][1][3]};
                    E.row8p(cur, r, wc * 32 + 8 * efq, g, up);
                } else {
#pragma unroll
                    for (int bj = 0; bj < 2; ++bj) {
                        const float v[8] = {acc[ai][bj][m][0][0], acc[ai][bj][m][0][1], acc[ai][bj][m][0][2], acc[ai][bj][m][0][3], acc[ai][bj][m][1][0], acc[ai][bj][m][1][1], acc[ai][bj][m][1][2], acc[ai][bj][m][1][3]};
                        E.row8(cur, r, bj * HALF + wc * 32 + 8 * efq, v);
                    }
                }
            }
        if (!has_next) break;
#pragma unroll
        for (int a = 0; a < 2; ++a)
#pragma unroll
            for (int b = 0; b < 2; ++b)
#pragma unroll
                for (int m = 0; m < 4; ++m)
#pragma unroll
                    for (int n = 0; n < 2; ++n) acc[a][b][m][n] = (f32x4){0.f, 0.f, 0.f, 0.f};
        cur = nxt; cA = nA; cB = nB; ++ui;
    }
    PG8_WAIT_V(0);
    if (wr == 0) PG8_BAR;
    PG8_BAR;
#undef PG8_SA
#undef PG8_SB
#undef PG8_STAGE
#undef PG8_LDA
#undef PG8_LDB
#undef PG8_MMA
#undef PG8_WAIT_V
#undef PG8_WAIT_L
#undef PG8_BAR
#undef PG8_SCHED
}

template <class Sched, class Epi>
DI void gemm_naive(LAS unsigned char* lds, int tid, const Sched& S, const Epi& E) {
    LAS float* As = (LAS float*)lds;
    LAS float* Bs = As + 32 * 132;
    LAS float* Bu = Bs + 32 * 132;
    const int ty = tid >> 4, tx = tid & 15, lr = tid >> 2, kq = tid & 3;
    Unit u;
    for (int i = 0; S.next(i, u); ++i) {
        const bf16* A = S.aptr(u); const bf16* B = S.bptr(u);
        for (int sm = 0; sm < 2; ++sm)
            for (int sn = 0; sn < (Epi::PAIR ? 1 : 2); ++sn) {
                float acc[4][8], accu[4][8];
#pragma unroll
                for (int a = 0; a < 4; ++a)
#pragma unroll
                    for (int b = 0; b < 8; ++b) { acc[a][b] = 0.f; accu[a][b] = 0.f; }
                for (int k0 = 0; k0 < 1024; k0 += 32) {
                    __syncthreads();
                    { float w[8]; unpack8(*(const u32x4*)(A + (size_t)(128 * sm + lr) * 1024 + k0 + 8 * kq), w);
#pragma unroll
                      for (int j = 0; j < 8; ++j) As[(8 * kq + j) * 132 + lr] = w[j];
                      unpack8(*(const u32x4*)(B + (size_t)(128 * sn + lr) * 1024 + k0 + 8 * kq), w);
#pragma unroll
                      for (int j = 0; j < 8; ++j) Bs[(8 * kq + j) * 132 + lr] = w[j];
                      if (Epi::PAIR) { unpack8(*(const u32x4*)(B + (size_t)(128 + lr) * 1024 + k0 + 8 * kq), w);
#pragma unroll
                          for (int j = 0; j < 8; ++j) Bu[(8 * kq + j) * 132 + lr] = w[j]; } }
                    __syncthreads();
#pragma unroll 4
                    for (int k = 0; k < 32; ++k) {
                        const f32x4 a4 = *(const LAS f32x4*)(As + k * 132 + 4 * ty);
                        const f32x4 b0 = *(const LAS f32x4*)(Bs + k * 132 + 8 * tx), b1 = *(const LAS f32x4*)(Bs + k * 132 + 8 * tx + 4);
#pragma unroll
                        for (int a = 0; a < 4; ++a) {
#pragma unroll
                            for (int b = 0; b < 4; ++b) { acc[a][b] += a4[a] * b0[b]; acc[a][4 + b] += a4[a] * b1[b]; } }
                        if (Epi::PAIR) {
                            const f32x4 c0 = *(const LAS f32x4*)(Bu + k * 132 + 8 * tx), c1 = *(const LAS f32x4*)(Bu + k * 132 + 8 * tx + 4);
#pragma unroll
                            for (int a = 0; a < 4; ++a) {
#pragma unroll
                                for (int b = 0; b < 4; ++b) { accu[a][b] += a4[a] * c0[b]; accu[a][4 + b] += a4[a] * c1[b]; } }
                        }
                    }
                }
#pragma unroll
                for (int a = 0; a < 4; ++a) {
                    if constexpr (Epi::PAIR) E.row8p(u, 128 * sm + 4 * ty + a, 8 * tx, acc[a], accu[a]);
                    else E.row8(u, 128 * sm + 4 * ty + a, 128 * sn + 8 * tx, acc[a]);
                }
            }
    }
    __syncthreads();
}
template <class Sched, class Epi>
DI void gemm_run(LAS unsigned char* lds, int tid, const Sched& S, const Epi& E) {
#if FAST_GEMM
    gemm_fast(lds, tid, S, E);
#else
    gemm_naive(lds, tid, S, E);
#endif
}

struct Ctx {
    LAS unsigned char* lds;
    int tid, lane, wave, gw, ngw;
    unsigned z;
    const float* const __attribute__((address_space(4)))* in;
    float* out;
    unsigned char* ws;
};
#define WSP(T, off) ((T*)(c.ws + (off)))

DI void transpose_item(const float* W, int N, bf16* WT, int k0, int n0, int dst_row0, LAS float* scr, int lane) {
#pragma unroll 8
    for (int i = 0; i < 32; ++i) { const int kk = 2 * i + (lane >> 5); scr[kk * 33 + (lane & 31)] = __builtin_nontemporal_load(W + (size_t)(k0 + kk) * N + n0 + (lane & 31)); }
    asm volatile("s_waitcnt lgkmcnt(0)" ::: "memory");
    const int cc = lane & 7;
#pragma unroll
    for (int j = 0; j < 4; ++j) { const int n = (lane >> 3) + 8 * j; const LAS float* s = scr + (8 * cc) * 33 + n;
        u32x4 o; o.x = cvt_pk_bf16(s[0 * 33], s[1 * 33]); o.y = cvt_pk_bf16(s[2 * 33], s[3 * 33]); o.z = cvt_pk_bf16(s[4 * 33], s[5 * 33]); o.w = cvt_pk_bf16(s[6 * 33], s[7 * 33]);
        *(u32x4*)(WT + (size_t)(dst_row0 + n) * 1024 + k0 + 8 * cc) = o; }
    asm volatile("s_waitcnt lgkmcnt(0)" ::: "memory");
}
DI void dense_transpose(const Ctx& c, const float* W, int N, bf16* WT, LAS float* scr) {
    const int nblk = N / 32, nitems = 16 * nblk;
    for (int it = c.gw; it < nitems; it += c.ngw) { const int kb = it / nblk, nb = it % nblk; transpose_item(W, N, WT, 64 * kb, 32 * nb, 32 * nb, scr, c.lane); }
}
DI void phase_pro0(const Ctx& c) {
    LAS float* scr = (LAS float*)(c.lds + c.wave * 8704);
    for (int j = 0; j < 2; ++j) {
        dense_transpose(c, c.in[I_MLWIN] + (size_t)j * 1024 * 3104, 3104, WSP(bf16, WS_ML_WIN) + (size_t)j * NINP * 1024, scr);
        dense_transpose(c, c.in[I_MLWOUT] + (size_t)j * 1024 * 1024, 1024, WSP(bf16, WS_ML_WOUT) + (size_t)j * 1024 * 1024, scr);
    }
    dense_transpose(c, c.in[I_GLWIN], 3104, WSP(bf16, WS_GLA_WIN), scr);
    dense_transpose(c, c.in[I_GLWOUT], 1024, WSP(bf16, WS_GLA_WOUT), scr);
    dense_transpose(c, c.in[I_HYWIN], 3072, WSP(bf16, WS_HY_WIN), scr);
    dense_transpose(c, c.in[I_HYWOUT], 1024, WSP(bf16, WS_HY_WOUT), scr);
    for (int it = c.gw * 64 + c.lane; it < 3 * 28672; it += c.ngw * 64) {
        const int m = it / 28672, r = it % 28672; bf16* base = (m < 2) ? WSP(bf16, WS_ML_WIN) + (size_t)m * NINP * 1024 : WSP(bf16, WS_GLA_WIN);
        *(u32x4*)(base + (size_t)3104 * 1024 + (size_t)r * 8) = (u32x4){c.z, c.z, c.z, c.z};
    }
    for (int it = c.gw; it < 64 * 3 * 512; it += c.ngw) {
        const int le = it / 1536, r0 = it % 1536, which = r0 / 512, r = r0 % 512, kb = r / 32, nb = r % 32;
        if (which < 2) {
            const float* W = c.in[which == 0 ? I_EW1 : I_EW3] + (size_t)le * 1024 * 1024;
            const int n0 = 32 * nb, drow = 256 * (n0 >> 7) + (n0 & 127) + (which ? 128 : 0);
            transpose_item(W, 1024, WSP(bf16, WS_EXP_UP) + (size_t)le * 2048 * 1024, 64 * kb, n0, drow, scr, c.lane);
        } else {
            transpose_item(c.in[I_EW2] + (size_t)le * 1024 * 1024, 1024, WSP(bf16, WS_EXP_DN) + (size_t)le * 1024 * 1024, 64 * kb, 32 * nb, 32 * nb, scr, c.lane);
        }
    }
    for (int i = blockIdx.x * 512 + c.tid; i < 16 * 1024; i += gridDim.x * 512) WSP(float, WS_RWT)[i] = c.in[I_RW][(i & 1023) * 16 + (i >> 10)];
    {
        const float* w1 = c.in[I_HYFW1]; const float* b1 = c.in[I_HYFB1]; const float* wm = c.in[I_HYFWM]; const float* bm = c.in[I_HYFBM]; const float* fr = c.in[I_HYFREQ];
        float* HM = WSP(float, WS_HM);
        for (int row = c.gw; row < 2304; row += c.ngw) {
            const int L = row < 2048 ? 2048 : 256, t = row < 2048 ? row : row - 2048, f = c.lane;
            float feat = 0.f;
            if (f == 0) feat = (float)t / (float)(L - 1);
            else if (f <= 32) { const int b = (f - 1) & 15; const float band = 1e-4f + (float)b * ((15.0f - 1e-4f) / 15.0f);
                const float ang = ((float)(2.0 * 3.14159265358979323846 / (double)L) * (float)t) * band; feat = (f <= 16) ? cosf(ang) : -sinf(ang); }
            float a = b1[f];
            for (int e = 0; e < 33; ++e) a += __shfl(feat, e) * w1[e * 64 + f];
            float h = sinf(fr[f] * a);
            for (int m = 0; m < 2; ++m) {
                float a2 = bm[m * 64 + f];
                for (int g = 0; g < 64; ++g) a2 += __shfl(h, g) * wm[m * 4096 + g * 64 + f];
                h = sinf(fr[f] * a2);
            }
            HM[row * 64 + f] = h;
        }
    }
    __syncthreads();
    {
        LAS float* sv = (LAS float*)c.lds;
        LAS float* red = sv + 9 * 1024;
        for (int i = c.tid; i < 9 * 1024; i += 512) { const float x = (i < 8192) ? c.in[I_C][i] : c.in[I_CCTX][i - 8192]; sv[i] = siluf_(x); }
        __syncthreads();
        float* MOD = WSP(float, WS_MOD);
        const int col = c.tid & 63, kg = c.tid >> 6;
        for (int item = blockIdx.x; item < 4 * 96; item += gridDim.x) {
            const int l = item / 96, j0 = 64 * (item % 96);
            const float* w = c.in[I_ADAW] + (size_t)l * 1024 * 6144 + j0 + col;
            float acc[9];
#pragma unroll
            for (int r = 0; r < 9; ++r) acc[r] = 0.f;
            for (int k = kg * 128; k < kg * 128 + 128; ++k) { const float wv = w[(size_t)k * 6144];
#pragma unroll
                for (int r = 0; r < 9; ++r) acc[r] += sv[r * 1024 + k] * wv; }
#pragma unroll
            for (int r = 0; r < 9; ++r) red[(kg * 9 + r) * 64 + col] = acc[r];
            __syncthreads();
            for (int o = c.tid; o < 9 * 64; o += 512) { const int r = o >> 6, cc = o & 63; float s = c.in[I_ADAB][l * 6144 + j0 + cc];
#pragma unroll
                for (int g = 0; g < 8; ++g) s += red[(g * 9 + r) * 64 + cc];
                MOD[(l * 9 + r) * 6144 + j0 + cc] = s; }
            __syncthreads();
        }
    }
}

template <int L>
DI void pro1_len(const Ctx& c, int c0, const float* hm, float* tab, LAS float* hmT  , const LAS f32x4* wo4  , float (&part)[4]) {
    const int side = c.wave & 1, ts = c.wave >> 1;
    const float da = -4.605170185988091f / 1.5f, db = -4.605170185988091f / 0.3f;
#pragma unroll 1
    for (int t0 = 0; t0 < L; t0 += 256) {
        __syncthreads();
#pragma unroll
        for (int k = 0; k < 8; ++k) { const int idx = c.tid + 512 * k, row = idx >> 4, q = idx & 15; const f32x4 v = *(const f32x4*)(hm + (size_t)(t0 + row) * 64 + 4 * q);
            LAS float* d = hmT + row * 65 + 4 * q; d[0] = v.x; d[1] = v.y; d[2] = v.z; d[3] = v.w; }
        __syncthreads();
        const int t = t0 + 64 * ts + c.lane; const LAS float* hr = hmT + (64 * ts + c.lane) * 65;
        f32x4 acc = {0.f, 0.f, 0.f, 0.f};
#pragma unroll 8
        for (int f = 0; f < 64; ++f) acc += wo4[side * 64 + f] * hr[f];
        const float tl = (float)t / (float)(L - 1);
#pragma unroll
        for (int ch = 0; ch < 4; ++ch) { const float delta = fabsf(da + (float)(c0 + ch) * ((db - da) / 1023.0f)), v = acc[ch] * expf(-tl * delta);
            float* trow = tab + (size_t)(c0 + ch) * (2 * L);
            if (side == 0) { trow[L + t] = v; part[ch] += fabsf(v); }
            else if (t >= 1) { trow[L - t] = v; part[ch] += fabsf(v); }
            else trow[0] = 0.f; }
    }
}
template <int L>
DI void pro1_scale(const Ctx& c, int c0, float* tab, const float (&inv)[4]) {
    const int side = c.wave & 1, ts = c.wave >> 1;
#pragma unroll 1
    for (int t0 = 0; t0 < L; t0 += 256) { const int t = t0 + 64 * ts + c.lane;
#pragma unroll
        for (int ch = 0; ch < 4; ++ch) { float* trow = tab + (size_t)(c0 + ch) * (2 * L); if (side == 0) trow[L + t] *= inv[ch]; else if (t >= 1) trow[L - t] *= inv[ch]; } }
}
DI void pro1_reduce(const Ctx& c, float (&part)[4], LAS float* red, float (&inv)[4]) {
#pragma unroll
    for (int ch = 0; ch < 4; ++ch) part[ch] = wave_sum(part[ch]);
    __syncthreads();
    if (c.lane == 0) {
#pragma unroll
        for (int ch = 0; ch < 4; ++ch) red[c.wave * 4 + ch] = part[ch]; }
    __syncthreads();
#pragma unroll
    for (int ch = 0; ch < 4; ++ch) { float s = 0.f;
#pragma unroll
        for (int w = 0; w < 8; ++w) s += red[w * 4 + ch];
        inv[ch] = 1.0f / s; }
}
DI void phase_pro1(const Ctx& c) {
    LAS float* hmT = (LAS float*)c.lds; LAS f32x4* wo4 = (LAS f32x4*)(c.lds + 67584); LAS float* red = (LAS float*)(c.lds + 67584 + 2048);
    const float* HM = WSP(float, WS_HM);
    for (int item = blockIdx.x; item < 256; item += gridDim.x) {
        const int c0 = 4 * item;
        __syncthreads();
        if (c.tid < 128) wo4[c.tid] = *(const f32x4*)(c.in[I_HYFWO] + (size_t)(c.tid & 63) * 2048 + (c.tid >> 6) * 1024 + c0);
        float part[4] = {0.f, 0.f, 0.f, 0.f}, inv[4];
        pro1_len<SEQ>(c, c0, HM, WSP(float, WS_HF), hmT, wo4, part);
        pro1_reduce(c, part, red, inv);
        pro1_scale<SEQ>(c, c0, WSP(float, WS_HF), inv);
        float part2[4] = {0.f, 0.f, 0.f, 0.f};
        pro1_len<CTX>(c, c0, HM + 2048 * 64, WSP(float, WS_HFC), hmT, wo4, part2);
        pro1_reduce(c, part2, red, inv);
        pro1_scale<CTX>(c, c0, WSP(float, WS_HFC), inv);
    }
}

DI void load_row(const float* src, f32x4 (&v)[4], int lane) {
#pragma unroll
    for (int j = 0; j < 4; ++j) v[j] = *(const f32x4*)(src + 256 * j + 4 * lane);
}
DI void load_row_bf(const bf16* src, f32x4 (&v)[4], int lane) {
#pragma unroll
    for (int j = 0; j < 4; ++j) { const u32x2 a = *(const u32x2*)(src + 256 * j + 4 * lane);
        v[j] = (f32x4){__uint_as_float(a.x << 16), __uint_as_float(a.x & 0xffff0000u), __uint_as_float(a.y << 16), __uint_as_float(a.y & 0xffff0000u)}; }
}
DI void load_row_raw(const bf16* src, u32x2 (&r)[4], int lane) {
#pragma unroll
    for (int j = 0; j < 4; ++j) r[j] = *(const u32x2*)(src + 256 * j + 4 * lane);
}
DI void cvt_row_raw(const u32x2 (&r)[4], f32x4 (&v)[4]) {
#pragma unroll
    for (int j = 0; j < 4; ++j) v[j] = (f32x4){__uint_as_float(r[j].x << 16), __uint_as_float(r[j].x & 0xffff0000u), __uint_as_float(r[j].y << 16), __uint_as_float(r[j].y & 0xffff0000u)};
}
DI void norm_row(f32x4 (&v)[4], const float* g, int lane) {
    float s = 0.f;
#pragma unroll
    for (int j = 0; j < 4; ++j) s += (v[j].x * v[j].x + v[j].y * v[j].y) + (v[j].z * v[j].z + v[j].w * v[j].w);
    s = wave_sum(s);
    const float r = 1.0f / sqrtf(s * (1.0f / 1024.0f) + EPS);
#pragma unroll
    for (int j = 0; j < 4; ++j) v[j] = v[j] * r * *(const f32x4*)(g + 256 * j + 4 * lane);
}
DI void mod_row(f32x4 (&v)[4], const float* sh, const float* sc, int lane) {
#pragma unroll
    for (int j = 0; j < 4; ++j) v[j] = v[j] * (*(const f32x4*)(sc + 256 * j + 4 * lane) + 1.0f) + *(const f32x4*)(sh + 256 * j + 4 * lane);
}
DI void load_vec(const float* p, f32x4 (&w)[4], int lane) {
#pragma unroll
    for (int j = 0; j < 4; ++j) w[j] = *(const f32x4*)(p + 256 * j + 4 * lane);
}
DI void norm_mod_row_reg(f32x4 (&v)[4], const f32x4 (&g)[4], const f32x4 (&sh)[4], const f32x4 (&sc)[4]) {
    float s = 0.f;
#pragma unroll
    for (int j = 0; j < 4; ++j) s += (v[j].x * v[j].x + v[j].y * v[j].y) + (v[j].z * v[j].z + v[j].w * v[j].w);
    s = wave_sum(s);
    const float r = 1.0f / sqrtf(s * (1.0f / 1024.0f) + EPS);
#pragma unroll
    for (int j = 0; j < 4; ++j) v[j] = (v[j] * r * g[j]) * (sc[j] + 1.0f) + sh[j];
}
DI void store_row_bf16(bf16* dst, const f32x4 (&v)[4], int lane) {
#pragma unroll
    for (int j = 0; j < 4; ++j) { u32x2 w; w.x = cvt_pk_bf16(v[j].x, v[j].y); w.y = cvt_pk_bf16(v[j].z, v[j].w); *(u32x2*)(dst + 256 * j + 4 * lane) = w; }
}
DI int hrow_of(int srow, int kind) {
    if (srow < TC || kind != 1) return srow;
    const int rr = srow - TC, b = rr >> 11, s = rr & (SEQ - 1); return TC + b * SEQ + perm_fwd(s);
}
DI void phase_norm1(const Ctx& c, int l, const float* xl, const float* xc) {
    const float* MOD = WSP(float, WS_MOD) + (size_t)l * 9 * 6144; const float* g = c.in[I_N1G] + l * D; bf16* H = WSP(bf16, WS_H);
    const int per = (TT + c.ngw - 1) / c.ngw, rfirst = c.gw * per, rend = min(rfirst + per, TT);
    f32x4 vA[4] = {}, vB[4] = {}, gv[4], shv[4] = {}, scv[4] = {}; int mr_cur = -1; load_vec(g, gv, c.lane);
    if (rfirst < rend) { const int r = rfirst; load_row(r < TC ? xc + (size_t)r * D : xl + (size_t)(r - TC) * D, vA, c.lane); }
    if (rfirst + 1 < rend) { const int r = rfirst + 1; load_row(r < TC ? xc + (size_t)r * D : xl + (size_t)(r - TC) * D, vB, c.lane); }
    for (int row = rfirst; row < rend; ++row) {
        f32x4 v[4]; const int mr = row < TC ? 8 : (row - TC) >> 11;
        if (mr != mr_cur) { load_vec(MOD + mr * 6144, shv, c.lane); load_vec(MOD + mr * 6144 + 1024, scv, c.lane); mr_cur = mr; }
#pragma unroll
        for (int j = 0; j < 4; ++j) { v[j] = vA[j]; vA[j] = vB[j]; }
        if (row + 2 < rend) { const int r = row + 2; load_row(r < TC ? xc + (size_t)r * D : xl + (size_t)(r - TC) * D, vB, c.lane); }
        norm_mod_row_reg(v, gv, shv, scv);
        store_row_bf16(H + (size_t)hrow_of(row, l % 3) * D, v, c.lane);
    }
}

DI void phase_conv(const Ctx& c, int ncols, const float* cw, const float* cb, bool act, float qs) {
    const bf16* P = WSP(bf16, WS_P); bf16* PC = WSP(bf16, WS_BIG + BIG_PC);
    const int ng = ncols / 8; const long total = (long)TT * ng;
    for (long idx = (long)blockIdx.x * 512 + c.tid; idx < total; idx += (long)gridDim.x * 512) {
        const int row = (int)(idx / ng), col = (int)(idx % ng) * 8; int lo, hi; seq_bounds(row, lo, hi);
        float x0[8], xm[8], xp[8];
        unpack8(*(const u32x4*)(P + (size_t)row * PLD + col), x0);
        if (row > lo) unpack8(*(const u32x4*)(P + (size_t)(row - 1) * PLD + col), xm); else {
#pragma unroll
            for (int j = 0; j < 8; ++j) xm[j] = 0.f; }
        if (row < hi) unpack8(*(const u32x4*)(P + (size_t)(row + 1) * PLD + col), xp); else {
#pragma unroll
            for (int j = 0; j < 8; ++j) xp[j] = 0.f; }
        float o[8];
#pragma unroll
        for (int j = 0; j < 8; ++j) { float v = cw[col + j] * xm[j] + cw[ncols + col + j] * x0[j] + cw[2 * ncols + col + j] * xp[j] + cb[col + j];
            if (act) v = siluf_(v); if (col < 512) v *= qs; o[j] = v; }
        *(u32x4*)(PC + (size_t)row * ncols + col) = pack8(o);
    }
}

DI int scan_row(int step, int b, int dir) {
    if (step < CTX) return b * CTX + (dir ? CTX - 1 - step : step);
    const int s = step - CTX; return TC + b * SEQ + (dir ? SEQ - 1 - s : s);
}
DI void phase_mlstm_scan_naive(const Ctx& c) {
    const bf16* P = WSP(bf16, WS_P); const bf16* PC = WSP(bf16, WS_BIG + BIG_PC); const float* EX = WSP(float, WS_EXTRA);
    LAS float* qs = (LAS float*)c.lds; LAS float* ks = qs + 32 * 64; LAS float* vs = ks + 32 * 64; LAS float* gs = vs + 32 * 128;
    const int v = c.tid >> 2, d0 = (c.tid & 3) * 16;
    for (int item = blockIdx.x; item < 128; item += gridDim.x) {
        const int b = item >> 4, h = (item >> 1) & 7, dir = item & 1;
        float* Yo = WSP(float, WS_BIG + (dir ? BIG_YB : BIG_YF));
        float C[16], n[16];
#pragma unroll
        for (int d = 0; d < 16; ++d) { C[d] = 0.f; n[d] = 0.f; }
        for (int ch = 0; ch < (CTX + SEQ) / 32; ++ch) {
            __syncthreads();
            for (int idx = c.tid; idx < 32 * 256; idx += 512) { const int st = idx >> 8, col = idx & 255, row = scan_row(ch * 32 + st, b, dir);
                if (col < 64) qs[st * 64 + col] = bf2f(PC[(size_t)row * 1024 + h * 64 + col]);
                else if (col < 128) ks[st * 64 + col - 64] = bf2f(PC[(size_t)row * 1024 + 512 + h * 64 + col - 64]);
                else vs[st * 128 + col - 128] = bf2f(P[(size_t)row * PLD + 1024 + h * 128 + col - 128]); }
            if (c.tid < 32) { const int row = scan_row(ch * 32 + c.tid, b, dir); gs[c.tid * 2] = sigmoidf_(EX[(size_t)row * 32 + dir * 16 + 8 + h]); gs[c.tid * 2 + 1] = __expf(EX[(size_t)row * 32 + dir * 16 + h]); }
            __syncthreads();
            for (int st = 0; st < 32; ++st) {
                const float f = gs[st * 2], ei = gs[st * 2 + 1], vv = vs[st * 128 + v] * ei;
                float part = 0.f, dpart = 0.f;
#pragma unroll
                for (int d = 0; d < 16; ++d) { const float kd = ks[st * 64 + d0 + d], qd = qs[st * 64 + d0 + d];
                    C[d] = f * C[d] + kd * vv; part += qd * C[d]; n[d] = f * n[d] + ei * kd; dpart += qd * n[d]; }
                part += shx_(part, 1); part += shx_(part, 2); dpart += shx_(dpart, 1); dpart += shx_(dpart, 2);
                if ((c.tid & 3) == 0) { const int row = scan_row(ch * 32 + st, b, dir); Yo[(size_t)row * D + h * 128 + v] = part / fmaxf(fabsf(dpart), 1.0f); }
            }
        }
    }
}
typedef short s16x4 __attribute__((ext_vector_type(4)));
typedef float f32x16 __attribute__((ext_vector_type(16)));
#define MFMA32(a, b, c) __builtin_amdgcn_mfma_f32_32x32x16_bf16((a), (b), (c), 0, 0, 0)
DI int crow(int reg, int h) { return (reg & 3) + 8 * (reg >> 2) + 4 * h; }
DI s16x4 ds_tr(const LAS unsigned char* p) { return __builtin_amdgcn_ds_read_tr16_b64_v4i16((LAS s16x4*)p); }
DI bf16x8 cat8(s16x4 lo, s16x4 hi) { return __builtin_shufflevector(lo, hi, 0, 1, 2, 3, 4, 5, 6, 7); }
DI bf16x8 tr_frag(const LAS unsigned char* img, int pitch, int k0, int n0, int lane) {
    const int h = lane >> 5, g16 = (lane >> 4) & 1, i = lane & 15;
    const LAS unsigned char* p = img + (k0 + 8 * h + (i >> 2)) * pitch + (n0 + 16 * g16 + 4 * (i & 3)) * 2;
    return cat8(ds_tr(p), ds_tr(p + 4 * pitch));
}
DI bf16x8 tr_frag_perm(const LAS unsigned char* img, int pitch, int k0, int n0, int lane) {
    const int h = lane >> 5, g16 = (lane >> 4) & 1, i = lane & 15;
    const LAS unsigned char* p = img + (k0 + 4 * h + (i >> 2)) * pitch + (n0 + 16 * g16 + 4 * (i & 3)) * 2;
    return cat8(ds_tr(p), ds_tr(p + 8 * pitch));
}
DI bf16x8 row_frag(const LAS unsigned char* img, int pitch, int row0, int k0, int lane) { return *(const LAS bf16x8*)(img + (row0 + (lane & 31)) * pitch + (k0 + 8 * (lane >> 5)) * 2); }
DI bf16x8 pack_acc(const f32x16& x, int step) {
    u32x4 p; const int o = 8 * step;
    p.x = cvt_pk_bf16(x[o], x[o + 1]); p.y = cvt_pk_bf16(x[o + 2], x[o + 3]); p.z = cvt_pk_bf16(x[o + 4], x[o + 5]); p.w = cvt_pk_bf16(x[o + 6], x[o + 7]);
    return __builtin_bit_cast(bf16x8, p);
}
DI f32x16 zero16() { f32x16 z;
#pragma unroll
    for (int i = 0; i < 16; ++i) z[i] = 0.f; return z; }
DI float wave_incl_prefix(float x, int lane) {
#pragma unroll
    for (int o = 1; o < 64; o <<= 1) { const float t = __shfl_up(x, o); if (lane >= o) x += t; }
    return x;
}
DI float wave_incl_suffix(float x, int lane) {
#pragma unroll
    for (int o = 1; o < 64; o <<= 1) { const float t = __shfl_down(x, o); if (lane + o < 64) x += t; }
    return x;
}
DI int chunk_row0(int p, int b, int dir) {
    if (p < 4) return b * CTX + 64 * (dir ? 3 - p : p);
    return TC + b * SEQ + 64 * (dir ? 35 - p : p - 4);
}

DI void phase_mlstm_state(const Ctx& c) {
    const bf16* P = WSP(bf16, WS_P); const bf16* PC = WSP(bf16, WS_BIG + BIG_PC); const float* EX = WSP(float, WS_EXTRA);
    bf16* MCT = WSP(bf16, WS_BIG + BIG_MCT); float* MN = WSP(float, WS_BIG + BIG_MN);
    LAS float* gi = (LAS float*)c.lds; LAS float* ga = gi + 2304; LAS float* wv = ga + 2304; LAS float* dec = wv + 64;
    LAS unsigned char* Kw = c.lds + 20480; LAS unsigned char* Vs = Kw + 64 * 144;
    const int lane = c.lane, wave = c.wave, h5 = lane >> 5, l31 = lane & 31;
    for (int it0 = blockIdx.x; it0 < 256; it0 += gridDim.x) {
        const int item = (gridDim.x == 256) ? ((it0 & 7) * 32 + (it0 >> 3)) : it0;
        const int b = item >> 5, h = (item >> 2) & 7, dir = (item >> 1) & 1, dvh = item & 1, seq = (b * 8 + h) * 2 + dir;
        __syncthreads();
        for (int idx = c.tid; idx < 2304; idx += 512) { const int row = chunk_row0(idx >> 6, b, dir) + (idx & 63);
            gi[idx] = EX[(size_t)row * 32 + dir * 16 + h]; ga[idx] = logsigf_(EX[(size_t)row * 32 + dir * 16 + 8 + h]); }
        f32x16 acc = zero16(); float nst = 0.f;
        const int dt = wave & 1, vt = (wave >> 1) & 1;
        const int srow = c.tid >> 3, spc = c.tid & 7;
        u32x4 kregA, vregA, kregB, vregB;
#define ML_PREFETCH(p_, kr, vr) do { const int r0_ = chunk_row0((p_), b, dir); \
          kr = *(const u32x4*)(PC + (size_t)(r0_ + srow) * 1024 + 512 + h * 64 + 8 * spc); \
          vr = *(const u32x4*)(P + (size_t)(r0_ + srow) * PLD + 1024 + h * 128 + dvh * 64 + 8 * spc); } while (0)
        ML_PREFETCH(0, kregA, vregA); ML_PREFETCH(1, kregB, vregB);
        __syncthreads();
#define ML_STEP(p, kreg, vreg) do { \
              \
            if (wave < 4) { \
                bf16* dst = MCT + ((size_t)seq * 36 + (p)) * 8192 + (size_t)(dvh * 64 + 32 * vt + l31) * 64 + 32 * dt + 4 * h5; \
                _Pragma("unroll") for (int q = 0; q < 4; ++q) { u32x2 w; w.x = cvt_pk_bf16(acc[4 * q], acc[4 * q + 1]); w.y = cvt_pk_bf16(acc[4 * q + 2], acc[4 * q + 3]); *(u32x2*)(dst + 8 * q) = w; } \
            } else if (wave == 4) { if (dvh == 0) MN[((size_t)seq * 36 + (p)) * 64 + lane] = nst; } \
            else if (wave == 7) { \
                const float a = ga[(p) * 64 + lane]; const float bj = dir ? wave_incl_suffix(a, lane) : wave_incl_prefix(a, lane); \
                const float tot = __shfl(bj, dir ? 0 : 63); \
                wv[lane] = __expf(tot - bj + gi[(p) * 64 + lane]); if (lane == 0) dec[0] = __expf(tot); \
            } \
            lds_barrier(); \
              \
            { float kk[8]; unpack8(kreg, kk); const float w = wv[srow]; \
              _Pragma("unroll") for (int j = 0; j < 8; ++j) kk[j] *= w; \
              *(LAS u32x4*)(Kw + srow * 144 + spc * 16) = pack8(kk); *(LAS u32x4*)(Vs + srow * 144 + spc * 16) = vreg; } \
            if ((p) + 2 < 36) ML_PREFETCH((p) + 2, kreg, vreg); \
            const float d = dec[0];            \
            lds_barrier(); \
              \
            if (wave < 4) { \
                _Pragma("unroll") for (int i = 0; i < 16; ++i) acc[i] *= d; \
                _Pragma("unroll") for (int kk = 0; kk < 4; ++kk) acc = MFMA32(tr_frag(Kw, 144, 16 * kk, 32 * dt, lane), tr_frag(Vs, 144, 16 * kk, 32 * vt, lane), acc); \
            } else if (wave == 4) { \
                float s = 0.f; \
                for (int r = 0; r < 64; ++r) s += bf2f(*(const LAS bf16*)(Kw + r * 144 + lane * 2)); \
                nst = d * nst + s; \
            } } while (0)
        for (int p = 0; p < 36; p += 2) { ML_STEP(p, kregA, vregA); ML_STEP(p + 1, kregB, vregB); }
#undef ML_STEP
#undef ML_PREFETCH
    }
}

DI void phase_mlstm_out(const Ctx& c, const float* ng) {
    const bf16* P = WSP(bf16, WS_P); const bf16* PC = WSP(bf16, WS_BIG + BIG_PC); const float* EX = WSP(float, WS_EXTRA);
    const bf16* MCT = WSP(bf16, WS_BIG + BIG_MCT); const float* MN = WSP(float, WS_BIG + BIG_MN); bf16* Y = WSP(bf16, WS_Y);
    LAS unsigned char* Qs = c.lds; LAS unsigned char* Ks = Qs + 9216; LAS unsigned char* Vs = Ks + 9216;
    LAS unsigned char* CT0 = Vs + 17408;
    LAS float* gt = (LAS float*)(c.lds + MISC_OFF + 1024);
    LAS float* YO = (LAS float*)c.lds;
    const int lane = c.lane, wave = c.wave, h5 = lane >> 5, l31 = lane & 31;
    const int dir = wave >> 2, jt = (wave >> 1) & 1, vh = wave & 1;
    const int srow = c.tid >> 3, spc = c.tid & 7;
    u32x4 pq, pk, pv[2], pct[4], pgate[2]; float pga = 0.f, pgi = 0.f, pgn = 0.f;
#define MO_DECODE(it_) const int b = (it_) / 288, h = ((it_) / 36) & 7, cc = (it_) % 36; \
        const int r0 = cc < 4 ? b * CTX + 64 * cc : TC + b * SEQ + 64 * (cc - 4); const int pf = cc, pb = cc < 4 ? 3 - cc : 39 - cc
#define MO_PREFETCH(it_) do { MO_DECODE(it_); \
        pq = *(const u32x4*)(PC + (size_t)(r0 + srow) * 1024 + h * 64 + 8 * spc); pk = *(const u32x4*)(PC + (size_t)(r0 + srow) * 1024 + 512 + h * 64 + 8 * spc); \
        _Pragma("unroll") for (int i = 0; i < 2; ++i) pv[i] = *(const u32x4*)(P + (size_t)(r0 + srow) * PLD + 1024 + h * 128 + 8 * (spc + 8 * i)); \
        _Pragma("unroll") for (int i = 0; i < 4; ++i) { const int pc = c.tid + 512 * i, d2 = pc >> 10, rr = (pc >> 3) & 127, sp = pc & 7; \
            pct[i] = *(const u32x4*)(MCT + (((size_t)((b * 8 + h) * 2 + d2)) * 36 + (d2 ? pb : pf)) * 8192 + rr * 64 + 8 * sp); } \
        _Pragma("unroll") for (int i = 0; i < 2; ++i) pgate[i] = *(const u32x4*)(P + (size_t)(r0 + srow) * PLD + 2048 + h * 128 + 16 * spc + 8 * i); \
        if (wave < 2) { const int d2 = wave, row = r0 + lane; pga = EX[(size_t)row * 32 + d2 * 16 + 8 + h]; pgi = EX[(size_t)row * 32 + d2 * 16 + h]; \
            pgn = MN[(((size_t)((b * 8 + h) * 2 + d2)) * 36 + (d2 ? pb : pf)) * 64 + lane]; } } while (0)
    if ((int)blockIdx.x < 2304) MO_PREFETCH((int)blockIdx.x);
    for (int item = blockIdx.x; item < 2304; item += gridDim.x) {
        MO_DECODE(item); (void)pf; (void)pb;
        lds_barrier();
        *(LAS u32x4*)(Qs + srow * 144 + spc * 16) = pq; *(LAS u32x4*)(Ks + srow * 144 + spc * 16) = pk;
#pragma unroll
        for (int i = 0; i < 2; ++i) *(LAS u32x4*)(Vs + srow * 272 + (spc + 8 * i) * 16) = pv[i];
#pragma unroll
        for (int i = 0; i < 4; ++i) { const int pc = c.tid + 512 * i, d2 = pc >> 10, rr = (pc >> 3) & 127, sp = pc & 7; *(LAS u32x4*)(CT0 + d2 * 18432 + rr * 144 + sp * 16) = pct[i]; }
        if (wave < 2) { const int d2 = wave; const float a = logsigf_(pga);
            const float bj = d2 ? wave_incl_suffix(a, lane) : wave_incl_prefix(a, lane);
            gt[d2 * 192 + lane] = bj; gt[d2 * 192 + 64 + lane] = pgi - bj; gt[d2 * 192 + 128 + lane] = pgn; }
        const u32x4 gate0 = pgate[0], gate1 = pgate[1];
        if (item + (int)gridDim.x < 2304) MO_PREFETCH(item + (int)gridDim.x);
        lds_barrier();
        const LAS float* g = gt + dir * 192; const LAS unsigned char* CT = CT0 + dir * 18432;
        const int j = 32 * jt + l31; const float bjj = g[j];
        bf16x8 qf[4];
#pragma unroll
        for (int kk = 0; kk < 4; ++kk) qf[kk] = row_frag(Qs, 144, 32 * jt, 16 * kk, lane);
        float qn = 0.f;
#pragma unroll
        for (int kk = 0; kk < 4; ++kk) { float qv[8]; unpack8(__builtin_bit_cast(u32x4, qf[kk]), qv);
#pragma unroll
            for (int e = 0; e < 8; ++e) qn += qv[e] * g[128 + 16 * kk + 8 * h5 + e]; }
        qn += shx_(qn, 32);
        f32x16 X[2]; float den = 0.f;
#pragma unroll
        for (int st = 0; st < 2; ++st) {
            X[st] = zero16();
            const bool live = dir ? (st >= jt) : (st <= jt);
            if (live) {
#pragma unroll
                for (int kk = 0; kk < 4; ++kk) X[st] = MFMA32(row_frag(Ks, 144, 32 * st, 16 * kk, lane), qf[kk], X[st]);
#pragma unroll
                for (int r = 0; r < 16; ++r) { const int s = 32 * st + crow(r, h5); const bool ok = dir ? (s >= j) : (s <= j);
                    const float w = ok ? __expf(bjj + g[64 + s]) : 0.f; X[st][r] *= w; den += X[st][r]; }
            }
        }
        den += shx_(den, 32);
        const float eb = __expf(bjj); den += eb * qn;
        const float scale = 1.0f / fmaxf(fabsf(den), 1.0f);
        f32x16 O[2];
#pragma unroll
        for (int t = 0; t < 2; ++t) {
            const int vt = 2 * vh + t; f32x16 z = zero16(), w = zero16();
#pragma unroll
            for (int st = 0; st < 2; ++st) { const bool live = dir ? (st >= jt) : (st <= jt);
                if (live) {
#pragma unroll
                    for (int step = 0; step < 2; ++step) z = MFMA32(tr_frag_perm(Vs, 272, 32 * st + 16 * step, 32 * vt, lane), pack_acc(X[st], step), z); } }
#pragma unroll
            for (int kk = 0; kk < 4; ++kk) w = MFMA32(row_frag(CT, 144, 32 * vt, 16 * kk, lane), qf[kk], w);
#pragma unroll
            for (int r = 0; r < 16; ++r) O[t][r] = (z[r] + eb * w[r]) * scale;
        }
        lds_barrier();
#pragma unroll
        for (int t = 0; t < 2; ++t) { const int vt = 2 * vh + t;
#pragma unroll
            for (int q = 0; q < 4; ++q) *(LAS f32x4*)(YO + dir * 8448 + j * 132 + 32 * vt + 8 * q + 4 * h5) = (f32x4){O[t][4 * q], O[t][4 * q + 1], O[t][4 * q + 2], O[t][4 * q + 3]}; }
        lds_barrier();
        { const int row = c.tid >> 3, c0 = (c.tid & 7) * 16; float y[16]; float ss = 0.f;
#pragma unroll
          for (int q = 0; q < 4; ++q) { const f32x4 a = *(const LAS f32x4*)(YO + row * 132 + c0 + 4 * q), bb = *(const LAS f32x4*)(YO + 8448 + row * 132 + c0 + 4 * q);
              y[4 * q] = a.x + bb.x; y[4 * q + 1] = a.y + bb.y; y[4 * q + 2] = a.z + bb.z; y[4 * q + 3] = a.w + bb.w; }
#pragma unroll
          for (int q = 0; q < 16; ++q) ss += y[q] * y[q];
          ss += shx_(ss, 1); ss += shx_(ss, 2); ss += shx_(ss, 4);
          const float r = 1.0f / sqrtf(ss * (1.0f / 128.0f) + EPS);
          float g0[8], g1[8];
          unpack8(gate0, g0); unpack8(gate1, g1);
          float o0[8], o1[8];
#pragma unroll
          for (int q = 0; q < 8; ++q) { o0[q] = y[q] * r * ng[h * 128 + c0 + q] * sigmoidf_(g0[q]); o1[q] = y[8 + q] * r * ng[h * 128 + c0 + 8 + q] * sigmoidf_(g1[q]); }
          *(u32x4*)(Y + (size_t)(r0 + row) * D + h * 128 + c0) = pack8(o0); *(u32x4*)(Y + (size_t)(r0 + row) * D + h * 128 + c0 + 8) = pack8(o1); }
    }
#undef MO_PREFETCH
#undef MO_DECODE
}

DI void phase_gla_decay(const Ctx& c) {
    const float* EX = WSP(float, WS_EXTRA); float* GB = WSP(float, WS_BIG + BIG_GB);
    LAS float* w2s = (LAS float*)c.lds; LAS float* gbs = w2s + 2048; LAS float* lgs = gbs + 128; LAS float* segs = lgs + 8192;
    const int srow = c.tid >> 3, dg = c.tid & 7;
    const int dir = (blockIdx.x >> 2) & 1, h = blockIdx.x & 3, nper = gridDim.x >> 3;
    __syncthreads();
    for (int i = c.tid; i < 2048; i += 512) w2s[i] = c.in[I_GLW2][(size_t)dir * 8192 + (i >> 7) * 512 + h * 128 + (i & 127)];
    if (c.tid < 128) gbs[c.tid] = c.in[I_GLGB][dir * 512 + h * 128 + c.tid];
    for (int ck = blockIdx.x >> 3; ck < 288; ck += nper) {
        const int r0 = 64 * ck;
        __syncthreads();
        f32x4 low[4];
#pragma unroll
        for (int q = 0; q < 4; ++q) low[q] = *(const f32x4*)(EX + (size_t)(r0 + srow) * 32 + dir * 16 + 4 * q);
        __syncthreads();
        { const int d0 = 16 * dg; float pre[16];
#pragma unroll
          for (int e = 0; e < 16; ++e) pre[e] = gbs[d0 + e];
#pragma unroll
          for (int r = 0; r < 16; ++r) { const float lv = low[r >> 2][r & 3];
#pragma unroll
              for (int q = 0; q < 4; ++q) { const f32x4 w = *(const LAS f32x4*)(w2s + r * 128 + d0 + 4 * q); pre[4 * q] += lv * w.x; pre[4 * q + 1] += lv * w.y; pre[4 * q + 2] += lv * w.z; pre[4 * q + 3] += lv * w.w; } }
#pragma unroll
          for (int q = 0; q < 4; ++q) *(LAS f32x4*)(lgs + srow * 128 + d0 + 4 * q) = (f32x4){logsigf_(pre[4 * q]) * 0.0625f, logsigf_(pre[4 * q + 1]) * 0.0625f, logsigf_(pre[4 * q + 2]) * 0.0625f, logsigf_(pre[4 * q + 3]) * 0.0625f}; }
        __syncthreads();
        { const int d = c.tid & 127, sg = c.tid >> 7; float v[16];
#pragma unroll
          for (int i = 0; i < 16; ++i) { const int s = dir ? 63 - (16 * sg + i) : 16 * sg + i; v[i] = lgs[s * 128 + d]; }
#pragma unroll
          for (int i = 1; i < 16; ++i) v[i] += v[i - 1];
          segs[sg * 128 + d] = v[15];
          __syncthreads();
          float off = 0.f;
#pragma unroll
          for (int g2 = 0; g2 < 3; ++g2) off += (g2 < sg) ? segs[g2 * 128 + d] : 0.f;
#pragma unroll
          for (int i = 0; i < 16; ++i) { const int s = dir ? 63 - (16 * sg + i) : 16 * sg + i; GB[((size_t)dir * TT + r0 + s) * 512 + h * 128 + d] = v[i] + off; } }
    }
}
DI void phase_gla_state(const Ctx& c) {
    const bf16* PC = WSP(bf16, WS_BIG + BIG_PC); const float* GB = WSP(float, WS_BIG + BIG_GB); bf16* GST = WSP(bf16, WS_BIG + BIG_GST);
    LAS float* tot = (LAS float*)c.lds;
    LAS unsigned char* Kd = c.lds + 1024; LAS unsigned char* Vs = Kd + 64 * 272;
    const int lane = c.lane, wave = c.wave, h5 = lane >> 5, l31 = lane & 31, dkt = wave & 3, dvt = wave >> 2;
    const int srow = c.tid >> 3, dg = c.tid & 7;
    for (int it0 = blockIdx.x; it0 < 256; it0 += gridDim.x) {
        const int item = (gridDim.x == 256) ? ((it0 & 7) * 32 + (it0 >> 3)) : it0;
        const int b = item >> 5, h = (item >> 3) & 3, dir = (item >> 2) & 1, dvq = item & 3, seq = (b * 4 + h) * 2 + dir;
        f32x16 acc = zero16();
        u32x4 kA0, kA1, vA, kB0, kB1, vB; f32x4 bvA[4], tvA[4], bvB[4], tvB[4];
#define GLA_PREFETCH(p_, k0, k1, vr, bv, tv) do { const int r0_ = chunk_row0((p_), b, dir), row = r0_ + srow; \
          k0 = *(const u32x4*)(PC + (size_t)row * 2048 + 512 + h * 128 + 16 * dg); k1 = *(const u32x4*)(PC + (size_t)row * 2048 + 512 + h * 128 + 16 * dg + 8); \
          vr = *(const u32x4*)(PC + (size_t)row * 2048 + 1024 + h * 256 + dvq * 64 + 8 * dg); \
          _Pragma("unroll") for (int q = 0; q < 4; ++q) { bv[q] = *(const f32x4*)(GB + ((size_t)dir * TT + row) * 512 + h * 128 + 16 * dg + 4 * q); \
              tv[q] = *(const f32x4*)(GB + ((size_t)dir * TT + r0_ + (dir ? 0 : 63)) * 512 + h * 128 + 16 * dg + 4 * q); } } while (0)
        GLA_PREFETCH(0, kA0, kA1, vA, bvA, tvA); GLA_PREFETCH(1, kB0, kB1, vB, bvB, tvB);
#define GLA_STEP(p, k0r, k1r, vr, bv, tv) do { \
            { bf16* dst = GST + ((size_t)seq * 36 + (p)) * 32768 + (size_t)(dvq * 64 + 32 * dvt + l31) * 128 + 32 * dkt + 4 * h5; \
              _Pragma("unroll") for (int q = 0; q < 4; ++q) { u32x2 w; w.x = cvt_pk_bf16(acc[4 * q], acc[4 * q + 1]); w.y = cvt_pk_bf16(acc[4 * q + 2], acc[4 * q + 3]); *(u32x2*)(dst + 8 * q) = w; } } \
            lds_barrier();                                    \
            { float kk[16]; { float t8[8]; unpack8(k0r, t8); \
                _Pragma("unroll") for (int e = 0; e < 8; ++e) kk[e] = t8[e]; unpack8(k1r, t8); \
                _Pragma("unroll") for (int e = 0; e < 8; ++e) kk[8 + e] = t8[e]; } \
              _Pragma("unroll") for (int e = 0; e < 16; ++e) kk[e] *= __expf(tv[e >> 2][e & 3] - bv[e >> 2][e & 3]); \
              const float k0[8] = {kk[0], kk[1], kk[2], kk[3], kk[4], kk[5], kk[6], kk[7]}, k1[8] = {kk[8], kk[9], kk[10], kk[11], kk[12], kk[13], kk[14], kk[15]}; \
              *(LAS u32x4*)(Kd + srow * 272 + dg * 32) = pack8(k0); *(LAS u32x4*)(Kd + srow * 272 + dg * 32 + 16) = pack8(k1); \
              *(LAS u32x4*)(Vs + srow * 144 + dg * 16) = vr; \
              if (srow == 0) { \
                  _Pragma("unroll") for (int q = 0; q < 4; ++q) *(LAS f32x4*)(tot + 16 * dg + 4 * q) = tv[q]; } } \
            if ((p) + 2 < 36) GLA_PREFETCH((p) + 2, k0r, k1r, vr, bv, tv); \
            lds_barrier(); \
            _Pragma("unroll") for (int r = 0; r < 16; ++r) acc[r] *= __expf(tot[32 * dkt + crow(r, h5)]); \
            _Pragma("unroll") for (int kk = 0; kk < 4; ++kk) acc = MFMA32(tr_frag(Kd, 272, 16 * kk, 32 * dkt, lane), tr_frag(Vs, 144, 16 * kk, 32 * dvt, lane), acc); \
            } while (0)
        for (int p = 0; p < 36; p += 2) { GLA_STEP(p, kA0, kA1, vA, bvA, tvA); GLA_STEP(p + 1, kB0, kB1, vB, bvB, tvB); }
#undef GLA_STEP
#undef GLA_PREFETCH
    }
}
DI void phase_gla_out(const Ctx& c, const float* ng) {
    const bf16* P = WSP(bf16, WS_P); const bf16* PC = WSP(bf16, WS_BIG + BIG_PC); const float* GB = WSP(float, WS_BIG + BIG_GB);
    const bf16* GST = WSP(bf16, WS_BIG + BIG_GST); bf16* Y = WSP(bf16, WS_Y);
    LAS unsigned char* Qt = c.lds; LAS unsigned char* Kt = Qt + 17408; LAS unsigned char* Vs = Kt + 17408; LAS unsigned char* STs = Vs + 33792;
    LAS float* YO = (LAS float*)STs;
    const int lane = c.lane, wave = c.wave, h5 = lane >> 5, l31 = lane & 31;
    const int srow = c.tid >> 3, dg = c.tid & 7;
    for (int item = blockIdx.x; item < 1152; item += gridDim.x) {
        const int b = item / 144, h = (item / 36) & 3, cc = item % 36;
        const int r0 = cc < 4 ? b * CTX + 64 * cc : TC + b * SEQ + 64 * (cc - 4);
        __syncthreads();
#pragma unroll
        for (int i = 0; i < 4; ++i) { const int pc = dg + 8 * i; *(LAS u32x4*)(Vs + srow * 528 + pc * 16) = *(const u32x4*)(PC + (size_t)(r0 + srow) * 2048 + 1024 + h * 256 + 8 * pc); }
        f32x16 O[2]; O[0] = zero16(); O[1] = zero16();
        for (int dir = 0; dir < 2; ++dir) {
            const int pslot = dir ? (cc < 4 ? 3 - cc : 39 - cc) : cc;
            if (dir) __syncthreads();
            { const bf16* src = GST + ((size_t)((b * 4 + h) * 2 + dir) * 36 + pslot) * 32768;
#pragma unroll
              for (int i = 0; i < 8; ++i) { const int pc = c.tid + 512 * i, rr = pc >> 4, sp = pc & 15; *(LAS u32x4*)(STs + rr * 272 + sp * 16) = *(const u32x4*)(src + rr * 128 + 8 * sp); } }
            { float qq[16], kk[16], bb[16]; float t8[8];
#pragma unroll
              for (int q = 0; q < 4; ++q) { const f32x4 t4 = *(const f32x4*)(GB + ((size_t)dir * TT + r0 + srow) * 512 + h * 128 + 16 * dg + 4 * q); bb[4 * q] = t4.x; bb[4 * q + 1] = t4.y; bb[4 * q + 2] = t4.z; bb[4 * q + 3] = t4.w; }
              unpack8(*(const u32x4*)(PC + (size_t)(r0 + srow) * 2048 + h * 128 + 16 * dg), t8);
#pragma unroll
              for (int e = 0; e < 8; ++e) qq[e] = t8[e];
              unpack8(*(const u32x4*)(PC + (size_t)(r0 + srow) * 2048 + h * 128 + 16 * dg + 8), t8);
#pragma unroll
              for (int e = 0; e < 8; ++e) qq[8 + e] = t8[e];
              unpack8(*(const u32x4*)(PC + (size_t)(r0 + srow) * 2048 + 512 + h * 128 + 16 * dg), t8);
#pragma unroll
              for (int e = 0; e < 8; ++e) kk[e] = t8[e];
              unpack8(*(const u32x4*)(PC + (size_t)(r0 + srow) * 2048 + 512 + h * 128 + 16 * dg + 8), t8);
#pragma unroll
              for (int e = 0; e < 8; ++e) kk[8 + e] = t8[e];
#pragma unroll
              for (int e = 0; e < 16; ++e) { const float eb = __expf(bb[e]); qq[e] *= eb; kk[e] *= 1.0f / eb; }
              const float q0[8] = {qq[0], qq[1], qq[2], qq[3], qq[4], qq[5], qq[6], qq[7]}, q1[8] = {qq[8], qq[9], qq[10], qq[11], qq[12], qq[13], qq[14], qq[15]};
              const float k0[8] = {kk[0], kk[1], kk[2], kk[3], kk[4], kk[5], kk[6], kk[7]}, k1[8] = {kk[8], kk[9], kk[10], kk[11], kk[12], kk[13], kk[14], kk[15]};
              *(LAS u32x4*)(Qt + srow * 272 + dg * 32) = pack8(q0); *(LAS u32x4*)(Qt + srow * 272 + dg * 32 + 16) = pack8(q1);
              *(LAS u32x4*)(Kt + srow * 272 + dg * 32) = pack8(k0); *(LAS u32x4*)(Kt + srow * 272 + dg * 32 + 16) = pack8(k1); }
            __syncthreads();
#pragma unroll
            for (int jt = 0; jt < 2; ++jt) {
#pragma unroll
                for (int st = 0; st < 2; ++st) {
                    const bool live = dir ? (st >= jt) : (st <= jt);
                    if (live) {
                        f32x16 X = zero16();
#pragma unroll
                        for (int kk = 0; kk < 8; ++kk) X = MFMA32(row_frag(Kt, 272, 32 * st, 16 * kk, lane), row_frag(Qt, 272, 32 * jt, 16 * kk, lane), X);
                        if (st == jt) {
#pragma unroll
                            for (int r = 0; r < 16; ++r) { const int s = crow(r, h5); const bool ok = dir ? (s >= l31) : (s <= l31); X[r] = ok ? X[r] : 0.f; } }
#pragma unroll
                        for (int step = 0; step < 2; ++step) O[jt] = MFMA32(tr_frag_perm(Vs, 528, 32 * st + 16 * step, 32 * wave, lane), pack_acc(X, step), O[jt]);
                    }
                }
#pragma unroll
                for (int kk = 0; kk < 8; ++kk) O[jt] = MFMA32(row_frag(STs, 272, 32 * wave, 16 * kk, lane), row_frag(Qt, 272, 32 * jt, 16 * kk, lane), O[jt]);
            }
        }
        __syncthreads();
#pragma unroll
        for (int jt = 0; jt < 2; ++jt)
#pragma unroll
            for (int q = 0; q < 4; ++q) *(LAS f32x4*)(YO + (32 * jt + l31) * 260 + 32 * wave + 8 * q + 4 * h5) = (f32x4){O[jt][4 * q], O[jt][4 * q + 1], O[jt][4 * q + 2], O[jt][4 * q + 3]};
        __syncthreads();
        { const int c0 = dg * 32; float y[32]; float ss = 0.f;
#pragma unroll
          for (int q = 0; q < 8; ++q) { const f32x4 a = *(const LAS f32x4*)(YO + srow * 260 + c0 + 4 * q); y[4 * q] = a.x; y[4 * q + 1] = a.y; y[4 * q + 2] = a.z; y[4 * q + 3] = a.w; }
#pragma unroll
          for (int q = 0; q < 32; ++q) ss += y[q] * y[q];
          ss += shx_(ss, 1); ss += shx_(ss, 2); ss += shx_(ss, 4);
          const float r = 1.0f / sqrtf(ss * (1.0f / 256.0f) + EPS);
#pragma unroll
          for (int q = 0; q < 4; ++q) { float g8[8], o8[8]; unpack8(*(const u32x4*)(P + (size_t)(r0 + srow) * PLD + 2048 + h * 256 + c0 + 8 * q), g8);
#pragma unroll
              for (int e = 0; e < 8; ++e) o8[e] = y[8 * q + e] * r * ng[h * 256 + c0 + 8 * q + e] * siluf_(g8[e]);
              *(u32x4*)(Y + (size_t)(r0 + srow) * D + h * 256 + c0 + 8 * q) = pack8(o8); } }
    }
}

DI void phase_gla_scan_naive(const Ctx& c) {
    const bf16* PC = WSP(bf16, WS_BIG + BIG_PC); const float* EX = WSP(float, WS_EXTRA);
    LAS float* qs = (LAS float*)c.lds; LAS float* ks = qs + 16 * 128; LAS float* as = ks + 16 * 128; LAS float* vs = as + 16 * 128; LAS float* lw = vs + 16 * 256;
    const int v = c.tid >> 1, d0 = (c.tid & 1) * 64;
    for (int item = blockIdx.x; item < 64; item += gridDim.x) {
        const int b = item >> 3, h = (item >> 1) & 3, dir = item & 1;
        float* Yo = WSP(float, WS_BIG + (dir ? BIG_YB : BIG_YF));
        const float* w2 = c.in[I_GLW2] + (size_t)dir * 16 * 512 + h * 128; const float* gb = c.in[I_GLGB] + dir * 512 + h * 128;
        float S[64];
#pragma unroll
        for (int d = 0; d < 64; ++d) S[d] = 0.f;
        for (int ch = 0; ch < (CTX + SEQ) / 16; ++ch) {
            __syncthreads();
            if (c.tid < 256) { const int st = c.tid >> 4, r = c.tid & 15, row = scan_row(ch * 16 + st, b, dir); lw[c.tid] = EX[(size_t)row * 32 + dir * 16 + r]; }
            for (int idx = c.tid; idx < 16 * 512; idx += 512) { const int st = idx >> 9, col = idx & 511, row = scan_row(ch * 16 + st, b, dir);
                if (col < 128) qs[st * 128 + col] = bf2f(PC[(size_t)row * 2048 + h * 128 + col]);
                else if (col < 256) ks[st * 128 + col - 128] = bf2f(PC[(size_t)row * 2048 + 512 + h * 128 + col - 128]);
                else vs[st * 256 + col - 256] = bf2f(PC[(size_t)row * 2048 + 1024 + h * 256 + col - 256]); }
            __syncthreads();
            for (int idx = c.tid; idx < 16 * 128; idx += 512) { const int st = idx >> 7, d = idx & 127; float pre = gb[d];
#pragma unroll
                for (int r = 0; r < 16; ++r) pre += lw[st * 16 + r] * w2[r * 512 + d];
                as[idx] = __expf(logsigf_(pre) * (1.0f / 16.0f)); }
            __syncthreads();
            for (int st = 0; st < 16; ++st) {
                const float vv = vs[st * 256 + v]; float part = 0.f;
#pragma unroll
                for (int d = 0; d < 64; ++d) { S[d] = as[st * 128 + d0 + d] * S[d] + ks[st * 128 + d0 + d] * vv; part += qs[st * 128 + d0 + d] * S[d]; }
                part += shx_(part, 1);
                if ((c.tid & 1) == 0) { const int row = scan_row(ch * 16 + st, b, dir); Yo[(size_t)row * D + h * 256 + v] = part; }
            }
        }
    }
}
DI void phase_headnorm(const Ctx& c, int hd, const float* ng) {
    const float* YF = WSP(float, WS_BIG + BIG_YF); const float* YB = WSP(float, WS_BIG + BIG_YB); const bf16* P = WSP(bf16, WS_P); bf16* Y = WSP(bf16, WS_Y);
    for (int row = c.gw; row < TT; row += c.ngw) {
        const int c0 = 16 * c.lane; float y[16]; float ss = 0.f;
#pragma unroll
        for (int j = 0; j < 4; ++j) { const f32x4 a = *(const f32x4*)(YF + (size_t)row * D + c0 + 4 * j), bb = *(const f32x4*)(YB + (size_t)row * D + c0 + 4 * j);
            y[4 * j] = a.x + bb.x; y[4 * j + 1] = a.y + bb.y; y[4 * j + 2] = a.z + bb.z; y[4 * j + 3] = a.w + bb.w; }
#pragma unroll
        for (int j = 0; j < 16; ++j) ss += y[j] * y[j];
        ss += shx_(ss, 1); ss += shx_(ss, 2); ss += shx_(ss, 4); if (hd == 256) ss += shx_(ss, 8);
        const float r = 1.0f / sqrtf(ss / (float)hd + EPS);
        float g0[8], g1[8];
        unpack8(*(const u32x4*)(P + (size_t)row * PLD + 2048 + c0), g0); unpack8(*(const u32x4*)(P + (size_t)row * PLD + 2048 + c0 + 8), g1);
        float o[16];
#pragma unroll
        for (int j = 0; j < 16; ++j) { const float gp = j < 8 ? g0[j] : g1[j - 8]; o[j] = y[j] * r * ng[c0 + j] * (hd == 128 ? sigmoidf_(gp) : siluf_(gp)); }
        const float o0[8] = {o[0], o[1], o[2], o[3], o[4], o[5], o[6], o[7]}, o1[8] = {o[8], o[9], o[10], o[11], o[12], o[13], o[14], o[15]};
        *(u32x4*)(Y + (size_t)row * D + c0) = pack8(o0); *(u32x4*)(Y + (size_t)row * D + c0 + 8) = pack8(o1);
    }
}
DI void phase_hyena_conv_naive(const Ctx& c) {
    const bf16* PC = WSP(bf16, WS_BIG + BIG_PC); bf16* Y = WSP(bf16, WS_Y); const float* skip = c.in[I_HYSKIP];
    LAS float* zt = (LAS float*)c.lds;
    LAS float* ft = zt + 4096;
    const int cc = c.tid & 63, tg = c.tid >> 6;
    for (int item = blockIdx.x; item < 4096 + 512; item += gridDim.x) {
        int L, rb, tt, cgi; const float* tab;
        if (item < 4096) { L = SEQ; const int b = item >> 9; tt = (item >> 4) & 31; cgi = item & 15; rb = TC + b * SEQ; tab = WSP(float, WS_HF); }
        else { const int it = item - 4096; L = CTX; const int b = it >> 6; tt = (it >> 4) & 3; cgi = it & 15; rb = b * CTX; tab = WSP(float, WS_HFC); }
        const int t0 = 64 * tt, c0 = 64 * cgi;
        float acc[8];
#pragma unroll
        for (int i = 0; i < 8; ++i) acc[i] = 0.f;
        for (int sb = 0; sb < L / 64; ++sb) {
            const int s0 = 64 * sb;
            __syncthreads();
            for (int idx = c.tid; idx < 4096; idx += 512) { const int sl = idx >> 6, ch = idx & 63; const size_t o = (size_t)(rb + s0 + sl) * PLD + c0 + ch;
                zt[idx] = bf2f(PC[o + 1024]) * bf2f(PC[o + 2048]); }
            for (int idx = c.tid; idx < 64 * 128; idx += 512) { const int ch = idx >> 7, j = idx & 127;
                if (j < 127) ft[j * 65 + ch] = tab[(size_t)(c0 + ch) * (2 * L) + L + (t0 - s0 - 63 + j)]; }
            __syncthreads();
#pragma unroll 1
            for (int g = 0; g < 8; ++g) {
                float w[15], z[8]; const int base = 8 * (tg - g) + 56;
#pragma unroll
                for (int m = 0; m < 15; ++m) w[m] = ft[(base + m) * 65 + cc];
#pragma unroll
                for (int j = 0; j < 8; ++j) z[j] = zt[(8 * g + j) * 64 + cc];
#pragma unroll
                for (int i = 0; i < 8; ++i)
#pragma unroll
                    for (int j = 0; j < 8; ++j) acc[i] += w[i - j + 7] * z[j];
            }
        }
#pragma unroll
        for (int i = 0; i < 8; ++i) { const int row = rb + t0 + 8 * tg + i; const size_t o = (size_t)row * PLD + c0 + cc;
            const float zin = bf2f(PC[o + 1024]) * bf2f(PC[o + 2048]), x0 = bf2f(PC[o]);
            Y[(size_t)row * D + c0 + cc] = f2bf(x0 * (acc[i] + skip[c0 + cc] * zin)); }
    }
}

DI void hy_item(int item, int& L, int& b, int& t0, int& c0, int& rb) {
    if (item < 4096) { L = SEQ; b = item >> 9; t0 = 64 * ((item >> 4) & 31); c0 = 64 * (item & 15); rb = TC + b * SEQ; }
    else { const int it = item - 4096; L = CTX; b = it >> 6; t0 = 64 * ((it >> 4) & 3); c0 = 64 * (it & 15); rb = b * CTX; }
}
DI void phase_hy_prep(const Ctx& c) {
    const bf16* P = WSP(bf16, WS_P); bf16* X0C = WSP(bf16, WS_BIG + BIG_PC); const float* cw = c.in[I_HYCW]; const float* cb = c.in[I_HYCB];
    LAS unsigned char* raw = c.lds;
    LAS float* zt = (LAS float*)(c.lds + 32768);
    u32x4 pre[4];
#define HP_PREF(it_) do { int L_, b_, t0_, c0_, rb_; hy_item((it_), L_, b_, t0_, c0_, rb_); \
        _Pragma("unroll") for (int k = 0; k < 4; ++k) { const int pc = c.tid + 512 * k; pre[k] = (u32x4){c.z, c.z, c.z, c.z}; \
            if (pc < 3 * 66 * 8) { const int g = pc / 528, rr = (pc % 528) >> 3, sp = pc & 7, t = t0_ - 1 + rr; \
                if (t >= 0 && t < L_) pre[k] = *(const u32x4*)(P + (size_t)(rb_ + t) * PLD + g * 1024 + c0_ + 8 * sp); } } } while (0)
    if ((int)blockIdx.x < 4608) HP_PREF((int)blockIdx.x);
    for (int item = blockIdx.x; item < 4608; item += gridDim.x) {
        int L, b, t0, c0, rb; hy_item(item, L, b, t0, c0, rb);
        bf16* ZT = L == SEQ ? WSP(bf16, WS_BIG + BIG_ZTL) : WSP(bf16, WS_BIG + BIG_ZTC);
        lds_barrier();
#pragma unroll
        for (int k = 0; k < 4; ++k) { const int pc = c.tid + 512 * k; if (pc < 3 * 66 * 8) { const int g = pc / 528, rr = (pc % 528) >> 3, sp = pc & 7; *(LAS u32x4*)(raw + (g * 66 + rr) * 128 + sp * 16) = pre[k]; } }
        if (item + (int)gridDim.x < 4608) HP_PREF(item + (int)gridDim.x);
        lds_barrier();
        { const int t = c.tid >> 3, sp = c.tid & 7; float u[3][8];
#pragma unroll
          for (int g = 0; g < 3; ++g) { float xm[8], x0[8], xp[8];
              unpack8(*(const LAS u32x4*)(raw + (g * 66 + t) * 128 + sp * 16), xm); unpack8(*(const LAS u32x4*)(raw + (g * 66 + t + 1) * 128 + sp * 16), x0); unpack8(*(const LAS u32x4*)(raw + (g * 66 + t + 2) * 128 + sp * 16), xp);
              const int col = g * 1024 + c0 + 8 * sp;
#pragma unroll
              for (int e = 0; e < 8; ++e) u[g][e] = cw[col + e] * xm[e] + cw[3072 + col + e] * x0[e] + cw[6144 + col + e] * xp[e] + cb[col + e]; }
          *(u32x4*)(X0C + (size_t)(rb + t0 + t) * 1024 + c0 + 8 * sp) = pack8(u[0]);
#pragma unroll
          for (int e = 0; e < 8; ++e) zt[t * 65 + 8 * sp + e] = u[1][e] * u[2][e]; }
        lds_barrier();
        { const int ch = c.tid >> 3, tp = c.tid & 7; float z[8];
#pragma unroll
          for (int e = 0; e < 8; ++e) z[e] = zt[(8 * tp + e) * 65 + ch];
          *(u32x4*)(ZT + ((size_t)(c0 + ch) * NB + b) * L + t0 + 8 * tp) = pack8(z); }
    }
#undef HP_PREF
}
template <int L>
DI void hy_toeplitz_channel(const Ctx& c, const float* hrow  , const bf16* zsrc  , bf16* ydst  ) {
    constexpr int NBK = L / 32, CP = 2 * L + 8, NT = (NBK + 31) / 32, DMIN = -(NBK - 1), DMAX = NBK - 1;
    LAS unsigned char* F = c.lds;
    LAS unsigned char* Zs = c.lds + 8 * CP * 2;
    LAS unsigned char* R1 = Zs + (8 * NBK + 1) * 80;
    const int lane = c.lane, w = c.wave, h5 = lane >> 5, a = lane & 31, pi = lane & 15, rho = (lane >> 4) & 1;
    __syncthreads();
    for (int g = c.tid; g < (2 * L + 16) / 8; g += 512) { float v[8];
#pragma unroll
        for (int j = 0; j < 8; ++j) { const int y = 8 * g + j; v[j] = (y >= 1 && y <= 2 * L - 1) ? hrow[2 * L - y] : 0.f; }
        *(LAS u32x4*)(R1 + g * 16) = pack8(v); }
    if (c.tid < 20) *(LAS unsigned*)(Zs + 8 * NBK * 80 + 4 * c.tid) = c.z;
    for (int pc = c.tid; pc < 8 * L / 8; pc += 512) { const int bb = pc / (L / 8), pj = pc % (L / 8);
        *(LAS u32x4*)(Zs + (bb * NBK + (pj >> 2)) * 80 + (pj & 3) * 16) = *(const u32x4*)(zsrc + (size_t)bb * L + 8 * pj); }
    __syncthreads();
    for (int g = c.tid; g < 2 * L / 8; g += 512) {
        const u32x4 lo = *(const LAS u32x4*)(R1 + g * 16), hi = *(const LAS u32x4*)(R1 + g * 16 + 16);
        const unsigned Dw[8] = {lo.x, lo.y, lo.z, lo.w, hi.x, hi.y, hi.z, hi.w};
#pragma unroll
        for (int r = 0; r < 8; ++r) { u32x4 o;
            if (r & 1) { o.x = __builtin_amdgcn_alignbit(Dw[r / 2 + 1], Dw[r / 2], 16); o.y = __builtin_amdgcn_alignbit(Dw[r / 2 + 2], Dw[r / 2 + 1], 16);
                         o.z = __builtin_amdgcn_alignbit(Dw[r / 2 + 3], Dw[r / 2 + 2], 16); o.w = __builtin_amdgcn_alignbit(Dw[r / 2 + 4], Dw[r / 2 + 3], 16); }
            else { o.x = Dw[r / 2]; o.y = Dw[r / 2 + 1]; o.z = Dw[r / 2 + 2]; o.w = Dw[r / 2 + 3]; }
            *(LAS u32x4*)(F + (r * CP + 8 * g) * 2) = o; } }
    __syncthreads();
    const int r = (-a) & 7;
    f32x16 acc[NT];
    u32x4 Bf[2][NT][2];
#define HY_BLK(blk_) ((unsigned)(blk_) < (unsigned)NBK ? w * NBK + (blk_) : 8 * NBK)
#pragma unroll
    for (int q = 0; q < NT; ++q) { acc[q] = zero16();
#pragma unroll
        for (int par = 0; par < 2; ++par)
#pragma unroll
            for (int step = 0; step < 2; ++step) Bf[par][q][step] = *(const LAS u32x4*)(Zs + HY_BLK(32 * q + 2 * pi + rho - (DMIN + par)) * 80 + 32 * step + 16 * h5); }
    for (int d0 = DMIN; d0 <= DMAX; d0 += 2) {
#pragma unroll
        for (int par = 0; par < 2; ++par) {
            const int d = d0 + par;
            if (d <= DMAX) {
#pragma unroll
                for (int step = 0; step < 2; ++step) {
                    const int y0 = L - 32 * d - a + 16 * step + 8 * h5;
                    const bf16x8 A = *(const LAS bf16x8*)(F + (r * CP + (y0 - r)) * 2);
#pragma unroll
                    for (int q = 0; q < NT; ++q) if (d >= 32 * q - (NBK - 1) && d <= 32 * q + 31) acc[q] = MFMA32(A, __builtin_bit_cast(bf16x8, Bf[par][q][step]), acc[q]);
                }
#pragma unroll
                for (int q = 0; q < NT; ++q)
#pragma unroll
                    for (int step = 0; step < 2; ++step) {
                        const u32x4 fr = *(const LAS u32x4*)(Zs + HY_BLK(32 * q + rho - (d + 2)) * 80 + 32 * step + 16 * h5); u32x4 nb;
                        nb.x = (unsigned)__builtin_amdgcn_update_dpp((int)fr.x, (int)Bf[par][q][step].x, 0x111, 0xf, 0xf, false);
                        nb.y = (unsigned)__builtin_amdgcn_update_dpp((int)fr.y, (int)Bf[par][q][step].y, 0x111, 0xf, 0xf, false);
                        nb.z = (unsigned)__builtin_amdgcn_update_dpp((int)fr.z, (int)Bf[par][q][step].z, 0x111, 0xf, 0xf, false);
                        nb.w = (unsigned)__builtin_amdgcn_update_dpp((int)fr.w, (int)Bf[par][q][step].w, 0x111, 0xf, 0xf, false);
                        Bf[par][q][step] = nb; }
            }
        }
    }
#undef HY_BLK
#pragma unroll
    for (int q = 0; q < NT; ++q) { const int i = 32 * q + 2 * pi + rho;
        if (i < NBK) {
#pragma unroll
            for (int qq = 0; qq < 4; ++qq) { u32x2 o; o.x = cvt_pk_bf16(acc[q][4 * qq], acc[q][4 * qq + 1]); o.y = cvt_pk_bf16(acc[q][4 * qq + 2], acc[q][4 * qq + 3]);
                *(u32x2*)(ydst + (size_t)w * L + 32 * i + 8 * qq + 4 * h5) = o; } } }
}
DI void phase_hy_toeplitz(const Ctx& c) {
    for (int ch = blockIdx.x; ch < 1024; ch += gridDim.x) {
        hy_toeplitz_channel<SEQ>(c, WSP(float, WS_HF) + (size_t)ch * 4096, WSP(bf16, WS_BIG + BIG_ZTL) + (size_t)ch * NB * SEQ, WSP(bf16, WS_BIG + BIG_YTL) + (size_t)ch * NB * SEQ);
        hy_toeplitz_channel<CTX>(c, WSP(float, WS_HFC) + (size_t)ch * 512, WSP(bf16, WS_BIG + BIG_ZTC) + (size_t)ch * NB * CTX, WSP(bf16, WS_BIG + BIG_YTC) + (size_t)ch * NB * CTX);
    }
}
DI void phase_hy_post(const Ctx& c) {
    const bf16* X0C = WSP(bf16, WS_BIG + BIG_PC); bf16* Y = WSP(bf16, WS_Y); const float* skip = c.in[I_HYSKIP];
    LAS float* tl = (LAS float*)c.lds;
    u32x4 py, pz, px; float psk = 0.f;
#define HQ_PREF(it_) do { int L_, b_, t0_, c0_, rb_; hy_item((it_), L_, b_, t0_, c0_, rb_); \
        const bf16* ZT_ = L_ == SEQ ? WSP(bf16, WS_BIG + BIG_ZTL) : WSP(bf16, WS_BIG + BIG_ZTC); const bf16* YT_ = L_ == SEQ ? WSP(bf16, WS_BIG + BIG_YTL) : WSP(bf16, WS_BIG + BIG_YTC); \
        const int ch_ = c.tid >> 3, tp_ = c.tid & 7; const size_t o_ = ((size_t)(c0_ + ch_) * NB + b_) * L_ + t0_ + 8 * tp_; \
        py = *(const u32x4*)(YT_ + o_); pz = *(const u32x4*)(ZT_ + o_); psk = skip[c0_ + ch_]; \
        px = *(const u32x4*)(X0C + (size_t)(rb_ + t0_ + (c.tid >> 3)) * 1024 + c0_ + 8 * (c.tid & 7)); } while (0)
    if ((int)blockIdx.x < 4608) HQ_PREF((int)blockIdx.x);
    for (int item = blockIdx.x; item < 4608; item += gridDim.x) {
        int L, b, t0, c0, rb; hy_item(item, L, b, t0, c0, rb); (void)L; (void)b;
        lds_barrier();
        { const int ch = c.tid >> 3, tp = c.tid & 7; float y[8], z[8]; unpack8(py, y); unpack8(pz, z); const float sk = psk;
#pragma unroll
          for (int e = 0; e < 8; ++e) tl[ch * 65 + 8 * tp + e] = y[e] + sk * z[e]; }
        const u32x4 xc = px;
        if (item + (int)gridDim.x < 4608) HQ_PREF(item + (int)gridDim.x);
        lds_barrier();
        { const int t = c.tid >> 3, sp = c.tid & 7; float x0[8], o[8]; unpack8(xc, x0);
#pragma unroll
          for (int e = 0; e < 8; ++e) o[e] = x0[e] * tl[(8 * sp + e) * 65 + t];
          *(u32x4*)(Y + (size_t)(rb + t0 + t) * D + c0 + 8 * sp) = pack8(o); }
    }
#undef HQ_PREF
}

DI void phase_route(const Ctx& c, int l) {
    LAS float* rw = (LAS float*)c.lds;
    LAS int* lcnt = (LAS int*)(c.lds + 65536);
    LAS int* rinfo = lcnt + 32;
    LAS float* rwt = (LAS float*)(rinfo + 4 * 128);
    { const f32x4* srcw = (const f32x4*)WSP(float, WS_RWT);
#pragma unroll
      for (int i = 0; i < 8; ++i) *(LAS f32x4*)(rw + 4 * (c.tid + 512 * i)) = srcw[c.tid + 512 * i]; }
    if (c.tid < 16) lcnt[c.tid] = 0;
    __syncthreads();
    const float* MOD = WSP(float, WS_MOD) + (size_t)l * 9 * 6144; const float* g = c.in[I_N2G] + l * D; bf16* H = WSP(bf16, WS_H);
    const bf16* X = WSP(bf16, WS_X); const bf16* XC = WSP(bf16, WS_XC);
    unsigned* cnt = WSP(unsigned, WS_CTL) + CW_CNT + l * 16; int* TOK = WSP(int, WS_TOK); float* TOKW = WSP(float, WS_TOK + 512 * 1024);
    const float rbl = c.lane < 16 ? c.in[I_RB][c.lane] : 0.f;
    const int rlo = (l == 3 ? TC : 0), nrow = TT - rlo, per = (nrow + (int)gridDim.x - 1) / (int)gridDim.x;
    const int brow0 = rlo + (int)blockIdx.x * per, bn = min(per, TT - brow0);
    f32x4 gv[4], shv[4] = {}, scv[4] = {}; int mr_cur = -1; load_vec(g, gv, c.lane);
    u32x2 rawA[4] = {}, rawB[4] = {};
    if (c.wave < bn) { const int row = brow0 + c.wave; load_row_raw(row < TC ? XC + (size_t)row * D : X + (size_t)(row - TC) * D, rawA, c.lane); }
    if (c.wave + 8 < bn) { const int row = brow0 + c.wave + 8; load_row_raw(row < TC ? XC + (size_t)row * D : X + (size_t)(row - TC) * D, rawB, c.lane); }
    for (int lr = c.wave; lr < bn; lr += 8) {
        const int row = brow0 + lr;
        f32x4 v[4];
        cvt_row_raw(rawA, v);
        const int mr = row < TC ? 8 : (row - TC) >> 11;
        if (mr != mr_cur) { load_vec(MOD + mr * 6144 + 3072, shv, c.lane); load_vec(MOD + mr * 6144 + 4096, scv, c.lane); mr_cur = mr; }
        norm_mod_row_reg(v, gv, shv, scv);
        store_row_bf16(H + (size_t)row * D, v, c.lane);
#pragma unroll
        for (int j = 0; j < 4; ++j) rawA[j] = rawB[j];
        if (lr + 16 < bn) { const int rn = row + 16; load_row_raw(rn < TC ? XC + (size_t)rn * D : X + (size_t)(rn - TC) * D, rawB, c.lane); }
        float s16[16];
#pragma unroll
        for (int e = 0; e < 16; ++e) { float s = 0.f;
#pragma unroll
            for (int j = 0; j < 4; ++j) { const f32x4 w = *(const LAS f32x4*)(rw + e * 1024 + 256 * j + 4 * c.lane); s += (v[j].x * w.x + v[j].y * w.y) + (v[j].z * w.z + v[j].w * w.w); }
            s16[e] = s; if ((e & 3) == 3) asm volatile("" ::: "memory"); }
        float s8[8], s4[4], s2[2], s1;
        { const bool up = (c.lane & 32) != 0;
#pragma unroll
          for (int i = 0; i < 8; ++i) { const float keep = up ? s16[8 + i] : s16[i], give = up ? s16[i] : s16[8 + i]; s8[i] = keep + shx_(give, 32); } }
        { const bool up = (c.lane & 16) != 0;
#pragma unroll
          for (int i = 0; i < 4; ++i) { const float keep = up ? s8[4 + i] : s8[i], give = up ? s8[i] : s8[4 + i]; s4[i] = keep + shx_(give, 16); } }
        { const bool up = (c.lane & 8) != 0;
#pragma unroll
          for (int i = 0; i < 2; ++i) { const float keep = up ? s4[2 + i] : s4[i], give = up ? s4[i] : s4[2 + i]; s2[i] = keep + shx_(give, 8); } }
        { const bool up = (c.lane & 4) != 0; const float keep = up ? s2[1] : s2[0], give = up ? s2[0] : s2[1]; s1 = keep + shx_(give, 4); }
        s1 += shx_(s1, 2); s1 += shx_(s1, 1);
        const int eb = c.lane & 15; const int srcl = (((eb >> 3) & 1) << 5) | (((eb >> 2) & 1) << 4) | (((eb >> 1) & 1) << 3) | ((eb & 1) << 2);
        const float sc = sigmoidf_(__shfl(s1, srcl));
        const float sel = sc + rbl;
        float m1 = sel, m2 = -1e30f;
        { const float o1 = shx_(sel, 1); const float hi = fmaxf(sel, o1), lo = fminf(sel, o1);
          const float ohi = shx_(hi, 2), olo = shx_(lo, 2);
          m1 = fmaxf(hi, ohi); m2 = fmaxf(fminf(hi, ohi), fmaxf(lo, olo)); }
        const float gs = m1 + m2;
        const float g0 = __shfl(gs, 0), g1 = __shfl(gs, 4), g2 = __shfl(gs, 8), g3 = __shfl(gs, 12);
        int bg = 0; float bgs = g0; if (g1 > bgs) { bgs = g1; bg = 1; } if (g2 > bgs) { bgs = g2; bg = 2; } if (g3 > bgs) { bgs = g3; bg = 3; }
        float s4b[4], p4b[4];
#pragma unroll
        for (int j = 0; j < 4; ++j) { s4b[j] = __shfl(sel, 4 * bg + j); p4b[j] = __shfl(sc, 4 * bg + j); }
        int i1 = 0; float v1 = s4b[0], q1 = p4b[0];
#pragma unroll
        for (int j = 1; j < 4; ++j) if (s4b[j] > v1) { v1 = s4b[j]; i1 = j; q1 = p4b[j]; }
        int i2 = -1; float v2 = -1e30f, q2 = 0.f;
#pragma unroll
        for (int j = 0; j < 4; ++j) if (j != i1 && s4b[j] > v2) { v2 = s4b[j]; i2 = j; q2 = p4b[j]; }
        if (c.lane == 0) {
            const int e0 = 4 * bg + i1, e1 = 4 * bg + i2;
            const int p0 = __hip_atomic_fetch_add(lcnt + e0, 1, __ATOMIC_RELAXED, __HIP_MEMORY_SCOPE_WORKGROUP), p1 = __hip_atomic_fetch_add(lcnt + e1, 1, __ATOMIC_RELAXED, __HIP_MEMORY_SCOPE_WORKGROUP);
            rinfo[lr * 4 + 0] = e0; rinfo[lr * 4 + 1] = p0; rinfo[lr * 4 + 2] = e1; rinfo[lr * 4 + 3] = p1;
            const float inv = 1.0f / (q1 + q2); rwt[lr * 2] = q1 * inv; rwt[lr * 2 + 1] = q2 * inv;
        }
    }
    __syncthreads();
    if (c.tid < 16) lcnt[16 + c.tid] = (int)atomicAdd(cnt + c.tid, (unsigned)lcnt[c.tid]);
    __syncthreads();
    for (int lr = c.tid; lr < bn; lr += 512) { const int row = brow0 + lr, e0 = rinfo[lr * 4], e1 = rinfo[lr * 4 + 2];
        TOK[row * 4 + 0] = e0; TOK[row * 4 + 1] = lcnt[16 + e0] + rinfo[lr * 4 + 1]; TOK[row * 4 + 2] = e1; TOK[row * 4 + 3] = lcnt[16 + e1] + rinfo[lr * 4 + 3];
        TOKW[row * 2] = rwt[lr * 2]; TOKW[row * 2 + 1] = rwt[lr * 2 + 1]; }
}
DI void slot_bases(const unsigned* cnt, int lane, int e0, int e1, int& b0, int& b1) {
    const unsigned mine = lane < 16 ? ((cnt[lane] + 255u) & ~255u) : 0u; unsigned pb = 0; b0 = 0; b1 = 0;
#pragma unroll
    for (int e = 0; e < 16; ++e) { const unsigned ce = __shfl(mine, e); if (e == e0) b0 = (int)pb; if (e == e1) b1 = (int)pb; pb += ce; }
}
DI void phase_gather(const Ctx& c, int l) {
    const unsigned* cnt = WSP(unsigned, WS_CTL) + CW_CNT + l * 16; const int* TOK = WSP(int, WS_TOK); int* TOKS = WSP(int, WS_TOK + 768 * 1024);
    const bf16* H = WSP(bf16, WS_H); bf16* HS = WSP(bf16, WS_BIG + BIG_HS);
    const unsigned minep = c.lane < 16 ? ((cnt[c.lane] + 255u) & ~255u) : 0u; unsigned pb = 0; int mybase = 0;
#pragma unroll
    for (int e = 0; e < 16; ++e) { const unsigned ce = __shfl(minep, e); if (c.lane == e) mybase = (int)pb; pb += ce; }
    const int rfirst = (l == 3 ? TC : 0) + c.gw, rstep = c.ngw;
    int e0n = 0, p0n = 0, e1n = 0, p1n = 0; u32x4 an = {0u, 0u, 0u, 0u}, bn = an;
    if (rfirst < TT) { e0n = TOK[rfirst * 4]; p0n = TOK[rfirst * 4 + 1]; e1n = TOK[rfirst * 4 + 2]; p1n = TOK[rfirst * 4 + 3];
        an = *(const u32x4*)(H + (size_t)rfirst * D + 8 * c.lane); bn = *(const u32x4*)(H + (size_t)rfirst * D + 512 + 8 * c.lane); }
    for (int row = rfirst; row < TT; row += rstep) {
        const int e0 = e0n, p0 = p0n, e1 = e1n, p1 = p1n; const u32x4 a = an, bq = bn;
        if (row + rstep < TT) { const int r = row + rstep; e0n = TOK[r * 4]; p0n = TOK[r * 4 + 1]; e1n = TOK[r * 4 + 2]; p1n = TOK[r * 4 + 3];
            an = *(const u32x4*)(H + (size_t)r * D + 8 * c.lane); bn = *(const u32x4*)(H + (size_t)r * D + 512 + 8 * c.lane); }
        const int s0 = __shfl(mybase, e0) + p0, s1 = __shfl(mybase, e1) + p1;
        *(u32x4*)(HS + (size_t)s0 * D + 8 * c.lane) = a; *(u32x4*)(HS + (size_t)s0 * D + 512 + 8 * c.lane) = bq;
        *(u32x4*)(HS + (size_t)s1 * D + 8 * c.lane) = a; *(u32x4*)(HS + (size_t)s1 * D + 512 + 8 * c.lane) = bq;
        if (c.lane == 0) { TOKS[row * 2] = s0; TOKS[row * 2 + 1] = s1; }
    }
}
DI LAS int* moe_tiles(const Ctx& c, int l, int nsh) {
    LAS int* tp = (LAS int*)(c.lds + MISC_OFF);
    LAS int* ul = tp + 192;
    __syncthreads();
    if (c.tid < 64) {
        const unsigned* cnt = WSP(unsigned, WS_CTL) + CW_CNT + l * 16;
        const int mine = c.lane < 16 ? (int)((cnt[c.lane] + 255u) >> 8) : 0; int p = 0;
        for (int e = 0; e < 16; ++e) { const int ne = __shfl(mine, e); for (int t = c.lane; t < ne; t += 64) tp[1 + p + t] = e; p += ne; }
        if (c.lane == 0) tp[0] = p;
    }
    __syncthreads();
    if (c.tid < 32) {
        const int i = c.tid, ntile = tp[0], G = gridDim.x, cb = blockIdx.x; int rt = 1 << 20, pn = 0;
        if ((G & 7) == 0 && ((G >> 3) >> nsh) > 0) { const int x = cb & 7, v = cb >> 3, rpx = (G >> 3) >> nsh;
            if (v < (rpx << nsh)) { rt = (i * 8 + x) * rpx + (v >> nsh); pn = v & ((1 << nsh) - 1); } }
        else { const int L = i * G + cb; rt = L >> nsh; pn = L & ((1 << nsh) - 1); }
        ul[i] = rt < ntile ? (rt | (pn << 12) | (tp[1 + rt] << 16)) : -1;
    }
    __syncthreads();
    return ul;
}
DI void phase_combine(const Ctx& c, int l) {
    const float* MOD = WSP(float, WS_MOD) + (size_t)l * 9 * 6144; const int* TOKS = WSP(int, WS_TOK + 768 * 1024); const float* TOKW = WSP(float, WS_TOK + 512 * 1024);
    const bf16* YS = WSP(bf16, WS_BIG + BIG_HS); bf16* X = WSP(bf16, WS_X); bf16* XC = WSP(bf16, WS_XC); bf16* H = WSP(bf16, WS_H);
    const int rlo = (l == 3 ? TC : 0), per = (TT - rlo + c.ngw - 1) / c.ngw;
    const int rfirst = rlo + c.gw * per, rend = min(rfirst + per, TT);
    int sa0 = 0, sa1 = 0, sb0 = 0, sb1 = 0; float wa0 = 0.f, wa1 = 0.f, wb0 = 0.f, wb1 = 0.f;
    u32x2 dx[4], dy0[4], dy1[4];
    f32x4 g2v[4] = {}, gnv[4], shn[4] = {}, scn[4] = {}; int mr_cur = -1;
    load_vec(l < 3 ? c.in[I_N1G] + (l + 1) * D : c.in[I_FING], gnv, c.lane);
    const float* MODn = WSP(float, WS_MOD) + (size_t)(l < 3 ? l + 1 : l) * 9 * 6144;
#define CB_XP(r_) ((r_) < TC ? XC + (size_t)(r_) * D : X + (size_t)((r_) - TC) * D)
#define CB_LOAD(r_, s0_, s1_) do { const bf16* xq = CB_XP(r_); _Pragma("unroll") for (int j = 0; j < 4; ++j) { dx[j] = *(const u32x2*)(xq + 256 * j + 4 * c.lane); \
        dy0[j] = *(const u32x2*)(YS + (size_t)(s0_) * D + 256 * j + 4 * c.lane); dy1[j] = *(const u32x2*)(YS + (size_t)(s1_) * D + 256 * j + 4 * c.lane); } } while (0)
    if (rfirst < rend) { sa0 = TOKS[rfirst * 2]; sa1 = TOKS[rfirst * 2 + 1]; wa0 = TOKW[rfirst * 2]; wa1 = TOKW[rfirst * 2 + 1]; }
    if (rfirst + 1 < rend) { const int r = rfirst + 1; sb0 = TOKS[r * 2]; sb1 = TOKS[r * 2 + 1]; wb0 = TOKW[r * 2]; wb1 = TOKW[r * 2 + 1]; }
    if (rfirst < rend) CB_LOAD(rfirst, sa0, sa1);
    for (int row = rfirst; row < rend; ++row) {
        const int mr = row < TC ? 8 : (row - TC) >> 11; bf16* xp = CB_XP(row);
        const float w0 = wa0, w1 = wa1;
        if (mr != mr_cur) { load_vec(MOD + mr * 6144 + 5120, g2v, c.lane); if (l < 3) { load_vec(MODn + mr * 6144, shn, c.lane); load_vec(MODn + mr * 6144 + 1024, scn, c.lane); } mr_cur = mr; }
        f32x4 v[4], ya[4], yb[4];
#pragma unroll
        for (int j = 0; j < 4; ++j) {
            v[j] = (f32x4){__uint_as_float(dx[j].x << 16), __uint_as_float(dx[j].x & 0xffff0000u), __uint_as_float(dx[j].y << 16), __uint_as_float(dx[j].y & 0xffff0000u)};
            ya[j] = (f32x4){__uint_as_float(dy0[j].x << 16), __uint_as_float(dy0[j].x & 0xffff0000u), __uint_as_float(dy0[j].y << 16), __uint_as_float(dy0[j].y & 0xffff0000u)};
            yb[j] = (f32x4){__uint_as_float(dy1[j].x << 16), __uint_as_float(dy1[j].x & 0xffff0000u), __uint_as_float(dy1[j].y << 16), __uint_as_float(dy1[j].y & 0xffff0000u)}; }
        sa0 = sb0; sa1 = sb1; wa0 = wb0; wa1 = wb1;
        if (row + 2 < rend) { const int r = row + 2; sb0 = TOKS[r * 2]; sb1 = TOKS[r * 2 + 1]; wb0 = TOKW[r * 2]; wb1 = TOKW[r * 2 + 1]; }
        if (row + 1 < rend) CB_LOAD(row + 1, sa0, sa1);
#pragma unroll
        for (int j = 0; j < 4; ++j) v[j] = v[j] + g2v[j] * (ya[j] * w0 + yb[j] * w1);
        if (l < 3) store_row_bf16(xp, v, c.lane);
        if (l < 3) {
            norm_mod_row_reg(v, gnv, shn, scn);
            store_row_bf16(H + (size_t)hrow_of(row, (l + 1) % 3) * D, v, c.lane);
        } else {
            float s = 0.f;
#pragma unroll
            for (int j = 0; j < 4; ++j) s += (v[j].x * v[j].x + v[j].y * v[j].y) + (v[j].z * v[j].z + v[j].w * v[j].w);
            s = wave_sum(s);
            const float r = 1.0f / sqrtf(s * (1.0f / 1024.0f) + EPS);
            float* o = c.out + (size_t)(row - TC) * D;
#pragma unroll
            for (int j = 0; j < 4; ++j) *(f32x4*)(o + 256 * j + 4 * c.lane) = v[j] * r * gnv[j];
        }
    }
#undef CB_LOAD
#undef CB_XP
}

DI void ctx_outproj_mini(const Ctx& c, const bf16* Yc, const bf16* Wt, const float* xs_c  , bf16* XC, const float* modc  , const float* bias) {
    constexpr int RS = 272, ABYTES = 64 * RS, STG = 192 * RS;
    const int lane = c.lane, h5 = lane >> 5, l31 = lane & 31;
    const int srow = c.tid >> 4, sch = c.tid & 15;
    for (int tile = blockIdx.x; tile < 256; tile += gridDim.x) {
        const int mt = 64 * (tile >> 3), nt = 128 * (tile & 7);
        const int m0 = mt + 32 * (c.wave >> 2), n0 = nt + 32 * (c.wave & 3);
        const bf16* ag = Yc + (size_t)(mt + srow) * 1024 + 8 * sch; const bf16* bg = Wt + (size_t)(nt + srow) * 1024 + 8 * sch;
        u32x4 st[6];
#define MINI_G(k0_) do { _Pragma("unroll") for (int i = 0; i < 2; ++i) st[i] = *(const u32x4*)(ag + (size_t)(32 * i) * 1024 + (k0_)); \
                         _Pragma("unroll") for (int i = 0; i < 4; ++i) st[2 + i] = *(const u32x4*)(bg + (size_t)(32 * i) * 1024 + (k0_)); } while (0)
#define MINI_W(buf_) do { LAS unsigned char* wb = c.lds + (buf_) * STG + srow * RS + sch * 16; \
                         _Pragma("unroll") for (int i = 0; i < 2; ++i) *(LAS u32x4*)(wb + 32 * i * RS) = st[i]; \
                         _Pragma("unroll") for (int i = 0; i < 4; ++i) *(LAS u32x4*)(wb + ABYTES + 32 * i * RS) = st[2 + i]; } while (0)
        MINI_G(0);
        const int row = m0 + l31;
        float xo[4][4]; f32x4 g1[4], bb[4];
#pragma unroll
        for (int q = 0; q < 4; ++q) { const int col = n0 + 8 * q + 4 * h5; const size_t o = (size_t)row * D + col;
            if (xs_c) { const f32x4 t = *(const f32x4*)(xs_c + o); xo[q][0] = t.x; xo[q][1] = t.y; xo[q][2] = t.z; xo[q][3] = t.w; }
            else { const u32x2 t = *(const u32x2*)(XC + o); xo[q][0] = __uint_as_float(t.x << 16); xo[q][1] = __uint_as_float(t.x & 0xffff0000u); xo[q][2] = __uint_as_float(t.y << 16); xo[q][3] = __uint_as_float(t.y & 0xffff0000u); }
            g1[q] = *(const f32x4*)(modc + 2048 + col); bb[q] = bias ? *(const f32x4*)(bias + col) : (f32x4){0.f, 0.f, 0.f, 0.f}; }
        __syncthreads();
        MINI_W(0);
        lds_barrier();
        f32x16 acc = zero16();
        const LAS unsigned char* ar = c.lds + (32 * (c.wave >> 2) + l31) * RS + 16 * h5;
        const LAS unsigned char* br = c.lds + ABYTES + (32 * (c.wave & 3) + l31) * RS + 16 * h5;
#pragma unroll 1
        for (int s = 0; s < 8; ++s) {
            if (s < 7) MINI_G(128 * (s + 1));
            const int bo = (s & 1) * STG;
#pragma unroll
            for (int k = 0; k < 8; ++k) { const bf16x8 af = *(const LAS bf16x8*)(ar + bo + 32 * k), wf = *(const LAS bf16x8*)(br + bo + 32 * k); acc = MFMA32(wf, af, acc); }
            if (s < 7) MINI_W((s + 1) & 1);
            lds_barrier();
        }
#undef MINI_G
#undef MINI_W
#pragma unroll
        for (int q = 0; q < 4; ++q) { const int col = n0 + 8 * q + 4 * h5; const size_t o = (size_t)row * D + col;
            u32x2 w; w.x = cvt_pk_bf16(xo[q][0] + g1[q].x * (acc[4 * q] + bb[q].x), xo[q][1] + g1[q].y * (acc[4 * q + 1] + bb[q].y));
            w.y = cvt_pk_bf16(xo[q][2] + g1[q].z * (acc[4 * q + 2] + bb[q].z), xo[q][3] + g1[q].w * (acc[4 * q + 3] + bb[q].w));
            *(u32x2*)(XC + o) = w; }
    }
}

#define XB_TMO      128
#define XB_XCNT(j)  (256  + 64 * (j))
#define XB_XSUB(j)  (1280 + 64 * (j))
#define XB_XGEN(j)  (2304 + 64 * (j))
#define XB_TOP      3328
#define XB_TOPGEN   3392
#define XCD_BAR_WORDS 3456
#define XB_SPIN_CAP (1u << 18)
DI unsigned xb_ld(unsigned* p)              { return __hip_atomic_load(p, __ATOMIC_RELAXED, __HIP_MEMORY_SCOPE_AGENT); }
DI unsigned xb_add(unsigned* p, unsigned v) { return __hip_atomic_fetch_add(p, v, __ATOMIC_RELAXED, __HIP_MEMORY_SCOPE_AGENT); }
DI unsigned xb_xcc_id() { return (unsigned)__builtin_amdgcn_s_getreg((3 << 11) | 20) & 0xFu; }
#define XB_SPIN(cond, bar) do { unsigned _sp = 0; while (cond) { __builtin_amdgcn_s_sleep(1); \
    if ((++_sp & 255u) == 0u) { if (xb_ld(&(bar)[XB_TMO])) break; if (_sp > XB_SPIN_CAP) { atomicAdd(&(bar)[XB_TMO], 1u); break; } } } } while (0)
DI void xcd_barrier_complete(unsigned* bar, unsigned x, unsigned& nloc, unsigned& nx) {
    const unsigned G = gridDim.x * gridDim.y * gridDim.z;
    unsigned sum, cnt, mine, sp = 0u;
    for (;;) {
        sum = 0u; cnt = 0u; mine = 0u;
#pragma unroll
        for (unsigned j = 0; j < 16; ++j) { const unsigned cj = xb_ld(&bar[XB_XCNT(j)]); sum += cj; cnt += (cj > 0u) ? 1u : 0u; mine = (j == x) ? cj : mine; }
        if (sum == G) break;
        __builtin_amdgcn_s_sleep(1);
        if ((++sp & 255u) == 0u) { if (xb_ld(&bar[XB_TMO])) break; if (sp > XB_SPIN_CAP) { atomicAdd(&bar[XB_TMO], 1u); break; } }
    }
    nloc = mine > 0u ? mine : 1u; nx = cnt > 0u ? cnt : 1u;
}
DI void xcd_barrier(unsigned* bar, volatile LAS unsigned* st) {
    asm volatile("s_waitcnt vmcnt(0)" ::: "memory");
    __syncthreads();
    if (threadIdx.x == 0) {
        const unsigned x = xb_xcc_id();
        __builtin_amdgcn_s_waitcnt(0);
        unsigned nloc = st[0], nx = st[1];
        if (nloc == 0u) { xcd_barrier_complete(bar, x, nloc, nx); st[0] = nloc; st[1] = nx; }
        const unsigned old = xb_add(&bar[XB_XSUB(x)], 1u);
        const unsigned gen = old / nloc;
        if (old + 1u == (gen + 1u) * nloc) {
            __builtin_amdgcn_fence(__ATOMIC_RELEASE, "agent");
            asm volatile("s_waitcnt vmcnt(0)" ::: "memory");
            const unsigned og = xb_add(&bar[XB_TOP], 1u);
            const unsigned tg = og / nx;
            if (og + 1u == (tg + 1u) * nx) xb_add(&bar[XB_TOPGEN], 1u);
            else XB_SPIN(xb_ld(&bar[XB_TOPGEN]) == tg, bar);
            __builtin_amdgcn_fence(__ATOMIC_ACQUIRE, "agent");
            xb_add(&bar[XB_XGEN(x)], 1u);
            asm volatile("s_waitcnt vmcnt(0)" ::: "memory");
        } else {
            XB_SPIN(xb_ld(&bar[XB_XGEN(x)]) == gen, bar);
            __builtin_amdgcn_fence(__ATOMIC_ACQUIRE, "agent");
            asm volatile("s_waitcnt vmcnt(0)" ::: "memory");
        }
    }
    __syncthreads();
}

constexpr int NPHASE = 2 + 11 * DEPTH;
__host__ __device__ inline bool phase_active(int ph) {
    if (ph < 2) return true;
    const int l = (ph - 2) / 11, s = (ph - 2) % 11, kind = l % 3;
    if (s == 0) return false;
    if (s == 4) return kind != 2 || HY_MFMA;
    return true;
}
DI void run_phase(const Ctx& c, int ph) {
    if (ph == 0) { if constexpr (PH_EN(0)) phase_pro0(c); return; }
    if (ph == 1) { if constexpr (PH_EN(1)) { phase_pro1(c); phase_norm1(c, 0, c.in[I_X], c.in[I_CTX]); } return; }
    const int l = (ph - 2) / 11, s = (ph - 2) % 11, kind = l % 3, j = l / 3;
    switch (s) {
    case 0: if constexpr (PH_EN(2)) phase_norm1(c, 0, c.in[I_X], c.in[I_CTX]); break;
    case 1: if constexpr (PH_EN(3)) {
        DenseOrder S; EpiInproj E; E.P = WSP(bf16, WS_P); E.extra = WSP(float, WS_EXTRA); E.bias = nullptr; E.bias_x = nullptr;
        S.A = WSP(bf16, WS_H); S.ul = dense_units(c.lds, c.tid, TT, kind == 2 ? 3072 : NINP);
        if (kind == 0) { S.Bt = WSP(bf16, WS_ML_WIN) + (size_t)j * NINP * 1024; E.bias_x = c.in[I_MLBG] + j * 32; }
        else if (kind == 1) { S.Bt = WSP(bf16, WS_GLA_WIN); }
        else { S.Bt = WSP(bf16, WS_HY_WIN); E.bias = c.in[I_HYBIN]; }
        gemm_run(c.lds, c.tid, S, E);
    } break;
    case 2: if constexpr (PH_EN(4))
        if (kind == 0) phase_conv(c, 1024, c.in[I_MLCW] + j * 3 * 1024, c.in[I_MLCB] + j * 1024, true, 0.125f);
        else if (kind == 1) { phase_conv(c, 2048, c.in[I_GLCW], c.in[I_GLCB], true, 0.08838834764831845f); if constexpr (GLA_CHUNK) phase_gla_decay(c); }
        else { if constexpr (HY_MFMA) phase_hy_prep(c); else phase_conv(c, 3072, c.in[I_HYCW], c.in[I_HYCB], false, 1.0f); }
        break;
    case 3: if constexpr (PH_EN(5))
        if (kind == 0) { if constexpr (MLSTM_CHUNK) phase_mlstm_state(c); else phase_mlstm_scan_naive(c); }
        else if (kind == 1) { if constexpr (GLA_CHUNK) phase_gla_state(c); else phase_gla_scan_naive(c); }
        else { if constexpr (HY_MFMA) phase_hy_toeplitz(c); else phase_hyena_conv_naive(c); }
        break;
    case 4: if constexpr (PH_EN(6))
        if (kind == 0) { if constexpr (MLSTM_CHUNK) phase_mlstm_out(c, c.in[I_MLNG] + j * 1024); else phase_headnorm(c, 128, c.in[I_MLNG] + j * 1024); }
        else if (kind == 1) { if constexpr (GLA_CHUNK) phase_gla_out(c, c.in[I_GLNG]); else phase_headnorm(c, 256, c.in[I_GLNG]); }
        else { if constexpr (HY_MFMA) phase_hy_post(c); }
        break;
    case 5: if constexpr (PH_EN(7)) {
        DenseOrder S; EpiOutproj E; E.X = WSP(bf16, WS_X); E.XC = WSP(bf16, WS_XC); E.mod = WSP(float, WS_MOD) + (size_t)l * 9 * 6144; E.bias = nullptr; E.perm = (kind == 1);
        E.xs_l = (l == 0) ? c.in[I_X] : nullptr; E.xs_c = (l == 0) ? c.in[I_CTX] : nullptr; E.row_off = TC;
        const bf16* W = kind == 0 ? WSP(bf16, WS_ML_WOUT) + (size_t)j * 1024 * 1024 : kind == 1 ? WSP(bf16, WS_GLA_WOUT) : WSP(bf16, WS_HY_WOUT);
        if (kind == 2) E.bias = c.in[I_HYBOUT];
        S.A = WSP(bf16, WS_Y) + (size_t)E.row_off * D; S.Bt = W; S.ul = dense_units(c.lds, c.tid, TT - E.row_off, 1024);
        gemm_run(c.lds, c.tid, S, E);
        if (l < 3) ctx_outproj_mini(c, WSP(bf16, WS_Y), W, E.xs_c, WSP(bf16, WS_XC), E.mod + 8 * 6144, E.bias);
    } break;
    case 6: if constexpr (PH_EN(8)) phase_route(c, l); break;
    case 7: if constexpr (PH_EN(9)) phase_gather(c, l); break;
    case 8: if constexpr (PH_EN(10)) {
        MoeOrder S; S.ul = moe_tiles(c, l, 3); S.A = WSP(bf16, WS_BIG + BIG_HS); S.Bt = WSP(bf16, WS_EXP_UP) + (size_t)l * 16 * 2048 * 1024; S.bstride = (size_t)2048 * 1024;
        EpiUp E; E.ACT = WSP(bf16, WS_BIG + BIG_ACT);
        gemm_run(c.lds, c.tid, S, E);
    } break;
    case 9: if constexpr (PH_EN(11)) {
        MoeOrder S; S.ul = moe_tiles(c, l, 2); S.A = WSP(bf16, WS_BIG + BIG_ACT); S.Bt = WSP(bf16, WS_EXP_DN) + (size_t)l * 16 * 1024 * 1024; S.bstride = (size_t)1024 * 1024;
        EpiDown E; E.YS = WSP(bf16, WS_BIG + BIG_HS);
        gemm_run(c.lds, c.tid, S, E);
    } break;
    case 10: if constexpr (PH_EN(12)) phase_combine(c, l); break;
    }
}

__global__ void __launch_bounds__(512, 2) mega_fwd(Params p) {
    extern __shared__ __attribute__((aligned(16))) unsigned char lds_raw[];
#if XCD_BARRIER
    {
        volatile LAS unsigned* st0 = (volatile LAS unsigned*)((LAS unsigned char*)lds_raw + BAR_LDS_OFF);
        if (threadIdx.x == 0) { st0[0] = 0u; st0[1] = 0u; (void)xb_add((unsigned*)(p.ws + WS_CTL) + CW_BAR + XB_XCNT(xb_xcc_id()), 1u); }
        __syncthreads();
    }
#endif
    bool first = true;
    int rep = 0;
    unsigned long long tp_acc = 0, tp_prev = 0; bool tp_sel = false;
    for (int ph = p.ph_lo; ph < p.ph_hi;) {
        if (!phase_active(ph)) { ++ph; continue; }
        int z; asm volatile("s_mov_b32 %0, 0" : "=s"(z));
        if (!first) {
#if XCD_BARRIER
            xcd_barrier((unsigned*)(p.ws + z + WS_CTL) + CW_BAR, (volatile LAS unsigned*)((LAS unsigned char*)lds_raw + BAR_LDS_OFF));
#else
            cg::this_grid().sync();
#endif
        }
        first = false;
        Ctx c;
        c.lds = (LAS unsigned char*)lds_raw;
        c.tid = threadIdx.x + z; c.lane = c.tid & 63; c.wave = __builtin_amdgcn_readfirstlane(c.tid >> 6);
        c.gw = blockIdx.x * 8 + c.wave; c.ngw = gridDim.x * 8;
        c.in = (const float* const __attribute__((address_space(4)))*)__builtin_amdgcn_kernarg_segment_ptr() + z; c.out = p.out + z; c.ws = p.ws + z; c.z = (unsigned)z;
        if (TP_MASK != 0u) {
            const unsigned long long now = __builtin_amdgcn_s_memrealtime();
            if (tp_sel) tp_acc += now - tp_prev;
            tp_prev = now; tp_sel = (ph >= 2 ? (((TP_MASK >> ((ph - 2) % 11)) & 1u) && ((TP_LAYERS >> ((ph - 2) / 11)) & 1u)) : ((TP_MASK >> (16 + ph)) & 1u));
        }
        run_phase(c, ph);
        if (REP_MASK != 0u && rep == 0 && (ph >= 2 ? (((REP_MASK >> ((ph - 2) % 11)) & 1u) && ((REP_LAYERS >> ((ph - 2) / 11)) & 1u)) : ((REP_MASK >> (16 + ph)) & 1u))) rep = 1; else { rep = 0; ++ph; }
    }
    if (TP_MASK != 0u && blockIdx.x == 0) { asm volatile("s_waitcnt vmcnt(0)" ::: "memory"); __syncthreads(); const unsigned long long now = __builtin_amdgcn_s_memrealtime(); if (tp_sel) tp_acc += now - tp_prev;
        const unsigned long long t_end = now + (unsigned long long)TP_AMP * tp_acc; while (__builtin_amdgcn_s_memrealtime() < t_end) __builtin_amdgcn_s_sleep(8); }
}

extern "C" void kernel_launch(void* const* d_in, const int* in_sizes, int n_in, void* d_out, int out_size, void* d_ws, size_t ws_size, hipStream_t stream) {
    static int grid = 0;
    if (grid == 0) {
        if (n_in != 40 || ws_size < WS_END || out_size != TL * D) { fprintf(stderr, "kernel_launch: unexpected shapes (n_in %d, ws %zu, out %d)\n", n_in, ws_size, out_size); grid = -1; return; }
        int dev = 0, cus = 0, per_cu = 0;
        hipGetDevice(&dev); hipDeviceGetAttribute(&cus, hipDeviceAttributeMultiprocessorCount, dev);
        if (hipFuncSetAttribute((const void*)mega_fwd, hipFuncAttributeMaxDynamicSharedMemorySize, LDS_BYTES) != hipSuccess) { fprintf(stderr, "kernel_launch: hipFuncSetAttribute failed\n"); grid = -1; return; }
        if (hipOccupancyMaxActiveBlocksPerMultiprocessor(&per_cu, (const void*)mega_fwd, 512, LDS_BYTES) != hipSuccess || per_cu < 1) { fprintf(stderr, "kernel_launch: occupancy query says %d\n", per_cu); per_cu = 1; }
        (void)hipGetLastError();
        grid = cus;
        fprintf(stderr, "kernel_launch: grid %d (cus %d, per_cu %d)\n", grid, cus, per_cu);
    }
    if (grid < 0) return;
    hipMemsetAsync((char*)d_ws + WS_CTL, 0, 1 * MiB, stream);
    Params p{};
    for (int i = 0; i < 40; ++i) p.in[i] = (const float*)d_in[i];
    p.out = (float*)d_out; p.ws = (unsigned char*)d_ws;
#if N_LAUNCH_PER_PHASE
    for (int ph = 0; ph < NPHASE; ++ph) {
        if (!phase_active(ph)) continue;
        p.ph_lo = ph; p.ph_hi = ph + 1; void* args[] = {&p};
        hipError_t e = hipLaunchCooperativeKernel((const void*)mega_fwd, dim3(grid), dim3(512), args, LDS_BYTES, stream);
        if (e != hipSuccess) { fprintf(stderr, "launch failed: %s\n", hipGetErrorString(e)); break; }
    }
#else
    p.ph_lo = 0; p.ph_hi = NPHASE; void* args[] = {&p};
    hipError_t e = hipLaunchCooperativeKernel((const void*)mega_fwd, dim3(grid), dim3(512), args, LDS_BYTES, stream);
    if (e != hipSuccess) fprintf(stderr, "cooperative launch failed: %s (grid %d)\n", hipGetErrorString(e), grid);
#endif
}
```

```cpp
#include <hip/hip_runtime.h>
#include <hip/hip_cooperative_groups.h>
#include <cstdio>
#include <cstdint>
namespace cg = cooperative_groups;

#define LAS __attribute__((address_space(3)))
#define DI __device__ __forceinline__
typedef unsigned short bf16;
typedef float f32x4 __attribute__((ext_vector_type(4)));
typedef float f32x2 __attribute__((ext_vector_type(2)));
typedef unsigned u32x4 __attribute__((ext_vector_type(4)));
typedef unsigned u32x2 __attribute__((ext_vector_type(2)));
typedef short bf16x8 __attribute__((ext_vector_type(8)));

#ifndef FAST_GEMM
#define FAST_GEMM 1
#endif
#ifndef MLSTM_CHUNK
#define MLSTM_CHUNK 1
#endif
#ifndef GLA_CHUNK
#define GLA_CHUNK 1
#endif
#ifndef HY_MFMA
#define HY_MFMA 1
#endif
#ifndef XCD_BARRIER
#define XCD_BARRIER 1
#endif
#ifndef PH_MASK
#define PH_MASK 0xFFFFFFFFu
#endif
#define PH_EN(b) ((PH_MASK >> (b)) & 1u)
#ifndef TP_MASK
#define TP_MASK 0u
#endif
#ifndef TP_LAYERS
#define TP_LAYERS 0xFu
#endif
#define TP_AMP 4
#ifndef REP_LAYERS
#define REP_LAYERS 0xFu
#endif
#ifndef REP_MASK
#define REP_MASK 0u
#endif
#ifndef N_LAUNCH_PER_PHASE
#define N_LAUNCH_PER_PHASE 0
#endif

constexpr int D = 1024, NB = 8, SEQ = 2048, CTX = 256, DEPTH = 4;
constexpr int TC = NB * CTX, TL = NB * SEQ, TT = TC + TL;
constexpr int NEXP = 16;
constexpr int PLD = 3072;
constexpr int NINP = 3328;
constexpr float EPS = 1e-6f;
constexpr int MAXSLOT = 40960;

constexpr size_t MiB = 1u << 20;
constexpr size_t WS_CTL = 0;
constexpr size_t WS_MOD = 1 * MiB;
constexpr size_t WS_HM = 2 * MiB;
constexpr size_t WS_TOK = 3 * MiB;
constexpr size_t WS_RWT = 3 * MiB + 944 * 1024;
constexpr size_t WS_HF = 4 * MiB;
constexpr size_t WS_HFC = 20 * MiB;
constexpr size_t WS_ML_WIN = 32 * MiB;
constexpr size_t WS_ML_WOUT = 45 * MiB;
constexpr size_t WS_GLA_WIN = 49 * MiB;
constexpr size_t WS_GLA_WOUT = 56 * MiB;
constexpr size_t WS_HY_WIN = 58 * MiB;
constexpr size_t WS_HY_WOUT = 64 * MiB;
constexpr size_t WS_EXP_UP = 66 * MiB;
constexpr size_t WS_EXP_DN = 322 * MiB;
constexpr size_t WS_X = 450 * MiB;
constexpr size_t WS_XC = 514 * MiB;
constexpr size_t WS_H = 522 * MiB;
constexpr size_t WS_P = 558 * MiB;
constexpr size_t WS_EXTRA = 667 * MiB;
constexpr size_t WS_Y = 670 * MiB;
constexpr size_t WS_BIG = 706 * MiB;
constexpr size_t WS_END = 1024 * MiB;
constexpr size_t BIG_HS = 0;
constexpr size_t BIG_ACT = 80 * MiB;
constexpr size_t BIG_PC = 0;
constexpr size_t BIG_YF = 108 * MiB;
constexpr size_t BIG_YB = 180 * MiB;

constexpr size_t BIG_MCT = 108 * MiB;
constexpr size_t BIG_MN = 180 * MiB;

constexpr size_t BIG_GB = 72 * MiB;
constexpr size_t BIG_GST = 144 * MiB;

constexpr size_t BIG_ZTL = 108 * MiB;
constexpr size_t BIG_ZTC = 140 * MiB;
constexpr size_t BIG_YTL = 144 * MiB;
constexpr size_t BIG_YTC = 176 * MiB;

constexpr int CW_CNT = 1024;
constexpr int CW_BAR = 4096;

constexpr int LDS_BYTES = 148480;
constexpr int BAR_LDS_OFF = 147456;
constexpr int MISC_OFF = 131072;

struct Params {
    const float* in[40];
    float* out;
    unsigned char* ws;
    int ph_lo, ph_hi;
};
static_assert(__builtin_offsetof(Params, in) == 0, "the input pointer table must be the first kernel argument bytes");
enum { I_X = 0, I_C, I_CTX, I_CCTX, I_ADAW, I_ADAB, I_N1G, I_N2G, I_FING, I_MLWIN, I_MLBG, I_MLCW, I_MLCB, I_MLNG, I_MLWOUT,
       I_GLWIN, I_GLCW, I_GLCB, I_GLW2, I_GLGB, I_GLNG, I_GLWOUT, I_HYWIN, I_HYBIN, I_HYCW, I_HYCB, I_HYFW1, I_HYFB1, I_HYFWM, I_HYFBM,
       I_HYFWO, I_HYFREQ, I_HYSKIP, I_HYWOUT, I_HYBOUT, I_RW, I_RB, I_EW1, I_EW3, I_EW2 };

DI float bf2f(bf16 v) { return __uint_as_float(((unsigned)v) << 16); }
typedef __bf16 b16x2_t __attribute__((ext_vector_type(2)));
DI unsigned cvt_pk_bf16(float lo, float hi) { const f32x2 v = {lo, hi}; const b16x2_t r = __builtin_convertvector(v, b16x2_t); return __builtin_bit_cast(unsigned, r); }
DI bf16 f2bf(float f) { return (bf16)(cvt_pk_bf16(f, 0.f) & 0xffffu); }
DI float sigmoidf_(float x) { return 1.0f / (1.0f + __expf(-x)); }
DI float siluf_(float x) { return x / (1.0f + __expf(-x)); }
DI float logsigf_(float x) { return fminf(x, 0.f) - __logf(1.0f + __expf(-fabsf(x))); }
DI void lds_barrier() { asm volatile("s_waitcnt lgkmcnt(0)" ::: "memory"); __builtin_amdgcn_s_barrier(); asm volatile("" ::: "memory"); }
DI float shx_(float v, int m) {
    const int x = __float_as_int(v); int r;
    switch (m) {
    case 1:  r = __builtin_amdgcn_update_dpp(0, x, 0xB1, 0xf, 0xf, true); break;
    case 2:  r = __builtin_amdgcn_update_dpp(0, x, 0x4E, 0xf, 0xf, true); break;
    case 4:  r = __builtin_amdgcn_ds_swizzle(x, 0x101F); break;
    case 8:  r = __builtin_amdgcn_update_dpp(0, x, 0x128, 0xf, 0xf, true); break;
    case 16: r = __builtin_amdgcn_ds_swizzle(x, 0x401F); break;
    default: { int idx = ((int)__builtin_amdgcn_mbcnt_hi(~0u, __builtin_amdgcn_mbcnt_lo(~0u, 0u)) ^ 32) << 2; asm volatile("" : "+v"(idx)); r = __builtin_amdgcn_ds_bpermute(idx, x); } break;
    }
    return __int_as_float(r);
}
DI float wave_sum(float v) {
#pragma unroll
    for (int o = 1; o < 64; o <<= 1) v += shx_(v, o);
    return v;
}
DI void unpack8(const u32x4 w, float (&v)[8]) {
    v[0] = __uint_as_float(w.x << 16); v[1] = __uint_as_float(w.x & 0xffff0000u);
    v[2] = __uint_as_float(w.y << 16); v[3] = __uint_as_float(w.y & 0xffff0000u);
    v[4] = __uint_as_float(w.z << 16); v[5] = __uint_as_float(w.z & 0xffff0000u);
    v[6] = __uint_as_float(w.w << 16); v[7] = __uint_as_float(w.w & 0xffff0000u);
}
DI u32x4 pack8(const float (&v)[8]) { u32x4 w; w.x = cvt_pk_bf16(v[0], v[1]); w.y = cvt_pk_bf16(v[2], v[3]); w.z = cvt_pk_bf16(v[4], v[5]); w.w = cvt_pk_bf16(v[6], v[7]); return w; }
DI void seq_bounds(int row, int& lo, int& hi) {
    if (row < TC) { lo = row & ~(CTX - 1); hi = lo + CTX - 1; } else { lo = TC + ((row - TC) & ~(SEQ - 1)); hi = lo + SEQ - 1; }
}
DI int perm_fwd(int s) { return (s & 63) * 32 + (s >> 6); }
DI int perm_inv(int sp) { return (sp & 31) * 64 + (sp >> 5); }

namespace pg8 {
constexpr int BM = 256, BK = 64, HALF = 128, HTB = HALF * BK * 2, STAGE_BYTES = 8 * HTB, NXCD = 8, WGM = 8;
__host__ __device__ __forceinline__ int lds_byte(int r, int c) { const int st = (r >> 4) * 2 + (c >> 5), rr = r & 15, cc = c & 31, ob = rr * 64 + cc * 2; return st * 1024 + (ob ^ (((ob >> 9) & 1) << 5)); }
__host__ __device__ __forceinline__ void stage_rc(int b, int& R, int& C) { const int st = b / 1024, sb = b % 1024, swz = sb ^ (((sb >> 9) & 1) << 5); R = (st >> 1) * 16 + swz / 64; C = (st & 1) * 32 + (swz % 64) / 2; }
__host__ __device__ __forceinline__ int perm32(int rho) { const int n = rho >> 4, i = rho & 15; return 8 * (i >> 2) + 4 * n + (i & 3); }
}
struct Unit { int pm, pn, e; };

DI LAS int* dense_units(LAS unsigned char* lds, int tid, int M, int N) {
    LAS int* ul = (LAS int*)(lds + MISC_OFF) + 192;
    __syncthreads();
    if (tid < 32) {
        const int nM = M / 256, nN = N / 256, nwg = nM * nN, G = gridDim.x, L = tid * G + (int)blockIdx.x; int w = -1;
        if (L < nwg) {
            int wgid = L; { const int q = nwg / 8, r = nwg % 8, xcd = wgid % 8, off = wgid / 8; wgid = (xcd < r ? xcd * (q + 1) : r * (q + 1) + (xcd - r) * q) + off; }
            const int nig = 8 * nN, gid = wgid / nig, fm = gid * 8, gsz = (nM - fm) < 8 ? (nM - fm) : 8;
            w = (fm + ((wgid % nig) % gsz)) | (((wgid % nig) / gsz) << 12);
        }
        ul[tid] = w;
    }
    __syncthreads();
    return ul;
}
struct DenseOrder {
    const bf16* A; const bf16* Bt; const LAS int* ul;
    DI bool next(int i, Unit& u) const {
        const int w = __builtin_amdgcn_readfirstlane(ul[i]); if (w < 0) return false;
        u.pm = w & 0xfff; u.pn = (w >> 12) & 0xf; u.e = 0; return true;
    }
    DI const bf16* aptr(const Unit& u) const { return A + (size_t)u.pm * 256 * 1024; }
    DI const bf16* bptr(const Unit& u) const { return Bt + (size_t)u.pn * 256 * 1024; }
};
struct MoeOrder {
    const bf16* A; const bf16* Bt; size_t bstride; const LAS int* ul;
    DI bool next(int i, Unit& u) const {
        const int w = __builtin_amdgcn_readfirstlane(ul[i]); if (w < 0) return false;
        u.pm = w & 0xfff; u.pn = (w >> 12) & 0xf; u.e = w >> 16; return true;
    }
    DI const bf16* aptr(const Unit& u) const { return A + (size_t)u.pm * 256 * 1024; }
    DI const bf16* bptr(const Unit& u) const { return Bt + (size_t)u.e * bstride + (size_t)u.pn * 256 * 1024; }
};

struct EpiInproj {
    static constexpr bool PAIR = false, BATCHED = false;
    bf16* P; float* extra; const float* bias; const float* bias_x;
    DI void row8(const Unit& u, int r, int c, const float (&v)[8]) const {
        const int row = u.pm * 256 + r, col = u.pn * 256 + c;
        if (col < PLD) {
            float w[8];
#pragma unroll
            for (int j = 0; j < 8; ++j) w[j] = v[j] + (bias ? bias[col + j] : 0.f);
            *(u32x4*)(P + (size_t)row * PLD + col) = pack8(w);
        } else if (col < PLD + 32) {
            float* o = extra + (size_t)row * 32 + (col - PLD);
#pragma unroll
            for (int j = 0; j < 8; ++j) o[j] = v[j] + (bias_x ? bias_x[col - PLD + j] : 0.f);
        }
    }
};
struct EpiOutproj {
    static constexpr bool PAIR = false, BATCHED = true;
    const float* xs_l; const float* xs_c; bf16* X; bf16* XC; const float* mod; const float* bias; int row_off; int perm;
    DI size_t off(const Unit& u, int r, int col) const {
        const int rr = u.pm * 256 + r + row_off - TC, b = rr >> 11, sp = rr & (SEQ - 1), s = perm ? perm_inv(sp) : sp; return ((size_t)b * SEQ + s) * D + col; }
    DI void tile(const f32x4 (&acc)[2][2][4][2], const Unit& u, int wr, int wc, int fr, int fq) const {
        const int b = (u.pm * 256 + row_off - TC) >> 11; const float* g1p = mod + b * 6144 + 2048;
        const int rr0 = u.pm * 256 + row_off - TC, sp0 = rr0 & (SEQ - 1);
        const int d_ai = perm ? 4 : 128, d_m1 = perm ? 1024 : 16, d_m2 = perm ? 1 : 32;
        const unsigned voff = (unsigned)((perm ? fr * 64 + wr * 2 : wr * 64 + fr) * D + wc * 32 + 8 * fq);
        const size_t ubase = ((size_t)b * SEQ + (perm ? (sp0 >> 5) : sp0)) * D + u.pn * 256;
#define OPJ_OFF(bj_, ai_, m_) ((size_t)((ai_) * d_ai + ((m_) & 1) * d_m1 + ((m_) >> 1) * d_m2) * D + (bj_) * 128)
#pragma unroll
        for (int bj = 0; bj < 2; ++bj) {
            char* Xu = (char*)(X + ubase); float g1[8], bs[8];
            if (xs_l) {
                const char* Su = (const char*)(xs_l + ubase); f32x4 rf[2][4][2];
#pragma unroll
                for (int ai = 0; ai < 2; ++ai)
#pragma unroll
                    for (int m = 0; m < 4; ++m) { const char* p = Su + OPJ_OFF(bj, ai, m) * 4 + voff * 4u; rf[ai][m][0] = *(const f32x4*)p; rf[ai][m][1] = *(const f32x4*)(p + 16); }
                { const int col = u.pn * 256 + bj * 128 + wc * 32 + 8 * fq;
#pragma unroll
                    for (int j = 0; j < 8; ++j) { g1[j] = g1p[col + j]; bs[j] = bias ? bias[col + j] : 0.f; } }
#pragma unroll
                for (int ai = 0; ai < 2; ++ai)
#pragma unroll
                    for (int m = 0; m < 4; ++m) { float w[8];
#pragma unroll
                        for (int j = 0; j < 8; ++j) w[j] = rf[ai][m][j >> 2][j & 3] + g1[j] * (acc[ai][bj][m][j >> 2][j & 3] + bs[j]);
                        *(u32x4*)(Xu + OPJ_OFF(bj, ai, m) * 2 + voff * 2u) = pack8(w); }
            } else {
                u32x4 raw[2][4];
#pragma unroll
                for (int ai = 0; ai < 2; ++ai)
#pragma unroll
                    for (int m = 0; m < 4; ++m) raw[ai][m] = *(const u32x4*)(Xu + OPJ_OFF(bj, ai, m) * 2 + voff * 2u);
                { const int col = u.pn * 256 + bj * 128 + wc * 32 + 8 * fq;
#pragma unroll
                    for (int j = 0; j < 8; ++j) { g1[j] = g1p[col + j]; bs[j] = bias ? bias[col + j] : 0.f; } }
#pragma unroll
                for (int ai = 0; ai < 2; ++ai)
#pragma unroll
                    for (int m = 0; m < 4; ++m) { float xo[8], w[8];
                        unpack8(raw[ai][m], xo);
#pragma unroll
                        for (int j = 0; j < 8; ++j) w[j] = xo[j] + g1[j] * (acc[ai][bj][m][j >> 2][j & 3] + bs[j]);
                        *(u32x4*)(Xu + OPJ_OFF(bj, ai, m) * 2 + voff * 2u) = pack8(w); }
            }
            asm volatile("" ::: "memory");
        }
#undef OPJ_OFF
    }
    DI void row8(const Unit& u, int r, int c, const float (&v)[8]) const {
        const int col = u.pn * 256 + c; const size_t o = off(u, r, col); const int b = (u.pm * 256 + row_off - TC) >> 11;
        float a[8];
        if (xs_l) { const f32x4 a0 = *(const f32x4*)(xs_l + o), a1 = *(const f32x4*)(xs_l + o + 4); a[0] = a0.x; a[1] = a0.y; a[2] = a0.z; a[3] = a0.w; a[4] = a1.x; a[5] = a1.y; a[6] = a1.z; a[7] = a1.w; }
        else unpack8(*(const u32x4*)(X + o), a);
        const float* g1 = mod + b * 6144 + 2048 + col; float w[8];
#pragma unroll
        for (int j = 0; j < 8; ++j) w[j] = a[j] + g1[j] * (v[j] + (bias ? bias[col + j] : 0.f));
        *(u32x4*)(X + o) = pack8(w);
    }
};
struct EpiUp {
    static constexpr bool PAIR = true, BATCHED = false;
    bf16* ACT;
    DI void row8p(const Unit& u, int r, int c, const float (&g)[8], const float (&up)[8]) const {
        float w[8];
#pragma unroll
        for (int j = 0; j < 8; ++j) w[j] = siluf_(g[j]) * up[j];
        *(u32x4*)(ACT + ((size_t)u.pm * 256 + r) * 1024 + u.pn * 128 + c) = pack8(w);
    }
};
struct EpiDown {
    static constexpr bool PAIR = false, BATCHED = false;
    bf16* YS;
    DI void row8(const Unit& u, int r, int c, const float (&v)[8]) const { *(u32x4*)(YS + ((size_t)u.pm * 256 + r) * 1024 + u.pn * 256 + c) = pack8(v); }
};

template <class Sched, class Epi>
DI void gemm_fast(LAS unsigned char* lds, int tid, const Sched& S, const Epi& E) {
    using namespace pg8;
    constexpr int K = 1024, nt = K / BK;
    const int wid = __builtin_amdgcn_readfirstlane(tid >> 6), lane = tid & 63, wr = wid >> 2, wc = wid & 3, fr = lane & 15, fq = lane >> 4;
    unsigned voffA[2], voffB[2];
#pragma unroll
    for (int i = 0; i < 2; ++i) { int R, C; stage_rc(tid * 16 + i * 8192, R, C); const int Rb = (R & ~31) + perm32(R & 31);
        voffA[i] = (unsigned)(R * K + C) * 2u; voffB[i] = (unsigned)(Rb * K + C) * 2u; }
    const size_t kstep = (size_t)(BK * 2);
    const size_t hstep = (size_t)HALF * K * 2;
    const unsigned ldsw = (unsigned)wid * 1024u;
    const int aoff = lds_byte(wr * 64 + fr, fq * 8), boff = lds_byte(wc * 32 + fr, fq * 8);
#define PG8_SA(b, h) (((b) * 2 + (h)) * HTB)
#define PG8_SB(b, h) ((4 + (b) * 2 + (h)) * HTB)
#define PG8_STAGE(bufoff, gbase, voff) do { _Pragma("unroll") for (int _i = 0; _i < 2; ++_i) \
        __builtin_amdgcn_global_load_lds((const unsigned*)((const char*)(gbase) + (voff)[_i]), (LAS unsigned*)(lds + (bufoff) + ldsw + _i * 8192), 16, 0, 0); } while (0)
#define PG8_LDA(dst, b, h) do { _Pragma("unroll") for (int m = 0; m < 4; ++m) _Pragma("unroll") for (int k = 0; k < 2; ++k) dst[m][k] = *(const LAS bf16x8*)(lds + PG8_SA(b, h) + aoff + m * 2048 + k * 1024); } while (0)
#define PG8_LDB(dst, b, h) do { _Pragma("unroll") for (int n = 0; n < 2; ++n) _Pragma("unroll") for (int k = 0; k < 2; ++k) dst[n][k] = *(const LAS bf16x8*)(lds + PG8_SB(b, h) + boff + n * 2048 + k * 1024); } while (0)
#define PG8_MMA(ai, bj, At, Bt) do { __builtin_amdgcn_s_setprio(1); _Pragma("unroll") for (int m = 0; m < 4; ++m) _Pragma("unroll") for (int n = 0; n < 2; ++n) _Pragma("unroll") for (int k = 0; k < 2; ++k) \
        acc[ai][bj][m][n] = __builtin_amdgcn_mfma_f32_16x16x32_bf16(Bt[n][k], At[m][k], acc[ai][bj][m][n], 0, 0, 0); __builtin_amdgcn_s_setprio(0); } while (0)
#define PG8_WAIT_V(n) asm volatile("s_waitcnt vmcnt(" #n ")" ::: "memory")
#define PG8_WAIT_L(n) asm volatile("s_waitcnt lgkmcnt(" #n ")" ::: "memory")
#define PG8_BAR __builtin_amdgcn_s_barrier()
#define PG8_SCHED __builtin_amdgcn_sched_barrier(0)
    Unit cur, nxt; int ui = 0;
    if (!S.next(0, cur)) return;
    f32x4 acc[2][2][4][2];
#pragma unroll
    for (int a = 0; a < 2; ++a)
#pragma unroll
        for (int b = 0; b < 2; ++b)
#pragma unroll
            for (int m = 0; m < 4; ++m)
#pragma unroll
                for (int n = 0; n < 2; ++n) acc[a][b][m][n] = (f32x4){0.f, 0.f, 0.f, 0.f};
    bf16x8 At[4][2], B0[2][2], B1[2][2];
    const char* cA = (const char*)S.aptr(cur); const char* cB = (const char*)S.bptr(cur);
    PG8_STAGE(PG8_SB(0, 0), cB, voffB); PG8_STAGE(PG8_SA(0, 0), cA, voffA); PG8_STAGE(PG8_SB(0, 1), cB + hstep, voffB); PG8_STAGE(PG8_SA(0, 1), cA + hstep, voffA);
    if (wr == 1) PG8_BAR;
    PG8_WAIT_V(4); PG8_BAR;
    PG8_STAGE(PG8_SB(1, 0), cB + kstep, voffB); PG8_STAGE(PG8_SA(1, 0), cA + kstep, voffA); PG8_STAGE(PG8_SB(1, 1), cB + hstep + kstep, voffB);
    PG8_WAIT_V(6); PG8_BAR;
    for (;;) {
        const bool has_next = S.next(ui + 1, nxt);
        const char* nA = has_next ? (const char*)S.aptr(nxt) : cA; const char* nB = has_next ? (const char*)S.bptr(nxt) : cB;
        for (int t = 0; t < nt; t += 2) {
            const bool last = (t == nt - 2);
            const char* a1 = cA + (size_t)(t + 1) * kstep;
            const char* a2 = last ? nA : cA + (size_t)(t + 2) * kstep; const char* b2 = last ? nB : cB + (size_t)(t + 2) * kstep;
            const char* a3 = a2 + kstep; const char* b3 = b2 + kstep;
            PG8_LDB(B0, 0, 0); PG8_SCHED; PG8_LDA(At, 0, 0); PG8_STAGE(PG8_SA(1, 1), a1 + hstep, voffA);
            PG8_WAIT_L(8); PG8_BAR; PG8_WAIT_L(0); PG8_MMA(0, 0, At, B0); PG8_BAR; PG8_SCHED;
            PG8_LDB(B1, 0, 1); PG8_STAGE(PG8_SB(0, 0), b2, voffB);
            PG8_BAR; PG8_WAIT_L(0); PG8_MMA(0, 1, At, B1); PG8_BAR;
            PG8_LDA(At, 0, 1); PG8_STAGE(PG8_SA(0, 0), a2, voffA);
            PG8_BAR; PG8_WAIT_L(0); PG8_MMA(1, 0, At, B0); PG8_BAR; PG8_SCHED;
            PG8_STAGE(PG8_SB(0, 1), b2 + hstep, voffB);
            PG8_WAIT_V(6); PG8_BAR; PG8_MMA(1, 1, At, B1); PG8_BAR;
            PG8_LDB(B0, 1, 0); PG8_SCHED; PG8_LDA(At, 1, 0); PG8_STAGE(PG8_SA(0, 1), a2 + hstep, voffA);
            PG8_WAIT_L(8); PG8_BAR; PG8_WAIT_L(0); PG8_MMA(0, 0, At, B0); PG8_BAR; PG8_SCHED;
            PG8_LDB(B1, 1, 1); PG8_STAGE(PG8_SB(1, 0), b3, voffB);
            PG8_BAR; PG8_WAIT_L(0); PG8_MMA(0, 1, At, B1); PG8_BAR;
            PG8_LDA(At, 1, 1); PG8_STAGE(PG8_SA(1, 0), a3, voffA);
            PG8_BAR; PG8_WAIT_L(0); PG8_MMA(1, 0, At, B0); PG8_BAR; PG8_SCHED;
            PG8_STAGE(PG8_SB(1, 1), b3 + hstep, voffB);
            PG8_WAIT_V(6); PG8_BAR; PG8_MMA(1, 1, At, B1); PG8_BAR;
        }
        int efr = fr, efq = fq; asm volatile("" : "+v"(efr), "+v"(efq));
        if constexpr (Epi::BATCHED) E.tile(acc, cur, wr, wc, efr, efq); else
#pragma unroll
        for (int ai = 0; ai < 2; ++ai)
#pragma unroll
            for (int m = 0; m < 4; ++m) {
                const int r = ai * HALF + wr * 64 + m * 16 + efr;
                if constexpr (Epi::PAIR) {
                    const float g[8] = {acc[ai][0][m][0][0], acc[ai][0][m][0][1], acc[ai][0][m][0][2], acc[ai][0][m][0][3], acc[ai][0][m][1][0], acc[ai][0][m][1][1], acc[ai][0][m][1][2], acc[ai][0][m][1][3]};
                    const float up[8] = {acc[ai][1][m][0][0], acc[ai][1][m][0][1], acc[ai][1][m][0][2], acc[ai][1][m][0][3], acc[ai][1][m][1][0], acc[ai][1][m][1][1], acc[ai][1][m][1][2], acc[ai][1][m][1][3]};
                    E.row8p(cur, r, wc * 32 + 8 * efq, g, up);
                } else {
#pragma unroll
                    for (int bj = 0; bj < 2; ++bj) {
                        const float v[8] = {acc[ai][bj][m][0][0], acc[ai][bj][m][0][1], acc[ai][bj][m][0][2], acc[ai][bj][m][0][3], acc[ai][bj][m][1][0], acc[ai][bj][m][1][1], acc[ai][bj][m][1][2], acc[ai][bj][m][1][3]};
                        E.row8(cur, r, bj * HALF + wc * 32 + 8 * efq, v);
                    }
                }
            }
        if (!has_next) break;
#pragma unroll
        for (int a = 0; a < 2; ++a)
#pragma unroll
            for (int b = 0; b < 2; ++b)
#pragma unroll
                for (int m = 0; m < 4; ++m)
#pragma unroll
                    for (int n = 0; n < 2; ++n) acc[a][b][m][n] = (f32x4){0.f, 0.f, 0.f, 0.f};
        cur = nxt; cA = nA; cB = nB; ++ui;
    }
    PG8_WAIT_V(0);
    if (wr == 0) PG8_BAR;
    PG8_BAR;
#undef PG8_SA
#undef PG8_SB
#undef PG8_STAGE
#undef PG8_LDA
#undef PG8_LDB
#undef PG8_MMA
#undef PG8_WAIT_V
#undef PG8_WAIT_L
#undef PG8_BAR
#undef PG8_SCHED
}

template <class Sched, class Epi>
DI void gemm_naive(LAS unsigned char* lds, int tid, const Sched& S, const Epi& E) {
    LAS float* As = (LAS float*)lds;
    LAS float* Bs = As + 32 * 132;
    LAS float* Bu = Bs + 32 * 132;
    const int ty = tid >> 4, tx = tid & 15, lr = tid >> 2, kq = tid & 3;
    Unit u;
    for (int i = 0; S.next(i, u); ++i) {
        const bf16* A = S.aptr(u); const bf16* B = S.bptr(u);
        for (int sm = 0; sm < 2; ++sm)
            for (int sn = 0; sn < (Epi::PAIR ? 1 : 2); ++sn) {
                float acc[4][8], accu[4][8];
#pragma unroll
                for (int a = 0; a < 4; ++a)
#pragma unroll
                    for (int b = 0; b < 8; ++b) { acc[a][b] = 0.f; accu[a][b] = 0.f; }
                for (int k0 = 0; k0 < 1024; k0 += 32) {
                    __syncthreads();
                    { float w[8]; unpack8(*(const u32x4*)(A + (size_t)(128 * sm + lr) * 1024 + k0 + 8 * kq), w);
#pragma unroll
                      for (int j = 0; j < 8; ++j) As[(8 * kq + j) * 132 + lr] = w[j];
                      unpack8(*(const u32x4*)(B + (size_t)(128 * sn + lr) * 1024 + k0 + 8 * kq), w);
#pragma unroll
                      for (int j = 0; j < 8; ++j) Bs[(8 * kq + j) * 132 + lr] = w[j];
                      if (Epi::PAIR) { unpack8(*(const u32x4*)(B + (size_t)(128 + lr) * 1024 + k0 + 8 * kq), w);
#pragma unroll
                          for (int j = 0; j < 8; ++j) Bu[(8 * kq + j) * 132 + lr] = w[j]; } }
                    __syncthreads();
#pragma unroll 4
                    for (int k = 0; k < 32; ++k) {
                        const f32x4 a4 = *(const LAS f32x4*)(As + k * 132 + 4 * ty);
                        const f32x4 b0 = *(const LAS f32x4*)(Bs + k * 132 + 8 * tx), b1 = *(const LAS f32x4*)(Bs + k * 132 + 8 * tx + 4);
#pragma unroll
                        for (int a = 0; a < 4; ++a) {
#pragma unroll
                            for (int b = 0; b < 4; ++b) { acc[a][b] += a4[a] * b0[b]; acc[a][4 + b] += a4[a] * b1[b]; } }
                        if (Epi::PAIR) {
                            const f32x4 c0 = *(const LAS f32x4*)(Bu + k * 132 + 8 * tx), c1 = *(const LAS f32x4*)(Bu + k * 132 + 8 * tx + 4);
#pragma unroll
                            for (int a = 0; a < 4; ++a) {
#pragma unroll
                                for (int b = 0; b < 4; ++b) { accu[a][b] += a4[a] * c0[b]; accu[a][4 + b] += a4[a] * c1[b]; } }
                        }
                    }
                }
#pragma unroll
                for (int a = 0; a < 4; ++a) {
                    if constexpr (Epi::PAIR) E.row8p(u, 128 * sm + 4 * ty + a, 8 * tx, acc[a], accu[a]);
                    else E.row8(u, 128 * sm + 4 * ty + a, 128 * sn + 8 * tx, acc[a]);
                }
            }
    }
    __syncthreads();
}
template <class Sched, class Epi>
DI void gemm_run(LAS unsigned char* lds, int tid, const Sched& S, const Epi& E) {
#if FAST_GEMM
    gemm_fast(lds, tid, S, E);
#else
    gemm_naive(lds, tid, S, E);
#endif
}

struct Ctx {
    LAS unsigned char* lds;
    int tid, lane, wave, gw, ngw;
    unsigned z;
    const float* const __attribute__((address_space(4)))* in;
    float* out;
    unsigned char* ws;
};
#define WSP(T, off) ((T*)(c.ws + (off)))

DI void transpose_item(const float* W, int N, bf16* WT, int k0, int n0, int dst_row0, LAS float* scr, int lane) {
#pragma unroll 8
    for (int i = 0; i < 32; ++i) { const int kk = 2 * i + (lane >> 5); scr[kk * 33 + (lane & 31)] = __builtin_nontemporal_load(W + (size_t)(k0 + kk) * N + n0 + (lane & 31)); }
    asm volatile("s_waitcnt lgkmcnt(0)" ::: "memory");
    const int cc = lane & 7;
#pragma unroll
    for (int j = 0; j < 4; ++j) { const int n = (lane >> 3) + 8 * j; const LAS float* s = scr + (8 * cc) * 33 + n;
        u32x4 o; o.x = cvt_pk_bf16(s[0 * 33], s[1 * 33]); o.y = cvt_pk_bf16(s[2 * 33], s[3 * 33]); o.z = cvt_pk_bf16(s[4 * 33], s[5 * 33]); o.w = cvt_pk_bf16(s[6 * 33], s[7 * 33]);
        *(u32x4*)(WT + (size_t)(dst_row0 + n) * 1024 + k0 + 8 * cc) = o; }
    asm volatile("s_waitcnt lgkmcnt(0)" ::: "memory");
}
DI void dense_transpose(const Ctx& c, const float* W, int N, bf16* WT, LAS float* scr) {
    const int nblk = N / 32, nitems = 16 * nblk;
    for (int it = c.gw; it < nitems; it += c.ngw) { const int kb = it / nblk, nb = it % nblk; transpose_item(W, N, WT, 64 * kb, 32 * nb, 32 * nb, scr, c.lane); }
}
DI void phase_pro0(const Ctx& c) {
    LAS float* scr = (LAS float*)(c.lds + c.wave * 8704);
    for (int j = 0; j < 2; ++j) {
        dense_transpose(c, c.in[I_MLWIN] + (size_t)j * 1024 * 3104, 3104, WSP(bf16, WS_ML_WIN) + (size_t)j * NINP * 1024, scr);
        dense_transpose(c, c.in[I_MLWOUT] + (size_t)j * 1024 * 1024, 1024, WSP(bf16, WS_ML_WOUT) + (size_t)j * 1024 * 1024, scr);
    }
    dense_transpose(c, c.in[I_GLWIN], 3104, WSP(bf16, WS_GLA_WIN), scr);
    dense_transpose(c, c.in[I_GLWOUT], 1024, WSP(bf16, WS_GLA_WOUT), scr);
    dense_transpose(c, c.in[I_HYWIN], 3072, WSP(bf16, WS_HY_WIN), scr);
    dense_transpose(c, c.in[I_HYWOUT], 1024, WSP(bf16, WS_HY_WOUT), scr);
    for (int it = c.gw * 64 + c.lane; it < 3 * 28672; it += c.ngw * 64) {
        const int m = it / 28672, r = it % 28672; bf16* base = (m < 2) ? WSP(bf16, WS_ML_WIN) + (size_t)m * NINP * 1024 : WSP(bf16, WS_GLA_WIN);
        *(u32x4*)(base + (size_t)3104 * 1024 + (size_t)r * 8) = (u32x4){c.z, c.z, c.z, c.z};
    }
    for (int it = c.gw; it < 64 * 3 * 512; it += c.ngw) {
        const int le = it / 1536, r0 = it % 1536, which = r0 / 512, r = r0 % 512, kb = r / 32, nb = r % 32;
        if (which < 2) {
            const float* W = c.in[which == 0 ? I_EW1 : I_EW3] + (size_t)le * 1024 * 1024;
            const int n0 = 32 * nb, drow = 256 * (n0 >> 7) + (n0 & 127) + (which ? 128 : 0);
            transpose_item(W, 1024, WSP(bf16, WS_EXP_UP) + (size_t)le * 2048 * 1024, 64 * kb, n0, drow, scr, c.lane);
        } else {
            transpose_item(c.in[I_EW2] + (size_t)le * 1024 * 1024, 1024, WSP(bf16, WS_EXP_DN) + (size_t)le * 1024 * 1024, 64 * kb, 32 * nb, 32 * nb, scr, c.lane);
        }
    }
    for (int i = blockIdx.x * 512 + c.tid; i < 16 * 1024; i += gridDim.x * 512) WSP(float, WS_RWT)[i] = c.in[I_RW][(i & 1023) * 16 + (i >> 10)];
    {
        const float* w1 = c.in[I_HYFW1]; const float* b1 = c.in[I_HYFB1]; const float* wm = c.in[I_HYFWM]; const float* bm = c.in[I_HYFBM]; const float* fr = c.in[I_HYFREQ];
        float* HM = WSP(float, WS_HM);
        for (int row = c.gw; row < 2304; row += c.ngw) {
            const int L = row < 2048 ? 2048 : 256, t = row < 2048 ? row : row - 2048, f = c.lane;
            float feat = 0.f;
            if (f == 0) feat = (float)t / (float)(L - 1);
            else if (f <= 32) { const int b = (f - 1) & 15; const float band = 1e-4f + (float)b * ((15.0f - 1e-4f) / 15.0f);
                const float ang = ((float)(2.0 * 3.14159265358979323846 / (double)L) * (float)t) * band; feat = (f <= 16) ? cosf(ang) : -sinf(ang); }
            float a = b1[f];
            for (int e = 0; e < 33; ++e) a += __shfl(feat, e) * w1[e * 64 + f];
            float h = sinf(fr[f] * a);
            for (int m = 0; m < 2; ++m) {
                float a2 = bm[m * 64 + f];
                for (int g = 0; g < 64; ++g) a2 += __shfl(h, g) * wm[m * 4096 + g * 64 + f];
                h = sinf(fr[f] * a2);
            }
            HM[row * 64 + f] = h;
        }
    }
    __syncthreads();
    {
        LAS float* sv = (LAS float*)c.lds;
        LAS float* red = sv + 9 * 1024;
        for (int i = c.tid; i < 9 * 1024; i += 512) { const float x = (i < 8192) ? c.in[I_C][i] : c.in[I_CCTX][i - 8192]; sv[i] = siluf_(x); }
        __syncthreads();
        float* MOD = WSP(float, WS_MOD);
        const int col = c.tid & 63, kg = c.tid >> 6;
        for (int item = blockIdx.x; item < 4 * 96; item += gridDim.x) {
            const int l = item / 96, j0 = 64 * (item % 96);
            const float* w = c.in[I_ADAW] + (size_t)l * 1024 * 6144 + j0 + col;
            float acc[9];
#pragma unroll
            for (int r = 0; r < 9; ++r) acc[r] = 0.f;
            for (int k = kg * 128; k < kg * 128 + 128; ++k) { const float wv = w[(size_t)k * 6144];
#pragma unroll
                for (int r = 0; r < 9; ++r) acc[r] += sv[r * 1024 + k] * wv; }
#pragma unroll
            for (int r = 0; r < 9; ++r) red[(kg * 9 + r) * 64 + col] = acc[r];
            __syncthreads();
            for (int o = c.tid; o < 9 * 64; o += 512) { const int r = o >> 6, cc = o & 63; float s = c.in[I_ADAB][l * 6144 + j0 + cc];
#pragma unroll
                for (int g = 0; g < 8; ++g) s += red[(g * 9 + r) * 64 + cc];
                MOD[(l * 9 + r) * 6144 + j0 + cc] = s; }
            __syncthreads();
        }
    }
}

template <int L>
DI void pro1_len(const Ctx& c, int c0, const float* hm, float* tab, LAS float* hmT  , const LAS f32x4* wo4  , float (&part)[4]) {
    const int side = c.wave & 1, ts = c.wave >> 1;
    const float da = -4.605170185988091f / 1.5f, db = -4.605170185988091f / 0.3f;
#pragma unroll 1
    for (int t0 = 0; t0 < L; t0 += 256) {
        __syncthreads();
#pragma unroll
        for (int k = 0; k < 8; ++k) { const int idx = c.tid + 512 * k, row = idx >> 4, q = idx & 15; const f32x4 v = *(const f32x4*)(hm + (size_t)(t0 + row) * 64 + 4 * q);
            LAS float* d = hmT + row * 65 + 4 * q; d[0] = v.x; d[1] = v.y; d[2] = v.z; d[3] = v.w; }
        __syncthreads();
        const int t = t0 + 64 * ts + c.lane; const LAS float* hr = hmT + (64 * ts + c.lane) * 65;
        f32x4 acc = {0.f, 0.f, 0.f, 0.f};
#pragma unroll 8
        for (int f = 0; f < 64; ++f) acc += wo4[side * 64 + f] * hr[f];
        const float tl = (float)t / (float)(L - 1);
#pragma unroll
        for (int ch = 0; ch < 4; ++ch) { const float delta = fabsf(da + (float)(c0 + ch) * ((db - da) / 1023.0f)), v = acc[ch] * expf(-tl * delta);
            float* trow = tab + (size_t)(c0 + ch) * (2 * L);
            if (side == 0) { trow[L + t] = v; part[ch] += fabsf(v); }
            else if (t >= 1) { trow[L - t] = v; part[ch] += fabsf(v); }
            else trow[0] = 0.f; }
    }
}
template <int L>
DI void pro1_scale(const Ctx& c, int c0, float* tab, const float (&inv)[4]) {
    const int side = c.wave & 1, ts = c.wave >> 1;
#pragma unroll 1
    for (int t0 = 0; t0 < L; t0 += 256) { const int t = t0 + 64 * ts + c.lane;
#pragma unroll
        for (int ch = 0; ch < 4; ++ch) { float* trow = tab + (size_t)(c0 + ch) * (2 * L); if (side == 0) trow[L + t] *= inv[ch]; else if (t >= 1) trow[L - t] *= inv[ch]; } }
}
DI void pro1_reduce(const Ctx& c, float (&part)[4], LAS float* red, float (&inv)[4]) {
#pragma unroll
    for (int ch = 0; ch < 4; ++ch) part[ch] = wave_sum(part[ch]);
    __syncthreads();
    if (c.lane == 0) {
#pragma unroll
        for (int ch = 0; ch < 4; ++ch) red[c.wave * 4 + ch] = part[ch]; }
    __syncthreads();
#pragma unroll
    for (int ch = 0; ch < 4; ++ch) { float s = 0.f;
#pragma unroll
        for (int w = 0; w < 8; ++w) s += red[w * 4 + ch];
        inv[ch] = 1.0f / s; }
}
DI void phase_pro1(const Ctx& c) {
    LAS float* hmT = (LAS float*)c.lds; LAS f32x4* wo4 = (LAS f32x4*)(c.lds + 67584); LAS float* red = (LAS float*)(c.lds + 67584 + 2048);
    const float* HM = WSP(float, WS_HM);
    for (int item = blockIdx.x; item < 256; item += gridDim.x) {
        const int c0 = 4 * item;
        __syncthreads();
        if (c.tid < 128) wo4[c.tid] = *(const f32x4*)(c.in[I_HYFWO] + (size_t)(c.tid & 63) * 2048 + (c.tid >> 6) * 1024 + c0);
        float part[4] = {0.f, 0.f, 0.f, 0.f}, inv[4];
        pro1_len<SEQ>(c, c0, HM, WSP(float, WS_HF), hmT, wo4, part);
        pro1_reduce(c, part, red, inv);
        pro1_scale<SEQ>(c, c0, WSP(float, WS_HF), inv);
        float part2[4] = {0.f, 0.f, 0.f, 0.f};
        pro1_len<CTX>(c, c0, HM + 2048 * 64, WSP(float, WS_HFC), hmT, wo4, part2);
        pro1_reduce(c, part2, red, inv);
        pro1_scale<CTX>(c, c0, WSP(float, WS_HFC), inv);
    }
}

DI void load_row(const float* src, f32x4 (&v)[4], int lane) {
#pragma unroll
    for (int j = 0; j < 4; ++j) v[j] = *(const f32x4*)(src + 256 * j + 4 * lane);
}
DI void load_row_bf(const bf16* src, f32x4 (&v)[4], int lane) {
#pragma unroll
    for (int j = 0; j < 4; ++j) { const u32x2 a = *(const u32x2*)(src + 256 * j + 4 * lane);
        v[j] = (f32x4){__uint_as_float(a.x << 16), __uint_as_float(a.x & 0xffff0000u), __uint_as_float(a.y << 16), __uint_as_float(a.y & 0xffff0000u)}; }
}
DI void load_row_raw(const bf16* src, u32x2 (&r)[4], int lane) {
#pragma unroll
    for (int j = 0; j < 4; ++j) r[j] = *(const u32x2*)(src + 256 * j + 4 * lane);
}
DI void cvt_row_raw(const u32x2 (&r)[4], f32x4 (&v)[4]) {
#pragma unroll
    for (int j = 0; j < 4; ++j) v[j] = (f32x4){__uint_as_float(r[j].x << 16), __uint_as_float(r[j].x & 0xffff0000u), __uint_as_float(r[j].y << 16), __uint_as_float(r[j].y & 0xffff0000u)};
}
DI void norm_row(f32x4 (&v)[4], const float* g, int lane) {
    float s = 0.f;
#pragma unroll
    for (int j = 0; j < 4; ++j) s += (v[j].x * v[j].x + v[j].y * v[j].y) + (v[j].z * v[j].z + v[j].w * v[j].w);
    s = wave_sum(s);
    const float r = 1.0f / sqrtf(s * (1.0f / 1024.0f) + EPS);
#pragma unroll
    for (int j = 0; j < 4; ++j) v[j] = v[j] * r * *(const f32x4*)(g + 256 * j + 4 * lane);
}
DI void mod_row(f32x4 (&v)[4], const float* sh, const float* sc, int lane) {
#pragma unroll
    for (int j = 0; j < 4; ++j) v[j] = v[j] * (*(const f32x4*)(sc + 256 * j + 4 * lane) + 1.0f) + *(const f32x4*)(sh + 256 * j + 4 * lane);
}
DI void load_vec(const float* p, f32x4 (&w)[4], int lane) {
#pragma unroll
    for (int j = 0; j < 4; ++j) w[j] = *(const f32x4*)(p + 256 * j + 4 * lane);
}
DI void norm_mod_row_reg(f32x4 (&v)[4], const f32x4 (&g)[4], const f32x4 (&sh)[4], const f32x4 (&sc)[4]) {
    float s = 0.f;
#pragma unroll
    for (int j = 0; j < 4; ++j) s += (v[j].x * v[j].x + v[j].y * v[j].y) + (v[j].z * v[j].z + v[j].w * v[j].w);
    s = wave_sum(s);
    const float r = 1.0f / sqrtf(s * (1.0f / 1024.0f) + EPS);
#pragma unroll
    for (int j = 0; j < 4; ++j) v[j] = (v[j] * r * g[j]) * (sc[j] + 1.0f) + sh[j];
}
DI void store_row_bf16(bf16* dst, const f32x4 (&v)[4], int lane) {
#pragma unroll
    for (int j = 0; j < 4; ++j) { u32x2 w; w.x = cvt_pk_bf16(v[j].x, v[j].y); w.y = cvt_pk_bf16(v[j].z, v[j].w); *(u32x2*)(dst + 256 * j + 4 * lane) = w; }
}
DI int hrow_of(int srow, int kind) {
    if (srow < TC || kind != 1) return srow;
    const int rr = srow - TC, b = rr >> 11, s = rr & (SEQ - 1); return TC + b * SEQ + perm_fwd(s);
}
DI void phase_norm1(const Ctx& c, int l, const float* xl, const float* xc) {
    const float* MOD = WSP(float, WS_MOD) + (size_t)l * 9 * 6144; const float* g = c.in[I_N1G] + l * D; bf16* H = WSP(bf16, WS_H);
    const int per = (TT + c.ngw - 1) / c.ngw, rfirst = c.gw * per, rend = min(rfirst + per, TT);
    f32x4 vA[4] = {}, vB[4] = {}, gv[4], shv[4] = {}, scv[4] = {}; int mr_cur = -1; load_vec(g, gv, c.lane);
    if (rfirst < rend) { const int r = rfirst; load_row(r < TC ? xc + (size_t)r * D : xl + (size_t)(r - TC) * D, vA, c.lane); }
    if (rfirst + 1 < rend) { const int r = rfirst + 1; load_row(r < TC ? xc + (size_t)r * D : xl + (size_t)(r - TC) * D, vB, c.lane); }
    for (int row = rfirst; row < rend; ++row) {
        f32x4 v[4]; const int mr = row < TC ? 8 : (row - TC) >> 11;
        if (mr != mr_cur) { load_vec(MOD + mr * 6144, shv, c.lane); load_vec(MOD + mr * 6144 + 1024, scv, c.lane); mr_cur = mr; }
#pragma unroll
        for (int j = 0; j < 4; ++j) { v[j] = vA[j]; vA[j] = vB[j]; }
        if (row + 2 < rend) { const int r = row + 2; load_row(r < TC ? xc + (size_t)r * D : xl + (size_t)(r - TC) * D, vB, c.lane); }
        norm_mod_row_reg(v, gv, shv, scv);
        store_row_bf16(H + (size_t)hrow_of(row, l % 3) * D, v, c.lane);
    }
}

DI void phase_conv(const Ctx& c, int ncols, const float* cw, const float* cb, bool act, float qs) {
    constexpr int CV_PD = 4;
    const bf16* P = WSP(bf16, WS_P); bf16* PC = WSP(bf16, WS_BIG + BIG_PC);
    const int ncb = ncols >> 9, nrun = c.ngw / ncb, cbk = c.gw % ncb, run = c.gw / ncb;
    const int per = (TT + nrun - 1) / nrun, r0 = run * per, r1 = min(r0 + per, TT);
    if (run < nrun && r0 < r1) {
        const int col = cbk * 512 + 8 * c.lane;
        float w0[8], w1[8], w2[8], bb[8];
#pragma unroll
        for (int j = 0; j < 8; ++j) { w0[j] = cw[col + j]; w1[j] = cw[ncols + col + j]; w2[j] = cw[2 * ncols + col + j]; bb[j] = cb[col + j]; }
        const float sc = col < 512 ? qs : 1.0f;
#define CV_LD(r_) (*(const u32x4*)(P + (size_t)min(max((r_), 0), TT - 1) * PLD + col))
        float xm[8], x0[8], xp[8]; u32x4 q[CV_PD];
        { const u32x4 a = CV_LD(r0 - 1), b = CV_LD(r0), d = CV_LD(r0 + 1);
#pragma unroll
          for (int k = 0; k < CV_PD; ++k) q[k] = CV_LD(r0 + 2 + k);
          unpack8(a, xm); unpack8(b, x0); unpack8(d, xp); }
        for (int row = r0; row < r1; ++row) {
            int lo, hi; seq_bounds(row, lo, hi);
            const bool hm = row > lo, hp = row < hi;
            float o[8];
#pragma unroll
            for (int j = 0; j < 8; ++j) { float v = w0[j] * (hm ? xm[j] : 0.f) + w1[j] * x0[j] + w2[j] * (hp ? xp[j] : 0.f) + bb[j];
                if (act) v = siluf_(v); o[j] = v * sc; }
            *(u32x4*)(PC + (size_t)row * ncols + col) = pack8(o);
#pragma unroll
            for (int j = 0; j < 8; ++j) { xm[j] = x0[j]; x0[j] = xp[j]; }
            unpack8(q[0], xp);
#pragma unroll
            for (int k = 0; k + 1 < CV_PD; ++k) q[k] = q[k + 1];
            if (row + 2 + CV_PD <= r1) q[CV_PD - 1] = CV_LD(row + 2 + CV_PD);
        }
#undef CV_LD
    }
}

DI int scan_row(int step, int b, int dir) {
    if (step < CTX) return b * CTX + (dir ? CTX - 1 - step : step);
    const int s = step - CTX; return TC + b * SEQ + (dir ? SEQ - 1 - s : s);
}
DI void phase_mlstm_scan_naive(const Ctx& c) {
    const bf16* P = WSP(bf16, WS_P); const bf16* PC = WSP(bf16, WS_BIG + BIG_PC); const float* EX = WSP(float, WS_EXTRA);
    LAS float* qs = (LAS float*)c.lds; LAS float* ks = qs + 32 * 64; LAS float* vs = ks + 32 * 64; LAS float* gs = vs + 32 * 128;
    const int v = c.tid >> 2, d0 = (c.tid & 3) * 16;
    for (int item = blockIdx.x; item < 128; item += gridDim.x) {
        const int b = item >> 4, h = (item >> 1) & 7, dir = item & 1;
        float* Yo = WSP(float, WS_BIG + (dir ? BIG_YB : BIG_YF));
        float C[16], n[16];
#pragma unroll
        for (int d = 0; d < 16; ++d) { C[d] = 0.f; n[d] = 0.f; }
        for (int ch = 0; ch < (CTX + SEQ) / 32; ++ch) {
            __syncthreads();
            for (int idx = c.tid; idx < 32 * 256; idx += 512) { const int st = idx >> 8, col = idx & 255, row = scan_row(ch * 32 + st, b, dir);
                if (col < 64) qs[st * 64 + col] = bf2f(PC[(size_t)row * 1024 + h * 64 + col]);
                else if (col < 128) ks[st * 64 + col - 64] = bf2f(PC[(size_t)row * 1024 + 512 + h * 64 + col - 64]);
                else vs[st * 128 + col - 128] = bf2f(P[(size_t)row * PLD + 1024 + h * 128 + col - 128]); }
            if (c.tid < 32) { const int row = scan_row(ch * 32 + c.tid, b, dir); gs[c.tid * 2] = sigmoidf_(EX[(size_t)row * 32 + dir * 16 + 8 + h]); gs[c.tid * 2 + 1] = __expf(EX[(size_t)row * 32 + dir * 16 + h]); }
            __syncthreads();
            for (int st = 0; st < 32; ++st) {
                const float f = gs[st * 2], ei = gs[st * 2 + 1], vv = vs[st * 128 + v] * ei;
                float part = 0.f, dpart = 0.f;
#pragma unroll
                for (int d = 0; d < 16; ++d) { const float kd = ks[st * 64 + d0 + d], qd = qs[st * 64 + d0 + d];
                    C[d] = f * C[d] + kd * vv; part += qd * C[d]; n[d] = f * n[d] + ei * kd; dpart += qd * n[d]; }
                part += shx_(part, 1); part += shx_(part, 2); dpart += shx_(dpart, 1); dpart += shx_(dpart, 2);
                if ((c.tid & 3) == 0) { const int row = scan_row(ch * 32 + st, b, dir); Yo[(size_t)row * D + h * 128 + v] = part / fmaxf(fabsf(dpart), 1.0f); }
            }
        }
    }
}
typedef short s16x4 __attribute__((ext_vector_type(4)));
typedef float f32x16 __attribute__((ext_vector_type(16)));
#define MFMA32(a, b, c) __builtin_amdgcn_mfma_f32_32x32x16_bf16((a), (b), (c), 0, 0, 0)
DI int crow(int reg, int h) { return (reg & 3) + 8 * (reg >> 2) + 4 * h; }
DI s16x4 ds_tr(const LAS unsigned char* p) { return __builtin_amdgcn_ds_read_tr16_b64_v4i16((LAS s16x4*)p); }
DI bf16x8 cat8(s16x4 lo, s16x4 hi) { return __builtin_shufflevector(lo, hi, 0, 1, 2, 3, 4, 5, 6, 7); }
DI bf16x8 tr_frag(const LAS unsigned char* img, int pitch, int k0, int n0, int lane) {
    const int h = lane >> 5, g16 = (lane >> 4) & 1, i = lane & 15;
    const LAS unsigned char* p = img + (k0 + 8 * h + (i >> 2)) * pitch + (n0 + 16 * g16 + 4 * (i & 3)) * 2;
    return cat8(ds_tr(p), ds_tr(p + 4 * pitch));
}
DI bf16x8 tr_frag_perm(const LAS unsigned char* img, int pitch, int k0, int n0, int lane) {
    const int h = lane >> 5, g16 = (lane >> 4) & 1, i = lane & 15;
    const LAS unsigned char* p = img + (k0 + 4 * h + (i >> 2)) * pitch + (n0 + 16 * g16 + 4 * (i & 3)) * 2;
    return cat8(ds_tr(p), ds_tr(p + 8 * pitch));
}
DI bf16x8 row_frag(const LAS unsigned char* img, int pitch, int row0, int k0, int lane) { return *(const LAS bf16x8*)(img + (row0 + (lane & 31)) * pitch + (k0 + 8 * (lane >> 5)) * 2); }
DI bf16x8 pack_acc(const f32x16& x, int step) {
    u32x4 p; const int o = 8 * step;
    p.x = cvt_pk_bf16(x[o], x[o + 1]); p.y = cvt_pk_bf16(x[o + 2], x[o + 3]); p.z = cvt_pk_bf16(x[o + 4], x[o + 5]); p.w = cvt_pk_bf16(x[o + 6], x[o + 7]);
    return __builtin_bit_cast(bf16x8, p);
}
DI f32x16 zero16() { f32x16 z;
#pragma unroll
    for (int i = 0; i < 16; ++i) z[i] = 0.f; return z; }
DI float wave_incl_prefix(float x, int lane) {
#pragma unroll
    for (int o = 1; o < 64; o <<= 1) { const float t = __shfl_up(x, o); if (lane >= o) x += t; }
    return x;
}
DI float wave_incl_suffix(float x, int lane) {
#pragma unroll
    for (int o = 1; o < 64; o <<= 1) { const float t = __shfl_down(x, o); if (lane + o < 64) x += t; }
    return x;
}
DI int chunk_row0(int p, int b, int dir) {
    if (p < 4) return b * CTX + 64 * (dir ? 3 - p : p);
    return TC + b * SEQ + 64 * (dir ? 35 - p : p - 4);
}

DI void phase_mlstm_state(const Ctx& c) {
    const bf16* P = WSP(bf16, WS_P); const bf16* PC = WSP(bf16, WS_BIG + BIG_PC); const float* EX = WSP(float, WS_EXTRA);
    bf16* MCT = WSP(bf16, WS_BIG + BIG_MCT); float* MN = WSP(float, WS_BIG + BIG_MN);
    LAS float* gi = (LAS float*)c.lds; LAS float* ga = gi + 2304; LAS float* wv = ga + 2304; LAS float* dec = wv + 64;
    LAS unsigned char* Kw = c.lds + 20480; LAS unsigned char* Vs = Kw + 64 * 144;
    const int lane = c.lane, wave = c.wave, h5 = lane >> 5, l31 = lane & 31;
    for (int it0 = blockIdx.x; it0 < 256; it0 += gridDim.x) {
        const int item = (gridDim.x == 256) ? ((it0 & 7) * 32 + (it0 >> 3)) : it0;
        const int b = item >> 5, h = (item >> 2) & 7, dir = (item >> 1) & 1, dvh = item & 1, seq = (b * 8 + h) * 2 + dir;
        __syncthreads();
        for (int idx = c.tid; idx < 2304; idx += 512) { const int row = chunk_row0(idx >> 6, b, dir) + (idx & 63);
            gi[idx] = EX[(size_t)row * 32 + dir * 16 + h]; ga[idx] = logsigf_(EX[(size_t)row * 32 + dir * 16 + 8 + h]); }
        f32x16 acc = zero16(); float nst = 0.f;
        const int dt = wave & 1, vt = (wave >> 1) & 1;
        const int srow = c.tid >> 3, spc = c.tid & 7;
        u32x4 kregA, vregA, kregB, vregB;
#define ML_PREFETCH(p_, kr, vr) do { const int r0_ = chunk_row0((p_), b, dir); \
          kr = *(const u32x4*)(PC + (size_t)(r0_ + srow) * 1024 + 512 + h * 64 + 8 * spc); \
          vr = *(const u32x4*)(P + (size_t)(r0_ + srow) * PLD + 1024 + h * 128 + dvh * 64 + 8 * spc); } while (0)
        ML_PREFETCH(0, kregA, vregA); ML_PREFETCH(1, kregB, vregB);
        __syncthreads();
#define ML_STEP(p, kreg, vreg) do { \
              \
            if (wave < 4) { \
                bf16* dst = MCT + ((size_t)seq * 36 + (p)) * 8192 + (size_t)(dvh * 64 + 32 * vt + l31) * 64 + 32 * dt + 4 * h5; \
                _Pragma("unroll") for (int q = 0; q < 4; ++q) { u32x2 w; w.x = cvt_pk_bf16(acc[4 * q], acc[4 * q + 1]); w.y = cvt_pk_bf16(acc[4 * q + 2], acc[4 * q + 3]); *(u32x2*)(dst + 8 * q) = w; } \
            } else if (wave == 4) { if (dvh == 0) MN[((size_t)seq * 36 + (p)) * 64 + lane] = nst; } \
            else if (wave == 7) { \
                const float a = ga[(p) * 64 + lane]; const float bj = dir ? wave_incl_suffix(a, lane) : wave_incl_prefix(a, lane); \
                const float tot = __shfl(bj, dir ? 0 : 63); \
                wv[lane] = __expf(tot - bj + gi[(p) * 64 + lane]); if (lane == 0) dec[0] = __expf(tot); \
            } \
            lds_barrier(); \
              \
            { float kk[8]; unpack8(kreg, kk); const float w = wv[srow]; \
              _Pragma("unroll") for (int j = 0; j < 8; ++j) kk[j] *= w; \
              *(LAS u32x4*)(Kw + srow * 144 + spc * 16) = pack8(kk); *(LAS u32x4*)(Vs + srow * 144 + spc * 16) = vreg; } \
            if ((p) + 2 < 36) ML_PREFETCH((p) + 2, kreg, vreg); \
            const float d = dec[0];            \
            lds_barrier(); \
              \
            if (wave < 4) { \
                _Pragma("unroll") for (int i = 0; i < 16; ++i) acc[i] *= d; \
                _Pragma("unroll") for (int kk = 0; kk < 4; ++kk) acc = MFMA32(tr_frag(Kw, 144, 16 * kk, 32 * dt, lane), tr_frag(Vs, 144, 16 * kk, 32 * vt, lane), acc); \
            } else if (wave == 4) { \
                float s = 0.f; \
                for (int r = 0; r < 64; ++r) s += bf2f(*(const LAS bf16*)(Kw + r * 144 + lane * 2)); \
                nst = d * nst + s; \
            } } while (0)
        for (int p = 0; p < 36; p += 2) { ML_STEP(p, kregA, vregA); ML_STEP(p + 1, kregB, vregB); }
#undef ML_STEP
#undef ML_PREFETCH
    }
}

DI void phase_mlstm_out(const Ctx& c, const float* ng) {
    const bf16* P = WSP(bf16, WS_P); const bf16* PC = WSP(bf16, WS_BIG + BIG_PC); const float* EX = WSP(float, WS_EXTRA);
    const bf16* MCT = WSP(bf16, WS_BIG + BIG_MCT); const float* MN = WSP(float, WS_BIG + BIG_MN); bf16* Y = WSP(bf16, WS_Y);
    LAS unsigned char* Qs = c.lds; LAS unsigned char* Ks = Qs + 9216; LAS unsigned char* Vs = Ks + 9216;
    LAS unsigned char* CT0 = Vs + 17408;
    LAS float* gt = (LAS float*)(c.lds + MISC_OFF + 1024);
    LAS float* YO = (LAS float*)c.lds;
    const int lane = c.lane, wave = c.wave, h5 = lane >> 5, l31 = lane & 31;
    const int dir = wave >> 2, jt = (wave >> 1) & 1, vh = wave & 1;
    const int srow = c.tid >> 3, spc = c.tid & 7;
    u32x4 pq, pk, pv[2], pct[4], pgate[2]; float pga = 0.f, pgi = 0.f, pgn = 0.f;
#define MO_DECODE(it_) const int b = (it_) / 288, h = ((it_) / 36) & 7, cc = (it_) % 36; \
        const int r0 = cc < 4 ? b * CTX + 64 * cc : TC + b * SEQ + 64 * (cc - 4); const int pf = cc, pb = cc < 4 ? 3 - cc : 39 - cc
#define MO_PREFETCH(it_) do { MO_DECODE(it_); \
        pq = *(const u32x4*)(PC + (size_t)(r0 + srow) * 1024 + h * 64 + 8 * spc); pk = *(const u32x4*)(PC + (size_t)(r0 + srow) * 1024 + 512 + h * 64 + 8 * spc); \
        _Pragma("unroll") for (int i = 0; i < 2; ++i) pv[i] = *(const u32x4*)(P + (size_t)(r0 + srow) * PLD + 1024 + h * 128 + 8 * (spc + 8 * i)); \
        _Pragma("unroll") for (int i = 0; i < 4; ++i) { const int pc = c.tid + 512 * i, d2 = pc >> 10, rr = (pc >> 3) & 127, sp = pc & 7; \
            pct[i] = *(const u32x4*)(MCT + (((size_t)((b * 8 + h) * 2 + d2)) * 36 + (d2 ? pb : pf)) * 8192 + rr * 64 + 8 * sp); } \
        _Pragma("unroll") for (int i = 0; i < 2; ++i) pgate[i] = *(const u32x4*)(P + (size_t)(r0 + srow) * PLD + 2048 + h * 128 + 16 * spc + 8 * i); \
        if (wave < 2) { const int d2 = wave, row = r0 + lane; pga = EX[(size_t)row * 32 + d2 * 16 + 8 + h]; pgi = EX[(size_t)row * 32 + d2 * 16 + h]; \
            pgn = MN[(((size_t)((b * 8 + h) * 2 + d2)) * 36 + (d2 ? pb : pf)) * 64 + lane]; } } while (0)
    LAS float* ngs = (LAS float*)(c.lds + MISC_OFF + 4096);
    for (int i = c.tid; i < 1024; i += 512) ngs[i] = ng[i];
    if ((int)blockIdx.x < 2304) MO_PREFETCH((int)blockIdx.x);
    for (int item = blockIdx.x; item < 2304; item += gridDim.x) {
        MO_DECODE(item); (void)pf; (void)pb;
        lds_barrier();
        *(LAS u32x4*)(Qs + srow * 144 + spc * 16) = pq; *(LAS u32x4*)(Ks + srow * 144 + spc * 16) = pk;
#pragma unroll
        for (int i = 0; i < 2; ++i) *(LAS u32x4*)(Vs + srow * 272 + (spc + 8 * i) * 16) = pv[i];
#pragma unroll
        for (int i = 0; i < 4; ++i) { const int pc = c.tid + 512 * i, d2 = pc >> 10, rr = (pc >> 3) & 127, sp = pc & 7; *(LAS u32x4*)(CT0 + d2 * 18432 + rr * 144 + sp * 16) = pct[i]; }
        if (wave < 2) { const int d2 = wave; const float a = logsigf_(pga);
            const float bj = d2 ? wave_incl_suffix(a, lane) : wave_incl_prefix(a, lane);
            gt[d2 * 192 + lane] = bj; gt[d2 * 192 + 64 + lane] = pgi - bj; gt[d2 * 192 + 128 + lane] = pgn; }
        const u32x4 gate0 = pgate[0], gate1 = pgate[1];
        if (item + (int)gridDim.x < 2304) MO_PREFETCH(item + (int)gridDim.x);
        lds_barrier();
        const LAS float* g = gt + dir * 192; const LAS unsigned char* CT = CT0 + dir * 18432;
        const int j = 32 * jt + l31; const float bjj = g[j];
        bf16x8 qf[4];
#pragma unroll
        for (int kk = 0; kk < 4; ++kk) qf[kk] = row_frag(Qs, 144, 32 * jt, 16 * kk, lane);
        float qn = 0.f;
#pragma unroll
        for (int kk = 0; kk < 4; ++kk) { float qv[8]; unpack8(__builtin_bit_cast(u32x4, qf[kk]), qv);
#pragma unroll
            for (int e = 0; e < 8; ++e) qn += qv[e] * g[128 + 16 * kk + 8 * h5 + e]; }
        qn += shx_(qn, 32);
        f32x16 X[2]; float den = 0.f;
#pragma unroll
        for (int st = 0; st < 2; ++st) {
            X[st] = zero16();
            const bool live = dir ? (st >= jt) : (st <= jt);
            if (live) {
#pragma unroll
                for (int kk = 0; kk < 4; ++kk) X[st] = MFMA32(row_frag(Ks, 144, 32 * st, 16 * kk, lane), qf[kk], X[st]);
#pragma unroll
                for (int r = 0; r < 16; ++r) { const int s = 32 * st + crow(r, h5); const bool ok = dir ? (s >= j) : (s <= j);
                    const float w = ok ? __expf(bjj + g[64 + s]) : 0.f; X[st][r] *= w; den += X[st][r]; }
            }
        }
        den += shx_(den, 32);
        const float eb = __expf(bjj); den += eb * qn;
        const float scale = 1.0f / fmaxf(fabsf(den), 1.0f);
        f32x16 O[2];
#pragma unroll
        for (int t = 0; t < 2; ++t) {
            const int vt = 2 * vh + t; f32x16 z = zero16(), w = zero16();
#pragma unroll
            for (int st = 0; st < 2; ++st) { const bool live = dir ? (st >= jt) : (st <= jt);
                if (live) {
#pragma unroll
                    for (int step = 0; step < 2; ++step) z = MFMA32(tr_frag_perm(Vs, 272, 32 * st + 16 * step, 32 * vt, lane), pack_acc(X[st], step), z); } }
#pragma unroll
            for (int kk = 0; kk < 4; ++kk) w = MFMA32(row_frag(CT, 144, 32 * vt, 16 * kk, lane), qf[kk], w);
#pragma unroll
            for (int r = 0; r < 16; ++r) O[t][r] = (z[r] + eb * w[r]) * scale;
        }
        lds_barrier();
#pragma unroll
        for (int t = 0; t < 2; ++t) { const int vt = 2 * vh + t;
#pragma unroll
            for (int q = 0; q < 4; ++q) *(LAS f32x4*)(YO + dir * 8448 + j * 132 + 32 * vt + 8 * q + 4 * h5) = (f32x4){O[t][4 * q], O[t][4 * q + 1], O[t][4 * q + 2], O[t][4 * q + 3]}; }
        lds_barrier();
        { const int row = c.tid >> 3, c0 = (c.tid & 7) * 16; float y[16]; float ss = 0.f;
#pragma unroll
          for (int q = 0; q < 4; ++q) { const f32x4 a = *(const LAS f32x4*)(YO + row * 132 + c0 + 4 * q), bb = *(const LAS f32x4*)(YO + 8448 + row * 132 + c0 + 4 * q);
              y[4 * q] = a.x + bb.x; y[4 * q + 1] = a.y + bb.y; y[4 * q + 2] = a.z + bb.z; y[4 * q + 3] = a.w + bb.w; }
#pragma unroll
          for (int q = 0; q < 16; ++q) ss += y[q] * y[q];
          ss += shx_(ss, 1); ss += shx_(ss, 2); ss += shx_(ss, 4);
          const float r = 1.0f / sqrtf(ss * (1.0f / 128.0f) + EPS);
          float g0[8], g1[8];
          unpack8(gate0, g0); unpack8(gate1, g1);
          float o0[8], o1[8];
#pragma unroll
          for (int q = 0; q < 8; ++q) { o0[q] = y[q] * r * ngs[h * 128 + c0 + q] * sigmoidf_(g0[q]); o1[q] = y[8 + q] * r * ngs[h * 128 + c0 + 8 + q] * sigmoidf_(g1[q]); }
          *(u32x4*)(Y + (size_t)(r0 + row) * D + h * 128 + c0) = pack8(o0); *(u32x4*)(Y + (size_t)(r0 + row) * D + h * 128 + c0 + 8) = pack8(o1); }
    }
#undef MO_PREFETCH
#undef MO_DECODE
}

DI void phase_gla_decay(const Ctx& c) {
    const float* EX = WSP(float, WS_EXTRA); float* GB = WSP(float, WS_BIG + BIG_GB);
    LAS float* w2s = (LAS float*)c.lds; LAS float* gbs = w2s + 2048; LAS float* lgs = gbs + 128; LAS float* segs = lgs + 8192;
    const int srow = c.tid >> 3, dg = c.tid & 7;
    const int dir = (blockIdx.x >> 2) & 1, h = blockIdx.x & 3, nper = gridDim.x >> 3;
    __syncthreads();
    for (int i = c.tid; i < 2048; i += 512) w2s[i] = c.in[I_GLW2][(size_t)dir * 8192 + (i >> 7) * 512 + h * 128 + (i & 127)];
    if (c.tid < 128) gbs[c.tid] = c.in[I_GLGB][dir * 512 + h * 128 + c.tid];
    for (int ck = blockIdx.x >> 3; ck < 288; ck += nper) {
        const int r0 = 64 * ck;
        __syncthreads();
        f32x4 low[4];
#pragma unroll
        for (int q = 0; q < 4; ++q) low[q] = *(const f32x4*)(EX + (size_t)(r0 + srow) * 32 + dir * 16 + 4 * q);
        __syncthreads();
        { const int d0 = 16 * dg; float pre[16];
#pragma unroll
          for (int e = 0; e < 16; ++e) pre[e] = gbs[d0 + e];
#pragma unroll
          for (int r = 0; r < 16; ++r) { const float lv = low[r >> 2][r & 3];
#pragma unroll
              for (int q = 0; q < 4; ++q) { const f32x4 w = *(const LAS f32x4*)(w2s + r * 128 + d0 + 4 * q); pre[4 * q] += lv * w.x; pre[4 * q + 1] += lv * w.y; pre[4 * q + 2] += lv * w.z; pre[4 * q + 3] += lv * w.w; } }
#pragma unroll
          for (int q = 0; q < 4; ++q) *(LAS f32x4*)(lgs + srow * 128 + d0 + 4 * q) = (f32x4){logsigf_(pre[4 * q]) * 0.0625f, logsigf_(pre[4 * q + 1]) * 0.0625f, logsigf_(pre[4 * q + 2]) * 0.0625f, logsigf_(pre[4 * q + 3]) * 0.0625f}; }
        __syncthreads();
        { const int d = c.tid & 127, sg = c.tid >> 7; float v[16];
#pragma unroll
          for (int i = 0; i < 16; ++i) { const int s = dir ? 63 - (16 * sg + i) : 16 * sg + i; v[i] = lgs[s * 128 + d]; }
#pragma unroll
          for (int i = 1; i < 16; ++i) v[i] += v[i - 1];
          segs[sg * 128 + d] = v[15];
          __syncthreads();
          float off = 0.f;
#pragma unroll
          for (int g2 = 0; g2 < 3; ++g2) off += (g2 < sg) ? segs[g2 * 128 + d] : 0.f;
#pragma unroll
          for (int i = 0; i < 16; ++i) { const int s = dir ? 63 - (16 * sg + i) : 16 * sg + i; GB[((size_t)dir * TT + r0 + s) * 512 + h * 128 + d] = v[i] + off; } }
    }
}
DI void phase_gla_state(const Ctx& c) {
    const bf16* PC = WSP(bf16, WS_BIG + BIG_PC); const float* GB = WSP(float, WS_BIG + BIG_GB); bf16* GST = WSP(bf16, WS_BIG + BIG_GST);
    LAS float* tot = (LAS float*)c.lds;
    LAS unsigned char* Kd = c.lds + 1024; LAS unsigned char* Vs = Kd + 64 * 272;
    const int lane = c.lane, wave = c.wave, h5 = lane >> 5, l31 = lane & 31, dkt = wave & 3, dvt = wave >> 2;
    const int srow = c.tid >> 3, dg = c.tid & 7;
    for (int it0 = blockIdx.x; it0 < 256; it0 += gridDim.x) {
        const int item = (gridDim.x == 256) ? ((it0 & 7) * 32 + (it0 >> 3)) : it0;
        const int b = item >> 5, h = (item >> 3) & 3, dir = (item >> 2) & 1, dvq = item & 3, seq = (b * 4 + h) * 2 + dir;
        f32x16 acc = zero16();
        u32x4 kA0, kA1, vA, kB0, kB1, vB; f32x4 bvA[4], tvA[4], bvB[4], tvB[4];
#define GLA_PREFETCH(p_, k0, k1, vr, bv, tv) do { const int r0_ = chunk_row0((p_), b, dir), row = r0_ + srow; \
          k0 = *(const u32x4*)(PC + (size_t)row * 2048 + 512 + h * 128 + 16 * dg); k1 = *(const u32x4*)(PC + (size_t)row * 2048 + 512 + h * 128 + 16 * dg + 8); \
          vr = *(const u32x4*)(PC + (size_t)row * 2048 + 1024 + h * 256 + dvq * 64 + 8 * dg); \
          _Pragma("unroll") for (int q = 0; q < 4; ++q) { bv[q] = *(const f32x4*)(GB + ((size_t)dir * TT + row) * 512 + h * 128 + 16 * dg + 4 * q); \
              tv[q] = *(const f32x4*)(GB + ((size_t)dir * TT + r0_ + (dir ? 0 : 63)) * 512 + h * 128 + 16 * dg + 4 * q); } } while (0)
        GLA_PREFETCH(0, kA0, kA1, vA, bvA, tvA); GLA_PREFETCH(1, kB0, kB1, vB, bvB, tvB);
#define GLA_STEP(p, k0r, k1r, vr, bv, tv) do { \
            { bf16* dst = GST + ((size_t)seq * 36 + (p)) * 32768 + (size_t)(dvq * 64 + 32 * dvt + l31) * 128 + 32 * dkt + 4 * h5; \
              _Pragma("unroll") for (int q = 0; q < 4; ++q) { u32x2 w; w.x = cvt_pk_bf16(acc[4 * q], acc[4 * q + 1]); w.y = cvt_pk_bf16(acc[4 * q + 2], acc[4 * q + 3]); *(u32x2*)(dst + 8 * q) = w; } } \
            lds_barrier();                                    \
            { float kk[16]; { float t8[8]; unpack8(k0r, t8); \
                _Pragma("unroll") for (int e = 0; e < 8; ++e) kk[e] = t8[e]; unpack8(k1r, t8); \
                _Pragma("unroll") for (int e = 0; e < 8; ++e) kk[8 + e] = t8[e]; } \
              _Pragma("unroll") for (int e = 0; e < 16; ++e) kk[e] *= __expf(tv[e >> 2][e & 3] - bv[e >> 2][e & 3]); \
              const float k0[8] = {kk[0], kk[1], kk[2], kk[3], kk[4], kk[5], kk[6], kk[7]}, k1[8] = {kk[8], kk[9], kk[10], kk[11], kk[12], kk[13], kk[14], kk[15]}; \
              *(LAS u32x4*)(Kd + srow * 272 + dg * 32) = pack8(k0); *(LAS u32x4*)(Kd + srow * 272 + dg * 32 + 16) = pack8(k1); \
              *(LAS u32x4*)(Vs + srow * 144 + dg * 16) = vr; \
              if (srow == 0) { \
                  _Pragma("unroll") for (int q = 0; q < 4; ++q) *(LAS f32x4*)(tot + 16 * dg + 4 * q) = tv[q]; } } \
            if ((p) + 2 < 36) GLA_PREFETCH((p) + 2, k0r, k1r, vr, bv, tv); \
            lds_barrier(); \
            _Pragma("unroll") for (int r = 0; r < 16; ++r) acc[r] *= __expf(tot[32 * dkt + crow(r, h5)]); \
            _Pragma("unroll") for (int kk = 0; kk < 4; ++kk) acc = MFMA32(tr_frag(Kd, 272, 16 * kk, 32 * dkt, lane), tr_frag(Vs, 144, 16 * kk, 32 * dvt, lane), acc); \
            } while (0)
        for (int p = 0; p < 36; p += 2) { GLA_STEP(p, kA0, kA1, vA, bvA, tvA); GLA_STEP(p + 1, kB0, kB1, vB, bvB, tvB); }
#undef GLA_STEP
#undef GLA_PREFETCH
    }
}
DI void phase_gla_out(const Ctx& c, const float* ng) {
    const bf16* P = WSP(bf16, WS_P); const bf16* PC = WSP(bf16, WS_BIG + BIG_PC); const float* GB = WSP(float, WS_BIG + BIG_GB);
    const bf16* GST = WSP(bf16, WS_BIG + BIG_GST); bf16* Y = WSP(bf16, WS_Y);
    LAS unsigned char* Qt = c.lds; LAS unsigned char* Kt = Qt + 17408; LAS unsigned char* Vs = Kt + 17408; LAS unsigned char* STs = Vs + 33792;
    LAS float* YO = (LAS float*)STs;
    const int lane = c.lane, wave = c.wave, h5 = lane >> 5, l31 = lane & 31;
    const int srow = c.tid >> 3, dg = c.tid & 7;
    for (int item = blockIdx.x; item < 1152; item += gridDim.x) {
        const int b = item / 144, h = (item / 36) & 3, cc = item % 36;
        const int r0 = cc < 4 ? b * CTX + 64 * cc : TC + b * SEQ + 64 * (cc - 4);
        __syncthreads();
#pragma unroll
        for (int i = 0; i < 4; ++i) { const int pc = dg + 8 * i; *(LAS u32x4*)(Vs + srow * 528 + pc * 16) = *(const u32x4*)(PC + (size_t)(r0 + srow) * 2048 + 1024 + h * 256 + 8 * pc); }
        f32x16 O[2]; O[0] = zero16(); O[1] = zero16();
        for (int dir = 0; dir < 2; ++dir) {
            const int pslot = dir ? (cc < 4 ? 3 - cc : 39 - cc) : cc;
            if (dir) __syncthreads();
            { const bf16* src = GST + ((size_t)((b * 4 + h) * 2 + dir) * 36 + pslot) * 32768;
#pragma unroll
              for (int i = 0; i < 8; ++i) { const int pc = c.tid + 512 * i, rr = pc >> 4, sp = pc & 15; *(LAS u32x4*)(STs + rr * 272 + sp * 16) = *(const u32x4*)(src + rr * 128 + 8 * sp); } }
            { float qq[16], kk[16], bb[16]; float t8[8];
#pragma unroll
              for (int q = 0; q < 4; ++q) { const f32x4 t4 = *(const f32x4*)(GB + ((size_t)dir * TT + r0 + srow) * 512 + h * 128 + 16 * dg + 4 * q); bb[4 * q] = t4.x; bb[4 * q + 1] = t4.y; bb[4 * q + 2] = t4.z; bb[4 * q + 3] = t4.w; }
              unpack8(*(const u32x4*)(PC + (size_t)(r0 + srow) * 2048 + h * 128 + 16 * dg), t8);
#pragma unroll
              for (int e = 0; e < 8; ++e) qq[e] = t8[e];
              unpack8(*(const u32x4*)(PC + (size_t)(r0 + srow) * 2048 + h * 128 + 16 * dg + 8), t8);
#pragma unroll
              for (int e = 0; e < 8; ++e) qq[8 + e] = t8[e];
              unpack8(*(const u32x4*)(PC + (size_t)(r0 + srow) * 2048 + 512 + h * 128 + 16 * dg), t8);
#pragma unroll
              for (int e = 0; e < 8; ++e) kk[e] = t8[e];
              unpack8(*(const u32x4*)(PC + (size_t)(r0 + srow) * 2048 + 512 + h * 128 + 16 * dg + 8), t8);
#pragma unroll
              for (int e = 0; e < 8; ++e) kk[8 + e] = t8[e];
#pragma unroll
              for (int e = 0; e < 16; ++e) { const float eb = __expf(bb[e]); qq[e] *= eb; kk[e] *= 1.0f / eb; }
              const float q0[8] = {qq[0], qq[1], qq[2], qq[3], qq[4], qq[5], qq[6], qq[7]}, q1[8] = {qq[8], qq[9], qq[10], qq[11], qq[12], qq[13], qq[14], qq[15]};
              const float k0[8] = {kk[0], kk[1], kk[2], kk[3], kk[4], kk[5], kk[6], kk[7]}, k1[8] = {kk[8], kk[9], kk[10], kk[11], kk[12], kk[13], kk[14], kk[15]};
              *(LAS u32x4*)(Qt + srow * 272 + dg * 32) = pack8(q0); *(LAS u32x4*)(Qt + srow * 272 + dg * 32 + 16) = pack8(q1);
              *(LAS u32x4*)(Kt + srow * 272 + dg * 32) = pack8(k0); *(LAS u32x4*)(Kt + srow * 272 + dg * 32 + 16) = pack8(k1); }
            __syncthreads();
#pragma unroll
            for (int jt = 0; jt < 2; ++jt) {
#pragma unroll
                for (int st = 0; st < 2; ++st) {
                    const bool live = dir ? (st >= jt) : (st <= jt);
                    if (live) {
                        f32x16 X = zero16();
#pragma unroll
                        for (int kk = 0; kk < 8; ++kk) X = MFMA32(row_frag(Kt, 272, 32 * st, 16 * kk, lane), row_frag(Qt, 272, 32 * jt, 16 * kk, lane), X);
                        if (st == jt) {
#pragma unroll
                            for (int r = 0; r < 16; ++r) { const int s = crow(r, h5); const bool ok = dir ? (s >= l31) : (s <= l31); X[r] = ok ? X[r] : 0.f; } }
#pragma unroll
                        for (int step = 0; step < 2; ++step) O[jt] = MFMA32(tr_frag_perm(Vs, 528, 32 * st + 16 * step, 32 * wave, lane), pack_acc(X, step), O[jt]);
                    }
                }
#pragma unroll
                for (int kk = 0; kk < 8; ++kk) O[jt] = MFMA32(row_frag(STs, 272, 32 * wave, 16 * kk, lane), row_frag(Qt, 272, 32 * jt, 16 * kk, lane), O[jt]);
            }
        }
        __syncthreads();
#pragma unroll
        for (int jt = 0; jt < 2; ++jt)
#pragma unroll
            for (int q = 0; q < 4; ++q) *(LAS f32x4*)(YO + (32 * jt + l31) * 260 + 32 * wave + 8 * q + 4 * h5) = (f32x4){O[jt][4 * q], O[jt][4 * q + 1], O[jt][4 * q + 2], O[jt][4 * q + 3]};
        __syncthreads();
        { const int c0 = dg * 32; float y[32]; float ss = 0.f;
#pragma unroll
          for (int q = 0; q < 8; ++q) { const f32x4 a = *(const LAS f32x4*)(YO + srow * 260 + c0 + 4 * q); y[4 * q] = a.x; y[4 * q + 1] = a.y; y[4 * q + 2] = a.z; y[4 * q + 3] = a.w; }
#pragma unroll
          for (int q = 0; q < 32; ++q) ss += y[q] * y[q];
          ss += shx_(ss, 1); ss += shx_(ss, 2); ss += shx_(ss, 4);
          const float r = 1.0f / sqrtf(ss * (1.0f / 256.0f) + EPS);
#pragma unroll
          for (int q = 0; q < 4; ++q) { float g8[8], o8[8]; unpack8(*(const u32x4*)(P + (size_t)(r0 + srow) * PLD + 2048 + h * 256 + c0 + 8 * q), g8);
#pragma unroll
              for (int e = 0; e < 8; ++e) o8[e] = y[8 * q + e] * r * ng[h * 256 + c0 + 8 * q + e] * siluf_(g8[e]);
              *(u32x4*)(Y + (size_t)(r0 + srow) * D + h * 256 + c0 + 8 * q) = pack8(o8); } }
    }
}

DI void phase_gla_scan_naive(const Ctx& c) {
    const bf16* PC = WSP(bf16, WS_BIG + BIG_PC); const float* EX = WSP(float, WS_EXTRA);
    LAS float* qs = (LAS float*)c.lds; LAS float* ks = qs + 16 * 128; LAS float* as = ks + 16 * 128; LAS float* vs = as + 16 * 128; LAS float* lw = vs + 16 * 256;
    const int v = c.tid >> 1, d0 = (c.tid & 1) * 64;
    for (int item = blockIdx.x; item < 64; item += gridDim.x) {
        const int b = item >> 3, h = (item >> 1) & 3, dir = item & 1;
        float* Yo = WSP(float, WS_BIG + (dir ? BIG_YB : BIG_YF));
        const float* w2 = c.in[I_GLW2] + (size_t)dir * 16 * 512 + h * 128; const float* gb = c.in[I_GLGB] + dir * 512 + h * 128;
        float S[64];
#pragma unroll
        for (int d = 0; d < 64; ++d) S[d] = 0.f;
        for (int ch = 0; ch < (CTX + SEQ) / 16; ++ch) {
            __syncthreads();
            if (c.tid < 256) { const int st = c.tid >> 4, r = c.tid & 15, row = scan_row(ch * 16 + st, b, dir); lw[c.tid] = EX[(size_t)row * 32 + dir * 16 + r]; }
            for (int idx = c.tid; idx < 16 * 512; idx += 512) { const int st = idx >> 9, col = idx & 511, row = scan_row(ch * 16 + st, b, dir);
                if (col < 128) qs[st * 128 + col] = bf2f(PC[(size_t)row * 2048 + h * 128 + col]);
                else if (col < 256) ks[st * 128 + col - 128] = bf2f(PC[(size_t)row * 2048 + 512 + h * 128 + col - 128]);
                else vs[st * 256 + col - 256] = bf2f(PC[(size_t)row * 2048 + 1024 + h * 256 + col - 256]); }
            __syncthreads();
            for (int idx = c.tid; idx < 16 * 128; idx += 512) { const int st = idx >> 7, d = idx & 127; float pre = gb[d];
#pragma unroll
                for (int r = 0; r < 16; ++r) pre += lw[st * 16 + r] * w2[r * 512 + d];
                as[idx] = __expf(logsigf_(pre) * (1.0f / 16.0f)); }
            __syncthreads();
            for (int st = 0; st < 16; ++st) {
                const float vv = vs[st * 256 + v]; float part = 0.f;
#pragma unroll
                for (int d = 0; d < 64; ++d) { S[d] = as[st * 128 + d0 + d] * S[d] + ks[st * 128 + d0 + d] * vv; part += qs[st * 128 + d0 + d] * S[d]; }
                part += shx_(part, 1);
                if ((c.tid & 1) == 0) { const int row = scan_row(ch * 16 + st, b, dir); Yo[(size_t)row * D + h * 256 + v] = part; }
            }
        }
    }
}
DI void phase_headnorm(const Ctx& c, int hd, const float* ng) {
    const float* YF = WSP(float, WS_BIG + BIG_YF); const float* YB = WSP(float, WS_BIG + BIG_YB); const bf16* P = WSP(bf16, WS_P); bf16* Y = WSP(bf16, WS_Y);
    for (int row = c.gw; row < TT; row += c.ngw) {
        const int c0 = 16 * c.lane; float y[16]; float ss = 0.f;
#pragma unroll
        for (int j = 0; j < 4; ++j) { const f32x4 a = *(const f32x4*)(YF + (size_t)row * D + c0 + 4 * j), bb = *(const f32x4*)(YB + (size_t)row * D + c0 + 4 * j);
            y[4 * j] = a.x + bb.x; y[4 * j + 1] = a.y + bb.y; y[4 * j + 2] = a.z + bb.z; y[4 * j + 3] = a.w + bb.w; }
#pragma unroll
        for (int j = 0; j < 16; ++j) ss += y[j] * y[j];
        ss += shx_(ss, 1); ss += shx_(ss, 2); ss += shx_(ss, 4); if (hd == 256) ss += shx_(ss, 8);
        const float r = 1.0f / sqrtf(ss / (float)hd + EPS);
        float g0[8], g1[8];
        unpack8(*(const u32x4*)(P + (size_t)row * PLD + 2048 + c0), g0); unpack8(*(const u32x4*)(P + (size_t)row * PLD + 2048 + c0 + 8), g1);
        float o[16];
#pragma unroll
        for (int j = 0; j < 16; ++j) { const float gp = j < 8 ? g0[j] : g1[j - 8]; o[j] = y[j] * r * ng[c0 + j] * (hd == 128 ? sigmoidf_(gp) : siluf_(gp)); }
        const float o0[8] = {o[0], o[1], o[2], o[3], o[4], o[5], o[6], o[7]}, o1[8] = {o[8], o[9], o[10], o[11], o[12], o[13], o[14], o[15]};
        *(u32x4*)(Y + (size_t)row * D + c0) = pack8(o0); *(u32x4*)(Y + (size_t)row * D + c0 + 8) = pack8(o1);
    }
}
DI void phase_hyena_conv_naive(const Ctx& c) {
    const bf16* PC = WSP(bf16, WS_BIG + BIG_PC); bf16* Y = WSP(bf16, WS_Y); const float* skip = c.in[I_HYSKIP];
    LAS float* zt = (LAS float*)c.lds;
    LAS float* ft = zt + 4096;
    const int cc = c.tid & 63, tg = c.tid >> 6;
    for (int item = blockIdx.x; item < 4096 + 512; item += gridDim.x) {
        int L, rb, tt, cgi; const float* tab;
        if (item < 4096) { L = SEQ; const int b = item >> 9; tt = (item >> 4) & 31; cgi = item & 15; rb = TC + b * SEQ; tab = WSP(float, WS_HF); }
        else { const int it = item - 4096; L = CTX; const int b = it >> 6; tt = (it >> 4) & 3; cgi = it & 15; rb = b * CTX; tab = WSP(float, WS_HFC); }
        const int t0 = 64 * tt, c0 = 64 * cgi;
        float acc[8];
#pragma unroll
        for (int i = 0; i < 8; ++i) acc[i] = 0.f;
        for (int sb = 0; sb < L / 64; ++sb) {
            const int s0 = 64 * sb;
            __syncthreads();
            for (int idx = c.tid; idx < 4096; idx += 512) { const int sl = idx >> 6, ch = idx & 63; const size_t o = (size_t)(rb + s0 + sl) * PLD + c0 + ch;
                zt[idx] = bf2f(PC[o + 1024]) * bf2f(PC[o + 2048]); }
            for (int idx = c.tid; idx < 64 * 128; idx += 512) { const int ch = idx >> 7, j = idx & 127;
                if (j < 127) ft[j * 65 + ch] = tab[(size_t)(c0 + ch) * (2 * L) + L + (t0 - s0 - 63 + j)]; }
            __syncthreads();
#pragma unroll 1
            for (int g = 0; g < 8; ++g) {
                float w[15], z[8]; const int base = 8 * (tg - g) + 56;
#pragma unroll
                for (int m = 0; m < 15; ++m) w[m] = ft[(base + m) * 65 + cc];
#pragma unroll
                for (int j = 0; j < 8; ++j) z[j] = zt[(8 * g + j) * 64 + cc];
#pragma unroll
                for (int i = 0; i < 8; ++i)
#pragma unroll
                    for (int j = 0; j < 8; ++j) acc[i] += w[i - j + 7] * z[j];
            }
        }
#pragma unroll
        for (int i = 0; i < 8; ++i) { const int row = rb + t0 + 8 * tg + i; const size_t o = (size_t)row * PLD + c0 + cc;
            const float zin = bf2f(PC[o + 1024]) * bf2f(PC[o + 2048]), x0 = bf2f(PC[o]);
            Y[(size_t)row * D + c0 + cc] = f2bf(x0 * (acc[i] + skip[c0 + cc] * zin)); }
    }
}

DI void hy_item(int item, int& L, int& b, int& t0, int& c0, int& rb) {
    if (item < 4096) { L = SEQ; b = item >> 9; t0 = 64 * ((item >> 4) & 31); c0 = 64 * (item & 15); rb = TC + b * SEQ; }
    else { const int it = item - 4096; L = CTX; b = it >> 6; t0 = 64 * ((it >> 4) & 3); c0 = 64 * (it & 15); rb = b * CTX; }
}
DI void phase_hy_prep(const Ctx& c) {
    const bf16* P = WSP(bf16, WS_P); bf16* X0C = WSP(bf16, WS_BIG + BIG_PC); const float* cw = c.in[I_HYCW]; const float* cb = c.in[I_HYCB];
    LAS unsigned char* raw = c.lds;
    LAS float* zt = (LAS float*)(c.lds + 32768);
    u32x4 pre[4];
#define HP_PREF(it_) do { int L_, b_, t0_, c0_, rb_; hy_item((it_), L_, b_, t0_, c0_, rb_); \
        _Pragma("unroll") for (int k = 0; k < 4; ++k) { const int pc = c.tid + 512 * k; pre[k] = (u32x4){c.z, c.z, c.z, c.z}; \
            if (pc < 3 * 66 * 8) { const int g = pc / 528, rr = (pc % 528) >> 3, sp = pc & 7, t = t0_ - 1 + rr; \
                if (t >= 0 && t < L_) pre[k] = *(const u32x4*)(P + (size_t)(rb_ + t) * PLD + g * 1024 + c0_ + 8 * sp); } } } while (0)
    const bool wfix = (gridDim.x & 15u) == 0u;
    float wt[3][4][8];
    if (wfix) { const int sp = c.tid & 7, c0f = 64 * ((int)blockIdx.x & 15);
#pragma unroll
        for (int g = 0; g < 3; ++g) { const int col = g * 1024 + c0f + 8 * sp;
#pragma unroll
            for (int e = 0; e < 8; ++e) { wt[g][0][e] = cw[col + e]; wt[g][1][e] = cw[3072 + col + e]; wt[g][2][e] = cw[6144 + col + e]; wt[g][3][e] = cb[col + e]; } } }
    if ((int)blockIdx.x < 4608) HP_PREF((int)blockIdx.x);
    for (int item = blockIdx.x; item < 4608; item += gridDim.x) {
        int L, b, t0, c0, rb; hy_item(item, L, b, t0, c0, rb);
        if (!wfix) { const int sp = c.tid & 7;
#pragma unroll
            for (int g = 0; g < 3; ++g) { const int col = g * 1024 + c0 + 8 * sp;
#pragma unroll
                for (int e = 0; e < 8; ++e) { wt[g][0][e] = cw[col + e]; wt[g][1][e] = cw[3072 + col + e]; wt[g][2][e] = cw[6144 + col + e]; wt[g][3][e] = cb[col + e]; } } }
        bf16* ZT = L == SEQ ? WSP(bf16, WS_BIG + BIG_ZTL) : WSP(bf16, WS_BIG + BIG_ZTC);
        lds_barrier();
#pragma unroll
        for (int k = 0; k < 4; ++k) { const int pc = c.tid + 512 * k; if (pc < 3 * 66 * 8) { const int g = pc / 528, rr = (pc % 528) >> 3, sp = pc & 7; *(LAS u32x4*)(raw + (g * 66 + rr) * 128 + sp * 16) = pre[k]; } }
        if (item + (int)gridDim.x < 4608) HP_PREF(item + (int)gridDim.x);
        lds_barrier();
        { const int t = c.tid >> 3, sp = c.tid & 7; float u[3][8];
#pragma unroll
          for (int g = 0; g < 3; ++g) { float xm[8], x0[8], xp[8];
              unpack8(*(const LAS u32x4*)(raw + (g * 66 + t) * 128 + sp * 16), xm); unpack8(*(const LAS u32x4*)(raw + (g * 66 + t + 1) * 128 + sp * 16), x0); unpack8(*(const LAS u32x4*)(raw + (g * 66 + t + 2) * 128 + sp * 16), xp);
#pragma unroll
              for (int e = 0; e < 8; ++e) u[g][e] = wt[g][0][e] * xm[e] + wt[g][1][e] * x0[e] + wt[g][2][e] * xp[e] + wt[g][3][e]; }
          *(u32x4*)(X0C + (size_t)(rb + t0 + t) * 1024 + c0 + 8 * sp) = pack8(u[0]);
#pragma unroll
          for (int e = 0; e < 8; ++e) zt[t * 65 + 8 * sp + e] = u[1][e] * u[2][e]; }
        lds_barrier();
        { const int ch = c.tid >> 3, tp = c.tid & 7; float z[8];
#pragma unroll
          for (int e = 0; e < 8; ++e) z[e] = zt[(8 * tp + e) * 65 + ch];
          *(u32x4*)(ZT + ((size_t)(c0 + ch) * NB + b) * L + t0 + 8 * tp) = pack8(z); }
    }
#undef HP_PREF
}
template <int L>
DI void hy_toeplitz_channel(const Ctx& c, const float* hrow  , const bf16* zsrc  , bf16* ydst  ) {
    constexpr int NBK = L / 32, CP = 2 * L + 8, NT = (NBK + 31) / 32, DMIN = -(NBK - 1), DMAX = NBK - 1;
    LAS unsigned char* F = c.lds;
    LAS unsigned char* Zs = c.lds + 8 * CP * 2;
    LAS unsigned char* R1 = Zs + (8 * NBK + 1) * 80;
    const int lane = c.lane, w = c.wave, h5 = lane >> 5, a = lane & 31, pi = lane & 15, rho = (lane >> 4) & 1;
    __syncthreads();
    for (int g = c.tid; g < (2 * L + 16) / 8; g += 512) { float v[8];
#pragma unroll
        for (int j = 0; j < 8; ++j) { const int y = 8 * g + j; v[j] = (y >= 1 && y <= 2 * L - 1) ? hrow[2 * L - y] : 0.f; }
        *(LAS u32x4*)(R1 + g * 16) = pack8(v); }
    if (c.tid < 20) *(LAS unsigned*)(Zs + 8 * NBK * 80 + 4 * c.tid) = c.z;
    for (int pc = c.tid; pc < 8 * L / 8; pc += 512) { const int bb = pc / (L / 8), pj = pc % (L / 8);
        *(LAS u32x4*)(Zs + (bb * NBK + (pj >> 2)) * 80 + (pj & 3) * 16) = *(const u32x4*)(zsrc + (size_t)bb * L + 8 * pj); }
    __syncthreads();
    for (int g = c.tid; g < 2 * L / 8; g += 512) {
        const u32x4 lo = *(const LAS u32x4*)(R1 + g * 16), hi = *(const LAS u32x4*)(R1 + g * 16 + 16);
        const unsigned Dw[8] = {lo.x, lo.y, lo.z, lo.w, hi.x, hi.y, hi.z, hi.w};
#pragma unroll
        for (int r = 0; r < 8; ++r) { u32x4 o;
            if (r & 1) { o.x = __builtin_amdgcn_alignbit(Dw[r / 2 + 1], Dw[r / 2], 16); o.y = __builtin_amdgcn_alignbit(Dw[r / 2 + 2], Dw[r / 2 + 1], 16);
                         o.z = __builtin_amdgcn_alignbit(Dw[r / 2 + 3], Dw[r / 2 + 2], 16); o.w = __builtin_amdgcn_alignbit(Dw[r / 2 + 4], Dw[r / 2 + 3], 16); }
            else { o.x = Dw[r / 2]; o.y = Dw[r / 2 + 1]; o.z = Dw[r / 2 + 2]; o.w = Dw[r / 2 + 3]; }
            *(LAS u32x4*)(F + (r * CP + 8 * g) * 2) = o; } }
    __syncthreads();
    const int r = (-a) & 7;
    f32x16 acc[NT];
    u32x4 Bf[2][NT][2];
#define HY_BLK(blk_) ((unsigned)(blk_) < (unsigned)NBK ? w * NBK + (blk_) : 8 * NBK)
#pragma unroll
    for (int q = 0; q < NT; ++q) { acc[q] = zero16();
#pragma unroll
        for (int par = 0; par < 2; ++par)
#pragma unroll
            for (int step = 0; step < 2; ++step) Bf[par][q][step] = *(const LAS u32x4*)(Zs + HY_BLK(32 * q + 2 * pi + rho - (DMIN + par)) * 80 + 32 * step + 16 * h5); }
    for (int d0 = DMIN; d0 <= DMAX; d0 += 2) {
#pragma unroll
        for (int par = 0; par < 2; ++par) {
            const int d = d0 + par;
            if (d <= DMAX) {
#pragma unroll
                for (int step = 0; step < 2; ++step) {
                    const int y0 = L - 32 * d - a + 16 * step + 8 * h5;
                    const bf16x8 A = *(const LAS bf16x8*)(F + (r * CP + (y0 - r)) * 2);
#pragma unroll
                    for (int q = 0; q < NT; ++q) if (d >= 32 * q - (NBK - 1) && d <= 32 * q + 31) acc[q] = MFMA32(A, __builtin_bit_cast(bf16x8, Bf[par][q][step]), acc[q]);
                }
#pragma unroll
                for (int q = 0; q < NT; ++q)
#pragma unroll
                    for (int step = 0; step < 2; ++step) {
                        const u32x4 fr = *(const LAS u32x4*)(Zs + HY_BLK(32 * q + rho - (d + 2)) * 80 + 32 * step + 16 * h5); u32x4 nb;
                        nb.x = (unsigned)__builtin_amdgcn_update_dpp((int)fr.x, (int)Bf[par][q][step].x, 0x111, 0xf, 0xf, false);
                        nb.y = (unsigned)__builtin_amdgcn_update_dpp((int)fr.y, (int)Bf[par][q][step].y, 0x111, 0xf, 0xf, false);
                        nb.z = (unsigned)__builtin_amdgcn_update_dpp((int)fr.z, (int)Bf[par][q][step].z, 0x111, 0xf, 0xf, false);
                        nb.w = (unsigned)__builtin_amdgcn_update_dpp((int)fr.w, (int)Bf[par][q][step].w, 0x111, 0xf, 0xf, false);
                        Bf[par][q][step] = nb; }
            }
        }
    }
#undef HY_BLK
#pragma unroll
    for (int q = 0; q < NT; ++q) { const int i = 32 * q + 2 * pi + rho;
        if (i < NBK) {
#pragma unroll
            for (int qq = 0; qq < 4; ++qq) { u32x2 o; o.x = cvt_pk_bf16(acc[q][4 * qq], acc[q][4 * qq + 1]); o.y = cvt_pk_bf16(acc[q][4 * qq + 2], acc[q][4 * qq + 3]);
                *(u32x2*)(ydst + (size_t)w * L + 32 * i + 8 * qq + 4 * h5) = o; } } }
}
DI void phase_hy_toeplitz(const Ctx& c) {
    for (int ch = blockIdx.x; ch < 1024; ch += gridDim.x) {
        hy_toeplitz_channel<SEQ>(c, WSP(float, WS_HF) + (size_t)ch * 4096, WSP(bf16, WS_BIG + BIG_ZTL) + (size_t)ch * NB * SEQ, WSP(bf16, WS_BIG + BIG_YTL) + (size_t)ch * NB * SEQ);
        hy_toeplitz_channel<CTX>(c, WSP(float, WS_HFC) + (size_t)ch * 512, WSP(bf16, WS_BIG + BIG_ZTC) + (size_t)ch * NB * CTX, WSP(bf16, WS_BIG + BIG_YTC) + (size_t)ch * NB * CTX);
    }
}
DI void phase_hy_post(const Ctx& c) {
    const bf16* X0C = WSP(bf16, WS_BIG + BIG_PC); bf16* Y = WSP(bf16, WS_Y); const float* skip = c.in[I_HYSKIP];
    LAS float* tl = (LAS float*)c.lds;
    u32x4 py, pz, px; float psk = 0.f;
#define HQ_PREF(it_) do { int L_, b_, t0_, c0_, rb_; hy_item((it_), L_, b_, t0_, c0_, rb_); \
        const bf16* ZT_ = L_ == SEQ ? WSP(bf16, WS_BIG + BIG_ZTL) : WSP(bf16, WS_BIG + BIG_ZTC); const bf16* YT_ = L_ == SEQ ? WSP(bf16, WS_BIG + BIG_YTL) : WSP(bf16, WS_BIG + BIG_YTC); \
        const int ch_ = c.tid >> 3, tp_ = c.tid & 7; const size_t o_ = ((size_t)(c0_ + ch_) * NB + b_) * L_ + t0_ + 8 * tp_; \
        py = *(const u32x4*)(YT_ + o_); pz = *(const u32x4*)(ZT_ + o_); psk = skip[c0_ + ch_]; \
        px = *(const u32x4*)(X0C + (size_t)(rb_ + t0_ + (c.tid >> 3)) * 1024 + c0_ + 8 * (c.tid & 7)); } while (0)
    if ((int)blockIdx.x < 4608) HQ_PREF((int)blockIdx.x);
    for (int item = blockIdx.x; item < 4608; item += gridDim.x) {
        int L, b, t0, c0, rb; hy_item(item, L, b, t0, c0, rb); (void)L; (void)b;
        lds_barrier();
        { const int ch = c.tid >> 3, tp = c.tid & 7; float y[8], z[8]; unpack8(py, y); unpack8(pz, z); const float sk = psk;
#pragma unroll
          for (int e = 0; e < 8; ++e) tl[ch * 65 + 8 * tp + e] = y[e] + sk * z[e]; }
        const u32x4 xc = px;
        if (item + (int)gridDim.x < 4608) HQ_PREF(item + (int)gridDim.x);
        lds_barrier();
        { const int t = c.tid >> 3, sp = c.tid & 7; float x0[8], o[8]; unpack8(xc, x0);
#pragma unroll
          for (int e = 0; e < 8; ++e) o[e] = x0[e] * tl[(8 * sp + e) * 65 + t];
          *(u32x4*)(Y + (size_t)(rb + t0 + t) * D + c0 + 8 * sp) = pack8(o); }
    }
#undef HQ_PREF
}

DI void phase_route(const Ctx& c, int l) {
    LAS float* rw = (LAS float*)c.lds;
    LAS int* lcnt = (LAS int*)(c.lds + 65536);
    LAS int* rinfo = lcnt + 32;
    LAS float* rwt = (LAS float*)(rinfo + 4 * 128);
    { const f32x4* srcw = (const f32x4*)WSP(float, WS_RWT);
#pragma unroll
      for (int i = 0; i < 8; ++i) *(LAS f32x4*)(rw + 4 * (c.tid + 512 * i)) = srcw[c.tid + 512 * i]; }
    if (c.tid < 16) lcnt[c.tid] = 0;
    __syncthreads();
    const float* MOD = WSP(float, WS_MOD) + (size_t)l * 9 * 6144; const float* g = c.in[I_N2G] + l * D; bf16* H = WSP(bf16, WS_H);
    const bf16* X = WSP(bf16, WS_X); const bf16* XC = WSP(bf16, WS_XC);
    unsigned* cnt = WSP(unsigned, WS_CTL) + CW_CNT + l * 16; int* TOK = WSP(int, WS_TOK); float* TOKW = WSP(float, WS_TOK + 512 * 1024);
    const float rbl = c.lane < 16 ? c.in[I_RB][c.lane] : 0.f;
    const int rlo = (l == 3 ? TC : 0), nrow = TT - rlo, per = (nrow + (int)gridDim.x - 1) / (int)gridDim.x;
    const int brow0 = rlo + (int)blockIdx.x * per, bn = min(per, TT - brow0);
    f32x4 gv[4], shv[4] = {}, scv[4] = {}; int mr_cur = -1; load_vec(g, gv, c.lane);
    u32x2 rawA[4] = {}, rawB[4] = {};
    if (c.wave < bn) { const int row = brow0 + c.wave; load_row_raw(row < TC ? XC + (size_t)row * D : X + (size_t)(row - TC) * D, rawA, c.lane); }
    if (c.wave + 8 < bn) { const int row = brow0 + c.wave + 8; load_row_raw(row < TC ? XC + (size_t)row * D : X + (size_t)(row - TC) * D, rawB, c.lane); }
    for (int lr = c.wave; lr < bn; lr += 8) {
        const int row = brow0 + lr;
        f32x4 v[4];
        cvt_row_raw(rawA, v);
        const int mr = row < TC ? 8 : (row - TC) >> 11;
        if (mr != mr_cur) { load_vec(MOD + mr * 6144 + 3072, shv, c.lane); load_vec(MOD + mr * 6144 + 4096, scv, c.lane); mr_cur = mr; }
        norm_mod_row_reg(v, gv, shv, scv);
        store_row_bf16(H + (size_t)row * D, v, c.lane);
#pragma unroll
        for (int j = 0; j < 4; ++j) rawA[j] = rawB[j];
        if (lr + 16 < bn) { const int rn = row + 16; load_row_raw(rn < TC ? XC + (size_t)rn * D : X + (size_t)(rn - TC) * D, rawB, c.lane); }
        float s16[16];
#pragma unroll
        for (int e = 0; e < 16; ++e) { float s = 0.f;
#pragma unroll
            for (int j = 0; j < 4; ++j) { const f32x4 w = *(const LAS f32x4*)(rw + e * 1024 + 256 * j + 4 * c.lane); s += (v[j].x * w.x + v[j].y * w.y) + (v[j].z * w.z + v[j].w * w.w); }
            s16[e] = s; if ((e & 3) == 3) asm volatile("" ::: "memory"); }
        float s8[8], s4[4], s2[2], s1;
        { const bool up = (c.lane & 32) != 0;
#pragma unroll
          for (int i = 0; i < 8; ++i) { const float keep = up ? s16[8 + i] : s16[i], give = up ? s16[i] : s16[8 + i]; s8[i] = keep + shx_(give, 32); } }
        { const bool up = (c.lane & 16) != 0;
#pragma unroll
          for (int i = 0; i < 4; ++i) { const float keep = up ? s8[4 + i] : s8[i], give = up ? s8[i] : s8[4 + i]; s4[i] = keep + shx_(give, 16); } }
        { const bool up = (c.lane & 8) != 0;
#pragma unroll
          for (int i = 0; i < 2; ++i) { const float keep = up ? s4[2 + i] : s4[i], give = up ? s4[i] : s4[2 + i]; s2[i] = keep + shx_(give, 8); } }
        { const bool up = (c.lane & 4) != 0; const float keep = up ? s2[1] : s2[0], give = up ? s2[0] : s2[1]; s1 = keep + shx_(give, 4); }
        s1 += shx_(s1, 2); s1 += shx_(s1, 1);
        const int eb = c.lane & 15; const int srcl = (((eb >> 3) & 1) << 5) | (((eb >> 2) & 1) << 4) | (((eb >> 1) & 1) << 3) | ((eb & 1) << 2);
        const float sc = sigmoidf_(__shfl(s1, srcl));
        const float sel = sc + rbl;
        float m1 = sel, m2 = -1e30f;
        { const float o1 = shx_(sel, 1); const float hi = fmaxf(sel, o1), lo = fminf(sel, o1);
          const float ohi = shx_(hi, 2), olo = shx_(lo, 2);
          m1 = fmaxf(hi, ohi); m2 = fmaxf(fminf(hi, ohi), fmaxf(lo, olo)); }
        const float gs = m1 + m2;
        const float g0 = __shfl(gs, 0), g1 = __shfl(gs, 4), g2 = __shfl(gs, 8), g3 = __shfl(gs, 12);
        int bg = 0; float bgs = g0; if (g1 > bgs) { bgs = g1; bg = 1; } if (g2 > bgs) { bgs = g2; bg = 2; } if (g3 > bgs) { bgs = g3; bg = 3; }
        float s4b[4], p4b[4];
#pragma unroll
        for (int j = 0; j < 4; ++j) { s4b[j] = __shfl(sel, 4 * bg + j); p4b[j] = __shfl(sc, 4 * bg + j); }
        int i1 = 0; float v1 = s4b[0], q1 = p4b[0];
#pragma unroll
        for (int j = 1; j < 4; ++j) if (s4b[j] > v1) { v1 = s4b[j]; i1 = j; q1 = p4b[j]; }
        int i2 = -1; float v2 = -1e30f, q2 = 0.f;
#pragma unroll
        for (int j = 0; j < 4; ++j) if (j != i1 && s4b[j] > v2) { v2 = s4b[j]; i2 = j; q2 = p4b[j]; }
        if (c.lane == 0) {
            const int e0 = 4 * bg + i1, e1 = 4 * bg + i2;
            const int p0 = __hip_atomic_fetch_add(lcnt + e0, 1, __ATOMIC_RELAXED, __HIP_MEMORY_SCOPE_WORKGROUP), p1 = __hip_atomic_fetch_add(lcnt + e1, 1, __ATOMIC_RELAXED, __HIP_MEMORY_SCOPE_WORKGROUP);
            rinfo[lr * 4 + 0] = e0; rinfo[lr * 4 + 1] = p0; rinfo[lr * 4 + 2] = e1; rinfo[lr * 4 + 3] = p1;
            const float inv = 1.0f / (q1 + q2); rwt[lr * 2] = q1 * inv; rwt[lr * 2 + 1] = q2 * inv;
        }
    }
    __syncthreads();
    if (c.tid < 16) lcnt[16 + c.tid] = (int)atomicAdd(cnt + c.tid, (unsigned)lcnt[c.tid]);
    __syncthreads();
    for (int lr = c.tid; lr < bn; lr += 512) { const int row = brow0 + lr, e0 = rinfo[lr * 4], e1 = rinfo[lr * 4 + 2];
        TOK[row * 4 + 0] = e0; TOK[row * 4 + 1] = lcnt[16 + e0] + rinfo[lr * 4 + 1]; TOK[row * 4 + 2] = e1; TOK[row * 4 + 3] = lcnt[16 + e1] + rinfo[lr * 4 + 3];
        TOKW[row * 2] = rwt[lr * 2]; TOKW[row * 2 + 1] = rwt[lr * 2 + 1]; }
}
DI void slot_bases(const unsigned* cnt, int lane, int e0, int e1, int& b0, int& b1) {
    const unsigned mine = lane < 16 ? ((cnt[lane] + 255u) & ~255u) : 0u; unsigned pb = 0; b0 = 0; b1 = 0;
#pragma unroll
    for (int e = 0; e < 16; ++e) { const unsigned ce = __shfl(mine, e); if (e == e0) b0 = (int)pb; if (e == e1) b1 = (int)pb; pb += ce; }
}
DI void phase_gather(const Ctx& c, int l) {
    const unsigned* cnt = WSP(unsigned, WS_CTL) + CW_CNT + l * 16; const int* TOK = WSP(int, WS_TOK); int* TOKS = WSP(int, WS_TOK + 768 * 1024);
    const bf16* H = WSP(bf16, WS_H); bf16* HS = WSP(bf16, WS_BIG + BIG_HS);
    const unsigned minep = c.lane < 16 ? ((cnt[c.lane] + 255u) & ~255u) : 0u; unsigned pb = 0; int mybase = 0;
#pragma unroll
    for (int e = 0; e < 16; ++e) { const unsigned ce = __shfl(minep, e); if (c.lane == e) mybase = (int)pb; pb += ce; }
    const int rfirst = (l == 3 ? TC : 0) + c.gw, rstep = c.ngw;
    int e0n = 0, p0n = 0, e1n = 0, p1n = 0; u32x4 an = {0u, 0u, 0u, 0u}, bn = an;
    if (rfirst < TT) { e0n = TOK[rfirst * 4]; p0n = TOK[rfirst * 4 + 1]; e1n = TOK[rfirst * 4 + 2]; p1n = TOK[rfirst * 4 + 3];
        an = *(const u32x4*)(H + (size_t)rfirst * D + 8 * c.lane); bn = *(const u32x4*)(H + (size_t)rfirst * D + 512 + 8 * c.lane); }
    for (int row = rfirst; row < TT; row += rstep) {
        const int e0 = e0n, p0 = p0n, e1 = e1n, p1 = p1n; const u32x4 a = an, bq = bn;
        if (row + rstep < TT) { const int r = row + rstep; e0n = TOK[r * 4]; p0n = TOK[r * 4 + 1]; e1n = TOK[r * 4 + 2]; p1n = TOK[r * 4 + 3];
            an = *(const u32x4*)(H + (size_t)r * D + 8 * c.lane); bn = *(const u32x4*)(H + (size_t)r * D + 512 + 8 * c.lane); }
        const int s0 = __shfl(mybase, e0) + p0, s1 = __shfl(mybase, e1) + p1;
        *(u32x4*)(HS + (size_t)s0 * D + 8 * c.lane) = a; *(u32x4*)(HS + (size_t)s0 * D + 512 + 8 * c.lane) = bq;
        *(u32x4*)(HS + (size_t)s1 * D + 8 * c.lane) = a; *(u32x4*)(HS + (size_t)s1 * D + 512 + 8 * c.lane) = bq;
        if (c.lane == 0) { TOKS[row * 2] = s0; TOKS[row * 2 + 1] = s1; }
    }
}
DI LAS int* moe_tiles(const Ctx& c, int l, int nsh) {
    LAS int* tp = (LAS int*)(c.lds + MISC_OFF);
    LAS int* ul = tp + 192;
    __syncthreads();
    if (c.tid < 64) {
        const unsigned* cnt = WSP(unsigned, WS_CTL) + CW_CNT + l * 16;
        const int mine = c.lane < 16 ? (int)((cnt[c.lane] + 255u) >> 8) : 0; int p = 0;
        for (int e = 0; e < 16; ++e) { const int ne = __shfl(mine, e); for (int t = c.lane; t < ne; t += 64) tp[1 + p + t] = e; p += ne; }
        if (c.lane == 0) tp[0] = p;
    }
    __syncthreads();
    if (c.tid < 32) {
        const int i = c.tid, ntile = tp[0], G = gridDim.x, cb = blockIdx.x; int rt = 1 << 20, pn = 0;
        if ((G & 7) == 0 && ((G >> 3) >> nsh) > 0) { const int x = cb & 7, v = cb >> 3, rpx = (G >> 3) >> nsh;
            if (v < (rpx << nsh)) { rt = (i * 8 + x) * rpx + (v >> nsh); pn = v & ((1 << nsh) - 1); } }
        else { const int L = i * G + cb; rt = L >> nsh; pn = L & ((1 << nsh) - 1); }
        ul[i] = rt < ntile ? (rt | (pn << 12) | (tp[1 + rt] << 16)) : -1;
    }
    __syncthreads();
    return ul;
}
DI void phase_combine(const Ctx& c, int l) {
    const float* MOD = WSP(float, WS_MOD) + (size_t)l * 9 * 6144; const int* TOKS = WSP(int, WS_TOK + 768 * 1024); const float* TOKW = WSP(float, WS_TOK + 512 * 1024);
    const bf16* YS = WSP(bf16, WS_BIG + BIG_HS); bf16* X = WSP(bf16, WS_X); bf16* XC = WSP(bf16, WS_XC); bf16* H = WSP(bf16, WS_H);
    const int rlo = (l == 3 ? TC : 0), per = (TT - rlo + c.ngw - 1) / c.ngw;
    const int rfirst = rlo + c.gw * per, rend = min(rfirst + per, TT);
    int sa0 = 0, sa1 = 0, sb0 = 0, sb1 = 0; float wa0 = 0.f, wa1 = 0.f, wb0 = 0.f, wb1 = 0.f;
    u32x2 dx[4], dy0[4], dy1[4];
    f32x4 g2v[4] = {}, gnv[4], shn[4] = {}, scn[4] = {}; int mr_cur = -1;
    load_vec(l < 3 ? c.in[I_N1G] + (l + 1) * D : c.in[I_FING], gnv, c.lane);
    const float* MODn = WSP(float, WS_MOD) + (size_t)(l < 3 ? l + 1 : l) * 9 * 6144;
#define CB_XP(r_) ((r_) < TC ? XC + (size_t)(r_) * D : X + (size_t)((r_) - TC) * D)
#define CB_LOAD(r_, s0_, s1_) do { const bf16* xq = CB_XP(r_); _Pragma("unroll") for (int j = 0; j < 4; ++j) { dx[j] = *(const u32x2*)(xq + 256 * j + 4 * c.lane); \
        dy0[j] = *(const u32x2*)(YS + (size_t)(s0_) * D + 256 * j + 4 * c.lane); dy1[j] = *(const u32x2*)(YS + (size_t)(s1_) * D + 256 * j + 4 * c.lane); } } while (0)
    if (rfirst < rend) { sa0 = TOKS[rfirst * 2]; sa1 = TOKS[rfirst * 2 + 1]; wa0 = TOKW[rfirst * 2]; wa1 = TOKW[rfirst * 2 + 1]; }
    if (rfirst + 1 < rend) { const int r = rfirst + 1; sb0 = TOKS[r * 2]; sb1 = TOKS[r * 2 + 1]; wb0 = TOKW[r * 2]; wb1 = TOKW[r * 2 + 1]; }
    if (rfirst < rend) CB_LOAD(rfirst, sa0, sa1);
    for (int row = rfirst; row < rend; ++row) {
        const int mr = row < TC ? 8 : (row - TC) >> 11; bf16* xp = CB_XP(row);
        const float w0 = wa0, w1 = wa1;
        if (mr != mr_cur) { load_vec(MOD + mr * 6144 + 5120, g2v, c.lane); if (l < 3) { load_vec(MODn + mr * 6144, shn, c.lane); load_vec(MODn + mr * 6144 + 1024, scn, c.lane); } mr_cur = mr; }
        f32x4 v[4], ya[4], yb[4];
#pragma unroll
        for (int j = 0; j < 4; ++j) {
            v[j] = (f32x4){__uint_as_float(dx[j].x << 16), __uint_as_float(dx[j].x & 0xffff0000u), __uint_as_float(dx[j].y << 16), __uint_as_float(dx[j].y & 0xffff0000u)};
            ya[j] = (f32x4){__uint_as_float(dy0[j].x << 16), __uint_as_float(dy0[j].x & 0xffff0000u), __uint_as_float(dy0[j].y << 16), __uint_as_float(dy0[j].y & 0xffff0000u)};
            yb[j] = (f32x4){__uint_as_float(dy1[j].x << 16), __uint_as_float(dy1[j].x & 0xffff0000u), __uint_as_float(dy1[j].y << 16), __uint_as_float(dy1[j].y & 0xffff0000u)}; }
        sa0 = sb0; sa1 = sb1; wa0 = wb0; wa1 = wb1;
        if (row + 2 < rend) { const int r = row + 2; sb0 = TOKS[r * 2]; sb1 = TOKS[r * 2 + 1]; wb0 = TOKW[r * 2]; wb1 = TOKW[r * 2 + 1]; }
        if (row + 1 < rend) CB_LOAD(row + 1, sa0, sa1);
#pragma unroll
        for (int j = 0; j < 4; ++j) v[j] = v[j] + g2v[j] * (ya[j] * w0 + yb[j] * w1);
        if (l < 3) store_row_bf16(xp, v, c.lane);
        if (l < 3) {
            norm_mod_row_reg(v, gnv, shn, scn);
            store_row_bf16(H + (size_t)hrow_of(row, (l + 1) % 3) * D, v, c.lane);
        } else {
            float s = 0.f;
#pragma unroll
            for (int j = 0; j < 4; ++j) s += (v[j].x * v[j].x + v[j].y * v[j].y) + (v[j].z * v[j].z + v[j].w * v[j].w);
            s = wave_sum(s);
            const float r = 1.0f / sqrtf(s * (1.0f / 1024.0f) + EPS);
            float* o = c.out + (size_t)(row - TC) * D;
#pragma unroll
            for (int j = 0; j < 4; ++j) *(f32x4*)(o + 256 * j + 4 * c.lane) = v[j] * r * gnv[j];
        }
    }
#undef CB_LOAD
#undef CB_XP
}

DI void ctx_outproj_mini(const Ctx& c, const bf16* Yc, const bf16* Wt, const float* xs_c  , bf16* XC, const float* modc  , const float* bias) {
    constexpr int RS = 272, ABYTES = 64 * RS, STG = 192 * RS;
    const int lane = c.lane, h5 = lane >> 5, l31 = lane & 31;
    const int srow = c.tid >> 4, sch = c.tid & 15;
    for (int tile = blockIdx.x; tile < 256; tile += gridDim.x) {
        const int mt = 64 * (tile >> 3), nt = 128 * (tile & 7);
        const int m0 = mt + 32 * (c.wave >> 2), n0 = nt + 32 * (c.wave & 3);
        const bf16* ag = Yc + (size_t)(mt + srow) * 1024 + 8 * sch; const bf16* bg = Wt + (size_t)(nt + srow) * 1024 + 8 * sch;
        u32x4 st[6];
#define MINI_G(k0_) do { _Pragma("unroll") for (int i = 0; i < 2; ++i) st[i] = *(const u32x4*)(ag + (size_t)(32 * i) * 1024 + (k0_)); \
                         _Pragma("unroll") for (int i = 0; i < 4; ++i) st[2 + i] = *(const u32x4*)(bg + (size_t)(32 * i) * 1024 + (k0_)); } while (0)
#define MINI_W(buf_) do { LAS unsigned char* wb = c.lds + (buf_) * STG + srow * RS + sch * 16; \
                         _Pragma("unroll") for (int i = 0; i < 2; ++i) *(LAS u32x4*)(wb + 32 * i * RS) = st[i]; \
                         _Pragma("unroll") for (int i = 0; i < 4; ++i) *(LAS u32x4*)(wb + ABYTES + 32 * i * RS) = st[2 + i]; } while (0)
        MINI_G(0);
        const int row = m0 + l31;
        float xo[4][4]; f32x4 g1[4], bb[4];
#pragma unroll
        for (int q = 0; q < 4; ++q) { const int col = n0 + 8 * q + 4 * h5; const size_t o = (size_t)row * D + col;
            if (xs_c) { const f32x4 t = *(const f32x4*)(xs_c + o); xo[q][0] = t.x; xo[q][1] = t.y; xo[q][2] = t.z; xo[q][3] = t.w; }
            else { const u32x2 t = *(const u32x2*)(XC + o); xo[q][0] = __uint_as_float(t.x << 16); xo[q][1] = __uint_as_float(t.x & 0xffff0000u); xo[q][2] = __uint_as_float(t.y << 16); xo[q][3] = __uint_as_float(t.y & 0xffff0000u); }
            g1[q] = *(const f32x4*)(modc + 2048 + col); bb[q] = bias ? *(const f32x4*)(bias + col) : (f32x4){0.f, 0.f, 0.f, 0.f}; }
        __syncthreads();
        MINI_W(0);
        lds_barrier();
        f32x16 acc = zero16();
        const LAS unsigned char* ar = c.lds + (32 * (c.wave >> 2) + l31) * RS + 16 * h5;
        const LAS unsigned char* br = c.lds + ABYTES + (32 * (c.wave & 3) + l31) * RS + 16 * h5;
#pragma unroll 1
        for (int s = 0; s < 8; ++s) {
            if (s < 7) MINI_G(128 * (s + 1));
            const int bo = (s & 1) * STG;
#pragma unroll
            for (int k = 0; k < 8; ++k) { const bf16x8 af = *(const LAS bf16x8*)(ar + bo + 32 * k), wf = *(const LAS bf16x8*)(br + bo + 32 * k); acc = MFMA32(wf, af, acc); }
            if (s < 7) MINI_W((s + 1) & 1);
            lds_barrier();
        }
#undef MINI_G
#undef MINI_W
#pragma unroll
        for (int q = 0; q < 4; ++q) { const int col = n0 + 8 * q + 4 * h5; const size_t o = (size_t)row * D + col;
            u32x2 w; w.x = cvt_pk_bf16(xo[q][0] + g1[q].x * (acc[4 * q] + bb[q].x), xo[q][1] + g1[q].y * (acc[4 * q + 1] + bb[q].y));
            w.y = cvt_pk_bf16(xo[q][2] + g1[q].z * (acc[4 * q + 2] + bb[q].z), xo[q][3] + g1[q].w * (acc[4 * q + 3] + bb[q].w));
            *(u32x2*)(XC + o) = w; }
    }
}

#define XB_TMO      128
#define XB_XCNT(j)  (256  + 64 * (j))
#define XB_XSUB(j)  (1280 + 64 * (j))
#define XB_XGEN(j)  (2304 + 64 * (j))
#define XB_TOP      3328
#define XB_TOPGEN   3392
#define XCD_BAR_WORDS 3456
#define XB_SPIN_CAP (1u << 18)
DI unsigned xb_ld(unsigned* p)              { return __hip_atomic_load(p, __ATOMIC_RELAXED, __HIP_MEMORY_SCOPE_AGENT); }
DI unsigned xb_add(unsigned* p, unsigned v) { return __hip_atomic_fetch_add(p, v, __ATOMIC_RELAXED, __HIP_MEMORY_SCOPE_AGENT); }
DI unsigned xb_xcc_id() { return (unsigned)__builtin_amdgcn_s_getreg((3 << 11) | 20) & 0xFu; }
#define XB_SPIN(cond, bar) do { unsigned _sp = 0; while (cond) { __builtin_amdgcn_s_sleep(1); \
    if ((++_sp & 255u) == 0u) { if (xb_ld(&(bar)[XB_TMO])) break; if (_sp > XB_SPIN_CAP) { atomicAdd(&(bar)[XB_TMO], 1u); break; } } } } while (0)
DI void xcd_barrier_complete(unsigned* bar, unsigned x, unsigned& nloc, unsigned& nx) {
    const unsigned G = gridDim.x * gridDim.y * gridDim.z;
    unsigned sum, cnt, mine, sp = 0u;
    for (;;) {
        sum = 0u; cnt = 0u; mine = 0u;
#pragma unroll
        for (unsigned j = 0; j < 16; ++j) { const unsigned cj = xb_ld(&bar[XB_XCNT(j)]); sum += cj; cnt += (cj > 0u) ? 1u : 0u; mine = (j == x) ? cj : mine; }
        if (sum == G) break;
        __builtin_amdgcn_s_sleep(1);
        if ((++sp & 255u) == 0u) { if (xb_ld(&bar[XB_TMO])) break; if (sp > XB_SPIN_CAP) { atomicAdd(&bar[XB_TMO], 1u); break; } }
    }
    nloc = mine > 0u ? mine : 1u; nx = cnt > 0u ? cnt : 1u;
}
DI void xcd_barrier(unsigned* bar, volatile LAS unsigned* st) {
    asm volatile("s_waitcnt vmcnt(0)" ::: "memory");
    __syncthreads();
    if (threadIdx.x == 0) {
        const unsigned x = xb_xcc_id();
        __builtin_amdgcn_s_waitcnt(0);
        unsigned nloc = st[0], nx = st[1];
        if (nloc == 0u) { xcd_barrier_complete(bar, x, nloc, nx); st[0] = nloc; st[1] = nx; }
        const unsigned old = xb_add(&bar[XB_XSUB(x)], 1u);
        const unsigned gen = old / nloc;
        if (old + 1u == (gen + 1u) * nloc) {
            __builtin_amdgcn_fence(__ATOMIC_RELEASE, "agent");
            asm volatile("s_waitcnt vmcnt(0)" ::: "memory");
            const unsigned og = xb_add(&bar[XB_TOP], 1u);
            const unsigned tg = og / nx;
            if (og + 1u == (tg + 1u) * nx) xb_add(&bar[XB_TOPGEN], 1u);
            else XB_SPIN(xb_ld(&bar[XB_TOPGEN]) == tg, bar);
            __builtin_amdgcn_fence(__ATOMIC_ACQUIRE, "agent");
            xb_add(&bar[XB_XGEN(x)], 1u);
            asm volatile("s_waitcnt vmcnt(0)" ::: "memory");
        } else {
            XB_SPIN(xb_ld(&bar[XB_XGEN(x)]) == gen, bar);
            __builtin_amdgcn_fence(__ATOMIC_ACQUIRE, "agent");
            asm volatile("s_waitcnt vmcnt(0)" ::: "memory");
        }
    }
    __syncthreads();
}

constexpr int NPHASE = 2 + 11 * DEPTH;
__host__ __device__ inline bool phase_active(int ph) {
    if (ph < 2) return true;
    const int l = (ph - 2) / 11, s = (ph - 2) % 11, kind = l % 3;
    if (s == 0) return false;
    if (s == 4) return kind != 2 || HY_MFMA;
    return true;
}
DI void run_phase(const Ctx& c, int ph) {
    if (ph == 0) { if constexpr (PH_EN(0)) phase_pro0(c); return; }
    if (ph == 1) { if constexpr (PH_EN(1)) { phase_pro1(c); phase_norm1(c, 0, c.in[I_X], c.in[I_CTX]); } return; }
    const int l = (ph - 2) / 11, s = (ph - 2) % 11, kind = l % 3, j = l / 3;
    switch (s) {
    case 0: if constexpr (PH_EN(2)) phase_norm1(c, 0, c.in[I_X], c.in[I_CTX]); break;
    case 1: if constexpr (PH_EN(3)) {
        DenseOrder S; EpiInproj E; E.P = WSP(bf16, WS_P); E.extra = WSP(float, WS_EXTRA); E.bias = nullptr; E.bias_x = nullptr;
        S.A = WSP(bf16, WS_H); S.ul = dense_units(c.lds, c.tid, TT, kind == 2 ? 3072 : NINP);
        if (kind == 0) { S.Bt = WSP(bf16, WS_ML_WIN) + (size_t)j * NINP * 1024; E.bias_x = c.in[I_MLBG] + j * 32; }
        else if (kind == 1) { S.Bt = WSP(bf16, WS_GLA_WIN); }
        else { S.Bt = WSP(bf16, WS_HY_WIN); E.bias = c.in[I_HYBIN]; }
        gemm_run(c.lds, c.tid, S, E);
    } break;
    case 2: if constexpr (PH_EN(4))
        if (kind == 0) phase_conv(c, 1024, c.in[I_MLCW] + j * 3 * 1024, c.in[I_MLCB] + j * 1024, true, 0.125f);
        else if (kind == 1) { phase_conv(c, 2048, c.in[I_GLCW], c.in[I_GLCB], true, 0.08838834764831845f); if constexpr (GLA_CHUNK) phase_gla_decay(c); }
        else { if constexpr (HY_MFMA) phase_hy_prep(c); else phase_conv(c, 3072, c.in[I_HYCW], c.in[I_HYCB], false, 1.0f); }
        break;
    case 3: if constexpr (PH_EN(5))
        if (kind == 0) { if constexpr (MLSTM_CHUNK) phase_mlstm_state(c); else phase_mlstm_scan_naive(c); }
        else if (kind == 1) { if constexpr (GLA_CHUNK) phase_gla_state(c); else phase_gla_scan_naive(c); }
        else { if constexpr (HY_MFMA) phase_hy_toeplitz(c); else phase_hyena_conv_naive(c); }
        break;
    case 4: if constexpr (PH_EN(6))
        if (kind == 0) { if constexpr (MLSTM_CHUNK) phase_mlstm_out(c, c.in[I_MLNG] + j * 1024); else phase_headnorm(c, 128, c.in[I_MLNG] + j * 1024); }
        else if (kind == 1) { if constexpr (GLA_CHUNK) phase_gla_out(c, c.in[I_GLNG]); else phase_headnorm(c, 256, c.in[I_GLNG]); }
        else { if constexpr (HY_MFMA) phase_hy_post(c); }
        break;
    case 5: if constexpr (PH_EN(7)) {
        DenseOrder S; EpiOutproj E; E.X = WSP(bf16, WS_X); E.XC = WSP(bf16, WS_XC); E.mod = WSP(float, WS_MOD) + (size_t)l * 9 * 6144; E.bias = nullptr; E.perm = (kind == 1);
        E.xs_l = (l == 0) ? c.in[I_X] : nullptr; E.xs_c = (l == 0) ? c.in[I_CTX] : nullptr; E.row_off = TC;
        const bf16* W = kind == 0 ? WSP(bf16, WS_ML_WOUT) + (size_t)j * 1024 * 1024 : kind == 1 ? WSP(bf16, WS_GLA_WOUT) : WSP(bf16, WS_HY_WOUT);
        if (kind == 2) E.bias = c.in[I_HYBOUT];
        S.A = WSP(bf16, WS_Y) + (size_t)E.row_off * D; S.Bt = W; S.ul = dense_units(c.lds, c.tid, TT - E.row_off, 1024);
        gemm_run(c.lds, c.tid, S, E);
        if (l < 3) ctx_outproj_mini(c, WSP(bf16, WS_Y), W, E.xs_c, WSP(bf16, WS_XC), E.mod + 8 * 6144, E.bias);
    } break;
    case 6: if constexpr (PH_EN(8)) phase_route(c, l); break;
    case 7: if constexpr (PH_EN(9)) phase_gather(c, l); break;
    case 8: if constexpr (PH_EN(10)) {
        MoeOrder S; S.ul = moe_tiles(c, l, 3); S.A = WSP(bf16, WS_BIG + BIG_HS); S.Bt = WSP(bf16, WS_EXP_UP) + (size_t)l * 16 * 2048 * 1024; S.bstride = (size_t)2048 * 1024;
        EpiUp E; E.ACT = WSP(bf16, WS_BIG + BIG_ACT);
        gemm_run(c.lds, c.tid, S, E);
    } break;
    case 9: if constexpr (PH_EN(11)) {
        MoeOrder S; S.ul = moe_tiles(c, l, 2); S.A = WSP(bf16, WS_BIG + BIG_ACT); S.Bt = WSP(bf16, WS_EXP_DN) + (size_t)l * 16 * 1024 * 1024; S.bstride = (size_t)1024 * 1024;
        EpiDown E; E.YS = WSP(bf16, WS_BIG + BIG_HS);
        gemm_run(c.lds, c.tid, S, E);
    } break;
    case 10: if constexpr (PH_EN(12)) phase_combine(c, l); break;
    }
}

__global__ void __launch_bounds__(512, 2) mega_fwd(Params p) {
    extern __shared__ __attribute__((aligned(16))) unsigned char lds_raw[];
#if XCD_BARRIER
    {
        volatile LAS unsigned* st0 = (volatile LAS unsigned*)((LAS unsigned char*)lds_raw + BAR_LDS_OFF);
        if (threadIdx.x == 0) { st0[0] = 0u; st0[1] = 0u; (void)xb_add((unsigned*)(p.ws + WS_CTL) + CW_BAR + XB_XCNT(xb_xcc_id()), 1u); }
        __syncthreads();
    }
#endif
    bool first = true;
    int rep = 0;
    unsigned long long tp_acc = 0, tp_prev = 0; bool tp_sel = false;
    for (int ph = p.ph_lo; ph < p.ph_hi;) {
        if (!phase_active(ph)) { ++ph; continue; }
        int z; asm volatile("s_mov_b32 %0, 0" : "=s"(z));
        if (!first) {
#if XCD_BARRIER
            xcd_barrier((unsigned*)(p.ws + z + WS_CTL) + CW_BAR, (volatile LAS unsigned*)((LAS unsigned char*)lds_raw + BAR_LDS_OFF));
#else
            cg::this_grid().sync();
#endif
        }
        first = false;
        Ctx c;
        c.lds = (LAS unsigned char*)lds_raw;
        c.tid = threadIdx.x + z; c.lane = c.tid & 63; c.wave = __builtin_amdgcn_readfirstlane(c.tid >> 6);
        c.gw = blockIdx.x * 8 + c.wave; c.ngw = gridDim.x * 8;
        c.in = (const float* const __attribute__((address_space(4)))*)__builtin_amdgcn_kernarg_segment_ptr() + z; c.out = p.out + z; c.ws = p.ws + z; c.z = (unsigned)z;
        if (TP_MASK != 0u) {
            const unsigned long long now = __builtin_amdgcn_s_memrealtime();
            if (tp_sel) tp_acc += now - tp_prev;
            tp_prev = now; tp_sel = (ph >= 2 ? (((TP_MASK >> ((ph - 2) % 11)) & 1u) && ((TP_LAYERS >> ((ph - 2) / 11)) & 1u)) : ((TP_MASK >> (16 + ph)) & 1u));
        }
        run_phase(c, ph);
        if (REP_MASK != 0u && rep == 0 && (ph >= 2 ? (((REP_MASK >> ((ph - 2) % 11)) & 1u) && ((REP_LAYERS >> ((ph - 2) / 11)) & 1u)) : ((REP_MASK >> (16 + ph)) & 1u))) rep = 1; else { rep = 0; ++ph; }
    }
    if (TP_MASK != 0u && blockIdx.x == 0) { asm volatile("s_waitcnt vmcnt(0)" ::: "memory"); __syncthreads(); const unsigned long long now = __builtin_amdgcn_s_memrealtime(); if (tp_sel) tp_acc += now - tp_prev;
        const unsigned long long t_end = now + (unsigned long long)TP_AMP * tp_acc; while (__builtin_amdgcn_s_memrealtime() < t_end) __builtin_amdgcn_s_sleep(8); }
}

extern "C" void kernel_launch(void* const* d_in, const int* in_sizes, int n_in, void* d_out, int out_size, void* d_ws, size_t ws_size, hipStream_t stream) {
    static int grid = 0;
    if (grid == 0) {
        if (n_in != 40 || ws_size < WS_END || out_size != TL * D) { fprintf(stderr, "kernel_launch: unexpected shapes (n_in %d, ws %zu, out %d)\n", n_in, ws_size, out_size); grid = -1; return; }
        int dev = 0, cus = 0, per_cu = 0;
        hipGetDevice(&dev); hipDeviceGetAttribute(&cus, hipDeviceAttributeMultiprocessorCount, dev);
        if (hipFuncSetAttribute((const void*)mega_fwd, hipFuncAttributeMaxDynamicSharedMemorySize, LDS_BYTES) != hipSuccess) { fprintf(stderr, "kernel_launch: hipFuncSetAttribute failed\n"); grid = -1; return; }
        if (hipOccupancyMaxActiveBlocksPerMultiprocessor(&per_cu, (const void*)mega_fwd, 512, LDS_BYTES) != hipSuccess || per_cu < 1) { fprintf(stderr, "kernel_launch: occupancy query says %d\n", per_cu); per_cu = 1; }
        (void)hipGetLastError();
        grid = cus;
        fprintf(stderr, "kernel_launch: grid %d (cus %d, per_cu %d)\n", grid, cus, per_cu);
    }
    if (grid < 0) return;
    hipMemsetAsync((char*)d_ws + WS_CTL, 0, 1 * MiB, stream);
    Params p{};
    for (int i = 0; i < 40; ++i) p.in[i] = (const float*)d_in[i];
    p.out = (float*)d_out; p.ws = (unsigned char*)d_ws;
#if N_LAUNCH_PER_PHASE
    for (int ph = 0; ph < NPHASE; ++ph) {
        if (!phase_active(ph)) continue;
        p.ph_lo = ph; p.ph_hi = ph + 1; void* args[] = {&p};
        hipError_t e = hipLaunchCooperativeKernel((const void*)mega_fwd, dim3(grid), dim3(512), args, LDS_BYTES, stream);
        if (e != hipSuccess) { fprintf(stderr, "launch failed: %s\n", hipGetErrorString(e)); break; }
    }
#else
    p.ph_lo = 0; p.ph_hi = NPHASE; void* args[] = {&p};
    hipError_t e = hipLaunchCooperativeKernel((const void*)mega_fwd, dim3(grid), dim3(512), args, LDS_BYTES, stream);
    if (e != hipSuccess) fprintf(stderr, "cooperative launch failed: %s (grid %d)\n", hipGetErrorString(e), grid);
#endif
}
```

```cpp
#include <hip/hip_runtime.h>
#include <hip/hip_cooperative_groups.h>
#include <cstdio>
#include <cstdint>
namespace cg = cooperative_groups;

#define LAS __attribute__((address_space(3)))
#define DI __device__ __forceinline__
typedef unsigned short bf16;
typedef float f32x4 __attribute__((ext_vector_type(4)));
typedef float f32x2 __attribute__((ext_vector_type(2)));
typedef unsigned u32x4 __attribute__((ext_vector_type(4)));
typedef unsigned u32x2 __attribute__((ext_vector_type(2)));
typedef short bf16x8 __attribute__((ext_vector_type(8)));

#ifndef FAST_GEMM
#define FAST_GEMM 1
#endif
#ifndef MLSTM_CHUNK
#define MLSTM_CHUNK 1
#endif
#ifndef GLA_CHUNK
#define GLA_CHUNK 1
#endif
#ifndef HY_MFMA
#define HY_MFMA 1
#endif
#ifndef XCD_BARRIER
#define XCD_BARRIER 1
#endif
#ifndef HY_DIRECT_B
#define HY_DIRECT_B 1
#endif
#ifndef PH_MASK
#define PH_MASK 0xFFFFFFFFu
#endif
#define PH_EN(b) ((PH_MASK >> (b)) & 1u)
#ifndef TP_MASK
#define TP_MASK 0u
#endif
#ifndef TP_LAYERS
#define TP_LAYERS 0xFu
#endif
#define TP_AMP 4
#ifndef REP_LAYERS
#define REP_LAYERS 0xFu
#endif
#ifndef REP_MASK
#define REP_MASK 0u
#endif
#ifndef N_LAUNCH_PER_PHASE
#define N_LAUNCH_PER_PHASE 0
#endif

constexpr int D = 1024, NB = 8, SEQ = 2048, CTX = 256, DEPTH = 4;
constexpr int TC = NB * CTX, TL = NB * SEQ, TT = TC + TL;
constexpr int NEXP = 16;
constexpr int PLD = 3072;
constexpr int NINP = 3328;
constexpr float EPS = 1e-6f;
constexpr int MAXSLOT = 40960;

constexpr size_t MiB = 1u << 20;
constexpr size_t WS_CTL = 0;
constexpr size_t WS_MOD = 1 * MiB;
constexpr size_t WS_HM = 2 * MiB;
constexpr size_t WS_TOK = 3 * MiB;
constexpr size_t WS_RWT = 3 * MiB + 944 * 1024;
constexpr size_t WS_HF = 4 * MiB;
constexpr size_t WS_HFC = 20 * MiB;
constexpr size_t WS_ML_WIN = 32 * MiB;
constexpr size_t WS_ML_WOUT = 45 * MiB;
constexpr size_t WS_GLA_WIN = 49 * MiB;
constexpr size_t WS_GLA_WOUT = 56 * MiB;
constexpr size_t WS_HY_WIN = 58 * MiB;
constexpr size_t WS_HY_WOUT = 64 * MiB;
constexpr size_t WS_EXP_UP = 66 * MiB;
constexpr size_t WS_EXP_DN = 322 * MiB;
constexpr size_t WS_X = 450 * MiB;
constexpr size_t WS_XC = 514 * MiB;
constexpr size_t WS_H = 522 * MiB;
constexpr size_t WS_P = 558 * MiB;
constexpr size_t WS_EXTRA = 667 * MiB;
constexpr size_t WS_Y = 670 * MiB;
constexpr size_t WS_BIG = 706 * MiB;
constexpr size_t WS_END = 1024 * MiB;
constexpr size_t BIG_HS = 0;
constexpr size_t BIG_ACT = 80 * MiB;
constexpr size_t BIG_PC = 0;
constexpr size_t BIG_YF = 108 * MiB;
constexpr size_t BIG_YB = 180 * MiB;

constexpr size_t BIG_MCT = 108 * MiB;
constexpr size_t BIG_MN = 180 * MiB;

constexpr size_t BIG_GB = 72 * MiB;
constexpr size_t BIG_GST = 144 * MiB;

constexpr size_t BIG_ZTL = 108 * MiB;
constexpr size_t BIG_ZTC = 140 * MiB;
constexpr size_t BIG_YTL = 144 * MiB;
constexpr size_t BIG_YTC = 176 * MiB;

constexpr int CW_CNT = 1024;
constexpr int CW_BAR = 4096;

constexpr int LDS_BYTES = 148480;
constexpr int BAR_LDS_OFF = 147456;
constexpr int MISC_OFF = 131072;

struct Params {
    const float* in[40];
    float* out;
    unsigned char* ws;
    int ph_lo, ph_hi;
};
static_assert(__builtin_offsetof(Params, in) == 0, "the input pointer table must be the first kernel argument bytes");
enum { I_X = 0, I_C, I_CTX, I_CCTX, I_ADAW, I_ADAB, I_N1G, I_N2G, I_FING, I_MLWIN, I_MLBG, I_MLCW, I_MLCB, I_MLNG, I_MLWOUT,
       I_GLWIN, I_GLCW, I_GLCB, I_GLW2, I_GLGB, I_GLNG, I_GLWOUT, I_HYWIN, I_HYBIN, I_HYCW, I_HYCB, I_HYFW1, I_HYFB1, I_HYFWM, I_HYFBM,
       I_HYFWO, I_HYFREQ, I_HYSKIP, I_HYWOUT, I_HYBOUT, I_RW, I_RB, I_EW1, I_EW3, I_EW2 };

DI float bf2f(bf16 v) { return __uint_as_float(((unsigned)v) << 16); }
typedef __bf16 b16x2_t __attribute__((ext_vector_type(2)));
DI unsigned cvt_pk_bf16(float lo, float hi) { const f32x2 v = {lo, hi}; const b16x2_t r = __builtin_convertvector(v, b16x2_t); return __builtin_bit_cast(unsigned, r); }
DI bf16 f2bf(float f) { return (bf16)(cvt_pk_bf16(f, 0.f) & 0xffffu); }
DI float sigmoidf_(float x) { return __builtin_amdgcn_rcpf(1.0f + __expf(-x)); }
DI float siluf_(float x) { return x * __builtin_amdgcn_rcpf(1.0f + __expf(-x)); }
DI float logsigf_(float x) { return fminf(x, 0.f) - __logf(1.0f + __expf(-fabsf(x))); }
DI void lds_barrier() { asm volatile("s_waitcnt lgkmcnt(0)" ::: "memory"); __builtin_amdgcn_s_barrier(); asm volatile("" ::: "memory"); }
DI float shx_(float v, int m) {
    const int x = __float_as_int(v); int r;
    switch (m) {
    case 1:  r = __builtin_amdgcn_update_dpp(0, x, 0xB1, 0xf, 0xf, true); break;
    case 2:  r = __builtin_amdgcn_update_dpp(0, x, 0x4E, 0xf, 0xf, true); break;
    case 4:  r = __builtin_amdgcn_ds_swizzle(x, 0x101F); break;
    case 8:  r = __builtin_amdgcn_update_dpp(0, x, 0x128, 0xf, 0xf, true); break;
    case 16: r = __builtin_amdgcn_ds_swizzle(x, 0x401F); break;
    default: { int idx = ((int)__builtin_amdgcn_mbcnt_hi(~0u, __builtin_amdgcn_mbcnt_lo(~0u, 0u)) ^ 32) << 2; asm volatile("" : "+v"(idx)); r = __builtin_amdgcn_ds_bpermute(idx, x); } break;
    }
    return __int_as_float(r);
}
DI float wave_sum(float v) {
#pragma unroll
    for (int o = 1; o < 64; o <<= 1) v += shx_(v, o);
    return v;
}
DI void unpack8(const u32x4 w, float (&v)[8]) {
    v[0] = __uint_as_float(w.x << 16); v[1] = __uint_as_float(w.x & 0xffff0000u);
    v[2] = __uint_as_float(w.y << 16); v[3] = __uint_as_float(w.y & 0xffff0000u);
    v[4] = __uint_as_float(w.z << 16); v[5] = __uint_as_float(w.z & 0xffff0000u);
    v[6] = __uint_as_float(w.w << 16); v[7] = __uint_as_float(w.w & 0xffff0000u);
}
DI u32x4 pack8(const float (&v)[8]) { u32x4 w; w.x = cvt_pk_bf16(v[0], v[1]); w.y = cvt_pk_bf16(v[2], v[3]); w.z = cvt_pk_bf16(v[4], v[5]); w.w = cvt_pk_bf16(v[6], v[7]); return w; }
DI void seq_bounds(int row, int& lo, int& hi) {
    if (row < TC) { lo = row & ~(CTX - 1); hi = lo + CTX - 1; } else { lo = TC + ((row - TC) & ~(SEQ - 1)); hi = lo + SEQ - 1; }
}
DI int perm_fwd(int s) { return (s & 63) * 32 + (s >> 6); }
DI int perm_inv(int sp) { return (sp & 31) * 64 + (sp >> 5); }

namespace pg8 {
constexpr int BM = 256, BK = 64, HALF = 128, HTB = HALF * BK * 2, STAGE_BYTES = 8 * HTB, NXCD = 8, WGM = 8;
__host__ __device__ __forceinline__ int lds_byte(int r, int c) { const int st = (r >> 4) * 2 + (c >> 5), rr = r & 15, cc = c & 31, ob = rr * 64 + cc * 2; return st * 1024 + (ob ^ (((ob >> 9) & 1) << 5)); }
__host__ __device__ __forceinline__ void stage_rc(int b, int& R, int& C) { const int st = b / 1024, sb = b % 1024, swz = sb ^ (((sb >> 9) & 1) << 5); R = (st >> 1) * 16 + swz / 64; C = (st & 1) * 32 + (swz % 64) / 2; }
__host__ __device__ __forceinline__ int perm32(int rho) { const int n = rho >> 4, i = rho & 15; return 8 * (i >> 2) + 4 * n + (i & 3); }
}
struct Unit { int pm, pn, e; };

DI LAS int* dense_units(LAS unsigned char* lds, int tid, int M, int N) {
    LAS int* ul = (LAS int*)(lds + MISC_OFF) + 192;
    __syncthreads();
    if (tid < 32) {
        const int nM = M / 256, nN = N / 256, nwg = nM * nN, G = gridDim.x, L = tid * G + (int)blockIdx.x; int w = -1;
        if (L < nwg) {
            int wgid = L; { const int q = nwg / 8, r = nwg % 8, xcd = wgid % 8, off = wgid / 8; wgid = (xcd < r ? xcd * (q + 1) : r * (q + 1) + (xcd - r) * q) + off; }
            const int nig = 8 * nN, gid = wgid / nig, fm = gid * 8, gsz = (nM - fm) < 8 ? (nM - fm) : 8;
            w = (fm + ((wgid % nig) % gsz)) | (((wgid % nig) / gsz) << 12);
        }
        ul[tid] = w;
    }
    __syncthreads();
    return ul;
}
struct DenseOrder {
    const bf16* A; const bf16* Bt; const LAS int* ul;
    DI bool next(int i, Unit& u) const {
        const int w = __builtin_amdgcn_readfirstlane(ul[i]); if (w < 0) return false;
        u.pm = w & 0xfff; u.pn = (w >> 12) & 0xf; u.e = 0; return true;
    }
    DI const bf16* aptr(const Unit& u) const { return A + (size_t)u.pm * 256 * 1024; }
    DI const bf16* bptr(const Unit& u) const { return Bt + (size_t)u.pn * 256 * 1024; }
};
struct MoeOrder {
    const bf16* A; const bf16* Bt; size_t bstride; const LAS int* ul;
    DI bool next(int i, Unit& u) const {
        const int w = __builtin_amdgcn_readfirstlane(ul[i]); if (w < 0) return false;
        u.pm = w & 0xfff; u.pn = (w >> 12) & 0xf; u.e = w >> 16; return true;
    }
    DI const bf16* aptr(const Unit& u) const { return A + (size_t)u.pm * 256 * 1024; }
    DI const bf16* bptr(const Unit& u) const { return Bt + (size_t)u.e * bstride + (size_t)u.pn * 256 * 1024; }
};

struct EpiInproj {
    static constexpr bool PAIR = false, BATCHED = false;
    bf16* P; float* extra; const float* bias; const float* bias_x;
    DI void row8(const Unit& u, int r, int c, const float (&v)[8]) const {
        const int row = u.pm * 256 + r, col = u.pn * 256 + c;
        if (col < PLD) {
            float w[8];
#pragma unroll
            for (int j = 0; j < 8; ++j) w[j] = v[j] + (bias ? bias[col + j] : 0.f);
            *(u32x4*)(P + (size_t)row * PLD + col) = pack8(w);
        } else if (col < PLD + 32) {
            float* o = extra + (size_t)row * 32 + (col - PLD);
#pragma unroll
            for (int j = 0; j < 8; ++j) o[j] = v[j] + (bias_x ? bias_x[col - PLD + j] : 0.f);
        }
    }
};
struct EpiOutproj {
    static constexpr bool PAIR = false, BATCHED = true;
    const float* xs_l; const float* xs_c; bf16* X; bf16* XC; const float* mod; const float* bias; int row_off; int perm;
    DI size_t off(const Unit& u, int r, int col) const {
        const int rr = u.pm * 256 + r + row_off - TC, b = rr >> 11, sp = rr & (SEQ - 1), s = perm ? perm_inv(sp) : sp; return ((size_t)b * SEQ + s) * D + col; }
    DI void tile(const f32x4 (&acc)[2][2][4][2], const Unit& u, int wr, int wc, int fr, int fq) const {
        const int b = (u.pm * 256 + row_off - TC) >> 11; const float* g1p = mod + b * 6144 + 2048;
        const int rr0 = u.pm * 256 + row_off - TC, sp0 = rr0 & (SEQ - 1);
        const int d_ai = perm ? 4 : 128, d_m1 = perm ? 1024 : 16, d_m2 = perm ? 1 : 32;
        const unsigned voff = (unsigned)((perm ? fr * 64 + wr * 2 : wr * 64 + fr) * D + wc * 32 + 8 * fq);
        const size_t ubase = ((size_t)b * SEQ + (perm ? (sp0 >> 5) : sp0)) * D + u.pn * 256;
#define OPJ_OFF(bj_, ai_, m_) ((size_t)((ai_) * d_ai + ((m_) & 1) * d_m1 + ((m_) >> 1) * d_m2) * D + (bj_) * 128)
#pragma unroll
        for (int bj = 0; bj < 2; ++bj) {
            char* Xu = (char*)(X + ubase); float g1[8], bs[8];
            if (xs_l) {
                const char* Su = (const char*)(xs_l + ubase); f32x4 rf[2][4][2];
#pragma unroll
                for (int ai = 0; ai < 2; ++ai)
#pragma unroll
                    for (int m = 0; m < 4; ++m) { const char* p = Su + OPJ_OFF(bj, ai, m) * 4 + voff * 4u; rf[ai][m][0] = *(const f32x4*)p; rf[ai][m][1] = *(const f32x4*)(p + 16); }
                { const int col = u.pn * 256 + bj * 128 + wc * 32 + 8 * fq;
#pragma unroll
                    for (int j = 0; j < 8; ++j) { g1[j] = g1p[col + j]; bs[j] = bias ? bias[col + j] : 0.f; } }
#pragma unroll
                for (int ai = 0; ai < 2; ++ai)
#pragma unroll
                    for (int m = 0; m < 4; ++m) { float w[8];
#pragma unroll
                        for (int j = 0; j < 8; ++j) w[j] = rf[ai][m][j >> 2][j & 3] + g1[j] * (acc[ai][bj][m][j >> 2][j & 3] + bs[j]);
                        *(u32x4*)(Xu + OPJ_OFF(bj, ai, m) * 2 + voff * 2u) = pack8(w); }
            } else {
                u32x4 raw[2][4];
#pragma unroll
                for (int ai = 0; ai < 2; ++ai)
#pragma unroll
                    for (int m = 0; m < 4; ++m) raw[ai][m] = *(const u32x4*)(Xu + OPJ_OFF(bj, ai, m) * 2 + voff * 2u);
                { const int col = u.pn * 256 + bj * 128 + wc * 32 + 8 * fq;
#pragma unroll
                    for (int j = 0; j < 8; ++j) { g1[j] = g1p[col + j]; bs[j] = bias ? bias[col + j] : 0.f; } }
#pragma unroll
                for (int ai = 0; ai < 2; ++ai)
#pragma unroll
                    for (int m = 0; m < 4; ++m) { float xo[8], w[8];
                        unpack8(raw[ai][m], xo);
#pragma unroll
                        for (int j = 0; j < 8; ++j) w[j] = xo[j] + g1[j] * (acc[ai][bj][m][j >> 2][j & 3] + bs[j]);
                        *(u32x4*)(Xu + OPJ_OFF(bj, ai, m) * 2 + voff * 2u) = pack8(w); }
            }
            asm volatile("" ::: "memory");
        }
#undef OPJ_OFF
    }
    DI void row8(const Unit& u, int r, int c, const float (&v)[8]) const {
        const int col = u.pn * 256 + c; const size_t o = off(u, r, col); const int b = (u.pm * 256 + row_off - TC) >> 11;
        float a[8];
        if (xs_l) { const f32x4 a0 = *(const f32x4*)(xs_l + o), a1 = *(const f32x4*)(xs_l + o + 4); a[0] = a0.x; a[1] = a0.y; a[2] = a0.z; a[3] = a0.w; a[4] = a1.x; a[5] = a1.y; a[6] = a1.z; a[7] = a1.w; }
        else unpack8(*(const u32x4*)(X + o), a);
        const float* g1 = mod + b * 6144 + 2048 + col; float w[8];
#pragma unroll
        for (int j = 0; j < 8; ++j) w[j] = a[j] + g1[j] * (v[j] + (bias ? bias[col + j] : 0.f));
        *(u32x4*)(X + o) = pack8(w);
    }
};
struct EpiUp {
    static constexpr bool PAIR = true, BATCHED = false;
    bf16* ACT;
    DI void row8p(const Unit& u, int r, int c, const float (&g)[8], const float (&up)[8]) const {
        float w[8];
#pragma unroll
        for (int j = 0; j < 8; ++j) w[j] = siluf_(g[j]) * up[j];
        *(u32x4*)(ACT + ((size_t)u.pm * 256 + r) * 1024 + u.pn * 128 + c) = pack8(w);
    }
};
struct EpiDown {
    static constexpr bool PAIR = false, BATCHED = false;
    bf16* YS;
    DI void row8(const Unit& u, int r, int c, const float (&v)[8]) const { *(u32x4*)(YS + ((size_t)u.pm * 256 + r) * 1024 + u.pn * 256 + c) = pack8(v); }
};

template <class Sched, class Epi>
DI void gemm_fast(LAS unsigned char* lds, int tid, const Sched& S, const Epi& E) {
    using namespace pg8;
    constexpr int K = 1024, nt = K / BK;
    const int wid = __builtin_amdgcn_readfirstlane(tid >> 6), lane = tid & 63, wr = wid >> 2, wc = wid & 3, fr = lane & 15, fq = lane >> 4;
    unsigned voffA[2], voffB[2];
#pragma unroll
    for (int i = 0; i < 2; ++i) { int R, C; stage_rc(tid * 16 + i * 8192, R, C); const int Rb = (R & ~31) + perm32(R & 31);
        voffA[i] = (unsigned)(R * K + C) * 2u; voffB[i] = (unsigned)(Rb * K + C) * 2u; }
    const size_t kstep = (size_t)(BK * 2);
    const size_t hstep = (size_t)HALF * K * 2;
    const unsigned ldsw = (unsigned)wid * 1024u;
    const int aoff = lds_byte(wr * 64 + fr, fq * 8), boff = lds_byte(wc * 32 + fr, fq * 8);
#define PG8_SA(b, h) (((b) * 2 + (h)) * HTB)
#define PG8_SB(b, h) ((4 + (b) * 2 + (h)) * HTB)
#define PG8_STAGE(bufoff, gbase, voff) do { _Pragma("unroll") for (int _i = 0; _i < 2; ++_i) \
        __builtin_amdgcn_global_load_lds((const unsigned*)((const char*)(gbase) + (voff)[_i]), (LAS unsigned*)(lds + (bufoff) + ldsw + _i * 8192), 16, 0, 0); } while (0)
#define PG8_LDA(dst, b, h) do { _Pragma("unroll") for (int m = 0; m < 4; ++m) _Pragma("unroll") for (int k = 0; k < 2; ++k) dst[m][k] = *(const LAS bf16x8*)(lds + PG8_SA(b, h) + aoff + m * 2048 + k * 1024); } while (0)
#define PG8_LDB(dst, b, h) do { _Pragma("unroll") for (int n = 0; n < 2; ++n) _Pragma("unroll") for (int k = 0; k < 2; ++k) dst[n][k] = *(const LAS bf16x8*)(lds + PG8_SB(b, h) + boff + n * 2048 + k * 1024); } while (0)
#define PG8_MMA(ai, bj, At, Bt) do { __builtin_amdgcn_s_setprio(1); _Pragma("unroll") for (int m = 0; m < 4; ++m) _Pragma("unroll") for (int n = 0; n < 2; ++n) _Pragma("unroll") for (int k = 0; k < 2; ++k) \
        acc[ai][bj][m][n] = __builtin_amdgcn_mfma_f32_16x16x32_bf16(Bt[n][k], At[m][k], acc[ai][bj][m][n], 0, 0, 0); __builtin_amdgcn_s_setprio(0); } while (0)
#define PG8_WAIT_V(n) asm volatile("s_waitcnt vmcnt(" #n ")" ::: "memory")
#define PG8_WAIT_L(n) asm volatile("s_waitcnt lgkmcnt(" #n ")" ::: "memory")
#define PG8_BAR __builtin_amdgcn_s_barrier()
#define PG8_SCHED __builtin_amdgcn_sched_barrier(0)
    Unit cur, nxt; int ui = 0;
    if (!S.next(0, cur)) return;
    f32x4 acc[2][2][4][2];
#pragma unroll
    for (int a = 0; a < 2; ++a)
#pragma unroll
        for (int b = 0; b < 2; ++b)
#pragma unroll
            for (int m = 0; m < 4; ++m)
#pragma unroll
                for (int n = 0; n < 2; ++n) acc[a][b][m][n] = (f32x4){0.f, 0.f, 0.f, 0.f};
    bf16x8 At[4][2], B0[2][2], B1[2][2];
    const char* cA = (const char*)S.aptr(cur); const char* cB = (const char*)S.bptr(cur);
    PG8_STAGE(PG8_SB(0, 0), cB, voffB); PG8_STAGE(PG8_SA(0, 0), cA, voffA); PG8_STAGE(PG8_SB(0, 1), cB + hstep, voffB); PG8_STAGE(PG8_SA(0, 1), cA + hstep, voffA);
    if (wr == 1) PG8_BAR;
    PG8_WAIT_V(4); PG8_BAR;
    PG8_STAGE(PG8_SB(1, 0), cB + kstep, voffB); PG8_STAGE(PG8_SA(1, 0), cA + kstep, voffA); PG8_STAGE(PG8_SB(1, 1), cB + hstep + kstep, voffB);
    PG8_WAIT_V(6); PG8_BAR;
    for (;;) {
        const bool has_next = S.next(ui + 1, nxt);
        const char* nA = has_next ? (const char*)S.aptr(nxt) : cA; const char* nB = has_next ? (const char*)S.bptr(nxt) : cB;
        for (int t = 0; t < nt; t += 2) {
            const bool last = (t == nt - 2);
            const char* a1 = cA + (size_t)(t + 1) * kstep;
            const char* a2 = last ? nA : cA + (size_t)(t + 2) * kstep; const char* b2 = last ? nB : cB + (size_t)(t + 2) * kstep;
            const char* a3 = a2 + kstep; const char* b3 = b2 + kstep;
            PG8_LDB(B0, 0, 0); PG8_SCHED; PG8_LDA(At, 0, 0); PG8_STAGE(PG8_SA(1, 1), a1 + hstep, voffA);
            PG8_WAIT_L(8); PG8_BAR; PG8_WAIT_L(0); PG8_MMA(0, 0, At, B0); PG8_BAR; PG8_SCHED;
            PG8_LDB(B1, 0, 1); PG8_STAGE(PG8_SB(0, 0), b2, voffB);
            PG8_BAR; PG8_WAIT_L(0); PG8_MMA(0, 1, At, B1); PG8_BAR;
            PG8_LDA(At, 0, 1); PG8_STAGE(PG8_SA(0, 0), a2, voffA);
            PG8_BAR; PG8_WAIT_L(0); PG8_MMA(1, 0, At, B0); PG8_BAR; PG8_SCHED;
            PG8_STAGE(PG8_SB(0, 1), b2 + hstep, voffB);
            PG8_WAIT_V(6); PG8_BAR; PG8_MMA(1, 1, At, B1); PG8_BAR;
            PG8_LDB(B0, 1, 0); PG8_SCHED; PG8_LDA(At, 1, 0); PG8_STAGE(PG8_SA(0, 1), a2 + hstep, voffA);
            PG8_WAIT_L(8); PG8_BAR; PG8_WAIT_L(0); PG8_MMA(0, 0, At, B0); PG8_BAR; PG8_SCHED;
            PG8_LDB(B1, 1, 1); PG8_STAGE(PG8_SB(1, 0), b3, voffB);
            PG8_BAR; PG8_WAIT_L(0); PG8_MMA(0, 1, At, B1); PG8_BAR;
            PG8_LDA(At, 1, 1); PG8_STAGE(PG8_SA(1, 0), a3, voffA);
            PG8_BAR; PG8_WAIT_L(0); PG8_MMA(1, 0, At, B0); PG8_BAR; PG8_SCHED;
            PG8_STAGE(PG8_SB(1, 1), b3 + hstep, voffB);
            PG8_WAIT_V(6); PG8_BAR; PG8_MMA(1, 1, At, B1); PG8_BAR;
        }
        int efr = fr, efq = fq; asm volatile("" : "+v"(efr), "+v"(efq));
        if constexpr (Epi::BATCHED) E.tile(acc, cur, wr, wc, efr, efq); else
#pragma unroll
        for (int ai = 0; ai < 2; ++ai)
#pragma unroll
            for (int m = 0; m < 4; ++m) {
                const int r = ai * HALF + wr * 64 + m * 16 + efr;
                if constexpr (Epi::PAIR) {
                    const float g[8] = {acc[ai][0][m][0][0], acc[ai][0][m][0][1], acc[ai][0][m][0][2], acc[ai][0][m][0][3], acc[ai][0][m][1][0], acc[ai][0][m][1][1], acc[ai][0][m][1][2], acc[ai][0][m][1][3]};
                    const float up[8] = {acc[ai][1][m][0][0], acc[ai][1][m][0][1], acc[ai][1][m][0][2], acc[ai][1][m][0][3], acc[ai][1][m][1][0], acc[ai][1][m][1][1], acc[ai][1][m][1][2], acc[ai][1][m][1][3]};
                    E.row8p(cur, r, wc * 32 + 8 * efq, g, up);
                } else {
#pragma unroll
                    for (int bj = 0; bj < 2; ++bj) {
                        const float v[8] = {acc[ai][bj][m][0][0], acc[ai][bj][m][0][1], acc[ai][bj][m][0][2], acc[ai][bj][m][0][3], acc[ai][bj][m][1][0], acc[ai][bj][m][1][1], acc[ai][bj][m][1][2], acc[ai][bj][m][1][3]};
                        E.row8(cur, r, bj * HALF + wc * 32 + 8 * efq, v);
                    }
                }
            }
        if (!has_next) break;
#pragma unroll
        for (int a = 0; a < 2; ++a)
#pragma unroll
            for (int b = 0; b < 2; ++b)
#pragma unroll
                for (int m = 0; m < 4; ++m)
#pragma unroll
                    for (int n = 0; n < 2; ++n) acc[a][b][m][n] = (f32x4){0.f, 0.f, 0.f, 0.f};
        cur = nxt; cA = nA; cB = nB; ++ui;
    }
    PG8_WAIT_V(0);
    if (wr == 0) PG8_BAR;
    PG8_BAR;
#undef PG8_SA
#undef PG8_SB
#undef PG8_STAGE
#undef PG8_LDA
#undef PG8_LDB
#undef PG8_MMA
#undef PG8_WAIT_V
#undef PG8_WAIT_L
#undef PG8_BAR
#undef PG8_SCHED
}

template <class Sched, class Epi>
DI void gemm_naive(LAS unsigned char* lds, int tid, const Sched& S, const Epi& E) {
    LAS float* As = (LAS float*)lds;
    LAS float* Bs = As + 32 * 132;
    LAS float* Bu = Bs + 32 * 132;
    const int ty = tid >> 4, tx = tid & 15, lr = tid >> 2, kq = tid & 3;
    Unit u;
    for (int i = 0; S.next(i, u); ++i) {
        const bf16* A = S.aptr(u); const bf16* B = S.bptr(u);
        for (int sm = 0; sm < 2; ++sm)
            for (int sn = 0; sn < (Epi::PAIR ? 1 : 2); ++sn) {
                float acc[4][8], accu[4][8];
#pragma unroll
                for (int a = 0; a < 4; ++a)
#pragma unroll
                    for (int b = 0; b < 8; ++b) { acc[a][b] = 0.f; accu[a][b] = 0.f; }
                for (int k0 = 0; k0 < 1024; k0 += 32) {
                    __syncthreads();
                    { float w[8]; unpack8(*(const u32x4*)(A + (size_t)(128 * sm + lr) * 1024 + k0 + 8 * kq), w);
#pragma unroll
                      for (int j = 0; j < 8; ++j) As[(8 * kq + j) * 132 + lr] = w[j];
                      unpack8(*(const u32x4*)(B + (size_t)(128 * sn + lr) * 1024 + k0 + 8 * kq), w);
#pragma unroll
                      for (int j = 0; j < 8; ++j) Bs[(8 * kq + j) * 132 + lr] = w[j];
                      if (Epi::PAIR) { unpack8(*(const u32x4*)(B + (size_t)(128 + lr) * 1024 + k0 + 8 * kq), w);
#pragma unroll
                          for (int j = 0; j < 8; ++j) Bu[(8 * kq + j) * 132 + lr] = w[j]; } }
                    __syncthreads();
#pragma unroll 4
                    for (int k = 0; k < 32; ++k) {
                        const f32x4 a4 = *(const LAS f32x4*)(As + k * 132 + 4 * ty);
                        const f32x4 b0 = *(const LAS f32x4*)(Bs + k * 132 + 8 * tx), b1 = *(const LAS f32x4*)(Bs + k * 132 + 8 * tx + 4);
#pragma unroll
                        for (int a = 0; a < 4; ++a) {
#pragma unroll
                            for (int b = 0; b < 4; ++b) { acc[a][b] += a4[a] * b0[b]; acc[a][4 + b] += a4[a] * b1[b]; } }
                        if (Epi::PAIR) {
                            const f32x4 c0 = *(const LAS f32x4*)(Bu + k * 132 + 8 * tx), c1 = *(const LAS f32x4*)(Bu + k * 132 + 8 * tx + 4);
#pragma unroll
                            for (int a = 0; a < 4; ++a) {
#pragma unroll
                                for (int b = 0; b < 4; ++b) { accu[a][b] += a4[a] * c0[b]; accu[a][4 + b] += a4[a] * c1[b]; } }
                        }
                    }
                }
#pragma unroll
                for (int a = 0; a < 4; ++a) {
                    if constexpr (Epi::PAIR) E.row8p(u, 128 * sm + 4 * ty + a, 8 * tx, acc[a], accu[a]);
                    else E.row8(u, 128 * sm + 4 * ty + a, 128 * sn + 8 * tx, acc[a]);
                }
            }
    }
    __syncthreads();
}
template <class Sched, class Epi>
DI void gemm_run(LAS unsigned char* lds, int tid, const Sched& S, const Epi& E) {
#if FAST_GEMM
    gemm_fast(lds, tid, S, E);
#else
    gemm_naive(lds, tid, S, E);
#endif
}

struct Ctx {
    LAS unsigned char* lds;
    int tid, lane, wave, gw, ngw;
    unsigned z;
    const float* const __attribute__((address_space(4)))* in;
    float* out;
    unsigned char* ws;
};
#define WSP(T, off) ((T*)(c.ws + (off)))

DI void transpose_item(const float* W, int N, bf16* WT, int k0, int n0, int dst_row0, LAS float* scr, int lane) {
#pragma unroll 8
    for (int i = 0; i < 32; ++i) { const int kk = 2 * i + (lane >> 5); scr[kk * 33 + (lane & 31)] = __builtin_nontemporal_load(W + (size_t)(k0 + kk) * N + n0 + (lane & 31)); }
    asm volatile("s_waitcnt lgkmcnt(0)" ::: "memory");
    const int cc = lane & 7;
#pragma unroll
    for (int j = 0; j < 4; ++j) { const int n = (lane >> 3) + 8 * j; const LAS float* s = scr + (8 * cc) * 33 + n;
        u32x4 o; o.x = cvt_pk_bf16(s[0 * 33], s[1 * 33]); o.y = cvt_pk_bf16(s[2 * 33], s[3 * 33]); o.z = cvt_pk_bf16(s[4 * 33], s[5 * 33]); o.w = cvt_pk_bf16(s[6 * 33], s[7 * 33]);
        *(u32x4*)(WT + (size_t)(dst_row0 + n) * 1024 + k0 + 8 * cc) = o; }
    asm volatile("s_waitcnt lgkmcnt(0)" ::: "memory");
}
DI void dense_transpose(const Ctx& c, const float* W, int N, bf16* WT, LAS float* scr, int& dealt) {
    const int nblk = N / 32, nitems = 16 * nblk;
    int first = c.gw - dealt % c.ngw; if (first < 0) first += c.ngw;
    for (int it = first; it < nitems; it += c.ngw) { const int kb = it / nblk, nb = it % nblk; transpose_item(W, N, WT, 64 * kb, 32 * nb, 32 * nb, scr, c.lane); }
    dealt += nitems;
}
DI void phase_pro0(const Ctx& c) {
    LAS float* scr = (LAS float*)(c.lds + c.wave * 8704);
    int dealt = 0;
    for (int j = 0; j < 2; ++j) {
        dense_transpose(c, c.in[I_MLWIN] + (size_t)j * 1024 * 3104, 3104, WSP(bf16, WS_ML_WIN) + (size_t)j * NINP * 1024, scr, dealt);
        dense_transpose(c, c.in[I_MLWOUT] + (size_t)j * 1024 * 1024, 1024, WSP(bf16, WS_ML_WOUT) + (size_t)j * 1024 * 1024, scr, dealt);
    }
    dense_transpose(c, c.in[I_GLWIN], 3104, WSP(bf16, WS_GLA_WIN), scr, dealt);
    dense_transpose(c, c.in[I_GLWOUT], 1024, WSP(bf16, WS_GLA_WOUT), scr, dealt);
    dense_transpose(c, c.in[I_HYWIN], 3072, WSP(bf16, WS_HY_WIN), scr, dealt);
    dense_transpose(c, c.in[I_HYWOUT], 1024, WSP(bf16, WS_HY_WOUT), scr, dealt);
    for (int it = c.gw * 64 + c.lane; it < 3 * 28672; it += c.ngw * 64) {
        const int m = it / 28672, r = it % 28672; bf16* base = (m < 2) ? WSP(bf16, WS_ML_WIN) + (size_t)m * NINP * 1024 : WSP(bf16, WS_GLA_WIN);
        *(u32x4*)(base + (size_t)3104 * 1024 + (size_t)r * 8) = (u32x4){c.z, c.z, c.z, c.z};
    }
    for (int it = c.gw; it < 64 * 3 * 512; it += c.ngw) {
        const int le = it / 1536, r0 = it % 1536, which = r0 / 512, r = r0 % 512, kb = r / 32, nb = r % 32;
        if (which < 2) {
            const float* W = c.in[which == 0 ? I_EW1 : I_EW3] + (size_t)le * 1024 * 1024;
            const int n0 = 32 * nb, drow = 256 * (n0 >> 7) + (n0 & 127) + (which ? 128 : 0);
            transpose_item(W, 1024, WSP(bf16, WS_EXP_UP) + (size_t)le * 2048 * 1024, 64 * kb, n0, drow, scr, c.lane);
        } else {
            transpose_item(c.in[I_EW2] + (size_t)le * 1024 * 1024, 1024, WSP(bf16, WS_EXP_DN) + (size_t)le * 1024 * 1024, 64 * kb, 32 * nb, 32 * nb, scr, c.lane);
        }
    }
    for (int i = blockIdx.x * 512 + c.tid; i < 16 * 1024; i += gridDim.x * 512) WSP(float, WS_RWT)[i] = c.in[I_RW][(i & 1023) * 16 + (i >> 10)];
    {
        const float* w1 = c.in[I_HYFW1]; const float* b1 = c.in[I_HYFB1]; const float* wm = c.in[I_HYFWM]; const float* bm = c.in[I_HYFBM]; const float* fr = c.in[I_HYFREQ];
        float* HM = WSP(float, WS_HM);
        for (int row = c.gw; row < 2304; row += c.ngw) {
            const int L = row < 2048 ? 2048 : 256, t = row < 2048 ? row : row - 2048, f = c.lane;
            float feat = 0.f;
            if (f == 0) feat = (float)t / (float)(L - 1);
            else if (f <= 32) { const int b = (f - 1) & 15; const float band = 1e-4f + (float)b * ((15.0f - 1e-4f) / 15.0f);
                const float ang = ((float)(2.0 * 3.14159265358979323846 / (double)L) * (float)t) * band; feat = (f <= 16) ? cosf(ang) : -sinf(ang); }
#define PF_RL(v_, l_) __int_as_float(__builtin_amdgcn_readlane(__float_as_int(v_), (l_)))
            float a = b1[f];
#pragma unroll 11
            for (int e = 0; e < 33; ++e) a += PF_RL(feat, e) * w1[e * 64 + f];
            float h = sinf(fr[f] * a);
            for (int m = 0; m < 2; ++m) {
                float a2 = bm[m * 64 + f];
#pragma unroll 16
                for (int g = 0; g < 64; ++g) a2 += PF_RL(h, g) * wm[m * 4096 + g * 64 + f];
                h = sinf(fr[f] * a2);
            }
#undef PF_RL
            HM[row * 64 + f] = h;
        }
    }
    __syncthreads();
    {
        LAS float* sv = (LAS float*)c.lds;
        LAS float* red = sv + 9 * 1024;
        for (int i = c.tid; i < 9 * 1024; i += 512) { const float x = (i < 8192) ? c.in[I_C][i] : c.in[I_CCTX][i - 8192]; sv[i] = siluf_(x); }
        __syncthreads();
        float* MOD = WSP(float, WS_MOD);
        const int col = c.tid & 31, kg = c.tid >> 5;
        for (int item = blockIdx.x; item < 4 * 192; item += gridDim.x) {
            const int l = item / 192, j0 = 32 * (item % 192);
            const float* w = c.in[I_ADAW] + (size_t)l * 1024 * 6144 + j0 + col;
            float acc[9];
#pragma unroll
            for (int r = 0; r < 9; ++r) acc[r] = 0.f;
            for (int k = kg * 64; k < kg * 64 + 64; ++k) { const float wv = w[(size_t)k * 6144];
#pragma unroll
                for (int r = 0; r < 9; ++r) acc[r] += sv[r * 1024 + k] * wv; }
#pragma unroll
            for (int r = 0; r < 9; ++r) red[(kg * 9 + r) * 32 + col] = acc[r];
            __syncthreads();
            for (int o = c.tid; o < 9 * 32; o += 512) { const int r = o >> 5, cc = o & 31; float s = c.in[I_ADAB][l * 6144 + j0 + cc];
#pragma unroll
                for (int g = 0; g < 16; ++g) s += red[(g * 9 + r) * 32 + cc];
                MOD[(l * 9 + r) * 6144 + j0 + cc] = s; }
            __syncthreads();
        }
    }
}

template <int L>
DI void pro1_len(const Ctx& c, int c0, const float* hm, LAS float* rawb  , LAS float* hmT  , const LAS f32x4* wo4  , float (&part)[4]) {
    const int side = c.wave & 1, ts = c.wave >> 1;
    const float da = -4.605170185988091f / 1.5f, db = -4.605170185988091f / 0.3f;
    f32x4 pre[8];
#pragma unroll
    for (int k = 0; k < 8; ++k) { const int idx = c.tid + 512 * k, row = idx >> 4, q = idx & 15; pre[k] = *(const f32x4*)(hm + (size_t)row * 64 + 4 * q); }
#pragma unroll 1
    for (int t0 = 0; t0 < L; t0 += 256) {
        lds_barrier();
#pragma unroll
        for (int k = 0; k < 8; ++k) { const int idx = c.tid + 512 * k, row = idx >> 4, q = idx & 15; const f32x4 v = pre[k];
            LAS float* d = hmT + row * 65 + 4 * q; d[0] = v.x; d[1] = v.y; d[2] = v.z; d[3] = v.w; }
        if (t0 + 256 < L) {
#pragma unroll
            for (int k = 0; k < 8; ++k) { const int idx = c.tid + 512 * k, row = idx >> 4, q = idx & 15; pre[k] = *(const f32x4*)(hm + (size_t)(t0 + 256 + row) * 64 + 4 * q); } }
        lds_barrier();
        const int t = t0 + 64 * ts + c.lane; const LAS float* hr = hmT + (64 * ts + c.lane) * 65;
        f32x4 acc = {0.f, 0.f, 0.f, 0.f};
#pragma unroll 8
        for (int f = 0; f < 64; ++f) acc += wo4[side * 64 + f] * hr[f];
        const float tl = (float)t / (float)(L - 1);
#pragma unroll
        for (int ch = 0; ch < 4; ++ch) { const float delta = fabsf(da + (float)(c0 + ch) * ((db - da) / 1023.0f)); acc[ch] *= expf(-tl * delta);
            if (side == 0 || t >= 1) part[ch] += fabsf(acc[ch]); }
        *(LAS f32x4*)(rawb + ((t0 >> 8) * 512 + c.tid) * 4) = acc;
    }
}
template <int L>
DI void pro1_scale(const Ctx& c, int c0, float* tab, const LAS float* rawb, const float (&inv)[4]) {
    const int side = c.wave & 1, ts = c.wave >> 1;
#pragma unroll 1
    for (int t0 = 0; t0 < L; t0 += 256) { const int t = t0 + 64 * ts + c.lane; const f32x4 v = *(const LAS f32x4*)(rawb + ((t0 >> 8) * 512 + c.tid) * 4);
#pragma unroll
        for (int ch = 0; ch < 4; ++ch) { float* trow = tab + (size_t)(c0 + ch) * (2 * L); if (side == 0) trow[L + t] = v[ch] * inv[ch]; else if (t >= 1) trow[L - t] = v[ch] * inv[ch]; else trow[0] = 0.f; } }
}
DI void pro1_reduce(const Ctx& c, float (&part)[4], LAS float* red, float (&inv)[4]) {
#pragma unroll
    for (int ch = 0; ch < 4; ++ch) part[ch] = wave_sum(part[ch]);
    __syncthreads();
    if (c.lane == 0) {
#pragma unroll
        for (int ch = 0; ch < 4; ++ch) red[c.wave * 4 + ch] = part[ch]; }
    __syncthreads();
#pragma unroll
    for (int ch = 0; ch < 4; ++ch) { float s = 0.f;
#pragma unroll
        for (int w = 0; w < 8; ++w) s += red[w * 4 + ch];
        inv[ch] = 1.0f / s; }
}
DI void phase_pro1(const Ctx& c) {
    LAS float* hmT = (LAS float*)c.lds; LAS f32x4* wo4 = (LAS f32x4*)(c.lds + 67584); LAS float* red = (LAS float*)(c.lds + 67584 + 2048);
    const float* HM = WSP(float, WS_HM);
    for (int item = blockIdx.x; item < 256; item += gridDim.x) {
        const int c0 = 4 * item;
        __syncthreads();
        if (c.tid < 128) wo4[c.tid] = *(const f32x4*)(c.in[I_HYFWO] + (size_t)(c.tid & 63) * 2048 + (c.tid >> 6) * 1024 + c0);
        float part[4] = {0.f, 0.f, 0.f, 0.f}, inv[4];
        LAS float* rawb = (LAS float*)(c.lds + 71680);
        pro1_len<SEQ>(c, c0, HM, rawb, hmT, wo4, part);
        pro1_reduce(c, part, red, inv);
        pro1_scale<SEQ>(c, c0, WSP(float, WS_HF), rawb, inv);
        float part2[4] = {0.f, 0.f, 0.f, 0.f};
        pro1_len<CTX>(c, c0, HM + 2048 * 64, rawb, hmT, wo4, part2);
        pro1_reduce(c, part2, red, inv);
        pro1_scale<CTX>(c, c0, WSP(float, WS_HFC), rawb, inv);
    }
}

DI void load_row(const float* src, f32x4 (&v)[4], int lane) {
#pragma unroll
    for (int j = 0; j < 4; ++j) v[j] = *(const f32x4*)(src + 256 * j + 4 * lane);
}
DI void load_row_bf(const bf16* src, f32x4 (&v)[4], int lane) {
#pragma unroll
    for (int j = 0; j < 4; ++j) { const u32x2 a = *(const u32x2*)(src + 256 * j + 4 * lane);
        v[j] = (f32x4){__uint_as_float(a.x << 16), __uint_as_float(a.x & 0xffff0000u), __uint_as_float(a.y << 16), __uint_as_float(a.y & 0xffff0000u)}; }
}
DI void load_row_raw(const bf16* src, u32x2 (&r)[4], int lane) {
#pragma unroll
    for (int j = 0; j < 4; ++j) r[j] = *(const u32x2*)(src + 256 * j + 4 * lane);
}
DI void cvt_row_raw(const u32x2 (&r)[4], f32x4 (&v)[4]) {
#pragma unroll
    for (int j = 0; j < 4; ++j) v[j] = (f32x4){__uint_as_float(r[j].x << 16), __uint_as_float(r[j].x & 0xffff0000u), __uint_as_float(r[j].y << 16), __uint_as_float(r[j].y & 0xffff0000u)};
}
DI void norm_row(f32x4 (&v)[4], const float* g, int lane) {
    float s = 0.f;
#pragma unroll
    for (int j = 0; j < 4; ++j) s += (v[j].x * v[j].x + v[j].y * v[j].y) + (v[j].z * v[j].z + v[j].w * v[j].w);
    s = wave_sum(s);
    const float r = __builtin_amdgcn_rsqf(s * (1.0f / 1024.0f) + EPS);
#pragma unroll
    for (int j = 0; j < 4; ++j) v[j] = v[j] * r * *(const f32x4*)(g + 256 * j + 4 * lane);
}
DI void mod_row(f32x4 (&v)[4], const float* sh, const float* sc, int lane) {
#pragma unroll
    for (int j = 0; j < 4; ++j) v[j] = v[j] * (*(const f32x4*)(sc + 256 * j + 4 * lane) + 1.0f) + *(const f32x4*)(sh + 256 * j + 4 * lane);
}
DI void load_vec(const float* p, f32x4 (&w)[4], int lane) {
#pragma unroll
    for (int j = 0; j < 4; ++j) w[j] = *(const f32x4*)(p + 256 * j + 4 * lane);
}
DI void norm_mod_row_reg(f32x4 (&v)[4], const f32x4 (&g)[4], const f32x4 (&sh)[4], const f32x4 (&sc)[4]) {
    float s = 0.f;
#pragma unroll
    for (int j = 0; j < 4; ++j) s += (v[j].x * v[j].x + v[j].y * v[j].y) + (v[j].z * v[j].z + v[j].w * v[j].w);
    s = wave_sum(s);
    const float r = __builtin_amdgcn_rsqf(s * (1.0f / 1024.0f) + EPS);
#pragma unroll
    for (int j = 0; j < 4; ++j) v[j] = (v[j] * r * g[j]) * (sc[j] + 1.0f) + sh[j];
}
DI void store_row_bf16(bf16* dst, const f32x4 (&v)[4], int lane) {
#pragma unroll
    for (int j = 0; j < 4; ++j) { u32x2 w; w.x = cvt_pk_bf16(v[j].x, v[j].y); w.y = cvt_pk_bf16(v[j].z, v[j].w); *(u32x2*)(dst + 256 * j + 4 * lane) = w; }
}
DI int hrow_of(int srow, int kind) {
    if (srow < TC || kind != 1) return srow;
    const int rr = srow - TC, b = rr >> 11, s = rr & (SEQ - 1); return TC + b * SEQ + perm_fwd(s);
}
DI void phase_norm1(const Ctx& c, int l, const float* xl, const float* xc) {
    const float* MOD = WSP(float, WS_MOD) + (size_t)l * 9 * 6144; const float* g = c.in[I_N1G] + l * D; bf16* H = WSP(bf16, WS_H);
    const int per = (TT + c.ngw - 1) / c.ngw, rfirst = c.gw * per, rend = min(rfirst + per, TT);
    f32x4 vA[4] = {}, vB[4] = {}, gv[4], shv[4] = {}, scv[4] = {}; int mr_cur = -1; load_vec(g, gv, c.lane);
    if (rfirst < rend) { const int r = rfirst; load_row(r < TC ? xc + (size_t)r * D : xl + (size_t)(r - TC) * D, vA, c.lane); }
    if (rfirst + 1 < rend) { const int r = rfirst + 1; load_row(r < TC ? xc + (size_t)r * D : xl + (size_t)(r - TC) * D, vB, c.lane); }
    for (int row = rfirst; row < rend; ++row) {
        f32x4 v[4]; const int mr = row < TC ? 8 : (row - TC) >> 11;
        if (mr != mr_cur) { load_vec(MOD + mr * 6144, shv, c.lane); load_vec(MOD + mr * 6144 + 1024, scv, c.lane); mr_cur = mr; }
#pragma unroll
        for (int j = 0; j < 4; ++j) { v[j] = vA[j]; vA[j] = vB[j]; }
        if (row + 2 < rend) { const int r = row + 2; load_row(r < TC ? xc + (size_t)r * D : xl + (size_t)(r - TC) * D, vB, c.lane); }
        norm_mod_row_reg(v, gv, shv, scv);
        store_row_bf16(H + (size_t)hrow_of(row, l % 3) * D, v, c.lane);
    }
}

DI void phase_conv(const Ctx& c, int ncols, const float* cw, const float* cb, bool act, float qs) {
    constexpr int CV_PD = 4;
    const bf16* P = WSP(bf16, WS_P); bf16* PC = WSP(bf16, WS_BIG + BIG_PC);
    const int ncb = ncols >> 9, nrun = c.ngw / ncb, cbk = c.gw % ncb, run = c.gw / ncb;
    const int per = (TT + nrun - 1) / nrun, r0 = run * per, r1 = min(r0 + per, TT);
    if (run < nrun && r0 < r1) {
        const int col = cbk * 512 + 8 * c.lane;
        float w0[8], w1[8], w2[8], bb[8];
#pragma unroll
        for (int j = 0; j < 8; ++j) { w0[j] = cw[col + j]; w1[j] = cw[ncols + col + j]; w2[j] = cw[2 * ncols + col + j]; bb[j] = cb[col + j]; }
        const float sc = col < 512 ? qs : 1.0f;
#define CV_LD(r_) (*(const u32x4*)(P + (size_t)min(max((r_), 0), TT - 1) * PLD + col))
        float xm[8], x0[8], xp[8]; u32x4 q[CV_PD];
        { const u32x4 a = CV_LD(r0 - 1), b = CV_LD(r0), d = CV_LD(r0 + 1);
#pragma unroll
          for (int k = 0; k < CV_PD; ++k) q[k] = CV_LD(r0 + 2 + k);
          unpack8(a, xm); unpack8(b, x0); unpack8(d, xp); }
        for (int row = r0; row < r1; ++row) {
            int lo, hi; seq_bounds(row, lo, hi);
            const bool hm = row > lo, hp = row < hi;
            float o[8];
#pragma unroll
            for (int j = 0; j < 8; ++j) { float v = w0[j] * (hm ? xm[j] : 0.f) + w1[j] * x0[j] + w2[j] * (hp ? xp[j] : 0.f) + bb[j];
                if (act) v = siluf_(v); o[j] = v * sc; }
            *(u32x4*)(PC + (size_t)row * ncols + col) = pack8(o);
#pragma unroll
            for (int j = 0; j < 8; ++j) { xm[j] = x0[j]; x0[j] = xp[j]; }
            unpack8(q[0], xp);
#pragma unroll
            for (int k = 0; k + 1 < CV_PD; ++k) q[k] = q[k + 1];
            if (row + 2 + CV_PD <= r1) q[CV_PD - 1] = CV_LD(row + 2 + CV_PD);
        }
#undef CV_LD
    }
}

DI int scan_row(int step, int b, int dir) {
    if (step < CTX) return b * CTX + (dir ? CTX - 1 - step : step);
    const int s = step - CTX; return TC + b * SEQ + (dir ? SEQ - 1 - s : s);
}
DI void phase_mlstm_scan_naive(const Ctx& c) {
    const bf16* P = WSP(bf16, WS_P); const bf16* PC = WSP(bf16, WS_BIG + BIG_PC); const float* EX = WSP(float, WS_EXTRA);
    LAS float* qs = (LAS float*)c.lds; LAS float* ks = qs + 32 * 64; LAS float* vs = ks + 32 * 64; LAS float* gs = vs + 32 * 128;
    const int v = c.tid >> 2, d0 = (c.tid & 3) * 16;
    for (int item = blockIdx.x; item < 128; item += gridDim.x) {
        const int b = item >> 4, h = (item >> 1) & 7, dir = item & 1;
        float* Yo = WSP(float, WS_BIG + (dir ? BIG_YB : BIG_YF));
        float C[16], n[16];
#pragma unroll
        for (int d = 0; d < 16; ++d) { C[d] = 0.f; n[d] = 0.f; }
        for (int ch = 0; ch < (CTX + SEQ) / 32; ++ch) {
            __syncthreads();
            for (int idx = c.tid; idx < 32 * 256; idx += 512) { const int st = idx >> 8, col = idx & 255, row = scan_row(ch * 32 + st, b, dir);
                if (col < 64) qs[st * 64 + col] = bf2f(PC[(size_t)row * 1024 + h * 64 + col]);
                else if (col < 128) ks[st * 64 + col - 64] = bf2f(PC[(size_t)row * 1024 + 512 + h * 64 + col - 64]);
                else vs[st * 128 + col - 128] = bf2f(P[(size_t)row * PLD + 1024 + h * 128 + col - 128]); }
            if (c.tid < 32) { const int row = scan_row(ch * 32 + c.tid, b, dir); gs[c.tid * 2] = sigmoidf_(EX[(size_t)row * 32 + dir * 16 + 8 + h]); gs[c.tid * 2 + 1] = __expf(EX[(size_t)row * 32 + dir * 16 + h]); }
            __syncthreads();
            for (int st = 0; st < 32; ++st) {
                const float f = gs[st * 2], ei = gs[st * 2 + 1], vv = vs[st * 128 + v] * ei;
                float part = 0.f, dpart = 0.f;
#pragma unroll
                for (int d = 0; d < 16; ++d) { const float kd = ks[st * 64 + d0 + d], qd = qs[st * 64 + d0 + d];
                    C[d] = f * C[d] + kd * vv; part += qd * C[d]; n[d] = f * n[d] + ei * kd; dpart += qd * n[d]; }
                part += shx_(part, 1); part += shx_(part, 2); dpart += shx_(dpart, 1); dpart += shx_(dpart, 2);
                if ((c.tid & 3) == 0) { const int row = scan_row(ch * 32 + st, b, dir); Yo[(size_t)row * D + h * 128 + v] = part / fmaxf(fabsf(dpart), 1.0f); }
            }
        }
    }
}
typedef short s16x4 __attribute__((ext_vector_type(4)));
typedef float f32x16 __attribute__((ext_vector_type(16)));
#define MFMA32(a, b, c) __builtin_amdgcn_mfma_f32_32x32x16_bf16((a), (b), (c), 0, 0, 0)
DI int crow(int reg, int h) { return (reg & 3) + 8 * (reg >> 2) + 4 * h; }
DI s16x4 ds_tr(const LAS unsigned char* p) { return __builtin_amdgcn_ds_read_tr16_b64_v4i16((LAS s16x4*)p); }
DI bf16x8 cat8(s16x4 lo, s16x4 hi) { return __builtin_shufflevector(lo, hi, 0, 1, 2, 3, 4, 5, 6, 7); }
DI bf16x8 tr_frag(const LAS unsigned char* img, int pitch, int k0, int n0, int lane) {
    const int h = lane >> 5, g16 = (lane >> 4) & 1, i = lane & 15;
    const LAS unsigned char* p = img + (k0 + 8 * h + (i >> 2)) * pitch + (n0 + 16 * g16 + 4 * (i & 3)) * 2;
    return cat8(ds_tr(p), ds_tr(p + 4 * pitch));
}
DI bf16x8 tr_frag_perm(const LAS unsigned char* img, int pitch, int k0, int n0, int lane) {
    const int h = lane >> 5, g16 = (lane >> 4) & 1, i = lane & 15;
    const LAS unsigned char* p = img + (k0 + 4 * h + (i >> 2)) * pitch + (n0 + 16 * g16 + 4 * (i & 3)) * 2;
    return cat8(ds_tr(p), ds_tr(p + 8 * pitch));
}
DI bf16x8 row_frag(const LAS unsigned char* img, int pitch, int row0, int k0, int lane) { return *(const LAS bf16x8*)(img + (row0 + (lane & 31)) * pitch + (k0 + 8 * (lane >> 5)) * 2); }
DI bf16x8 pack_acc(const f32x16& x, int step) {
    u32x4 p; const int o = 8 * step;
    p.x = cvt_pk_bf16(x[o], x[o + 1]); p.y = cvt_pk_bf16(x[o + 2], x[o + 3]); p.z = cvt_pk_bf16(x[o + 4], x[o + 5]); p.w = cvt_pk_bf16(x[o + 6], x[o + 7]);
    return __builtin_bit_cast(bf16x8, p);
}
DI f32x16 zero16() { f32x16 z;
#pragma unroll
    for (int i = 0; i < 16; ++i) z[i] = 0.f; return z; }
DI float wave_incl_prefix(float x, int lane) {
#pragma unroll
    for (int o = 1; o < 64; o <<= 1) { const float t = __shfl_up(x, o); if (lane >= o) x += t; }
    return x;
}
DI float wave_incl_suffix(float x, int lane) {
#pragma unroll
    for (int o = 1; o < 64; o <<= 1) { const float t = __shfl_down(x, o); if (lane + o < 64) x += t; }
    return x;
}
DI int chunk_row0(int p, int b, int dir) {
    if (p < 4) return b * CTX + 64 * (dir ? 3 - p : p);
    return TC + b * SEQ + 64 * (dir ? 35 - p : p - 4);
}

DI void phase_mlstm_state(const Ctx& c) {
    const bf16* P = WSP(bf16, WS_P); const bf16* PC = WSP(bf16, WS_BIG + BIG_PC); const float* EX = WSP(float, WS_EXTRA);
    bf16* MCT = WSP(bf16, WS_BIG + BIG_MCT); float* MN = WSP(float, WS_BIG + BIG_MN);
    LAS float* gi = (LAS float*)c.lds; LAS float* ga = gi + 2304;
    LAS unsigned char* Kw = c.lds + 20480; LAS unsigned char* Vs = Kw + 64 * 144;
    LAS float* wvall = (LAS float*)(c.lds + 57344); LAS float* decall = wvall + 2304;
    LAS float* npart = (LAS float*)(c.lds + 86528);
    LAS float* nstL = (LAS float*)(c.lds + 86016);
    const int lane = c.lane, wave = c.wave, h5 = lane >> 5, l31 = lane & 31;
    for (int it0 = blockIdx.x; it0 < 256; it0 += gridDim.x) {
        const int item = (gridDim.x == 256) ? ((it0 & 7) * 32 + (it0 >> 3)) : it0;
        const int b = item >> 5, h = (item >> 2) & 7, dir = (item >> 1) & 1, dvh = item & 1, seq = (b * 8 + h) * 2 + dir;
        __syncthreads();
        for (int idx = c.tid; idx < 2304; idx += 512) { const int row = chunk_row0(idx >> 6, b, dir) + (idx & 63);
            gi[idx] = EX[(size_t)row * 32 + dir * 16 + h]; ga[idx] = logsigf_(EX[(size_t)row * 32 + dir * 16 + 8 + h]); }
        f32x16 acc = zero16(); float nst = 0.f;
        const int dt = wave & 1, vt = (wave >> 1) & 1;
        const int srow = c.tid >> 3, spc = c.tid & 7;
        u32x4 kregA, vregA, kregB, vregB, kregC, vregC, kregD, vregD;
#define ML_PREFETCH(p_, kr, vr) do { const int r0_ = chunk_row0((p_), b, dir); \
          kr = *(const u32x4*)(PC + (size_t)(r0_ + srow) * 1024 + 512 + h * 64 + 8 * spc); \
          vr = *(const u32x4*)(P + (size_t)(r0_ + srow) * PLD + 1024 + h * 128 + dvh * 64 + 8 * spc); } while (0)
        ML_PREFETCH(0, kregA, vregA); ML_PREFETCH(1, kregB, vregB); ML_PREFETCH(2, kregC, vregC); ML_PREFETCH(3, kregD, vregD);
        __syncthreads();
        for (int p = wave; p < 36; p += 8) {
            const float a = ga[p * 64 + lane]; const float bj = dir ? wave_incl_suffix(a, lane) : wave_incl_prefix(a, lane);
            const float tot = __shfl(bj, dir ? 0 : 63);
            wvall[p * 64 + lane] = __expf(tot - bj + gi[p * 64 + lane]); if (lane == 0) decall[p] = __expf(tot);
        }
        __syncthreads();
#define ML_B(p, kreg, vreg) do { if ((p) < 36) { float kk[8]; unpack8(kreg, kk); const float w = wvall[(p) * 64 + srow]; \
            _Pragma("unroll") for (int j = 0; j < 8; ++j) kk[j] *= w; \
            *(LAS u32x4*)(Kw + ((p) & 1) * 18432 + srow * 144 + spc * 16) = pack8(kk); *(LAS u32x4*)(Vs + ((p) & 1) * 18432 + srow * 144 + spc * 16) = vreg; } \
            ML_PREFETCH(min((p) + 4, 35), kreg, vreg); } while (0)
#define ML_C(p) do { LAS unsigned char* T = c.lds + 67584 + ((p) & 1) * 9216; \
            if (wave < 4) { \
                _Pragma("unroll") for (int q = 0; q < 4; ++q) { u32x2 w; w.x = cvt_pk_bf16(acc[4 * q], acc[4 * q + 1]); w.y = cvt_pk_bf16(acc[4 * q + 2], acc[4 * q + 3]); \
                    *(LAS u32x2*)(T + (32 * vt + l31) * 144 + (32 * dt + 4 * h5 + 8 * q) * 2) = w; } \
            } else if (wave == 4) { \
                if ((p) > 0) { const LAS float* np = npart + (((p) - 1) & 1) * 256 + lane; nst = decall[(p) - 1] * nst + ((np[0] + np[64]) + (np[128] + np[192])); }     \
                nstL[((p) & 1) * 64 + lane] = nst; } \
            if (wave < 4) { \
                const float d = decall[(p)]; \
                _Pragma("unroll") for (int i = 0; i < 16; ++i) acc[i] *= d; \
                _Pragma("unroll") for (int kk = 0; kk < 4; ++kk) acc = MFMA32(tr_frag(Kw + ((p) & 1) * 18432, 144, 16 * kk, 32 * dt, lane), tr_frag(Vs + ((p) & 1) * 18432, 144, 16 * kk, 32 * vt, lane), acc); \
            } else { \
                float s = 0.f; const LAS unsigned char* kq = Kw + ((p) & 1) * 18432 + (16 * (wave - 4)) * 144 + lane * 2; \
                _Pragma("unroll") for (int r = 0; r < 16; ++r) s += bf2f(*(const LAS bf16*)(kq + r * 144)); \
                npart[((p) & 1) * 256 + (wave - 4) * 64 + lane] = s; \
            } } while (0)
#define ML_G(p) do { const LAS unsigned char* T = c.lds + 67584 + ((p) & 1) * 9216; \
            *(u32x4*)(MCT + ((size_t)seq * 36 + (p)) * 8192 + dvh * 4096 + c.tid * 8) = *(const LAS u32x4*)(T + srow * 144 + spc * 16); \
            MN[((size_t)seq * 36 + (p)) * 64 + lane] = nstL[((p) & 1) * 64 + lane]; } while (0)
        ML_B(0, kregA, vregA);
        lds_barrier();
        for (int p = 0; p < 36; p += 4) {
            ML_B(p + 1, kregB, vregB); ML_G(max(p - 1, 0)); ML_C(p); lds_barrier();
            ML_B(p + 2, kregC, vregC); ML_G(p); ML_C(p + 1); lds_barrier();
            ML_B(p + 3, kregD, vregD); ML_G(p + 1); ML_C(p + 2); lds_barrier();
            ML_B(p + 4, kregA, vregA); ML_G(p + 2); ML_C(p + 3); lds_barrier();
        }
        ML_G(35);
#undef ML_G
#undef ML_B
#undef ML_C
#undef ML_PREFETCH
    }
}

DI void phase_mlstm_out(const Ctx& c, const float* ng, int nc0  ) {
    const bf16* P = WSP(bf16, WS_P); const bf16* PC = WSP(bf16, WS_BIG + BIG_PC); const float* EX = WSP(float, WS_EXTRA);
    const bf16* MCT = WSP(bf16, WS_BIG + BIG_MCT); const float* MN = WSP(float, WS_BIG + BIG_MN); bf16* Y = WSP(bf16, WS_Y);
    LAS unsigned char* Qs = c.lds; LAS unsigned char* Ks = Qs + 9216; LAS unsigned char* Vs = Ks + 9216;
    LAS unsigned char* CT0 = Vs + 17408;
    LAS float* gt = (LAS float*)(c.lds + MISC_OFF + 1024);
    LAS float* YO = (LAS float*)c.lds;
    const int lane = c.lane, wave = c.wave, h5 = lane >> 5, l31 = lane & 31;
    const int dir = wave >> 2, jt = (wave >> 1) & 1, vh = wave & 1;
    const int srow = c.tid >> 3, spc = c.tid & 7;
    u32x4 pq, pk, pv[2], pct[4], pgate[2]; float pga = 0.f, pgi = 0.f, pgn = 0.f;
#define MO_DECODE(it_) const int bh = nc0 ? ((it_) >> 5) : ((it_) / 36), b = bh >> 3, h = bh & 7, cc = nc0 ? 4 + ((it_) & 31) : (it_) - 36 * bh; \
        const int r0 = cc < 4 ? b * CTX + 64 * cc : TC + b * SEQ + 64 * (cc - 4); const int pf = cc, pb = cc < 4 ? 3 - cc : 39 - cc
#define MO_PREFETCH(it_) do { MO_DECODE(it_); \
        pq = *(const u32x4*)(PC + (size_t)(r0 + srow) * 1024 + h * 64 + 8 * spc); pk = *(const u32x4*)(PC + (size_t)(r0 + srow) * 1024 + 512 + h * 64 + 8 * spc); \
        _Pragma("unroll") for (int i = 0; i < 2; ++i) pv[i] = *(const u32x4*)(P + (size_t)(r0 + srow) * PLD + 1024 + h * 128 + 8 * (spc + 8 * i)); \
        _Pragma("unroll") for (int i = 0; i < 4; ++i) { const int pc = c.tid + 512 * i, d2 = pc >> 10, rr = (pc >> 3) & 127, sp = pc & 7; \
            pct[i] = *(const u32x4*)(MCT + (((size_t)((b * 8 + h) * 2 + d2)) * 36 + (d2 ? pb : pf)) * 8192 + rr * 64 + 8 * sp); } \
        _Pragma("unroll") for (int i = 0; i < 2; ++i) pgate[i] = *(const u32x4*)(P + (size_t)(r0 + srow) * PLD + 2048 + h * 128 + 16 * spc + 8 * i); \
        if (wave < 2) { const int d2 = wave, row = r0 + lane; pga = EX[(size_t)row * 32 + d2 * 16 + 8 + h]; pgi = EX[(size_t)row * 32 + d2 * 16 + h]; \
            pgn = MN[(((size_t)((b * 8 + h) * 2 + d2)) * 36 + (d2 ? pb : pf)) * 64 + lane]; } } while (0)
    LAS float* ngs = (LAS float*)(c.lds + MISC_OFF + 4096);
    const int nitem = nc0 ? 64 * 32 : 64 * 36;
    if ((int)blockIdx.x < nitem) MO_PREFETCH((int)blockIdx.x);
    for (int i = c.tid; i < 1024; i += 512) ngs[i] = ng[i];
    for (int item = blockIdx.x; item < nitem; item += gridDim.x) {
        MO_DECODE(item); (void)pf; (void)pb;
        lds_barrier();
        *(LAS u32x4*)(Qs + srow * 144 + spc * 16) = pq; *(LAS u32x4*)(Ks + srow * 144 + spc * 16) = pk;
#pragma unroll
        for (int i = 0; i < 2; ++i) *(LAS u32x4*)(Vs + srow * 272 + (spc + 8 * i) * 16) = pv[i];
#pragma unroll
        for (int i = 0; i < 4; ++i) { const int pc = c.tid + 512 * i, d2 = pc >> 10, rr = (pc >> 3) & 127, sp = pc & 7; *(LAS u32x4*)(CT0 + d2 * 18432 + rr * 144 + sp * 16) = pct[i]; }
        if (wave < 2) { const int d2 = wave; const float a = logsigf_(pga);
            const float bj = d2 ? wave_incl_suffix(a, lane) : wave_incl_prefix(a, lane);
            gt[d2 * 192 + lane] = bj; gt[d2 * 192 + 64 + lane] = pgi - bj; gt[d2 * 192 + 128 + lane] = pgn; }
        const u32x4 gate0 = pgate[0], gate1 = pgate[1];
        if (item + (int)gridDim.x < nitem) MO_PREFETCH(item + (int)gridDim.x);
        lds_barrier();
        const LAS float* g = gt + dir * 192; const LAS unsigned char* CT = CT0 + dir * 18432;
        const int j = 32 * jt + l31; const float bjj = g[j];
        bf16x8 qf[4];
#pragma unroll
        for (int kk = 0; kk < 4; ++kk) qf[kk] = row_frag(Qs, 144, 32 * jt, 16 * kk, lane);
        float qn = 0.f;
#pragma unroll
        for (int kk = 0; kk < 4; ++kk) { float qv[8]; unpack8(__builtin_bit_cast(u32x4, qf[kk]), qv);
#pragma unroll
            for (int e = 0; e < 8; ++e) qn += qv[e] * g[128 + 16 * kk + 8 * h5 + e]; }
        qn += shx_(qn, 32);
        f32x16 X[2]; float den = 0.f;
#pragma unroll
        for (int st = 0; st < 2; ++st) {
            X[st] = zero16();
            const bool live = dir ? (st >= jt) : (st <= jt);
            if (live) {
#pragma unroll
                for (int kk = 0; kk < 4; ++kk) X[st] = MFMA32(row_frag(Ks, 144, 32 * st, 16 * kk, lane), qf[kk], X[st]);
#pragma unroll
                for (int r = 0; r < 16; ++r) { const int s = 32 * st + crow(r, h5); const bool ok = dir ? (s >= j) : (s <= j);
                    const float w = ok ? __expf(bjj + g[64 + s]) : 0.f; X[st][r] *= w; den += X[st][r]; }
            }
        }
        den += shx_(den, 32);
        const float eb = __expf(bjj); den += eb * qn;
        const float scale = __builtin_amdgcn_rcpf(fmaxf(fabsf(den), 1.0f));
        f32x16 O[2];
#pragma unroll
        for (int t = 0; t < 2; ++t) {
            const int vt = 2 * vh + t; f32x16 z = zero16(), w = zero16();
#pragma unroll
            for (int st = 0; st < 2; ++st) { const bool live = dir ? (st >= jt) : (st <= jt);
                if (live) {
#pragma unroll
                    for (int step = 0; step < 2; ++step) z = MFMA32(tr_frag_perm(Vs, 272, 32 * st + 16 * step, 32 * vt, lane), pack_acc(X[st], step), z); } }
#pragma unroll
            for (int kk = 0; kk < 4; ++kk) w = MFMA32(row_frag(CT, 144, 32 * vt, 16 * kk, lane), qf[kk], w);
#pragma unroll
            for (int r = 0; r < 16; ++r) O[t][r] = (z[r] + eb * w[r]) * scale;
        }
        lds_barrier();
#pragma unroll
        for (int t = 0; t < 2; ++t) { const int vt = 2 * vh + t;
#pragma unroll
            for (int q = 0; q < 4; ++q) *(LAS f32x4*)(YO + dir * 8448 + j * 132 + 32 * vt + 8 * q + 4 * h5) = (f32x4){O[t][4 * q], O[t][4 * q + 1], O[t][4 * q + 2], O[t][4 * q + 3]}; }
        lds_barrier();
        { const int row = c.tid >> 3, c0 = (c.tid & 7) * 16; float y[16]; float ss = 0.f;
#pragma unroll
          for (int q = 0; q < 4; ++q) { const f32x4 a = *(const LAS f32x4*)(YO + row * 132 + c0 + 4 * q), bb = *(const LAS f32x4*)(YO + 8448 + row * 132 + c0 + 4 * q);
              y[4 * q] = a.x + bb.x; y[4 * q + 1] = a.y + bb.y; y[4 * q + 2] = a.z + bb.z; y[4 * q + 3] = a.w + bb.w; }
#pragma unroll
          for (int q = 0; q < 16; ++q) ss += y[q] * y[q];
          ss += shx_(ss, 1); ss += shx_(ss, 2); ss += shx_(ss, 4);
          const float r = __builtin_amdgcn_rsqf(ss * (1.0f / 128.0f) + EPS);
          float g0[8], g1[8];
          unpack8(gate0, g0); unpack8(gate1, g1);
          float o0[8], o1[8];
#pragma unroll
          for (int q = 0; q < 8; ++q) { o0[q] = y[q] * r * ngs[h * 128 + c0 + q] * sigmoidf_(g0[q]); o1[q] = y[8 + q] * r * ngs[h * 128 + c0 + 8 + q] * sigmoidf_(g1[q]); }
          *(u32x4*)(Y + (size_t)(r0 + row) * D + h * 128 + c0) = pack8(o0); *(u32x4*)(Y + (size_t)(r0 + row) * D + h * 128 + c0 + 8) = pack8(o1); }
    }
#undef MO_PREFETCH
#undef MO_DECODE
}

DI void phase_gla_decay(const Ctx& c) {
    const float* EX = WSP(float, WS_EXTRA); float* GB = WSP(float, WS_BIG + BIG_GB);
    LAS float* w2s = (LAS float*)c.lds; LAS float* gbs = w2s + 2048; LAS float* lgs = gbs + 128; LAS float* segs = lgs + 8192;
    const int srow = c.tid >> 3, dg = c.tid & 7;
    const int dir = (blockIdx.x >> 2) & 1, h = blockIdx.x & 3, nper = gridDim.x >> 3;
    __syncthreads();
    for (int i = c.tid; i < 2048; i += 512) w2s[i] = c.in[I_GLW2][(size_t)dir * 8192 + (i >> 7) * 512 + h * 128 + (i & 127)];
    if (c.tid < 128) gbs[c.tid] = c.in[I_GLGB][dir * 512 + h * 128 + c.tid];
    f32x4 lown[4] = {};
    if ((int)(blockIdx.x >> 3) < 288) {
#pragma unroll
        for (int q = 0; q < 4; ++q) lown[q] = *(const f32x4*)(EX + (size_t)(64 * (blockIdx.x >> 3) + srow) * 32 + dir * 16 + 4 * q); }
    __syncthreads();
    for (int ck = blockIdx.x >> 3; ck < 288; ck += nper) {
        const int r0 = 64 * ck;
        lds_barrier();
        f32x4 low[4];
#pragma unroll
        for (int q = 0; q < 4; ++q) low[q] = lown[q];
        if (ck + nper < 288) {
#pragma unroll
            for (int q = 0; q < 4; ++q) lown[q] = *(const f32x4*)(EX + (size_t)(64 * (ck + nper) + srow) * 32 + dir * 16 + 4 * q); }
        { const int d0 = 16 * dg; float pre[16];
#pragma unroll
          for (int e = 0; e < 16; ++e) pre[e] = gbs[d0 + e];
#pragma unroll
          for (int r = 0; r < 16; ++r) { const float lv = low[r >> 2][r & 3];
#pragma unroll
              for (int q = 0; q < 4; ++q) { const f32x4 w = *(const LAS f32x4*)(w2s + r * 128 + d0 + 4 * q); pre[4 * q] += lv * w.x; pre[4 * q + 1] += lv * w.y; pre[4 * q + 2] += lv * w.z; pre[4 * q + 3] += lv * w.w; } }
#pragma unroll
          for (int q = 0; q < 4; ++q) *(LAS f32x4*)(lgs + srow * 128 + d0 + 4 * q) = (f32x4){logsigf_(pre[4 * q]) * 0.0625f, logsigf_(pre[4 * q + 1]) * 0.0625f, logsigf_(pre[4 * q + 2]) * 0.0625f, logsigf_(pre[4 * q + 3]) * 0.0625f}; }
        lds_barrier();
        { const int d = c.tid & 127, sg = c.tid >> 7; float v[16];
#pragma unroll
          for (int i = 0; i < 16; ++i) { const int s = dir ? 63 - (16 * sg + i) : 16 * sg + i; v[i] = lgs[s * 128 + d]; }
#pragma unroll
          for (int i = 1; i < 16; ++i) v[i] += v[i - 1];
          segs[sg * 128 + d] = v[15];
          lds_barrier();
          float off = 0.f;
#pragma unroll
          for (int g2 = 0; g2 < 3; ++g2) off += (g2 < sg) ? segs[g2 * 128 + d] : 0.f;
#pragma unroll
          for (int i = 0; i < 16; ++i) { const int s = dir ? 63 - (16 * sg + i) : 16 * sg + i; GB[((size_t)dir * TT + r0 + s) * 512 + h * 128 + d] = v[i] + off; } }
    }
}
DI void phase_gla_state(const Ctx& c) {
    const bf16* PC = WSP(bf16, WS_BIG + BIG_PC); const float* GB = WSP(float, WS_BIG + BIG_GB); bf16* GST = WSP(bf16, WS_BIG + BIG_GST);
    LAS float* tot = (LAS float*)c.lds;
    LAS unsigned char* Kd = c.lds + 1024; LAS unsigned char* Vs = Kd + 64 * 272;
    const int lane = c.lane, wave = c.wave, h5 = lane >> 5, l31 = lane & 31, dkt = wave & 3, dvt = wave >> 2;
    const int srow = c.tid >> 3, dg = c.tid & 7;
    for (int it0 = blockIdx.x; it0 < 256; it0 += gridDim.x) {
        const int item = (gridDim.x == 256) ? ((it0 & 7) * 32 + (it0 >> 3)) : it0;
        const int b = item >> 5, h = (item >> 3) & 3, dir = (item >> 2) & 1, dvq = item & 3, seq = (b * 4 + h) * 2 + dir;
        f32x16 acc = zero16();
        u32x4 kA0, kA1, vA, kB0, kB1, vB; f32x4 bvA[4], tvA[4], bvB[4], tvB[4];
#define GLA_PREFETCH(p_, k0, k1, vr, bv, tv) do { const int r0_ = chunk_row0((p_), b, dir), row = r0_ + srow; \
          k0 = *(const u32x4*)(PC + (size_t)row * 2048 + 512 + h * 128 + 16 * dg); k1 = *(const u32x4*)(PC + (size_t)row * 2048 + 512 + h * 128 + 16 * dg + 8); \
          vr = *(const u32x4*)(PC + (size_t)row * 2048 + 1024 + h * 256 + dvq * 64 + 8 * dg); \
          _Pragma("unroll") for (int q = 0; q < 4; ++q) { bv[q] = *(const f32x4*)(GB + ((size_t)dir * TT + row) * 512 + h * 128 + 16 * dg + 4 * q); \
              tv[q] = *(const f32x4*)(GB + ((size_t)dir * TT + r0_ + (dir ? 0 : 63)) * 512 + h * 128 + 16 * dg + 4 * q); } } while (0)
        GLA_PREFETCH(0, kA0, kA1, vA, bvA, tvA); GLA_PREFETCH(1, kB0, kB1, vB, bvB, tvB);
#define GLA_STEP(p, k0r, k1r, vr, bv, tv) do { \
            { bf16* dst = GST + ((size_t)seq * 36 + (p)) * 32768 + (size_t)(dvq * 64 + 32 * dvt + l31) * 128 + 32 * dkt + 4 * h5; \
              _Pragma("unroll") for (int q = 0; q < 4; ++q) { u32x2 w; w.x = cvt_pk_bf16(acc[4 * q], acc[4 * q + 1]); w.y = cvt_pk_bf16(acc[4 * q + 2], acc[4 * q + 3]); *(u32x2*)(dst + 8 * q) = w; } } \
            lds_barrier();                                    \
            { float kk[16]; { float t8[8]; unpack8(k0r, t8); \
                _Pragma("unroll") for (int e = 0; e < 8; ++e) kk[e] = t8[e]; unpack8(k1r, t8); \
                _Pragma("unroll") for (int e = 0; e < 8; ++e) kk[8 + e] = t8[e]; } \
              _Pragma("unroll") for (int e = 0; e < 16; ++e) kk[e] *= __expf(tv[e >> 2][e & 3] - bv[e >> 2][e & 3]); \
              const float k0[8] = {kk[0], kk[1], kk[2], kk[3], kk[4], kk[5], kk[6], kk[7]}, k1[8] = {kk[8], kk[9], kk[10], kk[11], kk[12], kk[13], kk[14], kk[15]}; \
              *(LAS u32x4*)(Kd + srow * 272 + dg * 32) = pack8(k0); *(LAS u32x4*)(Kd + srow * 272 + dg * 32 + 16) = pack8(k1); \
              *(LAS u32x4*)(Vs + srow * 144 + dg * 16) = vr; \
              if (srow == 0) { \
                  _Pragma("unroll") for (int q = 0; q < 4; ++q) *(LAS f32x4*)(tot + 16 * dg + 4 * q) = tv[q]; } } \
            if ((p) + 2 < 36) GLA_PREFETCH((p) + 2, k0r, k1r, vr, bv, tv); \
            lds_barrier(); \
            _Pragma("unroll") for (int r = 0; r < 16; ++r) acc[r] *= __expf(tot[32 * dkt + crow(r, h5)]); \
            _Pragma("unroll") for (int kk = 0; kk < 4; ++kk) acc = MFMA32(tr_frag(Kd, 272, 16 * kk, 32 * dkt, lane), tr_frag(Vs, 144, 16 * kk, 32 * dvt, lane), acc); \
            } while (0)
        for (int p = 0; p < 36; p += 2) { GLA_STEP(p, kA0, kA1, vA, bvA, tvA); GLA_STEP(p + 1, kB0, kB1, vB, bvB, tvB); }
#undef GLA_STEP
#undef GLA_PREFETCH
    }
}
DI void phase_gla_out(const Ctx& c, const float* ng) {
    const bf16* P = WSP(bf16, WS_P); const bf16* PC = WSP(bf16, WS_BIG + BIG_PC); const float* GB = WSP(float, WS_BIG + BIG_GB);
    const bf16* GST = WSP(bf16, WS_BIG + BIG_GST); bf16* Y = WSP(bf16, WS_Y);
    LAS unsigned char* Qt = c.lds; LAS unsigned char* Kt = Qt + 17408; LAS unsigned char* Vs = Kt + 17408; LAS unsigned char* STs = Vs + 33792;
    LAS float* YO = (LAS float*)STs;
    const int lane = c.lane, wave = c.wave, h5 = lane >> 5, l31 = lane & 31;
    const int srow = c.tid >> 3, dg = c.tid & 7;
    LAS float* ngs = (LAS float*)(c.lds + 139264);
    u32x4 pgst[8], pqk[4], pv[4], gcur[4]; f32x4 pgb[4];
#define GO_DECODE(it_) const int b = (it_) / 144, h = ((it_) / 36) & 3, cc = (it_) % 36; const int r0 = cc < 4 ? b * CTX + 64 * cc : TC + b * SEQ + 64 * (cc - 4)
#define GO_PREF_DIR(it_, dir_) do { GO_DECODE(it_); const int pslot = (dir_) ? (cc < 4 ? 3 - cc : 39 - cc) : cc; \
        const bf16* src = GST + ((size_t)((b * 4 + h) * 2 + (dir_)) * 36 + pslot) * 32768; \
        _Pragma("unroll") for (int i = 0; i < 8; ++i) { const int pc = c.tid + 512 * i, rr = pc >> 4, sp = pc & 15; pgst[i] = *(const u32x4*)(src + rr * 128 + 8 * sp); } \
        _Pragma("unroll") for (int q = 0; q < 4; ++q) pgb[q] = *(const f32x4*)(GB + ((size_t)(dir_) * TT + r0 + srow) * 512 + h * 128 + 16 * dg + 4 * q); } while (0)
#define GO_PREF_ITEM(it_) do { GO_DECODE(it_); const bf16* pr = PC + (size_t)(r0 + srow) * 2048; \
        pqk[0] = *(const u32x4*)(pr + h * 128 + 16 * dg); pqk[1] = *(const u32x4*)(pr + h * 128 + 16 * dg + 8); \
        pqk[2] = *(const u32x4*)(pr + 512 + h * 128 + 16 * dg); pqk[3] = *(const u32x4*)(pr + 512 + h * 128 + 16 * dg + 8); \
        _Pragma("unroll") for (int i = 0; i < 4; ++i) pv[i] = *(const u32x4*)(pr + 1024 + h * 256 + 8 * (dg + 8 * i)); } while (0)
    if ((int)blockIdx.x < 1152) { GO_PREF_ITEM((int)blockIdx.x); GO_PREF_DIR((int)blockIdx.x, 0); }
    for (int i = c.tid; i < 1024; i += 512) ngs[i] = ng[i];
    for (int item = blockIdx.x; item < 1152; item += gridDim.x) {
        GO_DECODE(item); (void)b;
        f32x16 O[2]; O[0] = zero16(); O[1] = zero16();
#pragma unroll
        for (int dir = 0; dir < 2; ++dir) {
            lds_barrier();
            if (dir == 0) {
#pragma unroll
                for (int i = 0; i < 4; ++i) *(LAS u32x4*)(Vs + srow * 528 + (dg + 8 * i) * 16) = pv[i]; }
#pragma unroll
            for (int i = 0; i < 8; ++i) { const int pc = c.tid + 512 * i, rr = pc >> 4, sp = pc & 15; *(LAS u32x4*)(STs + rr * 272 + sp * 16) = pgst[i]; }
            { float qq[16], kk[16], bb[16]; float t8[8];
#pragma unroll
              for (int q = 0; q < 4; ++q) { bb[4 * q] = pgb[q].x; bb[4 * q + 1] = pgb[q].y; bb[4 * q + 2] = pgb[q].z; bb[4 * q + 3] = pgb[q].w; }
              unpack8(pqk[0], t8);
#pragma unroll
              for (int e = 0; e < 8; ++e) qq[e] = t8[e];
              unpack8(pqk[1], t8);
#pragma unroll
              for (int e = 0; e < 8; ++e) qq[8 + e] = t8[e];
              unpack8(pqk[2], t8);
#pragma unroll
              for (int e = 0; e < 8; ++e) kk[e] = t8[e];
              unpack8(pqk[3], t8);
#pragma unroll
              for (int e = 0; e < 8; ++e) kk[8 + e] = t8[e];
#pragma unroll
              for (int e = 0; e < 16; ++e) { const float eb = __expf(bb[e]); qq[e] *= eb; kk[e] *= __builtin_amdgcn_rcpf(eb); }
              const float q0[8] = {qq[0], qq[1], qq[2], qq[3], qq[4], qq[5], qq[6], qq[7]}, q1[8] = {qq[8], qq[9], qq[10], qq[11], qq[12], qq[13], qq[14], qq[15]};
              const float k0[8] = {kk[0], kk[1], kk[2], kk[3], kk[4], kk[5], kk[6], kk[7]}, k1[8] = {kk[8], kk[9], kk[10], kk[11], kk[12], kk[13], kk[14], kk[15]};
              *(LAS u32x4*)(Qt + srow * 272 + dg * 32) = pack8(q0); *(LAS u32x4*)(Qt + srow * 272 + dg * 32 + 16) = pack8(q1);
              *(LAS u32x4*)(Kt + srow * 272 + dg * 32) = pack8(k0); *(LAS u32x4*)(Kt + srow * 272 + dg * 32 + 16) = pack8(k1); }
            if (dir == 0) GO_PREF_DIR(item, 1);
            else {
                if (item + (int)gridDim.x < 1152) { GO_PREF_ITEM(item + (int)gridDim.x); GO_PREF_DIR(item + (int)gridDim.x, 0); }
#pragma unroll
                for (int q = 0; q < 4; ++q) gcur[q] = *(const u32x4*)(P + (size_t)(r0 + srow) * PLD + 2048 + h * 256 + dg * 32 + 8 * q);
            }
            lds_barrier();
#pragma unroll
            for (int jt = 0; jt < 2; ++jt) {
#pragma unroll
                for (int st = 0; st < 2; ++st) {
                    const bool live = dir ? (st >= jt) : (st <= jt);
                    if (live) {
                        f32x16 X = zero16();
#pragma unroll
                        for (int kk = 0; kk < 8; ++kk) X = MFMA32(row_frag(Kt, 272, 32 * st, 16 * kk, lane), row_frag(Qt, 272, 32 * jt, 16 * kk, lane), X);
                        if (st == jt) {
#pragma unroll
                            for (int r = 0; r < 16; ++r) { const int s = crow(r, h5); const bool ok = dir ? (s >= l31) : (s <= l31); X[r] = ok ? X[r] : 0.f; } }
#pragma unroll
                        for (int step = 0; step < 2; ++step) O[jt] = MFMA32(tr_frag_perm(Vs, 528, 32 * st + 16 * step, 32 * wave, lane), pack_acc(X, step), O[jt]);
                        __builtin_amdgcn_sched_barrier(0);
                    }
                }
#pragma unroll
                for (int kk = 0; kk < 8; ++kk) O[jt] = MFMA32(row_frag(STs, 272, 32 * wave, 16 * kk, lane), row_frag(Qt, 272, 32 * jt, 16 * kk, lane), O[jt]);
                __builtin_amdgcn_sched_barrier(0);
            }
        }
        lds_barrier();
#pragma unroll
        for (int jt = 0; jt < 2; ++jt)
#pragma unroll
            for (int q = 0; q < 4; ++q) *(LAS f32x4*)(YO + (32 * jt + l31) * 260 + 32 * wave + 8 * q + 4 * h5) = (f32x4){O[jt][4 * q], O[jt][4 * q + 1], O[jt][4 * q + 2], O[jt][4 * q + 3]};
        lds_barrier();
        { const int c0 = dg * 32; float y[32]; float ss = 0.f;
#pragma unroll
          for (int q = 0; q < 8; ++q) { const f32x4 a = *(const LAS f32x4*)(YO + srow * 260 + c0 + 4 * q); y[4 * q] = a.x; y[4 * q + 1] = a.y; y[4 * q + 2] = a.z; y[4 * q + 3] = a.w; }
#pragma unroll
          for (int q = 0; q < 32; ++q) ss += y[q] * y[q];
          ss += shx_(ss, 1); ss += shx_(ss, 2); ss += shx_(ss, 4);
          const float r = __builtin_amdgcn_rsqf(ss * (1.0f / 256.0f) + EPS);
#pragma unroll
          for (int q = 0; q < 4; ++q) { float g8[8], o8[8]; unpack8(gcur[q], g8);
#pragma unroll
              for (int e = 0; e < 8; ++e) o8[e] = y[8 * q + e] * r * ngs[h * 256 + c0 + 8 * q + e] * siluf_(g8[e]);
              *(u32x4*)(Y + (size_t)(r0 + srow) * D + h * 256 + c0 + 8 * q) = pack8(o8); } }
    }
#undef GO_PREF_ITEM
#undef GO_PREF_DIR
#undef GO_DECODE
}

DI void phase_gla_scan_naive(const Ctx& c) {
    const bf16* PC = WSP(bf16, WS_BIG + BIG_PC); const float* EX = WSP(float, WS_EXTRA);
    LAS float* qs = (LAS float*)c.lds; LAS float* ks = qs + 16 * 128; LAS float* as = ks + 16 * 128; LAS float* vs = as + 16 * 128; LAS float* lw = vs + 16 * 256;
    const int v = c.tid >> 1, d0 = (c.tid & 1) * 64;
    for (int item = blockIdx.x; item < 64; item += gridDim.x) {
        const int b = item >> 3, h = (item >> 1) & 3, dir = item & 1;
        float* Yo = WSP(float, WS_BIG + (dir ? BIG_YB : BIG_YF));
        const float* w2 = c.in[I_GLW2] + (size_t)dir * 16 * 512 + h * 128; const float* gb = c.in[I_GLGB] + dir * 512 + h * 128;
        float S[64];
#pragma unroll
        for (int d = 0; d < 64; ++d) S[d] = 0.f;
        for (int ch = 0; ch < (CTX + SEQ) / 16; ++ch) {
            __syncthreads();
            if (c.tid < 256) { const int st = c.tid >> 4, r = c.tid & 15, row = scan_row(ch * 16 + st, b, dir); lw[c.tid] = EX[(size_t)row * 32 + dir * 16 + r]; }
            for (int idx = c.tid; idx < 16 * 512; idx += 512) { const int st = idx >> 9, col = idx & 511, row = scan_row(ch * 16 + st, b, dir);
                if (col < 128) qs[st * 128 + col] = bf2f(PC[(size_t)row * 2048 + h * 128 + col]);
                else if (col < 256) ks[st * 128 + col - 128] = bf2f(PC[(size_t)row * 2048 + 512 + h * 128 + col - 128]);
                else vs[st * 256 + col - 256] = bf2f(PC[(size_t)row * 2048 + 1024 + h * 256 + col - 256]); }
            __syncthreads();
            for (int idx = c.tid; idx < 16 * 128; idx += 512) { const int st = idx >> 7, d = idx & 127; float pre = gb[d];
#pragma unroll
                for (int r = 0; r < 16; ++r) pre += lw[st * 16 + r] * w2[r * 512 + d];
                as[idx] = __expf(logsigf_(pre) * (1.0f / 16.0f)); }
            __syncthreads();
            for (int st = 0; st < 16; ++st) {
                const float vv = vs[st * 256 + v]; float part = 0.f;
#pragma unroll
                for (int d = 0; d < 64; ++d) { S[d] = as[st * 128 + d0 + d] * S[d] + ks[st * 128 + d0 + d] * vv; part += qs[st * 128 + d0 + d] * S[d]; }
                part += shx_(part, 1);
                if ((c.tid & 1) == 0) { const int row = scan_row(ch * 16 + st, b, dir); Yo[(size_t)row * D + h * 256 + v] = part; }
            }
        }
    }
}
DI void phase_headnorm(const Ctx& c, int hd, const float* ng) {
    const float* YF = WSP(float, WS_BIG + BIG_YF); const float* YB = WSP(float, WS_BIG + BIG_YB); const bf16* P = WSP(bf16, WS_P); bf16* Y = WSP(bf16, WS_Y);
    for (int row = c.gw; row < TT; row += c.ngw) {
        const int c0 = 16 * c.lane; float y[16]; float ss = 0.f;
#pragma unroll
        for (int j = 0; j < 4; ++j) { const f32x4 a = *(const f32x4*)(YF + (size_t)row * D + c0 + 4 * j), bb = *(const f32x4*)(YB + (size_t)row * D + c0 + 4 * j);
            y[4 * j] = a.x + bb.x; y[4 * j + 1] = a.y + bb.y; y[4 * j + 2] = a.z + bb.z; y[4 * j + 3] = a.w + bb.w; }
#pragma unroll
        for (int j = 0; j < 16; ++j) ss += y[j] * y[j];
        ss += shx_(ss, 1); ss += shx_(ss, 2); ss += shx_(ss, 4); if (hd == 256) ss += shx_(ss, 8);
        const float r = 1.0f / sqrtf(ss / (float)hd + EPS);
        float g0[8], g1[8];
        unpack8(*(const u32x4*)(P + (size_t)row * PLD + 2048 + c0), g0); unpack8(*(const u32x4*)(P + (size_t)row * PLD + 2048 + c0 + 8), g1);
        float o[16];
#pragma unroll
        for (int j = 0; j < 16; ++j) { const float gp = j < 8 ? g0[j] : g1[j - 8]; o[j] = y[j] * r * ng[c0 + j] * (hd == 128 ? sigmoidf_(gp) : siluf_(gp)); }
        const float o0[8] = {o[0], o[1], o[2], o[3], o[4], o[5], o[6], o[7]}, o1[8] = {o[8], o[9], o[10], o[11], o[12], o[13], o[14], o[15]};
        *(u32x4*)(Y + (size_t)row * D + c0) = pack8(o0); *(u32x4*)(Y + (size_t)row * D + c0 + 8) = pack8(o1);
    }
}
DI void phase_hyena_conv_naive(const Ctx& c) {
    const bf16* PC = WSP(bf16, WS_BIG + BIG_PC); bf16* Y = WSP(bf16, WS_Y); const float* skip = c.in[I_HYSKIP];
    LAS float* zt = (LAS float*)c.lds;
    LAS float* ft = zt + 4096;
    const int cc = c.tid & 63, tg = c.tid >> 6;
    for (int item = blockIdx.x; item < 4096 + 512; item += gridDim.x) {
        int L, rb, tt, cgi; const float* tab;
        if (item < 4096) { L = SEQ; const int b = item >> 9; tt = (item >> 4) & 31; cgi = item & 15; rb = TC + b * SEQ; tab = WSP(float, WS_HF); }
        else { const int it = item - 4096; L = CTX; const int b = it >> 6; tt = (it >> 4) & 3; cgi = it & 15; rb = b * CTX; tab = WSP(float, WS_HFC); }
        const int t0 = 64 * tt, c0 = 64 * cgi;
        float acc[8];
#pragma unroll
        for (int i = 0; i < 8; ++i) acc[i] = 0.f;
        for (int sb = 0; sb < L / 64; ++sb) {
            const int s0 = 64 * sb;
            __syncthreads();
            for (int idx = c.tid; idx < 4096; idx += 512) { const int sl = idx >> 6, ch = idx & 63; const size_t o = (size_t)(rb + s0 + sl) * PLD + c0 + ch;
                zt[idx] = bf2f(PC[o + 1024]) * bf2f(PC[o + 2048]); }
            for (int idx = c.tid; idx < 64 * 128; idx += 512) { const int ch = idx >> 7, j = idx & 127;
                if (j < 127) ft[j * 65 + ch] = tab[(size_t)(c0 + ch) * (2 * L) + L + (t0 - s0 - 63 + j)]; }
            __syncthreads();
#pragma unroll 1
            for (int g = 0; g < 8; ++g) {
                float w[15], z[8]; const int base = 8 * (tg - g) + 56;
#pragma unroll
                for (int m = 0; m < 15; ++m) w[m] = ft[(base + m) * 65 + cc];
#pragma unroll
                for (int j = 0; j < 8; ++j) z[j] = zt[(8 * g + j) * 64 + cc];
#pragma unroll
                for (int i = 0; i < 8; ++i)
#pragma unroll
                    for (int j = 0; j < 8; ++j) acc[i] += w[i - j + 7] * z[j];
            }
        }
#pragma unroll
        for (int i = 0; i < 8; ++i) { const int row = rb + t0 + 8 * tg + i; const size_t o = (size_t)row * PLD + c0 + cc;
            const float zin = bf2f(PC[o + 1024]) * bf2f(PC[o + 2048]), x0 = bf2f(PC[o]);
            Y[(size_t)row * D + c0 + cc] = f2bf(x0 * (acc[i] + skip[c0 + cc] * zin)); }
    }
}

DI void hy_item(int item, int& L, int& b, int& t0, int& c0, int& rb) {
    if (item < 4096) { L = SEQ; b = item >> 9; t0 = 64 * ((item >> 4) & 31); c0 = 64 * (item & 15); rb = TC + b * SEQ; }
    else { const int it = item - 4096; L = CTX; b = it >> 6; t0 = 64 * ((it >> 4) & 3); c0 = 64 * (it & 15); rb = b * CTX; }
}
DI void phase_hy_prep(const Ctx& c) {
    const bf16* P = WSP(bf16, WS_P); bf16* X0C = WSP(bf16, WS_BIG + BIG_PC); const float* cw = c.in[I_HYCW]; const float* cb = c.in[I_HYCB];
    LAS unsigned char* raw = c.lds;
    LAS float* zt = (LAS float*)(c.lds + 32768);
    u32x4 pre[4];
#define HP_PREF(it_) do { int L_, b_, t0_, c0_, rb_; hy_item((it_), L_, b_, t0_, c0_, rb_); \
        _Pragma("unroll") for (int k = 0; k < 4; ++k) { const int pc = c.tid + 512 * k; pre[k] = (u32x4){c.z, c.z, c.z, c.z}; \
            if (pc < 3 * 66 * 8) { const int g = pc / 528, rr = (pc % 528) >> 3, sp = pc & 7, t = t0_ - 1 + rr; \
                if (t >= 0 && t < L_) pre[k] = *(const u32x4*)(P + (size_t)(rb_ + t) * PLD + g * 1024 + c0_ + 8 * sp); } } } while (0)
    const bool wfix = (gridDim.x & 15u) == 0u;
    float wt[3][4][8];
    if (wfix) { const int sp = c.tid & 7, c0f = 64 * ((int)blockIdx.x & 15);
#pragma unroll
        for (int g = 0; g < 3; ++g) { const int col = g * 1024 + c0f + 8 * sp;
#pragma unroll
            for (int e = 0; e < 8; ++e) { wt[g][0][e] = cw[col + e]; wt[g][1][e] = cw[3072 + col + e]; wt[g][2][e] = cw[6144 + col + e]; wt[g][3][e] = cb[col + e]; } } }
    if ((int)blockIdx.x < 4608) HP_PREF((int)blockIdx.x);
    for (int item = blockIdx.x; item < 4608; item += gridDim.x) {
        int L, b, t0, c0, rb; hy_item(item, L, b, t0, c0, rb);
        if (!wfix) { const int sp = c.tid & 7;
#pragma unroll
            for (int g = 0; g < 3; ++g) { const int col = g * 1024 + c0 + 8 * sp;
#pragma unroll
                for (int e = 0; e < 8; ++e) { wt[g][0][e] = cw[col + e]; wt[g][1][e] = cw[3072 + col + e]; wt[g][2][e] = cw[6144 + col + e]; wt[g][3][e] = cb[col + e]; } } }
        bf16* ZT = L == SEQ ? WSP(bf16, WS_BIG + BIG_ZTL) : WSP(bf16, WS_BIG + BIG_ZTC);
        lds_barrier();
#pragma unroll
        for (int k = 0; k < 4; ++k) { const int pc = c.tid + 512 * k; if (pc < 3 * 66 * 8) { const int g = pc / 528, rr = (pc % 528) >> 3, sp = pc & 7; *(LAS u32x4*)(raw + (g * 66 + rr) * 128 + sp * 16) = pre[k]; } }
        if (item + (int)gridDim.x < 4608) HP_PREF(item + (int)gridDim.x);
        lds_barrier();
        { const int t = c.tid >> 3, sp = c.tid & 7; float u[3][8];
#pragma unroll
          for (int g = 0; g < 3; ++g) { float xm[8], x0[8], xp[8];
              unpack8(*(const LAS u32x4*)(raw + (g * 66 + t) * 128 + sp * 16), xm); unpack8(*(const LAS u32x4*)(raw + (g * 66 + t + 1) * 128 + sp * 16), x0); unpack8(*(const LAS u32x4*)(raw + (g * 66 + t + 2) * 128 + sp * 16), xp);
#pragma unroll
              for (int e = 0; e < 8; ++e) u[g][e] = wt[g][0][e] * xm[e] + wt[g][1][e] * x0[e] + wt[g][2][e] * xp[e] + wt[g][3][e]; }
          *(u32x4*)(X0C + (size_t)(rb + t0 + t) * 1024 + c0 + 8 * sp) = pack8(u[0]);
#pragma unroll
          for (int e = 0; e < 8; ++e) zt[t * 65 + 8 * sp + e] = u[1][e] * u[2][e]; }
        lds_barrier();
        { const int ch = c.tid >> 3, tp = c.tid & 7; float z[8];
#pragma unroll
          for (int e = 0; e < 8; ++e) z[e] = zt[(8 * tp + e) * 65 + ch];
          *(u32x4*)(ZT + ((size_t)(c0 + ch) * NB + b) * L + t0 + 8 * tp) = pack8(z); }
    }
#undef HP_PREF
}
template <int L>
DI void hy_toeplitz_channel(const Ctx& c, const float* hrow  , const bf16* zsrc  , bf16* ydst  ) {
    constexpr int NBK = L / 32, CP = 2 * L + 8, NT = (NBK + 31) / 32, DMIN = -(NBK - 1), DMAX = NBK - 1;
    LAS unsigned char* F = c.lds;
    LAS unsigned char* Zs = c.lds + 8 * CP * 2;
    LAS unsigned char* R1 = Zs + (8 * NBK + 1) * 80;
    const int lane = c.lane, w = c.wave, h5 = lane >> 5, a = lane & 31, pi = lane & 15, rho = (lane >> 4) & 1;
    __syncthreads();
    for (int g = c.tid; g < (2 * L + 16) / 8; g += 512) { float v[8];
#pragma unroll
        for (int j = 0; j < 8; ++j) { const int y = 8 * g + j; v[j] = (y >= 1 && y <= 2 * L - 1) ? hrow[2 * L - y] : 0.f; }
        *(LAS u32x4*)(R1 + g * 16) = pack8(v); }
    if (c.tid < 20) *(LAS unsigned*)(Zs + 8 * NBK * 80 + 4 * c.tid) = c.z;
    for (int pc = c.tid; pc < 8 * L / 8; pc += 512) { const int bb = pc / (L / 8), pj = pc % (L / 8);
        *(LAS u32x4*)(Zs + (bb * NBK + (pj >> 2)) * 80 + (pj & 3) * 16) = *(const u32x4*)(zsrc + (size_t)bb * L + 8 * pj); }
    __syncthreads();
    for (int g = c.tid; g < 2 * L / 8; g += 512) {
        const u32x4 lo = *(const LAS u32x4*)(R1 + g * 16), hi = *(const LAS u32x4*)(R1 + g * 16 + 16);
        const unsigned Dw[8] = {lo.x, lo.y, lo.z, lo.w, hi.x, hi.y, hi.z, hi.w};
#pragma unroll
        for (int r = 0; r < 8; ++r) { u32x4 o;
            if (r & 1) { o.x = __builtin_amdgcn_alignbit(Dw[r / 2 + 1], Dw[r / 2], 16); o.y = __builtin_amdgcn_alignbit(Dw[r / 2 + 2], Dw[r / 2 + 1], 16);
                         o.z = __builtin_amdgcn_alignbit(Dw[r / 2 + 3], Dw[r / 2 + 2], 16); o.w = __builtin_amdgcn_alignbit(Dw[r / 2 + 4], Dw[r / 2 + 3], 16); }
            else { o.x = Dw[r / 2]; o.y = Dw[r / 2 + 1]; o.z = Dw[r / 2 + 2]; o.w = Dw[r / 2 + 3]; }
            *(LAS u32x4*)(F + (r * CP + 8 * g) * 2) = o; } }
    __syncthreads();
    const int r = (-a) & 7;
    f32x16 acc[NT];
#define HY_BLK(blk_) ((unsigned)(blk_) < (unsigned)NBK ? w * NBK + (blk_) : 8 * NBK)
#if HY_DIRECT_B
#pragma unroll
    for (int q = 0; q < NT; ++q) acc[q] = zero16();
    bf16x8 Ac[2], Bc[NT][2], An[2], Bn[NT][2];
#define HY_LOADF(A_, B_, d_) do { _Pragma("unroll") for (int step = 0; step < 2; ++step) { const int y0 = L - 32 * (d_) - a + 16 * step + 8 * h5; A_[step] = *(const LAS bf16x8*)(F + (r * CP + (y0 - r)) * 2); } \
        _Pragma("unroll") for (int q = 0; q < NT; ++q) { const LAS unsigned char* bp = Zs + HY_BLK(32 * q + 2 * pi + rho - (d_)) * 80 + 16 * h5; \
            _Pragma("unroll") for (int step = 0; step < 2; ++step) B_[q][step] = *(const LAS bf16x8*)(bp + 32 * step); } } while (0)
#define HY_MMA(A_, B_, d_) do { _Pragma("unroll") for (int q = 0; q < NT; ++q) if ((d_) >= 32 * q - (NBK - 1) && (d_) <= 32 * q + 31) { \
        _Pragma("unroll") for (int step = 0; step < 2; ++step) acc[q] = MFMA32(A_[step], B_[q][step], acc[q]); } } while (0)
    HY_LOADF(Ac, Bc, DMIN);
    for (int d = DMIN; d <= DMAX; d += 2) {
        HY_LOADF(An, Bn, min(d + 1, DMAX));
        HY_MMA(Ac, Bc, d);
        HY_LOADF(Ac, Bc, min(d + 2, DMAX));
        if (d + 1 <= DMAX) HY_MMA(An, Bn, d + 1);
    }
#undef HY_MMA
#undef HY_LOADF
#else
    u32x4 Bf[2][NT][2];
#pragma unroll
    for (int q = 0; q < NT; ++q) { acc[q] = zero16();
#pragma unroll
        for (int par = 0; par < 2; ++par)
#pragma unroll
            for (int step = 0; step < 2; ++step) Bf[par][q][step] = *(const LAS u32x4*)(Zs + HY_BLK(32 * q + 2 * pi + rho - (DMIN + par)) * 80 + 32 * step + 16 * h5); }
    for (int d0 = DMIN; d0 <= DMAX; d0 += 2) {
#pragma unroll
        for (int par = 0; par < 2; ++par) {
            const int d = d0 + par;
            if (d <= DMAX) {
#pragma unroll
                for (int step = 0; step < 2; ++step) {
                    const int y0 = L - 32 * d - a + 16 * step + 8 * h5;
                    const bf16x8 A = *(const LAS bf16x8*)(F + (r * CP + (y0 - r)) * 2);
#pragma unroll
                    for (int q = 0; q < NT; ++q) if (d >= 32 * q - (NBK - 1) && d <= 32 * q + 31) acc[q] = MFMA32(A, __builtin_bit_cast(bf16x8, Bf[par][q][step]), acc[q]);
                }
#pragma unroll
                for (int q = 0; q < NT; ++q)
#pragma unroll
                    for (int step = 0; step < 2; ++step) {
                        const u32x4 fr = *(const LAS u32x4*)(Zs + HY_BLK(32 * q + rho - (d + 2)) * 80 + 32 * step + 16 * h5); u32x4 nb;
                        nb.x = (unsigned)__builtin_amdgcn_update_dpp((int)fr.x, (int)Bf[par][q][step].x, 0x111, 0xf, 0xf, false);
                        nb.y = (unsigned)__builtin_amdgcn_update_dpp((int)fr.y, (int)Bf[par][q][step].y, 0x111, 0xf, 0xf, false);
                        nb.z = (unsigned)__builtin_amdgcn_update_dpp((int)fr.z, (int)Bf[par][q][step].z, 0x111, 0xf, 0xf, false);
                        nb.w = (unsigned)__builtin_amdgcn_update_dpp((int)fr.w, (int)Bf[par][q][step].w, 0x111, 0xf, 0xf, false);
                        Bf[par][q][step] = nb; }
            }
        }
    }
#endif
#undef HY_BLK
#pragma unroll
    for (int q = 0; q < NT; ++q) { const int i = 32 * q + 2 * pi + rho;
        if (i < NBK) {
#pragma unroll
            for (int qq = 0; qq < 4; ++qq) { u32x2 o; o.x = cvt_pk_bf16(acc[q][4 * qq], acc[q][4 * qq + 1]); o.y = cvt_pk_bf16(acc[q][4 * qq + 2], acc[q][4 * qq + 3]);
                *(u32x2*)(ydst + (size_t)w * L + 32 * i + 8 * qq + 4 * h5) = o; } } }
}
DI void phase_hy_toeplitz(const Ctx& c) {
    for (int ch = blockIdx.x; ch < 1024; ch += gridDim.x) {
        hy_toeplitz_channel<SEQ>(c, WSP(float, WS_HF) + (size_t)ch * 4096, WSP(bf16, WS_BIG + BIG_ZTL) + (size_t)ch * NB * SEQ, WSP(bf16, WS_BIG + BIG_YTL) + (size_t)ch * NB * SEQ);
        hy_toeplitz_channel<CTX>(c, WSP(float, WS_HFC) + (size_t)ch * 512, WSP(bf16, WS_BIG + BIG_ZTC) + (size_t)ch * NB * CTX, WSP(bf16, WS_BIG + BIG_YTC) + (size_t)ch * NB * CTX);
    }
}
DI void phase_hy_post(const Ctx& c) {
    const bf16* X0C = WSP(bf16, WS_BIG + BIG_PC); bf16* Y = WSP(bf16, WS_Y); const float* skip = c.in[I_HYSKIP];
    LAS float* tl = (LAS float*)c.lds;
    u32x4 py, pz, px; float psk = 0.f;
#define HQ_PREF(it_) do { int L_, b_, t0_, c0_, rb_; hy_item((it_), L_, b_, t0_, c0_, rb_); \
        const bf16* ZT_ = L_ == SEQ ? WSP(bf16, WS_BIG + BIG_ZTL) : WSP(bf16, WS_BIG + BIG_ZTC); const bf16* YT_ = L_ == SEQ ? WSP(bf16, WS_BIG + BIG_YTL) : WSP(bf16, WS_BIG + BIG_YTC); \
        const int ch_ = c.tid >> 3, tp_ = c.tid & 7; const size_t o_ = ((size_t)(c0_ + ch_) * NB + b_) * L_ + t0_ + 8 * tp_; \
        py = *(const u32x4*)(YT_ + o_); pz = *(const u32x4*)(ZT_ + o_); psk = skip[c0_ + ch_]; \
        px = *(const u32x4*)(X0C + (size_t)(rb_ + t0_ + (c.tid >> 3)) * 1024 + c0_ + 8 * (c.tid & 7)); } while (0)
    if ((int)blockIdx.x < 4608) HQ_PREF((int)blockIdx.x);
    for (int item = blockIdx.x; item < 4608; item += gridDim.x) {
        int L, b, t0, c0, rb; hy_item(item, L, b, t0, c0, rb); (void)L; (void)b;
        lds_barrier();
        { const int ch = c.tid >> 3, tp = c.tid & 7; float y[8], z[8]; unpack8(py, y); unpack8(pz, z); const float sk = psk;
#pragma unroll
          for (int e = 0; e < 8; ++e) tl[ch * 65 + 8 * tp + e] = y[e] + sk * z[e]; }
        const u32x4 xc = px;
        if (item + (int)gridDim.x < 4608) HQ_PREF(item + (int)gridDim.x);
        lds_barrier();
        { const int t = c.tid >> 3, sp = c.tid & 7; float x0[8], o[8]; unpack8(xc, x0);
#pragma unroll
          for (int e = 0; e < 8; ++e) o[e] = x0[e] * tl[(8 * sp + e) * 65 + t];
          *(u32x4*)(Y + (size_t)(rb + t0 + t) * D + c0 + 8 * sp) = pack8(o); }
    }
#undef HQ_PREF
}

DI void phase_route(const Ctx& c, int l) {
    LAS float* rw = (LAS float*)c.lds;
    LAS int* lcnt = (LAS int*)(c.lds + 65536);
    LAS int* rinfo = lcnt + 32;
    LAS float* rwt = (LAS float*)(rinfo + 4 * 128);
    const float* MOD = WSP(float, WS_MOD) + (size_t)l * 9 * 6144; const float* g = c.in[I_N2G] + l * D; bf16* H = WSP(bf16, WS_H);
    const bf16* X = WSP(bf16, WS_X); const bf16* XC = WSP(bf16, WS_XC);
    unsigned* cnt = WSP(unsigned, WS_CTL) + CW_CNT + l * 16; int* TOK = WSP(int, WS_TOK); float* TOKW = WSP(float, WS_TOK + 512 * 1024);
    const float rbl = c.lane < 16 ? c.in[I_RB][c.lane] : 0.f;
    const int rlo = (l == 3 ? TC : 0), nrow = TT - rlo, per = (nrow + (int)gridDim.x - 1) / (int)gridDim.x;
    const int brow0 = rlo + (int)blockIdx.x * per, bn = min(per, TT - brow0);
    f32x4 gv[4], shv[4] = {}, scv[4] = {}; int mr_cur = -1; load_vec(g, gv, c.lane);
    if (c.wave < bn) { const int row = brow0 + c.wave; mr_cur = row < TC ? 8 : (row - TC) >> 11; load_vec(MOD + mr_cur * 6144 + 3072, shv, c.lane); load_vec(MOD + mr_cur * 6144 + 4096, scv, c.lane); }
    u32x2 rawA[4] = {}, rawB[4] = {};
    if (c.wave < bn) { const int row = brow0 + c.wave; load_row_raw(row < TC ? XC + (size_t)row * D : X + (size_t)(row - TC) * D, rawA, c.lane); }
    if (c.wave + 8 < bn) { const int row = brow0 + c.wave + 8; load_row_raw(row < TC ? XC + (size_t)row * D : X + (size_t)(row - TC) * D, rawB, c.lane); }
    { const f32x4* srcw = (const f32x4*)WSP(float, WS_RWT);
#pragma unroll
      for (int i = 0; i < 8; ++i) *(LAS f32x4*)(rw + 4 * (c.tid + 512 * i)) = srcw[c.tid + 512 * i]; }
    if (c.tid < 16) lcnt[c.tid] = 0;
    __syncthreads();
    for (int lr = c.wave; lr < bn; lr += 8) {
        const int row = brow0 + lr;
        f32x4 v[4];
        cvt_row_raw(rawA, v);
        const int mr = row < TC ? 8 : (row - TC) >> 11;
        if (mr != mr_cur) { load_vec(MOD + mr * 6144 + 3072, shv, c.lane); load_vec(MOD + mr * 6144 + 4096, scv, c.lane); mr_cur = mr; }
        norm_mod_row_reg(v, gv, shv, scv);
        store_row_bf16(H + (size_t)row * D, v, c.lane);
#pragma unroll
        for (int j = 0; j < 4; ++j) rawA[j] = rawB[j];
        if (lr + 16 < bn) { const int rn = row + 16; load_row_raw(rn < TC ? XC + (size_t)rn * D : X + (size_t)(rn - TC) * D, rawB, c.lane); }
        float s16[16];
#pragma unroll
        for (int e = 0; e < 16; ++e) { float s = 0.f;
#pragma unroll
            for (int j = 0; j < 4; ++j) { const f32x4 w = *(const LAS f32x4*)(rw + e * 1024 + 256 * j + 4 * c.lane); s += (v[j].x * w.x + v[j].y * w.y) + (v[j].z * w.z + v[j].w * w.w); }
            s16[e] = s; if ((e & 3) == 3) asm volatile("" ::: "memory"); }
        float s8[8], s4[4], s2[2], s1;
        { const bool up = (c.lane & 32) != 0;
#pragma unroll
          for (int i = 0; i < 8; ++i) { const float keep = up ? s16[8 + i] : s16[i], give = up ? s16[i] : s16[8 + i]; s8[i] = keep + shx_(give, 32); } }
        { const bool up = (c.lane & 16) != 0;
#pragma unroll
          for (int i = 0; i < 4; ++i) { const float keep = up ? s8[4 + i] : s8[i], give = up ? s8[i] : s8[4 + i]; s4[i] = keep + shx_(give, 16); } }
        { const bool up = (c.lane & 8) != 0;
#pragma unroll
          for (int i = 0; i < 2; ++i) { const float keep = up ? s4[2 + i] : s4[i], give = up ? s4[i] : s4[2 + i]; s2[i] = keep + shx_(give, 8); } }
        { const bool up = (c.lane & 4) != 0; const float keep = up ? s2[1] : s2[0], give = up ? s2[0] : s2[1]; s1 = keep + shx_(give, 4); }
        s1 += shx_(s1, 2); s1 += shx_(s1, 1);
        const int eb = c.lane & 15; const int srcl = (((eb >> 3) & 1) << 5) | (((eb >> 2) & 1) << 4) | (((eb >> 1) & 1) << 3) | ((eb & 1) << 2);
        const float sc = sigmoidf_(__shfl(s1, srcl));
        const float sel = sc + rbl;
        float m1 = sel, m2 = -1e30f;
        { const float o1 = shx_(sel, 1); const float hi = fmaxf(sel, o1), lo = fminf(sel, o1);
          const float ohi = shx_(hi, 2), olo = shx_(lo, 2);
          m1 = fmaxf(hi, ohi); m2 = fmaxf(fminf(hi, ohi), fmaxf(lo, olo)); }
        const float gs = m1 + m2;
        const float g0 = __shfl(gs, 0), g1 = __shfl(gs, 4), g2 = __shfl(gs, 8), g3 = __shfl(gs, 12);
        int bg = 0; float bgs = g0; if (g1 > bgs) { bgs = g1; bg = 1; } if (g2 > bgs) { bgs = g2; bg = 2; } if (g3 > bgs) { bgs = g3; bg = 3; }
        float s4b[4], p4b[4];
#pragma unroll
        for (int j = 0; j < 4; ++j) { s4b[j] = __shfl(sel, 4 * bg + j); p4b[j] = __shfl(sc, 4 * bg + j); }
        int i1 = 0; float v1 = s4b[0], q1 = p4b[0];
#pragma unroll
        for (int j = 1; j < 4; ++j) if (s4b[j] > v1) { v1 = s4b[j]; i1 = j; q1 = p4b[j]; }
        int i2 = -1; float v2 = -1e30f, q2 = 0.f;
#pragma unroll
        for (int j = 0; j < 4; ++j) if (j != i1 && s4b[j] > v2) { v2 = s4b[j]; i2 = j; q2 = p4b[j]; }
        if (c.lane == 0) {
            const int e0 = 4 * bg + i1, e1 = 4 * bg + i2;
            const int p0 = __hip_atomic_fetch_add(lcnt + e0, 1, __ATOMIC_RELAXED, __HIP_MEMORY_SCOPE_WORKGROUP), p1 = __hip_atomic_fetch_add(lcnt + e1, 1, __ATOMIC_RELAXED, __HIP_MEMORY_SCOPE_WORKGROUP);
            rinfo[lr * 4 + 0] = e0; rinfo[lr * 4 + 1] = p0; rinfo[lr * 4 + 2] = e1; rinfo[lr * 4 + 3] = p1;
            const float inv = 1.0f / (q1 + q2); rwt[lr * 2] = q1 * inv; rwt[lr * 2 + 1] = q2 * inv;
        }
    }
    __syncthreads();
    if (c.tid < 16) lcnt[16 + c.tid] = (int)atomicAdd(cnt + c.tid, (unsigned)lcnt[c.tid]);
    __syncthreads();
    for (int lr = c.tid; lr < bn; lr += 512) { const int row = brow0 + lr, e0 = rinfo[lr * 4], e1 = rinfo[lr * 4 + 2];
        TOK[row * 4 + 0] = e0; TOK[row * 4 + 1] = lcnt[16 + e0] + rinfo[lr * 4 + 1]; TOK[row * 4 + 2] = e1; TOK[row * 4 + 3] = lcnt[16 + e1] + rinfo[lr * 4 + 3];
        TOKW[row * 2] = rwt[lr * 2]; TOKW[row * 2 + 1] = rwt[lr * 2 + 1]; }
}
DI void slot_bases(const unsigned* cnt, int lane, int e0, int e1, int& b0, int& b1) {
    const unsigned mine = lane < 16 ? ((cnt[lane] + 255u) & ~255u) : 0u; unsigned pb = 0; b0 = 0; b1 = 0;
#pragma unroll
    for (int e = 0; e < 16; ++e) { const unsigned ce = __shfl(mine, e); if (e == e0) b0 = (int)pb; if (e == e1) b1 = (int)pb; pb += ce; }
}
DI void phase_gather(const Ctx& c, int l) {
    const unsigned* cnt = WSP(unsigned, WS_CTL) + CW_CNT + l * 16; const int* TOK = WSP(int, WS_TOK); int* TOKS = WSP(int, WS_TOK + 768 * 1024);
    const bf16* H = WSP(bf16, WS_H); bf16* HS = WSP(bf16, WS_BIG + BIG_HS);
    const unsigned minep = c.lane < 16 ? ((cnt[c.lane] + 255u) & ~255u) : 0u; unsigned pb = 0; int mybase = 0;
#pragma unroll
    for (int e = 0; e < 16; ++e) { const unsigned ce = __shfl(minep, e); if (c.lane == e) mybase = (int)pb; pb += ce; }
    const int rfirst = (l == 3 ? TC : 0) + c.gw, rstep = c.ngw;
    int e0n = 0, p0n = 0, e1n = 0, p1n = 0; u32x4 an = {0u, 0u, 0u, 0u}, bn = an;
    if (rfirst < TT) { e0n = TOK[rfirst * 4]; p0n = TOK[rfirst * 4 + 1]; e1n = TOK[rfirst * 4 + 2]; p1n = TOK[rfirst * 4 + 3];
        an = *(const u32x4*)(H + (size_t)rfirst * D + 8 * c.lane); bn = *(const u32x4*)(H + (size_t)rfirst * D + 512 + 8 * c.lane); }
    for (int row = rfirst; row < TT; row += rstep) {
        const int e0 = e0n, p0 = p0n, e1 = e1n, p1 = p1n; const u32x4 a = an, bq = bn;
        if (row + rstep < TT) { const int r = row + rstep; e0n = TOK[r * 4]; p0n = TOK[r * 4 + 1]; e1n = TOK[r * 4 + 2]; p1n = TOK[r * 4 + 3];
            an = *(const u32x4*)(H + (size_t)r * D + 8 * c.lane); bn = *(const u32x4*)(H + (size_t)r * D + 512 + 8 * c.lane); }
        const int s0 = __shfl(mybase, e0) + p0, s1 = __shfl(mybase, e1) + p1;
        *(u32x4*)(HS + (size_t)s0 * D + 8 * c.lane) = a; *(u32x4*)(HS + (size_t)s0 * D + 512 + 8 * c.lane) = bq;
        *(u32x4*)(HS + (size_t)s1 * D + 8 * c.lane) = a; *(u32x4*)(HS + (size_t)s1 * D + 512 + 8 * c.lane) = bq;
        if (c.lane == 0) { TOKS[row * 2] = s0; TOKS[row * 2 + 1] = s1; }
    }
}
DI LAS int* moe_tiles(const Ctx& c, int l, int nsh) {
    LAS int* tp = (LAS int*)(c.lds + MISC_OFF);
    LAS int* ul = tp + 192;
    __syncthreads();
    if (c.tid < 64) {
        const unsigned* cnt = WSP(unsigned, WS_CTL) + CW_CNT + l * 16;
        const int mine = c.lane < 16 ? (int)((cnt[c.lane] + 255u) >> 8) : 0; int p = 0;
#pragma unroll 1
        for (int e = 0; e < 16; ++e) { const int ne = __shfl(mine, e); for (int t = c.lane; t < ne; t += 64) tp[1 + p + t] = e; p += ne; }
        if (c.lane == 0) tp[0] = p;
    }
    __syncthreads();
    if (c.tid < 32) {
        const int i = c.tid, ntile = tp[0], G = gridDim.x, cb = blockIdx.x; int rt = 1 << 20, pn = 0;
        if ((G & 7) == 0 && ((G >> 3) >> nsh) > 0) { const int x = cb & 7, v = cb >> 3, rpx = (G >> 3) >> nsh;
            if (v < (rpx << nsh)) { const int t0 = i * 8 * rpx;
                rt = (ntile - t0 >= 8 * rpx) ? t0 + x * rpx + (v >> nsh) : t0 + (v >> nsh) * 8 + x; pn = v & ((1 << nsh) - 1); } }
        else { const int L = i * G + cb; rt = L >> nsh; pn = L & ((1 << nsh) - 1); }
        ul[i] = rt < ntile ? (rt | (pn << 12) | (tp[1 + rt] << 16)) : -1;
    }
    __syncthreads();
    return ul;
}
DI void phase_combine(const Ctx& c, int l) {
    const float* MOD = WSP(float, WS_MOD) + (size_t)l * 9 * 6144; const int* TOKS = WSP(int, WS_TOK + 768 * 1024); const float* TOKW = WSP(float, WS_TOK + 512 * 1024);
    const bf16* YS = WSP(bf16, WS_BIG + BIG_HS); bf16* X = WSP(bf16, WS_X); bf16* XC = WSP(bf16, WS_XC); bf16* H = WSP(bf16, WS_H);
    const int rlo = (l == 3 ? TC : 0), per = (TT - rlo + c.ngw - 1) / c.ngw;
    const int rfirst = rlo + c.gw * per, rend = min(rfirst + per, TT);
    int sa0 = 0, sa1 = 0, sb0 = 0, sb1 = 0; float wa0 = 0.f, wa1 = 0.f, wb0 = 0.f, wb1 = 0.f;
    u32x2 dx[4], dy0[4], dy1[4];
    f32x4 g2v[4] = {}, gnv[4], shn[4] = {}, scn[4] = {}; int mr_cur = -1;
    load_vec(l < 3 ? c.in[I_N1G] + (l + 1) * D : c.in[I_FING], gnv, c.lane);
    const float* MODn = WSP(float, WS_MOD) + (size_t)(l < 3 ? l + 1 : l) * 9 * 6144;
#define CB_XP(r_) ((r_) < TC ? XC + (size_t)(r_) * D : X + (size_t)((r_) - TC) * D)
#define CB_LOAD(r_, s0_, s1_) do { const bf16* xq = CB_XP(r_); _Pragma("unroll") for (int j = 0; j < 4; ++j) { dx[j] = *(const u32x2*)(xq + 256 * j + 4 * c.lane); \
        dy0[j] = *(const u32x2*)(YS + (size_t)(s0_) * D + 256 * j + 4 * c.lane); dy1[j] = *(const u32x2*)(YS + (size_t)(s1_) * D + 256 * j + 4 * c.lane); } } while (0)
    if (rfirst < rend) { mr_cur = rfirst < TC ? 8 : (rfirst - TC) >> 11;
        load_vec(MOD + mr_cur * 6144 + 5120, g2v, c.lane); if (l < 3) { load_vec(MODn + mr_cur * 6144, shn, c.lane); load_vec(MODn + mr_cur * 6144 + 1024, scn, c.lane); } }
    if (rfirst < rend) { sa0 = TOKS[rfirst * 2]; sa1 = TOKS[rfirst * 2 + 1]; wa0 = TOKW[rfirst * 2]; wa1 = TOKW[rfirst * 2 + 1]; }
    if (rfirst + 1 < rend) { const int r = rfirst + 1; sb0 = TOKS[r * 2]; sb1 = TOKS[r * 2 + 1]; wb0 = TOKW[r * 2]; wb1 = TOKW[r * 2 + 1]; }
    if (rfirst < rend) CB_LOAD(rfirst, sa0, sa1);
    for (int row = rfirst; row < rend; ++row) {
        const int mr = row < TC ? 8 : (row - TC) >> 11; bf16* xp = CB_XP(row);
        const float w0 = wa0, w1 = wa1;
        if (mr != mr_cur) { load_vec(MOD + mr * 6144 + 5120, g2v, c.lane); if (l < 3) { load_vec(MODn + mr * 6144, shn, c.lane); load_vec(MODn + mr * 6144 + 1024, scn, c.lane); } mr_cur = mr; }
        f32x4 v[4], ya[4], yb[4];
#pragma unroll
        for (int j = 0; j < 4; ++j) {
            v[j] = (f32x4){__uint_as_float(dx[j].x << 16), __uint_as_float(dx[j].x & 0xffff0000u), __uint_as_float(dx[j].y << 16), __uint_as_float(dx[j].y & 0xffff0000u)};
            ya[j] = (f32x4){__uint_as_float(dy0[j].x << 16), __uint_as_float(dy0[j].x & 0xffff0000u), __uint_as_float(dy0[j].y << 16), __uint_as_float(dy0[j].y & 0xffff0000u)};
            yb[j] = (f32x4){__uint_as_float(dy1[j].x << 16), __uint_as_float(dy1[j].x & 0xffff0000u), __uint_as_float(dy1[j].y << 16), __uint_as_float(dy1[j].y & 0xffff0000u)}; }
        sa0 = sb0; sa1 = sb1; wa0 = wb0; wa1 = wb1;
        if (row + 2 < rend) { const int r = row + 2; sb0 = TOKS[r * 2]; sb1 = TOKS[r * 2 + 1]; wb0 = TOKW[r * 2]; wb1 = TOKW[r * 2 + 1]; }
        if (row + 1 < rend) CB_LOAD(row + 1, sa0, sa1);
#pragma unroll
        for (int j = 0; j < 4; ++j) v[j] = v[j] + g2v[j] * (ya[j] * w0 + yb[j] * w1);
        if (l < 3) store_row_bf16(xp, v, c.lane);
        if (l < 3) {
            norm_mod_row_reg(v, gnv, shn, scn);
            store_row_bf16(H + (size_t)hrow_of(row, (l + 1) % 3) * D, v, c.lane);
        } else {
            float s = 0.f;
#pragma unroll
            for (int j = 0; j < 4; ++j) s += (v[j].x * v[j].x + v[j].y * v[j].y) + (v[j].z * v[j].z + v[j].w * v[j].w);
            s = wave_sum(s);
            const float r = __builtin_amdgcn_rsqf(s * (1.0f / 1024.0f) + EPS);
            float* o = c.out + (size_t)(row - TC) * D;
#pragma unroll
            for (int j = 0; j < 4; ++j) *(f32x4*)(o + 256 * j + 4 * c.lane) = v[j] * r * gnv[j];
        }
    }
#undef CB_LOAD
#undef CB_XP
}

DI void ctx_outproj_mini(const Ctx& c, const bf16* Yc, const bf16* Wt, const float* xs_c  , bf16* XC, const float* modc  , const float* bias) {
    constexpr int RS = 272, ABYTES = 64 * RS, STG = 192 * RS;
    const int lane = c.lane, h5 = lane >> 5, l31 = lane & 31;
    const int srow = c.tid >> 4, sch = c.tid & 15;
    for (int tile = blockIdx.x; tile < 256; tile += gridDim.x) {
        const int mt = 64 * (tile >> 3), nt = 128 * (tile & 7);
        const int m0 = mt + 32 * (c.wave >> 2), n0 = nt + 32 * (c.wave & 3);
        const bf16* ag = Yc + (size_t)(mt + srow) * 1024 + 8 * sch; const bf16* bg = Wt + (size_t)(nt + srow) * 1024 + 8 * sch;
        u32x4 st[6];
#define MINI_G(k0_) do { _Pragma("unroll") for (int i = 0; i < 2; ++i) st[i] = *(const u32x4*)(ag + (size_t)(32 * i) * 1024 + (k0_)); \
                         _Pragma("unroll") for (int i = 0; i < 4; ++i) st[2 + i] = *(const u32x4*)(bg + (size_t)(32 * i) * 1024 + (k0_)); } while (0)
#define MINI_W(buf_) do { LAS unsigned char* wb = c.lds + (buf_) * STG + srow * RS + sch * 16; \
                         _Pragma("unroll") for (int i = 0; i < 2; ++i) *(LAS u32x4*)(wb + 32 * i * RS) = st[i]; \
                         _Pragma("unroll") for (int i = 0; i < 4; ++i) *(LAS u32x4*)(wb + ABYTES + 32 * i * RS) = st[2 + i]; } while (0)
        MINI_G(0);
        const int row = m0 + l31;
        float xo[4][4]; f32x4 g1[4], bb[4];
#pragma unroll
        for (int q = 0; q < 4; ++q) { const int col = n0 + 8 * q + 4 * h5; const size_t o = (size_t)row * D + col;
            if (xs_c) { const f32x4 t = *(const f32x4*)(xs_c + o); xo[q][0] = t.x; xo[q][1] = t.y; xo[q][2] = t.z; xo[q][3] = t.w; }
            else { const u32x2 t = *(const u32x2*)(XC + o); xo[q][0] = __uint_as_float(t.x << 16); xo[q][1] = __uint_as_float(t.x & 0xffff0000u); xo[q][2] = __uint_as_float(t.y << 16); xo[q][3] = __uint_as_float(t.y & 0xffff0000u); }
            g1[q] = *(const f32x4*)(modc + 2048 + col); bb[q] = bias ? *(const f32x4*)(bias + col) : (f32x4){0.f, 0.f, 0.f, 0.f}; }
        __syncthreads();
        MINI_W(0);
        lds_barrier();
        f32x16 acc = zero16();
        const LAS unsigned char* ar = c.lds + (32 * (c.wave >> 2) + l31) * RS + 16 * h5;
        const LAS unsigned char* br = c.lds + ABYTES + (32 * (c.wave & 3) + l31) * RS + 16 * h5;
#pragma unroll 1
        for (int s = 0; s < 8; ++s) {
            if (s < 7) MINI_G(128 * (s + 1));
            const int bo = (s & 1) * STG;
#pragma unroll
            for (int k = 0; k < 8; ++k) { const bf16x8 af = *(const LAS bf16x8*)(ar + bo + 32 * k), wf = *(const LAS bf16x8*)(br + bo + 32 * k); acc = MFMA32(wf, af, acc); }
            if (s < 7) MINI_W((s + 1) & 1);
            lds_barrier();
        }
#undef MINI_G
#undef MINI_W
#pragma unroll
        for (int q = 0; q < 4; ++q) { const int col = n0 + 8 * q + 4 * h5; const size_t o = (size_t)row * D + col;
            u32x2 w; w.x = cvt_pk_bf16(xo[q][0] + g1[q].x * (acc[4 * q] + bb[q].x), xo[q][1] + g1[q].y * (acc[4 * q + 1] + bb[q].y));
            w.y = cvt_pk_bf16(xo[q][2] + g1[q].z * (acc[4 * q + 2] + bb[q].z), xo[q][3] + g1[q].w * (acc[4 * q + 3] + bb[q].w));
            *(u32x2*)(XC + o) = w; }
    }
}

#define XB_TMO      128
#define XB_XCNT(j)  (256  + 64 * (j))
#define XB_XSUB(j)  (1280 + 64 * (j))
#define XB_XGEN(j)  (2304 + 64 * (j))
#define XB_TOP      3328
#define XB_TOPGEN   3392
#define XCD_BAR_WORDS 3456
#define XB_SPIN_CAP (1u << 18)
DI unsigned xb_ld(unsigned* p)              { return __hip_atomic_load(p, __ATOMIC_RELAXED, __HIP_MEMORY_SCOPE_AGENT); }
DI unsigned xb_add(unsigned* p, unsigned v) { return __hip_atomic_fetch_add(p, v, __ATOMIC_RELAXED, __HIP_MEMORY_SCOPE_AGENT); }
DI unsigned xb_xcc_id() { return (unsigned)__builtin_amdgcn_s_getreg((3 << 11) | 20) & 0xFu; }
#define XB_SPIN(cond, bar) do { unsigned _sp = 0; while (cond) { __builtin_amdgcn_s_sleep(1); \
    if ((++_sp & 255u) == 0u) { if (xb_ld(&(bar)[XB_TMO])) break; if (_sp > XB_SPIN_CAP) { atomicAdd(&(bar)[XB_TMO], 1u); break; } } } } while (0)
DI void xcd_barrier_complete(unsigned* bar, unsigned x, unsigned& nloc, unsigned& nx) {
    const unsigned G = gridDim.x * gridDim.y * gridDim.z;
    unsigned sum, cnt, mine, sp = 0u;
    for (;;) {
        sum = 0u; cnt = 0u; mine = 0u;
#pragma unroll
        for (unsigned j = 0; j < 16; ++j) { const unsigned cj = xb_ld(&bar[XB_XCNT(j)]); sum += cj; cnt += (cj > 0u) ? 1u : 0u; mine = (j == x) ? cj : mine; }
        if (sum == G) break;
        __builtin_amdgcn_s_sleep(1);
        if ((++sp & 255u) == 0u) { if (xb_ld(&bar[XB_TMO])) break; if (sp > XB_SPIN_CAP) { atomicAdd(&bar[XB_TMO], 1u); break; } }
    }
    nloc = mine > 0u ? mine : 1u; nx = cnt > 0u ? cnt : 1u;
}
DI void xcd_barrier(unsigned* bar, volatile LAS unsigned* st) {
    asm volatile("s_waitcnt vmcnt(0)" ::: "memory");
    __syncthreads();
    if (threadIdx.x == 0) {
        const unsigned x = xb_xcc_id();
        __builtin_amdgcn_s_waitcnt(0);
        unsigned nloc = st[0], nx = st[1];
        if (nloc == 0u) { xcd_barrier_complete(bar, x, nloc, nx); st[0] = nloc; st[1] = nx; }
        const unsigned old = xb_add(&bar[XB_XSUB(x)], 1u);
        const unsigned gen = old / nloc;
        if (old + 1u == (gen + 1u) * nloc) {
            __builtin_amdgcn_fence(__ATOMIC_RELEASE, "agent");
            asm volatile("s_waitcnt vmcnt(0)" ::: "memory");
            const unsigned og = xb_add(&bar[XB_TOP], 1u);
            const unsigned tg = og / nx;
            if (og + 1u == (tg + 1u) * nx) xb_add(&bar[XB_TOPGEN], 1u);
            else XB_SPIN(xb_ld(&bar[XB_TOPGEN]) == tg, bar);
            __builtin_amdgcn_fence(__ATOMIC_ACQUIRE, "agent");
            xb_add(&bar[XB_XGEN(x)], 1u);
            asm volatile("s_waitcnt vmcnt(0)" ::: "memory");
        } else {
            XB_SPIN(xb_ld(&bar[XB_XGEN(x)]) == gen, bar);
            __builtin_amdgcn_fence(__ATOMIC_ACQUIRE, "agent");
            asm volatile("s_waitcnt vmcnt(0)" ::: "memory");
        }
    }
    __syncthreads();
}

constexpr int NPHASE = 2 + 11 * DEPTH;
__host__ __device__ inline bool phase_active(int ph) {
    if (ph < 2) return true;
    const int l = (ph - 2) / 11, s = (ph - 2) % 11, kind = l % 3;
    if (s == 0) return false;
    if (s == 4) return kind != 2 || HY_MFMA;
    return true;
}
DI void run_phase(const Ctx& c, int ph) {
    if (ph == 0) { if constexpr (PH_EN(0)) phase_pro0(c); return; }
    if (ph == 1) { if constexpr (PH_EN(1)) { phase_pro1(c); phase_norm1(c, 0, c.in[I_X], c.in[I_CTX]); } return; }
    const int l = (ph - 2) / 11, s = (ph - 2) % 11, kind = l % 3, j = l / 3;
    switch (s) {
    case 0: if constexpr (PH_EN(2)) phase_norm1(c, 0, c.in[I_X], c.in[I_CTX]); break;
    case 1: if constexpr (PH_EN(3)) {
        DenseOrder S; EpiInproj E; E.P = WSP(bf16, WS_P); E.extra = WSP(float, WS_EXTRA); E.bias = nullptr; E.bias_x = nullptr;
        S.A = WSP(bf16, WS_H); S.ul = dense_units(c.lds, c.tid, TT, kind == 2 ? 3072 : NINP);
        if (kind == 0) { S.Bt = WSP(bf16, WS_ML_WIN) + (size_t)j * NINP * 1024; E.bias_x = c.in[I_MLBG] + j * 32; }
        else if (kind == 1) { S.Bt = WSP(bf16, WS_GLA_WIN); }
        else { S.Bt = WSP(bf16, WS_HY_WIN); E.bias = c.in[I_HYBIN]; }
        gemm_run(c.lds, c.tid, S, E);
    } break;
    case 2: if constexpr (PH_EN(4))
        if (kind == 0) phase_conv(c, 1024, c.in[I_MLCW] + j * 3 * 1024, c.in[I_MLCB] + j * 1024, true, 0.125f);
        else if (kind == 1) { phase_conv(c, 2048, c.in[I_GLCW], c.in[I_GLCB], true, 0.08838834764831845f); if constexpr (GLA_CHUNK) phase_gla_decay(c); }
        else { if constexpr (HY_MFMA) phase_hy_prep(c); else phase_conv(c, 3072, c.in[I_HYCW], c.in[I_HYCB], false, 1.0f); }
        break;
    case 3: if constexpr (PH_EN(5))
        if (kind == 0) { if constexpr (MLSTM_CHUNK) phase_mlstm_state(c); else phase_mlstm_scan_naive(c); }
        else if (kind == 1) { if constexpr (GLA_CHUNK) phase_gla_state(c); else phase_gla_scan_naive(c); }
        else { if constexpr (HY_MFMA) phase_hy_toeplitz(c); else phase_hyena_conv_naive(c); }
        break;
    case 4: if constexpr (PH_EN(6))
        if (kind == 0) { if constexpr (MLSTM_CHUNK) phase_mlstm_out(c, c.in[I_MLNG] + j * 1024, l == 3 ? 4 : 0); else phase_headnorm(c, 128, c.in[I_MLNG] + j * 1024); }
        else if (kind == 1) { if constexpr (GLA_CHUNK) phase_gla_out(c, c.in[I_GLNG]); else phase_headnorm(c, 256, c.in[I_GLNG]); }
        else { if constexpr (HY_MFMA) phase_hy_post(c); }
        break;
    case 5: if constexpr (PH_EN(7)) {
        DenseOrder S; EpiOutproj E; E.X = WSP(bf16, WS_X); E.XC = WSP(bf16, WS_XC); E.mod = WSP(float, WS_MOD) + (size_t)l * 9 * 6144; E.bias = nullptr; E.perm = (kind == 1);
        E.xs_l = (l == 0) ? c.in[I_X] : nullptr; E.xs_c = (l == 0) ? c.in[I_CTX] : nullptr; E.row_off = TC;
        const bf16* W = kind == 0 ? WSP(bf16, WS_ML_WOUT) + (size_t)j * 1024 * 1024 : kind == 1 ? WSP(bf16, WS_GLA_WOUT) : WSP(bf16, WS_HY_WOUT);
        if (kind == 2) E.bias = c.in[I_HYBOUT];
        S.A = WSP(bf16, WS_Y) + (size_t)E.row_off * D; S.Bt = W; S.ul = dense_units(c.lds, c.tid, TT - E.row_off, 1024);
        gemm_run(c.lds, c.tid, S, E);
        if (l < 3) ctx_outproj_mini(c, WSP(bf16, WS_Y), W, E.xs_c, WSP(bf16, WS_XC), E.mod + 8 * 6144, E.bias);
    } break;
    case 6: if constexpr (PH_EN(8)) phase_route(c, l); break;
    case 7: if constexpr (PH_EN(9)) phase_gather(c, l); break;
    case 8: if constexpr (PH_EN(10)) {
        MoeOrder S; S.ul = moe_tiles(c, l, 3); S.A = WSP(bf16, WS_BIG + BIG_HS); S.Bt = WSP(bf16, WS_EXP_UP) + (size_t)l * 16 * 2048 * 1024; S.bstride = (size_t)2048 * 1024;
        EpiUp E; E.ACT = WSP(bf16, WS_BIG + BIG_ACT);
        gemm_run(c.lds, c.tid, S, E);
    } break;
    case 9: if constexpr (PH_EN(11)) {
        MoeOrder S; S.ul = moe_tiles(c, l, 2); S.A = WSP(bf16, WS_BIG + BIG_ACT); S.Bt = WSP(bf16, WS_EXP_DN) + (size_t)l * 16 * 1024 * 1024; S.bstride = (size_t)1024 * 1024;
        EpiDown E; E.YS = WSP(bf16, WS_BIG + BIG_HS);
        gemm_run(c.lds, c.tid, S, E);
    } break;
    case 10: if constexpr (PH_EN(12)) phase_combine(c, l); break;
    }
}

__global__ void __launch_bounds__(512, 2) mega_fwd(Params p) {
    extern __shared__ __attribute__((aligned(16))) unsigned char lds_raw[];
#if XCD_BARRIER
    {
        volatile LAS unsigned* st0 = (volatile LAS unsigned*)((LAS unsigned char*)lds_raw + BAR_LDS_OFF);
        if (threadIdx.x == 0) { st0[0] = 0u; st0[1] = 0u; (void)xb_add((unsigned*)(p.ws + WS_CTL) + CW_BAR + XB_XCNT(xb_xcc_id()), 1u); }
        __syncthreads();
    }
#endif
    bool first = true;
    int rep = 0;
    unsigned long long tp_acc = 0, tp_prev = 0; bool tp_sel = false;
    for (int ph = p.ph_lo; ph < p.ph_hi;) {
        if (!phase_active(ph)) { ++ph; continue; }
        int z; asm volatile("s_mov_b32 %0, 0" : "=s"(z));
        if (!first) {
#if XCD_BARRIER
            xcd_barrier((unsigned*)(p.ws + z + WS_CTL) + CW_BAR, (volatile LAS unsigned*)((LAS unsigned char*)lds_raw + BAR_LDS_OFF));
#else
            cg::this_grid().sync();
#endif
        }
        first = false;
        Ctx c;
        c.lds = (LAS unsigned char*)lds_raw;
        c.tid = threadIdx.x + z; c.lane = c.tid & 63; c.wave = __builtin_amdgcn_readfirstlane(c.tid >> 6);
        c.gw = blockIdx.x * 8 + c.wave; c.ngw = gridDim.x * 8;
        c.in = (const float* const __attribute__((address_space(4)))*)__builtin_amdgcn_kernarg_segment_ptr() + z; c.out = p.out + z; c.ws = p.ws + z; c.z = (unsigned)z;
        if (TP_MASK != 0u) {
            const unsigned long long now = __builtin_amdgcn_s_memrealtime();
            if (tp_sel) tp_acc += now - tp_prev;
            tp_prev = now; tp_sel = (ph >= 2 ? (((TP_MASK >> ((ph - 2) % 11)) & 1u) && ((TP_LAYERS >> ((ph - 2) / 11)) & 1u)) : ((TP_MASK >> (16 + ph)) & 1u));
        }
        run_phase(c, ph);
        if (REP_MASK != 0u && rep == 0 && (ph >= 2 ? (((REP_MASK >> ((ph - 2) % 11)) & 1u) && ((REP_LAYERS >> ((ph - 2) / 11)) & 1u)) : ((REP_MASK >> (16 + ph)) & 1u))) rep = 1; else { rep = 0; ++ph; }
    }
    if (TP_MASK != 0u && blockIdx.x == 0) { asm volatile("s_waitcnt vmcnt(0)" ::: "memory"); __syncthreads(); const unsigned long long now = __builtin_amdgcn_s_memrealtime(); if (tp_sel) tp_acc += now - tp_prev;
        const unsigned long long t_end = now + (unsigned long long)TP_AMP * tp_acc; while (__builtin_amdgcn_s_memrealtime() < t_end) __builtin_amdgcn_s_sleep(8); }
}

extern "C" void kernel_launch(void* const* d_in, const int* in_sizes, int n_in, void* d_out, int out_size, void* d_ws, size_t ws_size, hipStream_t stream) {
    static int grid = 0;
    if (grid == 0) {
        if (n_in != 40 || ws_size < WS_END || out_size != TL * D) { fprintf(stderr, "kernel_launch: unexpected shapes (n_in %d, ws %zu, out %d)\n", n_in, ws_size, out_size); grid = -1; return; }
        int dev = 0, cus = 0, per_cu = 0;
        hipGetDevice(&dev); hipDeviceGetAttribute(&cus, hipDeviceAttributeMultiprocessorCount, dev);
        if (hipFuncSetAttribute((const void*)mega_fwd, hipFuncAttributeMaxDynamicSharedMemorySize, LDS_BYTES) != hipSuccess) { fprintf(stderr, "kernel_launch: hipFuncSetAttribute failed\n"); grid = -1; return; }
        if (hipOccupancyMaxActiveBlocksPerMultiprocessor(&per_cu, (const void*)mega_fwd, 512, LDS_BYTES) != hipSuccess || per_cu < 1) { fprintf(stderr, "kernel_launch: occupancy query says %d\n", per_cu); per_cu = 1; }
        (void)hipGetLastError();
        grid = cus;
        fprintf(stderr, "kernel_launch: grid %d (cus %d, per_cu %d)\n", grid, cus, per_cu);
    }
    if (grid < 0) return;
    hipMemsetAsync((char*)d_ws + WS_CTL, 0, 1 * MiB, stream);
    Params p{};
    for (int i = 0; i < 40; ++i) p.in[i] = (const float*)d_in[i];
    p.out = (float*)d_out; p.ws = (unsigned char*)d_ws;
#if N_LAUNCH_PER_PHASE
    for (int ph = 0; ph < NPHASE; ++ph) {
        if (!phase_active(ph)) continue;
        p.ph_lo = ph; p.ph_hi = ph + 1; void* args[] = {&p};
        hipError_t e = hipLaunchCooperativeKernel((const void*)mega_fwd, dim3(grid), dim3(512), args, LDS_BYTES, stream);
        if (e != hipSuccess) { fprintf(stderr, "launch failed: %s\n", hipGetErrorString(e)); break; }
    }
#else
    p.ph_lo = 0; p.ph_hi = NPHASE; void* args[] = {&p};
    hipError_t e = hipLaunchCooperativeKernel((const void*)mega_fwd, dim3(grid), dim3(512), args, LDS_BYTES, stream);
    if (e != hipSuccess) fprintf(stderr, "cooperative launch failed: %s (grid %d)\n", hipGetErrorString(e), grid);
#endif
}
```
